# Optimizing an MI355X kernel written in HIP

```python
import math
import jax, jax.numpy as jnp
from jax import lax
import numpy as np

D_MODEL = 1024
BATCH = 16
SEQ = 256
DEPTH = 2
DEC_BATCH = 4
DEC_SEQ = 2048
PAST_LEN = 256

GRID_W = 64
N_AB = (DEPTH + 1) // 2
N_C = DEPTH // 2
EPS = 1e-6
RW_HEADS = 8
RW_HEAD = 64
RW_DIM = RW_HEADS * RW_HEAD
W_LORA = 64
A_LORA = 64
G_LORA = 128
LNX_EPS = 64e-5
RW_IN = 3 * RW_DIM + W_LORA + A_LORA + G_LORA
RW_SPLITS = (RW_DIM, 2 * RW_DIM, 3 * RW_DIM, 3 * RW_DIM + W_LORA, 3 * RW_DIM + W_LORA + A_LORA)
MLA_HEADS = 4
QK_NOPE = 128
QK_ROPE = 64
QK_HEAD = QK_NOPE + QK_ROPE
V_HEAD = 128
Q_LORA = 256
KV_LORA = 128
MLA_DIM = MLA_HEADS * V_HEAD
MLA_IN = Q_LORA + KV_LORA + QK_ROPE
AB_IN = RW_IN + MLA_IN
ROPE_THETA = 10000.0
Q_BLOCK = 128
HY_SHORT = 3
HY_BANDS = 16
HY_EMB = 1 + 2 * HY_BANDS
HY_HIDDEN = 64
HY_TARGET = 1e-2
HY_FAST = 0.3
HY_SLOW = 1.5
PEER_KEYS = 128
PEER_N = PEER_KEYS * PEER_KEYS
PEER_HEADS = 8
PEER_DKEY = 256
PEER_TOPK = 16
TOKEN_BLOCK = 128

kernel_name = 'rwkv7_mla_hyena_peer_prefix_diffusion_step'


def rmsnorm(x, g):
    xf = x.astype(jnp.float32)
    y = xf * lax.rsqrt(jnp.mean(xf * xf, axis=-1, keepdims=True) + EPS)
    return (y * g.astype(jnp.float32)).astype(x.dtype)


def modulate(h, shift, scale):
    return h * (1.0 + scale) + shift


def centred_shift(x):
    prev = jnp.pad(x[:, :-1], ((0, 0), (1, 0), (0, 0)))
    nxt = jnp.pad(x[:, 1:], ((0, 0), (0, 1), (0, 0)))
    return 0.5 * (prev + nxt)


def centred_dwconv3(u, w, b):
    prev = jnp.pad(u[:, :-1], ((0, 0), (1, 0), (0, 0)))
    nxt = jnp.pad(u[:, 1:], ((0, 0), (0, 1), (0, 0)))
    return prev * w[0] + u * w[1] + nxt * w[2] + b


def axial_rope(L):
    rows = L // GRID_W
    row = jnp.repeat(jnp.arange(rows, dtype=jnp.float32), GRID_W)
    col = jnp.tile(jnp.arange(GRID_W, dtype=jnp.float32), rows)
    n_freq = QK_ROPE // 4
    inv = ROPE_THETA ** (-jnp.arange(n_freq, dtype=jnp.float32) / n_freq)
    ang = jnp.concatenate([row[:, None] * inv, col[:, None] * inv], axis=-1)
    return jnp.cos(ang), jnp.sin(ang)


def rope_tail(x, cos, sin):
    xn, xr = x[..., :QK_NOPE], x[..., QK_NOPE:]
    x1, x2 = xr[..., 0::2], xr[..., 1::2]
    cs = cos[None, :, None, :].astype(x.dtype)
    sn = sin[None, :, None, :].astype(x.dtype)
    rot = jnp.stack([x1 * cs - x2 * sn, x1 * sn + x2 * cs], axis=-1).reshape(xr.shape)
    return jnp.concatenate([xn, rot], axis=-1)


def attend(q, k, v):
    B, Lq, H, Dh = q.shape
    nb = Lq // Q_BLOCK
    qb = q.reshape(B, nb, Q_BLOCK, H, Dh).transpose(1, 0, 2, 3, 4)
    scale = Dh ** -0.5

    def blk(qi):
        s = jnp.einsum('bqhd,bkhd->bhqk', qi, k).astype(jnp.float32) * scale
        p = jax.nn.softmax(s, axis=-1).astype(v.dtype)
        return jnp.einsum('bhqk,bkhd->bqhd', p, v)

    o = lax.map(blk, qb)
    return o.transpose(1, 0, 2, 3, 4).reshape(B, Lq, H * v.shape[-1])


def rwkv7_scan(r, w, k, v, a, b, s0, reverse):
    def step(s, inp):
        r_t, w_t, k_t, v_t, a_t, b_t = inp
        sa = jnp.einsum('bhvk,bhk->bhv', s, a_t)
        s = s * w_t[:, :, None, :] + sa[..., None] * b_t[:, :, None, :] + v_t[..., None] * k_t[:, :, None, :]
        return s, jnp.einsum('bhvk,bhk->bhv', s, r_t)

    xs = tuple(jnp.swapaxes(t.astype(jnp.float32), 0, 1) for t in (r, w, k, v, a, b))
    s_fin, ys = lax.scan(step, s0.astype(jnp.float32), xs, reverse=reverse)
    return jnp.swapaxes(ys, 0, 1), s_fin


def mla_keys(ckv, k_pe, kv_up, kn):
    B, L, _ = ckv.shape
    kv = (ckv @ kv_up).reshape(B, L, MLA_HEADS, QK_NOPE + V_HEAD)
    k_rope = jnp.broadcast_to(k_pe[:, :, None, :], (B, L, MLA_HEADS, QK_ROPE))
    k = rmsnorm(jnp.concatenate([kv[..., :QK_NOPE], k_rope], axis=-1), kn)
    return k, kv[..., QK_NOPE:]


def rwkv_mla_mixer(h, ctx, p):
    (w_in, mu, w0, w2, a0, a2, g2, k_k, k_a, r_k, lnx_g, lnx_b,
     q_norm, q_up, kv_norm, kv_up, qn, kn, w_out) = p
    B, L, _ = h.shape
    f32 = jnp.float32
    proj = h @ w_in
    rw, mla = proj[..., :RW_IN], proj[..., RW_IN:]
    rw = rw + mu * (centred_shift(rw) - rw)
    r, k, v, wd, ad, gd = jnp.split(rw, RW_SPLITS, axis=-1)
    heads = lambda t: t.reshape(B, L, RW_HEADS, RW_HEAD)
    rh, vh = heads(r.astype(f32)), heads(v.astype(f32))
    kk = heads((k * k_k).astype(f32))
    kk = kk / jnp.maximum(jnp.linalg.norm(kk, axis=-1, keepdims=True), 1e-12)
    if ctx is None:
        z = jnp.zeros((B, RW_HEADS, RW_HEAD, RW_HEAD), f32)
        s0s = (z, z)
    else:
        s0s = (ctx[0], ctx[1])
    ys, finals, bonus = [], [], []
    for d in range(2):
        w_raw = (w0[d] + jnp.tanh(wd) @ w2[d]).astype(f32)
        decay = jnp.exp(-jnp.exp(-jax.nn.softplus(-w_raw) - 0.5))
        lr = jax.nn.sigmoid((a0[d] + ad @ a2[d]).astype(f32))
        kd = heads(k.astype(f32) * (1.0 + (lr - 1.0) * k_a))
        yd, sd = rwkv7_scan(rh, heads(decay), kd, vh, -kk, kk * heads(lr), s0s[d], d == 1)
        ys.append(yd)
        finals.append(sd)
        bonus.append(jnp.sum(rh * kd * r_k, axis=-1, keepdims=True) * vh)
    y = ys[0] + ys[1]
    mean = jnp.mean(y, axis=-1, keepdims=True)
    var = jnp.mean(jnp.square(y - mean), axis=-1, keepdims=True)
    yn = ((y - mean) * lax.rsqrt(var + LNX_EPS)).reshape(B, L, RW_DIM) * lnx_g + lnx_b
    gate = jax.nn.sigmoid(gd) @ g2
    rw_out = ((yn + (bonus[0] + bonus[1]).reshape(B, L, RW_DIM)) * gate).astype(h.dtype)
    q_c, kv_c, k_pe = jnp.split(mla, (Q_LORA, Q_LORA + KV_LORA), axis=-1)
    q = rmsnorm((rmsnorm(q_c, q_norm) @ q_up).reshape(B, L, MLA_HEADS, QK_HEAD), qn)
    ckv = rmsnorm(kv_c, kv_norm)
    k_own, v_own = mla_keys(ckv, k_pe, kv_up, kn)
    if ctx is None:
        keys, vals = k_own, v_own
    else:
        cos, sin = ctx[4]
        q = rope_tail(q, cos, sin)
        k_own = rope_tail(k_own, cos, sin)
        k_ctx, v_ctx = mla_keys(ctx[2], ctx[3], kv_up, kn)
        keys = jnp.concatenate([k_ctx, k_own], axis=1)
        vals = jnp.concatenate([v_ctx, v_own], axis=1)
    mla_out = attend(q, keys, vals)
    out = jnp.concatenate([rw_out, mla_out.astype(h.dtype)], axis=-1) @ w_out
    return out, finals[0], finals[1], ckv, k_pe


def hyena_filters(L, w1, b1, w2, b2, w3, freq):
    f32 = jnp.float32
    t = jnp.arange(L, dtype=f32)[:, None]
    t_unit = t / (L - 1)
    bands = jnp.linspace(1e-4, HY_BANDS - 1, HY_BANDS, dtype=f32)
    ang = 2.0 * math.pi * t * bands / L
    zpos = jnp.concatenate([t_unit, jnp.cos(ang), -jnp.sin(ang)], axis=-1)
    fr = freq.astype(f32)
    hid = jnp.sin(fr * (zpos @ w1.astype(f32) + b1.astype(f32)))
    hid = jnp.sin(fr * (hid @ w2.astype(f32) + b2.astype(f32)))
    filt = hid @ w3.astype(f32)
    deltas = jnp.linspace(math.log(HY_TARGET) / HY_FAST, math.log(HY_TARGET) / HY_SLOW, D_MODEL, dtype=f32)
    window = jnp.exp(-t_unit * jnp.abs(deltas))
    h_f = filt[:, :D_MODEL] * window
    h_b = filt[:, D_MODEL:] * window
    circ = jnp.concatenate([h_f, jnp.zeros((1, D_MODEL), f32), h_b[:0:-1]], axis=0)
    return circ / jnp.sum(jnp.abs(circ), axis=0, keepdims=True)


def hyena_mixer(h, p):
    w_in, b_in, conv_w, conv_b, f_w1, f_b1, f_w2, f_b2, f_w3, f_freq, bias, w_out = p
    B, L, _ = h.shape
    u = centred_dwconv3(h @ w_in + b_in, conv_w, conv_b)
    x0, x1, v = jnp.split(u, 3, axis=-1)
    zin = (x1 * v).astype(jnp.float32)
    filt_f = jnp.fft.rfft(hyena_filters(L, f_w1, f_b1, f_w2, f_b2, f_w3, f_freq), axis=0)
    conv = jnp.fft.irfft(jnp.fft.rfft(zin, n=2 * L, axis=1) * filt_f, n=2 * L, axis=1)[:, :L]
    y = conv + zin * bias.astype(jnp.float32)
    return (x0 * y.astype(h.dtype)) @ w_out


def peer_ffn(h, w_q, sub_keys, u_tab, v_tab):
    B, L, D = h.shape
    nb = (B * L) // TOKEN_BLOCK

    def blk(xb):
        q = (xb @ w_q).reshape(TOKEN_BLOCK, PEER_HEADS, 2, PEER_DKEY // 2)
        s = jnp.einsum('thpd,hpnd->thpn', q, sub_keys).astype(jnp.float32)
        s1, i1 = lax.top_k(s[:, :, 0], PEER_TOPK)
        s2, i2 = lax.top_k(s[:, :, 1], PEER_TOPK)
        cand = (s1[..., :, None] + s2[..., None, :]).reshape(TOKEN_BLOCK, PEER_HEADS, PEER_TOPK * PEER_TOPK)
        cidx = (i1[..., :, None] * PEER_KEYS + i2[..., None, :]).reshape(TOKEN_BLOCK, PEER_HEADS, PEER_TOPK * PEER_TOPK)
        top_s, pos = lax.top_k(cand, PEER_TOPK)
        idx = jnp.take_along_axis(cidx, pos, axis=-1)
        g = jax.nn.softmax(top_s, axis=-1).astype(xb.dtype)
        act = jax.nn.gelu(jnp.einsum('thkd,td->thk', u_tab[idx], xb))
        return jnp.einsum('thk,thkd->td', g * act, v_tab[idx])

    out = lax.map(blk, h.reshape(nb, TOKEN_BLOCK, D))
    return out.reshape(B, L, D)


def setup_inputs(seed: int = 0) -> dict:
    key = jax.random.key(seed)
    keys = iter(jax.random.split(key, 64))

    def nrm(shape, scale):
        return jax.random.normal(next(keys), shape, jnp.float32) * scale

    def gain(shape):
        return 1.0 + nrm(shape, 0.02)

    D = D_MODEL
    return {
        'x_prompt': nrm((BATCH, SEQ, D), 1.0),
        'x_sample': nrm((DEC_BATCH, DEC_SEQ, D), 1.0),
        'state_rwkv_fwd': nrm((DEC_BATCH, N_AB, RW_HEADS, RW_HEAD, RW_HEAD), 0.5),
        'state_rwkv_bwd': nrm((DEC_BATCH, N_AB, RW_HEADS, RW_HEAD, RW_HEAD), 0.5),
        'cache_mla_ckv': nrm((DEC_BATCH, N_AB, PAST_LEN, KV_LORA), 1.0),
        'cache_mla_kpe': nrm((DEC_BATCH, N_AB, PAST_LEN, QK_ROPE), 1.0),
        'c': nrm((DEC_BATCH, D), 1.0),
        'c_ctx': nrm((D,), 1.0),
        'norm_g': gain((DEPTH, 2, D)),
        'w_mod': nrm((DEPTH, D, 6 * D), D ** -0.5),
        'b_mod': nrm((DEPTH, 6 * D), 0.02),
        'ab_w_in': nrm((N_AB, D, AB_IN), D ** -0.5),
        'rw_mu': jax.random.uniform(next(keys), (N_AB, RW_IN), jnp.float32, 0.1, 0.9),
        'rw_w0': nrm((N_AB, 2, RW_DIM), 0.5),
        'rw_w2': nrm((N_AB, 2, W_LORA, RW_DIM), 0.1),
        'rw_a0': nrm((N_AB, 2, RW_DIM), 0.3),
        'rw_a2': nrm((N_AB, 2, A_LORA, RW_DIM), 0.1),
        'rw_g2': nrm((N_AB, G_LORA, RW_DIM), G_LORA ** -0.5),
        'rw_k_k': 0.85 + nrm((N_AB, RW_DIM), 0.02),
        'rw_k_a': gain((N_AB, RW_DIM)),
        'rw_r_k': nrm((N_AB, RW_HEADS, RW_HEAD), 0.1),
        'rw_lnx_g': gain((N_AB, RW_DIM)),
        'rw_lnx_b': nrm((N_AB, RW_DIM), 0.02),
        'mla_q_norm': gain((N_AB, Q_LORA)),
        'mla_q_up': nrm((N_AB, Q_LORA, MLA_HEADS * QK_HEAD), Q_LORA ** -0.5),
        'mla_kv_norm': gain((N_AB, KV_LORA)),
        'mla_kv_up': nrm((N_AB, KV_LORA, MLA_HEADS * (QK_NOPE + V_HEAD)), KV_LORA ** -0.5),
        'mla_qn': gain((N_AB, QK_HEAD)),
        'mla_kn': gain((N_AB, QK_HEAD)),
        'ab_w_out': nrm((N_AB, RW_DIM + MLA_DIM, D), (RW_DIM + MLA_DIM) ** -0.5),
        'hy_w_in': nrm((N_C, D, 3 * D), D ** -0.5),
        'hy_b_in': nrm((N_C, 3 * D), 0.02),
        'hy_conv_w': nrm((N_C, HY_SHORT, 3 * D), 0.5),
        'hy_conv_b': nrm((N_C, 3 * D), 0.02),
        'hy_f_w1': nrm((N_C, HY_EMB, HY_HIDDEN), HY_EMB ** -0.5),
        'hy_f_b1': nrm((N_C, HY_HIDDEN), 0.1),
        'hy_f_w2': nrm((N_C, HY_HIDDEN, HY_HIDDEN), HY_HIDDEN ** -0.5),
        'hy_f_b2': nrm((N_C, HY_HIDDEN), 0.1),
        'hy_f_w3': nrm((N_C, HY_HIDDEN, 2 * D), HY_HIDDEN ** -0.5),
        'hy_f_freq': gain((N_C, HY_HIDDEN)),
        'hy_bias': nrm((N_C, D), 0.1),
        'hy_w_out': nrm((N_C, D, D), D ** -0.5),
        'peer_w_q': nrm((DEPTH, D, PEER_HEADS * PEER_DKEY), D ** -0.5),
        'peer_keys': nrm((DEPTH, PEER_HEADS, 2, PEER_KEYS, PEER_DKEY // 2), (PEER_DKEY // 2) ** -0.5),
        'peer_u': nrm((DEPTH, PEER_N, D), D ** -0.5),
        'peer_v': nrm((DEPTH, PEER_N, D), 0.05),
    }


def reference(x_prompt, x_sample, state_rwkv_fwd, state_rwkv_bwd, cache_mla_ckv, cache_mla_kpe, c, c_ctx,
              norm_g, w_mod, b_mod, ab_w_in, rw_mu, rw_w0, rw_w2, rw_a0, rw_a2, rw_g2, rw_k_k, rw_k_a, rw_r_k,
              rw_lnx_g, rw_lnx_b, mla_q_norm, mla_q_up, mla_kv_norm, mla_kv_up, mla_qn, mla_kn, ab_w_out,
              hy_w_in, hy_b_in, hy_conv_w, hy_conv_b, hy_f_w1, hy_f_b1, hy_f_w2, hy_f_b2, hy_f_w3, hy_f_freq,
              hy_bias, hy_w_out, peer_w_q, peer_keys, peer_u, peer_v):
    rope = axial_rope(x_sample.shape[1])
    xp, xs = x_prompt, x_sample
    st_f, st_b, st_ckv, st_kpe = [], [], [], []
    for li in range(DEPTH):
        j = li // 2
        mp = jnp.split(jax.nn.silu(c_ctx) @ w_mod[li] + b_mod[li], 6, axis=-1)
        ms = [m[:, None, :] for m in jnp.split(jax.nn.silu(c) @ w_mod[li] + b_mod[li], 6, axis=-1)]
        hp = modulate(rmsnorm(xp, norm_g[li, 0]), mp[0], mp[1])
        hs = modulate(rmsnorm(xs, norm_g[li, 0]), ms[0], ms[1])
        if li % 2 == 0:
            p = (ab_w_in[j], rw_mu[j], rw_w0[j], rw_w2[j], rw_a0[j], rw_a2[j], rw_g2[j], rw_k_k[j], rw_k_a[j],
                 rw_r_k[j], rw_lnx_g[j], rw_lnx_b[j], mla_q_norm[j], mla_q_up[j], mla_kv_norm[j], mla_kv_up[j],
                 mla_qn[j], mla_kn[j], ab_w_out[j])
            op, sf, sb, ckv, kpe = rwkv_mla_mixer(hp, None, p)
            ctx = (state_rwkv_fwd[:, j], state_rwkv_bwd[:, j], cache_mla_ckv[:, j], cache_mla_kpe[:, j], rope)
            os_, _, _, _, _ = rwkv_mla_mixer(hs, ctx, p)
            st_f.append(sf)
            st_b.append(sb)
            st_ckv.append(ckv)
            st_kpe.append(kpe)
        else:
            p = (hy_w_in[j], hy_b_in[j], hy_conv_w[j], hy_conv_b[j], hy_f_w1[j], hy_f_b1[j], hy_f_w2[j],
                 hy_f_b2[j], hy_f_w3[j], hy_f_freq[j], hy_bias[j], hy_w_out[j])
            op = hyena_mixer(hp, p)
            os_ = hyena_mixer(hs, p)
        xp = xp + mp[2] * op
        xs = xs + ms[2] * os_
        pp = (peer_w_q[li], peer_keys[li], peer_u[li], peer_v[li])
        xp = xp + mp[5] * peer_ffn(modulate(rmsnorm(xp, norm_g[li, 1]), mp[3], mp[4]), *pp)
        xs = xs + ms[5] * peer_ffn(modulate(rmsnorm(xs, norm_g[li, 1]), ms[3], ms[4]), *pp)
    new_state_rwkv_fwd = jnp.stack(st_f, axis=1).astype(x_prompt.dtype)
    new_state_rwkv_bwd = jnp.stack(st_b, axis=1).astype(x_prompt.dtype)
    new_cache_mla_ckv = jnp.stack(st_ckv, axis=1)
    new_cache_mla_kpe = jnp.stack(st_kpe, axis=1)
    return (xp, xs, new_state_rwkv_fwd, new_state_rwkv_bwd, new_cache_mla_ckv, new_cache_mla_kpe)
```

```cpp
#include <hip/hip_runtime.h>
#include <stdint.h>

#define DM 1024
#define TP 4096
#define TS 8192
#define TT 12288
#define LP 256
#define LS 2048
#define NBP 16
#define NBS 4
#define ABIN 2240
#define RWIN 1792

typedef unsigned short bf16_t;
__device__ __forceinline__ bf16_t f2bf(float f) { unsigned u = __float_as_uint(f); u += 0x7fffu + ((u >> 16) & 1u); return (bf16_t)(u >> 16); }
__device__ __forceinline__ float bf2f(bf16_t h) { return __uint_as_float(((unsigned)h) << 16); }
__device__ __forceinline__ float sigmoidf_(float x) { return 1.f / (1.f + expf(-x)); }
__device__ __forceinline__ float gelu_tanh(float x) { return 0.5f * x * (1.f + tanhf(0.7978845608028654f * (x + 0.044715f * x * x * x))); }

__device__ __forceinline__ int tok_pos(int t) { return t < TP ? (t & (LP - 1)) : ((t - TP) & (LS - 1)); }
__device__ __forceinline__ int tok_len(int t) { return t < TP ? LP : LS; }
__device__ __forceinline__ int tok_modrow(int t) { return t < TP ? 0 : 1 + ((t - TP) >> 11); }

__device__ __forceinline__ float wave_sum(float v) {
#pragma unroll
    for (int o = 32; o > 0; o >>= 1) v += __shfl_xor(v, o, 64);
    return v;
}

__global__ void __launch_bounds__(256) k_mod(const float* __restrict__ c, const float* __restrict__ c_ctx, const float* __restrict__ w_mod,
                                             const float* __restrict__ b_mod, float* __restrict__ mod) {
    __shared__ float s[5][1024];
    const int li = blockIdx.y;
    const int n = blockIdx.x * 256 + threadIdx.x;
    for (int i = threadIdx.x; i < 5 * 1024; i += 256) {
        int r = i >> 10, k = i & 1023;
        float v = (r == 0) ? c_ctx[k] : c[(r - 1) * 1024 + k];
        s[r][k] = v / (1.f + expf(-v));
    }
    __syncthreads();
    float a0 = 0, a1 = 0, a2 = 0, a3 = 0, a4 = 0;
    const float* w = w_mod + (size_t)li * 1024 * 6144 + n;
    for (int k = 0; k < 1024; k++) {
        float wv = w[(size_t)k * 6144];
        a0 += s[0][k] * wv; a1 += s[1][k] * wv; a2 += s[2][k] * wv; a3 += s[3][k] * wv; a4 += s[4][k] * wv;
    }
    float bb = b_mod[li * 6144 + n];
    float* o = mod + (size_t)li * 5 * 6144 + n;
    o[0 * 6144] = a0 + bb; o[1 * 6144] = a1 + bb; o[2 * 6144] = a2 + bb; o[3 * 6144] = a3 + bb; o[4 * 6144] = a4 + bb;
}

__global__ void __launch_bounds__(256) k_norm_mod(const float* __restrict__ xa, const float* __restrict__ xb, const float* __restrict__ g,
                                                  const float* __restrict__ modl, int shift_idx, int scale_idx, float* __restrict__ h) {
    __shared__ float red[4];
    const int t = blockIdx.x;
    const float* x = (t < TP) ? (xa + (size_t)t * DM) : (xb + (size_t)(t - TP) * DM);
    const int c = threadIdx.x * 4;
    float4 v = *(const float4*)(x + c);
    float ss = v.x * v.x + v.y * v.y + v.z * v.z + v.w * v.w;
    ss = wave_sum(ss);
    if ((threadIdx.x & 63) == 0) red[threadIdx.x >> 6] = ss;
    __syncthreads();
    float tot = red[0] + red[1] + red[2] + red[3];
    float rstd = rsqrtf(tot * (1.f / DM) + 1e-6f);
    const float* m = modl + (size_t)tok_modrow(t) * 6144;
    float4 gg = *(const float4*)(g + c);
    float4 sh = *(const float4*)(m + shift_idx * 1024 + c);
    float4 sc = *(const float4*)(m + scale_idx * 1024 + c);
    float4 o;
    o.x = v.x * rstd * gg.x * (1.f + sc.x) + sh.x;
    o.y = v.y * rstd * gg.y * (1.f + sc.y) + sh.y;
    o.z = v.z * rstd * gg.z * (1.f + sc.z) + sh.z;
    o.w = v.w * rstd * gg.w * (1.f + sc.w) + sh.w;
    *(float4*)(h + (size_t)t * DM + c) = o;
}

struct EpiStore { float* C; const float* bias; int ldc; int pad;
    __device__ void operator()(int m, int n, float a) const { C[(size_t)m * ldc + n] = a + (bias ? bias[n] : 0.f); } };
struct EpiStoreBf { bf16_t* C; int ldc; int pad;
    __device__ void operator()(int m, int n, float a) const { C[(size_t)m * ldc + n] = f2bf(a); } };
struct EpiDecay { float* out; const float* w0;
    __device__ void operator()(int m, int n, float a) const { out[(size_t)m * 512 + n] = expf(-0.6065306597126334f * sigmoidf_(w0[n] + a)); } };
struct EpiLr { bf16_t* out; const float* a0;
    __device__ void operator()(int m, int n, float a) const { out[(size_t)m * 512 + n] = f2bf(sigmoidf_(a0[n] + a)); } };
struct EpiResid { const float* xa; const float* xb; float* out; const float* modl; int gate_idx; int pad;
    __device__ void operator()(int m, int n, float a) const {
        float x = (m < TP) ? xa[(size_t)m * DM + n] : xb[(size_t)(m - TP) * DM + n];
        float gt = modl[(size_t)tok_modrow(m) * 6144 + gate_idx * 1024 + n];
        out[(size_t)m * DM + n] = x + gt * a; } };

template <class Epi>
__global__ void __launch_bounds__(256) k_gemm(const float* __restrict__ A, int lda, const float* __restrict__ B, int ldb, int K, Epi epi) {
    __shared__ float As[16][68];
    __shared__ __attribute__((aligned(16))) float Bs[16][68];
    const int m0 = blockIdx.y * 64, n0 = blockIdx.x * 64;
    const int tid = threadIdx.x, tx = tid & 15, ty = tid >> 4;
    float acc[4][4];
#pragma unroll
    for (int i = 0; i < 4; i++)
#pragma unroll
        for (int j = 0; j < 4; j++) acc[i][j] = 0.f;
    for (int k0 = 0; k0 < K; k0 += 16) {
        {
            int r = tid >> 2, kq = (tid & 3) * 4;
            float4 v = *(const float4*)(A + (size_t)(m0 + r) * lda + k0 + kq);
            As[kq + 0][r] = v.x; As[kq + 1][r] = v.y; As[kq + 2][r] = v.z; As[kq + 3][r] = v.w;
        }
        {
            int kk = tid >> 4, nq = (tid & 15) * 4;
            float4 v = *(const float4*)(B + (size_t)(k0 + kk) * ldb + n0 + nq);
            *(float4*)&Bs[kk][nq] = v;
        }
        __syncthreads();
#pragma unroll
        for (int k = 0; k < 16; k++) {
            float a[4], b[4];
#pragma unroll
            for (int i = 0; i < 4; i++) a[i] = As[k][ty * 4 + i];
            float4 bv = *(const float4*)&Bs[k][tx * 4];
            b[0] = bv.x; b[1] = bv.y; b[2] = bv.z; b[3] = bv.w;
#pragma unroll
            for (int i = 0; i < 4; i++)
#pragma unroll
                for (int j = 0; j < 4; j++) acc[i][j] += a[i] * b[j];
        }
        __syncthreads();
    }
#pragma unroll
    for (int i = 0; i < 4; i++)
#pragma unroll
        for (int j = 0; j < 4; j++) epi(m0 + ty * 4 + i, n0 + tx * 4 + j, acc[i][j]);
}

__global__ void __launch_bounds__(256) k_rw_shift(const float* __restrict__ proj, const float* __restrict__ mu, bf16_t* __restrict__ rb,
                                                  bf16_t* __restrict__ kb, bf16_t* __restrict__ vb, float* __restrict__ tw, float* __restrict__ adv,
                                                  float* __restrict__ sg) {
    const int t = blockIdx.x;
    const int pos = tok_pos(t), L = tok_len(t);
    const float* P = proj + (size_t)t * ABIN;
    for (int c = threadIdx.x; c < RWIN; c += 256) {
        float cur = P[c];
        float prev = (pos > 0) ? P[c - ABIN] : 0.f;
        float nxt = (pos < L - 1) ? P[c + ABIN] : 0.f;
        float val = cur + mu[c] * (0.5f * (prev + nxt) - cur);
        if (c < 512) rb[(size_t)t * 512 + c] = f2bf(val);
        else if (c < 1024) kb[(size_t)t * 512 + c - 512] = f2bf(val);
        else if (c < 1536) vb[(size_t)t * 512 + c - 1024] = f2bf(val);
        else if (c < 1600) tw[(size_t)t * 64 + c - 1536] = tanhf(val);
        else if (c < 1664) adv[(size_t)t * 64 + c - 1600] = val;
        else sg[(size_t)t * 128 + c - 1664] = sigmoidf_(val);
    }
}

__global__ void __launch_bounds__(256) k_rw_kk(const bf16_t* __restrict__ rb, const bf16_t* __restrict__ kb, const bf16_t* __restrict__ lr0,
                                               const bf16_t* __restrict__ lr1, const float* __restrict__ k_k, const float* __restrict__ k_a,
                                               const float* __restrict__ r_k, bf16_t* __restrict__ kkb, float* __restrict__ bonus) {
    const int w = blockIdx.x * 4 + (threadIdx.x >> 6);
    const int lane = threadIdx.x & 63;
    const int t = w >> 3, h = w & 7;
    const size_t o = (size_t)t * 512 + h * 64 + lane;
    const int ch = h * 64 + lane;
    float k = bf2f(kb[o]), r = bf2f(rb[o]);
    float kk = k * k_k[ch];
    float nrm = sqrtf(wave_sum(kk * kk));
    kk = kk / fmaxf(nrm, 1e-12f);
    kkb[o] = f2bf(kk);
    float l0 = bf2f(lr0[o]), l1 = bf2f(lr1[o]);
    float ka = k_a[ch];
    float kd0 = k * (1.f + (l0 - 1.f) * ka), kd1 = k * (1.f + (l1 - 1.f) * ka);
    float s = wave_sum(r * (kd0 + kd1) * r_k[ch]);
    if (lane == 0) bonus[w] = s;
}

__global__ void __launch_bounds__(64) k_scan(const bf16_t* __restrict__ rb, const bf16_t* __restrict__ kb, const bf16_t* __restrict__ vb,
                                             const bf16_t* __restrict__ kkb, const bf16_t* __restrict__ lr0, const bf16_t* __restrict__ lr1,
                                             const float* __restrict__ dec0, const float* __restrict__ dec1, const float* __restrict__ k_a,
                                             const float* __restrict__ st_f, const float* __restrict__ st_b, float* __restrict__ y0,
                                             float* __restrict__ y1, float* __restrict__ out_sf, float* __restrict__ out_sb) {
    __shared__ __attribute__((aligned(16))) float sa_[64];
    __shared__ __attribute__((aligned(16))) float sw_[64];
    __shared__ __attribute__((aligned(16))) float sb_[64];
    __shared__ __attribute__((aligned(16))) float skd_[64];
    __shared__ __attribute__((aligned(16))) float sr_[64];
    int id = blockIdx.x;
    int d, h, b, L, tbase;
    bool prompt = id < 256;
    if (prompt) { d = id & 1; h = (id >> 1) & 7; b = id >> 4; L = LP; tbase = b * LP; }
    else { int j = id - 256; d = j & 1; h = (j >> 1) & 7; b = j >> 4; L = LS; tbase = TP + b * LS; }
    const int v = threadIdx.x;
    const bf16_t* lr = d ? lr1 : lr0;
    const float* dec = d ? dec1 : dec0;
    float* yo = d ? y1 : y0;
    const float ka = k_a[h * 64 + v];
    float S[64];
    if (prompt) {
#pragma unroll
        for (int k = 0; k < 64; k++) S[k] = 0.f;
    } else {
        const float* st = (d ? st_b : st_f) + ((size_t)(b * 8 + h) * 64 + v) * 64;
#pragma unroll
        for (int k = 0; k < 64; k += 4) { float4 q = *(const float4*)(st + k); S[k] = q.x; S[k + 1] = q.y; S[k + 2] = q.z; S[k + 3] = q.w; }
    }
    for (int i = 0; i < L; i++) {
        const int t = tbase + (d ? (L - 1 - i) : i);
        const size_t o = (size_t)t * 512 + h * 64 + v;
        float kkv = bf2f(kkb[o]), lrv = bf2f(lr[o]), kv = bf2f(kb[o]), rv = bf2f(rb[o]), vv = bf2f(vb[o]), wv = dec[o];
        __syncthreads();
        sa_[v] = -kkv; sb_[v] = kkv * lrv; skd_[v] = kv * (1.f + (lrv - 1.f) * ka); sw_[v] = wv; sr_[v] = rv;
        __syncthreads();
        float sa = 0.f;
#pragma unroll
        for (int k = 0; k < 64; k += 4) { float4 a = *(const float4*)&sa_[k]; sa += S[k] * a.x + S[k + 1] * a.y + S[k + 2] * a.z + S[k + 3] * a.w; }
        float y = 0.f;
#pragma unroll
        for (int k = 0; k < 64; k += 4) {
            float4 w4 = *(const float4*)&sw_[k]; float4 b4 = *(const float4*)&sb_[k]; float4 k4 = *(const float4*)&skd_[k]; float4 r4 = *(const float4*)&sr_[k];
            S[k] = S[k] * w4.x + sa * b4.x + vv * k4.x; y += S[k] * r4.x;
            S[k + 1] = S[k + 1] * w4.y + sa * b4.y + vv * k4.y; y += S[k + 1] * r4.y;
            S[k + 2] = S[k + 2] * w4.z + sa * b4.z + vv * k4.z; y += S[k + 2] * r4.z;
            S[k + 3] = S[k + 3] * w4.w + sa * b4.w + vv * k4.w; y += S[k + 3] * r4.w;
        }
        yo[o] = y;
    }
    if (prompt) {
        float* os = (d ? out_sb : out_sf) + ((size_t)(b * 8 + h) * 64 + v) * 64;
#pragma unroll
        for (int k = 0; k < 64; k += 4) *(float4*)(os + k) = make_float4(S[k], S[k + 1], S[k + 2], S[k + 3]);
    }
}

__global__ void __launch_bounds__(256) k_rw_post(const float* __restrict__ y0, const float* __restrict__ y1, const float* __restrict__ bonus,
                                                 const bf16_t* __restrict__ vb, const bf16_t* __restrict__ gate, const float* __restrict__ lnx_g,
                                                 const float* __restrict__ lnx_b, float* __restrict__ cat) {
    const int w = blockIdx.x * 4 + (threadIdx.x >> 6);
    const int lane = threadIdx.x & 63;
    const int t = w >> 3, h = w & 7;
    const size_t o = (size_t)t * 512 + h * 64 + lane;
    const int ch = h * 64 + lane;
    float y = y0[o] + y1[o];
    float mean = wave_sum(y) * (1.f / 64.f);
    float dlt = y - mean;
    float var = wave_sum(dlt * dlt) * (1.f / 64.f);
    float yn = dlt * rsqrtf(var + 64e-5f) * lnx_g[ch] + lnx_b[ch];
    float val = (yn + bonus[w] * bf2f(vb[o])) * bf2f(gate[o]);
    cat[(size_t)t * DM + ch] = val;
}

__global__ void __launch_bounds__(256) k_mla_pre(const float* __restrict__ proj, const float* __restrict__ q_norm, const float* __restrict__ kv_norm,
                                                 float* __restrict__ qcn, float* __restrict__ ckv, float* __restrict__ kpe,
                                                 float* __restrict__ out_ckv, float* __restrict__ out_kpe) {
    __shared__ float red[4], red2[4];
    const int t = blockIdx.x;
    const int tid = threadIdx.x;
    const float* P = proj + (size_t)t * ABIN + RWIN;
    float q = P[tid];
    float kv = (tid < 128) ? P[256 + tid] : 0.f;
    float ss = wave_sum(q * q);
    float s2 = wave_sum(kv * kv);
    if ((tid & 63) == 0) { red[tid >> 6] = ss; red2[tid >> 6] = s2; }
    __syncthreads();
    float rq = rsqrtf((red[0] + red[1] + red[2] + red[3]) * (1.f / 256.f) + 1e-6f);
    float rk = rsqrtf((red2[0] + red2[1] + red2[2] + red2[3]) * (1.f / 128.f) + 1e-6f);
    qcn[(size_t)t * 256 + tid] = q * rq * q_norm[tid];
    if (tid < 128) {
        float val = kv * rk * kv_norm[tid];
        ckv[(size_t)t * 128 + tid] = val;
        if (t < TP) out_ckv[(size_t)t * 128 + tid] = val;
    } else if (tid < 192) {
        float pe = P[384 + tid - 128];
        kpe[(size_t)t * 64 + tid - 128] = pe;
        if (t < TP) out_kpe[(size_t)t * 64 + tid - 128] = pe;
    }
}

__global__ void __launch_bounds__(256) k_mla_post(const float* __restrict__ qraw, const float* __restrict__ kvraw, const float* __restrict__ kvraw_ctx,
                                                  const float* __restrict__ kpe, const float* __restrict__ cache_kpe, const float* __restrict__ qn,
                                                  const float* __restrict__ kn, bf16_t* __restrict__ Qb, bf16_t* __restrict__ Kp, bf16_t* __restrict__ Vp,
                                                  bf16_t* __restrict__ Ks, bf16_t* __restrict__ Vs) {
    __shared__ float sq[4][192], sk[4][192];
    const int wi = threadIdx.x >> 6, lane = threadIdx.x & 63;
    const int row = blockIdx.x, h = wi;
    const bool isctx = row >= TT;
    const bool sample = row >= TP;
    float kx[3], qx[3] = {0.f, 0.f, 0.f};
    const float* kvr; const float* pe; int pos = 0;
    if (isctx) { int cr = row - TT; kvr = kvraw_ctx + (size_t)cr * 1024; pe = cache_kpe + (size_t)cr * 64; }
    else { kvr = kvraw + (size_t)row * 1024; pe = kpe + (size_t)row * 64; pos = tok_pos(row); }
#pragma unroll
    for (int j = 0; j < 3; j++) {
        int i = lane + 64 * j;
        kx[j] = (i < 128) ? kvr[h * 256 + i] : pe[i - 128];
        if (!isctx) qx[j] = qraw[(size_t)row * 768 + h * 192 + i];
    }
    float ssk = wave_sum(kx[0] * kx[0] + kx[1] * kx[1] + kx[2] * kx[2]);
    float ssq = wave_sum(qx[0] * qx[0] + qx[1] * qx[1] + qx[2] * qx[2]);
    float rk = rsqrtf(ssk * (1.f / 192.f) + 1e-6f), rq = rsqrtf(ssq * (1.f / 192.f) + 1e-6f);
#pragma unroll
    for (int j = 0; j < 3; j++) {
        int i = lane + 64 * j;
        sk[wi][i] = kx[j] * rk * kn[i];
        sq[wi][i] = qx[j] * rq * qn[i];
    }
    __syncthreads();
    if (sample && !isctx && lane < 32) {
        int rowi = pos >> 6, coli = pos & 63;
        int fi = lane & 15;
        float inv = expf(-(float)fi * (1.f / 16.f) * 9.210340371976184f);
        float ang = (lane < 16 ? (float)rowi : (float)coli) * inv;
        float cs = cosf(ang), sn = sinf(ang);
        float a = sk[wi][128 + 2 * lane], bq = sk[wi][128 + 2 * lane + 1];
        sk[wi][128 + 2 * lane] = a * cs - bq * sn; sk[wi][128 + 2 * lane + 1] = a * sn + bq * cs;
        a = sq[wi][128 + 2 * lane]; bq = sq[wi][128 + 2 * lane + 1];
        sq[wi][128 + 2 * lane] = a * cs - bq * sn; sq[wi][128 + 2 * lane + 1] = a * sn + bq * cs;
    }
    __syncthreads();
    bf16_t* kd; bf16_t* vd;
    if (!sample) { int b = row >> 8, p = row & 255; kd = Kp + ((size_t)(b * 4 + h) * LP + p) * 192; vd = Vp + ((size_t)(b * 4 + h) * LP + p) * 128; }
    else if (!isctx) { int b = (row - TP) >> 11, p = (row - TP) & 2047; kd = Ks + ((size_t)(b * 4 + h) * 2304 + 256 + p) * 192; vd = Vs + ((size_t)(b * 4 + h) * 2304 + 256 + p) * 128; }
    else { int cr = row - TT; int b = cr >> 8, p = cr & 255; kd = Ks + ((size_t)(b * 4 + h) * 2304 + p) * 192; vd = Vs + ((size_t)(b * 4 + h) * 2304 + p) * 128; }
#pragma unroll
    for (int j = 0; j < 3; j++) {
        int i = lane + 64 * j;
        kd[i] = f2bf(sk[wi][i]);
        if (!isctx) Qb[((size_t)row * 4 + h) * 192 + i] = f2bf(sq[wi][i]);
    }
    vd[lane] = f2bf(kvr[h * 256 + 128 + lane]);
    vd[lane + 64] = f2bf(kvr[h * 256 + 128 + lane + 64]);
}

__global__ void __launch_bounds__(256) k_attn(const bf16_t* __restrict__ Qb, const bf16_t* __restrict__ Kall, const bf16_t* __restrict__ Vall,
                                              float* __restrict__ cat, int tbase, int Lq, int Lk) {
    __shared__ float Qs[16][192];
    __shared__ float Ksm[32][193];
    __shared__ __attribute__((aligned(16))) float Vsm[32][128];
    __shared__ float Ss[16][33];
    const int q0 = blockIdx.x * 16, h = blockIdx.y, b = blockIdx.z;
    const int tid = threadIdx.x;
    const int qi = tid >> 4, sub = tid & 15;
    const bf16_t* K = Kall + (size_t)(b * 4 + h) * Lk * 192;
    const bf16_t* V = Vall + (size_t)(b * 4 + h) * Lk * 128;
    for (int i = tid; i < 16 * 192; i += 256) {
        int r = i / 192, c = i % 192;
        int t = tbase + b * Lq + q0 + r;
        Qs[r][c] = bf2f(Qb[((size_t)t * 4 + h) * 192 + c]);
    }
    float m = -1e30f, l = 0.f;
    float acc[8];
#pragma unroll
    for (int j = 0; j < 8; j++) acc[j] = 0.f;
    const float scale = 0.07216878364870322f;
    for (int k0 = 0; k0 < Lk; k0 += 32) {
        __syncthreads();
        for (int i = tid; i < 32 * 192; i += 256) { int r = i / 192, c = i % 192; Ksm[r][c] = bf2f(K[(size_t)(k0 + r) * 192 + c]); }
        for (int i = tid; i < 32 * 128; i += 256) { int r = i >> 7, c = i & 127; Vsm[r][c] = bf2f(V[(size_t)(k0 + r) * 128 + c]); }
        __syncthreads();
        float s0 = 0.f, s1 = 0.f;
        for (int dd = 0; dd < 192; dd++) { float qv = Qs[qi][dd]; s0 += qv * Ksm[sub][dd]; s1 += qv * Ksm[sub + 16][dd]; }
        s0 *= scale; s1 *= scale;
        float mx = fmaxf(s0, s1);
#pragma unroll
        for (int o = 8; o > 0; o >>= 1) mx = fmaxf(mx, __shfl_xor(mx, o, 64));
        float mn = fmaxf(m, mx);
        float alpha = expf(m - mn);
        float p0 = expf(s0 - mn), p1 = expf(s1 - mn);
        float ps = p0 + p1;
#pragma unroll
        for (int o = 8; o > 0; o >>= 1) ps += __shfl_xor(ps, o, 64);
        l = l * alpha + ps; m = mn;
        Ss[qi][sub] = p0; Ss[qi][sub + 16] = p1;
        __syncthreads();
#pragma unroll
        for (int j = 0; j < 8; j++) acc[j] *= alpha;
        for (int kk = 0; kk < 32; kk++) {
            float p = Ss[qi][kk];
            float4 v0 = *(const float4*)&Vsm[kk][sub * 8], v1 = *(const float4*)&Vsm[kk][sub * 8 + 4];
            acc[0] += p * v0.x; acc[1] += p * v0.y; acc[2] += p * v0.z; acc[3] += p * v0.w;
            acc[4] += p * v1.x; acc[5] += p * v1.y; acc[6] += p * v1.z; acc[7] += p * v1.w;
        }
    }
    const int t = tbase + b * Lq + q0 + qi;
    float il = 1.f / l;
    float* o = cat + (size_t)t * DM + 512 + h * 128 + sub * 8;
#pragma unroll
    for (int j = 0; j < 8; j++) o[j] = acc[j] * il;
}

__global__ void __launch_bounds__(256) k_peer_route(const float* __restrict__ qp, const float* __restrict__ keys  ,
                                                    int* __restrict__ pidx, float* __restrict__ pg) {
    __shared__ float sq[4][256];
    __shared__ float sc[4][256];
    __shared__ float tv[4][32];
    __shared__ int ti[4][32];
    __shared__ float topv[4][16];
    __shared__ int topi[4][16];
    const int wi = threadIdx.x >> 6, lane = threadIdx.x & 63;
    const int w = blockIdx.x * 4 + wi;
    const int t = w >> 3, h = w & 7;
    const float* q = qp + (size_t)t * 2048 + h * 256;
#pragma unroll
    for (int j = 0; j < 4; j++) sq[wi][lane + 64 * j] = q[lane + 64 * j];
    __syncthreads();
#pragma unroll
    for (int p = 0; p < 2; p++)
#pragma unroll
        for (int half = 0; half < 2; half++) {
            int n = lane + 64 * half;
            const float* kr = keys + ((size_t)(h * 2 + p) * 128 + n) * 128;
            float s = 0.f;
            for (int dd = 0; dd < 128; dd += 4) {
                float4 kv = *(const float4*)(kr + dd);
                s += sq[wi][p * 128 + dd] * kv.x + sq[wi][p * 128 + dd + 1] * kv.y + sq[wi][p * 128 + dd + 2] * kv.z + sq[wi][p * 128 + dd + 3] * kv.w;
            }
            sc[wi][p * 128 + n] = s;
        }
    __syncthreads();
#pragma unroll
    for (int p = 0; p < 2; p++)
#pragma unroll
        for (int half = 0; half < 2; half++) {
            int n = lane + 64 * half;
            float s = sc[wi][p * 128 + n];
            int rank = 0;
            for (int j = 0; j < 128; j++) { float o = sc[wi][p * 128 + j]; rank += (o > s || (o == s && j < n)) ? 1 : 0; }
            if (rank < 16) { tv[wi][p * 16 + rank] = s; ti[wi][p * 16 + rank] = n; }
        }
    __syncthreads();
    float cv[4];
#pragma unroll
    for (int j = 0; j < 4; j++) { int c = lane + 64 * j; cv[j] = tv[wi][c >> 4] + tv[wi][16 + (c & 15)]; }
    __syncthreads();
#pragma unroll
    for (int j = 0; j < 4; j++) sc[wi][lane + 64 * j] = cv[j];
    __syncthreads();
#pragma unroll
    for (int j = 0; j < 4; j++) {
        int c = lane + 64 * j;
        float s = cv[j];
        int rank = 0;
        for (int i = 0; i < 256; i++) { float o = sc[wi][i]; rank += (o > s || (o == s && i < c)) ? 1 : 0; }
        if (rank < 16) { topv[wi][rank] = s; topi[wi][rank] = ti[wi][c >> 4] * 128 + ti[wi][16 + (c & 15)]; }
    }
    __syncthreads();
    if (lane < 16) {
        float mx = topv[wi][0];
        float sum = 0.f;
        for (int i = 0; i < 16; i++) sum += expf(topv[wi][i] - mx);
        pg[(size_t)w * 16 + lane] = expf(topv[wi][lane] - mx) / sum;
        pidx[(size_t)w * 16 + lane] = topi[wi][lane];
    }
}

__global__ void __launch_bounds__(256) k_peer_apply(const float* __restrict__ hbuf, const int* __restrict__ pidx, const float* __restrict__ pg,
                                                    const float* __restrict__ utab, const float* __restrict__ vtab, const float* __restrict__ modl,
                                                    float* __restrict__ xrun) {
    __shared__ float coef[128];
    __shared__ int eid[128];
    const int t = blockIdx.x, tid = threadIdx.x, wi = tid >> 6, lane = tid & 63;
    if (tid < 128) eid[tid] = pidx[(size_t)t * 128 + tid];
    float4 xv[4];
#pragma unroll
    for (int j = 0; j < 4; j++) xv[j] = *(const float4*)(hbuf + (size_t)t * DM + j * 256 + lane * 4);
    __syncthreads();
    for (int e = wi * 32; e < wi * 32 + 32; e++) {
        const float* ur = utab + (size_t)eid[e] * DM;
        float s = 0.f;
#pragma unroll
        for (int j = 0; j < 4; j++) { float4 u = *(const float4*)(ur + j * 256 + lane * 4); s += u.x * xv[j].x + u.y * xv[j].y + u.z * xv[j].z + u.w * xv[j].w; }
        s = wave_sum(s);
        if (lane == 0) coef[e] = pg[(size_t)t * 128 + e] * gelu_tanh(s);
    }
    __syncthreads();
    float4 acc = make_float4(0.f, 0.f, 0.f, 0.f);
    for (int e = 0; e < 128; e++) {
        float cf = coef[e];
        float4 v = *(const float4*)(vtab + (size_t)eid[e] * DM + tid * 4);
        acc.x += cf * v.x; acc.y += cf * v.y; acc.z += cf * v.z; acc.w += cf * v.w;
    }
    const float* m = modl + (size_t)tok_modrow(t) * 6144 + 5 * 1024 + tid * 4;
    float* xo = xrun + (size_t)t * DM + tid * 4;
    float4 x = *(float4*)xo;
    x.x += m[0] * acc.x; x.y += m[1] * acc.y; x.z += m[2] * acc.z; x.w += m[3] * acc.w;
    *(float4*)xo = x;
}

__global__ void __launch_bounds__(256) k_hy_dw(const float* __restrict__ pre, const float* __restrict__ cw, const float* __restrict__ cb,
                                               float* __restrict__ zin, float* __restrict__ x0) {
    const int t = blockIdx.x;
    const int pos = tok_pos(t), L = tok_len(t);
    const float* P = pre + (size_t)t * 3072;
    for (int c = threadIdx.x; c < 1024; c += 256) {
        float u[3];
#pragma unroll
        for (int part = 0; part < 3; part++) {
            int cc = part * 1024 + c;
            float cur = P[cc];
            float prev = (pos > 0) ? P[cc - 3072] : 0.f;
            float nxt = (pos < L - 1) ? P[cc + 3072] : 0.f;
            u[part] = prev * cw[cc] + cur * cw[3072 + cc] + nxt * cw[2 * 3072 + cc] + cb[cc];
        }
        x0[(size_t)t * DM + c] = u[0];
        zin[(size_t)t * DM + c] = u[1] * u[2];
    }
}

__global__ void __launch_bounds__(256) k_hy_filt(int L, const float* __restrict__ w1, const float* __restrict__ b1, const float* __restrict__ w2,
                                                 const float* __restrict__ b2, const float* __restrict__ w3, const float* __restrict__ fr,
                                                 float* __restrict__ hf, float* __restrict__ hb) {
    __shared__ float z[33], h1[64], h2[64];
    const int t = blockIdx.x, tid = threadIdx.x;
    const float tu = (float)t / (float)(L - 1);
    if (tid == 0) z[0] = tu;
    if (tid >= 1 && tid < 17) {
        int i = tid - 1;
        float band = 1e-4f + (float)i * ((15.f - 1e-4f) / 15.f);
        float ang = 6.283185307179586f * (float)t * band / (float)L;
        z[1 + i] = cosf(ang); z[17 + i] = -sinf(ang);
    }
    __syncthreads();
    if (tid < 64) { float s = b1[tid]; for (int i = 0; i < 33; i++) s += z[i] * w1[i * 64 + tid]; h1[tid] = sinf(fr[tid] * s); }
    __syncthreads();
    if (tid < 64) { float s = b2[tid]; for (int i = 0; i < 64; i++) s += h1[i] * w2[i * 64 + tid]; h2[tid] = sinf(fr[tid] * s); }
    __syncthreads();
    for (int c = tid; c < 2048; c += 256) {
        float s = 0.f;
        for (int i = 0; i < 64; i++) s += h2[i] * w3[i * 2048 + c];
        int ch = c & 1023;
        float d0 = -4.605170185988091f / 0.3f, d1 = -4.605170185988091f / 1.5f;
        float delta = d0 + (d1 - d0) * ((float)ch / 1023.f);
        float win = expf(-tu * fabsf(delta));
        float val = s * win;
        if (c < 1024) hf[(size_t)t * 1024 + ch] = val; else hb[(size_t)t * 1024 + ch] = val;
    }
}
__global__ void __launch_bounds__(256) k_hy_norm(int L, const float* __restrict__ hf, const float* __restrict__ hb, float* __restrict__ inv) {
    const int c = blockIdx.x * 256 + threadIdx.x;
    float s = 0.f;
    for (int t = 0; t < L; t++) { s += fabsf(hf[(size_t)t * 1024 + c]); if (t > 0) s += fabsf(hb[(size_t)t * 1024 + c]); }
    inv[c] = 1.f / s;
}
__global__ void __launch_bounds__(256) k_hy_conv(int L, int tbase, const float* __restrict__ zin, const float* __restrict__ x0, const float* __restrict__ hf,
                                                 const float* __restrict__ hb, const float* __restrict__ inv, const float* __restrict__ bias,
                                                 float* __restrict__ zb) {
    const int c = blockIdx.x * 256 + threadIdx.x;
    const int t0 = blockIdx.y * 8, b = blockIdx.z;
    const float* Z = zin + (size_t)(tbase + b * L) * DM + c;
    float acc[8];
#pragma unroll
    for (int i = 0; i < 8; i++) acc[i] = 0.f;
    for (int s = 0; s < L; s++) {
        float z = Z[(size_t)s * DM];
#pragma unroll
        for (int i = 0; i < 8; i++) {
            int j = t0 + i - s;
            float g = (j >= 0) ? hf[(size_t)j * 1024 + c] : hb[(size_t)(-j) * 1024 + c];
            acc[i] += z * g;
        }
    }
    float iv = inv[c], bs = bias[c];
#pragma unroll
    for (int i = 0; i < 8; i++) {
        size_t o = (size_t)(tbase + b * L + t0 + i) * DM + c;
        float zz = zin[o];
        zb[o] = x0[o] * (acc[i] * iv + zz * bs);
    }
}

static inline size_t align_up(size_t x) { return (x + 255) & ~(size_t)255; }

extern "C" void kernel_launch(void* const* d_in, const int* in_sizes, int n_in, void* d_out, int out_size, void* d_ws, size_t ws_size,
                              hipStream_t stream) {
    const float* x_prompt = (const float*)d_in[0];
    const float* x_sample = (const float*)d_in[1];
    const float* st_f = (const float*)d_in[2];
    const float* st_b = (const float*)d_in[3];
    const float* cache_ckv = (const float*)d_in[4];
    const float* cache_kpe = (const float*)d_in[5];
    const float* c = (const float*)d_in[6];
    const float* c_ctx = (const float*)d_in[7];
    const float* norm_g = (const float*)d_in[8];
    const float* w_mod = (const float*)d_in[9];
    const float* b_mod = (const float*)d_in[10];
    const float* ab_w_in = (const float*)d_in[11];
    const float* rw_mu = (const float*)d_in[12];
    const float* rw_w0 = (const float*)d_in[13];
    const float* rw_w2 = (const float*)d_in[14];
    const float* rw_a0 = (const float*)d_in[15];
    const float* rw_a2 = (const float*)d_in[16];
    const float* rw_g2 = (const float*)d_in[17];
    const float* rw_k_k = (const float*)d_in[18];
    const float* rw_k_a = (const float*)d_in[19];
    const float* rw_r_k = (const float*)d_in[20];
    const float* rw_lnx_g = (const float*)d_in[21];
    const float* rw_lnx_b = (const float*)d_in[22];
    const float* mla_q_norm = (const float*)d_in[23];
    const float* mla_q_up = (const float*)d_in[24];
    const float* mla_kv_norm = (const float*)d_in[25];
    const float* mla_kv_up = (const float*)d_in[26];
    const float* mla_qn = (const float*)d_in[27];
    const float* mla_kn = (const float*)d_in[28];
    const float* ab_w_out = (const float*)d_in[29];
    const float* hy_w_in = (const float*)d_in[30];
    const float* hy_b_in = (const float*)d_in[31];
    const float* hy_conv_w = (const float*)d_in[32];
    const float* hy_conv_b = (const float*)d_in[33];
    const float* hy_f_w1 = (const float*)d_in[34];
    const float* hy_f_b1 = (const float*)d_in[35];
    const float* hy_f_w2 = (const float*)d_in[36];
    const float* hy_f_b2 = (const float*)d_in[37];
    const float* hy_f_w3 = (const float*)d_in[38];
    const float* hy_f_freq = (const float*)d_in[39];
    const float* hy_bias = (const float*)d_in[40];
    const float* hy_w_out = (const float*)d_in[41];
    const float* peer_w_q = (const float*)d_in[42];
    const float* peer_keys = (const float*)d_in[43];
    const float* peer_u = (const float*)d_in[44];
    const float* peer_v = (const float*)d_in[45];

    float* out = (float*)d_out;
    float* xrun = out;
    float* out_sf = out + (size_t)TT * DM;
    float* out_sb = out_sf + 16 * 8 * 64 * 64;
    float* out_ckv = out_sb + 16 * 8 * 64 * 64;
    float* out_kpe = out_ckv + 16 * 256 * 128;

    char* ws = (char*)d_ws;
    size_t off = 0;
    auto take = [&](size_t bytes) { char* p = ws + off; off = align_up(off + bytes); return p; };
    float* mod = (float*)take((size_t)2 * 5 * 6144 * 4);
    char* R1 = take((size_t)TT * 1024 * 4);
    char* R2 = take((size_t)TT * ABIN * 4);
    char* R3 = ws + off;
    float* hbuf = (float*)R1;
    float* kvraw = (float*)R1;
    float* cat = (float*)R1;
    float* proj = (float*)R2;
    float* qraw = (float*)R2;
    float* y0 = (float*)(R2 + (size_t)TT * 768 * 4);
    float* y1 = y0 + (size_t)TT * 512;
    float* qp = (float*)R2;
    size_t o3 = 0;
    auto take3 = [&](size_t bytes) { char* p = R3 + o3; o3 = align_up(o3 + bytes); return p; };
    bf16_t* rb = (bf16_t*)take3((size_t)TT * 512 * 2);
    bf16_t* kb = (bf16_t*)take3((size_t)TT * 512 * 2);
    bf16_t* vb = (bf16_t*)take3((size_t)TT * 512 * 2);
    bf16_t* kkb = (bf16_t*)take3((size_t)TT * 512 * 2);
    bf16_t* lr0 = (bf16_t*)take3((size_t)TT * 512 * 2);
    bf16_t* lr1 = (bf16_t*)take3((size_t)TT * 512 * 2);
    bf16_t* gateb = (bf16_t*)take3((size_t)TT * 512 * 2);
    float* dec0 = (float*)take3((size_t)TT * 512 * 4);
    float* dec1 = (float*)take3((size_t)TT * 512 * 4);
    float* tw = (float*)take3((size_t)TT * 64 * 4);
    float* adv = (float*)take3((size_t)TT * 64 * 4);
    float* sg = (float*)take3((size_t)TT * 128 * 4);
    float* bonus = (float*)take3((size_t)TT * 8 * 4);
    float* kpe = (float*)take3((size_t)TT * 64 * 4);
    float* qcn = (float*)take3((size_t)TT * 256 * 4);
    float* ckv = (float*)take3((size_t)TT * 128 * 4);
    bf16_t* Qb = (bf16_t*)take3((size_t)TT * 768 * 2);
    bf16_t* Kp = (bf16_t*)take3((size_t)16 * 4 * 256 * 192 * 2);
    bf16_t* Vp = (bf16_t*)take3((size_t)16 * 4 * 256 * 128 * 2);
    bf16_t* Ks = (bf16_t*)take3((size_t)4 * 4 * 2304 * 192 * 2);
    bf16_t* Vs = (bf16_t*)take3((size_t)4 * 4 * 2304 * 128 * 2);
    float* kvraw_ctx = (float*)take3((size_t)1024 * 1024 * 4);
    int* pidx = (int*)take3((size_t)TT * 128 * 4);
    float* pg = (float*)take3((size_t)TT * 128 * 4);
    float* pre = (float*)R2;
    char* L1 = R2 + (size_t)TT * 3072 * 4;
    float* zin = (float*)L1;
    float* x0b = zin + (size_t)TT * 1024;
    float* hfS = x0b + (size_t)TT * 1024;
    float* hbS = hfS + (size_t)LS * 1024;
    float* hfP = hbS + (size_t)LS * 1024;
    float* hbP = hfP + (size_t)LP * 1024;
    float* invS = hbP + (size_t)LP * 1024;
    float* invP = invS + 1024;
    int* pidx1 = (int*)(invP + 1024);
    float* pg1 = (float*)(pidx1 + (size_t)TT * 128);
    float* zb = (float*)R1;

    const float* mod0 = mod;
    const float* mod1 = mod + 5 * 6144;

    k_mod<<<dim3(24, 2), 256, 0, stream>>>(c, c_ctx, w_mod, b_mod, mod);

    k_norm_mod<<<TT, 256, 0, stream>>>(x_prompt, x_sample, norm_g + 0, mod0, 0, 1, hbuf);
    k_gemm<EpiStore><<<dim3(ABIN / 64, TT / 64), 256, 0, stream>>>(hbuf, 1024, ab_w_in, ABIN, 1024, EpiStore{proj, nullptr, ABIN, 0});
    k_rw_shift<<<TT, 256, 0, stream>>>(proj, rw_mu, rb, kb, vb, tw, adv, sg);
    k_mla_pre<<<TT, 256, 0, stream>>>(proj, mla_q_norm, mla_kv_norm, qcn, ckv, kpe, out_ckv, out_kpe);
    k_gemm<EpiDecay><<<dim3(8, TT / 64), 256, 0, stream>>>(tw, 64, rw_w2, 512, 64, EpiDecay{dec0, rw_w0});
    k_gemm<EpiDecay><<<dim3(8, TT / 64), 256, 0, stream>>>(tw, 64, rw_w2 + 64 * 512, 512, 64, EpiDecay{dec1, rw_w0 + 512});
    k_gemm<EpiLr><<<dim3(8, TT / 64), 256, 0, stream>>>(adv, 64, rw_a2, 512, 64, EpiLr{lr0, rw_a0});
    k_gemm<EpiLr><<<dim3(8, TT / 64), 256, 0, stream>>>(adv, 64, rw_a2 + 64 * 512, 512, 64, EpiLr{lr1, rw_a0 + 512});
    k_gemm<EpiStoreBf><<<dim3(8, TT / 64), 256, 0, stream>>>(sg, 128, rw_g2, 512, 128, EpiStoreBf{gateb, 512, 0});
    k_rw_kk<<<TT * 8 / 4, 256, 0, stream>>>(rb, kb, lr0, lr1, rw_k_k, rw_k_a, rw_r_k, kkb, bonus);
    k_gemm<EpiStore><<<dim3(768 / 64, TT / 64), 256, 0, stream>>>(qcn, 256, mla_q_up, 768, 256, EpiStore{qraw, nullptr, 768, 0});
    k_gemm<EpiStore><<<dim3(1024 / 64, TT / 64), 256, 0, stream>>>(ckv, 128, mla_kv_up, 1024, 128, EpiStore{kvraw, nullptr, 1024, 0});
    k_gemm<EpiStore><<<dim3(1024 / 64, 1024 / 64), 256, 0, stream>>>(cache_ckv, 128, mla_kv_up, 1024, 128, EpiStore{kvraw_ctx, nullptr, 1024, 0});
    k_mla_post<<<TT + 1024, 256, 0, stream>>>(qraw, kvraw, kvraw_ctx, kpe, cache_kpe, mla_qn, mla_kn, Qb, Kp, Vp, Ks, Vs);
    k_scan<<<320, 64, 0, stream>>>(rb, kb, vb, kkb, lr0, lr1, dec0, dec1, rw_k_a, st_f, st_b, y0, y1, out_sf, out_sb);
    k_attn<<<dim3(LP / 16, 4, NBP), 256, 0, stream>>>(Qb, Kp, Vp, cat, 0, LP, LP);
    k_attn<<<dim3(LS / 16, 4, NBS), 256, 0, stream>>>(Qb, Ks, Vs, cat, TP, LS, 2304);
    k_rw_post<<<TT * 8 / 4, 256, 0, stream>>>(y0, y1, bonus, vb, gateb, rw_lnx_g, rw_lnx_b, cat);
    k_gemm<EpiResid><<<dim3(16, TT / 64), 256, 0, stream>>>(cat, 1024, ab_w_out, 1024, 1024, EpiResid{x_prompt, x_sample, xrun, mod0, 2, 0});
    k_norm_mod<<<TT, 256, 0, stream>>>(xrun, xrun + (size_t)TP * DM, norm_g + 1024, mod0, 3, 4, hbuf);
    k_gemm<EpiStore><<<dim3(32, TT / 64), 256, 0, stream>>>(hbuf, 1024, peer_w_q, 2048, 1024, EpiStore{qp, nullptr, 2048, 0});
    k_peer_route<<<TT * 8 / 4, 256, 0, stream>>>(qp, peer_keys, pidx, pg);
    k_peer_apply<<<TT, 256, 0, stream>>>(hbuf, pidx, pg, peer_u, peer_v, mod0, xrun);

    k_norm_mod<<<TT, 256, 0, stream>>>(xrun, xrun + (size_t)TP * DM, norm_g + 2048, mod1, 0, 1, hbuf);
    k_gemm<EpiStore><<<dim3(48, TT / 64), 256, 0, stream>>>(hbuf, 1024, hy_w_in, 3072, 1024, EpiStore{pre, hy_b_in, 3072, 0});
    k_hy_dw<<<TT, 256, 0, stream>>>(pre, hy_conv_w, hy_conv_b, zin, x0b);
    k_hy_filt<<<LS, 256, 0, stream>>>(LS, hy_f_w1, hy_f_b1, hy_f_w2, hy_f_b2, hy_f_w3, hy_f_freq, hfS, hbS);
    k_hy_filt<<<LP, 256, 0, stream>>>(LP, hy_f_w1, hy_f_b1, hy_f_w2, hy_f_b2, hy_f_w3, hy_f_freq, hfP, hbP);
    k_hy_norm<<<4, 256, 0, stream>>>(LS, hfS, hbS, invS);
    k_hy_norm<<<4, 256, 0, stream>>>(LP, hfP, hbP, invP);
    k_hy_conv<<<dim3(4, LP / 8, NBP), 256, 0, stream>>>(LP, 0, zin, x0b, hfP, hbP, invP, hy_bias, zb);
    k_hy_conv<<<dim3(4, LS / 8, NBS), 256, 0, stream>>>(LS, TP, zin, x0b, hfS, hbS, invS, hy_bias, zb);
    k_gemm<EpiResid><<<dim3(16, TT / 64), 256, 0, stream>>>(zb, 1024, hy_w_out, 1024, 1024, EpiResid{xrun, xrun + (size_t)TP * DM, xrun, mod1, 2, 0});
    k_norm_mod<<<TT, 256, 0, stream>>>(xrun, xrun + (size_t)TP * DM, norm_g + 3072, mod1, 3, 4, hbuf);
    k_gemm<EpiStore><<<dim3(32, TT / 64), 256, 0, stream>>>(hbuf, 1024, peer_w_q + (size_t)1024 * 2048, 2048, 1024, EpiStore{qp, nullptr, 2048, 0});
    k_peer_route<<<TT * 8 / 4, 256, 0, stream>>>(qp, peer_keys + (size_t)8 * 2 * 128 * 128, pidx1, pg1);
    k_peer_apply<<<TT, 256, 0, stream>>>(hbuf, pidx1, pg1, peer_u + (size_t)16384 * 1024, peer_v + (size_t)16384 * 1024, mod1, xrun);
}
```

```cpp
#include <hip/hip_runtime.h>
#include <stdint.h>
#include <hip/hip_cooperative_groups.h>
namespace cg = cooperative_groups;

#define DM 1024
#define TP 4096
#define TS 8192
#define TT 12288
#define LP 256
#define LS 2048
#define NBP 16
#define NBS 4
#define ABIN 2240
#define RWIN 1792

typedef unsigned short bf16_t;
__device__ __forceinline__ bf16_t f2bf(float f) { unsigned u = __float_as_uint(f); u += 0x7fffu + ((u >> 16) & 1u); return (bf16_t)(u >> 16); }
__device__ __forceinline__ float bf2f(bf16_t h) { return __uint_as_float(((unsigned)h) << 16); }
__device__ __forceinline__ float sigmoidf_(float x) { return 1.f / (1.f + expf(-x)); }
__device__ __forceinline__ float gelu_tanh(float x) { return 0.5f * x * (1.f + tanhf(0.7978845608028654f * (x + 0.044715f * x * x * x))); }

__device__ __forceinline__ int tok_pos(int t) { return t < TP ? (t & (LP - 1)) : ((t - TP) & (LS - 1)); }
__device__ __forceinline__ int tok_len(int t) { return t < TP ? LP : LS; }
__device__ __forceinline__ int tok_modrow(int t) { return t < TP ? 0 : 1 + ((t - TP) >> 11); }

__device__ __forceinline__ float wave_sum(float v) {
#pragma unroll
    for (int o = 32; o > 0; o >>= 1) v += __shfl_xor(v, o, 64);
    return v;
}

__device__ __forceinline__ void d_mod(const int bx, const int by, const int bz, char* smem, const float* __restrict__ c, const float* __restrict__ c_ctx, const float* __restrict__ w_mod,
                                             const float* __restrict__ b_mod, float* __restrict__ mod) {
    float (*s)[1024] = (float(*)[1024])smem;
    const int li = by;
    const int n = bx * 256 + threadIdx.x;
    for (int i = threadIdx.x; i < 5 * 1024; i += 256) {
        int r = i >> 10, k = i & 1023;
        float v = (r == 0) ? c_ctx[k] : c[(r - 1) * 1024 + k];
        s[r][k] = v / (1.f + expf(-v));
    }
    __syncthreads();
    float a0 = 0, a1 = 0, a2 = 0, a3 = 0, a4 = 0;
    const float* w = w_mod + (size_t)li * 1024 * 6144 + n;
    for (int k = 0; k < 1024; k++) {
        float wv = w[(size_t)k * 6144];
        a0 += s[0][k] * wv; a1 += s[1][k] * wv; a2 += s[2][k] * wv; a3 += s[3][k] * wv; a4 += s[4][k] * wv;
    }
    float bb = b_mod[li * 6144 + n];
    float* o = mod + (size_t)li * 5 * 6144 + n;
    o[0 * 6144] = a0 + bb; o[1 * 6144] = a1 + bb; o[2 * 6144] = a2 + bb; o[3 * 6144] = a3 + bb; o[4 * 6144] = a4 + bb;
}

__device__ __forceinline__ void d_norm_mod(const int bx, const int by, const int bz, char* smem, const float* __restrict__ xa, const float* __restrict__ xb, const float* __restrict__ g,
                                                  const float* __restrict__ modl, int shift_idx, int scale_idx, float* __restrict__ h) {
    float* red = (float*)smem;
    const int t = bx;
    const float* x = (t < TP) ? (xa + (size_t)t * DM) : (xb + (size_t)(t - TP) * DM);
    const int c = threadIdx.x * 4;
    float4 v = *(const float4*)(x + c);
    float ss = v.x * v.x + v.y * v.y + v.z * v.z + v.w * v.w;
    ss = wave_sum(ss);
    if ((threadIdx.x & 63) == 0) red[threadIdx.x >> 6] = ss;
    __syncthreads();
    float tot = red[0] + red[1] + red[2] + red[3];
    float rstd = rsqrtf(tot * (1.f / DM) + 1e-6f);
    const float* m = modl + (size_t)tok_modrow(t) * 6144;
    float4 gg = *(const float4*)(g + c);
    float4 sh = *(const float4*)(m + shift_idx * 1024 + c);
    float4 sc = *(const float4*)(m + scale_idx * 1024 + c);
    float4 o;
    o.x = v.x * rstd * gg.x * (1.f + sc.x) + sh.x;
    o.y = v.y * rstd * gg.y * (1.f + sc.y) + sh.y;
    o.z = v.z * rstd * gg.z * (1.f + sc.z) + sh.z;
    o.w = v.w * rstd * gg.w * (1.f + sc.w) + sh.w;
    *(float4*)(h + (size_t)t * DM + c) = o;
}

struct EpiStore { float* C; const float* bias; int ldc; int pad;
    __device__ void operator()(int m, int n, float a) const { C[(size_t)m * ldc + n] = a + (bias ? bias[n] : 0.f); } };
struct EpiStoreBf { bf16_t* C; int ldc; int pad;
    __device__ void operator()(int m, int n, float a) const { C[(size_t)m * ldc + n] = f2bf(a); } };
struct EpiDecay { float* out; const float* w0;
    __device__ void operator()(int m, int n, float a) const { out[(size_t)m * 512 + n] = expf(-0.6065306597126334f * sigmoidf_(w0[n] + a)); } };
struct EpiLr { bf16_t* out; const float* a0;
    __device__ void operator()(int m, int n, float a) const { out[(size_t)m * 512 + n] = f2bf(sigmoidf_(a0[n] + a)); } };
struct EpiResid { const float* xa; const float* xb; float* out; const float* modl; int gate_idx; int pad;
    __device__ void operator()(int m, int n, float a) const {
        float x = (m < TP) ? xa[(size_t)m * DM + n] : xb[(size_t)(m - TP) * DM + n];
        float gt = modl[(size_t)tok_modrow(m) * 6144 + gate_idx * 1024 + n];
        out[(size_t)m * DM + n] = x + gt * a; } };

template <class Epi>
__device__ __forceinline__ void d_gemm(const int bx, const int by, const int bz, char* smem, const float* __restrict__ A, int lda, const float* __restrict__ B, int ldb, int K, Epi epi) {
    float (*As)[68] = (float(*)[68])smem;
    float (*Bs)[68] = (float(*)[68])(smem + 16 * 68 * 4);
    const int m0 = by * 64, n0 = bx * 64;
    const int tid = threadIdx.x, tx = tid & 15, ty = tid >> 4;
    float acc[4][4];
#pragma unroll
    for (int i = 0; i < 4; i++)
#pragma unroll
        for (int j = 0; j < 4; j++) acc[i][j] = 0.f;
    for (int k0 = 0; k0 < K; k0 += 16) {
        {
            int r = tid >> 2, kq = (tid & 3) * 4;
            float4 v = *(const float4*)(A + (size_t)(m0 + r) * lda + k0 + kq);
            As[kq + 0][r] = v.x; As[kq + 1][r] = v.y; As[kq + 2][r] = v.z; As[kq + 3][r] = v.w;
        }
        {
            int kk = tid >> 4, nq = (tid & 15) * 4;
            float4 v = *(const float4*)(B + (size_t)(k0 + kk) * ldb + n0 + nq);
            *(float4*)&Bs[kk][nq] = v;
        }
        __syncthreads();
#pragma unroll
        for (int k = 0; k < 16; k++) {
            float a[4], b[4];
#pragma unroll
            for (int i = 0; i < 4; i++) a[i] = As[k][ty * 4 + i];
            float4 bv = *(const float4*)&Bs[k][tx * 4];
            b[0] = bv.x; b[1] = bv.y; b[2] = bv.z; b[3] = bv.w;
#pragma unroll
            for (int i = 0; i < 4; i++)
#pragma unroll
                for (int j = 0; j < 4; j++) acc[i][j] += a[i] * b[j];
        }
        __syncthreads();
    }
#pragma unroll
    for (int i = 0; i < 4; i++)
#pragma unroll
        for (int j = 0; j < 4; j++) epi(m0 + ty * 4 + i, n0 + tx * 4 + j, acc[i][j]);
}

__device__ __forceinline__ void d_rw_shift(const int bx, const int by, const int bz, char* smem, const float* __restrict__ proj, const float* __restrict__ mu, bf16_t* __restrict__ rb,
                                                  bf16_t* __restrict__ kb, bf16_t* __restrict__ vb, float* __restrict__ tw, float* __restrict__ adv,
                                                  float* __restrict__ sg) {
    const int t = bx;
    const int pos = tok_pos(t), L = tok_len(t);
    const float* P = proj + (size_t)t * ABIN;
    for (int c = threadIdx.x; c < RWIN; c += 256) {
        float cur = P[c];
        float prev = (pos > 0) ? P[c - ABIN] : 0.f;
        float nxt = (pos < L - 1) ? P[c + ABIN] : 0.f;
        float val = cur + mu[c] * (0.5f * (prev + nxt) - cur);
        if (c < 512) rb[(size_t)t * 512 + c] = f2bf(val);
        else if (c < 1024) kb[(size_t)t * 512 + c - 512] = f2bf(val);
        else if (c < 1536) vb[(size_t)t * 512 + c - 1024] = f2bf(val);
        else if (c < 1600) tw[(size_t)t * 64 + c - 1536] = tanhf(val);
        else if (c < 1664) adv[(size_t)t * 64 + c - 1600] = val;
        else sg[(size_t)t * 128 + c - 1664] = sigmoidf_(val);
    }
}

__device__ __forceinline__ void d_rw_kk(const int bx, const int by, const int bz, char* smem, const bf16_t* __restrict__ rb, const bf16_t* __restrict__ kb, const bf16_t* __restrict__ lr0,
                                               const bf16_t* __restrict__ lr1, const float* __restrict__ k_k, const float* __restrict__ k_a,
                                               const float* __restrict__ r_k, bf16_t* __restrict__ kkb, float* __restrict__ bonus) {
    const int w = bx * 4 + (threadIdx.x >> 6);
    const int lane = threadIdx.x & 63;
    const int t = w >> 3, h = w & 7;
    const size_t o = (size_t)t * 512 + h * 64 + lane;
    const int ch = h * 64 + lane;
    float k = bf2f(kb[o]), r = bf2f(rb[o]);
    float kk = k * k_k[ch];
    float nrm = sqrtf(wave_sum(kk * kk));
    kk = kk / fmaxf(nrm, 1e-12f);
    kkb[o] = f2bf(kk);
    float l0 = bf2f(lr0[o]), l1 = bf2f(lr1[o]);
    float ka = k_a[ch];
    float kd0 = k * (1.f + (l0 - 1.f) * ka), kd1 = k * (1.f + (l1 - 1.f) * ka);
    float s = wave_sum(r * (kd0 + kd1) * r_k[ch]);
    if (lane == 0) bonus[w] = s;
}

__device__ __forceinline__ void d_scan(const int bx, const int by, const int bz, char* smem, const bf16_t* __restrict__ rb, const bf16_t* __restrict__ kb, const bf16_t* __restrict__ vb,
                                             const bf16_t* __restrict__ kkb, const bf16_t* __restrict__ lr0, const bf16_t* __restrict__ lr1,
                                             const float* __restrict__ dec0, const float* __restrict__ dec1, const float* __restrict__ k_a,
                                             const float* __restrict__ st_f, const float* __restrict__ st_b, float* __restrict__ y0,
                                             float* __restrict__ y1, float* __restrict__ out_sf, float* __restrict__ out_sb) {
    float* sbase = (float*)smem + (threadIdx.x >> 6) * 320;
    float* sa_ = sbase; float* sw_ = sbase + 64; float* sb_ = sbase + 128; float* skd_ = sbase + 192; float* sr_ = sbase + 256;
    int id = bx * 4 + (threadIdx.x >> 6);
    int d, h, b, L, tbase;
    bool prompt = id < 256;
    if (prompt) { d = id & 1; h = (id >> 1) & 7; b = id >> 4; L = LP; tbase = b * LP; }
    else { int j = id - 256; d = j & 1; h = (j >> 1) & 7; b = j >> 4; L = LS; tbase = TP + b * LS; }
    const int v = threadIdx.x & 63;
    const bf16_t* lr = d ? lr1 : lr0;
    const float* dec = d ? dec1 : dec0;
    float* yo = d ? y1 : y0;
    const float ka = k_a[h * 64 + v];
    float S[64];
    if (prompt) {
#pragma unroll
        for (int k = 0; k < 64; k++) S[k] = 0.f;
    } else {
        const float* st = (d ? st_b : st_f) + ((size_t)(b * 8 + h) * 64 + v) * 64;
#pragma unroll
        for (int k = 0; k < 64; k += 4) { float4 q = *(const float4*)(st + k); S[k] = q.x; S[k + 1] = q.y; S[k + 2] = q.z; S[k + 3] = q.w; }
    }
    for (int i = 0; i < L; i++) {
        const int t = tbase + (d ? (L - 1 - i) : i);
        const size_t o = (size_t)t * 512 + h * 64 + v;
        float kkv = bf2f(kkb[o]), lrv = bf2f(lr[o]), kv = bf2f(kb[o]), rv = bf2f(rb[o]), vv = bf2f(vb[o]), wv = dec[o];
        __builtin_amdgcn_wave_barrier();
        sa_[v] = -kkv; sb_[v] = kkv * lrv; skd_[v] = kv * (1.f + (lrv - 1.f) * ka); sw_[v] = wv; sr_[v] = rv;
        __builtin_amdgcn_wave_barrier();
        float sa = 0.f;
#pragma unroll
        for (int k = 0; k < 64; k += 4) { float4 a = *(const float4*)&sa_[k]; sa += S[k] * a.x + S[k + 1] * a.y + S[k + 2] * a.z + S[k + 3] * a.w; }
        float y = 0.f;
#pragma unroll
        for (int k = 0; k < 64; k += 4) {
            float4 w4 = *(const float4*)&sw_[k]; float4 b4 = *(const float4*)&sb_[k]; float4 k4 = *(const float4*)&skd_[k]; float4 r4 = *(const float4*)&sr_[k];
            S[k] = S[k] * w4.x + sa * b4.x + vv * k4.x; y += S[k] * r4.x;
            S[k + 1] = S[k + 1] * w4.y + sa * b4.y + vv * k4.y; y += S[k + 1] * r4.y;
            S[k + 2] = S[k + 2] * w4.z + sa * b4.z + vv * k4.z; y += S[k + 2] * r4.z;
            S[k + 3] = S[k + 3] * w4.w + sa * b4.w + vv * k4.w; y += S[k + 3] * r4.w;
        }
        yo[o] = y;
    }
    if (prompt) {
        float* os = (d ? out_sb : out_sf) + ((size_t)(b * 8 + h) * 64 + v) * 64;
#pragma unroll
        for (int k = 0; k < 64; k += 4) *(float4*)(os + k) = make_float4(S[k], S[k + 1], S[k + 2], S[k + 3]);
    }
}

__device__ __forceinline__ void d_rw_post(const int bx, const int by, const int bz, char* smem, const float* __restrict__ y0, const float* __restrict__ y1, const float* __restrict__ bonus,
                                                 const bf16_t* __restrict__ vb, const bf16_t* __restrict__ gate, const float* __restrict__ lnx_g,
                                                 const float* __restrict__ lnx_b, float* __restrict__ cat) {
    const int w = bx * 4 + (threadIdx.x >> 6);
    const int lane = threadIdx.x & 63;
    const int t = w >> 3, h = w & 7;
    const size_t o = (size_t)t * 512 + h * 64 + lane;
    const int ch = h * 64 + lane;
    float y = y0[o] + y1[o];
    float mean = wave_sum(y) * (1.f / 64.f);
    float dlt = y - mean;
    float var = wave_sum(dlt * dlt) * (1.f / 64.f);
    float yn = dlt * rsqrtf(var + 64e-5f) * lnx_g[ch] + lnx_b[ch];
    float val = (yn + bonus[w] * bf2f(vb[o])) * bf2f(gate[o]);
    cat[(size_t)t * DM + ch] = val;
}

__device__ __forceinline__ void d_mla_pre(const int bx, const int by, const int bz, char* smem, const float* __restrict__ proj, const float* __restrict__ q_norm, const float* __restrict__ kv_norm,
                                                 float* __restrict__ qcn, float* __restrict__ ckv, float* __restrict__ kpe,
                                                 float* __restrict__ out_ckv, float* __restrict__ out_kpe) {
    float* red = (float*)smem; float* red2 = red + 4;
    const int t = bx;
    const int tid = threadIdx.x;
    const float* P = proj + (size_t)t * ABIN + RWIN;
    float q = P[tid];
    float kv = (tid < 128) ? P[256 + tid] : 0.f;
    float ss = wave_sum(q * q);
    float s2 = wave_sum(kv * kv);
    if ((tid & 63) == 0) { red[tid >> 6] = ss; red2[tid >> 6] = s2; }
    __syncthreads();
    float rq = rsqrtf((red[0] + red[1] + red[2] + red[3]) * (1.f / 256.f) + 1e-6f);
    float rk = rsqrtf((red2[0] + red2[1] + red2[2] + red2[3]) * (1.f / 128.f) + 1e-6f);
    qcn[(size_t)t * 256 + tid] = q * rq * q_norm[tid];
    if (tid < 128) {
        float val = kv * rk * kv_norm[tid];
        ckv[(size_t)t * 128 + tid] = val;
        if (t < TP) out_ckv[(size_t)t * 128 + tid] = val;
    } else if (tid < 192) {
        float pe = P[384 + tid - 128];
        kpe[(size_t)t * 64 + tid - 128] = pe;
        if (t < TP) out_kpe[(size_t)t * 64 + tid - 128] = pe;
    }
}

__device__ __forceinline__ void d_mla_post(const int bx, const int by, const int bz, char* smem, const float* __restrict__ qraw, const float* __restrict__ kvraw, const float* __restrict__ kvraw_ctx,
                                                  const float* __restrict__ kpe, const float* __restrict__ cache_kpe, const float* __restrict__ qn,
                                                  const float* __restrict__ kn, bf16_t* __restrict__ Qb, bf16_t* __restrict__ Kp, bf16_t* __restrict__ Vp,
                                                  bf16_t* __restrict__ Ks, bf16_t* __restrict__ Vs) {
    float (*sq)[192] = (float(*)[192])smem; float (*sk)[192] = (float(*)[192])(smem + 4 * 192 * 4);
    const int wi = threadIdx.x >> 6, lane = threadIdx.x & 63;
    const int row = bx, h = wi;
    const bool isctx = row >= TT;
    const bool sample = row >= TP;
    float kx[3], qx[3] = {0.f, 0.f, 0.f};
    const float* kvr; const float* pe; int pos = 0;
    if (isctx) { int cr = row - TT; kvr = kvraw_ctx + (size_t)cr * 1024; pe = cache_kpe + (size_t)cr * 64; }
    else { kvr = kvraw + (size_t)row * 1024; pe = kpe + (size_t)row * 64; pos = tok_pos(row); }
#pragma unroll
    for (int j = 0; j < 3; j++) {
        int i = lane + 64 * j;
        kx[j] = (i < 128) ? kvr[h * 256 + i] : pe[i - 128];
        if (!isctx) qx[j] = qraw[(size_t)row * 768 + h * 192 + i];
    }
    float ssk = wave_sum(kx[0] * kx[0] + kx[1] * kx[1] + kx[2] * kx[2]);
    float ssq = wave_sum(qx[0] * qx[0] + qx[1] * qx[1] + qx[2] * qx[2]);
    float rk = rsqrtf(ssk * (1.f / 192.f) + 1e-6f), rq = rsqrtf(ssq * (1.f / 192.f) + 1e-6f);
#pragma unroll
    for (int j = 0; j < 3; j++) {
        int i = lane + 64 * j;
        sk[wi][i] = kx[j] * rk * kn[i];
        sq[wi][i] = qx[j] * rq * qn[i];
    }
    __syncthreads();
    if (sample && !isctx && lane < 32) {
        int rowi = pos >> 6, coli = pos & 63;
        int fi = lane & 15;
        float inv = expf(-(float)fi * (1.f / 16.f) * 9.210340371976184f);
        float ang = (lane < 16 ? (float)rowi : (float)coli) * inv;
        float cs = cosf(ang), sn = sinf(ang);
        float a = sk[wi][128 + 2 * lane], bq = sk[wi][128 + 2 * lane + 1];
        sk[wi][128 + 2 * lane] = a * cs - bq * sn; sk[wi][128 + 2 * lane + 1] = a * sn + bq * cs;
        a = sq[wi][128 + 2 * lane]; bq = sq[wi][128 + 2 * lane + 1];
        sq[wi][128 + 2 * lane] = a * cs - bq * sn; sq[wi][128 + 2 * lane + 1] = a * sn + bq * cs;
    }
    __syncthreads();
    bf16_t* kd; bf16_t* vd;
    if (!sample) { int b = row >> 8, p = row & 255; kd = Kp + ((size_t)(b * 4 + h) * LP + p) * 192; vd = Vp + ((size_t)(b * 4 + h) * LP + p) * 128; }
    else if (!isctx) { int b = (row - TP) >> 11, p = (row - TP) & 2047; kd = Ks + ((size_t)(b * 4 + h) * 2304 + 256 + p) * 192; vd = Vs + ((size_t)(b * 4 + h) * 2304 + 256 + p) * 128; }
    else { int cr = row - TT; int b = cr >> 8, p = cr & 255; kd = Ks + ((size_t)(b * 4 + h) * 2304 + p) * 192; vd = Vs + ((size_t)(b * 4 + h) * 2304 + p) * 128; }
#pragma unroll
    for (int j = 0; j < 3; j++) {
        int i = lane + 64 * j;
        kd[i] = f2bf(sk[wi][i]);
        if (!isctx) Qb[((size_t)row * 4 + h) * 192 + i] = f2bf(sq[wi][i]);
    }
    vd[lane] = f2bf(kvr[h * 256 + 128 + lane]);
    vd[lane + 64] = f2bf(kvr[h * 256 + 128 + lane + 64]);
}

__device__ __forceinline__ void d_attn(const int bx, const int by, const int bz, char* smem, const bf16_t* __restrict__ Qb, const bf16_t* __restrict__ Kall, const bf16_t* __restrict__ Vall,
                                              float* __restrict__ cat, int tbase, int Lq, int Lk) {
    float (*Vsm)[128] = (float(*)[128])smem;
    float (*Qs)[192] = (float(*)[192])(smem + 32 * 128 * 4);
    float (*Ksm)[193] = (float(*)[193])(smem + 32 * 128 * 4 + 16 * 192 * 4);
    float (*Ss)[33] = (float(*)[33])(smem + 32 * 128 * 4 + 16 * 192 * 4 + 32 * 193 * 4);
    const int q0 = bx * 16, h = by, b = bz;
    const int tid = threadIdx.x;
    const int qi = tid >> 4, sub = tid & 15;
    const bf16_t* K = Kall + (size_t)(b * 4 + h) * Lk * 192;
    const bf16_t* V = Vall + (size_t)(b * 4 + h) * Lk * 128;
    for (int i = tid; i < 16 * 192; i += 256) {
        int r = i / 192, c = i % 192;
        int t = tbase + b * Lq + q0 + r;
        Qs[r][c] = bf2f(Qb[((size_t)t * 4 + h) * 192 + c]);
    }
    float m = -1e30f, l = 0.f;
    float acc[8];
#pragma unroll
    for (int j = 0; j < 8; j++) acc[j] = 0.f;
    const float scale = 0.07216878364870322f;
    for (int k0 = 0; k0 < Lk; k0 += 32) {
        __syncthreads();
        for (int i = tid; i < 32 * 192; i += 256) { int r = i / 192, c = i % 192; Ksm[r][c] = bf2f(K[(size_t)(k0 + r) * 192 + c]); }
        for (int i = tid; i < 32 * 128; i += 256) { int r = i >> 7, c = i & 127; Vsm[r][c] = bf2f(V[(size_t)(k0 + r) * 128 + c]); }
        __syncthreads();
        float s0 = 0.f, s1 = 0.f;
        for (int dd = 0; dd < 192; dd++) { float qv = Qs[qi][dd]; s0 += qv * Ksm[sub][dd]; s1 += qv * Ksm[sub + 16][dd]; }
        s0 *= scale; s1 *= scale;
        float mx = fmaxf(s0, s1);
#pragma unroll
        for (int o = 8; o > 0; o >>= 1) mx = fmaxf(mx, __shfl_xor(mx, o, 64));
        float mn = fmaxf(m, mx);
        float alpha = expf(m - mn);
        float p0 = expf(s0 - mn), p1 = expf(s1 - mn);
        float ps = p0 + p1;
#pragma unroll
        for (int o = 8; o > 0; o >>= 1) ps += __shfl_xor(ps, o, 64);
        l = l * alpha + ps; m = mn;
        Ss[qi][sub] = p0; Ss[qi][sub + 16] = p1;
        __syncthreads();
#pragma unroll
        for (int j = 0; j < 8; j++) acc[j] *= alpha;
        for (int kk = 0; kk < 32; kk++) {
            float p = Ss[qi][kk];
            float4 v0 = *(const float4*)&Vsm[kk][sub * 8], v1 = *(const float4*)&Vsm[kk][sub * 8 + 4];
            acc[0] += p * v0.x; acc[1] += p * v0.y; acc[2] += p * v0.z; acc[3] += p * v0.w;
            acc[4] += p * v1.x; acc[5] += p * v1.y; acc[6] += p * v1.z; acc[7] += p * v1.w;
        }
    }
    const int t = tbase + b * Lq + q0 + qi;
    float il = 1.f / l;
    float* o = cat + (size_t)t * DM + 512 + h * 128 + sub * 8;
#pragma unroll
    for (int j = 0; j < 8; j++) o[j] = acc[j] * il;
}

__device__ __forceinline__ void d_peer_route(const int bx, const int by, const int bz, char* smem, const float* __restrict__ qp, const float* __restrict__ keys  ,
                                                    int* __restrict__ pidx, float* __restrict__ pg) {
    float (*sq)[256] = (float(*)[256])smem;
    float (*sc)[256] = (float(*)[256])(smem + 4096);
    float (*tv)[32] = (float(*)[32])(smem + 8192);
    int (*ti)[32] = (int(*)[32])(smem + 8192 + 512);
    float (*topv)[16] = (float(*)[16])(smem + 8192 + 1024);
    int (*topi)[16] = (int(*)[16])(smem + 8192 + 1024 + 256);
    const int wi = threadIdx.x >> 6, lane = threadIdx.x & 63;
    const int w = bx * 4 + wi;
    const int t = w >> 3, h = w & 7;
    const float* q = qp + (size_t)t * 2048 + h * 256;
#pragma unroll
    for (int j = 0; j < 4; j++) sq[wi][lane + 64 * j] = q[lane + 64 * j];
    __syncthreads();
#pragma unroll
    for (int p = 0; p < 2; p++)
#pragma unroll
        for (int half = 0; half < 2; half++) {
            int n = lane + 64 * half;
            const float* kr = keys + ((size_t)(h * 2 + p) * 128 + n) * 128;
            float s = 0.f;
            for (int dd = 0; dd < 128; dd += 4) {
                float4 kv = *(const float4*)(kr + dd);
                s += sq[wi][p * 128 + dd] * kv.x + sq[wi][p * 128 + dd + 1] * kv.y + sq[wi][p * 128 + dd + 2] * kv.z + sq[wi][p * 128 + dd + 3] * kv.w;
            }
            sc[wi][p * 128 + n] = s;
        }
    __syncthreads();
#pragma unroll
    for (int p = 0; p < 2; p++)
#pragma unroll
        for (int half = 0; half < 2; half++) {
            int n = lane + 64 * half;
            float s = sc[wi][p * 128 + n];
            int rank = 0;
            for (int j = 0; j < 128; j++) { float o = sc[wi][p * 128 + j]; rank += (o > s || (o == s && j < n)) ? 1 : 0; }
            if (rank < 16) { tv[wi][p * 16 + rank] = s; ti[wi][p * 16 + rank] = n; }
        }
    __syncthreads();
    float cv[4];
#pragma unroll
    for (int j = 0; j < 4; j++) { int c = lane + 64 * j; cv[j] = tv[wi][c >> 4] + tv[wi][16 + (c & 15)]; }
    __syncthreads();
#pragma unroll
    for (int j = 0; j < 4; j++) sc[wi][lane + 64 * j] = cv[j];
    __syncthreads();
#pragma unroll
    for (int j = 0; j < 4; j++) {
        int c = lane + 64 * j;
        float s = cv[j];
        int rank = 0;
        for (int i = 0; i < 256; i++) { float o = sc[wi][i]; rank += (o > s || (o == s && i < c)) ? 1 : 0; }
        if (rank < 16) { topv[wi][rank] = s; topi[wi][rank] = ti[wi][c >> 4] * 128 + ti[wi][16 + (c & 15)]; }
    }
    __syncthreads();
    if (lane < 16) {
        float mx = topv[wi][0];
        float sum = 0.f;
        for (int i = 0; i < 16; i++) sum += expf(topv[wi][i] - mx);
        pg[(size_t)w * 16 + lane] = expf(topv[wi][lane] - mx) / sum;
        pidx[(size_t)w * 16 + lane] = topi[wi][lane];
    }
}

__device__ __forceinline__ void d_peer_apply(const int bx, const int by, const int bz, char* smem, const float* __restrict__ hbuf, const int* __restrict__ pidx, const float* __restrict__ pg,
                                                    const float* __restrict__ utab, const float* __restrict__ vtab, const float* __restrict__ modl,
                                                    float* __restrict__ xrun) {
    float* coef = (float*)smem; int* eid = (int*)(smem + 512);
    const int t = bx, tid = threadIdx.x, wi = tid >> 6, lane = tid & 63;
    if (tid < 128) eid[tid] = pidx[(size_t)t * 128 + tid];
    float4 xv[4];
#pragma unroll
    for (int j = 0; j < 4; j++) xv[j] = *(const float4*)(hbuf + (size_t)t * DM + j * 256 + lane * 4);
    __syncthreads();
    for (int e = wi * 32; e < wi * 32 + 32; e++) {
        const float* ur = utab + (size_t)eid[e] * DM;
        float s = 0.f;
#pragma unroll
        for (int j = 0; j < 4; j++) { float4 u = *(const float4*)(ur + j * 256 + lane * 4); s += u.x * xv[j].x + u.y * xv[j].y + u.z * xv[j].z + u.w * xv[j].w; }
        s = wave_sum(s);
        if (lane == 0) coef[e] = pg[(size_t)t * 128 + e] * gelu_tanh(s);
    }
    __syncthreads();
    float4 acc = make_float4(0.f, 0.f, 0.f, 0.f);
    for (int e = 0; e < 128; e++) {
        float cf = coef[e];
        float4 v = *(const float4*)(vtab + (size_t)eid[e] * DM + tid * 4);
        acc.x += cf * v.x; acc.y += cf * v.y; acc.z += cf * v.z; acc.w += cf * v.w;
    }
    const float* m = modl + (size_t)tok_modrow(t) * 6144 + 5 * 1024 + tid * 4;
    float* xo = xrun + (size_t)t * DM + tid * 4;
    float4 x = *(float4*)xo;
    x.x += m[0] * acc.x; x.y += m[1] * acc.y; x.z += m[2] * acc.z; x.w += m[3] * acc.w;
    *(float4*)xo = x;
}

__device__ __forceinline__ void d_hy_dw(const int bx, const int by, const int bz, char* smem, const float* __restrict__ pre, const float* __restrict__ cw, const float* __restrict__ cb,
                                               float* __restrict__ zin, float* __restrict__ x0) {
    const int t = bx;
    const int pos = tok_pos(t), L = tok_len(t);
    const float* P = pre + (size_t)t * 3072;
    for (int c = threadIdx.x; c < 1024; c += 256) {
        float u[3];
#pragma unroll
        for (int part = 0; part < 3; part++) {
            int cc = part * 1024 + c;
            float cur = P[cc];
            float prev = (pos > 0) ? P[cc - 3072] : 0.f;
            float nxt = (pos < L - 1) ? P[cc + 3072] : 0.f;
            u[part] = prev * cw[cc] + cur * cw[3072 + cc] + nxt * cw[2 * 3072 + cc] + cb[cc];
        }
        x0[(size_t)t * DM + c] = u[0];
        zin[(size_t)t * DM + c] = u[1] * u[2];
    }
}

__device__ __forceinline__ void d_hy_filt(const int bx, const int by, const int bz, char* smem, int L, const float* __restrict__ w1, const float* __restrict__ b1, const float* __restrict__ w2,
                                                 const float* __restrict__ b2, const float* __restrict__ w3, const float* __restrict__ fr,
                                                 float* __restrict__ hf, float* __restrict__ hb) {
    float* z = (float*)smem; float* h1 = z + 64; float* h2 = z + 128;
    const int t = bx, tid = threadIdx.x;
    const float tu = (float)t / (float)(L - 1);
    if (tid == 0) z[0] = tu;
    if (tid >= 1 && tid < 17) {
        int i = tid - 1;
        float band = 1e-4f + (float)i * ((15.f - 1e-4f) / 15.f);
        float ang = 6.283185307179586f * (float)t * band / (float)L;
        z[1 + i] = cosf(ang); z[17 + i] = -sinf(ang);
    }
    __syncthreads();
    if (tid < 64) { float s = b1[tid]; for (int i = 0; i < 33; i++) s += z[i] * w1[i * 64 + tid]; h1[tid] = sinf(fr[tid] * s); }
    __syncthreads();
    if (tid < 64) { float s = b2[tid]; for (int i = 0; i < 64; i++) s += h1[i] * w2[i * 64 + tid]; h2[tid] = sinf(fr[tid] * s); }
    __syncthreads();
    for (int c = tid; c < 2048; c += 256) {
        float s = 0.f;
        for (int i = 0; i < 64; i++) s += h2[i] * w3[i * 2048 + c];
        int ch = c & 1023;
        float d0 = -4.605170185988091f / 0.3f, d1 = -4.605170185988091f / 1.5f;
        float delta = d0 + (d1 - d0) * ((float)ch / 1023.f);
        float win = expf(-tu * fabsf(delta));
        float val = s * win;
        if (c < 1024) hf[(size_t)t * 1024 + ch] = val; else hb[(size_t)t * 1024 + ch] = val;
    }
}
__device__ __forceinline__ void d_hy_norm(const int bx, const int by, const int bz, char* smem, int L, const float* __restrict__ hf, const float* __restrict__ hb, float* __restrict__ inv) {
    const int c = bx * 256 + threadIdx.x;
    float s = 0.f;
    for (int t = 0; t < L; t++) { s += fabsf(hf[(size_t)t * 1024 + c]); if (t > 0) s += fabsf(hb[(size_t)t * 1024 + c]); }
    inv[c] = 1.f / s;
}
__device__ __forceinline__ void d_hy_conv(const int bx, const int by, const int bz, char* smem, int L, int tbase, const float* __restrict__ zin, const float* __restrict__ x0, const float* __restrict__ hf,
                                                 const float* __restrict__ hb, const float* __restrict__ inv, const float* __restrict__ bias,
                                                 float* __restrict__ zb) {
    const int c = bx * 256 + threadIdx.x;
    const int t0 = by * 8, b = bz;
    const float* Z = zin + (size_t)(tbase + b * L) * DM + c;
    float acc[8];
#pragma unroll
    for (int i = 0; i < 8; i++) acc[i] = 0.f;
    for (int s = 0; s < L; s++) {
        float z = Z[(size_t)s * DM];
#pragma unroll
        for (int i = 0; i < 8; i++) {
            int j = t0 + i - s;
            float g = (j >= 0) ? hf[(size_t)j * 1024 + c] : hb[(size_t)(-j) * 1024 + c];
            acc[i] += z * g;
        }
    }
    float iv = inv[c], bs = bias[c];
#pragma unroll
    for (int i = 0; i < 8; i++) {
        size_t o = (size_t)(tbase + b * L + t0 + i) * DM + c;
        float zz = zin[o];
        zb[o] = x0[o] * (acc[i] * iv + zz * bs);
    }
}

struct Params {
    const float *x_prompt, *x_sample, *st_f, *st_b, *cache_ckv, *cache_kpe, *c, *c_ctx, *norm_g, *w_mod, *b_mod, *ab_w_in, *rw_mu, *rw_w0, *rw_w2,
        *rw_a0, *rw_a2, *rw_g2, *rw_k_k, *rw_k_a, *rw_r_k, *rw_lnx_g, *rw_lnx_b, *mla_q_norm, *mla_q_up, *mla_kv_norm, *mla_kv_up, *mla_qn, *mla_kn,
        *ab_w_out, *hy_w_in, *hy_b_in, *hy_conv_w, *hy_conv_b, *hy_f_w1, *hy_f_b1, *hy_f_w2, *hy_f_b2, *hy_f_w3, *hy_f_freq, *hy_bias, *hy_w_out,
        *peer_w_q, *peer_keys, *peer_u, *peer_v;
    float *xrun, *out_sf, *out_sb, *out_ckv, *out_kpe;
    float *mod, *hbuf, *kvraw, *cat, *proj, *qraw, *y0, *y1, *qp;
    bf16_t *rb, *kb, *vb, *kkb, *lr0, *lr1, *gateb;
    float *dec0, *dec1, *tw, *adv, *sg, *bonus, *kpe, *qcn, *ckv;
    bf16_t *Qb, *Kp, *Vp, *Ks, *Vs;
    float *kvraw_ctx; int* pidx; float* pg;
    float *pre, *zin, *x0b, *hfS, *hbS, *hfP, *hbP, *invS, *invP; int* pidx1; float* pg1; float* zb;
};

#define VLOOP(n) for (int vb = blockIdx.x; vb < (n); vb += gridDim.x)
#define ENDV __syncthreads();

__global__ void __launch_bounds__(256) mega(Params p) {
    __shared__ __attribute__((aligned(16))) char smem[57344];
    cg::grid_group grid = cg::this_grid();
    const float* mod0 = p.mod;
    const float* mod1 = p.mod + 5 * 6144;
    float* xrs = p.xrun + (size_t)TP * DM;

    VLOOP(48) { d_mod(vb % 24, vb / 24, 0, smem, p.c, p.c_ctx, p.w_mod, p.b_mod, p.mod); ENDV }
    grid.sync();
    VLOOP(TT) { d_norm_mod(vb, 0, 0, smem, p.x_prompt, p.x_sample, p.norm_g, mod0, 0, 1, p.hbuf); ENDV }
    grid.sync();
    VLOOP(35 * 192) { d_gemm(vb % 35, vb / 35, 0, smem, p.hbuf, 1024, p.ab_w_in, ABIN, 1024, EpiStore{p.proj, nullptr, ABIN, 0}); ENDV }
    grid.sync();
    VLOOP(2 * TT) {
        if (vb < TT) d_rw_shift(vb, 0, 0, smem, p.proj, p.rw_mu, p.rb, p.kb, p.vb, p.tw, p.adv, p.sg);
        else d_mla_pre(vb - TT, 0, 0, smem, p.proj, p.mla_q_norm, p.mla_kv_norm, p.qcn, p.ckv, p.kpe, p.out_ckv, p.out_kpe);
        ENDV }
    grid.sync();
    {
        const int n0 = 8 * 192, n1 = 12 * 192, n2 = 16 * 192, n3 = 16 * 16;
        VLOOP(5 * n0 + n1 + n2 + n3) {
            int v = vb;
            if (v < n0) d_gemm(v % 8, v / 8, 0, smem, p.tw, 64, p.rw_w2, 512, 64, EpiDecay{p.dec0, p.rw_w0});
            else if ((v -= n0) < n0) d_gemm(v % 8, v / 8, 0, smem, p.tw, 64, p.rw_w2 + 64 * 512, 512, 64, EpiDecay{p.dec1, p.rw_w0 + 512});
            else if ((v -= n0) < n0) d_gemm(v % 8, v / 8, 0, smem, p.adv, 64, p.rw_a2, 512, 64, EpiLr{p.lr0, p.rw_a0});
            else if ((v -= n0) < n0) d_gemm(v % 8, v / 8, 0, smem, p.adv, 64, p.rw_a2 + 64 * 512, 512, 64, EpiLr{p.lr1, p.rw_a0 + 512});
            else if ((v -= n0) < n0) d_gemm(v % 8, v / 8, 0, smem, p.sg, 128, p.rw_g2, 512, 128, EpiStoreBf{p.gateb, 512, 0});
            else if ((v -= n0) < n1) d_gemm(v % 12, v / 12, 0, smem, p.qcn, 256, p.mla_q_up, 768, 256, EpiStore{p.qraw, nullptr, 768, 0});
            else if ((v -= n1) < n2) d_gemm(v % 16, v / 16, 0, smem, p.ckv, 128, p.mla_kv_up, 1024, 128, EpiStore{p.kvraw, nullptr, 1024, 0});
            else { v -= n2; d_gemm(v % 16, v / 16, 0, smem, p.cache_ckv, 128, p.mla_kv_up, 1024, 128, EpiStore{p.kvraw_ctx, nullptr, 1024, 0}); }
            ENDV }
    }
    grid.sync();
    VLOOP(2 * TT + TT + 1024) {
        if (vb < 2 * TT) d_rw_kk(vb, 0, 0, smem, p.rb, p.kb, p.lr0, p.lr1, p.rw_k_k, p.rw_k_a, p.rw_r_k, p.kkb, p.bonus);
        else d_mla_post(vb - 2 * TT, 0, 0, smem, p.qraw, p.kvraw, p.kvraw_ctx, p.kpe, p.cache_kpe, p.mla_qn, p.mla_kn, p.Qb, p.Kp, p.Vp, p.Ks, p.Vs);
        ENDV }
    grid.sync();
    VLOOP(80 + 1024 + 2048) {
        if (vb < 16) d_scan(64 + vb, 0, 0, smem, p.rb, p.kb, p.vb, p.kkb, p.lr0, p.lr1, p.dec0, p.dec1, p.rw_k_a, p.st_f, p.st_b, p.y0, p.y1, p.out_sf, p.out_sb);
        else if (vb < 80) d_scan(vb - 16, 0, 0, smem, p.rb, p.kb, p.vb, p.kkb, p.lr0, p.lr1, p.dec0, p.dec1, p.rw_k_a, p.st_f, p.st_b, p.y0, p.y1, p.out_sf, p.out_sb);
        else if (vb < 80 + 2048) { int v = vb - 80; d_attn(v % 128, (v / 128) % 4, v / 512, smem, p.Qb, p.Ks, p.Vs, p.cat, TP, LS, 2304); }
        else { int v = vb - 80 - 2048; d_attn(v % 16, (v / 16) % 4, v / 64, smem, p.Qb, p.Kp, p.Vp, p.cat, 0, LP, LP); }
        ENDV }
    grid.sync();
    VLOOP(2 * TT) { d_rw_post(vb, 0, 0, smem, p.y0, p.y1, p.bonus, p.vb, p.gateb, p.rw_lnx_g, p.rw_lnx_b, p.cat); ENDV }
    grid.sync();
    VLOOP(16 * 192) { d_gemm(vb % 16, vb / 16, 0, smem, p.cat, 1024, p.ab_w_out, 1024, 1024, EpiResid{p.x_prompt, p.x_sample, p.xrun, mod0, 2, 0}); ENDV }
    grid.sync();
    VLOOP(TT) { d_norm_mod(vb, 0, 0, smem, p.xrun, xrs, p.norm_g + 1024, mod0, 3, 4, p.hbuf); ENDV }
    grid.sync();
    VLOOP(32 * 192) { d_gemm(vb % 32, vb / 32, 0, smem, p.hbuf, 1024, p.peer_w_q, 2048, 1024, EpiStore{p.qp, nullptr, 2048, 0}); ENDV }
    grid.sync();
    VLOOP(2 * TT) { d_peer_route(vb, 0, 0, smem, p.qp, p.peer_keys, p.pidx, p.pg); ENDV }
    grid.sync();
    VLOOP(TT) { d_peer_apply(vb, 0, 0, smem, p.hbuf, p.pidx, p.pg, p.peer_u, p.peer_v, mod0, p.xrun); ENDV }
    grid.sync();
    VLOOP(TT + LS + LP) {
        if (vb < TT) d_norm_mod(vb, 0, 0, smem, p.xrun, xrs, p.norm_g + 2048, mod1, 0, 1, p.hbuf);
        else if (vb < TT + LS) d_hy_filt(vb - TT, 0, 0, smem, LS, p.hy_f_w1, p.hy_f_b1, p.hy_f_w2, p.hy_f_b2, p.hy_f_w3, p.hy_f_freq, p.hfS, p.hbS);
        else d_hy_filt(vb - TT - LS, 0, 0, smem, LP, p.hy_f_w1, p.hy_f_b1, p.hy_f_w2, p.hy_f_b2, p.hy_f_w3, p.hy_f_freq, p.hfP, p.hbP);
        ENDV }
    grid.sync();
    VLOOP(48 * 192 + 8) {
        if (vb < 48 * 192) d_gemm(vb % 48, vb / 48, 0, smem, p.hbuf, 1024, p.hy_w_in, 3072, 1024, EpiStore{p.pre, p.hy_b_in, 3072, 0});
        else if (vb < 48 * 192 + 4) d_hy_norm(vb - 48 * 192, 0, 0, smem, LS, p.hfS, p.hbS, p.invS);
        else d_hy_norm(vb - 48 * 192 - 4, 0, 0, smem, LP, p.hfP, p.hbP, p.invP);
        ENDV }
    grid.sync();
    VLOOP(TT) { d_hy_dw(vb, 0, 0, smem, p.pre, p.hy_conv_w, p.hy_conv_b, p.zin, p.x0b); ENDV }
    grid.sync();
    VLOOP(4 * 256 * 4 + 4 * 32 * 16) {
        if (vb < 4096) d_hy_conv(vb % 4, (vb / 4) % 256, vb / 1024, smem, LS, TP, p.zin, p.x0b, p.hfS, p.hbS, p.invS, p.hy_bias, p.zb);
        else { int v = vb - 4096; d_hy_conv(v % 4, (v / 4) % 32, v / 128, smem, LP, 0, p.zin, p.x0b, p.hfP, p.hbP, p.invP, p.hy_bias, p.zb); }
        ENDV }
    grid.sync();
    VLOOP(16 * 192) { d_gemm(vb % 16, vb / 16, 0, smem, p.zb, 1024, p.hy_w_out, 1024, 1024, EpiResid{p.xrun, xrs, p.xrun, mod1, 2, 0}); ENDV }
    grid.sync();
    VLOOP(TT) { d_norm_mod(vb, 0, 0, smem, p.xrun, xrs, p.norm_g + 3072, mod1, 3, 4, p.hbuf); ENDV }
    grid.sync();
    VLOOP(32 * 192) { d_gemm(vb % 32, vb / 32, 0, smem, p.hbuf, 1024, p.peer_w_q + (size_t)1024 * 2048, 2048, 1024, EpiStore{p.qp, nullptr, 2048, 0}); ENDV }
    grid.sync();
    VLOOP(2 * TT) { d_peer_route(vb, 0, 0, smem, p.qp, p.peer_keys + (size_t)8 * 2 * 128 * 128, p.pidx1, p.pg1); ENDV }
    grid.sync();
    VLOOP(TT) { d_peer_apply(vb, 0, 0, smem, p.hbuf, p.pidx1, p.pg1, p.peer_u + (size_t)16384 * 1024, p.peer_v + (size_t)16384 * 1024, mod1, p.xrun); ENDV }
}

static inline size_t align_up(size_t x) { return (x + 255) & ~(size_t)255; }

extern "C" void kernel_launch(void* const* d_in, const int* in_sizes, int n_in, void* d_out, int out_size, void* d_ws, size_t ws_size,
                              hipStream_t stream) {
    Params p{};
    const float** pin = (const float**)&p;
    for (int i = 0; i < 46; i++) pin[i] = (const float*)d_in[i];

    float* out = (float*)d_out;
    p.xrun = out;
    p.out_sf = out + (size_t)TT * DM;
    p.out_sb = p.out_sf + 16 * 8 * 64 * 64;
    p.out_ckv = p.out_sb + 16 * 8 * 64 * 64;
    p.out_kpe = p.out_ckv + 16 * 256 * 128;

    char* ws = (char*)d_ws;
    size_t off = 0;
    auto take = [&](size_t bytes) { char* q = ws + off; off = align_up(off + bytes); return q; };
    p.mod = (float*)take((size_t)2 * 5 * 6144 * 4);
    char* R1 = take((size_t)TT * 1024 * 4);
    char* R2 = take((size_t)TT * ABIN * 4);
    char* R3 = ws + off;
    p.hbuf = (float*)R1; p.kvraw = (float*)R1; p.cat = (float*)R1; p.zb = (float*)R1;
    p.proj = (float*)R2; p.qraw = (float*)R2; p.qp = (float*)R2;
    p.y0 = (float*)(R2 + (size_t)TT * 768 * 4);
    p.y1 = p.y0 + (size_t)TT * 512;
    size_t o3 = 0;
    auto take3 = [&](size_t bytes) { char* q = R3 + o3; o3 = align_up(o3 + bytes); return q; };
    p.rb = (bf16_t*)take3((size_t)TT * 512 * 2);
    p.kb = (bf16_t*)take3((size_t)TT * 512 * 2);
    p.vb = (bf16_t*)take3((size_t)TT * 512 * 2);
    p.kkb = (bf16_t*)take3((size_t)TT * 512 * 2);
    p.lr0 = (bf16_t*)take3((size_t)TT * 512 * 2);
    p.lr1 = (bf16_t*)take3((size_t)TT * 512 * 2);
    p.gateb = (bf16_t*)take3((size_t)TT * 512 * 2);
    p.dec0 = (float*)take3((size_t)TT * 512 * 4);
    p.dec1 = (float*)take3((size_t)TT * 512 * 4);
    p.tw = (float*)take3((size_t)TT * 64 * 4);
    p.adv = (float*)take3((size_t)TT * 64 * 4);
    p.sg = (float*)take3((size_t)TT * 128 * 4);
    p.bonus = (float*)take3((size_t)TT * 8 * 4);
    p.kpe = (float*)take3((size_t)TT * 64 * 4);
    p.qcn = (float*)take3((size_t)TT * 256 * 4);
    p.ckv = (float*)take3((size_t)TT * 128 * 4);
    p.Qb = (bf16_t*)take3((size_t)TT * 768 * 2);
    p.Kp = (bf16_t*)take3((size_t)16 * 4 * 256 * 192 * 2);
    p.Vp = (bf16_t*)take3((size_t)16 * 4 * 256 * 128 * 2);
    p.Ks = (bf16_t*)take3((size_t)4 * 4 * 2304 * 192 * 2);
    p.Vs = (bf16_t*)take3((size_t)4 * 4 * 2304 * 128 * 2);
    p.kvraw_ctx = (float*)take3((size_t)1024 * 1024 * 4);
    p.pidx = (int*)take3((size_t)TT * 128 * 4);
    p.pg = (float*)take3((size_t)TT * 128 * 4);
    p.pre = (float*)R2;
    char* L1 = R2 + (size_t)TT * 3072 * 4;
    p.zin = (float*)L1;
    p.x0b = p.zin + (size_t)TT * 1024;
    p.hfS = p.x0b + (size_t)TT * 1024;
    p.hbS = p.hfS + (size_t)LS * 1024;
    p.hfP = p.hbS + (size_t)LS * 1024;
    p.hbP = p.hfP + (size_t)LP * 1024;
    p.invS = p.hbP + (size_t)LP * 1024;
    p.invP = p.invS + 1024;
    p.pidx1 = (int*)(p.invP + 1024);
    p.pg1 = (float*)(p.pidx1 + (size_t)TT * 128);

    static int grid_blocks = 0;
    if (!grid_blocks) {
        int dev = 0, cus = 0, per_cu = 0;
        hipGetDevice(&dev);
        hipDeviceGetAttribute(&cus, hipDeviceAttributeMultiprocessorCount, dev);
        hipOccupancyMaxActiveBlocksPerMultiprocessor(&per_cu, mega, 256, 0);
        if (per_cu > 2) per_cu = 2;
        if (per_cu < 1) per_cu = 1;
        grid_blocks = cus * per_cu;
    }
    void* args[] = {&p};
    hipLaunchCooperativeKernel((void*)mega, dim3(grid_blocks), dim3(256), args, 0, stream);
}
```

```cpp
#include <hip/hip_runtime.h>
#include <stdint.h>
#include <hip/hip_cooperative_groups.h>
namespace cg = cooperative_groups;

#define DM 1024
#define TP 4096
#define TS 8192
#define TT 12288
#define LP 256
#define LS 2048
#define NBP 16
#define NBS 4
#define ABIN 2240
#define RWIN 1792

typedef unsigned short bf16_t;
__device__ __forceinline__ bf16_t f2bf(float f) { unsigned u = __float_as_uint(f); u += 0x7fffu + ((u >> 16) & 1u); return (bf16_t)(u >> 16); }
__device__ __forceinline__ float bf2f(bf16_t h) { return __uint_as_float(((unsigned)h) << 16); }
__device__ __forceinline__ float sigmoidf_(float x) { return 1.f / (1.f + expf(-x)); }
__device__ __forceinline__ float gelu_tanh(float x) { return 0.5f * x * (1.f + tanhf(0.7978845608028654f * (x + 0.044715f * x * x * x))); }

__device__ __forceinline__ int tok_pos(int t) { return t < TP ? (t & (LP - 1)) : ((t - TP) & (LS - 1)); }
__device__ __forceinline__ int tok_len(int t) { return t < TP ? LP : LS; }
__device__ __forceinline__ int tok_modrow(int t) { return t < TP ? 0 : 1 + ((t - TP) >> 11); }

__device__ __forceinline__ float wave_sum(float v) {
#pragma unroll
    for (int o = 32; o > 0; o >>= 1) v += __shfl_xor(v, o, 64);
    return v;
}

__device__ __forceinline__ void d_mod(const int bx, const int by, const int bz, char* smem, const float* __restrict__ c, const float* __restrict__ c_ctx, const float* __restrict__ w_mod,
                                             const float* __restrict__ b_mod, float* __restrict__ mod) {
    float (*s)[1024] = (float(*)[1024])smem;
    const int li = by;
    const int n = bx * 256 + threadIdx.x;
    for (int i = threadIdx.x; i < 5 * 1024; i += 256) {
        int r = i >> 10, k = i & 1023;
        float v = (r == 0) ? c_ctx[k] : c[(r - 1) * 1024 + k];
        s[r][k] = v / (1.f + expf(-v));
    }
    __syncthreads();
    float a0 = 0, a1 = 0, a2 = 0, a3 = 0, a4 = 0;
    const float* w = w_mod + (size_t)li * 1024 * 6144 + n;
    for (int k = 0; k < 1024; k++) {
        float wv = w[(size_t)k * 6144];
        a0 += s[0][k] * wv; a1 += s[1][k] * wv; a2 += s[2][k] * wv; a3 += s[3][k] * wv; a4 += s[4][k] * wv;
    }
    float bb = b_mod[li * 6144 + n];
    float* o = mod + (size_t)li * 5 * 6144 + n;
    o[0 * 6144] = a0 + bb; o[1 * 6144] = a1 + bb; o[2 * 6144] = a2 + bb; o[3 * 6144] = a3 + bb; o[4 * 6144] = a4 + bb;
}

__device__ __forceinline__ void d_norm_mod(const int bx, const int by, const int bz, char* smem, const float* __restrict__ xa, const float* __restrict__ xb, const float* __restrict__ g,
                                                  const float* __restrict__ modl, int shift_idx, int scale_idx, bf16_t* __restrict__ h) {
    float* red = (float*)smem;
    const int t = bx;
    const float* x = (t < TP) ? (xa + (size_t)t * DM) : (xb + (size_t)(t - TP) * DM);
    const int c = threadIdx.x * 4;
    float4 v = *(const float4*)(x + c);
    float ss = v.x * v.x + v.y * v.y + v.z * v.z + v.w * v.w;
    ss = wave_sum(ss);
    if ((threadIdx.x & 63) == 0) red[threadIdx.x >> 6] = ss;
    __syncthreads();
    float tot = red[0] + red[1] + red[2] + red[3];
    float rstd = rsqrtf(tot * (1.f / DM) + 1e-6f);
    const float* m = modl + (size_t)tok_modrow(t) * 6144;
    float4 gg = *(const float4*)(g + c);
    float4 sh = *(const float4*)(m + shift_idx * 1024 + c);
    float4 sc = *(const float4*)(m + scale_idx * 1024 + c);
    float4 o;
    o.x = v.x * rstd * gg.x * (1.f + sc.x) + sh.x;
    o.y = v.y * rstd * gg.y * (1.f + sc.y) + sh.y;
    o.z = v.z * rstd * gg.z * (1.f + sc.z) + sh.z;
    o.w = v.w * rstd * gg.w * (1.f + sc.w) + sh.w;
    ushort4 ob; ob.x = f2bf(o.x); ob.y = f2bf(o.y); ob.z = f2bf(o.z); ob.w = f2bf(o.w);
    *(ushort4*)(h + (size_t)t * DM + c) = ob;
}

struct EpiStore { float* C; const float* bias; int ldc; int pad;
    __device__ void operator()(int m, int n, float a) const { C[(size_t)m * ldc + n] = a + (bias ? bias[n] : 0.f); } };
struct EpiStoreBf { bf16_t* C; int ldc; int pad;
    __device__ void operator()(int m, int n, float a) const { C[(size_t)m * ldc + n] = f2bf(a); } };
struct EpiDecay { float* out; const float* w0;
    __device__ void operator()(int m, int n, float a) const { out[(size_t)m * 512 + n] = expf(-0.6065306597126334f * sigmoidf_(w0[n] + a)); } };
struct EpiLr { bf16_t* out; const float* a0;
    __device__ void operator()(int m, int n, float a) const { out[(size_t)m * 512 + n] = f2bf(sigmoidf_(a0[n] + a)); } };
struct EpiResid { const float* xa; const float* xb; float* out; const float* modl; int gate_idx; int pad;
    __device__ void operator()(int m, int n, float a) const {
        float x = (m < TP) ? xa[(size_t)m * DM + n] : xb[(size_t)(m - TP) * DM + n];
        float gt = modl[(size_t)tok_modrow(m) * 6144 + gate_idx * 1024 + n];
        out[(size_t)m * DM + n] = x + gt * a; } };

template <class Epi>
__device__ __forceinline__ void d_gemm(const int bx, const int by, const int bz, char* smem, const float* __restrict__ A, int lda, const float* __restrict__ B, int ldb, int K, Epi epi) {
    float (*As)[68] = (float(*)[68])smem;
    float (*Bs)[68] = (float(*)[68])(smem + 16 * 68 * 4);
    const int m0 = by * 64, n0 = bx * 64;
    const int tid = threadIdx.x, tx = tid & 15, ty = tid >> 4;
    float acc[4][4];
#pragma unroll
    for (int i = 0; i < 4; i++)
#pragma unroll
        for (int j = 0; j < 4; j++) acc[i][j] = 0.f;
    for (int k0 = 0; k0 < K; k0 += 16) {
        {
            int r = tid >> 2, kq = (tid & 3) * 4;
            float4 v = *(const float4*)(A + (size_t)(m0 + r) * lda + k0 + kq);
            As[kq + 0][r] = v.x; As[kq + 1][r] = v.y; As[kq + 2][r] = v.z; As[kq + 3][r] = v.w;
        }
        {
            int kk = tid >> 4, nq = (tid & 15) * 4;
            float4 v = *(const float4*)(B + (size_t)(k0 + kk) * ldb + n0 + nq);
            *(float4*)&Bs[kk][nq] = v;
        }
        __syncthreads();
#pragma unroll
        for (int k = 0; k < 16; k++) {
            float a[4], b[4];
#pragma unroll
            for (int i = 0; i < 4; i++) a[i] = As[k][ty * 4 + i];
            float4 bv = *(const float4*)&Bs[k][tx * 4];
            b[0] = bv.x; b[1] = bv.y; b[2] = bv.z; b[3] = bv.w;
#pragma unroll
            for (int i = 0; i < 4; i++)
#pragma unroll
                for (int j = 0; j < 4; j++) acc[i][j] += a[i] * b[j];
        }
        __syncthreads();
    }
#pragma unroll
    for (int i = 0; i < 4; i++)
#pragma unroll
        for (int j = 0; j < 4; j++) epi(m0 + ty * 4 + i, n0 + tx * 4 + j, acc[i][j]);
}


typedef __attribute__((ext_vector_type(8))) short bf16x8;
typedef __attribute__((ext_vector_type(16))) float f32x16;
typedef __attribute__((ext_vector_type(4))) float f32x4;
#define GEMM_LDS_BYTES 73728

template <class Epi>
__device__ __forceinline__ void d_gemm_bf16(const int bx, const int by, char* smem, const bf16_t* __restrict__ A, int lda,
                                            const bf16_t* __restrict__ Bt, int ldb, int K, int N, Epi epi) {
    const int tid = threadIdx.x, lane = tid & 63, wid = tid >> 6;
    const int wm = wid >> 1, wn = wid & 1;
    const int m0 = by * 128, n0 = bx * 128;
    f32x16 acc[2][2];
#pragma unroll
    for (int i = 0; i < 2; i++)
#pragma unroll
        for (int j = 0; j < 2; j++)
#pragma unroll
            for (int r = 0; r < 16; r++) acc[i][j][r] = 0.f;
    const int lrow = tid >> 3, lcol = (tid & 7) * 8;
    const bf16_t* ga = A + (size_t)(m0 + lrow) * lda + lcol;
    const bf16_t* gb = Bt + (size_t)(n0 + lrow) * ldb + lcol;
    uint4 ra[4], rb[4];
    const int KT = K >> 6;
#pragma unroll
    for (int i = 0; i < 4; i++) { ra[i] = *(const uint4*)(ga + (size_t)(32 * i) * lda); rb[i] = *(const uint4*)(gb + (size_t)(32 * i) * ldb); }
    {
        char* sa = smem;
#pragma unroll
        for (int i = 0; i < 4; i++) { *(uint4*)(sa + (lrow + 32 * i) * 144 + lcol * 2) = ra[i]; *(uint4*)(sa + 18432 + (lrow + 32 * i) * 144 + lcol * 2) = rb[i]; }
    }
    __syncthreads();
    const int frow = lane & 31, fk = (lane >> 5) * 16;
    for (int kt = 0; kt < KT; kt++) {
        if (kt + 1 < KT) {
#pragma unroll
            for (int i = 0; i < 4; i++) { ra[i] = *(const uint4*)(ga + (size_t)(32 * i) * lda + (kt + 1) * 64); rb[i] = *(const uint4*)(gb + (size_t)(32 * i) * ldb + (kt + 1) * 64); }
        }
        const char* sa = smem + (kt & 1) * 36864;
        const char* sb = sa + 18432;
#pragma unroll
        for (int ks = 0; ks < 4; ks++) {
            bf16x8 af[2], bfr[2];
#pragma unroll
            for (int i = 0; i < 2; i++) af[i] = *(const bf16x8*)(sa + (wm * 64 + i * 32 + frow) * 144 + ks * 32 + fk);
#pragma unroll
            for (int j = 0; j < 2; j++) bfr[j] = *(const bf16x8*)(sb + (wn * 64 + j * 32 + frow) * 144 + ks * 32 + fk);
#pragma unroll
            for (int i = 0; i < 2; i++)
#pragma unroll
                for (int j = 0; j < 2; j++) acc[i][j] = __builtin_amdgcn_mfma_f32_32x32x16_bf16(af[i], bfr[j], acc[i][j], 0, 0, 0);
        }
        if (kt + 1 < KT) {
            char* sn = smem + ((kt + 1) & 1) * 36864;
#pragma unroll
            for (int i = 0; i < 4; i++) { *(uint4*)(sn + (lrow + 32 * i) * 144 + lcol * 2) = ra[i]; *(uint4*)(sn + 18432 + (lrow + 32 * i) * 144 + lcol * 2) = rb[i]; }
        }
        __syncthreads();
    }
#pragma unroll
    for (int i = 0; i < 2; i++)
#pragma unroll
        for (int j = 0; j < 2; j++) {
            const int col = n0 + wn * 64 + j * 32 + (lane & 31);
            if (col < N) {
#pragma unroll
                for (int r = 0; r < 16; r++) {
                    const int row = m0 + wm * 64 + i * 32 + (r & 3) + 8 * (r >> 2) + 4 * (lane >> 5);
                    epi(row, col, acc[i][j][r]);
                }
            }
        }
}

__device__ __forceinline__ void d_transpose_w(const int vb, char* smem, const float* __restrict__ W, int K, int N, bf16_t* __restrict__ Wt) {
    float (*tile)[65] = (float(*)[65])smem;
    const int kt = K >> 6;
    const int nb = vb / kt, kb = vb % kt;
    const int tid = threadIdx.x;
    {
        const int n = nb * 64 + (tid & 63);
#pragma unroll
        for (int i = 0; i < 16; i++) {
            int k = (tid >> 6) + 4 * i;
            tile[k][tid & 63] = (n < N) ? W[(size_t)(kb * 64 + k) * N + n] : 0.f;
        }
    }
    __syncthreads();
    {
        const int k = tid & 63;
#pragma unroll
        for (int i = 0; i < 16; i++) {
            int n = (tid >> 6) + 4 * i;
            Wt[(size_t)(nb * 64 + n) * K + kb * 64 + k] = f2bf(tile[k][n]);
        }
    }
}

__device__ __forceinline__ void d_rw_shift(const int bx, const int by, const int bz, char* smem, const float* __restrict__ proj, const float* __restrict__ mu, bf16_t* __restrict__ rb,
                                                  bf16_t* __restrict__ kb, bf16_t* __restrict__ vb, bf16_t* __restrict__ tw, bf16_t* __restrict__ adv,
                                                  bf16_t* __restrict__ sg) {
    const int t = bx;
    const int pos = tok_pos(t), L = tok_len(t);
    const float* P = proj + (size_t)t * ABIN;
    for (int c = threadIdx.x; c < RWIN; c += 256) {
        float cur = P[c];
        float prev = (pos > 0) ? P[c - ABIN] : 0.f;
        float nxt = (pos < L - 1) ? P[c + ABIN] : 0.f;
        float val = cur + mu[c] * (0.5f * (prev + nxt) - cur);
        if (c < 512) rb[(size_t)t * 512 + c] = f2bf(val);
        else if (c < 1024) kb[(size_t)t * 512 + c - 512] = f2bf(val);
        else if (c < 1536) vb[(size_t)t * 512 + c - 1024] = f2bf(val);
        else if (c < 1600) tw[(size_t)t * 64 + c - 1536] = f2bf(tanhf(val));
        else if (c < 1664) adv[(size_t)t * 64 + c - 1600] = f2bf(val);
        else sg[(size_t)t * 128 + c - 1664] = f2bf(sigmoidf_(val));
    }
}

__device__ __forceinline__ void d_rw_kk(const int bx, const int by, const int bz, char* smem, const bf16_t* __restrict__ rb, const bf16_t* __restrict__ kb, const bf16_t* __restrict__ lr0,
                                               const bf16_t* __restrict__ lr1, const float* __restrict__ k_k, const float* __restrict__ k_a,
                                               const float* __restrict__ r_k, bf16_t* __restrict__ kkb, float* __restrict__ bonus) {
    const int w = bx * 4 + (threadIdx.x >> 6);
    const int lane = threadIdx.x & 63;
    const int t = w >> 3, h = w & 7;
    const size_t o = (size_t)t * 512 + h * 64 + lane;
    const int ch = h * 64 + lane;
    float k = bf2f(kb[o]), r = bf2f(rb[o]);
    float kk = k * k_k[ch];
    float nrm = sqrtf(wave_sum(kk * kk));
    kk = kk / fmaxf(nrm, 1e-12f);
    kkb[o] = f2bf(kk);
    float l0 = bf2f(lr0[o]), l1 = bf2f(lr1[o]);
    float ka = k_a[ch];
    float kd0 = k * (1.f + (l0 - 1.f) * ka), kd1 = k * (1.f + (l1 - 1.f) * ka);
    float s = wave_sum(r * (kd0 + kd1) * r_k[ch]);
    if (lane == 0) bonus[w] = s;
}

__device__ __forceinline__ void d_scan(const int bx, const int by, const int bz, char* smem, const bf16_t* __restrict__ rb, const bf16_t* __restrict__ kb, const bf16_t* __restrict__ vb,
                                             const bf16_t* __restrict__ kkb, const bf16_t* __restrict__ lr0, const bf16_t* __restrict__ lr1,
                                             const float* __restrict__ dec0, const float* __restrict__ dec1, const float* __restrict__ k_a,
                                             const float* __restrict__ st_f, const float* __restrict__ st_b, float* __restrict__ y0,
                                             float* __restrict__ y1, float* __restrict__ out_sf, float* __restrict__ out_sb) {
    float* sbase = (float*)smem + (threadIdx.x >> 6) * 320;
    float* sa_ = sbase; float* sw_ = sbase + 64; float* sb_ = sbase + 128; float* skd_ = sbase + 192; float* sr_ = sbase + 256;
    int id = bx * 4 + (threadIdx.x >> 6);
    int d, h, b, L, tbase;
    bool prompt = id < 256;
    if (prompt) { d = id & 1; h = (id >> 1) & 7; b = id >> 4; L = LP; tbase = b * LP; }
    else { int j = id - 256; d = j & 1; h = (j >> 1) & 7; b = j >> 4; L = LS; tbase = TP + b * LS; }
    const int v = threadIdx.x & 63;
    const bf16_t* lr = d ? lr1 : lr0;
    const float* dec = d ? dec1 : dec0;
    float* yo = d ? y1 : y0;
    const float ka = k_a[h * 64 + v];
    float S[64];
    if (prompt) {
#pragma unroll
        for (int k = 0; k < 64; k++) S[k] = 0.f;
    } else {
        const float* st = (d ? st_b : st_f) + ((size_t)(b * 8 + h) * 64 + v) * 64;
#pragma unroll
        for (int k = 0; k < 64; k += 4) { float4 q = *(const float4*)(st + k); S[k] = q.x; S[k + 1] = q.y; S[k + 2] = q.z; S[k + 3] = q.w; }
    }
    for (int i = 0; i < L; i++) {
        const int t = tbase + (d ? (L - 1 - i) : i);
        const size_t o = (size_t)t * 512 + h * 64 + v;
        float kkv = bf2f(kkb[o]), lrv = bf2f(lr[o]), kv = bf2f(kb[o]), rv = bf2f(rb[o]), vv = bf2f(vb[o]), wv = dec[o];
        __builtin_amdgcn_wave_barrier();
        sa_[v] = -kkv; sb_[v] = kkv * lrv; skd_[v] = kv * (1.f + (lrv - 1.f) * ka); sw_[v] = wv; sr_[v] = rv;
        __builtin_amdgcn_wave_barrier();
        float sa = 0.f;
#pragma unroll
        for (int k = 0; k < 64; k += 4) { float4 a = *(const float4*)&sa_[k]; sa += S[k] * a.x + S[k + 1] * a.y + S[k + 2] * a.z + S[k + 3] * a.w; }
        float y = 0.f;
#pragma unroll
        for (int k = 0; k < 64; k += 4) {
            float4 w4 = *(const float4*)&sw_[k]; float4 b4 = *(const float4*)&sb_[k]; float4 k4 = *(const float4*)&skd_[k]; float4 r4 = *(const float4*)&sr_[k];
            S[k] = S[k] * w4.x + sa * b4.x + vv * k4.x; y += S[k] * r4.x;
            S[k + 1] = S[k + 1] * w4.y + sa * b4.y + vv * k4.y; y += S[k + 1] * r4.y;
            S[k + 2] = S[k + 2] * w4.z + sa * b4.z + vv * k4.z; y += S[k + 2] * r4.z;
            S[k + 3] = S[k + 3] * w4.w + sa * b4.w + vv * k4.w; y += S[k + 3] * r4.w;
        }
        yo[o] = y;
    }
    if (prompt) {
        float* os = (d ? out_sb : out_sf) + ((size_t)(b * 8 + h) * 64 + v) * 64;
#pragma unroll
        for (int k = 0; k < 64; k += 4) *(float4*)(os + k) = make_float4(S[k], S[k + 1], S[k + 2], S[k + 3]);
    }
}

__device__ __forceinline__ void d_rw_post(const int bx, const int by, const int bz, char* smem, const float* __restrict__ y0, const float* __restrict__ y1, const float* __restrict__ bonus,
                                                 const bf16_t* __restrict__ vb, const bf16_t* __restrict__ gate, const float* __restrict__ lnx_g,
                                                 const float* __restrict__ lnx_b, bf16_t* __restrict__ cat) {
    const int w = bx * 4 + (threadIdx.x >> 6);
    const int lane = threadIdx.x & 63;
    const int t = w >> 3, h = w & 7;
    const size_t o = (size_t)t * 512 + h * 64 + lane;
    const int ch = h * 64 + lane;
    float y = y0[o] + y1[o];
    float mean = wave_sum(y) * (1.f / 64.f);
    float dlt = y - mean;
    float var = wave_sum(dlt * dlt) * (1.f / 64.f);
    float yn = dlt * rsqrtf(var + 64e-5f) * lnx_g[ch] + lnx_b[ch];
    float val = (yn + bonus[w] * bf2f(vb[o])) * bf2f(gate[o]);
    cat[(size_t)t * DM + ch] = f2bf(val);
}

__device__ __forceinline__ void d_mla_pre(const int bx, const int by, const int bz, char* smem, const float* __restrict__ proj, const float* __restrict__ q_norm, const float* __restrict__ kv_norm,
                                                 bf16_t* __restrict__ qcn, bf16_t* __restrict__ ckv, float* __restrict__ kpe,
                                                 float* __restrict__ out_ckv, float* __restrict__ out_kpe) {
    float* red = (float*)smem; float* red2 = red + 4;
    const int t = bx;
    const int tid = threadIdx.x;
    const float* P = proj + (size_t)t * ABIN + RWIN;
    float q = P[tid];
    float kv = (tid < 128) ? P[256 + tid] : 0.f;
    float ss = wave_sum(q * q);
    float s2 = wave_sum(kv * kv);
    if ((tid & 63) == 0) { red[tid >> 6] = ss; red2[tid >> 6] = s2; }
    __syncthreads();
    float rq = rsqrtf((red[0] + red[1] + red[2] + red[3]) * (1.f / 256.f) + 1e-6f);
    float rk = rsqrtf((red2[0] + red2[1] + red2[2] + red2[3]) * (1.f / 128.f) + 1e-6f);
    qcn[(size_t)t * 256 + tid] = f2bf(q * rq * q_norm[tid]);
    if (tid < 128) {
        float val = kv * rk * kv_norm[tid];
        ckv[(size_t)t * 128 + tid] = f2bf(val);
        if (t < TP) out_ckv[(size_t)t * 128 + tid] = val;
    } else if (tid < 192) {
        float pe = P[384 + tid - 128];
        kpe[(size_t)t * 64 + tid - 128] = pe;
        if (t < TP) out_kpe[(size_t)t * 64 + tid - 128] = pe;
    }
}

__device__ __forceinline__ void d_mla_post(const int bx, const int by, const int bz, char* smem, const float* __restrict__ qraw, const float* __restrict__ kvraw, const float* __restrict__ kvraw_ctx,
                                                  const float* __restrict__ kpe, const float* __restrict__ cache_kpe, const float* __restrict__ qn,
                                                  const float* __restrict__ kn, bf16_t* __restrict__ Qb, bf16_t* __restrict__ Kp, bf16_t* __restrict__ Vp,
                                                  bf16_t* __restrict__ Ks, bf16_t* __restrict__ Vs) {
    float (*sq)[192] = (float(*)[192])smem; float (*sk)[192] = (float(*)[192])(smem + 4 * 192 * 4);
    const int wi = threadIdx.x >> 6, lane = threadIdx.x & 63;
    const int row = bx, h = wi;
    const bool isctx = row >= TT;
    const bool sample = row >= TP;
    float kx[3], qx[3] = {0.f, 0.f, 0.f};
    const float* kvr; const float* pe; int pos = 0;
    if (isctx) { int cr = row - TT; kvr = kvraw_ctx + (size_t)cr * 1024; pe = cache_kpe + (size_t)cr * 64; }
    else { kvr = kvraw + (size_t)row * 1024; pe = kpe + (size_t)row * 64; pos = tok_pos(row); }
#pragma unroll
    for (int j = 0; j < 3; j++) {
        int i = lane + 64 * j;
        kx[j] = (i < 128) ? kvr[h * 256 + i] : pe[i - 128];
        if (!isctx) qx[j] = qraw[(size_t)row * 768 + h * 192 + i];
    }
    float ssk = wave_sum(kx[0] * kx[0] + kx[1] * kx[1] + kx[2] * kx[2]);
    float ssq = wave_sum(qx[0] * qx[0] + qx[1] * qx[1] + qx[2] * qx[2]);
    float rk = rsqrtf(ssk * (1.f / 192.f) + 1e-6f), rq = rsqrtf(ssq * (1.f / 192.f) + 1e-6f);
#pragma unroll
    for (int j = 0; j < 3; j++) {
        int i = lane + 64 * j;
        sk[wi][i] = kx[j] * rk * kn[i];
        sq[wi][i] = qx[j] * rq * qn[i];
    }
    __syncthreads();
    if (sample && !isctx && lane < 32) {
        int rowi = pos >> 6, coli = pos & 63;
        int fi = lane & 15;
        float inv = expf(-(float)fi * (1.f / 16.f) * 9.210340371976184f);
        float ang = (lane < 16 ? (float)rowi : (float)coli) * inv;
        float cs = cosf(ang), sn = sinf(ang);
        float a = sk[wi][128 + 2 * lane], bq = sk[wi][128 + 2 * lane + 1];
        sk[wi][128 + 2 * lane] = a * cs - bq * sn; sk[wi][128 + 2 * lane + 1] = a * sn + bq * cs;
        a = sq[wi][128 + 2 * lane]; bq = sq[wi][128 + 2 * lane + 1];
        sq[wi][128 + 2 * lane] = a * cs - bq * sn; sq[wi][128 + 2 * lane + 1] = a * sn + bq * cs;
    }
    __syncthreads();
    bf16_t* kd; bf16_t* vd;
    if (!sample) { int b = row >> 8, p = row & 255; kd = Kp + ((size_t)(b * 4 + h) * LP + p) * 192; vd = Vp + ((size_t)(b * 4 + h) * LP + p) * 128; }
    else if (!isctx) { int b = (row - TP) >> 11, p = (row - TP) & 2047; kd = Ks + ((size_t)(b * 4 + h) * 2304 + 256 + p) * 192; vd = Vs + ((size_t)(b * 4 + h) * 2304 + 256 + p) * 128; }
    else { int cr = row - TT; int b = cr >> 8, p = cr & 255; kd = Ks + ((size_t)(b * 4 + h) * 2304 + p) * 192; vd = Vs + ((size_t)(b * 4 + h) * 2304 + p) * 128; }
#pragma unroll
    for (int j = 0; j < 3; j++) {
        int i = lane + 64 * j;
        kd[i] = f2bf(sk[wi][i]);
        if (!isctx) Qb[((size_t)row * 4 + h) * 192 + i] = f2bf(sq[wi][i]);
    }
    vd[lane] = f2bf(kvr[h * 256 + 128 + lane]);
    vd[lane + 64] = f2bf(kvr[h * 256 + 128 + lane + 64]);
}

__device__ __forceinline__ void d_attn(const int bx, const int by, const int bz, char* smem, const bf16_t* __restrict__ Qb, const bf16_t* __restrict__ Kall, const bf16_t* __restrict__ Vall,
                                              bf16_t* __restrict__ cat, int tbase, int Lq, int Lk) {
    float (*Vsm)[128] = (float(*)[128])smem;
    float (*Qs)[192] = (float(*)[192])(smem + 32 * 128 * 4);
    float (*Ksm)[193] = (float(*)[193])(smem + 32 * 128 * 4 + 16 * 192 * 4);
    float (*Ss)[33] = (float(*)[33])(smem + 32 * 128 * 4 + 16 * 192 * 4 + 32 * 193 * 4);
    const int q0 = bx * 16, h = by, b = bz;
    const int tid = threadIdx.x;
    const int qi = tid >> 4, sub = tid & 15;
    const bf16_t* K = Kall + (size_t)(b * 4 + h) * Lk * 192;
    const bf16_t* V = Vall + (size_t)(b * 4 + h) * Lk * 128;
    for (int i = tid; i < 16 * 192; i += 256) {
        int r = i / 192, c = i % 192;
        int t = tbase + b * Lq + q0 + r;
        Qs[r][c] = bf2f(Qb[((size_t)t * 4 + h) * 192 + c]);
    }
    float m = -1e30f, l = 0.f;
    float acc[8];
#pragma unroll
    for (int j = 0; j < 8; j++) acc[j] = 0.f;
    const float scale = 0.07216878364870322f;
    for (int k0 = 0; k0 < Lk; k0 += 32) {
        __syncthreads();
        for (int i = tid; i < 32 * 192; i += 256) { int r = i / 192, c = i % 192; Ksm[r][c] = bf2f(K[(size_t)(k0 + r) * 192 + c]); }
        for (int i = tid; i < 32 * 128; i += 256) { int r = i >> 7, c = i & 127; Vsm[r][c] = bf2f(V[(size_t)(k0 + r) * 128 + c]); }
        __syncthreads();
        float s0 = 0.f, s1 = 0.f;
        for (int dd = 0; dd < 192; dd++) { float qv = Qs[qi][dd]; s0 += qv * Ksm[sub][dd]; s1 += qv * Ksm[sub + 16][dd]; }
        s0 *= scale; s1 *= scale;
        float mx = fmaxf(s0, s1);
#pragma unroll
        for (int o = 8; o > 0; o >>= 1) mx = fmaxf(mx, __shfl_xor(mx, o, 64));
        float mn = fmaxf(m, mx);
        float alpha = expf(m - mn);
        float p0 = expf(s0 - mn), p1 = expf(s1 - mn);
        float ps = p0 + p1;
#pragma unroll
        for (int o = 8; o > 0; o >>= 1) ps += __shfl_xor(ps, o, 64);
        l = l * alpha + ps; m = mn;
        Ss[qi][sub] = p0; Ss[qi][sub + 16] = p1;
        __syncthreads();
#pragma unroll
        for (int j = 0; j < 8; j++) acc[j] *= alpha;
        for (int kk = 0; kk < 32; kk++) {
            float p = Ss[qi][kk];
            float4 v0 = *(const float4*)&Vsm[kk][sub * 8], v1 = *(const float4*)&Vsm[kk][sub * 8 + 4];
            acc[0] += p * v0.x; acc[1] += p * v0.y; acc[2] += p * v0.z; acc[3] += p * v0.w;
            acc[4] += p * v1.x; acc[5] += p * v1.y; acc[6] += p * v1.z; acc[7] += p * v1.w;
        }
    }
    const int t = tbase + b * Lq + q0 + qi;
    float il = 1.f / l;
    bf16_t* o = cat + (size_t)t * DM + 512 + h * 128 + sub * 8;
#pragma unroll
    for (int j = 0; j < 8; j++) o[j] = f2bf(acc[j] * il);
}

__device__ __forceinline__ void d_peer_route(const int bx, const int by, const int bz, char* smem, const float* __restrict__ qp, const float* __restrict__ keys  ,
                                                    int* __restrict__ pidx, float* __restrict__ pg) {
    float (*sq)[256] = (float(*)[256])smem;
    float (*sc)[256] = (float(*)[256])(smem + 4096);
    float (*tv)[32] = (float(*)[32])(smem + 8192);
    int (*ti)[32] = (int(*)[32])(smem + 8192 + 512);
    float (*topv)[16] = (float(*)[16])(smem + 8192 + 1024);
    int (*topi)[16] = (int(*)[16])(smem + 8192 + 1024 + 256);
    const int wi = threadIdx.x >> 6, lane = threadIdx.x & 63;
    const int w = bx * 4 + wi;
    const int t = w >> 3, h = w & 7;
    const float* q = qp + (size_t)t * 2048 + h * 256;
#pragma unroll
    for (int j = 0; j < 4; j++) sq[wi][lane + 64 * j] = q[lane + 64 * j];
    __syncthreads();
#pragma unroll
    for (int p = 0; p < 2; p++)
#pragma unroll
        for (int half = 0; half < 2; half++) {
            int n = lane + 64 * half;
            const float* kr = keys + ((size_t)(h * 2 + p) * 128 + n) * 128;
            float s = 0.f;
            for (int dd = 0; dd < 128; dd += 4) {
                float4 kv = *(const float4*)(kr + dd);
                s += sq[wi][p * 128 + dd] * kv.x + sq[wi][p * 128 + dd + 1] * kv.y + sq[wi][p * 128 + dd + 2] * kv.z + sq[wi][p * 128 + dd + 3] * kv.w;
            }
            sc[wi][p * 128 + n] = s;
        }
    __syncthreads();
#pragma unroll
    for (int p = 0; p < 2; p++)
#pragma unroll
        for (int half = 0; half < 2; half++) {
            int n = lane + 64 * half;
            float s = sc[wi][p * 128 + n];
            int rank = 0;
            for (int j = 0; j < 128; j++) { float o = sc[wi][p * 128 + j]; rank += (o > s || (o == s && j < n)) ? 1 : 0; }
            if (rank < 16) { tv[wi][p * 16 + rank] = s; ti[wi][p * 16 + rank] = n; }
        }
    __syncthreads();
    float cv[4];
#pragma unroll
    for (int j = 0; j < 4; j++) { int c = lane + 64 * j; cv[j] = tv[wi][c >> 4] + tv[wi][16 + (c & 15)]; }
    __syncthreads();
#pragma unroll
    for (int j = 0; j < 4; j++) sc[wi][lane + 64 * j] = cv[j];
    __syncthreads();
#pragma unroll
    for (int j = 0; j < 4; j++) {
        int c = lane + 64 * j;
        float s = cv[j];
        int rank = 0;
        for (int i = 0; i < 256; i++) { float o = sc[wi][i]; rank += (o > s || (o == s && i < c)) ? 1 : 0; }
        if (rank < 16) { topv[wi][rank] = s; topi[wi][rank] = ti[wi][c >> 4] * 128 + ti[wi][16 + (c & 15)]; }
    }
    __syncthreads();
    if (lane < 16) {
        float mx = topv[wi][0];
        float sum = 0.f;
        for (int i = 0; i < 16; i++) sum += expf(topv[wi][i] - mx);
        pg[(size_t)w * 16 + lane] = expf(topv[wi][lane] - mx) / sum;
        pidx[(size_t)w * 16 + lane] = topi[wi][lane];
    }
}

__device__ __forceinline__ void d_peer_apply(const int bx, const int by, const int bz, char* smem, const bf16_t* __restrict__ hbuf, const int* __restrict__ pidx, const float* __restrict__ pg,
                                                    const float* __restrict__ utab, const float* __restrict__ vtab, const float* __restrict__ modl,
                                                    float* __restrict__ xrun) {
    float* coef = (float*)smem; int* eid = (int*)(smem + 512);
    const int t = bx, tid = threadIdx.x, wi = tid >> 6, lane = tid & 63;
    if (tid < 128) eid[tid] = pidx[(size_t)t * 128 + tid];
    float4 xv[4];
#pragma unroll
    for (int j = 0; j < 4; j++) { ushort4 q = *(const ushort4*)(hbuf + (size_t)t * DM + j * 256 + lane * 4); xv[j] = make_float4(bf2f(q.x), bf2f(q.y), bf2f(q.z), bf2f(q.w)); }
    __syncthreads();
    for (int e = wi * 32; e < wi * 32 + 32; e++) {
        const float* ur = utab + (size_t)eid[e] * DM;
        float s = 0.f;
#pragma unroll
        for (int j = 0; j < 4; j++) { float4 u = *(const float4*)(ur + j * 256 + lane * 4); s += u.x * xv[j].x + u.y * xv[j].y + u.z * xv[j].z + u.w * xv[j].w; }
        s = wave_sum(s);
        if (lane == 0) coef[e] = pg[(size_t)t * 128 + e] * gelu_tanh(s);
    }
    __syncthreads();
    float4 acc = make_float4(0.f, 0.f, 0.f, 0.f);
    for (int e = 0; e < 128; e++) {
        float cf = coef[e];
        float4 v = *(const float4*)(vtab + (size_t)eid[e] * DM + tid * 4);
        acc.x += cf * v.x; acc.y += cf * v.y; acc.z += cf * v.z; acc.w += cf * v.w;
    }
    const float* m = modl + (size_t)tok_modrow(t) * 6144 + 5 * 1024 + tid * 4;
    float* xo = xrun + (size_t)t * DM + tid * 4;
    float4 x = *(float4*)xo;
    x.x += m[0] * acc.x; x.y += m[1] * acc.y; x.z += m[2] * acc.z; x.w += m[3] * acc.w;
    *(float4*)xo = x;
}

__device__ __forceinline__ void d_hy_dw(const int bx, const int by, const int bz, char* smem, const float* __restrict__ pre, const float* __restrict__ cw, const float* __restrict__ cb,
                                               float* __restrict__ zin, float* __restrict__ x0) {
    const int t = bx;
    const int pos = tok_pos(t), L = tok_len(t);
    const float* P = pre + (size_t)t * 3072;
    for (int c = threadIdx.x; c < 1024; c += 256) {
        float u[3];
#pragma unroll
        for (int part = 0; part < 3; part++) {
            int cc = part * 1024 + c;
            float cur = P[cc];
            float prev = (pos > 0) ? P[cc - 3072] : 0.f;
            float nxt = (pos < L - 1) ? P[cc + 3072] : 0.f;
            u[part] = prev * cw[cc] + cur * cw[3072 + cc] + nxt * cw[2 * 3072 + cc] + cb[cc];
        }
        x0[(size_t)t * DM + c] = u[0];
        zin[(size_t)t * DM + c] = u[1] * u[2];
    }
}

__device__ __forceinline__ void d_hy_filt(const int bx, const int by, const int bz, char* smem, int L, const float* __restrict__ w1, const float* __restrict__ b1, const float* __restrict__ w2,
                                                 const float* __restrict__ b2, const float* __restrict__ w3, const float* __restrict__ fr,
                                                 float* __restrict__ hf, float* __restrict__ hb) {
    float* z = (float*)smem; float* h1 = z + 64; float* h2 = z + 128;
    const int t = bx, tid = threadIdx.x;
    const float tu = (float)t / (float)(L - 1);
    if (tid == 0) z[0] = tu;
    if (tid >= 1 && tid < 17) {
        int i = tid - 1;
        float band = 1e-4f + (float)i * ((15.f - 1e-4f) / 15.f);
        float ang = 6.283185307179586f * (float)t * band / (float)L;
        z[1 + i] = cosf(ang); z[17 + i] = -sinf(ang);
    }
    __syncthreads();
    if (tid < 64) { float s = b1[tid]; for (int i = 0; i < 33; i++) s += z[i] * w1[i * 64 + tid]; h1[tid] = sinf(fr[tid] * s); }
    __syncthreads();
    if (tid < 64) { float s = b2[tid]; for (int i = 0; i < 64; i++) s += h1[i] * w2[i * 64 + tid]; h2[tid] = sinf(fr[tid] * s); }
    __syncthreads();
    for (int c = tid; c < 2048; c += 256) {
        float s = 0.f;
        for (int i = 0; i < 64; i++) s += h2[i] * w3[i * 2048 + c];
        int ch = c & 1023;
        float d0 = -4.605170185988091f / 0.3f, d1 = -4.605170185988091f / 1.5f;
        float delta = d0 + (d1 - d0) * ((float)ch / 1023.f);
        float win = expf(-tu * fabsf(delta));
        float val = s * win;
        if (c < 1024) hf[(size_t)t * 1024 + ch] = val; else hb[(size_t)t * 1024 + ch] = val;
    }
}
__device__ __forceinline__ void d_hy_norm(const int bx, const int by, const int bz, char* smem, int L, const float* __restrict__ hf, const float* __restrict__ hb, float* __restrict__ inv) {
    const int c = bx * 256 + threadIdx.x;
    float s = 0.f;
    for (int t = 0; t < L; t++) { s += fabsf(hf[(size_t)t * 1024 + c]); if (t > 0) s += fabsf(hb[(size_t)t * 1024 + c]); }
    inv[c] = 1.f / s;
}
__device__ __forceinline__ void d_hy_conv(const int bx, const int by, const int bz, char* smem, int L, int tbase, const float* __restrict__ zin, const float* __restrict__ x0, const float* __restrict__ hf,
                                                 const float* __restrict__ hb, const float* __restrict__ inv, const float* __restrict__ bias,
                                                 bf16_t* __restrict__ zb) {
    const int c = bx * 256 + threadIdx.x;
    const int t0 = by * 8, b = bz;
    const float* Z = zin + (size_t)(tbase + b * L) * DM + c;
    float acc[8];
#pragma unroll
    for (int i = 0; i < 8; i++) acc[i] = 0.f;
    for (int s = 0; s < L; s++) {
        float z = Z[(size_t)s * DM];
#pragma unroll
        for (int i = 0; i < 8; i++) {
            int j = t0 + i - s;
            float g = (j >= 0) ? hf[(size_t)j * 1024 + c] : hb[(size_t)(-j) * 1024 + c];
            acc[i] += z * g;
        }
    }
    float iv = inv[c], bs = bias[c];
#pragma unroll
    for (int i = 0; i < 8; i++) {
        size_t o = (size_t)(tbase + b * L + t0 + i) * DM + c;
        float zz = zin[o];
        zb[o] = f2bf(x0[o] * (acc[i] * iv + zz * bs));
    }
}

struct Params {
    const float *x_prompt, *x_sample, *st_f, *st_b, *cache_ckv, *cache_kpe, *c, *c_ctx, *norm_g, *w_mod, *b_mod, *ab_w_in, *rw_mu, *rw_w0, *rw_w2,
        *rw_a0, *rw_a2, *rw_g2, *rw_k_k, *rw_k_a, *rw_r_k, *rw_lnx_g, *rw_lnx_b, *mla_q_norm, *mla_q_up, *mla_kv_norm, *mla_kv_up, *mla_qn, *mla_kn,
        *ab_w_out, *hy_w_in, *hy_b_in, *hy_conv_w, *hy_conv_b, *hy_f_w1, *hy_f_b1, *hy_f_w2, *hy_f_b2, *hy_f_w3, *hy_f_freq, *hy_bias, *hy_w_out,
        *peer_w_q, *peer_keys, *peer_u, *peer_v;
    float *xrun, *out_sf, *out_sb, *out_ckv, *out_kpe;
    float *mod, *kvraw, *proj, *qraw, *y0, *y1, *qp;
    bf16_t *hb, *catb, *zbb;
    bf16_t *w_in_t, *w_out_t, *hy_w_in_t, *hy_w_out_t, *w_q_t, *q_up_t, *kv_up_t, *w2_t, *a2_t, *g2_t, *ctxb;
    bf16_t *rb, *kb, *vb, *kkb, *lr0, *lr1, *gateb;
    float *dec0, *dec1; bf16_t *twb, *advb, *sgb; float *bonus, *kpe; bf16_t *qcnb, *ckvb;
    bf16_t *Qb, *Kp, *Vp, *Ks, *Vs;
    float *kvraw_ctx; int* pidx; float* pg;
    float *pre, *zin, *x0b, *hfS, *hbS, *hfP, *hbP, *invS, *invP; int* pidx1; float* pg1;
};

#define VLOOP(n) for (int vb = blockIdx.x; vb < (n); vb += gridDim.x)
#define ENDV __syncthreads();

__global__ void __launch_bounds__(256) mega(Params p) {
    __shared__ __attribute__((aligned(16))) char smem[GEMM_LDS_BYTES];
    cg::grid_group grid = cg::this_grid();
    const float* mod0 = p.mod;
    const float* mod1 = p.mod + 5 * 6144;
    float* xrs = p.xrun + (size_t)TP * DM;

    {
        const int j0 = 48;
        const int j1 = j0 + 36 * 16;
        const int j2 = j1 + 16 * 16;
        const int j3 = j2 + 48 * 16;
        const int j4 = j3 + 16 * 16;
        const int j5 = j4 + 32 * 16;
        const int j6 = j5 + 32 * 16;
        const int j7 = j6 + 12 * 4;
        const int j8 = j7 + 16 * 2;
        const int j9 = j8 + 8;
        const int j10 = j9 + 8;
        const int j11 = j10 + 8;
        const int j12 = j11 + 8;
        const int j13 = j12 + 8 * 2;
        const int j14 = j13 + 128;
        VLOOP(j14) {
            if (vb < j0) d_mod(vb % 24, vb / 24, 0, smem, p.c, p.c_ctx, p.w_mod, p.b_mod, p.mod);
            else if (vb < j1) d_transpose_w(vb - j0, smem, p.ab_w_in, 1024, 2240, p.w_in_t);
            else if (vb < j2) d_transpose_w(vb - j1, smem, p.ab_w_out, 1024, 1024, p.w_out_t);
            else if (vb < j3) d_transpose_w(vb - j2, smem, p.hy_w_in, 1024, 3072, p.hy_w_in_t);
            else if (vb < j4) d_transpose_w(vb - j3, smem, p.hy_w_out, 1024, 1024, p.hy_w_out_t);
            else if (vb < j5) d_transpose_w(vb - j4, smem, p.peer_w_q, 1024, 2048, p.w_q_t);
            else if (vb < j6) d_transpose_w(vb - j5, smem, p.peer_w_q + (size_t)1024 * 2048, 1024, 2048, p.w_q_t + (size_t)2048 * 1024);
            else if (vb < j7) d_transpose_w(vb - j6, smem, p.mla_q_up, 256, 768, p.q_up_t);
            else if (vb < j8) d_transpose_w(vb - j7, smem, p.mla_kv_up, 128, 1024, p.kv_up_t);
            else if (vb < j9) d_transpose_w(vb - j8, smem, p.rw_w2, 64, 512, p.w2_t);
            else if (vb < j10) d_transpose_w(vb - j9, smem, p.rw_w2 + 64 * 512, 64, 512, p.w2_t + 512 * 64);
            else if (vb < j11) d_transpose_w(vb - j10, smem, p.rw_a2, 64, 512, p.a2_t);
            else if (vb < j12) d_transpose_w(vb - j11, smem, p.rw_a2 + 64 * 512, 64, 512, p.a2_t + 512 * 64);
            else if (vb < j13) d_transpose_w(vb - j12, smem, p.rw_g2, 128, 512, p.g2_t);
            else { int i = (vb - j13) * 1024 + threadIdx.x * 4;
#pragma unroll
                for (int q = 0; q < 4; q++) p.ctxb[i + q] = f2bf(p.cache_ckv[i + q]); }
            ENDV }
    }
    grid.sync();
    VLOOP(TT) { d_norm_mod(vb, 0, 0, smem, p.x_prompt, p.x_sample, p.norm_g, mod0, 0, 1, p.hb); ENDV }
    grid.sync();
    VLOOP(18 * 96) { d_gemm_bf16(vb % 18, vb / 18, smem, p.hb, 1024, p.w_in_t, 1024, 1024, ABIN, EpiStore{p.proj, nullptr, ABIN, 0}); }
    grid.sync();
    VLOOP(2 * TT) {
        if (vb < TT) d_rw_shift(vb, 0, 0, smem, p.proj, p.rw_mu, p.rb, p.kb, p.vb, p.twb, p.advb, p.sgb);
        else d_mla_pre(vb - TT, 0, 0, smem, p.proj, p.mla_q_norm, p.mla_kv_norm, p.qcnb, p.ckvb, p.kpe, p.out_ckv, p.out_kpe);
        ENDV }
    grid.sync();
    {
        const int n0 = 4 * 96, n1 = 6 * 96, n2 = 8 * 96, n3 = 8 * 8;
        VLOOP(5 * n0 + n1 + n2 + n3) {
            int v = vb;
            if (v < n0) d_gemm_bf16(v % 4, v / 4, smem, p.twb, 64, p.w2_t, 64, 64, 512, EpiDecay{p.dec0, p.rw_w0});
            else if ((v -= n0) < n0) d_gemm_bf16(v % 4, v / 4, smem, p.twb, 64, p.w2_t + 512 * 64, 64, 64, 512, EpiDecay{p.dec1, p.rw_w0 + 512});
            else if ((v -= n0) < n0) d_gemm_bf16(v % 4, v / 4, smem, p.advb, 64, p.a2_t, 64, 64, 512, EpiLr{p.lr0, p.rw_a0});
            else if ((v -= n0) < n0) d_gemm_bf16(v % 4, v / 4, smem, p.advb, 64, p.a2_t + 512 * 64, 64, 64, 512, EpiLr{p.lr1, p.rw_a0 + 512});
            else if ((v -= n0) < n0) d_gemm_bf16(v % 4, v / 4, smem, p.sgb, 128, p.g2_t, 128, 128, 512, EpiStoreBf{p.gateb, 512, 0});
            else if ((v -= n0) < n1) d_gemm_bf16(v % 6, v / 6, smem, p.qcnb, 256, p.q_up_t, 256, 256, 768, EpiStore{p.qraw, nullptr, 768, 0});
            else if ((v -= n1) < n2) d_gemm_bf16(v % 8, v / 8, smem, p.ckvb, 128, p.kv_up_t, 128, 128, 1024, EpiStore{p.kvraw, nullptr, 1024, 0});
            else { v -= n2; d_gemm_bf16(v % 8, v / 8, smem, p.ctxb, 128, p.kv_up_t, 128, 128, 1024, EpiStore{p.kvraw_ctx, nullptr, 1024, 0}); }
        }
    }
    grid.sync();
    VLOOP(2 * TT + TT + 1024) {
        if (vb < 2 * TT) d_rw_kk(vb, 0, 0, smem, p.rb, p.kb, p.lr0, p.lr1, p.rw_k_k, p.rw_k_a, p.rw_r_k, p.kkb, p.bonus);
        else d_mla_post(vb - 2 * TT, 0, 0, smem, p.qraw, p.kvraw, p.kvraw_ctx, p.kpe, p.cache_kpe, p.mla_qn, p.mla_kn, p.Qb, p.Kp, p.Vp, p.Ks, p.Vs);
        ENDV }
    grid.sync();
    VLOOP(80 + 1024 + 2048) {
        if (vb < 16) d_scan(64 + vb, 0, 0, smem, p.rb, p.kb, p.vb, p.kkb, p.lr0, p.lr1, p.dec0, p.dec1, p.rw_k_a, p.st_f, p.st_b, p.y0, p.y1, p.out_sf, p.out_sb);
        else if (vb < 80) d_scan(vb - 16, 0, 0, smem, p.rb, p.kb, p.vb, p.kkb, p.lr0, p.lr1, p.dec0, p.dec1, p.rw_k_a, p.st_f, p.st_b, p.y0, p.y1, p.out_sf, p.out_sb);
        else if (vb < 80 + 2048) { int v = vb - 80; d_attn(v % 128, (v / 128) % 4, v / 512, smem, p.Qb, p.Ks, p.Vs, p.catb, TP, LS, 2304); }
        else { int v = vb - 80 - 2048; d_attn(v % 16, (v / 16) % 4, v / 64, smem, p.Qb, p.Kp, p.Vp, p.catb, 0, LP, LP); }
        ENDV }
    grid.sync();
    VLOOP(2 * TT) { d_rw_post(vb, 0, 0, smem, p.y0, p.y1, p.bonus, p.vb, p.gateb, p.rw_lnx_g, p.rw_lnx_b, p.catb); ENDV }
    grid.sync();
    VLOOP(8 * 96) { d_gemm_bf16(vb % 8, vb / 8, smem, p.catb, 1024, p.w_out_t, 1024, 1024, 1024, EpiResid{p.x_prompt, p.x_sample, p.xrun, mod0, 2, 0}); }
    grid.sync();
    VLOOP(TT) { d_norm_mod(vb, 0, 0, smem, p.xrun, xrs, p.norm_g + 1024, mod0, 3, 4, p.hb); ENDV }
    grid.sync();
    VLOOP(16 * 96) { d_gemm_bf16(vb % 16, vb / 16, smem, p.hb, 1024, p.w_q_t, 1024, 1024, 2048, EpiStore{p.qp, nullptr, 2048, 0}); }
    grid.sync();
    VLOOP(2 * TT) { d_peer_route(vb, 0, 0, smem, p.qp, p.peer_keys, p.pidx, p.pg); ENDV }
    grid.sync();
    VLOOP(TT) { d_peer_apply(vb, 0, 0, smem, p.hb, p.pidx, p.pg, p.peer_u, p.peer_v, mod0, p.xrun); ENDV }
    grid.sync();
    VLOOP(TT + LS + LP) {
        if (vb < TT) d_norm_mod(vb, 0, 0, smem, p.xrun, xrs, p.norm_g + 2048, mod1, 0, 1, p.hb);
        else if (vb < TT + LS) d_hy_filt(vb - TT, 0, 0, smem, LS, p.hy_f_w1, p.hy_f_b1, p.hy_f_w2, p.hy_f_b2, p.hy_f_w3, p.hy_f_freq, p.hfS, p.hbS);
        else d_hy_filt(vb - TT - LS, 0, 0, smem, LP, p.hy_f_w1, p.hy_f_b1, p.hy_f_w2, p.hy_f_b2, p.hy_f_w3, p.hy_f_freq, p.hfP, p.hbP);
        ENDV }
    grid.sync();
    VLOOP(24 * 96 + 8) {
        if (vb < 24 * 96) d_gemm_bf16(vb % 24, vb / 24, smem, p.hb, 1024, p.hy_w_in_t, 1024, 1024, 3072, EpiStore{p.pre, p.hy_b_in, 3072, 0});
        else if (vb < 24 * 96 + 4) { d_hy_norm(vb - 24 * 96, 0, 0, smem, LS, p.hfS, p.hbS, p.invS); ENDV }
        else { d_hy_norm(vb - 24 * 96 - 4, 0, 0, smem, LP, p.hfP, p.hbP, p.invP); ENDV }
    }
    grid.sync();
    VLOOP(TT) { d_hy_dw(vb, 0, 0, smem, p.pre, p.hy_conv_w, p.hy_conv_b, p.zin, p.x0b); ENDV }
    grid.sync();
    VLOOP(4 * 256 * 4 + 4 * 32 * 16) {
        if (vb < 4096) d_hy_conv(vb % 4, (vb / 4) % 256, vb / 1024, smem, LS, TP, p.zin, p.x0b, p.hfS, p.hbS, p.invS, p.hy_bias, p.zbb);
        else { int v = vb - 4096; d_hy_conv(v % 4, (v / 4) % 32, v / 128, smem, LP, 0, p.zin, p.x0b, p.hfP, p.hbP, p.invP, p.hy_bias, p.zbb); }
        ENDV }
    grid.sync();
    VLOOP(8 * 96) { d_gemm_bf16(vb % 8, vb / 8, smem, p.zbb, 1024, p.hy_w_out_t, 1024, 1024, 1024, EpiResid{p.xrun, xrs, p.xrun, mod1, 2, 0}); }
    grid.sync();
    VLOOP(TT) { d_norm_mod(vb, 0, 0, smem, p.xrun, xrs, p.norm_g + 3072, mod1, 3, 4, p.hb); ENDV }
    grid.sync();
    VLOOP(16 * 96) { d_gemm_bf16(vb % 16, vb / 16, smem, p.hb, 1024, p.w_q_t + (size_t)2048 * 1024, 1024, 1024, 2048, EpiStore{p.qp, nullptr, 2048, 0}); }
    grid.sync();
    VLOOP(2 * TT) { d_peer_route(vb, 0, 0, smem, p.qp, p.peer_keys + (size_t)8 * 2 * 128 * 128, p.pidx1, p.pg1); ENDV }
    grid.sync();
    VLOOP(TT) { d_peer_apply(vb, 0, 0, smem, p.hb, p.pidx1, p.pg1, p.peer_u + (size_t)16384 * 1024, p.peer_v + (size_t)16384 * 1024, mod1, p.xrun); ENDV }
}

static inline size_t align_up(size_t x) { return (x + 255) & ~(size_t)255; }

extern "C" void kernel_launch(void* const* d_in, const int* in_sizes, int n_in, void* d_out, int out_size, void* d_ws, size_t ws_size,
                              hipStream_t stream) {
    Params p{};
    const float** pin = (const float**)&p;
    for (int i = 0; i < 46; i++) pin[i] = (const float*)d_in[i];

    float* out = (float*)d_out;
    p.xrun = out;
    p.out_sf = out + (size_t)TT * DM;
    p.out_sb = p.out_sf + 16 * 8 * 64 * 64;
    p.out_ckv = p.out_sb + 16 * 8 * 64 * 64;
    p.out_kpe = p.out_ckv + 16 * 256 * 128;

    char* ws = (char*)d_ws;
    size_t off = 0;
    auto take = [&](size_t bytes) { char* q = ws + off; off = align_up(off + bytes); return q; };
    p.mod = (float*)take((size_t)2 * 5 * 6144 * 4);
    p.w_in_t = (bf16_t*)take((size_t)2304 * 1024 * 2);
    p.w_out_t = (bf16_t*)take((size_t)1024 * 1024 * 2);
    p.hy_w_in_t = (bf16_t*)take((size_t)3072 * 1024 * 2);
    p.hy_w_out_t = (bf16_t*)take((size_t)1024 * 1024 * 2);
    p.w_q_t = (bf16_t*)take((size_t)2 * 2048 * 1024 * 2);
    p.q_up_t = (bf16_t*)take((size_t)768 * 256 * 2);
    p.kv_up_t = (bf16_t*)take((size_t)1024 * 128 * 2);
    p.w2_t = (bf16_t*)take((size_t)2 * 512 * 64 * 2);
    p.a2_t = (bf16_t*)take((size_t)2 * 512 * 64 * 2);
    p.g2_t = (bf16_t*)take((size_t)512 * 128 * 2);
    p.ctxb = (bf16_t*)take((size_t)1024 * 128 * 2);
    char* R1 = take((size_t)TT * 1024 * 4);
    char* R2 = take((size_t)TT * ABIN * 4);
    char* R3 = ws + off;
    p.hb = (bf16_t*)R1; p.kvraw = (float*)R1; p.catb = (bf16_t*)R1; p.zbb = (bf16_t*)R1;
    p.proj = (float*)R2; p.qraw = (float*)R2; p.qp = (float*)R2;
    p.y0 = (float*)(R2 + (size_t)TT * 768 * 4);
    p.y1 = p.y0 + (size_t)TT * 512;
    size_t o3 = 0;
    auto take3 = [&](size_t bytes) { char* q = R3 + o3; o3 = align_up(o3 + bytes); return q; };
    p.rb = (bf16_t*)take3((size_t)TT * 512 * 2);
    p.kb = (bf16_t*)take3((size_t)TT * 512 * 2);
    p.vb = (bf16_t*)take3((size_t)TT * 512 * 2);
    p.kkb = (bf16_t*)take3((size_t)TT * 512 * 2);
    p.lr0 = (bf16_t*)take3((size_t)TT * 512 * 2);
    p.lr1 = (bf16_t*)take3((size_t)TT * 512 * 2);
    p.gateb = (bf16_t*)take3((size_t)TT * 512 * 2);
    p.dec0 = (float*)take3((size_t)TT * 512 * 4);
    p.dec1 = (float*)take3((size_t)TT * 512 * 4);
    p.twb = (bf16_t*)take3((size_t)TT * 64 * 2);
    p.advb = (bf16_t*)take3((size_t)TT * 64 * 2);
    p.sgb = (bf16_t*)take3((size_t)TT * 128 * 2);
    p.bonus = (float*)take3((size_t)TT * 8 * 4);
    p.kpe = (float*)take3((size_t)TT * 64 * 4);
    p.qcnb = (bf16_t*)take3((size_t)TT * 256 * 2);
    p.ckvb = (bf16_t*)take3((size_t)TT * 128 * 2);
    p.Qb = (bf16_t*)take3((size_t)TT * 768 * 2);
    p.Kp = (bf16_t*)take3((size_t)16 * 4 * 256 * 192 * 2);
    p.Vp = (bf16_t*)take3((size_t)16 * 4 * 256 * 128 * 2);
    p.Ks = (bf16_t*)take3((size_t)4 * 4 * 2304 * 192 * 2);
    p.Vs = (bf16_t*)take3((size_t)4 * 4 * 2304 * 128 * 2);
    p.kvraw_ctx = (float*)take3((size_t)1024 * 1024 * 4);
    p.pidx = (int*)take3((size_t)TT * 128 * 4);
    p.pg = (float*)take3((size_t)TT * 128 * 4);
    p.pre = (float*)R2;
    char* L1 = R2 + (size_t)TT * 3072 * 4;
    p.zin = (float*)L1;
    p.x0b = p.zin + (size_t)TT * 1024;
    p.hfS = p.x0b + (size_t)TT * 1024;
    p.hbS = p.hfS + (size_t)LS * 1024;
    p.hfP = p.hbS + (size_t)LS * 1024;
    p.hbP = p.hfP + (size_t)LP * 1024;
    p.invS = p.hbP + (size_t)LP * 1024;
    p.invP = p.invS + 1024;
    p.pidx1 = (int*)(p.invP + 1024);
    p.pg1 = (float*)(p.pidx1 + (size_t)TT * 128);

    static int grid_blocks = 0;
    if (!grid_blocks) {
        int dev = 0, cus = 0, per_cu = 0;
        (void)hipGetDevice(&dev);
        (void)hipDeviceGetAttribute(&cus, hipDeviceAttributeMultiprocessorCount, dev);
        (void)hipOccupancyMaxActiveBlocksPerMultiprocessor(&per_cu, mega, 256, 0);
        if (per_cu > 2) per_cu = 2;
        if (per_cu < 1) per_cu = 1;
        grid_blocks = cus * per_cu;
    }
    void* args[] = {&p};
    (void)hipLaunchCooperativeKernel((void*)mega, dim3(grid_blocks), dim3(256), args, 0, stream);
}
```

```cpp
#include <hip/hip_runtime.h>
#include <stdint.h>
#include <hip/hip_cooperative_groups.h>
namespace cg = cooperative_groups;

#define DM 1024
#define TP 4096
#define TS 8192
#define TT 12288
#define LP 256
#define LS 2048
#define NBP 16
#define NBS 4
#define ABIN 2240
#define RWIN 1792

typedef unsigned short bf16_t;
__device__ __forceinline__ bf16_t f2bf(float f) { unsigned u = __float_as_uint(f); u += 0x7fffu + ((u >> 16) & 1u); return (bf16_t)(u >> 16); }
__device__ __forceinline__ float bf2f(bf16_t h) { return __uint_as_float(((unsigned)h) << 16); }
__device__ __forceinline__ float sigmoidf_(float x) { return 1.f / (1.f + expf(-x)); }
__device__ __forceinline__ float gelu_tanh(float x) { return 0.5f * x * (1.f + tanhf(0.7978845608028654f * (x + 0.044715f * x * x * x))); }

__device__ __forceinline__ int tok_pos(int t) { return t < TP ? (t & (LP - 1)) : ((t - TP) & (LS - 1)); }
__device__ __forceinline__ int tok_len(int t) { return t < TP ? LP : LS; }
__device__ __forceinline__ int tok_modrow(int t) { return t < TP ? 0 : 1 + ((t - TP) >> 11); }

__device__ __forceinline__ float wave_sum(float v) {
#pragma unroll
    for (int o = 32; o > 0; o >>= 1) v += __shfl_xor(v, o, 64);
    return v;
}

__device__ __forceinline__ void d_mod(const int bx, const int by, const int bz, char* smem, const float* __restrict__ c, const float* __restrict__ c_ctx, const float* __restrict__ w_mod,
                                             const float* __restrict__ b_mod, float* __restrict__ mod) {
    float (*s)[1024] = (float(*)[1024])smem;
    const int li = by;
    const int n = bx * 256 + threadIdx.x;
    for (int i = threadIdx.x; i < 5 * 1024; i += 256) {
        int r = i >> 10, k = i & 1023;
        float v = (r == 0) ? c_ctx[k] : c[(r - 1) * 1024 + k];
        s[r][k] = v / (1.f + expf(-v));
    }
    __syncthreads();
    float a0 = 0, a1 = 0, a2 = 0, a3 = 0, a4 = 0;
    const float* w = w_mod + (size_t)li * 1024 * 6144 + n;
    for (int k = 0; k < 1024; k++) {
        float wv = w[(size_t)k * 6144];
        a0 += s[0][k] * wv; a1 += s[1][k] * wv; a2 += s[2][k] * wv; a3 += s[3][k] * wv; a4 += s[4][k] * wv;
    }
    float bb = b_mod[li * 6144 + n];
    float* o = mod + (size_t)li * 5 * 6144 + n;
    o[0 * 6144] = a0 + bb; o[1 * 6144] = a1 + bb; o[2 * 6144] = a2 + bb; o[3 * 6144] = a3 + bb; o[4 * 6144] = a4 + bb;
}

__device__ __forceinline__ void d_norm_mod(const int bx, const int by, const int bz, char* smem, const float* __restrict__ xa, const float* __restrict__ xb, const float* __restrict__ g,
                                                  const float* __restrict__ modl, int shift_idx, int scale_idx, bf16_t* __restrict__ h) {
    float* red = (float*)smem;
    const int t = bx;
    const float* x = (t < TP) ? (xa + (size_t)t * DM) : (xb + (size_t)(t - TP) * DM);
    const int c = threadIdx.x * 4;
    float4 v = *(const float4*)(x + c);
    float ss = v.x * v.x + v.y * v.y + v.z * v.z + v.w * v.w;
    ss = wave_sum(ss);
    if ((threadIdx.x & 63) == 0) red[threadIdx.x >> 6] = ss;
    __syncthreads();
    float tot = red[0] + red[1] + red[2] + red[3];
    float rstd = rsqrtf(tot * (1.f / DM) + 1e-6f);
    const float* m = modl + (size_t)tok_modrow(t) * 6144;
    float4 gg = *(const float4*)(g + c);
    float4 sh = *(const float4*)(m + shift_idx * 1024 + c);
    float4 sc = *(const float4*)(m + scale_idx * 1024 + c);
    float4 o;
    o.x = v.x * rstd * gg.x * (1.f + sc.x) + sh.x;
    o.y = v.y * rstd * gg.y * (1.f + sc.y) + sh.y;
    o.z = v.z * rstd * gg.z * (1.f + sc.z) + sh.z;
    o.w = v.w * rstd * gg.w * (1.f + sc.w) + sh.w;
    ushort4 ob; ob.x = f2bf(o.x); ob.y = f2bf(o.y); ob.z = f2bf(o.z); ob.w = f2bf(o.w);
    *(ushort4*)(h + (size_t)t * DM + c) = ob;
}

struct EpiStore { float* C; const float* bias; int ldc; int pad;
    __device__ void operator()(int m, int n, float a) const { C[(size_t)m * ldc + n] = a + (bias ? bias[n] : 0.f); } };
struct EpiStoreBf { bf16_t* C; int ldc; int pad;
    __device__ void operator()(int m, int n, float a) const { C[(size_t)m * ldc + n] = f2bf(a); } };
struct EpiDecay { float* out; const float* w0;
    __device__ void operator()(int m, int n, float a) const { out[(size_t)m * 512 + n] = expf(-0.6065306597126334f * sigmoidf_(w0[n] + a)); } };
struct EpiLr { bf16_t* out; const float* a0;
    __device__ void operator()(int m, int n, float a) const { out[(size_t)m * 512 + n] = f2bf(sigmoidf_(a0[n] + a)); } };
struct EpiResid { const float* xa; const float* xb; float* out; const float* modl; int gate_idx; int pad;
    __device__ void operator()(int m, int n, float a) const {
        float x = (m < TP) ? xa[(size_t)m * DM + n] : xb[(size_t)(m - TP) * DM + n];
        float gt = modl[(size_t)tok_modrow(m) * 6144 + gate_idx * 1024 + n];
        out[(size_t)m * DM + n] = x + gt * a; } };

template <class Epi>
__device__ __forceinline__ void d_gemm(const int bx, const int by, const int bz, char* smem, const float* __restrict__ A, int lda, const float* __restrict__ B, int ldb, int K, Epi epi) {
    float (*As)[68] = (float(*)[68])smem;
    float (*Bs)[68] = (float(*)[68])(smem + 16 * 68 * 4);
    const int m0 = by * 64, n0 = bx * 64;
    const int tid = threadIdx.x, tx = tid & 15, ty = tid >> 4;
    float acc[4][4];
#pragma unroll
    for (int i = 0; i < 4; i++)
#pragma unroll
        for (int j = 0; j < 4; j++) acc[i][j] = 0.f;
    for (int k0 = 0; k0 < K; k0 += 16) {
        {
            int r = tid >> 2, kq = (tid & 3) * 4;
            float4 v = *(const float4*)(A + (size_t)(m0 + r) * lda + k0 + kq);
            As[kq + 0][r] = v.x; As[kq + 1][r] = v.y; As[kq + 2][r] = v.z; As[kq + 3][r] = v.w;
        }
        {
            int kk = tid >> 4, nq = (tid & 15) * 4;
            float4 v = *(const float4*)(B + (size_t)(k0 + kk) * ldb + n0 + nq);
            *(float4*)&Bs[kk][nq] = v;
        }
        __syncthreads();
#pragma unroll
        for (int k = 0; k < 16; k++) {
            float a[4], b[4];
#pragma unroll
            for (int i = 0; i < 4; i++) a[i] = As[k][ty * 4 + i];
            float4 bv = *(const float4*)&Bs[k][tx * 4];
            b[0] = bv.x; b[1] = bv.y; b[2] = bv.z; b[3] = bv.w;
#pragma unroll
            for (int i = 0; i < 4; i++)
#pragma unroll
                for (int j = 0; j < 4; j++) acc[i][j] += a[i] * b[j];
        }
        __syncthreads();
    }
#pragma unroll
    for (int i = 0; i < 4; i++)
#pragma unroll
        for (int j = 0; j < 4; j++) epi(m0 + ty * 4 + i, n0 + tx * 4 + j, acc[i][j]);
}


typedef __attribute__((ext_vector_type(8))) short bf16x8;
typedef __attribute__((ext_vector_type(16))) float f32x16;
typedef __attribute__((ext_vector_type(4))) float f32x4;
typedef __attribute__((ext_vector_type(4))) unsigned u32x4;
#define GEMM_LDS_BYTES 73728

template <class Epi>
__device__ __forceinline__ void d_gemm_bf16(const int bx, const int by, char* smem, const bf16_t* __restrict__ A, int lda,
                                            const bf16_t* __restrict__ Bt, int ldb, int K, int N, Epi epi) {
    const int tid = threadIdx.x, lane = tid & 63, wid = tid >> 6;
    const int wm = wid >> 1, wn = wid & 1;
    const int m0 = by * 128, n0 = bx * 128;
    f32x16 acc[2][2];
#pragma unroll
    for (int i = 0; i < 2; i++)
#pragma unroll
        for (int j = 0; j < 2; j++)
#pragma unroll
            for (int r = 0; r < 16; r++) acc[i][j][r] = 0.f;
    const int lrow = tid >> 3, lcol = (tid & 7) * 8;
    const bf16_t* ga = A + (size_t)(m0 + lrow) * lda + lcol;
    const bf16_t* gb = Bt + (size_t)(n0 + lrow) * ldb + lcol;
    u32x4 ra[4], rb[4];
    const int KT = K >> 6;
#pragma unroll
    for (int i = 0; i < 4; i++) { ra[i] = *(const u32x4*)(ga + (size_t)(32 * i) * lda); rb[i] = *(const u32x4*)(gb + (size_t)(32 * i) * ldb); }
    {
        char* sa = smem;
#pragma unroll
        for (int i = 0; i < 4; i++) { *(u32x4*)(sa + (lrow + 32 * i) * 144 + lcol * 2) = ra[i]; *(u32x4*)(sa + 18432 + (lrow + 32 * i) * 144 + lcol * 2) = rb[i]; }
    }
    __syncthreads();
    const int frow = lane & 31, fk = (lane >> 5) * 16;
    for (int kt = 0; kt < KT; kt++) {
        if (kt + 1 < KT) {
#pragma unroll
            for (int i = 0; i < 4; i++) { ra[i] = *(const u32x4*)(ga + (size_t)(32 * i) * lda + (kt + 1) * 64); rb[i] = *(const u32x4*)(gb + (size_t)(32 * i) * ldb + (kt + 1) * 64); }
        }
        const char* sa = smem + (kt & 1) * 36864;
        const char* sb = sa + 18432;
#pragma unroll
        for (int ks = 0; ks < 4; ks++) {
            bf16x8 af[2], bfr[2];
#pragma unroll
            for (int i = 0; i < 2; i++) af[i] = *(const bf16x8*)(sa + (wm * 64 + i * 32 + frow) * 144 + ks * 32 + fk);
#pragma unroll
            for (int j = 0; j < 2; j++) bfr[j] = *(const bf16x8*)(sb + (wn * 64 + j * 32 + frow) * 144 + ks * 32 + fk);
#pragma unroll
            for (int i = 0; i < 2; i++)
#pragma unroll
                for (int j = 0; j < 2; j++) acc[i][j] = __builtin_amdgcn_mfma_f32_32x32x16_bf16(af[i], bfr[j], acc[i][j], 0, 0, 0);
        }
        if (kt + 1 < KT) {
            char* sn = smem + ((kt + 1) & 1) * 36864;
#pragma unroll
            for (int i = 0; i < 4; i++) { *(u32x4*)(sn + (lrow + 32 * i) * 144 + lcol * 2) = ra[i]; *(u32x4*)(sn + 18432 + (lrow + 32 * i) * 144 + lcol * 2) = rb[i]; }
        }
        __syncthreads();
    }
#pragma unroll
    for (int i = 0; i < 2; i++)
#pragma unroll
        for (int j = 0; j < 2; j++) {
            const int col = n0 + wn * 64 + j * 32 + (lane & 31);
            if (col < N) {
#pragma unroll
                for (int r = 0; r < 16; r++) {
                    const int row = m0 + wm * 64 + i * 32 + (r & 3) + 8 * (r >> 2) + 4 * (lane >> 5);
                    epi(row, col, acc[i][j][r]);
                }
            }
        }
}

__device__ __forceinline__ void d_transpose_w(const int vb, char* smem, const float* __restrict__ W, int K, int N, bf16_t* __restrict__ Wt) {
    float (*tile)[65] = (float(*)[65])smem;
    const int kt = K >> 6;
    const int nb = vb / kt, kb = vb % kt;
    const int tid = threadIdx.x;
    {
        const int n = nb * 64 + (tid & 63);
#pragma unroll
        for (int i = 0; i < 16; i++) {
            int k = (tid >> 6) + 4 * i;
            tile[k][tid & 63] = (n < N) ? W[(size_t)(kb * 64 + k) * N + n] : 0.f;
        }
    }
    __syncthreads();
    {
        const int k = tid & 63;
#pragma unroll
        for (int i = 0; i < 16; i++) {
            int n = (tid >> 6) + 4 * i;
            Wt[(size_t)(nb * 64 + n) * K + kb * 64 + k] = f2bf(tile[k][n]);
        }
    }
}

__device__ __forceinline__ void d_rw_shift(const int bx, const int by, const int bz, char* smem, const float* __restrict__ proj, const float* __restrict__ mu, bf16_t* __restrict__ rb,
                                                  bf16_t* __restrict__ kb, bf16_t* __restrict__ vb, bf16_t* __restrict__ tw, bf16_t* __restrict__ adv,
                                                  bf16_t* __restrict__ sg) {
    const int t = bx;
    const int pos = tok_pos(t), L = tok_len(t);
    const float* P = proj + (size_t)t * ABIN;
    for (int c = threadIdx.x; c < RWIN; c += 256) {
        float cur = P[c];
        float prev = (pos > 0) ? P[c - ABIN] : 0.f;
        float nxt = (pos < L - 1) ? P[c + ABIN] : 0.f;
        float val = cur + mu[c] * (0.5f * (prev + nxt) - cur);
        if (c < 512) rb[(size_t)t * 512 + c] = f2bf(val);
        else if (c < 1024) kb[(size_t)t * 512 + c - 512] = f2bf(val);
        else if (c < 1536) vb[(size_t)t * 512 + c - 1024] = f2bf(val);
        else if (c < 1600) tw[(size_t)t * 64 + c - 1536] = f2bf(tanhf(val));
        else if (c < 1664) adv[(size_t)t * 64 + c - 1600] = f2bf(val);
        else sg[(size_t)t * 128 + c - 1664] = f2bf(sigmoidf_(val));
    }
}

__device__ __forceinline__ void d_rw_kk(const int bx, const int by, const int bz, char* smem, const bf16_t* __restrict__ rb, const bf16_t* __restrict__ kb, const bf16_t* __restrict__ lr0,
                                               const bf16_t* __restrict__ lr1, const float* __restrict__ k_k, const float* __restrict__ k_a,
                                               const float* __restrict__ r_k, bf16_t* __restrict__ kkb, float* __restrict__ bonus) {
    const int w = bx * 4 + (threadIdx.x >> 6);
    const int lane = threadIdx.x & 63;
    const int t = w >> 3, h = w & 7;
    const size_t o = (size_t)t * 512 + h * 64 + lane;
    const int ch = h * 64 + lane;
    float k = bf2f(kb[o]), r = bf2f(rb[o]);
    float kk = k * k_k[ch];
    float nrm = sqrtf(wave_sum(kk * kk));
    kk = kk / fmaxf(nrm, 1e-12f);
    kkb[o] = f2bf(kk);
    float l0 = bf2f(lr0[o]), l1 = bf2f(lr1[o]);
    float ka = k_a[ch];
    float kd0 = k * (1.f + (l0 - 1.f) * ka), kd1 = k * (1.f + (l1 - 1.f) * ka);
    float s = wave_sum(r * (kd0 + kd1) * r_k[ch]);
    if (lane == 0) bonus[w] = s;
}

__device__ __forceinline__ void d_scan(const int bx, const int by, const int bz, char* smem, const bf16_t* __restrict__ rb, const bf16_t* __restrict__ kb, const bf16_t* __restrict__ vb,
                                             const bf16_t* __restrict__ kkb, const bf16_t* __restrict__ lr0, const bf16_t* __restrict__ lr1,
                                             const float* __restrict__ dec0, const float* __restrict__ dec1, const float* __restrict__ k_a,
                                             const float* __restrict__ st_f, const float* __restrict__ st_b, float* __restrict__ y0,
                                             float* __restrict__ y1, float* __restrict__ out_sf, float* __restrict__ out_sb) {
    float* sbase = (float*)smem + (threadIdx.x >> 6) * 320;
    float* sa_ = sbase; float* sw_ = sbase + 64; float* sb_ = sbase + 128; float* skd_ = sbase + 192; float* sr_ = sbase + 256;
    int id = bx * 4 + (threadIdx.x >> 6);
    int d, h, b, L, tbase;
    bool prompt = id < 256;
    if (prompt) { d = id & 1; h = (id >> 1) & 7; b = id >> 4; L = LP; tbase = b * LP; }
    else { int j = id - 256; d = j & 1; h = (j >> 1) & 7; b = j >> 4; L = LS; tbase = TP + b * LS; }
    const int v = threadIdx.x & 63;
    const bf16_t* lr = d ? lr1 : lr0;
    const float* dec = d ? dec1 : dec0;
    float* yo = d ? y1 : y0;
    const float ka = k_a[h * 64 + v];
    float S[64];
    if (prompt) {
#pragma unroll
        for (int k = 0; k < 64; k++) S[k] = 0.f;
    } else {
        const float* st = (d ? st_b : st_f) + ((size_t)(b * 8 + h) * 64 + v) * 64;
#pragma unroll
        for (int k = 0; k < 64; k += 4) { float4 q = *(const float4*)(st + k); S[k] = q.x; S[k + 1] = q.y; S[k + 2] = q.z; S[k + 3] = q.w; }
    }
    for (int i = 0; i < L; i++) {
        const int t = tbase + (d ? (L - 1 - i) : i);
        const size_t o = (size_t)t * 512 + h * 64 + v;
        float kkv = bf2f(kkb[o]), lrv = bf2f(lr[o]), kv = bf2f(kb[o]), rv = bf2f(rb[o]), vv = bf2f(vb[o]), wv = dec[o];
        __builtin_amdgcn_wave_barrier();
        sa_[v] = -kkv; sb_[v] = kkv * lrv; skd_[v] = kv * (1.f + (lrv - 1.f) * ka); sw_[v] = wv; sr_[v] = rv;
        __builtin_amdgcn_wave_barrier();
        float sa = 0.f;
#pragma unroll
        for (int k = 0; k < 64; k += 4) { float4 a = *(const float4*)&sa_[k]; sa += S[k] * a.x + S[k + 1] * a.y + S[k + 2] * a.z + S[k + 3] * a.w; }
        float y = 0.f;
#pragma unroll
        for (int k = 0; k < 64; k += 4) {
            float4 w4 = *(const float4*)&sw_[k]; float4 b4 = *(const float4*)&sb_[k]; float4 k4 = *(const float4*)&skd_[k]; float4 r4 = *(const float4*)&sr_[k];
            S[k] = S[k] * w4.x + sa * b4.x + vv * k4.x; y += S[k] * r4.x;
            S[k + 1] = S[k + 1] * w4.y + sa * b4.y + vv * k4.y; y += S[k + 1] * r4.y;
            S[k + 2] = S[k + 2] * w4.z + sa * b4.z + vv * k4.z; y += S[k + 2] * r4.z;
            S[k + 3] = S[k + 3] * w4.w + sa * b4.w + vv * k4.w; y += S[k + 3] * r4.w;
        }
        yo[o] = y;
    }
    if (prompt) {
        float* os = (d ? out_sb : out_sf) + ((size_t)(b * 8 + h) * 64 + v) * 64;
#pragma unroll
        for (int k = 0; k < 64; k += 4) *(float4*)(os + k) = make_float4(S[k], S[k + 1], S[k + 2], S[k + 3]);
    }
}

__device__ __forceinline__ void d_rw_post(const int bx, const int by, const int bz, char* smem, const float* __restrict__ y0, const float* __restrict__ y1, const float* __restrict__ bonus,
                                                 const bf16_t* __restrict__ vb, const bf16_t* __restrict__ gate, const float* __restrict__ lnx_g,
                                                 const float* __restrict__ lnx_b, bf16_t* __restrict__ cat) {
    const int w = bx * 4 + (threadIdx.x >> 6);
    const int lane = threadIdx.x & 63;
    const int t = w >> 3, h = w & 7;
    const size_t o = (size_t)t * 512 + h * 64 + lane;
    const int ch = h * 64 + lane;
    float y = y0[o] + y1[o];
    float mean = wave_sum(y) * (1.f / 64.f);
    float dlt = y - mean;
    float var = wave_sum(dlt * dlt) * (1.f / 64.f);
    float yn = dlt * rsqrtf(var + 64e-5f) * lnx_g[ch] + lnx_b[ch];
    float val = (yn + bonus[w] * bf2f(vb[o])) * bf2f(gate[o]);
    cat[(size_t)t * DM + ch] = f2bf(val);
}

__device__ __forceinline__ void d_mla_pre(const int bx, const int by, const int bz, char* smem, const float* __restrict__ proj, const float* __restrict__ q_norm, const float* __restrict__ kv_norm,
                                                 bf16_t* __restrict__ qcn, bf16_t* __restrict__ ckv, float* __restrict__ kpe,
                                                 float* __restrict__ out_ckv, float* __restrict__ out_kpe) {
    float* red = (float*)smem; float* red2 = red + 4;
    const int t = bx;
    const int tid = threadIdx.x;
    const float* P = proj + (size_t)t * ABIN + RWIN;
    float q = P[tid];
    float kv = (tid < 128) ? P[256 + tid] : 0.f;
    float ss = wave_sum(q * q);
    float s2 = wave_sum(kv * kv);
    if ((tid & 63) == 0) { red[tid >> 6] = ss; red2[tid >> 6] = s2; }
    __syncthreads();
    float rq = rsqrtf((red[0] + red[1] + red[2] + red[3]) * (1.f / 256.f) + 1e-6f);
    float rk = rsqrtf((red2[0] + red2[1] + red2[2] + red2[3]) * (1.f / 128.f) + 1e-6f);
    qcn[(size_t)t * 256 + tid] = f2bf(q * rq * q_norm[tid]);
    if (tid < 128) {
        float val = kv * rk * kv_norm[tid];
        ckv[(size_t)t * 128 + tid] = f2bf(val);
        if (t < TP) out_ckv[(size_t)t * 128 + tid] = val;
    } else if (tid < 192) {
        float pe = P[384 + tid - 128];
        kpe[(size_t)t * 64 + tid - 128] = pe;
        if (t < TP) out_kpe[(size_t)t * 64 + tid - 128] = pe;
    }
}

__device__ __forceinline__ void d_mla_post(const int bx, const int by, const int bz, char* smem, const float* __restrict__ qraw, const float* __restrict__ kvraw, const float* __restrict__ kvraw_ctx,
                                                  const float* __restrict__ kpe, const float* __restrict__ cache_kpe, const float* __restrict__ qn,
                                                  const float* __restrict__ kn, bf16_t* __restrict__ Qb, bf16_t* __restrict__ Kp, bf16_t* __restrict__ Vp,
                                                  bf16_t* __restrict__ Ks, bf16_t* __restrict__ Vs) {
    float (*sq)[192] = (float(*)[192])smem; float (*sk)[192] = (float(*)[192])(smem + 4 * 192 * 4);
    const int wi = threadIdx.x >> 6, lane = threadIdx.x & 63;
    const int row = bx, h = wi;
    const bool isctx = row >= TT;
    const bool sample = row >= TP;
    float kx[3], qx[3] = {0.f, 0.f, 0.f};
    const float* kvr; const float* pe; int pos = 0;
    if (isctx) { int cr = row - TT; kvr = kvraw_ctx + (size_t)cr * 1024; pe = cache_kpe + (size_t)cr * 64; }
    else { kvr = kvraw + (size_t)row * 1024; pe = kpe + (size_t)row * 64; pos = tok_pos(row); }
#pragma unroll
    for (int j = 0; j < 3; j++) {
        int i = lane + 64 * j;
        kx[j] = (i < 128) ? kvr[h * 256 + i] : pe[i - 128];
        if (!isctx) qx[j] = qraw[(size_t)row * 768 + h * 192 + i];
    }
    float ssk = wave_sum(kx[0] * kx[0] + kx[1] * kx[1] + kx[2] * kx[2]);
    float ssq = wave_sum(qx[0] * qx[0] + qx[1] * qx[1] + qx[2] * qx[2]);
    float rk = rsqrtf(ssk * (1.f / 192.f) + 1e-6f), rq = rsqrtf(ssq * (1.f / 192.f) + 1e-6f);
#pragma unroll
    for (int j = 0; j < 3; j++) {
        int i = lane + 64 * j;
        sk[wi][i] = kx[j] * rk * kn[i];
        sq[wi][i] = qx[j] * rq * qn[i];
    }
    __syncthreads();
    if (sample && !isctx && lane < 32) {
        int rowi = pos >> 6, coli = pos & 63;
        int fi = lane & 15;
        float inv = expf(-(float)fi * (1.f / 16.f) * 9.210340371976184f);
        float ang = (lane < 16 ? (float)rowi : (float)coli) * inv;
        float cs = cosf(ang), sn = sinf(ang);
        float a = sk[wi][128 + 2 * lane], bq = sk[wi][128 + 2 * lane + 1];
        sk[wi][128 + 2 * lane] = a * cs - bq * sn; sk[wi][128 + 2 * lane + 1] = a * sn + bq * cs;
        a = sq[wi][128 + 2 * lane]; bq = sq[wi][128 + 2 * lane + 1];
        sq[wi][128 + 2 * lane] = a * cs - bq * sn; sq[wi][128 + 2 * lane + 1] = a * sn + bq * cs;
    }
    __syncthreads();
    bf16_t* kd; bf16_t* vd; int vLk, kidx;
    if (!sample) { int b = row >> 8, p = row & 255; kd = Kp + ((size_t)(b * 4 + h) * LP + p) * 192; vd = Vp + (size_t)(b * 4 + h) * 128 * LP; vLk = LP; kidx = p; }
    else if (!isctx) { int b = (row - TP) >> 11, p = (row - TP) & 2047; kd = Ks + ((size_t)(b * 4 + h) * 2304 + 256 + p) * 192; vd = Vs + (size_t)(b * 4 + h) * 128 * 2304; vLk = 2304; kidx = 256 + p; }
    else { int cr = row - TT; int b = cr >> 8, p = cr & 255; kd = Ks + ((size_t)(b * 4 + h) * 2304 + p) * 192; vd = Vs + (size_t)(b * 4 + h) * 128 * 2304; vLk = 2304; kidx = p; }
    const int kpos = (kidx & ~12) | ((kidx & 8) >> 1) | ((kidx & 4) << 1);
#pragma unroll
    for (int j = 0; j < 3; j++) {
        int i = lane + 64 * j;
        kd[i] = f2bf(sk[wi][i]);
        if (!isctx) Qb[((size_t)row * 4 + h) * 192 + i] = f2bf(sq[wi][i]);
    }
    vd[(size_t)lane * vLk + kpos] = f2bf(kvr[h * 256 + 128 + lane]);
    vd[(size_t)(lane + 64) * vLk + kpos] = f2bf(kvr[h * 256 + 128 + lane + 64]);
}

__device__ __forceinline__ void d_attn(const int bx, const int by, const int bz, char* smem, const bf16_t* __restrict__ Qb, const bf16_t* __restrict__ Kall, const bf16_t* __restrict__ Vall,
                                              bf16_t* __restrict__ cat, int tbase, int Lq, int Lk) {
    float (*Vsm)[128] = (float(*)[128])smem;
    float (*Qs)[192] = (float(*)[192])(smem + 32 * 128 * 4);
    float (*Ksm)[193] = (float(*)[193])(smem + 32 * 128 * 4 + 16 * 192 * 4);
    float (*Ss)[33] = (float(*)[33])(smem + 32 * 128 * 4 + 16 * 192 * 4 + 32 * 193 * 4);
    const int q0 = bx * 16, h = by, b = bz;
    const int tid = threadIdx.x;
    const int qi = tid >> 4, sub = tid & 15;
    const bf16_t* K = Kall + (size_t)(b * 4 + h) * Lk * 192;
    const bf16_t* V = Vall + (size_t)(b * 4 + h) * Lk * 128;
    for (int i = tid; i < 16 * 192; i += 256) {
        int r = i / 192, c = i % 192;
        int t = tbase + b * Lq + q0 + r;
        Qs[r][c] = bf2f(Qb[((size_t)t * 4 + h) * 192 + c]);
    }
    float m = -1e30f, l = 0.f;
    float acc[8];
#pragma unroll
    for (int j = 0; j < 8; j++) acc[j] = 0.f;
    const float scale = 0.07216878364870322f;
    for (int k0 = 0; k0 < Lk; k0 += 32) {
        __syncthreads();
        for (int i = tid; i < 32 * 192; i += 256) { int r = i / 192, c = i % 192; Ksm[r][c] = bf2f(K[(size_t)(k0 + r) * 192 + c]); }
        for (int i = tid; i < 32 * 128; i += 256) { int r = i >> 7, c = i & 127; Vsm[r][c] = bf2f(V[(size_t)(k0 + r) * 128 + c]); }
        __syncthreads();
        float s0 = 0.f, s1 = 0.f;
        for (int dd = 0; dd < 192; dd++) { float qv = Qs[qi][dd]; s0 += qv * Ksm[sub][dd]; s1 += qv * Ksm[sub + 16][dd]; }
        s0 *= scale; s1 *= scale;
        float mx = fmaxf(s0, s1);
#pragma unroll
        for (int o = 8; o > 0; o >>= 1) mx = fmaxf(mx, __shfl_xor(mx, o, 64));
        float mn = fmaxf(m, mx);
        float alpha = expf(m - mn);
        float p0 = expf(s0 - mn), p1 = expf(s1 - mn);
        float ps = p0 + p1;
#pragma unroll
        for (int o = 8; o > 0; o >>= 1) ps += __shfl_xor(ps, o, 64);
        l = l * alpha + ps; m = mn;
        Ss[qi][sub] = p0; Ss[qi][sub + 16] = p1;
        __syncthreads();
#pragma unroll
        for (int j = 0; j < 8; j++) acc[j] *= alpha;
        for (int kk = 0; kk < 32; kk++) {
            float p = Ss[qi][kk];
            float4 v0 = *(const float4*)&Vsm[kk][sub * 8], v1 = *(const float4*)&Vsm[kk][sub * 8 + 4];
            acc[0] += p * v0.x; acc[1] += p * v0.y; acc[2] += p * v0.z; acc[3] += p * v0.w;
            acc[4] += p * v1.x; acc[5] += p * v1.y; acc[6] += p * v1.z; acc[7] += p * v1.w;
        }
    }
    const int t = tbase + b * Lq + q0 + qi;
    float il = 1.f / l;
    bf16_t* o = cat + (size_t)t * DM + 512 + h * 128 + sub * 8;
#pragma unroll
    for (int j = 0; j < 8; j++) o[j] = f2bf(acc[j] * il);
}


#define ATT_SV_OFF 25600
__device__ __forceinline__ void d_attn_mfma(const int item, char* smem, const bf16_t* __restrict__ Qb, const bf16_t* __restrict__ Kall,
                                            const bf16_t* __restrict__ VtAll, bf16_t* __restrict__ cat, int tbase, int Lq, int Lk, int nqb) {
    const int qb = item % nqb, bh = item / nqb;
    const int b = bh >> 2, h = bh & 3;
    const int tid = threadIdx.x, lane = tid & 63, wid = tid >> 6;
    const int q = lane & 31, hh = lane >> 5;
    const int t = tbase + b * Lq + qb * 128 + wid * 32 + q;
    bf16x8 qf[12];
    {
        const bf16_t* qp = Qb + ((size_t)t * 4 + h) * 192 + hh * 8;
#pragma unroll
        for (int ks = 0; ks < 12; ks++) qf[ks] = *(const bf16x8*)(qp + ks * 16);
    }
    f32x16 o[4];
#pragma unroll
    for (int i = 0; i < 4; i++)
#pragma unroll
        for (int r = 0; r < 16; r++) o[i][r] = 0.f;
    float m = -1e30f, l = 0.f;
    const bf16_t* K = Kall + (size_t)bh * Lk * 192;
    const bf16_t* Vt = VtAll + (size_t)bh * 128 * Lk;
    char* sK = smem;
    char* sV = smem + ATT_SV_OFF;
    u32x4 pk[6], pv[4];
    const int nkt = Lk >> 6;
#pragma unroll
    for (int i = 0; i < 6; i++) pk[i] = *(const u32x4*)(K + (size_t)(tid + 256 * i) * 8);
#pragma unroll
    for (int i = 0; i < 4; i++) { int c = tid + 256 * i; pv[i] = *(const u32x4*)(Vt + (size_t)(c >> 3) * Lk + (c & 7) * 8); }
#pragma unroll
    for (int i = 0; i < 6; i++) { int c = tid + 256 * i; *(u32x4*)(sK + (c / 24) * 400 + (c % 24) * 16) = pk[i]; }
#pragma unroll
    for (int i = 0; i < 4; i++) { int c = tid + 256 * i; *(u32x4*)(sV + (c >> 3) * 144 + (c & 7) * 16) = pv[i]; }
    __syncthreads();
    const float sc2 = 0.07216878364870322f * 1.4426950408889634f;
    for (int kt = 0; kt < nkt; kt++) {
        if (kt + 1 < nkt) {
            const bf16_t* Kn = K + (size_t)(kt + 1) * 64 * 192;
            const bf16_t* Vn = Vt + (kt + 1) * 64;
#pragma unroll
            for (int i = 0; i < 6; i++) pk[i] = *(const u32x4*)(Kn + (size_t)(tid + 256 * i) * 8);
#pragma unroll
            for (int i = 0; i < 4; i++) { int c = tid + 256 * i; pv[i] = *(const u32x4*)(Vn + (size_t)(c >> 3) * Lk + (c & 7) * 8); }
        }
        f32x16 st[2];
#pragma unroll
        for (int bk = 0; bk < 2; bk++)
#pragma unroll
            for (int r = 0; r < 16; r++) st[bk][r] = 0.f;
#pragma unroll
        for (int ks = 0; ks < 12; ks++) {
#pragma unroll
            for (int bk = 0; bk < 2; bk++) {
                bf16x8 a = *(const bf16x8*)(sK + (bk * 32 + q) * 400 + ks * 32 + hh * 16);
                st[bk] = __builtin_amdgcn_mfma_f32_32x32x16_bf16(a, qf[ks], st[bk], 0, 0, 0);
            }
        }
        float mx = -1e30f;
#pragma unroll
        for (int bk = 0; bk < 2; bk++)
#pragma unroll
            for (int r = 0; r < 16; r++) { st[bk][r] *= sc2; mx = fmaxf(mx, st[bk][r]); }
        mx = fmaxf(mx, __shfl_xor(mx, 32, 64));
        const float mn = fmaxf(m, mx);
        const float alpha = exp2f(m - mn);
        float ps = 0.f;
#pragma unroll
        for (int bk = 0; bk < 2; bk++)
#pragma unroll
            for (int r = 0; r < 16; r++) { st[bk][r] = exp2f(st[bk][r] - mn); ps += st[bk][r]; }
        ps += __shfl_xor(ps, 32, 64);
        l = l * alpha + ps; m = mn;
#pragma unroll
        for (int i = 0; i < 4; i++)
#pragma unroll
            for (int r = 0; r < 16; r++) o[i][r] *= alpha;
#pragma unroll
        for (int s4 = 0; s4 < 4; s4++) {
            bf16x8 pb;
#pragma unroll
            for (int j = 0; j < 8; j++) pb[j] = (short)f2bf(st[s4 >> 1][8 * (s4 & 1) + j]);
#pragma unroll
            for (int i = 0; i < 4; i++) {
                bf16x8 a = *(const bf16x8*)(sV + (i * 32 + q) * 144 + s4 * 32 + hh * 16);
                o[i] = __builtin_amdgcn_mfma_f32_32x32x16_bf16(a, pb, o[i], 0, 0, 0);
            }
        }
        __syncthreads();
        if (kt + 1 < nkt) {
#pragma unroll
            for (int i = 0; i < 6; i++) { int c = tid + 256 * i; *(u32x4*)(sK + (c / 24) * 400 + (c % 24) * 16) = pk[i]; }
#pragma unroll
            for (int i = 0; i < 4; i++) { int c = tid + 256 * i; *(u32x4*)(sV + (c >> 3) * 144 + (c & 7) * 16) = pv[i]; }
        }
        __syncthreads();
    }
    const float il = 1.f / l;
    bf16_t* op = cat + (size_t)t * DM + 512 + h * 128;
#pragma unroll
    for (int i = 0; i < 4; i++)
#pragma unroll
        for (int g = 0; g < 4; g++) {
            ushort4 w;
            w.x = f2bf(o[i][4 * g + 0] * il); w.y = f2bf(o[i][4 * g + 1] * il); w.z = f2bf(o[i][4 * g + 2] * il); w.w = f2bf(o[i][4 * g + 3] * il);
            *(ushort4*)(op + i * 32 + 8 * g + 4 * hh) = w;
        }
}

__device__ __forceinline__ void d_peer_route(const int bx, const int by, const int bz, char* smem, const float* __restrict__ qp, const float* __restrict__ keys  ,
                                                    int* __restrict__ pidx, float* __restrict__ pg) {
    float (*sq)[256] = (float(*)[256])smem;
    float (*sc)[256] = (float(*)[256])(smem + 4096);
    float (*tv)[32] = (float(*)[32])(smem + 8192);
    int (*ti)[32] = (int(*)[32])(smem + 8192 + 512);
    float (*topv)[16] = (float(*)[16])(smem + 8192 + 1024);
    int (*topi)[16] = (int(*)[16])(smem + 8192 + 1024 + 256);
    const int wi = threadIdx.x >> 6, lane = threadIdx.x & 63;
    const int w = bx * 4 + wi;
    const int t = w >> 3, h = w & 7;
    const float* q = qp + (size_t)t * 2048 + h * 256;
#pragma unroll
    for (int j = 0; j < 4; j++) sq[wi][lane + 64 * j] = q[lane + 64 * j];
    __syncthreads();
#pragma unroll
    for (int p = 0; p < 2; p++)
#pragma unroll
        for (int half = 0; half < 2; half++) {
            int n = lane + 64 * half;
            const float* kr = keys + ((size_t)(h * 2 + p) * 128 + n) * 128;
            float s = 0.f;
            for (int dd = 0; dd < 128; dd += 4) {
                float4 kv = *(const float4*)(kr + dd);
                s += sq[wi][p * 128 + dd] * kv.x + sq[wi][p * 128 + dd + 1] * kv.y + sq[wi][p * 128 + dd + 2] * kv.z + sq[wi][p * 128 + dd + 3] * kv.w;
            }
            sc[wi][p * 128 + n] = s;
        }
    __syncthreads();
#pragma unroll
    for (int p = 0; p < 2; p++)
#pragma unroll
        for (int half = 0; half < 2; half++) {
            int n = lane + 64 * half;
            float s = sc[wi][p * 128 + n];
            int rank = 0;
            for (int j = 0; j < 128; j++) { float o = sc[wi][p * 128 + j]; rank += (o > s || (o == s && j < n)) ? 1 : 0; }
            if (rank < 16) { tv[wi][p * 16 + rank] = s; ti[wi][p * 16 + rank] = n; }
        }
    __syncthreads();
    float cv[4];
#pragma unroll
    for (int j = 0; j < 4; j++) { int c = lane + 64 * j; cv[j] = tv[wi][c >> 4] + tv[wi][16 + (c & 15)]; }
    __syncthreads();
#pragma unroll
    for (int j = 0; j < 4; j++) sc[wi][lane + 64 * j] = cv[j];
    __syncthreads();
#pragma unroll
    for (int j = 0; j < 4; j++) {
        int c = lane + 64 * j;
        float s = cv[j];
        int rank = 0;
        for (int i = 0; i < 256; i++) { float o = sc[wi][i]; rank += (o > s || (o == s && i < c)) ? 1 : 0; }
        if (rank < 16) { topv[wi][rank] = s; topi[wi][rank] = (ti[wi][c >> 4] * 128 + ti[wi][16 + (c & 15)]) & 16383; }
    }
    __syncthreads();
    if (lane < 16) {
        float mx = topv[wi][0];
        float sum = 0.f;
        for (int i = 0; i < 16; i++) sum += expf(topv[wi][i] - mx);
        pg[(size_t)w * 16 + lane] = expf(topv[wi][lane] - mx) / sum;
        pidx[(size_t)w * 16 + lane] = topi[wi][lane] & 16383;
    }
}

__device__ __forceinline__ void d_peer_apply(const int bx, const int by, const int bz, char* smem, const bf16_t* __restrict__ hbuf, const int* __restrict__ pidx, const float* __restrict__ pg,
                                                    const float* __restrict__ utab, const float* __restrict__ vtab, const float* __restrict__ modl,
                                                    float* __restrict__ xrun) {
    float* coef = (float*)smem; int* eid = (int*)(smem + 512);
    const int t = bx, tid = threadIdx.x, wi = tid >> 6, lane = tid & 63;
    if (tid < 128) eid[tid] = pidx[(size_t)t * 128 + tid];
    float4 xv[4];
#pragma unroll
    for (int j = 0; j < 4; j++) { ushort4 q = *(const ushort4*)(hbuf + (size_t)t * DM + j * 256 + lane * 4); xv[j] = make_float4(bf2f(q.x), bf2f(q.y), bf2f(q.z), bf2f(q.w)); }
    __syncthreads();
    for (int e = wi * 32; e < wi * 32 + 32; e++) {
        const float* ur = utab + (size_t)eid[e] * DM;
        float s = 0.f;
#pragma unroll
        for (int j = 0; j < 4; j++) { float4 u = *(const float4*)(ur + j * 256 + lane * 4); s += u.x * xv[j].x + u.y * xv[j].y + u.z * xv[j].z + u.w * xv[j].w; }
        s = wave_sum(s);
        if (lane == 0) coef[e] = pg[(size_t)t * 128 + e] * gelu_tanh(s);
    }
    __syncthreads();
    float4 acc = make_float4(0.f, 0.f, 0.f, 0.f);
    for (int e = 0; e < 128; e++) {
        float cf = coef[e];
        float4 v = *(const float4*)(vtab + (size_t)eid[e] * DM + tid * 4);
        acc.x += cf * v.x; acc.y += cf * v.y; acc.z += cf * v.z; acc.w += cf * v.w;
    }
    const float* m = modl + (size_t)tok_modrow(t) * 6144 + 5 * 1024 + tid * 4;
    float* xo = xrun + (size_t)t * DM + tid * 4;
    float4 x = *(float4*)xo;
    x.x += m[0] * acc.x; x.y += m[1] * acc.y; x.z += m[2] * acc.z; x.w += m[3] * acc.w;
    *(float4*)xo = x;
}

__device__ __forceinline__ void d_hy_dw(const int bx, const int by, const int bz, char* smem, const float* __restrict__ pre, const float* __restrict__ cw, const float* __restrict__ cb,
                                               float* __restrict__ zin, float* __restrict__ x0) {
    const int t = bx;
    const int pos = tok_pos(t), L = tok_len(t);
    const float* P = pre + (size_t)t * 3072;
    for (int c = threadIdx.x; c < 1024; c += 256) {
        float u[3];
#pragma unroll
        for (int part = 0; part < 3; part++) {
            int cc = part * 1024 + c;
            float cur = P[cc];
            float prev = (pos > 0) ? P[cc - 3072] : 0.f;
            float nxt = (pos < L - 1) ? P[cc + 3072] : 0.f;
            u[part] = prev * cw[cc] + cur * cw[3072 + cc] + nxt * cw[2 * 3072 + cc] + cb[cc];
        }
        x0[(size_t)t * DM + c] = u[0];
        zin[(size_t)t * DM + c] = u[1] * u[2];
    }
}

__device__ __forceinline__ void d_hy_filt(const int bx, const int by, const int bz, char* smem, int L, const float* __restrict__ w1, const float* __restrict__ b1, const float* __restrict__ w2,
                                                 const float* __restrict__ b2, const float* __restrict__ w3, const float* __restrict__ fr,
                                                 float* __restrict__ hf, float* __restrict__ hb) {
    float* z = (float*)smem; float* h1 = z + 64; float* h2 = z + 128;
    const int t = bx, tid = threadIdx.x;
    const float tu = (float)t / (float)(L - 1);
    if (tid == 0) z[0] = tu;
    if (tid >= 1 && tid < 17) {
        int i = tid - 1;
        float band = 1e-4f + (float)i * ((15.f - 1e-4f) / 15.f);
        float ang = 6.283185307179586f * (float)t * band / (float)L;
        z[1 + i] = cosf(ang); z[17 + i] = -sinf(ang);
    }
    __syncthreads();
    if (tid < 64) { float s = b1[tid]; for (int i = 0; i < 33; i++) s += z[i] * w1[i * 64 + tid]; h1[tid] = sinf(fr[tid] * s); }
    __syncthreads();
    if (tid < 64) { float s = b2[tid]; for (int i = 0; i < 64; i++) s += h1[i] * w2[i * 64 + tid]; h2[tid] = sinf(fr[tid] * s); }
    __syncthreads();
    for (int c = tid; c < 2048; c += 256) {
        float s = 0.f;
        for (int i = 0; i < 64; i++) s += h2[i] * w3[i * 2048 + c];
        int ch = c & 1023;
        float d0 = -4.605170185988091f / 0.3f, d1 = -4.605170185988091f / 1.5f;
        float delta = d0 + (d1 - d0) * ((float)ch / 1023.f);
        float win = expf(-tu * fabsf(delta));
        float val = s * win;
        if (c < 1024) hf[(size_t)t * 1024 + ch] = val; else hb[(size_t)t * 1024 + ch] = val;
    }
}
__device__ __forceinline__ void d_hy_norm(const int bx, const int by, const int bz, char* smem, int L, const float* __restrict__ hf, const float* __restrict__ hb, float* __restrict__ inv) {
    const int c = bx * 256 + threadIdx.x;
    float s = 0.f;
    for (int t = 0; t < L; t++) { s += fabsf(hf[(size_t)t * 1024 + c]); if (t > 0) s += fabsf(hb[(size_t)t * 1024 + c]); }
    inv[c] = 1.f / s;
}
__device__ __forceinline__ void d_hy_conv(const int bx, const int by, const int bz, char* smem, int L, int tbase, const float* __restrict__ zin, const float* __restrict__ x0, const float* __restrict__ hf,
                                                 const float* __restrict__ hb, const float* __restrict__ inv, const float* __restrict__ bias,
                                                 bf16_t* __restrict__ zb) {
    const int c = bx * 256 + threadIdx.x;
    const int t0 = by * 8, b = bz;
    const float* Z = zin + (size_t)(tbase + b * L) * DM + c;
    float acc[8];
#pragma unroll
    for (int i = 0; i < 8; i++) acc[i] = 0.f;
    for (int s = 0; s < L; s++) {
        float z = Z[(size_t)s * DM];
#pragma unroll
        for (int i = 0; i < 8; i++) {
            int j = t0 + i - s;
            float g = (j >= 0) ? hf[(size_t)j * 1024 + c] : hb[(size_t)(-j) * 1024 + c];
            acc[i] += z * g;
        }
    }
    float iv = inv[c], bs = bias[c];
#pragma unroll
    for (int i = 0; i < 8; i++) {
        size_t o = (size_t)(tbase + b * L + t0 + i) * DM + c;
        float zz = zin[o];
        zb[o] = f2bf(x0[o] * (acc[i] * iv + zz * bs));
    }
}

struct Params {
    const float *x_prompt, *x_sample, *st_f, *st_b, *cache_ckv, *cache_kpe, *c, *c_ctx, *norm_g, *w_mod, *b_mod, *ab_w_in, *rw_mu, *rw_w0, *rw_w2,
        *rw_a0, *rw_a2, *rw_g2, *rw_k_k, *rw_k_a, *rw_r_k, *rw_lnx_g, *rw_lnx_b, *mla_q_norm, *mla_q_up, *mla_kv_norm, *mla_kv_up, *mla_qn, *mla_kn,
        *ab_w_out, *hy_w_in, *hy_b_in, *hy_conv_w, *hy_conv_b, *hy_f_w1, *hy_f_b1, *hy_f_w2, *hy_f_b2, *hy_f_w3, *hy_f_freq, *hy_bias, *hy_w_out,
        *peer_w_q, *peer_keys, *peer_u, *peer_v;
    float *xrun, *out_sf, *out_sb, *out_ckv, *out_kpe;
    float *mod, *kvraw, *proj, *qraw, *y0, *y1, *qp;
    bf16_t *hb, *catb, *zbb;
    bf16_t *w_in_t, *w_out_t, *hy_w_in_t, *hy_w_out_t, *w_q_t, *q_up_t, *kv_up_t, *w2_t, *a2_t, *g2_t, *ctxb;
    bf16_t *rb, *kb, *vb, *kkb, *lr0, *lr1, *gateb;
    float *dec0, *dec1; bf16_t *twb, *advb, *sgb; float *bonus, *kpe; bf16_t *qcnb, *ckvb;
    bf16_t *Qb, *Kp, *Vp, *Ks, *Vs;
    float *kvraw_ctx; int* pidx; float* pg;
    float *pre, *zin, *x0b, *hfS, *hbS, *hfP, *hbP, *invS, *invP; int* pidx1; float* pg1;
};

#define VLOOP(n) for (int vb = blockIdx.x; vb < (n); vb += gridDim.x)
#define ENDV __syncthreads();

__global__ void __launch_bounds__(256) mega(Params p) {
    __shared__ __attribute__((aligned(16))) char smem[GEMM_LDS_BYTES];
    cg::grid_group grid = cg::this_grid();
    const float* mod0 = p.mod;
    const float* mod1 = p.mod + 5 * 6144;
    float* xrs = p.xrun + (size_t)TP * DM;

    {
        const int j0 = 48;
        const int j1 = j0 + 36 * 16;
        const int j2 = j1 + 16 * 16;
        const int j3 = j2 + 48 * 16;
        const int j4 = j3 + 16 * 16;
        const int j5 = j4 + 32 * 16;
        const int j6 = j5 + 32 * 16;
        const int j7 = j6 + 12 * 4;
        const int j8 = j7 + 16 * 2;
        const int j9 = j8 + 8;
        const int j10 = j9 + 8;
        const int j11 = j10 + 8;
        const int j12 = j11 + 8;
        const int j13 = j12 + 8 * 2;
        const int j14 = j13 + 128;
        VLOOP(j14) {
            if (vb < j0) d_mod(vb % 24, vb / 24, 0, smem, p.c, p.c_ctx, p.w_mod, p.b_mod, p.mod);
            else if (vb < j1) d_transpose_w(vb - j0, smem, p.ab_w_in, 1024, 2240, p.w_in_t);
            else if (vb < j2) d_transpose_w(vb - j1, smem, p.ab_w_out, 1024, 1024, p.w_out_t);
            else if (vb < j3) d_transpose_w(vb - j2, smem, p.hy_w_in, 1024, 3072, p.hy_w_in_t);
            else if (vb < j4) d_transpose_w(vb - j3, smem, p.hy_w_out, 1024, 1024, p.hy_w_out_t);
            else if (vb < j5) d_transpose_w(vb - j4, smem, p.peer_w_q, 1024, 2048, p.w_q_t);
            else if (vb < j6) d_transpose_w(vb - j5, smem, p.peer_w_q + (size_t)1024 * 2048, 1024, 2048, p.w_q_t + (size_t)2048 * 1024);
            else if (vb < j7) d_transpose_w(vb - j6, smem, p.mla_q_up, 256, 768, p.q_up_t);
            else if (vb < j8) d_transpose_w(vb - j7, smem, p.mla_kv_up, 128, 1024, p.kv_up_t);
            else if (vb < j9) d_transpose_w(vb - j8, smem, p.rw_w2, 64, 512, p.w2_t);
            else if (vb < j10) d_transpose_w(vb - j9, smem, p.rw_w2 + 64 * 512, 64, 512, p.w2_t + 512 * 64);
            else if (vb < j11) d_transpose_w(vb - j10, smem, p.rw_a2, 64, 512, p.a2_t);
            else if (vb < j12) d_transpose_w(vb - j11, smem, p.rw_a2 + 64 * 512, 64, 512, p.a2_t + 512 * 64);
            else if (vb < j13) d_transpose_w(vb - j12, smem, p.rw_g2, 128, 512, p.g2_t);
            else { int i = (vb - j13) * 1024 + threadIdx.x * 4;
#pragma unroll
                for (int q = 0; q < 4; q++) p.ctxb[i + q] = f2bf(p.cache_ckv[i + q]); }
            ENDV }
    }
    grid.sync();
    VLOOP(TT) { d_norm_mod(vb, 0, 0, smem, p.x_prompt, p.x_sample, p.norm_g, mod0, 0, 1, p.hb); ENDV }
    grid.sync();
    VLOOP(18 * 96) { d_gemm_bf16(vb % 18, vb / 18, smem, p.hb, 1024, p.w_in_t, 1024, 1024, ABIN, EpiStore{p.proj, nullptr, ABIN, 0}); }
    grid.sync();
    VLOOP(2 * TT) {
        if (vb < TT) d_rw_shift(vb, 0, 0, smem, p.proj, p.rw_mu, p.rb, p.kb, p.vb, p.twb, p.advb, p.sgb);
        else d_mla_pre(vb - TT, 0, 0, smem, p.proj, p.mla_q_norm, p.mla_kv_norm, p.qcnb, p.ckvb, p.kpe, p.out_ckv, p.out_kpe);
        ENDV }
    grid.sync();
    {
        const int n0 = 4 * 96, n1 = 6 * 96, n2 = 8 * 96, n3 = 8 * 8;
        VLOOP(5 * n0 + n1 + n2 + n3) {
            int v = vb;
            if (v < n0) d_gemm_bf16(v % 4, v / 4, smem, p.twb, 64, p.w2_t, 64, 64, 512, EpiDecay{p.dec0, p.rw_w0});
            else if ((v -= n0) < n0) d_gemm_bf16(v % 4, v / 4, smem, p.twb, 64, p.w2_t + 512 * 64, 64, 64, 512, EpiDecay{p.dec1, p.rw_w0 + 512});
            else if ((v -= n0) < n0) d_gemm_bf16(v % 4, v / 4, smem, p.advb, 64, p.a2_t, 64, 64, 512, EpiLr{p.lr0, p.rw_a0});
            else if ((v -= n0) < n0) d_gemm_bf16(v % 4, v / 4, smem, p.advb, 64, p.a2_t + 512 * 64, 64, 64, 512, EpiLr{p.lr1, p.rw_a0 + 512});
            else if ((v -= n0) < n0) d_gemm_bf16(v % 4, v / 4, smem, p.sgb, 128, p.g2_t, 128, 128, 512, EpiStoreBf{p.gateb, 512, 0});
            else if ((v -= n0) < n1) d_gemm_bf16(v % 6, v / 6, smem, p.qcnb, 256, p.q_up_t, 256, 256, 768, EpiStore{p.qraw, nullptr, 768, 0});
            else if ((v -= n1) < n2) d_gemm_bf16(v % 8, v / 8, smem, p.ckvb, 128, p.kv_up_t, 128, 128, 1024, EpiStore{p.kvraw, nullptr, 1024, 0});
            else { v -= n2; d_gemm_bf16(v % 8, v / 8, smem, p.ctxb, 128, p.kv_up_t, 128, 128, 1024, EpiStore{p.kvraw_ctx, nullptr, 1024, 0}); }
        }
    }
    grid.sync();
    VLOOP(2 * TT + TT + 1024) {
        if (vb < 2 * TT) d_rw_kk(vb, 0, 0, smem, p.rb, p.kb, p.lr0, p.lr1, p.rw_k_k, p.rw_k_a, p.rw_r_k, p.kkb, p.bonus);
        else d_mla_post(vb - 2 * TT, 0, 0, smem, p.qraw, p.kvraw, p.kvraw_ctx, p.kpe, p.cache_kpe, p.mla_qn, p.mla_kn, p.Qb, p.Kp, p.Vp, p.Ks, p.Vs);
        ENDV }
    grid.sync();
    VLOOP(80) {
        if (vb < 16) d_scan(64 + vb, 0, 0, smem, p.rb, p.kb, p.vb, p.kkb, p.lr0, p.lr1, p.dec0, p.dec1, p.rw_k_a, p.st_f, p.st_b, p.y0, p.y1, p.out_sf, p.out_sb);
        else if (vb < 80) d_scan(vb - 16, 0, 0, smem, p.rb, p.kb, p.vb, p.kkb, p.lr0, p.lr1, p.dec0, p.dec1, p.rw_k_a, p.st_f, p.st_b, p.y0, p.y1, p.out_sf, p.out_sb);
        ENDV }
    grid.sync();
    VLOOP(256 + 128) {
        if (vb < 256) { d_attn_mfma(vb, smem, p.Qb, p.Ks, p.Vs, p.catb, TP, LS, 2304, 16); }
        else { d_attn_mfma(vb - 256, smem, p.Qb, p.Kp, p.Vp, p.catb, 0, LP, LP, 2); }
        ENDV }
    grid.sync();
    VLOOP(2 * TT) { d_rw_post(vb, 0, 0, smem, p.y0, p.y1, p.bonus, p.vb, p.gateb, p.rw_lnx_g, p.rw_lnx_b, p.catb); ENDV }
    grid.sync();
    VLOOP(8 * 96) { d_gemm_bf16(vb % 8, vb / 8, smem, p.catb, 1024, p.w_out_t, 1024, 1024, 1024, EpiResid{p.x_prompt, p.x_sample, p.xrun, mod0, 2, 0}); }
    grid.sync();
    VLOOP(TT) { d_norm_mod(vb, 0, 0, smem, p.xrun, xrs, p.norm_g + 1024, mod0, 3, 4, p.hb); ENDV }
    grid.sync();
    VLOOP(16 * 96) { d_gemm_bf16(vb % 16, vb / 16, smem, p.hb, 1024, p.w_q_t, 1024, 1024, 2048, EpiStore{p.qp, nullptr, 2048, 0}); }
    grid.sync();
    VLOOP(2 * TT) { d_peer_route(vb, 0, 0, smem, p.qp, p.peer_keys, p.pidx, p.pg); ENDV }
    grid.sync();
    VLOOP(TT) { d_peer_apply(vb, 0, 0, smem, p.hb, p.pidx, p.pg, p.peer_u, p.peer_v, mod0, p.xrun); ENDV }
    grid.sync();
    VLOOP(TT + LS + LP) {
        if (vb < TT) d_norm_mod(vb, 0, 0, smem, p.xrun, xrs, p.norm_g + 2048, mod1, 0, 1, p.hb);
        else if (vb < TT + LS) d_hy_filt(vb - TT, 0, 0, smem, LS, p.hy_f_w1, p.hy_f_b1, p.hy_f_w2, p.hy_f_b2, p.hy_f_w3, p.hy_f_freq, p.hfS, p.hbS);
        else d_hy_filt(vb - TT - LS, 0, 0, smem, LP, p.hy_f_w1, p.hy_f_b1, p.hy_f_w2, p.hy_f_b2, p.hy_f_w3, p.hy_f_freq, p.hfP, p.hbP);
        ENDV }
    grid.sync();
    VLOOP(24 * 96 + 8) {
        if (vb < 24 * 96) d_gemm_bf16(vb % 24, vb / 24, smem, p.hb, 1024, p.hy_w_in_t, 1024, 1024, 3072, EpiStore{p.pre, p.hy_b_in, 3072, 0});
        else if (vb < 24 * 96 + 4) { d_hy_norm(vb - 24 * 96, 0, 0, smem, LS, p.hfS, p.hbS, p.invS); ENDV }
        else { d_hy_norm(vb - 24 * 96 - 4, 0, 0, smem, LP, p.hfP, p.hbP, p.invP); ENDV }
    }
    grid.sync();
    VLOOP(TT) { d_hy_dw(vb, 0, 0, smem, p.pre, p.hy_conv_w, p.hy_conv_b, p.zin, p.x0b); ENDV }
    grid.sync();
    VLOOP(4 * 256 * 4 + 4 * 32 * 16) {
        if (vb < 4096) d_hy_conv(vb % 4, (vb / 4) % 256, vb / 1024, smem, LS, TP, p.zin, p.x0b, p.hfS, p.hbS, p.invS, p.hy_bias, p.zbb);
        else { int v = vb - 4096; d_hy_conv(v % 4, (v / 4) % 32, v / 128, smem, LP, 0, p.zin, p.x0b, p.hfP, p.hbP, p.invP, p.hy_bias, p.zbb); }
        ENDV }
    grid.sync();
    VLOOP(8 * 96) { d_gemm_bf16(vb % 8, vb / 8, smem, p.zbb, 1024, p.hy_w_out_t, 1024, 1024, 1024, EpiResid{p.xrun, xrs, p.xrun, mod1, 2, 0}); }
    grid.sync();
    VLOOP(TT) { d_norm_mod(vb, 0, 0, smem, p.xrun, xrs, p.norm_g + 3072, mod1, 3, 4, p.hb); ENDV }
    grid.sync();
    VLOOP(16 * 96) { d_gemm_bf16(vb % 16, vb / 16, smem, p.hb, 1024, p.w_q_t + (size_t)2048 * 1024, 1024, 1024, 2048, EpiStore{p.qp, nullptr, 2048, 0}); }
    grid.sync();
    VLOOP(2 * TT) { d_peer_route(vb, 0, 0, smem, p.qp, p.peer_keys + (size_t)8 * 2 * 128 * 128, p.pidx1, p.pg1); ENDV }
    grid.sync();
    VLOOP(TT) { d_peer_apply(vb, 0, 0, smem, p.hb, p.pidx1, p.pg1, p.peer_u + (size_t)16384 * 1024, p.peer_v + (size_t)16384 * 1024, mod1, p.xrun); ENDV }
}

static inline size_t align_up(size_t x) { return (x + 255) & ~(size_t)255; }

extern "C" void kernel_launch(void* const* d_in, const int* in_sizes, int n_in, void* d_out, int out_size, void* d_ws, size_t ws_size,
                              hipStream_t stream) {
    Params p{};
    const float** pin = (const float**)&p;
    for (int i = 0; i < 46; i++) pin[i] = (const float*)d_in[i];

    float* out = (float*)d_out;
    p.xrun = out;
    p.out_sf = out + (size_t)TT * DM;
    p.out_sb = p.out_sf + 16 * 8 * 64 * 64;
    p.out_ckv = p.out_sb + 16 * 8 * 64 * 64;
    p.out_kpe = p.out_ckv + 16 * 256 * 128;

    char* ws = (char*)d_ws;
    size_t off = 0;
    auto take = [&](size_t bytes) { char* q = ws + off; off = align_up(off + bytes); return q; };
    p.mod = (float*)take((size_t)2 * 5 * 6144 * 4);
    p.w_in_t = (bf16_t*)take((size_t)2304 * 1024 * 2);
    p.w_out_t = (bf16_t*)take((size_t)1024 * 1024 * 2);
    p.hy_w_in_t = (bf16_t*)take((size_t)3072 * 1024 * 2);
    p.hy_w_out_t = (bf16_t*)take((size_t)1024 * 1024 * 2);
    p.w_q_t = (bf16_t*)take((size_t)2 * 2048 * 1024 * 2);
    p.q_up_t = (bf16_t*)take((size_t)768 * 256 * 2);
    p.kv_up_t = (bf16_t*)take((size_t)1024 * 128 * 2);
    p.w2_t = (bf16_t*)take((size_t)2 * 512 * 64 * 2);
    p.a2_t = (bf16_t*)take((size_t)2 * 512 * 64 * 2);
    p.g2_t = (bf16_t*)take((size_t)512 * 128 * 2);
    p.ctxb = (bf16_t*)take((size_t)1024 * 128 * 2);
    char* R1 = take((size_t)TT * 1024 * 4);
    char* R2 = take((size_t)TT * ABIN * 4);
    char* R3 = ws + off;
    p.hb = (bf16_t*)R1; p.kvraw = (float*)R1; p.catb = (bf16_t*)R1; p.zbb = (bf16_t*)R1;
    p.proj = (float*)R2; p.qraw = (float*)R2; p.qp = (float*)R2;
    p.y0 = (float*)(R2 + (size_t)TT * 768 * 4);
    p.y1 = p.y0 + (size_t)TT * 512;
    size_t o3 = 0;
    auto take3 = [&](size_t bytes) { char* q = R3 + o3; o3 = align_up(o3 + bytes); return q; };
    p.rb = (bf16_t*)take3((size_t)TT * 512 * 2);
    p.kb = (bf16_t*)take3((size_t)TT * 512 * 2);
    p.vb = (bf16_t*)take3((size_t)TT * 512 * 2);
    p.kkb = (bf16_t*)take3((size_t)TT * 512 * 2);
    p.lr0 = (bf16_t*)take3((size_t)TT * 512 * 2);
    p.lr1 = (bf16_t*)take3((size_t)TT * 512 * 2);
    p.gateb = (bf16_t*)take3((size_t)TT * 512 * 2);
    p.dec0 = (float*)take3((size_t)TT * 512 * 4);
    p.dec1 = (float*)take3((size_t)TT * 512 * 4);
    p.twb = (bf16_t*)take3((size_t)TT * 64 * 2);
    p.advb = (bf16_t*)take3((size_t)TT * 64 * 2);
    p.sgb = (bf16_t*)take3((size_t)TT * 128 * 2);
    p.bonus = (float*)take3((size_t)TT * 8 * 4);
    p.kpe = (float*)take3((size_t)TT * 64 * 4);
    p.qcnb = (bf16_t*)take3((size_t)TT * 256 * 2);
    p.ckvb = (bf16_t*)take3((size_t)TT * 128 * 2);
    p.Qb = (bf16_t*)take3((size_t)TT * 768 * 2);
    p.Kp = (bf16_t*)take3((size_t)16 * 4 * 256 * 192 * 2);
    p.Vp = (bf16_t*)take3((size_t)16 * 4 * 256 * 128 * 2);
    p.Ks = (bf16_t*)take3((size_t)4 * 4 * 2304 * 192 * 2);
    p.Vs = (bf16_t*)take3((size_t)4 * 4 * 2304 * 128 * 2);
    p.kvraw_ctx = (float*)take3((size_t)1024 * 1024 * 4);
    p.pidx = (int*)take3((size_t)TT * 128 * 4);
    p.pg = (float*)take3((size_t)TT * 128 * 4);
    p.pre = (float*)R2;
    char* L1 = R2 + (size_t)TT * 3072 * 4;
    p.zin = (float*)L1;
    p.x0b = p.zin + (size_t)TT * 1024;
    p.hfS = p.x0b + (size_t)TT * 1024;
    p.hbS = p.hfS + (size_t)LS * 1024;
    p.hfP = p.hbS + (size_t)LS * 1024;
    p.hbP = p.hfP + (size_t)LP * 1024;
    p.invS = p.hbP + (size_t)LP * 1024;
    p.invP = p.invS + 1024;
    p.pidx1 = (int*)(p.invP + 1024);
    p.pg1 = (float*)(p.pidx1 + (size_t)TT * 128);

    static int grid_blocks = 0;
    if (!grid_blocks) {
        int dev = 0, cus = 0, per_cu = 0;
        (void)hipGetDevice(&dev);
        (void)hipDeviceGetAttribute(&cus, hipDeviceAttributeMultiprocessorCount, dev);
        (void)hipOccupancyMaxActiveBlocksPerMultiprocessor(&per_cu, mega, 256, 0);
        if (per_cu > 2) per_cu = 2;
        if (per_cu < 1) per_cu = 1;
        grid_blocks = cus * per_cu;
    }
    void* args[] = {&p};
    (void)hipLaunchCooperativeKernel((void*)mega, dim3(grid_blocks), dim3(256), args, 0, stream);
}
```

```cpp
#include <hip/hip_runtime.h>
#include <stdint.h>
#include <hip/hip_cooperative_groups.h>
namespace cg = cooperative_groups;

#define DM 1024
#define TP 4096
#define TS 8192
#define TT 12288
#define LP 256
#define LS 2048
#define NBP 16
#define NBS 4
#define ABIN 2240
#define RWIN 1792

typedef unsigned short bf16_t;
__device__ __forceinline__ bf16_t f2bf(float f) { unsigned u = __float_as_uint(f); u += 0x7fffu + ((u >> 16) & 1u); return (bf16_t)(u >> 16); }
__device__ __forceinline__ float bf2f(bf16_t h) { return __uint_as_float(((unsigned)h) << 16); }
__device__ __forceinline__ float sigmoidf_(float x) { return 1.f / (1.f + expf(-x)); }
__device__ __forceinline__ float gelu_tanh(float x) { return 0.5f * x * (1.f + tanhf(0.7978845608028654f * (x + 0.044715f * x * x * x))); }

__device__ __forceinline__ int tok_pos(int t) { return t < TP ? (t & (LP - 1)) : ((t - TP) & (LS - 1)); }
__device__ __forceinline__ int tok_len(int t) { return t < TP ? LP : LS; }
__device__ __forceinline__ int tok_modrow(int t) { return t < TP ? 0 : 1 + ((t - TP) >> 11); }

__device__ __forceinline__ float wave_sum(float v) {
#pragma unroll
    for (int o = 32; o > 0; o >>= 1) v += __shfl_xor(v, o, 64);
    return v;
}

__device__ __forceinline__ void d_mod(const int bx, const int by, const int bz, char* smem, const float* __restrict__ c, const float* __restrict__ c_ctx, const float* __restrict__ w_mod,
                                             const float* __restrict__ b_mod, float* __restrict__ mod) {
    float (*s)[1024] = (float(*)[1024])smem;
    const int li = by;
    const int n = bx * 256 + threadIdx.x;
    for (int i = threadIdx.x; i < 5 * 1024; i += 256) {
        int r = i >> 10, k = i & 1023;
        float v = (r == 0) ? c_ctx[k] : c[(r - 1) * 1024 + k];
        s[r][k] = v / (1.f + expf(-v));
    }
    __syncthreads();
    float a0 = 0, a1 = 0, a2 = 0, a3 = 0, a4 = 0;
    const float* w = w_mod + (size_t)li * 1024 * 6144 + n;
    for (int k = 0; k < 1024; k++) {
        float wv = w[(size_t)k * 6144];
        a0 += s[0][k] * wv; a1 += s[1][k] * wv; a2 += s[2][k] * wv; a3 += s[3][k] * wv; a4 += s[4][k] * wv;
    }
    float bb = b_mod[li * 6144 + n];
    float* o = mod + (size_t)li * 5 * 6144 + n;
    o[0 * 6144] = a0 + bb; o[1 * 6144] = a1 + bb; o[2 * 6144] = a2 + bb; o[3 * 6144] = a3 + bb; o[4 * 6144] = a4 + bb;
}

__device__ __forceinline__ void d_norm_mod(const int bx, const int by, const int bz, char* smem, const float* __restrict__ xa, const float* __restrict__ xb, const float* __restrict__ g,
                                                  const float* __restrict__ modl, int shift_idx, int scale_idx, bf16_t* __restrict__ h) {
    float* red = (float*)smem;
    const int t = bx;
    const float* x = (t < TP) ? (xa + (size_t)t * DM) : (xb + (size_t)(t - TP) * DM);
    const int c = threadIdx.x * 4;
    float4 v = *(const float4*)(x + c);
    float ss = v.x * v.x + v.y * v.y + v.z * v.z + v.w * v.w;
    ss = wave_sum(ss);
    if ((threadIdx.x & 63) == 0) red[threadIdx.x >> 6] = ss;
    __syncthreads();
    float tot = red[0] + red[1] + red[2] + red[3];
    float rstd = rsqrtf(tot * (1.f / DM) + 1e-6f);
    const float* m = modl + (size_t)tok_modrow(t) * 6144;
    float4 gg = *(const float4*)(g + c);
    float4 sh = *(const float4*)(m + shift_idx * 1024 + c);
    float4 sc = *(const float4*)(m + scale_idx * 1024 + c);
    float4 o;
    o.x = v.x * rstd * gg.x * (1.f + sc.x) + sh.x;
    o.y = v.y * rstd * gg.y * (1.f + sc.y) + sh.y;
    o.z = v.z * rstd * gg.z * (1.f + sc.z) + sh.z;
    o.w = v.w * rstd * gg.w * (1.f + sc.w) + sh.w;
    ushort4 ob; ob.x = f2bf(o.x); ob.y = f2bf(o.y); ob.z = f2bf(o.z); ob.w = f2bf(o.w);
    *(ushort4*)(h + (size_t)t * DM + c) = ob;
}

struct EpiStore { float* C; const float* bias; int ldc; int pad;
    __device__ void operator()(int m, int n, float a) const { C[(size_t)m * ldc + n] = a + (bias ? bias[n] : 0.f); } };
struct EpiStoreBf { bf16_t* C; int ldc; int pad;
    __device__ void operator()(int m, int n, float a) const { C[(size_t)m * ldc + n] = f2bf(a); } };
struct EpiDecay { _Float16* out; const float* w0;
    __device__ void operator()(int m, int n, float a) const { out[(size_t)m * 512 + n] = (_Float16)sigmoidf_(w0[n] + a); } };
struct EpiProj { bf16_t* rw; float* mla;
    __device__ void operator()(int m, int n, float a) const { if (n < RWIN) rw[(size_t)m * RWIN + n] = f2bf(a); else mla[(size_t)m * 448 + (n - RWIN)] = a; } };
struct EpiLr { bf16_t* out; const float* a0;
    __device__ void operator()(int m, int n, float a) const { out[(size_t)m * 512 + n] = f2bf(sigmoidf_(a0[n] + a)); } };
struct EpiResid { const float* xa; const float* xb; float* out; const float* modl; int gate_idx; int pad;
    __device__ void operator()(int m, int n, float a) const {
        float x = (m < TP) ? xa[(size_t)m * DM + n] : xb[(size_t)(m - TP) * DM + n];
        float gt = modl[(size_t)tok_modrow(m) * 6144 + gate_idx * 1024 + n];
        out[(size_t)m * DM + n] = x + gt * a; } };

template <class Epi>
__device__ __forceinline__ void d_gemm(const int bx, const int by, const int bz, char* smem, const float* __restrict__ A, int lda, const float* __restrict__ B, int ldb, int K, Epi epi) {
    float (*As)[68] = (float(*)[68])smem;
    float (*Bs)[68] = (float(*)[68])(smem + 16 * 68 * 4);
    const int m0 = by * 64, n0 = bx * 64;
    const int tid = threadIdx.x, tx = tid & 15, ty = tid >> 4;
    float acc[4][4];
#pragma unroll
    for (int i = 0; i < 4; i++)
#pragma unroll
        for (int j = 0; j < 4; j++) acc[i][j] = 0.f;
    for (int k0 = 0; k0 < K; k0 += 16) {
        {
            int r = tid >> 2, kq = (tid & 3) * 4;
            float4 v = *(const float4*)(A + (size_t)(m0 + r) * lda + k0 + kq);
            As[kq + 0][r] = v.x; As[kq + 1][r] = v.y; As[kq + 2][r] = v.z; As[kq + 3][r] = v.w;
        }
        {
            int kk = tid >> 4, nq = (tid & 15) * 4;
            float4 v = *(const float4*)(B + (size_t)(k0 + kk) * ldb + n0 + nq);
            *(float4*)&Bs[kk][nq] = v;
        }
        __syncthreads();
#pragma unroll
        for (int k = 0; k < 16; k++) {
            float a[4], b[4];
#pragma unroll
            for (int i = 0; i < 4; i++) a[i] = As[k][ty * 4 + i];
            float4 bv = *(const float4*)&Bs[k][tx * 4];
            b[0] = bv.x; b[1] = bv.y; b[2] = bv.z; b[3] = bv.w;
#pragma unroll
            for (int i = 0; i < 4; i++)
#pragma unroll
                for (int j = 0; j < 4; j++) acc[i][j] += a[i] * b[j];
        }
        __syncthreads();
    }
#pragma unroll
    for (int i = 0; i < 4; i++)
#pragma unroll
        for (int j = 0; j < 4; j++) epi(m0 + ty * 4 + i, n0 + tx * 4 + j, acc[i][j]);
}


typedef __attribute__((ext_vector_type(8))) short bf16x8;
typedef __attribute__((ext_vector_type(16))) float f32x16;
typedef __attribute__((ext_vector_type(4))) float f32x4;
typedef __attribute__((ext_vector_type(4))) unsigned u32x4;
#define GEMM_LDS_BYTES 73728

template <class Epi>
__device__ __forceinline__ void d_gemm_bf16(const int bx, const int by, char* smem, const bf16_t* __restrict__ A, int lda,
                                            const bf16_t* __restrict__ Bt, int ldb, int K, int N, Epi epi) {
    const int tid = threadIdx.x, lane = tid & 63, wid = tid >> 6;
    const int wm = wid >> 1, wn = wid & 1;
    const int m0 = by * 128, n0 = bx * 128;
    f32x16 acc[2][2];
#pragma unroll
    for (int i = 0; i < 2; i++)
#pragma unroll
        for (int j = 0; j < 2; j++)
#pragma unroll
            for (int r = 0; r < 16; r++) acc[i][j][r] = 0.f;
    const int lrow = tid >> 3, lcol = (tid & 7) * 8;
    const bf16_t* ga = A + (size_t)(m0 + lrow) * lda + lcol;
    const bf16_t* gb = Bt + (size_t)(n0 + lrow) * ldb + lcol;
    u32x4 ra[4], rb[4];
    const int KT = K >> 6;
#pragma unroll
    for (int i = 0; i < 4; i++) { ra[i] = *(const u32x4*)(ga + (size_t)(32 * i) * lda); rb[i] = *(const u32x4*)(gb + (size_t)(32 * i) * ldb); }
    {
        char* sa = smem;
#pragma unroll
        for (int i = 0; i < 4; i++) { *(u32x4*)(sa + (lrow + 32 * i) * 144 + lcol * 2) = ra[i]; *(u32x4*)(sa + 18432 + (lrow + 32 * i) * 144 + lcol * 2) = rb[i]; }
    }
    __syncthreads();
    const int frow = lane & 31, fk = (lane >> 5) * 16;
    for (int kt = 0; kt < KT; kt++) {
        if (kt + 1 < KT) {
#pragma unroll
            for (int i = 0; i < 4; i++) { ra[i] = *(const u32x4*)(ga + (size_t)(32 * i) * lda + (kt + 1) * 64); rb[i] = *(const u32x4*)(gb + (size_t)(32 * i) * ldb + (kt + 1) * 64); }
        }
        const char* sa = smem + (kt & 1) * 36864;
        const char* sb = sa + 18432;
#pragma unroll
        for (int ks = 0; ks < 4; ks++) {
            bf16x8 af[2], bfr[2];
#pragma unroll
            for (int i = 0; i < 2; i++) af[i] = *(const bf16x8*)(sa + (wm * 64 + i * 32 + frow) * 144 + ks * 32 + fk);
#pragma unroll
            for (int j = 0; j < 2; j++) bfr[j] = *(const bf16x8*)(sb + (wn * 64 + j * 32 + frow) * 144 + ks * 32 + fk);
#pragma unroll
            for (int i = 0; i < 2; i++)
#pragma unroll
                for (int j = 0; j < 2; j++) acc[i][j] = __builtin_amdgcn_mfma_f32_32x32x16_bf16(af[i], bfr[j], acc[i][j], 0, 0, 0);
        }
        if (kt + 1 < KT) {
            char* sn = smem + ((kt + 1) & 1) * 36864;
#pragma unroll
            for (int i = 0; i < 4; i++) { *(u32x4*)(sn + (lrow + 32 * i) * 144 + lcol * 2) = ra[i]; *(u32x4*)(sn + 18432 + (lrow + 32 * i) * 144 + lcol * 2) = rb[i]; }
        }
        __syncthreads();
    }
#pragma unroll
    for (int i = 0; i < 2; i++)
#pragma unroll
        for (int j = 0; j < 2; j++) {
            const int col = n0 + wn * 64 + j * 32 + (lane & 31);
            if (col < N) {
#pragma unroll
                for (int r = 0; r < 16; r++) {
                    const int row = m0 + wm * 64 + i * 32 + (r & 3) + 8 * (r >> 2) + 4 * (lane >> 5);
                    epi(row, col, acc[i][j][r]);
                }
            }
        }
}

__device__ __forceinline__ void d_transpose_w(const int vb, char* smem, const float* __restrict__ W, int K, int N, bf16_t* __restrict__ Wt) {
    float (*tile)[65] = (float(*)[65])smem;
    const int kt = K >> 6;
    const int nb = vb / kt, kb = vb % kt;
    const int tid = threadIdx.x;
    {
        const int n = nb * 64 + (tid & 63);
#pragma unroll
        for (int i = 0; i < 16; i++) {
            int k = (tid >> 6) + 4 * i;
            tile[k][tid & 63] = (n < N) ? W[(size_t)(kb * 64 + k) * N + n] : 0.f;
        }
    }
    __syncthreads();
    {
        const int k = tid & 63;
#pragma unroll
        for (int i = 0; i < 16; i++) {
            int n = (tid >> 6) + 4 * i;
            Wt[(size_t)(nb * 64 + n) * K + kb * 64 + k] = f2bf(tile[k][n]);
        }
    }
}

__device__ __forceinline__ void d_rw_shift(const int bx, const int by, const int bz, char* smem, const bf16_t* __restrict__ proj, const float* __restrict__ mu, bf16_t* __restrict__ rb,
                                                  bf16_t* __restrict__ kb, bf16_t* __restrict__ vb, bf16_t* __restrict__ tw, bf16_t* __restrict__ adv,
                                                  bf16_t* __restrict__ sg) {
    const int t = bx;
    const int pos = tok_pos(t), L = tok_len(t);
    const bf16_t* P = proj + (size_t)t * RWIN;
    for (int c = threadIdx.x; c < RWIN; c += 256) {
        float cur = bf2f(P[c]);
        float prev = (pos > 0) ? bf2f(P[c - RWIN]) : 0.f;
        float nxt = (pos < L - 1) ? bf2f(P[c + RWIN]) : 0.f;
        float val = cur + mu[c] * (0.5f * (prev + nxt) - cur);
        if (c < 512) rb[(size_t)t * 512 + c] = f2bf(val);
        else if (c < 1024) kb[(size_t)t * 512 + c - 512] = f2bf(val);
        else if (c < 1536) vb[(size_t)t * 512 + c - 1024] = f2bf(val);
        else if (c < 1600) tw[(size_t)t * 64 + c - 1536] = f2bf(tanhf(val));
        else if (c < 1664) adv[(size_t)t * 64 + c - 1600] = f2bf(val);
        else sg[(size_t)t * 128 + c - 1664] = f2bf(sigmoidf_(val));
    }
}

__device__ __forceinline__ void d_rw_kk(const int bx, const int by, const int bz, char* smem, const bf16_t* __restrict__ rb, const bf16_t* __restrict__ kb, const bf16_t* __restrict__ lr0,
                                               const bf16_t* __restrict__ lr1, const float* __restrict__ k_k, const float* __restrict__ k_a,
                                               const float* __restrict__ r_k, bf16_t* __restrict__ kkb, float* __restrict__ bonus) {
    const int w = bx * 4 + (threadIdx.x >> 6);
    const int lane = threadIdx.x & 63;
    const int t = w >> 3, h = w & 7;
    const size_t o = (size_t)t * 512 + h * 64 + lane;
    const int ch = h * 64 + lane;
    float k = bf2f(kb[o]), r = bf2f(rb[o]);
    float kk = k * k_k[ch];
    float nrm = sqrtf(wave_sum(kk * kk));
    kk = kk / fmaxf(nrm, 1e-12f);
    kkb[o] = f2bf(kk);
    float l0 = bf2f(lr0[o]), l1 = bf2f(lr1[o]);
    float ka = k_a[ch];
    float kd0 = k * (1.f + (l0 - 1.f) * ka), kd1 = k * (1.f + (l1 - 1.f) * ka);
    float s = wave_sum(r * (kd0 + kd1) * r_k[ch]);
    if (lane == 0) bonus[w] = s;
}

__device__ __forceinline__ void d_scan(const int bx, const int by, const int bz, char* smem, const bf16_t* __restrict__ rb, const bf16_t* __restrict__ kb, const bf16_t* __restrict__ vb,
                                             const bf16_t* __restrict__ kkb, const bf16_t* __restrict__ lr0, const bf16_t* __restrict__ lr1,
                                             const _Float16* __restrict__ dec0, const _Float16* __restrict__ dec1, const float* __restrict__ k_a,
                                             const float* __restrict__ st_f, const float* __restrict__ st_b, float* __restrict__ y0,
                                             float* __restrict__ y1, float* __restrict__ out_sf, float* __restrict__ out_sb) {
    float* sbase = (float*)smem + (threadIdx.x >> 6) * 320;
    float* sa_ = sbase; float* sw_ = sbase + 64; float* sb_ = sbase + 128; float* skd_ = sbase + 192; float* sr_ = sbase + 256;
    int id = bx * 4 + (threadIdx.x >> 6);
    int d, h, b, L, tbase;
    bool prompt = id < 256;
    if (prompt) { d = id & 1; h = (id >> 1) & 7; b = id >> 4; L = LP; tbase = b * LP; }
    else { int j = id - 256; d = j & 1; h = (j >> 1) & 7; b = j >> 4; L = LS; tbase = TP + b * LS; }
    const int v = threadIdx.x & 63;
    const bf16_t* lr = d ? lr1 : lr0;
    const _Float16* dec = d ? dec1 : dec0;
    float* yo = d ? y1 : y0;
    const float ka = k_a[h * 64 + v];
    float S[64];
    if (prompt) {
#pragma unroll
        for (int k = 0; k < 64; k++) S[k] = 0.f;
    } else {
        const float* st = (d ? st_b : st_f) + ((size_t)(b * 8 + h) * 64 + v) * 64;
#pragma unroll
        for (int k = 0; k < 64; k += 4) { float4 q = *(const float4*)(st + k); S[k] = q.x; S[k + 1] = q.y; S[k + 2] = q.z; S[k + 3] = q.w; }
    }
    for (int i = 0; i < L; i++) {
        const int t = tbase + (d ? (L - 1 - i) : i);
        const size_t o = (size_t)t * 512 + h * 64 + v;
        float kkv = bf2f(kkb[o]), lrv = bf2f(lr[o]), kv = bf2f(kb[o]), rv = bf2f(rb[o]), vv = bf2f(vb[o]), wv = __expf(-0.6065306597126334f * (float)dec[o]);
        __builtin_amdgcn_wave_barrier();
        sa_[v] = -kkv; sb_[v] = kkv * lrv; skd_[v] = kv * (1.f + (lrv - 1.f) * ka); sw_[v] = wv; sr_[v] = rv;
        __builtin_amdgcn_wave_barrier();
        float sa = 0.f;
#pragma unroll
        for (int k = 0; k < 64; k += 4) { float4 a = *(const float4*)&sa_[k]; sa += S[k] * a.x + S[k + 1] * a.y + S[k + 2] * a.z + S[k + 3] * a.w; }
        float y = 0.f;
#pragma unroll
        for (int k = 0; k < 64; k += 4) {
            float4 w4 = *(const float4*)&sw_[k]; float4 b4 = *(const float4*)&sb_[k]; float4 k4 = *(const float4*)&skd_[k]; float4 r4 = *(const float4*)&sr_[k];
            S[k] = S[k] * w4.x + sa * b4.x + vv * k4.x; y += S[k] * r4.x;
            S[k + 1] = S[k + 1] * w4.y + sa * b4.y + vv * k4.y; y += S[k + 1] * r4.y;
            S[k + 2] = S[k + 2] * w4.z + sa * b4.z + vv * k4.z; y += S[k + 2] * r4.z;
            S[k + 3] = S[k + 3] * w4.w + sa * b4.w + vv * k4.w; y += S[k + 3] * r4.w;
        }
        yo[o] = y;
    }
    if (prompt) {
        float* os = (d ? out_sb : out_sf) + ((size_t)(b * 8 + h) * 64 + v) * 64;
#pragma unroll
        for (int k = 0; k < 64; k += 4) *(float4*)(os + k) = make_float4(S[k], S[k + 1], S[k + 2], S[k + 3]);
    }
}

__device__ __forceinline__ void d_rw_post(const int bx, const int by, const int bz, char* smem, const float* __restrict__ y0, const float* __restrict__ y1, const float* __restrict__ bonus,
                                                 const bf16_t* __restrict__ vb, const bf16_t* __restrict__ gate, const float* __restrict__ lnx_g,
                                                 const float* __restrict__ lnx_b, bf16_t* __restrict__ cat) {
    const int w = bx * 4 + (threadIdx.x >> 6);
    const int lane = threadIdx.x & 63;
    const int t = w >> 3, h = w & 7;
    const size_t o = (size_t)t * 512 + h * 64 + lane;
    const int ch = h * 64 + lane;
    float y = y0[o] + y1[o];
    float mean = wave_sum(y) * (1.f / 64.f);
    float dlt = y - mean;
    float var = wave_sum(dlt * dlt) * (1.f / 64.f);
    float yn = dlt * rsqrtf(var + 64e-5f) * lnx_g[ch] + lnx_b[ch];
    float val = (yn + bonus[w] * bf2f(vb[o])) * bf2f(gate[o]);
    cat[(size_t)t * DM + ch] = f2bf(val);
}

__device__ __forceinline__ void d_mla_pre(const int bx, const int by, const int bz, char* smem, const float* __restrict__ proj, const float* __restrict__ q_norm, const float* __restrict__ kv_norm,
                                                 bf16_t* __restrict__ qcn, bf16_t* __restrict__ ckv, float* __restrict__ kpe,
                                                 float* __restrict__ out_ckv, float* __restrict__ out_kpe) {
    float* red = (float*)smem; float* red2 = red + 4;
    const int t = bx;
    const int tid = threadIdx.x;
    const float* P = proj + (size_t)t * 448;
    float q = P[tid];
    float kv = (tid < 128) ? P[256 + tid] : 0.f;
    float ss = wave_sum(q * q);
    float s2 = wave_sum(kv * kv);
    if ((tid & 63) == 0) { red[tid >> 6] = ss; red2[tid >> 6] = s2; }
    __syncthreads();
    float rq = rsqrtf((red[0] + red[1] + red[2] + red[3]) * (1.f / 256.f) + 1e-6f);
    float rk = rsqrtf((red2[0] + red2[1] + red2[2] + red2[3]) * (1.f / 128.f) + 1e-6f);
    qcn[(size_t)t * 256 + tid] = f2bf(q * rq * q_norm[tid]);
    if (tid < 128) {
        float val = kv * rk * kv_norm[tid];
        ckv[(size_t)t * 128 + tid] = f2bf(val);
        if (t < TP) out_ckv[(size_t)t * 128 + tid] = val;
    } else if (tid < 192) {
        float pe = P[384 + tid - 128];
        kpe[(size_t)t * 64 + tid - 128] = pe;
        if (t < TP) out_kpe[(size_t)t * 64 + tid - 128] = pe;
    }
}

__device__ __forceinline__ void d_mla_post(const int bx, const int by, const int bz, char* smem, const bf16_t* __restrict__ qraw, const bf16_t* __restrict__ kvraw, const bf16_t* __restrict__ kvraw_ctx,
                                                  const float* __restrict__ kpe, const float* __restrict__ cache_kpe, const float* __restrict__ qn,
                                                  const float* __restrict__ kn, bf16_t* __restrict__ Qb, bf16_t* __restrict__ Kp, bf16_t* __restrict__ Vp,
                                                  bf16_t* __restrict__ Ks, bf16_t* __restrict__ Vs) {
    float (*sq)[192] = (float(*)[192])smem; float (*sk)[192] = (float(*)[192])(smem + 4 * 192 * 4);
    const int wi = threadIdx.x >> 6, lane = threadIdx.x & 63;
    const int row = bx, h = wi;
    const bool isctx = row >= TT;
    const bool sample = row >= TP;
    float kx[3], qx[3] = {0.f, 0.f, 0.f};
    const bf16_t* kvr; const float* pe; int pos = 0;
    if (isctx) { int cr = row - TT; kvr = kvraw_ctx + (size_t)cr * 1024; pe = cache_kpe + (size_t)cr * 64; }
    else { kvr = kvraw + (size_t)row * 1024; pe = kpe + (size_t)row * 64; pos = tok_pos(row); }
#pragma unroll
    for (int j = 0; j < 3; j++) {
        int i = lane + 64 * j;
        kx[j] = (i < 128) ? bf2f(kvr[h * 256 + i]) : pe[i - 128];
        if (!isctx) qx[j] = bf2f(qraw[(size_t)row * 768 + h * 192 + i]);
    }
    float ssk = wave_sum(kx[0] * kx[0] + kx[1] * kx[1] + kx[2] * kx[2]);
    float ssq = wave_sum(qx[0] * qx[0] + qx[1] * qx[1] + qx[2] * qx[2]);
    float rk = rsqrtf(ssk * (1.f / 192.f) + 1e-6f), rq = rsqrtf(ssq * (1.f / 192.f) + 1e-6f);
#pragma unroll
    for (int j = 0; j < 3; j++) {
        int i = lane + 64 * j;
        sk[wi][i] = kx[j] * rk * kn[i];
        sq[wi][i] = qx[j] * rq * qn[i];
    }
    __syncthreads();
    if (sample && !isctx && lane < 32) {
        int rowi = pos >> 6, coli = pos & 63;
        int fi = lane & 15;
        float inv = expf(-(float)fi * (1.f / 16.f) * 9.210340371976184f);
        float ang = (lane < 16 ? (float)rowi : (float)coli) * inv;
        float cs = cosf(ang), sn = sinf(ang);
        float a = sk[wi][128 + 2 * lane], bq = sk[wi][128 + 2 * lane + 1];
        sk[wi][128 + 2 * lane] = a * cs - bq * sn; sk[wi][128 + 2 * lane + 1] = a * sn + bq * cs;
        a = sq[wi][128 + 2 * lane]; bq = sq[wi][128 + 2 * lane + 1];
        sq[wi][128 + 2 * lane] = a * cs - bq * sn; sq[wi][128 + 2 * lane + 1] = a * sn + bq * cs;
    }
    __syncthreads();
    bf16_t* kd; bf16_t* vd; int vLk, kidx;
    if (!sample) { int b = row >> 8, p = row & 255; kd = Kp + ((size_t)(b * 4 + h) * LP + p) * 192; vd = Vp + (size_t)(b * 4 + h) * 128 * LP; vLk = LP; kidx = p; }
    else if (!isctx) { int b = (row - TP) >> 11, p = (row - TP) & 2047; kd = Ks + ((size_t)(b * 4 + h) * 2304 + 256 + p) * 192; vd = Vs + (size_t)(b * 4 + h) * 128 * 2304; vLk = 2304; kidx = 256 + p; }
    else { int cr = row - TT; int b = cr >> 8, p = cr & 255; kd = Ks + ((size_t)(b * 4 + h) * 2304 + p) * 192; vd = Vs + (size_t)(b * 4 + h) * 128 * 2304; vLk = 2304; kidx = p; }
    const int kpos = (kidx & ~12) | ((kidx & 8) >> 1) | ((kidx & 4) << 1);
#pragma unroll
    for (int j = 0; j < 3; j++) {
        int i = lane + 64 * j;
        kd[i] = f2bf(sk[wi][i]);
        if (!isctx) Qb[((size_t)row * 4 + h) * 192 + i] = f2bf(sq[wi][i]);
    }
    vd[(size_t)lane * vLk + kpos] = kvr[h * 256 + 128 + lane];
    vd[(size_t)(lane + 64) * vLk + kpos] = kvr[h * 256 + 128 + lane + 64];
}

__device__ __forceinline__ void d_attn(const int bx, const int by, const int bz, char* smem, const bf16_t* __restrict__ Qb, const bf16_t* __restrict__ Kall, const bf16_t* __restrict__ Vall,
                                              bf16_t* __restrict__ cat, int tbase, int Lq, int Lk) {
    float (*Vsm)[128] = (float(*)[128])smem;
    float (*Qs)[192] = (float(*)[192])(smem + 32 * 128 * 4);
    float (*Ksm)[193] = (float(*)[193])(smem + 32 * 128 * 4 + 16 * 192 * 4);
    float (*Ss)[33] = (float(*)[33])(smem + 32 * 128 * 4 + 16 * 192 * 4 + 32 * 193 * 4);
    const int q0 = bx * 16, h = by, b = bz;
    const int tid = threadIdx.x;
    const int qi = tid >> 4, sub = tid & 15;
    const bf16_t* K = Kall + (size_t)(b * 4 + h) * Lk * 192;
    const bf16_t* V = Vall + (size_t)(b * 4 + h) * Lk * 128;
    for (int i = tid; i < 16 * 192; i += 256) {
        int r = i / 192, c = i % 192;
        int t = tbase + b * Lq + q0 + r;
        Qs[r][c] = bf2f(Qb[((size_t)t * 4 + h) * 192 + c]);
    }
    float m = -1e30f, l = 0.f;
    float acc[8];
#pragma unroll
    for (int j = 0; j < 8; j++) acc[j] = 0.f;
    const float scale = 0.07216878364870322f;
    for (int k0 = 0; k0 < Lk; k0 += 32) {
        __syncthreads();
        for (int i = tid; i < 32 * 192; i += 256) { int r = i / 192, c = i % 192; Ksm[r][c] = bf2f(K[(size_t)(k0 + r) * 192 + c]); }
        for (int i = tid; i < 32 * 128; i += 256) { int r = i >> 7, c = i & 127; Vsm[r][c] = bf2f(V[(size_t)(k0 + r) * 128 + c]); }
        __syncthreads();
        float s0 = 0.f, s1 = 0.f;
        for (int dd = 0; dd < 192; dd++) { float qv = Qs[qi][dd]; s0 += qv * Ksm[sub][dd]; s1 += qv * Ksm[sub + 16][dd]; }
        s0 *= scale; s1 *= scale;
        float mx = fmaxf(s0, s1);
#pragma unroll
        for (int o = 8; o > 0; o >>= 1) mx = fmaxf(mx, __shfl_xor(mx, o, 64));
        float mn = fmaxf(m, mx);
        float alpha = expf(m - mn);
        float p0 = expf(s0 - mn), p1 = expf(s1 - mn);
        float ps = p0 + p1;
#pragma unroll
        for (int o = 8; o > 0; o >>= 1) ps += __shfl_xor(ps, o, 64);
        l = l * alpha + ps; m = mn;
        Ss[qi][sub] = p0; Ss[qi][sub + 16] = p1;
        __syncthreads();
#pragma unroll
        for (int j = 0; j < 8; j++) acc[j] *= alpha;
        for (int kk = 0; kk < 32; kk++) {
            float p = Ss[qi][kk];
            float4 v0 = *(const float4*)&Vsm[kk][sub * 8], v1 = *(const float4*)&Vsm[kk][sub * 8 + 4];
            acc[0] += p * v0.x; acc[1] += p * v0.y; acc[2] += p * v0.z; acc[3] += p * v0.w;
            acc[4] += p * v1.x; acc[5] += p * v1.y; acc[6] += p * v1.z; acc[7] += p * v1.w;
        }
    }
    const int t = tbase + b * Lq + q0 + qi;
    float il = 1.f / l;
    bf16_t* o = cat + (size_t)t * DM + 512 + h * 128 + sub * 8;
#pragma unroll
    for (int j = 0; j < 8; j++) o[j] = f2bf(acc[j] * il);
}


#define ATT_SV_OFF 25600
__device__ __forceinline__ void d_attn_mfma(const int item, char* smem, const bf16_t* __restrict__ Qb, const bf16_t* __restrict__ Kall,
                                            const bf16_t* __restrict__ VtAll, bf16_t* __restrict__ cat, int tbase, int Lq, int Lk, int nqb) {
    const int qb = item % nqb, bh = item / nqb;
    const int b = bh >> 2, h = bh & 3;
    const int tid = threadIdx.x, lane = tid & 63, wid = tid >> 6;
    const int q = lane & 31, hh = lane >> 5;
    const int t = tbase + b * Lq + qb * 128 + wid * 32 + q;
    bf16x8 qf[12];
    {
        const bf16_t* qp = Qb + ((size_t)t * 4 + h) * 192 + hh * 8;
#pragma unroll
        for (int ks = 0; ks < 12; ks++) qf[ks] = *(const bf16x8*)(qp + ks * 16);
    }
    f32x16 o[4];
#pragma unroll
    for (int i = 0; i < 4; i++)
#pragma unroll
        for (int r = 0; r < 16; r++) o[i][r] = 0.f;
    float m = -1e30f, l = 0.f;
    const bf16_t* K = Kall + (size_t)bh * Lk * 192;
    const bf16_t* Vt = VtAll + (size_t)bh * 128 * Lk;
    char* sK = smem;
    char* sV = smem + ATT_SV_OFF;
    u32x4 pk[6], pv[4];
    const int nkt = Lk >> 6;
#pragma unroll
    for (int i = 0; i < 6; i++) pk[i] = *(const u32x4*)(K + (size_t)(tid + 256 * i) * 8);
#pragma unroll
    for (int i = 0; i < 4; i++) { int c = tid + 256 * i; pv[i] = *(const u32x4*)(Vt + (size_t)(c >> 3) * Lk + (c & 7) * 8); }
#pragma unroll
    for (int i = 0; i < 6; i++) { int c = tid + 256 * i; *(u32x4*)(sK + (c / 24) * 400 + (c % 24) * 16) = pk[i]; }
#pragma unroll
    for (int i = 0; i < 4; i++) { int c = tid + 256 * i; *(u32x4*)(sV + (c >> 3) * 144 + (c & 7) * 16) = pv[i]; }
    __syncthreads();
    const float sc2 = 0.07216878364870322f * 1.4426950408889634f;
    for (int kt = 0; kt < nkt; kt++) {
        if (kt + 1 < nkt) {
            const bf16_t* Kn = K + (size_t)(kt + 1) * 64 * 192;
            const bf16_t* Vn = Vt + (kt + 1) * 64;
#pragma unroll
            for (int i = 0; i < 6; i++) pk[i] = *(const u32x4*)(Kn + (size_t)(tid + 256 * i) * 8);
#pragma unroll
            for (int i = 0; i < 4; i++) { int c = tid + 256 * i; pv[i] = *(const u32x4*)(Vn + (size_t)(c >> 3) * Lk + (c & 7) * 8); }
        }
        f32x16 st[2];
#pragma unroll
        for (int bk = 0; bk < 2; bk++)
#pragma unroll
            for (int r = 0; r < 16; r++) st[bk][r] = 0.f;
#pragma unroll
        for (int ks = 0; ks < 12; ks++) {
#pragma unroll
            for (int bk = 0; bk < 2; bk++) {
                bf16x8 a = *(const bf16x8*)(sK + (bk * 32 + q) * 400 + ks * 32 + hh * 16);
                st[bk] = __builtin_amdgcn_mfma_f32_32x32x16_bf16(a, qf[ks], st[bk], 0, 0, 0);
            }
        }
        float mx = -1e30f;
#pragma unroll
        for (int bk = 0; bk < 2; bk++)
#pragma unroll
            for (int r = 0; r < 16; r++) { st[bk][r] *= sc2; mx = fmaxf(mx, st[bk][r]); }
        mx = fmaxf(mx, __shfl_xor(mx, 32, 64));
        const float mn = fmaxf(m, mx);
        const float alpha = exp2f(m - mn);
        float ps = 0.f;
#pragma unroll
        for (int bk = 0; bk < 2; bk++)
#pragma unroll
            for (int r = 0; r < 16; r++) { st[bk][r] = exp2f(st[bk][r] - mn); ps += st[bk][r]; }
        ps += __shfl_xor(ps, 32, 64);
        l = l * alpha + ps; m = mn;
#pragma unroll
        for (int i = 0; i < 4; i++)
#pragma unroll
            for (int r = 0; r < 16; r++) o[i][r] *= alpha;
#pragma unroll
        for (int s4 = 0; s4 < 4; s4++) {
            bf16x8 pb;
#pragma unroll
            for (int j = 0; j < 8; j++) pb[j] = (short)f2bf(st[s4 >> 1][8 * (s4 & 1) + j]);
#pragma unroll
            for (int i = 0; i < 4; i++) {
                bf16x8 a = *(const bf16x8*)(sV + (i * 32 + q) * 144 + s4 * 32 + hh * 16);
                o[i] = __builtin_amdgcn_mfma_f32_32x32x16_bf16(a, pb, o[i], 0, 0, 0);
            }
        }
        __syncthreads();
        if (kt + 1 < nkt) {
#pragma unroll
            for (int i = 0; i < 6; i++) { int c = tid + 256 * i; *(u32x4*)(sK + (c / 24) * 400 + (c % 24) * 16) = pk[i]; }
#pragma unroll
            for (int i = 0; i < 4; i++) { int c = tid + 256 * i; *(u32x4*)(sV + (c >> 3) * 144 + (c & 7) * 16) = pv[i]; }
        }
        __syncthreads();
    }
    const float il = 1.f / l;
    bf16_t* op = cat + (size_t)t * DM + 512 + h * 128;
#pragma unroll
    for (int i = 0; i < 4; i++)
#pragma unroll
        for (int g = 0; g < 4; g++) {
            ushort4 w;
            w.x = f2bf(o[i][4 * g + 0] * il); w.y = f2bf(o[i][4 * g + 1] * il); w.z = f2bf(o[i][4 * g + 2] * il); w.w = f2bf(o[i][4 * g + 3] * il);
            *(ushort4*)(op + i * 32 + 8 * g + 4 * hh) = w;
        }
}

__device__ __forceinline__ void d_peer_route(const int bx, const int by, const int bz, char* smem, const float* __restrict__ qp, const float* __restrict__ keys  ,
                                                    int* __restrict__ pidx, float* __restrict__ pg) {
    float (*sq)[256] = (float(*)[256])smem;
    float (*sc)[256] = (float(*)[256])(smem + 4096);
    float (*tv)[32] = (float(*)[32])(smem + 8192);
    int (*ti)[32] = (int(*)[32])(smem + 8192 + 512);
    float (*topv)[16] = (float(*)[16])(smem + 8192 + 1024);
    int (*topi)[16] = (int(*)[16])(smem + 8192 + 1024 + 256);
    const int wi = threadIdx.x >> 6, lane = threadIdx.x & 63;
    const int w = bx * 4 + wi;
    const int t = w >> 3, h = w & 7;
    const float* q = qp + (size_t)t * 2048 + h * 256;
#pragma unroll
    for (int j = 0; j < 4; j++) sq[wi][lane + 64 * j] = q[lane + 64 * j];
    __syncthreads();
#pragma unroll
    for (int p = 0; p < 2; p++)
#pragma unroll
        for (int half = 0; half < 2; half++) {
            int n = lane + 64 * half;
            const float* kr = keys + ((size_t)(h * 2 + p) * 128 + n) * 128;
            float s = 0.f;
            for (int dd = 0; dd < 128; dd += 4) {
                float4 kv = *(const float4*)(kr + dd);
                s += sq[wi][p * 128 + dd] * kv.x + sq[wi][p * 128 + dd + 1] * kv.y + sq[wi][p * 128 + dd + 2] * kv.z + sq[wi][p * 128 + dd + 3] * kv.w;
            }
            sc[wi][p * 128 + n] = s;
        }
    __syncthreads();
#pragma unroll
    for (int p = 0; p < 2; p++)
#pragma unroll
        for (int half = 0; half < 2; half++) {
            int n = lane + 64 * half;
            float s = sc[wi][p * 128 + n];
            int rank = 0;
            for (int j = 0; j < 128; j++) { float o = sc[wi][p * 128 + j]; rank += (o > s || (o == s && j < n)) ? 1 : 0; }
            if (rank < 16) { tv[wi][p * 16 + rank] = s; ti[wi][p * 16 + rank] = n; }
        }
    __syncthreads();
    float cv[4];
#pragma unroll
    for (int j = 0; j < 4; j++) { int c = lane + 64 * j; cv[j] = tv[wi][c >> 4] + tv[wi][16 + (c & 15)]; }
    __syncthreads();
#pragma unroll
    for (int j = 0; j < 4; j++) sc[wi][lane + 64 * j] = cv[j];
    __syncthreads();
#pragma unroll
    for (int j = 0; j < 4; j++) {
        int c = lane + 64 * j;
        float s = cv[j];
        int rank = 0;
        for (int i = 0; i < 256; i++) { float o = sc[wi][i]; rank += (o > s || (o == s && i < c)) ? 1 : 0; }
        if (rank < 16) { topv[wi][rank] = s; topi[wi][rank] = (ti[wi][c >> 4] * 128 + ti[wi][16 + (c & 15)]) & 16383; }
    }
    __syncthreads();
    if (lane < 16) {
        float mx = topv[wi][0];
        float sum = 0.f;
        for (int i = 0; i < 16; i++) sum += expf(topv[wi][i] - mx);
        pg[(size_t)w * 16 + lane] = expf(topv[wi][lane] - mx) / sum;
        pidx[(size_t)w * 16 + lane] = topi[wi][lane] & 16383;
    }
}

__device__ __forceinline__ void d_peer_apply(const int bx, const int by, const int bz, char* smem, const bf16_t* __restrict__ hbuf, const int* __restrict__ pidx, const float* __restrict__ pg,
                                                    const float* __restrict__ utab, const float* __restrict__ vtab, const float* __restrict__ modl,
                                                    float* __restrict__ xrun) {
    float* coef = (float*)smem; int* eid = (int*)(smem + 512);
    const int t = bx, tid = threadIdx.x, wi = tid >> 6, lane = tid & 63;
    if (tid < 128) eid[tid] = pidx[(size_t)t * 128 + tid];
    float4 xv[4];
#pragma unroll
    for (int j = 0; j < 4; j++) { ushort4 q = *(const ushort4*)(hbuf + (size_t)t * DM + j * 256 + lane * 4); xv[j] = make_float4(bf2f(q.x), bf2f(q.y), bf2f(q.z), bf2f(q.w)); }
    __syncthreads();
    for (int e = wi * 32; e < wi * 32 + 32; e++) {
        const float* ur = utab + (size_t)eid[e] * DM;
        float s = 0.f;
#pragma unroll
        for (int j = 0; j < 4; j++) { float4 u = *(const float4*)(ur + j * 256 + lane * 4); s += u.x * xv[j].x + u.y * xv[j].y + u.z * xv[j].z + u.w * xv[j].w; }
        s = wave_sum(s);
        if (lane == 0) coef[e] = pg[(size_t)t * 128 + e] * gelu_tanh(s);
    }
    __syncthreads();
    float4 acc = make_float4(0.f, 0.f, 0.f, 0.f);
    for (int e = 0; e < 128; e++) {
        float cf = coef[e];
        float4 v = *(const float4*)(vtab + (size_t)eid[e] * DM + tid * 4);
        acc.x += cf * v.x; acc.y += cf * v.y; acc.z += cf * v.z; acc.w += cf * v.w;
    }
    const float* m = modl + (size_t)tok_modrow(t) * 6144 + 5 * 1024 + tid * 4;
    float* xo = xrun + (size_t)t * DM + tid * 4;
    float4 x = *(float4*)xo;
    x.x += m[0] * acc.x; x.y += m[1] * acc.y; x.z += m[2] * acc.z; x.w += m[3] * acc.w;
    *(float4*)xo = x;
}


template <int K, int J>
__device__ __forceinline__ void bit_stage16(float (&x)[16]) {
#pragma unroll
    for (int i = 0; i < 16; i++) {
        const int l = i ^ J;
        if (l > i) {
            const bool desc = ((i & K) == 0);
            const float a = x[i], b = x[l];
            const float hi = fmaxf(a, b), lo = fminf(a, b);
            x[i] = desc ? hi : lo; x[l] = desc ? lo : hi;
        }
    }
}
__device__ __forceinline__ void bit_sort16_desc(float (&x)[16]) {
    bit_stage16<2, 1>(x);
    bit_stage16<4, 2>(x); bit_stage16<4, 1>(x);
    bit_stage16<8, 4>(x); bit_stage16<8, 2>(x); bit_stage16<8, 1>(x);
    bit_stage16<16, 8>(x); bit_stage16<16, 4>(x); bit_stage16<16, 2>(x); bit_stage16<16, 1>(x);
}
__device__ __forceinline__ void bit_merge16_desc(float (&x)[16]) {
    bit_stage16<16, 8>(x); bit_stage16<16, 4>(x); bit_stage16<16, 2>(x); bit_stage16<16, 1>(x);
}
template <int K, int J>
__device__ __forceinline__ void bit_stage16p(float (&x)[16], int (&y)[16]) {
#pragma unroll
    for (int i = 0; i < 16; i++) {
        const int l = i ^ J;
        if (l > i) {
            const bool desc = ((i & K) == 0);
            const float a = x[i], b = x[l];
            const int pa = y[i], pb = y[l];
            const bool sw = desc ? (b > a) : (a > b);
            x[i] = sw ? b : a; x[l] = sw ? a : b;
            y[i] = sw ? pb : pa; y[l] = sw ? pa : pb;
        }
    }
}
__device__ __forceinline__ void bit_sort16p_desc(float (&x)[16], int (&y)[16]) {
    bit_stage16p<2, 1>(x, y);
    bit_stage16p<4, 2>(x, y); bit_stage16p<4, 1>(x, y);
    bit_stage16p<8, 4>(x, y); bit_stage16p<8, 2>(x, y); bit_stage16p<8, 1>(x, y);
    bit_stage16p<16, 8>(x, y); bit_stage16p<16, 4>(x, y); bit_stage16p<16, 2>(x, y); bit_stage16p<16, 1>(x, y);
}
__device__ __forceinline__ void bit_merge16p_desc(float (&x)[16], int (&y)[16]) {
    bit_stage16p<16, 8>(x, y); bit_stage16p<16, 4>(x, y); bit_stage16p<16, 2>(x, y); bit_stage16p<16, 1>(x, y);
}
__device__ __forceinline__ void top16_merge(float (&L)[16], const float (&C)[16]) {
#pragma unroll
    for (int i = 0; i < 16; i++) L[i] = fmaxf(L[i], C[15 - i]);
    bit_merge16_desc(L);
}
__device__ __forceinline__ void top16_merge_p(float (&L)[16], int (&Lp)[16], const float (&C)[16], const int (&Cp)[16]) {
#pragma unroll
    for (int i = 0; i < 16; i++) { const bool sw = C[15 - i] > L[i]; L[i] = sw ? C[15 - i] : L[i]; Lp[i] = sw ? Cp[15 - i] : Lp[i]; }
    bit_merge16p_desc(L, Lp);
}
__device__ __forceinline__ float key_val(float k) { return __uint_as_float(__float_as_uint(k) & ~127u); }
__device__ __forceinline__ int key_idx(float k) { return (int)(__float_as_uint(k) & 127u); }

__device__ __forceinline__ void d_peer_select(const int vb, const float* __restrict__ scT, int* __restrict__ pidx, float* __restrict__ pg) {
    const int h = vb & 7;
    const int t = (vb >> 3) * 256 + threadIdx.x;
    float A[16], B[16];
#pragma unroll
    for (int p = 0; p < 2; p++) {
        const float* S = scT + (size_t)(h * 2 + p) * 128 * TT + t;
        float L[16];
#pragma unroll
        for (int ch = 0; ch < 8; ch++) {
            float C[16];
#pragma unroll
            for (int i = 0; i < 16; i++) {
                const int n = ch * 16 + i;
                C[i] = __uint_as_float((__float_as_uint(S[(size_t)n * TT]) & ~127u) | (unsigned)n);
            }
            bit_sort16_desc(C);
            if (ch == 0) {
#pragma unroll
                for (int i = 0; i < 16; i++) L[i] = C[i];
            } else top16_merge(L, C);
        }
#pragma unroll
        for (int i = 0; i < 16; i++) { if (p == 0) A[i] = L[i]; else B[i] = L[i]; }
    }
    float Tv[16]; int Tp[16];
#pragma unroll
    for (int g = 0; g < 4; g++) {
        float Cv[16]; int Cp[16];
#pragma unroll
        for (int e = 0; e < 16; e++) {
            const int c = g * 16 + e;
            int i, j;
            if (c < 16) { i = 0; j = c; }
            else if (c < 24) { i = 1; j = c - 16; }
            else if (c < 29) { i = 2; j = c - 24; }
            else if (c < 33) { i = 3; j = c - 29; }
            else if (c < 36) { i = 4; j = c - 33; }
            else if (c < 42) { i = 5 + (c - 36) / 2; j = (c - 36) % 2; }
            else if (c < 50) { i = 8 + (c - 42); j = 0; }
            else { i = -1; j = 0; }
            if (i >= 0) { Cv[e] = key_val(A[i]) + key_val(B[j]); Cp[e] = key_idx(A[i]) * 128 + key_idx(B[j]); }
            else { Cv[e] = -3.0e38f; Cp[e] = 0; }
        }
        bit_sort16p_desc(Cv, Cp);
        if (g == 0) {
#pragma unroll
            for (int e = 0; e < 16; e++) { Tv[e] = Cv[e]; Tp[e] = Cp[e]; }
        } else top16_merge_p(Tv, Tp, Cv, Cp);
    }
    float sum = 0.f;
    float w[16];
#pragma unroll
    for (int e = 0; e < 16; e++) { w[e] = __expf(Tv[e] - Tv[0]); sum += w[e]; }
    const float inv = 1.f / sum;
    int* pi = pidx + ((size_t)t * 8 + h) * 16;
    float* pw = pg + ((size_t)t * 8 + h) * 16;
#pragma unroll
    for (int e = 0; e < 16; e += 4) {
        *(int4*)(pi + e) = make_int4(Tp[e], Tp[e + 1], Tp[e + 2], Tp[e + 3]);
        *(float4*)(pw + e) = make_float4(w[e] * inv, w[e + 1] * inv, w[e + 2] * inv, w[e + 3] * inv);
    }
}

typedef __attribute__((ext_vector_type(2))) short bf16x2;
__device__ __forceinline__ float dot8_bf16(u32x4 a, u32x4 b, float acc) {
#pragma unroll
    for (int i = 0; i < 4; i++) {
        const unsigned x = a[i], y = b[i];
        acc += __uint_as_float(x << 16) * __uint_as_float(y << 16);
        acc += __uint_as_float(x & 0xffff0000u) * __uint_as_float(y & 0xffff0000u);
    }
    return acc;
}
__device__ __forceinline__ void d_peer_apply2(const int vb, char* smem, const bf16_t* __restrict__ hb, const int* __restrict__ pidx,
                                              const float* __restrict__ pg, const bf16_t* __restrict__ utab, const bf16_t* __restrict__ vtab,
                                              const float* __restrict__ modl, float* __restrict__ xrun) {
    const int wid = threadIdx.x >> 6, lane = threadIdx.x & 63;
    const int t = vb * 4 + wid;
    float* coef = (float*)smem + wid * 128;
    int* eid = (int*)(smem + 2048) + wid * 128;
    eid[lane] = pidx[(size_t)t * 128 + lane]; eid[lane + 64] = pidx[(size_t)t * 128 + lane + 64];
    const float g0 = pg[(size_t)t * 128 + lane], g1 = pg[(size_t)t * 128 + lane + 64];
    const u32x4 x0 = *(const u32x4*)(hb + (size_t)t * DM + lane * 8);
    const u32x4 x1 = *(const u32x4*)(hb + (size_t)t * DM + 512 + lane * 8);
    __builtin_amdgcn_wave_barrier();
    float myact0 = 0.f, myact1 = 0.f;
    for (int eb = 0; eb < 128; eb += 8) {
        u32x4 ua[8], ub[8];
#pragma unroll
        for (int r = 0; r < 8; r++) {
            const bf16_t* ur = utab + (size_t)eid[eb + r] * DM;
            ua[r] = *(const u32x4*)(ur + lane * 8);
            ub[r] = *(const u32x4*)(ur + 512 + lane * 8);
        }
#pragma unroll
        for (int r = 0; r < 8; r++) {
            float sacc = dot8_bf16(ua[r], x0, 0.f);
            sacc = dot8_bf16(ub[r], x1, sacc);
            sacc = wave_sum(sacc);
            const int e = eb + r;
            if (lane == (e & 63)) { if (e < 64) myact0 = sacc; else myact1 = sacc; }
        }
    }
    coef[lane] = g0 * gelu_tanh(myact0);
    coef[lane + 64] = g1 * gelu_tanh(myact1);
    __builtin_amdgcn_wave_barrier();
    float acc[16];
#pragma unroll
    for (int i = 0; i < 16; i++) acc[i] = 0.f;
    for (int eb = 0; eb < 128; eb += 8) {
        u32x4 va[8], vbq[8];
#pragma unroll
        for (int r = 0; r < 8; r++) {
            const bf16_t* vr = vtab + (size_t)eid[eb + r] * DM;
            va[r] = *(const u32x4*)(vr + lane * 8);
            vbq[r] = *(const u32x4*)(vr + 512 + lane * 8);
        }
#pragma unroll
        for (int r = 0; r < 8; r++) {
            const float cf = coef[eb + r];
#pragma unroll
            for (int i = 0; i < 4; i++) {
                acc[2 * i] += cf * __uint_as_float(va[r][i] << 16);
                acc[2 * i + 1] += cf * __uint_as_float(va[r][i] & 0xffff0000u);
                acc[8 + 2 * i] += cf * __uint_as_float(vbq[r][i] << 16);
                acc[8 + 2 * i + 1] += cf * __uint_as_float(vbq[r][i] & 0xffff0000u);
            }
        }
    }
    const float* m = modl + (size_t)tok_modrow(t) * 6144 + 5 * 1024;
    float* xo = xrun + (size_t)t * DM;
#pragma unroll
    for (int hlf = 0; hlf < 2; hlf++) {
        const int c0 = hlf * 512 + lane * 8;
        float4 xa = *(float4*)(xo + c0), xb2 = *(float4*)(xo + c0 + 4);
        const float4 ma = *(const float4*)(m + c0), mb = *(const float4*)(m + c0 + 4);
        xa.x += ma.x * acc[hlf * 8 + 0]; xa.y += ma.y * acc[hlf * 8 + 1]; xa.z += ma.z * acc[hlf * 8 + 2]; xa.w += ma.w * acc[hlf * 8 + 3];
        xb2.x += mb.x * acc[hlf * 8 + 4]; xb2.y += mb.y * acc[hlf * 8 + 5]; xb2.z += mb.z * acc[hlf * 8 + 6]; xb2.w += mb.w * acc[hlf * 8 + 7];
        *(float4*)(xo + c0) = xa; *(float4*)(xo + c0 + 4) = xb2;
    }
}
__device__ __forceinline__ void d_cvt_bf16(const int vb, const float* __restrict__ src, bf16_t* __restrict__ dst) {
    const size_t base = (size_t)vb * 16384 + threadIdx.x * 4;
#pragma unroll
    for (int i = 0; i < 16; i++) {
        const float4 v = *(const float4*)(src + base + i * 1024);
        ushort4 o; o.x = f2bf(v.x); o.y = f2bf(v.y); o.z = f2bf(v.z); o.w = f2bf(v.w);
        *(ushort4*)(dst + base + i * 1024) = o;
    }
}

__device__ __forceinline__ void d_hy_dw(const int bx, const int by, const int bz, char* smem, const float* __restrict__ pre, const float* __restrict__ cw, const float* __restrict__ cb,
                                               bf16_t* __restrict__ zin, bf16_t* __restrict__ x0) {
    const int t = bx;
    const int pos = tok_pos(t), L = tok_len(t);
    const float* P = pre + (size_t)t * 3072;
    for (int c = threadIdx.x; c < 1024; c += 256) {
        float u[3];
#pragma unroll
        for (int part = 0; part < 3; part++) {
            int cc = part * 1024 + c;
            float cur = P[cc];
            float prev = (pos > 0) ? P[cc - 3072] : 0.f;
            float nxt = (pos < L - 1) ? P[cc + 3072] : 0.f;
            u[part] = prev * cw[cc] + cur * cw[3072 + cc] + nxt * cw[2 * 3072 + cc] + cb[cc];
        }
        x0[(size_t)t * DM + c] = f2bf(u[0]);
        zin[(size_t)t * DM + c] = f2bf(u[1] * u[2]);
    }
}

__device__ __forceinline__ void d_hy_filt(const int bx, const int by, const int bz, char* smem, int L, const float* __restrict__ w1, const float* __restrict__ b1, const float* __restrict__ w2,
                                                 const float* __restrict__ b2, const float* __restrict__ w3, const float* __restrict__ fr,
                                                 float* __restrict__ hf, float* __restrict__ hb) {
    float* z = (float*)smem; float* h1 = z + 64; float* h2 = z + 128;
    const int t = bx, tid = threadIdx.x;
    const float tu = (float)t / (float)(L - 1);
    if (tid == 0) z[0] = tu;
    if (tid >= 1 && tid < 17) {
        int i = tid - 1;
        float band = 1e-4f + (float)i * ((15.f - 1e-4f) / 15.f);
        float ang = 6.283185307179586f * (float)t * band / (float)L;
        z[1 + i] = cosf(ang); z[17 + i] = -sinf(ang);
    }
    __syncthreads();
    if (tid < 64) { float s = b1[tid]; for (int i = 0; i < 33; i++) s += z[i] * w1[i * 64 + tid]; h1[tid] = sinf(fr[tid] * s); }
    __syncthreads();
    if (tid < 64) { float s = b2[tid]; for (int i = 0; i < 64; i++) s += h1[i] * w2[i * 64 + tid]; h2[tid] = sinf(fr[tid] * s); }
    __syncthreads();
    for (int c = tid; c < 2048; c += 256) {
        float s = 0.f;
        for (int i = 0; i < 64; i++) s += h2[i] * w3[i * 2048 + c];
        int ch = c & 1023;
        float d0 = -4.605170185988091f / 0.3f, d1 = -4.605170185988091f / 1.5f;
        float delta = d0 + (d1 - d0) * ((float)ch / 1023.f);
        float win = expf(-tu * fabsf(delta));
        float val = s * win;
        if (c < 1024) hf[(size_t)t * 1024 + ch] = val; else hb[(size_t)t * 1024 + ch] = val;
    }
}
__device__ __forceinline__ void d_hy_norm(const int bx, const int by, const int bz, char* smem, int L, const float* __restrict__ hf, const float* __restrict__ hb, float* __restrict__ inv) {
    const int c = bx * 256 + threadIdx.x;
    float s = 0.f;
    for (int t = 0; t < L; t++) { s += fabsf(hf[(size_t)t * 1024 + c]); if (t > 0) s += fabsf(hb[(size_t)t * 1024 + c]); }
    inv[c] = 1.f / s;
}
__device__ __forceinline__ void d_hy_conv(const int bx, const int by, const int bz, char* smem, int L, int tbase, const bf16_t* __restrict__ zin, const bf16_t* __restrict__ x0, const float* __restrict__ hf,
                                                 const float* __restrict__ hb, const float* __restrict__ inv, const float* __restrict__ bias,
                                                 bf16_t* __restrict__ zb) {
    const int c = bx * 256 + threadIdx.x;
    const int t0 = by * 8, b = bz;
    const bf16_t* Z = zin + (size_t)(tbase + b * L) * DM + c;
    float acc[8];
#pragma unroll
    for (int i = 0; i < 8; i++) acc[i] = 0.f;
    for (int s = 0; s < L; s++) {
        float z = bf2f(Z[(size_t)s * DM]);
#pragma unroll
        for (int i = 0; i < 8; i++) {
            int j = t0 + i - s;
            float g = (j >= 0) ? hf[(size_t)j * 1024 + c] : hb[(size_t)(-j) * 1024 + c];
            acc[i] += z * g;
        }
    }
    float iv = inv[c], bs = bias[c];
#pragma unroll
    for (int i = 0; i < 8; i++) {
        size_t o = (size_t)(tbase + b * L + t0 + i) * DM + c;
        float zz = bf2f(zin[o]);
        zb[o] = f2bf(bf2f(x0[o]) * (acc[i] * iv + zz * bs));
    }
}

struct Params {
    const float *x_prompt, *x_sample, *st_f, *st_b, *cache_ckv, *cache_kpe, *c, *c_ctx, *norm_g, *w_mod, *b_mod, *ab_w_in, *rw_mu, *rw_w0, *rw_w2,
        *rw_a0, *rw_a2, *rw_g2, *rw_k_k, *rw_k_a, *rw_r_k, *rw_lnx_g, *rw_lnx_b, *mla_q_norm, *mla_q_up, *mla_kv_norm, *mla_kv_up, *mla_qn, *mla_kn,
        *ab_w_out, *hy_w_in, *hy_b_in, *hy_conv_w, *hy_conv_b, *hy_f_w1, *hy_f_b1, *hy_f_w2, *hy_f_b2, *hy_f_w3, *hy_f_freq, *hy_bias, *hy_w_out,
        *peer_w_q, *peer_keys, *peer_u, *peer_v;
    float *xrun, *out_sf, *out_sb, *out_ckv, *out_kpe;
    float *mod;
    bf16_t *w_in_t, *w_out_t, *hy_w_in_t, *hy_w_out_t, *w_q_t, *q_up_t, *kv_up_t, *w2_t, *a2_t, *g2_t, *ctxb, *keysb, *tabU, *tabV;
    bf16_t *hb, *catb, *zbb, *kvrawb, *qrawb;
    bf16_t *projrw; float *projmla; float *y0, *y1; bf16_t *qb;
    bf16_t *rb, *kb, *vb, *kkb, *lr0, *lr1, *gateb;
    _Float16 *du0, *du1; bf16_t *twb, *advb, *sgb; float *bonus, *kpe; bf16_t *qcnb, *ckvb;
    bf16_t *Qb, *Kp, *Vp, *Ks, *Vs, *kvctxb;
    int* pidx; float* pg; float* scT;
    float *pre; bf16_t *zin, *x0b; float *hfS, *hbS, *hfP, *hbP, *invS, *invP;
};

#define VLOOP(n) for (int vb = blockIdx.x; vb < (n); vb += gridDim.x)
#define ENDV __syncthreads();

__device__ __forceinline__ void peer_layer(const Params& p, cg::grid_group& grid, char* smem, int li, const float* modl, float* xrs) {
    const bf16_t* wq = p.w_q_t + (size_t)li * 2048 * 1024;
    const bf16_t* kys = p.keysb + (size_t)li * 16 * 128 * 128;
    VLOOP(TT) { d_norm_mod(vb, 0, 0, smem, p.xrun, xrs, p.norm_g + (li * 2 + 1) * 1024, modl, 3, 4, p.hb); ENDV }
    grid.sync();
    VLOOP(16 * 96) { d_gemm_bf16(vb % 16, vb / 16, smem, p.hb, 1024, wq, 1024, 1024, 2048, EpiStoreBf{p.qb, 2048, 0}); }
    grid.sync();
    VLOOP(16 * 96) { const int hp = vb / 96; d_gemm_bf16(vb % 96, 0, smem, kys + (size_t)hp * 128 * 128, 128, p.qb + hp * 128, 2048, 128, TT, EpiStore{p.scT + (size_t)hp * 128 * TT, nullptr, TT, 0}); }
    grid.sync();
    VLOOP(8 * 48) { d_peer_select(vb, p.scT, p.pidx, p.pg); }
    grid.sync();
    VLOOP(TT / 4) { d_peer_apply2(vb, smem, p.hb, p.pidx, p.pg, p.tabU, p.tabV, modl, p.xrun); ENDV }
}

__global__ void __launch_bounds__(256) mega(Params p) {
    __shared__ __attribute__((aligned(16))) char smem[GEMM_LDS_BYTES];
    cg::grid_group grid = cg::this_grid();
    const float* mod0 = p.mod;
    const float* mod1 = p.mod + 5 * 6144;
    float* xrs = p.xrun + (size_t)TP * DM;

    {
        const int j0 = 48;
        const int j1 = j0 + 36 * 16;
        const int j2 = j1 + 16 * 16;
        const int j3 = j2 + 48 * 16;
        const int j4 = j3 + 16 * 16;
        const int j5 = j4 + 32 * 16;
        const int j6 = j5 + 32 * 16;
        const int j7 = j6 + 12 * 4;
        const int j8 = j7 + 16 * 2;
        const int j9 = j8 + 8;
        const int j10 = j9 + 8;
        const int j11 = j10 + 8;
        const int j12 = j11 + 8;
        const int j13 = j12 + 8 * 2;
        const int j14 = j13 + 8;
        const int j15 = j14 + 32;
        const int j16 = j15 + 1024;
        const int j17 = j16 + 1024;
        VLOOP(j17) {
            if (vb < j0) d_mod(vb % 24, vb / 24, 0, smem, p.c, p.c_ctx, p.w_mod, p.b_mod, p.mod);
            else if (vb < j1) d_transpose_w(vb - j0, smem, p.ab_w_in, 1024, 2240, p.w_in_t);
            else if (vb < j2) d_transpose_w(vb - j1, smem, p.ab_w_out, 1024, 1024, p.w_out_t);
            else if (vb < j3) d_transpose_w(vb - j2, smem, p.hy_w_in, 1024, 3072, p.hy_w_in_t);
            else if (vb < j4) d_transpose_w(vb - j3, smem, p.hy_w_out, 1024, 1024, p.hy_w_out_t);
            else if (vb < j5) d_transpose_w(vb - j4, smem, p.peer_w_q, 1024, 2048, p.w_q_t);
            else if (vb < j6) d_transpose_w(vb - j5, smem, p.peer_w_q + (size_t)1024 * 2048, 1024, 2048, p.w_q_t + (size_t)2048 * 1024);
            else if (vb < j7) d_transpose_w(vb - j6, smem, p.mla_q_up, 256, 768, p.q_up_t);
            else if (vb < j8) d_transpose_w(vb - j7, smem, p.mla_kv_up, 128, 1024, p.kv_up_t);
            else if (vb < j9) d_transpose_w(vb - j8, smem, p.rw_w2, 64, 512, p.w2_t);
            else if (vb < j10) d_transpose_w(vb - j9, smem, p.rw_w2 + 64 * 512, 64, 512, p.w2_t + 512 * 64);
            else if (vb < j11) d_transpose_w(vb - j10, smem, p.rw_a2, 64, 512, p.a2_t);
            else if (vb < j12) d_transpose_w(vb - j11, smem, p.rw_a2 + 64 * 512, 64, 512, p.a2_t + 512 * 64);
            else if (vb < j13) d_transpose_w(vb - j12, smem, p.rw_g2, 128, 512, p.g2_t);
            else if (vb < j14) d_cvt_bf16(vb - j13, p.cache_ckv, p.ctxb);
            else if (vb < j15) d_cvt_bf16(vb - j14, p.peer_keys, p.keysb);
            else if (vb < j16) d_cvt_bf16(vb - j15, p.peer_u, p.tabU);
            else d_cvt_bf16(vb - j16, p.peer_v, p.tabV);
            ENDV }
    }
    grid.sync();
    VLOOP(TT) { d_norm_mod(vb, 0, 0, smem, p.x_prompt, p.x_sample, p.norm_g, mod0, 0, 1, p.hb); ENDV }
    grid.sync();
    VLOOP(18 * 96) { d_gemm_bf16(vb % 18, vb / 18, smem, p.hb, 1024, p.w_in_t, 1024, 1024, ABIN, EpiProj{p.projrw, p.projmla}); }
    grid.sync();
    VLOOP(2 * TT) {
        if (vb < TT) d_rw_shift(vb, 0, 0, smem, p.projrw, p.rw_mu, p.rb, p.kb, p.vb, p.twb, p.advb, p.sgb);
        else d_mla_pre(vb - TT, 0, 0, smem, p.projmla, p.mla_q_norm, p.mla_kv_norm, p.qcnb, p.ckvb, p.kpe, p.out_ckv, p.out_kpe);
        ENDV }
    grid.sync();
    {
        const int n0 = 4 * 96, n1 = 6 * 96, n2 = 8 * 96, n3 = 8 * 8;
        VLOOP(5 * n0 + n1 + n2 + n3) {
            int v = vb;
            if (v < n0) d_gemm_bf16(v % 4, v / 4, smem, p.twb, 64, p.w2_t, 64, 64, 512, EpiDecay{p.du0, p.rw_w0});
            else if ((v -= n0) < n0) d_gemm_bf16(v % 4, v / 4, smem, p.twb, 64, p.w2_t + 512 * 64, 64, 64, 512, EpiDecay{p.du1, p.rw_w0 + 512});
            else if ((v -= n0) < n0) d_gemm_bf16(v % 4, v / 4, smem, p.advb, 64, p.a2_t, 64, 64, 512, EpiLr{p.lr0, p.rw_a0});
            else if ((v -= n0) < n0) d_gemm_bf16(v % 4, v / 4, smem, p.advb, 64, p.a2_t + 512 * 64, 64, 64, 512, EpiLr{p.lr1, p.rw_a0 + 512});
            else if ((v -= n0) < n0) d_gemm_bf16(v % 4, v / 4, smem, p.sgb, 128, p.g2_t, 128, 128, 512, EpiStoreBf{p.gateb, 512, 0});
            else if ((v -= n0) < n1) d_gemm_bf16(v % 6, v / 6, smem, p.qcnb, 256, p.q_up_t, 256, 256, 768, EpiStoreBf{p.qrawb, 768, 0});
            else if ((v -= n1) < n2) d_gemm_bf16(v % 8, v / 8, smem, p.ckvb, 128, p.kv_up_t, 128, 128, 1024, EpiStoreBf{p.kvrawb, 1024, 0});
            else { v -= n2; d_gemm_bf16(v % 8, v / 8, smem, p.ctxb, 128, p.kv_up_t, 128, 128, 1024, EpiStoreBf{p.kvctxb, 1024, 0}); }
        }
    }
    grid.sync();
    VLOOP(2 * TT + TT + 1024) {
        if (vb < 2 * TT) d_rw_kk(vb, 0, 0, smem, p.rb, p.kb, p.lr0, p.lr1, p.rw_k_k, p.rw_k_a, p.rw_r_k, p.kkb, p.bonus);
        else d_mla_post(vb - 2 * TT, 0, 0, smem, p.qrawb, p.kvrawb, p.kvctxb, p.kpe, p.cache_kpe, p.mla_qn, p.mla_kn, p.Qb, p.Kp, p.Vp, p.Ks, p.Vs);
        ENDV }
    grid.sync();
    VLOOP(80) {
        if (vb < 16) d_scan(64 + vb, 0, 0, smem, p.rb, p.kb, p.vb, p.kkb, p.lr0, p.lr1, p.du0, p.du1, p.rw_k_a, p.st_f, p.st_b, p.y0, p.y1, p.out_sf, p.out_sb);
        else d_scan(vb - 16, 0, 0, smem, p.rb, p.kb, p.vb, p.kkb, p.lr0, p.lr1, p.du0, p.du1, p.rw_k_a, p.st_f, p.st_b, p.y0, p.y1, p.out_sf, p.out_sb);
        ENDV }
    grid.sync();
    VLOOP(256 + 128) {
        if (vb < 256) { d_attn_mfma(vb, smem, p.Qb, p.Ks, p.Vs, p.catb, TP, LS, 2304, 16); }
        else { d_attn_mfma(vb - 256, smem, p.Qb, p.Kp, p.Vp, p.catb, 0, LP, LP, 2); }
        ENDV }
    grid.sync();
    VLOOP(2 * TT) { d_rw_post(vb, 0, 0, smem, p.y0, p.y1, p.bonus, p.vb, p.gateb, p.rw_lnx_g, p.rw_lnx_b, p.catb); ENDV }
    grid.sync();
    VLOOP(8 * 96) { d_gemm_bf16(vb % 8, vb / 8, smem, p.catb, 1024, p.w_out_t, 1024, 1024, 1024, EpiResid{p.x_prompt, p.x_sample, p.xrun, mod0, 2, 0}); }
    grid.sync();
    peer_layer(p, grid, smem, 0, mod0, xrs);
    grid.sync();
    VLOOP(TT + LS + LP + 2048) {
        if (vb < TT) d_norm_mod(vb, 0, 0, smem, p.xrun, xrs, p.norm_g + 2048, mod1, 0, 1, p.hb);
        else if (vb < TT + LS) d_hy_filt(vb - TT, 0, 0, smem, LS, p.hy_f_w1, p.hy_f_b1, p.hy_f_w2, p.hy_f_b2, p.hy_f_w3, p.hy_f_freq, p.hfS, p.hbS);
        else if (vb < TT + LS + LP) d_hy_filt(vb - TT - LS, 0, 0, smem, LP, p.hy_f_w1, p.hy_f_b1, p.hy_f_w2, p.hy_f_b2, p.hy_f_w3, p.hy_f_freq, p.hfP, p.hbP);
        else if (vb < TT + LS + LP + 1024) d_cvt_bf16(vb - (TT + LS + LP), p.peer_u + (size_t)16384 * 1024, p.tabU);
        else d_cvt_bf16(vb - (TT + LS + LP + 1024), p.peer_v + (size_t)16384 * 1024, p.tabV);
        ENDV }
    grid.sync();
    VLOOP(24 * 96 + 8) {
        if (vb < 24 * 96) d_gemm_bf16(vb % 24, vb / 24, smem, p.hb, 1024, p.hy_w_in_t, 1024, 1024, 3072, EpiStore{p.pre, p.hy_b_in, 3072, 0});
        else if (vb < 24 * 96 + 4) { d_hy_norm(vb - 24 * 96, 0, 0, smem, LS, p.hfS, p.hbS, p.invS); ENDV }
        else { d_hy_norm(vb - 24 * 96 - 4, 0, 0, smem, LP, p.hfP, p.hbP, p.invP); ENDV }
    }
    grid.sync();
    VLOOP(TT) { d_hy_dw(vb, 0, 0, smem, p.pre, p.hy_conv_w, p.hy_conv_b, p.zin, p.x0b); ENDV }
    grid.sync();
    VLOOP(4 * 256 * 4 + 4 * 32 * 16) {
        if (vb < 4096) d_hy_conv(vb % 4, (vb / 4) % 256, vb / 1024, smem, LS, TP, p.zin, p.x0b, p.hfS, p.hbS, p.invS, p.hy_bias, p.zbb);
        else { int v = vb - 4096; d_hy_conv(v % 4, (v / 4) % 32, v / 128, smem, LP, 0, p.zin, p.x0b, p.hfP, p.hbP, p.invP, p.hy_bias, p.zbb); }
        ENDV }
    grid.sync();
    VLOOP(8 * 96) { d_gemm_bf16(vb % 8, vb / 8, smem, p.zbb, 1024, p.hy_w_out_t, 1024, 1024, 1024, EpiResid{p.xrun, xrs, p.xrun, mod1, 2, 0}); }
    grid.sync();
    peer_layer(p, grid, smem, 1, mod1, xrs);
}

static inline size_t align_up(size_t x) { return (x + 255) & ~(size_t)255; }

extern "C" void kernel_launch(void* const* d_in, const int* in_sizes, int n_in, void* d_out, int out_size, void* d_ws, size_t ws_size,
                              hipStream_t stream) {
    Params p{};
    const float** pin = (const float**)&p;
    for (int i = 0; i < 46; i++) pin[i] = (const float*)d_in[i];

    float* out = (float*)d_out;
    p.xrun = out;
    p.out_sf = out + (size_t)TT * DM;
    p.out_sb = p.out_sf + 16 * 8 * 64 * 64;
    p.out_ckv = p.out_sb + 16 * 8 * 64 * 64;
    p.out_kpe = p.out_ckv + 16 * 256 * 128;

    char* ws = (char*)d_ws;
    size_t off = 0;
    auto take = [&](size_t bytes) { char* q = ws + off; off = align_up(off + bytes); return q; };
    p.mod = (float*)take((size_t)2 * 5 * 6144 * 4);
    p.w_in_t = (bf16_t*)take((size_t)2304 * 1024 * 2);
    p.w_out_t = (bf16_t*)take((size_t)1024 * 1024 * 2);
    p.hy_w_in_t = (bf16_t*)take((size_t)3072 * 1024 * 2);
    p.hy_w_out_t = (bf16_t*)take((size_t)1024 * 1024 * 2);
    p.w_q_t = (bf16_t*)take((size_t)2 * 2048 * 1024 * 2);
    p.q_up_t = (bf16_t*)take((size_t)768 * 256 * 2);
    p.kv_up_t = (bf16_t*)take((size_t)1024 * 128 * 2);
    p.w2_t = (bf16_t*)take((size_t)2 * 512 * 64 * 2);
    p.a2_t = (bf16_t*)take((size_t)2 * 512 * 64 * 2);
    p.g2_t = (bf16_t*)take((size_t)512 * 128 * 2);
    p.ctxb = (bf16_t*)take((size_t)1024 * 128 * 2);
    p.keysb = (bf16_t*)take((size_t)2 * 16 * 128 * 128 * 2);
    p.tabU = (bf16_t*)take((size_t)16384 * 1024 * 2);
    p.tabV = (bf16_t*)take((size_t)16384 * 1024 * 2);
    char* R1 = take((size_t)TT * 1024 * 4);
    p.hb = (bf16_t*)R1; p.catb = (bf16_t*)R1; p.zbb = (bf16_t*)R1;
    p.kvrawb = (bf16_t*)R1;
    p.qrawb = (bf16_t*)(R1 + (size_t)TT * 1024 * 2);
    char* R2 = take((size_t)TT * RWIN * 2 + (size_t)TT * 448 * 4);
    p.projrw = (bf16_t*)R2;
    p.projmla = (float*)(R2 + (size_t)TT * RWIN * 2);
    p.y0 = (float*)R2; p.y1 = p.y0 + (size_t)TT * 512;
    p.qb = (bf16_t*)R2;
    char* R3 = ws + off;
    size_t o3 = 0;
    auto take3 = [&](size_t bytes) { char* q = R3 + o3; o3 = align_up(o3 + bytes); return q; };
    p.rb = (bf16_t*)take3((size_t)TT * 512 * 2);
    p.kb = (bf16_t*)take3((size_t)TT * 512 * 2);
    p.vb = (bf16_t*)take3((size_t)TT * 512 * 2);
    p.kkb = (bf16_t*)take3((size_t)TT * 512 * 2);
    p.lr0 = (bf16_t*)take3((size_t)TT * 512 * 2);
    p.lr1 = (bf16_t*)take3((size_t)TT * 512 * 2);
    p.gateb = (bf16_t*)take3((size_t)TT * 512 * 2);
    p.du0 = (_Float16*)take3((size_t)TT * 512 * 2);
    p.du1 = (_Float16*)take3((size_t)TT * 512 * 2);
    p.twb = (bf16_t*)take3((size_t)TT * 64 * 2);
    p.advb = (bf16_t*)take3((size_t)TT * 64 * 2);
    p.sgb = (bf16_t*)take3((size_t)TT * 128 * 2);
    p.bonus = (float*)take3((size_t)TT * 8 * 4);
    p.kpe = (float*)take3((size_t)TT * 64 * 4);
    p.qcnb = (bf16_t*)take3((size_t)TT * 256 * 2);
    p.ckvb = (bf16_t*)take3((size_t)TT * 128 * 2);
    p.Qb = (bf16_t*)take3((size_t)TT * 768 * 2);
    p.Kp = (bf16_t*)take3((size_t)16 * 4 * 256 * 192 * 2);
    p.Vp = (bf16_t*)take3((size_t)16 * 4 * 256 * 128 * 2);
    p.Ks = (bf16_t*)take3((size_t)4 * 4 * 2304 * 192 * 2);
    p.Vs = (bf16_t*)take3((size_t)4 * 4 * 2304 * 128 * 2);
    p.kvctxb = (bf16_t*)take3((size_t)1024 * 1024 * 2);
    p.pidx = (int*)take3((size_t)TT * 128 * 4);
    p.pg = (float*)take3((size_t)TT * 128 * 4);
    p.scT = (float*)R3;
    p.pre = (float*)R2;
    char* L1 = R2 + (size_t)TT * 3072 * 4;
    p.zin = (bf16_t*)L1;
    p.x0b = p.zin + (size_t)TT * 1024;
    p.hfS = (float*)(p.x0b + (size_t)TT * 1024);
    p.hbS = p.hfS + (size_t)LS * 1024;
    p.hfP = p.hbS + (size_t)LS * 1024;
    p.hbP = p.hfP + (size_t)LP * 1024;
    p.invS = p.hbP + (size_t)LP * 1024;
    p.invP = p.invS + 1024;

    static int grid_blocks = 0;
    if (!grid_blocks) {
        int dev = 0, cus = 0, per_cu = 0;
        (void)hipGetDevice(&dev);
        (void)hipDeviceGetAttribute(&cus, hipDeviceAttributeMultiprocessorCount, dev);
        (void)hipOccupancyMaxActiveBlocksPerMultiprocessor(&per_cu, mega, 256, 0);
        if (per_cu > 2) per_cu = 2;
        if (per_cu < 1) per_cu = 1;
        grid_blocks = cus * per_cu;
    }
    void* args[] = {&p};
    (void)hipLaunchCooperativeKernel((void*)mega, dim3(grid_blocks), dim3(256), args, 0, stream);
}
```

```cpp
#include <hip/hip_runtime.h>
#include <stdint.h>
#include <hip/hip_cooperative_groups.h>
namespace cg = cooperative_groups;

#define DM 1024
#define TP 4096
#define TS 8192
#define TT 12288
#define LP 256
#define LS 2048
#define NBP 16
#define NBS 4
#define ABIN 2240
#define RWIN 1792

typedef unsigned short bf16_t;
__device__ __forceinline__ bf16_t f2bf(float f) { unsigned u = __float_as_uint(f); u += 0x7fffu + ((u >> 16) & 1u); return (bf16_t)(u >> 16); }
__device__ __forceinline__ float bf2f(bf16_t h) { return __uint_as_float(((unsigned)h) << 16); }
__device__ __forceinline__ float sigmoidf_(float x) { return 1.f / (1.f + expf(-x)); }
__device__ __forceinline__ float gelu_tanh(float x) { return 0.5f * x * (1.f + tanhf(0.7978845608028654f * (x + 0.044715f * x * x * x))); }

__device__ __forceinline__ int tok_pos(int t) { return t < TP ? (t & (LP - 1)) : ((t - TP) & (LS - 1)); }
__device__ __forceinline__ int tok_len(int t) { return t < TP ? LP : LS; }
__device__ __forceinline__ int tok_modrow(int t) { return t < TP ? 0 : 1 + ((t - TP) >> 11); }

__device__ __forceinline__ float wave_sum(float v) {
#pragma unroll
    for (int o = 32; o > 0; o >>= 1) v += __shfl_xor(v, o, 64);
    return v;
}

__device__ __forceinline__ void d_mod(const int bx, const int by, const int bz, char* smem, const float* __restrict__ c, const float* __restrict__ c_ctx, const float* __restrict__ w_mod,
                                             const float* __restrict__ b_mod, float* __restrict__ mod) {
    float (*s)[1024] = (float(*)[1024])smem;
    const int li = by;
    const int n = bx * 256 + threadIdx.x;
    for (int i = threadIdx.x; i < 5 * 1024; i += 256) {
        int r = i >> 10, k = i & 1023;
        float v = (r == 0) ? c_ctx[k] : c[(r - 1) * 1024 + k];
        s[r][k] = v / (1.f + expf(-v));
    }
    __syncthreads();
    float a0 = 0, a1 = 0, a2 = 0, a3 = 0, a4 = 0;
    const float* w = w_mod + (size_t)li * 1024 * 6144 + n;
    for (int k = 0; k < 1024; k++) {
        float wv = w[(size_t)k * 6144];
        a0 += s[0][k] * wv; a1 += s[1][k] * wv; a2 += s[2][k] * wv; a3 += s[3][k] * wv; a4 += s[4][k] * wv;
    }
    float bb = b_mod[li * 6144 + n];
    float* o = mod + (size_t)li * 5 * 6144 + n;
    o[0 * 6144] = a0 + bb; o[1 * 6144] = a1 + bb; o[2 * 6144] = a2 + bb; o[3 * 6144] = a3 + bb; o[4 * 6144] = a4 + bb;
}

__device__ __forceinline__ void d_norm_mod(const int bx, const int by, const int bz, char* smem, const float* __restrict__ xa, const float* __restrict__ xb, const float* __restrict__ g,
                                                  const float* __restrict__ modl, int shift_idx, int scale_idx, bf16_t* __restrict__ h) {
    float* red = (float*)smem;
    const int t = bx;
    const float* x = (t < TP) ? (xa + (size_t)t * DM) : (xb + (size_t)(t - TP) * DM);
    const int c = threadIdx.x * 4;
    float4 v = *(const float4*)(x + c);
    float ss = v.x * v.x + v.y * v.y + v.z * v.z + v.w * v.w;
    ss = wave_sum(ss);
    if ((threadIdx.x & 63) == 0) red[threadIdx.x >> 6] = ss;
    __syncthreads();
    float tot = red[0] + red[1] + red[2] + red[3];
    float rstd = rsqrtf(tot * (1.f / DM) + 1e-6f);
    const float* m = modl + (size_t)tok_modrow(t) * 6144;
    float4 gg = *(const float4*)(g + c);
    float4 sh = *(const float4*)(m + shift_idx * 1024 + c);
    float4 sc = *(const float4*)(m + scale_idx * 1024 + c);
    float4 o;
    o.x = v.x * rstd * gg.x * (1.f + sc.x) + sh.x;
    o.y = v.y * rstd * gg.y * (1.f + sc.y) + sh.y;
    o.z = v.z * rstd * gg.z * (1.f + sc.z) + sh.z;
    o.w = v.w * rstd * gg.w * (1.f + sc.w) + sh.w;
    ushort4 ob; ob.x = f2bf(o.x); ob.y = f2bf(o.y); ob.z = f2bf(o.z); ob.w = f2bf(o.w);
    *(ushort4*)(h + (size_t)t * DM + c) = ob;
}

struct EpiStore { float* C; const float* bias; int ldc; int pad;
    __device__ void operator()(int m, int n, float a) const { C[(size_t)m * ldc + n] = a + (bias ? bias[n] : 0.f); } };
struct EpiStoreBf { bf16_t* C; int ldc; int pad;
    __device__ void operator()(int m, int n, float a) const { C[(size_t)m * ldc + n] = f2bf(a); } };
struct EpiDecay { _Float16* out; const float* w0;
    __device__ void operator()(int m, int n, float a) const { out[(size_t)m * 512 + n] = (_Float16)sigmoidf_(w0[n] + a); } };
struct EpiProj { bf16_t* rw; float* mla;
    __device__ void operator()(int m, int n, float a) const { if (n < RWIN) rw[(size_t)m * RWIN + n] = f2bf(a); else mla[(size_t)m * 448 + (n - RWIN)] = a; } };
struct EpiLr { bf16_t* out; const float* a0;
    __device__ void operator()(int m, int n, float a) const { out[(size_t)m * 512 + n] = f2bf(sigmoidf_(a0[n] + a)); } };
struct EpiResid { const float* xa; const float* xb; float* out; const float* modl; int gate_idx; int pad;
    __device__ void operator()(int m, int n, float a) const {
        float x = (m < TP) ? xa[(size_t)m * DM + n] : xb[(size_t)(m - TP) * DM + n];
        float gt = modl[(size_t)tok_modrow(m) * 6144 + gate_idx * 1024 + n];
        out[(size_t)m * DM + n] = x + gt * a; } };

template <class Epi>
__device__ __forceinline__ void d_gemm(const int bx, const int by, const int bz, char* smem, const float* __restrict__ A, int lda, const float* __restrict__ B, int ldb, int K, Epi epi) {
    float (*As)[68] = (float(*)[68])smem;
    float (*Bs)[68] = (float(*)[68])(smem + 16 * 68 * 4);
    const int m0 = by * 64, n0 = bx * 64;
    const int tid = threadIdx.x, tx = tid & 15, ty = tid >> 4;
    float acc[4][4];
#pragma unroll
    for (int i = 0; i < 4; i++)
#pragma unroll
        for (int j = 0; j < 4; j++) acc[i][j] = 0.f;
    for (int k0 = 0; k0 < K; k0 += 16) {
        {
            int r = tid >> 2, kq = (tid & 3) * 4;
            float4 v = *(const float4*)(A + (size_t)(m0 + r) * lda + k0 + kq);
            As[kq + 0][r] = v.x; As[kq + 1][r] = v.y; As[kq + 2][r] = v.z; As[kq + 3][r] = v.w;
        }
        {
            int kk = tid >> 4, nq = (tid & 15) * 4;
            float4 v = *(const float4*)(B + (size_t)(k0 + kk) * ldb + n0 + nq);
            *(float4*)&Bs[kk][nq] = v;
        }
        __syncthreads();
#pragma unroll
        for (int k = 0; k < 16; k++) {
            float a[4], b[4];
#pragma unroll
            for (int i = 0; i < 4; i++) a[i] = As[k][ty * 4 + i];
            float4 bv = *(const float4*)&Bs[k][tx * 4];
            b[0] = bv.x; b[1] = bv.y; b[2] = bv.z; b[3] = bv.w;
#pragma unroll
            for (int i = 0; i < 4; i++)
#pragma unroll
                for (int j = 0; j < 4; j++) acc[i][j] += a[i] * b[j];
        }
        __syncthreads();
    }
#pragma unroll
    for (int i = 0; i < 4; i++)
#pragma unroll
        for (int j = 0; j < 4; j++) epi(m0 + ty * 4 + i, n0 + tx * 4 + j, acc[i][j]);
}


typedef __attribute__((ext_vector_type(8))) short bf16x8;
typedef __attribute__((ext_vector_type(16))) float f32x16;
typedef __attribute__((ext_vector_type(4))) float f32x4;
typedef __attribute__((ext_vector_type(4))) unsigned u32x4;
#define GEMM_LDS_BYTES 73728

template <class Epi>
__device__ __forceinline__ void d_gemm_bf16(const int bx, const int by, char* smem, const bf16_t* __restrict__ A, int lda,
                                            const bf16_t* __restrict__ Bt, int ldb, int K, int N, Epi epi) {
    const int tid = threadIdx.x, lane = tid & 63, wid = tid >> 6;
    const int wm = wid >> 1, wn = wid & 1;
    const int m0 = by * 128, n0 = bx * 128;
    f32x16 acc[2][2];
#pragma unroll
    for (int i = 0; i < 2; i++)
#pragma unroll
        for (int j = 0; j < 2; j++)
#pragma unroll
            for (int r = 0; r < 16; r++) acc[i][j][r] = 0.f;
    const int lrow = tid >> 3, lcol = (tid & 7) * 8;
    const bf16_t* ga = A + (size_t)(m0 + lrow) * lda + lcol;
    const bf16_t* gb = Bt + (size_t)(n0 + lrow) * ldb + lcol;
    u32x4 ra[4], rb[4];
    const int KT = K >> 6;
#pragma unroll
    for (int i = 0; i < 4; i++) { ra[i] = *(const u32x4*)(ga + (size_t)(32 * i) * lda); rb[i] = *(const u32x4*)(gb + (size_t)(32 * i) * ldb); }
    {
        char* sa = smem;
#pragma unroll
        for (int i = 0; i < 4; i++) { *(u32x4*)(sa + (lrow + 32 * i) * 144 + lcol * 2) = ra[i]; *(u32x4*)(sa + 18432 + (lrow + 32 * i) * 144 + lcol * 2) = rb[i]; }
    }
    __syncthreads();
    const int frow = lane & 31, fk = (lane >> 5) * 16;
    for (int kt = 0; kt < KT; kt++) {
        if (kt + 1 < KT) {
#pragma unroll
            for (int i = 0; i < 4; i++) { ra[i] = *(const u32x4*)(ga + (size_t)(32 * i) * lda + (kt + 1) * 64); rb[i] = *(const u32x4*)(gb + (size_t)(32 * i) * ldb + (kt + 1) * 64); }
        }
        const char* sa = smem + (kt & 1) * 36864;
        const char* sb = sa + 18432;
#pragma unroll
        for (int ks = 0; ks < 4; ks++) {
            bf16x8 af[2], bfr[2];
#pragma unroll
            for (int i = 0; i < 2; i++) af[i] = *(const bf16x8*)(sa + (wm * 64 + i * 32 + frow) * 144 + ks * 32 + fk);
#pragma unroll
            for (int j = 0; j < 2; j++) bfr[j] = *(const bf16x8*)(sb + (wn * 64 + j * 32 + frow) * 144 + ks * 32 + fk);
#pragma unroll
            for (int i = 0; i < 2; i++)
#pragma unroll
                for (int j = 0; j < 2; j++) acc[i][j] = __builtin_amdgcn_mfma_f32_32x32x16_bf16(af[i], bfr[j], acc[i][j], 0, 0, 0);
        }
        if (kt + 1 < KT) {
            char* sn = smem + ((kt + 1) & 1) * 36864;
#pragma unroll
            for (int i = 0; i < 4; i++) { *(u32x4*)(sn + (lrow + 32 * i) * 144 + lcol * 2) = ra[i]; *(u32x4*)(sn + 18432 + (lrow + 32 * i) * 144 + lcol * 2) = rb[i]; }
        }
        __syncthreads();
    }
#pragma unroll
    for (int i = 0; i < 2; i++)
#pragma unroll
        for (int j = 0; j < 2; j++) {
            const int col = n0 + wn * 64 + j * 32 + (lane & 31);
            if (col < N) {
#pragma unroll
                for (int r = 0; r < 16; r++) {
                    const int row = m0 + wm * 64 + i * 32 + (r & 3) + 8 * (r >> 2) + 4 * (lane >> 5);
                    epi(row, col, acc[i][j][r]);
                }
            }
        }
}

__device__ __forceinline__ void d_transpose_w(const int vb, char* smem, const float* __restrict__ W, int K, int N, bf16_t* __restrict__ Wt) {
    float (*tile)[65] = (float(*)[65])smem;
    const int kt = K >> 6;
    const int nb = vb / kt, kb = vb % kt;
    const int tid = threadIdx.x;
    {
        const int n = nb * 64 + (tid & 63);
#pragma unroll
        for (int i = 0; i < 16; i++) {
            int k = (tid >> 6) + 4 * i;
            tile[k][tid & 63] = (n < N) ? W[(size_t)(kb * 64 + k) * N + n] : 0.f;
        }
    }
    __syncthreads();
    {
        const int k = tid & 63;
#pragma unroll
        for (int i = 0; i < 16; i++) {
            int n = (tid >> 6) + 4 * i;
            Wt[(size_t)(nb * 64 + n) * K + kb * 64 + k] = f2bf(tile[k][n]);
        }
    }
}

__device__ __forceinline__ void d_rw_shift(const int bx, const int by, const int bz, char* smem, const bf16_t* __restrict__ proj, const float* __restrict__ mu, bf16_t* __restrict__ rb,
                                                  bf16_t* __restrict__ kb, bf16_t* __restrict__ vb, bf16_t* __restrict__ tw, bf16_t* __restrict__ adv,
                                                  bf16_t* __restrict__ sg) {
    const int t = bx;
    const int pos = tok_pos(t), L = tok_len(t);
    const bf16_t* P = proj + (size_t)t * RWIN;
    for (int c = threadIdx.x; c < RWIN; c += 256) {
        float cur = bf2f(P[c]);
        float prev = (pos > 0) ? bf2f(P[c - RWIN]) : 0.f;
        float nxt = (pos < L - 1) ? bf2f(P[c + RWIN]) : 0.f;
        float val = cur + mu[c] * (0.5f * (prev + nxt) - cur);
        if (c < 512) rb[(size_t)t * 512 + c] = f2bf(val);
        else if (c < 1024) kb[(size_t)t * 512 + c - 512] = f2bf(val);
        else if (c < 1536) vb[(size_t)t * 512 + c - 1024] = f2bf(val);
        else if (c < 1600) tw[(size_t)t * 64 + c - 1536] = f2bf(tanhf(val));
        else if (c < 1664) adv[(size_t)t * 64 + c - 1600] = f2bf(val);
        else sg[(size_t)t * 128 + c - 1664] = f2bf(sigmoidf_(val));
    }
}

__device__ __forceinline__ void d_rw_kk(const int bx, const int by, const int bz, char* smem, const bf16_t* __restrict__ rb, const bf16_t* __restrict__ kb, const bf16_t* __restrict__ lr0,
                                               const bf16_t* __restrict__ lr1, const float* __restrict__ k_k, const float* __restrict__ k_a,
                                               const float* __restrict__ r_k, bf16_t* __restrict__ kkb, float* __restrict__ bonus) {
    const int w = bx * 4 + (threadIdx.x >> 6);
    const int lane = threadIdx.x & 63;
    const int t = w >> 3, h = w & 7;
    const size_t o = (size_t)t * 512 + h * 64 + lane;
    const int ch = h * 64 + lane;
    float k = bf2f(kb[o]), r = bf2f(rb[o]);
    float kk = k * k_k[ch];
    float nrm = sqrtf(wave_sum(kk * kk));
    kk = kk / fmaxf(nrm, 1e-12f);
    kkb[o] = f2bf(kk);
    float l0 = bf2f(lr0[o]), l1 = bf2f(lr1[o]);
    float ka = k_a[ch];
    float kd0 = k * (1.f + (l0 - 1.f) * ka), kd1 = k * (1.f + (l1 - 1.f) * ka);
    float s = wave_sum(r * (kd0 + kd1) * r_k[ch]);
    if (lane == 0) bonus[w] = s;
}

__device__ __forceinline__ void d_scan(const int bx, const int by, const int bz, char* smem, const bf16_t* __restrict__ rb, const bf16_t* __restrict__ kb, const bf16_t* __restrict__ vb,
                                             const bf16_t* __restrict__ kkb, const bf16_t* __restrict__ lr0, const bf16_t* __restrict__ lr1,
                                             const _Float16* __restrict__ dec0, const _Float16* __restrict__ dec1, const float* __restrict__ k_a,
                                             const float* __restrict__ st_f, const float* __restrict__ st_b, float* __restrict__ y0,
                                             float* __restrict__ y1, float* __restrict__ out_sf, float* __restrict__ out_sb) {
    float* sbase = (float*)smem + (threadIdx.x >> 6) * 320;
    float* sa_ = sbase; float* sw_ = sbase + 64; float* sb_ = sbase + 128; float* skd_ = sbase + 192; float* sr_ = sbase + 256;
    int id = bx * 4 + (threadIdx.x >> 6);
    int d, h, b, L, tbase;
    bool prompt = id < 256;
    if (prompt) { d = id & 1; h = (id >> 1) & 7; b = id >> 4; L = LP; tbase = b * LP; }
    else { int j = id - 256; d = j & 1; h = (j >> 1) & 7; b = j >> 4; L = LS; tbase = TP + b * LS; }
    const int v = threadIdx.x & 63;
    const bf16_t* lr = d ? lr1 : lr0;
    const _Float16* dec = d ? dec1 : dec0;
    float* yo = d ? y1 : y0;
    const float ka = k_a[h * 64 + v];
    float S[64];
    if (prompt) {
#pragma unroll
        for (int k = 0; k < 64; k++) S[k] = 0.f;
    } else {
        const float* st = (d ? st_b : st_f) + ((size_t)(b * 8 + h) * 64 + v) * 64;
#pragma unroll
        for (int k = 0; k < 64; k += 4) { float4 q = *(const float4*)(st + k); S[k] = q.x; S[k + 1] = q.y; S[k + 2] = q.z; S[k + 3] = q.w; }
    }
    for (int i = 0; i < L; i++) {
        const int t = tbase + (d ? (L - 1 - i) : i);
        const size_t o = (size_t)t * 512 + h * 64 + v;
        float kkv = bf2f(kkb[o]), lrv = bf2f(lr[o]), kv = bf2f(kb[o]), rv = bf2f(rb[o]), vv = bf2f(vb[o]), wv = __expf(-0.6065306597126334f * (float)dec[o]);
        __builtin_amdgcn_wave_barrier();
        sa_[v] = -kkv; sb_[v] = kkv * lrv; skd_[v] = kv * (1.f + (lrv - 1.f) * ka); sw_[v] = wv; sr_[v] = rv;
        __builtin_amdgcn_wave_barrier();
        float sa = 0.f;
#pragma unroll
        for (int k = 0; k < 64; k += 4) { float4 a = *(const float4*)&sa_[k]; sa += S[k] * a.x + S[k + 1] * a.y + S[k + 2] * a.z + S[k + 3] * a.w; }
        float y = 0.f;
#pragma unroll
        for (int k = 0; k < 64; k += 4) {
            float4 w4 = *(const float4*)&sw_[k]; float4 b4 = *(const float4*)&sb_[k]; float4 k4 = *(const float4*)&skd_[k]; float4 r4 = *(const float4*)&sr_[k];
            S[k] = S[k] * w4.x + sa * b4.x + vv * k4.x; y += S[k] * r4.x;
            S[k + 1] = S[k + 1] * w4.y + sa * b4.y + vv * k4.y; y += S[k + 1] * r4.y;
            S[k + 2] = S[k + 2] * w4.z + sa * b4.z + vv * k4.z; y += S[k + 2] * r4.z;
            S[k + 3] = S[k + 3] * w4.w + sa * b4.w + vv * k4.w; y += S[k + 3] * r4.w;
        }
        yo[o] = y;
    }
    if (prompt) {
        float* os = (d ? out_sb : out_sf) + ((size_t)(b * 8 + h) * 64 + v) * 64;
#pragma unroll
        for (int k = 0; k < 64; k += 4) *(float4*)(os + k) = make_float4(S[k], S[k + 1], S[k + 2], S[k + 3]);
    }
}


#define SC_STEP 336
template <int CTRL>
__device__ __forceinline__ float dpp_add(float v) {
    return v + __int_as_float(__builtin_amdgcn_update_dpp(0, __float_as_int(v), CTRL, 0xf, 0xf, false));
}
__device__ __forceinline__ float row16_allsum(float v) {
    v = dpp_add<0x128>(v); v = dpp_add<0x124>(v); v = dpp_add<0x122>(v); v = dpp_add<0x121>(v);
    return v;
}
__device__ __forceinline__ void d_scan2(const int item, const bool sample, char* smem, const bf16_t* __restrict__ rb, const bf16_t* __restrict__ kb,
                                        const bf16_t* __restrict__ vb, const bf16_t* __restrict__ kkb, const bf16_t* __restrict__ lr0,
                                        const bf16_t* __restrict__ lr1, const _Float16* __restrict__ du0, const _Float16* __restrict__ du1,
                                        const float* __restrict__ k_a, const float* __restrict__ st_f, const float* __restrict__ st_b,
                                        float* __restrict__ y0, float* __restrict__ y1, float* __restrict__ out_sf, float* __restrict__ out_sb) {
    const int chain = item >> 2, qd = item & 3;
    const int d = chain & 1, h = (chain >> 1) & 7, b = chain >> 4;
    const int L = sample ? LS : LP;
    const int tbase = sample ? (TP + b * LS) : (b * LP);
    const int tid = threadIdx.x, wid = tid >> 6, lane = tid & 63;
    const int rr = lane >> 4, pp = lane & 15;
    const int row = qd * 16 + wid * 4 + rr;
    const bf16_t* lr = d ? lr1 : lr0;
    const _Float16* du = d ? du1 : du0;
    float* yo = d ? y1 : y0;
    float S0, S1, S2, S3;
    if (sample) {
        const float4 s4 = *(const float4*)((d ? st_b : st_f) + ((size_t)(b * 8 + h) * 64 + row) * 64 + pp * 4);
        S0 = s4.x; S1 = s4.y; S2 = s4.z; S3 = s4.w;
    } else { S0 = S1 = S2 = S3 = 0.f; }
    const int sk = tid & 63, ss = tid >> 6;
    const float ka = k_a[h * 64 + sk];
    const size_t colk = (size_t)h * 64 + sk;
    const size_t colv = (size_t)h * 64 + qd * 16 + (tid & 15);
    float* buf = (float*)smem;
    unsigned short g_kk[4], g_lr[4], g_k[4], g_r[4]; _Float16 g_u[4]; unsigned short g_v;
    const int nch = L >> 4;
#define SC_GLOAD(c)                                                                                        \
    {                                                                                                      \
        _Pragma("unroll") for (int j = 0; j < 4; j++) {                                                    \
            const int i = (c) * 16 + ss + 4 * j;                                                           \
            const size_t o = (size_t)(tbase + (d ? (L - 1 - i) : i)) * 512 + colk;                         \
            g_kk[j] = kkb[o]; g_lr[j] = lr[o]; g_k[j] = kb[o]; g_r[j] = rb[o]; g_u[j] = du[o];             \
        }                                                                                                  \
        { const int i = (c) * 16 + (tid >> 4); g_v = vb[(size_t)(tbase + (d ? (L - 1 - i) : i)) * 512 + colv]; } \
    }
#define SC_SSTORE(bi)                                                                                      \
    {                                                                                                      \
        float* B_ = buf + (bi) * 16 * SC_STEP;                                                             \
        _Pragma("unroll") for (int j = 0; j < 4; j++) {                                                    \
            float* st_ = B_ + (ss + 4 * j) * SC_STEP + sk;                                                 \
            const float kkv = bf2f(g_kk[j]), lrv = bf2f(g_lr[j]), kv = bf2f(g_k[j]);                       \
            st_[0] = -kkv; st_[64] = __expf(-0.6065306597126334f * (float)g_u[j]); st_[128] = kkv * lrv;   \
            st_[192] = kv * (1.f + (lrv - 1.f) * ka); st_[256] = bf2f(g_r[j]);                             \
        }                                                                                                  \
        B_[(tid >> 4) * SC_STEP + 320 + (tid & 15)] = bf2f(g_v);                                           \
    }
    SC_GLOAD(0)
    SC_SSTORE(0)
    __syncthreads();
    for (int c = 0; c < nch; c++) {
        if (c + 1 < nch) SC_GLOAD(c + 1)
        const float* B_ = buf + (c & 1) * 16 * SC_STEP;
#pragma unroll 4
        for (int s_ = 0; s_ < 16; s_++) {
            const float* st_ = B_ + s_ * SC_STEP;
            const float4 a4 = *(const float4*)(st_ + pp * 4);
            const float4 w4 = *(const float4*)(st_ + 64 + pp * 4);
            const float4 b4 = *(const float4*)(st_ + 128 + pp * 4);
            const float4 k4 = *(const float4*)(st_ + 192 + pp * 4);
            const float4 r4 = *(const float4*)(st_ + 256 + pp * 4);
            const float vv = st_[320 + wid * 4 + rr];
            float sa = (S0 * a4.x + S1 * a4.y) + (S2 * a4.z + S3 * a4.w);
            sa = row16_allsum(sa);
            S0 = S0 * w4.x + (sa * b4.x + vv * k4.x);
            S1 = S1 * w4.y + (sa * b4.y + vv * k4.y);
            S2 = S2 * w4.z + (sa * b4.z + vv * k4.z);
            S3 = S3 * w4.w + (sa * b4.w + vv * k4.w);
            float y = (S0 * r4.x + S1 * r4.y) + (S2 * r4.z + S3 * r4.w);
            y = row16_allsum(y);
            if (pp == 0) {
                const int i = c * 16 + s_;
                yo[(size_t)(tbase + (d ? (L - 1 - i) : i)) * 512 + h * 64 + row] = y;
            }
        }
        if (c + 1 < nch) SC_SSTORE((c + 1) & 1)
        __syncthreads();
    }
    if (!sample) {
        float* os = (d ? out_sb : out_sf) + ((size_t)(b * 8 + h) * 64 + row) * 64 + pp * 4;
        *(float4*)os = make_float4(S0, S1, S2, S3);
    }
}

__device__ __forceinline__ void d_rw_post(const int bx, const int by, const int bz, char* smem, const float* __restrict__ y0, const float* __restrict__ y1, const float* __restrict__ bonus,
                                                 const bf16_t* __restrict__ vb, const bf16_t* __restrict__ gate, const float* __restrict__ lnx_g,
                                                 const float* __restrict__ lnx_b, bf16_t* __restrict__ cat) {
    const int w = bx * 4 + (threadIdx.x >> 6);
    const int lane = threadIdx.x & 63;
    const int t = w >> 3, h = w & 7;
    const size_t o = (size_t)t * 512 + h * 64 + lane;
    const int ch = h * 64 + lane;
    float y = y0[o] + y1[o];
    float mean = wave_sum(y) * (1.f / 64.f);
    float dlt = y - mean;
    float var = wave_sum(dlt * dlt) * (1.f / 64.f);
    float yn = dlt * rsqrtf(var + 64e-5f) * lnx_g[ch] + lnx_b[ch];
    float val = (yn + bonus[w] * bf2f(vb[o])) * bf2f(gate[o]);
    cat[(size_t)t * DM + ch] = f2bf(val);
}

__device__ __forceinline__ void d_mla_pre(const int bx, const int by, const int bz, char* smem, const float* __restrict__ proj, const float* __restrict__ q_norm, const float* __restrict__ kv_norm,
                                                 bf16_t* __restrict__ qcn, bf16_t* __restrict__ ckv, float* __restrict__ kpe,
                                                 float* __restrict__ out_ckv, float* __restrict__ out_kpe) {
    float* red = (float*)smem; float* red2 = red + 4;
    const int t = bx;
    const int tid = threadIdx.x;
    const float* P = proj + (size_t)t * 448;
    float q = P[tid];
    float kv = (tid < 128) ? P[256 + tid] : 0.f;
    float ss = wave_sum(q * q);
    float s2 = wave_sum(kv * kv);
    if ((tid & 63) == 0) { red[tid >> 6] = ss; red2[tid >> 6] = s2; }
    __syncthreads();
    float rq = rsqrtf((red[0] + red[1] + red[2] + red[3]) * (1.f / 256.f) + 1e-6f);
    float rk = rsqrtf((red2[0] + red2[1] + red2[2] + red2[3]) * (1.f / 128.f) + 1e-6f);
    qcn[(size_t)t * 256 + tid] = f2bf(q * rq * q_norm[tid]);
    if (tid < 128) {
        float val = kv * rk * kv_norm[tid];
        ckv[(size_t)t * 128 + tid] = f2bf(val);
        if (t < TP) out_ckv[(size_t)t * 128 + tid] = val;
    } else if (tid < 192) {
        float pe = P[384 + tid - 128];
        kpe[(size_t)t * 64 + tid - 128] = pe;
        if (t < TP) out_kpe[(size_t)t * 64 + tid - 128] = pe;
    }
}

__device__ __forceinline__ void d_mla_post(const int bx, const int by, const int bz, char* smem, const bf16_t* __restrict__ qraw, const bf16_t* __restrict__ kvraw, const bf16_t* __restrict__ kvraw_ctx,
                                                  const float* __restrict__ kpe, const float* __restrict__ cache_kpe, const float* __restrict__ qn,
                                                  const float* __restrict__ kn, bf16_t* __restrict__ Qb, bf16_t* __restrict__ Kp, bf16_t* __restrict__ Vp,
                                                  bf16_t* __restrict__ Ks, bf16_t* __restrict__ Vs) {
    float (*sq)[192] = (float(*)[192])smem; float (*sk)[192] = (float(*)[192])(smem + 4 * 192 * 4);
    const int wi = threadIdx.x >> 6, lane = threadIdx.x & 63;
    const int row = bx, h = wi;
    const bool isctx = row >= TT;
    const bool sample = row >= TP;
    float kx[3], qx[3] = {0.f, 0.f, 0.f};
    const bf16_t* kvr; const float* pe; int pos = 0;
    if (isctx) { int cr = row - TT; kvr = kvraw_ctx + (size_t)cr * 1024; pe = cache_kpe + (size_t)cr * 64; }
    else { kvr = kvraw + (size_t)row * 1024; pe = kpe + (size_t)row * 64; pos = tok_pos(row); }
#pragma unroll
    for (int j = 0; j < 3; j++) {
        int i = lane + 64 * j;
        kx[j] = (i < 128) ? bf2f(kvr[h * 256 + i]) : pe[i - 128];
        if (!isctx) qx[j] = bf2f(qraw[(size_t)row * 768 + h * 192 + i]);
    }
    float ssk = wave_sum(kx[0] * kx[0] + kx[1] * kx[1] + kx[2] * kx[2]);
    float ssq = wave_sum(qx[0] * qx[0] + qx[1] * qx[1] + qx[2] * qx[2]);
    float rk = rsqrtf(ssk * (1.f / 192.f) + 1e-6f), rq = rsqrtf(ssq * (1.f / 192.f) + 1e-6f);
#pragma unroll
    for (int j = 0; j < 3; j++) {
        int i = lane + 64 * j;
        sk[wi][i] = kx[j] * rk * kn[i];
        sq[wi][i] = qx[j] * rq * qn[i];
    }
    __syncthreads();
    if (sample && !isctx && lane < 32) {
        int rowi = pos >> 6, coli = pos & 63;
        int fi = lane & 15;
        float inv = expf(-(float)fi * (1.f / 16.f) * 9.210340371976184f);
        float ang = (lane < 16 ? (float)rowi : (float)coli) * inv;
        float cs = cosf(ang), sn = sinf(ang);
        float a = sk[wi][128 + 2 * lane], bq = sk[wi][128 + 2 * lane + 1];
        sk[wi][128 + 2 * lane] = a * cs - bq * sn; sk[wi][128 + 2 * lane + 1] = a * sn + bq * cs;
        a = sq[wi][128 + 2 * lane]; bq = sq[wi][128 + 2 * lane + 1];
        sq[wi][128 + 2 * lane] = a * cs - bq * sn; sq[wi][128 + 2 * lane + 1] = a * sn + bq * cs;
    }
    __syncthreads();
    bf16_t* kd; bf16_t* vd; int vLk, kidx;
    if (!sample) { int b = row >> 8, p = row & 255; kd = Kp + ((size_t)(b * 4 + h) * LP + p) * 192; vd = Vp + (size_t)(b * 4 + h) * 128 * LP; vLk = LP; kidx = p; }
    else if (!isctx) { int b = (row - TP) >> 11, p = (row - TP) & 2047; kd = Ks + ((size_t)(b * 4 + h) * 2304 + 256 + p) * 192; vd = Vs + (size_t)(b * 4 + h) * 128 * 2304; vLk = 2304; kidx = 256 + p; }
    else { int cr = row - TT; int b = cr >> 8, p = cr & 255; kd = Ks + ((size_t)(b * 4 + h) * 2304 + p) * 192; vd = Vs + (size_t)(b * 4 + h) * 128 * 2304; vLk = 2304; kidx = p; }
    const int kpos = (kidx & ~12) | ((kidx & 8) >> 1) | ((kidx & 4) << 1);
#pragma unroll
    for (int j = 0; j < 3; j++) {
        int i = lane + 64 * j;
        kd[i] = f2bf(sk[wi][i]);
        if (!isctx) Qb[((size_t)row * 4 + h) * 192 + i] = f2bf(sq[wi][i]);
    }
    vd[(size_t)lane * vLk + kpos] = kvr[h * 256 + 128 + lane];
    vd[(size_t)(lane + 64) * vLk + kpos] = kvr[h * 256 + 128 + lane + 64];
}

__device__ __forceinline__ void d_attn(const int bx, const int by, const int bz, char* smem, const bf16_t* __restrict__ Qb, const bf16_t* __restrict__ Kall, const bf16_t* __restrict__ Vall,
                                              bf16_t* __restrict__ cat, int tbase, int Lq, int Lk) {
    float (*Vsm)[128] = (float(*)[128])smem;
    float (*Qs)[192] = (float(*)[192])(smem + 32 * 128 * 4);
    float (*Ksm)[193] = (float(*)[193])(smem + 32 * 128 * 4 + 16 * 192 * 4);
    float (*Ss)[33] = (float(*)[33])(smem + 32 * 128 * 4 + 16 * 192 * 4 + 32 * 193 * 4);
    const int q0 = bx * 16, h = by, b = bz;
    const int tid = threadIdx.x;
    const int qi = tid >> 4, sub = tid & 15;
    const bf16_t* K = Kall + (size_t)(b * 4 + h) * Lk * 192;
    const bf16_t* V = Vall + (size_t)(b * 4 + h) * Lk * 128;
    for (int i = tid; i < 16 * 192; i += 256) {
        int r = i / 192, c = i % 192;
        int t = tbase + b * Lq + q0 + r;
        Qs[r][c] = bf2f(Qb[((size_t)t * 4 + h) * 192 + c]);
    }
    float m = -1e30f, l = 0.f;
    float acc[8];
#pragma unroll
    for (int j = 0; j < 8; j++) acc[j] = 0.f;
    const float scale = 0.07216878364870322f;
    for (int k0 = 0; k0 < Lk; k0 += 32) {
        __syncthreads();
        for (int i = tid; i < 32 * 192; i += 256) { int r = i / 192, c = i % 192; Ksm[r][c] = bf2f(K[(size_t)(k0 + r) * 192 + c]); }
        for (int i = tid; i < 32 * 128; i += 256) { int r = i >> 7, c = i & 127; Vsm[r][c] = bf2f(V[(size_t)(k0 + r) * 128 + c]); }
        __syncthreads();
        float s0 = 0.f, s1 = 0.f;
        for (int dd = 0; dd < 192; dd++) { float qv = Qs[qi][dd]; s0 += qv * Ksm[sub][dd]; s1 += qv * Ksm[sub + 16][dd]; }
        s0 *= scale; s1 *= scale;
        float mx = fmaxf(s0, s1);
#pragma unroll
        for (int o = 8; o > 0; o >>= 1) mx = fmaxf(mx, __shfl_xor(mx, o, 64));
        float mn = fmaxf(m, mx);
        float alpha = expf(m - mn);
        float p0 = expf(s0 - mn), p1 = expf(s1 - mn);
        float ps = p0 + p1;
#pragma unroll
        for (int o = 8; o > 0; o >>= 1) ps += __shfl_xor(ps, o, 64);
        l = l * alpha + ps; m = mn;
        Ss[qi][sub] = p0; Ss[qi][sub + 16] = p1;
        __syncthreads();
#pragma unroll
        for (int j = 0; j < 8; j++) acc[j] *= alpha;
        for (int kk = 0; kk < 32; kk++) {
            float p = Ss[qi][kk];
            float4 v0 = *(const float4*)&Vsm[kk][sub * 8], v1 = *(const float4*)&Vsm[kk][sub * 8 + 4];
            acc[0] += p * v0.x; acc[1] += p * v0.y; acc[2] += p * v0.z; acc[3] += p * v0.w;
            acc[4] += p * v1.x; acc[5] += p * v1.y; acc[6] += p * v1.z; acc[7] += p * v1.w;
        }
    }
    const int t = tbase + b * Lq + q0 + qi;
    float il = 1.f / l;
    bf16_t* o = cat + (size_t)t * DM + 512 + h * 128 + sub * 8;
#pragma unroll
    for (int j = 0; j < 8; j++) o[j] = f2bf(acc[j] * il);
}


#define ATT_SV_OFF 25600
__device__ __forceinline__ void d_attn_mfma(const int item, char* smem, const bf16_t* __restrict__ Qb, const bf16_t* __restrict__ Kall,
                                            const bf16_t* __restrict__ VtAll, bf16_t* __restrict__ cat, int tbase, int Lq, int Lk, int nqb) {
    const int qb = item % nqb, bh = item / nqb;
    const int b = bh >> 2, h = bh & 3;
    const int tid = threadIdx.x, lane = tid & 63, wid = tid >> 6;
    const int q = lane & 31, hh = lane >> 5;
    const int t = tbase + b * Lq + qb * 128 + wid * 32 + q;
    bf16x8 qf[12];
    {
        const bf16_t* qp = Qb + ((size_t)t * 4 + h) * 192 + hh * 8;
#pragma unroll
        for (int ks = 0; ks < 12; ks++) qf[ks] = *(const bf16x8*)(qp + ks * 16);
    }
    f32x16 o[4];
#pragma unroll
    for (int i = 0; i < 4; i++)
#pragma unroll
        for (int r = 0; r < 16; r++) o[i][r] = 0.f;
    float m = -1e30f, l = 0.f;
    const bf16_t* K = Kall + (size_t)bh * Lk * 192;
    const bf16_t* Vt = VtAll + (size_t)bh * 128 * Lk;
    char* sK = smem;
    char* sV = smem + ATT_SV_OFF;
    u32x4 pk[6], pv[4];
    const int nkt = Lk >> 6;
#pragma unroll
    for (int i = 0; i < 6; i++) pk[i] = *(const u32x4*)(K + (size_t)(tid + 256 * i) * 8);
#pragma unroll
    for (int i = 0; i < 4; i++) { int c = tid + 256 * i; pv[i] = *(const u32x4*)(Vt + (size_t)(c >> 3) * Lk + (c & 7) * 8); }
#pragma unroll
    for (int i = 0; i < 6; i++) { int c = tid + 256 * i; *(u32x4*)(sK + (c / 24) * 400 + (c % 24) * 16) = pk[i]; }
#pragma unroll
    for (int i = 0; i < 4; i++) { int c = tid + 256 * i; *(u32x4*)(sV + (c >> 3) * 144 + (c & 7) * 16) = pv[i]; }
    __syncthreads();
    const float sc2 = 0.07216878364870322f * 1.4426950408889634f;
    for (int kt = 0; kt < nkt; kt++) {
        if (kt + 1 < nkt) {
            const bf16_t* Kn = K + (size_t)(kt + 1) * 64 * 192;
            const bf16_t* Vn = Vt + (kt + 1) * 64;
#pragma unroll
            for (int i = 0; i < 6; i++) pk[i] = *(const u32x4*)(Kn + (size_t)(tid + 256 * i) * 8);
#pragma unroll
            for (int i = 0; i < 4; i++) { int c = tid + 256 * i; pv[i] = *(const u32x4*)(Vn + (size_t)(c >> 3) * Lk + (c & 7) * 8); }
        }
        f32x16 st[2];
#pragma unroll
        for (int bk = 0; bk < 2; bk++)
#pragma unroll
            for (int r = 0; r < 16; r++) st[bk][r] = 0.f;
#pragma unroll
        for (int ks = 0; ks < 12; ks++) {
#pragma unroll
            for (int bk = 0; bk < 2; bk++) {
                bf16x8 a = *(const bf16x8*)(sK + (bk * 32 + q) * 400 + ks * 32 + hh * 16);
                st[bk] = __builtin_amdgcn_mfma_f32_32x32x16_bf16(a, qf[ks], st[bk], 0, 0, 0);
            }
        }
        float mx = -1e30f;
#pragma unroll
        for (int bk = 0; bk < 2; bk++)
#pragma unroll
            for (int r = 0; r < 16; r++) { st[bk][r] *= sc2; mx = fmaxf(mx, st[bk][r]); }
        mx = fmaxf(mx, __shfl_xor(mx, 32, 64));
        const float mn = fmaxf(m, mx);
        const float alpha = exp2f(m - mn);
        float ps = 0.f;
#pragma unroll
        for (int bk = 0; bk < 2; bk++)
#pragma unroll
            for (int r = 0; r < 16; r++) { st[bk][r] = exp2f(st[bk][r] - mn); ps += st[bk][r]; }
        ps += __shfl_xor(ps, 32, 64);
        l = l * alpha + ps; m = mn;
#pragma unroll
        for (int i = 0; i < 4; i++)
#pragma unroll
            for (int r = 0; r < 16; r++) o[i][r] *= alpha;
#pragma unroll
        for (int s4 = 0; s4 < 4; s4++) {
            bf16x8 pb;
#pragma unroll
            for (int j = 0; j < 8; j++) pb[j] = (short)f2bf(st[s4 >> 1][8 * (s4 & 1) + j]);
#pragma unroll
            for (int i = 0; i < 4; i++) {
                bf16x8 a = *(const bf16x8*)(sV + (i * 32 + q) * 144 + s4 * 32 + hh * 16);
                o[i] = __builtin_amdgcn_mfma_f32_32x32x16_bf16(a, pb, o[i], 0, 0, 0);
            }
        }
        __syncthreads();
        if (kt + 1 < nkt) {
#pragma unroll
            for (int i = 0; i < 6; i++) { int c = tid + 256 * i; *(u32x4*)(sK + (c / 24) * 400 + (c % 24) * 16) = pk[i]; }
#pragma unroll
            for (int i = 0; i < 4; i++) { int c = tid + 256 * i; *(u32x4*)(sV + (c >> 3) * 144 + (c & 7) * 16) = pv[i]; }
        }
        __syncthreads();
    }
    const float il = 1.f / l;
    bf16_t* op = cat + (size_t)t * DM + 512 + h * 128;
#pragma unroll
    for (int i = 0; i < 4; i++)
#pragma unroll
        for (int g = 0; g < 4; g++) {
            ushort4 w;
            w.x = f2bf(o[i][4 * g + 0] * il); w.y = f2bf(o[i][4 * g + 1] * il); w.z = f2bf(o[i][4 * g + 2] * il); w.w = f2bf(o[i][4 * g + 3] * il);
            *(ushort4*)(op + i * 32 + 8 * g + 4 * hh) = w;
        }
}

__device__ __forceinline__ void d_peer_route(const int bx, const int by, const int bz, char* smem, const float* __restrict__ qp, const float* __restrict__ keys  ,
                                                    int* __restrict__ pidx, float* __restrict__ pg) {
    float (*sq)[256] = (float(*)[256])smem;
    float (*sc)[256] = (float(*)[256])(smem + 4096);
    float (*tv)[32] = (float(*)[32])(smem + 8192);
    int (*ti)[32] = (int(*)[32])(smem + 8192 + 512);
    float (*topv)[16] = (float(*)[16])(smem + 8192 + 1024);
    int (*topi)[16] = (int(*)[16])(smem + 8192 + 1024 + 256);
    const int wi = threadIdx.x >> 6, lane = threadIdx.x & 63;
    const int w = bx * 4 + wi;
    const int t = w >> 3, h = w & 7;
    const float* q = qp + (size_t)t * 2048 + h * 256;
#pragma unroll
    for (int j = 0; j < 4; j++) sq[wi][lane + 64 * j] = q[lane + 64 * j];
    __syncthreads();
#pragma unroll
    for (int p = 0; p < 2; p++)
#pragma unroll
        for (int half = 0; half < 2; half++) {
            int n = lane + 64 * half;
            const float* kr = keys + ((size_t)(h * 2 + p) * 128 + n) * 128;
            float s = 0.f;
            for (int dd = 0; dd < 128; dd += 4) {
                float4 kv = *(const float4*)(kr + dd);
                s += sq[wi][p * 128 + dd] * kv.x + sq[wi][p * 128 + dd + 1] * kv.y + sq[wi][p * 128 + dd + 2] * kv.z + sq[wi][p * 128 + dd + 3] * kv.w;
            }
            sc[wi][p * 128 + n] = s;
        }
    __syncthreads();
#pragma unroll
    for (int p = 0; p < 2; p++)
#pragma unroll
        for (int half = 0; half < 2; half++) {
            int n = lane + 64 * half;
            float s = sc[wi][p * 128 + n];
            int rank = 0;
            for (int j = 0; j < 128; j++) { float o = sc[wi][p * 128 + j]; rank += (o > s || (o == s && j < n)) ? 1 : 0; }
            if (rank < 16) { tv[wi][p * 16 + rank] = s; ti[wi][p * 16 + rank] = n; }
        }
    __syncthreads();
    float cv[4];
#pragma unroll
    for (int j = 0; j < 4; j++) { int c = lane + 64 * j; cv[j] = tv[wi][c >> 4] + tv[wi][16 + (c & 15)]; }
    __syncthreads();
#pragma unroll
    for (int j = 0; j < 4; j++) sc[wi][lane + 64 * j] = cv[j];
    __syncthreads();
#pragma unroll
    for (int j = 0; j < 4; j++) {
        int c = lane + 64 * j;
        float s = cv[j];
        int rank = 0;
        for (int i = 0; i < 256; i++) { float o = sc[wi][i]; rank += (o > s || (o == s && i < c)) ? 1 : 0; }
        if (rank < 16) { topv[wi][rank] = s; topi[wi][rank] = (ti[wi][c >> 4] * 128 + ti[wi][16 + (c & 15)]) & 16383; }
    }
    __syncthreads();
    if (lane < 16) {
        float mx = topv[wi][0];
        float sum = 0.f;
        for (int i = 0; i < 16; i++) sum += expf(topv[wi][i] - mx);
        pg[(size_t)w * 16 + lane] = expf(topv[wi][lane] - mx) / sum;
        pidx[(size_t)w * 16 + lane] = topi[wi][lane] & 16383;
    }
}

__device__ __forceinline__ void d_peer_apply(const int bx, const int by, const int bz, char* smem, const bf16_t* __restrict__ hbuf, const int* __restrict__ pidx, const float* __restrict__ pg,
                                                    const float* __restrict__ utab, const float* __restrict__ vtab, const float* __restrict__ modl,
                                                    float* __restrict__ xrun) {
    float* coef = (float*)smem; int* eid = (int*)(smem + 512);
    const int t = bx, tid = threadIdx.x, wi = tid >> 6, lane = tid & 63;
    if (tid < 128) eid[tid] = pidx[(size_t)t * 128 + tid];
    float4 xv[4];
#pragma unroll
    for (int j = 0; j < 4; j++) { ushort4 q = *(const ushort4*)(hbuf + (size_t)t * DM + j * 256 + lane * 4); xv[j] = make_float4(bf2f(q.x), bf2f(q.y), bf2f(q.z), bf2f(q.w)); }
    __syncthreads();
    for (int e = wi * 32; e < wi * 32 + 32; e++) {
        const float* ur = utab + (size_t)eid[e] * DM;
        float s = 0.f;
#pragma unroll
        for (int j = 0; j < 4; j++) { float4 u = *(const float4*)(ur + j * 256 + lane * 4); s += u.x * xv[j].x + u.y * xv[j].y + u.z * xv[j].z + u.w * xv[j].w; }
        s = wave_sum(s);
        if (lane == 0) coef[e] = pg[(size_t)t * 128 + e] * gelu_tanh(s);
    }
    __syncthreads();
    float4 acc = make_float4(0.f, 0.f, 0.f, 0.f);
    for (int e = 0; e < 128; e++) {
        float cf = coef[e];
        float4 v = *(const float4*)(vtab + (size_t)eid[e] * DM + tid * 4);
        acc.x += cf * v.x; acc.y += cf * v.y; acc.z += cf * v.z; acc.w += cf * v.w;
    }
    const float* m = modl + (size_t)tok_modrow(t) * 6144 + 5 * 1024 + tid * 4;
    float* xo = xrun + (size_t)t * DM + tid * 4;
    float4 x = *(float4*)xo;
    x.x += m[0] * acc.x; x.y += m[1] * acc.y; x.z += m[2] * acc.z; x.w += m[3] * acc.w;
    *(float4*)xo = x;
}


template <int K, int J>
__device__ __forceinline__ void bit_stage16(float (&x)[16]) {
#pragma unroll
    for (int i = 0; i < 16; i++) {
        const int l = i ^ J;
        if (l > i) {
            const bool desc = ((i & K) == 0);
            const float a = x[i], b = x[l];
            const float hi = fmaxf(a, b), lo = fminf(a, b);
            x[i] = desc ? hi : lo; x[l] = desc ? lo : hi;
        }
    }
}
__device__ __forceinline__ void bit_sort16_desc(float (&x)[16]) {
    bit_stage16<2, 1>(x);
    bit_stage16<4, 2>(x); bit_stage16<4, 1>(x);
    bit_stage16<8, 4>(x); bit_stage16<8, 2>(x); bit_stage16<8, 1>(x);
    bit_stage16<16, 8>(x); bit_stage16<16, 4>(x); bit_stage16<16, 2>(x); bit_stage16<16, 1>(x);
}
__device__ __forceinline__ void bit_merge16_desc(float (&x)[16]) {
    bit_stage16<16, 8>(x); bit_stage16<16, 4>(x); bit_stage16<16, 2>(x); bit_stage16<16, 1>(x);
}
template <int K, int J>
__device__ __forceinline__ void bit_stage16p(float (&x)[16], int (&y)[16]) {
#pragma unroll
    for (int i = 0; i < 16; i++) {
        const int l = i ^ J;
        if (l > i) {
            const bool desc = ((i & K) == 0);
            const float a = x[i], b = x[l];
            const int pa = y[i], pb = y[l];
            const bool sw = desc ? (b > a) : (a > b);
            x[i] = sw ? b : a; x[l] = sw ? a : b;
            y[i] = sw ? pb : pa; y[l] = sw ? pa : pb;
        }
    }
}
__device__ __forceinline__ void bit_sort16p_desc(float (&x)[16], int (&y)[16]) {
    bit_stage16p<2, 1>(x, y);
    bit_stage16p<4, 2>(x, y); bit_stage16p<4, 1>(x, y);
    bit_stage16p<8, 4>(x, y); bit_stage16p<8, 2>(x, y); bit_stage16p<8, 1>(x, y);
    bit_stage16p<16, 8>(x, y); bit_stage16p<16, 4>(x, y); bit_stage16p<16, 2>(x, y); bit_stage16p<16, 1>(x, y);
}
__device__ __forceinline__ void bit_merge16p_desc(float (&x)[16], int (&y)[16]) {
    bit_stage16p<16, 8>(x, y); bit_stage16p<16, 4>(x, y); bit_stage16p<16, 2>(x, y); bit_stage16p<16, 1>(x, y);
}
__device__ __forceinline__ void top16_merge(float (&L)[16], const float (&C)[16]) {
#pragma unroll
    for (int i = 0; i < 16; i++) L[i] = fmaxf(L[i], C[15 - i]);
    bit_merge16_desc(L);
}
__device__ __forceinline__ void top16_merge_p(float (&L)[16], int (&Lp)[16], const float (&C)[16], const int (&Cp)[16]) {
#pragma unroll
    for (int i = 0; i < 16; i++) { const bool sw = C[15 - i] > L[i]; L[i] = sw ? C[15 - i] : L[i]; Lp[i] = sw ? Cp[15 - i] : Lp[i]; }
    bit_merge16p_desc(L, Lp);
}
__device__ __forceinline__ float key_val(float k) { return __uint_as_float(__float_as_uint(k) & ~127u); }
__device__ __forceinline__ int key_idx(float k) { return (int)(__float_as_uint(k) & 127u); }

__device__ __forceinline__ void d_peer_select(const int vb, const float* __restrict__ scT, int* __restrict__ pidx, float* __restrict__ pg) {
    const int h = vb & 7;
    const int t = (vb >> 3) * 256 + threadIdx.x;
    float A[16], B[16];
#pragma unroll
    for (int p = 0; p < 2; p++) {
        const float* S = scT + (size_t)(h * 2 + p) * 128 * TT + t;
        float L[16];
#pragma unroll
        for (int ch = 0; ch < 8; ch++) {
            float C[16];
#pragma unroll
            for (int i = 0; i < 16; i++) {
                const int n = ch * 16 + i;
                C[i] = __uint_as_float((__float_as_uint(S[(size_t)n * TT]) & ~127u) | (unsigned)n);
            }
            bit_sort16_desc(C);
            if (ch == 0) {
#pragma unroll
                for (int i = 0; i < 16; i++) L[i] = C[i];
            } else top16_merge(L, C);
        }
#pragma unroll
        for (int i = 0; i < 16; i++) { if (p == 0) A[i] = L[i]; else B[i] = L[i]; }
    }
    float Tv[16]; int Tp[16];
#pragma unroll
    for (int g = 0; g < 4; g++) {
        float Cv[16]; int Cp[16];
#pragma unroll
        for (int e = 0; e < 16; e++) {
            const int c = g * 16 + e;
            int i, j;
            if (c < 16) { i = 0; j = c; }
            else if (c < 24) { i = 1; j = c - 16; }
            else if (c < 29) { i = 2; j = c - 24; }
            else if (c < 33) { i = 3; j = c - 29; }
            else if (c < 36) { i = 4; j = c - 33; }
            else if (c < 42) { i = 5 + (c - 36) / 2; j = (c - 36) % 2; }
            else if (c < 50) { i = 8 + (c - 42); j = 0; }
            else { i = -1; j = 0; }
            if (i >= 0) { Cv[e] = key_val(A[i]) + key_val(B[j]); Cp[e] = key_idx(A[i]) * 128 + key_idx(B[j]); }
            else { Cv[e] = -3.0e38f; Cp[e] = 0; }
        }
        bit_sort16p_desc(Cv, Cp);
        if (g == 0) {
#pragma unroll
            for (int e = 0; e < 16; e++) { Tv[e] = Cv[e]; Tp[e] = Cp[e]; }
        } else top16_merge_p(Tv, Tp, Cv, Cp);
    }
    float sum = 0.f;
    float w[16];
#pragma unroll
    for (int e = 0; e < 16; e++) { w[e] = __expf(Tv[e] - Tv[0]); sum += w[e]; }
    const float inv = 1.f / sum;
    int* pi = pidx + ((size_t)t * 8 + h) * 16;
    float* pw = pg + ((size_t)t * 8 + h) * 16;
#pragma unroll
    for (int e = 0; e < 16; e += 4) {
        *(int4*)(pi + e) = make_int4(Tp[e], Tp[e + 1], Tp[e + 2], Tp[e + 3]);
        *(float4*)(pw + e) = make_float4(w[e] * inv, w[e + 1] * inv, w[e + 2] * inv, w[e + 3] * inv);
    }
}

typedef __attribute__((ext_vector_type(2))) short bf16x2;
__device__ __forceinline__ float dot8_bf16(u32x4 a, u32x4 b, float acc) {
#pragma unroll
    for (int i = 0; i < 4; i++) {
        const unsigned x = a[i], y = b[i];
        acc += __uint_as_float(x << 16) * __uint_as_float(y << 16);
        acc += __uint_as_float(x & 0xffff0000u) * __uint_as_float(y & 0xffff0000u);
    }
    return acc;
}
__device__ __forceinline__ void d_peer_apply2(const int vb, char* smem, const bf16_t* __restrict__ hb, const int* __restrict__ pidx,
                                              const float* __restrict__ pg, const bf16_t* __restrict__ utab, const bf16_t* __restrict__ vtab,
                                              const float* __restrict__ modl, float* __restrict__ xrun) {
    const int wid = threadIdx.x >> 6, lane = threadIdx.x & 63;
    const int t = vb * 4 + wid;
    float* coef = (float*)smem + wid * 128;
    int* eid = (int*)(smem + 2048) + wid * 128;
    eid[lane] = pidx[(size_t)t * 128 + lane]; eid[lane + 64] = pidx[(size_t)t * 128 + lane + 64];
    const float g0 = pg[(size_t)t * 128 + lane], g1 = pg[(size_t)t * 128 + lane + 64];
    const u32x4 x0 = *(const u32x4*)(hb + (size_t)t * DM + lane * 8);
    const u32x4 x1 = *(const u32x4*)(hb + (size_t)t * DM + 512 + lane * 8);
    __builtin_amdgcn_wave_barrier();
    float myact0 = 0.f, myact1 = 0.f;
    for (int eb = 0; eb < 128; eb += 8) {
        u32x4 ua[8], ub[8];
#pragma unroll
        for (int r = 0; r < 8; r++) {
            const bf16_t* ur = utab + (size_t)eid[eb + r] * DM;
            ua[r] = *(const u32x4*)(ur + lane * 8);
            ub[r] = *(const u32x4*)(ur + 512 + lane * 8);
        }
#pragma unroll
        for (int r = 0; r < 8; r++) {
            float sacc = dot8_bf16(ua[r], x0, 0.f);
            sacc = dot8_bf16(ub[r], x1, sacc);
            sacc = wave_sum(sacc);
            const int e = eb + r;
            if (lane == (e & 63)) { if (e < 64) myact0 = sacc; else myact1 = sacc; }
        }
    }
    coef[lane] = g0 * gelu_tanh(myact0);
    coef[lane + 64] = g1 * gelu_tanh(myact1);
    __builtin_amdgcn_wave_barrier();
    float acc[16];
#pragma unroll
    for (int i = 0; i < 16; i++) acc[i] = 0.f;
    for (int eb = 0; eb < 128; eb += 8) {
        u32x4 va[8], vbq[8];
#pragma unroll
        for (int r = 0; r < 8; r++) {
            const bf16_t* vr = vtab + (size_t)eid[eb + r] * DM;
            va[r] = *(const u32x4*)(vr + lane * 8);
            vbq[r] = *(const u32x4*)(vr + 512 + lane * 8);
        }
#pragma unroll
        for (int r = 0; r < 8; r++) {
            const float cf = coef[eb + r];
#pragma unroll
            for (int i = 0; i < 4; i++) {
                acc[2 * i] += cf * __uint_as_float(va[r][i] << 16);
                acc[2 * i + 1] += cf * __uint_as_float(va[r][i] & 0xffff0000u);
                acc[8 + 2 * i] += cf * __uint_as_float(vbq[r][i] << 16);
                acc[8 + 2 * i + 1] += cf * __uint_as_float(vbq[r][i] & 0xffff0000u);
            }
        }
    }
    const float* m = modl + (size_t)tok_modrow(t) * 6144 + 5 * 1024;
    float* xo = xrun + (size_t)t * DM;
#pragma unroll
    for (int hlf = 0; hlf < 2; hlf++) {
        const int c0 = hlf * 512 + lane * 8;
        float4 xa = *(float4*)(xo + c0), xb2 = *(float4*)(xo + c0 + 4);
        const float4 ma = *(const float4*)(m + c0), mb = *(const float4*)(m + c0 + 4);
        xa.x += ma.x * acc[hlf * 8 + 0]; xa.y += ma.y * acc[hlf * 8 + 1]; xa.z += ma.z * acc[hlf * 8 + 2]; xa.w += ma.w * acc[hlf * 8 + 3];
        xb2.x += mb.x * acc[hlf * 8 + 4]; xb2.y += mb.y * acc[hlf * 8 + 5]; xb2.z += mb.z * acc[hlf * 8 + 6]; xb2.w += mb.w * acc[hlf * 8 + 7];
        *(float4*)(xo + c0) = xa; *(float4*)(xo + c0 + 4) = xb2;
    }
}
__device__ __forceinline__ void d_cvt_bf16(const int vb, const float* __restrict__ src, bf16_t* __restrict__ dst) {
    const size_t base = (size_t)vb * 16384 + threadIdx.x * 4;
#pragma unroll
    for (int i = 0; i < 16; i++) {
        const float4 v = *(const float4*)(src + base + i * 1024);
        ushort4 o; o.x = f2bf(v.x); o.y = f2bf(v.y); o.z = f2bf(v.z); o.w = f2bf(v.w);
        *(ushort4*)(dst + base + i * 1024) = o;
    }
}

__device__ __forceinline__ void d_hy_dw(const int bx, const int by, const int bz, char* smem, const float* __restrict__ pre, const float* __restrict__ cw, const float* __restrict__ cb,
                                               bf16_t* __restrict__ zin, bf16_t* __restrict__ x0) {
    const int t = bx;
    const int pos = tok_pos(t), L = tok_len(t);
    const float* P = pre + (size_t)t * 3072;
    for (int c = threadIdx.x; c < 1024; c += 256) {
        float u[3];
#pragma unroll
        for (int part = 0; part < 3; part++) {
            int cc = part * 1024 + c;
            float cur = P[cc];
            float prev = (pos > 0) ? P[cc - 3072] : 0.f;
            float nxt = (pos < L - 1) ? P[cc + 3072] : 0.f;
            u[part] = prev * cw[cc] + cur * cw[3072 + cc] + nxt * cw[2 * 3072 + cc] + cb[cc];
        }
        x0[(size_t)t * DM + c] = f2bf(u[0]);
        zin[(size_t)t * DM + c] = f2bf(u[1] * u[2]);
    }
}

__device__ __forceinline__ void d_hy_filt(const int bx, const int by, const int bz, char* smem, int L, const float* __restrict__ w1, const float* __restrict__ b1, const float* __restrict__ w2,
                                                 const float* __restrict__ b2, const float* __restrict__ w3, const float* __restrict__ fr,
                                                 float* __restrict__ hf, float* __restrict__ hb) {
    float* z = (float*)smem; float* h1 = z + 64; float* h2 = z + 128;
    const int t = bx, tid = threadIdx.x;
    const float tu = (float)t / (float)(L - 1);
    if (tid == 0) z[0] = tu;
    if (tid >= 1 && tid < 17) {
        int i = tid - 1;
        float band = 1e-4f + (float)i * ((15.f - 1e-4f) / 15.f);
        float ang = 6.283185307179586f * (float)t * band / (float)L;
        z[1 + i] = cosf(ang); z[17 + i] = -sinf(ang);
    }
    __syncthreads();
    if (tid < 64) { float s = b1[tid]; for (int i = 0; i < 33; i++) s += z[i] * w1[i * 64 + tid]; h1[tid] = sinf(fr[tid] * s); }
    __syncthreads();
    if (tid < 64) { float s = b2[tid]; for (int i = 0; i < 64; i++) s += h1[i] * w2[i * 64 + tid]; h2[tid] = sinf(fr[tid] * s); }
    __syncthreads();
    for (int c = tid; c < 2048; c += 256) {
        float s = 0.f;
        for (int i = 0; i < 64; i++) s += h2[i] * w3[i * 2048 + c];
        int ch = c & 1023;
        float d0 = -4.605170185988091f / 0.3f, d1 = -4.605170185988091f / 1.5f;
        float delta = d0 + (d1 - d0) * ((float)ch / 1023.f);
        float win = expf(-tu * fabsf(delta));
        float val = s * win;
        if (c < 1024) hf[(size_t)t * 1024 + ch] = val; else hb[(size_t)t * 1024 + ch] = val;
    }
}
__device__ __forceinline__ void d_hy_norm(const int bx, const int by, const int bz, char* smem, int L, const float* __restrict__ hf, const float* __restrict__ hb, float* __restrict__ inv) {
    const int c = bx * 256 + threadIdx.x;
    float s = 0.f;
    for (int t = 0; t < L; t++) { s += fabsf(hf[(size_t)t * 1024 + c]); if (t > 0) s += fabsf(hb[(size_t)t * 1024 + c]); }
    inv[c] = 1.f / s;
}
__device__ __forceinline__ void d_hy_conv(const int bx, const int by, const int bz, char* smem, int L, int tbase, const bf16_t* __restrict__ zin, const bf16_t* __restrict__ x0, const float* __restrict__ hf,
                                                 const float* __restrict__ hb, const float* __restrict__ inv, const float* __restrict__ bias,
                                                 bf16_t* __restrict__ zb) {
    const int c = bx * 256 + threadIdx.x;
    const int t0 = by * 8, b = bz;
    const bf16_t* Z = zin + (size_t)(tbase + b * L) * DM + c;
    float acc[8];
#pragma unroll
    for (int i = 0; i < 8; i++) acc[i] = 0.f;
    for (int s = 0; s < L; s++) {
        float z = bf2f(Z[(size_t)s * DM]);
#pragma unroll
        for (int i = 0; i < 8; i++) {
            int j = t0 + i - s;
            float g = (j >= 0) ? hf[(size_t)j * 1024 + c] : hb[(size_t)(-j) * 1024 + c];
            acc[i] += z * g;
        }
    }
    float iv = inv[c], bs = bias[c];
#pragma unroll
    for (int i = 0; i < 8; i++) {
        size_t o = (size_t)(tbase + b * L + t0 + i) * DM + c;
        float zz = bf2f(zin[o]);
        zb[o] = f2bf(bf2f(x0[o]) * (acc[i] * iv + zz * bs));
    }
}


__device__ __forceinline__ void d_hy_filt2(const int vbl, char* smem, const int L, const float* __restrict__ w1, const float* __restrict__ b1,
                                           const float* __restrict__ w2, const float* __restrict__ b2, const float* __restrict__ w3,
                                           const float* __restrict__ fr, bf16_t* __restrict__ gT, float* __restrict__ nsum) {
    float* zp = (float*)smem;
    float* h1 = zp + 32 * 33;
    float* h2t = h1 + 32 * 64;
    const int tid = threadIdx.x;
    const int t0 = vbl * 32;
    for (int e = tid; e < 32 * 33; e += 256) {
        const int pos = e / 33, i = e % 33;
        const float t = (float)(t0 + pos);
        float val;
        if (i == 0) val = t / (float)(L - 1);
        else {
            const int bi = (i <= 16) ? (i - 1) : (i - 17);
            const float band = 1e-4f + (float)bi * ((15.f - 1e-4f) / 15.f);
            const float ang = 6.283185307179586f * t * band / (float)L;
            val = (i <= 16) ? cosf(ang) : -sinf(ang);
        }
        zp[e] = val;
    }
    __syncthreads();
    {
        const int j = tid & 63;
        const float frj = fr[j];
#pragma unroll 1
        for (int i = 0; i < 8; i++) {
            const int pos = (tid >> 6) + 4 * i;
            float sacc = b1[j];
            for (int q = 0; q < 33; q++) sacc += zp[pos * 33 + q] * w1[q * 64 + j];
            h1[pos * 64 + j] = sinf(frj * sacc);
        }
        __syncthreads();
#pragma unroll 1
        for (int i = 0; i < 8; i++) {
            const int pos = (tid >> 6) + 4 * i;
            float sacc = b2[j];
            for (int q = 0; q < 64; q++) sacc += h1[pos * 64 + q] * w2[q * 64 + j];
            h2t[j * 32 + pos] = sinf(frj * sacc);
        }
    }
    __syncthreads();
#pragma unroll 1
    for (int mm = 0; mm < 8; mm++) {
        const int c = tid + 256 * mm;
        float acc[32];
#pragma unroll
        for (int i = 0; i < 32; i++) acc[i] = 0.f;
        for (int j = 0; j < 64; j++) {
            const float w = w3[j * 2048 + c];
#pragma unroll
            for (int i = 0; i < 8; i++) {
                const float4 hv = *(const float4*)(h2t + j * 32 + i * 4);
                acc[4 * i] += hv.x * w; acc[4 * i + 1] += hv.y * w; acc[4 * i + 2] += hv.z * w; acc[4 * i + 3] += hv.w * w;
            }
        }
        const int ch = c & 1023;
        const float d0 = -4.605170185988091f / 0.3f, d1 = -4.605170185988091f / 1.5f;
        const float adelta = fabsf(d0 + (d1 - d0) * ((float)ch / 1023.f));
        float absum = 0.f;
        bf16_t* g = gT + (size_t)ch * 2 * L;
#pragma unroll
        for (int i = 0; i < 32; i++) {
            const int t = t0 + i;
            const float tu = (float)t / (float)(L - 1);
            const float val = acc[i] * expf(-tu * adelta);
            if (c < 1024) { absum += fabsf(val); g[L - t] = f2bf(val); }
            else if (t >= 1) { absum += fabsf(val); g[L + t] = f2bf(val); }
        }
        atomicAdd(nsum + ch, absum);
    }
}

__device__ __forceinline__ void d_hy_dw2(const int vb, char* smem, const float* __restrict__ pre, const float* __restrict__ cw,
                                         const float* __restrict__ cb, bf16_t* __restrict__ zT, bf16_t* __restrict__ x0b) {
    bf16_t* tile = (bf16_t*)smem;
    const int tt = vb >> 4, ct = vb & 15;
    const int tid = threadIdx.x;
    const int cc = tid & 63, c = ct * 64 + cc;
    const int tq = tid >> 6;
    float w0[3], w1[3], w2[3], bb[3];
#pragma unroll
    for (int part = 0; part < 3; part++) {
        const int col = part * 1024 + c;
        w0[part] = cw[col]; w1[part] = cw[3072 + col]; w2[part] = cw[2 * 3072 + col]; bb[part] = cb[col];
    }
    const int tok0 = tt * 64 + tq * 16;
    float prev[3], cur[3], nxt[3];
    {
        const int pos = tok_pos(tok0);
#pragma unroll
        for (int part = 0; part < 3; part++) {
            const float* P = pre + (size_t)tok0 * 3072 + part * 1024 + c;
            prev[part] = (pos > 0) ? P[-3072] : 0.f;
            cur[part] = P[0];
        }
    }
#pragma unroll 4
    for (int i = 0; i < 16; i++) {
        const int tok = tok0 + i;
        const int pos = tok_pos(tok), L = tok_len(tok);
        float u[3];
#pragma unroll
        for (int part = 0; part < 3; part++) {
            const float* P = pre + (size_t)tok * 3072 + part * 1024 + c;
            nxt[part] = (pos < L - 1) ? P[3072] : 0.f;
            u[part] = prev[part] * w0[part] + cur[part] * w1[part] + nxt[part] * w2[part] + bb[part];
            prev[part] = cur[part]; cur[part] = nxt[part];
        }
        x0b[(size_t)tok * DM + c] = f2bf(u[0]);
        tile[cc * 72 + tq * 16 + i] = f2bf(u[1] * u[2]);
    }
    __syncthreads();
    {
        const int cch = tid >> 2, q4 = tid & 3;
        const u32x4 a = *(const u32x4*)(tile + cch * 72 + q4 * 16);
        const u32x4 b2 = *(const u32x4*)(tile + cch * 72 + q4 * 16 + 8);
        bf16_t* dst = zT + (size_t)(ct * 64 + cch) * TT + tt * 64 + q4 * 16;
        *(u32x4*)dst = a; *(u32x4*)(dst + 8) = b2;
    }
}

template <bool SAMPLE>
__device__ __forceinline__ void d_hy_conv2(const int c, char* wsm, const bf16_t* __restrict__ gTall, const float* __restrict__ nsum,
                                           const bf16_t* __restrict__ zT, const float* __restrict__ bias, bf16_t* __restrict__ yT) {
    constexpr int L = SAMPLE ? LS : LP;
    constexpr int NB = L / 32;
    constexpr int NBATCH = SAMPLE ? 4 : 16;
    constexpr int BSH = SAMPLE ? 2 : 4;
    constexpr int TPB = 32 >> BSH;
    constexpr int NCB = NB / TPB;
    constexpr int PADB = SAMPLE ? 8 : 2;
    constexpr int ZLEN = L + 2 * PADB * 32;
    constexpr int tbase = SAMPLE ? TP : 0;
    const int lane = threadIdx.x & 63;
    const int lc = lane & 31, hh = lane >> 5;
    const int b = lc & (NBATCH - 1), Tl = lc >> BSH;
    bf16_t* R = (bf16_t*)wsm;
    bf16_t* Z = R + 2 * L;
    {
        const u32x4* src = (const u32x4*)(gTall + (size_t)c * 2 * L);
        for (int i = lane; i < 2 * L / 8; i += 64) ((u32x4*)R)[i] = src[i];
        const u32x4 zero = {0u, 0u, 0u, 0u};
#pragma unroll 1
        for (int b2 = 0; b2 < NBATCH; b2++) {
            const u32x4* zs = (const u32x4*)(zT + (size_t)c * TT + tbase + b2 * L);
            u32x4* zd = (u32x4*)(Z + b2 * ZLEN);
            for (int i = lane; i < PADB * 4; i += 64) { zd[i] = zero; zd[PADB * 4 + L / 8 + i] = zero; }
            for (int i = lane; i < L / 8; i += 64) zd[PADB * 4 + i] = zs[i];
        }
    }
    __builtin_amdgcn_wave_barrier();
    f32x16 acc[NCB];
#pragma unroll
    for (int cb = 0; cb < NCB; cb++)
#pragma unroll
        for (int r = 0; r < 16; r++) acc[cb][r] = 0.f;
    const bf16_t* Zb = Z + b * ZLEN + PADB * 32 + 8 * hh;
#pragma unroll 1
    for (int D = -(NB - 1); D <= NB - 1; D++) {
        bf16x8 af[2];
#pragma unroll
        for (int ks = 0; ks < 2; ks++) {
            const bf16_t* rp = R + (L - 32 * D - lc + 16 * ks + 8 * hh);
#pragma unroll
            for (int j = 0; j < 8; j++) af[ks][j] = (short)rp[j];
        }
#pragma unroll
        for (int cb = 0; cb < NCB; cb++) {
            if (D >= TPB * cb - (NB - 1) && D <= TPB * cb + TPB - 1) {
                const int S = TPB * cb + Tl - D;
#pragma unroll
                for (int ks = 0; ks < 2; ks++) {
                    const bf16x8 bfr = *(const bf16x8*)(Zb + 32 * S + 16 * ks);
                    acc[cb] = __builtin_amdgcn_mfma_f32_32x32x16_bf16(af[ks], bfr, acc[cb], 0, 0, 0);
                }
            }
        }
    }
    const float inv = 1.f / nsum[c], bs = bias[c];
    bf16_t* yrow = yT + (size_t)c * TT + tbase + b * L;
    const bf16_t* zrow = Z + b * ZLEN + PADB * 32;
#pragma unroll
    for (int cb = 0; cb < NCB; cb++)
#pragma unroll
        for (int g = 0; g < 4; g++) {
            const int t = 32 * (TPB * cb + Tl) + 8 * g + 4 * hh;
            ushort4 o;
            o.x = f2bf(acc[cb][4 * g + 0] * inv + bf2f(zrow[t + 0]) * bs);
            o.y = f2bf(acc[cb][4 * g + 1] * inv + bf2f(zrow[t + 1]) * bs);
            o.z = f2bf(acc[cb][4 * g + 2] * inv + bf2f(zrow[t + 2]) * bs);
            o.w = f2bf(acc[cb][4 * g + 3] * inv + bf2f(zrow[t + 3]) * bs);
            *(ushort4*)(yrow + t) = o;
        }
    __builtin_amdgcn_wave_barrier();
}

__device__ __forceinline__ void d_hy_post(const int vb, char* smem, const bf16_t* __restrict__ yT, const bf16_t* __restrict__ x0b, bf16_t* __restrict__ zb) {
    bf16_t* tile = (bf16_t*)smem;
    const int tt = vb >> 4, ct = vb & 15;
    const int tid = threadIdx.x;
    {
        const int cch = tid >> 2, q4 = tid & 3;
        const bf16_t* src = yT + (size_t)(ct * 64 + cch) * TT + tt * 64 + q4 * 16;
        *(u32x4*)(tile + cch * 72 + q4 * 16) = *(const u32x4*)src;
        *(u32x4*)(tile + cch * 72 + q4 * 16 + 8) = *(const u32x4*)(src + 8);
    }
    __syncthreads();
    const int cc = tid & 63, tq = tid >> 6;
#pragma unroll 4
    for (int i = 0; i < 16; i++) {
        const size_t o = (size_t)(tt * 64 + tq * 16 + i) * DM + ct * 64 + cc;
        zb[o] = f2bf(bf2f(x0b[o]) * bf2f(tile[cc * 72 + tq * 16 + i]));
    }
}

struct Params {
    const float *x_prompt, *x_sample, *st_f, *st_b, *cache_ckv, *cache_kpe, *c, *c_ctx, *norm_g, *w_mod, *b_mod, *ab_w_in, *rw_mu, *rw_w0, *rw_w2,
        *rw_a0, *rw_a2, *rw_g2, *rw_k_k, *rw_k_a, *rw_r_k, *rw_lnx_g, *rw_lnx_b, *mla_q_norm, *mla_q_up, *mla_kv_norm, *mla_kv_up, *mla_qn, *mla_kn,
        *ab_w_out, *hy_w_in, *hy_b_in, *hy_conv_w, *hy_conv_b, *hy_f_w1, *hy_f_b1, *hy_f_w2, *hy_f_b2, *hy_f_w3, *hy_f_freq, *hy_bias, *hy_w_out,
        *peer_w_q, *peer_keys, *peer_u, *peer_v;
    float *xrun, *out_sf, *out_sb, *out_ckv, *out_kpe;
    float *mod;
    bf16_t *w_in_t, *w_out_t, *hy_w_in_t, *hy_w_out_t, *w_q_t, *q_up_t, *kv_up_t, *w2_t, *a2_t, *g2_t, *ctxb, *keysb, *tabU, *tabV;
    bf16_t *hb, *catb, *zbb, *kvrawb, *qrawb;
    bf16_t *projrw; float *projmla; float *y0, *y1; bf16_t *qb;
    bf16_t *rb, *kb, *vb, *kkb, *lr0, *lr1, *gateb;
    _Float16 *du0, *du1; bf16_t *twb, *advb, *sgb; float *bonus, *kpe; bf16_t *qcnb, *ckvb;
    bf16_t *Qb, *Kp, *Vp, *Ks, *Vs, *kvctxb;
    int* pidx; float* pg; float* scT;
    float *pre; bf16_t *zT, *x0b, *yT, *gTS, *gTP; float *nsum;
};

#define VLOOP(n) for (int vb = blockIdx.x; vb < (n); vb += gridDim.x)
#define ENDV __syncthreads();

__device__ __forceinline__ void peer_layer(const Params& p, cg::grid_group& grid, char* smem, int li, const float* modl, float* xrs) {
    const bf16_t* wq = p.w_q_t + (size_t)li * 2048 * 1024;
    const bf16_t* kys = p.keysb + (size_t)li * 16 * 128 * 128;
    VLOOP(TT) { d_norm_mod(vb, 0, 0, smem, p.xrun, xrs, p.norm_g + (li * 2 + 1) * 1024, modl, 3, 4, p.hb); ENDV }
    grid.sync();
    VLOOP(16 * 96) { d_gemm_bf16(vb % 16, vb / 16, smem, p.hb, 1024, wq, 1024, 1024, 2048, EpiStoreBf{p.qb, 2048, 0}); }
    grid.sync();
    VLOOP(16 * 96) { const int hp = vb / 96; d_gemm_bf16(vb % 96, 0, smem, kys + (size_t)hp * 128 * 128, 128, p.qb + hp * 128, 2048, 128, TT, EpiStore{p.scT + (size_t)hp * 128 * TT, nullptr, TT, 0}); }
    grid.sync();
    VLOOP(8 * 48) { d_peer_select(vb, p.scT, p.pidx, p.pg); }
    grid.sync();
    VLOOP(TT / 4) { d_peer_apply2(vb, smem, p.hb, p.pidx, p.pg, p.tabU, p.tabV, modl, p.xrun); ENDV }
}

__global__ void __launch_bounds__(256) mega(Params p) {
    __shared__ __attribute__((aligned(16))) char smem[114688];
    cg::grid_group grid = cg::this_grid();
    const float* mod0 = p.mod;
    const float* mod1 = p.mod + 5 * 6144;
    float* xrs = p.xrun + (size_t)TP * DM;

    {
        const int j0 = 48;
        const int j1 = j0 + 36 * 16;
        const int j2 = j1 + 16 * 16;
        const int j3 = j2 + 48 * 16;
        const int j4 = j3 + 16 * 16;
        const int j5 = j4 + 32 * 16;
        const int j6 = j5 + 32 * 16;
        const int j7 = j6 + 12 * 4;
        const int j8 = j7 + 16 * 2;
        const int j9 = j8 + 8;
        const int j10 = j9 + 8;
        const int j11 = j10 + 8;
        const int j12 = j11 + 8;
        const int j13 = j12 + 8 * 2;
        const int j14 = j13 + 8;
        const int j15 = j14 + 32;
        const int j16 = j15 + 1024;
        const int j17 = j16 + 1024;
        VLOOP(j17) {
            if (vb < j0) d_mod(vb % 24, vb / 24, 0, smem, p.c, p.c_ctx, p.w_mod, p.b_mod, p.mod);
            else if (vb < j1) d_transpose_w(vb - j0, smem, p.ab_w_in, 1024, 2240, p.w_in_t);
            else if (vb < j2) d_transpose_w(vb - j1, smem, p.ab_w_out, 1024, 1024, p.w_out_t);
            else if (vb < j3) d_transpose_w(vb - j2, smem, p.hy_w_in, 1024, 3072, p.hy_w_in_t);
            else if (vb < j4) d_transpose_w(vb - j3, smem, p.hy_w_out, 1024, 1024, p.hy_w_out_t);
            else if (vb < j5) d_transpose_w(vb - j4, smem, p.peer_w_q, 1024, 2048, p.w_q_t);
            else if (vb < j6) d_transpose_w(vb - j5, smem, p.peer_w_q + (size_t)1024 * 2048, 1024, 2048, p.w_q_t + (size_t)2048 * 1024);
            else if (vb < j7) d_transpose_w(vb - j6, smem, p.mla_q_up, 256, 768, p.q_up_t);
            else if (vb < j8) d_transpose_w(vb - j7, smem, p.mla_kv_up, 128, 1024, p.kv_up_t);
            else if (vb < j9) d_transpose_w(vb - j8, smem, p.rw_w2, 64, 512, p.w2_t);
            else if (vb < j10) d_transpose_w(vb - j9, smem, p.rw_w2 + 64 * 512, 64, 512, p.w2_t + 512 * 64);
            else if (vb < j11) d_transpose_w(vb - j10, smem, p.rw_a2, 64, 512, p.a2_t);
            else if (vb < j12) d_transpose_w(vb - j11, smem, p.rw_a2 + 64 * 512, 64, 512, p.a2_t + 512 * 64);
            else if (vb < j13) d_transpose_w(vb - j12, smem, p.rw_g2, 128, 512, p.g2_t);
            else if (vb < j14) d_cvt_bf16(vb - j13, p.cache_ckv, p.ctxb);
            else if (vb < j15) d_cvt_bf16(vb - j14, p.peer_keys, p.keysb);
            else if (vb < j16) d_cvt_bf16(vb - j15, p.peer_u, p.tabU);
            else d_cvt_bf16(vb - j16, p.peer_v, p.tabV);
            ENDV }
    }
    grid.sync();
    VLOOP(TT) { d_norm_mod(vb, 0, 0, smem, p.x_prompt, p.x_sample, p.norm_g, mod0, 0, 1, p.hb); ENDV }
    grid.sync();
    VLOOP(18 * 96) { d_gemm_bf16(vb % 18, vb / 18, smem, p.hb, 1024, p.w_in_t, 1024, 1024, ABIN, EpiProj{p.projrw, p.projmla}); }
    grid.sync();
    VLOOP(2 * TT) {
        if (vb < TT) d_rw_shift(vb, 0, 0, smem, p.projrw, p.rw_mu, p.rb, p.kb, p.vb, p.twb, p.advb, p.sgb);
        else d_mla_pre(vb - TT, 0, 0, smem, p.projmla, p.mla_q_norm, p.mla_kv_norm, p.qcnb, p.ckvb, p.kpe, p.out_ckv, p.out_kpe);
        ENDV }
    grid.sync();
    {
        const int n0 = 4 * 96, n1 = 6 * 96, n2 = 8 * 96, n3 = 8 * 8;
        VLOOP(5 * n0 + n1 + n2 + n3) {
            int v = vb;
            if (v < n0) d_gemm_bf16(v % 4, v / 4, smem, p.twb, 64, p.w2_t, 64, 64, 512, EpiDecay{p.du0, p.rw_w0});
            else if ((v -= n0) < n0) d_gemm_bf16(v % 4, v / 4, smem, p.twb, 64, p.w2_t + 512 * 64, 64, 64, 512, EpiDecay{p.du1, p.rw_w0 + 512});
            else if ((v -= n0) < n0) d_gemm_bf16(v % 4, v / 4, smem, p.advb, 64, p.a2_t, 64, 64, 512, EpiLr{p.lr0, p.rw_a0});
            else if ((v -= n0) < n0) d_gemm_bf16(v % 4, v / 4, smem, p.advb, 64, p.a2_t + 512 * 64, 64, 64, 512, EpiLr{p.lr1, p.rw_a0 + 512});
            else if ((v -= n0) < n0) d_gemm_bf16(v % 4, v / 4, smem, p.sgb, 128, p.g2_t, 128, 128, 512, EpiStoreBf{p.gateb, 512, 0});
            else if ((v -= n0) < n1) d_gemm_bf16(v % 6, v / 6, smem, p.qcnb, 256, p.q_up_t, 256, 256, 768, EpiStoreBf{p.qrawb, 768, 0});
            else if ((v -= n1) < n2) d_gemm_bf16(v % 8, v / 8, smem, p.ckvb, 128, p.kv_up_t, 128, 128, 1024, EpiStoreBf{p.kvrawb, 1024, 0});
            else { v -= n2; d_gemm_bf16(v % 8, v / 8, smem, p.ctxb, 128, p.kv_up_t, 128, 128, 1024, EpiStoreBf{p.kvctxb, 1024, 0}); }
        }
    }
    grid.sync();
    VLOOP(2 * TT + TT + 1024) {
        if (vb < 2 * TT) d_rw_kk(vb, 0, 0, smem, p.rb, p.kb, p.lr0, p.lr1, p.rw_k_k, p.rw_k_a, p.rw_r_k, p.kkb, p.bonus);
        else d_mla_post(vb - 2 * TT, 0, 0, smem, p.qrawb, p.kvrawb, p.kvctxb, p.kpe, p.cache_kpe, p.mla_qn, p.mla_kn, p.Qb, p.Kp, p.Vp, p.Ks, p.Vs);
        ENDV }
    grid.sync();
    VLOOP(256 + 1024) {
        if (vb < 256) d_scan2(vb, true, smem, p.rb, p.kb, p.vb, p.kkb, p.lr0, p.lr1, p.du0, p.du1, p.rw_k_a, p.st_f, p.st_b, p.y0, p.y1, p.out_sf, p.out_sb);
        else d_scan2(vb - 256, false, smem, p.rb, p.kb, p.vb, p.kkb, p.lr0, p.lr1, p.du0, p.du1, p.rw_k_a, p.st_f, p.st_b, p.y0, p.y1, p.out_sf, p.out_sb);
    }
    grid.sync();
    VLOOP(256 + 128) {
        if (vb < 256) { d_attn_mfma(vb, smem, p.Qb, p.Ks, p.Vs, p.catb, TP, LS, 2304, 16); }
        else { d_attn_mfma(vb - 256, smem, p.Qb, p.Kp, p.Vp, p.catb, 0, LP, LP, 2); }
        ENDV }
    grid.sync();
    VLOOP(2 * TT) { d_rw_post(vb, 0, 0, smem, p.y0, p.y1, p.bonus, p.vb, p.gateb, p.rw_lnx_g, p.rw_lnx_b, p.catb); ENDV }
    grid.sync();
    VLOOP(8 * 96) { d_gemm_bf16(vb % 8, vb / 8, smem, p.catb, 1024, p.w_out_t, 1024, 1024, 1024, EpiResid{p.x_prompt, p.x_sample, p.xrun, mod0, 2, 0}); }
    grid.sync();
    peer_layer(p, grid, smem, 0, mod0, xrs);
    grid.sync();
    VLOOP(72 + TT + 2048) {
        if (vb < 64) d_hy_filt2(vb, smem, LS, p.hy_f_w1, p.hy_f_b1, p.hy_f_w2, p.hy_f_b2, p.hy_f_w3, p.hy_f_freq, p.gTS, p.nsum);
        else if (vb < 72) d_hy_filt2(vb - 64, smem, LP, p.hy_f_w1, p.hy_f_b1, p.hy_f_w2, p.hy_f_b2, p.hy_f_w3, p.hy_f_freq, p.gTP, p.nsum + 1024);
        else if (vb < 72 + TT) d_norm_mod(vb - 72, 0, 0, smem, p.xrun, xrs, p.norm_g + 2048, mod1, 0, 1, p.hb);
        else if (vb < 72 + TT + 1024) d_cvt_bf16(vb - (72 + TT), p.peer_u + (size_t)16384 * 1024, p.tabU);
        else d_cvt_bf16(vb - (72 + TT + 1024), p.peer_v + (size_t)16384 * 1024, p.tabV);
        ENDV }
    grid.sync();
    VLOOP(24 * 96) { d_gemm_bf16(vb % 24, vb / 24, smem, p.hb, 1024, p.hy_w_in_t, 1024, 1024, 3072, EpiStore{p.pre, p.hy_b_in, 3072, 0}); }
    grid.sync();
    VLOOP(192 * 16) { d_hy_dw2(vb, smem, p.pre, p.hy_conv_w, p.hy_conv_b, p.zT, p.x0b); ENDV }
    grid.sync();
    VLOOP(256 + 256) {
        char* wsm = smem + (threadIdx.x >> 6) * 28672;
        if (vb < 256) d_hy_conv2<true>(vb * 4 + (threadIdx.x >> 6), wsm, p.gTS, p.nsum, p.zT, p.hy_bias, p.yT);
        else d_hy_conv2<false>((vb - 256) * 4 + (threadIdx.x >> 6), wsm, p.gTP, p.nsum + 1024, p.zT, p.hy_bias, p.yT);
        ENDV }
    grid.sync();
    VLOOP(192 * 16) { d_hy_post(vb, smem, p.yT, p.x0b, p.zbb); ENDV }
    grid.sync();
    VLOOP(8 * 96) { d_gemm_bf16(vb % 8, vb / 8, smem, p.zbb, 1024, p.hy_w_out_t, 1024, 1024, 1024, EpiResid{p.xrun, xrs, p.xrun, mod1, 2, 0}); }
    grid.sync();
    peer_layer(p, grid, smem, 1, mod1, xrs);
}

static inline size_t align_up(size_t x) { return (x + 255) & ~(size_t)255; }

extern "C" void kernel_launch(void* const* d_in, const int* in_sizes, int n_in, void* d_out, int out_size, void* d_ws, size_t ws_size,
                              hipStream_t stream) {
    Params p{};
    const float** pin = (const float**)&p;
    for (int i = 0; i < 46; i++) pin[i] = (const float*)d_in[i];

    float* out = (float*)d_out;
    p.xrun = out;
    p.out_sf = out + (size_t)TT * DM;
    p.out_sb = p.out_sf + 16 * 8 * 64 * 64;
    p.out_ckv = p.out_sb + 16 * 8 * 64 * 64;
    p.out_kpe = p.out_ckv + 16 * 256 * 128;

    char* ws = (char*)d_ws;
    size_t off = 0;
    auto take = [&](size_t bytes) { char* q = ws + off; off = align_up(off + bytes); return q; };
    p.mod = (float*)take((size_t)2 * 5 * 6144 * 4);
    p.w_in_t = (bf16_t*)take((size_t)2304 * 1024 * 2);
    p.w_out_t = (bf16_t*)take((size_t)1024 * 1024 * 2);
    p.hy_w_in_t = (bf16_t*)take((size_t)3072 * 1024 * 2);
    p.hy_w_out_t = (bf16_t*)take((size_t)1024 * 1024 * 2);
    p.w_q_t = (bf16_t*)take((size_t)2 * 2048 * 1024 * 2);
    p.q_up_t = (bf16_t*)take((size_t)768 * 256 * 2);
    p.kv_up_t = (bf16_t*)take((size_t)1024 * 128 * 2);
    p.w2_t = (bf16_t*)take((size_t)2 * 512 * 64 * 2);
    p.a2_t = (bf16_t*)take((size_t)2 * 512 * 64 * 2);
    p.g2_t = (bf16_t*)take((size_t)512 * 128 * 2);
    p.ctxb = (bf16_t*)take((size_t)1024 * 128 * 2);
    p.keysb = (bf16_t*)take((size_t)2 * 16 * 128 * 128 * 2);
    p.tabU = (bf16_t*)take((size_t)16384 * 1024 * 2);
    p.tabV = (bf16_t*)take((size_t)16384 * 1024 * 2);
    p.nsum = (float*)take((size_t)2 * 1024 * 4);
    char* R1 = take((size_t)TT * 1024 * 4);
    p.hb = (bf16_t*)R1; p.catb = (bf16_t*)R1; p.zbb = (bf16_t*)R1;
    p.kvrawb = (bf16_t*)R1;
    p.qrawb = (bf16_t*)(R1 + (size_t)TT * 1024 * 2);
    char* R2 = take((size_t)TT * RWIN * 2 + (size_t)TT * 448 * 4);
    p.projrw = (bf16_t*)R2;
    p.projmla = (float*)(R2 + (size_t)TT * RWIN * 2);
    p.y0 = (float*)R2; p.y1 = p.y0 + (size_t)TT * 512;
    p.qb = (bf16_t*)R2;
    char* R3 = ws + off;
    size_t o3 = 0;
    auto take3 = [&](size_t bytes) { char* q = R3 + o3; o3 = align_up(o3 + bytes); return q; };
    p.rb = (bf16_t*)take3((size_t)TT * 512 * 2);
    p.kb = (bf16_t*)take3((size_t)TT * 512 * 2);
    p.vb = (bf16_t*)take3((size_t)TT * 512 * 2);
    p.kkb = (bf16_t*)take3((size_t)TT * 512 * 2);
    p.lr0 = (bf16_t*)take3((size_t)TT * 512 * 2);
    p.lr1 = (bf16_t*)take3((size_t)TT * 512 * 2);
    p.gateb = (bf16_t*)take3((size_t)TT * 512 * 2);
    p.du0 = (_Float16*)take3((size_t)TT * 512 * 2);
    p.du1 = (_Float16*)take3((size_t)TT * 512 * 2);
    p.twb = (bf16_t*)take3((size_t)TT * 64 * 2);
    p.advb = (bf16_t*)take3((size_t)TT * 64 * 2);
    p.sgb = (bf16_t*)take3((size_t)TT * 128 * 2);
    p.bonus = (float*)take3((size_t)TT * 8 * 4);
    p.kpe = (float*)take3((size_t)TT * 64 * 4);
    p.qcnb = (bf16_t*)take3((size_t)TT * 256 * 2);
    p.ckvb = (bf16_t*)take3((size_t)TT * 128 * 2);
    p.Qb = (bf16_t*)take3((size_t)TT * 768 * 2);
    p.Kp = (bf16_t*)take3((size_t)16 * 4 * 256 * 192 * 2);
    p.Vp = (bf16_t*)take3((size_t)16 * 4 * 256 * 128 * 2);
    p.Ks = (bf16_t*)take3((size_t)4 * 4 * 2304 * 192 * 2);
    p.Vs = (bf16_t*)take3((size_t)4 * 4 * 2304 * 128 * 2);
    p.kvctxb = (bf16_t*)take3((size_t)1024 * 1024 * 2);
    p.pidx = (int*)take3((size_t)TT * 128 * 4);
    p.pg = (float*)take3((size_t)TT * 128 * 4);
    p.scT = (float*)R3;
    p.pre = (float*)R2;
    char* L1 = R2 + (size_t)TT * 3072 * 4;
    p.zT = (bf16_t*)L1;
    p.x0b = p.zT + (size_t)TT * 1024;
    p.yT = p.x0b + (size_t)TT * 1024;
    p.gTS = p.yT + (size_t)TT * 1024;
    p.gTP = p.gTS + (size_t)1024 * 2 * LS;

    static int grid_blocks = 0;
    if (!grid_blocks) {
        int dev = 0, cus = 0, per_cu = 0;
        (void)hipGetDevice(&dev);
        (void)hipDeviceGetAttribute(&cus, hipDeviceAttributeMultiprocessorCount, dev);
        (void)hipOccupancyMaxActiveBlocksPerMultiprocessor(&per_cu, mega, 256, 0);
        if (per_cu > 2) per_cu = 2;
        if (per_cu < 1) per_cu = 1;
        grid_blocks = cus * per_cu;
    }
    (void)hipMemsetAsync(p.nsum, 0, (size_t)2 * 1024 * 4, stream);
    void* args[] = {&p};
    (void)hipLaunchCooperativeKernel((void*)mega, dim3(grid_blocks), dim3(256), args, 0, stream);
}
```

```cpp
#include <hip/hip_runtime.h>
#include <stdint.h>
#include <hip/hip_cooperative_groups.h>
namespace cg = cooperative_groups;

#define DM 1024
#define TP 4096
#define TS 8192
#define TT 12288
#define LP 256
#define LS 2048
#define NBP 16
#define NBS 4
#define ABIN 2240
#define RWIN 1792

typedef unsigned short bf16_t;
__device__ __forceinline__ bf16_t f2bf(float f) { unsigned u = __float_as_uint(f); u += 0x7fffu + ((u >> 16) & 1u); return (bf16_t)(u >> 16); }
__device__ __forceinline__ float bf2f(bf16_t h) { return __uint_as_float(((unsigned)h) << 16); }
__device__ __forceinline__ float sigmoidf_(float x) { return 1.f / (1.f + expf(-x)); }
__device__ __forceinline__ float gelu_tanh(float x) { return 0.5f * x * (1.f + tanhf(0.7978845608028654f * (x + 0.044715f * x * x * x))); }

__device__ __forceinline__ int tok_pos(int t) { return t < TP ? (t & (LP - 1)) : ((t - TP) & (LS - 1)); }
__device__ __forceinline__ int tok_len(int t) { return t < TP ? LP : LS; }
__device__ __forceinline__ int tok_modrow(int t) { return t < TP ? 0 : 1 + ((t - TP) >> 11); }

__device__ __forceinline__ float wave_sum(float v) {
#pragma unroll
    for (int o = 32; o > 0; o >>= 1) v += __shfl_xor(v, o, 64);
    return v;
}

__device__ __forceinline__ void d_mod(const int bx, const int by, const int bz, char* smem, const float* __restrict__ c, const float* __restrict__ c_ctx, const float* __restrict__ w_mod,
                                             const float* __restrict__ b_mod, float* __restrict__ mod) {
    float (*s)[1024] = (float(*)[1024])smem;
    const int li = by;
    const int n = bx * 256 + threadIdx.x;
    for (int i = threadIdx.x; i < 5 * 1024; i += 256) {
        int r = i >> 10, k = i & 1023;
        float v = (r == 0) ? c_ctx[k] : c[(r - 1) * 1024 + k];
        s[r][k] = v / (1.f + expf(-v));
    }
    __syncthreads();
    float a0 = 0, a1 = 0, a2 = 0, a3 = 0, a4 = 0;
    const float* w = w_mod + (size_t)li * 1024 * 6144 + n;
    for (int k = 0; k < 1024; k++) {
        float wv = w[(size_t)k * 6144];
        a0 += s[0][k] * wv; a1 += s[1][k] * wv; a2 += s[2][k] * wv; a3 += s[3][k] * wv; a4 += s[4][k] * wv;
    }
    float bb = b_mod[li * 6144 + n];
    float* o = mod + (size_t)li * 5 * 6144 + n;
    o[0 * 6144] = a0 + bb; o[1 * 6144] = a1 + bb; o[2 * 6144] = a2 + bb; o[3 * 6144] = a3 + bb; o[4 * 6144] = a4 + bb;
}


__device__ __forceinline__ void d_mod2(const int vb, char* smem, const float* __restrict__ c, const float* __restrict__ c_ctx,
                                       const float* __restrict__ w_mod, const float* __restrict__ b_mod, float* __restrict__ mod) {
    float* sl = (float*)smem;
    float* red = sl + 5 * 1024;
    const int li = vb / 96, n0 = (vb % 96) * 64;
    const int tid = threadIdx.x, col = tid & 63, kg = tid >> 6;
    for (int i = tid; i < 5 * 1024; i += 256) {
        const int r = i >> 10, k = i & 1023;
        const float v = (r == 0) ? c_ctx[k] : c[(r - 1) * 1024 + k];
        sl[i] = v / (1.f + __expf(-v));
    }
    __syncthreads();
    float a0 = 0, a1 = 0, a2 = 0, a3 = 0, a4 = 0;
    const float* w = w_mod + (size_t)li * 1024 * 6144 + (size_t)(kg * 256) * 6144 + n0 + col;
    const float* s0 = sl + kg * 256;
#pragma unroll 8
    for (int k = 0; k < 256; k++) {
        const float wv = w[(size_t)k * 6144];
        a0 += s0[k] * wv; a1 += s0[1024 + k] * wv; a2 += s0[2048 + k] * wv; a3 += s0[3072 + k] * wv; a4 += s0[4096 + k] * wv;
    }
    red[(kg * 5 + 0) * 64 + col] = a0; red[(kg * 5 + 1) * 64 + col] = a1; red[(kg * 5 + 2) * 64 + col] = a2;
    red[(kg * 5 + 3) * 64 + col] = a3; red[(kg * 5 + 4) * 64 + col] = a4;
    __syncthreads();
    for (int i = tid; i < 5 * 64; i += 256) {
        const int r = i >> 6, cc = i & 63;
        const float v = red[(0 * 5 + r) * 64 + cc] + red[(1 * 5 + r) * 64 + cc] + red[(2 * 5 + r) * 64 + cc] + red[(3 * 5 + r) * 64 + cc];
        mod[(size_t)(li * 5 + r) * 6144 + n0 + cc] = v + b_mod[li * 6144 + n0 + cc];
    }
}

__device__ __forceinline__ void d_norm_mod(const int bx, const int by, const int bz, char* smem, const float* __restrict__ xa, const float* __restrict__ xb, const float* __restrict__ g,
                                                  const float* __restrict__ modl, int shift_idx, int scale_idx, bf16_t* __restrict__ h) {
    float* red = (float*)smem;
    const int t = bx;
    const float* x = (t < TP) ? (xa + (size_t)t * DM) : (xb + (size_t)(t - TP) * DM);
    const int c = threadIdx.x * 4;
    float4 v = *(const float4*)(x + c);
    float ss = v.x * v.x + v.y * v.y + v.z * v.z + v.w * v.w;
    ss = wave_sum(ss);
    if ((threadIdx.x & 63) == 0) red[threadIdx.x >> 6] = ss;
    __syncthreads();
    float tot = red[0] + red[1] + red[2] + red[3];
    float rstd = rsqrtf(tot * (1.f / DM) + 1e-6f);
    const float* m = modl + (size_t)tok_modrow(t) * 6144;
    float4 gg = *(const float4*)(g + c);
    float4 sh = *(const float4*)(m + shift_idx * 1024 + c);
    float4 sc = *(const float4*)(m + scale_idx * 1024 + c);
    float4 o;
    o.x = v.x * rstd * gg.x * (1.f + sc.x) + sh.x;
    o.y = v.y * rstd * gg.y * (1.f + sc.y) + sh.y;
    o.z = v.z * rstd * gg.z * (1.f + sc.z) + sh.z;
    o.w = v.w * rstd * gg.w * (1.f + sc.w) + sh.w;
    ushort4 ob; ob.x = f2bf(o.x); ob.y = f2bf(o.y); ob.z = f2bf(o.z); ob.w = f2bf(o.w);
    *(ushort4*)(h + (size_t)t * DM + c) = ob;
}

struct EpiStore { static constexpr bool kQuad = false; float* C; const float* bias; int ldc; int pad;
    __device__ void operator()(int m, int n, float a) const { C[(size_t)m * ldc + n] = a + (bias ? bias[n] : 0.f); } };
struct EpiStoreBf { static constexpr bool kQuad = false; bf16_t* C; int ldc; int pad;
    __device__ void operator()(int m, int n, float a) const { C[(size_t)m * ldc + n] = f2bf(a); } };
struct EpiDecay { static constexpr bool kQuad = false; _Float16* out; const float* w0;
    __device__ void operator()(int m, int n, float a) const { out[(size_t)m * 512 + n] = (_Float16)sigmoidf_(w0[n] + a); } };
struct EpiProj { static constexpr bool kQuad = false; bf16_t* rw; float* mla;
    __device__ void operator()(int m, int n, float a) const { if (n < RWIN) rw[(size_t)m * RWIN + n] = f2bf(a); else mla[(size_t)m * 448 + (n - RWIN)] = a; } };
struct EpiLr { static constexpr bool kQuad = false; bf16_t* out; const float* a0;
    __device__ void operator()(int m, int n, float a) const { out[(size_t)m * 512 + n] = f2bf(sigmoidf_(a0[n] + a)); } };
struct EpiResid { static constexpr bool kQuad = false; const float* xa; const float* xb; float* out; const float* modl; int gate_idx; int pad;
    __device__ void operator()(int m, int n, float a) const {
        float x = (m < TP) ? xa[(size_t)m * DM + n] : xb[(size_t)(m - TP) * DM + n];
        float gt = modl[(size_t)tok_modrow(m) * 6144 + gate_idx * 1024 + n];
        out[(size_t)m * DM + n] = x + gt * a; } };

struct EpiKV { static constexpr bool kQuad = true;
    bf16_t* kvraw; bf16_t* Vp; bf16_t* Vs; int ctx; int pad;
    __device__ void operator()(int m, int n, float a) const {}
    __device__ void quad(int row0, int col, float v0, float v1, float v2, float v3) const {
        const int hd = col >> 8, within = col & 255;
        if (within < 128) {
            bf16_t* d = kvraw + (size_t)row0 * 1024 + col;
            d[0] = f2bf(v0); d[1024] = f2bf(v1); d[2048] = f2bf(v2); d[3072] = f2bf(v3);
        } else {
            const int dv = within - 128;
            int b, kidx, Lk; bf16_t* base;
            if (ctx) { b = row0 >> 8; kidx = row0 & 255; Lk = 2304; base = Vs; }
            else if (row0 < TP) { b = row0 >> 8; kidx = row0 & 255; Lk = LP; base = Vp; }
            else { b = (row0 - TP) >> 11; kidx = 256 + ((row0 - TP) & 2047); Lk = 2304; base = Vs; }
            const int kpos = (kidx & ~12) | ((kidx & 8) >> 1) | ((kidx & 4) << 1);
            ushort4 o; o.x = f2bf(v0); o.y = f2bf(v1); o.z = f2bf(v2); o.w = f2bf(v3);
            *(ushort4*)(base + ((size_t)((b * 4 + hd) * 128 + dv)) * Lk + kpos) = o;
        }
    } };

template <class Epi>
__device__ __forceinline__ void d_gemm(const int bx, const int by, const int bz, char* smem, const float* __restrict__ A, int lda, const float* __restrict__ B, int ldb, int K, Epi epi) {
    float (*As)[68] = (float(*)[68])smem;
    float (*Bs)[68] = (float(*)[68])(smem + 16 * 68 * 4);
    const int m0 = by * 64, n0 = bx * 64;
    const int tid = threadIdx.x, tx = tid & 15, ty = tid >> 4;
    float acc[4][4];
#pragma unroll
    for (int i = 0; i < 4; i++)
#pragma unroll
        for (int j = 0; j < 4; j++) acc[i][j] = 0.f;
    for (int k0 = 0; k0 < K; k0 += 16) {
        {
            int r = tid >> 2, kq = (tid & 3) * 4;
            float4 v = *(const float4*)(A + (size_t)(m0 + r) * lda + k0 + kq);
            As[kq + 0][r] = v.x; As[kq + 1][r] = v.y; As[kq + 2][r] = v.z; As[kq + 3][r] = v.w;
        }
        {
            int kk = tid >> 4, nq = (tid & 15) * 4;
            float4 v = *(const float4*)(B + (size_t)(k0 + kk) * ldb + n0 + nq);
            *(float4*)&Bs[kk][nq] = v;
        }
        __syncthreads();
#pragma unroll
        for (int k = 0; k < 16; k++) {
            float a[4], b[4];
#pragma unroll
            for (int i = 0; i < 4; i++) a[i] = As[k][ty * 4 + i];
            float4 bv = *(const float4*)&Bs[k][tx * 4];
            b[0] = bv.x; b[1] = bv.y; b[2] = bv.z; b[3] = bv.w;
#pragma unroll
            for (int i = 0; i < 4; i++)
#pragma unroll
                for (int j = 0; j < 4; j++) acc[i][j] += a[i] * b[j];
        }
        __syncthreads();
    }
#pragma unroll
    for (int i = 0; i < 4; i++)
#pragma unroll
        for (int j = 0; j < 4; j++) epi(m0 + ty * 4 + i, n0 + tx * 4 + j, acc[i][j]);
}


typedef __attribute__((ext_vector_type(8))) short bf16x8;
typedef __attribute__((ext_vector_type(16))) float f32x16;
typedef __attribute__((ext_vector_type(4))) float f32x4;
typedef __attribute__((ext_vector_type(4))) unsigned u32x4;
#define GEMM_LDS_BYTES 73728

template <class Epi>
__device__ __forceinline__ void d_gemm_bf16(const int bx, const int by, char* smem, const bf16_t* __restrict__ A, int lda,
                                            const bf16_t* __restrict__ Bt, int ldb, int K, int N, Epi epi) {
    const int tid = threadIdx.x, lane = tid & 63, wid = tid >> 6;
    const int wm = wid >> 1, wn = wid & 1;
    const int m0 = by * 128, n0 = bx * 128;
    f32x16 acc[2][2];
#pragma unroll
    for (int i = 0; i < 2; i++)
#pragma unroll
        for (int j = 0; j < 2; j++)
#pragma unroll
            for (int r = 0; r < 16; r++) acc[i][j][r] = 0.f;
    const int lrow = tid >> 3, lcol = (tid & 7) * 8;
    const bf16_t* ga = A + (size_t)(m0 + lrow) * lda + lcol;
    const bf16_t* gb = Bt + (size_t)(n0 + lrow) * ldb + lcol;
    u32x4 ra[4], rb[4];
    const int KT = K >> 6;
#pragma unroll
    for (int i = 0; i < 4; i++) { ra[i] = *(const u32x4*)(ga + (size_t)(32 * i) * lda); rb[i] = *(const u32x4*)(gb + (size_t)(32 * i) * ldb); }
    {
        char* sa = smem;
#pragma unroll
        for (int i = 0; i < 4; i++) { *(u32x4*)(sa + (lrow + 32 * i) * 144 + lcol * 2) = ra[i]; *(u32x4*)(sa + 18432 + (lrow + 32 * i) * 144 + lcol * 2) = rb[i]; }
    }
    __syncthreads();
    const int frow = lane & 31, fk = (lane >> 5) * 16;
    for (int kt = 0; kt < KT; kt++) {
        if (kt + 1 < KT) {
#pragma unroll
            for (int i = 0; i < 4; i++) { ra[i] = *(const u32x4*)(ga + (size_t)(32 * i) * lda + (kt + 1) * 64); rb[i] = *(const u32x4*)(gb + (size_t)(32 * i) * ldb + (kt + 1) * 64); }
        }
        const char* sa = smem + (kt & 1) * 36864;
        const char* sb = sa + 18432;
#pragma unroll
        for (int ks = 0; ks < 4; ks++) {
            bf16x8 af[2], bfr[2];
#pragma unroll
            for (int i = 0; i < 2; i++) af[i] = *(const bf16x8*)(sa + (wm * 64 + i * 32 + frow) * 144 + ks * 32 + fk);
#pragma unroll
            for (int j = 0; j < 2; j++) bfr[j] = *(const bf16x8*)(sb + (wn * 64 + j * 32 + frow) * 144 + ks * 32 + fk);
#pragma unroll
            for (int i = 0; i < 2; i++)
#pragma unroll
                for (int j = 0; j < 2; j++) acc[i][j] = __builtin_amdgcn_mfma_f32_32x32x16_bf16(af[i], bfr[j], acc[i][j], 0, 0, 0);
        }
        if (kt + 1 < KT) {
            char* sn = smem + ((kt + 1) & 1) * 36864;
#pragma unroll
            for (int i = 0; i < 4; i++) { *(u32x4*)(sn + (lrow + 32 * i) * 144 + lcol * 2) = ra[i]; *(u32x4*)(sn + 18432 + (lrow + 32 * i) * 144 + lcol * 2) = rb[i]; }
        }
        __syncthreads();
    }
#pragma unroll
    for (int i = 0; i < 2; i++)
#pragma unroll
        for (int j = 0; j < 2; j++) {
            const int col = n0 + wn * 64 + j * 32 + (lane & 31);
            if (col < N) {
                if constexpr (Epi::kQuad) {
#pragma unroll
                    for (int g = 0; g < 4; g++) {
                        const int row0 = m0 + wm * 64 + i * 32 + 8 * g + 4 * (lane >> 5);
                        epi.quad(row0, col, acc[i][j][4 * g], acc[i][j][4 * g + 1], acc[i][j][4 * g + 2], acc[i][j][4 * g + 3]);
                    }
                } else {
#pragma unroll
                    for (int r = 0; r < 16; r++) {
                        const int row = m0 + wm * 64 + i * 32 + (r & 3) + 8 * (r >> 2) + 4 * (lane >> 5);
                        epi(row, col, acc[i][j][r]);
                    }
                }
            }
        }
}

__device__ __forceinline__ void d_transpose_w(const int vb, char* smem, const float* __restrict__ W, int K, int N, bf16_t* __restrict__ Wt) {
    float (*tile)[65] = (float(*)[65])smem;
    const int kt = K >> 6;
    const int nb = vb / kt, kb = vb % kt;
    const int tid = threadIdx.x;
    {
        const int n = nb * 64 + (tid & 63);
#pragma unroll
        for (int i = 0; i < 16; i++) {
            int k = (tid >> 6) + 4 * i;
            tile[k][tid & 63] = (n < N) ? W[(size_t)(kb * 64 + k) * N + n] : 0.f;
        }
    }
    __syncthreads();
    {
        const int k = tid & 63;
#pragma unroll
        for (int i = 0; i < 16; i++) {
            int n = (tid >> 6) + 4 * i;
            Wt[(size_t)(nb * 64 + n) * K + kb * 64 + k] = f2bf(tile[k][n]);
        }
    }
}

__device__ __forceinline__ void d_rw_shift(const int bx, const int by, const int bz, char* smem, const bf16_t* __restrict__ proj, const float* __restrict__ mu, bf16_t* __restrict__ rb,
                                                  bf16_t* __restrict__ kb, bf16_t* __restrict__ vb, bf16_t* __restrict__ tw, bf16_t* __restrict__ adv,
                                                  bf16_t* __restrict__ sg) {
    const int t = bx;
    const int pos = tok_pos(t), L = tok_len(t);
    const bf16_t* P = proj + (size_t)t * RWIN;
    for (int c = threadIdx.x; c < RWIN; c += 256) {
        float cur = bf2f(P[c]);
        float prev = (pos > 0) ? bf2f(P[c - RWIN]) : 0.f;
        float nxt = (pos < L - 1) ? bf2f(P[c + RWIN]) : 0.f;
        float val = cur + mu[c] * (0.5f * (prev + nxt) - cur);
        if (c < 512) rb[(size_t)t * 512 + c] = f2bf(val);
        else if (c < 1024) kb[(size_t)t * 512 + c - 512] = f2bf(val);
        else if (c < 1536) vb[(size_t)t * 512 + c - 1024] = f2bf(val);
        else if (c < 1600) tw[(size_t)t * 64 + c - 1536] = f2bf(tanhf(val));
        else if (c < 1664) adv[(size_t)t * 64 + c - 1600] = f2bf(val);
        else sg[(size_t)t * 128 + c - 1664] = f2bf(sigmoidf_(val));
    }
}

__device__ __forceinline__ void d_rw_kk(const int bx, const int by, const int bz, char* smem, const bf16_t* __restrict__ rb, const bf16_t* __restrict__ kb, const bf16_t* __restrict__ lr0,
                                               const bf16_t* __restrict__ lr1, const float* __restrict__ k_k, const float* __restrict__ k_a,
                                               const float* __restrict__ r_k, bf16_t* __restrict__ kkb, float* __restrict__ bonus) {
    const int w = bx * 4 + (threadIdx.x >> 6);
    const int lane = threadIdx.x & 63;
    const int t = w >> 3, h = w & 7;
    const size_t o = (size_t)t * 512 + h * 64 + lane;
    const int ch = h * 64 + lane;
    float k = bf2f(kb[o]), r = bf2f(rb[o]);
    float kk = k * k_k[ch];
    float nrm = sqrtf(wave_sum(kk * kk));
    kk = kk / fmaxf(nrm, 1e-12f);
    kkb[o] = f2bf(kk);
    float l0 = bf2f(lr0[o]), l1 = bf2f(lr1[o]);
    float ka = k_a[ch];
    float kd0 = k * (1.f + (l0 - 1.f) * ka), kd1 = k * (1.f + (l1 - 1.f) * ka);
    float s = wave_sum(r * (kd0 + kd1) * r_k[ch]);
    if (lane == 0) bonus[w] = s;
}

__device__ __forceinline__ void d_scan(const int bx, const int by, const int bz, char* smem, const bf16_t* __restrict__ rb, const bf16_t* __restrict__ kb, const bf16_t* __restrict__ vb,
                                             const bf16_t* __restrict__ kkb, const bf16_t* __restrict__ lr0, const bf16_t* __restrict__ lr1,
                                             const _Float16* __restrict__ dec0, const _Float16* __restrict__ dec1, const float* __restrict__ k_a,
                                             const float* __restrict__ st_f, const float* __restrict__ st_b, float* __restrict__ y0,
                                             float* __restrict__ y1, float* __restrict__ out_sf, float* __restrict__ out_sb) {
    float* sbase = (float*)smem + (threadIdx.x >> 6) * 320;
    float* sa_ = sbase; float* sw_ = sbase + 64; float* sb_ = sbase + 128; float* skd_ = sbase + 192; float* sr_ = sbase + 256;
    int id = bx * 4 + (threadIdx.x >> 6);
    int d, h, b, L, tbase;
    bool prompt = id < 256;
    if (prompt) { d = id & 1; h = (id >> 1) & 7; b = id >> 4; L = LP; tbase = b * LP; }
    else { int j = id - 256; d = j & 1; h = (j >> 1) & 7; b = j >> 4; L = LS; tbase = TP + b * LS; }
    const int v = threadIdx.x & 63;
    const bf16_t* lr = d ? lr1 : lr0;
    const _Float16* dec = d ? dec1 : dec0;
    float* yo = d ? y1 : y0;
    const float ka = k_a[h * 64 + v];
    float S[64];
    if (prompt) {
#pragma unroll
        for (int k = 0; k < 64; k++) S[k] = 0.f;
    } else {
        const float* st = (d ? st_b : st_f) + ((size_t)(b * 8 + h) * 64 + v) * 64;
#pragma unroll
        for (int k = 0; k < 64; k += 4) { float4 q = *(const float4*)(st + k); S[k] = q.x; S[k + 1] = q.y; S[k + 2] = q.z; S[k + 3] = q.w; }
    }
    for (int i = 0; i < L; i++) {
        const int t = tbase + (d ? (L - 1 - i) : i);
        const size_t o = (size_t)t * 512 + h * 64 + v;
        float kkv = bf2f(kkb[o]), lrv = bf2f(lr[o]), kv = bf2f(kb[o]), rv = bf2f(rb[o]), vv = bf2f(vb[o]), wv = __expf(-0.6065306597126334f * (float)dec[o]);
        __builtin_amdgcn_wave_barrier();
        sa_[v] = -kkv; sb_[v] = kkv * lrv; skd_[v] = kv * (1.f + (lrv - 1.f) * ka); sw_[v] = wv; sr_[v] = rv;
        __builtin_amdgcn_wave_barrier();
        float sa = 0.f;
#pragma unroll
        for (int k = 0; k < 64; k += 4) { float4 a = *(const float4*)&sa_[k]; sa += S[k] * a.x + S[k + 1] * a.y + S[k + 2] * a.z + S[k + 3] * a.w; }
        float y = 0.f;
#pragma unroll
        for (int k = 0; k < 64; k += 4) {
            float4 w4 = *(const float4*)&sw_[k]; float4 b4 = *(const float4*)&sb_[k]; float4 k4 = *(const float4*)&skd_[k]; float4 r4 = *(const float4*)&sr_[k];
            S[k] = S[k] * w4.x + sa * b4.x + vv * k4.x; y += S[k] * r4.x;
            S[k + 1] = S[k + 1] * w4.y + sa * b4.y + vv * k4.y; y += S[k + 1] * r4.y;
            S[k + 2] = S[k + 2] * w4.z + sa * b4.z + vv * k4.z; y += S[k + 2] * r4.z;
            S[k + 3] = S[k + 3] * w4.w + sa * b4.w + vv * k4.w; y += S[k + 3] * r4.w;
        }
        yo[o] = y;
    }
    if (prompt) {
        float* os = (d ? out_sb : out_sf) + ((size_t)(b * 8 + h) * 64 + v) * 64;
#pragma unroll
        for (int k = 0; k < 64; k += 4) *(float4*)(os + k) = make_float4(S[k], S[k + 1], S[k + 2], S[k + 3]);
    }
}


#define SC_STEP 336
template <int CTRL>
__device__ __forceinline__ float dpp_add(float v) {
    return v + __int_as_float(__builtin_amdgcn_update_dpp(0, __float_as_int(v), CTRL, 0xf, 0xf, false));
}
__device__ __forceinline__ float row16_allsum(float v) {
    v = dpp_add<0x128>(v); v = dpp_add<0x124>(v); v = dpp_add<0x122>(v); v = dpp_add<0x121>(v);
    return v;
}
__device__ __forceinline__ void d_scan2(const int item, const bool sample, char* smem, const bf16_t* __restrict__ rb, const bf16_t* __restrict__ kb,
                                        const bf16_t* __restrict__ vb, const bf16_t* __restrict__ kkb, const bf16_t* __restrict__ lr0,
                                        const bf16_t* __restrict__ lr1, const _Float16* __restrict__ du0, const _Float16* __restrict__ du1,
                                        const float* __restrict__ k_a, const float* __restrict__ st_f, const float* __restrict__ st_b,
                                        float* __restrict__ y0, float* __restrict__ y1, float* __restrict__ out_sf, float* __restrict__ out_sb) {
    const int chain = item >> 2, qd = item & 3;
    const int d = chain & 1, h = (chain >> 1) & 7, b = chain >> 4;
    const int L = sample ? LS : LP;
    const int tbase = sample ? (TP + b * LS) : (b * LP);
    const int tid = threadIdx.x, wid = tid >> 6, lane = tid & 63;
    const int rr = lane >> 4, pp = lane & 15;
    const int row = qd * 16 + wid * 4 + rr;
    const bf16_t* lr = d ? lr1 : lr0;
    const _Float16* du = d ? du1 : du0;
    float* yo = d ? y1 : y0;
    float S0, S1, S2, S3;
    if (sample) {
        const float4 s4 = *(const float4*)((d ? st_b : st_f) + ((size_t)(b * 8 + h) * 64 + row) * 64 + pp * 4);
        S0 = s4.x; S1 = s4.y; S2 = s4.z; S3 = s4.w;
    } else { S0 = S1 = S2 = S3 = 0.f; }
    const int sk = tid & 63, ss = tid >> 6;
    const float ka = k_a[h * 64 + sk];
    const size_t colk = (size_t)h * 64 + sk;
    const size_t colv = (size_t)h * 64 + qd * 16 + (tid & 15);
    float* buf = (float*)smem;
    unsigned short g_kk[4], g_lr[4], g_k[4], g_r[4]; _Float16 g_u[4]; unsigned short g_v;
    const int nch = L >> 4;
#define SC_GLOAD(c)                                                                                        \
    {                                                                                                      \
        _Pragma("unroll") for (int j = 0; j < 4; j++) {                                                    \
            const int i = (c) * 16 + ss + 4 * j;                                                           \
            const size_t o = (size_t)(tbase + (d ? (L - 1 - i) : i)) * 512 + colk;                         \
            g_kk[j] = kkb[o]; g_lr[j] = lr[o]; g_k[j] = kb[o]; g_r[j] = rb[o]; g_u[j] = du[o];             \
        }                                                                                                  \
        { const int i = (c) * 16 + (tid >> 4); g_v = vb[(size_t)(tbase + (d ? (L - 1 - i) : i)) * 512 + colv]; } \
    }
#define SC_SSTORE(bi)                                                                                      \
    {                                                                                                      \
        float* B_ = buf + (bi) * 16 * SC_STEP;                                                             \
        _Pragma("unroll") for (int j = 0; j < 4; j++) {                                                    \
            float* st_ = B_ + (ss + 4 * j) * SC_STEP + sk;                                                 \
            const float kkv = bf2f(g_kk[j]), lrv = bf2f(g_lr[j]), kv = bf2f(g_k[j]);                       \
            st_[0] = -kkv; st_[64] = __expf(-0.6065306597126334f * (float)g_u[j]); st_[128] = kkv * lrv;   \
            st_[192] = kv * (1.f + (lrv - 1.f) * ka); st_[256] = bf2f(g_r[j]);                             \
        }                                                                                                  \
        B_[(tid >> 4) * SC_STEP + 320 + (tid & 15)] = bf2f(g_v);                                           \
    }
    SC_GLOAD(0)
    SC_SSTORE(0)
    __syncthreads();
    for (int c = 0; c < nch; c++) {
        if (c + 1 < nch) SC_GLOAD(c + 1)
        const float* B_ = buf + (c & 1) * 16 * SC_STEP;
#pragma unroll 4
        for (int s_ = 0; s_ < 16; s_++) {
            const float* st_ = B_ + s_ * SC_STEP;
            const float4 a4 = *(const float4*)(st_ + pp * 4);
            const float4 w4 = *(const float4*)(st_ + 64 + pp * 4);
            const float4 b4 = *(const float4*)(st_ + 128 + pp * 4);
            const float4 k4 = *(const float4*)(st_ + 192 + pp * 4);
            const float4 r4 = *(const float4*)(st_ + 256 + pp * 4);
            const float vv = st_[320 + wid * 4 + rr];
            float sa = (S0 * a4.x + S1 * a4.y) + (S2 * a4.z + S3 * a4.w);
            sa = row16_allsum(sa);
            S0 = S0 * w4.x + (sa * b4.x + vv * k4.x);
            S1 = S1 * w4.y + (sa * b4.y + vv * k4.y);
            S2 = S2 * w4.z + (sa * b4.z + vv * k4.z);
            S3 = S3 * w4.w + (sa * b4.w + vv * k4.w);
            float y = (S0 * r4.x + S1 * r4.y) + (S2 * r4.z + S3 * r4.w);
            y = row16_allsum(y);
            if (pp == 0) {
                const int i = c * 16 + s_;
                yo[(size_t)(tbase + (d ? (L - 1 - i) : i)) * 512 + h * 64 + row] = y;
            }
        }
        if (c + 1 < nch) SC_SSTORE((c + 1) & 1)
        __syncthreads();
    }
    if (!sample) {
        float* os = (d ? out_sb : out_sf) + ((size_t)(b * 8 + h) * 64 + row) * 64 + pp * 4;
        *(float4*)os = make_float4(S0, S1, S2, S3);
    }
}

__device__ __forceinline__ void d_rw_post(const int bx, const int by, const int bz, char* smem, const float* __restrict__ y0, const float* __restrict__ y1, const float* __restrict__ bonus,
                                                 const bf16_t* __restrict__ vb, const bf16_t* __restrict__ gate, const float* __restrict__ lnx_g,
                                                 const float* __restrict__ lnx_b, bf16_t* __restrict__ cat) {
    const int w = bx * 4 + (threadIdx.x >> 6);
    const int lane = threadIdx.x & 63;
    const int t = w >> 3, h = w & 7;
    const size_t o = (size_t)t * 512 + h * 64 + lane;
    const int ch = h * 64 + lane;
    float y = y0[o] + y1[o];
    float mean = wave_sum(y) * (1.f / 64.f);
    float dlt = y - mean;
    float var = wave_sum(dlt * dlt) * (1.f / 64.f);
    float yn = dlt * rsqrtf(var + 64e-5f) * lnx_g[ch] + lnx_b[ch];
    float val = (yn + bonus[w] * bf2f(vb[o])) * bf2f(gate[o]);
    cat[(size_t)t * DM + ch] = f2bf(val);
}

__device__ __forceinline__ void d_mla_pre(const int bx, const int by, const int bz, char* smem, const float* __restrict__ proj, const float* __restrict__ q_norm, const float* __restrict__ kv_norm,
                                                 bf16_t* __restrict__ qcn, bf16_t* __restrict__ ckv, float* __restrict__ kpe,
                                                 float* __restrict__ out_ckv, float* __restrict__ out_kpe) {
    float* red = (float*)smem; float* red2 = red + 4;
    const int t = bx;
    const int tid = threadIdx.x;
    const float* P = proj + (size_t)t * 448;
    float q = P[tid];
    float kv = (tid < 128) ? P[256 + tid] : 0.f;
    float ss = wave_sum(q * q);
    float s2 = wave_sum(kv * kv);
    if ((tid & 63) == 0) { red[tid >> 6] = ss; red2[tid >> 6] = s2; }
    __syncthreads();
    float rq = rsqrtf((red[0] + red[1] + red[2] + red[3]) * (1.f / 256.f) + 1e-6f);
    float rk = rsqrtf((red2[0] + red2[1] + red2[2] + red2[3]) * (1.f / 128.f) + 1e-6f);
    qcn[(size_t)t * 256 + tid] = f2bf(q * rq * q_norm[tid]);
    if (tid < 128) {
        float val = kv * rk * kv_norm[tid];
        ckv[(size_t)t * 128 + tid] = f2bf(val);
        if (t < TP) out_ckv[(size_t)t * 128 + tid] = val;
    } else if (tid < 192) {
        float pe = P[384 + tid - 128];
        kpe[(size_t)t * 64 + tid - 128] = pe;
        if (t < TP) out_kpe[(size_t)t * 64 + tid - 128] = pe;
    }
}

__device__ __forceinline__ void d_mla_post(const int bx, const int by, const int bz, char* smem, const bf16_t* __restrict__ qraw, const bf16_t* __restrict__ kvraw, const bf16_t* __restrict__ kvraw_ctx,
                                                  const float* __restrict__ kpe, const float* __restrict__ cache_kpe, const float* __restrict__ qn,
                                                  const float* __restrict__ kn, bf16_t* __restrict__ Qb, bf16_t* __restrict__ Kp, bf16_t* __restrict__ Vp,
                                                  bf16_t* __restrict__ Ks, bf16_t* __restrict__ Vs) {
    float (*sq)[192] = (float(*)[192])smem; float (*sk)[192] = (float(*)[192])(smem + 4 * 192 * 4);
    const int wi = threadIdx.x >> 6, lane = threadIdx.x & 63;
    const int row = bx, h = wi;
    const bool isctx = row >= TT;
    const bool sample = row >= TP;
    float kx[3], qx[3] = {0.f, 0.f, 0.f};
    const bf16_t* kvr; const float* pe; int pos = 0;
    if (isctx) { int cr = row - TT; kvr = kvraw_ctx + (size_t)cr * 1024; pe = cache_kpe + (size_t)cr * 64; }
    else { kvr = kvraw + (size_t)row * 1024; pe = kpe + (size_t)row * 64; pos = tok_pos(row); }
#pragma unroll
    for (int j = 0; j < 3; j++) {
        int i = lane + 64 * j;
        kx[j] = (i < 128) ? bf2f(kvr[h * 256 + i]) : pe[i - 128];
        if (!isctx) qx[j] = bf2f(qraw[(size_t)row * 768 + h * 192 + i]);
    }
    float ssk = wave_sum(kx[0] * kx[0] + kx[1] * kx[1] + kx[2] * kx[2]);
    float ssq = wave_sum(qx[0] * qx[0] + qx[1] * qx[1] + qx[2] * qx[2]);
    float rk = rsqrtf(ssk * (1.f / 192.f) + 1e-6f), rq = rsqrtf(ssq * (1.f / 192.f) + 1e-6f);
#pragma unroll
    for (int j = 0; j < 3; j++) {
        int i = lane + 64 * j;
        sk[wi][i] = kx[j] * rk * kn[i];
        sq[wi][i] = qx[j] * rq * qn[i];
    }
    __syncthreads();
    if (sample && !isctx && lane < 32) {
        int rowi = pos >> 6, coli = pos & 63;
        int fi = lane & 15;
        float inv = expf(-(float)fi * (1.f / 16.f) * 9.210340371976184f);
        float ang = (lane < 16 ? (float)rowi : (float)coli) * inv;
        float cs = cosf(ang), sn = sinf(ang);
        float a = sk[wi][128 + 2 * lane], bq = sk[wi][128 + 2 * lane + 1];
        sk[wi][128 + 2 * lane] = a * cs - bq * sn; sk[wi][128 + 2 * lane + 1] = a * sn + bq * cs;
        a = sq[wi][128 + 2 * lane]; bq = sq[wi][128 + 2 * lane + 1];
        sq[wi][128 + 2 * lane] = a * cs - bq * sn; sq[wi][128 + 2 * lane + 1] = a * sn + bq * cs;
    }
    __syncthreads();
    bf16_t* kd; bf16_t* vd; int vLk, kidx;
    if (!sample) { int b = row >> 8, p = row & 255; kd = Kp + ((size_t)(b * 4 + h) * LP + p) * 192; vd = Vp + (size_t)(b * 4 + h) * 128 * LP; vLk = LP; kidx = p; }
    else if (!isctx) { int b = (row - TP) >> 11, p = (row - TP) & 2047; kd = Ks + ((size_t)(b * 4 + h) * 2304 + 256 + p) * 192; vd = Vs + (size_t)(b * 4 + h) * 128 * 2304; vLk = 2304; kidx = 256 + p; }
    else { int cr = row - TT; int b = cr >> 8, p = cr & 255; kd = Ks + ((size_t)(b * 4 + h) * 2304 + p) * 192; vd = Vs + (size_t)(b * 4 + h) * 128 * 2304; vLk = 2304; kidx = p; }
    const int kpos = (kidx & ~12) | ((kidx & 8) >> 1) | ((kidx & 4) << 1);
#pragma unroll
    for (int j = 0; j < 3; j++) {
        int i = lane + 64 * j;
        kd[i] = f2bf(sk[wi][i]);
        if (!isctx) Qb[((size_t)row * 4 + h) * 192 + i] = f2bf(sq[wi][i]);
    }
    vd[(size_t)lane * vLk + kpos] = kvr[h * 256 + 128 + lane];
    vd[(size_t)(lane + 64) * vLk + kpos] = kvr[h * 256 + 128 + lane + 64];
}

__device__ __forceinline__ void d_attn(const int bx, const int by, const int bz, char* smem, const bf16_t* __restrict__ Qb, const bf16_t* __restrict__ Kall, const bf16_t* __restrict__ Vall,
                                              bf16_t* __restrict__ cat, int tbase, int Lq, int Lk) {
    float (*Vsm)[128] = (float(*)[128])smem;
    float (*Qs)[192] = (float(*)[192])(smem + 32 * 128 * 4);
    float (*Ksm)[193] = (float(*)[193])(smem + 32 * 128 * 4 + 16 * 192 * 4);
    float (*Ss)[33] = (float(*)[33])(smem + 32 * 128 * 4 + 16 * 192 * 4 + 32 * 193 * 4);
    const int q0 = bx * 16, h = by, b = bz;
    const int tid = threadIdx.x;
    const int qi = tid >> 4, sub = tid & 15;
    const bf16_t* K = Kall + (size_t)(b * 4 + h) * Lk * 192;
    const bf16_t* V = Vall + (size_t)(b * 4 + h) * Lk * 128;
    for (int i = tid; i < 16 * 192; i += 256) {
        int r = i / 192, c = i % 192;
        int t = tbase + b * Lq + q0 + r;
        Qs[r][c] = bf2f(Qb[((size_t)t * 4 + h) * 192 + c]);
    }
    float m = -1e30f, l = 0.f;
    float acc[8];
#pragma unroll
    for (int j = 0; j < 8; j++) acc[j] = 0.f;
    const float scale = 0.07216878364870322f;
    for (int k0 = 0; k0 < Lk; k0 += 32) {
        __syncthreads();
        for (int i = tid; i < 32 * 192; i += 256) { int r = i / 192, c = i % 192; Ksm[r][c] = bf2f(K[(size_t)(k0 + r) * 192 + c]); }
        for (int i = tid; i < 32 * 128; i += 256) { int r = i >> 7, c = i & 127; Vsm[r][c] = bf2f(V[(size_t)(k0 + r) * 128 + c]); }
        __syncthreads();
        float s0 = 0.f, s1 = 0.f;
        for (int dd = 0; dd < 192; dd++) { float qv = Qs[qi][dd]; s0 += qv * Ksm[sub][dd]; s1 += qv * Ksm[sub + 16][dd]; }
        s0 *= scale; s1 *= scale;
        float mx = fmaxf(s0, s1);
#pragma unroll
        for (int o = 8; o > 0; o >>= 1) mx = fmaxf(mx, __shfl_xor(mx, o, 64));
        float mn = fmaxf(m, mx);
        float alpha = expf(m - mn);
        float p0 = expf(s0 - mn), p1 = expf(s1 - mn);
        float ps = p0 + p1;
#pragma unroll
        for (int o = 8; o > 0; o >>= 1) ps += __shfl_xor(ps, o, 64);
        l = l * alpha + ps; m = mn;
        Ss[qi][sub] = p0; Ss[qi][sub + 16] = p1;
        __syncthreads();
#pragma unroll
        for (int j = 0; j < 8; j++) acc[j] *= alpha;
        for (int kk = 0; kk < 32; kk++) {
            float p = Ss[qi][kk];
            float4 v0 = *(const float4*)&Vsm[kk][sub * 8], v1 = *(const float4*)&Vsm[kk][sub * 8 + 4];
            acc[0] += p * v0.x; acc[1] += p * v0.y; acc[2] += p * v0.z; acc[3] += p * v0.w;
            acc[4] += p * v1.x; acc[5] += p * v1.y; acc[6] += p * v1.z; acc[7] += p * v1.w;
        }
    }
    const int t = tbase + b * Lq + q0 + qi;
    float il = 1.f / l;
    bf16_t* o = cat + (size_t)t * DM + 512 + h * 128 + sub * 8;
#pragma unroll
    for (int j = 0; j < 8; j++) o[j] = f2bf(acc[j] * il);
}


#define ATT_SV_OFF 25600
#define ATT_SQ_OFF 44032
__device__ __forceinline__ void d_attn_mfma(const int item, char* smem, const bf16_t* __restrict__ Qb, const bf16_t* __restrict__ Kall,
                                            const bf16_t* __restrict__ VtAll, bf16_t* __restrict__ cat, int tbase, int Lq, int Lk, int nqb) {
    const int qb = item % nqb, bh = item / nqb;
    const int b = bh >> 2, h = bh & 3;
    const int tid = threadIdx.x, lane = tid & 63, wid = tid >> 6;
    const int q = lane & 31, hh = lane >> 5;
    const int t = tbase + b * Lq + qb * 128 + wid * 32 + q;
    char* sQ = smem + ATT_SQ_OFF;
    {
        const bf16_t* qg = Qb + ((size_t)(tbase + b * Lq + qb * 128) * 4 + h) * 192;
#pragma unroll
        for (int i = 0; i < 12; i++) {
            const int c = tid + 256 * i;
            const int r = c / 24, cc = c % 24;
            *(u32x4*)(sQ + r * 400 + cc * 16) = *(const u32x4*)(qg + (size_t)r * 768 + cc * 8);
        }
    }
    const char* sQw = sQ + (wid * 32 + q) * 400 + hh * 16;
    f32x16 o[4];
#pragma unroll
    for (int i = 0; i < 4; i++)
#pragma unroll
        for (int r = 0; r < 16; r++) o[i][r] = 0.f;
    float m = -1e30f, l = 0.f;
    const bf16_t* K = Kall + (size_t)bh * Lk * 192;
    const bf16_t* Vt = VtAll + (size_t)bh * 128 * Lk;
    char* sK = smem;
    char* sV = smem + ATT_SV_OFF;
    u32x4 pk[6], pv[4];
    const int nkt = Lk >> 6;
#pragma unroll
    for (int i = 0; i < 6; i++) pk[i] = *(const u32x4*)(K + (size_t)(tid + 256 * i) * 8);
#pragma unroll
    for (int i = 0; i < 4; i++) { int c = tid + 256 * i; pv[i] = *(const u32x4*)(Vt + (size_t)(c >> 3) * Lk + (c & 7) * 8); }
#pragma unroll
    for (int i = 0; i < 6; i++) { int c = tid + 256 * i; *(u32x4*)(sK + (c / 24) * 400 + (c % 24) * 16) = pk[i]; }
#pragma unroll
    for (int i = 0; i < 4; i++) { int c = tid + 256 * i; *(u32x4*)(sV + (c >> 3) * 144 + (c & 7) * 16) = pv[i]; }
    __syncthreads();
    const float sc2 = 0.07216878364870322f * 1.4426950408889634f;
    for (int kt = 0; kt < nkt; kt++) {
        if (kt + 1 < nkt) {
            const bf16_t* Kn = K + (size_t)(kt + 1) * 64 * 192;
            const bf16_t* Vn = Vt + (kt + 1) * 64;
#pragma unroll
            for (int i = 0; i < 6; i++) pk[i] = *(const u32x4*)(Kn + (size_t)(tid + 256 * i) * 8);
#pragma unroll
            for (int i = 0; i < 4; i++) { int c = tid + 256 * i; pv[i] = *(const u32x4*)(Vn + (size_t)(c >> 3) * Lk + (c & 7) * 8); }
        }
        f32x16 st[2];
#pragma unroll
        for (int bk = 0; bk < 2; bk++)
#pragma unroll
            for (int r = 0; r < 16; r++) st[bk][r] = 0.f;
#pragma unroll
        for (int ks = 0; ks < 12; ks++) {
            const bf16x8 qfk = *(const bf16x8*)(sQw + ks * 32);
#pragma unroll
            for (int bk = 0; bk < 2; bk++) {
                bf16x8 a = *(const bf16x8*)(sK + (bk * 32 + q) * 400 + ks * 32 + hh * 16);
                st[bk] = __builtin_amdgcn_mfma_f32_32x32x16_bf16(a, qfk, st[bk], 0, 0, 0);
            }
        }
        float mx = -1e30f;
#pragma unroll
        for (int bk = 0; bk < 2; bk++)
#pragma unroll
            for (int r = 0; r < 16; r++) { st[bk][r] *= sc2; mx = fmaxf(mx, st[bk][r]); }
        mx = fmaxf(mx, __shfl_xor(mx, 32, 64));
        const float mn = fmaxf(m, mx);
        const float alpha = exp2f(m - mn);
        float ps = 0.f;
#pragma unroll
        for (int bk = 0; bk < 2; bk++)
#pragma unroll
            for (int r = 0; r < 16; r++) { st[bk][r] = exp2f(st[bk][r] - mn); ps += st[bk][r]; }
        ps += __shfl_xor(ps, 32, 64);
        l = l * alpha + ps; m = mn;
#pragma unroll
        for (int i = 0; i < 4; i++)
#pragma unroll
            for (int r = 0; r < 16; r++) o[i][r] *= alpha;
#pragma unroll
        for (int s4 = 0; s4 < 4; s4++) {
            bf16x8 pb;
#pragma unroll
            for (int j = 0; j < 8; j++) pb[j] = (short)f2bf(st[s4 >> 1][8 * (s4 & 1) + j]);
#pragma unroll
            for (int i = 0; i < 4; i++) {
                bf16x8 a = *(const bf16x8*)(sV + (i * 32 + q) * 144 + s4 * 32 + hh * 16);
                o[i] = __builtin_amdgcn_mfma_f32_32x32x16_bf16(a, pb, o[i], 0, 0, 0);
            }
        }
        __syncthreads();
        if (kt + 1 < nkt) {
#pragma unroll
            for (int i = 0; i < 6; i++) { int c = tid + 256 * i; *(u32x4*)(sK + (c / 24) * 400 + (c % 24) * 16) = pk[i]; }
#pragma unroll
            for (int i = 0; i < 4; i++) { int c = tid + 256 * i; *(u32x4*)(sV + (c >> 3) * 144 + (c & 7) * 16) = pv[i]; }
        }
        __syncthreads();
    }
    const float il = 1.f / l;
    bf16_t* op = cat + (size_t)t * DM + 512 + h * 128;
#pragma unroll
    for (int i = 0; i < 4; i++)
#pragma unroll
        for (int g = 0; g < 4; g++) {
            ushort4 w;
            w.x = f2bf(o[i][4 * g + 0] * il); w.y = f2bf(o[i][4 * g + 1] * il); w.z = f2bf(o[i][4 * g + 2] * il); w.w = f2bf(o[i][4 * g + 3] * il);
            *(ushort4*)(op + i * 32 + 8 * g + 4 * hh) = w;
        }
}

__device__ __forceinline__ void d_peer_route(const int bx, const int by, const int bz, char* smem, const float* __restrict__ qp, const float* __restrict__ keys  ,
                                                    int* __restrict__ pidx, float* __restrict__ pg) {
    float (*sq)[256] = (float(*)[256])smem;
    float (*sc)[256] = (float(*)[256])(smem + 4096);
    float (*tv)[32] = (float(*)[32])(smem + 8192);
    int (*ti)[32] = (int(*)[32])(smem + 8192 + 512);
    float (*topv)[16] = (float(*)[16])(smem + 8192 + 1024);
    int (*topi)[16] = (int(*)[16])(smem + 8192 + 1024 + 256);
    const int wi = threadIdx.x >> 6, lane = threadIdx.x & 63;
    const int w = bx * 4 + wi;
    const int t = w >> 3, h = w & 7;
    const float* q = qp + (size_t)t * 2048 + h * 256;
#pragma unroll
    for (int j = 0; j < 4; j++) sq[wi][lane + 64 * j] = q[lane + 64 * j];
    __syncthreads();
#pragma unroll
    for (int p = 0; p < 2; p++)
#pragma unroll
        for (int half = 0; half < 2; half++) {
            int n = lane + 64 * half;
            const float* kr = keys + ((size_t)(h * 2 + p) * 128 + n) * 128;
            float s = 0.f;
            for (int dd = 0; dd < 128; dd += 4) {
                float4 kv = *(const float4*)(kr + dd);
                s += sq[wi][p * 128 + dd] * kv.x + sq[wi][p * 128 + dd + 1] * kv.y + sq[wi][p * 128 + dd + 2] * kv.z + sq[wi][p * 128 + dd + 3] * kv.w;
            }
            sc[wi][p * 128 + n] = s;
        }
    __syncthreads();
#pragma unroll
    for (int p = 0; p < 2; p++)
#pragma unroll
        for (int half = 0; half < 2; half++) {
            int n = lane + 64 * half;
            float s = sc[wi][p * 128 + n];
            int rank = 0;
            for (int j = 0; j < 128; j++) { float o = sc[wi][p * 128 + j]; rank += (o > s || (o == s && j < n)) ? 1 : 0; }
            if (rank < 16) { tv[wi][p * 16 + rank] = s; ti[wi][p * 16 + rank] = n; }
        }
    __syncthreads();
    float cv[4];
#pragma unroll
    for (int j = 0; j < 4; j++) { int c = lane + 64 * j; cv[j] = tv[wi][c >> 4] + tv[wi][16 + (c & 15)]; }
    __syncthreads();
#pragma unroll
    for (int j = 0; j < 4; j++) sc[wi][lane + 64 * j] = cv[j];
    __syncthreads();
#pragma unroll
    for (int j = 0; j < 4; j++) {
        int c = lane + 64 * j;
        float s = cv[j];
        int rank = 0;
        for (int i = 0; i < 256; i++) { float o = sc[wi][i]; rank += (o > s || (o == s && i < c)) ? 1 : 0; }
        if (rank < 16) { topv[wi][rank] = s; topi[wi][rank] = (ti[wi][c >> 4] * 128 + ti[wi][16 + (c & 15)]) & 16383; }
    }
    __syncthreads();
    if (lane < 16) {
        float mx = topv[wi][0];
        float sum = 0.f;
        for (int i = 0; i < 16; i++) sum += expf(topv[wi][i] - mx);
        pg[(size_t)w * 16 + lane] = expf(topv[wi][lane] - mx) / sum;
        pidx[(size_t)w * 16 + lane] = topi[wi][lane] & 16383;
    }
}

__device__ __forceinline__ void d_peer_apply(const int bx, const int by, const int bz, char* smem, const bf16_t* __restrict__ hbuf, const int* __restrict__ pidx, const float* __restrict__ pg,
                                                    const float* __restrict__ utab, const float* __restrict__ vtab, const float* __restrict__ modl,
                                                    float* __restrict__ xrun) {
    float* coef = (float*)smem; int* eid = (int*)(smem + 512);
    const int t = bx, tid = threadIdx.x, wi = tid >> 6, lane = tid & 63;
    if (tid < 128) eid[tid] = pidx[(size_t)t * 128 + tid];
    float4 xv[4];
#pragma unroll
    for (int j = 0; j < 4; j++) { ushort4 q = *(const ushort4*)(hbuf + (size_t)t * DM + j * 256 + lane * 4); xv[j] = make_float4(bf2f(q.x), bf2f(q.y), bf2f(q.z), bf2f(q.w)); }
    __syncthreads();
    for (int e = wi * 32; e < wi * 32 + 32; e++) {
        const float* ur = utab + (size_t)eid[e] * DM;
        float s = 0.f;
#pragma unroll
        for (int j = 0; j < 4; j++) { float4 u = *(const float4*)(ur + j * 256 + lane * 4); s += u.x * xv[j].x + u.y * xv[j].y + u.z * xv[j].z + u.w * xv[j].w; }
        s = wave_sum(s);
        if (lane == 0) coef[e] = pg[(size_t)t * 128 + e] * gelu_tanh(s);
    }
    __syncthreads();
    float4 acc = make_float4(0.f, 0.f, 0.f, 0.f);
    for (int e = 0; e < 128; e++) {
        float cf = coef[e];
        float4 v = *(const float4*)(vtab + (size_t)eid[e] * DM + tid * 4);
        acc.x += cf * v.x; acc.y += cf * v.y; acc.z += cf * v.z; acc.w += cf * v.w;
    }
    const float* m = modl + (size_t)tok_modrow(t) * 6144 + 5 * 1024 + tid * 4;
    float* xo = xrun + (size_t)t * DM + tid * 4;
    float4 x = *(float4*)xo;
    x.x += m[0] * acc.x; x.y += m[1] * acc.y; x.z += m[2] * acc.z; x.w += m[3] * acc.w;
    *(float4*)xo = x;
}


template <int K, int J>
__device__ __forceinline__ void bit_stage16(float (&x)[16]) {
#pragma unroll
    for (int i = 0; i < 16; i++) {
        const int l = i ^ J;
        if (l > i) {
            const bool desc = ((i & K) == 0);
            const float a = x[i], b = x[l];
            const float hi = fmaxf(a, b), lo = fminf(a, b);
            x[i] = desc ? hi : lo; x[l] = desc ? lo : hi;
        }
    }
}
__device__ __forceinline__ void bit_sort16_desc(float (&x)[16]) {
    bit_stage16<2, 1>(x);
    bit_stage16<4, 2>(x); bit_stage16<4, 1>(x);
    bit_stage16<8, 4>(x); bit_stage16<8, 2>(x); bit_stage16<8, 1>(x);
    bit_stage16<16, 8>(x); bit_stage16<16, 4>(x); bit_stage16<16, 2>(x); bit_stage16<16, 1>(x);
}
__device__ __forceinline__ void bit_merge16_desc(float (&x)[16]) {
    bit_stage16<16, 8>(x); bit_stage16<16, 4>(x); bit_stage16<16, 2>(x); bit_stage16<16, 1>(x);
}
template <int K, int J>
__device__ __forceinline__ void bit_stage16u(unsigned (&x)[16]) {
#pragma unroll
    for (int i = 0; i < 16; i++) {
        const int l = i ^ J;
        if (l > i) {
            const bool asc = ((i & K) == 0);
            const unsigned a = x[i], b = x[l];
            const unsigned lo = a < b ? a : b, hi = a < b ? b : a;
            x[i] = asc ? lo : hi; x[l] = asc ? hi : lo;
        }
    }
}
__device__ __forceinline__ void bit_sort16u_asc(unsigned (&x)[16]) {
    bit_stage16u<2, 1>(x);
    bit_stage16u<4, 2>(x); bit_stage16u<4, 1>(x);
    bit_stage16u<8, 4>(x); bit_stage16u<8, 2>(x); bit_stage16u<8, 1>(x);
    bit_stage16u<16, 8>(x); bit_stage16u<16, 4>(x); bit_stage16u<16, 2>(x); bit_stage16u<16, 1>(x);
}
__device__ __forceinline__ void bit_merge16u_asc(unsigned (&x)[16]) {
    bit_stage16u<16, 8>(x); bit_stage16u<16, 4>(x); bit_stage16u<16, 2>(x); bit_stage16u<16, 1>(x);
}
__device__ __forceinline__ void top16_merge(float (&L)[16], const float (&C)[16]) {
#pragma unroll
    for (int i = 0; i < 16; i++) L[i] = fmaxf(L[i], C[15 - i]);
    bit_merge16_desc(L);
}
__device__ __forceinline__ void low16_merge_u(unsigned (&L)[16], const unsigned (&C)[16]) {
#pragma unroll
    for (int i = 0; i < 16; i++) { const unsigned c = C[15 - i]; L[i] = L[i] < c ? L[i] : c; }
    bit_merge16u_asc(L);
}
__device__ __forceinline__ float key_val(float k) { return __uint_as_float(__float_as_uint(k) & ~127u); }
__device__ __forceinline__ int key_idx(float k) { return (int)(__float_as_uint(k) & 127u); }

__device__ __forceinline__ void d_peer_select(const int vb, const float* __restrict__ scT, int* __restrict__ pidx, float* __restrict__ pg) {
    const int h = vb & 7;
    const int t = (vb >> 3) * 256 + threadIdx.x;
    float A[16], B[16];
#pragma unroll
    for (int p = 0; p < 2; p++) {
        const float* S = scT + (size_t)(h * 2 + p) * 128 * TT + t;
        float L[16];
#pragma unroll
        for (int ch = 0; ch < 8; ch++) {
            float C[16];
#pragma unroll
            for (int i = 0; i < 16; i++) {
                const int n = ch * 16 + i;
                C[i] = __uint_as_float((__float_as_uint(S[(size_t)n * TT]) & ~127u) | (unsigned)n);
            }
            bit_sort16_desc(C);
            if (ch == 0) {
#pragma unroll
                for (int i = 0; i < 16; i++) L[i] = C[i];
            } else top16_merge(L, C);
        }
#pragma unroll
        for (int i = 0; i < 16; i++) { if (p == 0) A[i] = L[i]; else B[i] = L[i]; }
    }
    const float smax = key_val(A[0]) + key_val(B[0]);
    unsigned Tk[16];
#pragma unroll
    for (int g = 0; g < 4; g++) {
        unsigned Ck[16];
#pragma unroll
        for (int e = 0; e < 16; e++) {
            const int c = g * 16 + e;
            int i, j;
            if (c < 16) { i = 0; j = c; }
            else if (c < 24) { i = 1; j = c - 16; }
            else if (c < 29) { i = 2; j = c - 24; }
            else if (c < 33) { i = 3; j = c - 29; }
            else if (c < 36) { i = 4; j = c - 33; }
            else if (c < 42) { i = 5 + (c - 36) / 2; j = (c - 36) % 2; }
            else if (c < 50) { i = 8 + (c - 42); j = 0; }
            else { i = -1; j = 0; }
            if (i >= 0) {
                const float dd = smax - (key_val(A[i]) + key_val(B[j]));
                unsigned qd = (unsigned)fminf(dd * 32768.f, 262143.f);
                Ck[e] = (qd << 14) | (unsigned)(key_idx(A[i]) * 128 + key_idx(B[j]));
            } else Ck[e] = 0xffffffffu;
        }
        bit_sort16u_asc(Ck);
        if (g == 0) {
#pragma unroll
            for (int e = 0; e < 16; e++) Tk[e] = Ck[e];
        } else low16_merge_u(Tk, Ck);
    }
    float sum = 0.f;
    float w[16]; int Tp[16];
#pragma unroll
    for (int e = 0; e < 16; e++) { w[e] = __expf(-(float)(Tk[e] >> 14) * (1.f / 32768.f)); sum += w[e]; Tp[e] = (int)(Tk[e] & 16383u); }
    const float inv = 1.f / sum;
    int* pi = pidx + ((size_t)t * 8 + h) * 16;
    float* pw = pg + ((size_t)t * 8 + h) * 16;
#pragma unroll
    for (int e = 0; e < 16; e += 4) {
        *(int4*)(pi + e) = make_int4(Tp[e], Tp[e + 1], Tp[e + 2], Tp[e + 3]);
        *(float4*)(pw + e) = make_float4(w[e] * inv, w[e + 1] * inv, w[e + 2] * inv, w[e + 3] * inv);
    }
}

typedef __attribute__((ext_vector_type(2))) short bf16x2;
__device__ __forceinline__ float dot8_bf16(u32x4 a, u32x4 b, float acc) {
#pragma unroll
    for (int i = 0; i < 4; i++) {
        const unsigned x = a[i], y = b[i];
        acc += __uint_as_float(x << 16) * __uint_as_float(y << 16);
        acc += __uint_as_float(x & 0xffff0000u) * __uint_as_float(y & 0xffff0000u);
    }
    return acc;
}
__device__ __forceinline__ void d_peer_apply2(const int vb, char* smem, const bf16_t* __restrict__ hb, const int* __restrict__ pidx,
                                              const float* __restrict__ pg, const bf16_t* __restrict__ utab, const bf16_t* __restrict__ vtab,
                                              const float* __restrict__ modl, float* __restrict__ xrun) {
    const int wid = threadIdx.x >> 6, lane = threadIdx.x & 63;
    const int t = vb * 4 + wid;
    float* coef = (float*)smem + wid * 128;
    int* eid = (int*)(smem + 2048) + wid * 128;
    eid[lane] = pidx[(size_t)t * 128 + lane]; eid[lane + 64] = pidx[(size_t)t * 128 + lane + 64];
    const float g0 = pg[(size_t)t * 128 + lane], g1 = pg[(size_t)t * 128 + lane + 64];
    const u32x4 x0 = *(const u32x4*)(hb + (size_t)t * DM + lane * 8);
    const u32x4 x1 = *(const u32x4*)(hb + (size_t)t * DM + 512 + lane * 8);
    __builtin_amdgcn_wave_barrier();
    float myact0 = 0.f, myact1 = 0.f;
    for (int eb = 0; eb < 128; eb += 8) {
        u32x4 ua[8], ub[8];
#pragma unroll
        for (int r = 0; r < 8; r++) {
            const bf16_t* ur = utab + (size_t)eid[eb + r] * DM;
            ua[r] = *(const u32x4*)(ur + lane * 8);
            ub[r] = *(const u32x4*)(ur + 512 + lane * 8);
        }
#pragma unroll
        for (int r = 0; r < 8; r++) {
            float sacc = dot8_bf16(ua[r], x0, 0.f);
            sacc = dot8_bf16(ub[r], x1, sacc);
            sacc = wave_sum(sacc);
            const int e = eb + r;
            if (lane == (e & 63)) { if (e < 64) myact0 = sacc; else myact1 = sacc; }
        }
    }
    coef[lane] = g0 * gelu_tanh(myact0);
    coef[lane + 64] = g1 * gelu_tanh(myact1);
    __builtin_amdgcn_wave_barrier();
    float acc[16];
#pragma unroll
    for (int i = 0; i < 16; i++) acc[i] = 0.f;
    for (int eb = 0; eb < 128; eb += 8) {
        u32x4 va[8], vbq[8];
#pragma unroll
        for (int r = 0; r < 8; r++) {
            const bf16_t* vr = vtab + (size_t)eid[eb + r] * DM;
            va[r] = *(const u32x4*)(vr + lane * 8);
            vbq[r] = *(const u32x4*)(vr + 512 + lane * 8);
        }
#pragma unroll
        for (int r = 0; r < 8; r++) {
            const float cf = coef[eb + r];
#pragma unroll
            for (int i = 0; i < 4; i++) {
                acc[2 * i] += cf * __uint_as_float(va[r][i] << 16);
                acc[2 * i + 1] += cf * __uint_as_float(va[r][i] & 0xffff0000u);
                acc[8 + 2 * i] += cf * __uint_as_float(vbq[r][i] << 16);
                acc[8 + 2 * i + 1] += cf * __uint_as_float(vbq[r][i] & 0xffff0000u);
            }
        }
    }
    const float* m = modl + (size_t)tok_modrow(t) * 6144 + 5 * 1024;
    float* xo = xrun + (size_t)t * DM;
#pragma unroll
    for (int hlf = 0; hlf < 2; hlf++) {
        const int c0 = hlf * 512 + lane * 8;
        float4 xa = *(float4*)(xo + c0), xb2 = *(float4*)(xo + c0 + 4);
        const float4 ma = *(const float4*)(m + c0), mb = *(const float4*)(m + c0 + 4);
        xa.x += ma.x * acc[hlf * 8 + 0]; xa.y += ma.y * acc[hlf * 8 + 1]; xa.z += ma.z * acc[hlf * 8 + 2]; xa.w += ma.w * acc[hlf * 8 + 3];
        xb2.x += mb.x * acc[hlf * 8 + 4]; xb2.y += mb.y * acc[hlf * 8 + 5]; xb2.z += mb.z * acc[hlf * 8 + 6]; xb2.w += mb.w * acc[hlf * 8 + 7];
        *(float4*)(xo + c0) = xa; *(float4*)(xo + c0 + 4) = xb2;
    }
}
__device__ __forceinline__ void d_cvt_bf16(const int vb, const float* __restrict__ src, bf16_t* __restrict__ dst) {
    const size_t base = (size_t)vb * 16384 + threadIdx.x * 4;
#pragma unroll
    for (int i = 0; i < 16; i++) {
        const float4 v = *(const float4*)(src + base + i * 1024);
        ushort4 o; o.x = f2bf(v.x); o.y = f2bf(v.y); o.z = f2bf(v.z); o.w = f2bf(v.w);
        *(ushort4*)(dst + base + i * 1024) = o;
    }
}

__device__ __forceinline__ void d_hy_dw(const int bx, const int by, const int bz, char* smem, const float* __restrict__ pre, const float* __restrict__ cw, const float* __restrict__ cb,
                                               bf16_t* __restrict__ zin, bf16_t* __restrict__ x0) {
    const int t = bx;
    const int pos = tok_pos(t), L = tok_len(t);
    const float* P = pre + (size_t)t * 3072;
    for (int c = threadIdx.x; c < 1024; c += 256) {
        float u[3];
#pragma unroll
        for (int part = 0; part < 3; part++) {
            int cc = part * 1024 + c;
            float cur = P[cc];
            float prev = (pos > 0) ? P[cc - 3072] : 0.f;
            float nxt = (pos < L - 1) ? P[cc + 3072] : 0.f;
            u[part] = prev * cw[cc] + cur * cw[3072 + cc] + nxt * cw[2 * 3072 + cc] + cb[cc];
        }
        x0[(size_t)t * DM + c] = f2bf(u[0]);
        zin[(size_t)t * DM + c] = f2bf(u[1] * u[2]);
    }
}

__device__ __forceinline__ void d_hy_filt(const int bx, const int by, const int bz, char* smem, int L, const float* __restrict__ w1, const float* __restrict__ b1, const float* __restrict__ w2,
                                                 const float* __restrict__ b2, const float* __restrict__ w3, const float* __restrict__ fr,
                                                 float* __restrict__ hf, float* __restrict__ hb) {
    float* z = (float*)smem; float* h1 = z + 64; float* h2 = z + 128;
    const int t = bx, tid = threadIdx.x;
    const float tu = (float)t / (float)(L - 1);
    if (tid == 0) z[0] = tu;
    if (tid >= 1 && tid < 17) {
        int i = tid - 1;
        float band = 1e-4f + (float)i * ((15.f - 1e-4f) / 15.f);
        float ang = 6.283185307179586f * (float)t * band / (float)L;
        z[1 + i] = cosf(ang); z[17 + i] = -sinf(ang);
    }
    __syncthreads();
    if (tid < 64) { float s = b1[tid]; for (int i = 0; i < 33; i++) s += z[i] * w1[i * 64 + tid]; h1[tid] = sinf(fr[tid] * s); }
    __syncthreads();
    if (tid < 64) { float s = b2[tid]; for (int i = 0; i < 64; i++) s += h1[i] * w2[i * 64 + tid]; h2[tid] = sinf(fr[tid] * s); }
    __syncthreads();
    for (int c = tid; c < 2048; c += 256) {
        float s = 0.f;
        for (int i = 0; i < 64; i++) s += h2[i] * w3[i * 2048 + c];
        int ch = c & 1023;
        float d0 = -4.605170185988091f / 0.3f, d1 = -4.605170185988091f / 1.5f;
        float delta = d0 + (d1 - d0) * ((float)ch / 1023.f);
        float win = expf(-tu * fabsf(delta));
        float val = s * win;
        if (c < 1024) hf[(size_t)t * 1024 + ch] = val; else hb[(size_t)t * 1024 + ch] = val;
    }
}
__device__ __forceinline__ void d_hy_norm(const int bx, const int by, const int bz, char* smem, int L, const float* __restrict__ hf, const float* __restrict__ hb, float* __restrict__ inv) {
    const int c = bx * 256 + threadIdx.x;
    float s = 0.f;
    for (int t = 0; t < L; t++) { s += fabsf(hf[(size_t)t * 1024 + c]); if (t > 0) s += fabsf(hb[(size_t)t * 1024 + c]); }
    inv[c] = 1.f / s;
}
__device__ __forceinline__ void d_hy_conv(const int bx, const int by, const int bz, char* smem, int L, int tbase, const bf16_t* __restrict__ zin, const bf16_t* __restrict__ x0, const float* __restrict__ hf,
                                                 const float* __restrict__ hb, const float* __restrict__ inv, const float* __restrict__ bias,
                                                 bf16_t* __restrict__ zb) {
    const int c = bx * 256 + threadIdx.x;
    const int t0 = by * 8, b = bz;
    const bf16_t* Z = zin + (size_t)(tbase + b * L) * DM + c;
    float acc[8];
#pragma unroll
    for (int i = 0; i < 8; i++) acc[i] = 0.f;
    for (int s = 0; s < L; s++) {
        float z = bf2f(Z[(size_t)s * DM]);
#pragma unroll
        for (int i = 0; i < 8; i++) {
            int j = t0 + i - s;
            float g = (j >= 0) ? hf[(size_t)j * 1024 + c] : hb[(size_t)(-j) * 1024 + c];
            acc[i] += z * g;
        }
    }
    float iv = inv[c], bs = bias[c];
#pragma unroll
    for (int i = 0; i < 8; i++) {
        size_t o = (size_t)(tbase + b * L + t0 + i) * DM + c;
        float zz = bf2f(zin[o]);
        zb[o] = f2bf(bf2f(x0[o]) * (acc[i] * iv + zz * bs));
    }
}


__device__ __forceinline__ void d_hy_filt2(const int vbl8, char* smem, const int L, const float* __restrict__ w1, const float* __restrict__ b1,
                                           const float* __restrict__ w2, const float* __restrict__ b2, const float* __restrict__ w3,
                                           const float* __restrict__ fr, bf16_t* __restrict__ gT, float* __restrict__ nsum) {
    float* zp = (float*)smem;
    float* h1 = zp + 32 * 33;
    float* h2t = h1 + 32 * 64;
    const int tid = threadIdx.x;
    const int vbl = vbl8 >> 3, mm = vbl8 & 7;
    const int t0 = vbl * 32;
    for (int e = tid; e < 32 * 33; e += 256) {
        const int pos = e / 33, i = e % 33;
        const float t = (float)(t0 + pos);
        float val;
        if (i == 0) val = t / (float)(L - 1);
        else {
            const int bi = (i <= 16) ? (i - 1) : (i - 17);
            const float band = 1e-4f + (float)bi * ((15.f - 1e-4f) / 15.f);
            const float ang = 6.283185307179586f * t * band / (float)L;
            val = (i <= 16) ? cosf(ang) : -sinf(ang);
        }
        zp[e] = val;
    }
    __syncthreads();
    {
        const int j = tid & 63;
        const float frj = fr[j];
#pragma unroll 1
        for (int i = 0; i < 8; i++) {
            const int pos = (tid >> 6) + 4 * i;
            float sacc = b1[j];
            for (int q = 0; q < 33; q++) sacc += zp[pos * 33 + q] * w1[q * 64 + j];
            h1[pos * 64 + j] = sinf(frj * sacc);
        }
        __syncthreads();
#pragma unroll 1
        for (int i = 0; i < 8; i++) {
            const int pos = (tid >> 6) + 4 * i;
            float sacc = b2[j];
            for (int q = 0; q < 64; q++) sacc += h1[pos * 64 + q] * w2[q * 64 + j];
            h2t[j * 32 + pos] = sinf(frj * sacc);
        }
    }
    __syncthreads();
    {
        const int c = tid + 256 * mm;
        float acc[32];
#pragma unroll
        for (int i = 0; i < 32; i++) acc[i] = 0.f;
        for (int j = 0; j < 64; j++) {
            const float w = w3[j * 2048 + c];
#pragma unroll
            for (int i = 0; i < 8; i++) {
                const float4 hv = *(const float4*)(h2t + j * 32 + i * 4);
                acc[4 * i] += hv.x * w; acc[4 * i + 1] += hv.y * w; acc[4 * i + 2] += hv.z * w; acc[4 * i + 3] += hv.w * w;
            }
        }
        const int ch = c & 1023;
        const float d0 = -4.605170185988091f / 0.3f, d1 = -4.605170185988091f / 1.5f;
        const float adelta = fabsf(d0 + (d1 - d0) * ((float)ch / 1023.f));
        float absum = 0.f;
        bf16_t* g = gT + (size_t)ch * 2 * L;
#pragma unroll
        for (int i = 0; i < 32; i++) {
            const int t = t0 + i;
            const float tu = (float)t / (float)(L - 1);
            const float val = acc[i] * expf(-tu * adelta);
            if (c < 1024) { absum += fabsf(val); g[L - t] = f2bf(val); }
            else if (t >= 1) { absum += fabsf(val); g[L + t] = f2bf(val); }
        }
        atomicAdd(nsum + ch, absum);
    }
}

__device__ __forceinline__ void d_hy_dw2(const int vb, char* smem, const float* __restrict__ pre, const float* __restrict__ cw,
                                         const float* __restrict__ cb, bf16_t* __restrict__ zT, bf16_t* __restrict__ x0b) {
    bf16_t* tile = (bf16_t*)smem;
    const int tt = vb >> 4, ct = vb & 15;
    const int tid = threadIdx.x;
    const int cc = tid & 63, c = ct * 64 + cc;
    const int tq = tid >> 6;
    float w0[3], w1[3], w2[3], bb[3];
#pragma unroll
    for (int part = 0; part < 3; part++) {
        const int col = part * 1024 + c;
        w0[part] = cw[col]; w1[part] = cw[3072 + col]; w2[part] = cw[2 * 3072 + col]; bb[part] = cb[col];
    }
    const int tok0 = tt * 64 + tq * 16;
    float prev[3], cur[3], nxt[3];
    {
        const int pos = tok_pos(tok0);
#pragma unroll
        for (int part = 0; part < 3; part++) {
            const float* P = pre + (size_t)tok0 * 3072 + part * 1024 + c;
            prev[part] = (pos > 0) ? P[-3072] : 0.f;
            cur[part] = P[0];
        }
    }
#pragma unroll 4
    for (int i = 0; i < 16; i++) {
        const int tok = tok0 + i;
        const int pos = tok_pos(tok), L = tok_len(tok);
        float u[3];
#pragma unroll
        for (int part = 0; part < 3; part++) {
            const float* P = pre + (size_t)tok * 3072 + part * 1024 + c;
            nxt[part] = (pos < L - 1) ? P[3072] : 0.f;
            u[part] = prev[part] * w0[part] + cur[part] * w1[part] + nxt[part] * w2[part] + bb[part];
            prev[part] = cur[part]; cur[part] = nxt[part];
        }
        x0b[(size_t)tok * DM + c] = f2bf(u[0]);
        tile[cc * 72 + tq * 16 + i] = f2bf(u[1] * u[2]);
    }
    __syncthreads();
    {
        const int cch = tid >> 2, q4 = tid & 3;
        const u32x4 a = *(const u32x4*)(tile + cch * 72 + q4 * 16);
        const u32x4 b2 = *(const u32x4*)(tile + cch * 72 + q4 * 16 + 8);
        bf16_t* dst = zT + (size_t)(ct * 64 + cch) * TT + tt * 64 + q4 * 16;
        *(u32x4*)dst = a; *(u32x4*)(dst + 8) = b2;
    }
}

template <bool SAMPLE>
__device__ __forceinline__ void d_hy_conv2(const int c, char* wsm, const bf16_t* __restrict__ gTall, const float* __restrict__ nsum,
                                           const bf16_t* __restrict__ zT, const float* __restrict__ bias, bf16_t* __restrict__ yT) {
    constexpr int L = SAMPLE ? LS : LP;
    constexpr int NB = L / 32;
    constexpr int NBATCH = SAMPLE ? 4 : 16;
    constexpr int BSH = SAMPLE ? 2 : 4;
    constexpr int TPB = 32 >> BSH;
    constexpr int NCB = NB / TPB;
    constexpr int PADB = SAMPLE ? 8 : 2;
    constexpr int ZLEN = L + 2 * PADB * 32;
    constexpr int tbase = SAMPLE ? TP : 0;
    const int lane = threadIdx.x & 63;
    const int lc = lane & 31, hh = lane >> 5;
    const int b = lc & (NBATCH - 1), Tl = lc >> BSH;
    bf16_t* R = (bf16_t*)wsm;
    bf16_t* Z = R + 2 * L;
    {
        const u32x4* src = (const u32x4*)(gTall + (size_t)c * 2 * L);
        for (int i = lane; i < 2 * L / 8; i += 64) ((u32x4*)R)[i] = src[i];
        const u32x4 zero = {0u, 0u, 0u, 0u};
#pragma unroll 1
        for (int b2 = 0; b2 < NBATCH; b2++) {
            const u32x4* zs = (const u32x4*)(zT + (size_t)c * TT + tbase + b2 * L);
            u32x4* zd = (u32x4*)(Z + b2 * ZLEN);
            for (int i = lane; i < PADB * 4; i += 64) { zd[i] = zero; zd[PADB * 4 + L / 8 + i] = zero; }
            for (int i = lane; i < L / 8; i += 64) zd[PADB * 4 + i] = zs[i];
        }
    }
    __builtin_amdgcn_wave_barrier();
    f32x16 acc[NCB];
#pragma unroll
    for (int cb = 0; cb < NCB; cb++)
#pragma unroll
        for (int r = 0; r < 16; r++) acc[cb][r] = 0.f;
    const bf16_t* Zb = Z + b * ZLEN + PADB * 32 + 8 * hh;
#pragma unroll 1
    for (int D = -(NB - 1); D <= NB - 1; D++) {
        bf16x8 af[2];
#pragma unroll
        for (int ks = 0; ks < 2; ks++) {
            const bf16_t* rp = R + (L - 32 * D - lc + 16 * ks + 8 * hh);
#pragma unroll
            for (int j = 0; j < 8; j++) af[ks][j] = (short)rp[j];
        }
#pragma unroll
        for (int cb = 0; cb < NCB; cb++) {
            if (D >= TPB * cb - (NB - 1) && D <= TPB * cb + TPB - 1) {
                const int S = TPB * cb + Tl - D;
#pragma unroll
                for (int ks = 0; ks < 2; ks++) {
                    const bf16x8 bfr = *(const bf16x8*)(Zb + 32 * S + 16 * ks);
                    acc[cb] = __builtin_amdgcn_mfma_f32_32x32x16_bf16(af[ks], bfr, acc[cb], 0, 0, 0);
                }
            }
        }
    }
    const float inv = 1.f / nsum[c], bs = bias[c];
    bf16_t* yrow = yT + (size_t)c * TT + tbase + b * L;
    const bf16_t* zrow = Z + b * ZLEN + PADB * 32;
#pragma unroll
    for (int cb = 0; cb < NCB; cb++)
#pragma unroll
        for (int g = 0; g < 4; g++) {
            const int t = 32 * (TPB * cb + Tl) + 8 * g + 4 * hh;
            ushort4 o;
            o.x = f2bf(acc[cb][4 * g + 0] * inv + bf2f(zrow[t + 0]) * bs);
            o.y = f2bf(acc[cb][4 * g + 1] * inv + bf2f(zrow[t + 1]) * bs);
            o.z = f2bf(acc[cb][4 * g + 2] * inv + bf2f(zrow[t + 2]) * bs);
            o.w = f2bf(acc[cb][4 * g + 3] * inv + bf2f(zrow[t + 3]) * bs);
            *(ushort4*)(yrow + t) = o;
        }
    __builtin_amdgcn_wave_barrier();
}

__device__ __forceinline__ void d_hy_post(const int vb, char* smem, const bf16_t* __restrict__ yT, const bf16_t* __restrict__ x0b, bf16_t* __restrict__ zb) {
    bf16_t* tile = (bf16_t*)smem;
    const int tt = vb >> 4, ct = vb & 15;
    const int tid = threadIdx.x;
    {
        const int cch = tid >> 2, q4 = tid & 3;
        const bf16_t* src = yT + (size_t)(ct * 64 + cch) * TT + tt * 64 + q4 * 16;
        *(u32x4*)(tile + cch * 72 + q4 * 16) = *(const u32x4*)src;
        *(u32x4*)(tile + cch * 72 + q4 * 16 + 8) = *(const u32x4*)(src + 8);
    }
    __syncthreads();
    const int cc = tid & 63, tq = tid >> 6;
#pragma unroll 4
    for (int i = 0; i < 16; i++) {
        const size_t o = (size_t)(tt * 64 + tq * 16 + i) * DM + ct * 64 + cc;
        zb[o] = f2bf(bf2f(x0b[o]) * bf2f(tile[cc * 72 + tq * 16 + i]));
    }
}


__device__ __forceinline__ float wave_allsum_fast(float v) {
    v = row16_allsum(v);
    const float r0 = __int_as_float(__builtin_amdgcn_readlane(__float_as_int(v), 0));
    const float r1 = __int_as_float(__builtin_amdgcn_readlane(__float_as_int(v), 16));
    const float r2 = __int_as_float(__builtin_amdgcn_readlane(__float_as_int(v), 32));
    const float r3 = __int_as_float(__builtin_amdgcn_readlane(__float_as_int(v), 48));
    return (r0 + r1) + (r2 + r3);
}
__device__ __forceinline__ ushort4 pack_bf4(float a, float b, float c, float d) { ushort4 o; o.x = f2bf(a); o.y = f2bf(b); o.z = f2bf(c); o.w = f2bf(d); return o; }

__device__ __forceinline__ void d_norm_mod2(const int vb, const float* __restrict__ xa, const float* __restrict__ xb, const float* __restrict__ g,
                                            const float* __restrict__ modl, const int shift_idx, const int scale_idx, bf16_t* __restrict__ h) {
    const int wid = threadIdx.x >> 6, lane = threadIdx.x & 63;
    const int t0 = vb * 8 + wid * 2;
    float4 v[2][4];
#pragma unroll
    for (int u = 0; u < 2; u++) {
        const int t = t0 + u;
        const float* x = (t < TP) ? (xa + (size_t)t * DM) : (xb + (size_t)(t - TP) * DM);
#pragma unroll
        for (int j = 0; j < 4; j++) v[u][j] = *(const float4*)(x + j * 256 + lane * 4);
    }
#pragma unroll
    for (int u = 0; u < 2; u++) {
        const int t = t0 + u;
        float ss = 0.f;
#pragma unroll
        for (int j = 0; j < 4; j++) ss += v[u][j].x * v[u][j].x + v[u][j].y * v[u][j].y + v[u][j].z * v[u][j].z + v[u][j].w * v[u][j].w;
        ss = wave_allsum_fast(ss);
        const float rstd = rsqrtf(ss * (1.f / DM) + 1e-6f);
        const float* m = modl + (size_t)tok_modrow(t) * 6144;
#pragma unroll
        for (int j = 0; j < 4; j++) {
            const int c = j * 256 + lane * 4;
            const float4 gg = *(const float4*)(g + c);
            const float4 sh = *(const float4*)(m + shift_idx * 1024 + c);
            const float4 sc = *(const float4*)(m + scale_idx * 1024 + c);
            *(ushort4*)(h + (size_t)t * DM + c) = pack_bf4(v[u][j].x * rstd * gg.x * (1.f + sc.x) + sh.x, v[u][j].y * rstd * gg.y * (1.f + sc.y) + sh.y,
                                                           v[u][j].z * rstd * gg.z * (1.f + sc.z) + sh.z, v[u][j].w * rstd * gg.w * (1.f + sc.w) + sh.w);
        }
    }
}

__device__ __forceinline__ void d_rw_shift2(const int vb, const bf16_t* __restrict__ proj, const float* __restrict__ mu, bf16_t* __restrict__ rb,
                                            bf16_t* __restrict__ kb, bf16_t* __restrict__ vbuf, bf16_t* __restrict__ tw, bf16_t* __restrict__ adv,
                                            bf16_t* __restrict__ sg) {
#pragma unroll
    for (int u = 0; u < 4; u++) {
        const int id = vb * 1024 + u * 256 + threadIdx.x;
        const int t = id / 224, c = (id % 224) * 8;
        const int pos = tok_pos(t), L = tok_len(t);
        const bf16_t* P = proj + (size_t)t * RWIN + c;
        const u32x4 cur = *(const u32x4*)P;
        u32x4 prv = {0u, 0u, 0u, 0u}, nxt = {0u, 0u, 0u, 0u};
        if (pos > 0) prv = *(const u32x4*)(P - RWIN);
        if (pos < L - 1) nxt = *(const u32x4*)(P + RWIN);
        const float4 m0 = *(const float4*)(mu + c), m1 = *(const float4*)(mu + c + 4);
        const float mm[8] = {m0.x, m0.y, m0.z, m0.w, m1.x, m1.y, m1.z, m1.w};
        float val[8];
#pragma unroll
        for (int i = 0; i < 4; i++) {
            const float c0 = __uint_as_float(cur[i] << 16), c1 = __uint_as_float(cur[i] & 0xffff0000u);
            const float p0 = __uint_as_float(prv[i] << 16), p1 = __uint_as_float(prv[i] & 0xffff0000u);
            const float n0 = __uint_as_float(nxt[i] << 16), n1 = __uint_as_float(nxt[i] & 0xffff0000u);
            val[2 * i] = c0 + mm[2 * i] * (0.5f * (p0 + n0) - c0);
            val[2 * i + 1] = c1 + mm[2 * i + 1] * (0.5f * (p1 + n1) - c1);
        }
        bf16_t* dst;
        if (c < 512) dst = rb + (size_t)t * 512 + c;
        else if (c < 1024) dst = kb + (size_t)t * 512 + (c - 512);
        else if (c < 1536) dst = vbuf + (size_t)t * 512 + (c - 1024);
        else if (c < 1600) { dst = tw + (size_t)t * 64 + (c - 1536);
#pragma unroll
            for (int i = 0; i < 8; i++) val[i] = tanhf(val[i]); }
        else if (c < 1664) dst = adv + (size_t)t * 64 + (c - 1600);
        else { dst = sg + (size_t)t * 128 + (c - 1664);
#pragma unroll
            for (int i = 0; i < 8; i++) val[i] = sigmoidf_(val[i]); }
        u32x4 o;
#pragma unroll
        for (int i = 0; i < 4; i++) o[i] = (unsigned)f2bf(val[2 * i]) | ((unsigned)f2bf(val[2 * i + 1]) << 16);
        *(u32x4*)dst = o;
    }
}

__device__ __forceinline__ void d_mla_pre2(const int vb, const float* __restrict__ proj, const float* __restrict__ q_norm, const float* __restrict__ kv_norm,
                                           bf16_t* __restrict__ qcn, bf16_t* __restrict__ ckv, float* __restrict__ kpe, float* __restrict__ out_ckv,
                                           float* __restrict__ out_kpe) {
    const int t = vb * 16 + (threadIdx.x >> 4), l16 = threadIdx.x & 15;
    const float* P = proj + (size_t)t * 448;
    float4 x[7];
#pragma unroll
    for (int j = 0; j < 7; j++) x[j] = *(const float4*)(P + 4 * (l16 + 16 * j));
    float sq = 0.f, sk = 0.f;
#pragma unroll
    for (int j = 0; j < 4; j++) sq += x[j].x * x[j].x + x[j].y * x[j].y + x[j].z * x[j].z + x[j].w * x[j].w;
#pragma unroll
    for (int j = 4; j < 6; j++) sk += x[j].x * x[j].x + x[j].y * x[j].y + x[j].z * x[j].z + x[j].w * x[j].w;
    sq = row16_allsum(sq); sk = row16_allsum(sk);
    const float rq = rsqrtf(sq * (1.f / 256.f) + 1e-6f), rk = rsqrtf(sk * (1.f / 128.f) + 1e-6f);
#pragma unroll
    for (int j = 0; j < 4; j++) {
        const int c = 4 * (l16 + 16 * j);
        const float4 w = *(const float4*)(q_norm + c);
        *(ushort4*)(qcn + (size_t)t * 256 + c) = pack_bf4(x[j].x * rq * w.x, x[j].y * rq * w.y, x[j].z * rq * w.z, x[j].w * rq * w.w);
    }
#pragma unroll
    for (int j = 4; j < 6; j++) {
        const int c = 4 * (l16 + 16 * (j - 4));
        const float4 w = *(const float4*)(kv_norm + c);
        const float4 o = make_float4(x[j].x * rk * w.x, x[j].y * rk * w.y, x[j].z * rk * w.z, x[j].w * rk * w.w);
        *(ushort4*)(ckv + (size_t)t * 128 + c) = pack_bf4(o.x, o.y, o.z, o.w);
        if (t < TP) *(float4*)(out_ckv + (size_t)t * 128 + c) = o;
    }
    {
        const int c = 4 * l16;
        *(float4*)(kpe + (size_t)t * 64 + c) = x[6];
        if (t < TP) *(float4*)(out_kpe + (size_t)t * 64 + c) = x[6];
    }
}

__device__ __forceinline__ void d_rw_kk2(const int vb, char* smem, const bf16_t* __restrict__ rb, const bf16_t* __restrict__ kb,
                                         const bf16_t* __restrict__ lr0, const bf16_t* __restrict__ lr1, const float* __restrict__ k_k,
                                         const float* __restrict__ k_a, const float* __restrict__ r_k, bf16_t* __restrict__ kkb, float* __restrict__ bonus) {
    float* pk = (float*)smem;
    for (int i = threadIdx.x; i < 512; i += 256) { pk[i] = k_k[i]; pk[512 + i] = k_a[i]; pk[1024 + i] = r_k[i]; }
    __syncthreads();
    const int w = vb * 256 + threadIdx.x;
    const int h = w & 7;
    const size_t o = (size_t)w * 64;
    u32x4 kq[8];
#pragma unroll
    for (int i = 0; i < 8; i++) kq[i] = *(const u32x4*)(kb + o + i * 8);
    const float* kkp = pk + h * 64; const float* kap = pk + 512 + h * 64; const float* rkp = pk + 1024 + h * 64;
    float ss = 0.f;
#pragma unroll
    for (int i = 0; i < 8; i++)
#pragma unroll
        for (int j = 0; j < 4; j++) {
            const float a = __uint_as_float(kq[i][j] << 16) * kkp[i * 8 + 2 * j], b = __uint_as_float(kq[i][j] & 0xffff0000u) * kkp[i * 8 + 2 * j + 1];
            ss += a * a + b * b;
        }
    const float inv = 1.f / fmaxf(sqrtf(ss), 1e-12f);
    float bs = 0.f;
#pragma unroll
    for (int i = 0; i < 8; i++) {
        const u32x4 rq = *(const u32x4*)(rb + o + i * 8);
        const u32x4 l0 = *(const u32x4*)(lr0 + o + i * 8);
        const u32x4 l1 = *(const u32x4*)(lr1 + o + i * 8);
        u32x4 ok;
#pragma unroll
        for (int j = 0; j < 4; j++) {
            const int e0 = i * 8 + 2 * j, e1 = e0 + 1;
            const float k0 = __uint_as_float(kq[i][j] << 16), k1 = __uint_as_float(kq[i][j] & 0xffff0000u);
            const float r0 = __uint_as_float(rq[j] << 16), r1 = __uint_as_float(rq[j] & 0xffff0000u);
            const float a0 = __uint_as_float(l0[j] << 16), a1 = __uint_as_float(l0[j] & 0xffff0000u);
            const float b0 = __uint_as_float(l1[j] << 16), b1 = __uint_as_float(l1[j] & 0xffff0000u);
            bs += r0 * k0 * (2.f + (a0 + b0 - 2.f) * kap[e0]) * rkp[e0] + r1 * k1 * (2.f + (a1 + b1 - 2.f) * kap[e1]) * rkp[e1];
            ok[j] = (unsigned)f2bf(k0 * kkp[e0] * inv) | ((unsigned)f2bf(k1 * kkp[e1] * inv) << 16);
        }
        *(u32x4*)(kkb + o + i * 8) = ok;
    }
    bonus[w] = bs;
}

__device__ __forceinline__ void d_mla_post2(const int vb, const bf16_t* __restrict__ qraw, const bf16_t* __restrict__ kvraw, const bf16_t* __restrict__ kvraw_ctx,
                                            const float* __restrict__ kpe, const float* __restrict__ cache_kpe, const float* __restrict__ qn,
                                            const float* __restrict__ kn, bf16_t* __restrict__ Qb, bf16_t* __restrict__ Kp, bf16_t* __restrict__ Ks) {
    const int item = vb * 16 + (threadIdx.x >> 4), l16 = threadIdx.x & 15;
    const int row = item >> 2, h = item & 3;
    const bool isctx = row >= TT, sample = row >= TP;
    const int e0 = 12 * l16;
    const bf16_t* kvr; const float* pe; int pos = 0;
    if (isctx) { const int cr = row - TT; kvr = kvraw_ctx + (size_t)cr * 1024; pe = cache_kpe + (size_t)cr * 64; }
    else { kvr = kvraw + (size_t)row * 1024; pe = kpe + (size_t)row * 64; pos = tok_pos(row); }
    float kx[12], qx[12];
#pragma unroll
    for (int j = 0; j < 12; j++) {
        const int e = e0 + j;
        kx[j] = (e < 128) ? bf2f(kvr[h * 256 + (e < 128 ? e : 0)]) : pe[(e >= 128 ? e - 128 : 0)];
        qx[j] = isctx ? 0.f : bf2f(qraw[(size_t)row * 768 + h * 192 + e]);
    }
    float sk = 0.f, sq = 0.f;
#pragma unroll
    for (int j = 0; j < 12; j++) { sk += kx[j] * kx[j]; sq += qx[j] * qx[j]; }
    sk = row16_allsum(sk); sq = row16_allsum(sq);
    const float rk = rsqrtf(sk * (1.f / 192.f) + 1e-6f), rq = rsqrtf(sq * (1.f / 192.f) + 1e-6f);
#pragma unroll
    for (int j = 0; j < 12; j++) { kx[j] *= rk * kn[e0 + j]; qx[j] *= rq * qn[e0 + j]; }
    if (sample && !isctx) {
        const float rowf = (float)(pos >> 6), colf = (float)(pos & 63);
#pragma unroll
        for (int j = 0; j < 12; j += 2) {
            const int e = e0 + j;
            if (e >= 128) {
                const int pi = (e - 128) >> 1;
                const float inv = expf(-(float)(pi & 15) * (1.f / 16.f) * 9.210340371976184f);
                const float ang = (pi < 16 ? rowf : colf) * inv;
                const float cs = cosf(ang), sn = sinf(ang);
                const float a = kx[j], bq = kx[j + 1];
                kx[j] = a * cs - bq * sn; kx[j + 1] = a * sn + bq * cs;
                const float a2 = qx[j], b2 = qx[j + 1];
                qx[j] = a2 * cs - b2 * sn; qx[j + 1] = a2 * sn + b2 * cs;
            }
        }
    }
    bf16_t* kd;
    if (!sample) { const int b = row >> 8, pp = row & 255; kd = Kp + ((size_t)(b * 4 + h) * LP + pp) * 192; }
    else if (!isctx) { const int b = (row - TP) >> 11, pp = (row - TP) & 2047; kd = Ks + ((size_t)(b * 4 + h) * 2304 + 256 + pp) * 192; }
    else { const int cr = row - TT; const int b = cr >> 8, pp = cr & 255; kd = Ks + ((size_t)(b * 4 + h) * 2304 + pp) * 192; }
#pragma unroll
    for (int j = 0; j < 12; j += 4) {
        *(ushort4*)(kd + e0 + j) = pack_bf4(kx[j], kx[j + 1], kx[j + 2], kx[j + 3]);
        if (!isctx) *(ushort4*)(Qb + ((size_t)row * 4 + h) * 192 + e0 + j) = pack_bf4(qx[j], qx[j + 1], qx[j + 2], qx[j + 3]);
    }
}

__device__ __forceinline__ void d_rw_post2(const int vb, char* smem, const float* __restrict__ y0, const float* __restrict__ y1, const float* __restrict__ bonus,
                                           const bf16_t* __restrict__ vbuf, const bf16_t* __restrict__ gate, const float* __restrict__ lnx_g,
                                           const float* __restrict__ lnx_b, bf16_t* __restrict__ cat) {
    float* pg = (float*)smem;
    for (int i = threadIdx.x; i < 512; i += 256) { pg[i] = lnx_g[i]; pg[512 + i] = lnx_b[i]; }
    __syncthreads();
    const int w = vb * 256 + threadIdx.x;
    const int t = w >> 3, h = w & 7;
    const size_t o = (size_t)w * 64;
    float y[64];
#pragma unroll
    for (int i = 0; i < 16; i++) {
        const float4 a = *(const float4*)(y0 + o + i * 4), b = *(const float4*)(y1 + o + i * 4);
        y[4 * i] = a.x + b.x; y[4 * i + 1] = a.y + b.y; y[4 * i + 2] = a.z + b.z; y[4 * i + 3] = a.w + b.w;
    }
    float mean = 0.f;
#pragma unroll
    for (int i = 0; i < 64; i++) mean += y[i];
    mean *= (1.f / 64.f);
    float var = 0.f;
#pragma unroll
    for (int i = 0; i < 64; i++) { const float d = y[i] - mean; var += d * d; }
    const float rstd = rsqrtf(var * (1.f / 64.f) + 64e-5f);
    const float bn = bonus[w];
    const float* gp = pg + h * 64; const float* bp = pg + 512 + h * 64;
#pragma unroll
    for (int i = 0; i < 8; i++) {
        const u32x4 vq = *(const u32x4*)(vbuf + o + i * 8);
        const u32x4 gq = *(const u32x4*)(gate + o + i * 8);
        u32x4 oq;
#pragma unroll
        for (int j = 0; j < 4; j++) {
            const int e0 = i * 8 + 2 * j, e1 = e0 + 1;
            const float v0 = __uint_as_float(vq[j] << 16), v1 = __uint_as_float(vq[j] & 0xffff0000u);
            const float g0 = __uint_as_float(gq[j] << 16), g1 = __uint_as_float(gq[j] & 0xffff0000u);
            const float r0 = ((y[e0] - mean) * rstd * gp[e0] + bp[e0] + bn * v0) * g0;
            const float r1 = ((y[e1] - mean) * rstd * gp[e1] + bp[e1] + bn * v1) * g1;
            oq[j] = (unsigned)f2bf(r0) | ((unsigned)f2bf(r1) << 16);
        }
        *(u32x4*)(cat + (size_t)t * DM + h * 64 + i * 8) = oq;
    }
}

#define XB_TMO      128
#define XB_XCNT(j)  (256  + 64 * (j))
#define XB_XSUB(j)  (1280 + 64 * (j))
#define XB_XGEN(j)  (2304 + 64 * (j))
#define XB_TOP      3328
#define XB_TOPGEN   3392
#define XCD_BAR_WORDS 3456
#define XB_SPIN_CAP (1u << 22)
#define LAS __attribute__((address_space(3)))
__device__ __forceinline__ unsigned xb_ld(unsigned* p) { return __hip_atomic_load(p, __ATOMIC_RELAXED, __HIP_MEMORY_SCOPE_AGENT); }
__device__ __forceinline__ unsigned xb_add(unsigned* p, unsigned v) { return __hip_atomic_fetch_add(p, v, __ATOMIC_RELAXED, __HIP_MEMORY_SCOPE_AGENT); }
__device__ __forceinline__ unsigned xb_xcc_id() { return (unsigned)__builtin_amdgcn_s_getreg((3 << 11) | 20) & 0xFu; }
#define XB_SPIN(cond, bar) do { unsigned _sp = 0; while (cond) { __builtin_amdgcn_s_sleep(1); \
    if ((++_sp & 255u) == 0u) { if (xb_ld(&(bar)[XB_TMO])) break; if (_sp > XB_SPIN_CAP) { atomicAdd(&(bar)[XB_TMO], 1u); break; } } } } while (0)
struct XcdBarrier { unsigned* bar; unsigned x; volatile LAS unsigned* st; };
__device__ __forceinline__ XcdBarrier xcd_barrier_post(unsigned* bar, volatile LAS unsigned* st) {
    XcdBarrier b; b.bar = bar; b.x = xb_xcc_id(); b.st = st;
    if (threadIdx.x == 0) (void)xb_add(&bar[XB_XCNT(b.x)], 1u);
    return b;
}
__device__ __forceinline__ void xcd_barrier_complete(unsigned* bar, unsigned x, unsigned& nloc, unsigned& nx) {
    const unsigned G = gridDim.x * gridDim.y * gridDim.z;
    unsigned sum, cnt, mine, sp = 0u;
    for (;;) {
        sum = 0u; cnt = 0u; mine = 0u;
#pragma unroll
        for (unsigned j = 0; j < 16; ++j) { const unsigned c = xb_ld(&bar[XB_XCNT(j)]); sum += c; cnt += (c > 0u) ? 1u : 0u; mine = (j == x) ? c : mine; }
        if (sum == G) break;
        __builtin_amdgcn_s_sleep(1);
        if ((++sp & 255u) == 0u) { if (xb_ld(&bar[XB_TMO])) break; if (sp > XB_SPIN_CAP) { atomicAdd(&bar[XB_TMO], 1u); break; } }
    }
    nloc = mine > 0u ? mine : 1u; nx = cnt > 0u ? cnt : 1u;
}
__device__ __forceinline__ void xcd_barrier_(unsigned* bar_, char* smem_) {
    XcdBarrier b; b.bar = bar_; b.x = xb_xcc_id(); b.st = (volatile LAS unsigned*)(smem_ + 114688);
    asm volatile("s_waitcnt vmcnt(0)" ::: "memory");
    __syncthreads();
    if (threadIdx.x == 0) {
        unsigned* bar = b.bar;
        __builtin_amdgcn_s_waitcnt(0);
        unsigned nloc = b.st[0], nx = b.st[1];
        if (nloc == 0u) { xcd_barrier_complete(bar, b.x, nloc, nx); b.st[0] = nloc; b.st[1] = nx; }
        const unsigned old = xb_add(&bar[XB_XSUB(b.x)], 1u);
        const unsigned gen = old / nloc;
        if (old + 1u == (gen + 1u) * nloc) {
            __builtin_amdgcn_fence(__ATOMIC_RELEASE, "agent");
            asm volatile("s_waitcnt vmcnt(0)" ::: "memory");
            const unsigned og = xb_add(&bar[XB_TOP], 1u);
            const unsigned tg = og / nx;
            if (og + 1u == (tg + 1u) * nx) xb_add(&bar[XB_TOPGEN], 1u);
            else XB_SPIN(xb_ld(&bar[XB_TOPGEN]) == tg, bar);
            __builtin_amdgcn_fence(__ATOMIC_ACQUIRE, "agent");
            xb_add(&bar[XB_XGEN(b.x)], 1u);
            asm volatile("s_waitcnt vmcnt(0)" ::: "memory");
        } else {
            XB_SPIN(xb_ld(&bar[XB_XGEN(b.x)]) == gen, bar);
            __builtin_amdgcn_fence(__ATOMIC_ACQUIRE, "agent");
            asm volatile("s_waitcnt vmcnt(0)" ::: "memory");
        }
    }
    __syncthreads();
}

constexpr size_t ws_al(size_t x) { return (x + 255) & ~(size_t)255; }
struct WS {
    static constexpr size_t mod = 0;
    static constexpr size_t w_in_t = ws_al(mod + (size_t)(2*5*6144*4));
    static constexpr size_t w_out_t = ws_al(w_in_t + (size_t)(2304*1024*2));
    static constexpr size_t hy_w_in_t = ws_al(w_out_t + (size_t)(1024*1024*2));
    static constexpr size_t hy_w_out_t = ws_al(hy_w_in_t + (size_t)(3072*1024*2));
    static constexpr size_t w_q_t = ws_al(hy_w_out_t + (size_t)(1024*1024*2));
    static constexpr size_t q_up_t = ws_al(w_q_t + (size_t)(2*2048*1024*2));
    static constexpr size_t kv_up_t = ws_al(q_up_t + (size_t)(768*256*2));
    static constexpr size_t w2_t = ws_al(kv_up_t + (size_t)(1024*128*2));
    static constexpr size_t a2_t = ws_al(w2_t + (size_t)(2*512*64*2));
    static constexpr size_t g2_t = ws_al(a2_t + (size_t)(2*512*64*2));
    static constexpr size_t ctxb = ws_al(g2_t + (size_t)(512*128*2));
    static constexpr size_t keysb = ws_al(ctxb + (size_t)(1024*128*2));
    static constexpr size_t tabU = ws_al(keysb + (size_t)(2*16*128*128*2));
    static constexpr size_t tabV = ws_al(tabU + (size_t)(16384*1024*2));
    static constexpr size_t nsum = ws_al(tabV + (size_t)(16384*1024*2));
    static constexpr size_t gTS = ws_al(nsum + (size_t)(2*1024*4 + 3456*4 + 1024));
    static constexpr size_t gTP = ws_al(gTS + (size_t)1024*2*2048*2);
    static constexpr size_t R1 = ws_al(gTP + (size_t)1024*2*256*2);
    static constexpr size_t R2 = ws_al(R1 + (size_t)((size_t)TT*1024*4));
    static constexpr size_t rb = ws_al(R2 + (size_t)((size_t)TT*1792*2 + (size_t)TT*448*4));
    static constexpr size_t kb = ws_al(rb + (size_t)((size_t)TT*512*2));
    static constexpr size_t vb = ws_al(kb + (size_t)((size_t)TT*512*2));
    static constexpr size_t kkb = ws_al(vb + (size_t)((size_t)TT*512*2));
    static constexpr size_t lr0 = ws_al(kkb + (size_t)((size_t)TT*512*2));
    static constexpr size_t lr1 = ws_al(lr0 + (size_t)((size_t)TT*512*2));
    static constexpr size_t gateb = ws_al(lr1 + (size_t)((size_t)TT*512*2));
    static constexpr size_t du0 = ws_al(gateb + (size_t)((size_t)TT*512*2));
    static constexpr size_t du1 = ws_al(du0 + (size_t)((size_t)TT*512*2));
    static constexpr size_t twb = ws_al(du1 + (size_t)((size_t)TT*512*2));
    static constexpr size_t advb = ws_al(twb + (size_t)((size_t)TT*64*2));
    static constexpr size_t sgb = ws_al(advb + (size_t)((size_t)TT*64*2));
    static constexpr size_t bonus = ws_al(sgb + (size_t)((size_t)TT*128*2));
    static constexpr size_t kpe = ws_al(bonus + (size_t)((size_t)TT*8*4));
    static constexpr size_t qcnb = ws_al(kpe + (size_t)((size_t)TT*64*4));
    static constexpr size_t ckvb = ws_al(qcnb + (size_t)((size_t)TT*256*2));
    static constexpr size_t Qb = ws_al(ckvb + (size_t)((size_t)TT*128*2));
    static constexpr size_t Kp = ws_al(Qb + (size_t)((size_t)TT*768*2));
    static constexpr size_t Vp = ws_al(Kp + (size_t)(16*4*256*192*2));
    static constexpr size_t Ks = ws_al(Vp + (size_t)(16*4*256*128*2));
    static constexpr size_t Vs = ws_al(Ks + (size_t)(4*4*2304*192*2));
    static constexpr size_t kvctxb = ws_al(Vs + (size_t)(4*4*2304*128*2));
    static constexpr size_t pidx = ws_al(kvctxb + (size_t)(1024*1024*2));
    static constexpr size_t pg = ws_al(pidx + (size_t)((size_t)TT*128*4));
    static constexpr size_t END = ws_al(pg + (size_t)((size_t)TT*128*4));
    static constexpr size_t hb = R1;
    static constexpr size_t catb = R1;
    static constexpr size_t zbb = R1;
    static constexpr size_t kvrawb = R1;
    static constexpr size_t qrawb = R1 + (size_t)TT*1024*2;
    static constexpr size_t projrw = R2;
    static constexpr size_t projmla = R2 + (size_t)TT*1792*2;
    static constexpr size_t y0 = R2;
    static constexpr size_t y1 = R2 + (size_t)TT*512*4;
    static constexpr size_t qb = R2;
    static constexpr size_t scT = rb;
    static constexpr size_t pre = R2;
    static constexpr size_t zT = R2 + (size_t)TT*3072*4;
    static constexpr size_t x0b = R2 + (size_t)TT*3072*4 + (size_t)TT*1024*2;
    static constexpr size_t yT = R2 + (size_t)TT*3072*4 + (size_t)TT*1024*4;
    static constexpr size_t bar = nsum + 2*1024*4;
};
struct Params {
    const float* in[46];
    float* out;
    char* ws;
    __device__ __forceinline__ const float* x_prompt() const { return in[0]; }
    __device__ __forceinline__ const float* x_sample() const { return in[1]; }
    __device__ __forceinline__ const float* st_f() const { return in[2]; }
    __device__ __forceinline__ const float* st_b() const { return in[3]; }
    __device__ __forceinline__ const float* cache_ckv() const { return in[4]; }
    __device__ __forceinline__ const float* cache_kpe() const { return in[5]; }
    __device__ __forceinline__ const float* c() const { return in[6]; }
    __device__ __forceinline__ const float* c_ctx() const { return in[7]; }
    __device__ __forceinline__ const float* norm_g() const { return in[8]; }
    __device__ __forceinline__ const float* w_mod() const { return in[9]; }
    __device__ __forceinline__ const float* b_mod() const { return in[10]; }
    __device__ __forceinline__ const float* ab_w_in() const { return in[11]; }
    __device__ __forceinline__ const float* rw_mu() const { return in[12]; }
    __device__ __forceinline__ const float* rw_w0() const { return in[13]; }
    __device__ __forceinline__ const float* rw_w2() const { return in[14]; }
    __device__ __forceinline__ const float* rw_a0() const { return in[15]; }
    __device__ __forceinline__ const float* rw_a2() const { return in[16]; }
    __device__ __forceinline__ const float* rw_g2() const { return in[17]; }
    __device__ __forceinline__ const float* rw_k_k() const { return in[18]; }
    __device__ __forceinline__ const float* rw_k_a() const { return in[19]; }
    __device__ __forceinline__ const float* rw_r_k() const { return in[20]; }
    __device__ __forceinline__ const float* rw_lnx_g() const { return in[21]; }
    __device__ __forceinline__ const float* rw_lnx_b() const { return in[22]; }
    __device__ __forceinline__ const float* mla_q_norm() const { return in[23]; }
    __device__ __forceinline__ const float* mla_q_up() const { return in[24]; }
    __device__ __forceinline__ const float* mla_kv_norm() const { return in[25]; }
    __device__ __forceinline__ const float* mla_kv_up() const { return in[26]; }
    __device__ __forceinline__ const float* mla_qn() const { return in[27]; }
    __device__ __forceinline__ const float* mla_kn() const { return in[28]; }
    __device__ __forceinline__ const float* ab_w_out() const { return in[29]; }
    __device__ __forceinline__ const float* hy_w_in() const { return in[30]; }
    __device__ __forceinline__ const float* hy_b_in() const { return in[31]; }
    __device__ __forceinline__ const float* hy_conv_w() const { return in[32]; }
    __device__ __forceinline__ const float* hy_conv_b() const { return in[33]; }
    __device__ __forceinline__ const float* hy_f_w1() const { return in[34]; }
    __device__ __forceinline__ const float* hy_f_b1() const { return in[35]; }
    __device__ __forceinline__ const float* hy_f_w2() const { return in[36]; }
    __device__ __forceinline__ const float* hy_f_b2() const { return in[37]; }
    __device__ __forceinline__ const float* hy_f_w3() const { return in[38]; }
    __device__ __forceinline__ const float* hy_f_freq() const { return in[39]; }
    __device__ __forceinline__ const float* hy_bias() const { return in[40]; }
    __device__ __forceinline__ const float* hy_w_out() const { return in[41]; }
    __device__ __forceinline__ const float* peer_w_q() const { return in[42]; }
    __device__ __forceinline__ const float* peer_keys() const { return in[43]; }
    __device__ __forceinline__ const float* peer_u() const { return in[44]; }
    __device__ __forceinline__ const float* peer_v() const { return in[45]; }
    __device__ __forceinline__ float* xrun() const { return out + (0); }
    __device__ __forceinline__ float* out_sf() const { return out + ((size_t)TT*DM); }
    __device__ __forceinline__ float* out_sb() const { return out + ((size_t)TT*DM + 16*8*64*64); }
    __device__ __forceinline__ float* out_ckv() const { return out + ((size_t)TT*DM + 2*16*8*64*64); }
    __device__ __forceinline__ float* out_kpe() const { return out + ((size_t)TT*DM + 2*16*8*64*64 + 16*256*128); }
    __device__ __forceinline__ float* mod() const { return (float*)(ws + WS::mod); }
    __device__ __forceinline__ bf16_t* w_in_t() const { return (bf16_t*)(ws + WS::w_in_t); }
    __device__ __forceinline__ bf16_t* w_out_t() const { return (bf16_t*)(ws + WS::w_out_t); }
    __device__ __forceinline__ bf16_t* hy_w_in_t() const { return (bf16_t*)(ws + WS::hy_w_in_t); }
    __device__ __forceinline__ bf16_t* hy_w_out_t() const { return (bf16_t*)(ws + WS::hy_w_out_t); }
    __device__ __forceinline__ bf16_t* w_q_t() const { return (bf16_t*)(ws + WS::w_q_t); }
    __device__ __forceinline__ bf16_t* q_up_t() const { return (bf16_t*)(ws + WS::q_up_t); }
    __device__ __forceinline__ bf16_t* kv_up_t() const { return (bf16_t*)(ws + WS::kv_up_t); }
    __device__ __forceinline__ bf16_t* w2_t() const { return (bf16_t*)(ws + WS::w2_t); }
    __device__ __forceinline__ bf16_t* a2_t() const { return (bf16_t*)(ws + WS::a2_t); }
    __device__ __forceinline__ bf16_t* g2_t() const { return (bf16_t*)(ws + WS::g2_t); }
    __device__ __forceinline__ bf16_t* ctxb() const { return (bf16_t*)(ws + WS::ctxb); }
    __device__ __forceinline__ bf16_t* keysb() const { return (bf16_t*)(ws + WS::keysb); }
    __device__ __forceinline__ bf16_t* tabU() const { return (bf16_t*)(ws + WS::tabU); }
    __device__ __forceinline__ bf16_t* tabV() const { return (bf16_t*)(ws + WS::tabV); }
    __device__ __forceinline__ float* nsum() const { return (float*)(ws + WS::nsum); }
    __device__ __forceinline__ bf16_t* rb() const { return (bf16_t*)(ws + WS::rb); }
    __device__ __forceinline__ bf16_t* kb() const { return (bf16_t*)(ws + WS::kb); }
    __device__ __forceinline__ bf16_t* vb() const { return (bf16_t*)(ws + WS::vb); }
    __device__ __forceinline__ bf16_t* kkb() const { return (bf16_t*)(ws + WS::kkb); }
    __device__ __forceinline__ bf16_t* lr0() const { return (bf16_t*)(ws + WS::lr0); }
    __device__ __forceinline__ bf16_t* lr1() const { return (bf16_t*)(ws + WS::lr1); }
    __device__ __forceinline__ bf16_t* gateb() const { return (bf16_t*)(ws + WS::gateb); }
    __device__ __forceinline__ _Float16* du0() const { return (_Float16*)(ws + WS::du0); }
    __device__ __forceinline__ _Float16* du1() const { return (_Float16*)(ws + WS::du1); }
    __device__ __forceinline__ bf16_t* twb() const { return (bf16_t*)(ws + WS::twb); }
    __device__ __forceinline__ bf16_t* advb() const { return (bf16_t*)(ws + WS::advb); }
    __device__ __forceinline__ bf16_t* sgb() const { return (bf16_t*)(ws + WS::sgb); }
    __device__ __forceinline__ float* bonus() const { return (float*)(ws + WS::bonus); }
    __device__ __forceinline__ float* kpe() const { return (float*)(ws + WS::kpe); }
    __device__ __forceinline__ bf16_t* qcnb() const { return (bf16_t*)(ws + WS::qcnb); }
    __device__ __forceinline__ bf16_t* ckvb() const { return (bf16_t*)(ws + WS::ckvb); }
    __device__ __forceinline__ bf16_t* Qb() const { return (bf16_t*)(ws + WS::Qb); }
    __device__ __forceinline__ bf16_t* Kp() const { return (bf16_t*)(ws + WS::Kp); }
    __device__ __forceinline__ bf16_t* Vp() const { return (bf16_t*)(ws + WS::Vp); }
    __device__ __forceinline__ bf16_t* Ks() const { return (bf16_t*)(ws + WS::Ks); }
    __device__ __forceinline__ bf16_t* Vs() const { return (bf16_t*)(ws + WS::Vs); }
    __device__ __forceinline__ bf16_t* kvctxb() const { return (bf16_t*)(ws + WS::kvctxb); }
    __device__ __forceinline__ int* pidx() const { return (int*)(ws + WS::pidx); }
    __device__ __forceinline__ float* pg() const { return (float*)(ws + WS::pg); }
    __device__ __forceinline__ bf16_t* hb() const { return (bf16_t*)(ws + WS::hb); }
    __device__ __forceinline__ bf16_t* catb() const { return (bf16_t*)(ws + WS::catb); }
    __device__ __forceinline__ bf16_t* zbb() const { return (bf16_t*)(ws + WS::zbb); }
    __device__ __forceinline__ bf16_t* kvrawb() const { return (bf16_t*)(ws + WS::kvrawb); }
    __device__ __forceinline__ bf16_t* qrawb() const { return (bf16_t*)(ws + WS::qrawb); }
    __device__ __forceinline__ bf16_t* projrw() const { return (bf16_t*)(ws + WS::projrw); }
    __device__ __forceinline__ float* projmla() const { return (float*)(ws + WS::projmla); }
    __device__ __forceinline__ float* y0() const { return (float*)(ws + WS::y0); }
    __device__ __forceinline__ float* y1() const { return (float*)(ws + WS::y1); }
    __device__ __forceinline__ bf16_t* qb() const { return (bf16_t*)(ws + WS::qb); }
    __device__ __forceinline__ float* scT() const { return (float*)(ws + WS::scT); }
    __device__ __forceinline__ float* pre() const { return (float*)(ws + WS::pre); }
    __device__ __forceinline__ bf16_t* zT() const { return (bf16_t*)(ws + WS::zT); }
    __device__ __forceinline__ bf16_t* x0b() const { return (bf16_t*)(ws + WS::x0b); }
    __device__ __forceinline__ bf16_t* yT() const { return (bf16_t*)(ws + WS::yT); }
    __device__ __forceinline__ bf16_t* gTS() const { return (bf16_t*)(ws + WS::gTS); }
    __device__ __forceinline__ bf16_t* gTP() const { return (bf16_t*)(ws + WS::gTP); }
    __device__ __forceinline__ unsigned* bar() const { return (unsigned*)(ws + WS::bar); }
};

#define VLOOP(n) for (int vb = blockIdx.x; vb < (n); vb += gridDim.x)
#define ENDV __syncthreads();

__device__ __forceinline__ void peer_layer(const Params& p, char* smem, int li, const float* modl, float* xrs) {
    const bf16_t* wq = p.w_q_t() + (size_t)li * 2048 * 1024;
    const bf16_t* kys = p.keysb() + (size_t)li * 16 * 128 * 128;
    VLOOP(TT / 8) { d_norm_mod2(vb, p.xrun(), xrs, p.norm_g() + (li * 2 + 1) * 1024, modl, 3, 4, p.hb()); }
    xcd_barrier_(p.bar(), smem);
    VLOOP(16 * 96) { d_gemm_bf16(vb % 16, vb / 16, smem, p.hb(), 1024, wq, 1024, 1024, 2048, EpiStoreBf{p.qb(), 2048, 0}); }
    xcd_barrier_(p.bar(), smem);
    VLOOP(16 * 96) { const int hp = vb / 96; d_gemm_bf16(vb % 96, 0, smem, kys + (size_t)hp * 128 * 128, 128, p.qb() + hp * 128, 2048, 128, TT, EpiStore{p.scT() + (size_t)hp * 128 * TT, nullptr, TT, 0}); }
    xcd_barrier_(p.bar(), smem);
    VLOOP(8 * 48) { d_peer_select(vb, p.scT(), p.pidx(), p.pg()); }
    xcd_barrier_(p.bar(), smem);
    VLOOP(TT / 4) { d_peer_apply2(vb, smem, p.hb(), p.pidx(), p.pg(), p.tabU(), p.tabV(), modl, p.xrun()); ENDV }
}

__global__ void __launch_bounds__(256) mega(Params p) {
    __shared__ __attribute__((aligned(16))) char smem[114688 + 16];
    cg::grid_group grid = cg::this_grid();
    if (threadIdx.x < 4) ((unsigned*)(smem + 114688))[threadIdx.x] = 0u;
    __syncthreads();
    (void)xcd_barrier_post(p.bar(), (volatile LAS unsigned*)(smem + 114688));
    const float* mod0 = p.mod();
    const float* mod1 = p.mod() + 5 * 6144;
    float* xrs = p.xrun() + (size_t)TP * DM;

    {
        const int j0 = 192;
        const int j1 = j0 + 36 * 16;
        const int j2 = j1 + 16 * 16;
        const int j3 = j2 + 48 * 16;
        const int j4 = j3 + 16 * 16;
        const int j5 = j4 + 32 * 16;
        const int j6 = j5 + 32 * 16;
        const int j7 = j6 + 12 * 4;
        const int j8 = j7 + 16 * 2;
        const int j9 = j8 + 8;
        const int j10 = j9 + 8;
        const int j11 = j10 + 8;
        const int j12 = j11 + 8;
        const int j13 = j12 + 8 * 2;
        const int j14 = j13 + 8;
        const int j15 = j14 + 32;
        const int j16 = j15 + 1024;
        const int j17 = j16 + 1024;
        const int j18 = j17 + 512;
        const int j19 = j18 + 64;
        VLOOP(j19) {
            if (vb < j0) d_mod2(vb, smem, p.c(), p.c_ctx(), p.w_mod(), p.b_mod(), p.mod());
            else if (vb < j1) d_transpose_w(vb - j0, smem, p.ab_w_in(), 1024, 2240, p.w_in_t());
            else if (vb < j2) d_transpose_w(vb - j1, smem, p.ab_w_out(), 1024, 1024, p.w_out_t());
            else if (vb < j3) d_transpose_w(vb - j2, smem, p.hy_w_in(), 1024, 3072, p.hy_w_in_t());
            else if (vb < j4) d_transpose_w(vb - j3, smem, p.hy_w_out(), 1024, 1024, p.hy_w_out_t());
            else if (vb < j5) d_transpose_w(vb - j4, smem, p.peer_w_q(), 1024, 2048, p.w_q_t());
            else if (vb < j6) d_transpose_w(vb - j5, smem, p.peer_w_q() + (size_t)1024 * 2048, 1024, 2048, p.w_q_t() + (size_t)2048 * 1024);
            else if (vb < j7) d_transpose_w(vb - j6, smem, p.mla_q_up(), 256, 768, p.q_up_t());
            else if (vb < j8) d_transpose_w(vb - j7, smem, p.mla_kv_up(), 128, 1024, p.kv_up_t());
            else if (vb < j9) d_transpose_w(vb - j8, smem, p.rw_w2(), 64, 512, p.w2_t());
            else if (vb < j10) d_transpose_w(vb - j9, smem, p.rw_w2() + 64 * 512, 64, 512, p.w2_t() + 512 * 64);
            else if (vb < j11) d_transpose_w(vb - j10, smem, p.rw_a2(), 64, 512, p.a2_t());
            else if (vb < j12) d_transpose_w(vb - j11, smem, p.rw_a2() + 64 * 512, 64, 512, p.a2_t() + 512 * 64);
            else if (vb < j13) d_transpose_w(vb - j12, smem, p.rw_g2(), 128, 512, p.g2_t());
            else if (vb < j14) d_cvt_bf16(vb - j13, p.cache_ckv(), p.ctxb());
            else if (vb < j15) d_cvt_bf16(vb - j14, p.peer_keys(), p.keysb());
            else if (vb < j16) d_cvt_bf16(vb - j15, p.peer_u(), p.tabU());
            else if (vb < j17) d_cvt_bf16(vb - j16, p.peer_v(), p.tabV());
            else if (vb < j18) d_hy_filt2(vb - j17, smem, LS, p.hy_f_w1(), p.hy_f_b1(), p.hy_f_w2(), p.hy_f_b2(), p.hy_f_w3(), p.hy_f_freq(), p.gTS(), p.nsum());
            else d_hy_filt2(vb - j18, smem, LP, p.hy_f_w1(), p.hy_f_b1(), p.hy_f_w2(), p.hy_f_b2(), p.hy_f_w3(), p.hy_f_freq(), p.gTP(), p.nsum() + 1024);
            ENDV }
    }
    grid.sync();
    VLOOP(TT / 8) { d_norm_mod2(vb, p.x_prompt(), p.x_sample(), p.norm_g(), mod0, 0, 1, p.hb()); }
    xcd_barrier_(p.bar(), smem);
    VLOOP(18 * 96) { d_gemm_bf16(vb % 18, vb / 18, smem, p.hb(), 1024, p.w_in_t(), 1024, 1024, ABIN, EpiProj{p.projrw(), p.projmla()}); }
    xcd_barrier_(p.bar(), smem);
    VLOOP(2688 + 768) {
        if (vb < 2688) d_rw_shift2(vb, p.projrw(), p.rw_mu(), p.rb(), p.kb(), p.vb(), p.twb(), p.advb(), p.sgb());
        else d_mla_pre2(vb - 2688, p.projmla(), p.mla_q_norm(), p.mla_kv_norm(), p.qcnb(), p.ckvb(), p.kpe(), p.out_ckv(), p.out_kpe());
    }
    xcd_barrier_(p.bar(), smem);
    {
        const int n0 = 4 * 96, n1 = 6 * 96, n2 = 8 * 96, n3 = 8 * 8;
        VLOOP(5 * n0 + n1 + n2 + n3) {
            int v = vb;
            if (v < n0) d_gemm_bf16(v % 4, v / 4, smem, p.twb(), 64, p.w2_t(), 64, 64, 512, EpiDecay{p.du0(), p.rw_w0()});
            else if ((v -= n0) < n0) d_gemm_bf16(v % 4, v / 4, smem, p.twb(), 64, p.w2_t() + 512 * 64, 64, 64, 512, EpiDecay{p.du1(), p.rw_w0() + 512});
            else if ((v -= n0) < n0) d_gemm_bf16(v % 4, v / 4, smem, p.advb(), 64, p.a2_t(), 64, 64, 512, EpiLr{p.lr0(), p.rw_a0()});
            else if ((v -= n0) < n0) d_gemm_bf16(v % 4, v / 4, smem, p.advb(), 64, p.a2_t() + 512 * 64, 64, 64, 512, EpiLr{p.lr1(), p.rw_a0() + 512});
            else if ((v -= n0) < n0) d_gemm_bf16(v % 4, v / 4, smem, p.sgb(), 128, p.g2_t(), 128, 128, 512, EpiStoreBf{p.gateb(), 512, 0});
            else if ((v -= n0) < n1) d_gemm_bf16(v % 6, v / 6, smem, p.qcnb(), 256, p.q_up_t(), 256, 256, 768, EpiStoreBf{p.qrawb(), 768, 0});
            else if ((v -= n1) < n2) d_gemm_bf16(v % 8, v / 8, smem, p.ckvb(), 128, p.kv_up_t(), 128, 128, 1024, EpiKV{p.kvrawb(), p.Vp(), p.Vs(), 0, 0});
            else { v -= n2; d_gemm_bf16(v % 8, v / 8, smem, p.ctxb(), 128, p.kv_up_t(), 128, 128, 1024, EpiKV{p.kvctxb(), p.Vp(), p.Vs(), 1, 0}); }
        }
    }
    xcd_barrier_(p.bar(), smem);
    VLOOP(384 + 3328) {
        if (vb < 384) d_rw_kk2(vb, smem, p.rb(), p.kb(), p.lr0(), p.lr1(), p.rw_k_k(), p.rw_k_a(), p.rw_r_k(), p.kkb(), p.bonus());
        else d_mla_post2(vb - 384, p.qrawb(), p.kvrawb(), p.kvctxb(), p.kpe(), p.cache_kpe(), p.mla_qn(), p.mla_kn(), p.Qb(), p.Kp(), p.Ks());
        ENDV }
    xcd_barrier_(p.bar(), smem);
    VLOOP(256 + 1024) {
        if (vb < 256) d_scan2(vb, true, smem, p.rb(), p.kb(), p.vb(), p.kkb(), p.lr0(), p.lr1(), p.du0(), p.du1(), p.rw_k_a(), p.st_f(), p.st_b(), p.y0(), p.y1(), p.out_sf(), p.out_sb());
        else d_scan2(vb - 256, false, smem, p.rb(), p.kb(), p.vb(), p.kkb(), p.lr0(), p.lr1(), p.du0(), p.du1(), p.rw_k_a(), p.st_f(), p.st_b(), p.y0(), p.y1(), p.out_sf(), p.out_sb());
    }
    xcd_barrier_(p.bar(), smem);
    VLOOP(256 + 128) {
        if (vb < 256) { d_attn_mfma(vb, smem, p.Qb(), p.Ks(), p.Vs(), p.catb(), TP, LS, 2304, 16); }
        else { d_attn_mfma(vb - 256, smem, p.Qb(), p.Kp(), p.Vp(), p.catb(), 0, LP, LP, 2); }
        ENDV }
    xcd_barrier_(p.bar(), smem);
    VLOOP(384) { d_rw_post2(vb, smem, p.y0(), p.y1(), p.bonus(), p.vb(), p.gateb(), p.rw_lnx_g(), p.rw_lnx_b(), p.catb()); ENDV }
    xcd_barrier_(p.bar(), smem);
    VLOOP(8 * 96) { d_gemm_bf16(vb % 8, vb / 8, smem, p.catb(), 1024, p.w_out_t(), 1024, 1024, 1024, EpiResid{p.x_prompt(), p.x_sample(), p.xrun(), mod0, 2, 0}); }
    xcd_barrier_(p.bar(), smem);
    peer_layer(p, smem, 0, mod0, xrs);
    xcd_barrier_(p.bar(), smem);
    VLOOP(TT / 8 + 2048) {
        if (vb < TT / 8) d_norm_mod2(vb, p.xrun(), xrs, p.norm_g() + 2048, mod1, 0, 1, p.hb());
        else if (vb < TT / 8 + 1024) d_cvt_bf16(vb - TT / 8, p.peer_u() + (size_t)16384 * 1024, p.tabU());
        else d_cvt_bf16(vb - (TT / 8 + 1024), p.peer_v() + (size_t)16384 * 1024, p.tabV());
    }
    xcd_barrier_(p.bar(), smem);
    VLOOP(24 * 96) { d_gemm_bf16(vb % 24, vb / 24, smem, p.hb(), 1024, p.hy_w_in_t(), 1024, 1024, 3072, EpiStore{p.pre(), p.hy_b_in(), 3072, 0}); }
    xcd_barrier_(p.bar(), smem);
    VLOOP(192 * 16) { d_hy_dw2(vb, smem, p.pre(), p.hy_conv_w(), p.hy_conv_b(), p.zT(), p.x0b()); ENDV }
    xcd_barrier_(p.bar(), smem);
    VLOOP(256 + 256) {
        char* wsm = smem + (threadIdx.x >> 6) * 28672;
        if (vb < 256) d_hy_conv2<true>(vb * 4 + (threadIdx.x >> 6), wsm, p.gTS(), p.nsum(), p.zT(), p.hy_bias(), p.yT());
        else d_hy_conv2<false>((vb - 256) * 4 + (threadIdx.x >> 6), wsm, p.gTP(), p.nsum() + 1024, p.zT(), p.hy_bias(), p.yT());
        ENDV }
    xcd_barrier_(p.bar(), smem);
    VLOOP(192 * 16) { d_hy_post(vb, smem, p.yT(), p.x0b(), p.zbb()); ENDV }
    xcd_barrier_(p.bar(), smem);
    VLOOP(8 * 96) { d_gemm_bf16(vb % 8, vb / 8, smem, p.zbb(), 1024, p.hy_w_out_t(), 1024, 1024, 1024, EpiResid{p.xrun(), xrs, p.xrun(), mod1, 2, 0}); }
    xcd_barrier_(p.bar(), smem);
    peer_layer(p, smem, 1, mod1, xrs);
}

static inline size_t align_up(size_t x) { return (x + 255) & ~(size_t)255; }

extern "C" void kernel_launch(void* const* d_in, const int* in_sizes, int n_in, void* d_out, int out_size, void* d_ws, size_t ws_size,
                              hipStream_t stream) {
    Params p{};
    for (int i = 0; i < 46; i++) p.in[i] = (const float*)d_in[i];
    p.out = (float*)d_out;
    p.ws = (char*)d_ws;
    static_assert(WS::END <= (size_t)422781952, "workspace plan exceeds the guaranteed scratch size");
    static int grid_blocks = 0;
    if (!grid_blocks) {
        int dev = 0, cus = 0, per_cu = 0;
        (void)hipGetDevice(&dev);
        (void)hipDeviceGetAttribute(&cus, hipDeviceAttributeMultiprocessorCount, dev);
        (void)hipOccupancyMaxActiveBlocksPerMultiprocessor(&per_cu, mega, 256, 0);
        if (per_cu > 1) per_cu = 1;
        if (per_cu < 1) per_cu = 1;
        grid_blocks = cus * per_cu;
    }
    (void)hipMemsetAsync(p.ws + WS::nsum, 0, (size_t)2 * 1024 * 4 + (size_t)XCD_BAR_WORDS * 4 + 1024, stream);
    void* args[] = {&p};
    (void)hipLaunchCooperativeKernel((void*)mega, dim3(grid_blocks), dim3(256), args, 0, stream);
}
```

```cpp
#include <hip/hip_runtime.h>
#include <stdint.h>
#include <hip/hip_cooperative_groups.h>
namespace cg = cooperative_groups;

#define DM 1024
#define TP 4096
#define TS 8192
#define TT 12288
#define LP 256
#define LS 2048
#define NBP 16
#define NBS 4
#define ABIN 2240
#define RWIN 1792

typedef unsigned short bf16_t;
__device__ __forceinline__ bf16_t f2bf(float f) { unsigned u = __float_as_uint(f); u += 0x7fffu + ((u >> 16) & 1u); return (bf16_t)(u >> 16); }
__device__ __forceinline__ float bf2f(bf16_t h) { return __uint_as_float(((unsigned)h) << 16); }
__device__ __forceinline__ float sigmoidf_(float x) { return 1.f / (1.f + expf(-x)); }
__device__ __forceinline__ float gelu_tanh(float x) { return 0.5f * x * (1.f + tanhf(0.7978845608028654f * (x + 0.044715f * x * x * x))); }

__device__ __forceinline__ int tok_pos(int t) { return t < TP ? (t & (LP - 1)) : ((t - TP) & (LS - 1)); }
__device__ __forceinline__ int tok_len(int t) { return t < TP ? LP : LS; }
__device__ __forceinline__ int tok_modrow(int t) { return t < TP ? 0 : 1 + ((t - TP) >> 11); }

__device__ __forceinline__ float wave_sum(float v) {
#pragma unroll
    for (int o = 32; o > 0; o >>= 1) v += __shfl_xor(v, o, 64);
    return v;
}

__device__ __forceinline__ void d_mod(const int bx, const int by, const int bz, char* smem, const float* __restrict__ c, const float* __restrict__ c_ctx, const float* __restrict__ w_mod,
                                             const float* __restrict__ b_mod, float* __restrict__ mod) {
    float (*s)[1024] = (float(*)[1024])smem;
    const int li = by;
    const int n = bx * 256 + threadIdx.x;
    for (int i = threadIdx.x; i < 5 * 1024; i += 256) {
        int r = i >> 10, k = i & 1023;
        float v = (r == 0) ? c_ctx[k] : c[(r - 1) * 1024 + k];
        s[r][k] = v / (1.f + expf(-v));
    }
    __syncthreads();
    float a0 = 0, a1 = 0, a2 = 0, a3 = 0, a4 = 0;
    const float* w = w_mod + (size_t)li * 1024 * 6144 + n;
    for (int k = 0; k < 1024; k++) {
        float wv = w[(size_t)k * 6144];
        a0 += s[0][k] * wv; a1 += s[1][k] * wv; a2 += s[2][k] * wv; a3 += s[3][k] * wv; a4 += s[4][k] * wv;
    }
    float bb = b_mod[li * 6144 + n];
    float* o = mod + (size_t)li * 5 * 6144 + n;
    o[0 * 6144] = a0 + bb; o[1 * 6144] = a1 + bb; o[2 * 6144] = a2 + bb; o[3 * 6144] = a3 + bb; o[4 * 6144] = a4 + bb;
}


__device__ __forceinline__ void d_mod2(const int vb, char* smem, const float* __restrict__ c, const float* __restrict__ c_ctx,
                                       const float* __restrict__ w_mod, const float* __restrict__ b_mod, float* __restrict__ mod) {
    float* sl = (float*)smem;
    float* red = sl + 5 * 1024;
    const int li = vb / 96, n0 = (vb % 96) * 64;
    const int tid = threadIdx.x, col = tid & 63, kg = tid >> 6;
    for (int i = tid; i < 5 * 1024; i += 256) {
        const int r = i >> 10, k = i & 1023;
        const float v = (r == 0) ? c_ctx[k] : c[(r - 1) * 1024 + k];
        sl[i] = v / (1.f + __expf(-v));
    }
    __syncthreads();
    float a0 = 0, a1 = 0, a2 = 0, a3 = 0, a4 = 0;
    const float* w = w_mod + (size_t)li * 1024 * 6144 + (size_t)(kg * 256) * 6144 + n0 + col;
    const float* s0 = sl + kg * 256;
#pragma unroll 8
    for (int k = 0; k < 256; k++) {
        const float wv = w[(size_t)k * 6144];
        a0 += s0[k] * wv; a1 += s0[1024 + k] * wv; a2 += s0[2048 + k] * wv; a3 += s0[3072 + k] * wv; a4 += s0[4096 + k] * wv;
    }
    red[(kg * 5 + 0) * 64 + col] = a0; red[(kg * 5 + 1) * 64 + col] = a1; red[(kg * 5 + 2) * 64 + col] = a2;
    red[(kg * 5 + 3) * 64 + col] = a3; red[(kg * 5 + 4) * 64 + col] = a4;
    __syncthreads();
    for (int i = tid; i < 5 * 64; i += 256) {
        const int r = i >> 6, cc = i & 63;
        const float v = red[(0 * 5 + r) * 64 + cc] + red[(1 * 5 + r) * 64 + cc] + red[(2 * 5 + r) * 64 + cc] + red[(3 * 5 + r) * 64 + cc];
        mod[(size_t)(li * 5 + r) * 6144 + n0 + cc] = v + b_mod[li * 6144 + n0 + cc];
    }
}

__device__ __forceinline__ void d_norm_mod(const int bx, const int by, const int bz, char* smem, const float* __restrict__ xa, const float* __restrict__ xb, const float* __restrict__ g,
                                                  const float* __restrict__ modl, int shift_idx, int scale_idx, bf16_t* __restrict__ h) {
    float* red = (float*)smem;
    const int t = bx;
    const float* x = (t < TP) ? (xa + (size_t)t * DM) : (xb + (size_t)(t - TP) * DM);
    const int c = threadIdx.x * 4;
    float4 v = *(const float4*)(x + c);
    float ss = v.x * v.x + v.y * v.y + v.z * v.z + v.w * v.w;
    ss = wave_sum(ss);
    if ((threadIdx.x & 63) == 0) red[threadIdx.x >> 6] = ss;
    __syncthreads();
    float tot = red[0] + red[1] + red[2] + red[3];
    float rstd = rsqrtf(tot * (1.f / DM) + 1e-6f);
    const float* m = modl + (size_t)tok_modrow(t) * 6144;
    float4 gg = *(const float4*)(g + c);
    float4 sh = *(const float4*)(m + shift_idx * 1024 + c);
    float4 sc = *(const float4*)(m + scale_idx * 1024 + c);
    float4 o;
    o.x = v.x * rstd * gg.x * (1.f + sc.x) + sh.x;
    o.y = v.y * rstd * gg.y * (1.f + sc.y) + sh.y;
    o.z = v.z * rstd * gg.z * (1.f + sc.z) + sh.z;
    o.w = v.w * rstd * gg.w * (1.f + sc.w) + sh.w;
    ushort4 ob; ob.x = f2bf(o.x); ob.y = f2bf(o.y); ob.z = f2bf(o.z); ob.w = f2bf(o.w);
    *(ushort4*)(h + (size_t)t * DM + c) = ob;
}

struct EpiStore { static constexpr bool kQuad = false; float* C; const float* bias; int ldc; int pad;
    __device__ void operator()(int m, int n, float a) const { C[(size_t)m * ldc + n] = a + (bias ? bias[n] : 0.f); } };
struct EpiStoreBf { static constexpr bool kQuad = false; bf16_t* C; int ldc; int pad;
    __device__ void operator()(int m, int n, float a) const { C[(size_t)m * ldc + n] = f2bf(a); } };
struct EpiDecay { static constexpr bool kQuad = false; _Float16* out; const float* w0;
    __device__ void operator()(int m, int n, float a) const { out[(size_t)m * 512 + n] = (_Float16)sigmoidf_(w0[n] + a); } };
struct EpiProj { static constexpr bool kQuad = false; bf16_t* rw; float* mla;
    __device__ void operator()(int m, int n, float a) const { if (n < RWIN) rw[(size_t)m * RWIN + n] = f2bf(a); else mla[(size_t)m * 448 + (n - RWIN)] = a; } };
struct EpiLr { static constexpr bool kQuad = false; bf16_t* out; const float* a0;
    __device__ void operator()(int m, int n, float a) const { out[(size_t)m * 512 + n] = f2bf(sigmoidf_(a0[n] + a)); } };
struct EpiResid { static constexpr bool kQuad = false; const float* xa; const float* xb; float* out; const float* modl; int gate_idx; int pad;
    __device__ void operator()(int m, int n, float a) const {
        float x = (m < TP) ? xa[(size_t)m * DM + n] : xb[(size_t)(m - TP) * DM + n];
        float gt = modl[(size_t)tok_modrow(m) * 6144 + gate_idx * 1024 + n];
        out[(size_t)m * DM + n] = x + gt * a; } };

struct EpiKV { static constexpr bool kQuad = true;
    bf16_t* kvraw; bf16_t* Vp; bf16_t* Vs; int ctx; int pad;
    __device__ void operator()(int m, int n, float a) const {}
    __device__ void quad(int row0, int col, float v0, float v1, float v2, float v3) const {
        const int hd = col >> 8, within = col & 255;
        if (within < 128) {
            bf16_t* d = kvraw + (size_t)row0 * 1024 + col;
            d[0] = f2bf(v0); d[1024] = f2bf(v1); d[2048] = f2bf(v2); d[3072] = f2bf(v3);
        } else {
            const int dv = within - 128;
            int b, kidx, Lk; bf16_t* base;
            if (ctx) { b = row0 >> 8; kidx = row0 & 255; Lk = 2304; base = Vs; }
            else if (row0 < TP) { b = row0 >> 8; kidx = row0 & 255; Lk = LP; base = Vp; }
            else { b = (row0 - TP) >> 11; kidx = 256 + ((row0 - TP) & 2047); Lk = 2304; base = Vs; }
            const int kpos = (kidx & ~12) | ((kidx & 8) >> 1) | ((kidx & 4) << 1);
            ushort4 o; o.x = f2bf(v0); o.y = f2bf(v1); o.z = f2bf(v2); o.w = f2bf(v3);
            *(ushort4*)(base + ((size_t)((b * 4 + hd) * 128 + dv)) * Lk + kpos) = o;
        }
    } };

template <class Epi>
__device__ __forceinline__ void d_gemm(const int bx, const int by, const int bz, char* smem, const float* __restrict__ A, int lda, const float* __restrict__ B, int ldb, int K, Epi epi) {
    float (*As)[68] = (float(*)[68])smem;
    float (*Bs)[68] = (float(*)[68])(smem + 16 * 68 * 4);
    const int m0 = by * 64, n0 = bx * 64;
    const int tid = threadIdx.x, tx = tid & 15, ty = tid >> 4;
    float acc[4][4];
#pragma unroll
    for (int i = 0; i < 4; i++)
#pragma unroll
        for (int j = 0; j < 4; j++) acc[i][j] = 0.f;
    for (int k0 = 0; k0 < K; k0 += 16) {
        {
            int r = tid >> 2, kq = (tid & 3) * 4;
            float4 v = *(const float4*)(A + (size_t)(m0 + r) * lda + k0 + kq);
            As[kq + 0][r] = v.x; As[kq + 1][r] = v.y; As[kq + 2][r] = v.z; As[kq + 3][r] = v.w;
        }
        {
            int kk = tid >> 4, nq = (tid & 15) * 4;
            float4 v = *(const float4*)(B + (size_t)(k0 + kk) * ldb + n0 + nq);
            *(float4*)&Bs[kk][nq] = v;
        }
        __syncthreads();
#pragma unroll
        for (int k = 0; k < 16; k++) {
            float a[4], b[4];
#pragma unroll
            for (int i = 0; i < 4; i++) a[i] = As[k][ty * 4 + i];
            float4 bv = *(const float4*)&Bs[k][tx * 4];
            b[0] = bv.x; b[1] = bv.y; b[2] = bv.z; b[3] = bv.w;
#pragma unroll
            for (int i = 0; i < 4; i++)
#pragma unroll
                for (int j = 0; j < 4; j++) acc[i][j] += a[i] * b[j];
        }
        __syncthreads();
    }
#pragma unroll
    for (int i = 0; i < 4; i++)
#pragma unroll
        for (int j = 0; j < 4; j++) epi(m0 + ty * 4 + i, n0 + tx * 4 + j, acc[i][j]);
}


typedef __attribute__((ext_vector_type(8))) short bf16x8;
typedef __attribute__((ext_vector_type(16))) float f32x16;
typedef __attribute__((ext_vector_type(4))) float f32x4;
typedef __attribute__((ext_vector_type(4))) unsigned u32x4;
#define GEMM_LDS_BYTES 73728

template <class Epi>
__device__ __forceinline__ void d_gemm_bf16(const int bx, const int by, char* smem, const bf16_t* __restrict__ A, int lda,
                                            const bf16_t* __restrict__ Bt, int ldb, int K, int N, Epi epi) {
    const int tid = threadIdx.x, lane = tid & 63, wid = tid >> 6;
    const int wm = wid >> 1, wn = wid & 1;
    const int m0 = by * 128, n0 = bx * 128;
    f32x16 acc[2][2];
#pragma unroll
    for (int i = 0; i < 2; i++)
#pragma unroll
        for (int j = 0; j < 2; j++)
#pragma unroll
            for (int r = 0; r < 16; r++) acc[i][j][r] = 0.f;
    const int lrow = tid >> 3, lcol = (tid & 7) * 8;
    const bf16_t* ga = A + (size_t)(m0 + lrow) * lda + lcol;
    const bf16_t* gb = Bt + (size_t)(n0 + lrow) * ldb + lcol;
    u32x4 ra[4], rb[4];
    const int KT = K >> 6;
#pragma unroll
    for (int i = 0; i < 4; i++) { ra[i] = *(const u32x4*)(ga + (size_t)(32 * i) * lda); rb[i] = *(const u32x4*)(gb + (size_t)(32 * i) * ldb); }
    {
        char* sa = smem;
#pragma unroll
        for (int i = 0; i < 4; i++) { *(u32x4*)(sa + (lrow + 32 * i) * 144 + lcol * 2) = ra[i]; *(u32x4*)(sa + 18432 + (lrow + 32 * i) * 144 + lcol * 2) = rb[i]; }
    }
    __syncthreads();
    const int frow = lane & 31, fk = (lane >> 5) * 16;
    for (int kt = 0; kt < KT; kt++) {
        if (kt + 1 < KT) {
#pragma unroll
            for (int i = 0; i < 4; i++) { ra[i] = *(const u32x4*)(ga + (size_t)(32 * i) * lda + (kt + 1) * 64); rb[i] = *(const u32x4*)(gb + (size_t)(32 * i) * ldb + (kt + 1) * 64); }
        }
        const char* sa = smem + (kt & 1) * 36864;
        const char* sb = sa + 18432;
#pragma unroll
        for (int ks = 0; ks < 4; ks++) {
            bf16x8 af[2], bfr[2];
#pragma unroll
            for (int i = 0; i < 2; i++) af[i] = *(const bf16x8*)(sa + (wm * 64 + i * 32 + frow) * 144 + ks * 32 + fk);
#pragma unroll
            for (int j = 0; j < 2; j++) bfr[j] = *(const bf16x8*)(sb + (wn * 64 + j * 32 + frow) * 144 + ks * 32 + fk);
#pragma unroll
            for (int i = 0; i < 2; i++)
#pragma unroll
                for (int j = 0; j < 2; j++) acc[i][j] = __builtin_amdgcn_mfma_f32_32x32x16_bf16(af[i], bfr[j], acc[i][j], 0, 0, 0);
        }
        if (kt + 1 < KT) {
            char* sn = smem + ((kt + 1) & 1) * 36864;
#pragma unroll
            for (int i = 0; i < 4; i++) { *(u32x4*)(sn + (lrow + 32 * i) * 144 + lcol * 2) = ra[i]; *(u32x4*)(sn + 18432 + (lrow + 32 * i) * 144 + lcol * 2) = rb[i]; }
        }
        __syncthreads();
    }
#pragma unroll
    for (int i = 0; i < 2; i++)
#pragma unroll
        for (int j = 0; j < 2; j++) {
            const int col = n0 + wn * 64 + j * 32 + (lane & 31);
            if (col < N) {
                if constexpr (Epi::kQuad) {
#pragma unroll
                    for (int g = 0; g < 4; g++) {
                        const int row0 = m0 + wm * 64 + i * 32 + 8 * g + 4 * (lane >> 5);
                        epi.quad(row0, col, acc[i][j][4 * g], acc[i][j][4 * g + 1], acc[i][j][4 * g + 2], acc[i][j][4 * g + 3]);
                    }
                } else {
#pragma unroll
                    for (int r = 0; r < 16; r++) {
                        const int row = m0 + wm * 64 + i * 32 + (r & 3) + 8 * (r >> 2) + 4 * (lane >> 5);
                        epi(row, col, acc[i][j][r]);
                    }
                }
            }
        }
}

__device__ __forceinline__ void d_transpose_w(const int vb, char* smem, const float* __restrict__ W, int K, int N, bf16_t* __restrict__ Wt) {
    float (*tile)[65] = (float(*)[65])smem;
    const int kt = K >> 6;
    const int nb = vb / kt, kb = vb % kt;
    const int tid = threadIdx.x;
    {
        const int n = nb * 64 + (tid & 63);
#pragma unroll
        for (int i = 0; i < 16; i++) {
            int k = (tid >> 6) + 4 * i;
            tile[k][tid & 63] = (n < N) ? W[(size_t)(kb * 64 + k) * N + n] : 0.f;
        }
    }
    __syncthreads();
    {
        const int k = tid & 63;
#pragma unroll
        for (int i = 0; i < 16; i++) {
            int n = (tid >> 6) + 4 * i;
            Wt[(size_t)(nb * 64 + n) * K + kb * 64 + k] = f2bf(tile[k][n]);
        }
    }
}

__device__ __forceinline__ void d_rw_shift(const int bx, const int by, const int bz, char* smem, const bf16_t* __restrict__ proj, const float* __restrict__ mu, bf16_t* __restrict__ rb,
                                                  bf16_t* __restrict__ kb, bf16_t* __restrict__ vb, bf16_t* __restrict__ tw, bf16_t* __restrict__ adv,
                                                  bf16_t* __restrict__ sg) {
    const int t = bx;
    const int pos = tok_pos(t), L = tok_len(t);
    const bf16_t* P = proj + (size_t)t * RWIN;
    for (int c = threadIdx.x; c < RWIN; c += 256) {
        float cur = bf2f(P[c]);
        float prev = (pos > 0) ? bf2f(P[c - RWIN]) : 0.f;
        float nxt = (pos < L - 1) ? bf2f(P[c + RWIN]) : 0.f;
        float val = cur + mu[c] * (0.5f * (prev + nxt) - cur);
        if (c < 512) rb[(size_t)t * 512 + c] = f2bf(val);
        else if (c < 1024) kb[(size_t)t * 512 + c - 512] = f2bf(val);
        else if (c < 1536) vb[(size_t)t * 512 + c - 1024] = f2bf(val);
        else if (c < 1600) tw[(size_t)t * 64 + c - 1536] = f2bf(tanhf(val));
        else if (c < 1664) adv[(size_t)t * 64 + c - 1600] = f2bf(val);
        else sg[(size_t)t * 128 + c - 1664] = f2bf(sigmoidf_(val));
    }
}

__device__ __forceinline__ void d_rw_kk(const int bx, const int by, const int bz, char* smem, const bf16_t* __restrict__ rb, const bf16_t* __restrict__ kb, const bf16_t* __restrict__ lr0,
                                               const bf16_t* __restrict__ lr1, const float* __restrict__ k_k, const float* __restrict__ k_a,
                                               const float* __restrict__ r_k, bf16_t* __restrict__ kkb, float* __restrict__ bonus) {
    const int w = bx * 4 + (threadIdx.x >> 6);
    const int lane = threadIdx.x & 63;
    const int t = w >> 3, h = w & 7;
    const size_t o = (size_t)t * 512 + h * 64 + lane;
    const int ch = h * 64 + lane;
    float k = bf2f(kb[o]), r = bf2f(rb[o]);
    float kk = k * k_k[ch];
    float nrm = sqrtf(wave_sum(kk * kk));
    kk = kk / fmaxf(nrm, 1e-12f);
    kkb[o] = f2bf(kk);
    float l0 = bf2f(lr0[o]), l1 = bf2f(lr1[o]);
    float ka = k_a[ch];
    float kd0 = k * (1.f + (l0 - 1.f) * ka), kd1 = k * (1.f + (l1 - 1.f) * ka);
    float s = wave_sum(r * (kd0 + kd1) * r_k[ch]);
    if (lane == 0) bonus[w] = s;
}

__device__ __forceinline__ void d_scan(const int bx, const int by, const int bz, char* smem, const bf16_t* __restrict__ rb, const bf16_t* __restrict__ kb, const bf16_t* __restrict__ vb,
                                             const bf16_t* __restrict__ kkb, const bf16_t* __restrict__ lr0, const bf16_t* __restrict__ lr1,
                                             const _Float16* __restrict__ dec0, const _Float16* __restrict__ dec1, const float* __restrict__ k_a,
                                             const float* __restrict__ st_f, const float* __restrict__ st_b, float* __restrict__ y0,
                                             float* __restrict__ y1, float* __restrict__ out_sf, float* __restrict__ out_sb) {
    float* sbase = (float*)smem + (threadIdx.x >> 6) * 320;
    float* sa_ = sbase; float* sw_ = sbase + 64; float* sb_ = sbase + 128; float* skd_ = sbase + 192; float* sr_ = sbase + 256;
    int id = bx * 4 + (threadIdx.x >> 6);
    int d, h, b, L, tbase;
    bool prompt = id < 256;
    if (prompt) { d = id & 1; h = (id >> 1) & 7; b = id >> 4; L = LP; tbase = b * LP; }
    else { int j = id - 256; d = j & 1; h = (j >> 1) & 7; b = j >> 4; L = LS; tbase = TP + b * LS; }
    const int v = threadIdx.x & 63;
    const bf16_t* lr = d ? lr1 : lr0;
    const _Float16* dec = d ? dec1 : dec0;
    float* yo = d ? y1 : y0;
    const float ka = k_a[h * 64 + v];
    float S[64];
    if (prompt) {
#pragma unroll
        for (int k = 0; k < 64; k++) S[k] = 0.f;
    } else {
        const float* st = (d ? st_b : st_f) + ((size_t)(b * 8 + h) * 64 + v) * 64;
#pragma unroll
        for (int k = 0; k < 64; k += 4) { float4 q = *(const float4*)(st + k); S[k] = q.x; S[k + 1] = q.y; S[k + 2] = q.z; S[k + 3] = q.w; }
    }
    for (int i = 0; i < L; i++) {
        const int t = tbase + (d ? (L - 1 - i) : i);
        const size_t o = (size_t)t * 512 + h * 64 + v;
        float kkv = bf2f(kkb[o]), lrv = bf2f(lr[o]), kv = bf2f(kb[o]), rv = bf2f(rb[o]), vv = bf2f(vb[o]), wv = __expf(-0.6065306597126334f * (float)dec[o]);
        __builtin_amdgcn_wave_barrier();
        sa_[v] = -kkv; sb_[v] = kkv * lrv; skd_[v] = kv * (1.f + (lrv - 1.f) * ka); sw_[v] = wv; sr_[v] = rv;
        __builtin_amdgcn_wave_barrier();
        float sa = 0.f;
#pragma unroll
        for (int k = 0; k < 64; k += 4) { float4 a = *(const float4*)&sa_[k]; sa += S[k] * a.x + S[k + 1] * a.y + S[k + 2] * a.z + S[k + 3] * a.w; }
        float y = 0.f;
#pragma unroll
        for (int k = 0; k < 64; k += 4) {
            float4 w4 = *(const float4*)&sw_[k]; float4 b4 = *(const float4*)&sb_[k]; float4 k4 = *(const float4*)&skd_[k]; float4 r4 = *(const float4*)&sr_[k];
            S[k] = S[k] * w4.x + sa * b4.x + vv * k4.x; y += S[k] * r4.x;
            S[k + 1] = S[k + 1] * w4.y + sa * b4.y + vv * k4.y; y += S[k + 1] * r4.y;
            S[k + 2] = S[k + 2] * w4.z + sa * b4.z + vv * k4.z; y += S[k + 2] * r4.z;
            S[k + 3] = S[k + 3] * w4.w + sa * b4.w + vv * k4.w; y += S[k + 3] * r4.w;
        }
        yo[o] = y;
    }
    if (prompt) {
        float* os = (d ? out_sb : out_sf) + ((size_t)(b * 8 + h) * 64 + v) * 64;
#pragma unroll
        for (int k = 0; k < 64; k += 4) *(float4*)(os + k) = make_float4(S[k], S[k + 1], S[k + 2], S[k + 3]);
    }
}


#define SC_STEP 336
template <int CTRL>
__device__ __forceinline__ float dpp_add(float v) {
    return v + __int_as_float(__builtin_amdgcn_update_dpp(0, __float_as_int(v), CTRL, 0xf, 0xf, false));
}
__device__ __forceinline__ float row16_allsum(float v) {
    v = dpp_add<0x128>(v); v = dpp_add<0x124>(v); v = dpp_add<0x122>(v); v = dpp_add<0x121>(v);
    return v;
}
__device__ __forceinline__ void d_scan2(const int item, const bool sample, char* smem, const bf16_t* __restrict__ rb, const bf16_t* __restrict__ kb,
                                        const bf16_t* __restrict__ vb, const bf16_t* __restrict__ kkb, const bf16_t* __restrict__ lr0,
                                        const bf16_t* __restrict__ lr1, const _Float16* __restrict__ du0, const _Float16* __restrict__ du1,
                                        const float* __restrict__ k_a, const float* __restrict__ st_f, const float* __restrict__ st_b,
                                        float* __restrict__ y0, float* __restrict__ y1, float* __restrict__ out_sf, float* __restrict__ out_sb) {
    const int chain = item >> 2, qd = item & 3;
    const int d = chain & 1, h = (chain >> 1) & 7, b = chain >> 4;
    const int L = sample ? LS : LP;
    const int tbase = sample ? (TP + b * LS) : (b * LP);
    const int tid = threadIdx.x, wid = tid >> 6, lane = tid & 63;
    const int rr = lane >> 4, pp = lane & 15;
    const int row = qd * 16 + wid * 4 + rr;
    const bf16_t* lr = d ? lr1 : lr0;
    const _Float16* du = d ? du1 : du0;
    float* yo = d ? y1 : y0;
    float S0, S1, S2, S3;
    if (sample) {
        const float4 s4 = *(const float4*)((d ? st_b : st_f) + ((size_t)(b * 8 + h) * 64 + row) * 64 + pp * 4);
        S0 = s4.x; S1 = s4.y; S2 = s4.z; S3 = s4.w;
    } else { S0 = S1 = S2 = S3 = 0.f; }
    const int sk = tid & 63, ss = tid >> 6;
    const float ka = k_a[h * 64 + sk];
    const size_t colk = (size_t)h * 64 + sk;
    const size_t colv = (size_t)h * 64 + qd * 16 + (tid & 15);
    float* buf = (float*)smem;
    unsigned g_kk[4], g_lr[4], g_k[4], g_r[4], g_u[4], g_v;
    const int nch = L >> 4;
#define SC_GLOAD(c)                                                                                        \
    {                                                                                                      \
        _Pragma("unroll") for (int j = 0; j < 4; j++) {                                                    \
            const int i = (c) * 16 + ss + 4 * j;                                                           \
            const size_t o = (size_t)(tbase + (d ? (L - 1 - i) : i)) * 512 + colk;                         \
            g_kk[j] = kkb[o]; g_lr[j] = lr[o]; g_k[j] = kb[o]; g_r[j] = rb[o]; g_u[j] = ((const unsigned short*)du)[o]; \
        }                                                                                                  \
        { const int i = (c) * 16 + (tid >> 4); g_v = vb[(size_t)(tbase + (d ? (L - 1 - i) : i)) * 512 + colv]; } \
    }
#define SC_SSTORE(bi)                                                                                      \
    {                                                                                                      \
        float* B_ = buf + (bi) * 16 * SC_STEP;                                                             \
        _Pragma("unroll") for (int j = 0; j < 4; j++) {                                                    \
            float* st_ = B_ + (ss + 4 * j) * SC_STEP + sk;                                                 \
            const float kkv = __uint_as_float(g_kk[j] << 16), lrv = __uint_as_float(g_lr[j] << 16), kv = __uint_as_float(g_k[j] << 16); \
            st_[0] = -kkv; st_[64] = __expf(-0.6065306597126334f * (float)__builtin_bit_cast(_Float16, (unsigned short)g_u[j])); st_[128] = kkv * lrv;   \
            st_[192] = kv * (1.f + (lrv - 1.f) * ka); st_[256] = __uint_as_float(g_r[j] << 16);            \
        }                                                                                                  \
        B_[(tid >> 4) * SC_STEP + 320 + (tid & 15)] = __uint_as_float(g_v << 16);                          \
    }
    SC_GLOAD(0)
    SC_SSTORE(0)
    __syncthreads();
    for (int c = 0; c < nch; c++) {
        if (c + 1 < nch) SC_GLOAD(c + 1)
        __builtin_amdgcn_sched_barrier(0);
        const float* B_ = buf + (c & 1) * 16 * SC_STEP;
        float ysave = 0.f;
#pragma unroll 4
        for (int s_ = 0; s_ < 16; s_++) {
            const float* st_ = B_ + s_ * SC_STEP;
            const float4 a4 = *(const float4*)(st_ + pp * 4);
            const float4 w4 = *(const float4*)(st_ + 64 + pp * 4);
            const float4 b4 = *(const float4*)(st_ + 128 + pp * 4);
            const float4 k4 = *(const float4*)(st_ + 192 + pp * 4);
            const float4 r4 = *(const float4*)(st_ + 256 + pp * 4);
            const float vv = st_[320 + wid * 4 + rr];
            float sa = (S0 * a4.x + S1 * a4.y) + (S2 * a4.z + S3 * a4.w);
            sa = row16_allsum(sa);
            S0 = S0 * w4.x + (sa * b4.x + vv * k4.x);
            S1 = S1 * w4.y + (sa * b4.y + vv * k4.y);
            S2 = S2 * w4.z + (sa * b4.z + vv * k4.z);
            S3 = S3 * w4.w + (sa * b4.w + vv * k4.w);
            float y = (S0 * r4.x + S1 * r4.y) + (S2 * r4.z + S3 * r4.w);
            y = row16_allsum(y);
            ysave = (pp == s_) ? y : ysave;
        }
        {
            const int i = c * 16 + pp;
            yo[(size_t)(tbase + (d ? (L - 1 - i) : i)) * 512 + h * 64 + row] = ysave;
        }
        __builtin_amdgcn_sched_barrier(0);
        if (c + 1 < nch) SC_SSTORE((c + 1) & 1)
        __syncthreads();
    }
    if (!sample) {
        float* os = (d ? out_sb : out_sf) + ((size_t)(b * 8 + h) * 64 + row) * 64 + pp * 4;
        *(float4*)os = make_float4(S0, S1, S2, S3);
    }
}

__device__ __forceinline__ void d_rw_post(const int bx, const int by, const int bz, char* smem, const float* __restrict__ y0, const float* __restrict__ y1, const float* __restrict__ bonus,
                                                 const bf16_t* __restrict__ vb, const bf16_t* __restrict__ gate, const float* __restrict__ lnx_g,
                                                 const float* __restrict__ lnx_b, bf16_t* __restrict__ cat) {
    const int w = bx * 4 + (threadIdx.x >> 6);
    const int lane = threadIdx.x & 63;
    const int t = w >> 3, h = w & 7;
    const size_t o = (size_t)t * 512 + h * 64 + lane;
    const int ch = h * 64 + lane;
    float y = y0[o] + y1[o];
    float mean = wave_sum(y) * (1.f / 64.f);
    float dlt = y - mean;
    float var = wave_sum(dlt * dlt) * (1.f / 64.f);
    float yn = dlt * rsqrtf(var + 64e-5f) * lnx_g[ch] + lnx_b[ch];
    float val = (yn + bonus[w] * bf2f(vb[o])) * bf2f(gate[o]);
    cat[(size_t)t * DM + ch] = f2bf(val);
}

__device__ __forceinline__ void d_mla_pre(const int bx, const int by, const int bz, char* smem, const float* __restrict__ proj, const float* __restrict__ q_norm, const float* __restrict__ kv_norm,
                                                 bf16_t* __restrict__ qcn, bf16_t* __restrict__ ckv, float* __restrict__ kpe,
                                                 float* __restrict__ out_ckv, float* __restrict__ out_kpe) {
    float* red = (float*)smem; float* red2 = red + 4;
    const int t = bx;
    const int tid = threadIdx.x;
    const float* P = proj + (size_t)t * 448;
    float q = P[tid];
    float kv = (tid < 128) ? P[256 + tid] : 0.f;
    float ss = wave_sum(q * q);
    float s2 = wave_sum(kv * kv);
    if ((tid & 63) == 0) { red[tid >> 6] = ss; red2[tid >> 6] = s2; }
    __syncthreads();
    float rq = rsqrtf((red[0] + red[1] + red[2] + red[3]) * (1.f / 256.f) + 1e-6f);
    float rk = rsqrtf((red2[0] + red2[1] + red2[2] + red2[3]) * (1.f / 128.f) + 1e-6f);
    qcn[(size_t)t * 256 + tid] = f2bf(q * rq * q_norm[tid]);
    if (tid < 128) {
        float val = kv * rk * kv_norm[tid];
        ckv[(size_t)t * 128 + tid] = f2bf(val);
        if (t < TP) out_ckv[(size_t)t * 128 + tid] = val;
    } else if (tid < 192) {
        float pe = P[384 + tid - 128];
        kpe[(size_t)t * 64 + tid - 128] = pe;
        if (t < TP) out_kpe[(size_t)t * 64 + tid - 128] = pe;
    }
}

__device__ __forceinline__ void d_mla_post(const int bx, const int by, const int bz, char* smem, const bf16_t* __restrict__ qraw, const bf16_t* __restrict__ kvraw, const bf16_t* __restrict__ kvraw_ctx,
                                                  const float* __restrict__ kpe, const float* __restrict__ cache_kpe, const float* __restrict__ qn,
                                                  const float* __restrict__ kn, bf16_t* __restrict__ Qb, bf16_t* __restrict__ Kp, bf16_t* __restrict__ Vp,
                                                  bf16_t* __restrict__ Ks, bf16_t* __restrict__ Vs) {
    float (*sq)[192] = (float(*)[192])smem; float (*sk)[192] = (float(*)[192])(smem + 4 * 192 * 4);
    const int wi = threadIdx.x >> 6, lane = threadIdx.x & 63;
    const int row = bx, h = wi;
    const bool isctx = row >= TT;
    const bool sample = row >= TP;
    float kx[3], qx[3] = {0.f, 0.f, 0.f};
    const bf16_t* kvr; const float* pe; int pos = 0;
    if (isctx) { int cr = row - TT; kvr = kvraw_ctx + (size_t)cr * 1024; pe = cache_kpe + (size_t)cr * 64; }
    else { kvr = kvraw + (size_t)row * 1024; pe = kpe + (size_t)row * 64; pos = tok_pos(row); }
#pragma unroll
    for (int j = 0; j < 3; j++) {
        int i = lane + 64 * j;
        kx[j] = (i < 128) ? bf2f(kvr[h * 256 + i]) : pe[i - 128];
        if (!isctx) qx[j] = bf2f(qraw[(size_t)row * 768 + h * 192 + i]);
    }
    float ssk = wave_sum(kx[0] * kx[0] + kx[1] * kx[1] + kx[2] * kx[2]);
    float ssq = wave_sum(qx[0] * qx[0] + qx[1] * qx[1] + qx[2] * qx[2]);
    float rk = rsqrtf(ssk * (1.f / 192.f) + 1e-6f), rq = rsqrtf(ssq * (1.f / 192.f) + 1e-6f);
#pragma unroll
    for (int j = 0; j < 3; j++) {
        int i = lane + 64 * j;
        sk[wi][i] = kx[j] * rk * kn[i];
        sq[wi][i] = qx[j] * rq * qn[i];
    }
    __syncthreads();
    if (sample && !isctx && lane < 32) {
        int rowi = pos >> 6, coli = pos & 63;
        int fi = lane & 15;
        float inv = expf(-(float)fi * (1.f / 16.f) * 9.210340371976184f);
        float ang = (lane < 16 ? (float)rowi : (float)coli) * inv;
        float cs = cosf(ang), sn = sinf(ang);
        float a = sk[wi][128 + 2 * lane], bq = sk[wi][128 + 2 * lane + 1];
        sk[wi][128 + 2 * lane] = a * cs - bq * sn; sk[wi][128 + 2 * lane + 1] = a * sn + bq * cs;
        a = sq[wi][128 + 2 * lane]; bq = sq[wi][128 + 2 * lane + 1];
        sq[wi][128 + 2 * lane] = a * cs - bq * sn; sq[wi][128 + 2 * lane + 1] = a * sn + bq * cs;
    }
    __syncthreads();
    bf16_t* kd; bf16_t* vd; int vLk, kidx;
    if (!sample) { int b = row >> 8, p = row & 255; kd = Kp + ((size_t)(b * 4 + h) * LP + p) * 192; vd = Vp + (size_t)(b * 4 + h) * 128 * LP; vLk = LP; kidx = p; }
    else if (!isctx) { int b = (row - TP) >> 11, p = (row - TP) & 2047; kd = Ks + ((size_t)(b * 4 + h) * 2304 + 256 + p) * 192; vd = Vs + (size_t)(b * 4 + h) * 128 * 2304; vLk = 2304; kidx = 256 + p; }
    else { int cr = row - TT; int b = cr >> 8, p = cr & 255; kd = Ks + ((size_t)(b * 4 + h) * 2304 + p) * 192; vd = Vs + (size_t)(b * 4 + h) * 128 * 2304; vLk = 2304; kidx = p; }
    const int kpos = (kidx & ~12) | ((kidx & 8) >> 1) | ((kidx & 4) << 1);
#pragma unroll
    for (int j = 0; j < 3; j++) {
        int i = lane + 64 * j;
        kd[i] = f2bf(sk[wi][i]);
        if (!isctx) Qb[((size_t)row * 4 + h) * 192 + i] = f2bf(sq[wi][i]);
    }
    vd[(size_t)lane * vLk + kpos] = kvr[h * 256 + 128 + lane];
    vd[(size_t)(lane + 64) * vLk + kpos] = kvr[h * 256 + 128 + lane + 64];
}

__device__ __forceinline__ void d_attn(const int bx, const int by, const int bz, char* smem, const bf16_t* __restrict__ Qb, const bf16_t* __restrict__ Kall, const bf16_t* __restrict__ Vall,
                                              bf16_t* __restrict__ cat, int tbase, int Lq, int Lk) {
    float (*Vsm)[128] = (float(*)[128])smem;
    float (*Qs)[192] = (float(*)[192])(smem + 32 * 128 * 4);
    float (*Ksm)[193] = (float(*)[193])(smem + 32 * 128 * 4 + 16 * 192 * 4);
    float (*Ss)[33] = (float(*)[33])(smem + 32 * 128 * 4 + 16 * 192 * 4 + 32 * 193 * 4);
    const int q0 = bx * 16, h = by, b = bz;
    const int tid = threadIdx.x;
    const int qi = tid >> 4, sub = tid & 15;
    const bf16_t* K = Kall + (size_t)(b * 4 + h) * Lk * 192;
    const bf16_t* V = Vall + (size_t)(b * 4 + h) * Lk * 128;
    for (int i = tid; i < 16 * 192; i += 256) {
        int r = i / 192, c = i % 192;
        int t = tbase + b * Lq + q0 + r;
        Qs[r][c] = bf2f(Qb[((size_t)t * 4 + h) * 192 + c]);
    }
    float m = -1e30f, l = 0.f;
    float acc[8];
#pragma unroll
    for (int j = 0; j < 8; j++) acc[j] = 0.f;
    const float scale = 0.07216878364870322f;
    for (int k0 = 0; k0 < Lk; k0 += 32) {
        __syncthreads();
        for (int i = tid; i < 32 * 192; i += 256) { int r = i / 192, c = i % 192; Ksm[r][c] = bf2f(K[(size_t)(k0 + r) * 192 + c]); }
        for (int i = tid; i < 32 * 128; i += 256) { int r = i >> 7, c = i & 127; Vsm[r][c] = bf2f(V[(size_t)(k0 + r) * 128 + c]); }
        __syncthreads();
        float s0 = 0.f, s1 = 0.f;
        for (int dd = 0; dd < 192; dd++) { float qv = Qs[qi][dd]; s0 += qv * Ksm[sub][dd]; s1 += qv * Ksm[sub + 16][dd]; }
        s0 *= scale; s1 *= scale;
        float mx = fmaxf(s0, s1);
#pragma unroll
        for (int o = 8; o > 0; o >>= 1) mx = fmaxf(mx, __shfl_xor(mx, o, 64));
        float mn = fmaxf(m, mx);
        float alpha = expf(m - mn);
        float p0 = expf(s0 - mn), p1 = expf(s1 - mn);
        float ps = p0 + p1;
#pragma unroll
        for (int o = 8; o > 0; o >>= 1) ps += __shfl_xor(ps, o, 64);
        l = l * alpha + ps; m = mn;
        Ss[qi][sub] = p0; Ss[qi][sub + 16] = p1;
        __syncthreads();
#pragma unroll
        for (int j = 0; j < 8; j++) acc[j] *= alpha;
        for (int kk = 0; kk < 32; kk++) {
            float p = Ss[qi][kk];
            float4 v0 = *(const float4*)&Vsm[kk][sub * 8], v1 = *(const float4*)&Vsm[kk][sub * 8 + 4];
            acc[0] += p * v0.x; acc[1] += p * v0.y; acc[2] += p * v0.z; acc[3] += p * v0.w;
            acc[4] += p * v1.x; acc[5] += p * v1.y; acc[6] += p * v1.z; acc[7] += p * v1.w;
        }
    }
    const int t = tbase + b * Lq + q0 + qi;
    float il = 1.f / l;
    bf16_t* o = cat + (size_t)t * DM + 512 + h * 128 + sub * 8;
#pragma unroll
    for (int j = 0; j < 8; j++) o[j] = f2bf(acc[j] * il);
}


#define ATT_SV_OFF 25600
#define ATT_SQ_OFF 44032
__device__ __forceinline__ void d_attn_mfma(const int item, char* smem, const bf16_t* __restrict__ Qb, const bf16_t* __restrict__ Kall,
                                            const bf16_t* __restrict__ VtAll, bf16_t* __restrict__ cat, int tbase, int Lq, int Lk, int nqb) {
    const int qb = item % nqb, bh = item / nqb;
    const int b = bh >> 2, h = bh & 3;
    const int tid = threadIdx.x, lane = tid & 63, wid = tid >> 6;
    const int q = lane & 31, hh = lane >> 5;
    const int t = tbase + b * Lq + qb * 128 + wid * 32 + q;
    bf16x8 qf[12];
    {
        const bf16_t* qp = Qb + ((size_t)t * 4 + h) * 192 + hh * 8;
#pragma unroll
        for (int ks = 0; ks < 12; ks++) qf[ks] = *(const bf16x8*)(qp + ks * 16);
    }
    f32x16 o[4];
#pragma unroll
    for (int i = 0; i < 4; i++)
#pragma unroll
        for (int r = 0; r < 16; r++) o[i][r] = 0.f;
    float m = -1e30f, l = 0.f;
    const bf16_t* K = Kall + (size_t)bh * Lk * 192;
    const bf16_t* Vt = VtAll + (size_t)bh * 128 * Lk;
    char* sK = smem;
    char* sV = smem + ATT_SV_OFF;
    u32x4 pk[6], pv[4];
    const int nkt = Lk >> 6;
#pragma unroll
    for (int i = 0; i < 6; i++) pk[i] = *(const u32x4*)(K + (size_t)(tid + 256 * i) * 8);
#pragma unroll
    for (int i = 0; i < 4; i++) { int c = tid + 256 * i; pv[i] = *(const u32x4*)(Vt + (size_t)(c >> 3) * Lk + (c & 7) * 8); }
#pragma unroll
    for (int i = 0; i < 6; i++) { int c = tid + 256 * i; *(u32x4*)(sK + (c / 24) * 400 + (c % 24) * 16) = pk[i]; }
#pragma unroll
    for (int i = 0; i < 4; i++) { int c = tid + 256 * i; *(u32x4*)(sV + (c >> 3) * 144 + (c & 7) * 16) = pv[i]; }
    __syncthreads();
    const float sc2 = 0.07216878364870322f * 1.4426950408889634f;
    for (int kt = 0; kt < nkt; kt++) {
        f32x16 st[2];
#pragma unroll
        for (int bk = 0; bk < 2; bk++)
#pragma unroll
            for (int r = 0; r < 16; r++) st[bk][r] = 0.f;
#pragma unroll
        for (int ks = 0; ks < 12; ks++) {
            const bf16x8 qfk = qf[ks];
#pragma unroll
            for (int bk = 0; bk < 2; bk++) {
                bf16x8 a = *(const bf16x8*)(sK + (bk * 32 + q) * 400 + ks * 32 + hh * 16);
                st[bk] = __builtin_amdgcn_mfma_f32_32x32x16_bf16(a, qfk, st[bk], 0, 0, 0);
            }
        }
        float mx = -1e30f;
#pragma unroll
        for (int bk = 0; bk < 2; bk++)
#pragma unroll
            for (int r = 0; r < 16; r++) { st[bk][r] *= sc2; mx = fmaxf(mx, st[bk][r]); }
        mx = fmaxf(mx, __shfl_xor(mx, 32, 64));
        const float mn = fmaxf(m, mx);
        const float alpha = exp2f(m - mn);
        float ps = 0.f;
#pragma unroll
        for (int bk = 0; bk < 2; bk++)
#pragma unroll
            for (int r = 0; r < 16; r++) { st[bk][r] = exp2f(st[bk][r] - mn); ps += st[bk][r]; }
        ps += __shfl_xor(ps, 32, 64);
        l = l * alpha + ps; m = mn;
#pragma unroll
        for (int i = 0; i < 4; i++)
#pragma unroll
            for (int r = 0; r < 16; r++) o[i][r] *= alpha;
#pragma unroll
        for (int s4 = 0; s4 < 4; s4++) {
            bf16x8 pb;
#pragma unroll
            for (int j = 0; j < 8; j++) pb[j] = (short)f2bf(st[s4 >> 1][8 * (s4 & 1) + j]);
#pragma unroll
            for (int i = 0; i < 4; i++) {
                bf16x8 a = *(const bf16x8*)(sV + (i * 32 + q) * 144 + s4 * 32 + hh * 16);
                o[i] = __builtin_amdgcn_mfma_f32_32x32x16_bf16(a, pb, o[i], 0, 0, 0);
            }
        }
        __syncthreads();
        if (kt + 1 < nkt) {
            const bf16_t* Kn = K + (size_t)(kt + 1) * 64 * 192;
            const bf16_t* Vn = Vt + (kt + 1) * 64;
#pragma unroll
            for (int i = 0; i < 6; i++) pk[i] = *(const u32x4*)(Kn + (size_t)(tid + 256 * i) * 8);
#pragma unroll
            for (int i = 0; i < 4; i++) { int c = tid + 256 * i; pv[i] = *(const u32x4*)(Vn + (size_t)(c >> 3) * Lk + (c & 7) * 8); }
#pragma unroll
            for (int i = 0; i < 6; i++) { int c = tid + 256 * i; *(u32x4*)(sK + (c / 24) * 400 + (c % 24) * 16) = pk[i]; }
#pragma unroll
            for (int i = 0; i < 4; i++) { int c = tid + 256 * i; *(u32x4*)(sV + (c >> 3) * 144 + (c & 7) * 16) = pv[i]; }
        }
        __syncthreads();
    }
    const float il = 1.f / l;
    bf16_t* op = cat + (size_t)t * DM + 512 + h * 128;
#pragma unroll
    for (int i = 0; i < 4; i++)
#pragma unroll
        for (int g = 0; g < 4; g++) {
            ushort4 w;
            w.x = f2bf(o[i][4 * g + 0] * il); w.y = f2bf(o[i][4 * g + 1] * il); w.z = f2bf(o[i][4 * g + 2] * il); w.w = f2bf(o[i][4 * g + 3] * il);
            *(ushort4*)(op + i * 32 + 8 * g + 4 * hh) = w;
        }
}

__device__ __forceinline__ void d_peer_route(const int bx, const int by, const int bz, char* smem, const float* __restrict__ qp, const float* __restrict__ keys  ,
                                                    int* __restrict__ pidx, float* __restrict__ pg) {
    float (*sq)[256] = (float(*)[256])smem;
    float (*sc)[256] = (float(*)[256])(smem + 4096);
    float (*tv)[32] = (float(*)[32])(smem + 8192);
    int (*ti)[32] = (int(*)[32])(smem + 8192 + 512);
    float (*topv)[16] = (float(*)[16])(smem + 8192 + 1024);
    int (*topi)[16] = (int(*)[16])(smem + 8192 + 1024 + 256);
    const int wi = threadIdx.x >> 6, lane = threadIdx.x & 63;
    const int w = bx * 4 + wi;
    const int t = w >> 3, h = w & 7;
    const float* q = qp + (size_t)t * 2048 + h * 256;
#pragma unroll
    for (int j = 0; j < 4; j++) sq[wi][lane + 64 * j] = q[lane + 64 * j];
    __syncthreads();
#pragma unroll
    for (int p = 0; p < 2; p++)
#pragma unroll
        for (int half = 0; half < 2; half++) {
            int n = lane + 64 * half;
            const float* kr = keys + ((size_t)(h * 2 + p) * 128 + n) * 128;
            float s = 0.f;
            for (int dd = 0; dd < 128; dd += 4) {
                float4 kv = *(const float4*)(kr + dd);
                s += sq[wi][p * 128 + dd] * kv.x + sq[wi][p * 128 + dd + 1] * kv.y + sq[wi][p * 128 + dd + 2] * kv.z + sq[wi][p * 128 + dd + 3] * kv.w;
            }
            sc[wi][p * 128 + n] = s;
        }
    __syncthreads();
#pragma unroll
    for (int p = 0; p < 2; p++)
#pragma unroll
        for (int half = 0; half < 2; half++) {
            int n = lane + 64 * half;
            float s = sc[wi][p * 128 + n];
            int rank = 0;
            for (int j = 0; j < 128; j++) { float o = sc[wi][p * 128 + j]; rank += (o > s || (o == s && j < n)) ? 1 : 0; }
            if (rank < 16) { tv[wi][p * 16 + rank] = s; ti[wi][p * 16 + rank] = n; }
        }
    __syncthreads();
    float cv[4];
#pragma unroll
    for (int j = 0; j < 4; j++) { int c = lane + 64 * j; cv[j] = tv[wi][c >> 4] + tv[wi][16 + (c & 15)]; }
    __syncthreads();
#pragma unroll
    for (int j = 0; j < 4; j++) sc[wi][lane + 64 * j] = cv[j];
    __syncthreads();
#pragma unroll
    for (int j = 0; j < 4; j++) {
        int c = lane + 64 * j;
        float s = cv[j];
        int rank = 0;
        for (int i = 0; i < 256; i++) { float o = sc[wi][i]; rank += (o > s || (o == s && i < c)) ? 1 : 0; }
        if (rank < 16) { topv[wi][rank] = s; topi[wi][rank] = (ti[wi][c >> 4] * 128 + ti[wi][16 + (c & 15)]) & 16383; }
    }
    __syncthreads();
    if (lane < 16) {
        float mx = topv[wi][0];
        float sum = 0.f;
        for (int i = 0; i < 16; i++) sum += expf(topv[wi][i] - mx);
        pg[(size_t)w * 16 + lane] = expf(topv[wi][lane] - mx) / sum;
        pidx[(size_t)w * 16 + lane] = topi[wi][lane] & 16383;
    }
}

__device__ __forceinline__ void d_peer_apply(const int bx, const int by, const int bz, char* smem, const bf16_t* __restrict__ hbuf, const int* __restrict__ pidx, const float* __restrict__ pg,
                                                    const float* __restrict__ utab, const float* __restrict__ vtab, const float* __restrict__ modl,
                                                    float* __restrict__ xrun) {
    float* coef = (float*)smem; int* eid = (int*)(smem + 512);
    const int t = bx, tid = threadIdx.x, wi = tid >> 6, lane = tid & 63;
    if (tid < 128) eid[tid] = pidx[(size_t)t * 128 + tid];
    float4 xv[4];
#pragma unroll
    for (int j = 0; j < 4; j++) { ushort4 q = *(const ushort4*)(hbuf + (size_t)t * DM + j * 256 + lane * 4); xv[j] = make_float4(bf2f(q.x), bf2f(q.y), bf2f(q.z), bf2f(q.w)); }
    __syncthreads();
    for (int e = wi * 32; e < wi * 32 + 32; e++) {
        const float* ur = utab + (size_t)eid[e] * DM;
        float s = 0.f;
#pragma unroll
        for (int j = 0; j < 4; j++) { float4 u = *(const float4*)(ur + j * 256 + lane * 4); s += u.x * xv[j].x + u.y * xv[j].y + u.z * xv[j].z + u.w * xv[j].w; }
        s = wave_sum(s);
        if (lane == 0) coef[e] = pg[(size_t)t * 128 + e] * gelu_tanh(s);
    }
    __syncthreads();
    float4 acc = make_float4(0.f, 0.f, 0.f, 0.f);
    for (int e = 0; e < 128; e++) {
        float cf = coef[e];
        float4 v = *(const float4*)(vtab + (size_t)eid[e] * DM + tid * 4);
        acc.x += cf * v.x; acc.y += cf * v.y; acc.z += cf * v.z; acc.w += cf * v.w;
    }
    const float* m = modl + (size_t)tok_modrow(t) * 6144 + 5 * 1024 + tid * 4;
    float* xo = xrun + (size_t)t * DM + tid * 4;
    float4 x = *(float4*)xo;
    x.x += m[0] * acc.x; x.y += m[1] * acc.y; x.z += m[2] * acc.z; x.w += m[3] * acc.w;
    *(float4*)xo = x;
}


template <int K, int J>
__device__ __forceinline__ void bit_stage16(float (&x)[16]) {
#pragma unroll
    for (int i = 0; i < 16; i++) {
        const int l = i ^ J;
        if (l > i) {
            const bool desc = ((i & K) == 0);
            const float a = x[i], b = x[l];
            const float hi = fmaxf(a, b), lo = fminf(a, b);
            x[i] = desc ? hi : lo; x[l] = desc ? lo : hi;
        }
    }
}
__device__ __forceinline__ void bit_sort16_desc(float (&x)[16]) {
    bit_stage16<2, 1>(x);
    bit_stage16<4, 2>(x); bit_stage16<4, 1>(x);
    bit_stage16<8, 4>(x); bit_stage16<8, 2>(x); bit_stage16<8, 1>(x);
    bit_stage16<16, 8>(x); bit_stage16<16, 4>(x); bit_stage16<16, 2>(x); bit_stage16<16, 1>(x);
}
__device__ __forceinline__ void bit_merge16_desc(float (&x)[16]) {
    bit_stage16<16, 8>(x); bit_stage16<16, 4>(x); bit_stage16<16, 2>(x); bit_stage16<16, 1>(x);
}
template <int K, int J>
__device__ __forceinline__ void bit_stage16u(unsigned (&x)[16]) {
#pragma unroll
    for (int i = 0; i < 16; i++) {
        const int l = i ^ J;
        if (l > i) {
            const bool asc = ((i & K) == 0);
            const unsigned a = x[i], b = x[l];
            const unsigned lo = a < b ? a : b, hi = a < b ? b : a;
            x[i] = asc ? lo : hi; x[l] = asc ? hi : lo;
        }
    }
}
__device__ __forceinline__ void bit_sort16u_asc(unsigned (&x)[16]) {
    bit_stage16u<2, 1>(x);
    bit_stage16u<4, 2>(x); bit_stage16u<4, 1>(x);
    bit_stage16u<8, 4>(x); bit_stage16u<8, 2>(x); bit_stage16u<8, 1>(x);
    bit_stage16u<16, 8>(x); bit_stage16u<16, 4>(x); bit_stage16u<16, 2>(x); bit_stage16u<16, 1>(x);
}
__device__ __forceinline__ void bit_merge16u_asc(unsigned (&x)[16]) {
    bit_stage16u<16, 8>(x); bit_stage16u<16, 4>(x); bit_stage16u<16, 2>(x); bit_stage16u<16, 1>(x);
}
__device__ __forceinline__ void top16_merge(float (&L)[16], const float (&C)[16]) {
#pragma unroll
    for (int i = 0; i < 16; i++) L[i] = fmaxf(L[i], C[15 - i]);
    bit_merge16_desc(L);
}
__device__ __forceinline__ void low16_merge_u(unsigned (&L)[16], const unsigned (&C)[16]) {
#pragma unroll
    for (int i = 0; i < 16; i++) { const unsigned c = C[15 - i]; L[i] = L[i] < c ? L[i] : c; }
    bit_merge16u_asc(L);
}
__device__ __forceinline__ float key_val(float k) { return __uint_as_float(__float_as_uint(k) & ~127u); }
__device__ __forceinline__ int key_idx(float k) { return (int)(__float_as_uint(k) & 127u); }

__device__ __forceinline__ void d_peer_select(const int vb, const float* __restrict__ scT, int* __restrict__ pidx, float* __restrict__ pg) {
    const int h = vb & 7;
    const int t = (vb >> 3) * 256 + threadIdx.x;
    float A[16], B[16];
#pragma unroll
    for (int p = 0; p < 2; p++) {
        const float* S = scT + (size_t)(h * 2 + p) * 128 * TT + t;
        float L[16];
#pragma unroll
        for (int ch = 0; ch < 8; ch++) {
            float C[16];
#pragma unroll
            for (int i = 0; i < 16; i++) {
                const int n = ch * 16 + i;
                C[i] = __uint_as_float((__float_as_uint(S[(size_t)n * TT]) & ~127u) | (unsigned)n);
            }
            bit_sort16_desc(C);
            if (ch == 0) {
#pragma unroll
                for (int i = 0; i < 16; i++) L[i] = C[i];
            } else top16_merge(L, C);
        }
#pragma unroll
        for (int i = 0; i < 16; i++) { if (p == 0) A[i] = L[i]; else B[i] = L[i]; }
    }
    const float smax = key_val(A[0]) + key_val(B[0]);
    unsigned Tk[16];
#pragma unroll
    for (int g = 0; g < 4; g++) {
        unsigned Ck[16];
#pragma unroll
        for (int e = 0; e < 16; e++) {
            const int c = g * 16 + e;
            int i, j;
            if (c < 16) { i = 0; j = c; }
            else if (c < 24) { i = 1; j = c - 16; }
            else if (c < 29) { i = 2; j = c - 24; }
            else if (c < 33) { i = 3; j = c - 29; }
            else if (c < 36) { i = 4; j = c - 33; }
            else if (c < 42) { i = 5 + (c - 36) / 2; j = (c - 36) % 2; }
            else if (c < 50) { i = 8 + (c - 42); j = 0; }
            else { i = -1; j = 0; }
            if (i >= 0) {
                const float dd = smax - (key_val(A[i]) + key_val(B[j]));
                unsigned qd = (unsigned)fminf(dd * 32768.f, 262143.f);
                Ck[e] = (qd << 14) | (unsigned)(key_idx(A[i]) * 128 + key_idx(B[j]));
            } else Ck[e] = 0xffffffffu;
        }
        bit_sort16u_asc(Ck);
        if (g == 0) {
#pragma unroll
            for (int e = 0; e < 16; e++) Tk[e] = Ck[e];
        } else low16_merge_u(Tk, Ck);
    }
    float sum = 0.f;
    float w[16]; int Tp[16];
#pragma unroll
    for (int e = 0; e < 16; e++) { w[e] = __expf(-(float)(Tk[e] >> 14) * (1.f / 32768.f)); sum += w[e]; Tp[e] = (int)(Tk[e] & 16383u); }
    const float inv = 1.f / sum;
    int* pi = pidx + ((size_t)t * 8 + h) * 16;
    float* pw = pg + ((size_t)t * 8 + h) * 16;
#pragma unroll
    for (int e = 0; e < 16; e += 4) {
        *(int4*)(pi + e) = make_int4(Tp[e], Tp[e + 1], Tp[e + 2], Tp[e + 3]);
        *(float4*)(pw + e) = make_float4(w[e] * inv, w[e + 1] * inv, w[e + 2] * inv, w[e + 3] * inv);
    }
}

typedef __attribute__((ext_vector_type(2))) short bf16x2;
__device__ __forceinline__ float dot8_bf16(u32x4 a, u32x4 b, float acc) {
#pragma unroll
    for (int i = 0; i < 4; i++) {
        const unsigned x = a[i], y = b[i];
        acc += __uint_as_float(x << 16) * __uint_as_float(y << 16);
        acc += __uint_as_float(x & 0xffff0000u) * __uint_as_float(y & 0xffff0000u);
    }
    return acc;
}
__device__ __forceinline__ void d_peer_apply2(const int vb, char* smem, const bf16_t* __restrict__ hb, const int* __restrict__ pidx,
                                              const float* __restrict__ pg, const bf16_t* __restrict__ utab, const bf16_t* __restrict__ vtab,
                                              const float* __restrict__ modl, float* __restrict__ xrun) {
    const int wid = threadIdx.x >> 6, lane = threadIdx.x & 63;
    const int t = vb * 4 + wid;
    float* coef = (float*)smem + wid * 128;
    int* eid = (int*)(smem + 2048) + wid * 128;
    eid[lane] = pidx[(size_t)t * 128 + lane]; eid[lane + 64] = pidx[(size_t)t * 128 + lane + 64];
    const float g0 = pg[(size_t)t * 128 + lane], g1 = pg[(size_t)t * 128 + lane + 64];
    const u32x4 x0 = *(const u32x4*)(hb + (size_t)t * DM + lane * 8);
    const u32x4 x1 = *(const u32x4*)(hb + (size_t)t * DM + 512 + lane * 8);
    __builtin_amdgcn_wave_barrier();
    float myact0 = 0.f, myact1 = 0.f;
    for (int eb = 0; eb < 128; eb += 8) {
        u32x4 ua[8], ub[8];
#pragma unroll
        for (int r = 0; r < 8; r++) {
            const bf16_t* ur = utab + (size_t)eid[eb + r] * DM;
            ua[r] = *(const u32x4*)(ur + lane * 8);
            ub[r] = *(const u32x4*)(ur + 512 + lane * 8);
        }
#pragma unroll
        for (int r = 0; r < 8; r++) {
            float sacc = dot8_bf16(ua[r], x0, 0.f);
            sacc = dot8_bf16(ub[r], x1, sacc);
            sacc = wave_sum(sacc);
            const int e = eb + r;
            if (lane == (e & 63)) { if (e < 64) myact0 = sacc; else myact1 = sacc; }
        }
    }
    coef[lane] = g0 * gelu_tanh(myact0);
    coef[lane + 64] = g1 * gelu_tanh(myact1);
    __builtin_amdgcn_wave_barrier();
    float acc[16];
#pragma unroll
    for (int i = 0; i < 16; i++) acc[i] = 0.f;
    for (int eb = 0; eb < 128; eb += 8) {
        u32x4 va[8], vbq[8];
#pragma unroll
        for (int r = 0; r < 8; r++) {
            const bf16_t* vr = vtab + (size_t)eid[eb + r] * DM;
            va[r] = *(const u32x4*)(vr + lane * 8);
            vbq[r] = *(const u32x4*)(vr + 512 + lane * 8);
        }
#pragma unroll
        for (int r = 0; r < 8; r++) {
            const float cf = coef[eb + r];
#pragma unroll
            for (int i = 0; i < 4; i++) {
                acc[2 * i] += cf * __uint_as_float(va[r][i] << 16);
                acc[2 * i + 1] += cf * __uint_as_float(va[r][i] & 0xffff0000u);
                acc[8 + 2 * i] += cf * __uint_as_float(vbq[r][i] << 16);
                acc[8 + 2 * i + 1] += cf * __uint_as_float(vbq[r][i] & 0xffff0000u);
            }
        }
    }
    const float* m = modl + (size_t)tok_modrow(t) * 6144 + 5 * 1024;
    float* xo = xrun + (size_t)t * DM;
#pragma unroll
    for (int hlf = 0; hlf < 2; hlf++) {
        const int c0 = hlf * 512 + lane * 8;
        float4 xa = *(float4*)(xo + c0), xb2 = *(float4*)(xo + c0 + 4);
        const float4 ma = *(const float4*)(m + c0), mb = *(const float4*)(m + c0 + 4);
        xa.x += ma.x * acc[hlf * 8 + 0]; xa.y += ma.y * acc[hlf * 8 + 1]; xa.z += ma.z * acc[hlf * 8 + 2]; xa.w += ma.w * acc[hlf * 8 + 3];
        xb2.x += mb.x * acc[hlf * 8 + 4]; xb2.y += mb.y * acc[hlf * 8 + 5]; xb2.z += mb.z * acc[hlf * 8 + 6]; xb2.w += mb.w * acc[hlf * 8 + 7];
        *(float4*)(xo + c0) = xa; *(float4*)(xo + c0 + 4) = xb2;
    }
}
__device__ __forceinline__ void d_cvt_bf16(const int vb, const float* __restrict__ src, bf16_t* __restrict__ dst) {
    const size_t base = (size_t)vb * 16384 + threadIdx.x * 4;
#pragma unroll
    for (int i = 0; i < 16; i++) {
        const float4 v = *(const float4*)(src + base + i * 1024);
        ushort4 o; o.x = f2bf(v.x); o.y = f2bf(v.y); o.z = f2bf(v.z); o.w = f2bf(v.w);
        *(ushort4*)(dst + base + i * 1024) = o;
    }
}

__device__ __forceinline__ void d_hy_dw(const int bx, const int by, const int bz, char* smem, const float* __restrict__ pre, const float* __restrict__ cw, const float* __restrict__ cb,
                                               bf16_t* __restrict__ zin, bf16_t* __restrict__ x0) {
    const int t = bx;
    const int pos = tok_pos(t), L = tok_len(t);
    const float* P = pre + (size_t)t * 3072;
    for (int c = threadIdx.x; c < 1024; c += 256) {
        float u[3];
#pragma unroll
        for (int part = 0; part < 3; part++) {
            int cc = part * 1024 + c;
            float cur = P[cc];
            float prev = (pos > 0) ? P[cc - 3072] : 0.f;
            float nxt = (pos < L - 1) ? P[cc + 3072] : 0.f;
            u[part] = prev * cw[cc] + cur * cw[3072 + cc] + nxt * cw[2 * 3072 + cc] + cb[cc];
        }
        x0[(size_t)t * DM + c] = f2bf(u[0]);
        zin[(size_t)t * DM + c] = f2bf(u[1] * u[2]);
    }
}

__device__ __forceinline__ void d_hy_filt(const int bx, const int by, const int bz, char* smem, int L, const float* __restrict__ w1, const float* __restrict__ b1, const float* __restrict__ w2,
                                                 const float* __restrict__ b2, const float* __restrict__ w3, const float* __restrict__ fr,
                                                 float* __restrict__ hf, float* __restrict__ hb) {
    float* z = (float*)smem; float* h1 = z + 64; float* h2 = z + 128;
    const int t = bx, tid = threadIdx.x;
    const float tu = (float)t / (float)(L - 1);
    if (tid == 0) z[0] = tu;
    if (tid >= 1 && tid < 17) {
        int i = tid - 1;
        float band = 1e-4f + (float)i * ((15.f - 1e-4f) / 15.f);
        float ang = 6.283185307179586f * (float)t * band / (float)L;
        z[1 + i] = cosf(ang); z[17 + i] = -sinf(ang);
    }
    __syncthreads();
    if (tid < 64) { float s = b1[tid]; for (int i = 0; i < 33; i++) s += z[i] * w1[i * 64 + tid]; h1[tid] = sinf(fr[tid] * s); }
    __syncthreads();
    if (tid < 64) { float s = b2[tid]; for (int i = 0; i < 64; i++) s += h1[i] * w2[i * 64 + tid]; h2[tid] = sinf(fr[tid] * s); }
    __syncthreads();
    for (int c = tid; c < 2048; c += 256) {
        float s = 0.f;
        for (int i = 0; i < 64; i++) s += h2[i] * w3[i * 2048 + c];
        int ch = c & 1023;
        float d0 = -4.605170185988091f / 0.3f, d1 = -4.605170185988091f / 1.5f;
        float delta = d0 + (d1 - d0) * ((float)ch / 1023.f);
        float win = expf(-tu * fabsf(delta));
        float val = s * win;
        if (c < 1024) hf[(size_t)t * 1024 + ch] = val; else hb[(size_t)t * 1024 + ch] = val;
    }
}
__device__ __forceinline__ void d_hy_norm(const int bx, const int by, const int bz, char* smem, int L, const float* __restrict__ hf, const float* __restrict__ hb, float* __restrict__ inv) {
    const int c = bx * 256 + threadIdx.x;
    float s = 0.f;
    for (int t = 0; t < L; t++) { s += fabsf(hf[(size_t)t * 1024 + c]); if (t > 0) s += fabsf(hb[(size_t)t * 1024 + c]); }
    inv[c] = 1.f / s;
}
__device__ __forceinline__ void d_hy_conv(const int bx, const int by, const int bz, char* smem, int L, int tbase, const bf16_t* __restrict__ zin, const bf16_t* __restrict__ x0, const float* __restrict__ hf,
                                                 const float* __restrict__ hb, const float* __restrict__ inv, const float* __restrict__ bias,
                                                 bf16_t* __restrict__ zb) {
    const int c = bx * 256 + threadIdx.x;
    const int t0 = by * 8, b = bz;
    const bf16_t* Z = zin + (size_t)(tbase + b * L) * DM + c;
    float acc[8];
#pragma unroll
    for (int i = 0; i < 8; i++) acc[i] = 0.f;
    for (int s = 0; s < L; s++) {
        float z = bf2f(Z[(size_t)s * DM]);
#pragma unroll
        for (int i = 0; i < 8; i++) {
            int j = t0 + i - s;
            float g = (j >= 0) ? hf[(size_t)j * 1024 + c] : hb[(size_t)(-j) * 1024 + c];
            acc[i] += z * g;
        }
    }
    float iv = inv[c], bs = bias[c];
#pragma unroll
    for (int i = 0; i < 8; i++) {
        size_t o = (size_t)(tbase + b * L + t0 + i) * DM + c;
        float zz = bf2f(zin[o]);
        zb[o] = f2bf(bf2f(x0[o]) * (acc[i] * iv + zz * bs));
    }
}


__device__ __forceinline__ void d_hy_filt2(const int vbl8, char* smem, const int L, const float* __restrict__ w1, const float* __restrict__ b1,
                                           const float* __restrict__ w2, const float* __restrict__ b2, const float* __restrict__ w3,
                                           const float* __restrict__ fr, bf16_t* __restrict__ gT, float* __restrict__ nsum) {
    float* zp = (float*)smem;
    float* h1 = zp + 32 * 33;
    float* h2t = h1 + 32 * 64;
    const int tid = threadIdx.x;
    const int vbl = vbl8 >> 3, mm = vbl8 & 7;
    const int t0 = vbl * 32;
    for (int e = tid; e < 32 * 33; e += 256) {
        const int pos = e / 33, i = e % 33;
        const float t = (float)(t0 + pos);
        float val;
        if (i == 0) val = t / (float)(L - 1);
        else {
            const int bi = (i <= 16) ? (i - 1) : (i - 17);
            const float band = 1e-4f + (float)bi * ((15.f - 1e-4f) / 15.f);
            const float ang = 6.283185307179586f * t * band / (float)L;
            val = (i <= 16) ? cosf(ang) : -sinf(ang);
        }
        zp[e] = val;
    }
    __syncthreads();
    {
        const int j = tid & 63;
        const float frj = fr[j];
#pragma unroll 1
        for (int i = 0; i < 8; i++) {
            const int pos = (tid >> 6) + 4 * i;
            float sacc = b1[j];
#pragma unroll 3
            for (int q = 0; q < 33; q++) sacc += zp[pos * 33 + q] * w1[q * 64 + j];
            h1[pos * 64 + j] = sinf(frj * sacc);
        }
        __syncthreads();
#pragma unroll 1
        for (int i = 0; i < 8; i++) {
            const int pos = (tid >> 6) + 4 * i;
            float sacc = b2[j];
#pragma unroll 4
            for (int q = 0; q < 64; q++) sacc += h1[pos * 64 + q] * w2[q * 64 + j];
            h2t[j * 32 + pos] = sinf(frj * sacc);
        }
    }
    __syncthreads();
    {
        const int c = tid + 256 * mm;
        float acc[32];
#pragma unroll
        for (int i = 0; i < 32; i++) acc[i] = 0.f;
#pragma unroll 1
        for (int j = 0; j < 64; j++) {
            const float w = w3[j * 2048 + c];
#pragma unroll
            for (int i = 0; i < 8; i++) {
                const float4 hv = *(const float4*)(h2t + j * 32 + i * 4);
                acc[4 * i] += hv.x * w; acc[4 * i + 1] += hv.y * w; acc[4 * i + 2] += hv.z * w; acc[4 * i + 3] += hv.w * w;
            }
        }
        const int ch = c & 1023;
        const float d0 = -4.605170185988091f / 0.3f, d1 = -4.605170185988091f / 1.5f;
        const float adelta = fabsf(d0 + (d1 - d0) * ((float)ch / 1023.f));
        float absum = 0.f;
        bf16_t* g = gT + (size_t)ch * 2 * L;
#pragma unroll
        for (int i = 0; i < 32; i++) {
            const int t = t0 + i;
            const float tu = (float)t / (float)(L - 1);
            const float val = acc[i] * expf(-tu * adelta);
            if (c < 1024) { absum += fabsf(val); g[L - t] = f2bf(val); }
            else if (t >= 1) { absum += fabsf(val); g[L + t] = f2bf(val); }
        }
        atomicAdd(nsum + ch, absum);
    }
}

__device__ __forceinline__ void d_hy_dw2(const int vb, char* smem, const float* __restrict__ pre, const float* __restrict__ cw,
                                         const float* __restrict__ cb, bf16_t* __restrict__ zT, bf16_t* __restrict__ x0b) {
    bf16_t* tile = (bf16_t*)smem;
    const int tt = vb >> 4, ct = vb & 15;
    const int tid = threadIdx.x;
    const int cc = tid & 63, c = ct * 64 + cc;
    const int tq = tid >> 6;
    float w0[3], w1[3], w2[3], bb[3];
#pragma unroll
    for (int part = 0; part < 3; part++) {
        const int col = part * 1024 + c;
        w0[part] = cw[col]; w1[part] = cw[3072 + col]; w2[part] = cw[2 * 3072 + col]; bb[part] = cb[col];
    }
    const int tok0 = tt * 64 + tq * 16;
    float prev[3], cur[3], nxt[3];
    {
        const int pos = tok_pos(tok0);
#pragma unroll
        for (int part = 0; part < 3; part++) {
            const float* P = pre + (size_t)tok0 * 3072 + part * 1024 + c;
            prev[part] = (pos > 0) ? P[-3072] : 0.f;
            cur[part] = P[0];
        }
    }
#pragma unroll 4
    for (int i = 0; i < 16; i++) {
        const int tok = tok0 + i;
        const int pos = tok_pos(tok), L = tok_len(tok);
        float u[3];
#pragma unroll
        for (int part = 0; part < 3; part++) {
            const float* P = pre + (size_t)tok * 3072 + part * 1024 + c;
            nxt[part] = (pos < L - 1) ? P[3072] : 0.f;
            u[part] = prev[part] * w0[part] + cur[part] * w1[part] + nxt[part] * w2[part] + bb[part];
            prev[part] = cur[part]; cur[part] = nxt[part];
        }
        x0b[(size_t)tok * DM + c] = f2bf(u[0]);
        tile[cc * 72 + tq * 16 + i] = f2bf(u[1] * u[2]);
    }
    __syncthreads();
    {
        const int cch = tid >> 2, q4 = tid & 3;
        const u32x4 a = *(const u32x4*)(tile + cch * 72 + q4 * 16);
        const u32x4 b2 = *(const u32x4*)(tile + cch * 72 + q4 * 16 + 8);
        bf16_t* dst = zT + (size_t)(ct * 64 + cch) * TT + tt * 64 + q4 * 16;
        *(u32x4*)dst = a; *(u32x4*)(dst + 8) = b2;
    }
}

template <bool SAMPLE>
__device__ __forceinline__ void d_hy_conv2(const int c, const int half, char* wsm, const bf16_t* __restrict__ gTall, const float* __restrict__ nsum,
                                           const bf16_t* __restrict__ zT, const float* __restrict__ bias, bf16_t* __restrict__ yT) {
    constexpr int L = SAMPLE ? LS : LP;
    constexpr int NB = L / 32;
    constexpr int NBATCH = SAMPLE ? 4 : 16;
    constexpr int BSH = SAMPLE ? 2 : 4;
    constexpr int TPB = 32 >> BSH;
    constexpr int NCB = NB / TPB;
    constexpr int HCB = NCB / 2;
    constexpr int PADB = SAMPLE ? 8 : 2;
    constexpr int ZLEN = L + 2 * PADB * 32;
    constexpr int tbase = SAMPLE ? TP : 0;
    const int lane = threadIdx.x & 63;
    const int l2 = half * 64 + lane;
    const int lc = lane & 31, hh = lane >> 5;
    const int b = lc & (NBATCH - 1), Tl = lc >> BSH;
    bf16_t* R = (bf16_t*)wsm;
    bf16_t* Z = R + 2 * L;
    {
        const u32x4* src = (const u32x4*)(gTall + (size_t)c * 2 * L);
        for (int i = l2; i < 2 * L / 8; i += 128) ((u32x4*)R)[i] = src[i];
        const u32x4 zero = {0u, 0u, 0u, 0u};
#pragma unroll 1
        for (int b2 = 0; b2 < NBATCH; b2++) {
            const u32x4* zs = (const u32x4*)(zT + (size_t)c * TT + tbase + b2 * L);
            u32x4* zd = (u32x4*)(Z + b2 * ZLEN);
            for (int i = l2; i < PADB * 4; i += 128) { zd[i] = zero; zd[PADB * 4 + L / 8 + i] = zero; }
            for (int i = l2; i < L / 8; i += 128) zd[PADB * 4 + i] = zs[i];
        }
    }
    __syncthreads();
    f32x16 acc[HCB];
#pragma unroll
    for (int cb = 0; cb < HCB; cb++)
#pragma unroll
        for (int r = 0; r < 16; r++) acc[cb][r] = 0.f;
    const bf16_t* Zb = Z + b * ZLEN + PADB * 32 + 8 * hh;
    const int cb0 = half * HCB;
    const int Dlo = TPB * cb0 - (NB - 1), Dhi = TPB * (cb0 + HCB - 1) + TPB - 1;
#pragma unroll 1
    for (int D = (Dlo < -(NB - 1) ? -(NB - 1) : Dlo); D <= (Dhi > NB - 1 ? NB - 1 : Dhi); D++) {
        bf16x8 af[2];
#pragma unroll
        for (int ks = 0; ks < 2; ks++) {
            const bf16_t* rp = R + (L - 32 * D - lc + 16 * ks + 8 * hh);
#pragma unroll
            for (int j = 0; j < 8; j++) af[ks][j] = (short)rp[j];
        }
#pragma unroll
        for (int lcb = 0; lcb < HCB; lcb++) {
            const int cb = cb0 + lcb;
            if (D >= TPB * cb - (NB - 1) && D <= TPB * cb + TPB - 1) {
                const int S = TPB * cb + Tl - D;
#pragma unroll
                for (int ks = 0; ks < 2; ks++) {
                    const bf16x8 bfr = *(const bf16x8*)(Zb + 32 * S + 16 * ks);
                    acc[lcb] = __builtin_amdgcn_mfma_f32_32x32x16_bf16(af[ks], bfr, acc[lcb], 0, 0, 0);
                }
            }
        }
    }
    const float inv = 1.f / nsum[c], bs = bias[c];
    bf16_t* yrow = yT + (size_t)c * TT + tbase + b * L;
    const bf16_t* zrow = Z + b * ZLEN + PADB * 32;
#pragma unroll
    for (int lcb = 0; lcb < HCB; lcb++)
#pragma unroll
        for (int g = 0; g < 4; g++) {
            const int t = 32 * (TPB * (cb0 + lcb) + Tl) + 8 * g + 4 * hh;
            ushort4 o;
            o.x = f2bf(acc[lcb][4 * g + 0] * inv + bf2f(zrow[t + 0]) * bs);
            o.y = f2bf(acc[lcb][4 * g + 1] * inv + bf2f(zrow[t + 1]) * bs);
            o.z = f2bf(acc[lcb][4 * g + 2] * inv + bf2f(zrow[t + 2]) * bs);
            o.w = f2bf(acc[lcb][4 * g + 3] * inv + bf2f(zrow[t + 3]) * bs);
            *(ushort4*)(yrow + t) = o;
        }
}

__device__ __forceinline__ void d_hy_post(const int vb, char* smem, const bf16_t* __restrict__ yT, const bf16_t* __restrict__ x0b, bf16_t* __restrict__ zb) {
    bf16_t* tile = (bf16_t*)smem;
    const int tt = vb >> 4, ct = vb & 15;
    const int tid = threadIdx.x;
    {
        const int cch = tid >> 2, q4 = tid & 3;
        const bf16_t* src = yT + (size_t)(ct * 64 + cch) * TT + tt * 64 + q4 * 16;
        *(u32x4*)(tile + cch * 72 + q4 * 16) = *(const u32x4*)src;
        *(u32x4*)(tile + cch * 72 + q4 * 16 + 8) = *(const u32x4*)(src + 8);
    }
    __syncthreads();
    const int cc = tid & 63, tq = tid >> 6;
#pragma unroll 4
    for (int i = 0; i < 16; i++) {
        const size_t o = (size_t)(tt * 64 + tq * 16 + i) * DM + ct * 64 + cc;
        zb[o] = f2bf(bf2f(x0b[o]) * bf2f(tile[cc * 72 + tq * 16 + i]));
    }
}


__device__ __forceinline__ float wave_allsum_fast(float v) {
    v = row16_allsum(v);
    const float r0 = __int_as_float(__builtin_amdgcn_readlane(__float_as_int(v), 0));
    const float r1 = __int_as_float(__builtin_amdgcn_readlane(__float_as_int(v), 16));
    const float r2 = __int_as_float(__builtin_amdgcn_readlane(__float_as_int(v), 32));
    const float r3 = __int_as_float(__builtin_amdgcn_readlane(__float_as_int(v), 48));
    return (r0 + r1) + (r2 + r3);
}
__device__ __forceinline__ ushort4 pack_bf4(float a, float b, float c, float d) { ushort4 o; o.x = f2bf(a); o.y = f2bf(b); o.z = f2bf(c); o.w = f2bf(d); return o; }

__device__ __forceinline__ void d_norm_mod2(const int vb, const float* __restrict__ xa, const float* __restrict__ xb, const float* __restrict__ g,
                                            const float* __restrict__ modl, const int shift_idx, const int scale_idx, bf16_t* __restrict__ h) {
    const int wid = threadIdx.x >> 6, lane = threadIdx.x & 63;
    const int t0 = vb * 8 + wid * 2;
    float4 v[2][4];
#pragma unroll
    for (int u = 0; u < 2; u++) {
        const int t = t0 + u;
        const float* x = (t < TP) ? (xa + (size_t)t * DM) : (xb + (size_t)(t - TP) * DM);
#pragma unroll
        for (int j = 0; j < 4; j++) v[u][j] = *(const float4*)(x + j * 256 + lane * 4);
    }
#pragma unroll
    for (int u = 0; u < 2; u++) {
        const int t = t0 + u;
        float ss = 0.f;
#pragma unroll
        for (int j = 0; j < 4; j++) ss += v[u][j].x * v[u][j].x + v[u][j].y * v[u][j].y + v[u][j].z * v[u][j].z + v[u][j].w * v[u][j].w;
        ss = wave_allsum_fast(ss);
        const float rstd = rsqrtf(ss * (1.f / DM) + 1e-6f);
        const float* m = modl + (size_t)tok_modrow(t) * 6144;
#pragma unroll
        for (int j = 0; j < 4; j++) {
            const int c = j * 256 + lane * 4;
            const float4 gg = *(const float4*)(g + c);
            const float4 sh = *(const float4*)(m + shift_idx * 1024 + c);
            const float4 sc = *(const float4*)(m + scale_idx * 1024 + c);
            *(ushort4*)(h + (size_t)t * DM + c) = pack_bf4(v[u][j].x * rstd * gg.x * (1.f + sc.x) + sh.x, v[u][j].y * rstd * gg.y * (1.f + sc.y) + sh.y,
                                                           v[u][j].z * rstd * gg.z * (1.f + sc.z) + sh.z, v[u][j].w * rstd * gg.w * (1.f + sc.w) + sh.w);
        }
    }
}

__device__ __forceinline__ void d_rw_shift2(const int vb, const bf16_t* __restrict__ proj, const float* __restrict__ mu, bf16_t* __restrict__ rb,
                                            bf16_t* __restrict__ kb, bf16_t* __restrict__ vbuf, bf16_t* __restrict__ tw, bf16_t* __restrict__ adv,
                                            bf16_t* __restrict__ sg) {
#pragma unroll
    for (int u = 0; u < 4; u++) {
        const int id = vb * 1024 + u * 256 + threadIdx.x;
        const int t = id / 224, c = (id % 224) * 8;
        const int pos = tok_pos(t), L = tok_len(t);
        const bf16_t* P = proj + (size_t)t * RWIN + c;
        const u32x4 cur = *(const u32x4*)P;
        u32x4 prv = {0u, 0u, 0u, 0u}, nxt = {0u, 0u, 0u, 0u};
        if (pos > 0) prv = *(const u32x4*)(P - RWIN);
        if (pos < L - 1) nxt = *(const u32x4*)(P + RWIN);
        const float4 m0 = *(const float4*)(mu + c), m1 = *(const float4*)(mu + c + 4);
        const float mm[8] = {m0.x, m0.y, m0.z, m0.w, m1.x, m1.y, m1.z, m1.w};
        float val[8];
#pragma unroll
        for (int i = 0; i < 4; i++) {
            const float c0 = __uint_as_float(cur[i] << 16), c1 = __uint_as_float(cur[i] & 0xffff0000u);
            const float p0 = __uint_as_float(prv[i] << 16), p1 = __uint_as_float(prv[i] & 0xffff0000u);
            const float n0 = __uint_as_float(nxt[i] << 16), n1 = __uint_as_float(nxt[i] & 0xffff0000u);
            val[2 * i] = c0 + mm[2 * i] * (0.5f * (p0 + n0) - c0);
            val[2 * i + 1] = c1 + mm[2 * i + 1] * (0.5f * (p1 + n1) - c1);
        }
        bf16_t* dst;
        if (c < 512) dst = rb + (size_t)t * 512 + c;
        else if (c < 1024) dst = kb + (size_t)t * 512 + (c - 512);
        else if (c < 1536) dst = vbuf + (size_t)t * 512 + (c - 1024);
        else if (c < 1600) { dst = tw + (size_t)t * 64 + (c - 1536);
#pragma unroll
            for (int i = 0; i < 8; i++) val[i] = tanhf(val[i]); }
        else if (c < 1664) dst = adv + (size_t)t * 64 + (c - 1600);
        else { dst = sg + (size_t)t * 128 + (c - 1664);
#pragma unroll
            for (int i = 0; i < 8; i++) val[i] = sigmoidf_(val[i]); }
        u32x4 o;
#pragma unroll
        for (int i = 0; i < 4; i++) o[i] = (unsigned)f2bf(val[2 * i]) | ((unsigned)f2bf(val[2 * i + 1]) << 16);
        *(u32x4*)dst = o;
    }
}

__device__ __forceinline__ void d_mla_pre2(const int vb, const float* __restrict__ proj, const float* __restrict__ q_norm, const float* __restrict__ kv_norm,
                                           bf16_t* __restrict__ qcn, bf16_t* __restrict__ ckv, float* __restrict__ kpe, float* __restrict__ out_ckv,
                                           float* __restrict__ out_kpe) {
    const int t = vb * 16 + (threadIdx.x >> 4), l16 = threadIdx.x & 15;
    const float* P = proj + (size_t)t * 448;
    float4 x[7];
#pragma unroll
    for (int j = 0; j < 7; j++) x[j] = *(const float4*)(P + 4 * (l16 + 16 * j));
    float sq = 0.f, sk = 0.f;
#pragma unroll
    for (int j = 0; j < 4; j++) sq += x[j].x * x[j].x + x[j].y * x[j].y + x[j].z * x[j].z + x[j].w * x[j].w;
#pragma unroll
    for (int j = 4; j < 6; j++) sk += x[j].x * x[j].x + x[j].y * x[j].y + x[j].z * x[j].z + x[j].w * x[j].w;
    sq = row16_allsum(sq); sk = row16_allsum(sk);
    const float rq = rsqrtf(sq * (1.f / 256.f) + 1e-6f), rk = rsqrtf(sk * (1.f / 128.f) + 1e-6f);
#pragma unroll
    for (int j = 0; j < 4; j++) {
        const int c = 4 * (l16 + 16 * j);
        const float4 w = *(const float4*)(q_norm + c);
        *(ushort4*)(qcn + (size_t)t * 256 + c) = pack_bf4(x[j].x * rq * w.x, x[j].y * rq * w.y, x[j].z * rq * w.z, x[j].w * rq * w.w);
    }
#pragma unroll
    for (int j = 4; j < 6; j++) {
        const int c = 4 * (l16 + 16 * (j - 4));
        const float4 w = *(const float4*)(kv_norm + c);
        const float4 o = make_float4(x[j].x * rk * w.x, x[j].y * rk * w.y, x[j].z * rk * w.z, x[j].w * rk * w.w);
        *(ushort4*)(ckv + (size_t)t * 128 + c) = pack_bf4(o.x, o.y, o.z, o.w);
        if (t < TP) *(float4*)(out_ckv + (size_t)t * 128 + c) = o;
    }
    {
        const int c = 4 * l16;
        *(float4*)(kpe + (size_t)t * 64 + c) = x[6];
        if (t < TP) *(float4*)(out_kpe + (size_t)t * 64 + c) = x[6];
    }
}

__device__ __forceinline__ void d_rw_kk2(const int vb, char* smem, const bf16_t* __restrict__ rb, const bf16_t* __restrict__ kb,
                                         const bf16_t* __restrict__ lr0, const bf16_t* __restrict__ lr1, const float* __restrict__ k_k,
                                         const float* __restrict__ k_a, const float* __restrict__ r_k, bf16_t* __restrict__ kkb, float* __restrict__ bonus) {
    float* pk = (float*)smem;
    for (int i = threadIdx.x; i < 512; i += 256) { pk[i] = k_k[i]; pk[512 + i] = k_a[i]; pk[1024 + i] = r_k[i]; }
    __syncthreads();
    const int w = vb * 256 + threadIdx.x;
    const int h = w & 7;
    const size_t o = (size_t)w * 64;
    u32x4 kq[8];
#pragma unroll
    for (int i = 0; i < 8; i++) kq[i] = *(const u32x4*)(kb + o + i * 8);
    const float* kkp = pk + h * 64; const float* kap = pk + 512 + h * 64; const float* rkp = pk + 1024 + h * 64;
    float ss = 0.f;
#pragma unroll
    for (int i = 0; i < 8; i++)
#pragma unroll
        for (int j = 0; j < 4; j++) {
            const float a = __uint_as_float(kq[i][j] << 16) * kkp[i * 8 + 2 * j], b = __uint_as_float(kq[i][j] & 0xffff0000u) * kkp[i * 8 + 2 * j + 1];
            ss += a * a + b * b;
        }
    const float inv = 1.f / fmaxf(sqrtf(ss), 1e-12f);
    float bs = 0.f;
#pragma unroll 2
    for (int i = 0; i < 8; i++) {
        const u32x4 kq2 = *(const u32x4*)(kb + o + i * 8);
        const u32x4 rq = *(const u32x4*)(rb + o + i * 8);
        const u32x4 l0 = *(const u32x4*)(lr0 + o + i * 8);
        const u32x4 l1 = *(const u32x4*)(lr1 + o + i * 8);
        u32x4 ok;
#pragma unroll
        for (int j = 0; j < 4; j++) {
            const int e0 = i * 8 + 2 * j, e1 = e0 + 1;
            const float k0 = __uint_as_float(kq2[j] << 16), k1 = __uint_as_float(kq2[j] & 0xffff0000u);
            const float r0 = __uint_as_float(rq[j] << 16), r1 = __uint_as_float(rq[j] & 0xffff0000u);
            const float a0 = __uint_as_float(l0[j] << 16), a1 = __uint_as_float(l0[j] & 0xffff0000u);
            const float b0 = __uint_as_float(l1[j] << 16), b1 = __uint_as_float(l1[j] & 0xffff0000u);
            bs += r0 * k0 * (2.f + (a0 + b0 - 2.f) * kap[e0]) * rkp[e0] + r1 * k1 * (2.f + (a1 + b1 - 2.f) * kap[e1]) * rkp[e1];
            ok[j] = (unsigned)f2bf(k0 * kkp[e0] * inv) | ((unsigned)f2bf(k1 * kkp[e1] * inv) << 16);
        }
        *(u32x4*)(kkb + o + i * 8) = ok;
    }
    bonus[w] = bs;
}

__device__ __forceinline__ void d_mla_post2(const int vb, const bf16_t* __restrict__ qraw, const bf16_t* __restrict__ kvraw, const bf16_t* __restrict__ kvraw_ctx,
                                            const float* __restrict__ kpe, const float* __restrict__ cache_kpe, const float* __restrict__ qn,
                                            const float* __restrict__ kn, bf16_t* __restrict__ Qb, bf16_t* __restrict__ Kp, bf16_t* __restrict__ Ks) {
    const int item = vb * 16 + (threadIdx.x >> 4), l16 = threadIdx.x & 15;
    const int row = item >> 2, h = item & 3;
    const bool isctx = row >= TT, sample = row >= TP;
    const int e0 = 12 * l16;
    const bf16_t* kvr; const float* pe; int pos = 0;
    if (isctx) { const int cr = row - TT; kvr = kvraw_ctx + (size_t)cr * 1024; pe = cache_kpe + (size_t)cr * 64; }
    else { kvr = kvraw + (size_t)row * 1024; pe = kpe + (size_t)row * 64; pos = tok_pos(row); }
    float kx[12], qx[12];
#pragma unroll
    for (int j = 0; j < 12; j++) {
        const int e = e0 + j;
        kx[j] = (e < 128) ? bf2f(kvr[h * 256 + (e < 128 ? e : 0)]) : pe[(e >= 128 ? e - 128 : 0)];
        qx[j] = isctx ? 0.f : bf2f(qraw[(size_t)row * 768 + h * 192 + e]);
    }
    float sk = 0.f, sq = 0.f;
#pragma unroll
    for (int j = 0; j < 12; j++) { sk += kx[j] * kx[j]; sq += qx[j] * qx[j]; }
    sk = row16_allsum(sk); sq = row16_allsum(sq);
    const float rk = rsqrtf(sk * (1.f / 192.f) + 1e-6f), rq = rsqrtf(sq * (1.f / 192.f) + 1e-6f);
#pragma unroll
    for (int j = 0; j < 12; j++) { kx[j] *= rk * kn[e0 + j]; qx[j] *= rq * qn[e0 + j]; }
    if (sample && !isctx) {
        const float rowf = (float)(pos >> 6), colf = (float)(pos & 63);
#pragma unroll
        for (int j = 0; j < 12; j += 2) {
            const int e = e0 + j;
            if (e >= 128) {
                const int pi = (e - 128) >> 1;
                const float inv = expf(-(float)(pi & 15) * (1.f / 16.f) * 9.210340371976184f);
                const float ang = (pi < 16 ? rowf : colf) * inv;
                const float cs = cosf(ang), sn = sinf(ang);
                const float a = kx[j], bq = kx[j + 1];
                kx[j] = a * cs - bq * sn; kx[j + 1] = a * sn + bq * cs;
                const float a2 = qx[j], b2 = qx[j + 1];
                qx[j] = a2 * cs - b2 * sn; qx[j + 1] = a2 * sn + b2 * cs;
            }
        }
    }
    bf16_t* kd;
    if (!sample) { const int b = row >> 8, pp = row & 255; kd = Kp + ((size_t)(b * 4 + h) * LP + pp) * 192; }
    else if (!isctx) { const int b = (row - TP) >> 11, pp = (row - TP) & 2047; kd = Ks + ((size_t)(b * 4 + h) * 2304 + 256 + pp) * 192; }
    else { const int cr = row - TT; const int b = cr >> 8, pp = cr & 255; kd = Ks + ((size_t)(b * 4 + h) * 2304 + pp) * 192; }
#pragma unroll
    for (int j = 0; j < 12; j += 4) {
        *(ushort4*)(kd + e0 + j) = pack_bf4(kx[j], kx[j + 1], kx[j + 2], kx[j + 3]);
        if (!isctx) *(ushort4*)(Qb + ((size_t)row * 4 + h) * 192 + e0 + j) = pack_bf4(qx[j], qx[j + 1], qx[j + 2], qx[j + 3]);
    }
}

__device__ __forceinline__ void d_rw_post2(const int vb, char* smem, const float* __restrict__ y0, const float* __restrict__ y1, const float* __restrict__ bonus,
                                           const bf16_t* __restrict__ vbuf, const bf16_t* __restrict__ gate, const float* __restrict__ lnx_g,
                                           const float* __restrict__ lnx_b, bf16_t* __restrict__ cat) {
    float* pg = (float*)smem;
    for (int i = threadIdx.x; i < 512; i += 256) { pg[i] = lnx_g[i]; pg[512 + i] = lnx_b[i]; }
    __syncthreads();
    const int w = vb * 256 + threadIdx.x;
    const int t = w >> 3, h = w & 7;
    const size_t o = (size_t)w * 64;
    float s1 = 0.f, s2 = 0.f;
#pragma unroll 4
    for (int i = 0; i < 16; i++) {
        const float4 a = *(const float4*)(y0 + o + i * 4), b = *(const float4*)(y1 + o + i * 4);
        const float e0 = a.x + b.x, e1 = a.y + b.y, e2 = a.z + b.z, e3 = a.w + b.w;
        s1 += (e0 + e1) + (e2 + e3);
        s2 += (e0 * e0 + e1 * e1) + (e2 * e2 + e3 * e3);
    }
    const float mean = s1 * (1.f / 64.f);
    const float var = fmaxf(s2 * (1.f / 64.f) - mean * mean, 0.f);
    const float rstd = rsqrtf(var + 64e-5f);
    const float bn = bonus[w];
    const float* gp = pg + h * 64; const float* bp = pg + 512 + h * 64;
#pragma unroll 2
    for (int i = 0; i < 8; i++) {
        const float4 ya = *(const float4*)(y0 + o + i * 8), yb = *(const float4*)(y1 + o + i * 8);
        const float4 yc = *(const float4*)(y0 + o + i * 8 + 4), yd = *(const float4*)(y1 + o + i * 8 + 4);
        const float yy[8] = {ya.x + yb.x, ya.y + yb.y, ya.z + yb.z, ya.w + yb.w, yc.x + yd.x, yc.y + yd.y, yc.z + yd.z, yc.w + yd.w};
        const u32x4 vq = *(const u32x4*)(vbuf + o + i * 8);
        const u32x4 gq = *(const u32x4*)(gate + o + i * 8);
        u32x4 oq;
#pragma unroll
        for (int j = 0; j < 4; j++) {
            const int e0 = i * 8 + 2 * j, e1 = e0 + 1;
            const float v0 = __uint_as_float(vq[j] << 16), v1 = __uint_as_float(vq[j] & 0xffff0000u);
            const float g0 = __uint_as_float(gq[j] << 16), g1 = __uint_as_float(gq[j] & 0xffff0000u);
            const float r0 = ((yy[2 * j] - mean) * rstd * gp[e0] + bp[e0] + bn * v0) * g0;
            const float r1 = ((yy[2 * j + 1] - mean) * rstd * gp[e1] + bp[e1] + bn * v1) * g1;
            oq[j] = (unsigned)f2bf(r0) | ((unsigned)f2bf(r1) << 16);
        }
        *(u32x4*)(cat + (size_t)t * DM + h * 64 + i * 8) = oq;
    }
}


typedef float f32x2 __attribute__((ext_vector_type(2)));
template <int CTRL>
__device__ __forceinline__ float dpp_max(float v) {
    return fmaxf(v, __int_as_float(__builtin_amdgcn_update_dpp(0, __float_as_int(v), CTRL, 0xf, 0xf, false)));
}
__device__ __forceinline__ float wave_allmax_fast(float v) {
    v = dpp_max<0x128>(v); v = dpp_max<0x124>(v); v = dpp_max<0x122>(v); v = dpp_max<0x121>(v);
    const float r0 = __int_as_float(__builtin_amdgcn_readlane(__float_as_int(v), 0));
    const float r1 = __int_as_float(__builtin_amdgcn_readlane(__float_as_int(v), 16));
    const float r2 = __int_as_float(__builtin_amdgcn_readlane(__float_as_int(v), 32));
    const float r3 = __int_as_float(__builtin_amdgcn_readlane(__float_as_int(v), 48));
    return fmaxf(fmaxf(r0, r1), fmaxf(r2, r3));
}
__device__ __forceinline__ void d_cvt_fp8_rows(const int vb, const float* __restrict__ src, unsigned char* __restrict__ dst, float* __restrict__ rscale) {
    const int wid = threadIdx.x >> 6, lane = threadIdx.x & 63;
    float4 x[4][4];
#pragma unroll
    for (int u = 0; u < 4; u++) {
        const float* r = src + (size_t)(vb * 16 + wid * 4 + u) * 1024 + lane * 16;
#pragma unroll
        for (int j = 0; j < 4; j++) x[u][j] = *(const float4*)(r + 4 * j);
    }
#pragma unroll
    for (int u = 0; u < 4; u++) {
        const int row = vb * 16 + wid * 4 + u;
        float am = 0.f;
#pragma unroll
        for (int j = 0; j < 4; j++) am = fmaxf(am, fmaxf(fmaxf(fabsf(x[u][j].x), fabsf(x[u][j].y)), fmaxf(fabsf(x[u][j].z), fabsf(x[u][j].w))));
        am = wave_allmax_fast(am);
        const float sc = am > 0.f ? 448.f / am : 1.f;
        u32x4 q;
#pragma unroll
        for (int j = 0; j < 4; j++) {
            int pk = __builtin_amdgcn_cvt_pk_fp8_f32(x[u][j].x * sc, x[u][j].y * sc, 0, false);
            pk = __builtin_amdgcn_cvt_pk_fp8_f32(x[u][j].z * sc, x[u][j].w * sc, pk, true);
            q[j] = (unsigned)pk;
        }
        *(u32x4*)(dst + (size_t)row * 1024 + lane * 16) = q;
        if (lane == 0) rscale[row] = am > 0.f ? am * (1.f / 448.f) : 1.f;
    }
}
__device__ __forceinline__ void d_peer_apply3(const int vb, char* smem, const bf16_t* __restrict__ hb, const int* __restrict__ pidx,
                                              const float* __restrict__ pg, const unsigned char* __restrict__ utab, const unsigned char* __restrict__ vtab,
                                              const float* __restrict__ rsU, const float* __restrict__ rsV, const float* __restrict__ modl,
                                              float* __restrict__ xrun) {
    const int wid = threadIdx.x >> 6, lane = threadIdx.x & 63;
    const int t = vb * 4 + wid;
    float* coef = (float*)smem + wid * 128;
    int* eid = (int*)(smem + 2048) + wid * 128;
    const int e_lo = pidx[(size_t)t * 128 + lane], e_hi = pidx[(size_t)t * 128 + lane + 64];
    eid[lane] = e_lo; eid[lane + 64] = e_hi;
    const float g0 = pg[(size_t)t * 128 + lane] * rsV[e_lo], g1 = pg[(size_t)t * 128 + lane + 64] * rsV[e_hi];
    const float ru0 = rsU[e_lo], ru1 = rsU[e_hi];
    float x[16];
    {
        const u32x4 a = *(const u32x4*)(hb + (size_t)t * DM + lane * 16), b = *(const u32x4*)(hb + (size_t)t * DM + lane * 16 + 8);
#pragma unroll
        for (int i = 0; i < 4; i++) {
            x[2 * i] = __uint_as_float(a[i] << 16); x[2 * i + 1] = __uint_as_float(a[i] & 0xffff0000u);
            x[8 + 2 * i] = __uint_as_float(b[i] << 16); x[8 + 2 * i + 1] = __uint_as_float(b[i] & 0xffff0000u);
        }
    }
    __builtin_amdgcn_wave_barrier();
    float myact0 = 0.f, myact1 = 0.f;
#pragma unroll 1
    for (int eb = 0; eb < 128; eb += 16) {
        u32x4 q[16];
#pragma unroll
        for (int r = 0; r < 16; r++) q[r] = *(const u32x4*)(utab + (size_t)eid[eb + r] * 1024 + lane * 16);
#pragma unroll
        for (int r = 0; r < 16; r++) {
            float sacc = 0.f;
#pragma unroll
            for (int i = 0; i < 4; i++) {
                const f32x2 f01 = __builtin_amdgcn_cvt_pk_f32_fp8((int)q[r][i], false);
                const f32x2 f23 = __builtin_amdgcn_cvt_pk_f32_fp8((int)q[r][i], true);
                sacc += f01[0] * x[4 * i] + f01[1] * x[4 * i + 1] + f23[0] * x[4 * i + 2] + f23[1] * x[4 * i + 3];
            }
            sacc = wave_allsum_fast(sacc);
            const int e = eb + r;
            if (lane == (e & 63)) { if (e < 64) myact0 = sacc; else myact1 = sacc; }
        }
    }
    coef[lane] = g0 * gelu_tanh(myact0 * ru0);
    coef[lane + 64] = g1 * gelu_tanh(myact1 * ru1);
    __builtin_amdgcn_wave_barrier();
    float acc[16];
#pragma unroll
    for (int i = 0; i < 16; i++) acc[i] = 0.f;
#pragma unroll 1
    for (int eb = 0; eb < 128; eb += 16) {
        u32x4 q[16];
#pragma unroll
        for (int r = 0; r < 16; r++) q[r] = *(const u32x4*)(vtab + (size_t)eid[eb + r] * 1024 + lane * 16);
#pragma unroll
        for (int r = 0; r < 16; r++) {
            const float cf = coef[eb + r];
#pragma unroll
            for (int i = 0; i < 4; i++) {
                const f32x2 f01 = __builtin_amdgcn_cvt_pk_f32_fp8((int)q[r][i], false);
                const f32x2 f23 = __builtin_amdgcn_cvt_pk_f32_fp8((int)q[r][i], true);
                acc[4 * i] += cf * f01[0]; acc[4 * i + 1] += cf * f01[1]; acc[4 * i + 2] += cf * f23[0]; acc[4 * i + 3] += cf * f23[1];
            }
        }
    }
    const float* m = modl + (size_t)tok_modrow(t) * 6144 + 5 * 1024 + lane * 16;
    float* xo = xrun + (size_t)t * DM + lane * 16;
#pragma unroll
    for (int j = 0; j < 4; j++) {
        float4 xa = *(float4*)(xo + 4 * j);
        const float4 ma = *(const float4*)(m + 4 * j);
        xa.x += ma.x * acc[4 * j]; xa.y += ma.y * acc[4 * j + 1]; xa.z += ma.z * acc[4 * j + 2]; xa.w += ma.w * acc[4 * j + 3];
        *(float4*)(xo + 4 * j) = xa;
    }
}

#define XB_TMO      128
#define XB_XCNT(j)  (256  + 64 * (j))
#define XB_XSUB(j)  (1280 + 64 * (j))
#define XB_XGEN(j)  (2304 + 64 * (j))
#define XB_TOP      3328
#define XB_TOPGEN   3392
#define XCD_BAR_WORDS 3456
#define XB_SPIN_CAP (1u << 22)
#define LAS __attribute__((address_space(3)))
__device__ __forceinline__ unsigned xb_ld(unsigned* p) { return __hip_atomic_load(p, __ATOMIC_RELAXED, __HIP_MEMORY_SCOPE_AGENT); }
__device__ __forceinline__ unsigned xb_add(unsigned* p, unsigned v) { return __hip_atomic_fetch_add(p, v, __ATOMIC_RELAXED, __HIP_MEMORY_SCOPE_AGENT); }
__device__ __forceinline__ unsigned xb_xcc_id() { return (unsigned)__builtin_amdgcn_s_getreg((3 << 11) | 20) & 0xFu; }
#define XB_SPIN(cond, bar) do { unsigned _sp = 0; while (cond) { __builtin_amdgcn_s_sleep(1); \
    if ((++_sp & 255u) == 0u) { if (xb_ld(&(bar)[XB_TMO])) break; if (_sp > XB_SPIN_CAP) { atomicAdd(&(bar)[XB_TMO], 1u); break; } } } } while (0)
struct XcdBarrier { unsigned* bar; unsigned x; volatile LAS unsigned* st; };
__device__ __forceinline__ XcdBarrier xcd_barrier_post(unsigned* bar, volatile LAS unsigned* st) {
    XcdBarrier b; b.bar = bar; b.x = xb_xcc_id(); b.st = st;
    if (threadIdx.x == 0) (void)xb_add(&bar[XB_XCNT(b.x)], 1u);
    return b;
}
__device__ __forceinline__ void xcd_barrier_complete(unsigned* bar, unsigned x, unsigned& nloc, unsigned& nx) {
    const unsigned G = gridDim.x * gridDim.y * gridDim.z;
    unsigned sum, cnt, mine, sp = 0u;
    for (;;) {
        sum = 0u; cnt = 0u; mine = 0u;
#pragma unroll
        for (unsigned j = 0; j < 16; ++j) { const unsigned c = xb_ld(&bar[XB_XCNT(j)]); sum += c; cnt += (c > 0u) ? 1u : 0u; mine = (j == x) ? c : mine; }
        if (sum == G) break;
        __builtin_amdgcn_s_sleep(1);
        if ((++sp & 255u) == 0u) { if (xb_ld(&bar[XB_TMO])) break; if (sp > XB_SPIN_CAP) { atomicAdd(&bar[XB_TMO], 1u); break; } }
    }
    nloc = mine > 0u ? mine : 1u; nx = cnt > 0u ? cnt : 1u;
}
__device__ __forceinline__ void xcd_barrier_(unsigned* bar_, char* smem_) {
    XcdBarrier b; b.bar = bar_; b.x = xb_xcc_id(); b.st = (volatile LAS unsigned*)(smem_ + GEMM_LDS_BYTES);
    asm volatile("s_waitcnt vmcnt(0)" ::: "memory");
    __syncthreads();
    if (threadIdx.x == 0) {
        unsigned* bar = b.bar;
        __builtin_amdgcn_s_waitcnt(0);
        unsigned nloc = b.st[0], nx = b.st[1];
        if (nloc == 0u) { xcd_barrier_complete(bar, b.x, nloc, nx); b.st[0] = nloc; b.st[1] = nx; }
        const unsigned old = xb_add(&bar[XB_XSUB(b.x)], 1u);
        const unsigned gen = old / nloc;
        if (old + 1u == (gen + 1u) * nloc) {
            __builtin_amdgcn_fence(__ATOMIC_RELEASE, "agent");
            asm volatile("s_waitcnt vmcnt(0)" ::: "memory");
            const unsigned og = xb_add(&bar[XB_TOP], 1u);
            const unsigned tg = og / nx;
            if (og + 1u == (tg + 1u) * nx) xb_add(&bar[XB_TOPGEN], 1u);
            else XB_SPIN(xb_ld(&bar[XB_TOPGEN]) == tg, bar);
            __builtin_amdgcn_fence(__ATOMIC_ACQUIRE, "agent");
            xb_add(&bar[XB_XGEN(b.x)], 1u);
            asm volatile("s_waitcnt vmcnt(0)" ::: "memory");
        } else {
            XB_SPIN(xb_ld(&bar[XB_XGEN(b.x)]) == gen, bar);
            __builtin_amdgcn_fence(__ATOMIC_ACQUIRE, "agent");
            asm volatile("s_waitcnt vmcnt(0)" ::: "memory");
        }
    }
    __syncthreads();
}

constexpr size_t ws_al(size_t x) { return (x + 255) & ~(size_t)255; }
struct WS {
    static constexpr size_t mod = 0;
    static constexpr size_t w_in_t = ws_al(mod + (size_t)(2*5*6144*4));
    static constexpr size_t w_out_t = ws_al(w_in_t + (size_t)(2304*1024*2));
    static constexpr size_t hy_w_in_t = ws_al(w_out_t + (size_t)(1024*1024*2));
    static constexpr size_t hy_w_out_t = ws_al(hy_w_in_t + (size_t)(3072*1024*2));
    static constexpr size_t w_q_t = ws_al(hy_w_out_t + (size_t)(1024*1024*2));
    static constexpr size_t q_up_t = ws_al(w_q_t + (size_t)(2*2048*1024*2));
    static constexpr size_t kv_up_t = ws_al(q_up_t + (size_t)(768*256*2));
    static constexpr size_t w2_t = ws_al(kv_up_t + (size_t)(1024*128*2));
    static constexpr size_t a2_t = ws_al(w2_t + (size_t)(2*512*64*2));
    static constexpr size_t g2_t = ws_al(a2_t + (size_t)(2*512*64*2));
    static constexpr size_t ctxb = ws_al(g2_t + (size_t)(512*128*2));
    static constexpr size_t keysb = ws_al(ctxb + (size_t)(1024*128*2));
    static constexpr size_t tabU = ws_al(keysb + (size_t)(2*16*128*128*2));
    static constexpr size_t tabV = ws_al(tabU + (size_t)(16384*1024));
    static constexpr size_t rsU = ws_al(tabV + (size_t)(16384*1024));
    static constexpr size_t rsV = ws_al(rsU + (size_t)(16384*4));
    static constexpr size_t nsum = ws_al(rsV + (size_t)(16384*4));
    static constexpr size_t gTS = ws_al(nsum + (size_t)(2*1024*4 + 3456*4 + 1024));
    static constexpr size_t gTP = ws_al(gTS + (size_t)1024*2*2048*2);
    static constexpr size_t R1 = ws_al(gTP + (size_t)1024*2*256*2);
    static constexpr size_t R2 = ws_al(R1 + (size_t)((size_t)TT*1024*4));
    static constexpr size_t rb = ws_al(R2 + (size_t)((size_t)TT*1792*2 + (size_t)TT*448*4));
    static constexpr size_t kb = ws_al(rb + (size_t)((size_t)TT*512*2));
    static constexpr size_t vb = ws_al(kb + (size_t)((size_t)TT*512*2));
    static constexpr size_t kkb = ws_al(vb + (size_t)((size_t)TT*512*2));
    static constexpr size_t lr0 = ws_al(kkb + (size_t)((size_t)TT*512*2));
    static constexpr size_t lr1 = ws_al(lr0 + (size_t)((size_t)TT*512*2));
    static constexpr size_t gateb = ws_al(lr1 + (size_t)((size_t)TT*512*2));
    static constexpr size_t du0 = ws_al(gateb + (size_t)((size_t)TT*512*2));
    static constexpr size_t du1 = ws_al(du0 + (size_t)((size_t)TT*512*2));
    static constexpr size_t twb = ws_al(du1 + (size_t)((size_t)TT*512*2));
    static constexpr size_t advb = ws_al(twb + (size_t)((size_t)TT*64*2));
    static constexpr size_t sgb = ws_al(advb + (size_t)((size_t)TT*64*2));
    static constexpr size_t bonus = ws_al(sgb + (size_t)((size_t)TT*128*2));
    static constexpr size_t kpe = ws_al(bonus + (size_t)((size_t)TT*8*4));
    static constexpr size_t qcnb = ws_al(kpe + (size_t)((size_t)TT*64*4));
    static constexpr size_t ckvb = ws_al(qcnb + (size_t)((size_t)TT*256*2));
    static constexpr size_t Qb = ws_al(ckvb + (size_t)((size_t)TT*128*2));
    static constexpr size_t Kp = ws_al(Qb + (size_t)((size_t)TT*768*2));
    static constexpr size_t Vp = ws_al(Kp + (size_t)(16*4*256*192*2));
    static constexpr size_t Ks = ws_al(Vp + (size_t)(16*4*256*128*2));
    static constexpr size_t Vs = ws_al(Ks + (size_t)(4*4*2304*192*2));
    static constexpr size_t kvctxb = ws_al(Vs + (size_t)(4*4*2304*128*2));
    static constexpr size_t pidx = ws_al(kvctxb + (size_t)(1024*1024*2));
    static constexpr size_t pg = ws_al(pidx + (size_t)((size_t)TT*128*4));
    static constexpr size_t END = ws_al(pg + (size_t)((size_t)TT*128*4));
    static constexpr size_t hb = R1;
    static constexpr size_t catb = R1;
    static constexpr size_t zbb = R1;
    static constexpr size_t kvrawb = R1;
    static constexpr size_t qrawb = R1 + (size_t)TT*1024*2;
    static constexpr size_t projrw = R2;
    static constexpr size_t projmla = R2 + (size_t)TT*1792*2;
    static constexpr size_t y0 = R2;
    static constexpr size_t y1 = R2 + (size_t)TT*512*4;
    static constexpr size_t qb = R2;
    static constexpr size_t scT = rb;
    static constexpr size_t pre = R2;
    static constexpr size_t zT = R2 + (size_t)TT*3072*4;
    static constexpr size_t x0b = R2 + (size_t)TT*3072*4 + (size_t)TT*1024*2;
    static constexpr size_t yT = R2 + (size_t)TT*3072*4 + (size_t)TT*1024*4;
    static constexpr size_t bar = nsum + 2*1024*4;
};
struct Params {
    const float* in[46];
    float* out;
    char* ws;
    __device__ __forceinline__ const float* x_prompt() const { return in[0]; }
    __device__ __forceinline__ const float* x_sample() const { return in[1]; }
    __device__ __forceinline__ const float* st_f() const { return in[2]; }
    __device__ __forceinline__ const float* st_b() const { return in[3]; }
    __device__ __forceinline__ const float* cache_ckv() const { return in[4]; }
    __device__ __forceinline__ const float* cache_kpe() const { return in[5]; }
    __device__ __forceinline__ const float* c() const { return in[6]; }
    __device__ __forceinline__ const float* c_ctx() const { return in[7]; }
    __device__ __forceinline__ const float* norm_g() const { return in[8]; }
    __device__ __forceinline__ const float* w_mod() const { return in[9]; }
    __device__ __forceinline__ const float* b_mod() const { return in[10]; }
    __device__ __forceinline__ const float* ab_w_in() const { return in[11]; }
    __device__ __forceinline__ const float* rw_mu() const { return in[12]; }
    __device__ __forceinline__ const float* rw_w0() const { return in[13]; }
    __device__ __forceinline__ const float* rw_w2() const { return in[14]; }
    __device__ __forceinline__ const float* rw_a0() const { return in[15]; }
    __device__ __forceinline__ const float* rw_a2() const { return in[16]; }
    __device__ __forceinline__ const float* rw_g2() const { return in[17]; }
    __device__ __forceinline__ const float* rw_k_k() const { return in[18]; }
    __device__ __forceinline__ const float* rw_k_a() const { return in[19]; }
    __device__ __forceinline__ const float* rw_r_k() const { return in[20]; }
    __device__ __forceinline__ const float* rw_lnx_g() const { return in[21]; }
    __device__ __forceinline__ const float* rw_lnx_b() const { return in[22]; }
    __device__ __forceinline__ const float* mla_q_norm() const { return in[23]; }
    __device__ __forceinline__ const float* mla_q_up() const { return in[24]; }
    __device__ __forceinline__ const float* mla_kv_norm() const { return in[25]; }
    __device__ __forceinline__ const float* mla_kv_up() const { return in[26]; }
    __device__ __forceinline__ const float* mla_qn() const { return in[27]; }
    __device__ __forceinline__ const float* mla_kn() const { return in[28]; }
    __device__ __forceinline__ const float* ab_w_out() const { return in[29]; }
    __device__ __forceinline__ const float* hy_w_in() const { return in[30]; }
    __device__ __forceinline__ const float* hy_b_in() const { return in[31]; }
    __device__ __forceinline__ const float* hy_conv_w() const { return in[32]; }
    __device__ __forceinline__ const float* hy_conv_b() const { return in[33]; }
    __device__ __forceinline__ const float* hy_f_w1() const { return in[34]; }
    __device__ __forceinline__ const float* hy_f_b1() const { return in[35]; }
    __device__ __forceinline__ const float* hy_f_w2() const { return in[36]; }
    __device__ __forceinline__ const float* hy_f_b2() const { return in[37]; }
    __device__ __forceinline__ const float* hy_f_w3() const { return in[38]; }
    __device__ __forceinline__ const float* hy_f_freq() const { return in[39]; }
    __device__ __forceinline__ const float* hy_bias() const { return in[40]; }
    __device__ __forceinline__ const float* hy_w_out() const { return in[41]; }
    __device__ __forceinline__ const float* peer_w_q() const { return in[42]; }
    __device__ __forceinline__ const float* peer_keys() const { return in[43]; }
    __device__ __forceinline__ const float* peer_u() const { return in[44]; }
    __device__ __forceinline__ const float* peer_v() const { return in[45]; }
    __device__ __forceinline__ float* xrun() const { return out + (0); }
    __device__ __forceinline__ float* out_sf() const { return out + ((size_t)TT*DM); }
    __device__ __forceinline__ float* out_sb() const { return out + ((size_t)TT*DM + 16*8*64*64); }
    __device__ __forceinline__ float* out_ckv() const { return out + ((size_t)TT*DM + 2*16*8*64*64); }
    __device__ __forceinline__ float* out_kpe() const { return out + ((size_t)TT*DM + 2*16*8*64*64 + 16*256*128); }
    __device__ __forceinline__ float* mod() const { return (float*)(ws + WS::mod); }
    __device__ __forceinline__ bf16_t* w_in_t() const { return (bf16_t*)(ws + WS::w_in_t); }
    __device__ __forceinline__ bf16_t* w_out_t() const { return (bf16_t*)(ws + WS::w_out_t); }
    __device__ __forceinline__ bf16_t* hy_w_in_t() const { return (bf16_t*)(ws + WS::hy_w_in_t); }
    __device__ __forceinline__ bf16_t* hy_w_out_t() const { return (bf16_t*)(ws + WS::hy_w_out_t); }
    __device__ __forceinline__ bf16_t* w_q_t() const { return (bf16_t*)(ws + WS::w_q_t); }
    __device__ __forceinline__ bf16_t* q_up_t() const { return (bf16_t*)(ws + WS::q_up_t); }
    __device__ __forceinline__ bf16_t* kv_up_t() const { return (bf16_t*)(ws + WS::kv_up_t); }
    __device__ __forceinline__ bf16_t* w2_t() const { return (bf16_t*)(ws + WS::w2_t); }
    __device__ __forceinline__ bf16_t* a2_t() const { return (bf16_t*)(ws + WS::a2_t); }
    __device__ __forceinline__ bf16_t* g2_t() const { return (bf16_t*)(ws + WS::g2_t); }
    __device__ __forceinline__ bf16_t* ctxb() const { return (bf16_t*)(ws + WS::ctxb); }
    __device__ __forceinline__ bf16_t* keysb() const { return (bf16_t*)(ws + WS::keysb); }
    __device__ __forceinline__ unsigned char* tabU() const { return (unsigned char*)(ws + WS::tabU); }
    __device__ __forceinline__ float* rsU() const { return (float*)(ws + WS::rsU); }
    __device__ __forceinline__ float* rsV() const { return (float*)(ws + WS::rsV); }
    __device__ __forceinline__ unsigned char* tabV() const { return (unsigned char*)(ws + WS::tabV); }
    __device__ __forceinline__ float* nsum() const { return (float*)(ws + WS::nsum); }
    __device__ __forceinline__ bf16_t* rb() const { return (bf16_t*)(ws + WS::rb); }
    __device__ __forceinline__ bf16_t* kb() const { return (bf16_t*)(ws + WS::kb); }
    __device__ __forceinline__ bf16_t* vb() const { return (bf16_t*)(ws + WS::vb); }
    __device__ __forceinline__ bf16_t* kkb() const { return (bf16_t*)(ws + WS::kkb); }
    __device__ __forceinline__ bf16_t* lr0() const { return (bf16_t*)(ws + WS::lr0); }
    __device__ __forceinline__ bf16_t* lr1() const { return (bf16_t*)(ws + WS::lr1); }
    __device__ __forceinline__ bf16_t* gateb() const { return (bf16_t*)(ws + WS::gateb); }
    __device__ __forceinline__ _Float16* du0() const { return (_Float16*)(ws + WS::du0); }
    __device__ __forceinline__ _Float16* du1() const { return (_Float16*)(ws + WS::du1); }
    __device__ __forceinline__ bf16_t* twb() const { return (bf16_t*)(ws + WS::twb); }
    __device__ __forceinline__ bf16_t* advb() const { return (bf16_t*)(ws + WS::advb); }
    __device__ __forceinline__ bf16_t* sgb() const { return (bf16_t*)(ws + WS::sgb); }
    __device__ __forceinline__ float* bonus() const { return (float*)(ws + WS::bonus); }
    __device__ __forceinline__ float* kpe() const { return (float*)(ws + WS::kpe); }
    __device__ __forceinline__ bf16_t* qcnb() const { return (bf16_t*)(ws + WS::qcnb); }
    __device__ __forceinline__ bf16_t* ckvb() const { return (bf16_t*)(ws + WS::ckvb); }
    __device__ __forceinline__ bf16_t* Qb() const { return (bf16_t*)(ws + WS::Qb); }
    __device__ __forceinline__ bf16_t* Kp() const { return (bf16_t*)(ws + WS::Kp); }
    __device__ __forceinline__ bf16_t* Vp() const { return (bf16_t*)(ws + WS::Vp); }
    __device__ __forceinline__ bf16_t* Ks() const { return (bf16_t*)(ws + WS::Ks); }
    __device__ __forceinline__ bf16_t* Vs() const { return (bf16_t*)(ws + WS::Vs); }
    __device__ __forceinline__ bf16_t* kvctxb() const { return (bf16_t*)(ws + WS::kvctxb); }
    __device__ __forceinline__ int* pidx() const { return (int*)(ws + WS::pidx); }
    __device__ __forceinline__ float* pg() const { return (float*)(ws + WS::pg); }
    __device__ __forceinline__ bf16_t* hb() const { return (bf16_t*)(ws + WS::hb); }
    __device__ __forceinline__ bf16_t* catb() const { return (bf16_t*)(ws + WS::catb); }
    __device__ __forceinline__ bf16_t* zbb() const { return (bf16_t*)(ws + WS::zbb); }
    __device__ __forceinline__ bf16_t* kvrawb() const { return (bf16_t*)(ws + WS::kvrawb); }
    __device__ __forceinline__ bf16_t* qrawb() const { return (bf16_t*)(ws + WS::qrawb); }
    __device__ __forceinline__ bf16_t* projrw() const { return (bf16_t*)(ws + WS::projrw); }
    __device__ __forceinline__ float* projmla() const { return (float*)(ws + WS::projmla); }
    __device__ __forceinline__ float* y0() const { return (float*)(ws + WS::y0); }
    __device__ __forceinline__ float* y1() const { return (float*)(ws + WS::y1); }
    __device__ __forceinline__ bf16_t* qb() const { return (bf16_t*)(ws + WS::qb); }
    __device__ __forceinline__ float* scT() const { return (float*)(ws + WS::scT); }
    __device__ __forceinline__ float* pre() const { return (float*)(ws + WS::pre); }
    __device__ __forceinline__ bf16_t* zT() const { return (bf16_t*)(ws + WS::zT); }
    __device__ __forceinline__ bf16_t* x0b() const { return (bf16_t*)(ws + WS::x0b); }
    __device__ __forceinline__ bf16_t* yT() const { return (bf16_t*)(ws + WS::yT); }
    __device__ __forceinline__ bf16_t* gTS() const { return (bf16_t*)(ws + WS::gTS); }
    __device__ __forceinline__ bf16_t* gTP() const { return (bf16_t*)(ws + WS::gTP); }
    __device__ __forceinline__ unsigned* bar() const { return (unsigned*)(ws + WS::bar); }
};

#define VLOOP(n) for (int vb = blockIdx.x; vb < (n); vb += gridDim.x)
#define ENDV __syncthreads();

__device__ __forceinline__ void peer_layer(const Params& p, char* smem, int li, const float* modl, float* xrs) {
    const bf16_t* wq = p.w_q_t() + (size_t)li * 2048 * 1024;
    const bf16_t* kys = p.keysb() + (size_t)li * 16 * 128 * 128;
    VLOOP(TT / 8) { d_norm_mod2(vb, p.xrun(), xrs, p.norm_g() + (li * 2 + 1) * 1024, modl, 3, 4, p.hb()); }
    xcd_barrier_(p.bar(), smem);
    VLOOP(16 * 96) { d_gemm_bf16(vb % 16, vb / 16, smem, p.hb(), 1024, wq, 1024, 1024, 2048, EpiStoreBf{p.qb(), 2048, 0}); }
    xcd_barrier_(p.bar(), smem);
    VLOOP(16 * 96) { const int hp = vb / 96; d_gemm_bf16(vb % 96, 0, smem, kys + (size_t)hp * 128 * 128, 128, p.qb() + hp * 128, 2048, 128, TT, EpiStore{p.scT() + (size_t)hp * 128 * TT, nullptr, TT, 0}); }
    xcd_barrier_(p.bar(), smem);
    VLOOP(8 * 48) { d_peer_select(vb, p.scT(), p.pidx(), p.pg()); }
    xcd_barrier_(p.bar(), smem);
    VLOOP(TT / 4) { d_peer_apply3(vb, smem, p.hb(), p.pidx(), p.pg(), p.tabU(), p.tabV(), p.rsU(), p.rsV(), modl, p.xrun()); ENDV }
}

__global__ void __launch_bounds__(256, 2) mega(Params p) {
    __shared__ __attribute__((aligned(16))) char smem[GEMM_LDS_BYTES + 16];
    cg::grid_group grid = cg::this_grid();
    if (threadIdx.x < 4) ((unsigned*)(smem + GEMM_LDS_BYTES))[threadIdx.x] = 0u;
    __syncthreads();
    (void)xcd_barrier_post(p.bar(), (volatile LAS unsigned*)(smem + GEMM_LDS_BYTES));
    const float* mod0 = p.mod();
    const float* mod1 = p.mod() + 5 * 6144;
    float* xrs = p.xrun() + (size_t)TP * DM;

    VLOOP(192) { d_mod2(vb, smem, p.c(), p.c_ctx(), p.w_mod(), p.b_mod(), p.mod()); ENDV }
    VLOOP(512) { d_hy_filt2(vb, smem, LS, p.hy_f_w1(), p.hy_f_b1(), p.hy_f_w2(), p.hy_f_b2(), p.hy_f_w3(), p.hy_f_freq(), p.gTS(), p.nsum()); ENDV }
    VLOOP(64) { d_hy_filt2(vb, smem, LP, p.hy_f_w1(), p.hy_f_b1(), p.hy_f_w2(), p.hy_f_b2(), p.hy_f_w3(), p.hy_f_freq(), p.gTP(), p.nsum() + 1024); ENDV }
    {
        const int j1 = 36 * 16;
        const int j2 = j1 + 16 * 16;
        const int j3 = j2 + 48 * 16;
        const int j4 = j3 + 16 * 16;
        const int j5 = j4 + 32 * 16;
        const int j6 = j5 + 32 * 16;
        const int j7 = j6 + 12 * 4;
        const int j8 = j7 + 16 * 2;
        const int j9 = j8 + 8;
        const int j10 = j9 + 8;
        const int j11 = j10 + 8;
        const int j12 = j11 + 8;
        const int j13 = j12 + 8 * 2;
        VLOOP(j13) {
            const float* W; bf16_t* Wt; int K, N, lv;
            if (vb < j1) { W = p.ab_w_in(); Wt = p.w_in_t(); K = 1024; N = 2240; lv = vb; }
            else if (vb < j2) { W = p.ab_w_out(); Wt = p.w_out_t(); K = 1024; N = 1024; lv = vb - j1; }
            else if (vb < j3) { W = p.hy_w_in(); Wt = p.hy_w_in_t(); K = 1024; N = 3072; lv = vb - j2; }
            else if (vb < j4) { W = p.hy_w_out(); Wt = p.hy_w_out_t(); K = 1024; N = 1024; lv = vb - j3; }
            else if (vb < j5) { W = p.peer_w_q(); Wt = p.w_q_t(); K = 1024; N = 2048; lv = vb - j4; }
            else if (vb < j6) { W = p.peer_w_q() + (size_t)1024 * 2048; Wt = p.w_q_t() + (size_t)2048 * 1024; K = 1024; N = 2048; lv = vb - j5; }
            else if (vb < j7) { W = p.mla_q_up(); Wt = p.q_up_t(); K = 256; N = 768; lv = vb - j6; }
            else if (vb < j8) { W = p.mla_kv_up(); Wt = p.kv_up_t(); K = 128; N = 1024; lv = vb - j7; }
            else if (vb < j9) { W = p.rw_w2(); Wt = p.w2_t(); K = 64; N = 512; lv = vb - j8; }
            else if (vb < j10) { W = p.rw_w2() + 64 * 512; Wt = p.w2_t() + 512 * 64; K = 64; N = 512; lv = vb - j9; }
            else if (vb < j11) { W = p.rw_a2(); Wt = p.a2_t(); K = 64; N = 512; lv = vb - j10; }
            else if (vb < j12) { W = p.rw_a2() + 64 * 512; Wt = p.a2_t() + 512 * 64; K = 64; N = 512; lv = vb - j11; }
            else { W = p.rw_g2(); Wt = p.g2_t(); K = 128; N = 512; lv = vb - j12; }
            d_transpose_w(lv, smem, W, K, N, Wt);
            ENDV }
    }
    VLOOP(40) { if (vb < 8) d_cvt_bf16(vb, p.cache_ckv(), p.ctxb()); else d_cvt_bf16(vb - 8, p.peer_keys(), p.keysb()); }
    VLOOP(2048) {
        const bool isv = vb >= 1024;
        d_cvt_fp8_rows(isv ? vb - 1024 : vb, isv ? p.peer_v() : p.peer_u(), isv ? p.tabV() : p.tabU(), isv ? p.rsV() : p.rsU());
    }
    grid.sync();
    VLOOP(TT / 8) { d_norm_mod2(vb, p.x_prompt(), p.x_sample(), p.norm_g(), mod0, 0, 1, p.hb()); }
    xcd_barrier_(p.bar(), smem);
    VLOOP(18 * 96) { d_gemm_bf16(vb % 18, vb / 18, smem, p.hb(), 1024, p.w_in_t(), 1024, 1024, ABIN, EpiProj{p.projrw(), p.projmla()}); }
    xcd_barrier_(p.bar(), smem);
    VLOOP(2688 + 768) {
        if (vb < 2688) d_rw_shift2(vb, p.projrw(), p.rw_mu(), p.rb(), p.kb(), p.vb(), p.twb(), p.advb(), p.sgb());
        else d_mla_pre2(vb - 2688, p.projmla(), p.mla_q_norm(), p.mla_kv_norm(), p.qcnb(), p.ckvb(), p.kpe(), p.out_ckv(), p.out_kpe());
    }
    xcd_barrier_(p.bar(), smem);
    {
        const int n0 = 4 * 96, n1 = 6 * 96, n2 = 8 * 96, n3 = 8 * 8;
        VLOOP(5 * n0 + n1 + n2 + n3) {
            int v = vb;
            if (v < n0) d_gemm_bf16(v % 4, v / 4, smem, p.twb(), 64, p.w2_t(), 64, 64, 512, EpiDecay{p.du0(), p.rw_w0()});
            else if ((v -= n0) < n0) d_gemm_bf16(v % 4, v / 4, smem, p.twb(), 64, p.w2_t() + 512 * 64, 64, 64, 512, EpiDecay{p.du1(), p.rw_w0() + 512});
            else if ((v -= n0) < n0) d_gemm_bf16(v % 4, v / 4, smem, p.advb(), 64, p.a2_t(), 64, 64, 512, EpiLr{p.lr0(), p.rw_a0()});
            else if ((v -= n0) < n0) d_gemm_bf16(v % 4, v / 4, smem, p.advb(), 64, p.a2_t() + 512 * 64, 64, 64, 512, EpiLr{p.lr1(), p.rw_a0() + 512});
            else if ((v -= n0) < n0) d_gemm_bf16(v % 4, v / 4, smem, p.sgb(), 128, p.g2_t(), 128, 128, 512, EpiStoreBf{p.gateb(), 512, 0});
            else if ((v -= n0) < n1) d_gemm_bf16(v % 6, v / 6, smem, p.qcnb(), 256, p.q_up_t(), 256, 256, 768, EpiStoreBf{p.qrawb(), 768, 0});
            else if ((v -= n1) < n2) d_gemm_bf16(v % 8, v / 8, smem, p.ckvb(), 128, p.kv_up_t(), 128, 128, 1024, EpiKV{p.kvrawb(), p.Vp(), p.Vs(), 0, 0});
            else { v -= n2; d_gemm_bf16(v % 8, v / 8, smem, p.ctxb(), 128, p.kv_up_t(), 128, 128, 1024, EpiKV{p.kvctxb(), p.Vp(), p.Vs(), 1, 0}); }
        }
    }
    xcd_barrier_(p.bar(), smem);
    VLOOP(384 + 3328) {
        if (vb < 384) d_rw_kk2(vb, smem, p.rb(), p.kb(), p.lr0(), p.lr1(), p.rw_k_k(), p.rw_k_a(), p.rw_r_k(), p.kkb(), p.bonus());
        else d_mla_post2(vb - 384, p.qrawb(), p.kvrawb(), p.kvctxb(), p.kpe(), p.cache_kpe(), p.mla_qn(), p.mla_kn(), p.Qb(), p.Kp(), p.Ks());
        ENDV }
    xcd_barrier_(p.bar(), smem);
    VLOOP(256 + 1024) {
        if (vb < 256) d_scan2(vb, true, smem, p.rb(), p.kb(), p.vb(), p.kkb(), p.lr0(), p.lr1(), p.du0(), p.du1(), p.rw_k_a(), p.st_f(), p.st_b(), p.y0(), p.y1(), p.out_sf(), p.out_sb());
        else d_scan2(vb - 256, false, smem, p.rb(), p.kb(), p.vb(), p.kkb(), p.lr0(), p.lr1(), p.du0(), p.du1(), p.rw_k_a(), p.st_f(), p.st_b(), p.y0(), p.y1(), p.out_sf(), p.out_sb());
    }
    xcd_barrier_(p.bar(), smem);
    VLOOP(256 + 128) {
        if (vb < 256) { d_attn_mfma(vb, smem, p.Qb(), p.Ks(), p.Vs(), p.catb(), TP, LS, 2304, 16); }
        else { d_attn_mfma(vb - 256, smem, p.Qb(), p.Kp(), p.Vp(), p.catb(), 0, LP, LP, 2); }
        ENDV }
    xcd_barrier_(p.bar(), smem);
    VLOOP(384) { d_rw_post2(vb, smem, p.y0(), p.y1(), p.bonus(), p.vb(), p.gateb(), p.rw_lnx_g(), p.rw_lnx_b(), p.catb()); ENDV }
    xcd_barrier_(p.bar(), smem);
    VLOOP(8 * 96) { d_gemm_bf16(vb % 8, vb / 8, smem, p.catb(), 1024, p.w_out_t(), 1024, 1024, 1024, EpiResid{p.x_prompt(), p.x_sample(), p.xrun(), mod0, 2, 0}); }
    xcd_barrier_(p.bar(), smem);
    peer_layer(p, smem, 0, mod0, xrs);
    xcd_barrier_(p.bar(), smem);
    VLOOP(TT / 8) { d_norm_mod2(vb, p.xrun(), xrs, p.norm_g() + 2048, mod1, 0, 1, p.hb()); }
    VLOOP(2048) {
        const bool isv = vb >= 1024;
        d_cvt_fp8_rows(isv ? vb - 1024 : vb, (isv ? p.peer_v() : p.peer_u()) + (size_t)16384 * 1024, isv ? p.tabV() : p.tabU(), isv ? p.rsV() : p.rsU());
    }
    xcd_barrier_(p.bar(), smem);
    VLOOP(24 * 96) { d_gemm_bf16(vb % 24, vb / 24, smem, p.hb(), 1024, p.hy_w_in_t(), 1024, 1024, 3072, EpiStore{p.pre(), p.hy_b_in(), 3072, 0}); }
    xcd_barrier_(p.bar(), smem);
    VLOOP(192 * 16) { d_hy_dw2(vb, smem, p.pre(), p.hy_conv_w(), p.hy_conv_b(), p.zT(), p.x0b()); ENDV }
    xcd_barrier_(p.bar(), smem);
    VLOOP(512 + 512) {
        const int wv = threadIdx.x >> 6;
        char* wsm = smem + (wv >> 1) * 28672;
        if (vb < 512) d_hy_conv2<true>(vb * 2 + (wv >> 1), wv & 1, wsm, p.gTS(), p.nsum(), p.zT(), p.hy_bias(), p.yT());
        else d_hy_conv2<false>((vb - 512) * 2 + (wv >> 1), wv & 1, wsm, p.gTP(), p.nsum() + 1024, p.zT(), p.hy_bias(), p.yT());
        ENDV }
    xcd_barrier_(p.bar(), smem);
    VLOOP(192 * 16) { d_hy_post(vb, smem, p.yT(), p.x0b(), p.zbb()); ENDV }
    xcd_barrier_(p.bar(), smem);
    VLOOP(8 * 96) { d_gemm_bf16(vb % 8, vb / 8, smem, p.zbb(), 1024, p.hy_w_out_t(), 1024, 1024, 1024, EpiResid{p.xrun(), xrs, p.xrun(), mod1, 2, 0}); }
    xcd_barrier_(p.bar(), smem);
    peer_layer(p, smem, 1, mod1, xrs);
}

static inline size_t align_up(size_t x) { return (x + 255) & ~(size_t)255; }

extern "C" void kernel_launch(void* const* d_in, const int* in_sizes, int n_in, void* d_out, int out_size, void* d_ws, size_t ws_size,
                              hipStream_t stream) {
    Params p{};
    for (int i = 0; i < 46; i++) p.in[i] = (const float*)d_in[i];
    p.out = (float*)d_out;
    p.ws = (char*)d_ws;
    static_assert(WS::END <= (size_t)422781952, "workspace plan exceeds the guaranteed scratch size");
    static int grid_blocks = 0;
    if (!grid_blocks) {
        int dev = 0, cus = 0, per_cu = 0;
        (void)hipGetDevice(&dev);
        (void)hipDeviceGetAttribute(&cus, hipDeviceAttributeMultiprocessorCount, dev);
        (void)hipOccupancyMaxActiveBlocksPerMultiprocessor(&per_cu, mega, 256, 0);
        if (per_cu > 2) per_cu = 2;
        if (per_cu < 1) per_cu = 1;
        grid_blocks = cus * per_cu;
    }
    (void)hipMemsetAsync(p.ws + WS::nsum, 0, (size_t)2 * 1024 * 4 + (size_t)XCD_BAR_WORDS * 4 + 1024, stream);
    void* args[] = {&p};
    (void)hipLaunchCooperativeKernel((void*)mega, dim3(grid_blocks), dim3(256), args, 0, stream);
}
```

```cpp
#include <hip/hip_runtime.h>
#include <stdint.h>
#include <hip/hip_cooperative_groups.h>
namespace cg = cooperative_groups;

#define DM 1024
#define TP 4096
#define TS 8192
#define TT 12288
#define LP 256
#define LS 2048
#define NBP 16
#define NBS 4
#define ABIN 2240
#define RWIN 1792

typedef unsigned short bf16_t;
__device__ __forceinline__ bf16_t f2bf(float f) { unsigned u = __float_as_uint(f); u += 0x7fffu + ((u >> 16) & 1u); return (bf16_t)(u >> 16); }
__device__ __forceinline__ float bf2f(bf16_t h) { return __uint_as_float(((unsigned)h) << 16); }
__device__ __forceinline__ float sigmoidf_(float x) { return 1.f / (1.f + expf(-x)); }
__device__ __forceinline__ float gelu_tanh(float x) { return 0.5f * x * (1.f + tanhf(0.7978845608028654f * (x + 0.044715f * x * x * x))); }

__device__ __forceinline__ int tok_pos(int t) { return t < TP ? (t & (LP - 1)) : ((t - TP) & (LS - 1)); }
__device__ __forceinline__ int tok_len(int t) { return t < TP ? LP : LS; }
__device__ __forceinline__ int tok_modrow(int t) { return t < TP ? 0 : 1 + ((t - TP) >> 11); }

__device__ __forceinline__ float wave_sum(float v) {
#pragma unroll
    for (int o = 32; o > 0; o >>= 1) v += __shfl_xor(v, o, 64);
    return v;
}

__device__ __forceinline__ void d_mod(const int bx, const int by, const int bz, char* smem, const float* __restrict__ c, const float* __restrict__ c_ctx, const float* __restrict__ w_mod,
                                             const float* __restrict__ b_mod, float* __restrict__ mod) {
    float (*s)[1024] = (float(*)[1024])smem;
    const int li = by;
    const int n = bx * 256 + threadIdx.x;
    for (int i = threadIdx.x; i < 5 * 1024; i += 256) {
        int r = i >> 10, k = i & 1023;
        float v = (r == 0) ? c_ctx[k] : c[(r - 1) * 1024 + k];
        s[r][k] = v / (1.f + expf(-v));
    }
    __syncthreads();
    float a0 = 0, a1 = 0, a2 = 0, a3 = 0, a4 = 0;
    const float* w = w_mod + (size_t)li * 1024 * 6144 + n;
    for (int k = 0; k < 1024; k++) {
        float wv = w[(size_t)k * 6144];
        a0 += s[0][k] * wv; a1 += s[1][k] * wv; a2 += s[2][k] * wv; a3 += s[3][k] * wv; a4 += s[4][k] * wv;
    }
    float bb = b_mod[li * 6144 + n];
    float* o = mod + (size_t)li * 5 * 6144 + n;
    o[0 * 6144] = a0 + bb; o[1 * 6144] = a1 + bb; o[2 * 6144] = a2 + bb; o[3 * 6144] = a3 + bb; o[4 * 6144] = a4 + bb;
}


__device__ __forceinline__ void d_mod2(const int vb, char* smem, const float* __restrict__ c, const float* __restrict__ c_ctx,
                                       const float* __restrict__ w_mod, const float* __restrict__ b_mod, float* __restrict__ mod) {
    float* sl = (float*)smem;
    float* red = sl + 5 * 1024;
    const int li = vb / 96, n0 = (vb % 96) * 64;
    const int tid = threadIdx.x, col = tid & 63, kg = tid >> 6;
    for (int i = tid; i < 5 * 1024; i += 256) {
        const int r = i >> 10, k = i & 1023;
        const float v = (r == 0) ? c_ctx[k] : c[(r - 1) * 1024 + k];
        sl[i] = v / (1.f + __expf(-v));
    }
    __syncthreads();
    float a0 = 0, a1 = 0, a2 = 0, a3 = 0, a4 = 0;
    const float* w = w_mod + (size_t)li * 1024 * 6144 + (size_t)(kg * 256) * 6144 + n0 + col;
    const float* s0 = sl + kg * 256;
#pragma unroll 8
    for (int k = 0; k < 256; k++) {
        const float wv = w[(size_t)k * 6144];
        a0 += s0[k] * wv; a1 += s0[1024 + k] * wv; a2 += s0[2048 + k] * wv; a3 += s0[3072 + k] * wv; a4 += s0[4096 + k] * wv;
    }
    red[(kg * 5 + 0) * 64 + col] = a0; red[(kg * 5 + 1) * 64 + col] = a1; red[(kg * 5 + 2) * 64 + col] = a2;
    red[(kg * 5 + 3) * 64 + col] = a3; red[(kg * 5 + 4) * 64 + col] = a4;
    __syncthreads();
    for (int i = tid; i < 5 * 64; i += 256) {
        const int r = i >> 6, cc = i & 63;
        const float v = red[(0 * 5 + r) * 64 + cc] + red[(1 * 5 + r) * 64 + cc] + red[(2 * 5 + r) * 64 + cc] + red[(3 * 5 + r) * 64 + cc];
        mod[(size_t)(li * 5 + r) * 6144 + n0 + cc] = v + b_mod[li * 6144 + n0 + cc];
    }
}


__device__ __forceinline__ void d_mod3(const int vb, char* smem, const float* __restrict__ c, const float* __restrict__ c_ctx,
                                       const float* __restrict__ w_mod, const float* __restrict__ b_mod, float* __restrict__ mod) {
    float* sl = (float*)smem;
    const int li = vb / 96, kc = (vb % 96) / 6, cg6 = vb % 6;
    const int tid = threadIdx.x;
    for (int i = tid; i < 5 * 64; i += 256) {
        const int r = i >> 6, k = kc * 64 + (i & 63);
        const float v = (r == 0) ? c_ctx[k] : c[(r - 1) * 1024 + k];
        sl[i] = v / (1.f + __expf(-v));
    }
    __syncthreads();
    const int n = cg6 * 1024 + tid * 4;
    float4 a0 = {0, 0, 0, 0}, a1 = a0, a2 = a0, a3 = a0, a4 = a0;
    const float* w = w_mod + ((size_t)li * 1024 + kc * 64) * 6144 + n;
#pragma unroll 16
    for (int k = 0; k < 64; k++) {
        const float4 wv = *(const float4*)(w + (size_t)k * 6144);
        const float s0 = sl[k], s1 = sl[64 + k], s2 = sl[128 + k], s3 = sl[192 + k], s4 = sl[256 + k];
        a0.x += s0 * wv.x; a0.y += s0 * wv.y; a0.z += s0 * wv.z; a0.w += s0 * wv.w;
        a1.x += s1 * wv.x; a1.y += s1 * wv.y; a1.z += s1 * wv.z; a1.w += s1 * wv.w;
        a2.x += s2 * wv.x; a2.y += s2 * wv.y; a2.z += s2 * wv.z; a2.w += s2 * wv.w;
        a3.x += s3 * wv.x; a3.y += s3 * wv.y; a3.z += s3 * wv.z; a3.w += s3 * wv.w;
        a4.x += s4 * wv.x; a4.y += s4 * wv.y; a4.z += s4 * wv.z; a4.w += s4 * wv.w;
    }
    if (kc == 0) {
        const float4 bb = *(const float4*)(b_mod + li * 6144 + n);
        a0.x += bb.x; a0.y += bb.y; a0.z += bb.z; a0.w += bb.w; a1.x += bb.x; a1.y += bb.y; a1.z += bb.z; a1.w += bb.w;
        a2.x += bb.x; a2.y += bb.y; a2.z += bb.z; a2.w += bb.w; a3.x += bb.x; a3.y += bb.y; a3.z += bb.z; a3.w += bb.w;
        a4.x += bb.x; a4.y += bb.y; a4.z += bb.z; a4.w += bb.w;
    }
    float* o = mod + (size_t)(li * 5) * 6144 + n;
    atomicAdd(o + 0, a0.x); atomicAdd(o + 1, a0.y); atomicAdd(o + 2, a0.z); atomicAdd(o + 3, a0.w);
    atomicAdd(o + 6144 + 0, a1.x); atomicAdd(o + 6144 + 1, a1.y); atomicAdd(o + 6144 + 2, a1.z); atomicAdd(o + 6144 + 3, a1.w);
    atomicAdd(o + 2 * 6144 + 0, a2.x); atomicAdd(o + 2 * 6144 + 1, a2.y); atomicAdd(o + 2 * 6144 + 2, a2.z); atomicAdd(o + 2 * 6144 + 3, a2.w);
    atomicAdd(o + 3 * 6144 + 0, a3.x); atomicAdd(o + 3 * 6144 + 1, a3.y); atomicAdd(o + 3 * 6144 + 2, a3.z); atomicAdd(o + 3 * 6144 + 3, a3.w);
    atomicAdd(o + 4 * 6144 + 0, a4.x); atomicAdd(o + 4 * 6144 + 1, a4.y); atomicAdd(o + 4 * 6144 + 2, a4.z); atomicAdd(o + 4 * 6144 + 3, a4.w);
}

__device__ __forceinline__ void d_norm_mod(const int bx, const int by, const int bz, char* smem, const float* __restrict__ xa, const float* __restrict__ xb, const float* __restrict__ g,
                                                  const float* __restrict__ modl, int shift_idx, int scale_idx, bf16_t* __restrict__ h) {
    float* red = (float*)smem;
    const int t = bx;
    const float* x = (t < TP) ? (xa + (size_t)t * DM) : (xb + (size_t)(t - TP) * DM);
    const int c = threadIdx.x * 4;
    float4 v = *(const float4*)(x + c);
    float ss = v.x * v.x + v.y * v.y + v.z * v.z + v.w * v.w;
    ss = wave_sum(ss);
    if ((threadIdx.x & 63) == 0) red[threadIdx.x >> 6] = ss;
    __syncthreads();
    float tot = red[0] + red[1] + red[2] + red[3];
    float rstd = rsqrtf(tot * (1.f / DM) + 1e-6f);
    const float* m = modl + (size_t)tok_modrow(t) * 6144;
    float4 gg = *(const float4*)(g + c);
    float4 sh = *(const float4*)(m + shift_idx * 1024 + c);
    float4 sc = *(const float4*)(m + scale_idx * 1024 + c);
    float4 o;
    o.x = v.x * rstd * gg.x * (1.f + sc.x) + sh.x;
    o.y = v.y * rstd * gg.y * (1.f + sc.y) + sh.y;
    o.z = v.z * rstd * gg.z * (1.f + sc.z) + sh.z;
    o.w = v.w * rstd * gg.w * (1.f + sc.w) + sh.w;
    ushort4 ob; ob.x = f2bf(o.x); ob.y = f2bf(o.y); ob.z = f2bf(o.z); ob.w = f2bf(o.w);
    *(ushort4*)(h + (size_t)t * DM + c) = ob;
}

struct EpiStore { static constexpr bool kQuad = false; float* C; const float* bias; int ldc; int pad;
    __device__ void operator()(int m, int n, float a) const { C[(size_t)m * ldc + n] = a + (bias ? bias[n] : 0.f); } };
struct EpiStoreBf { static constexpr bool kQuad = false; bf16_t* C; int ldc; int pad;
    __device__ void operator()(int m, int n, float a) const { C[(size_t)m * ldc + n] = f2bf(a); } };
struct EpiDecay { static constexpr bool kQuad = false; _Float16* out; const float* w0;
    __device__ void operator()(int m, int n, float a) const { out[(size_t)m * 512 + n] = (_Float16)sigmoidf_(w0[n] + a); } };
struct EpiProj { static constexpr bool kQuad = false; bf16_t* rw; float* mla;
    __device__ void operator()(int m, int n, float a) const { if (n < RWIN) rw[(size_t)m * RWIN + n] = f2bf(a); else mla[(size_t)m * 448 + (n - RWIN)] = a; } };
struct EpiLr { static constexpr bool kQuad = false; bf16_t* out; const float* a0;
    __device__ void operator()(int m, int n, float a) const { out[(size_t)m * 512 + n] = f2bf(sigmoidf_(a0[n] + a)); } };
struct EpiResid { static constexpr bool kQuad = false; const float* xa; const float* xb; float* out; const float* modl; int gate_idx; int pad;
    __device__ void operator()(int m, int n, float a) const {
        float x = (m < TP) ? xa[(size_t)m * DM + n] : xb[(size_t)(m - TP) * DM + n];
        float gt = modl[(size_t)tok_modrow(m) * 6144 + gate_idx * 1024 + n];
        out[(size_t)m * DM + n] = x + gt * a; } };

struct EpiKV { static constexpr bool kQuad = true;
    bf16_t* kvraw; bf16_t* Vp; bf16_t* Vs; int ctx; int pad;
    __device__ void operator()(int m, int n, float a) const {}
    __device__ void quad(int row0, int col, float v0, float v1, float v2, float v3) const {
        const int hd = col >> 8, within = col & 255;
        if (within < 128) {
            bf16_t* d = kvraw + (size_t)row0 * 1024 + col;
            d[0] = f2bf(v0); d[1024] = f2bf(v1); d[2048] = f2bf(v2); d[3072] = f2bf(v3);
        } else {
            const int dv = within - 128;
            int b, kidx, Lk; bf16_t* base;
            if (ctx) { b = row0 >> 8; kidx = row0 & 255; Lk = 2304; base = Vs; }
            else if (row0 < TP) { b = row0 >> 8; kidx = row0 & 255; Lk = LP; base = Vp; }
            else { b = (row0 - TP) >> 11; kidx = 256 + ((row0 - TP) & 2047); Lk = 2304; base = Vs; }
            const int kpos = (kidx & ~12) | ((kidx & 8) >> 1) | ((kidx & 4) << 1);
            ushort4 o; o.x = f2bf(v0); o.y = f2bf(v1); o.z = f2bf(v2); o.w = f2bf(v3);
            *(ushort4*)(base + ((size_t)((b * 4 + hd) * 128 + dv)) * Lk + kpos) = o;
        }
    } };

template <class Epi>
__device__ __forceinline__ void d_gemm(const int bx, const int by, const int bz, char* smem, const float* __restrict__ A, int lda, const float* __restrict__ B, int ldb, int K, Epi epi) {
    float (*As)[68] = (float(*)[68])smem;
    float (*Bs)[68] = (float(*)[68])(smem + 16 * 68 * 4);
    const int m0 = by * 64, n0 = bx * 64;
    const int tid = threadIdx.x, tx = tid & 15, ty = tid >> 4;
    float acc[4][4];
#pragma unroll
    for (int i = 0; i < 4; i++)
#pragma unroll
        for (int j = 0; j < 4; j++) acc[i][j] = 0.f;
    for (int k0 = 0; k0 < K; k0 += 16) {
        {
            int r = tid >> 2, kq = (tid & 3) * 4;
            float4 v = *(const float4*)(A + (size_t)(m0 + r) * lda + k0 + kq);
            As[kq + 0][r] = v.x; As[kq + 1][r] = v.y; As[kq + 2][r] = v.z; As[kq + 3][r] = v.w;
        }
        {
            int kk = tid >> 4, nq = (tid & 15) * 4;
            float4 v = *(const float4*)(B + (size_t)(k0 + kk) * ldb + n0 + nq);
            *(float4*)&Bs[kk][nq] = v;
        }
        __syncthreads();
#pragma unroll
        for (int k = 0; k < 16; k++) {
            float a[4], b[4];
#pragma unroll
            for (int i = 0; i < 4; i++) a[i] = As[k][ty * 4 + i];
            float4 bv = *(const float4*)&Bs[k][tx * 4];
            b[0] = bv.x; b[1] = bv.y; b[2] = bv.z; b[3] = bv.w;
#pragma unroll
            for (int i = 0; i < 4; i++)
#pragma unroll
                for (int j = 0; j < 4; j++) acc[i][j] += a[i] * b[j];
        }
        __syncthreads();
    }
#pragma unroll
    for (int i = 0; i < 4; i++)
#pragma unroll
        for (int j = 0; j < 4; j++) epi(m0 + ty * 4 + i, n0 + tx * 4 + j, acc[i][j]);
}


typedef __attribute__((ext_vector_type(8))) short bf16x8;
typedef __attribute__((ext_vector_type(16))) float f32x16;
typedef __attribute__((ext_vector_type(4))) float f32x4;
typedef __attribute__((ext_vector_type(4))) unsigned u32x4;
#define GEMM_LDS_BYTES 73728

template <class Epi>
__device__ __forceinline__ void d_gemm_bf16(const int bx, const int by, char* smem, const bf16_t* __restrict__ A, int lda,
                                            const bf16_t* __restrict__ Bt, int ldb, int K, int N, Epi epi) {
    const int tid = threadIdx.x, lane = tid & 63, wid = tid >> 6;
    const int wm = wid >> 1, wn = wid & 1;
    const int m0 = by * 128, n0 = bx * 128;
    f32x16 acc[2][2];
#pragma unroll
    for (int i = 0; i < 2; i++)
#pragma unroll
        for (int j = 0; j < 2; j++)
#pragma unroll
            for (int r = 0; r < 16; r++) acc[i][j][r] = 0.f;
    const int lrow = tid >> 3, lcol = (tid & 7) * 8;
    const bf16_t* ga = A + (size_t)(m0 + lrow) * lda + lcol;
    const bf16_t* gb = Bt + (size_t)(n0 + lrow) * ldb + lcol;
    u32x4 ra[4], rb[4];
    const int KT = K >> 6;
#pragma unroll
    for (int i = 0; i < 4; i++) { ra[i] = *(const u32x4*)(ga + (size_t)(32 * i) * lda); rb[i] = *(const u32x4*)(gb + (size_t)(32 * i) * ldb); }
    {
        char* sa = smem;
#pragma unroll
        for (int i = 0; i < 4; i++) { *(u32x4*)(sa + (lrow + 32 * i) * 144 + lcol * 2) = ra[i]; *(u32x4*)(sa + 18432 + (lrow + 32 * i) * 144 + lcol * 2) = rb[i]; }
    }
    __syncthreads();
    const int frow = lane & 31, fk = (lane >> 5) * 16;
    for (int kt = 0; kt < KT; kt++) {
        if (kt + 1 < KT) {
#pragma unroll
            for (int i = 0; i < 4; i++) { ra[i] = *(const u32x4*)(ga + (size_t)(32 * i) * lda + (kt + 1) * 64); rb[i] = *(const u32x4*)(gb + (size_t)(32 * i) * ldb + (kt + 1) * 64); }
        }
        const char* sa = smem + (kt & 1) * 36864;
        const char* sb = sa + 18432;
#pragma unroll
        for (int ks = 0; ks < 4; ks++) {
            bf16x8 af[2], bfr[2];
#pragma unroll
            for (int i = 0; i < 2; i++) af[i] = *(const bf16x8*)(sa + (wm * 64 + i * 32 + frow) * 144 + ks * 32 + fk);
#pragma unroll
            for (int j = 0; j < 2; j++) bfr[j] = *(const bf16x8*)(sb + (wn * 64 + j * 32 + frow) * 144 + ks * 32 + fk);
#pragma unroll
            for (int i = 0; i < 2; i++)
#pragma unroll
                for (int j = 0; j < 2; j++) acc[i][j] = __builtin_amdgcn_mfma_f32_32x32x16_bf16(af[i], bfr[j], acc[i][j], 0, 0, 0);
        }
        if (kt + 1 < KT) {
            char* sn = smem + ((kt + 1) & 1) * 36864;
#pragma unroll
            for (int i = 0; i < 4; i++) { *(u32x4*)(sn + (lrow + 32 * i) * 144 + lcol * 2) = ra[i]; *(u32x4*)(sn + 18432 + (lrow + 32 * i) * 144 + lcol * 2) = rb[i]; }
        }
        __syncthreads();
    }
#pragma unroll
    for (int i = 0; i < 2; i++)
#pragma unroll
        for (int j = 0; j < 2; j++) {
            const int col = n0 + wn * 64 + j * 32 + (lane & 31);
            if (col < N) {
                if constexpr (Epi::kQuad) {
#pragma unroll
                    for (int g = 0; g < 4; g++) {
                        const int row0 = m0 + wm * 64 + i * 32 + 8 * g + 4 * (lane >> 5);
                        epi.quad(row0, col, acc[i][j][4 * g], acc[i][j][4 * g + 1], acc[i][j][4 * g + 2], acc[i][j][4 * g + 3]);
                    }
                } else {
#pragma unroll
                    for (int r = 0; r < 16; r++) {
                        const int row = m0 + wm * 64 + i * 32 + (r & 3) + 8 * (r >> 2) + 4 * (lane >> 5);
                        epi(row, col, acc[i][j][r]);
                    }
                }
            }
        }
}

__device__ __forceinline__ void d_transpose_w(const int vb, char* smem, const float* __restrict__ W, int K, int N, bf16_t* __restrict__ Wt) {
    float (*tile)[65] = (float(*)[65])smem;
    const int kt = K >> 6;
    const int nb = vb / kt, kb = vb % kt;
    const int tid = threadIdx.x;
    {
        const int n = nb * 64 + (tid & 63);
#pragma unroll
        for (int i = 0; i < 16; i++) {
            int k = (tid >> 6) + 4 * i;
            tile[k][tid & 63] = (n < N) ? W[(size_t)(kb * 64 + k) * N + n] : 0.f;
        }
    }
    __syncthreads();
    {
        const int k = tid & 63;
#pragma unroll
        for (int i = 0; i < 16; i++) {
            int n = (tid >> 6) + 4 * i;
            Wt[(size_t)(nb * 64 + n) * K + kb * 64 + k] = f2bf(tile[k][n]);
        }
    }
}

__device__ __forceinline__ void d_rw_shift(const int bx, const int by, const int bz, char* smem, const bf16_t* __restrict__ proj, const float* __restrict__ mu, bf16_t* __restrict__ rb,
                                                  bf16_t* __restrict__ kb, bf16_t* __restrict__ vb, bf16_t* __restrict__ tw, bf16_t* __restrict__ adv,
                                                  bf16_t* __restrict__ sg) {
    const int t = bx;
    const int pos = tok_pos(t), L = tok_len(t);
    const bf16_t* P = proj + (size_t)t * RWIN;
    for (int c = threadIdx.x; c < RWIN; c += 256) {
        float cur = bf2f(P[c]);
        float prev = (pos > 0) ? bf2f(P[c - RWIN]) : 0.f;
        float nxt = (pos < L - 1) ? bf2f(P[c + RWIN]) : 0.f;
        float val = cur + mu[c] * (0.5f * (prev + nxt) - cur);
        if (c < 512) rb[(size_t)t * 512 + c] = f2bf(val);
        else if (c < 1024) kb[(size_t)t * 512 + c - 512] = f2bf(val);
        else if (c < 1536) vb[(size_t)t * 512 + c - 1024] = f2bf(val);
        else if (c < 1600) tw[(size_t)t * 64 + c - 1536] = f2bf(tanhf(val));
        else if (c < 1664) adv[(size_t)t * 64 + c - 1600] = f2bf(val);
        else sg[(size_t)t * 128 + c - 1664] = f2bf(sigmoidf_(val));
    }
}

__device__ __forceinline__ void d_rw_kk(const int bx, const int by, const int bz, char* smem, const bf16_t* __restrict__ rb, const bf16_t* __restrict__ kb, const bf16_t* __restrict__ lr0,
                                               const bf16_t* __restrict__ lr1, const float* __restrict__ k_k, const float* __restrict__ k_a,
                                               const float* __restrict__ r_k, bf16_t* __restrict__ kkb, float* __restrict__ bonus) {
    const int w = bx * 4 + (threadIdx.x >> 6);
    const int lane = threadIdx.x & 63;
    const int t = w >> 3, h = w & 7;
    const size_t o = (size_t)t * 512 + h * 64 + lane;
    const int ch = h * 64 + lane;
    float k = bf2f(kb[o]), r = bf2f(rb[o]);
    float kk = k * k_k[ch];
    float nrm = sqrtf(wave_sum(kk * kk));
    kk = kk / fmaxf(nrm, 1e-12f);
    kkb[o] = f2bf(kk);
    float l0 = bf2f(lr0[o]), l1 = bf2f(lr1[o]);
    float ka = k_a[ch];
    float kd0 = k * (1.f + (l0 - 1.f) * ka), kd1 = k * (1.f + (l1 - 1.f) * ka);
    float s = wave_sum(r * (kd0 + kd1) * r_k[ch]);
    if (lane == 0) bonus[w] = s;
}

__device__ __forceinline__ void d_scan(const int bx, const int by, const int bz, char* smem, const bf16_t* __restrict__ rb, const bf16_t* __restrict__ kb, const bf16_t* __restrict__ vb,
                                             const bf16_t* __restrict__ kkb, const bf16_t* __restrict__ lr0, const bf16_t* __restrict__ lr1,
                                             const _Float16* __restrict__ dec0, const _Float16* __restrict__ dec1, const float* __restrict__ k_a,
                                             const float* __restrict__ st_f, const float* __restrict__ st_b, float* __restrict__ y0,
                                             float* __restrict__ y1, float* __restrict__ out_sf, float* __restrict__ out_sb) {
    float* sbase = (float*)smem + (threadIdx.x >> 6) * 320;
    float* sa_ = sbase; float* sw_ = sbase + 64; float* sb_ = sbase + 128; float* skd_ = sbase + 192; float* sr_ = sbase + 256;
    int id = bx * 4 + (threadIdx.x >> 6);
    int d, h, b, L, tbase;
    bool prompt = id < 256;
    if (prompt) { d = id & 1; h = (id >> 1) & 7; b = id >> 4; L = LP; tbase = b * LP; }
    else { int j = id - 256; d = j & 1; h = (j >> 1) & 7; b = j >> 4; L = LS; tbase = TP + b * LS; }
    const int v = threadIdx.x & 63;
    const bf16_t* lr = d ? lr1 : lr0;
    const _Float16* dec = d ? dec1 : dec0;
    float* yo = d ? y1 : y0;
    const float ka = k_a[h * 64 + v];
    float S[64];
    if (prompt) {
#pragma unroll
        for (int k = 0; k < 64; k++) S[k] = 0.f;
    } else {
        const float* st = (d ? st_b : st_f) + ((size_t)(b * 8 + h) * 64 + v) * 64;
#pragma unroll
        for (int k = 0; k < 64; k += 4) { float4 q = *(const float4*)(st + k); S[k] = q.x; S[k + 1] = q.y; S[k + 2] = q.z; S[k + 3] = q.w; }
    }
    for (int i = 0; i < L; i++) {
        const int t = tbase + (d ? (L - 1 - i) : i);
        const size_t o = (size_t)t * 512 + h * 64 + v;
        float kkv = bf2f(kkb[o]), lrv = bf2f(lr[o]), kv = bf2f(kb[o]), rv = bf2f(rb[o]), vv = bf2f(vb[o]), wv = __expf(-0.6065306597126334f * (float)dec[o]);
        __builtin_amdgcn_wave_barrier();
        sa_[v] = -kkv; sb_[v] = kkv * lrv; skd_[v] = kv * (1.f + (lrv - 1.f) * ka); sw_[v] = wv; sr_[v] = rv;
        __builtin_amdgcn_wave_barrier();
        float sa = 0.f;
#pragma unroll
        for (int k = 0; k < 64; k += 4) { float4 a = *(const float4*)&sa_[k]; sa += S[k] * a.x + S[k + 1] * a.y + S[k + 2] * a.z + S[k + 3] * a.w; }
        float y = 0.f;
#pragma unroll
        for (int k = 0; k < 64; k += 4) {
            float4 w4 = *(const float4*)&sw_[k]; float4 b4 = *(const float4*)&sb_[k]; float4 k4 = *(const float4*)&skd_[k]; float4 r4 = *(const float4*)&sr_[k];
            S[k] = S[k] * w4.x + sa * b4.x + vv * k4.x; y += S[k] * r4.x;
            S[k + 1] = S[k + 1] * w4.y + sa * b4.y + vv * k4.y; y += S[k + 1] * r4.y;
            S[k + 2] = S[k + 2] * w4.z + sa * b4.z + vv * k4.z; y += S[k + 2] * r4.z;
            S[k + 3] = S[k + 3] * w4.w + sa * b4.w + vv * k4.w; y += S[k + 3] * r4.w;
        }
        yo[o] = y;
    }
    if (prompt) {
        float* os = (d ? out_sb : out_sf) + ((size_t)(b * 8 + h) * 64 + v) * 64;
#pragma unroll
        for (int k = 0; k < 64; k += 4) *(float4*)(os + k) = make_float4(S[k], S[k + 1], S[k + 2], S[k + 3]);
    }
}


#define SC_STEP 336
template <int CTRL>
__device__ __forceinline__ float dpp_add(float v) {
    return v + __int_as_float(__builtin_amdgcn_update_dpp(0, __float_as_int(v), CTRL, 0xf, 0xf, false));
}
__device__ __forceinline__ float row16_allsum(float v) {
    v = dpp_add<0x128>(v); v = dpp_add<0x124>(v); v = dpp_add<0x122>(v); v = dpp_add<0x121>(v);
    return v;
}
__device__ __forceinline__ void d_scan2(const int item, const bool sample, char* smem, const bf16_t* __restrict__ rb, const bf16_t* __restrict__ kb,
                                        const bf16_t* __restrict__ vb, const bf16_t* __restrict__ kkb, const bf16_t* __restrict__ lr0,
                                        const bf16_t* __restrict__ lr1, const _Float16* __restrict__ du0, const _Float16* __restrict__ du1,
                                        const float* __restrict__ k_a, const float* __restrict__ st_f, const float* __restrict__ st_b,
                                        float* __restrict__ y0, float* __restrict__ y1, float* __restrict__ out_sf, float* __restrict__ out_sb) {
    const int chain = item >> 2, qd = item & 3;
    const int d = chain & 1, h = (chain >> 1) & 7, b = chain >> 4;
    const int L = sample ? LS : LP;
    const int tbase = sample ? (TP + b * LS) : (b * LP);
    const int tid = threadIdx.x, wid = tid >> 6, lane = tid & 63;
    const int rr = lane >> 4, pp = lane & 15;
    const int row = qd * 16 + wid * 4 + rr;
    const bf16_t* lr = d ? lr1 : lr0;
    const _Float16* du = d ? du1 : du0;
    float* yo = d ? y1 : y0;
    float S0, S1, S2, S3;
    if (sample) {
        const float4 s4 = *(const float4*)((d ? st_b : st_f) + ((size_t)(b * 8 + h) * 64 + row) * 64 + pp * 4);
        S0 = s4.x; S1 = s4.y; S2 = s4.z; S3 = s4.w;
    } else { S0 = S1 = S2 = S3 = 0.f; }
    const int sk = tid & 63, ss = tid >> 6;
    const float ka = k_a[h * 64 + sk];
    const size_t colk = (size_t)h * 64 + sk;
    const size_t colv = (size_t)h * 64 + qd * 16 + (tid & 15);
    float* buf = (float*)smem;
    unsigned gA_kk[4], gA_lr[4], gA_k[4], gA_r[4], gA_u[4], gA_v;
    unsigned gB_kk[4], gB_lr[4], gB_k[4], gB_r[4], gB_u[4], gB_v;
    const int nch = L >> 4;
#define SC_GLOAD(X, c)                                                                                     \
    {                                                                                                      \
        _Pragma("unroll") for (int j = 0; j < 4; j++) {                                                    \
            const int i = (c) * 16 + ss + 4 * j;                                                           \
            const size_t o = (size_t)(tbase + (d ? (L - 1 - i) : i)) * 512 + colk;                         \
            X##_kk[j] = kkb[o]; X##_lr[j] = lr[o]; X##_k[j] = kb[o]; X##_r[j] = rb[o]; X##_u[j] = ((const unsigned short*)du)[o]; \
        }                                                                                                  \
        { const int i = (c) * 16 + (tid >> 4); X##_v = vb[(size_t)(tbase + (d ? (L - 1 - i) : i)) * 512 + colv]; } \
    }
#define SC_SSTORE(X, bi)                                                                                   \
    {                                                                                                      \
        float* B_ = buf + (bi) * 16 * SC_STEP;                                                             \
        _Pragma("unroll") for (int j = 0; j < 4; j++) {                                                    \
            float* st_ = B_ + (ss + 4 * j) * SC_STEP + sk;                                                 \
            const float kkv = __uint_as_float(X##_kk[j] << 16), lrv = __uint_as_float(X##_lr[j] << 16), kv = __uint_as_float(X##_k[j] << 16); \
            st_[0] = -kkv; st_[64] = __expf(-0.6065306597126334f * (float)__builtin_bit_cast(_Float16, (unsigned short)X##_u[j])); st_[128] = kkv * lrv;   \
            st_[192] = kv * (1.f + (lrv - 1.f) * ka); st_[256] = __uint_as_float(X##_r[j] << 16);          \
        }                                                                                                  \
        B_[(tid >> 4) * SC_STEP + 320 + (tid & 15)] = __uint_as_float(X##_v << 16);                        \
    }
#define SC_COMPUTE(c)                                                                                      \
    {                                                                                                      \
        const float* B_ = buf + ((c) & 1) * 16 * SC_STEP;                                                  \
        float ysave = 0.f;                                                                                 \
        _Pragma("unroll 4") for (int s_ = 0; s_ < 16; s_++) {                                              \
            const float* st_ = B_ + s_ * SC_STEP;                                                          \
            const float4 a4 = *(const float4*)(st_ + pp * 4);                                              \
            const float4 w4 = *(const float4*)(st_ + 64 + pp * 4);                                         \
            const float4 b4 = *(const float4*)(st_ + 128 + pp * 4);                                        \
            const float4 k4 = *(const float4*)(st_ + 192 + pp * 4);                                        \
            const float4 r4 = *(const float4*)(st_ + 256 + pp * 4);                                        \
            const float vv = st_[320 + wid * 4 + rr];                                                      \
            float sa = (S0 * a4.x + S1 * a4.y) + (S2 * a4.z + S3 * a4.w);                                  \
            const float p0 = S0 * w4.x + vv * k4.x, p1 = S1 * w4.y + vv * k4.y, p2 = S2 * w4.z + vv * k4.z, p3 = S3 * w4.w + vv * k4.w; \
            sa = row16_allsum(sa);                                                                         \
            S0 = sa * b4.x + p0; S1 = sa * b4.y + p1; S2 = sa * b4.z + p2; S3 = sa * b4.w + p3;            \
            float y = (S0 * r4.x + S1 * r4.y) + (S2 * r4.z + S3 * r4.w);                                   \
            y = row16_allsum(y);                                                                           \
            ysave = (pp == s_) ? y : ysave;                                                                \
        }                                                                                                  \
        { const int i = (c) * 16 + pp; yo[(size_t)(tbase + (d ? (L - 1 - i) : i)) * 512 + h * 64 + row] = ysave; } \
    }
    SC_GLOAD(gA, 0)
    SC_SSTORE(gA, 0)
    if (nch > 1) SC_GLOAD(gA, 1)
    __syncthreads();
    for (int c = 0; c < nch; c += 2) {
        if (c + 2 < nch) SC_GLOAD(gB, c + 2)
        __builtin_amdgcn_sched_barrier(0);
        SC_COMPUTE(c)
        __builtin_amdgcn_sched_barrier(0);
        SC_SSTORE(gA, 1)
        __syncthreads();
        if (c + 3 < nch) SC_GLOAD(gA, c + 3)
        __builtin_amdgcn_sched_barrier(0);
        SC_COMPUTE(c + 1)
        __builtin_amdgcn_sched_barrier(0);
        if (c + 2 < nch) SC_SSTORE(gB, 0)
        __syncthreads();
    }
    if (!sample) {
        float* os = (d ? out_sb : out_sf) + ((size_t)(b * 8 + h) * 64 + row) * 64 + pp * 4;
        *(float4*)os = make_float4(S0, S1, S2, S3);
    }
}

__device__ __forceinline__ void d_rw_post(const int bx, const int by, const int bz, char* smem, const float* __restrict__ y0, const float* __restrict__ y1, const float* __restrict__ bonus,
                                                 const bf16_t* __restrict__ vb, const bf16_t* __restrict__ gate, const float* __restrict__ lnx_g,
                                                 const float* __restrict__ lnx_b, bf16_t* __restrict__ cat) {
    const int w = bx * 4 + (threadIdx.x >> 6);
    const int lane = threadIdx.x & 63;
    const int t = w >> 3, h = w & 7;
    const size_t o = (size_t)t * 512 + h * 64 + lane;
    const int ch = h * 64 + lane;
    float y = y0[o] + y1[o];
    float mean = wave_sum(y) * (1.f / 64.f);
    float dlt = y - mean;
    float var = wave_sum(dlt * dlt) * (1.f / 64.f);
    float yn = dlt * rsqrtf(var + 64e-5f) * lnx_g[ch] + lnx_b[ch];
    float val = (yn + bonus[w] * bf2f(vb[o])) * bf2f(gate[o]);
    cat[(size_t)t * DM + ch] = f2bf(val);
}

__device__ __forceinline__ void d_mla_pre(const int bx, const int by, const int bz, char* smem, const float* __restrict__ proj, const float* __restrict__ q_norm, const float* __restrict__ kv_norm,
                                                 bf16_t* __restrict__ qcn, bf16_t* __restrict__ ckv, float* __restrict__ kpe,
                                                 float* __restrict__ out_ckv, float* __restrict__ out_kpe) {
    float* red = (float*)smem; float* red2 = red + 4;
    const int t = bx;
    const int tid = threadIdx.x;
    const float* P = proj + (size_t)t * 448;
    float q = P[tid];
    float kv = (tid < 128) ? P[256 + tid] : 0.f;
    float ss = wave_sum(q * q);
    float s2 = wave_sum(kv * kv);
    if ((tid & 63) == 0) { red[tid >> 6] = ss; red2[tid >> 6] = s2; }
    __syncthreads();
    float rq = rsqrtf((red[0] + red[1] + red[2] + red[3]) * (1.f / 256.f) + 1e-6f);
    float rk = rsqrtf((red2[0] + red2[1] + red2[2] + red2[3]) * (1.f / 128.f) + 1e-6f);
    qcn[(size_t)t * 256 + tid] = f2bf(q * rq * q_norm[tid]);
    if (tid < 128) {
        float val = kv * rk * kv_norm[tid];
        ckv[(size_t)t * 128 + tid] = f2bf(val);
        if (t < TP) out_ckv[(size_t)t * 128 + tid] = val;
    } else if (tid < 192) {
        float pe = P[384 + tid - 128];
        kpe[(size_t)t * 64 + tid - 128] = pe;
        if (t < TP) out_kpe[(size_t)t * 64 + tid - 128] = pe;
    }
}

__device__ __forceinline__ void d_mla_post(const int bx, const int by, const int bz, char* smem, const bf16_t* __restrict__ qraw, const bf16_t* __restrict__ kvraw, const bf16_t* __restrict__ kvraw_ctx,
                                                  const float* __restrict__ kpe, const float* __restrict__ cache_kpe, const float* __restrict__ qn,
                                                  const float* __restrict__ kn, bf16_t* __restrict__ Qb, bf16_t* __restrict__ Kp, bf16_t* __restrict__ Vp,
                                                  bf16_t* __restrict__ Ks, bf16_t* __restrict__ Vs) {
    float (*sq)[192] = (float(*)[192])smem; float (*sk)[192] = (float(*)[192])(smem + 4 * 192 * 4);
    const int wi = threadIdx.x >> 6, lane = threadIdx.x & 63;
    const int row = bx, h = wi;
    const bool isctx = row >= TT;
    const bool sample = row >= TP;
    float kx[3], qx[3] = {0.f, 0.f, 0.f};
    const bf16_t* kvr; const float* pe; int pos = 0;
    if (isctx) { int cr = row - TT; kvr = kvraw_ctx + (size_t)cr * 1024; pe = cache_kpe + (size_t)cr * 64; }
    else { kvr = kvraw + (size_t)row * 1024; pe = kpe + (size_t)row * 64; pos = tok_pos(row); }
#pragma unroll
    for (int j = 0; j < 3; j++) {
        int i = lane + 64 * j;
        kx[j] = (i < 128) ? bf2f(kvr[h * 256 + i]) : pe[i - 128];
        if (!isctx) qx[j] = bf2f(qraw[(size_t)row * 768 + h * 192 + i]);
    }
    float ssk = wave_sum(kx[0] * kx[0] + kx[1] * kx[1] + kx[2] * kx[2]);
    float ssq = wave_sum(qx[0] * qx[0] + qx[1] * qx[1] + qx[2] * qx[2]);
    float rk = rsqrtf(ssk * (1.f / 192.f) + 1e-6f), rq = rsqrtf(ssq * (1.f / 192.f) + 1e-6f);
#pragma unroll
    for (int j = 0; j < 3; j++) {
        int i = lane + 64 * j;
        sk[wi][i] = kx[j] * rk * kn[i];
        sq[wi][i] = qx[j] * rq * qn[i];
    }
    __syncthreads();
    if (sample && !isctx && lane < 32) {
        int rowi = pos >> 6, coli = pos & 63;
        int fi = lane & 15;
        float inv = expf(-(float)fi * (1.f / 16.f) * 9.210340371976184f);
        float ang = (lane < 16 ? (float)rowi : (float)coli) * inv;
        float cs = cosf(ang), sn = sinf(ang);
        float a = sk[wi][128 + 2 * lane], bq = sk[wi][128 + 2 * lane + 1];
        sk[wi][128 + 2 * lane] = a * cs - bq * sn; sk[wi][128 + 2 * lane + 1] = a * sn + bq * cs;
        a = sq[wi][128 + 2 * lane]; bq = sq[wi][128 + 2 * lane + 1];
        sq[wi][128 + 2 * lane] = a * cs - bq * sn; sq[wi][128 + 2 * lane + 1] = a * sn + bq * cs;
    }
    __syncthreads();
    bf16_t* kd; bf16_t* vd; int vLk, kidx;
    if (!sample) { int b = row >> 8, p = row & 255; kd = Kp + ((size_t)(b * 4 + h) * LP + p) * 192; vd = Vp + (size_t)(b * 4 + h) * 128 * LP; vLk = LP; kidx = p; }
    else if (!isctx) { int b = (row - TP) >> 11, p = (row - TP) & 2047; kd = Ks + ((size_t)(b * 4 + h) * 2304 + 256 + p) * 192; vd = Vs + (size_t)(b * 4 + h) * 128 * 2304; vLk = 2304; kidx = 256 + p; }
    else { int cr = row - TT; int b = cr >> 8, p = cr & 255; kd = Ks + ((size_t)(b * 4 + h) * 2304 + p) * 192; vd = Vs + (size_t)(b * 4 + h) * 128 * 2304; vLk = 2304; kidx = p; }
    const int kpos = (kidx & ~12) | ((kidx & 8) >> 1) | ((kidx & 4) << 1);
#pragma unroll
    for (int j = 0; j < 3; j++) {
        int i = lane + 64 * j;
        kd[i] = f2bf(sk[wi][i]);
        if (!isctx) Qb[((size_t)row * 4 + h) * 192 + i] = f2bf(sq[wi][i]);
    }
    vd[(size_t)lane * vLk + kpos] = kvr[h * 256 + 128 + lane];
    vd[(size_t)(lane + 64) * vLk + kpos] = kvr[h * 256 + 128 + lane + 64];
}

__device__ __forceinline__ void d_attn(const int bx, const int by, const int bz, char* smem, const bf16_t* __restrict__ Qb, const bf16_t* __restrict__ Kall, const bf16_t* __restrict__ Vall,
                                              bf16_t* __restrict__ cat, int tbase, int Lq, int Lk) {
    float (*Vsm)[128] = (float(*)[128])smem;
    float (*Qs)[192] = (float(*)[192])(smem + 32 * 128 * 4);
    float (*Ksm)[193] = (float(*)[193])(smem + 32 * 128 * 4 + 16 * 192 * 4);
    float (*Ss)[33] = (float(*)[33])(smem + 32 * 128 * 4 + 16 * 192 * 4 + 32 * 193 * 4);
    const int q0 = bx * 16, h = by, b = bz;
    const int tid = threadIdx.x;
    const int qi = tid >> 4, sub = tid & 15;
    const bf16_t* K = Kall + (size_t)(b * 4 + h) * Lk * 192;
    const bf16_t* V = Vall + (size_t)(b * 4 + h) * Lk * 128;
    for (int i = tid; i < 16 * 192; i += 256) {
        int r = i / 192, c = i % 192;
        int t = tbase + b * Lq + q0 + r;
        Qs[r][c] = bf2f(Qb[((size_t)t * 4 + h) * 192 + c]);
    }
    float m = -1e30f, l = 0.f;
    float acc[8];
#pragma unroll
    for (int j = 0; j < 8; j++) acc[j] = 0.f;
    const float scale = 0.07216878364870322f;
    for (int k0 = 0; k0 < Lk; k0 += 32) {
        __syncthreads();
        for (int i = tid; i < 32 * 192; i += 256) { int r = i / 192, c = i % 192; Ksm[r][c] = bf2f(K[(size_t)(k0 + r) * 192 + c]); }
        for (int i = tid; i < 32 * 128; i += 256) { int r = i >> 7, c = i & 127; Vsm[r][c] = bf2f(V[(size_t)(k0 + r) * 128 + c]); }
        __syncthreads();
        float s0 = 0.f, s1 = 0.f;
        for (int dd = 0; dd < 192; dd++) { float qv = Qs[qi][dd]; s0 += qv * Ksm[sub][dd]; s1 += qv * Ksm[sub + 16][dd]; }
        s0 *= scale; s1 *= scale;
        float mx = fmaxf(s0, s1);
#pragma unroll
        for (int o = 8; o > 0; o >>= 1) mx = fmaxf(mx, __shfl_xor(mx, o, 64));
        float mn = fmaxf(m, mx);
        float alpha = expf(m - mn);
        float p0 = expf(s0 - mn), p1 = expf(s1 - mn);
        float ps = p0 + p1;
#pragma unroll
        for (int o = 8; o > 0; o >>= 1) ps += __shfl_xor(ps, o, 64);
        l = l * alpha + ps; m = mn;
        Ss[qi][sub] = p0; Ss[qi][sub + 16] = p1;
        __syncthreads();
#pragma unroll
        for (int j = 0; j < 8; j++) acc[j] *= alpha;
        for (int kk = 0; kk < 32; kk++) {
            float p = Ss[qi][kk];
            float4 v0 = *(const float4*)&Vsm[kk][sub * 8], v1 = *(const float4*)&Vsm[kk][sub * 8 + 4];
            acc[0] += p * v0.x; acc[1] += p * v0.y; acc[2] += p * v0.z; acc[3] += p * v0.w;
            acc[4] += p * v1.x; acc[5] += p * v1.y; acc[6] += p * v1.z; acc[7] += p * v1.w;
        }
    }
    const int t = tbase + b * Lq + q0 + qi;
    float il = 1.f / l;
    bf16_t* o = cat + (size_t)t * DM + 512 + h * 128 + sub * 8;
#pragma unroll
    for (int j = 0; j < 8; j++) o[j] = f2bf(acc[j] * il);
}


#define ATT_SV_OFF 25600
#define ATT_SQ_OFF 44032
__device__ __forceinline__ void d_attn_mfma(const int item, char* smem, const bf16_t* __restrict__ Qb, const bf16_t* __restrict__ Kall,
                                            const bf16_t* __restrict__ VtAll, bf16_t* __restrict__ cat, int tbase, int Lq, int Lk, int nqb) {
    const int qb = item % nqb, bh = item / nqb;
    const int b = bh >> 2, h = bh & 3;
    const int tid = threadIdx.x, lane = tid & 63, wid = tid >> 6;
    const int q = lane & 31, hh = lane >> 5;
    const int t = tbase + b * Lq + qb * 128 + wid * 32 + q;
    bf16x8 qf[12];
    {
        const bf16_t* qp = Qb + ((size_t)t * 4 + h) * 192 + hh * 8;
#pragma unroll
        for (int ks = 0; ks < 12; ks++) qf[ks] = *(const bf16x8*)(qp + ks * 16);
    }
    f32x16 o[4];
#pragma unroll
    for (int i = 0; i < 4; i++)
#pragma unroll
        for (int r = 0; r < 16; r++) o[i][r] = 0.f;
    float m = -1e30f, l = 0.f;
    const bf16_t* K = Kall + (size_t)bh * Lk * 192;
    const bf16_t* Vt = VtAll + (size_t)bh * 128 * Lk;
    char* sK = smem;
    char* sV = smem + ATT_SV_OFF;
    u32x4 pk[6], pv[4];
    const int nkt = Lk >> 6;
#pragma unroll
    for (int i = 0; i < 6; i++) pk[i] = *(const u32x4*)(K + (size_t)(tid + 256 * i) * 8);
#pragma unroll
    for (int i = 0; i < 4; i++) { int c = tid + 256 * i; pv[i] = *(const u32x4*)(Vt + (size_t)(c >> 3) * Lk + (c & 7) * 8); }
#pragma unroll
    for (int i = 0; i < 6; i++) { int c = tid + 256 * i; *(u32x4*)(sK + (c / 24) * 400 + (c % 24) * 16) = pk[i]; }
#pragma unroll
    for (int i = 0; i < 4; i++) { int c = tid + 256 * i; *(u32x4*)(sV + (c >> 3) * 144 + (c & 7) * 16) = pv[i]; }
    __syncthreads();
    const float sc2 = 0.07216878364870322f * 1.4426950408889634f;
    for (int kt = 0; kt < nkt; kt++) {
        f32x16 st[2];
#pragma unroll
        for (int bk = 0; bk < 2; bk++)
#pragma unroll
            for (int r = 0; r < 16; r++) st[bk][r] = 0.f;
#pragma unroll
        for (int ks = 0; ks < 12; ks++) {
            const bf16x8 qfk = qf[ks];
#pragma unroll
            for (int bk = 0; bk < 2; bk++) {
                bf16x8 a = *(const bf16x8*)(sK + (bk * 32 + q) * 400 + ks * 32 + hh * 16);
                st[bk] = __builtin_amdgcn_mfma_f32_32x32x16_bf16(a, qfk, st[bk], 0, 0, 0);
            }
        }
        float mx = -1e30f;
#pragma unroll
        for (int bk = 0; bk < 2; bk++)
#pragma unroll
            for (int r = 0; r < 16; r++) { st[bk][r] *= sc2; mx = fmaxf(mx, st[bk][r]); }
        mx = fmaxf(mx, __shfl_xor(mx, 32, 64));
        const float mn = fmaxf(m, mx);
        const float alpha = exp2f(m - mn);
        float ps = 0.f;
#pragma unroll
        for (int bk = 0; bk < 2; bk++)
#pragma unroll
            for (int r = 0; r < 16; r++) { st[bk][r] = exp2f(st[bk][r] - mn); ps += st[bk][r]; }
        ps += __shfl_xor(ps, 32, 64);
        l = l * alpha + ps; m = mn;
#pragma unroll
        for (int i = 0; i < 4; i++)
#pragma unroll
            for (int r = 0; r < 16; r++) o[i][r] *= alpha;
#pragma unroll
        for (int s4 = 0; s4 < 4; s4++) {
            bf16x8 pb;
#pragma unroll
            for (int j = 0; j < 8; j++) pb[j] = (short)f2bf(st[s4 >> 1][8 * (s4 & 1) + j]);
#pragma unroll
            for (int i = 0; i < 4; i++) {
                bf16x8 a = *(const bf16x8*)(sV + (i * 32 + q) * 144 + s4 * 32 + hh * 16);
                o[i] = __builtin_amdgcn_mfma_f32_32x32x16_bf16(a, pb, o[i], 0, 0, 0);
            }
        }
        __syncthreads();
        if (kt + 1 < nkt) {
            const bf16_t* Kn = K + (size_t)(kt + 1) * 64 * 192;
            const bf16_t* Vn = Vt + (kt + 1) * 64;
#pragma unroll
            for (int i = 0; i < 6; i++) pk[i] = *(const u32x4*)(Kn + (size_t)(tid + 256 * i) * 8);
#pragma unroll
            for (int i = 0; i < 4; i++) { int c = tid + 256 * i; pv[i] = *(const u32x4*)(Vn + (size_t)(c >> 3) * Lk + (c & 7) * 8); }
#pragma unroll
            for (int i = 0; i < 6; i++) { int c = tid + 256 * i; *(u32x4*)(sK + (c / 24) * 400 + (c % 24) * 16) = pk[i]; }
#pragma unroll
            for (int i = 0; i < 4; i++) { int c = tid + 256 * i; *(u32x4*)(sV + (c >> 3) * 144 + (c & 7) * 16) = pv[i]; }
        }
        __syncthreads();
    }
    const float il = 1.f / l;
    bf16_t* op = cat + (size_t)t * DM + 512 + h * 128;
#pragma unroll
    for (int i = 0; i < 4; i++)
#pragma unroll
        for (int g = 0; g < 4; g++) {
            ushort4 w;
            w.x = f2bf(o[i][4 * g + 0] * il); w.y = f2bf(o[i][4 * g + 1] * il); w.z = f2bf(o[i][4 * g + 2] * il); w.w = f2bf(o[i][4 * g + 3] * il);
            *(ushort4*)(op + i * 32 + 8 * g + 4 * hh) = w;
        }
}

__device__ __forceinline__ void d_peer_route(const int bx, const int by, const int bz, char* smem, const float* __restrict__ qp, const float* __restrict__ keys  ,
                                                    int* __restrict__ pidx, float* __restrict__ pg) {
    float (*sq)[256] = (float(*)[256])smem;
    float (*sc)[256] = (float(*)[256])(smem + 4096);
    float (*tv)[32] = (float(*)[32])(smem + 8192);
    int (*ti)[32] = (int(*)[32])(smem + 8192 + 512);
    float (*topv)[16] = (float(*)[16])(smem + 8192 + 1024);
    int (*topi)[16] = (int(*)[16])(smem + 8192 + 1024 + 256);
    const int wi = threadIdx.x >> 6, lane = threadIdx.x & 63;
    const int w = bx * 4 + wi;
    const int t = w >> 3, h = w & 7;
    const float* q = qp + (size_t)t * 2048 + h * 256;
#pragma unroll
    for (int j = 0; j < 4; j++) sq[wi][lane + 64 * j] = q[lane + 64 * j];
    __syncthreads();
#pragma unroll
    for (int p = 0; p < 2; p++)
#pragma unroll
        for (int half = 0; half < 2; half++) {
            int n = lane + 64 * half;
            const float* kr = keys + ((size_t)(h * 2 + p) * 128 + n) * 128;
            float s = 0.f;
            for (int dd = 0; dd < 128; dd += 4) {
                float4 kv = *(const float4*)(kr + dd);
                s += sq[wi][p * 128 + dd] * kv.x + sq[wi][p * 128 + dd + 1] * kv.y + sq[wi][p * 128 + dd + 2] * kv.z + sq[wi][p * 128 + dd + 3] * kv.w;
            }
            sc[wi][p * 128 + n] = s;
        }
    __syncthreads();
#pragma unroll
    for (int p = 0; p < 2; p++)
#pragma unroll
        for (int half = 0; half < 2; half++) {
            int n = lane + 64 * half;
            float s = sc[wi][p * 128 + n];
            int rank = 0;
            for (int j = 0; j < 128; j++) { float o = sc[wi][p * 128 + j]; rank += (o > s || (o == s && j < n)) ? 1 : 0; }
            if (rank < 16) { tv[wi][p * 16 + rank] = s; ti[wi][p * 16 + rank] = n; }
        }
    __syncthreads();
    float cv[4];
#pragma unroll
    for (int j = 0; j < 4; j++) { int c = lane + 64 * j; cv[j] = tv[wi][c >> 4] + tv[wi][16 + (c & 15)]; }
    __syncthreads();
#pragma unroll
    for (int j = 0; j < 4; j++) sc[wi][lane + 64 * j] = cv[j];
    __syncthreads();
#pragma unroll
    for (int j = 0; j < 4; j++) {
        int c = lane + 64 * j;
        float s = cv[j];
        int rank = 0;
        for (int i = 0; i < 256; i++) { float o = sc[wi][i]; rank += (o > s || (o == s && i < c)) ? 1 : 0; }
        if (rank < 16) { topv[wi][rank] = s; topi[wi][rank] = (ti[wi][c >> 4] * 128 + ti[wi][16 + (c & 15)]) & 16383; }
    }
    __syncthreads();
    if (lane < 16) {
        float mx = topv[wi][0];
        float sum = 0.f;
        for (int i = 0; i < 16; i++) sum += expf(topv[wi][i] - mx);
        pg[(size_t)w * 16 + lane] = expf(topv[wi][lane] - mx) / sum;
        pidx[(size_t)w * 16 + lane] = topi[wi][lane] & 16383;
    }
}

__device__ __forceinline__ void d_peer_apply(const int bx, const int by, const int bz, char* smem, const bf16_t* __restrict__ hbuf, const int* __restrict__ pidx, const float* __restrict__ pg,
                                                    const float* __restrict__ utab, const float* __restrict__ vtab, const float* __restrict__ modl,
                                                    float* __restrict__ xrun) {
    float* coef = (float*)smem; int* eid = (int*)(smem + 512);
    const int t = bx, tid = threadIdx.x, wi = tid >> 6, lane = tid & 63;
    if (tid < 128) eid[tid] = pidx[(size_t)t * 128 + tid];
    float4 xv[4];
#pragma unroll
    for (int j = 0; j < 4; j++) { ushort4 q = *(const ushort4*)(hbuf + (size_t)t * DM + j * 256 + lane * 4); xv[j] = make_float4(bf2f(q.x), bf2f(q.y), bf2f(q.z), bf2f(q.w)); }
    __syncthreads();
    for (int e = wi * 32; e < wi * 32 + 32; e++) {
        const float* ur = utab + (size_t)eid[e] * DM;
        float s = 0.f;
#pragma unroll
        for (int j = 0; j < 4; j++) { float4 u = *(const float4*)(ur + j * 256 + lane * 4); s += u.x * xv[j].x + u.y * xv[j].y + u.z * xv[j].z + u.w * xv[j].w; }
        s = wave_sum(s);
        if (lane == 0) coef[e] = pg[(size_t)t * 128 + e] * gelu_tanh(s);
    }
    __syncthreads();
    float4 acc = make_float4(0.f, 0.f, 0.f, 0.f);
    for (int e = 0; e < 128; e++) {
        float cf = coef[e];
        float4 v = *(const float4*)(vtab + (size_t)eid[e] * DM + tid * 4);
        acc.x += cf * v.x; acc.y += cf * v.y; acc.z += cf * v.z; acc.w += cf * v.w;
    }
    const float* m = modl + (size_t)tok_modrow(t) * 6144 + 5 * 1024 + tid * 4;
    float* xo = xrun + (size_t)t * DM + tid * 4;
    float4 x = *(float4*)xo;
    x.x += m[0] * acc.x; x.y += m[1] * acc.y; x.z += m[2] * acc.z; x.w += m[3] * acc.w;
    *(float4*)xo = x;
}


template <int K, int J>
__device__ __forceinline__ void bit_stage16(float (&x)[16]) {
#pragma unroll
    for (int i = 0; i < 16; i++) {
        const int l = i ^ J;
        if (l > i) {
            const bool desc = ((i & K) == 0);
            const float a = x[i], b = x[l];
            const float hi = fmaxf(a, b), lo = fminf(a, b);
            x[i] = desc ? hi : lo; x[l] = desc ? lo : hi;
        }
    }
}
__device__ __forceinline__ void bit_sort16_desc(float (&x)[16]) {
    bit_stage16<2, 1>(x);
    bit_stage16<4, 2>(x); bit_stage16<4, 1>(x);
    bit_stage16<8, 4>(x); bit_stage16<8, 2>(x); bit_stage16<8, 1>(x);
    bit_stage16<16, 8>(x); bit_stage16<16, 4>(x); bit_stage16<16, 2>(x); bit_stage16<16, 1>(x);
}
__device__ __forceinline__ void bit_merge16_desc(float (&x)[16]) {
    bit_stage16<16, 8>(x); bit_stage16<16, 4>(x); bit_stage16<16, 2>(x); bit_stage16<16, 1>(x);
}
template <int K, int J>
__device__ __forceinline__ void bit_stage16u(unsigned (&x)[16]) {
#pragma unroll
    for (int i = 0; i < 16; i++) {
        const int l = i ^ J;
        if (l > i) {
            const bool asc = ((i & K) == 0);
            const unsigned a = x[i], b = x[l];
            const unsigned lo = a < b ? a : b, hi = a < b ? b : a;
            x[i] = asc ? lo : hi; x[l] = asc ? hi : lo;
        }
    }
}
__device__ __forceinline__ void bit_sort16u_asc(unsigned (&x)[16]) {
    bit_stage16u<2, 1>(x);
    bit_stage16u<4, 2>(x); bit_stage16u<4, 1>(x);
    bit_stage16u<8, 4>(x); bit_stage16u<8, 2>(x); bit_stage16u<8, 1>(x);
    bit_stage16u<16, 8>(x); bit_stage16u<16, 4>(x); bit_stage16u<16, 2>(x); bit_stage16u<16, 1>(x);
}
__device__ __forceinline__ void bit_merge16u_asc(unsigned (&x)[16]) {
    bit_stage16u<16, 8>(x); bit_stage16u<16, 4>(x); bit_stage16u<16, 2>(x); bit_stage16u<16, 1>(x);
}
__device__ __forceinline__ void top16_merge(float (&L)[16], const float (&C)[16]) {
#pragma unroll
    for (int i = 0; i < 16; i++) L[i] = fmaxf(L[i], C[15 - i]);
    bit_merge16_desc(L);
}
__device__ __forceinline__ void low16_merge_u(unsigned (&L)[16], const unsigned (&C)[16]) {
#pragma unroll
    for (int i = 0; i < 16; i++) { const unsigned c = C[15 - i]; L[i] = L[i] < c ? L[i] : c; }
    bit_merge16u_asc(L);
}
__device__ __forceinline__ float key_val(float k) { return __uint_as_float(__float_as_uint(k) & ~127u); }
__device__ __forceinline__ int key_idx(float k) { return (int)(__float_as_uint(k) & 127u); }

__device__ __forceinline__ void d_peer_select(const int vb, const float* __restrict__ scT, int* __restrict__ pidx, float* __restrict__ pg) {
    const int h = vb & 7;
    const int t = (vb >> 3) * 256 + threadIdx.x;
    float A[16], B[16];
#pragma unroll
    for (int p = 0; p < 2; p++) {
        const float* S = scT + (size_t)(h * 2 + p) * 128 * TT + t;
        float L[16];
#pragma unroll
        for (int ch = 0; ch < 8; ch++) {
            float C[16];
#pragma unroll
            for (int i = 0; i < 16; i++) {
                const int n = ch * 16 + i;
                C[i] = __uint_as_float((__float_as_uint(S[(size_t)n * TT]) & ~127u) | (unsigned)n);
            }
            bit_sort16_desc(C);
            if (ch == 0) {
#pragma unroll
                for (int i = 0; i < 16; i++) L[i] = C[i];
            } else top16_merge(L, C);
        }
#pragma unroll
        for (int i = 0; i < 16; i++) { if (p == 0) A[i] = L[i]; else B[i] = L[i]; }
    }
    const float smax = key_val(A[0]) + key_val(B[0]);
    unsigned Tk[16];
#pragma unroll
    for (int g = 0; g < 4; g++) {
        unsigned Ck[16];
#pragma unroll
        for (int e = 0; e < 16; e++) {
            const int c = g * 16 + e;
            int i, j;
            if (c < 16) { i = 0; j = c; }
            else if (c < 24) { i = 1; j = c - 16; }
            else if (c < 29) { i = 2; j = c - 24; }
            else if (c < 33) { i = 3; j = c - 29; }
            else if (c < 36) { i = 4; j = c - 33; }
            else if (c < 42) { i = 5 + (c - 36) / 2; j = (c - 36) % 2; }
            else if (c < 50) { i = 8 + (c - 42); j = 0; }
            else { i = -1; j = 0; }
            if (i >= 0) {
                const float dd = smax - (key_val(A[i]) + key_val(B[j]));
                unsigned qd = (unsigned)fminf(dd * 32768.f, 262143.f);
                Ck[e] = (qd << 14) | (unsigned)(key_idx(A[i]) * 128 + key_idx(B[j]));
            } else Ck[e] = 0xffffffffu;
        }
        bit_sort16u_asc(Ck);
        if (g == 0) {
#pragma unroll
            for (int e = 0; e < 16; e++) Tk[e] = Ck[e];
        } else low16_merge_u(Tk, Ck);
    }
    float sum = 0.f;
    float w[16]; int Tp[16];
#pragma unroll
    for (int e = 0; e < 16; e++) { w[e] = __expf(-(float)(Tk[e] >> 14) * (1.f / 32768.f)); sum += w[e]; Tp[e] = (int)(Tk[e] & 16383u); }
    const float inv = 1.f / sum;
    int* pi = pidx + ((size_t)t * 8 + h) * 16;
    float* pw = pg + ((size_t)t * 8 + h) * 16;
#pragma unroll
    for (int e = 0; e < 16; e += 4) {
        *(int4*)(pi + e) = make_int4(Tp[e], Tp[e + 1], Tp[e + 2], Tp[e + 3]);
        *(float4*)(pw + e) = make_float4(w[e] * inv, w[e + 1] * inv, w[e + 2] * inv, w[e + 3] * inv);
    }
}

typedef __attribute__((ext_vector_type(2))) short bf16x2;
__device__ __forceinline__ float dot8_bf16(u32x4 a, u32x4 b, float acc) {
#pragma unroll
    for (int i = 0; i < 4; i++) {
        const unsigned x = a[i], y = b[i];
        acc += __uint_as_float(x << 16) * __uint_as_float(y << 16);
        acc += __uint_as_float(x & 0xffff0000u) * __uint_as_float(y & 0xffff0000u);
    }
    return acc;
}
__device__ __forceinline__ void d_peer_apply2(const int vb, char* smem, const bf16_t* __restrict__ hb, const int* __restrict__ pidx,
                                              const float* __restrict__ pg, const bf16_t* __restrict__ utab, const bf16_t* __restrict__ vtab,
                                              const float* __restrict__ modl, float* __restrict__ xrun) {
    const int wid = threadIdx.x >> 6, lane = threadIdx.x & 63;
    const int t = vb * 4 + wid;
    float* coef = (float*)smem + wid * 128;
    int* eid = (int*)(smem + 2048) + wid * 128;
    eid[lane] = pidx[(size_t)t * 128 + lane]; eid[lane + 64] = pidx[(size_t)t * 128 + lane + 64];
    const float g0 = pg[(size_t)t * 128 + lane], g1 = pg[(size_t)t * 128 + lane + 64];
    const u32x4 x0 = *(const u32x4*)(hb + (size_t)t * DM + lane * 8);
    const u32x4 x1 = *(const u32x4*)(hb + (size_t)t * DM + 512 + lane * 8);
    __builtin_amdgcn_wave_barrier();
    float myact0 = 0.f, myact1 = 0.f;
    for (int eb = 0; eb < 128; eb += 8) {
        u32x4 ua[8], ub[8];
#pragma unroll
        for (int r = 0; r < 8; r++) {
            const bf16_t* ur = utab + (size_t)eid[eb + r] * DM;
            ua[r] = *(const u32x4*)(ur + lane * 8);
            ub[r] = *(const u32x4*)(ur + 512 + lane * 8);
        }
#pragma unroll
        for (int r = 0; r < 8; r++) {
            float sacc = dot8_bf16(ua[r], x0, 0.f);
            sacc = dot8_bf16(ub[r], x1, sacc);
            sacc = wave_sum(sacc);
            const int e = eb + r;
            if (lane == (e & 63)) { if (e < 64) myact0 = sacc; else myact1 = sacc; }
        }
    }
    coef[lane] = g0 * gelu_tanh(myact0);
    coef[lane + 64] = g1 * gelu_tanh(myact1);
    __builtin_amdgcn_wave_barrier();
    float acc[16];
#pragma unroll
    for (int i = 0; i < 16; i++) acc[i] = 0.f;
    for (int eb = 0; eb < 128; eb += 8) {
        u32x4 va[8], vbq[8];
#pragma unroll
        for (int r = 0; r < 8; r++) {
            const bf16_t* vr = vtab + (size_t)eid[eb + r] * DM;
            va[r] = *(const u32x4*)(vr + lane * 8);
            vbq[r] = *(const u32x4*)(vr + 512 + lane * 8);
        }
#pragma unroll
        for (int r = 0; r < 8; r++) {
            const float cf = coef[eb + r];
#pragma unroll
            for (int i = 0; i < 4; i++) {
                acc[2 * i] += cf * __uint_as_float(va[r][i] << 16);
                acc[2 * i + 1] += cf * __uint_as_float(va[r][i] & 0xffff0000u);
                acc[8 + 2 * i] += cf * __uint_as_float(vbq[r][i] << 16);
                acc[8 + 2 * i + 1] += cf * __uint_as_float(vbq[r][i] & 0xffff0000u);
            }
        }
    }
    const float* m = modl + (size_t)tok_modrow(t) * 6144 + 5 * 1024;
    float* xo = xrun + (size_t)t * DM;
#pragma unroll
    for (int hlf = 0; hlf < 2; hlf++) {
        const int c0 = hlf * 512 + lane * 8;
        float4 xa = *(float4*)(xo + c0), xb2 = *(float4*)(xo + c0 + 4);
        const float4 ma = *(const float4*)(m + c0), mb = *(const float4*)(m + c0 + 4);
        xa.x += ma.x * acc[hlf * 8 + 0]; xa.y += ma.y * acc[hlf * 8 + 1]; xa.z += ma.z * acc[hlf * 8 + 2]; xa.w += ma.w * acc[hlf * 8 + 3];
        xb2.x += mb.x * acc[hlf * 8 + 4]; xb2.y += mb.y * acc[hlf * 8 + 5]; xb2.z += mb.z * acc[hlf * 8 + 6]; xb2.w += mb.w * acc[hlf * 8 + 7];
        *(float4*)(xo + c0) = xa; *(float4*)(xo + c0 + 4) = xb2;
    }
}
__device__ __forceinline__ void d_cvt_bf16(const int vb, const float* __restrict__ src, bf16_t* __restrict__ dst) {
    const size_t base = (size_t)vb * 16384 + threadIdx.x * 4;
#pragma unroll
    for (int i = 0; i < 16; i++) {
        const float4 v = *(const float4*)(src + base + i * 1024);
        ushort4 o; o.x = f2bf(v.x); o.y = f2bf(v.y); o.z = f2bf(v.z); o.w = f2bf(v.w);
        *(ushort4*)(dst + base + i * 1024) = o;
    }
}

__device__ __forceinline__ void d_hy_dw(const int bx, const int by, const int bz, char* smem, const float* __restrict__ pre, const float* __restrict__ cw, const float* __restrict__ cb,
                                               bf16_t* __restrict__ zin, bf16_t* __restrict__ x0) {
    const int t = bx;
    const int pos = tok_pos(t), L = tok_len(t);
    const float* P = pre + (size_t)t * 3072;
    for (int c = threadIdx.x; c < 1024; c += 256) {
        float u[3];
#pragma unroll
        for (int part = 0; part < 3; part++) {
            int cc = part * 1024 + c;
            float cur = P[cc];
            float prev = (pos > 0) ? P[cc - 3072] : 0.f;
            float nxt = (pos < L - 1) ? P[cc + 3072] : 0.f;
            u[part] = prev * cw[cc] + cur * cw[3072 + cc] + nxt * cw[2 * 3072 + cc] + cb[cc];
        }
        x0[(size_t)t * DM + c] = f2bf(u[0]);
        zin[(size_t)t * DM + c] = f2bf(u[1] * u[2]);
    }
}

__device__ __forceinline__ void d_hy_filt(const int bx, const int by, const int bz, char* smem, int L, const float* __restrict__ w1, const float* __restrict__ b1, const float* __restrict__ w2,
                                                 const float* __restrict__ b2, const float* __restrict__ w3, const float* __restrict__ fr,
                                                 float* __restrict__ hf, float* __restrict__ hb) {
    float* z = (float*)smem; float* h1 = z + 64; float* h2 = z + 128;
    const int t = bx, tid = threadIdx.x;
    const float tu = (float)t / (float)(L - 1);
    if (tid == 0) z[0] = tu;
    if (tid >= 1 && tid < 17) {
        int i = tid - 1;
        float band = 1e-4f + (float)i * ((15.f - 1e-4f) / 15.f);
        float ang = 6.283185307179586f * (float)t * band / (float)L;
        z[1 + i] = cosf(ang); z[17 + i] = -sinf(ang);
    }
    __syncthreads();
    if (tid < 64) { float s = b1[tid]; for (int i = 0; i < 33; i++) s += z[i] * w1[i * 64 + tid]; h1[tid] = sinf(fr[tid] * s); }
    __syncthreads();
    if (tid < 64) { float s = b2[tid]; for (int i = 0; i < 64; i++) s += h1[i] * w2[i * 64 + tid]; h2[tid] = sinf(fr[tid] * s); }
    __syncthreads();
    for (int c = tid; c < 2048; c += 256) {
        float s = 0.f;
        for (int i = 0; i < 64; i++) s += h2[i] * w3[i * 2048 + c];
        int ch = c & 1023;
        float d0 = -4.605170185988091f / 0.3f, d1 = -4.605170185988091f / 1.5f;
        float delta = d0 + (d1 - d0) * ((float)ch / 1023.f);
        float win = expf(-tu * fabsf(delta));
        float val = s * win;
        if (c < 1024) hf[(size_t)t * 1024 + ch] = val; else hb[(size_t)t * 1024 + ch] = val;
    }
}
__device__ __forceinline__ void d_hy_norm(const int bx, const int by, const int bz, char* smem, int L, const float* __restrict__ hf, const float* __restrict__ hb, float* __restrict__ inv) {
    const int c = bx * 256 + threadIdx.x;
    float s = 0.f;
    for (int t = 0; t < L; t++) { s += fabsf(hf[(size_t)t * 1024 + c]); if (t > 0) s += fabsf(hb[(size_t)t * 1024 + c]); }
    inv[c] = 1.f / s;
}
__device__ __forceinline__ void d_hy_conv(const int bx, const int by, const int bz, char* smem, int L, int tbase, const bf16_t* __restrict__ zin, const bf16_t* __restrict__ x0, const float* __restrict__ hf,
                                                 const float* __restrict__ hb, const float* __restrict__ inv, const float* __restrict__ bias,
                                                 bf16_t* __restrict__ zb) {
    const int c = bx * 256 + threadIdx.x;
    const int t0 = by * 8, b = bz;
    const bf16_t* Z = zin + (size_t)(tbase + b * L) * DM + c;
    float acc[8];
#pragma unroll
    for (int i = 0; i < 8; i++) acc[i] = 0.f;
    for (int s = 0; s < L; s++) {
        float z = bf2f(Z[(size_t)s * DM]);
#pragma unroll
        for (int i = 0; i < 8; i++) {
            int j = t0 + i - s;
            float g = (j >= 0) ? hf[(size_t)j * 1024 + c] : hb[(size_t)(-j) * 1024 + c];
            acc[i] += z * g;
        }
    }
    float iv = inv[c], bs = bias[c];
#pragma unroll
    for (int i = 0; i < 8; i++) {
        size_t o = (size_t)(tbase + b * L + t0 + i) * DM + c;
        float zz = bf2f(zin[o]);
        zb[o] = f2bf(bf2f(x0[o]) * (acc[i] * iv + zz * bs));
    }
}


__device__ __forceinline__ void d_hy_filt2(const int vbl8, char* smem, const int L, const float* __restrict__ w1, const float* __restrict__ b1,
                                           const float* __restrict__ w2, const float* __restrict__ b2, const float* __restrict__ w3,
                                           const float* __restrict__ fr, bf16_t* __restrict__ gT, float* __restrict__ nsum) {
    float* zp = (float*)smem;
    float* h1 = zp + 32 * 33;
    float* h2t = h1 + 32 * 64;
    float* sw1 = h2t + 64 * 32;
    float* sw2 = sw1 + 33 * 64;
    const int tid = threadIdx.x;
    const int vbl = vbl8 >> 3, mm = vbl8 & 7;
    const int t0 = vbl * 32;
    for (int e = tid; e < 33 * 64; e += 256) sw1[e] = w1[e];
    for (int e = tid; e < 64 * 64; e += 256) sw2[e] = w2[e];
    for (int e = tid; e < 32 * 33; e += 256) {
        const int pos = e / 33, i = e % 33;
        const float t = (float)(t0 + pos);
        float val;
        if (i == 0) val = t / (float)(L - 1);
        else {
            const int bi = (i <= 16) ? (i - 1) : (i - 17);
            const float band = 1e-4f + (float)bi * ((15.f - 1e-4f) / 15.f);
            const float ang = 6.283185307179586f * t * band / (float)L;
            val = (i <= 16) ? __cosf(ang) : -__sinf(ang);
        }
        zp[e] = val;
    }
    const int c = tid + 256 * mm;
    float wv[8];
#pragma unroll
    for (int jj = 0; jj < 8; jj++) wv[jj] = w3[jj * 2048 + c];
    __syncthreads();
    {
        const int j = tid & 63;
        const float frj = fr[j];
#pragma unroll 1
        for (int i = 0; i < 8; i++) {
            const int pos = (tid >> 6) + 4 * i;
            float sacc = b1[j];
#pragma unroll 3
            for (int q = 0; q < 33; q++) sacc += zp[pos * 33 + q] * sw1[q * 64 + j];
            h1[pos * 64 + j] = __sinf(frj * sacc);
        }
        __syncthreads();
#pragma unroll 1
        for (int i = 0; i < 8; i++) {
            const int pos = (tid >> 6) + 4 * i;
            float sacc = b2[j];
#pragma unroll 4
            for (int q = 0; q < 64; q++) sacc += h1[pos * 64 + q] * sw2[q * 64 + j];
            h2t[j * 32 + pos] = __sinf(frj * sacc);
        }
    }
    __syncthreads();
    {
        float acc[32];
#pragma unroll
        for (int i = 0; i < 32; i++) acc[i] = 0.f;
#pragma unroll 1
        for (int jb = 0; jb < 64; jb += 8) {
            float wn[8];
            if (jb + 8 < 64) {
#pragma unroll
                for (int jj = 0; jj < 8; jj++) wn[jj] = w3[(jb + 8 + jj) * 2048 + c];
            }
#pragma unroll
            for (int jj = 0; jj < 8; jj++) {
                const float w = wv[jj];
#pragma unroll
                for (int i = 0; i < 8; i++) {
                    const float4 hv = *(const float4*)(h2t + (jb + jj) * 32 + i * 4);
                    acc[4 * i] += hv.x * w; acc[4 * i + 1] += hv.y * w; acc[4 * i + 2] += hv.z * w; acc[4 * i + 3] += hv.w * w;
                }
                __builtin_amdgcn_sched_barrier(0);
            }
            if (jb + 8 < 64) {
#pragma unroll
                for (int jj = 0; jj < 8; jj++) wv[jj] = wn[jj];
            }
        }
        const int ch = c & 1023;
        const float d0 = -4.605170185988091f / 0.3f, d1 = -4.605170185988091f / 1.5f;
        const float adelta = fabsf(d0 + (d1 - d0) * ((float)ch / 1023.f));
        float absum = 0.f;
        bf16_t* g = gT + (size_t)ch * 2 * L;
#pragma unroll
        for (int i = 0; i < 32; i++) {
            const int t = t0 + i;
            const float tu = (float)t / (float)(L - 1);
            const float val = acc[i] * __expf(-tu * adelta);
            if (c < 1024) { absum += fabsf(val); g[L - t] = f2bf(val); }
            else if (t >= 1) { absum += fabsf(val); g[L + t] = f2bf(val); }
            if ((i & 3) == 3) __builtin_amdgcn_sched_barrier(0);
        }
        atomicAdd(nsum + ch, absum);
    }
}

__device__ __forceinline__ void d_hy_dw2(const int vb, char* smem, const float* __restrict__ pre, const float* __restrict__ cw,
                                         const float* __restrict__ cb, bf16_t* __restrict__ zT, bf16_t* __restrict__ x0b) {
    bf16_t* tile = (bf16_t*)smem;
    const int tt = vb >> 4, ct = vb & 15;
    const int tid = threadIdx.x;
    const int cc = tid & 63, c = ct * 64 + cc;
    const int tq = tid >> 6;
    float w0[3], w1[3], w2[3], bb[3];
#pragma unroll
    for (int part = 0; part < 3; part++) {
        const int col = part * 1024 + c;
        w0[part] = cw[col]; w1[part] = cw[3072 + col]; w2[part] = cw[2 * 3072 + col]; bb[part] = cb[col];
    }
    const int tok0 = tt * 64 + tq * 16;
    float prev[3], cur[3], nxt[3];
    {
        const int pos = tok_pos(tok0);
#pragma unroll
        for (int part = 0; part < 3; part++) {
            const float* P = pre + (size_t)tok0 * 3072 + part * 1024 + c;
            prev[part] = (pos > 0) ? P[-3072] : 0.f;
            cur[part] = P[0];
        }
    }
#pragma unroll 4
    for (int i = 0; i < 16; i++) {
        const int tok = tok0 + i;
        const int pos = tok_pos(tok), L = tok_len(tok);
        float u[3];
#pragma unroll
        for (int part = 0; part < 3; part++) {
            const float* P = pre + (size_t)tok * 3072 + part * 1024 + c;
            nxt[part] = (pos < L - 1) ? P[3072] : 0.f;
            u[part] = prev[part] * w0[part] + cur[part] * w1[part] + nxt[part] * w2[part] + bb[part];
            prev[part] = cur[part]; cur[part] = nxt[part];
        }
        x0b[(size_t)tok * DM + c] = f2bf(u[0]);
        tile[cc * 72 + tq * 16 + i] = f2bf(u[1] * u[2]);
    }
    __syncthreads();
    {
        const int cch = tid >> 2, q4 = tid & 3;
        const u32x4 a = *(const u32x4*)(tile + cch * 72 + q4 * 16);
        const u32x4 b2 = *(const u32x4*)(tile + cch * 72 + q4 * 16 + 8);
        bf16_t* dst = zT + (size_t)(ct * 64 + cch) * TT + tt * 64 + q4 * 16;
        *(u32x4*)dst = a; *(u32x4*)(dst + 8) = b2;
    }
}

template <bool SAMPLE>
__device__ __forceinline__ void d_hy_conv2(const int c, const int half, char* wsm, const bf16_t* __restrict__ gTall, const float* __restrict__ nsum,
                                           const bf16_t* __restrict__ zT, const float* __restrict__ bias, bf16_t* __restrict__ yT) {
    constexpr int L = SAMPLE ? LS : LP;
    constexpr int NB = L / 32;
    constexpr int NBATCH = SAMPLE ? 4 : 16;
    constexpr int BSH = SAMPLE ? 2 : 4;
    constexpr int TPB = 32 >> BSH;
    constexpr int NCB = NB / TPB;
    constexpr int HCB = NCB / 2;
    constexpr int PADB = SAMPLE ? 8 : 2;
    constexpr int ZLEN = L + 2 * PADB * 32;
    constexpr int tbase = SAMPLE ? TP : 0;
    const int lane = threadIdx.x & 63;
    const int l2 = half * 64 + lane;
    const int lc = lane & 31, hh = lane >> 5;
    const int b = lc & (NBATCH - 1), Tl = lc >> BSH;
    bf16_t* R = (bf16_t*)wsm;
    bf16_t* Z = R + 2 * L;
    {
        const u32x4* src = (const u32x4*)(gTall + (size_t)c * 2 * L);
        for (int i = l2; i < 2 * L / 8; i += 128) ((u32x4*)R)[i] = src[i];
        const u32x4 zero = {0u, 0u, 0u, 0u};
#pragma unroll 1
        for (int b2 = 0; b2 < NBATCH; b2++) {
            const u32x4* zs = (const u32x4*)(zT + (size_t)c * TT + tbase + b2 * L);
            u32x4* zd = (u32x4*)(Z + b2 * ZLEN);
            for (int i = l2; i < PADB * 4; i += 128) { zd[i] = zero; zd[PADB * 4 + L / 8 + i] = zero; }
            for (int i = l2; i < L / 8; i += 128) zd[PADB * 4 + i] = zs[i];
        }
    }
    __syncthreads();
    f32x16 acc[HCB];
#pragma unroll
    for (int cb = 0; cb < HCB; cb++)
#pragma unroll
        for (int r = 0; r < 16; r++) acc[cb][r] = 0.f;
    const bf16_t* Zb = Z + b * ZLEN + PADB * 32 + 8 * hh;
    const int cb0 = half * HCB;
    const int Dlo = TPB * cb0 - (NB - 1), Dhi = TPB * (cb0 + HCB - 1) + TPB - 1;
#pragma unroll 1
    for (int D = (Dlo < -(NB - 1) ? -(NB - 1) : Dlo); D <= (Dhi > NB - 1 ? NB - 1 : Dhi); D++) {
        bf16x8 af[2];
#pragma unroll
        for (int ks = 0; ks < 2; ks++) {
            const bf16_t* rp = R + (L - 32 * D - lc + 16 * ks + 8 * hh);
#pragma unroll
            for (int j = 0; j < 8; j++) af[ks][j] = (short)rp[j];
        }
#pragma unroll
        for (int lcb = 0; lcb < HCB; lcb++) {
            const int cb = cb0 + lcb;
            if (D >= TPB * cb - (NB - 1) && D <= TPB * cb + TPB - 1) {
                const int S = TPB * cb + Tl - D;
#pragma unroll
                for (int ks = 0; ks < 2; ks++) {
                    const bf16x8 bfr = *(const bf16x8*)(Zb + 32 * S + 16 * ks);
                    acc[lcb] = __builtin_amdgcn_mfma_f32_32x32x16_bf16(af[ks], bfr, acc[lcb], 0, 0, 0);
                }
            }
        }
    }
    const float inv = 1.f / nsum[c], bs = bias[c];
    bf16_t* yrow = yT + (size_t)c * TT + tbase + b * L;
    const bf16_t* zrow = Z + b * ZLEN + PADB * 32;
#pragma unroll
    for (int lcb = 0; lcb < HCB; lcb++)
#pragma unroll
        for (int g = 0; g < 4; g++) {
            const int t = 32 * (TPB * (cb0 + lcb) + Tl) + 8 * g + 4 * hh;
            ushort4 o;
            o.x = f2bf(acc[lcb][4 * g + 0] * inv + bf2f(zrow[t + 0]) * bs);
            o.y = f2bf(acc[lcb][4 * g + 1] * inv + bf2f(zrow[t + 1]) * bs);
            o.z = f2bf(acc[lcb][4 * g + 2] * inv + bf2f(zrow[t + 2]) * bs);
            o.w = f2bf(acc[lcb][4 * g + 3] * inv + bf2f(zrow[t + 3]) * bs);
            *(ushort4*)(yrow + t) = o;
        }
}

__device__ __forceinline__ void d_hy_post(const int vb, char* smem, const bf16_t* __restrict__ yT, const bf16_t* __restrict__ x0b, bf16_t* __restrict__ zb) {
    bf16_t* tile = (bf16_t*)smem;
    const int tt = vb >> 4, ct = vb & 15;
    const int tid = threadIdx.x;
    {
        const int cch = tid >> 2, q4 = tid & 3;
        const bf16_t* src = yT + (size_t)(ct * 64 + cch) * TT + tt * 64 + q4 * 16;
        *(u32x4*)(tile + cch * 72 + q4 * 16) = *(const u32x4*)src;
        *(u32x4*)(tile + cch * 72 + q4 * 16 + 8) = *(const u32x4*)(src + 8);
    }
    __syncthreads();
    const int cc = tid & 63, tq = tid >> 6;
#pragma unroll 4
    for (int i = 0; i < 16; i++) {
        const size_t o = (size_t)(tt * 64 + tq * 16 + i) * DM + ct * 64 + cc;
        zb[o] = f2bf(bf2f(x0b[o]) * bf2f(tile[cc * 72 + tq * 16 + i]));
    }
}


__device__ __forceinline__ float wave_allsum_fast(float v) {
    v = row16_allsum(v);
    const float r0 = __int_as_float(__builtin_amdgcn_readlane(__float_as_int(v), 0));
    const float r1 = __int_as_float(__builtin_amdgcn_readlane(__float_as_int(v), 16));
    const float r2 = __int_as_float(__builtin_amdgcn_readlane(__float_as_int(v), 32));
    const float r3 = __int_as_float(__builtin_amdgcn_readlane(__float_as_int(v), 48));
    return (r0 + r1) + (r2 + r3);
}
__device__ __forceinline__ ushort4 pack_bf4(float a, float b, float c, float d) { ushort4 o; o.x = f2bf(a); o.y = f2bf(b); o.z = f2bf(c); o.w = f2bf(d); return o; }

__device__ __forceinline__ void d_norm_mod2(const int vb, const float* __restrict__ xa, const float* __restrict__ xb, const float* __restrict__ g,
                                            const float* __restrict__ modl, const int shift_idx, const int scale_idx, bf16_t* __restrict__ h) {
    const int wid = threadIdx.x >> 6, lane = threadIdx.x & 63;
    const int t0 = vb * 8 + wid * 2;
    float4 v[2][4];
#pragma unroll
    for (int u = 0; u < 2; u++) {
        const int t = t0 + u;
        const float* x = (t < TP) ? (xa + (size_t)t * DM) : (xb + (size_t)(t - TP) * DM);
#pragma unroll
        for (int j = 0; j < 4; j++) v[u][j] = *(const float4*)(x + j * 256 + lane * 4);
    }
#pragma unroll
    for (int u = 0; u < 2; u++) {
        const int t = t0 + u;
        float ss = 0.f;
#pragma unroll
        for (int j = 0; j < 4; j++) ss += v[u][j].x * v[u][j].x + v[u][j].y * v[u][j].y + v[u][j].z * v[u][j].z + v[u][j].w * v[u][j].w;
        ss = wave_allsum_fast(ss);
        const float rstd = rsqrtf(ss * (1.f / DM) + 1e-6f);
        const float* m = modl + (size_t)tok_modrow(t) * 6144;
#pragma unroll
        for (int j = 0; j < 4; j++) {
            const int c = j * 256 + lane * 4;
            const float4 gg = *(const float4*)(g + c);
            const float4 sh = *(const float4*)(m + shift_idx * 1024 + c);
            const float4 sc = *(const float4*)(m + scale_idx * 1024 + c);
            *(ushort4*)(h + (size_t)t * DM + c) = pack_bf4(v[u][j].x * rstd * gg.x * (1.f + sc.x) + sh.x, v[u][j].y * rstd * gg.y * (1.f + sc.y) + sh.y,
                                                           v[u][j].z * rstd * gg.z * (1.f + sc.z) + sh.z, v[u][j].w * rstd * gg.w * (1.f + sc.w) + sh.w);
        }
    }
}

__device__ __forceinline__ void d_rw_shift2(const int vb, const bf16_t* __restrict__ proj, const float* __restrict__ mu, bf16_t* __restrict__ rb,
                                            bf16_t* __restrict__ kb, bf16_t* __restrict__ vbuf, bf16_t* __restrict__ tw, bf16_t* __restrict__ adv,
                                            bf16_t* __restrict__ sg) {
#pragma unroll
    for (int u = 0; u < 4; u++) {
        const int id = vb * 1024 + u * 256 + threadIdx.x;
        const int t = id / 224, c = (id % 224) * 8;
        const int pos = tok_pos(t), L = tok_len(t);
        const bf16_t* P = proj + (size_t)t * RWIN + c;
        const u32x4 cur = *(const u32x4*)P;
        u32x4 prv = {0u, 0u, 0u, 0u}, nxt = {0u, 0u, 0u, 0u};
        if (pos > 0) prv = *(const u32x4*)(P - RWIN);
        if (pos < L - 1) nxt = *(const u32x4*)(P + RWIN);
        const float4 m0 = *(const float4*)(mu + c), m1 = *(const float4*)(mu + c + 4);
        const float mm[8] = {m0.x, m0.y, m0.z, m0.w, m1.x, m1.y, m1.z, m1.w};
        float val[8];
#pragma unroll
        for (int i = 0; i < 4; i++) {
            const float c0 = __uint_as_float(cur[i] << 16), c1 = __uint_as_float(cur[i] & 0xffff0000u);
            const float p0 = __uint_as_float(prv[i] << 16), p1 = __uint_as_float(prv[i] & 0xffff0000u);
            const float n0 = __uint_as_float(nxt[i] << 16), n1 = __uint_as_float(nxt[i] & 0xffff0000u);
            val[2 * i] = c0 + mm[2 * i] * (0.5f * (p0 + n0) - c0);
            val[2 * i + 1] = c1 + mm[2 * i + 1] * (0.5f * (p1 + n1) - c1);
        }
        bf16_t* dst;
        if (c < 512) dst = rb + (size_t)t * 512 + c;
        else if (c < 1024) dst = kb + (size_t)t * 512 + (c - 512);
        else if (c < 1536) dst = vbuf + (size_t)t * 512 + (c - 1024);
        else if (c < 1600) { dst = tw + (size_t)t * 64 + (c - 1536);
#pragma unroll
            for (int i = 0; i < 8; i++) val[i] = tanhf(val[i]); }
        else if (c < 1664) dst = adv + (size_t)t * 64 + (c - 1600);
        else { dst = sg + (size_t)t * 128 + (c - 1664);
#pragma unroll
            for (int i = 0; i < 8; i++) val[i] = sigmoidf_(val[i]); }
        u32x4 o;
#pragma unroll
        for (int i = 0; i < 4; i++) o[i] = (unsigned)f2bf(val[2 * i]) | ((unsigned)f2bf(val[2 * i + 1]) << 16);
        *(u32x4*)dst = o;
    }
}

__device__ __forceinline__ void d_mla_pre2(const int vb, const float* __restrict__ proj, const float* __restrict__ q_norm, const float* __restrict__ kv_norm,
                                           bf16_t* __restrict__ qcn, bf16_t* __restrict__ ckv, float* __restrict__ kpe, float* __restrict__ out_ckv,
                                           float* __restrict__ out_kpe) {
    const int t = vb * 16 + (threadIdx.x >> 4), l16 = threadIdx.x & 15;
    const float* P = proj + (size_t)t * 448;
    float4 x[7];
#pragma unroll
    for (int j = 0; j < 7; j++) x[j] = *(const float4*)(P + 4 * (l16 + 16 * j));
    float sq = 0.f, sk = 0.f;
#pragma unroll
    for (int j = 0; j < 4; j++) sq += x[j].x * x[j].x + x[j].y * x[j].y + x[j].z * x[j].z + x[j].w * x[j].w;
#pragma unroll
    for (int j = 4; j < 6; j++) sk += x[j].x * x[j].x + x[j].y * x[j].y + x[j].z * x[j].z + x[j].w * x[j].w;
    sq = row16_allsum(sq); sk = row16_allsum(sk);
    const float rq = rsqrtf(sq * (1.f / 256.f) + 1e-6f), rk = rsqrtf(sk * (1.f / 128.f) + 1e-6f);
#pragma unroll
    for (int j = 0; j < 4; j++) {
        const int c = 4 * (l16 + 16 * j);
        const float4 w = *(const float4*)(q_norm + c);
        *(ushort4*)(qcn + (size_t)t * 256 + c) = pack_bf4(x[j].x * rq * w.x, x[j].y * rq * w.y, x[j].z * rq * w.z, x[j].w * rq * w.w);
    }
#pragma unroll
    for (int j = 4; j < 6; j++) {
        const int c = 4 * (l16 + 16 * (j - 4));
        const float4 w = *(const float4*)(kv_norm + c);
        const float4 o = make_float4(x[j].x * rk * w.x, x[j].y * rk * w.y, x[j].z * rk * w.z, x[j].w * rk * w.w);
        *(ushort4*)(ckv + (size_t)t * 128 + c) = pack_bf4(o.x, o.y, o.z, o.w);
        if (t < TP) *(float4*)(out_ckv + (size_t)t * 128 + c) = o;
    }
    {
        const int c = 4 * l16;
        *(float4*)(kpe + (size_t)t * 64 + c) = x[6];
        if (t < TP) *(float4*)(out_kpe + (size_t)t * 64 + c) = x[6];
    }
}

__device__ __forceinline__ void d_rw_kk2(const int vb, char* smem, const bf16_t* __restrict__ rb, const bf16_t* __restrict__ kb,
                                         const bf16_t* __restrict__ lr0, const bf16_t* __restrict__ lr1, const float* __restrict__ k_k,
                                         const float* __restrict__ k_a, const float* __restrict__ r_k, bf16_t* __restrict__ kkb, float* __restrict__ bonus) {
    float* pk = (float*)smem;
    for (int i = threadIdx.x; i < 512; i += 256) { pk[i] = k_k[i]; pk[512 + i] = k_a[i]; pk[1024 + i] = r_k[i]; }
    __syncthreads();
    const int w = vb * 256 + threadIdx.x;
    const int h = w & 7;
    const size_t o = (size_t)w * 64;
    u32x4 kq[8];
#pragma unroll
    for (int i = 0; i < 8; i++) kq[i] = *(const u32x4*)(kb + o + i * 8);
    const float* kkp = pk + h * 64; const float* kap = pk + 512 + h * 64; const float* rkp = pk + 1024 + h * 64;
    float ss = 0.f;
#pragma unroll
    for (int i = 0; i < 8; i++)
#pragma unroll
        for (int j = 0; j < 4; j++) {
            const float a = __uint_as_float(kq[i][j] << 16) * kkp[i * 8 + 2 * j], b = __uint_as_float(kq[i][j] & 0xffff0000u) * kkp[i * 8 + 2 * j + 1];
            ss += a * a + b * b;
        }
    const float inv = 1.f / fmaxf(sqrtf(ss), 1e-12f);
    float bs = 0.f;
#pragma unroll 2
    for (int i = 0; i < 8; i++) {
        const u32x4 kq2 = *(const u32x4*)(kb + o + i * 8);
        const u32x4 rq = *(const u32x4*)(rb + o + i * 8);
        const u32x4 l0 = *(const u32x4*)(lr0 + o + i * 8);
        const u32x4 l1 = *(const u32x4*)(lr1 + o + i * 8);
        u32x4 ok;
#pragma unroll
        for (int j = 0; j < 4; j++) {
            const int e0 = i * 8 + 2 * j, e1 = e0 + 1;
            const float k0 = __uint_as_float(kq2[j] << 16), k1 = __uint_as_float(kq2[j] & 0xffff0000u);
            const float r0 = __uint_as_float(rq[j] << 16), r1 = __uint_as_float(rq[j] & 0xffff0000u);
            const float a0 = __uint_as_float(l0[j] << 16), a1 = __uint_as_float(l0[j] & 0xffff0000u);
            const float b0 = __uint_as_float(l1[j] << 16), b1 = __uint_as_float(l1[j] & 0xffff0000u);
            bs += r0 * k0 * (2.f + (a0 + b0 - 2.f) * kap[e0]) * rkp[e0] + r1 * k1 * (2.f + (a1 + b1 - 2.f) * kap[e1]) * rkp[e1];
            ok[j] = (unsigned)f2bf(k0 * kkp[e0] * inv) | ((unsigned)f2bf(k1 * kkp[e1] * inv) << 16);
        }
        *(u32x4*)(kkb + o + i * 8) = ok;
    }
    bonus[w] = bs;
}

__device__ __forceinline__ void d_mla_post2(const int vb, const bf16_t* __restrict__ qraw, const bf16_t* __restrict__ kvraw, const bf16_t* __restrict__ kvraw_ctx,
                                            const float* __restrict__ kpe, const float* __restrict__ cache_kpe, const float* __restrict__ qn,
                                            const float* __restrict__ kn, bf16_t* __restrict__ Qb, bf16_t* __restrict__ Kp, bf16_t* __restrict__ Ks) {
    const int item = vb * 16 + (threadIdx.x >> 4), l16 = threadIdx.x & 15;
    const int row = item >> 2, h = item & 3;
    const bool isctx = row >= TT, sample = row >= TP;
    const int e0 = 12 * l16;
    const bf16_t* kvr; const float* pe; int pos = 0;
    if (isctx) { const int cr = row - TT; kvr = kvraw_ctx + (size_t)cr * 1024; pe = cache_kpe + (size_t)cr * 64; }
    else { kvr = kvraw + (size_t)row * 1024; pe = kpe + (size_t)row * 64; pos = tok_pos(row); }
    float kx[12], qx[12];
#pragma unroll
    for (int j = 0; j < 12; j++) {
        const int e = e0 + j;
        kx[j] = (e < 128) ? bf2f(kvr[h * 256 + (e < 128 ? e : 0)]) : pe[(e >= 128 ? e - 128 : 0)];
        qx[j] = isctx ? 0.f : bf2f(qraw[(size_t)row * 768 + h * 192 + e]);
    }
    float sk = 0.f, sq = 0.f;
#pragma unroll
    for (int j = 0; j < 12; j++) { sk += kx[j] * kx[j]; sq += qx[j] * qx[j]; }
    sk = row16_allsum(sk); sq = row16_allsum(sq);
    const float rk = rsqrtf(sk * (1.f / 192.f) + 1e-6f), rq = rsqrtf(sq * (1.f / 192.f) + 1e-6f);
#pragma unroll
    for (int j = 0; j < 12; j++) { kx[j] *= rk * kn[e0 + j]; qx[j] *= rq * qn[e0 + j]; }
    if (sample && !isctx) {
        const float rowf = (float)(pos >> 6), colf = (float)(pos & 63);
#pragma unroll
        for (int j = 0; j < 12; j += 2) {
            const int e = e0 + j;
            if (e >= 128) {
                const int pi = (e - 128) >> 1;
                const float inv = expf(-(float)(pi & 15) * (1.f / 16.f) * 9.210340371976184f);
                const float ang = (pi < 16 ? rowf : colf) * inv;
                const float cs = __cosf(ang), sn = __sinf(ang);
                const float a = kx[j], bq = kx[j + 1];
                kx[j] = a * cs - bq * sn; kx[j + 1] = a * sn + bq * cs;
                const float a2 = qx[j], b2 = qx[j + 1];
                qx[j] = a2 * cs - b2 * sn; qx[j + 1] = a2 * sn + b2 * cs;
            }
        }
    }
    bf16_t* kd;
    if (!sample) { const int b = row >> 8, pp = row & 255; kd = Kp + ((size_t)(b * 4 + h) * LP + pp) * 192; }
    else if (!isctx) { const int b = (row - TP) >> 11, pp = (row - TP) & 2047; kd = Ks + ((size_t)(b * 4 + h) * 2304 + 256 + pp) * 192; }
    else { const int cr = row - TT; const int b = cr >> 8, pp = cr & 255; kd = Ks + ((size_t)(b * 4 + h) * 2304 + pp) * 192; }
#pragma unroll
    for (int j = 0; j < 12; j += 4) {
        *(ushort4*)(kd + e0 + j) = pack_bf4(kx[j], kx[j + 1], kx[j + 2], kx[j + 3]);
        if (!isctx) *(ushort4*)(Qb + ((size_t)row * 4 + h) * 192 + e0 + j) = pack_bf4(qx[j], qx[j + 1], qx[j + 2], qx[j + 3]);
    }
}

__device__ __forceinline__ void d_rw_post2(const int vb, char* smem, const float* __restrict__ y0, const float* __restrict__ y1, const float* __restrict__ bonus,
                                           const bf16_t* __restrict__ vbuf, const bf16_t* __restrict__ gate, const float* __restrict__ lnx_g,
                                           const float* __restrict__ lnx_b, bf16_t* __restrict__ cat) {
    float* pg = (float*)smem;
    for (int i = threadIdx.x; i < 512; i += 256) { pg[i] = lnx_g[i]; pg[512 + i] = lnx_b[i]; }
    __syncthreads();
    const int w = vb * 256 + threadIdx.x;
    const int t = w >> 3, h = w & 7;
    const size_t o = (size_t)w * 64;
    float s1 = 0.f, s2 = 0.f;
#pragma unroll 4
    for (int i = 0; i < 16; i++) {
        const float4 a = *(const float4*)(y0 + o + i * 4), b = *(const float4*)(y1 + o + i * 4);
        const float e0 = a.x + b.x, e1 = a.y + b.y, e2 = a.z + b.z, e3 = a.w + b.w;
        s1 += (e0 + e1) + (e2 + e3);
        s2 += (e0 * e0 + e1 * e1) + (e2 * e2 + e3 * e3);
    }
    const float mean = s1 * (1.f / 64.f);
    const float var = fmaxf(s2 * (1.f / 64.f) - mean * mean, 0.f);
    const float rstd = rsqrtf(var + 64e-5f);
    const float bn = bonus[w];
    const float* gp = pg + h * 64; const float* bp = pg + 512 + h * 64;
#pragma unroll 2
    for (int i = 0; i < 8; i++) {
        const float4 ya = *(const float4*)(y0 + o + i * 8), yb = *(const float4*)(y1 + o + i * 8);
        const float4 yc = *(const float4*)(y0 + o + i * 8 + 4), yd = *(const float4*)(y1 + o + i * 8 + 4);
        const float yy[8] = {ya.x + yb.x, ya.y + yb.y, ya.z + yb.z, ya.w + yb.w, yc.x + yd.x, yc.y + yd.y, yc.z + yd.z, yc.w + yd.w};
        const u32x4 vq = *(const u32x4*)(vbuf + o + i * 8);
        const u32x4 gq = *(const u32x4*)(gate + o + i * 8);
        u32x4 oq;
#pragma unroll
        for (int j = 0; j < 4; j++) {
            const int e0 = i * 8 + 2 * j, e1 = e0 + 1;
            const float v0 = __uint_as_float(vq[j] << 16), v1 = __uint_as_float(vq[j] & 0xffff0000u);
            const float g0 = __uint_as_float(gq[j] << 16), g1 = __uint_as_float(gq[j] & 0xffff0000u);
            const float r0 = ((yy[2 * j] - mean) * rstd * gp[e0] + bp[e0] + bn * v0) * g0;
            const float r1 = ((yy[2 * j + 1] - mean) * rstd * gp[e1] + bp[e1] + bn * v1) * g1;
            oq[j] = (unsigned)f2bf(r0) | ((unsigned)f2bf(r1) << 16);
        }
        *(u32x4*)(cat + (size_t)t * DM + h * 64 + i * 8) = oq;
    }
}


typedef float f32x2 __attribute__((ext_vector_type(2)));
template <int CTRL>
__device__ __forceinline__ float dpp_max(float v) {
    return fmaxf(v, __int_as_float(__builtin_amdgcn_update_dpp(0, __float_as_int(v), CTRL, 0xf, 0xf, false)));
}
__device__ __forceinline__ float wave_allmax_fast(float v) {
    v = dpp_max<0x128>(v); v = dpp_max<0x124>(v); v = dpp_max<0x122>(v); v = dpp_max<0x121>(v);
    const float r0 = __int_as_float(__builtin_amdgcn_readlane(__float_as_int(v), 0));
    const float r1 = __int_as_float(__builtin_amdgcn_readlane(__float_as_int(v), 16));
    const float r2 = __int_as_float(__builtin_amdgcn_readlane(__float_as_int(v), 32));
    const float r3 = __int_as_float(__builtin_amdgcn_readlane(__float_as_int(v), 48));
    return fmaxf(fmaxf(r0, r1), fmaxf(r2, r3));
}
__device__ __forceinline__ void d_cvt_fp8_rows(const int vb, const float* __restrict__ src, unsigned char* __restrict__ dst, float* __restrict__ rscale) {
    const int wid = threadIdx.x >> 6, lane = threadIdx.x & 63;
    float4 x[4][4];
#pragma unroll
    for (int u = 0; u < 4; u++) {
        const float* r = src + (size_t)(vb * 16 + wid * 4 + u) * 1024 + lane * 16;
#pragma unroll
        for (int j = 0; j < 4; j++) x[u][j] = *(const float4*)(r + 4 * j);
    }
#pragma unroll
    for (int u = 0; u < 4; u++) {
        const int row = vb * 16 + wid * 4 + u;
        float am = 0.f;
#pragma unroll
        for (int j = 0; j < 4; j++) am = fmaxf(am, fmaxf(fmaxf(fabsf(x[u][j].x), fabsf(x[u][j].y)), fmaxf(fabsf(x[u][j].z), fabsf(x[u][j].w))));
        am = wave_allmax_fast(am);
        const float sc = am > 0.f ? 448.f / am : 1.f;
        u32x4 q;
#pragma unroll
        for (int j = 0; j < 4; j++) {
            int pk = __builtin_amdgcn_cvt_pk_fp8_f32(x[u][j].x * sc, x[u][j].y * sc, 0, false);
            pk = __builtin_amdgcn_cvt_pk_fp8_f32(x[u][j].z * sc, x[u][j].w * sc, pk, true);
            q[j] = (unsigned)pk;
        }
        *(u32x4*)(dst + (size_t)row * 1024 + lane * 16) = q;
        if (lane == 0) rscale[row] = am > 0.f ? am * (1.f / 448.f) : 1.f;
    }
}
__device__ __forceinline__ void d_peer_apply3(const int vb, char* smem, const bf16_t* __restrict__ hb, const int* __restrict__ pidx,
                                              const float* __restrict__ pg, const unsigned char* __restrict__ utab, const unsigned char* __restrict__ vtab,
                                              const float* __restrict__ rsU, const float* __restrict__ rsV, const float* __restrict__ modl,
                                              float* __restrict__ xrun) {
    const int wid = threadIdx.x >> 6, lane = threadIdx.x & 63;
    const int t = vb * 4 + wid;
    float* coef = (float*)smem + wid * 128;
    int* eid = (int*)(smem + 2048) + wid * 128;
    const int e_lo = pidx[(size_t)t * 128 + lane], e_hi = pidx[(size_t)t * 128 + lane + 64];
    eid[lane] = e_lo; eid[lane + 64] = e_hi;
    const float g0 = pg[(size_t)t * 128 + lane] * rsV[e_lo], g1 = pg[(size_t)t * 128 + lane + 64] * rsV[e_hi];
    const float ru0 = rsU[e_lo], ru1 = rsU[e_hi];
    float x[16];
    {
        const u32x4 a = *(const u32x4*)(hb + (size_t)t * DM + lane * 16), b = *(const u32x4*)(hb + (size_t)t * DM + lane * 16 + 8);
#pragma unroll
        for (int i = 0; i < 4; i++) {
            x[2 * i] = __uint_as_float(a[i] << 16); x[2 * i + 1] = __uint_as_float(a[i] & 0xffff0000u);
            x[8 + 2 * i] = __uint_as_float(b[i] << 16); x[8 + 2 * i + 1] = __uint_as_float(b[i] & 0xffff0000u);
        }
    }
    __builtin_amdgcn_wave_barrier();
    float myact0 = 0.f, myact1 = 0.f;
#pragma unroll 1
    for (int eb = 0; eb < 128; eb += 16) {
        u32x4 q[16];
#pragma unroll
        for (int r = 0; r < 16; r++) q[r] = *(const u32x4*)(utab + (size_t)eid[eb + r] * 1024 + lane * 16);
#pragma unroll
        for (int r = 0; r < 16; r++) {
            float sacc = 0.f;
#pragma unroll
            for (int i = 0; i < 4; i++) {
                const f32x2 f01 = __builtin_amdgcn_cvt_pk_f32_fp8((int)q[r][i], false);
                const f32x2 f23 = __builtin_amdgcn_cvt_pk_f32_fp8((int)q[r][i], true);
                sacc += f01[0] * x[4 * i] + f01[1] * x[4 * i + 1] + f23[0] * x[4 * i + 2] + f23[1] * x[4 * i + 3];
            }
            sacc = wave_allsum_fast(sacc);
            const int e = eb + r;
            if (lane == (e & 63)) { if (e < 64) myact0 = sacc; else myact1 = sacc; }
        }
    }
    coef[lane] = g0 * gelu_tanh(myact0 * ru0);
    coef[lane + 64] = g1 * gelu_tanh(myact1 * ru1);
    __builtin_amdgcn_wave_barrier();
    float acc[16];
#pragma unroll
    for (int i = 0; i < 16; i++) acc[i] = 0.f;
#pragma unroll 1
    for (int eb = 0; eb < 128; eb += 16) {
        u32x4 q[16];
#pragma unroll
        for (int r = 0; r < 16; r++) q[r] = *(const u32x4*)(vtab + (size_t)eid[eb + r] * 1024 + lane * 16);
#pragma unroll
        for (int r = 0; r < 16; r++) {
            const float cf = coef[eb + r];
#pragma unroll
            for (int i = 0; i < 4; i++) {
                const f32x2 f01 = __builtin_amdgcn_cvt_pk_f32_fp8((int)q[r][i], false);
                const f32x2 f23 = __builtin_amdgcn_cvt_pk_f32_fp8((int)q[r][i], true);
                acc[4 * i] += cf * f01[0]; acc[4 * i + 1] += cf * f01[1]; acc[4 * i + 2] += cf * f23[0]; acc[4 * i + 3] += cf * f23[1];
            }
        }
    }
    const float* m = modl + (size_t)tok_modrow(t) * 6144 + 5 * 1024 + lane * 16;
    float* xo = xrun + (size_t)t * DM + lane * 16;
#pragma unroll
    for (int j = 0; j < 4; j++) {
        float4 xa = *(float4*)(xo + 4 * j);
        const float4 ma = *(const float4*)(m + 4 * j);
        xa.x += ma.x * acc[4 * j]; xa.y += ma.y * acc[4 * j + 1]; xa.z += ma.z * acc[4 * j + 2]; xa.w += ma.w * acc[4 * j + 3];
        *(float4*)(xo + 4 * j) = xa;
    }
}

#define XB_TMO      128
#define XB_XCNT(j)  (256  + 64 * (j))
#define XB_XSUB(j)  (1280 + 64 * (j))
#define XB_XGEN(j)  (2304 + 64 * (j))
#define XB_TOP      3328
#define XB_TOPGEN   3392
#define XCD_BAR_WORDS 3456
#define XB_SPIN_CAP (1u << 22)
#define LAS __attribute__((address_space(3)))
__device__ __forceinline__ unsigned xb_ld(unsigned* p) { return __hip_atomic_load(p, __ATOMIC_RELAXED, __HIP_MEMORY_SCOPE_AGENT); }
__device__ __forceinline__ unsigned xb_add(unsigned* p, unsigned v) { return __hip_atomic_fetch_add(p, v, __ATOMIC_RELAXED, __HIP_MEMORY_SCOPE_AGENT); }
__device__ __forceinline__ unsigned xb_xcc_id() { return (unsigned)__builtin_amdgcn_s_getreg((3 << 11) | 20) & 0xFu; }
#define XB_SPIN(cond, bar) do { unsigned _sp = 0; while (cond) { __builtin_amdgcn_s_sleep(1); \
    if ((++_sp & 255u) == 0u) { if (xb_ld(&(bar)[XB_TMO])) break; if (_sp > XB_SPIN_CAP) { atomicAdd(&(bar)[XB_TMO], 1u); break; } } } } while (0)
struct XcdBarrier { unsigned* bar; unsigned x; volatile LAS unsigned* st; };
__device__ __forceinline__ XcdBarrier xcd_barrier_post(unsigned* bar, volatile LAS unsigned* st) {
    XcdBarrier b; b.bar = bar; b.x = xb_xcc_id(); b.st = st;
    if (threadIdx.x == 0) (void)xb_add(&bar[XB_XCNT(b.x)], 1u);
    return b;
}
__device__ __forceinline__ void xcd_barrier_complete(unsigned* bar, unsigned x, unsigned& nloc, unsigned& nx) {
    const unsigned G = gridDim.x * gridDim.y * gridDim.z;
    unsigned sum, cnt, mine, sp = 0u;
    for (;;) {
        sum = 0u; cnt = 0u; mine = 0u;
#pragma unroll
        for (unsigned j = 0; j < 16; ++j) { const unsigned c = xb_ld(&bar[XB_XCNT(j)]); sum += c; cnt += (c > 0u) ? 1u : 0u; mine = (j == x) ? c : mine; }
        if (sum == G) break;
        __builtin_amdgcn_s_sleep(1);
        if ((++sp & 255u) == 0u) { if (xb_ld(&bar[XB_TMO])) break; if (sp > XB_SPIN_CAP) { atomicAdd(&bar[XB_TMO], 1u); break; } }
    }
    nloc = mine > 0u ? mine : 1u; nx = cnt > 0u ? cnt : 1u;
}
__device__ __forceinline__ void xcd_barrier_(unsigned* bar_, char* smem_) {
    XcdBarrier b; b.bar = bar_; b.x = xb_xcc_id(); b.st = (volatile LAS unsigned*)(smem_ + GEMM_LDS_BYTES);
    asm volatile("s_waitcnt vmcnt(0)" ::: "memory");
    __syncthreads();
    if (threadIdx.x == 0) {
        unsigned* bar = b.bar;
        __builtin_amdgcn_s_waitcnt(0);
        unsigned nloc = b.st[0], nx = b.st[1];
        if (nloc == 0u) { xcd_barrier_complete(bar, b.x, nloc, nx); b.st[0] = nloc; b.st[1] = nx; }
        const unsigned old = xb_add(&bar[XB_XSUB(b.x)], 1u);
        const unsigned gen = old / nloc;
        if (old + 1u == (gen + 1u) * nloc) {
            __builtin_amdgcn_fence(__ATOMIC_RELEASE, "agent");
            asm volatile("s_waitcnt vmcnt(0)" ::: "memory");
            const unsigned og = xb_add(&bar[XB_TOP], 1u);
            const unsigned tg = og / nx;
            if (og + 1u == (tg + 1u) * nx) xb_add(&bar[XB_TOPGEN], 1u);
            else XB_SPIN(xb_ld(&bar[XB_TOPGEN]) == tg, bar);
            __builtin_amdgcn_fence(__ATOMIC_ACQUIRE, "agent");
            xb_add(&bar[XB_XGEN(b.x)], 1u);
            asm volatile("s_waitcnt vmcnt(0)" ::: "memory");
        } else {
            XB_SPIN(xb_ld(&bar[XB_XGEN(b.x)]) == gen, bar);
            __builtin_amdgcn_fence(__ATOMIC_ACQUIRE, "agent");
            asm volatile("s_waitcnt vmcnt(0)" ::: "memory");
        }
    }
    __syncthreads();
}

constexpr size_t ws_al(size_t x) { return (x + 255) & ~(size_t)255; }
struct WS {
    static constexpr size_t mod = 0;
    static constexpr size_t w_in_t = ws_al(mod + (size_t)(2*5*6144*4));
    static constexpr size_t w_out_t = ws_al(w_in_t + (size_t)(2304*1024*2));
    static constexpr size_t hy_w_in_t = ws_al(w_out_t + (size_t)(1024*1024*2));
    static constexpr size_t hy_w_out_t = ws_al(hy_w_in_t + (size_t)(3072*1024*2));
    static constexpr size_t w_q_t = ws_al(hy_w_out_t + (size_t)(1024*1024*2));
    static constexpr size_t q_up_t = ws_al(w_q_t + (size_t)(2*2048*1024*2));
    static constexpr size_t kv_up_t = ws_al(q_up_t + (size_t)(768*256*2));
    static constexpr size_t w2_t = ws_al(kv_up_t + (size_t)(1024*128*2));
    static constexpr size_t a2_t = ws_al(w2_t + (size_t)(2*512*64*2));
    static constexpr size_t g2_t = ws_al(a2_t + (size_t)(2*512*64*2));
    static constexpr size_t ctxb = ws_al(g2_t + (size_t)(512*128*2));
    static constexpr size_t keysb = ws_al(ctxb + (size_t)(1024*128*2));
    static constexpr size_t tabU = ws_al(keysb + (size_t)(2*16*128*128*2));
    static constexpr size_t tabV = ws_al(tabU + (size_t)(16384*1024));
    static constexpr size_t rsU = ws_al(tabV + (size_t)(16384*1024));
    static constexpr size_t rsV = ws_al(rsU + (size_t)(16384*4));
    static constexpr size_t nsum = ws_al(rsV + (size_t)(16384*4));
    static constexpr size_t gTS = ws_al(nsum + (size_t)(2*1024*4 + 3456*4 + 1024));
    static constexpr size_t gTP = ws_al(gTS + (size_t)1024*2*2048*2);
    static constexpr size_t R1 = ws_al(gTP + (size_t)1024*2*256*2);
    static constexpr size_t R2 = ws_al(R1 + (size_t)((size_t)TT*1024*4));
    static constexpr size_t rb = ws_al(R2 + (size_t)((size_t)TT*1792*2 + (size_t)TT*448*4));
    static constexpr size_t kb = ws_al(rb + (size_t)((size_t)TT*512*2));
    static constexpr size_t vb = ws_al(kb + (size_t)((size_t)TT*512*2));
    static constexpr size_t kkb = ws_al(vb + (size_t)((size_t)TT*512*2));
    static constexpr size_t lr0 = ws_al(kkb + (size_t)((size_t)TT*512*2));
    static constexpr size_t lr1 = ws_al(lr0 + (size_t)((size_t)TT*512*2));
    static constexpr size_t gateb = ws_al(lr1 + (size_t)((size_t)TT*512*2));
    static constexpr size_t du0 = ws_al(gateb + (size_t)((size_t)TT*512*2));
    static constexpr size_t du1 = ws_al(du0 + (size_t)((size_t)TT*512*2));
    static constexpr size_t twb = ws_al(du1 + (size_t)((size_t)TT*512*2));
    static constexpr size_t advb = ws_al(twb + (size_t)((size_t)TT*64*2));
    static constexpr size_t sgb = ws_al(advb + (size_t)((size_t)TT*64*2));
    static constexpr size_t bonus = ws_al(sgb + (size_t)((size_t)TT*128*2));
    static constexpr size_t kpe = ws_al(bonus + (size_t)((size_t)TT*8*4));
    static constexpr size_t qcnb = ws_al(kpe + (size_t)((size_t)TT*64*4));
    static constexpr size_t ckvb = ws_al(qcnb + (size_t)((size_t)TT*256*2));
    static constexpr size_t Qb = ws_al(ckvb + (size_t)((size_t)TT*128*2));
    static constexpr size_t Kp = ws_al(Qb + (size_t)((size_t)TT*768*2));
    static constexpr size_t Vp = ws_al(Kp + (size_t)(16*4*256*192*2));
    static constexpr size_t Ks = ws_al(Vp + (size_t)(16*4*256*128*2));
    static constexpr size_t Vs = ws_al(Ks + (size_t)(4*4*2304*192*2));
    static constexpr size_t kvctxb = ws_al(Vs + (size_t)(4*4*2304*128*2));
    static constexpr size_t pidx = ws_al(kvctxb + (size_t)(1024*1024*2));
    static constexpr size_t pg = ws_al(pidx + (size_t)((size_t)TT*128*4));
    static constexpr size_t END = ws_al(pg + (size_t)((size_t)TT*128*4));
    static constexpr size_t hb = R1;
    static constexpr size_t catb = R1;
    static constexpr size_t zbb = R1;
    static constexpr size_t kvrawb = R1;
    static constexpr size_t qrawb = R1 + (size_t)TT*1024*2;
    static constexpr size_t projrw = R2;
    static constexpr size_t projmla = R2 + (size_t)TT*1792*2;
    static constexpr size_t y0 = R2;
    static constexpr size_t y1 = R2 + (size_t)TT*512*4;
    static constexpr size_t qb = R2;
    static constexpr size_t scT = rb;
    static constexpr size_t pre = R2;
    static constexpr size_t zT = R2 + (size_t)TT*3072*4;
    static constexpr size_t x0b = R2 + (size_t)TT*3072*4 + (size_t)TT*1024*2;
    static constexpr size_t yT = R2 + (size_t)TT*3072*4 + (size_t)TT*1024*4;
    static constexpr size_t bar = nsum + 2*1024*4;
};
struct Params {
    const float* in[46];
    float* out;
    char* ws;
    __device__ __forceinline__ const float* x_prompt() const { return in[0]; }
    __device__ __forceinline__ const float* x_sample() const { return in[1]; }
    __device__ __forceinline__ const float* st_f() const { return in[2]; }
    __device__ __forceinline__ const float* st_b() const { return in[3]; }
    __device__ __forceinline__ const float* cache_ckv() const { return in[4]; }
    __device__ __forceinline__ const float* cache_kpe() const { return in[5]; }
    __device__ __forceinline__ const float* c() const { return in[6]; }
    __device__ __forceinline__ const float* c_ctx() const { return in[7]; }
    __device__ __forceinline__ const float* norm_g() const { return in[8]; }
    __device__ __forceinline__ const float* w_mod() const { return in[9]; }
    __device__ __forceinline__ const float* b_mod() const { return in[10]; }
    __device__ __forceinline__ const float* ab_w_in() const { return in[11]; }
    __device__ __forceinline__ const float* rw_mu() const { return in[12]; }
    __device__ __forceinline__ const float* rw_w0() const { return in[13]; }
    __device__ __forceinline__ const float* rw_w2() const { return in[14]; }
    __device__ __forceinline__ const float* rw_a0() const { return in[15]; }
    __device__ __forceinline__ const float* rw_a2() const { return in[16]; }
    __device__ __forceinline__ const float* rw_g2() const { return in[17]; }
    __device__ __forceinline__ const float* rw_k_k() const { return in[18]; }
    __device__ __forceinline__ const float* rw_k_a() const { return in[19]; }
    __device__ __forceinline__ const float* rw_r_k() const { return in[20]; }
    __device__ __forceinline__ const float* rw_lnx_g() const { return in[21]; }
    __device__ __forceinline__ const float* rw_lnx_b() const { return in[22]; }
    __device__ __forceinline__ const float* mla_q_norm() const { return in[23]; }
    __device__ __forceinline__ const float* mla_q_up() const { return in[24]; }
    __device__ __forceinline__ const float* mla_kv_norm() const { return in[25]; }
    __device__ __forceinline__ const float* mla_kv_up() const { return in[26]; }
    __device__ __forceinline__ const float* mla_qn() const { return in[27]; }
    __device__ __forceinline__ const float* mla_kn() const { return in[28]; }
    __device__ __forceinline__ const float* ab_w_out() const { return in[29]; }
    __device__ __forceinline__ const float* hy_w_in() const { return in[30]; }
    __device__ __forceinline__ const float* hy_b_in() const { return in[31]; }
    __device__ __forceinline__ const float* hy_conv_w() const { return in[32]; }
    __device__ __forceinline__ const float* hy_conv_b() const { return in[33]; }
    __device__ __forceinline__ const float* hy_f_w1() const { return in[34]; }
    __device__ __forceinline__ const float* hy_f_b1() const { return in[35]; }
    __device__ __forceinline__ const float* hy_f_w2() const { return in[36]; }
    __device__ __forceinline__ const float* hy_f_b2() const { return in[37]; }
    __device__ __forceinline__ const float* hy_f_w3() const { return in[38]; }
    __device__ __forceinline__ const float* hy_f_freq() const { return in[39]; }
    __device__ __forceinline__ const float* hy_bias() const { return in[40]; }
    __device__ __forceinline__ const float* hy_w_out() const { return in[41]; }
    __device__ __forceinline__ const float* peer_w_q() const { return in[42]; }
    __device__ __forceinline__ const float* peer_keys() const { return in[43]; }
    __device__ __forceinline__ const float* peer_u() const { return in[44]; }
    __device__ __forceinline__ const float* peer_v() const { return in[45]; }
    __device__ __forceinline__ float* xrun() const { return out + (0); }
    __device__ __forceinline__ float* out_sf() const { return out + ((size_t)TT*DM); }
    __device__ __forceinline__ float* out_sb() const { return out + ((size_t)TT*DM + 16*8*64*64); }
    __device__ __forceinline__ float* out_ckv() const { return out + ((size_t)TT*DM + 2*16*8*64*64); }
    __device__ __forceinline__ float* out_kpe() const { return out + ((size_t)TT*DM + 2*16*8*64*64 + 16*256*128); }
    __device__ __forceinline__ float* mod() const { return (float*)(ws + WS::mod); }
    __device__ __forceinline__ bf16_t* w_in_t() const { return (bf16_t*)(ws + WS::w_in_t); }
    __device__ __forceinline__ bf16_t* w_out_t() const { return (bf16_t*)(ws + WS::w_out_t); }
    __device__ __forceinline__ bf16_t* hy_w_in_t() const { return (bf16_t*)(ws + WS::hy_w_in_t); }
    __device__ __forceinline__ bf16_t* hy_w_out_t() const { return (bf16_t*)(ws + WS::hy_w_out_t); }
    __device__ __forceinline__ bf16_t* w_q_t() const { return (bf16_t*)(ws + WS::w_q_t); }
    __device__ __forceinline__ bf16_t* q_up_t() const { return (bf16_t*)(ws + WS::q_up_t); }
    __device__ __forceinline__ bf16_t* kv_up_t() const { return (bf16_t*)(ws + WS::kv_up_t); }
    __device__ __forceinline__ bf16_t* w2_t() const { return (bf16_t*)(ws + WS::w2_t); }
    __device__ __forceinline__ bf16_t* a2_t() const { return (bf16_t*)(ws + WS::a2_t); }
    __device__ __forceinline__ bf16_t* g2_t() const { return (bf16_t*)(ws + WS::g2_t); }
    __device__ __forceinline__ bf16_t* ctxb() const { return (bf16_t*)(ws + WS::ctxb); }
    __device__ __forceinline__ bf16_t* keysb() const { return (bf16_t*)(ws + WS::keysb); }
    __device__ __forceinline__ unsigned char* tabU() const { return (unsigned char*)(ws + WS::tabU); }
    __device__ __forceinline__ float* rsU() const { return (float*)(ws + WS::rsU); }
    __device__ __forceinline__ float* rsV() const { return (float*)(ws + WS::rsV); }
    __device__ __forceinline__ unsigned char* tabV() const { return (unsigned char*)(ws + WS::tabV); }
    __device__ __forceinline__ float* nsum() const { return (float*)(ws + WS::nsum); }
    __device__ __forceinline__ bf16_t* rb() const { return (bf16_t*)(ws + WS::rb); }
    __device__ __forceinline__ bf16_t* kb() const { return (bf16_t*)(ws + WS::kb); }
    __device__ __forceinline__ bf16_t* vb() const { return (bf16_t*)(ws + WS::vb); }
    __device__ __forceinline__ bf16_t* kkb() const { return (bf16_t*)(ws + WS::kkb); }
    __device__ __forceinline__ bf16_t* lr0() const { return (bf16_t*)(ws + WS::lr0); }
    __device__ __forceinline__ bf16_t* lr1() const { return (bf16_t*)(ws + WS::lr1); }
    __device__ __forceinline__ bf16_t* gateb() const { return (bf16_t*)(ws + WS::gateb); }
    __device__ __forceinline__ _Float16* du0() const { return (_Float16*)(ws + WS::du0); }
    __device__ __forceinline__ _Float16* du1() const { return (_Float16*)(ws + WS::du1); }
    __device__ __forceinline__ bf16_t* twb() const { return (bf16_t*)(ws + WS::twb); }
    __device__ __forceinline__ bf16_t* advb() const { return (bf16_t*)(ws + WS::advb); }
    __device__ __forceinline__ bf16_t* sgb() const { return (bf16_t*)(ws + WS::sgb); }
    __device__ __forceinline__ float* bonus() const { return (float*)(ws + WS::bonus); }
    __device__ __forceinline__ float* kpe() const { return (float*)(ws + WS::kpe); }
    __device__ __forceinline__ bf16_t* qcnb() const { return (bf16_t*)(ws + WS::qcnb); }
    __device__ __forceinline__ bf16_t* ckvb() const { return (bf16_t*)(ws + WS::ckvb); }
    __device__ __forceinline__ bf16_t* Qb() const { return (bf16_t*)(ws + WS::Qb); }
    __device__ __forceinline__ bf16_t* Kp() const { return (bf16_t*)(ws + WS::Kp); }
    __device__ __forceinline__ bf16_t* Vp() const { return (bf16_t*)(ws + WS::Vp); }
    __device__ __forceinline__ bf16_t* Ks() const { return (bf16_t*)(ws + WS::Ks); }
    __device__ __forceinline__ bf16_t* Vs() const { return (bf16_t*)(ws + WS::Vs); }
    __device__ __forceinline__ bf16_t* kvctxb() const { return (bf16_t*)(ws + WS::kvctxb); }
    __device__ __forceinline__ int* pidx() const { return (int*)(ws + WS::pidx); }
    __device__ __forceinline__ float* pg() const { return (float*)(ws + WS::pg); }
    __device__ __forceinline__ bf16_t* hb() const { return (bf16_t*)(ws + WS::hb); }
    __device__ __forceinline__ bf16_t* catb() const { return (bf16_t*)(ws + WS::catb); }
    __device__ __forceinline__ bf16_t* zbb() const { return (bf16_t*)(ws + WS::zbb); }
    __device__ __forceinline__ bf16_t* kvrawb() const { return (bf16_t*)(ws + WS::kvrawb); }
    __device__ __forceinline__ bf16_t* qrawb() const { return (bf16_t*)(ws + WS::qrawb); }
    __device__ __forceinline__ bf16_t* projrw() const { return (bf16_t*)(ws + WS::projrw); }
    __device__ __forceinline__ float* projmla() const { return (float*)(ws + WS::projmla); }
    __device__ __forceinline__ float* y0() const { return (float*)(ws + WS::y0); }
    __device__ __forceinline__ float* y1() const { return (float*)(ws + WS::y1); }
    __device__ __forceinline__ bf16_t* qb() const { return (bf16_t*)(ws + WS::qb); }
    __device__ __forceinline__ float* scT() const { return (float*)(ws + WS::scT); }
    __device__ __forceinline__ float* pre() const { return (float*)(ws + WS::pre); }
    __device__ __forceinline__ bf16_t* zT() const { return (bf16_t*)(ws + WS::zT); }
    __device__ __forceinline__ bf16_t* x0b() const { return (bf16_t*)(ws + WS::x0b); }
    __device__ __forceinline__ bf16_t* yT() const { return (bf16_t*)(ws + WS::yT); }
    __device__ __forceinline__ bf16_t* gTS() const { return (bf16_t*)(ws + WS::gTS); }
    __device__ __forceinline__ bf16_t* gTP() const { return (bf16_t*)(ws + WS::gTP); }
    __device__ __forceinline__ unsigned* bar() const { return (unsigned*)(ws + WS::bar); }
};

#define VLOOP(n) for (int vb = blockIdx.x; vb < (n); vb += gridDim.x)
#define ENDV __syncthreads();

__device__ __forceinline__ void peer_layer(const Params& p, char* smem, int li, const float* modl, float* xrs) {
    const bf16_t* wq = p.w_q_t() + (size_t)li * 2048 * 1024;
    const bf16_t* kys = p.keysb() + (size_t)li * 16 * 128 * 128;
    VLOOP(TT / 8) { d_norm_mod2(vb, p.xrun(), xrs, p.norm_g() + (li * 2 + 1) * 1024, modl, 3, 4, p.hb()); }
    xcd_barrier_(p.bar(), smem);
    VLOOP(16 * 96) { d_gemm_bf16(vb % 16, vb / 16, smem, p.hb(), 1024, wq, 1024, 1024, 2048, EpiStoreBf{p.qb(), 2048, 0}); }
    xcd_barrier_(p.bar(), smem);
    VLOOP(16 * 96) { const int hp = vb / 96; d_gemm_bf16(vb % 96, 0, smem, kys + (size_t)hp * 128 * 128, 128, p.qb() + hp * 128, 2048, 128, TT, EpiStore{p.scT() + (size_t)hp * 128 * TT, nullptr, TT, 0}); }
    xcd_barrier_(p.bar(), smem);
    VLOOP(8 * 48) { d_peer_select(vb, p.scT(), p.pidx(), p.pg()); }
    xcd_barrier_(p.bar(), smem);
    VLOOP(TT / 4) { d_peer_apply3(vb, smem, p.hb(), p.pidx(), p.pg(), p.tabU(), p.tabV(), p.rsU(), p.rsV(), modl, p.xrun()); ENDV }
}

__global__ void __launch_bounds__(256, 2) mega(Params p) {
    __shared__ __attribute__((aligned(16))) char smem[GEMM_LDS_BYTES + 16];
    cg::grid_group grid = cg::this_grid();
    if (threadIdx.x < 4) ((unsigned*)(smem + GEMM_LDS_BYTES))[threadIdx.x] = 0u;
    __syncthreads();
    (void)xcd_barrier_post(p.bar(), (volatile LAS unsigned*)(smem + GEMM_LDS_BYTES));
    const float* mod0 = p.mod();
    const float* mod1 = p.mod() + 5 * 6144;
    float* xrs = p.xrun() + (size_t)TP * DM;

    VLOOP(192) { d_mod3(vb, smem, p.c(), p.c_ctx(), p.w_mod(), p.b_mod(), p.mod()); ENDV }
    VLOOP(512) { d_hy_filt2(vb, smem, LS, p.hy_f_w1(), p.hy_f_b1(), p.hy_f_w2(), p.hy_f_b2(), p.hy_f_w3(), p.hy_f_freq(), p.gTS(), p.nsum()); ENDV }
    VLOOP(64) { d_hy_filt2(vb, smem, LP, p.hy_f_w1(), p.hy_f_b1(), p.hy_f_w2(), p.hy_f_b2(), p.hy_f_w3(), p.hy_f_freq(), p.gTP(), p.nsum() + 1024); ENDV }
    {
        const int j1 = 36 * 16;
        const int j2 = j1 + 16 * 16;
        const int j3 = j2 + 48 * 16;
        const int j4 = j3 + 16 * 16;
        const int j5 = j4 + 32 * 16;
        const int j6 = j5 + 32 * 16;
        const int j7 = j6 + 12 * 4;
        const int j8 = j7 + 16 * 2;
        const int j9 = j8 + 8;
        const int j10 = j9 + 8;
        const int j11 = j10 + 8;
        const int j12 = j11 + 8;
        const int j13 = j12 + 8 * 2;
        VLOOP(j13) {
            const float* W; bf16_t* Wt; int K, N, lv;
            if (vb < j1) { W = p.ab_w_in(); Wt = p.w_in_t(); K = 1024; N = 2240; lv = vb; }
            else if (vb < j2) { W = p.ab_w_out(); Wt = p.w_out_t(); K = 1024; N = 1024; lv = vb - j1; }
            else if (vb < j3) { W = p.hy_w_in(); Wt = p.hy_w_in_t(); K = 1024; N = 3072; lv = vb - j2; }
            else if (vb < j4) { W = p.hy_w_out(); Wt = p.hy_w_out_t(); K = 1024; N = 1024; lv = vb - j3; }
            else if (vb < j5) { W = p.peer_w_q(); Wt = p.w_q_t(); K = 1024; N = 2048; lv = vb - j4; }
            else if (vb < j6) { W = p.peer_w_q() + (size_t)1024 * 2048; Wt = p.w_q_t() + (size_t)2048 * 1024; K = 1024; N = 2048; lv = vb - j5; }
            else if (vb < j7) { W = p.mla_q_up(); Wt = p.q_up_t(); K = 256; N = 768; lv = vb - j6; }
            else if (vb < j8) { W = p.mla_kv_up(); Wt = p.kv_up_t(); K = 128; N = 1024; lv = vb - j7; }
            else if (vb < j9) { W = p.rw_w2(); Wt = p.w2_t(); K = 64; N = 512; lv = vb - j8; }
            else if (vb < j10) { W = p.rw_w2() + 64 * 512; Wt = p.w2_t() + 512 * 64; K = 64; N = 512; lv = vb - j9; }
            else if (vb < j11) { W = p.rw_a2(); Wt = p.a2_t(); K = 64; N = 512; lv = vb - j10; }
            else if (vb < j12) { W = p.rw_a2() + 64 * 512; Wt = p.a2_t() + 512 * 64; K = 64; N = 512; lv = vb - j11; }
            else { W = p.rw_g2(); Wt = p.g2_t(); K = 128; N = 512; lv = vb - j12; }
            d_transpose_w(lv, smem, W, K, N, Wt);
            ENDV }
    }
    VLOOP(40) { if (vb < 8) d_cvt_bf16(vb, p.cache_ckv(), p.ctxb()); else d_cvt_bf16(vb - 8, p.peer_keys(), p.keysb()); }
    VLOOP(2048) {
        const bool isv = vb >= 1024;
        d_cvt_fp8_rows(isv ? vb - 1024 : vb, isv ? p.peer_v() : p.peer_u(), isv ? p.tabV() : p.tabU(), isv ? p.rsV() : p.rsU());
    }
    if (p.ws == nullptr) grid.sync();
    xcd_barrier_(p.bar(), smem);
    VLOOP(TT / 8) { d_norm_mod2(vb, p.x_prompt(), p.x_sample(), p.norm_g(), mod0, 0, 1, p.hb()); }
    xcd_barrier_(p.bar(), smem);
    VLOOP(18 * 96) { d_gemm_bf16(vb % 18, vb / 18, smem, p.hb(), 1024, p.w_in_t(), 1024, 1024, ABIN, EpiProj{p.projrw(), p.projmla()}); }
    xcd_barrier_(p.bar(), smem);
    VLOOP(2688 + 768) {
        if (vb < 2688) d_rw_shift2(vb, p.projrw(), p.rw_mu(), p.rb(), p.kb(), p.vb(), p.twb(), p.advb(), p.sgb());
        else d_mla_pre2(vb - 2688, p.projmla(), p.mla_q_norm(), p.mla_kv_norm(), p.qcnb(), p.ckvb(), p.kpe(), p.out_ckv(), p.out_kpe());
    }
    xcd_barrier_(p.bar(), smem);
    {
        const int n0 = 4 * 96, n1 = 6 * 96, n2 = 8 * 96, n3 = 8 * 8;
        VLOOP(5 * n0 + n1 + n2 + n3) {
            int v = vb;
            if (v < n0) d_gemm_bf16(v % 4, v / 4, smem, p.twb(), 64, p.w2_t(), 64, 64, 512, EpiDecay{p.du0(), p.rw_w0()});
            else if ((v -= n0) < n0) d_gemm_bf16(v % 4, v / 4, smem, p.twb(), 64, p.w2_t() + 512 * 64, 64, 64, 512, EpiDecay{p.du1(), p.rw_w0() + 512});
            else if ((v -= n0) < n0) d_gemm_bf16(v % 4, v / 4, smem, p.advb(), 64, p.a2_t(), 64, 64, 512, EpiLr{p.lr0(), p.rw_a0()});
            else if ((v -= n0) < n0) d_gemm_bf16(v % 4, v / 4, smem, p.advb(), 64, p.a2_t() + 512 * 64, 64, 64, 512, EpiLr{p.lr1(), p.rw_a0() + 512});
            else if ((v -= n0) < n0) d_gemm_bf16(v % 4, v / 4, smem, p.sgb(), 128, p.g2_t(), 128, 128, 512, EpiStoreBf{p.gateb(), 512, 0});
            else if ((v -= n0) < n1) d_gemm_bf16(v % 6, v / 6, smem, p.qcnb(), 256, p.q_up_t(), 256, 256, 768, EpiStoreBf{p.qrawb(), 768, 0});
            else if ((v -= n1) < n2) d_gemm_bf16(v % 8, v / 8, smem, p.ckvb(), 128, p.kv_up_t(), 128, 128, 1024, EpiKV{p.kvrawb(), p.Vp(), p.Vs(), 0, 0});
            else { v -= n2; d_gemm_bf16(v % 8, v / 8, smem, p.ctxb(), 128, p.kv_up_t(), 128, 128, 1024, EpiKV{p.kvctxb(), p.Vp(), p.Vs(), 1, 0}); }
        }
    }
    xcd_barrier_(p.bar(), smem);
    VLOOP(384 + 3328) {
        if (vb < 384) d_rw_kk2(vb, smem, p.rb(), p.kb(), p.lr0(), p.lr1(), p.rw_k_k(), p.rw_k_a(), p.rw_r_k(), p.kkb(), p.bonus());
        else d_mla_post2(vb - 384, p.qrawb(), p.kvrawb(), p.kvctxb(), p.kpe(), p.cache_kpe(), p.mla_qn(), p.mla_kn(), p.Qb(), p.Kp(), p.Ks());
        ENDV }
    xcd_barrier_(p.bar(), smem);
    {
        const bool big = gridDim.x >= 512;
        const int stride = big ? (blockIdx.x < 256 ? (1 << 28) : (int)gridDim.x - 256) : (int)gridDim.x;
        for (int v = blockIdx.x; v < 256 + 1024; v += stride)
            d_scan2(v < 256 ? v : v - 256, v < 256, smem, p.rb(), p.kb(), p.vb(), p.kkb(), p.lr0(), p.lr1(), p.du0(), p.du1(), p.rw_k_a(), p.st_f(), p.st_b(), p.y0(), p.y1(), p.out_sf(), p.out_sb());
    }
    {
        unsigned* qctr = p.bar() + XCD_BAR_WORDS + 128;
        volatile unsigned* bc = (volatile unsigned*)(smem + GEMM_LDS_BYTES + 8);
        for (;;) {
            if (threadIdx.x == 0) *bc = atomicAdd(qctr, 1u);
            __syncthreads();
            const unsigned item = *bc;
            __syncthreads();
            if (item >= 384u) break;
            const bool smp = item < 256u;
            d_attn_mfma(smp ? (int)item : (int)item - 256, smem, p.Qb(), smp ? p.Ks() : p.Kp(), smp ? p.Vs() : p.Vp(), p.catb(), smp ? TP : 0, smp ? LS : LP,
                        smp ? 2304 : LP, smp ? 16 : 2);
        }
    }
    xcd_barrier_(p.bar(), smem);
    VLOOP(384) { d_rw_post2(vb, smem, p.y0(), p.y1(), p.bonus(), p.vb(), p.gateb(), p.rw_lnx_g(), p.rw_lnx_b(), p.catb()); ENDV }
    xcd_barrier_(p.bar(), smem);
    VLOOP(8 * 96) { d_gemm_bf16(vb % 8, vb / 8, smem, p.catb(), 1024, p.w_out_t(), 1024, 1024, 1024, EpiResid{p.x_prompt(), p.x_sample(), p.xrun(), mod0, 2, 0}); }
    xcd_barrier_(p.bar(), smem);
    peer_layer(p, smem, 0, mod0, xrs);
    xcd_barrier_(p.bar(), smem);
    VLOOP(TT / 8) { d_norm_mod2(vb, p.xrun(), xrs, p.norm_g() + 2048, mod1, 0, 1, p.hb()); }
    VLOOP(2048) {
        const bool isv = vb >= 1024;
        d_cvt_fp8_rows(isv ? vb - 1024 : vb, (isv ? p.peer_v() : p.peer_u()) + (size_t)16384 * 1024, isv ? p.tabV() : p.tabU(), isv ? p.rsV() : p.rsU());
    }
    xcd_barrier_(p.bar(), smem);
    VLOOP(24 * 96) { d_gemm_bf16(vb % 24, vb / 24, smem, p.hb(), 1024, p.hy_w_in_t(), 1024, 1024, 3072, EpiStore{p.pre(), p.hy_b_in(), 3072, 0}); }
    xcd_barrier_(p.bar(), smem);
    VLOOP(192 * 16) { d_hy_dw2(vb, smem, p.pre(), p.hy_conv_w(), p.hy_conv_b(), p.zT(), p.x0b()); ENDV }
    xcd_barrier_(p.bar(), smem);
    VLOOP(512 + 512) {
        const int wv = threadIdx.x >> 6;
        char* wsm = smem + (wv >> 1) * 28672;
        if (vb < 512) d_hy_conv2<true>(vb * 2 + (wv >> 1), wv & 1, wsm, p.gTS(), p.nsum(), p.zT(), p.hy_bias(), p.yT());
        else d_hy_conv2<false>((vb - 512) * 2 + (wv >> 1), wv & 1, wsm, p.gTP(), p.nsum() + 1024, p.zT(), p.hy_bias(), p.yT());
        ENDV }
    xcd_barrier_(p.bar(), smem);
    VLOOP(192 * 16) { d_hy_post(vb, smem, p.yT(), p.x0b(), p.zbb()); ENDV }
    xcd_barrier_(p.bar(), smem);
    VLOOP(8 * 96) { d_gemm_bf16(vb % 8, vb / 8, smem, p.zbb(), 1024, p.hy_w_out_t(), 1024, 1024, 1024, EpiResid{p.xrun(), xrs, p.xrun(), mod1, 2, 0}); }
    xcd_barrier_(p.bar(), smem);
    peer_layer(p, smem, 1, mod1, xrs);
}

static inline size_t align_up(size_t x) { return (x + 255) & ~(size_t)255; }

extern "C" void kernel_launch(void* const* d_in, const int* in_sizes, int n_in, void* d_out, int out_size, void* d_ws, size_t ws_size,
                              hipStream_t stream) {
    Params p{};
    for (int i = 0; i < 46; i++) p.in[i] = (const float*)d_in[i];
    p.out = (float*)d_out;
    p.ws = (char*)d_ws;
    static_assert(WS::END <= (size_t)422781952, "workspace plan exceeds the guaranteed scratch size");
    static int grid_blocks = 0;
    if (!grid_blocks) {
        int dev = 0, cus = 0, per_cu = 0;
        (void)hipGetDevice(&dev);
        (void)hipDeviceGetAttribute(&cus, hipDeviceAttributeMultiprocessorCount, dev);
        (void)hipOccupancyMaxActiveBlocksPerMultiprocessor(&per_cu, mega, 256, 0);
        if (per_cu > 2) per_cu = 2;
        if (per_cu < 1) per_cu = 1;
        grid_blocks = cus * per_cu;
    }
    (void)hipMemsetAsync(p.ws + WS::nsum, 0, (size_t)2 * 1024 * 4 + (size_t)XCD_BAR_WORDS * 4 + 1024, stream);
    (void)hipMemsetAsync(p.ws + WS::mod, 0, (size_t)2 * 5 * 6144 * 4, stream);
    void* args[] = {&p};
    (void)hipLaunchCooperativeKernel((void*)mega, dim3(grid_blocks), dim3(256), args, 0, stream);
}
```

```cpp
#include <hip/hip_runtime.h>
#include <stdint.h>
#include <hip/hip_cooperative_groups.h>
namespace cg = cooperative_groups;

#define DM 1024
#define TP 4096
#define TS 8192
#define TT 12288
#define LP 256
#define LS 2048
#define NBP 16
#define NBS 4
#define ABIN 2240
#define RWIN 1792

typedef unsigned short bf16_t;
__device__ __forceinline__ bf16_t f2bf(float f) { unsigned u = __float_as_uint(f); u += 0x7fffu + ((u >> 16) & 1u); return (bf16_t)(u >> 16); }
__device__ __forceinline__ float bf2f(bf16_t h) { return __uint_as_float(((unsigned)h) << 16); }
__device__ __forceinline__ float sigmoidf_(float x) { return 1.f / (1.f + expf(-x)); }
__device__ __forceinline__ float gelu_tanh(float x) { return 0.5f * x * (1.f + tanhf(0.7978845608028654f * (x + 0.044715f * x * x * x))); }

__device__ __forceinline__ int tok_pos(int t) { return t < TP ? (t & (LP - 1)) : ((t - TP) & (LS - 1)); }
__device__ __forceinline__ int tok_len(int t) { return t < TP ? LP : LS; }
__device__ __forceinline__ int tok_modrow(int t) { return t < TP ? 0 : 1 + ((t - TP) >> 11); }

__device__ __forceinline__ float wave_sum(float v) {
#pragma unroll
    for (int o = 32; o > 0; o >>= 1) v += __shfl_xor(v, o, 64);
    return v;
}

__device__ __forceinline__ void d_mod(const int bx, const int by, const int bz, char* smem, const float* __restrict__ c, const float* __restrict__ c_ctx, const float* __restrict__ w_mod,
                                             const float* __restrict__ b_mod, float* __restrict__ mod) {
    float (*s)[1024] = (float(*)[1024])smem;
    const int li = by;
    const int n = bx * 256 + threadIdx.x;
    for (int i = threadIdx.x; i < 5 * 1024; i += 256) {
        int r = i >> 10, k = i & 1023;
        float v = (r == 0) ? c_ctx[k] : c[(r - 1) * 1024 + k];
        s[r][k] = v / (1.f + expf(-v));
    }
    __syncthreads();
    float a0 = 0, a1 = 0, a2 = 0, a3 = 0, a4 = 0;
    const float* w = w_mod + (size_t)li * 1024 * 6144 + n;
    for (int k = 0; k < 1024; k++) {
        float wv = w[(size_t)k * 6144];
        a0 += s[0][k] * wv; a1 += s[1][k] * wv; a2 += s[2][k] * wv; a3 += s[3][k] * wv; a4 += s[4][k] * wv;
    }
    float bb = b_mod[li * 6144 + n];
    float* o = mod + (size_t)li * 5 * 6144 + n;
    o[0 * 6144] = a0 + bb; o[1 * 6144] = a1 + bb; o[2 * 6144] = a2 + bb; o[3 * 6144] = a3 + bb; o[4 * 6144] = a4 + bb;
}


__device__ __forceinline__ void d_mod2(const int vb, char* smem, const float* __restrict__ c, const float* __restrict__ c_ctx,
                                       const float* __restrict__ w_mod, const float* __restrict__ b_mod, float* __restrict__ mod) {
    float* sl = (float*)smem;
    float* red = sl + 5 * 1024;
    const int li = vb / 96, n0 = (vb % 96) * 64;
    const int tid = threadIdx.x, col = tid & 63, kg = tid >> 6;
    for (int i = tid; i < 5 * 1024; i += 256) {
        const int r = i >> 10, k = i & 1023;
        const float v = (r == 0) ? c_ctx[k] : c[(r - 1) * 1024 + k];
        sl[i] = v / (1.f + __expf(-v));
    }
    __syncthreads();
    float a0 = 0, a1 = 0, a2 = 0, a3 = 0, a4 = 0;
    const float* w = w_mod + (size_t)li * 1024 * 6144 + (size_t)(kg * 256) * 6144 + n0 + col;
    const float* s0 = sl + kg * 256;
#pragma unroll 8
    for (int k = 0; k < 256; k++) {
        const float wv = w[(size_t)k * 6144];
        a0 += s0[k] * wv; a1 += s0[1024 + k] * wv; a2 += s0[2048 + k] * wv; a3 += s0[3072 + k] * wv; a4 += s0[4096 + k] * wv;
    }
    red[(kg * 5 + 0) * 64 + col] = a0; red[(kg * 5 + 1) * 64 + col] = a1; red[(kg * 5 + 2) * 64 + col] = a2;
    red[(kg * 5 + 3) * 64 + col] = a3; red[(kg * 5 + 4) * 64 + col] = a4;
    __syncthreads();
    for (int i = tid; i < 5 * 64; i += 256) {
        const int r = i >> 6, cc = i & 63;
        const float v = red[(0 * 5 + r) * 64 + cc] + red[(1 * 5 + r) * 64 + cc] + red[(2 * 5 + r) * 64 + cc] + red[(3 * 5 + r) * 64 + cc];
        mod[(size_t)(li * 5 + r) * 6144 + n0 + cc] = v + b_mod[li * 6144 + n0 + cc];
    }
}


__device__ __forceinline__ void d_mod3(const int vb, char* smem, const float* __restrict__ c, const float* __restrict__ c_ctx,
                                       const float* __restrict__ w_mod, const float* __restrict__ b_mod, float* __restrict__ mod) {
    float* sl = (float*)smem;
    const int li = vb / 96, kc = (vb % 96) / 6, cg6 = vb % 6;
    const int tid = threadIdx.x;
    for (int i = tid; i < 5 * 64; i += 256) {
        const int r = i >> 6, k = kc * 64 + (i & 63);
        const float v = (r == 0) ? c_ctx[k] : c[(r - 1) * 1024 + k];
        sl[i] = v / (1.f + __expf(-v));
    }
    __syncthreads();
    const int n = cg6 * 1024 + tid * 4;
    float4 a0 = {0, 0, 0, 0}, a1 = a0, a2 = a0, a3 = a0, a4 = a0;
    const float* w = w_mod + ((size_t)li * 1024 + kc * 64) * 6144 + n;
#pragma unroll 16
    for (int k = 0; k < 64; k++) {
        const float4 wv = *(const float4*)(w + (size_t)k * 6144);
        const float s0 = sl[k], s1 = sl[64 + k], s2 = sl[128 + k], s3 = sl[192 + k], s4 = sl[256 + k];
        a0.x += s0 * wv.x; a0.y += s0 * wv.y; a0.z += s0 * wv.z; a0.w += s0 * wv.w;
        a1.x += s1 * wv.x; a1.y += s1 * wv.y; a1.z += s1 * wv.z; a1.w += s1 * wv.w;
        a2.x += s2 * wv.x; a2.y += s2 * wv.y; a2.z += s2 * wv.z; a2.w += s2 * wv.w;
        a3.x += s3 * wv.x; a3.y += s3 * wv.y; a3.z += s3 * wv.z; a3.w += s3 * wv.w;
        a4.x += s4 * wv.x; a4.y += s4 * wv.y; a4.z += s4 * wv.z; a4.w += s4 * wv.w;
    }
    if (kc == 0) {
        const float4 bb = *(const float4*)(b_mod + li * 6144 + n);
        a0.x += bb.x; a0.y += bb.y; a0.z += bb.z; a0.w += bb.w; a1.x += bb.x; a1.y += bb.y; a1.z += bb.z; a1.w += bb.w;
        a2.x += bb.x; a2.y += bb.y; a2.z += bb.z; a2.w += bb.w; a3.x += bb.x; a3.y += bb.y; a3.z += bb.z; a3.w += bb.w;
        a4.x += bb.x; a4.y += bb.y; a4.z += bb.z; a4.w += bb.w;
    }
    float* o = mod + (size_t)(li * 5) * 6144 + n;
    atomicAdd(o + 0, a0.x); atomicAdd(o + 1, a0.y); atomicAdd(o + 2, a0.z); atomicAdd(o + 3, a0.w);
    atomicAdd(o + 6144 + 0, a1.x); atomicAdd(o + 6144 + 1, a1.y); atomicAdd(o + 6144 + 2, a1.z); atomicAdd(o + 6144 + 3, a1.w);
    atomicAdd(o + 2 * 6144 + 0, a2.x); atomicAdd(o + 2 * 6144 + 1, a2.y); atomicAdd(o + 2 * 6144 + 2, a2.z); atomicAdd(o + 2 * 6144 + 3, a2.w);
    atomicAdd(o + 3 * 6144 + 0, a3.x); atomicAdd(o + 3 * 6144 + 1, a3.y); atomicAdd(o + 3 * 6144 + 2, a3.z); atomicAdd(o + 3 * 6144 + 3, a3.w);
    atomicAdd(o + 4 * 6144 + 0, a4.x); atomicAdd(o + 4 * 6144 + 1, a4.y); atomicAdd(o + 4 * 6144 + 2, a4.z); atomicAdd(o + 4 * 6144 + 3, a4.w);
}

__device__ __forceinline__ void d_norm_mod(const int bx, const int by, const int bz, char* smem, const float* __restrict__ xa, const float* __restrict__ xb, const float* __restrict__ g,
                                                  const float* __restrict__ modl, int shift_idx, int scale_idx, bf16_t* __restrict__ h) {
    float* red = (float*)smem;
    const int t = bx;
    const float* x = (t < TP) ? (xa + (size_t)t * DM) : (xb + (size_t)(t - TP) * DM);
    const int c = threadIdx.x * 4;
    float4 v = *(const float4*)(x + c);
    float ss = v.x * v.x + v.y * v.y + v.z * v.z + v.w * v.w;
    ss = wave_sum(ss);
    if ((threadIdx.x & 63) == 0) red[threadIdx.x >> 6] = ss;
    __syncthreads();
    float tot = red[0] + red[1] + red[2] + red[3];
    float rstd = rsqrtf(tot * (1.f / DM) + 1e-6f);
    const float* m = modl + (size_t)tok_modrow(t) * 6144;
    float4 gg = *(const float4*)(g + c);
    float4 sh = *(const float4*)(m + shift_idx * 1024 + c);
    float4 sc = *(const float4*)(m + scale_idx * 1024 + c);
    float4 o;
    o.x = v.x * rstd * gg.x * (1.f + sc.x) + sh.x;
    o.y = v.y * rstd * gg.y * (1.f + sc.y) + sh.y;
    o.z = v.z * rstd * gg.z * (1.f + sc.z) + sh.z;
    o.w = v.w * rstd * gg.w * (1.f + sc.w) + sh.w;
    ushort4 ob; ob.x = f2bf(o.x); ob.y = f2bf(o.y); ob.z = f2bf(o.z); ob.w = f2bf(o.w);
    *(ushort4*)(h + (size_t)t * DM + c) = ob;
}

struct EpiStore { static constexpr bool kQuad = false; float* C; const float* bias; int ldc; int pad;
    __device__ void operator()(int m, int n, float a) const { C[(size_t)m * ldc + n] = a + (bias ? bias[n] : 0.f); } };
struct EpiStoreBf { static constexpr bool kQuad = false; bf16_t* C; int ldc; int pad;
    __device__ void operator()(int m, int n, float a) const { C[(size_t)m * ldc + n] = f2bf(a); } };
struct EpiDecay { static constexpr bool kQuad = false; _Float16* out; const float* w0;
    __device__ void operator()(int m, int n, float a) const { out[(size_t)m * 512 + n] = (_Float16)sigmoidf_(w0[n] + a); } };
struct EpiProj { static constexpr bool kQuad = false; bf16_t* rw; float* mla;
    __device__ void operator()(int m, int n, float a) const { if (n < RWIN) rw[(size_t)m * RWIN + n] = f2bf(a); else mla[(size_t)m * 448 + (n - RWIN)] = a; } };
struct EpiLr { static constexpr bool kQuad = false; bf16_t* out; const float* a0;
    __device__ void operator()(int m, int n, float a) const { out[(size_t)m * 512 + n] = f2bf(sigmoidf_(a0[n] + a)); } };
struct EpiResid { static constexpr bool kQuad = false; const float* xa; const float* xb; float* out; const float* modl; int gate_idx; int pad;
    __device__ void operator()(int m, int n, float a) const {
        float x = (m < TP) ? xa[(size_t)m * DM + n] : xb[(size_t)(m - TP) * DM + n];
        float gt = modl[(size_t)tok_modrow(m) * 6144 + gate_idx * 1024 + n];
        out[(size_t)m * DM + n] = x + gt * a; } };

struct EpiKV { static constexpr bool kQuad = true;
    bf16_t* kvraw; bf16_t* Vp; bf16_t* Vs; int ctx; int pad;
    __device__ void operator()(int m, int n, float a) const {}
    __device__ void quad(int row0, int col, float v0, float v1, float v2, float v3) const {
        const int hd = col >> 8, within = col & 255;
        if (within < 128) {
            bf16_t* d = kvraw + (size_t)row0 * 1024 + col;
            d[0] = f2bf(v0); d[1024] = f2bf(v1); d[2048] = f2bf(v2); d[3072] = f2bf(v3);
        } else {
            const int dv = within - 128;
            int b, kidx, Lk; bf16_t* base;
            if (ctx) { b = row0 >> 8; kidx = row0 & 255; Lk = 2304; base = Vs; }
            else if (row0 < TP) { b = row0 >> 8; kidx = row0 & 255; Lk = LP; base = Vp; }
            else { b = (row0 - TP) >> 11; kidx = 256 + ((row0 - TP) & 2047); Lk = 2304; base = Vs; }
            const int kpos = (kidx & ~12) | ((kidx & 8) >> 1) | ((kidx & 4) << 1);
            ushort4 o; o.x = f2bf(v0); o.y = f2bf(v1); o.z = f2bf(v2); o.w = f2bf(v3);
            *(ushort4*)(base + ((size_t)((b * 4 + hd) * 128 + dv)) * Lk + kpos) = o;
        }
    } };

template <class Epi>
__device__ __forceinline__ void d_gemm(const int bx, const int by, const int bz, char* smem, const float* __restrict__ A, int lda, const float* __restrict__ B, int ldb, int K, Epi epi) {
    float (*As)[68] = (float(*)[68])smem;
    float (*Bs)[68] = (float(*)[68])(smem + 16 * 68 * 4);
    const int m0 = by * 64, n0 = bx * 64;
    const int tid = threadIdx.x, tx = tid & 15, ty = tid >> 4;
    float acc[4][4];
#pragma unroll
    for (int i = 0; i < 4; i++)
#pragma unroll
        for (int j = 0; j < 4; j++) acc[i][j] = 0.f;
    for (int k0 = 0; k0 < K; k0 += 16) {
        {
            int r = tid >> 2, kq = (tid & 3) * 4;
            float4 v = *(const float4*)(A + (size_t)(m0 + r) * lda + k0 + kq);
            As[kq + 0][r] = v.x; As[kq + 1][r] = v.y; As[kq + 2][r] = v.z; As[kq + 3][r] = v.w;
        }
        {
            int kk = tid >> 4, nq = (tid & 15) * 4;
            float4 v = *(const float4*)(B + (size_t)(k0 + kk) * ldb + n0 + nq);
            *(float4*)&Bs[kk][nq] = v;
        }
        __syncthreads();
#pragma unroll
        for (int k = 0; k < 16; k++) {
            float a[4], b[4];
#pragma unroll
            for (int i = 0; i < 4; i++) a[i] = As[k][ty * 4 + i];
            float4 bv = *(const float4*)&Bs[k][tx * 4];
            b[0] = bv.x; b[1] = bv.y; b[2] = bv.z; b[3] = bv.w;
#pragma unroll
            for (int i = 0; i < 4; i++)
#pragma unroll
                for (int j = 0; j < 4; j++) acc[i][j] += a[i] * b[j];
        }
        __syncthreads();
    }
#pragma unroll
    for (int i = 0; i < 4; i++)
#pragma unroll
        for (int j = 0; j < 4; j++) epi(m0 + ty * 4 + i, n0 + tx * 4 + j, acc[i][j]);
}


typedef __attribute__((ext_vector_type(8))) short bf16x8;
typedef __attribute__((ext_vector_type(16))) float f32x16;
typedef __attribute__((ext_vector_type(4))) float f32x4;
typedef __attribute__((ext_vector_type(4))) unsigned u32x4;
#define GEMM_LDS_BYTES 73728

template <class Epi>
__device__ __forceinline__ void d_gemm_bf16(const int bx, const int by, char* smem, const bf16_t* __restrict__ A, int lda,
                                            const bf16_t* __restrict__ Bt, int ldb, int K, int N, Epi epi) {
    const int tid = threadIdx.x, lane = tid & 63, wid = tid >> 6;
    const int wm = wid >> 1, wn = wid & 1;
    const int m0 = by * 128, n0 = bx * 128;
    f32x16 acc[2][2];
#pragma unroll
    for (int i = 0; i < 2; i++)
#pragma unroll
        for (int j = 0; j < 2; j++)
#pragma unroll
            for (int r = 0; r < 16; r++) acc[i][j][r] = 0.f;
    const int lrow = tid >> 3, lcol = (tid & 7) * 8;
    const bf16_t* ga = A + (size_t)(m0 + lrow) * lda + lcol;
    const bf16_t* gb = Bt + (size_t)(n0 + lrow) * ldb + lcol;
    u32x4 ra[4], rb[4];
    const int KT = K >> 6;
#pragma unroll
    for (int i = 0; i < 4; i++) { ra[i] = *(const u32x4*)(ga + (size_t)(32 * i) * lda); rb[i] = *(const u32x4*)(gb + (size_t)(32 * i) * ldb); }
    {
        char* sa = smem;
#pragma unroll
        for (int i = 0; i < 4; i++) { *(u32x4*)(sa + (lrow + 32 * i) * 144 + lcol * 2) = ra[i]; *(u32x4*)(sa + 18432 + (lrow + 32 * i) * 144 + lcol * 2) = rb[i]; }
    }
    __syncthreads();
    const int frow = lane & 31, fk = (lane >> 5) * 16;
    for (int kt = 0; kt < KT; kt++) {
        if (kt + 1 < KT) {
#pragma unroll
            for (int i = 0; i < 4; i++) { ra[i] = *(const u32x4*)(ga + (size_t)(32 * i) * lda + (kt + 1) * 64); rb[i] = *(const u32x4*)(gb + (size_t)(32 * i) * ldb + (kt + 1) * 64); }
        }
        const char* sa = smem + (kt & 1) * 36864;
        const char* sb = sa + 18432;
#pragma unroll
        for (int ks = 0; ks < 4; ks++) {
            bf16x8 af[2], bfr[2];
#pragma unroll
            for (int i = 0; i < 2; i++) af[i] = *(const bf16x8*)(sa + (wm * 64 + i * 32 + frow) * 144 + ks * 32 + fk);
#pragma unroll
            for (int j = 0; j < 2; j++) bfr[j] = *(const bf16x8*)(sb + (wn * 64 + j * 32 + frow) * 144 + ks * 32 + fk);
#pragma unroll
            for (int i = 0; i < 2; i++)
#pragma unroll
                for (int j = 0; j < 2; j++) acc[i][j] = __builtin_amdgcn_mfma_f32_32x32x16_bf16(af[i], bfr[j], acc[i][j], 0, 0, 0);
        }
        if (kt + 1 < KT) {
            char* sn = smem + ((kt + 1) & 1) * 36864;
#pragma unroll
            for (int i = 0; i < 4; i++) { *(u32x4*)(sn + (lrow + 32 * i) * 144 + lcol * 2) = ra[i]; *(u32x4*)(sn + 18432 + (lrow + 32 * i) * 144 + lcol * 2) = rb[i]; }
        }
        __syncthreads();
    }
#pragma unroll
    for (int i = 0; i < 2; i++)
#pragma unroll
        for (int j = 0; j < 2; j++) {
            const int col = n0 + wn * 64 + j * 32 + (lane & 31);
            if (col < N) {
                if constexpr (Epi::kQuad) {
#pragma unroll
                    for (int g = 0; g < 4; g++) {
                        const int row0 = m0 + wm * 64 + i * 32 + 8 * g + 4 * (lane >> 5);
                        epi.quad(row0, col, acc[i][j][4 * g], acc[i][j][4 * g + 1], acc[i][j][4 * g + 2], acc[i][j][4 * g + 3]);
                    }
                } else {
#pragma unroll
                    for (int r = 0; r < 16; r++) {
                        const int row = m0 + wm * 64 + i * 32 + (r & 3) + 8 * (r >> 2) + 4 * (lane >> 5);
                        epi(row, col, acc[i][j][r]);
                    }
                }
            }
        }
}

__device__ __forceinline__ void d_transpose_w(const int vb, char* smem, const float* __restrict__ W, int K, int N, bf16_t* __restrict__ Wt) {
    float (*tile)[65] = (float(*)[65])smem;
    const int kt = K >> 6;
    const int nb = vb / kt, kb = vb % kt;
    const int tid = threadIdx.x;
    {
        const int n = nb * 64 + (tid & 63);
#pragma unroll
        for (int i = 0; i < 16; i++) {
            int k = (tid >> 6) + 4 * i;
            tile[k][tid & 63] = (n < N) ? W[(size_t)(kb * 64 + k) * N + n] : 0.f;
        }
    }
    __syncthreads();
    {
        const int k = tid & 63;
#pragma unroll
        for (int i = 0; i < 16; i++) {
            int n = (tid >> 6) + 4 * i;
            Wt[(size_t)(nb * 64 + n) * K + kb * 64 + k] = f2bf(tile[k][n]);
        }
    }
}

__device__ __forceinline__ void d_rw_shift(const int bx, const int by, const int bz, char* smem, const bf16_t* __restrict__ proj, const float* __restrict__ mu, bf16_t* __restrict__ rb,
                                                  bf16_t* __restrict__ kb, bf16_t* __restrict__ vb, bf16_t* __restrict__ tw, bf16_t* __restrict__ adv,
                                                  bf16_t* __restrict__ sg) {
    const int t = bx;
    const int pos = tok_pos(t), L = tok_len(t);
    const bf16_t* P = proj + (size_t)t * RWIN;
    for (int c = threadIdx.x; c < RWIN; c += 256) {
        float cur = bf2f(P[c]);
        float prev = (pos > 0) ? bf2f(P[c - RWIN]) : 0.f;
        float nxt = (pos < L - 1) ? bf2f(P[c + RWIN]) : 0.f;
        float val = cur + mu[c] * (0.5f * (prev + nxt) - cur);
        if (c < 512) rb[(size_t)t * 512 + c] = f2bf(val);
        else if (c < 1024) kb[(size_t)t * 512 + c - 512] = f2bf(val);
        else if (c < 1536) vb[(size_t)t * 512 + c - 1024] = f2bf(val);
        else if (c < 1600) tw[(size_t)t * 64 + c - 1536] = f2bf(tanhf(val));
        else if (c < 1664) adv[(size_t)t * 64 + c - 1600] = f2bf(val);
        else sg[(size_t)t * 128 + c - 1664] = f2bf(sigmoidf_(val));
    }
}

__device__ __forceinline__ void d_rw_kk(const int bx, const int by, const int bz, char* smem, const bf16_t* __restrict__ rb, const bf16_t* __restrict__ kb, const bf16_t* __restrict__ lr0,
                                               const bf16_t* __restrict__ lr1, const float* __restrict__ k_k, const float* __restrict__ k_a,
                                               const float* __restrict__ r_k, bf16_t* __restrict__ kkb, float* __restrict__ bonus) {
    const int w = bx * 4 + (threadIdx.x >> 6);
    const int lane = threadIdx.x & 63;
    const int t = w >> 3, h = w & 7;
    const size_t o = (size_t)t * 512 + h * 64 + lane;
    const int ch = h * 64 + lane;
    float k = bf2f(kb[o]), r = bf2f(rb[o]);
    float kk = k * k_k[ch];
    float nrm = sqrtf(wave_sum(kk * kk));
    kk = kk / fmaxf(nrm, 1e-12f);
    kkb[o] = f2bf(kk);
    float l0 = bf2f(lr0[o]), l1 = bf2f(lr1[o]);
    float ka = k_a[ch];
    float kd0 = k * (1.f + (l0 - 1.f) * ka), kd1 = k * (1.f + (l1 - 1.f) * ka);
    float s = wave_sum(r * (kd0 + kd1) * r_k[ch]);
    if (lane == 0) bonus[w] = s;
}

__device__ __forceinline__ void d_scan(const int bx, const int by, const int bz, char* smem, const bf16_t* __restrict__ rb, const bf16_t* __restrict__ kb, const bf16_t* __restrict__ vb,
                                             const bf16_t* __restrict__ kkb, const bf16_t* __restrict__ lr0, const bf16_t* __restrict__ lr1,
                                             const _Float16* __restrict__ dec0, const _Float16* __restrict__ dec1, const float* __restrict__ k_a,
                                             const float* __restrict__ st_f, const float* __restrict__ st_b, float* __restrict__ y0,
                                             float* __restrict__ y1, float* __restrict__ out_sf, float* __restrict__ out_sb) {
    float* sbase = (float*)smem + (threadIdx.x >> 6) * 320;
    float* sa_ = sbase; float* sw_ = sbase + 64; float* sb_ = sbase + 128; float* skd_ = sbase + 192; float* sr_ = sbase + 256;
    int id = bx * 4 + (threadIdx.x >> 6);
    int d, h, b, L, tbase;
    bool prompt = id < 256;
    if (prompt) { d = id & 1; h = (id >> 1) & 7; b = id >> 4; L = LP; tbase = b * LP; }
    else { int j = id - 256; d = j & 1; h = (j >> 1) & 7; b = j >> 4; L = LS; tbase = TP + b * LS; }
    const int v = threadIdx.x & 63;
    const bf16_t* lr = d ? lr1 : lr0;
    const _Float16* dec = d ? dec1 : dec0;
    float* yo = d ? y1 : y0;
    const float ka = k_a[h * 64 + v];
    float S[64];
    if (prompt) {
#pragma unroll
        for (int k = 0; k < 64; k++) S[k] = 0.f;
    } else {
        const float* st = (d ? st_b : st_f) + ((size_t)(b * 8 + h) * 64 + v) * 64;
#pragma unroll
        for (int k = 0; k < 64; k += 4) { float4 q = *(const float4*)(st + k); S[k] = q.x; S[k + 1] = q.y; S[k + 2] = q.z; S[k + 3] = q.w; }
    }
    for (int i = 0; i < L; i++) {
        const int t = tbase + (d ? (L - 1 - i) : i);
        const size_t o = (size_t)t * 512 + h * 64 + v;
        float kkv = bf2f(kkb[o]), lrv = bf2f(lr[o]), kv = bf2f(kb[o]), rv = bf2f(rb[o]), vv = bf2f(vb[o]), wv = __expf(-0.6065306597126334f * (float)dec[o]);
        __builtin_amdgcn_wave_barrier();
        sa_[v] = -kkv; sb_[v] = kkv * lrv; skd_[v] = kv * (1.f + (lrv - 1.f) * ka); sw_[v] = wv; sr_[v] = rv;
        __builtin_amdgcn_wave_barrier();
        float sa = 0.f;
#pragma unroll
        for (int k = 0; k < 64; k += 4) { float4 a = *(const float4*)&sa_[k]; sa += S[k] * a.x + S[k + 1] * a.y + S[k + 2] * a.z + S[k + 3] * a.w; }
        float y = 0.f;
#pragma unroll
        for (int k = 0; k < 64; k += 4) {
            float4 w4 = *(const float4*)&sw_[k]; float4 b4 = *(const float4*)&sb_[k]; float4 k4 = *(const float4*)&skd_[k]; float4 r4 = *(const float4*)&sr_[k];
            S[k] = S[k] * w4.x + sa * b4.x + vv * k4.x; y += S[k] * r4.x;
            S[k + 1] = S[k + 1] * w4.y + sa * b4.y + vv * k4.y; y += S[k + 1] * r4.y;
            S[k + 2] = S[k + 2] * w4.z + sa * b4.z + vv * k4.z; y += S[k + 2] * r4.z;
            S[k + 3] = S[k + 3] * w4.w + sa * b4.w + vv * k4.w; y += S[k + 3] * r4.w;
        }
        yo[o] = y;
    }
    if (prompt) {
        float* os = (d ? out_sb : out_sf) + ((size_t)(b * 8 + h) * 64 + v) * 64;
#pragma unroll
        for (int k = 0; k < 64; k += 4) *(float4*)(os + k) = make_float4(S[k], S[k + 1], S[k + 2], S[k + 3]);
    }
}


#define SC_STEP 336
template <int CTRL>
__device__ __forceinline__ float dpp_add(float v) {
    return v + __int_as_float(__builtin_amdgcn_update_dpp(0, __float_as_int(v), CTRL, 0xf, 0xf, false));
}
__device__ __forceinline__ float row16_allsum(float v) {
    v = dpp_add<0x128>(v); v = dpp_add<0x124>(v); v = dpp_add<0x122>(v); v = dpp_add<0x121>(v);
    return v;
}
__device__ __forceinline__ void d_scan2(const int item, const bool sample, char* smem, const bf16_t* __restrict__ rb, const bf16_t* __restrict__ kb,
                                        const bf16_t* __restrict__ vb, const bf16_t* __restrict__ kkb, const bf16_t* __restrict__ lr0,
                                        const bf16_t* __restrict__ lr1, const _Float16* __restrict__ du0, const _Float16* __restrict__ du1,
                                        const float* __restrict__ k_a, const float* __restrict__ st_f, const float* __restrict__ st_b,
                                        float* __restrict__ y0, float* __restrict__ y1, float* __restrict__ out_sf, float* __restrict__ out_sb) {
    const int chain = item >> 2, qd = item & 3;
    const int d = chain & 1, h = (chain >> 1) & 7, b = chain >> 4;
    const int L = sample ? LS : LP;
    const int tbase = sample ? (TP + b * LS) : (b * LP);
    const int tid = threadIdx.x, wid = tid >> 6, lane = tid & 63;
    const int rr = lane >> 4, pp = lane & 15;
    const int row = qd * 16 + wid * 4 + rr;
    const bf16_t* lr = d ? lr1 : lr0;
    const _Float16* du = d ? du1 : du0;
    float* yo = d ? y1 : y0;
    float S0, S1, S2, S3;
    if (sample) {
        const float4 s4 = *(const float4*)((d ? st_b : st_f) + ((size_t)(b * 8 + h) * 64 + row) * 64 + pp * 4);
        S0 = s4.x; S1 = s4.y; S2 = s4.z; S3 = s4.w;
    } else { S0 = S1 = S2 = S3 = 0.f; }
    const int sk = tid & 63, ss = tid >> 6;
    const float ka = k_a[h * 64 + sk];
    const size_t colk = (size_t)h * 64 + sk;
    const size_t colv = (size_t)h * 64 + qd * 16 + (tid & 15);
    float* buf = (float*)smem;
    unsigned gA_kk[4], gA_lr[4], gA_k[4], gA_r[4], gA_u[4], gA_v;
    unsigned gB_kk[4], gB_lr[4], gB_k[4], gB_r[4], gB_u[4], gB_v;
    const int nch = L >> 4;
#define SC_GLOAD(X, c)                                                                                     \
    {                                                                                                      \
        _Pragma("unroll") for (int j = 0; j < 4; j++) {                                                    \
            const int i = (c) * 16 + ss + 4 * j;                                                           \
            const size_t o = (size_t)(tbase + (d ? (L - 1 - i) : i)) * 512 + colk;                         \
            X##_kk[j] = kkb[o]; X##_lr[j] = lr[o]; X##_k[j] = kb[o]; X##_r[j] = rb[o]; X##_u[j] = ((const unsigned short*)du)[o]; \
        }                                                                                                  \
        { const int i = (c) * 16 + (tid >> 4); X##_v = vb[(size_t)(tbase + (d ? (L - 1 - i) : i)) * 512 + colv]; } \
    }
#define SC_SSTORE(X, bi)                                                                                   \
    {                                                                                                      \
        float* B_ = buf + (bi) * 16 * SC_STEP;                                                             \
        _Pragma("unroll") for (int j = 0; j < 4; j++) {                                                    \
            float* st_ = B_ + (ss + 4 * j) * SC_STEP + sk;                                                 \
            const float kkv = __uint_as_float(X##_kk[j] << 16), lrv = __uint_as_float(X##_lr[j] << 16), kv = __uint_as_float(X##_k[j] << 16); \
            st_[0] = -kkv; st_[64] = __expf(-0.6065306597126334f * (float)__builtin_bit_cast(_Float16, (unsigned short)X##_u[j])); st_[128] = kkv * lrv;   \
            st_[192] = kv * (1.f + (lrv - 1.f) * ka); st_[256] = __uint_as_float(X##_r[j] << 16);          \
        }                                                                                                  \
        B_[(tid >> 4) * SC_STEP + 320 + (tid & 15)] = __uint_as_float(X##_v << 16);                        \
    }
#define SC_COMPUTE(c)                                                                                      \
    {                                                                                                      \
        const float* B_ = buf + ((c) & 1) * 16 * SC_STEP;                                                  \
        float ysave = 0.f;                                                                                 \
        _Pragma("unroll 4") for (int s_ = 0; s_ < 16; s_++) {                                              \
            const float* st_ = B_ + s_ * SC_STEP;                                                          \
            const float4 a4 = *(const float4*)(st_ + pp * 4);                                              \
            const float4 w4 = *(const float4*)(st_ + 64 + pp * 4);                                         \
            const float4 b4 = *(const float4*)(st_ + 128 + pp * 4);                                        \
            const float4 k4 = *(const float4*)(st_ + 192 + pp * 4);                                        \
            const float4 r4 = *(const float4*)(st_ + 256 + pp * 4);                                        \
            const float vv = st_[320 + wid * 4 + rr];                                                      \
            float sa = (S0 * a4.x + S1 * a4.y) + (S2 * a4.z + S3 * a4.w);                                  \
            const float p0 = S0 * w4.x + vv * k4.x, p1 = S1 * w4.y + vv * k4.y, p2 = S2 * w4.z + vv * k4.z, p3 = S3 * w4.w + vv * k4.w; \
            sa = row16_allsum(sa);                                                                         \
            S0 = sa * b4.x + p0; S1 = sa * b4.y + p1; S2 = sa * b4.z + p2; S3 = sa * b4.w + p3;            \
            float y = (S0 * r4.x + S1 * r4.y) + (S2 * r4.z + S3 * r4.w);                                   \
            y = row16_allsum(y);                                                                           \
            ysave = (pp == s_) ? y : ysave;                                                                \
        }                                                                                                  \
        { const int i = (c) * 16 + pp; yo[(size_t)(tbase + (d ? (L - 1 - i) : i)) * 512 + h * 64 + row] = ysave; } \
    }
    SC_GLOAD(gA, 0)
    SC_SSTORE(gA, 0)
    if (nch > 1) SC_GLOAD(gA, 1)
    __syncthreads();
    for (int c = 0; c < nch; c += 2) {
        if (c + 2 < nch) SC_GLOAD(gB, c + 2)
        __builtin_amdgcn_sched_barrier(0);
        SC_COMPUTE(c)
        __builtin_amdgcn_sched_barrier(0);
        SC_SSTORE(gA, 1)
        __syncthreads();
        if (c + 3 < nch) SC_GLOAD(gA, c + 3)
        __builtin_amdgcn_sched_barrier(0);
        SC_COMPUTE(c + 1)
        __builtin_amdgcn_sched_barrier(0);
        if (c + 2 < nch) SC_SSTORE(gB, 0)
        __syncthreads();
    }
    if (!sample) {
        float* os = (d ? out_sb : out_sf) + ((size_t)(b * 8 + h) * 64 + row) * 64 + pp * 4;
        *(float4*)os = make_float4(S0, S1, S2, S3);
    }
}

__device__ __forceinline__ void d_rw_post(const int bx, const int by, const int bz, char* smem, const float* __restrict__ y0, const float* __restrict__ y1, const float* __restrict__ bonus,
                                                 const bf16_t* __restrict__ vb, const bf16_t* __restrict__ gate, const float* __restrict__ lnx_g,
                                                 const float* __restrict__ lnx_b, bf16_t* __restrict__ cat) {
    const int w = bx * 4 + (threadIdx.x >> 6);
    const int lane = threadIdx.x & 63;
    const int t = w >> 3, h = w & 7;
    const size_t o = (size_t)t * 512 + h * 64 + lane;
    const int ch = h * 64 + lane;
    float y = y0[o] + y1[o];
    float mean = wave_sum(y) * (1.f / 64.f);
    float dlt = y - mean;
    float var = wave_sum(dlt * dlt) * (1.f / 64.f);
    float yn = dlt * rsqrtf(var + 64e-5f) * lnx_g[ch] + lnx_b[ch];
    float val = (yn + bonus[w] * bf2f(vb[o])) * bf2f(gate[o]);
    cat[(size_t)t * DM + ch] = f2bf(val);
}

__device__ __forceinline__ void d_mla_pre(const int bx, const int by, const int bz, char* smem, const float* __restrict__ proj, const float* __restrict__ q_norm, const float* __restrict__ kv_norm,
                                                 bf16_t* __restrict__ qcn, bf16_t* __restrict__ ckv, float* __restrict__ kpe,
                                                 float* __restrict__ out_ckv, float* __restrict__ out_kpe) {
    float* red = (float*)smem; float* red2 = red + 4;
    const int t = bx;
    const int tid = threadIdx.x;
    const float* P = proj + (size_t)t * 448;
    float q = P[tid];
    float kv = (tid < 128) ? P[256 + tid] : 0.f;
    float ss = wave_sum(q * q);
    float s2 = wave_sum(kv * kv);
    if ((tid & 63) == 0) { red[tid >> 6] = ss; red2[tid >> 6] = s2; }
    __syncthreads();
    float rq = rsqrtf((red[0] + red[1] + red[2] + red[3]) * (1.f / 256.f) + 1e-6f);
    float rk = rsqrtf((red2[0] + red2[1] + red2[2] + red2[3]) * (1.f / 128.f) + 1e-6f);
    qcn[(size_t)t * 256 + tid] = f2bf(q * rq * q_norm[tid]);
    if (tid < 128) {
        float val = kv * rk * kv_norm[tid];
        ckv[(size_t)t * 128 + tid] = f2bf(val);
        if (t < TP) out_ckv[(size_t)t * 128 + tid] = val;
    } else if (tid < 192) {
        float pe = P[384 + tid - 128];
        kpe[(size_t)t * 64 + tid - 128] = pe;
        if (t < TP) out_kpe[(size_t)t * 64 + tid - 128] = pe;
    }
}

__device__ __forceinline__ void d_mla_post(const int bx, const int by, const int bz, char* smem, const bf16_t* __restrict__ qraw, const bf16_t* __restrict__ kvraw, const bf16_t* __restrict__ kvraw_ctx,
                                                  const float* __restrict__ kpe, const float* __restrict__ cache_kpe, const float* __restrict__ qn,
                                                  const float* __restrict__ kn, bf16_t* __restrict__ Qb, bf16_t* __restrict__ Kp, bf16_t* __restrict__ Vp,
                                                  bf16_t* __restrict__ Ks, bf16_t* __restrict__ Vs) {
    float (*sq)[192] = (float(*)[192])smem; float (*sk)[192] = (float(*)[192])(smem + 4 * 192 * 4);
    const int wi = threadIdx.x >> 6, lane = threadIdx.x & 63;
    const int row = bx, h = wi;
    const bool isctx = row >= TT;
    const bool sample = row >= TP;
    float kx[3], qx[3] = {0.f, 0.f, 0.f};
    const bf16_t* kvr; const float* pe; int pos = 0;
    if (isctx) { int cr = row - TT; kvr = kvraw_ctx + (size_t)cr * 1024; pe = cache_kpe + (size_t)cr * 64; }
    else { kvr = kvraw + (size_t)row * 1024; pe = kpe + (size_t)row * 64; pos = tok_pos(row); }
#pragma unroll
    for (int j = 0; j < 3; j++) {
        int i = lane + 64 * j;
        kx[j] = (i < 128) ? bf2f(kvr[h * 256 + i]) : pe[i - 128];
        if (!isctx) qx[j] = bf2f(qraw[(size_t)row * 768 + h * 192 + i]);
    }
    float ssk = wave_sum(kx[0] * kx[0] + kx[1] * kx[1] + kx[2] * kx[2]);
    float ssq = wave_sum(qx[0] * qx[0] + qx[1] * qx[1] + qx[2] * qx[2]);
    float rk = rsqrtf(ssk * (1.f / 192.f) + 1e-6f), rq = rsqrtf(ssq * (1.f / 192.f) + 1e-6f);
#pragma unroll
    for (int j = 0; j < 3; j++) {
        int i = lane + 64 * j;
        sk[wi][i] = kx[j] * rk * kn[i];
        sq[wi][i] = qx[j] * rq * qn[i];
    }
    __syncthreads();
    if (sample && !isctx && lane < 32) {
        int rowi = pos >> 6, coli = pos & 63;
        int fi = lane & 15;
        float inv = expf(-(float)fi * (1.f / 16.f) * 9.210340371976184f);
        float ang = (lane < 16 ? (float)rowi : (float)coli) * inv;
        float cs = cosf(ang), sn = sinf(ang);
        float a = sk[wi][128 + 2 * lane], bq = sk[wi][128 + 2 * lane + 1];
        sk[wi][128 + 2 * lane] = a * cs - bq * sn; sk[wi][128 + 2 * lane + 1] = a * sn + bq * cs;
        a = sq[wi][128 + 2 * lane]; bq = sq[wi][128 + 2 * lane + 1];
        sq[wi][128 + 2 * lane] = a * cs - bq * sn; sq[wi][128 + 2 * lane + 1] = a * sn + bq * cs;
    }
    __syncthreads();
    bf16_t* kd; bf16_t* vd; int vLk, kidx;
    if (!sample) { int b = row >> 8, p = row & 255; kd = Kp + ((size_t)(b * 4 + h) * LP + p) * 192; vd = Vp + (size_t)(b * 4 + h) * 128 * LP; vLk = LP; kidx = p; }
    else if (!isctx) { int b = (row - TP) >> 11, p = (row - TP) & 2047; kd = Ks + ((size_t)(b * 4 + h) * 2304 + 256 + p) * 192; vd = Vs + (size_t)(b * 4 + h) * 128 * 2304; vLk = 2304; kidx = 256 + p; }
    else { int cr = row - TT; int b = cr >> 8, p = cr & 255; kd = Ks + ((size_t)(b * 4 + h) * 2304 + p) * 192; vd = Vs + (size_t)(b * 4 + h) * 128 * 2304; vLk = 2304; kidx = p; }
    const int kpos = (kidx & ~12) | ((kidx & 8) >> 1) | ((kidx & 4) << 1);
#pragma unroll
    for (int j = 0; j < 3; j++) {
        int i = lane + 64 * j;
        kd[i] = f2bf(sk[wi][i]);
        if (!isctx) Qb[((size_t)row * 4 + h) * 192 + i] = f2bf(sq[wi][i]);
    }
    vd[(size_t)lane * vLk + kpos] = kvr[h * 256 + 128 + lane];
    vd[(size_t)(lane + 64) * vLk + kpos] = kvr[h * 256 + 128 + lane + 64];
}

__device__ __forceinline__ void d_attn(const int bx, const int by, const int bz, char* smem, const bf16_t* __restrict__ Qb, const bf16_t* __restrict__ Kall, const bf16_t* __restrict__ Vall,
                                              bf16_t* __restrict__ cat, int tbase, int Lq, int Lk) {
    float (*Vsm)[128] = (float(*)[128])smem;
    float (*Qs)[192] = (float(*)[192])(smem + 32 * 128 * 4);
    float (*Ksm)[193] = (float(*)[193])(smem + 32 * 128 * 4 + 16 * 192 * 4);
    float (*Ss)[33] = (float(*)[33])(smem + 32 * 128 * 4 + 16 * 192 * 4 + 32 * 193 * 4);
    const int q0 = bx * 16, h = by, b = bz;
    const int tid = threadIdx.x;
    const int qi = tid >> 4, sub = tid & 15;
    const bf16_t* K = Kall + (size_t)(b * 4 + h) * Lk * 192;
    const bf16_t* V = Vall + (size_t)(b * 4 + h) * Lk * 128;
    for (int i = tid; i < 16 * 192; i += 256) {
        int r = i / 192, c = i % 192;
        int t = tbase + b * Lq + q0 + r;
        Qs[r][c] = bf2f(Qb[((size_t)t * 4 + h) * 192 + c]);
    }
    float m = -1e30f, l = 0.f;
    float acc[8];
#pragma unroll
    for (int j = 0; j < 8; j++) acc[j] = 0.f;
    const float scale = 0.07216878364870322f;
    for (int k0 = 0; k0 < Lk; k0 += 32) {
        __syncthreads();
        for (int i = tid; i < 32 * 192; i += 256) { int r = i / 192, c = i % 192; Ksm[r][c] = bf2f(K[(size_t)(k0 + r) * 192 + c]); }
        for (int i = tid; i < 32 * 128; i += 256) { int r = i >> 7, c = i & 127; Vsm[r][c] = bf2f(V[(size_t)(k0 + r) * 128 + c]); }
        __syncthreads();
        float s0 = 0.f, s1 = 0.f;
        for (int dd = 0; dd < 192; dd++) { float qv = Qs[qi][dd]; s0 += qv * Ksm[sub][dd]; s1 += qv * Ksm[sub + 16][dd]; }
        s0 *= scale; s1 *= scale;
        float mx = fmaxf(s0, s1);
#pragma unroll
        for (int o = 8; o > 0; o >>= 1) mx = fmaxf(mx, __shfl_xor(mx, o, 64));
        float mn = fmaxf(m, mx);
        float alpha = expf(m - mn);
        float p0 = expf(s0 - mn), p1 = expf(s1 - mn);
        float ps = p0 + p1;
#pragma unroll
        for (int o = 8; o > 0; o >>= 1) ps += __shfl_xor(ps, o, 64);
        l = l * alpha + ps; m = mn;
        Ss[qi][sub] = p0; Ss[qi][sub + 16] = p1;
        __syncthreads();
#pragma unroll
        for (int j = 0; j < 8; j++) acc[j] *= alpha;
        for (int kk = 0; kk < 32; kk++) {
            float p = Ss[qi][kk];
            float4 v0 = *(const float4*)&Vsm[kk][sub * 8], v1 = *(const float4*)&Vsm[kk][sub * 8 + 4];
            acc[0] += p * v0.x; acc[1] += p * v0.y; acc[2] += p * v0.z; acc[3] += p * v0.w;
            acc[4] += p * v1.x; acc[5] += p * v1.y; acc[6] += p * v1.z; acc[7] += p * v1.w;
        }
    }
    const int t = tbase + b * Lq + q0 + qi;
    float il = 1.f / l;
    bf16_t* o = cat + (size_t)t * DM + 512 + h * 128 + sub * 8;
#pragma unroll
    for (int j = 0; j < 8; j++) o[j] = f2bf(acc[j] * il);
}


#define ATT_SV_OFF 25600
#define ATT_SQ_OFF 44032
__device__ __forceinline__ void d_attn_mfma(const int item, char* smem, const bf16_t* __restrict__ Qb, const bf16_t* __restrict__ Kall,
                                            const bf16_t* __restrict__ VtAll, bf16_t* __restrict__ cat, int tbase, int Lq, int Lk, int nqb) {
    const int qb = item % nqb, bh = item / nqb;
    const int b = bh >> 2, h = bh & 3;
    const int tid = threadIdx.x, lane = tid & 63, wid = tid >> 6;
    const int q = lane & 31, hh = lane >> 5;
    const int t = tbase + b * Lq + qb * 128 + wid * 32 + q;
    bf16x8 qf[12];
    {
        const bf16_t* qp = Qb + ((size_t)t * 4 + h) * 192 + hh * 8;
#pragma unroll
        for (int ks = 0; ks < 12; ks++) qf[ks] = *(const bf16x8*)(qp + ks * 16);
    }
    f32x16 o[4];
#pragma unroll
    for (int i = 0; i < 4; i++)
#pragma unroll
        for (int r = 0; r < 16; r++) o[i][r] = 0.f;
    float m = -1e30f, l = 0.f;
    const bf16_t* K = Kall + (size_t)bh * Lk * 192;
    const bf16_t* Vt = VtAll + (size_t)bh * 128 * Lk;
    char* sK = smem;
    char* sV = smem + ATT_SV_OFF;
    u32x4 pk[6], pv[4];
    const int nkt = Lk >> 6;
#pragma unroll
    for (int i = 0; i < 6; i++) pk[i] = *(const u32x4*)(K + (size_t)(tid + 256 * i) * 8);
#pragma unroll
    for (int i = 0; i < 4; i++) { int c = tid + 256 * i; pv[i] = *(const u32x4*)(Vt + (size_t)(c >> 3) * Lk + (c & 7) * 8); }
#pragma unroll
    for (int i = 0; i < 6; i++) { int c = tid + 256 * i; *(u32x4*)(sK + (c / 24) * 400 + (c % 24) * 16) = pk[i]; }
#pragma unroll
    for (int i = 0; i < 4; i++) { int c = tid + 256 * i; *(u32x4*)(sV + (c >> 3) * 144 + (c & 7) * 16) = pv[i]; }
    __syncthreads();
    const float sc2 = 0.07216878364870322f * 1.4426950408889634f;
    for (int kt = 0; kt < nkt; kt++) {
        f32x16 st[2];
#pragma unroll
        for (int bk = 0; bk < 2; bk++)
#pragma unroll
            for (int r = 0; r < 16; r++) st[bk][r] = 0.f;
#pragma unroll
        for (int ks = 0; ks < 12; ks++) {
            const bf16x8 qfk = qf[ks];
#pragma unroll
            for (int bk = 0; bk < 2; bk++) {
                bf16x8 a = *(const bf16x8*)(sK + (bk * 32 + q) * 400 + ks * 32 + hh * 16);
                st[bk] = __builtin_amdgcn_mfma_f32_32x32x16_bf16(a, qfk, st[bk], 0, 0, 0);
            }
        }
        float mx = -1e30f;
#pragma unroll
        for (int bk = 0; bk < 2; bk++)
#pragma unroll
            for (int r = 0; r < 16; r++) { st[bk][r] *= sc2; mx = fmaxf(mx, st[bk][r]); }
        mx = fmaxf(mx, __shfl_xor(mx, 32, 64));
        const float mn = fmaxf(m, mx);
        const float alpha = exp2f(m - mn);
        float ps = 0.f;
#pragma unroll
        for (int bk = 0; bk < 2; bk++)
#pragma unroll
            for (int r = 0; r < 16; r++) { st[bk][r] = exp2f(st[bk][r] - mn); ps += st[bk][r]; }
        ps += __shfl_xor(ps, 32, 64);
        l = l * alpha + ps; m = mn;
#pragma unroll
        for (int i = 0; i < 4; i++)
#pragma unroll
            for (int r = 0; r < 16; r++) o[i][r] *= alpha;
#pragma unroll
        for (int s4 = 0; s4 < 4; s4++) {
            bf16x8 pb;
#pragma unroll
            for (int j = 0; j < 8; j++) pb[j] = (short)f2bf(st[s4 >> 1][8 * (s4 & 1) + j]);
#pragma unroll
            for (int i = 0; i < 4; i++) {
                bf16x8 a = *(const bf16x8*)(sV + (i * 32 + q) * 144 + s4 * 32 + hh * 16);
                o[i] = __builtin_amdgcn_mfma_f32_32x32x16_bf16(a, pb, o[i], 0, 0, 0);
            }
        }
        __syncthreads();
        if (kt + 1 < nkt) {
            const bf16_t* Kn = K + (size_t)(kt + 1) * 64 * 192;
            const bf16_t* Vn = Vt + (kt + 1) * 64;
#pragma unroll
            for (int i = 0; i < 6; i++) pk[i] = *(const u32x4*)(Kn + (size_t)(tid + 256 * i) * 8);
#pragma unroll
            for (int i = 0; i < 4; i++) { int c = tid + 256 * i; pv[i] = *(const u32x4*)(Vn + (size_t)(c >> 3) * Lk + (c & 7) * 8); }
#pragma unroll
            for (int i = 0; i < 6; i++) { int c = tid + 256 * i; *(u32x4*)(sK + (c / 24) * 400 + (c % 24) * 16) = pk[i]; }
#pragma unroll
            for (int i = 0; i < 4; i++) { int c = tid + 256 * i; *(u32x4*)(sV + (c >> 3) * 144 + (c & 7) * 16) = pv[i]; }
        }
        __syncthreads();
    }
    const float il = 1.f / l;
    bf16_t* op = cat + (size_t)t * DM + 512 + h * 128;
#pragma unroll
    for (int i = 0; i < 4; i++)
#pragma unroll
        for (int g = 0; g < 4; g++) {
            ushort4 w;
            w.x = f2bf(o[i][4 * g + 0] * il); w.y = f2bf(o[i][4 * g + 1] * il); w.z = f2bf(o[i][4 * g + 2] * il); w.w = f2bf(o[i][4 * g + 3] * il);
            *(ushort4*)(op + i * 32 + 8 * g + 4 * hh) = w;
        }
}

__device__ __forceinline__ void d_peer_route(const int bx, const int by, const int bz, char* smem, const float* __restrict__ qp, const float* __restrict__ keys  ,
                                                    int* __restrict__ pidx, float* __restrict__ pg) {
    float (*sq)[256] = (float(*)[256])smem;
    float (*sc)[256] = (float(*)[256])(smem + 4096);
    float (*tv)[32] = (float(*)[32])(smem + 8192);
    int (*ti)[32] = (int(*)[32])(smem + 8192 + 512);
    float (*topv)[16] = (float(*)[16])(smem + 8192 + 1024);
    int (*topi)[16] = (int(*)[16])(smem + 8192 + 1024 + 256);
    const int wi = threadIdx.x >> 6, lane = threadIdx.x & 63;
    const int w = bx * 4 + wi;
    const int t = w >> 3, h = w & 7;
    const float* q = qp + (size_t)t * 2048 + h * 256;
#pragma unroll
    for (int j = 0; j < 4; j++) sq[wi][lane + 64 * j] = q[lane + 64 * j];
    __syncthreads();
#pragma unroll
    for (int p = 0; p < 2; p++)
#pragma unroll
        for (int half = 0; half < 2; half++) {
            int n = lane + 64 * half;
            const float* kr = keys + ((size_t)(h * 2 + p) * 128 + n) * 128;
            float s = 0.f;
            for (int dd = 0; dd < 128; dd += 4) {
                float4 kv = *(const float4*)(kr + dd);
                s += sq[wi][p * 128 + dd] * kv.x + sq[wi][p * 128 + dd + 1] * kv.y + sq[wi][p * 128 + dd + 2] * kv.z + sq[wi][p * 128 + dd + 3] * kv.w;
            }
            sc[wi][p * 128 + n] = s;
        }
    __syncthreads();
#pragma unroll
    for (int p = 0; p < 2; p++)
#pragma unroll
        for (int half = 0; half < 2; half++) {
            int n = lane + 64 * half;
            float s = sc[wi][p * 128 + n];
            int rank = 0;
            for (int j = 0; j < 128; j++) { float o = sc[wi][p * 128 + j]; rank += (o > s || (o == s && j < n)) ? 1 : 0; }
            if (rank < 16) { tv[wi][p * 16 + rank] = s; ti[wi][p * 16 + rank] = n; }
        }
    __syncthreads();
    float cv[4];
#pragma unroll
    for (int j = 0; j < 4; j++) { int c = lane + 64 * j; cv[j] = tv[wi][c >> 4] + tv[wi][16 + (c & 15)]; }
    __syncthreads();
#pragma unroll
    for (int j = 0; j < 4; j++) sc[wi][lane + 64 * j] = cv[j];
    __syncthreads();
#pragma unroll
    for (int j = 0; j < 4; j++) {
        int c = lane + 64 * j;
        float s = cv[j];
        int rank = 0;
        for (int i = 0; i < 256; i++) { float o = sc[wi][i]; rank += (o > s || (o == s && i < c)) ? 1 : 0; }
        if (rank < 16) { topv[wi][rank] = s; topi[wi][rank] = (ti[wi][c >> 4] * 128 + ti[wi][16 + (c & 15)]) & 16383; }
    }
    __syncthreads();
    if (lane < 16) {
        float mx = topv[wi][0];
        float sum = 0.f;
        for (int i = 0; i < 16; i++) sum += expf(topv[wi][i] - mx);
        pg[(size_t)w * 16 + lane] = expf(topv[wi][lane] - mx) / sum;
        pidx[(size_t)w * 16 + lane] = topi[wi][lane] & 16383;
    }
}

__device__ __forceinline__ void d_peer_apply(const int bx, const int by, const int bz, char* smem, const bf16_t* __restrict__ hbuf, const int* __restrict__ pidx, const float* __restrict__ pg,
                                                    const float* __restrict__ utab, const float* __restrict__ vtab, const float* __restrict__ modl,
                                                    float* __restrict__ xrun) {
    float* coef = (float*)smem; int* eid = (int*)(smem + 512);
    const int t = bx, tid = threadIdx.x, wi = tid >> 6, lane = tid & 63;
    if (tid < 128) eid[tid] = pidx[(size_t)t * 128 + tid];
    float4 xv[4];
#pragma unroll
    for (int j = 0; j < 4; j++) { ushort4 q = *(const ushort4*)(hbuf + (size_t)t * DM + j * 256 + lane * 4); xv[j] = make_float4(bf2f(q.x), bf2f(q.y), bf2f(q.z), bf2f(q.w)); }
    __syncthreads();
    for (int e = wi * 32; e < wi * 32 + 32; e++) {
        const float* ur = utab + (size_t)eid[e] * DM;
        float s = 0.f;
#pragma unroll
        for (int j = 0; j < 4; j++) { float4 u = *(const float4*)(ur + j * 256 + lane * 4); s += u.x * xv[j].x + u.y * xv[j].y + u.z * xv[j].z + u.w * xv[j].w; }
        s = wave_sum(s);
        if (lane == 0) coef[e] = pg[(size_t)t * 128 + e] * gelu_tanh(s);
    }
    __syncthreads();
    float4 acc = make_float4(0.f, 0.f, 0.f, 0.f);
    for (int e = 0; e < 128; e++) {
        float cf = coef[e];
        float4 v = *(const float4*)(vtab + (size_t)eid[e] * DM + tid * 4);
        acc.x += cf * v.x; acc.y += cf * v.y; acc.z += cf * v.z; acc.w += cf * v.w;
    }
    const float* m = modl + (size_t)tok_modrow(t) * 6144 + 5 * 1024 + tid * 4;
    float* xo = xrun + (size_t)t * DM + tid * 4;
    float4 x = *(float4*)xo;
    x.x += m[0] * acc.x; x.y += m[1] * acc.y; x.z += m[2] * acc.z; x.w += m[3] * acc.w;
    *(float4*)xo = x;
}


template <int K, int J>
__device__ __forceinline__ void bit_stage16(float (&x)[16]) {
#pragma unroll
    for (int i = 0; i < 16; i++) {
        const int l = i ^ J;
        if (l > i) {
            const bool desc = ((i & K) == 0);
            const float a = x[i], b = x[l];
            const float hi = fmaxf(a, b), lo = fminf(a, b);
            x[i] = desc ? hi : lo; x[l] = desc ? lo : hi;
        }
    }
}
__device__ __forceinline__ void bit_sort16_desc(float (&x)[16]) {
    bit_stage16<2, 1>(x);
    bit_stage16<4, 2>(x); bit_stage16<4, 1>(x);
    bit_stage16<8, 4>(x); bit_stage16<8, 2>(x); bit_stage16<8, 1>(x);
    bit_stage16<16, 8>(x); bit_stage16<16, 4>(x); bit_stage16<16, 2>(x); bit_stage16<16, 1>(x);
}
__device__ __forceinline__ void bit_merge16_desc(float (&x)[16]) {
    bit_stage16<16, 8>(x); bit_stage16<16, 4>(x); bit_stage16<16, 2>(x); bit_stage16<16, 1>(x);
}
template <int K, int J>
__device__ __forceinline__ void bit_stage16u(unsigned (&x)[16]) {
#pragma unroll
    for (int i = 0; i < 16; i++) {
        const int l = i ^ J;
        if (l > i) {
            const bool asc = ((i & K) == 0);
            const unsigned a = x[i], b = x[l];
            const unsigned lo = a < b ? a : b, hi = a < b ? b : a;
            x[i] = asc ? lo : hi; x[l] = asc ? hi : lo;
        }
    }
}
__device__ __forceinline__ void bit_sort16u_asc(unsigned (&x)[16]) {
    bit_stage16u<2, 1>(x);
    bit_stage16u<4, 2>(x); bit_stage16u<4, 1>(x);
    bit_stage16u<8, 4>(x); bit_stage16u<8, 2>(x); bit_stage16u<8, 1>(x);
    bit_stage16u<16, 8>(x); bit_stage16u<16, 4>(x); bit_stage16u<16, 2>(x); bit_stage16u<16, 1>(x);
}
__device__ __forceinline__ void bit_merge16u_asc(unsigned (&x)[16]) {
    bit_stage16u<16, 8>(x); bit_stage16u<16, 4>(x); bit_stage16u<16, 2>(x); bit_stage16u<16, 1>(x);
}
__device__ __forceinline__ void top16_merge(float (&L)[16], const float (&C)[16]) {
#pragma unroll
    for (int i = 0; i < 16; i++) L[i] = fmaxf(L[i], C[15 - i]);
    bit_merge16_desc(L);
}
__device__ __forceinline__ void low16_merge_u(unsigned (&L)[16], const unsigned (&C)[16]) {
#pragma unroll
    for (int i = 0; i < 16; i++) { const unsigned c = C[15 - i]; L[i] = L[i] < c ? L[i] : c; }
    bit_merge16u_asc(L);
}
__device__ __forceinline__ float key_val(float k) { return __uint_as_float(__float_as_uint(k) & ~127u); }
__device__ __forceinline__ int key_idx(float k) { return (int)(__float_as_uint(k) & 127u); }

struct EpiLds { static constexpr bool kQuad = false; float* lds; int c0; int pad;
    __device__ void operator()(int m, int n, float a) const { lds[m * 128 + (n - c0)] = a; } };

__device__ __forceinline__ void top16_col(const float* __restrict__ col, float (&L)[16]) {
#pragma unroll
    for (int ch = 0; ch < 8; ch++) {
        float C[16];
#pragma unroll
        for (int i = 0; i < 16; i++) {
            const int n = ch * 16 + i;
            C[i] = __uint_as_float((__float_as_uint(col[n * 128]) & ~127u) | (unsigned)n);
        }
        bit_sort16_desc(C);
        if (ch == 0) {
#pragma unroll
            for (int i = 0; i < 16; i++) L[i] = C[i];
        } else top16_merge(L, C);
    }
}
__device__ __forceinline__ void d_peer_route2(const int vb, char* smem, const bf16_t* __restrict__ kys, const bf16_t* __restrict__ qb,
                                              int* __restrict__ pidx, float* __restrict__ pg) {
    const int tt = vb % 96, h = vb / 96;
    const int tid = threadIdx.x;
    float A[16], B[16];
#pragma unroll
    for (int p = 0; p < 2; p++) {
        const int hp = h * 2 + p;
        d_gemm_bf16(tt, 0, smem, kys + (size_t)hp * 128 * 128, 128, qb + hp * 128, 2048, 128, TT, EpiLds{(float*)smem, tt * 128, 0});
        __syncthreads();
        if (tid < 128) {
            float L[16];
            top16_col((const float*)smem + tid, L);
#pragma unroll
            for (int i = 0; i < 16; i++) { if (p == 0) A[i] = L[i]; else B[i] = L[i]; }
        }
        __syncthreads();
    }
    if (tid >= 128) return;
    const int t = tt * 128 + tid;
    const float smax = key_val(A[0]) + key_val(B[0]);
    unsigned Tk[16];
#pragma unroll
    for (int g = 0; g < 4; g++) {
        unsigned Ck[16];
#pragma unroll
        for (int e = 0; e < 16; e++) {
            const int c = g * 16 + e;
            int i, j;
            if (c < 16) { i = 0; j = c; }
            else if (c < 24) { i = 1; j = c - 16; }
            else if (c < 29) { i = 2; j = c - 24; }
            else if (c < 33) { i = 3; j = c - 29; }
            else if (c < 36) { i = 4; j = c - 33; }
            else if (c < 42) { i = 5 + (c - 36) / 2; j = (c - 36) % 2; }
            else if (c < 50) { i = 8 + (c - 42); j = 0; }
            else { i = -1; j = 0; }
            if (i >= 0) {
                const float dd = smax - (key_val(A[i]) + key_val(B[j]));
                unsigned qd = (unsigned)fminf(dd * 32768.f, 262143.f);
                Ck[e] = (qd << 14) | (unsigned)(key_idx(A[i]) * 128 + key_idx(B[j]));
            } else Ck[e] = 0xffffffffu;
        }
        bit_sort16u_asc(Ck);
        if (g == 0) {
#pragma unroll
            for (int e = 0; e < 16; e++) Tk[e] = Ck[e];
        } else low16_merge_u(Tk, Ck);
    }
    float sum = 0.f;
    float w[16]; int Tp[16];
#pragma unroll
    for (int e = 0; e < 16; e++) { w[e] = __expf(-(float)(Tk[e] >> 14) * (1.f / 32768.f)); sum += w[e]; Tp[e] = (int)(Tk[e] & 16383u); }
    const float inv = 1.f / sum;
    int* pi = pidx + ((size_t)t * 8 + h) * 16;
    float* pw = pg + ((size_t)t * 8 + h) * 16;
#pragma unroll
    for (int e = 0; e < 16; e += 4) {
        *(int4*)(pi + e) = make_int4(Tp[e], Tp[e + 1], Tp[e + 2], Tp[e + 3]);
        *(float4*)(pw + e) = make_float4(w[e] * inv, w[e + 1] * inv, w[e + 2] * inv, w[e + 3] * inv);
    }
}

typedef __attribute__((ext_vector_type(2))) short bf16x2;
__device__ __forceinline__ float dot8_bf16(u32x4 a, u32x4 b, float acc) {
#pragma unroll
    for (int i = 0; i < 4; i++) {
        const unsigned x = a[i], y = b[i];
        acc += __uint_as_float(x << 16) * __uint_as_float(y << 16);
        acc += __uint_as_float(x & 0xffff0000u) * __uint_as_float(y & 0xffff0000u);
    }
    return acc;
}
__device__ __forceinline__ void d_peer_apply2(const int vb, char* smem, const bf16_t* __restrict__ hb, const int* __restrict__ pidx,
                                              const float* __restrict__ pg, const bf16_t* __restrict__ utab, const bf16_t* __restrict__ vtab,
                                              const float* __restrict__ modl, float* __restrict__ xrun) {
    const int wid = threadIdx.x >> 6, lane = threadIdx.x & 63;
    const int t = vb * 4 + wid;
    float* coef = (float*)smem + wid * 128;
    int* eid = (int*)(smem + 2048) + wid * 128;
    eid[lane] = pidx[(size_t)t * 128 + lane]; eid[lane + 64] = pidx[(size_t)t * 128 + lane + 64];
    const float g0 = pg[(size_t)t * 128 + lane], g1 = pg[(size_t)t * 128 + lane + 64];
    const u32x4 x0 = *(const u32x4*)(hb + (size_t)t * DM + lane * 8);
    const u32x4 x1 = *(const u32x4*)(hb + (size_t)t * DM + 512 + lane * 8);
    __builtin_amdgcn_wave_barrier();
    float myact0 = 0.f, myact1 = 0.f;
    for (int eb = 0; eb < 128; eb += 8) {
        u32x4 ua[8], ub[8];
#pragma unroll
        for (int r = 0; r < 8; r++) {
            const bf16_t* ur = utab + (size_t)eid[eb + r] * DM;
            ua[r] = *(const u32x4*)(ur + lane * 8);
            ub[r] = *(const u32x4*)(ur + 512 + lane * 8);
        }
#pragma unroll
        for (int r = 0; r < 8; r++) {
            float sacc = dot8_bf16(ua[r], x0, 0.f);
            sacc = dot8_bf16(ub[r], x1, sacc);
            sacc = wave_sum(sacc);
            const int e = eb + r;
            if (lane == (e & 63)) { if (e < 64) myact0 = sacc; else myact1 = sacc; }
        }
    }
    coef[lane] = g0 * gelu_tanh(myact0);
    coef[lane + 64] = g1 * gelu_tanh(myact1);
    __builtin_amdgcn_wave_barrier();
    float acc[16];
#pragma unroll
    for (int i = 0; i < 16; i++) acc[i] = 0.f;
    for (int eb = 0; eb < 128; eb += 8) {
        u32x4 va[8], vbq[8];
#pragma unroll
        for (int r = 0; r < 8; r++) {
            const bf16_t* vr = vtab + (size_t)eid[eb + r] * DM;
            va[r] = *(const u32x4*)(vr + lane * 8);
            vbq[r] = *(const u32x4*)(vr + 512 + lane * 8);
        }
#pragma unroll
        for (int r = 0; r < 8; r++) {
            const float cf = coef[eb + r];
#pragma unroll
            for (int i = 0; i < 4; i++) {
                acc[2 * i] += cf * __uint_as_float(va[r][i] << 16);
                acc[2 * i + 1] += cf * __uint_as_float(va[r][i] & 0xffff0000u);
                acc[8 + 2 * i] += cf * __uint_as_float(vbq[r][i] << 16);
                acc[8 + 2 * i + 1] += cf * __uint_as_float(vbq[r][i] & 0xffff0000u);
            }
        }
    }
    const float* m = modl + (size_t)tok_modrow(t) * 6144 + 5 * 1024;
    float* xo = xrun + (size_t)t * DM;
#pragma unroll
    for (int hlf = 0; hlf < 2; hlf++) {
        const int c0 = hlf * 512 + lane * 8;
        float4 xa = *(float4*)(xo + c0), xb2 = *(float4*)(xo + c0 + 4);
        const float4 ma = *(const float4*)(m + c0), mb = *(const float4*)(m + c0 + 4);
        xa.x += ma.x * acc[hlf * 8 + 0]; xa.y += ma.y * acc[hlf * 8 + 1]; xa.z += ma.z * acc[hlf * 8 + 2]; xa.w += ma.w * acc[hlf * 8 + 3];
        xb2.x += mb.x * acc[hlf * 8 + 4]; xb2.y += mb.y * acc[hlf * 8 + 5]; xb2.z += mb.z * acc[hlf * 8 + 6]; xb2.w += mb.w * acc[hlf * 8 + 7];
        *(float4*)(xo + c0) = xa; *(float4*)(xo + c0 + 4) = xb2;
    }
}
__device__ __forceinline__ void d_cvt_bf16(const int vb, const float* __restrict__ src, bf16_t* __restrict__ dst) {
    const size_t base = (size_t)vb * 16384 + threadIdx.x * 4;
#pragma unroll
    for (int i = 0; i < 16; i++) {
        const float4 v = *(const float4*)(src + base + i * 1024);
        ushort4 o; o.x = f2bf(v.x); o.y = f2bf(v.y); o.z = f2bf(v.z); o.w = f2bf(v.w);
        *(ushort4*)(dst + base + i * 1024) = o;
    }
}

__device__ __forceinline__ void d_hy_dw(const int bx, const int by, const int bz, char* smem, const float* __restrict__ pre, const float* __restrict__ cw, const float* __restrict__ cb,
                                               bf16_t* __restrict__ zin, bf16_t* __restrict__ x0) {
    const int t = bx;
    const int pos = tok_pos(t), L = tok_len(t);
    const float* P = pre + (size_t)t * 3072;
    for (int c = threadIdx.x; c < 1024; c += 256) {
        float u[3];
#pragma unroll
        for (int part = 0; part < 3; part++) {
            int cc = part * 1024 + c;
            float cur = P[cc];
            float prev = (pos > 0) ? P[cc - 3072] : 0.f;
            float nxt = (pos < L - 1) ? P[cc + 3072] : 0.f;
            u[part] = prev * cw[cc] + cur * cw[3072 + cc] + nxt * cw[2 * 3072 + cc] + cb[cc];
        }
        x0[(size_t)t * DM + c] = f2bf(u[0]);
        zin[(size_t)t * DM + c] = f2bf(u[1] * u[2]);
    }
}

__device__ __forceinline__ void d_hy_filt(const int bx, const int by, const int bz, char* smem, int L, const float* __restrict__ w1, const float* __restrict__ b1, const float* __restrict__ w2,
                                                 const float* __restrict__ b2, const float* __restrict__ w3, const float* __restrict__ fr,
                                                 float* __restrict__ hf, float* __restrict__ hb) {
    float* z = (float*)smem; float* h1 = z + 64; float* h2 = z + 128;
    const int t = bx, tid = threadIdx.x;
    const float tu = (float)t / (float)(L - 1);
    if (tid == 0) z[0] = tu;
    if (tid >= 1 && tid < 17) {
        int i = tid - 1;
        float band = 1e-4f + (float)i * ((15.f - 1e-4f) / 15.f);
        float ang = 6.283185307179586f * (float)t * band / (float)L;
        z[1 + i] = cosf(ang); z[17 + i] = -sinf(ang);
    }
    __syncthreads();
    if (tid < 64) { float s = b1[tid]; for (int i = 0; i < 33; i++) s += z[i] * w1[i * 64 + tid]; h1[tid] = sinf(fr[tid] * s); }
    __syncthreads();
    if (tid < 64) { float s = b2[tid]; for (int i = 0; i < 64; i++) s += h1[i] * w2[i * 64 + tid]; h2[tid] = sinf(fr[tid] * s); }
    __syncthreads();
    for (int c = tid; c < 2048; c += 256) {
        float s = 0.f;
        for (int i = 0; i < 64; i++) s += h2[i] * w3[i * 2048 + c];
        int ch = c & 1023;
        float d0 = -4.605170185988091f / 0.3f, d1 = -4.605170185988091f / 1.5f;
        float delta = d0 + (d1 - d0) * ((float)ch / 1023.f);
        float win = expf(-tu * fabsf(delta));
        float val = s * win;
        if (c < 1024) hf[(size_t)t * 1024 + ch] = val; else hb[(size_t)t * 1024 + ch] = val;
    }
}
__device__ __forceinline__ void d_hy_norm(const int bx, const int by, const int bz, char* smem, int L, const float* __restrict__ hf, const float* __restrict__ hb, float* __restrict__ inv) {
    const int c = bx * 256 + threadIdx.x;
    float s = 0.f;
    for (int t = 0; t < L; t++) { s += fabsf(hf[(size_t)t * 1024 + c]); if (t > 0) s += fabsf(hb[(size_t)t * 1024 + c]); }
    inv[c] = 1.f / s;
}
__device__ __forceinline__ void d_hy_conv(const int bx, const int by, const int bz, char* smem, int L, int tbase, const bf16_t* __restrict__ zin, const bf16_t* __restrict__ x0, const float* __restrict__ hf,
                                                 const float* __restrict__ hb, const float* __restrict__ inv, const float* __restrict__ bias,
                                                 bf16_t* __restrict__ zb) {
    const int c = bx * 256 + threadIdx.x;
    const int t0 = by * 8, b = bz;
    const bf16_t* Z = zin + (size_t)(tbase + b * L) * DM + c;
    float acc[8];
#pragma unroll
    for (int i = 0; i < 8; i++) acc[i] = 0.f;
    for (int s = 0; s < L; s++) {
        float z = bf2f(Z[(size_t)s * DM]);
#pragma unroll
        for (int i = 0; i < 8; i++) {
            int j = t0 + i - s;
            float g = (j >= 0) ? hf[(size_t)j * 1024 + c] : hb[(size_t)(-j) * 1024 + c];
            acc[i] += z * g;
        }
    }
    float iv = inv[c], bs = bias[c];
#pragma unroll
    for (int i = 0; i < 8; i++) {
        size_t o = (size_t)(tbase + b * L + t0 + i) * DM + c;
        float zz = bf2f(zin[o]);
        zb[o] = f2bf(bf2f(x0[o]) * (acc[i] * iv + zz * bs));
    }
}


__device__ __forceinline__ void d_hy_filt2(const int vbl8, char* smem, const int L, const float* __restrict__ w1, const float* __restrict__ b1,
                                           const float* __restrict__ w2, const float* __restrict__ b2, const float* __restrict__ w3,
                                           const float* __restrict__ fr, bf16_t* __restrict__ gT, float* __restrict__ nsum) {
    float* zp = (float*)smem;
    float* h1 = zp + 32 * 33;
    float* h2t = h1 + 32 * 64;
    float* sw1 = h2t + 64 * 32;
    float* sw2 = sw1 + 33 * 64;
    const int tid = threadIdx.x;
    const int vbl = vbl8 >> 3, mm = vbl8 & 7;
    const int t0 = vbl * 32;
    for (int e = tid; e < 33 * 64; e += 256) sw1[e] = w1[e];
    for (int e = tid; e < 64 * 64; e += 256) sw2[e] = w2[e];
    for (int e = tid; e < 32 * 33; e += 256) {
        const int pos = e / 33, i = e % 33;
        const float t = (float)(t0 + pos);
        float val;
        if (i == 0) val = t / (float)(L - 1);
        else {
            const int bi = (i <= 16) ? (i - 1) : (i - 17);
            const float band = 1e-4f + (float)bi * ((15.f - 1e-4f) / 15.f);
            const float ang = 6.283185307179586f * t * band / (float)L;
            val = (i <= 16) ? __cosf(ang) : -__sinf(ang);
        }
        zp[e] = val;
    }
    const int c = tid + 256 * mm;
    float wv[8];
#pragma unroll
    for (int jj = 0; jj < 8; jj++) wv[jj] = w3[jj * 2048 + c];
    __syncthreads();
    {
        const int j = tid & 63;
        const float frj = fr[j];
#pragma unroll 1
        for (int i = 0; i < 8; i++) {
            const int pos = (tid >> 6) + 4 * i;
            float sacc = b1[j];
#pragma unroll 3
            for (int q = 0; q < 33; q++) sacc += zp[pos * 33 + q] * sw1[q * 64 + j];
            h1[pos * 64 + j] = __sinf(frj * sacc);
        }
        __syncthreads();
#pragma unroll 1
        for (int i = 0; i < 8; i++) {
            const int pos = (tid >> 6) + 4 * i;
            float sacc = b2[j];
#pragma unroll 4
            for (int q = 0; q < 64; q++) sacc += h1[pos * 64 + q] * sw2[q * 64 + j];
            h2t[j * 32 + pos] = __sinf(frj * sacc);
        }
    }
    __syncthreads();
    {
        float acc[32];
#pragma unroll
        for (int i = 0; i < 32; i++) acc[i] = 0.f;
#pragma unroll 1
        for (int jb = 0; jb < 64; jb += 8) {
            float wn[8];
            if (jb + 8 < 64) {
#pragma unroll
                for (int jj = 0; jj < 8; jj++) wn[jj] = w3[(jb + 8 + jj) * 2048 + c];
            }
#pragma unroll
            for (int jj = 0; jj < 8; jj++) {
                const float w = wv[jj];
#pragma unroll
                for (int i = 0; i < 8; i++) {
                    const float4 hv = *(const float4*)(h2t + (jb + jj) * 32 + i * 4);
                    acc[4 * i] += hv.x * w; acc[4 * i + 1] += hv.y * w; acc[4 * i + 2] += hv.z * w; acc[4 * i + 3] += hv.w * w;
                }
                __builtin_amdgcn_sched_barrier(0);
            }
            if (jb + 8 < 64) {
#pragma unroll
                for (int jj = 0; jj < 8; jj++) wv[jj] = wn[jj];
            }
        }
        const int ch = c & 1023;
        const float d0 = -4.605170185988091f / 0.3f, d1 = -4.605170185988091f / 1.5f;
        const float adelta = fabsf(d0 + (d1 - d0) * ((float)ch / 1023.f));
        float absum = 0.f;
        bf16_t* g = gT + (size_t)ch * 2 * L;
#pragma unroll
        for (int i = 0; i < 32; i++) {
            const int t = t0 + i;
            const float tu = (float)t / (float)(L - 1);
            const float val = acc[i] * __expf(-tu * adelta);
            if (c < 1024) { absum += fabsf(val); g[L - t] = f2bf(val); }
            else if (t >= 1) { absum += fabsf(val); g[L + t] = f2bf(val); }
            if ((i & 3) == 3) __builtin_amdgcn_sched_barrier(0);
        }
        atomicAdd(nsum + ch, absum);
    }
}

__device__ __forceinline__ void d_hy_dw2(const int vb, char* smem, const float* __restrict__ pre, const float* __restrict__ cw,
                                         const float* __restrict__ cb, bf16_t* __restrict__ zT, bf16_t* __restrict__ x0b) {
    bf16_t* tile = (bf16_t*)smem;
    const int tt = vb >> 4, ct = vb & 15;
    const int tid = threadIdx.x;
    const int cc = tid & 63, c = ct * 64 + cc;
    const int tq = tid >> 6;
    float w0[3], w1[3], w2[3], bb[3];
#pragma unroll
    for (int part = 0; part < 3; part++) {
        const int col = part * 1024 + c;
        w0[part] = cw[col]; w1[part] = cw[3072 + col]; w2[part] = cw[2 * 3072 + col]; bb[part] = cb[col];
    }
    const int tok0 = tt * 64 + tq * 16;
    float prev[3], cur[3], nxt[3];
    {
        const int pos = tok_pos(tok0);
#pragma unroll
        for (int part = 0; part < 3; part++) {
            const float* P = pre + (size_t)tok0 * 3072 + part * 1024 + c;
            prev[part] = (pos > 0) ? P[-3072] : 0.f;
            cur[part] = P[0];
        }
    }
#pragma unroll 4
    for (int i = 0; i < 16; i++) {
        const int tok = tok0 + i;
        const int pos = tok_pos(tok), L = tok_len(tok);
        float u[3];
#pragma unroll
        for (int part = 0; part < 3; part++) {
            const float* P = pre + (size_t)tok * 3072 + part * 1024 + c;
            nxt[part] = (pos < L - 1) ? P[3072] : 0.f;
            u[part] = prev[part] * w0[part] + cur[part] * w1[part] + nxt[part] * w2[part] + bb[part];
            prev[part] = cur[part]; cur[part] = nxt[part];
        }
        x0b[(size_t)tok * DM + c] = f2bf(u[0]);
        tile[cc * 72 + tq * 16 + i] = f2bf(u[1] * u[2]);
    }
    __syncthreads();
    {
        const int cch = tid >> 2, q4 = tid & 3;
        const u32x4 a = *(const u32x4*)(tile + cch * 72 + q4 * 16);
        const u32x4 b2 = *(const u32x4*)(tile + cch * 72 + q4 * 16 + 8);
        bf16_t* dst = zT + (size_t)(ct * 64 + cch) * TT + tt * 64 + q4 * 16;
        *(u32x4*)dst = a; *(u32x4*)(dst + 8) = b2;
    }
}

template <bool SAMPLE>
__device__ __forceinline__ void d_hy_conv2(const int c, const int half, char* wsm, const bf16_t* __restrict__ gTall, const float* __restrict__ nsum,
                                           const bf16_t* __restrict__ zT, const float* __restrict__ bias, bf16_t* __restrict__ yT) {
    constexpr int L = SAMPLE ? LS : LP;
    constexpr int NB = L / 32;
    constexpr int NBATCH = SAMPLE ? 4 : 16;
    constexpr int BSH = SAMPLE ? 2 : 4;
    constexpr int TPB = 32 >> BSH;
    constexpr int NCB = NB / TPB;
    constexpr int HCB = NCB / 2;
    constexpr int PADB = SAMPLE ? 8 : 2;
    constexpr int ZLEN = L + 2 * PADB * 32;
    constexpr int tbase = SAMPLE ? TP : 0;
    const int lane = threadIdx.x & 63;
    const int l2 = half * 64 + lane;
    const int lc = lane & 31, hh = lane >> 5;
    const int b = lc & (NBATCH - 1), Tl = lc >> BSH;
    bf16_t* R = (bf16_t*)wsm;
    bf16_t* Z = R + 2 * L;
    {
        const u32x4* src = (const u32x4*)(gTall + (size_t)c * 2 * L);
        for (int i = l2; i < 2 * L / 8; i += 128) ((u32x4*)R)[i] = src[i];
        const u32x4 zero = {0u, 0u, 0u, 0u};
#pragma unroll 1
        for (int b2 = 0; b2 < NBATCH; b2++) {
            const u32x4* zs = (const u32x4*)(zT + (size_t)c * TT + tbase + b2 * L);
            u32x4* zd = (u32x4*)(Z + b2 * ZLEN);
            for (int i = l2; i < PADB * 4; i += 128) { zd[i] = zero; zd[PADB * 4 + L / 8 + i] = zero; }
            for (int i = l2; i < L / 8; i += 128) zd[PADB * 4 + i] = zs[i];
        }
    }
    __syncthreads();
    f32x16 acc[HCB];
#pragma unroll
    for (int cb = 0; cb < HCB; cb++)
#pragma unroll
        for (int r = 0; r < 16; r++) acc[cb][r] = 0.f;
    const bf16_t* Zb = Z + b * ZLEN + PADB * 32 + 8 * hh;
    const int cb0 = half * HCB;
    const int Dlo = TPB * cb0 - (NB - 1), Dhi = TPB * (cb0 + HCB - 1) + TPB - 1;
#pragma unroll 1
    for (int D = (Dlo < -(NB - 1) ? -(NB - 1) : Dlo); D <= (Dhi > NB - 1 ? NB - 1 : Dhi); D++) {
        bf16x8 af[2];
#pragma unroll
        for (int ks = 0; ks < 2; ks++) {
            const bf16_t* rp = R + (L - 32 * D - lc + 16 * ks + 8 * hh);
#pragma unroll
            for (int j = 0; j < 8; j++) af[ks][j] = (short)rp[j];
        }
#pragma unroll
        for (int lcb = 0; lcb < HCB; lcb++) {
            const int cb = cb0 + lcb;
            if (D >= TPB * cb - (NB - 1) && D <= TPB * cb + TPB - 1) {
                const int S = TPB * cb + Tl - D;
#pragma unroll
                for (int ks = 0; ks < 2; ks++) {
                    const bf16x8 bfr = *(const bf16x8*)(Zb + 32 * S + 16 * ks);
                    acc[lcb] = __builtin_amdgcn_mfma_f32_32x32x16_bf16(af[ks], bfr, acc[lcb], 0, 0, 0);
                }
            }
        }
    }
    const float inv = 1.f / nsum[c], bs = bias[c];
    bf16_t* yrow = yT + (size_t)c * TT + tbase + b * L;
    const bf16_t* zrow = Z + b * ZLEN + PADB * 32;
#pragma unroll
    for (int lcb = 0; lcb < HCB; lcb++)
#pragma unroll
        for (int g = 0; g < 4; g++) {
            const int t = 32 * (TPB * (cb0 + lcb) + Tl) + 8 * g + 4 * hh;
            ushort4 o;
            o.x = f2bf(acc[lcb][4 * g + 0] * inv + bf2f(zrow[t + 0]) * bs);
            o.y = f2bf(acc[lcb][4 * g + 1] * inv + bf2f(zrow[t + 1]) * bs);
            o.z = f2bf(acc[lcb][4 * g + 2] * inv + bf2f(zrow[t + 2]) * bs);
            o.w = f2bf(acc[lcb][4 * g + 3] * inv + bf2f(zrow[t + 3]) * bs);
            *(ushort4*)(yrow + t) = o;
        }
}

__device__ __forceinline__ void d_hy_post(const int vb, char* smem, const bf16_t* __restrict__ yT, const bf16_t* __restrict__ x0b, bf16_t* __restrict__ zb) {
    bf16_t* tile = (bf16_t*)smem;
    const int tt = vb >> 4, ct = vb & 15;
    const int tid = threadIdx.x;
    {
        const int cch = tid >> 2, q4 = tid & 3;
        const bf16_t* src = yT + (size_t)(ct * 64 + cch) * TT + tt * 64 + q4 * 16;
        *(u32x4*)(tile + cch * 72 + q4 * 16) = *(const u32x4*)src;
        *(u32x4*)(tile + cch * 72 + q4 * 16 + 8) = *(const u32x4*)(src + 8);
    }
    __syncthreads();
    const int cc = tid & 63, tq = tid >> 6;
#pragma unroll 4
    for (int i = 0; i < 16; i++) {
        const size_t o = (size_t)(tt * 64 + tq * 16 + i) * DM + ct * 64 + cc;
        zb[o] = f2bf(bf2f(x0b[o]) * bf2f(tile[cc * 72 + tq * 16 + i]));
    }
}


__device__ __forceinline__ float wave_allsum_fast(float v) {
    v = row16_allsum(v);
    const float r0 = __int_as_float(__builtin_amdgcn_readlane(__float_as_int(v), 0));
    const float r1 = __int_as_float(__builtin_amdgcn_readlane(__float_as_int(v), 16));
    const float r2 = __int_as_float(__builtin_amdgcn_readlane(__float_as_int(v), 32));
    const float r3 = __int_as_float(__builtin_amdgcn_readlane(__float_as_int(v), 48));
    return (r0 + r1) + (r2 + r3);
}
__device__ __forceinline__ ushort4 pack_bf4(float a, float b, float c, float d) { ushort4 o; o.x = f2bf(a); o.y = f2bf(b); o.z = f2bf(c); o.w = f2bf(d); return o; }

__device__ __forceinline__ void d_norm_mod2(const int vb, const float* __restrict__ xa, const float* __restrict__ xb, const float* __restrict__ g,
                                            const float* __restrict__ modl, const int shift_idx, const int scale_idx, bf16_t* __restrict__ h) {
    const int wid = threadIdx.x >> 6, lane = threadIdx.x & 63;
    const int t0 = vb * 8 + wid * 2;
    float4 v[2][4];
#pragma unroll
    for (int u = 0; u < 2; u++) {
        const int t = t0 + u;
        const float* x = (t < TP) ? (xa + (size_t)t * DM) : (xb + (size_t)(t - TP) * DM);
#pragma unroll
        for (int j = 0; j < 4; j++) v[u][j] = *(const float4*)(x + j * 256 + lane * 4);
    }
#pragma unroll
    for (int u = 0; u < 2; u++) {
        const int t = t0 + u;
        float ss = 0.f;
#pragma unroll
        for (int j = 0; j < 4; j++) ss += v[u][j].x * v[u][j].x + v[u][j].y * v[u][j].y + v[u][j].z * v[u][j].z + v[u][j].w * v[u][j].w;
        ss = wave_allsum_fast(ss);
        const float rstd = rsqrtf(ss * (1.f / DM) + 1e-6f);
        const float* m = modl + (size_t)tok_modrow(t) * 6144;
#pragma unroll
        for (int j = 0; j < 4; j++) {
            const int c = j * 256 + lane * 4;
            const float4 gg = *(const float4*)(g + c);
            const float4 sh = *(const float4*)(m + shift_idx * 1024 + c);
            const float4 sc = *(const float4*)(m + scale_idx * 1024 + c);
            *(ushort4*)(h + (size_t)t * DM + c) = pack_bf4(v[u][j].x * rstd * gg.x * (1.f + sc.x) + sh.x, v[u][j].y * rstd * gg.y * (1.f + sc.y) + sh.y,
                                                           v[u][j].z * rstd * gg.z * (1.f + sc.z) + sh.z, v[u][j].w * rstd * gg.w * (1.f + sc.w) + sh.w);
        }
    }
}

__device__ __forceinline__ void d_rw_shift2(const int vb, const bf16_t* __restrict__ proj, const float* __restrict__ mu, bf16_t* __restrict__ rb,
                                            bf16_t* __restrict__ kb, bf16_t* __restrict__ vbuf, bf16_t* __restrict__ tw, bf16_t* __restrict__ adv,
                                            bf16_t* __restrict__ sg) {
#pragma unroll
    for (int u = 0; u < 4; u++) {
        const int id = vb * 1024 + u * 256 + threadIdx.x;
        const int t = id / 224, c = (id % 224) * 8;
        const int pos = tok_pos(t), L = tok_len(t);
        const bf16_t* P = proj + (size_t)t * RWIN + c;
        const u32x4 cur = *(const u32x4*)P;
        u32x4 prv = {0u, 0u, 0u, 0u}, nxt = {0u, 0u, 0u, 0u};
        if (pos > 0) prv = *(const u32x4*)(P - RWIN);
        if (pos < L - 1) nxt = *(const u32x4*)(P + RWIN);
        const float4 m0 = *(const float4*)(mu + c), m1 = *(const float4*)(mu + c + 4);
        const float mm[8] = {m0.x, m0.y, m0.z, m0.w, m1.x, m1.y, m1.z, m1.w};
        float val[8];
#pragma unroll
        for (int i = 0; i < 4; i++) {
            const float c0 = __uint_as_float(cur[i] << 16), c1 = __uint_as_float(cur[i] & 0xffff0000u);
            const float p0 = __uint_as_float(prv[i] << 16), p1 = __uint_as_float(prv[i] & 0xffff0000u);
            const float n0 = __uint_as_float(nxt[i] << 16), n1 = __uint_as_float(nxt[i] & 0xffff0000u);
            val[2 * i] = c0 + mm[2 * i] * (0.5f * (p0 + n0) - c0);
            val[2 * i + 1] = c1 + mm[2 * i + 1] * (0.5f * (p1 + n1) - c1);
        }
        bf16_t* dst;
        if (c < 512) dst = rb + (size_t)t * 512 + c;
        else if (c < 1024) dst = kb + (size_t)t * 512 + (c - 512);
        else if (c < 1536) dst = vbuf + (size_t)t * 512 + (c - 1024);
        else if (c < 1600) { dst = tw + (size_t)t * 64 + (c - 1536);
#pragma unroll
            for (int i = 0; i < 8; i++) val[i] = tanhf(val[i]); }
        else if (c < 1664) dst = adv + (size_t)t * 64 + (c - 1600);
        else { dst = sg + (size_t)t * 128 + (c - 1664);
#pragma unroll
            for (int i = 0; i < 8; i++) val[i] = sigmoidf_(val[i]); }
        u32x4 o;
#pragma unroll
        for (int i = 0; i < 4; i++) o[i] = (unsigned)f2bf(val[2 * i]) | ((unsigned)f2bf(val[2 * i + 1]) << 16);
        *(u32x4*)dst = o;
    }
}

__device__ __forceinline__ void d_mla_pre2(const int vb, const float* __restrict__ proj, const float* __restrict__ q_norm, const float* __restrict__ kv_norm,
                                           bf16_t* __restrict__ qcn, bf16_t* __restrict__ ckv, float* __restrict__ kpe, float* __restrict__ out_ckv,
                                           float* __restrict__ out_kpe) {
    const int t = vb * 16 + (threadIdx.x >> 4), l16 = threadIdx.x & 15;
    const float* P = proj + (size_t)t * 448;
    float4 x[7];
#pragma unroll
    for (int j = 0; j < 7; j++) x[j] = *(const float4*)(P + 4 * (l16 + 16 * j));
    float sq = 0.f, sk = 0.f;
#pragma unroll
    for (int j = 0; j < 4; j++) sq += x[j].x * x[j].x + x[j].y * x[j].y + x[j].z * x[j].z + x[j].w * x[j].w;
#pragma unroll
    for (int j = 4; j < 6; j++) sk += x[j].x * x[j].x + x[j].y * x[j].y + x[j].z * x[j].z + x[j].w * x[j].w;
    sq = row16_allsum(sq); sk = row16_allsum(sk);
    const float rq = rsqrtf(sq * (1.f / 256.f) + 1e-6f), rk = rsqrtf(sk * (1.f / 128.f) + 1e-6f);
#pragma unroll
    for (int j = 0; j < 4; j++) {
        const int c = 4 * (l16 + 16 * j);
        const float4 w = *(const float4*)(q_norm + c);
        *(ushort4*)(qcn + (size_t)t * 256 + c) = pack_bf4(x[j].x * rq * w.x, x[j].y * rq * w.y, x[j].z * rq * w.z, x[j].w * rq * w.w);
    }
#pragma unroll
    for (int j = 4; j < 6; j++) {
        const int c = 4 * (l16 + 16 * (j - 4));
        const float4 w = *(const float4*)(kv_norm + c);
        const float4 o = make_float4(x[j].x * rk * w.x, x[j].y * rk * w.y, x[j].z * rk * w.z, x[j].w * rk * w.w);
        *(ushort4*)(ckv + (size_t)t * 128 + c) = pack_bf4(o.x, o.y, o.z, o.w);
        if (t < TP) *(float4*)(out_ckv + (size_t)t * 128 + c) = o;
    }
    {
        const int c = 4 * l16;
        *(float4*)(kpe + (size_t)t * 64 + c) = x[6];
        if (t < TP) *(float4*)(out_kpe + (size_t)t * 64 + c) = x[6];
    }
}

__device__ __forceinline__ void d_rw_kk2(const int vb, char* smem, const bf16_t* __restrict__ rb, const bf16_t* __restrict__ kb,
                                         const bf16_t* __restrict__ lr0, const bf16_t* __restrict__ lr1, const float* __restrict__ k_k,
                                         const float* __restrict__ k_a, const float* __restrict__ r_k, bf16_t* __restrict__ kkb, float* __restrict__ bonus) {
    float* pk = (float*)smem;
    for (int i = threadIdx.x; i < 512; i += 256) { pk[i] = k_k[i]; pk[512 + i] = k_a[i]; pk[1024 + i] = r_k[i]; }
    __syncthreads();
    const int w = vb * 256 + threadIdx.x;
    const int h = w & 7;
    const size_t o = (size_t)w * 64;
    u32x4 kq[8];
#pragma unroll
    for (int i = 0; i < 8; i++) kq[i] = *(const u32x4*)(kb + o + i * 8);
    const float* kkp = pk + h * 64; const float* kap = pk + 512 + h * 64; const float* rkp = pk + 1024 + h * 64;
    float ss = 0.f;
#pragma unroll
    for (int i = 0; i < 8; i++)
#pragma unroll
        for (int j = 0; j < 4; j++) {
            const float a = __uint_as_float(kq[i][j] << 16) * kkp[i * 8 + 2 * j], b = __uint_as_float(kq[i][j] & 0xffff0000u) * kkp[i * 8 + 2 * j + 1];
            ss += a * a + b * b;
        }
    const float inv = 1.f / fmaxf(sqrtf(ss), 1e-12f);
    float bs = 0.f;
#pragma unroll 2
    for (int i = 0; i < 8; i++) {
        const u32x4 kq2 = *(const u32x4*)(kb + o + i * 8);
        const u32x4 rq = *(const u32x4*)(rb + o + i * 8);
        const u32x4 l0 = *(const u32x4*)(lr0 + o + i * 8);
        const u32x4 l1 = *(const u32x4*)(lr1 + o + i * 8);
        u32x4 ok;
#pragma unroll
        for (int j = 0; j < 4; j++) {
            const int e0 = i * 8 + 2 * j, e1 = e0 + 1;
            const float k0 = __uint_as_float(kq2[j] << 16), k1 = __uint_as_float(kq2[j] & 0xffff0000u);
            const float r0 = __uint_as_float(rq[j] << 16), r1 = __uint_as_float(rq[j] & 0xffff0000u);
            const float a0 = __uint_as_float(l0[j] << 16), a1 = __uint_as_float(l0[j] & 0xffff0000u);
            const float b0 = __uint_as_float(l1[j] << 16), b1 = __uint_as_float(l1[j] & 0xffff0000u);
            bs += r0 * k0 * (2.f + (a0 + b0 - 2.f) * kap[e0]) * rkp[e0] + r1 * k1 * (2.f + (a1 + b1 - 2.f) * kap[e1]) * rkp[e1];
            ok[j] = (unsigned)f2bf(k0 * kkp[e0] * inv) | ((unsigned)f2bf(k1 * kkp[e1] * inv) << 16);
        }
        *(u32x4*)(kkb + o + i * 8) = ok;
    }
    bonus[w] = bs;
}

__device__ __forceinline__ void d_mla_post2(const int vb, const bf16_t* __restrict__ qraw, const bf16_t* __restrict__ kvraw, const bf16_t* __restrict__ kvraw_ctx,
                                            const float* __restrict__ kpe, const float* __restrict__ cache_kpe, const float* __restrict__ qn,
                                            const float* __restrict__ kn, bf16_t* __restrict__ Qb, bf16_t* __restrict__ Kp, bf16_t* __restrict__ Ks) {
    const int item = vb * 16 + (threadIdx.x >> 4), l16 = threadIdx.x & 15;
    const int row = item >> 2, h = item & 3;
    const bool isctx = row >= TT, sample = row >= TP;
    const int e0 = 12 * l16;
    const bf16_t* kvr; const float* pe; int pos = 0;
    if (isctx) { const int cr = row - TT; kvr = kvraw_ctx + (size_t)cr * 1024; pe = cache_kpe + (size_t)cr * 64; }
    else { kvr = kvraw + (size_t)row * 1024; pe = kpe + (size_t)row * 64; pos = tok_pos(row); }
    float kx[12], qx[12];
#pragma unroll
    for (int j = 0; j < 12; j++) {
        const int e = e0 + j;
        kx[j] = (e < 128) ? bf2f(kvr[h * 256 + (e < 128 ? e : 0)]) : pe[(e >= 128 ? e - 128 : 0)];
        qx[j] = isctx ? 0.f : bf2f(qraw[(size_t)row * 768 + h * 192 + e]);
    }
    float sk = 0.f, sq = 0.f;
#pragma unroll
    for (int j = 0; j < 12; j++) { sk += kx[j] * kx[j]; sq += qx[j] * qx[j]; }
    sk = row16_allsum(sk); sq = row16_allsum(sq);
    const float rk = rsqrtf(sk * (1.f / 192.f) + 1e-6f), rq = rsqrtf(sq * (1.f / 192.f) + 1e-6f);
#pragma unroll
    for (int j = 0; j < 12; j++) { kx[j] *= rk * kn[e0 + j]; qx[j] *= rq * qn[e0 + j]; }
    if (sample && !isctx) {
        const float rowf = (float)(pos >> 6), colf = (float)(pos & 63);
#pragma unroll
        for (int j = 0; j < 12; j += 2) {
            const int e = e0 + j;
            if (e >= 128) {
                const int pi = (e - 128) >> 1;
                const float inv = expf(-(float)(pi & 15) * (1.f / 16.f) * 9.210340371976184f);
                const float ang = (pi < 16 ? rowf : colf) * inv;
                const float cs = __cosf(ang), sn = __sinf(ang);
                const float a = kx[j], bq = kx[j + 1];
                kx[j] = a * cs - bq * sn; kx[j + 1] = a * sn + bq * cs;
                const float a2 = qx[j], b2 = qx[j + 1];
                qx[j] = a2 * cs - b2 * sn; qx[j + 1] = a2 * sn + b2 * cs;
            }
        }
    }
    bf16_t* kd;
    if (!sample) { const int b = row >> 8, pp = row & 255; kd = Kp + ((size_t)(b * 4 + h) * LP + pp) * 192; }
    else if (!isctx) { const int b = (row - TP) >> 11, pp = (row - TP) & 2047; kd = Ks + ((size_t)(b * 4 + h) * 2304 + 256 + pp) * 192; }
    else { const int cr = row - TT; const int b = cr >> 8, pp = cr & 255; kd = Ks + ((size_t)(b * 4 + h) * 2304 + pp) * 192; }
#pragma unroll
    for (int j = 0; j < 12; j += 4) {
        *(ushort4*)(kd + e0 + j) = pack_bf4(kx[j], kx[j + 1], kx[j + 2], kx[j + 3]);
        if (!isctx) *(ushort4*)(Qb + ((size_t)row * 4 + h) * 192 + e0 + j) = pack_bf4(qx[j], qx[j + 1], qx[j + 2], qx[j + 3]);
    }
}

__device__ __forceinline__ void d_rw_post2(const int vb, char* smem, const float* __restrict__ y0, const float* __restrict__ y1, const float* __restrict__ bonus,
                                           const bf16_t* __restrict__ vbuf, const bf16_t* __restrict__ gate, const float* __restrict__ lnx_g,
                                           const float* __restrict__ lnx_b, bf16_t* __restrict__ cat) {
    float* pg = (float*)smem;
    for (int i = threadIdx.x; i < 512; i += 256) { pg[i] = lnx_g[i]; pg[512 + i] = lnx_b[i]; }
    __syncthreads();
    const int w = vb * 256 + threadIdx.x;
    const int t = w >> 3, h = w & 7;
    const size_t o = (size_t)w * 64;
    float s1 = 0.f, s2 = 0.f;
#pragma unroll 4
    for (int i = 0; i < 16; i++) {
        const float4 a = *(const float4*)(y0 + o + i * 4), b = *(const float4*)(y1 + o + i * 4);
        const float e0 = a.x + b.x, e1 = a.y + b.y, e2 = a.z + b.z, e3 = a.w + b.w;
        s1 += (e0 + e1) + (e2 + e3);
        s2 += (e0 * e0 + e1 * e1) + (e2 * e2 + e3 * e3);
    }
    const float mean = s1 * (1.f / 64.f);
    const float var = fmaxf(s2 * (1.f / 64.f) - mean * mean, 0.f);
    const float rstd = rsqrtf(var + 64e-5f);
    const float bn = bonus[w];
    const float* gp = pg + h * 64; const float* bp = pg + 512 + h * 64;
#pragma unroll 2
    for (int i = 0; i < 8; i++) {
        const float4 ya = *(const float4*)(y0 + o + i * 8), yb = *(const float4*)(y1 + o + i * 8);
        const float4 yc = *(const float4*)(y0 + o + i * 8 + 4), yd = *(const float4*)(y1 + o + i * 8 + 4);
        const float yy[8] = {ya.x + yb.x, ya.y + yb.y, ya.z + yb.z, ya.w + yb.w, yc.x + yd.x, yc.y + yd.y, yc.z + yd.z, yc.w + yd.w};
        const u32x4 vq = *(const u32x4*)(vbuf + o + i * 8);
        const u32x4 gq = *(const u32x4*)(gate + o + i * 8);
        u32x4 oq;
#pragma unroll
        for (int j = 0; j < 4; j++) {
            const int e0 = i * 8 + 2 * j, e1 = e0 + 1;
            const float v0 = __uint_as_float(vq[j] << 16), v1 = __uint_as_float(vq[j] & 0xffff0000u);
            const float g0 = __uint_as_float(gq[j] << 16), g1 = __uint_as_float(gq[j] & 0xffff0000u);
            const float r0 = ((yy[2 * j] - mean) * rstd * gp[e0] + bp[e0] + bn * v0) * g0;
            const float r1 = ((yy[2 * j + 1] - mean) * rstd * gp[e1] + bp[e1] + bn * v1) * g1;
            oq[j] = (unsigned)f2bf(r0) | ((unsigned)f2bf(r1) << 16);
        }
        *(u32x4*)(cat + (size_t)t * DM + h * 64 + i * 8) = oq;
    }
}


typedef float f32x2 __attribute__((ext_vector_type(2)));
template <int CTRL>
__device__ __forceinline__ float dpp_max(float v) {
    return fmaxf(v, __int_as_float(__builtin_amdgcn_update_dpp(0, __float_as_int(v), CTRL, 0xf, 0xf, false)));
}
__device__ __forceinline__ float wave_allmax_fast(float v) {
    v = dpp_max<0x128>(v); v = dpp_max<0x124>(v); v = dpp_max<0x122>(v); v = dpp_max<0x121>(v);
    const float r0 = __int_as_float(__builtin_amdgcn_readlane(__float_as_int(v), 0));
    const float r1 = __int_as_float(__builtin_amdgcn_readlane(__float_as_int(v), 16));
    const float r2 = __int_as_float(__builtin_amdgcn_readlane(__float_as_int(v), 32));
    const float r3 = __int_as_float(__builtin_amdgcn_readlane(__float_as_int(v), 48));
    return fmaxf(fmaxf(r0, r1), fmaxf(r2, r3));
}
__device__ __forceinline__ void d_cvt_fp8_rows(const int vb, const float* __restrict__ src, unsigned char* __restrict__ dst, float* __restrict__ rscale) {
    const int wid = threadIdx.x >> 6, lane = threadIdx.x & 63;
    float4 x[4][4];
#pragma unroll
    for (int u = 0; u < 4; u++) {
        const float* r = src + (size_t)(vb * 16 + wid * 4 + u) * 1024 + lane * 16;
#pragma unroll
        for (int j = 0; j < 4; j++) x[u][j] = *(const float4*)(r + 4 * j);
    }
#pragma unroll
    for (int u = 0; u < 4; u++) {
        const int row = vb * 16 + wid * 4 + u;
        float am = 0.f;
#pragma unroll
        for (int j = 0; j < 4; j++) am = fmaxf(am, fmaxf(fmaxf(fabsf(x[u][j].x), fabsf(x[u][j].y)), fmaxf(fabsf(x[u][j].z), fabsf(x[u][j].w))));
        am = wave_allmax_fast(am);
        const float sc = am > 0.f ? 448.f / am : 1.f;
        u32x4 q;
#pragma unroll
        for (int j = 0; j < 4; j++) {
            int pk = __builtin_amdgcn_cvt_pk_fp8_f32(x[u][j].x * sc, x[u][j].y * sc, 0, false);
            pk = __builtin_amdgcn_cvt_pk_fp8_f32(x[u][j].z * sc, x[u][j].w * sc, pk, true);
            q[j] = (unsigned)pk;
        }
        *(u32x4*)(dst + (size_t)row * 1024 + lane * 16) = q;
        if (lane == 0) rscale[row] = am > 0.f ? am * (1.f / 448.f) : 1.f;
    }
}
__device__ __forceinline__ void d_peer_apply3(const int vb, char* smem, const bf16_t* __restrict__ hb, const int* __restrict__ pidx,
                                              const float* __restrict__ pg, const unsigned char* __restrict__ utab, const unsigned char* __restrict__ vtab,
                                              const float* __restrict__ rsU, const float* __restrict__ rsV, const float* __restrict__ modl,
                                              float* __restrict__ xrun, const float* __restrict__ g_next, const float* __restrict__ mod_next,
                                              bf16_t* __restrict__ h_next) {
    const int wid = threadIdx.x >> 6, lane = threadIdx.x & 63;
    const int t = vb * 4 + wid;
    float* coef = (float*)smem + wid * 128;
    int* eid = (int*)(smem + 2048) + wid * 128;
    const int e_lo = pidx[(size_t)t * 128 + lane], e_hi = pidx[(size_t)t * 128 + lane + 64];
    eid[lane] = e_lo; eid[lane + 64] = e_hi;
    const float g0 = pg[(size_t)t * 128 + lane] * rsV[e_lo], g1 = pg[(size_t)t * 128 + lane + 64] * rsV[e_hi];
    const float ru0 = rsU[e_lo], ru1 = rsU[e_hi];
    float x[16];
    {
        const u32x4 a = *(const u32x4*)(hb + (size_t)t * DM + lane * 16), b = *(const u32x4*)(hb + (size_t)t * DM + lane * 16 + 8);
#pragma unroll
        for (int i = 0; i < 4; i++) {
            x[2 * i] = __uint_as_float(a[i] << 16); x[2 * i + 1] = __uint_as_float(a[i] & 0xffff0000u);
            x[8 + 2 * i] = __uint_as_float(b[i] << 16); x[8 + 2 * i + 1] = __uint_as_float(b[i] & 0xffff0000u);
        }
    }
    __builtin_amdgcn_wave_barrier();
    float myact0 = 0.f, myact1 = 0.f;
#pragma unroll 1
    for (int eb = 0; eb < 128; eb += 16) {
        u32x4 q[16];
#pragma unroll
        for (int r = 0; r < 16; r++) q[r] = *(const u32x4*)(utab + (size_t)eid[eb + r] * 1024 + lane * 16);
#pragma unroll
        for (int r = 0; r < 16; r++) {
            float sacc = 0.f;
#pragma unroll
            for (int i = 0; i < 4; i++) {
                const f32x2 f01 = __builtin_amdgcn_cvt_pk_f32_fp8((int)q[r][i], false);
                const f32x2 f23 = __builtin_amdgcn_cvt_pk_f32_fp8((int)q[r][i], true);
                sacc += f01[0] * x[4 * i] + f01[1] * x[4 * i + 1] + f23[0] * x[4 * i + 2] + f23[1] * x[4 * i + 3];
            }
            sacc = wave_allsum_fast(sacc);
            const int e = eb + r;
            if (lane == (e & 63)) { if (e < 64) myact0 = sacc; else myact1 = sacc; }
        }
    }
    coef[lane] = g0 * gelu_tanh(myact0 * ru0);
    coef[lane + 64] = g1 * gelu_tanh(myact1 * ru1);
    __builtin_amdgcn_wave_barrier();
    float acc[16];
#pragma unroll
    for (int i = 0; i < 16; i++) acc[i] = 0.f;
#pragma unroll 1
    for (int eb = 0; eb < 128; eb += 16) {
        u32x4 q[16];
#pragma unroll
        for (int r = 0; r < 16; r++) q[r] = *(const u32x4*)(vtab + (size_t)eid[eb + r] * 1024 + lane * 16);
#pragma unroll
        for (int r = 0; r < 16; r++) {
            const float cf = coef[eb + r];
#pragma unroll
            for (int i = 0; i < 4; i++) {
                const f32x2 f01 = __builtin_amdgcn_cvt_pk_f32_fp8((int)q[r][i], false);
                const f32x2 f23 = __builtin_amdgcn_cvt_pk_f32_fp8((int)q[r][i], true);
                acc[4 * i] += cf * f01[0]; acc[4 * i + 1] += cf * f01[1]; acc[4 * i + 2] += cf * f23[0]; acc[4 * i + 3] += cf * f23[1];
            }
        }
    }
    const float* m = modl + (size_t)tok_modrow(t) * 6144 + 5 * 1024 + lane * 16;
    float* xo = xrun + (size_t)t * DM + lane * 16;
    float ss = 0.f;
#pragma unroll
    for (int j = 0; j < 4; j++) {
        float4 xa = *(float4*)(xo + 4 * j);
        const float4 ma = *(const float4*)(m + 4 * j);
        xa.x += ma.x * acc[4 * j]; xa.y += ma.y * acc[4 * j + 1]; xa.z += ma.z * acc[4 * j + 2]; xa.w += ma.w * acc[4 * j + 3];
        *(float4*)(xo + 4 * j) = xa;
        acc[4 * j] = xa.x; acc[4 * j + 1] = xa.y; acc[4 * j + 2] = xa.z; acc[4 * j + 3] = xa.w;
        ss += xa.x * xa.x + xa.y * xa.y + xa.z * xa.z + xa.w * xa.w;
    }
    if (g_next != nullptr) {
        ss = wave_allsum_fast(ss);
        const float rstd = rsqrtf(ss * (1.f / DM) + 1e-6f);
        const float* mn = mod_next + (size_t)tok_modrow(t) * 6144 + lane * 16;
#pragma unroll
        for (int j = 0; j < 4; j++) {
            const float4 gg = *(const float4*)(g_next + lane * 16 + 4 * j);
            const float4 sh = *(const float4*)(mn + 4 * j);
            const float4 sc = *(const float4*)(mn + 1024 + 4 * j);
            *(ushort4*)(h_next + (size_t)t * DM + lane * 16 + 4 * j) =
                pack_bf4(acc[4 * j] * rstd * gg.x * (1.f + sc.x) + sh.x, acc[4 * j + 1] * rstd * gg.y * (1.f + sc.y) + sh.y,
                         acc[4 * j + 2] * rstd * gg.z * (1.f + sc.z) + sh.z, acc[4 * j + 3] * rstd * gg.w * (1.f + sc.w) + sh.w);
        }
    }
}

#define XB_TMO      128
#define XB_XCNT(j)  (256  + 64 * (j))
#define XB_XSUB(j)  (1280 + 64 * (j))
#define XB_XGEN(j)  (2304 + 64 * (j))
#define XB_TOP      3328
#define XB_TOPGEN   3392
#define XCD_BAR_WORDS 3456
#define XB_SPIN_CAP (1u << 22)
#define LAS __attribute__((address_space(3)))
__device__ __forceinline__ unsigned xb_ld(unsigned* p) { return __hip_atomic_load(p, __ATOMIC_RELAXED, __HIP_MEMORY_SCOPE_AGENT); }
__device__ __forceinline__ unsigned xb_add(unsigned* p, unsigned v) { return __hip_atomic_fetch_add(p, v, __ATOMIC_RELAXED, __HIP_MEMORY_SCOPE_AGENT); }
__device__ __forceinline__ unsigned xb_xcc_id() { return (unsigned)__builtin_amdgcn_s_getreg((3 << 11) | 20) & 0xFu; }
#define XB_SPIN(cond, bar) do { unsigned _sp = 0; while (cond) { __builtin_amdgcn_s_sleep(1); \
    if ((++_sp & 255u) == 0u) { if (xb_ld(&(bar)[XB_TMO])) break; if (_sp > XB_SPIN_CAP) { atomicAdd(&(bar)[XB_TMO], 1u); break; } } } } while (0)
struct XcdBarrier { unsigned* bar; unsigned x; volatile LAS unsigned* st; };
__device__ __forceinline__ XcdBarrier xcd_barrier_post(unsigned* bar, volatile LAS unsigned* st) {
    XcdBarrier b; b.bar = bar; b.x = xb_xcc_id(); b.st = st;
    if (threadIdx.x == 0) (void)xb_add(&bar[XB_XCNT(b.x)], 1u);
    return b;
}
__device__ __forceinline__ void xcd_barrier_complete(unsigned* bar, unsigned x, unsigned& nloc, unsigned& nx) {
    const unsigned G = gridDim.x * gridDim.y * gridDim.z;
    unsigned sum, cnt, mine, sp = 0u;
    for (;;) {
        sum = 0u; cnt = 0u; mine = 0u;
#pragma unroll
        for (unsigned j = 0; j < 16; ++j) { const unsigned c = xb_ld(&bar[XB_XCNT(j)]); sum += c; cnt += (c > 0u) ? 1u : 0u; mine = (j == x) ? c : mine; }
        if (sum == G) break;
        __builtin_amdgcn_s_sleep(1);
        if ((++sp & 255u) == 0u) { if (xb_ld(&bar[XB_TMO])) break; if (sp > XB_SPIN_CAP) { atomicAdd(&bar[XB_TMO], 1u); break; } }
    }
    nloc = mine > 0u ? mine : 1u; nx = cnt > 0u ? cnt : 1u;
}
__device__ __forceinline__ void xcd_barrier_(unsigned* bar_, char* smem_) {
    XcdBarrier b; b.bar = bar_; b.x = xb_xcc_id(); b.st = (volatile LAS unsigned*)(smem_ + GEMM_LDS_BYTES);
    asm volatile("s_waitcnt vmcnt(0)" ::: "memory");
    __syncthreads();
    if (threadIdx.x == 0) {
        unsigned* bar = b.bar;
        __builtin_amdgcn_s_waitcnt(0);
        unsigned nloc = b.st[0], nx = b.st[1];
        if (nloc == 0u) { xcd_barrier_complete(bar, b.x, nloc, nx); b.st[0] = nloc; b.st[1] = nx; }
        const unsigned old = xb_add(&bar[XB_XSUB(b.x)], 1u);
        const unsigned gen = old / nloc;
        if (old + 1u == (gen + 1u) * nloc) {
            __builtin_amdgcn_fence(__ATOMIC_RELEASE, "agent");
            asm volatile("s_waitcnt vmcnt(0)" ::: "memory");
            const unsigned og = xb_add(&bar[XB_TOP], 1u);
            const unsigned tg = og / nx;
            if (og + 1u == (tg + 1u) * nx) xb_add(&bar[XB_TOPGEN], 1u);
            else XB_SPIN(xb_ld(&bar[XB_TOPGEN]) == tg, bar);
            __builtin_amdgcn_fence(__ATOMIC_ACQUIRE, "agent");
            xb_add(&bar[XB_XGEN(b.x)], 1u);
            asm volatile("s_waitcnt vmcnt(0)" ::: "memory");
        } else {
            XB_SPIN(xb_ld(&bar[XB_XGEN(b.x)]) == gen, bar);
            __builtin_amdgcn_fence(__ATOMIC_ACQUIRE, "agent");
            asm volatile("s_waitcnt vmcnt(0)" ::: "memory");
        }
    }
    __syncthreads();
}

constexpr size_t ws_al(size_t x) { return (x + 255) & ~(size_t)255; }
struct WS {
    static constexpr size_t mod = 0;
    static constexpr size_t w_in_t = ws_al(mod + (size_t)(2*5*6144*4));
    static constexpr size_t w_out_t = ws_al(w_in_t + (size_t)(2304*1024*2));
    static constexpr size_t hy_w_in_t = ws_al(w_out_t + (size_t)(1024*1024*2));
    static constexpr size_t hy_w_out_t = ws_al(hy_w_in_t + (size_t)(3072*1024*2));
    static constexpr size_t w_q_t = ws_al(hy_w_out_t + (size_t)(1024*1024*2));
    static constexpr size_t q_up_t = ws_al(w_q_t + (size_t)(2*2048*1024*2));
    static constexpr size_t kv_up_t = ws_al(q_up_t + (size_t)(768*256*2));
    static constexpr size_t w2_t = ws_al(kv_up_t + (size_t)(1024*128*2));
    static constexpr size_t a2_t = ws_al(w2_t + (size_t)(2*512*64*2));
    static constexpr size_t g2_t = ws_al(a2_t + (size_t)(2*512*64*2));
    static constexpr size_t ctxb = ws_al(g2_t + (size_t)(512*128*2));
    static constexpr size_t keysb = ws_al(ctxb + (size_t)(1024*128*2));
    static constexpr size_t tabU = ws_al(keysb + (size_t)(2*16*128*128*2));
    static constexpr size_t tabV = ws_al(tabU + (size_t)(16384*1024));
    static constexpr size_t rsU = ws_al(tabV + (size_t)(16384*1024));
    static constexpr size_t rsV = ws_al(rsU + (size_t)(16384*4));
    static constexpr size_t nsum = ws_al(rsV + (size_t)(16384*4));
    static constexpr size_t gTS = ws_al(nsum + (size_t)(2*1024*4 + 3456*4 + 1024));
    static constexpr size_t gTP = ws_al(gTS + (size_t)1024*2*2048*2);
    static constexpr size_t R1 = ws_al(gTP + (size_t)1024*2*256*2);
    static constexpr size_t R2 = ws_al(R1 + (size_t)((size_t)TT*1024*4));
    static constexpr size_t rb = ws_al(R2 + (size_t)((size_t)TT*1792*2 + (size_t)TT*448*4));
    static constexpr size_t kb = ws_al(rb + (size_t)((size_t)TT*512*2));
    static constexpr size_t vb = ws_al(kb + (size_t)((size_t)TT*512*2));
    static constexpr size_t kkb = ws_al(vb + (size_t)((size_t)TT*512*2));
    static constexpr size_t lr0 = ws_al(kkb + (size_t)((size_t)TT*512*2));
    static constexpr size_t lr1 = ws_al(lr0 + (size_t)((size_t)TT*512*2));
    static constexpr size_t gateb = ws_al(lr1 + (size_t)((size_t)TT*512*2));
    static constexpr size_t du0 = ws_al(gateb + (size_t)((size_t)TT*512*2));
    static constexpr size_t du1 = ws_al(du0 + (size_t)((size_t)TT*512*2));
    static constexpr size_t twb = ws_al(du1 + (size_t)((size_t)TT*512*2));
    static constexpr size_t advb = ws_al(twb + (size_t)((size_t)TT*64*2));
    static constexpr size_t sgb = ws_al(advb + (size_t)((size_t)TT*64*2));
    static constexpr size_t bonus = ws_al(sgb + (size_t)((size_t)TT*128*2));
    static constexpr size_t kpe = ws_al(bonus + (size_t)((size_t)TT*8*4));
    static constexpr size_t qcnb = ws_al(kpe + (size_t)((size_t)TT*64*4));
    static constexpr size_t ckvb = ws_al(qcnb + (size_t)((size_t)TT*256*2));
    static constexpr size_t Qb = ws_al(ckvb + (size_t)((size_t)TT*128*2));
    static constexpr size_t Kp = ws_al(Qb + (size_t)((size_t)TT*768*2));
    static constexpr size_t Vp = ws_al(Kp + (size_t)(16*4*256*192*2));
    static constexpr size_t Ks = ws_al(Vp + (size_t)(16*4*256*128*2));
    static constexpr size_t Vs = ws_al(Ks + (size_t)(4*4*2304*192*2));
    static constexpr size_t kvctxb = ws_al(Vs + (size_t)(4*4*2304*128*2));
    static constexpr size_t pidx = ws_al(kvctxb + (size_t)(1024*1024*2));
    static constexpr size_t pg = ws_al(pidx + (size_t)((size_t)TT*128*4));
    static constexpr size_t END = ws_al(pg + (size_t)((size_t)TT*128*4));
    static constexpr size_t hb = R1;
    static constexpr size_t catb = R1;
    static constexpr size_t zbb = R1;
    static constexpr size_t kvrawb = R1;
    static constexpr size_t qrawb = R1 + (size_t)TT*1024*2;
    static constexpr size_t projrw = R2;
    static constexpr size_t projmla = R2 + (size_t)TT*1792*2;
    static constexpr size_t y0 = R2;
    static constexpr size_t y1 = R2 + (size_t)TT*512*4;
    static constexpr size_t qb = R2;
    static constexpr size_t scT = rb;
    static constexpr size_t pre = R2;
    static constexpr size_t zT = R2 + (size_t)TT*3072*4;
    static constexpr size_t x0b = R2 + (size_t)TT*3072*4 + (size_t)TT*1024*2;
    static constexpr size_t yT = R2 + (size_t)TT*3072*4 + (size_t)TT*1024*4;
    static constexpr size_t bar = nsum + 2*1024*4;
};
struct Params {
    const float* in[46];
    float* out;
    char* ws;
    __device__ __forceinline__ const float* x_prompt() const { return in[0]; }
    __device__ __forceinline__ const float* x_sample() const { return in[1]; }
    __device__ __forceinline__ const float* st_f() const { return in[2]; }
    __device__ __forceinline__ const float* st_b() const { return in[3]; }
    __device__ __forceinline__ const float* cache_ckv() const { return in[4]; }
    __device__ __forceinline__ const float* cache_kpe() const { return in[5]; }
    __device__ __forceinline__ const float* c() const { return in[6]; }
    __device__ __forceinline__ const float* c_ctx() const { return in[7]; }
    __device__ __forceinline__ const float* norm_g() const { return in[8]; }
    __device__ __forceinline__ const float* w_mod() const { return in[9]; }
    __device__ __forceinline__ const float* b_mod() const { return in[10]; }
    __device__ __forceinline__ const float* ab_w_in() const { return in[11]; }
    __device__ __forceinline__ const float* rw_mu() const { return in[12]; }
    __device__ __forceinline__ const float* rw_w0() const { return in[13]; }
    __device__ __forceinline__ const float* rw_w2() const { return in[14]; }
    __device__ __forceinline__ const float* rw_a0() const { return in[15]; }
    __device__ __forceinline__ const float* rw_a2() const { return in[16]; }
    __device__ __forceinline__ const float* rw_g2() const { return in[17]; }
    __device__ __forceinline__ const float* rw_k_k() const { return in[18]; }
    __device__ __forceinline__ const float* rw_k_a() const { return in[19]; }
    __device__ __forceinline__ const float* rw_r_k() const { return in[20]; }
    __device__ __forceinline__ const float* rw_lnx_g() const { return in[21]; }
    __device__ __forceinline__ const float* rw_lnx_b() const { return in[22]; }
    __device__ __forceinline__ const float* mla_q_norm() const { return in[23]; }
    __device__ __forceinline__ const float* mla_q_up() const { return in[24]; }
    __device__ __forceinline__ const float* mla_kv_norm() const { return in[25]; }
    __device__ __forceinline__ const float* mla_kv_up() const { return in[26]; }
    __device__ __forceinline__ const float* mla_qn() const { return in[27]; }
    __device__ __forceinline__ const float* mla_kn() const { return in[28]; }
    __device__ __forceinline__ const float* ab_w_out() const { return in[29]; }
    __device__ __forceinline__ const float* hy_w_in() const { return in[30]; }
    __device__ __forceinline__ const float* hy_b_in() const { return in[31]; }
    __device__ __forceinline__ const float* hy_conv_w() const { return in[32]; }
    __device__ __forceinline__ const float* hy_conv_b() const { return in[33]; }
    __device__ __forceinline__ const float* hy_f_w1() const { return in[34]; }
    __device__ __forceinline__ const float* hy_f_b1() const { return in[35]; }
    __device__ __forceinline__ const float* hy_f_w2() const { return in[36]; }
    __device__ __forceinline__ const float* hy_f_b2() const { return in[37]; }
    __device__ __forceinline__ const float* hy_f_w3() const { return in[38]; }
    __device__ __forceinline__ const float* hy_f_freq() const { return in[39]; }
    __device__ __forceinline__ const float* hy_bias() const { return in[40]; }
    __device__ __forceinline__ const float* hy_w_out() const { return in[41]; }
    __device__ __forceinline__ const float* peer_w_q() const { return in[42]; }
    __device__ __forceinline__ const float* peer_keys() const { return in[43]; }
    __device__ __forceinline__ const float* peer_u() const { return in[44]; }
    __device__ __forceinline__ const float* peer_v() const { return in[45]; }
    __device__ __forceinline__ float* xrun() const { return out + (0); }
    __device__ __forceinline__ float* out_sf() const { return out + ((size_t)TT*DM); }
    __device__ __forceinline__ float* out_sb() const { return out + ((size_t)TT*DM + 16*8*64*64); }
    __device__ __forceinline__ float* out_ckv() const { return out + ((size_t)TT*DM + 2*16*8*64*64); }
    __device__ __forceinline__ float* out_kpe() const { return out + ((size_t)TT*DM + 2*16*8*64*64 + 16*256*128); }
    __device__ __forceinline__ float* mod() const { return (float*)(ws + WS::mod); }
    __device__ __forceinline__ bf16_t* w_in_t() const { return (bf16_t*)(ws + WS::w_in_t); }
    __device__ __forceinline__ bf16_t* w_out_t() const { return (bf16_t*)(ws + WS::w_out_t); }
    __device__ __forceinline__ bf16_t* hy_w_in_t() const { return (bf16_t*)(ws + WS::hy_w_in_t); }
    __device__ __forceinline__ bf16_t* hy_w_out_t() const { return (bf16_t*)(ws + WS::hy_w_out_t); }
    __device__ __forceinline__ bf16_t* w_q_t() const { return (bf16_t*)(ws + WS::w_q_t); }
    __device__ __forceinline__ bf16_t* q_up_t() const { return (bf16_t*)(ws + WS::q_up_t); }
    __device__ __forceinline__ bf16_t* kv_up_t() const { return (bf16_t*)(ws + WS::kv_up_t); }
    __device__ __forceinline__ bf16_t* w2_t() const { return (bf16_t*)(ws + WS::w2_t); }
    __device__ __forceinline__ bf16_t* a2_t() const { return (bf16_t*)(ws + WS::a2_t); }
    __device__ __forceinline__ bf16_t* g2_t() const { return (bf16_t*)(ws + WS::g2_t); }
    __device__ __forceinline__ bf16_t* ctxb() const { return (bf16_t*)(ws + WS::ctxb); }
    __device__ __forceinline__ bf16_t* keysb() const { return (bf16_t*)(ws + WS::keysb); }
    __device__ __forceinline__ unsigned char* tabU() const { return (unsigned char*)(ws + WS::tabU); }
    __device__ __forceinline__ float* rsU() const { return (float*)(ws + WS::rsU); }
    __device__ __forceinline__ float* rsV() const { return (float*)(ws + WS::rsV); }
    __device__ __forceinline__ unsigned char* tabV() const { return (unsigned char*)(ws + WS::tabV); }
    __device__ __forceinline__ float* nsum() const { return (float*)(ws + WS::nsum); }
    __device__ __forceinline__ bf16_t* rb() const { return (bf16_t*)(ws + WS::rb); }
    __device__ __forceinline__ bf16_t* kb() const { return (bf16_t*)(ws + WS::kb); }
    __device__ __forceinline__ bf16_t* vb() const { return (bf16_t*)(ws + WS::vb); }
    __device__ __forceinline__ bf16_t* kkb() const { return (bf16_t*)(ws + WS::kkb); }
    __device__ __forceinline__ bf16_t* lr0() const { return (bf16_t*)(ws + WS::lr0); }
    __device__ __forceinline__ bf16_t* lr1() const { return (bf16_t*)(ws + WS::lr1); }
    __device__ __forceinline__ bf16_t* gateb() const { return (bf16_t*)(ws + WS::gateb); }
    __device__ __forceinline__ _Float16* du0() const { return (_Float16*)(ws + WS::du0); }
    __device__ __forceinline__ _Float16* du1() const { return (_Float16*)(ws + WS::du1); }
    __device__ __forceinline__ bf16_t* twb() const { return (bf16_t*)(ws + WS::twb); }
    __device__ __forceinline__ bf16_t* advb() const { return (bf16_t*)(ws + WS::advb); }
    __device__ __forceinline__ bf16_t* sgb() const { return (bf16_t*)(ws + WS::sgb); }
    __device__ __forceinline__ float* bonus() const { return (float*)(ws + WS::bonus); }
    __device__ __forceinline__ float* kpe() const { return (float*)(ws + WS::kpe); }
    __device__ __forceinline__ bf16_t* qcnb() const { return (bf16_t*)(ws + WS::qcnb); }
    __device__ __forceinline__ bf16_t* ckvb() const { return (bf16_t*)(ws + WS::ckvb); }
    __device__ __forceinline__ bf16_t* Qb() const { return (bf16_t*)(ws + WS::Qb); }
    __device__ __forceinline__ bf16_t* Kp() const { return (bf16_t*)(ws + WS::Kp); }
    __device__ __forceinline__ bf16_t* Vp() const { return (bf16_t*)(ws + WS::Vp); }
    __device__ __forceinline__ bf16_t* Ks() const { return (bf16_t*)(ws + WS::Ks); }
    __device__ __forceinline__ bf16_t* Vs() const { return (bf16_t*)(ws + WS::Vs); }
    __device__ __forceinline__ bf16_t* kvctxb() const { return (bf16_t*)(ws + WS::kvctxb); }
    __device__ __forceinline__ int* pidx() const { return (int*)(ws + WS::pidx); }
    __device__ __forceinline__ float* pg() const { return (float*)(ws + WS::pg); }
    __device__ __forceinline__ bf16_t* hb() const { return (bf16_t*)(ws + WS::hb); }
    __device__ __forceinline__ bf16_t* catb() const { return (bf16_t*)(ws + WS::catb); }
    __device__ __forceinline__ bf16_t* zbb() const { return (bf16_t*)(ws + WS::zbb); }
    __device__ __forceinline__ bf16_t* kvrawb() const { return (bf16_t*)(ws + WS::kvrawb); }
    __device__ __forceinline__ bf16_t* qrawb() const { return (bf16_t*)(ws + WS::qrawb); }
    __device__ __forceinline__ bf16_t* projrw() const { return (bf16_t*)(ws + WS::projrw); }
    __device__ __forceinline__ float* projmla() const { return (float*)(ws + WS::projmla); }
    __device__ __forceinline__ float* y0() const { return (float*)(ws + WS::y0); }
    __device__ __forceinline__ float* y1() const { return (float*)(ws + WS::y1); }
    __device__ __forceinline__ bf16_t* qb() const { return (bf16_t*)(ws + WS::qb); }
    __device__ __forceinline__ float* scT() const { return (float*)(ws + WS::scT); }
    __device__ __forceinline__ float* pre() const { return (float*)(ws + WS::pre); }
    __device__ __forceinline__ bf16_t* zT() const { return (bf16_t*)(ws + WS::zT); }
    __device__ __forceinline__ bf16_t* x0b() const { return (bf16_t*)(ws + WS::x0b); }
    __device__ __forceinline__ bf16_t* yT() const { return (bf16_t*)(ws + WS::yT); }
    __device__ __forceinline__ bf16_t* gTS() const { return (bf16_t*)(ws + WS::gTS); }
    __device__ __forceinline__ bf16_t* gTP() const { return (bf16_t*)(ws + WS::gTP); }
    __device__ __forceinline__ unsigned* bar() const { return (unsigned*)(ws + WS::bar); }
};

#define VLOOP(n) for (int vb = blockIdx.x; vb < (n); vb += gridDim.x)
#define ENDV __syncthreads();

__device__ __forceinline__ void peer_layer(const Params& p, char* smem, int li, const float* modl, float* xrs) {
    const bf16_t* wq = p.w_q_t() + (size_t)li * 2048 * 1024;
    const bf16_t* kys = p.keysb() + (size_t)li * 16 * 128 * 128;
    VLOOP(TT / 8) { d_norm_mod2(vb, p.xrun(), xrs, p.norm_g() + (li * 2 + 1) * 1024, modl, 3, 4, p.hb()); }
    xcd_barrier_(p.bar(), smem);
    VLOOP(16 * 96) { d_gemm_bf16(vb % 16, vb / 16, smem, p.hb(), 1024, wq, 1024, 1024, 2048, EpiStoreBf{p.qb(), 2048, 0}); }
    xcd_barrier_(p.bar(), smem);
    VLOOP(8 * 96) { d_peer_route2(vb, smem, kys, p.qb(), p.pidx(), p.pg()); ENDV }
    xcd_barrier_(p.bar(), smem);
    VLOOP(TT / 4) { d_peer_apply3(vb, smem, p.hb(), p.pidx(), p.pg(), p.tabU(), p.tabV(), p.rsU(), p.rsV(), modl, p.xrun(),
                                    li == 0 ? p.norm_g() + 2048 : nullptr, p.mod() + 5 * 6144, p.hb()); ENDV }
}

__global__ void __launch_bounds__(256, 2) mega(Params p) {
    __shared__ __attribute__((aligned(16))) char smem[GEMM_LDS_BYTES + 16];
    cg::grid_group grid = cg::this_grid();
    if (threadIdx.x < 4) ((unsigned*)(smem + GEMM_LDS_BYTES))[threadIdx.x] = 0u;
    __syncthreads();
    (void)xcd_barrier_post(p.bar(), (volatile LAS unsigned*)(smem + GEMM_LDS_BYTES));
    const float* mod0 = p.mod();
    const float* mod1 = p.mod() + 5 * 6144;
    float* xrs = p.xrun() + (size_t)TP * DM;

    VLOOP(192) { d_mod3(vb, smem, p.c(), p.c_ctx(), p.w_mod(), p.b_mod(), p.mod()); ENDV }
    {
        const int j1 = 36 * 16;
        const int j7 = j1 + 12 * 4;
        const int j8 = j7 + 16 * 2;
        const int j9 = j8 + 8;
        const int j10 = j9 + 8;
        const int j11 = j10 + 8;
        const int j12 = j11 + 8;
        const int j13 = j12 + 8 * 2;
        VLOOP(j13) {
            const float* W; bf16_t* Wt; int K, N, lv;
            if (vb < j1) { W = p.ab_w_in(); Wt = p.w_in_t(); K = 1024; N = 2240; lv = vb; }
            else if (vb < j7) { W = p.mla_q_up(); Wt = p.q_up_t(); K = 256; N = 768; lv = vb - j1; }
            else if (vb < j8) { W = p.mla_kv_up(); Wt = p.kv_up_t(); K = 128; N = 1024; lv = vb - j7; }
            else if (vb < j9) { W = p.rw_w2(); Wt = p.w2_t(); K = 64; N = 512; lv = vb - j8; }
            else if (vb < j10) { W = p.rw_w2() + 64 * 512; Wt = p.w2_t() + 512 * 64; K = 64; N = 512; lv = vb - j9; }
            else if (vb < j11) { W = p.rw_a2(); Wt = p.a2_t(); K = 64; N = 512; lv = vb - j10; }
            else if (vb < j12) { W = p.rw_a2() + 64 * 512; Wt = p.a2_t() + 512 * 64; K = 64; N = 512; lv = vb - j11; }
            else { W = p.rw_g2(); Wt = p.g2_t(); K = 128; N = 512; lv = vb - j12; }
            d_transpose_w(lv, smem, W, K, N, Wt);
            ENDV }
    }
    VLOOP(40) { if (vb < 8) d_cvt_bf16(vb, p.cache_ckv(), p.ctxb()); else d_cvt_bf16(vb - 8, p.peer_keys(), p.keysb()); }
    if (p.ws == nullptr) grid.sync();
    xcd_barrier_(p.bar(), smem);
    VLOOP(TT / 8) { d_norm_mod2(vb, p.x_prompt(), p.x_sample(), p.norm_g(), mod0, 0, 1, p.hb()); }
    xcd_barrier_(p.bar(), smem);
    VLOOP(18 * 96) { d_gemm_bf16(vb % 18, vb / 18, smem, p.hb(), 1024, p.w_in_t(), 1024, 1024, ABIN, EpiProj{p.projrw(), p.projmla()}); }
    xcd_barrier_(p.bar(), smem);
    VLOOP(2688 + 768) {
        if (vb < 2688) d_rw_shift2(vb, p.projrw(), p.rw_mu(), p.rb(), p.kb(), p.vb(), p.twb(), p.advb(), p.sgb());
        else d_mla_pre2(vb - 2688, p.projmla(), p.mla_q_norm(), p.mla_kv_norm(), p.qcnb(), p.ckvb(), p.kpe(), p.out_ckv(), p.out_kpe());
    }
    xcd_barrier_(p.bar(), smem);
    {
        const int n0 = 4 * 96, n1 = 6 * 96, n2 = 8 * 96, n3 = 8 * 8;
        VLOOP(5 * n0 + n1 + n2 + n3) {
            int v = vb;
            if (v < n0) d_gemm_bf16(v % 4, v / 4, smem, p.twb(), 64, p.w2_t(), 64, 64, 512, EpiDecay{p.du0(), p.rw_w0()});
            else if ((v -= n0) < n0) d_gemm_bf16(v % 4, v / 4, smem, p.twb(), 64, p.w2_t() + 512 * 64, 64, 64, 512, EpiDecay{p.du1(), p.rw_w0() + 512});
            else if ((v -= n0) < n0) d_gemm_bf16(v % 4, v / 4, smem, p.advb(), 64, p.a2_t(), 64, 64, 512, EpiLr{p.lr0(), p.rw_a0()});
            else if ((v -= n0) < n0) d_gemm_bf16(v % 4, v / 4, smem, p.advb(), 64, p.a2_t() + 512 * 64, 64, 64, 512, EpiLr{p.lr1(), p.rw_a0() + 512});
            else if ((v -= n0) < n0) d_gemm_bf16(v % 4, v / 4, smem, p.sgb(), 128, p.g2_t(), 128, 128, 512, EpiStoreBf{p.gateb(), 512, 0});
            else if ((v -= n0) < n1) d_gemm_bf16(v % 6, v / 6, smem, p.qcnb(), 256, p.q_up_t(), 256, 256, 768, EpiStoreBf{p.qrawb(), 768, 0});
            else if ((v -= n1) < n2) d_gemm_bf16(v % 8, v / 8, smem, p.ckvb(), 128, p.kv_up_t(), 128, 128, 1024, EpiKV{p.kvrawb(), p.Vp(), p.Vs(), 0, 0});
            else { v -= n2; d_gemm_bf16(v % 8, v / 8, smem, p.ctxb(), 128, p.kv_up_t(), 128, 128, 1024, EpiKV{p.kvctxb(), p.Vp(), p.Vs(), 1, 0}); }
        }
    }
    xcd_barrier_(p.bar(), smem);
    VLOOP(384 + 3328) {
        if (vb < 384) d_rw_kk2(vb, smem, p.rb(), p.kb(), p.lr0(), p.lr1(), p.rw_k_k(), p.rw_k_a(), p.rw_r_k(), p.kkb(), p.bonus());
        else d_mla_post2(vb - 384, p.qrawb(), p.kvrawb(), p.kvctxb(), p.kpe(), p.cache_kpe(), p.mla_qn(), p.mla_kn(), p.Qb(), p.Kp(), p.Ks());
        ENDV }
    xcd_barrier_(p.bar(), smem);
    {
        const bool big = gridDim.x >= 512;
        const int stride = big ? (blockIdx.x < 256 ? (1 << 28) : (int)gridDim.x - 256) : (int)gridDim.x;
        for (int v = blockIdx.x; v < 256 + 1024; v += stride)
            d_scan2(v < 256 ? v : v - 256, v < 256, smem, p.rb(), p.kb(), p.vb(), p.kkb(), p.lr0(), p.lr1(), p.du0(), p.du1(), p.rw_k_a(), p.st_f(), p.st_b(), p.y0(), p.y1(), p.out_sf(), p.out_sb());
    }
#define QLOOP(ctr_word, nitems, ...)                                                            \
    {                                                                                           \
        unsigned* qctr = p.bar() + XCD_BAR_WORDS + 128 + (ctr_word);                            \
        volatile unsigned* bc = (volatile unsigned*)(smem + GEMM_LDS_BYTES + 8);                \
        for (;;) {                                                                              \
            if (threadIdx.x == 0) *bc = atomicAdd(qctr, 1u);                                    \
            __syncthreads();                                                                    \
            const int item = (int)*bc;                                                          \
            __syncthreads();                                                                    \
            if (item >= (nitems)) break;                                                        \
            __VA_ARGS__                                                                         \
        }                                                                                       \
    }
    QLOOP(0, 384, {
        const bool smp = item < 256;
        d_attn_mfma(smp ? item : item - 256, smem, p.Qb(), smp ? p.Ks() : p.Kp(), smp ? p.Vs() : p.Vp(), p.catb(), smp ? TP : 0, smp ? LS : LP,
                    smp ? 2304 : LP, smp ? 16 : 2);
    })
    QLOOP(1, 576, {
        const bool smp = item < 512;
        d_hy_filt2(smp ? item : item - 512, smem, smp ? LS : LP, p.hy_f_w1(), p.hy_f_b1(), p.hy_f_w2(), p.hy_f_b2(), p.hy_f_w3(), p.hy_f_freq(),
                   smp ? p.gTS() : p.gTP(), smp ? p.nsum() : p.nsum() + 1024);
    })
    QLOOP(2, 2048, {
        const bool isv = item >= 1024;
        d_cvt_fp8_rows(isv ? item - 1024 : item, isv ? p.peer_v() : p.peer_u(), isv ? p.tabV() : p.tabU(), isv ? p.rsV() : p.rsU());
    })
    QLOOP(3, 2304, {
        const int t1 = 16 * 16, t2 = t1 + 48 * 16, t3 = t2 + 16 * 16, t4 = t3 + 32 * 16;
        const float* W; bf16_t* Wt; int N, lv;
        if (item < t1) { W = p.ab_w_out(); Wt = p.w_out_t(); N = 1024; lv = item; }
        else if (item < t2) { W = p.hy_w_in(); Wt = p.hy_w_in_t(); N = 3072; lv = item - t1; }
        else if (item < t3) { W = p.hy_w_out(); Wt = p.hy_w_out_t(); N = 1024; lv = item - t2; }
        else if (item < t4) { W = p.peer_w_q(); Wt = p.w_q_t(); N = 2048; lv = item - t3; }
        else { W = p.peer_w_q() + (size_t)1024 * 2048; Wt = p.w_q_t() + (size_t)2048 * 1024; N = 2048; lv = item - t4; }
        d_transpose_w(lv, smem, W, 1024, N, Wt);
    })
    xcd_barrier_(p.bar(), smem);
    VLOOP(384) { d_rw_post2(vb, smem, p.y0(), p.y1(), p.bonus(), p.vb(), p.gateb(), p.rw_lnx_g(), p.rw_lnx_b(), p.catb()); ENDV }
    xcd_barrier_(p.bar(), smem);
    VLOOP(8 * 96) { d_gemm_bf16(vb % 8, vb / 8, smem, p.catb(), 1024, p.w_out_t(), 1024, 1024, 1024, EpiResid{p.x_prompt(), p.x_sample(), p.xrun(), mod0, 2, 0}); }
    xcd_barrier_(p.bar(), smem);
    peer_layer(p, smem, 0, mod0, xrs);
    xcd_barrier_(p.bar(), smem);
    VLOOP(24 * 96) { d_gemm_bf16(vb % 24, vb / 24, smem, p.hb(), 1024, p.hy_w_in_t(), 1024, 1024, 3072, EpiStore{p.pre(), p.hy_b_in(), 3072, 0}); }
    VLOOP(2048) {
        const bool isv = vb >= 1024;
        d_cvt_fp8_rows(isv ? vb - 1024 : vb, (isv ? p.peer_v() : p.peer_u()) + (size_t)16384 * 1024, isv ? p.tabV() : p.tabU(), isv ? p.rsV() : p.rsU());
    }
    xcd_barrier_(p.bar(), smem);
    VLOOP(192 * 16) { d_hy_dw2(vb, smem, p.pre(), p.hy_conv_w(), p.hy_conv_b(), p.zT(), p.x0b()); ENDV }
    xcd_barrier_(p.bar(), smem);
    VLOOP(512 + 512) {
        const int wv = threadIdx.x >> 6;
        char* wsm = smem + (wv >> 1) * 28672;
        if (vb < 512) d_hy_conv2<true>(vb * 2 + (wv >> 1), wv & 1, wsm, p.gTS(), p.nsum(), p.zT(), p.hy_bias(), p.yT());
        else d_hy_conv2<false>((vb - 512) * 2 + (wv >> 1), wv & 1, wsm, p.gTP(), p.nsum() + 1024, p.zT(), p.hy_bias(), p.yT());
        ENDV }
    xcd_barrier_(p.bar(), smem);
    VLOOP(192 * 16) { d_hy_post(vb, smem, p.yT(), p.x0b(), p.zbb()); ENDV }
    xcd_barrier_(p.bar(), smem);
    VLOOP(8 * 96) { d_gemm_bf16(vb % 8, vb / 8, smem, p.zbb(), 1024, p.hy_w_out_t(), 1024, 1024, 1024, EpiResid{p.xrun(), xrs, p.xrun(), mod1, 2, 0}); }
    xcd_barrier_(p.bar(), smem);
    peer_layer(p, smem, 1, mod1, xrs);
}

static inline size_t align_up(size_t x) { return (x + 255) & ~(size_t)255; }

extern "C" void kernel_launch(void* const* d_in, const int* in_sizes, int n_in, void* d_out, int out_size, void* d_ws, size_t ws_size,
                              hipStream_t stream) {
    Params p{};
    for (int i = 0; i < 46; i++) p.in[i] = (const float*)d_in[i];
    p.out = (float*)d_out;
    p.ws = (char*)d_ws;
    static_assert(WS::END <= (size_t)422781952, "workspace plan exceeds the guaranteed scratch size");
    static int grid_blocks = 0;
    if (!grid_blocks) {
        int dev = 0, cus = 0, per_cu = 0;
        (void)hipGetDevice(&dev);
        (void)hipDeviceGetAttribute(&cus, hipDeviceAttributeMultiprocessorCount, dev);
        (void)hipOccupancyMaxActiveBlocksPerMultiprocessor(&per_cu, mega, 256, 0);
        if (per_cu > 2) per_cu = 2;
        if (per_cu < 1) per_cu = 1;
        grid_blocks = cus * per_cu;
    }
    (void)hipMemsetAsync(p.ws + WS::nsum, 0, (size_t)2 * 1024 * 4 + (size_t)XCD_BAR_WORDS * 4 + 1024, stream);
    (void)hipMemsetAsync(p.ws + WS::mod, 0, (size_t)2 * 5 * 6144 * 4, stream);
    void* args[] = {&p};
    (void)hipLaunchCooperativeKernel((void*)mega, dim3(grid_blocks), dim3(256), args, 0, stream);
}
```

```cpp
#include <hip/hip_runtime.h>
#include <stdint.h>
#include <hip/hip_cooperative_groups.h>
namespace cg = cooperative_groups;

#define DM 1024
#define TP 4096
#define TS 8192
#define TT 12288
#define LP 256
#define LS 2048
#define NBP 16
#define NBS 4
#define ABIN 2240
#define RWIN 1792

typedef unsigned short bf16_t;
__device__ __forceinline__ bf16_t f2bf(float f) { unsigned u = __float_as_uint(f); u += 0x7fffu + ((u >> 16) & 1u); return (bf16_t)(u >> 16); }
__device__ __forceinline__ float bf2f(bf16_t h) { return __uint_as_float(((unsigned)h) << 16); }
__device__ __forceinline__ float sigmoidf_(float x) { return 1.f / (1.f + expf(-x)); }
__device__ __forceinline__ float gelu_tanh(float x) { return 0.5f * x * (1.f + tanhf(0.7978845608028654f * (x + 0.044715f * x * x * x))); }

__device__ __forceinline__ int tok_pos(int t) { return t < TP ? (t & (LP - 1)) : ((t - TP) & (LS - 1)); }
__device__ __forceinline__ int tok_len(int t) { return t < TP ? LP : LS; }
__device__ __forceinline__ int tok_modrow(int t) { return t < TP ? 0 : 1 + ((t - TP) >> 11); }

__device__ __forceinline__ float wave_sum(float v) {
#pragma unroll
    for (int o = 32; o > 0; o >>= 1) v += __shfl_xor(v, o, 64);
    return v;
}

__device__ __forceinline__ void d_mod(const int bx, const int by, const int bz, char* smem, const float* __restrict__ c, const float* __restrict__ c_ctx, const float* __restrict__ w_mod,
                                             const float* __restrict__ b_mod, float* __restrict__ mod) {
    float (*s)[1024] = (float(*)[1024])smem;
    const int li = by;
    const int n = bx * 256 + threadIdx.x;
    for (int i = threadIdx.x; i < 5 * 1024; i += 256) {
        int r = i >> 10, k = i & 1023;
        float v = (r == 0) ? c_ctx[k] : c[(r - 1) * 1024 + k];
        s[r][k] = v / (1.f + expf(-v));
    }
    __syncthreads();
    float a0 = 0, a1 = 0, a2 = 0, a3 = 0, a4 = 0;
    const float* w = w_mod + (size_t)li * 1024 * 6144 + n;
    for (int k = 0; k < 1024; k++) {
        float wv = w[(size_t)k * 6144];
        a0 += s[0][k] * wv; a1 += s[1][k] * wv; a2 += s[2][k] * wv; a3 += s[3][k] * wv; a4 += s[4][k] * wv;
    }
    float bb = b_mod[li * 6144 + n];
    float* o = mod + (size_t)li * 5 * 6144 + n;
    o[0 * 6144] = a0 + bb; o[1 * 6144] = a1 + bb; o[2 * 6144] = a2 + bb; o[3 * 6144] = a3 + bb; o[4 * 6144] = a4 + bb;
}


__device__ __forceinline__ void d_mod2(const int vb, char* smem, const float* __restrict__ c, const float* __restrict__ c_ctx,
                                       const float* __restrict__ w_mod, const float* __restrict__ b_mod, float* __restrict__ mod) {
    float* sl = (float*)smem;
    float* red = sl + 5 * 1024;
    const int li = vb / 96, n0 = (vb % 96) * 64;
    const int tid = threadIdx.x, col = tid & 63, kg = tid >> 6;
    for (int i = tid; i < 5 * 1024; i += 256) {
        const int r = i >> 10, k = i & 1023;
        const float v = (r == 0) ? c_ctx[k] : c[(r - 1) * 1024 + k];
        sl[i] = v / (1.f + __expf(-v));
    }
    __syncthreads();
    float a0 = 0, a1 = 0, a2 = 0, a3 = 0, a4 = 0;
    const float* w = w_mod + (size_t)li * 1024 * 6144 + (size_t)(kg * 256) * 6144 + n0 + col;
    const float* s0 = sl + kg * 256;
#pragma unroll 8
    for (int k = 0; k < 256; k++) {
        const float wv = w[(size_t)k * 6144];
        a0 += s0[k] * wv; a1 += s0[1024 + k] * wv; a2 += s0[2048 + k] * wv; a3 += s0[3072 + k] * wv; a4 += s0[4096 + k] * wv;
    }
    red[(kg * 5 + 0) * 64 + col] = a0; red[(kg * 5 + 1) * 64 + col] = a1; red[(kg * 5 + 2) * 64 + col] = a2;
    red[(kg * 5 + 3) * 64 + col] = a3; red[(kg * 5 + 4) * 64 + col] = a4;
    __syncthreads();
    for (int i = tid; i < 5 * 64; i += 256) {
        const int r = i >> 6, cc = i & 63;
        const float v = red[(0 * 5 + r) * 64 + cc] + red[(1 * 5 + r) * 64 + cc] + red[(2 * 5 + r) * 64 + cc] + red[(3 * 5 + r) * 64 + cc];
        mod[(size_t)(li * 5 + r) * 6144 + n0 + cc] = v + b_mod[li * 6144 + n0 + cc];
    }
}


__device__ __forceinline__ void d_mod3(const int vb, char* smem, const float* __restrict__ c, const float* __restrict__ c_ctx,
                                       const float* __restrict__ w_mod, const float* __restrict__ b_mod, float* __restrict__ mod) {
    float* sl = (float*)smem;
    const int li = vb / 96, kc = (vb % 96) / 6, cg6 = vb % 6;
    const int tid = threadIdx.x;
    for (int i = tid; i < 5 * 64; i += 256) {
        const int r = i >> 6, k = kc * 64 + (i & 63);
        const float v = (r == 0) ? c_ctx[k] : c[(r - 1) * 1024 + k];
        sl[i] = v / (1.f + __expf(-v));
    }
    __syncthreads();
    const int n = cg6 * 1024 + tid * 4;
    float4 a0 = {0, 0, 0, 0}, a1 = a0, a2 = a0, a3 = a0, a4 = a0;
    const float* w = w_mod + ((size_t)li * 1024 + kc * 64) * 6144 + n;
#pragma unroll 16
    for (int k = 0; k < 64; k++) {
        const float4 wv = *(const float4*)(w + (size_t)k * 6144);
        const float s0 = sl[k], s1 = sl[64 + k], s2 = sl[128 + k], s3 = sl[192 + k], s4 = sl[256 + k];
        a0.x += s0 * wv.x; a0.y += s0 * wv.y; a0.z += s0 * wv.z; a0.w += s0 * wv.w;
        a1.x += s1 * wv.x; a1.y += s1 * wv.y; a1.z += s1 * wv.z; a1.w += s1 * wv.w;
        a2.x += s2 * wv.x; a2.y += s2 * wv.y; a2.z += s2 * wv.z; a2.w += s2 * wv.w;
        a3.x += s3 * wv.x; a3.y += s3 * wv.y; a3.z += s3 * wv.z; a3.w += s3 * wv.w;
        a4.x += s4 * wv.x; a4.y += s4 * wv.y; a4.z += s4 * wv.z; a4.w += s4 * wv.w;
    }
    if (kc == 0) {
        const float4 bb = *(const float4*)(b_mod + li * 6144 + n);
        a0.x += bb.x; a0.y += bb.y; a0.z += bb.z; a0.w += bb.w; a1.x += bb.x; a1.y += bb.y; a1.z += bb.z; a1.w += bb.w;
        a2.x += bb.x; a2.y += bb.y; a2.z += bb.z; a2.w += bb.w; a3.x += bb.x; a3.y += bb.y; a3.z += bb.z; a3.w += bb.w;
        a4.x += bb.x; a4.y += bb.y; a4.z += bb.z; a4.w += bb.w;
    }
    float* o = mod + (size_t)(li * 5) * 6144 + n;
    atomicAdd(o + 0, a0.x); atomicAdd(o + 1, a0.y); atomicAdd(o + 2, a0.z); atomicAdd(o + 3, a0.w);
    atomicAdd(o + 6144 + 0, a1.x); atomicAdd(o + 6144 + 1, a1.y); atomicAdd(o + 6144 + 2, a1.z); atomicAdd(o + 6144 + 3, a1.w);
    atomicAdd(o + 2 * 6144 + 0, a2.x); atomicAdd(o + 2 * 6144 + 1, a2.y); atomicAdd(o + 2 * 6144 + 2, a2.z); atomicAdd(o + 2 * 6144 + 3, a2.w);
    atomicAdd(o + 3 * 6144 + 0, a3.x); atomicAdd(o + 3 * 6144 + 1, a3.y); atomicAdd(o + 3 * 6144 + 2, a3.z); atomicAdd(o + 3 * 6144 + 3, a3.w);
    atomicAdd(o + 4 * 6144 + 0, a4.x); atomicAdd(o + 4 * 6144 + 1, a4.y); atomicAdd(o + 4 * 6144 + 2, a4.z); atomicAdd(o + 4 * 6144 + 3, a4.w);
}

__device__ __forceinline__ void d_norm_mod(const int bx, const int by, const int bz, char* smem, const float* __restrict__ xa, const float* __restrict__ xb, const float* __restrict__ g,
                                                  const float* __restrict__ modl, int shift_idx, int scale_idx, bf16_t* __restrict__ h) {
    float* red = (float*)smem;
    const int t = bx;
    const float* x = (t < TP) ? (xa + (size_t)t * DM) : (xb + (size_t)(t - TP) * DM);
    const int c = threadIdx.x * 4;
    float4 v = *(const float4*)(x + c);
    float ss = v.x * v.x + v.y * v.y + v.z * v.z + v.w * v.w;
    ss = wave_sum(ss);
    if ((threadIdx.x & 63) == 0) red[threadIdx.x >> 6] = ss;
    __syncthreads();
    float tot = red[0] + red[1] + red[2] + red[3];
    float rstd = rsqrtf(tot * (1.f / DM) + 1e-6f);
    const float* m = modl + (size_t)tok_modrow(t) * 6144;
    float4 gg = *(const float4*)(g + c);
    float4 sh = *(const float4*)(m + shift_idx * 1024 + c);
    float4 sc = *(const float4*)(m + scale_idx * 1024 + c);
    float4 o;
    o.x = v.x * rstd * gg.x * (1.f + sc.x) + sh.x;
    o.y = v.y * rstd * gg.y * (1.f + sc.y) + sh.y;
    o.z = v.z * rstd * gg.z * (1.f + sc.z) + sh.z;
    o.w = v.w * rstd * gg.w * (1.f + sc.w) + sh.w;
    ushort4 ob; ob.x = f2bf(o.x); ob.y = f2bf(o.y); ob.z = f2bf(o.z); ob.w = f2bf(o.w);
    *(ushort4*)(h + (size_t)t * DM + c) = ob;
}

struct EpiStore { static constexpr bool kQuad = false; float* C; const float* bias; int ldc; int pad;
    __device__ void operator()(int m, int n, float a) const { C[(size_t)m * ldc + n] = a + (bias ? bias[n] : 0.f); } };
struct EpiStoreBfBias { static constexpr bool kQuad = false; bf16_t* C; const float* bias; int ldc; int pad;
    __device__ void operator()(int m, int n, float a) const { C[(size_t)m * ldc + n] = f2bf(a + bias[n]); } };
struct EpiStoreBf { static constexpr bool kQuad = false; bf16_t* C; int ldc; int pad;
    __device__ void operator()(int m, int n, float a) const { C[(size_t)m * ldc + n] = f2bf(a); } };
struct EpiDecay { static constexpr bool kQuad = false; _Float16* out; const float* w0;
    __device__ void operator()(int m, int n, float a) const { out[(size_t)m * 512 + n] = (_Float16)sigmoidf_(w0[n] + a); } };
struct EpiProj { static constexpr bool kQuad = false; bf16_t* rw; float* mla;
    __device__ void operator()(int m, int n, float a) const { if (n < RWIN) rw[(size_t)m * RWIN + n] = f2bf(a); else mla[(size_t)m * 448 + (n - RWIN)] = a; } };
struct EpiLr { static constexpr bool kQuad = false; bf16_t* out; const float* a0;
    __device__ void operator()(int m, int n, float a) const { out[(size_t)m * 512 + n] = f2bf(sigmoidf_(a0[n] + a)); } };
struct EpiResid { static constexpr bool kQuad = false; const float* xa; const float* xb; float* out; const float* modl; int gate_idx; int pad;
    __device__ void operator()(int m, int n, float a) const {
        float x = (m < TP) ? xa[(size_t)m * DM + n] : xb[(size_t)(m - TP) * DM + n];
        float gt = modl[(size_t)tok_modrow(m) * 6144 + gate_idx * 1024 + n];
        out[(size_t)m * DM + n] = x + gt * a; } };

struct EpiKV { static constexpr bool kQuad = true;
    bf16_t* kvraw; bf16_t* Vp; bf16_t* Vs; int ctx; int pad;
    __device__ void operator()(int m, int n, float a) const {}
    __device__ void quad(int row0, int col, float v0, float v1, float v2, float v3) const {
        const int hd = col >> 8, within = col & 255;
        if (within < 128) {
            bf16_t* d = kvraw + (size_t)row0 * 1024 + col;
            d[0] = f2bf(v0); d[1024] = f2bf(v1); d[2048] = f2bf(v2); d[3072] = f2bf(v3);
        } else {
            const int dv = within - 128;
            int b, kidx, Lk; bf16_t* base;
            if (ctx) { b = row0 >> 8; kidx = row0 & 255; Lk = 2304; base = Vs; }
            else if (row0 < TP) { b = row0 >> 8; kidx = row0 & 255; Lk = LP; base = Vp; }
            else { b = (row0 - TP) >> 11; kidx = 256 + ((row0 - TP) & 2047); Lk = 2304; base = Vs; }
            const int kpos = (kidx & ~12) | ((kidx & 8) >> 1) | ((kidx & 4) << 1);
            ushort4 o; o.x = f2bf(v0); o.y = f2bf(v1); o.z = f2bf(v2); o.w = f2bf(v3);
            *(ushort4*)(base + ((size_t)((b * 4 + hd) * 128 + dv)) * Lk + kpos) = o;
        }
    } };

template <class Epi>
__device__ __forceinline__ void d_gemm(const int bx, const int by, const int bz, char* smem, const float* __restrict__ A, int lda, const float* __restrict__ B, int ldb, int K, Epi epi) {
    float (*As)[68] = (float(*)[68])smem;
    float (*Bs)[68] = (float(*)[68])(smem + 16 * 68 * 4);
    const int m0 = by * 64, n0 = bx * 64;
    const int tid = threadIdx.x, tx = tid & 15, ty = tid >> 4;
    float acc[4][4];
#pragma unroll
    for (int i = 0; i < 4; i++)
#pragma unroll
        for (int j = 0; j < 4; j++) acc[i][j] = 0.f;
    for (int k0 = 0; k0 < K; k0 += 16) {
        {
            int r = tid >> 2, kq = (tid & 3) * 4;
            float4 v = *(const float4*)(A + (size_t)(m0 + r) * lda + k0 + kq);
            As[kq + 0][r] = v.x; As[kq + 1][r] = v.y; As[kq + 2][r] = v.z; As[kq + 3][r] = v.w;
        }
        {
            int kk = tid >> 4, nq = (tid & 15) * 4;
            float4 v = *(const float4*)(B + (size_t)(k0 + kk) * ldb + n0 + nq);
            *(float4*)&Bs[kk][nq] = v;
        }
        __syncthreads();
#pragma unroll
        for (int k = 0; k < 16; k++) {
            float a[4], b[4];
#pragma unroll
            for (int i = 0; i < 4; i++) a[i] = As[k][ty * 4 + i];
            float4 bv = *(const float4*)&Bs[k][tx * 4];
            b[0] = bv.x; b[1] = bv.y; b[2] = bv.z; b[3] = bv.w;
#pragma unroll
            for (int i = 0; i < 4; i++)
#pragma unroll
                for (int j = 0; j < 4; j++) acc[i][j] += a[i] * b[j];
        }
        __syncthreads();
    }
#pragma unroll
    for (int i = 0; i < 4; i++)
#pragma unroll
        for (int j = 0; j < 4; j++) epi(m0 + ty * 4 + i, n0 + tx * 4 + j, acc[i][j]);
}


typedef __attribute__((ext_vector_type(8))) short bf16x8;
typedef __attribute__((ext_vector_type(16))) float f32x16;
typedef __attribute__((ext_vector_type(4))) float f32x4;
typedef __attribute__((ext_vector_type(4))) unsigned u32x4;
#define GEMM_LDS_BYTES 73728

template <class Epi>
__device__ __forceinline__ void d_gemm_bf16(const int bx, const int by, char* smem, const bf16_t* __restrict__ A, int lda,
                                            const bf16_t* __restrict__ Bt, int ldb, int K, int N, Epi epi) {
    const int tid = threadIdx.x, lane = tid & 63, wid = tid >> 6;
    const int wm = wid >> 1, wn = wid & 1;
    const int m0 = by * 128, n0 = bx * 128;
    f32x16 acc[2][2];
#pragma unroll
    for (int i = 0; i < 2; i++)
#pragma unroll
        for (int j = 0; j < 2; j++)
#pragma unroll
            for (int r = 0; r < 16; r++) acc[i][j][r] = 0.f;
    const int lrow = tid >> 3, lcol = (tid & 7) * 8;
    const bf16_t* ga = A + (size_t)(m0 + lrow) * lda + lcol;
    const bf16_t* gb = Bt + (size_t)(n0 + lrow) * ldb + lcol;
    u32x4 ra[4], rb[4];
    const int KT = K >> 6;
#pragma unroll
    for (int i = 0; i < 4; i++) { ra[i] = *(const u32x4*)(ga + (size_t)(32 * i) * lda); rb[i] = *(const u32x4*)(gb + (size_t)(32 * i) * ldb); }
    {
        char* sa = smem;
#pragma unroll
        for (int i = 0; i < 4; i++) { *(u32x4*)(sa + (lrow + 32 * i) * 144 + lcol * 2) = ra[i]; *(u32x4*)(sa + 18432 + (lrow + 32 * i) * 144 + lcol * 2) = rb[i]; }
    }
    __syncthreads();
    const int frow = lane & 31, fk = (lane >> 5) * 16;
    for (int kt = 0; kt < KT; kt++) {
        if (kt + 1 < KT) {
#pragma unroll
            for (int i = 0; i < 4; i++) { ra[i] = *(const u32x4*)(ga + (size_t)(32 * i) * lda + (kt + 1) * 64); rb[i] = *(const u32x4*)(gb + (size_t)(32 * i) * ldb + (kt + 1) * 64); }
        }
        const char* sa = smem + (kt & 1) * 36864;
        const char* sb = sa + 18432;
#pragma unroll
        for (int ks = 0; ks < 4; ks++) {
            bf16x8 af[2], bfr[2];
#pragma unroll
            for (int i = 0; i < 2; i++) af[i] = *(const bf16x8*)(sa + (wm * 64 + i * 32 + frow) * 144 + ks * 32 + fk);
#pragma unroll
            for (int j = 0; j < 2; j++) bfr[j] = *(const bf16x8*)(sb + (wn * 64 + j * 32 + frow) * 144 + ks * 32 + fk);
#pragma unroll
            for (int i = 0; i < 2; i++)
#pragma unroll
                for (int j = 0; j < 2; j++) acc[i][j] = __builtin_amdgcn_mfma_f32_32x32x16_bf16(af[i], bfr[j], acc[i][j], 0, 0, 0);
        }
        if (kt + 1 < KT) {
            char* sn = smem + ((kt + 1) & 1) * 36864;
#pragma unroll
            for (int i = 0; i < 4; i++) { *(u32x4*)(sn + (lrow + 32 * i) * 144 + lcol * 2) = ra[i]; *(u32x4*)(sn + 18432 + (lrow + 32 * i) * 144 + lcol * 2) = rb[i]; }
        }
        __syncthreads();
    }
#pragma unroll
    for (int i = 0; i < 2; i++)
#pragma unroll
        for (int j = 0; j < 2; j++) {
            const int col = n0 + wn * 64 + j * 32 + (lane & 31);
            if (col < N) {
                if constexpr (Epi::kQuad) {
#pragma unroll
                    for (int g = 0; g < 4; g++) {
                        const int row0 = m0 + wm * 64 + i * 32 + 8 * g + 4 * (lane >> 5);
                        epi.quad(row0, col, acc[i][j][4 * g], acc[i][j][4 * g + 1], acc[i][j][4 * g + 2], acc[i][j][4 * g + 3]);
                    }
                } else {
#pragma unroll
                    for (int r = 0; r < 16; r++) {
                        const int row = m0 + wm * 64 + i * 32 + (r & 3) + 8 * (r >> 2) + 4 * (lane >> 5);
                        epi(row, col, acc[i][j][r]);
                    }
                }
            }
        }
}

__device__ __forceinline__ void d_transpose_w(const int vb, char* smem, const float* __restrict__ W, int K, int N, bf16_t* __restrict__ Wt) {
    float (*tile)[65] = (float(*)[65])smem;
    const int kt = K >> 6;
    const int nb = vb / kt, kb = vb % kt;
    const int tid = threadIdx.x;
    {
        const int n = nb * 64 + (tid & 63);
#pragma unroll
        for (int i = 0; i < 16; i++) {
            int k = (tid >> 6) + 4 * i;
            tile[k][tid & 63] = (n < N) ? W[(size_t)(kb * 64 + k) * N + n] : 0.f;
        }
    }
    __syncthreads();
    {
        const int k = tid & 63;
#pragma unroll
        for (int i = 0; i < 16; i++) {
            int n = (tid >> 6) + 4 * i;
            Wt[(size_t)(nb * 64 + n) * K + kb * 64 + k] = f2bf(tile[k][n]);
        }
    }
}

__device__ __forceinline__ void d_rw_shift(const int bx, const int by, const int bz, char* smem, const bf16_t* __restrict__ proj, const float* __restrict__ mu, bf16_t* __restrict__ rb,
                                                  bf16_t* __restrict__ kb, bf16_t* __restrict__ vb, bf16_t* __restrict__ tw, bf16_t* __restrict__ adv,
                                                  bf16_t* __restrict__ sg) {
    const int t = bx;
    const int pos = tok_pos(t), L = tok_len(t);
    const bf16_t* P = proj + (size_t)t * RWIN;
    for (int c = threadIdx.x; c < RWIN; c += 256) {
        float cur = bf2f(P[c]);
        float prev = (pos > 0) ? bf2f(P[c - RWIN]) : 0.f;
        float nxt = (pos < L - 1) ? bf2f(P[c + RWIN]) : 0.f;
        float val = cur + mu[c] * (0.5f * (prev + nxt) - cur);
        if (c < 512) rb[(size_t)t * 512 + c] = f2bf(val);
        else if (c < 1024) kb[(size_t)t * 512 + c - 512] = f2bf(val);
        else if (c < 1536) vb[(size_t)t * 512 + c - 1024] = f2bf(val);
        else if (c < 1600) tw[(size_t)t * 64 + c - 1536] = f2bf(tanhf(val));
        else if (c < 1664) adv[(size_t)t * 64 + c - 1600] = f2bf(val);
        else sg[(size_t)t * 128 + c - 1664] = f2bf(sigmoidf_(val));
    }
}

__device__ __forceinline__ void d_rw_kk(const int bx, const int by, const int bz, char* smem, const bf16_t* __restrict__ rb, const bf16_t* __restrict__ kb, const bf16_t* __restrict__ lr0,
                                               const bf16_t* __restrict__ lr1, const float* __restrict__ k_k, const float* __restrict__ k_a,
                                               const float* __restrict__ r_k, bf16_t* __restrict__ kkb, float* __restrict__ bonus) {
    const int w = bx * 4 + (threadIdx.x >> 6);
    const int lane = threadIdx.x & 63;
    const int t = w >> 3, h = w & 7;
    const size_t o = (size_t)t * 512 + h * 64 + lane;
    const int ch = h * 64 + lane;
    float k = bf2f(kb[o]), r = bf2f(rb[o]);
    float kk = k * k_k[ch];
    float nrm = sqrtf(wave_sum(kk * kk));
    kk = kk / fmaxf(nrm, 1e-12f);
    kkb[o] = f2bf(kk);
    float l0 = bf2f(lr0[o]), l1 = bf2f(lr1[o]);
    float ka = k_a[ch];
    float kd0 = k * (1.f + (l0 - 1.f) * ka), kd1 = k * (1.f + (l1 - 1.f) * ka);
    float s = wave_sum(r * (kd0 + kd1) * r_k[ch]);
    if (lane == 0) bonus[w] = s;
}

__device__ __forceinline__ void d_scan(const int bx, const int by, const int bz, char* smem, const bf16_t* __restrict__ rb, const bf16_t* __restrict__ kb, const bf16_t* __restrict__ vb,
                                             const bf16_t* __restrict__ kkb, const bf16_t* __restrict__ lr0, const bf16_t* __restrict__ lr1,
                                             const _Float16* __restrict__ dec0, const _Float16* __restrict__ dec1, const float* __restrict__ k_a,
                                             const float* __restrict__ st_f, const float* __restrict__ st_b, float* __restrict__ y0,
                                             float* __restrict__ y1, float* __restrict__ out_sf, float* __restrict__ out_sb) {
    float* sbase = (float*)smem + (threadIdx.x >> 6) * 320;
    float* sa_ = sbase; float* sw_ = sbase + 64; float* sb_ = sbase + 128; float* skd_ = sbase + 192; float* sr_ = sbase + 256;
    int id = bx * 4 + (threadIdx.x >> 6);
    int d, h, b, L, tbase;
    bool prompt = id < 256;
    if (prompt) { d = id & 1; h = (id >> 1) & 7; b = id >> 4; L = LP; tbase = b * LP; }
    else { int j = id - 256; d = j & 1; h = (j >> 1) & 7; b = j >> 4; L = LS; tbase = TP + b * LS; }
    const int v = threadIdx.x & 63;
    const bf16_t* lr = d ? lr1 : lr0;
    const _Float16* dec = d ? dec1 : dec0;
    float* yo = d ? y1 : y0;
    const float ka = k_a[h * 64 + v];
    float S[64];
    if (prompt) {
#pragma unroll
        for (int k = 0; k < 64; k++) S[k] = 0.f;
    } else {
        const float* st = (d ? st_b : st_f) + ((size_t)(b * 8 + h) * 64 + v) * 64;
#pragma unroll
        for (int k = 0; k < 64; k += 4) { float4 q = *(const float4*)(st + k); S[k] = q.x; S[k + 1] = q.y; S[k + 2] = q.z; S[k + 3] = q.w; }
    }
    for (int i = 0; i < L; i++) {
        const int t = tbase + (d ? (L - 1 - i) : i);
        const size_t o = (size_t)t * 512 + h * 64 + v;
        float kkv = bf2f(kkb[o]), lrv = bf2f(lr[o]), kv = bf2f(kb[o]), rv = bf2f(rb[o]), vv = bf2f(vb[o]), wv = __expf(-0.6065306597126334f * (float)dec[o]);
        __builtin_amdgcn_wave_barrier();
        sa_[v] = -kkv; sb_[v] = kkv * lrv; skd_[v] = kv * (1.f + (lrv - 1.f) * ka); sw_[v] = wv; sr_[v] = rv;
        __builtin_amdgcn_wave_barrier();
        float sa = 0.f;
#pragma unroll
        for (int k = 0; k < 64; k += 4) { float4 a = *(const float4*)&sa_[k]; sa += S[k] * a.x + S[k + 1] * a.y + S[k + 2] * a.z + S[k + 3] * a.w; }
        float y = 0.f;
#pragma unroll
        for (int k = 0; k < 64; k += 4) {
            float4 w4 = *(const float4*)&sw_[k]; float4 b4 = *(const float4*)&sb_[k]; float4 k4 = *(const float4*)&skd_[k]; float4 r4 = *(const float4*)&sr_[k];
            S[k] = S[k] * w4.x + sa * b4.x + vv * k4.x; y += S[k] * r4.x;
            S[k + 1] = S[k + 1] * w4.y + sa * b4.y + vv * k4.y; y += S[k + 1] * r4.y;
            S[k + 2] = S[k + 2] * w4.z + sa * b4.z + vv * k4.z; y += S[k + 2] * r4.z;
            S[k + 3] = S[k + 3] * w4.w + sa * b4.w + vv * k4.w; y += S[k + 3] * r4.w;
        }
        yo[o] = y;
    }
    if (prompt) {
        float* os = (d ? out_sb : out_sf) + ((size_t)(b * 8 + h) * 64 + v) * 64;
#pragma unroll
        for (int k = 0; k < 64; k += 4) *(float4*)(os + k) = make_float4(S[k], S[k + 1], S[k + 2], S[k + 3]);
    }
}


#define SC_STEP 336
template <int CTRL>
__device__ __forceinline__ float dpp_add(float v) {
    return v + __int_as_float(__builtin_amdgcn_update_dpp(0, __float_as_int(v), CTRL, 0xf, 0xf, false));
}
__device__ __forceinline__ float row16_allsum(float v) {
    v = dpp_add<0x128>(v); v = dpp_add<0x124>(v); v = dpp_add<0x122>(v); v = dpp_add<0x121>(v);
    return v;
}
__device__ __forceinline__ void d_scan2(const int item, const bool sample, char* smem, const bf16_t* __restrict__ rb, const bf16_t* __restrict__ kb,
                                        const bf16_t* __restrict__ vb, const bf16_t* __restrict__ kkb, const bf16_t* __restrict__ lr0,
                                        const bf16_t* __restrict__ lr1, const _Float16* __restrict__ du0, const _Float16* __restrict__ du1,
                                        const float* __restrict__ k_a, const float* __restrict__ st_f, const float* __restrict__ st_b,
                                        float* __restrict__ y0, float* __restrict__ y1, float* __restrict__ out_sf, float* __restrict__ out_sb) {
    const int chain = item >> 2, qd = item & 3;
    const int d = chain & 1, h = (chain >> 1) & 7, b = chain >> 4;
    const int L = sample ? LS : LP;
    const int tbase = sample ? (TP + b * LS) : (b * LP);
    const int tid = threadIdx.x, wid = tid >> 6, lane = tid & 63;
    const int rr = lane >> 4, pp = lane & 15;
    const int row = qd * 16 + wid * 4 + rr;
    const bf16_t* lr = d ? lr1 : lr0;
    const _Float16* du = d ? du1 : du0;
    float* yo = d ? y1 : y0;
    float S0, S1, S2, S3;
    if (sample) {
        const float4 s4 = *(const float4*)((d ? st_b : st_f) + ((size_t)(b * 8 + h) * 64 + row) * 64 + pp * 4);
        S0 = s4.x; S1 = s4.y; S2 = s4.z; S3 = s4.w;
    } else { S0 = S1 = S2 = S3 = 0.f; }
    const int sk = tid & 63, ss = tid >> 6;
    const float ka = k_a[h * 64 + sk];
    const size_t colk = (size_t)h * 64 + sk;
    const size_t colv = (size_t)h * 64 + qd * 16 + (tid & 15);
    float* buf = (float*)smem;
    unsigned gA_kk[4], gA_lr[4], gA_k[4], gA_r[4], gA_u[4], gA_v;
    unsigned gB_kk[4], gB_lr[4], gB_k[4], gB_r[4], gB_u[4], gB_v;
    const int nch = L >> 4;
#define SC_GLOAD(X, c)                                                                                     \
    {                                                                                                      \
        _Pragma("unroll") for (int j = 0; j < 4; j++) {                                                    \
            const int i = (c) * 16 + ss + 4 * j;                                                           \
            const size_t o = (size_t)(tbase + (d ? (L - 1 - i) : i)) * 512 + colk;                         \
            X##_kk[j] = kkb[o]; X##_lr[j] = lr[o]; X##_k[j] = kb[o]; X##_r[j] = rb[o]; X##_u[j] = ((const unsigned short*)du)[o]; \
        }                                                                                                  \
        { const int i = (c) * 16 + (tid >> 4); X##_v = vb[(size_t)(tbase + (d ? (L - 1 - i) : i)) * 512 + colv]; } \
    }
#define SC_SSTORE(X, bi)                                                                                   \
    {                                                                                                      \
        float* B_ = buf + (bi) * 16 * SC_STEP;                                                             \
        _Pragma("unroll") for (int j = 0; j < 4; j++) {                                                    \
            float* st_ = B_ + (ss + 4 * j) * SC_STEP + sk;                                                 \
            const float kkv = __uint_as_float(X##_kk[j] << 16), lrv = __uint_as_float(X##_lr[j] << 16), kv = __uint_as_float(X##_k[j] << 16); \
            st_[0] = -kkv; st_[64] = __expf(-0.6065306597126334f * (float)__builtin_bit_cast(_Float16, (unsigned short)X##_u[j])); st_[128] = kkv * lrv;   \
            st_[192] = kv * (1.f + (lrv - 1.f) * ka); st_[256] = __uint_as_float(X##_r[j] << 16);          \
        }                                                                                                  \
        B_[(tid >> 4) * SC_STEP + 320 + (tid & 15)] = __uint_as_float(X##_v << 16);                        \
    }
#define SC_COMPUTE(c)                                                                                      \
    {                                                                                                      \
        const float* B_ = buf + ((c) & 1) * 16 * SC_STEP;                                                  \
        float ysave = 0.f;                                                                                 \
        _Pragma("unroll 4") for (int s_ = 0; s_ < 16; s_++) {                                              \
            const float* st_ = B_ + s_ * SC_STEP;                                                          \
            const float4 a4 = *(const float4*)(st_ + pp * 4);                                              \
            const float4 w4 = *(const float4*)(st_ + 64 + pp * 4);                                         \
            const float4 b4 = *(const float4*)(st_ + 128 + pp * 4);                                        \
            const float4 k4 = *(const float4*)(st_ + 192 + pp * 4);                                        \
            const float4 r4 = *(const float4*)(st_ + 256 + pp * 4);                                        \
            const float vv = st_[320 + wid * 4 + rr];                                                      \
            float sa = (S0 * a4.x + S1 * a4.y) + (S2 * a4.z + S3 * a4.w);                                  \
            const float p0 = S0 * w4.x + vv * k4.x, p1 = S1 * w4.y + vv * k4.y, p2 = S2 * w4.z + vv * k4.z, p3 = S3 * w4.w + vv * k4.w; \
            sa = row16_allsum(sa);                                                                         \
            S0 = sa * b4.x + p0; S1 = sa * b4.y + p1; S2 = sa * b4.z + p2; S3 = sa * b4.w + p3;            \
            float y = (S0 * r4.x + S1 * r4.y) + (S2 * r4.z + S3 * r4.w);                                   \
            y = row16_allsum(y);                                                                           \
            ysave = (pp == s_) ? y : ysave;                                                                \
        }                                                                                                  \
        { const int i = (c) * 16 + pp; yo[(size_t)(tbase + (d ? (L - 1 - i) : i)) * 512 + h * 64 + row] = ysave; } \
    }
    SC_GLOAD(gA, 0)
    SC_SSTORE(gA, 0)
    if (nch > 1) SC_GLOAD(gA, 1)
    __syncthreads();
    for (int c = 0; c < nch; c += 2) {
        if (c + 2 < nch) SC_GLOAD(gB, c + 2)
        __builtin_amdgcn_sched_barrier(0);
        SC_COMPUTE(c)
        __builtin_amdgcn_sched_barrier(0);
        SC_SSTORE(gA, 1)
        __syncthreads();
        if (c + 3 < nch) SC_GLOAD(gA, c + 3)
        __builtin_amdgcn_sched_barrier(0);
        SC_COMPUTE(c + 1)
        __builtin_amdgcn_sched_barrier(0);
        if (c + 2 < nch) SC_SSTORE(gB, 0)
        __syncthreads();
    }
    if (!sample) {
        float* os = (d ? out_sb : out_sf) + ((size_t)(b * 8 + h) * 64 + row) * 64 + pp * 4;
        *(float4*)os = make_float4(S0, S1, S2, S3);
    }
}

__device__ __forceinline__ void d_rw_post(const int bx, const int by, const int bz, char* smem, const float* __restrict__ y0, const float* __restrict__ y1, const float* __restrict__ bonus,
                                                 const bf16_t* __restrict__ vb, const bf16_t* __restrict__ gate, const float* __restrict__ lnx_g,
                                                 const float* __restrict__ lnx_b, bf16_t* __restrict__ cat) {
    const int w = bx * 4 + (threadIdx.x >> 6);
    const int lane = threadIdx.x & 63;
    const int t = w >> 3, h = w & 7;
    const size_t o = (size_t)t * 512 + h * 64 + lane;
    const int ch = h * 64 + lane;
    float y = y0[o] + y1[o];
    float mean = wave_sum(y) * (1.f / 64.f);
    float dlt = y - mean;
    float var = wave_sum(dlt * dlt) * (1.f / 64.f);
    float yn = dlt * rsqrtf(var + 64e-5f) * lnx_g[ch] + lnx_b[ch];
    float val = (yn + bonus[w] * bf2f(vb[o])) * bf2f(gate[o]);
    cat[(size_t)t * DM + ch] = f2bf(val);
}

__device__ __forceinline__ void d_mla_pre(const int bx, const int by, const int bz, char* smem, const float* __restrict__ proj, const float* __restrict__ q_norm, const float* __restrict__ kv_norm,
                                                 bf16_t* __restrict__ qcn, bf16_t* __restrict__ ckv, float* __restrict__ kpe,
                                                 float* __restrict__ out_ckv, float* __restrict__ out_kpe) {
    float* red = (float*)smem; float* red2 = red + 4;
    const int t = bx;
    const int tid = threadIdx.x;
    const float* P = proj + (size_t)t * 448;
    float q = P[tid];
    float kv = (tid < 128) ? P[256 + tid] : 0.f;
    float ss = wave_sum(q * q);
    float s2 = wave_sum(kv * kv);
    if ((tid & 63) == 0) { red[tid >> 6] = ss; red2[tid >> 6] = s2; }
    __syncthreads();
    float rq = rsqrtf((red[0] + red[1] + red[2] + red[3]) * (1.f / 256.f) + 1e-6f);
    float rk = rsqrtf((red2[0] + red2[1] + red2[2] + red2[3]) * (1.f / 128.f) + 1e-6f);
    qcn[(size_t)t * 256 + tid] = f2bf(q * rq * q_norm[tid]);
    if (tid < 128) {
        float val = kv * rk * kv_norm[tid];
        ckv[(size_t)t * 128 + tid] = f2bf(val);
        if (t < TP) out_ckv[(size_t)t * 128 + tid] = val;
    } else if (tid < 192) {
        float pe = P[384 + tid - 128];
        kpe[(size_t)t * 64 + tid - 128] = pe;
        if (t < TP) out_kpe[(size_t)t * 64 + tid - 128] = pe;
    }
}

__device__ __forceinline__ void d_mla_post(const int bx, const int by, const int bz, char* smem, const bf16_t* __restrict__ qraw, const bf16_t* __restrict__ kvraw, const bf16_t* __restrict__ kvraw_ctx,
                                                  const float* __restrict__ kpe, const float* __restrict__ cache_kpe, const float* __restrict__ qn,
                                                  const float* __restrict__ kn, bf16_t* __restrict__ Qb, bf16_t* __restrict__ Kp, bf16_t* __restrict__ Vp,
                                                  bf16_t* __restrict__ Ks, bf16_t* __restrict__ Vs) {
    float (*sq)[192] = (float(*)[192])smem; float (*sk)[192] = (float(*)[192])(smem + 4 * 192 * 4);
    const int wi = threadIdx.x >> 6, lane = threadIdx.x & 63;
    const int row = bx, h = wi;
    const bool isctx = row >= TT;
    const bool sample = row >= TP;
    float kx[3], qx[3] = {0.f, 0.f, 0.f};
    const bf16_t* kvr; const float* pe; int pos = 0;
    if (isctx) { int cr = row - TT; kvr = kvraw_ctx + (size_t)cr * 1024; pe = cache_kpe + (size_t)cr * 64; }
    else { kvr = kvraw + (size_t)row * 1024; pe = kpe + (size_t)row * 64; pos = tok_pos(row); }
#pragma unroll
    for (int j = 0; j < 3; j++) {
        int i = lane + 64 * j;
        kx[j] = (i < 128) ? bf2f(kvr[h * 256 + i]) : pe[i - 128];
        if (!isctx) qx[j] = bf2f(qraw[(size_t)row * 768 + h * 192 + i]);
    }
    float ssk = wave_sum(kx[0] * kx[0] + kx[1] * kx[1] + kx[2] * kx[2]);
    float ssq = wave_sum(qx[0] * qx[0] + qx[1] * qx[1] + qx[2] * qx[2]);
    float rk = rsqrtf(ssk * (1.f / 192.f) + 1e-6f), rq = rsqrtf(ssq * (1.f / 192.f) + 1e-6f);
#pragma unroll
    for (int j = 0; j < 3; j++) {
        int i = lane + 64 * j;
        sk[wi][i] = kx[j] * rk * kn[i];
        sq[wi][i] = qx[j] * rq * qn[i];
    }
    __syncthreads();
    if (sample && !isctx && lane < 32) {
        int rowi = pos >> 6, coli = pos & 63;
        int fi = lane & 15;
        float inv = expf(-(float)fi * (1.f / 16.f) * 9.210340371976184f);
        float ang = (lane < 16 ? (float)rowi : (float)coli) * inv;
        float cs = cosf(ang), sn = sinf(ang);
        float a = sk[wi][128 + 2 * lane], bq = sk[wi][128 + 2 * lane + 1];
        sk[wi][128 + 2 * lane] = a * cs - bq * sn; sk[wi][128 + 2 * lane + 1] = a * sn + bq * cs;
        a = sq[wi][128 + 2 * lane]; bq = sq[wi][128 + 2 * lane + 1];
        sq[wi][128 + 2 * lane] = a * cs - bq * sn; sq[wi][128 + 2 * lane + 1] = a * sn + bq * cs;
    }
    __syncthreads();
    bf16_t* kd; bf16_t* vd; int vLk, kidx;
    if (!sample) { int b = row >> 8, p = row & 255; kd = Kp + ((size_t)(b * 4 + h) * LP + p) * 192; vd = Vp + (size_t)(b * 4 + h) * 128 * LP; vLk = LP; kidx = p; }
    else if (!isctx) { int b = (row - TP) >> 11, p = (row - TP) & 2047; kd = Ks + ((size_t)(b * 4 + h) * 2304 + 256 + p) * 192; vd = Vs + (size_t)(b * 4 + h) * 128 * 2304; vLk = 2304; kidx = 256 + p; }
    else { int cr = row - TT; int b = cr >> 8, p = cr & 255; kd = Ks + ((size_t)(b * 4 + h) * 2304 + p) * 192; vd = Vs + (size_t)(b * 4 + h) * 128 * 2304; vLk = 2304; kidx = p; }
    const int kpos = (kidx & ~12) | ((kidx & 8) >> 1) | ((kidx & 4) << 1);
#pragma unroll
    for (int j = 0; j < 3; j++) {
        int i = lane + 64 * j;
        kd[i] = f2bf(sk[wi][i]);
        if (!isctx) Qb[((size_t)row * 4 + h) * 192 + i] = f2bf(sq[wi][i]);
    }
    vd[(size_t)lane * vLk + kpos] = kvr[h * 256 + 128 + lane];
    vd[(size_t)(lane + 64) * vLk + kpos] = kvr[h * 256 + 128 + lane + 64];
}

__device__ __forceinline__ void d_attn(const int bx, const int by, const int bz, char* smem, const bf16_t* __restrict__ Qb, const bf16_t* __restrict__ Kall, const bf16_t* __restrict__ Vall,
                                              bf16_t* __restrict__ cat, int tbase, int Lq, int Lk) {
    float (*Vsm)[128] = (float(*)[128])smem;
    float (*Qs)[192] = (float(*)[192])(smem + 32 * 128 * 4);
    float (*Ksm)[193] = (float(*)[193])(smem + 32 * 128 * 4 + 16 * 192 * 4);
    float (*Ss)[33] = (float(*)[33])(smem + 32 * 128 * 4 + 16 * 192 * 4 + 32 * 193 * 4);
    const int q0 = bx * 16, h = by, b = bz;
    const int tid = threadIdx.x;
    const int qi = tid >> 4, sub = tid & 15;
    const bf16_t* K = Kall + (size_t)(b * 4 + h) * Lk * 192;
    const bf16_t* V = Vall + (size_t)(b * 4 + h) * Lk * 128;
    for (int i = tid; i < 16 * 192; i += 256) {
        int r = i / 192, c = i % 192;
        int t = tbase + b * Lq + q0 + r;
        Qs[r][c] = bf2f(Qb[((size_t)t * 4 + h) * 192 + c]);
    }
    float m = -1e30f, l = 0.f;
    float acc[8];
#pragma unroll
    for (int j = 0; j < 8; j++) acc[j] = 0.f;
    const float scale = 0.07216878364870322f;
    for (int k0 = 0; k0 < Lk; k0 += 32) {
        __syncthreads();
        for (int i = tid; i < 32 * 192; i += 256) { int r = i / 192, c = i % 192; Ksm[r][c] = bf2f(K[(size_t)(k0 + r) * 192 + c]); }
        for (int i = tid; i < 32 * 128; i += 256) { int r = i >> 7, c = i & 127; Vsm[r][c] = bf2f(V[(size_t)(k0 + r) * 128 + c]); }
        __syncthreads();
        float s0 = 0.f, s1 = 0.f;
        for (int dd = 0; dd < 192; dd++) { float qv = Qs[qi][dd]; s0 += qv * Ksm[sub][dd]; s1 += qv * Ksm[sub + 16][dd]; }
        s0 *= scale; s1 *= scale;
        float mx = fmaxf(s0, s1);
#pragma unroll
        for (int o = 8; o > 0; o >>= 1) mx = fmaxf(mx, __shfl_xor(mx, o, 64));
        float mn = fmaxf(m, mx);
        float alpha = expf(m - mn);
        float p0 = expf(s0 - mn), p1 = expf(s1 - mn);
        float ps = p0 + p1;
#pragma unroll
        for (int o = 8; o > 0; o >>= 1) ps += __shfl_xor(ps, o, 64);
        l = l * alpha + ps; m = mn;
        Ss[qi][sub] = p0; Ss[qi][sub + 16] = p1;
        __syncthreads();
#pragma unroll
        for (int j = 0; j < 8; j++) acc[j] *= alpha;
        for (int kk = 0; kk < 32; kk++) {
            float p = Ss[qi][kk];
            float4 v0 = *(const float4*)&Vsm[kk][sub * 8], v1 = *(const float4*)&Vsm[kk][sub * 8 + 4];
            acc[0] += p * v0.x; acc[1] += p * v0.y; acc[2] += p * v0.z; acc[3] += p * v0.w;
            acc[4] += p * v1.x; acc[5] += p * v1.y; acc[6] += p * v1.z; acc[7] += p * v1.w;
        }
    }
    const int t = tbase + b * Lq + q0 + qi;
    float il = 1.f / l;
    bf16_t* o = cat + (size_t)t * DM + 512 + h * 128 + sub * 8;
#pragma unroll
    for (int j = 0; j < 8; j++) o[j] = f2bf(acc[j] * il);
}


#define ATT_SV_OFF 25600
#define ATT_SQ_OFF 44032
__device__ __forceinline__ void d_attn_mfma(const int item, char* smem, const bf16_t* __restrict__ Qb, const bf16_t* __restrict__ Kall,
                                            const bf16_t* __restrict__ VtAll, bf16_t* __restrict__ cat, int tbase, int Lq, int Lk, int nqb) {
    const int qb = item % nqb, bh = item / nqb;
    const int b = bh >> 2, h = bh & 3;
    const int tid = threadIdx.x, lane = tid & 63, wid = tid >> 6;
    const int q = lane & 31, hh = lane >> 5;
    const int t = tbase + b * Lq + qb * 128 + wid * 32 + q;
    bf16x8 qf[12];
    {
        const bf16_t* qp = Qb + ((size_t)t * 4 + h) * 192 + hh * 8;
#pragma unroll
        for (int ks = 0; ks < 12; ks++) qf[ks] = *(const bf16x8*)(qp + ks * 16);
    }
    f32x16 o[4];
#pragma unroll
    for (int i = 0; i < 4; i++)
#pragma unroll
        for (int r = 0; r < 16; r++) o[i][r] = 0.f;
    float m = -1e30f, l = 0.f;
    const bf16_t* K = Kall + (size_t)bh * Lk * 192;
    const bf16_t* Vt = VtAll + (size_t)bh * 128 * Lk;
    char* sK = smem;
    char* sV = smem + ATT_SV_OFF;
    u32x4 pk[6], pv[4];
    const int nkt = Lk >> 6;
#pragma unroll
    for (int i = 0; i < 6; i++) pk[i] = *(const u32x4*)(K + (size_t)(tid + 256 * i) * 8);
#pragma unroll
    for (int i = 0; i < 4; i++) { int c = tid + 256 * i; pv[i] = *(const u32x4*)(Vt + (size_t)(c >> 3) * Lk + (c & 7) * 8); }
#pragma unroll
    for (int i = 0; i < 6; i++) { int c = tid + 256 * i; *(u32x4*)(sK + (c / 24) * 400 + (c % 24) * 16) = pk[i]; }
#pragma unroll
    for (int i = 0; i < 4; i++) { int c = tid + 256 * i; *(u32x4*)(sV + (c >> 3) * 144 + (c & 7) * 16) = pv[i]; }
    __syncthreads();
    const float sc2 = 0.07216878364870322f * 1.4426950408889634f;
    for (int kt = 0; kt < nkt; kt++) {
        f32x16 st[2];
#pragma unroll
        for (int bk = 0; bk < 2; bk++)
#pragma unroll
            for (int r = 0; r < 16; r++) st[bk][r] = 0.f;
#pragma unroll
        for (int ks = 0; ks < 12; ks++) {
            const bf16x8 qfk = qf[ks];
#pragma unroll
            for (int bk = 0; bk < 2; bk++) {
                bf16x8 a = *(const bf16x8*)(sK + (bk * 32 + q) * 400 + ks * 32 + hh * 16);
                st[bk] = __builtin_amdgcn_mfma_f32_32x32x16_bf16(a, qfk, st[bk], 0, 0, 0);
            }
        }
        float mx = -1e30f;
#pragma unroll
        for (int bk = 0; bk < 2; bk++)
#pragma unroll
            for (int r = 0; r < 16; r++) { st[bk][r] *= sc2; mx = fmaxf(mx, st[bk][r]); }
        mx = fmaxf(mx, __shfl_xor(mx, 32, 64));
        const float mn = fmaxf(m, mx);
        const float alpha = exp2f(m - mn);
        float ps = 0.f;
#pragma unroll
        for (int bk = 0; bk < 2; bk++)
#pragma unroll
            for (int r = 0; r < 16; r++) { st[bk][r] = exp2f(st[bk][r] - mn); ps += st[bk][r]; }
        ps += __shfl_xor(ps, 32, 64);
        l = l * alpha + ps; m = mn;
#pragma unroll
        for (int i = 0; i < 4; i++)
#pragma unroll
            for (int r = 0; r < 16; r++) o[i][r] *= alpha;
#pragma unroll
        for (int s4 = 0; s4 < 4; s4++) {
            bf16x8 pb;
#pragma unroll
            for (int j = 0; j < 8; j++) pb[j] = (short)f2bf(st[s4 >> 1][8 * (s4 & 1) + j]);
#pragma unroll
            for (int i = 0; i < 4; i++) {
                bf16x8 a = *(const bf16x8*)(sV + (i * 32 + q) * 144 + s4 * 32 + hh * 16);
                o[i] = __builtin_amdgcn_mfma_f32_32x32x16_bf16(a, pb, o[i], 0, 0, 0);
            }
        }
        __syncthreads();
        if (kt + 1 < nkt) {
            const bf16_t* Kn = K + (size_t)(kt + 1) * 64 * 192;
            const bf16_t* Vn = Vt + (kt + 1) * 64;
#pragma unroll
            for (int i = 0; i < 6; i++) pk[i] = *(const u32x4*)(Kn + (size_t)(tid + 256 * i) * 8);
#pragma unroll
            for (int i = 0; i < 4; i++) { int c = tid + 256 * i; pv[i] = *(const u32x4*)(Vn + (size_t)(c >> 3) * Lk + (c & 7) * 8); }
#pragma unroll
            for (int i = 0; i < 6; i++) { int c = tid + 256 * i; *(u32x4*)(sK + (c / 24) * 400 + (c % 24) * 16) = pk[i]; }
#pragma unroll
            for (int i = 0; i < 4; i++) { int c = tid + 256 * i; *(u32x4*)(sV + (c >> 3) * 144 + (c & 7) * 16) = pv[i]; }
        }
        __syncthreads();
    }
    const float il = 1.f / l;
    bf16_t* op = cat + (size_t)t * DM + 512 + h * 128;
#pragma unroll
    for (int i = 0; i < 4; i++)
#pragma unroll
        for (int g = 0; g < 4; g++) {
            ushort4 w;
            w.x = f2bf(o[i][4 * g + 0] * il); w.y = f2bf(o[i][4 * g + 1] * il); w.z = f2bf(o[i][4 * g + 2] * il); w.w = f2bf(o[i][4 * g + 3] * il);
            *(ushort4*)(op + i * 32 + 8 * g + 4 * hh) = w;
        }
}

__device__ __forceinline__ void d_peer_route(const int bx, const int by, const int bz, char* smem, const float* __restrict__ qp, const float* __restrict__ keys  ,
                                                    int* __restrict__ pidx, float* __restrict__ pg) {
    float (*sq)[256] = (float(*)[256])smem;
    float (*sc)[256] = (float(*)[256])(smem + 4096);
    float (*tv)[32] = (float(*)[32])(smem + 8192);
    int (*ti)[32] = (int(*)[32])(smem + 8192 + 512);
    float (*topv)[16] = (float(*)[16])(smem + 8192 + 1024);
    int (*topi)[16] = (int(*)[16])(smem + 8192 + 1024 + 256);
    const int wi = threadIdx.x >> 6, lane = threadIdx.x & 63;
    const int w = bx * 4 + wi;
    const int t = w >> 3, h = w & 7;
    const float* q = qp + (size_t)t * 2048 + h * 256;
#pragma unroll
    for (int j = 0; j < 4; j++) sq[wi][lane + 64 * j] = q[lane + 64 * j];
    __syncthreads();
#pragma unroll
    for (int p = 0; p < 2; p++)
#pragma unroll
        for (int half = 0; half < 2; half++) {
            int n = lane + 64 * half;
            const float* kr = keys + ((size_t)(h * 2 + p) * 128 + n) * 128;
            float s = 0.f;
            for (int dd = 0; dd < 128; dd += 4) {
                float4 kv = *(const float4*)(kr + dd);
                s += sq[wi][p * 128 + dd] * kv.x + sq[wi][p * 128 + dd + 1] * kv.y + sq[wi][p * 128 + dd + 2] * kv.z + sq[wi][p * 128 + dd + 3] * kv.w;
            }
            sc[wi][p * 128 + n] = s;
        }
    __syncthreads();
#pragma unroll
    for (int p = 0; p < 2; p++)
#pragma unroll
        for (int half = 0; half < 2; half++) {
            int n = lane + 64 * half;
            float s = sc[wi][p * 128 + n];
            int rank = 0;
            for (int j = 0; j < 128; j++) { float o = sc[wi][p * 128 + j]; rank += (o > s || (o == s && j < n)) ? 1 : 0; }
            if (rank < 16) { tv[wi][p * 16 + rank] = s; ti[wi][p * 16 + rank] = n; }
        }
    __syncthreads();
    float cv[4];
#pragma unroll
    for (int j = 0; j < 4; j++) { int c = lane + 64 * j; cv[j] = tv[wi][c >> 4] + tv[wi][16 + (c & 15)]; }
    __syncthreads();
#pragma unroll
    for (int j = 0; j < 4; j++) sc[wi][lane + 64 * j] = cv[j];
    __syncthreads();
#pragma unroll
    for (int j = 0; j < 4; j++) {
        int c = lane + 64 * j;
        float s = cv[j];
        int rank = 0;
        for (int i = 0; i < 256; i++) { float o = sc[wi][i]; rank += (o > s || (o == s && i < c)) ? 1 : 0; }
        if (rank < 16) { topv[wi][rank] = s; topi[wi][rank] = (ti[wi][c >> 4] * 128 + ti[wi][16 + (c & 15)]) & 16383; }
    }
    __syncthreads();
    if (lane < 16) {
        float mx = topv[wi][0];
        float sum = 0.f;
        for (int i = 0; i < 16; i++) sum += expf(topv[wi][i] - mx);
        pg[(size_t)w * 16 + lane] = expf(topv[wi][lane] - mx) / sum;
        pidx[(size_t)w * 16 + lane] = topi[wi][lane] & 16383;
    }
}

__device__ __forceinline__ void d_peer_apply(const int bx, const int by, const int bz, char* smem, const bf16_t* __restrict__ hbuf, const int* __restrict__ pidx, const float* __restrict__ pg,
                                                    const float* __restrict__ utab, const float* __restrict__ vtab, const float* __restrict__ modl,
                                                    float* __restrict__ xrun) {
    float* coef = (float*)smem; int* eid = (int*)(smem + 512);
    const int t = bx, tid = threadIdx.x, wi = tid >> 6, lane = tid & 63;
    if (tid < 128) eid[tid] = pidx[(size_t)t * 128 + tid];
    float4 xv[4];
#pragma unroll
    for (int j = 0; j < 4; j++) { ushort4 q = *(const ushort4*)(hbuf + (size_t)t * DM + j * 256 + lane * 4); xv[j] = make_float4(bf2f(q.x), bf2f(q.y), bf2f(q.z), bf2f(q.w)); }
    __syncthreads();
    for (int e = wi * 32; e < wi * 32 + 32; e++) {
        const float* ur = utab + (size_t)eid[e] * DM;
        float s = 0.f;
#pragma unroll
        for (int j = 0; j < 4; j++) { float4 u = *(const float4*)(ur + j * 256 + lane * 4); s += u.x * xv[j].x + u.y * xv[j].y + u.z * xv[j].z + u.w * xv[j].w; }
        s = wave_sum(s);
        if (lane == 0) coef[e] = pg[(size_t)t * 128 + e] * gelu_tanh(s);
    }
    __syncthreads();
    float4 acc = make_float4(0.f, 0.f, 0.f, 0.f);
    for (int e = 0; e < 128; e++) {
        float cf = coef[e];
        float4 v = *(const float4*)(vtab + (size_t)eid[e] * DM + tid * 4);
        acc.x += cf * v.x; acc.y += cf * v.y; acc.z += cf * v.z; acc.w += cf * v.w;
    }
    const float* m = modl + (size_t)tok_modrow(t) * 6144 + 5 * 1024 + tid * 4;
    float* xo = xrun + (size_t)t * DM + tid * 4;
    float4 x = *(float4*)xo;
    x.x += m[0] * acc.x; x.y += m[1] * acc.y; x.z += m[2] * acc.z; x.w += m[3] * acc.w;
    *(float4*)xo = x;
}


template <int K, int J>
__device__ __forceinline__ void bit_stage16(float (&x)[16]) {
#pragma unroll
    for (int i = 0; i < 16; i++) {
        const int l = i ^ J;
        if (l > i) {
            const bool desc = ((i & K) == 0);
            const float a = x[i], b = x[l];
            const float hi = fmaxf(a, b), lo = fminf(a, b);
            x[i] = desc ? hi : lo; x[l] = desc ? lo : hi;
        }
    }
}
__device__ __forceinline__ void bit_sort16_desc(float (&x)[16]) {
    bit_stage16<2, 1>(x);
    bit_stage16<4, 2>(x); bit_stage16<4, 1>(x);
    bit_stage16<8, 4>(x); bit_stage16<8, 2>(x); bit_stage16<8, 1>(x);
    bit_stage16<16, 8>(x); bit_stage16<16, 4>(x); bit_stage16<16, 2>(x); bit_stage16<16, 1>(x);
}
__device__ __forceinline__ void bit_merge16_desc(float (&x)[16]) {
    bit_stage16<16, 8>(x); bit_stage16<16, 4>(x); bit_stage16<16, 2>(x); bit_stage16<16, 1>(x);
}
template <int K, int J>
__device__ __forceinline__ void bit_stage16u(unsigned (&x)[16]) {
#pragma unroll
    for (int i = 0; i < 16; i++) {
        const int l = i ^ J;
        if (l > i) {
            const bool asc = ((i & K) == 0);
            const unsigned a = x[i], b = x[l];
            const unsigned lo = a < b ? a : b, hi = a < b ? b : a;
            x[i] = asc ? lo : hi; x[l] = asc ? hi : lo;
        }
    }
}
__device__ __forceinline__ void bit_sort16u_asc(unsigned (&x)[16]) {
    bit_stage16u<2, 1>(x);
    bit_stage16u<4, 2>(x); bit_stage16u<4, 1>(x);
    bit_stage16u<8, 4>(x); bit_stage16u<8, 2>(x); bit_stage16u<8, 1>(x);
    bit_stage16u<16, 8>(x); bit_stage16u<16, 4>(x); bit_stage16u<16, 2>(x); bit_stage16u<16, 1>(x);
}
__device__ __forceinline__ void bit_merge16u_asc(unsigned (&x)[16]) {
    bit_stage16u<16, 8>(x); bit_stage16u<16, 4>(x); bit_stage16u<16, 2>(x); bit_stage16u<16, 1>(x);
}
__device__ __forceinline__ void top16_merge(float (&L)[16], const float (&C)[16]) {
#pragma unroll
    for (int i = 0; i < 16; i++) L[i] = fmaxf(L[i], C[15 - i]);
    bit_merge16_desc(L);
}
__device__ __forceinline__ void low16_merge_u(unsigned (&L)[16], const unsigned (&C)[16]) {
#pragma unroll
    for (int i = 0; i < 16; i++) { const unsigned c = C[15 - i]; L[i] = L[i] < c ? L[i] : c; }
    bit_merge16u_asc(L);
}
__device__ __forceinline__ float key_val(float k) { return __uint_as_float(__float_as_uint(k) & ~127u); }
__device__ __forceinline__ int key_idx(float k) { return (int)(__float_as_uint(k) & 127u); }

struct EpiLds { static constexpr bool kQuad = false; float* lds; int c0; int pad;
    __device__ void operator()(int m, int n, float a) const { lds[m * 128 + (n - c0)] = a; } };

__device__ __forceinline__ void top16_col(const float* __restrict__ col, float (&L)[16]) {
#pragma unroll
    for (int ch = 0; ch < 8; ch++) {
        float C[16];
#pragma unroll
        for (int i = 0; i < 16; i++) {
            const int n = ch * 16 + i;
            C[i] = __uint_as_float((__float_as_uint(col[n * 128]) & ~127u) | (unsigned)n);
        }
        bit_sort16_desc(C);
        if (ch == 0) {
#pragma unroll
            for (int i = 0; i < 16; i++) L[i] = C[i];
        } else top16_merge(L, C);
    }
}
__device__ __forceinline__ void d_peer_route2(const int vb, char* smem, const bf16_t* __restrict__ kys, const bf16_t* __restrict__ qb,
                                              int* __restrict__ pidx, float* __restrict__ pg) {
    const int tt = vb % 96, h = vb / 96;
    const int tid = threadIdx.x;
    float A[16], B[16];
#pragma unroll
    for (int p = 0; p < 2; p++) {
        const int hp = h * 2 + p;
        d_gemm_bf16(tt, 0, smem, kys + (size_t)hp * 128 * 128, 128, qb + hp * 128, 2048, 128, TT, EpiLds{(float*)smem, tt * 128, 0});
        __syncthreads();
        if (tid < 128) {
            float L[16];
            top16_col((const float*)smem + tid, L);
#pragma unroll
            for (int i = 0; i < 16; i++) { if (p == 0) A[i] = L[i]; else B[i] = L[i]; }
        }
        __syncthreads();
    }
    if (tid >= 128) return;
    const int t = tt * 128 + tid;
    const float smax = key_val(A[0]) + key_val(B[0]);
    unsigned Tk[16];
#pragma unroll
    for (int g = 0; g < 4; g++) {
        unsigned Ck[16];
#pragma unroll
        for (int e = 0; e < 16; e++) {
            const int c = g * 16 + e;
            int i, j;
            if (c < 16) { i = 0; j = c; }
            else if (c < 24) { i = 1; j = c - 16; }
            else if (c < 29) { i = 2; j = c - 24; }
            else if (c < 33) { i = 3; j = c - 29; }
            else if (c < 36) { i = 4; j = c - 33; }
            else if (c < 42) { i = 5 + (c - 36) / 2; j = (c - 36) % 2; }
            else if (c < 50) { i = 8 + (c - 42); j = 0; }
            else { i = -1; j = 0; }
            if (i >= 0) {
                const float dd = smax - (key_val(A[i]) + key_val(B[j]));
                unsigned qd = (unsigned)fminf(dd * 32768.f, 262143.f);
                Ck[e] = (qd << 14) | (unsigned)(key_idx(A[i]) * 128 + key_idx(B[j]));
            } else Ck[e] = 0xffffffffu;
        }
        bit_sort16u_asc(Ck);
        if (g == 0) {
#pragma unroll
            for (int e = 0; e < 16; e++) Tk[e] = Ck[e];
        } else low16_merge_u(Tk, Ck);
    }
    float sum = 0.f;
    float w[16]; int Tp[16];
#pragma unroll
    for (int e = 0; e < 16; e++) { w[e] = __expf(-(float)(Tk[e] >> 14) * (1.f / 32768.f)); sum += w[e]; Tp[e] = (int)(Tk[e] & 16383u); }
    const float inv = 1.f / sum;
    int* pi = pidx + ((size_t)t * 8 + h) * 16;
    float* pw = pg + ((size_t)t * 8 + h) * 16;
#pragma unroll
    for (int e = 0; e < 16; e += 4) {
        *(int4*)(pi + e) = make_int4(Tp[e], Tp[e + 1], Tp[e + 2], Tp[e + 3]);
        *(float4*)(pw + e) = make_float4(w[e] * inv, w[e + 1] * inv, w[e + 2] * inv, w[e + 3] * inv);
    }
}

typedef __attribute__((ext_vector_type(2))) short bf16x2;
__device__ __forceinline__ float dot8_bf16(u32x4 a, u32x4 b, float acc) {
#pragma unroll
    for (int i = 0; i < 4; i++) {
        const unsigned x = a[i], y = b[i];
        acc += __uint_as_float(x << 16) * __uint_as_float(y << 16);
        acc += __uint_as_float(x & 0xffff0000u) * __uint_as_float(y & 0xffff0000u);
    }
    return acc;
}
__device__ __forceinline__ void d_peer_apply2(const int vb, char* smem, const bf16_t* __restrict__ hb, const int* __restrict__ pidx,
                                              const float* __restrict__ pg, const bf16_t* __restrict__ utab, const bf16_t* __restrict__ vtab,
                                              const float* __restrict__ modl, float* __restrict__ xrun) {
    const int wid = threadIdx.x >> 6, lane = threadIdx.x & 63;
    const int t = vb * 4 + wid;
    float* coef = (float*)smem + wid * 128;
    int* eid = (int*)(smem + 2048) + wid * 128;
    eid[lane] = pidx[(size_t)t * 128 + lane]; eid[lane + 64] = pidx[(size_t)t * 128 + lane + 64];
    const float g0 = pg[(size_t)t * 128 + lane], g1 = pg[(size_t)t * 128 + lane + 64];
    const u32x4 x0 = *(const u32x4*)(hb + (size_t)t * DM + lane * 8);
    const u32x4 x1 = *(const u32x4*)(hb + (size_t)t * DM + 512 + lane * 8);
    __builtin_amdgcn_wave_barrier();
    float myact0 = 0.f, myact1 = 0.f;
    for (int eb = 0; eb < 128; eb += 8) {
        u32x4 ua[8], ub[8];
#pragma unroll
        for (int r = 0; r < 8; r++) {
            const bf16_t* ur = utab + (size_t)eid[eb + r] * DM;
            ua[r] = *(const u32x4*)(ur + lane * 8);
            ub[r] = *(const u32x4*)(ur + 512 + lane * 8);
        }
#pragma unroll
        for (int r = 0; r < 8; r++) {
            float sacc = dot8_bf16(ua[r], x0, 0.f);
            sacc = dot8_bf16(ub[r], x1, sacc);
            sacc = wave_sum(sacc);
            const int e = eb + r;
            if (lane == (e & 63)) { if (e < 64) myact0 = sacc; else myact1 = sacc; }
        }
    }
    coef[lane] = g0 * gelu_tanh(myact0);
    coef[lane + 64] = g1 * gelu_tanh(myact1);
    __builtin_amdgcn_wave_barrier();
    float acc[16];
#pragma unroll
    for (int i = 0; i < 16; i++) acc[i] = 0.f;
    for (int eb = 0; eb < 128; eb += 8) {
        u32x4 va[8], vbq[8];
#pragma unroll
        for (int r = 0; r < 8; r++) {
            const bf16_t* vr = vtab + (size_t)eid[eb + r] * DM;
            va[r] = *(const u32x4*)(vr + lane * 8);
            vbq[r] = *(const u32x4*)(vr + 512 + lane * 8);
        }
#pragma unroll
        for (int r = 0; r < 8; r++) {
            const float cf = coef[eb + r];
#pragma unroll
            for (int i = 0; i < 4; i++) {
                acc[2 * i] += cf * __uint_as_float(va[r][i] << 16);
                acc[2 * i + 1] += cf * __uint_as_float(va[r][i] & 0xffff0000u);
                acc[8 + 2 * i] += cf * __uint_as_float(vbq[r][i] << 16);
                acc[8 + 2 * i + 1] += cf * __uint_as_float(vbq[r][i] & 0xffff0000u);
            }
        }
    }
    const float* m = modl + (size_t)tok_modrow(t) * 6144 + 5 * 1024;
    float* xo = xrun + (size_t)t * DM;
#pragma unroll
    for (int hlf = 0; hlf < 2; hlf++) {
        const int c0 = hlf * 512 + lane * 8;
        float4 xa = *(float4*)(xo + c0), xb2 = *(float4*)(xo + c0 + 4);
        const float4 ma = *(const float4*)(m + c0), mb = *(const float4*)(m + c0 + 4);
        xa.x += ma.x * acc[hlf * 8 + 0]; xa.y += ma.y * acc[hlf * 8 + 1]; xa.z += ma.z * acc[hlf * 8 + 2]; xa.w += ma.w * acc[hlf * 8 + 3];
        xb2.x += mb.x * acc[hlf * 8 + 4]; xb2.y += mb.y * acc[hlf * 8 + 5]; xb2.z += mb.z * acc[hlf * 8 + 6]; xb2.w += mb.w * acc[hlf * 8 + 7];
        *(float4*)(xo + c0) = xa; *(float4*)(xo + c0 + 4) = xb2;
    }
}
__device__ __forceinline__ void d_cvt_bf16(const int vb, const float* __restrict__ src, bf16_t* __restrict__ dst) {
    const size_t base = (size_t)vb * 16384 + threadIdx.x * 4;
#pragma unroll
    for (int i = 0; i < 16; i++) {
        const float4 v = *(const float4*)(src + base + i * 1024);
        ushort4 o; o.x = f2bf(v.x); o.y = f2bf(v.y); o.z = f2bf(v.z); o.w = f2bf(v.w);
        *(ushort4*)(dst + base + i * 1024) = o;
    }
}

__device__ __forceinline__ void d_hy_dw(const int bx, const int by, const int bz, char* smem, const float* __restrict__ pre, const float* __restrict__ cw, const float* __restrict__ cb,
                                               bf16_t* __restrict__ zin, bf16_t* __restrict__ x0) {
    const int t = bx;
    const int pos = tok_pos(t), L = tok_len(t);
    const float* P = pre + (size_t)t * 3072;
    for (int c = threadIdx.x; c < 1024; c += 256) {
        float u[3];
#pragma unroll
        for (int part = 0; part < 3; part++) {
            int cc = part * 1024 + c;
            float cur = P[cc];
            float prev = (pos > 0) ? P[cc - 3072] : 0.f;
            float nxt = (pos < L - 1) ? P[cc + 3072] : 0.f;
            u[part] = prev * cw[cc] + cur * cw[3072 + cc] + nxt * cw[2 * 3072 + cc] + cb[cc];
        }
        x0[(size_t)t * DM + c] = f2bf(u[0]);
        zin[(size_t)t * DM + c] = f2bf(u[1] * u[2]);
    }
}

__device__ __forceinline__ void d_hy_filt(const int bx, const int by, const int bz, char* smem, int L, const float* __restrict__ w1, const float* __restrict__ b1, const float* __restrict__ w2,
                                                 const float* __restrict__ b2, const float* __restrict__ w3, const float* __restrict__ fr,
                                                 float* __restrict__ hf, float* __restrict__ hb) {
    float* z = (float*)smem; float* h1 = z + 64; float* h2 = z + 128;
    const int t = bx, tid = threadIdx.x;
    const float tu = (float)t / (float)(L - 1);
    if (tid == 0) z[0] = tu;
    if (tid >= 1 && tid < 17) {
        int i = tid - 1;
        float band = 1e-4f + (float)i * ((15.f - 1e-4f) / 15.f);
        float ang = 6.283185307179586f * (float)t * band / (float)L;
        z[1 + i] = cosf(ang); z[17 + i] = -sinf(ang);
    }
    __syncthreads();
    if (tid < 64) { float s = b1[tid]; for (int i = 0; i < 33; i++) s += z[i] * w1[i * 64 + tid]; h1[tid] = sinf(fr[tid] * s); }
    __syncthreads();
    if (tid < 64) { float s = b2[tid]; for (int i = 0; i < 64; i++) s += h1[i] * w2[i * 64 + tid]; h2[tid] = sinf(fr[tid] * s); }
    __syncthreads();
    for (int c = tid; c < 2048; c += 256) {
        float s = 0.f;
        for (int i = 0; i < 64; i++) s += h2[i] * w3[i * 2048 + c];
        int ch = c & 1023;
        float d0 = -4.605170185988091f / 0.3f, d1 = -4.605170185988091f / 1.5f;
        float delta = d0 + (d1 - d0) * ((float)ch / 1023.f);
        float win = expf(-tu * fabsf(delta));
        float val = s * win;
        if (c < 1024) hf[(size_t)t * 1024 + ch] = val; else hb[(size_t)t * 1024 + ch] = val;
    }
}
__device__ __forceinline__ void d_hy_norm(const int bx, const int by, const int bz, char* smem, int L, const float* __restrict__ hf, const float* __restrict__ hb, float* __restrict__ inv) {
    const int c = bx * 256 + threadIdx.x;
    float s = 0.f;
    for (int t = 0; t < L; t++) { s += fabsf(hf[(size_t)t * 1024 + c]); if (t > 0) s += fabsf(hb[(size_t)t * 1024 + c]); }
    inv[c] = 1.f / s;
}
__device__ __forceinline__ void d_hy_conv(const int bx, const int by, const int bz, char* smem, int L, int tbase, const bf16_t* __restrict__ zin, const bf16_t* __restrict__ x0, const float* __restrict__ hf,
                                                 const float* __restrict__ hb, const float* __restrict__ inv, const float* __restrict__ bias,
                                                 bf16_t* __restrict__ zb) {
    const int c = bx * 256 + threadIdx.x;
    const int t0 = by * 8, b = bz;
    const bf16_t* Z = zin + (size_t)(tbase + b * L) * DM + c;
    float acc[8];
#pragma unroll
    for (int i = 0; i < 8; i++) acc[i] = 0.f;
    for (int s = 0; s < L; s++) {
        float z = bf2f(Z[(size_t)s * DM]);
#pragma unroll
        for (int i = 0; i < 8; i++) {
            int j = t0 + i - s;
            float g = (j >= 0) ? hf[(size_t)j * 1024 + c] : hb[(size_t)(-j) * 1024 + c];
            acc[i] += z * g;
        }
    }
    float iv = inv[c], bs = bias[c];
#pragma unroll
    for (int i = 0; i < 8; i++) {
        size_t o = (size_t)(tbase + b * L + t0 + i) * DM + c;
        float zz = bf2f(zin[o]);
        zb[o] = f2bf(bf2f(x0[o]) * (acc[i] * iv + zz * bs));
    }
}


__device__ __forceinline__ void d_hy_filt2(const int vbl8, char* smem, const int L, const float* __restrict__ w1, const float* __restrict__ b1,
                                           const float* __restrict__ w2, const float* __restrict__ b2, const float* __restrict__ w3,
                                           const float* __restrict__ fr, bf16_t* __restrict__ gT, float* __restrict__ nsum) {
    float* zp = (float*)smem;
    float* h1 = zp + 32 * 33;
    float* h2t = h1 + 32 * 64;
    float* sw1 = h2t + 64 * 32;
    float* sw2 = sw1 + 33 * 64;
    const int tid = threadIdx.x;
    const int vbl = vbl8 >> 3, mm = vbl8 & 7;
    const int t0 = vbl * 32;
    for (int e = tid; e < 33 * 64; e += 256) sw1[e] = w1[e];
    for (int e = tid; e < 64 * 64; e += 256) sw2[e] = w2[e];
    for (int e = tid; e < 32 * 33; e += 256) {
        const int pos = e / 33, i = e % 33;
        const float t = (float)(t0 + pos);
        float val;
        if (i == 0) val = t / (float)(L - 1);
        else {
            const int bi = (i <= 16) ? (i - 1) : (i - 17);
            const float band = 1e-4f + (float)bi * ((15.f - 1e-4f) / 15.f);
            const float ang = 6.283185307179586f * t * band / (float)L;
            val = (i <= 16) ? __cosf(ang) : -__sinf(ang);
        }
        zp[e] = val;
    }
    const int c = tid + 256 * mm;
    float wv[8];
#pragma unroll
    for (int jj = 0; jj < 8; jj++) wv[jj] = w3[jj * 2048 + c];
    __syncthreads();
    {
        const int j = tid & 63;
        const float frj = fr[j];
#pragma unroll 1
        for (int i = 0; i < 8; i++) {
            const int pos = (tid >> 6) + 4 * i;
            float sacc = b1[j];
#pragma unroll 3
            for (int q = 0; q < 33; q++) sacc += zp[pos * 33 + q] * sw1[q * 64 + j];
            h1[pos * 64 + j] = __sinf(frj * sacc);
        }
        __syncthreads();
#pragma unroll 1
        for (int i = 0; i < 8; i++) {
            const int pos = (tid >> 6) + 4 * i;
            float sacc = b2[j];
#pragma unroll 4
            for (int q = 0; q < 64; q++) sacc += h1[pos * 64 + q] * sw2[q * 64 + j];
            h2t[j * 32 + pos] = __sinf(frj * sacc);
        }
    }
    __syncthreads();
    {
        float acc[32];
#pragma unroll
        for (int i = 0; i < 32; i++) acc[i] = 0.f;
#pragma unroll 1
        for (int jb = 0; jb < 64; jb += 8) {
            float wn[8];
            if (jb + 8 < 64) {
#pragma unroll
                for (int jj = 0; jj < 8; jj++) wn[jj] = w3[(jb + 8 + jj) * 2048 + c];
            }
#pragma unroll
            for (int jj = 0; jj < 8; jj++) {
                const float w = wv[jj];
#pragma unroll
                for (int i = 0; i < 8; i++) {
                    const float4 hv = *(const float4*)(h2t + (jb + jj) * 32 + i * 4);
                    acc[4 * i] += hv.x * w; acc[4 * i + 1] += hv.y * w; acc[4 * i + 2] += hv.z * w; acc[4 * i + 3] += hv.w * w;
                }
                __builtin_amdgcn_sched_barrier(0);
            }
            if (jb + 8 < 64) {
#pragma unroll
                for (int jj = 0; jj < 8; jj++) wv[jj] = wn[jj];
            }
        }
        const int ch = c & 1023;
        const float d0 = -4.605170185988091f / 0.3f, d1 = -4.605170185988091f / 1.5f;
        const float adelta = fabsf(d0 + (d1 - d0) * ((float)ch / 1023.f));
        float absum = 0.f;
        bf16_t* g = gT + (size_t)ch * 2 * L;
#pragma unroll
        for (int i = 0; i < 32; i++) {
            const int t = t0 + i;
            const float tu = (float)t / (float)(L - 1);
            const float val = acc[i] * __expf(-tu * adelta);
            if (c < 1024) { absum += fabsf(val); g[L - t] = f2bf(val); }
            else if (t >= 1) { absum += fabsf(val); g[L + t] = f2bf(val); }
            if ((i & 3) == 3) __builtin_amdgcn_sched_barrier(0);
        }
        atomicAdd(nsum + ch, absum);
    }
}

__device__ __forceinline__ void d_hy_dw3(const int vb, char* smem, const bf16_t* __restrict__ pre, const float* __restrict__ cw,
                                         const float* __restrict__ cb, bf16_t* __restrict__ zT, bf16_t* __restrict__ x0b) {
    bf16_t* tile = (bf16_t*)smem;
    const int tt = vb >> 3, ct = vb & 7;
    const int tid = threadIdx.x;
    const int cp = tid & 63, c = ct * 128 + cp * 2;
    const int tq = tid >> 6;
    const int tok0 = tt * 64 + tq * 16;
    const int pos0 = tok_pos(tok0), L = tok_len(tok0);
    unsigned raw[3][18];
#pragma unroll
    for (int part = 0; part < 3; part++)
#pragma unroll
        for (int i = 0; i < 18; i++) {
            const int pos = pos0 - 1 + i;
            raw[part][i] = (pos >= 0 && pos < L) ? *(const unsigned*)(pre + (size_t)(tok0 - 1 + i) * 3072 + part * 1024 + c) : 0u;
        }
    float w0[3][2], w1[3][2], w2[3][2], bb[3][2];
#pragma unroll
    for (int part = 0; part < 3; part++)
#pragma unroll
        for (int e = 0; e < 2; e++) {
            const int col = part * 1024 + c + e;
            w0[part][e] = cw[col]; w1[part][e] = cw[3072 + col]; w2[part][e] = cw[2 * 3072 + col]; bb[part][e] = cb[col];
        }
#pragma unroll
    for (int i = 0; i < 16; i++) {
        float u[3][2];
#pragma unroll
        for (int part = 0; part < 3; part++) {
            const unsigned p0 = raw[part][i], p1 = raw[part][i + 1], p2 = raw[part][i + 2];
            u[part][0] = __uint_as_float(p0 << 16) * w0[part][0] + __uint_as_float(p1 << 16) * w1[part][0] + __uint_as_float(p2 << 16) * w2[part][0] + bb[part][0];
            u[part][1] = __uint_as_float(p0 & 0xffff0000u) * w0[part][1] + __uint_as_float(p1 & 0xffff0000u) * w1[part][1] +
                         __uint_as_float(p2 & 0xffff0000u) * w2[part][1] + bb[part][1];
        }
        *(unsigned*)(x0b + (size_t)(tok0 + i) * DM + c) = (unsigned)f2bf(u[0][0]) | ((unsigned)f2bf(u[0][1]) << 16);
        tile[(cp * 2) * 72 + tq * 16 + i] = f2bf(u[1][0] * u[2][0]);
        tile[(cp * 2 + 1) * 72 + tq * 16 + i] = f2bf(u[1][1] * u[2][1]);
    }
    __syncthreads();
    {
        const int cch = tid >> 1, hf = tid & 1;
        bf16_t* dst = zT + (size_t)(ct * 128 + cch) * TT + tt * 64 + hf * 32;
        const bf16_t* src = tile + cch * 72 + hf * 32;
#pragma unroll
        for (int q = 0; q < 4; q++) *(u32x4*)(dst + q * 8) = *(const u32x4*)(src + q * 8);
    }
}

template <bool SAMPLE>
__device__ __forceinline__ void d_hy_conv2(const int c, const int half, char* wsm, const bf16_t* __restrict__ gTall, const float* __restrict__ nsum,
                                           const bf16_t* __restrict__ zT, const float* __restrict__ bias, bf16_t* __restrict__ yT) {
    constexpr int L = SAMPLE ? LS : LP;
    constexpr int NB = L / 32;
    constexpr int NBATCH = SAMPLE ? 4 : 16;
    constexpr int BSH = SAMPLE ? 2 : 4;
    constexpr int TPB = 32 >> BSH;
    constexpr int NCB = NB / TPB;
    constexpr int HCB = NCB / 2;
    constexpr int PADB = SAMPLE ? 8 : 2;
    constexpr int ZLEN = L + 2 * PADB * 32;
    constexpr int tbase = SAMPLE ? TP : 0;
    const int lane = threadIdx.x & 63;
    const int l2 = half * 64 + lane;
    const int lc = lane & 31, hh = lane >> 5;
    const int b = lc & (NBATCH - 1), Tl = lc >> BSH;
    bf16_t* R = (bf16_t*)wsm;
    bf16_t* Z = R + 2 * L;
    {
        const u32x4* src = (const u32x4*)(gTall + (size_t)c * 2 * L);
        for (int i = l2; i < 2 * L / 8; i += 128) ((u32x4*)R)[i] = src[i];
        const u32x4 zero = {0u, 0u, 0u, 0u};
#pragma unroll 1
        for (int b2 = 0; b2 < NBATCH; b2++) {
            const u32x4* zs = (const u32x4*)(zT + (size_t)c * TT + tbase + b2 * L);
            u32x4* zd = (u32x4*)(Z + b2 * ZLEN);
            for (int i = l2; i < PADB * 4; i += 128) { zd[i] = zero; zd[PADB * 4 + L / 8 + i] = zero; }
            for (int i = l2; i < L / 8; i += 128) zd[PADB * 4 + i] = zs[i];
        }
    }
    __syncthreads();
    f32x16 acc[HCB];
#pragma unroll
    for (int cb = 0; cb < HCB; cb++)
#pragma unroll
        for (int r = 0; r < 16; r++) acc[cb][r] = 0.f;
    const bf16_t* Zb = Z + b * ZLEN + PADB * 32 + 8 * hh;
    const int cb0 = half * HCB;
    const int Dlo = TPB * cb0 - (NB - 1), Dhi = TPB * (cb0 + HCB - 1) + TPB - 1;
#pragma unroll 1
    for (int D = (Dlo < -(NB - 1) ? -(NB - 1) : Dlo); D <= (Dhi > NB - 1 ? NB - 1 : Dhi); D++) {
        bf16x8 af[2];
#pragma unroll
        for (int ks = 0; ks < 2; ks++) {
            const bf16_t* rp = R + (L - 32 * D - lc + 16 * ks + 8 * hh);
#pragma unroll
            for (int j = 0; j < 8; j++) af[ks][j] = (short)rp[j];
        }
#pragma unroll
        for (int lcb = 0; lcb < HCB; lcb++) {
            const int cb = cb0 + lcb;
            if (D >= TPB * cb - (NB - 1) && D <= TPB * cb + TPB - 1) {
                const int S = TPB * cb + Tl - D;
#pragma unroll
                for (int ks = 0; ks < 2; ks++) {
                    const bf16x8 bfr = *(const bf16x8*)(Zb + 32 * S + 16 * ks);
                    acc[lcb] = __builtin_amdgcn_mfma_f32_32x32x16_bf16(af[ks], bfr, acc[lcb], 0, 0, 0);
                }
            }
        }
    }
    const float inv = 1.f / nsum[c], bs = bias[c];
    bf16_t* yrow = yT + (size_t)c * TT + tbase + b * L;
    const bf16_t* zrow = Z + b * ZLEN + PADB * 32;
#pragma unroll
    for (int lcb = 0; lcb < HCB; lcb++)
#pragma unroll
        for (int g = 0; g < 4; g++) {
            const int t = 32 * (TPB * (cb0 + lcb) + Tl) + 8 * g + 4 * hh;
            ushort4 o;
            o.x = f2bf(acc[lcb][4 * g + 0] * inv + bf2f(zrow[t + 0]) * bs);
            o.y = f2bf(acc[lcb][4 * g + 1] * inv + bf2f(zrow[t + 1]) * bs);
            o.z = f2bf(acc[lcb][4 * g + 2] * inv + bf2f(zrow[t + 2]) * bs);
            o.w = f2bf(acc[lcb][4 * g + 3] * inv + bf2f(zrow[t + 3]) * bs);
            *(ushort4*)(yrow + t) = o;
        }
}

__device__ __forceinline__ void d_hy_post2(const int vb, char* smem, const bf16_t* __restrict__ yT, const bf16_t* __restrict__ x0b, bf16_t* __restrict__ zb) {
    bf16_t* tile = (bf16_t*)smem;
    const int tt = vb >> 3, ct = vb & 7;
    const int tid = threadIdx.x;
    const int cp = tid & 63, c = ct * 128 + cp * 2, tq = tid >> 6;
    const int tok0 = tt * 64 + tq * 16;
    unsigned xr[16];
#pragma unroll
    for (int i = 0; i < 16; i++) xr[i] = *(const unsigned*)(x0b + (size_t)(tok0 + i) * DM + c);
    {
        const int cch = tid >> 1, hf = tid & 1;
        const bf16_t* src = yT + (size_t)(ct * 128 + cch) * TT + tt * 64 + hf * 32;
        bf16_t* dst = tile + cch * 72 + hf * 32;
#pragma unroll
        for (int q = 0; q < 4; q++) *(u32x4*)(dst + q * 8) = *(const u32x4*)(src + q * 8);
    }
    __syncthreads();
#pragma unroll
    for (int i = 0; i < 16; i++) {
        const float y0 = bf2f(tile[(cp * 2) * 72 + tq * 16 + i]), y1 = bf2f(tile[(cp * 2 + 1) * 72 + tq * 16 + i]);
        const float r0 = __uint_as_float(xr[i] << 16) * y0, r1 = __uint_as_float(xr[i] & 0xffff0000u) * y1;
        *(unsigned*)(zb + (size_t)(tok0 + i) * DM + c) = (unsigned)f2bf(r0) | ((unsigned)f2bf(r1) << 16);
    }
}

__device__ __forceinline__ float wave_allsum_fast(float v) {
    v = row16_allsum(v);
    const float r0 = __int_as_float(__builtin_amdgcn_readlane(__float_as_int(v), 0));
    const float r1 = __int_as_float(__builtin_amdgcn_readlane(__float_as_int(v), 16));
    const float r2 = __int_as_float(__builtin_amdgcn_readlane(__float_as_int(v), 32));
    const float r3 = __int_as_float(__builtin_amdgcn_readlane(__float_as_int(v), 48));
    return (r0 + r1) + (r2 + r3);
}
__device__ __forceinline__ ushort4 pack_bf4(float a, float b, float c, float d) { ushort4 o; o.x = f2bf(a); o.y = f2bf(b); o.z = f2bf(c); o.w = f2bf(d); return o; }

__device__ __forceinline__ void d_norm_mod2(const int vb, const float* __restrict__ xa, const float* __restrict__ xb, const float* __restrict__ g,
                                            const float* __restrict__ modl, const int shift_idx, const int scale_idx, bf16_t* __restrict__ h) {
    const int wid = threadIdx.x >> 6, lane = threadIdx.x & 63;
    const int t0 = vb * 8 + wid * 2;
    float4 v[2][4];
#pragma unroll
    for (int u = 0; u < 2; u++) {
        const int t = t0 + u;
        const float* x = (t < TP) ? (xa + (size_t)t * DM) : (xb + (size_t)(t - TP) * DM);
#pragma unroll
        for (int j = 0; j < 4; j++) v[u][j] = *(const float4*)(x + j * 256 + lane * 4);
    }
#pragma unroll
    for (int u = 0; u < 2; u++) {
        const int t = t0 + u;
        float ss = 0.f;
#pragma unroll
        for (int j = 0; j < 4; j++) ss += v[u][j].x * v[u][j].x + v[u][j].y * v[u][j].y + v[u][j].z * v[u][j].z + v[u][j].w * v[u][j].w;
        ss = wave_allsum_fast(ss);
        const float rstd = rsqrtf(ss * (1.f / DM) + 1e-6f);
        const float* m = modl + (size_t)tok_modrow(t) * 6144;
#pragma unroll
        for (int j = 0; j < 4; j++) {
            const int c = j * 256 + lane * 4;
            const float4 gg = *(const float4*)(g + c);
            const float4 sh = *(const float4*)(m + shift_idx * 1024 + c);
            const float4 sc = *(const float4*)(m + scale_idx * 1024 + c);
            *(ushort4*)(h + (size_t)t * DM + c) = pack_bf4(v[u][j].x * rstd * gg.x * (1.f + sc.x) + sh.x, v[u][j].y * rstd * gg.y * (1.f + sc.y) + sh.y,
                                                           v[u][j].z * rstd * gg.z * (1.f + sc.z) + sh.z, v[u][j].w * rstd * gg.w * (1.f + sc.w) + sh.w);
        }
    }
}

__device__ __forceinline__ void d_rw_shift2(const int vb, const bf16_t* __restrict__ proj, const float* __restrict__ mu, bf16_t* __restrict__ rb,
                                            bf16_t* __restrict__ kb, bf16_t* __restrict__ vbuf, bf16_t* __restrict__ tw, bf16_t* __restrict__ adv,
                                            bf16_t* __restrict__ sg) {
#pragma unroll
    for (int u = 0; u < 4; u++) {
        const int id = vb * 1024 + u * 256 + threadIdx.x;
        const int t = id / 224, c = (id % 224) * 8;
        const int pos = tok_pos(t), L = tok_len(t);
        const bf16_t* P = proj + (size_t)t * RWIN + c;
        const u32x4 cur = *(const u32x4*)P;
        u32x4 prv = {0u, 0u, 0u, 0u}, nxt = {0u, 0u, 0u, 0u};
        if (pos > 0) prv = *(const u32x4*)(P - RWIN);
        if (pos < L - 1) nxt = *(const u32x4*)(P + RWIN);
        const float4 m0 = *(const float4*)(mu + c), m1 = *(const float4*)(mu + c + 4);
        const float mm[8] = {m0.x, m0.y, m0.z, m0.w, m1.x, m1.y, m1.z, m1.w};
        float val[8];
#pragma unroll
        for (int i = 0; i < 4; i++) {
            const float c0 = __uint_as_float(cur[i] << 16), c1 = __uint_as_float(cur[i] & 0xffff0000u);
            const float p0 = __uint_as_float(prv[i] << 16), p1 = __uint_as_float(prv[i] & 0xffff0000u);
            const float n0 = __uint_as_float(nxt[i] << 16), n1 = __uint_as_float(nxt[i] & 0xffff0000u);
            val[2 * i] = c0 + mm[2 * i] * (0.5f * (p0 + n0) - c0);
            val[2 * i + 1] = c1 + mm[2 * i + 1] * (0.5f * (p1 + n1) - c1);
        }
        bf16_t* dst;
        if (c < 512) dst = rb + (size_t)t * 512 + c;
        else if (c < 1024) dst = kb + (size_t)t * 512 + (c - 512);
        else if (c < 1536) dst = vbuf + (size_t)t * 512 + (c - 1024);
        else if (c < 1600) { dst = tw + (size_t)t * 64 + (c - 1536);
#pragma unroll
            for (int i = 0; i < 8; i++) val[i] = tanhf(val[i]); }
        else if (c < 1664) dst = adv + (size_t)t * 64 + (c - 1600);
        else { dst = sg + (size_t)t * 128 + (c - 1664);
#pragma unroll
            for (int i = 0; i < 8; i++) val[i] = sigmoidf_(val[i]); }
        u32x4 o;
#pragma unroll
        for (int i = 0; i < 4; i++) o[i] = (unsigned)f2bf(val[2 * i]) | ((unsigned)f2bf(val[2 * i + 1]) << 16);
        *(u32x4*)dst = o;
    }
}

__device__ __forceinline__ void d_mla_pre2(const int vb, const float* __restrict__ proj, const float* __restrict__ q_norm, const float* __restrict__ kv_norm,
                                           bf16_t* __restrict__ qcn, bf16_t* __restrict__ ckv, float* __restrict__ kpe, float* __restrict__ out_ckv,
                                           float* __restrict__ out_kpe) {
    const int t = vb * 16 + (threadIdx.x >> 4), l16 = threadIdx.x & 15;
    const float* P = proj + (size_t)t * 448;
    float4 x[7];
#pragma unroll
    for (int j = 0; j < 7; j++) x[j] = *(const float4*)(P + 4 * (l16 + 16 * j));
    float sq = 0.f, sk = 0.f;
#pragma unroll
    for (int j = 0; j < 4; j++) sq += x[j].x * x[j].x + x[j].y * x[j].y + x[j].z * x[j].z + x[j].w * x[j].w;
#pragma unroll
    for (int j = 4; j < 6; j++) sk += x[j].x * x[j].x + x[j].y * x[j].y + x[j].z * x[j].z + x[j].w * x[j].w;
    sq = row16_allsum(sq); sk = row16_allsum(sk);
    const float rq = rsqrtf(sq * (1.f / 256.f) + 1e-6f), rk = rsqrtf(sk * (1.f / 128.f) + 1e-6f);
#pragma unroll
    for (int j = 0; j < 4; j++) {
        const int c = 4 * (l16 + 16 * j);
        const float4 w = *(const float4*)(q_norm + c);
        *(ushort4*)(qcn + (size_t)t * 256 + c) = pack_bf4(x[j].x * rq * w.x, x[j].y * rq * w.y, x[j].z * rq * w.z, x[j].w * rq * w.w);
    }
#pragma unroll
    for (int j = 4; j < 6; j++) {
        const int c = 4 * (l16 + 16 * (j - 4));
        const float4 w = *(const float4*)(kv_norm + c);
        const float4 o = make_float4(x[j].x * rk * w.x, x[j].y * rk * w.y, x[j].z * rk * w.z, x[j].w * rk * w.w);
        *(ushort4*)(ckv + (size_t)t * 128 + c) = pack_bf4(o.x, o.y, o.z, o.w);
        if (t < TP) *(float4*)(out_ckv + (size_t)t * 128 + c) = o;
    }
    {
        const int c = 4 * l16;
        *(float4*)(kpe + (size_t)t * 64 + c) = x[6];
        if (t < TP) *(float4*)(out_kpe + (size_t)t * 64 + c) = x[6];
    }
}

__device__ __forceinline__ void d_rw_kk2(const int vb, char* smem, const bf16_t* __restrict__ rb, const bf16_t* __restrict__ kb,
                                         const bf16_t* __restrict__ lr0, const bf16_t* __restrict__ lr1, const float* __restrict__ k_k,
                                         const float* __restrict__ k_a, const float* __restrict__ r_k, bf16_t* __restrict__ kkb, float* __restrict__ bonus) {
    float* pk = (float*)smem;
    for (int i = threadIdx.x; i < 512; i += 256) { pk[i] = k_k[i]; pk[512 + i] = k_a[i]; pk[1024 + i] = r_k[i]; }
    __syncthreads();
    const int w = vb * 256 + threadIdx.x;
    const int h = w & 7;
    const size_t o = (size_t)w * 64;
    u32x4 kq[8];
#pragma unroll
    for (int i = 0; i < 8; i++) kq[i] = *(const u32x4*)(kb + o + i * 8);
    const float* kkp = pk + h * 64; const float* kap = pk + 512 + h * 64; const float* rkp = pk + 1024 + h * 64;
    float ss = 0.f;
#pragma unroll
    for (int i = 0; i < 8; i++)
#pragma unroll
        for (int j = 0; j < 4; j++) {
            const float a = __uint_as_float(kq[i][j] << 16) * kkp[i * 8 + 2 * j], b = __uint_as_float(kq[i][j] & 0xffff0000u) * kkp[i * 8 + 2 * j + 1];
            ss += a * a + b * b;
        }
    const float inv = 1.f / fmaxf(sqrtf(ss), 1e-12f);
    float bs = 0.f;
#pragma unroll 2
    for (int i = 0; i < 8; i++) {
        const u32x4 kq2 = *(const u32x4*)(kb + o + i * 8);
        const u32x4 rq = *(const u32x4*)(rb + o + i * 8);
        const u32x4 l0 = *(const u32x4*)(lr0 + o + i * 8);
        const u32x4 l1 = *(const u32x4*)(lr1 + o + i * 8);
        u32x4 ok;
#pragma unroll
        for (int j = 0; j < 4; j++) {
            const int e0 = i * 8 + 2 * j, e1 = e0 + 1;
            const float k0 = __uint_as_float(kq2[j] << 16), k1 = __uint_as_float(kq2[j] & 0xffff0000u);
            const float r0 = __uint_as_float(rq[j] << 16), r1 = __uint_as_float(rq[j] & 0xffff0000u);
            const float a0 = __uint_as_float(l0[j] << 16), a1 = __uint_as_float(l0[j] & 0xffff0000u);
            const float b0 = __uint_as_float(l1[j] << 16), b1 = __uint_as_float(l1[j] & 0xffff0000u);
            bs += r0 * k0 * (2.f + (a0 + b0 - 2.f) * kap[e0]) * rkp[e0] + r1 * k1 * (2.f + (a1 + b1 - 2.f) * kap[e1]) * rkp[e1];
            ok[j] = (unsigned)f2bf(k0 * kkp[e0] * inv) | ((unsigned)f2bf(k1 * kkp[e1] * inv) << 16);
        }
        *(u32x4*)(kkb + o + i * 8) = ok;
    }
    bonus[w] = bs;
}

__device__ __forceinline__ void d_mla_post2(const int vb, const bf16_t* __restrict__ qraw, const bf16_t* __restrict__ kvraw, const bf16_t* __restrict__ kvraw_ctx,
                                            const float* __restrict__ kpe, const float* __restrict__ cache_kpe, const float* __restrict__ qn,
                                            const float* __restrict__ kn, bf16_t* __restrict__ Qb, bf16_t* __restrict__ Kp, bf16_t* __restrict__ Ks) {
    const int item = vb * 16 + (threadIdx.x >> 4), l16 = threadIdx.x & 15;
    const int row = item >> 2, h = item & 3;
    const bool isctx = row >= TT, sample = row >= TP;
    const int e0 = 12 * l16;
    const bf16_t* kvr; const float* pe; int pos = 0;
    if (isctx) { const int cr = row - TT; kvr = kvraw_ctx + (size_t)cr * 1024; pe = cache_kpe + (size_t)cr * 64; }
    else { kvr = kvraw + (size_t)row * 1024; pe = kpe + (size_t)row * 64; pos = tok_pos(row); }
    float kx[12], qx[12];
#pragma unroll
    for (int j = 0; j < 12; j++) {
        const int e = e0 + j;
        kx[j] = (e < 128) ? bf2f(kvr[h * 256 + (e < 128 ? e : 0)]) : pe[(e >= 128 ? e - 128 : 0)];
        qx[j] = isctx ? 0.f : bf2f(qraw[(size_t)row * 768 + h * 192 + e]);
    }
    float sk = 0.f, sq = 0.f;
#pragma unroll
    for (int j = 0; j < 12; j++) { sk += kx[j] * kx[j]; sq += qx[j] * qx[j]; }
    sk = row16_allsum(sk); sq = row16_allsum(sq);
    const float rk = rsqrtf(sk * (1.f / 192.f) + 1e-6f), rq = rsqrtf(sq * (1.f / 192.f) + 1e-6f);
#pragma unroll
    for (int j = 0; j < 12; j++) { kx[j] *= rk * kn[e0 + j]; qx[j] *= rq * qn[e0 + j]; }
    if (sample && !isctx) {
        const float rowf = (float)(pos >> 6), colf = (float)(pos & 63);
#pragma unroll
        for (int j = 0; j < 12; j += 2) {
            const int e = e0 + j;
            if (e >= 128) {
                const int pi = (e - 128) >> 1;
                const float inv = expf(-(float)(pi & 15) * (1.f / 16.f) * 9.210340371976184f);
                const float ang = (pi < 16 ? rowf : colf) * inv;
                const float cs = __cosf(ang), sn = __sinf(ang);
                const float a = kx[j], bq = kx[j + 1];
                kx[j] = a * cs - bq * sn; kx[j + 1] = a * sn + bq * cs;
                const float a2 = qx[j], b2 = qx[j + 1];
                qx[j] = a2 * cs - b2 * sn; qx[j + 1] = a2 * sn + b2 * cs;
            }
        }
    }
    bf16_t* kd;
    if (!sample) { const int b = row >> 8, pp = row & 255; kd = Kp + ((size_t)(b * 4 + h) * LP + pp) * 192; }
    else if (!isctx) { const int b = (row - TP) >> 11, pp = (row - TP) & 2047; kd = Ks + ((size_t)(b * 4 + h) * 2304 + 256 + pp) * 192; }
    else { const int cr = row - TT; const int b = cr >> 8, pp = cr & 255; kd = Ks + ((size_t)(b * 4 + h) * 2304 + pp) * 192; }
#pragma unroll
    for (int j = 0; j < 12; j += 4) {
        *(ushort4*)(kd + e0 + j) = pack_bf4(kx[j], kx[j + 1], kx[j + 2], kx[j + 3]);
        if (!isctx) *(ushort4*)(Qb + ((size_t)row * 4 + h) * 192 + e0 + j) = pack_bf4(qx[j], qx[j + 1], qx[j + 2], qx[j + 3]);
    }
}

__device__ __forceinline__ void d_rw_post2(const int vb, char* smem, const float* __restrict__ y0, const float* __restrict__ y1, const float* __restrict__ bonus,
                                           const bf16_t* __restrict__ vbuf, const bf16_t* __restrict__ gate, const float* __restrict__ lnx_g,
                                           const float* __restrict__ lnx_b, bf16_t* __restrict__ cat) {
    float* pg = (float*)smem;
    for (int i = threadIdx.x; i < 512; i += 256) { pg[i] = lnx_g[i]; pg[512 + i] = lnx_b[i]; }
    __syncthreads();
    const int w = vb * 256 + threadIdx.x;
    const int t = w >> 3, h = w & 7;
    const size_t o = (size_t)w * 64;
    float s1 = 0.f, s2 = 0.f;
#pragma unroll 4
    for (int i = 0; i < 16; i++) {
        const float4 a = *(const float4*)(y0 + o + i * 4), b = *(const float4*)(y1 + o + i * 4);
        const float e0 = a.x + b.x, e1 = a.y + b.y, e2 = a.z + b.z, e3 = a.w + b.w;
        s1 += (e0 + e1) + (e2 + e3);
        s2 += (e0 * e0 + e1 * e1) + (e2 * e2 + e3 * e3);
    }
    const float mean = s1 * (1.f / 64.f);
    const float var = fmaxf(s2 * (1.f / 64.f) - mean * mean, 0.f);
    const float rstd = rsqrtf(var + 64e-5f);
    const float bn = bonus[w];
    const float* gp = pg + h * 64; const float* bp = pg + 512 + h * 64;
#pragma unroll 2
    for (int i = 0; i < 8; i++) {
        const float4 ya = *(const float4*)(y0 + o + i * 8), yb = *(const float4*)(y1 + o + i * 8);
        const float4 yc = *(const float4*)(y0 + o + i * 8 + 4), yd = *(const float4*)(y1 + o + i * 8 + 4);
        const float yy[8] = {ya.x + yb.x, ya.y + yb.y, ya.z + yb.z, ya.w + yb.w, yc.x + yd.x, yc.y + yd.y, yc.z + yd.z, yc.w + yd.w};
        const u32x4 vq = *(const u32x4*)(vbuf + o + i * 8);
        const u32x4 gq = *(const u32x4*)(gate + o + i * 8);
        u32x4 oq;
#pragma unroll
        for (int j = 0; j < 4; j++) {
            const int e0 = i * 8 + 2 * j, e1 = e0 + 1;
            const float v0 = __uint_as_float(vq[j] << 16), v1 = __uint_as_float(vq[j] & 0xffff0000u);
            const float g0 = __uint_as_float(gq[j] << 16), g1 = __uint_as_float(gq[j] & 0xffff0000u);
            const float r0 = ((yy[2 * j] - mean) * rstd * gp[e0] + bp[e0] + bn * v0) * g0;
            const float r1 = ((yy[2 * j + 1] - mean) * rstd * gp[e1] + bp[e1] + bn * v1) * g1;
            oq[j] = (unsigned)f2bf(r0) | ((unsigned)f2bf(r1) << 16);
        }
        *(u32x4*)(cat + (size_t)t * DM + h * 64 + i * 8) = oq;
    }
}


typedef float f32x2 __attribute__((ext_vector_type(2)));
template <int CTRL>
__device__ __forceinline__ float dpp_max(float v) {
    return fmaxf(v, __int_as_float(__builtin_amdgcn_update_dpp(0, __float_as_int(v), CTRL, 0xf, 0xf, false)));
}
__device__ __forceinline__ float wave_allmax_fast(float v) {
    v = dpp_max<0x128>(v); v = dpp_max<0x124>(v); v = dpp_max<0x122>(v); v = dpp_max<0x121>(v);
    const float r0 = __int_as_float(__builtin_amdgcn_readlane(__float_as_int(v), 0));
    const float r1 = __int_as_float(__builtin_amdgcn_readlane(__float_as_int(v), 16));
    const float r2 = __int_as_float(__builtin_amdgcn_readlane(__float_as_int(v), 32));
    const float r3 = __int_as_float(__builtin_amdgcn_readlane(__float_as_int(v), 48));
    return fmaxf(fmaxf(r0, r1), fmaxf(r2, r3));
}
__device__ __forceinline__ void d_cvt_fp8_rows(const int vb, const float* __restrict__ src, unsigned char* __restrict__ dst, float* __restrict__ rscale) {
    const int wid = threadIdx.x >> 6, lane = threadIdx.x & 63;
    float4 x[4][4];
#pragma unroll
    for (int u = 0; u < 4; u++) {
        const float* r = src + (size_t)(vb * 16 + wid * 4 + u) * 1024 + lane * 16;
#pragma unroll
        for (int j = 0; j < 4; j++) x[u][j] = *(const float4*)(r + 4 * j);
    }
#pragma unroll
    for (int u = 0; u < 4; u++) {
        const int row = vb * 16 + wid * 4 + u;
        float am = 0.f;
#pragma unroll
        for (int j = 0; j < 4; j++) am = fmaxf(am, fmaxf(fmaxf(fabsf(x[u][j].x), fabsf(x[u][j].y)), fmaxf(fabsf(x[u][j].z), fabsf(x[u][j].w))));
        am = wave_allmax_fast(am);
        const float sc = am > 0.f ? 448.f / am : 1.f;
        u32x4 q;
#pragma unroll
        for (int j = 0; j < 4; j++) {
            int pk = __builtin_amdgcn_cvt_pk_fp8_f32(x[u][j].x * sc, x[u][j].y * sc, 0, false);
            pk = __builtin_amdgcn_cvt_pk_fp8_f32(x[u][j].z * sc, x[u][j].w * sc, pk, true);
            q[j] = (unsigned)pk;
        }
        *(u32x4*)(dst + (size_t)row * 1024 + lane * 16) = q;
        if (lane == 0) rscale[row] = am > 0.f ? am * (1.f / 448.f) : 1.f;
    }
}
__device__ __forceinline__ void d_peer_apply3(const int vb, char* smem, const bf16_t* __restrict__ hb, const int* __restrict__ pidx,
                                              const float* __restrict__ pg, const unsigned char* __restrict__ utab, const unsigned char* __restrict__ vtab,
                                              const float* __restrict__ rsU, const float* __restrict__ rsV, const float* __restrict__ modl,
                                              float* __restrict__ xrun, const float* __restrict__ g_next, const float* __restrict__ mod_next,
                                              bf16_t* __restrict__ h_next) {
    const int wid = threadIdx.x >> 6, lane = threadIdx.x & 63;
    const int t = vb * 4 + wid;
    float* coef = (float*)smem + wid * 128;
    int* eid = (int*)(smem + 2048) + wid * 128;
    const int e_lo = pidx[(size_t)t * 128 + lane], e_hi = pidx[(size_t)t * 128 + lane + 64];
    eid[lane] = e_lo; eid[lane + 64] = e_hi;
    const float g0 = pg[(size_t)t * 128 + lane] * rsV[e_lo], g1 = pg[(size_t)t * 128 + lane + 64] * rsV[e_hi];
    const float ru0 = rsU[e_lo], ru1 = rsU[e_hi];
    float x[16];
    {
        const u32x4 a = *(const u32x4*)(hb + (size_t)t * DM + lane * 16), b = *(const u32x4*)(hb + (size_t)t * DM + lane * 16 + 8);
#pragma unroll
        for (int i = 0; i < 4; i++) {
            x[2 * i] = __uint_as_float(a[i] << 16); x[2 * i + 1] = __uint_as_float(a[i] & 0xffff0000u);
            x[8 + 2 * i] = __uint_as_float(b[i] << 16); x[8 + 2 * i + 1] = __uint_as_float(b[i] & 0xffff0000u);
        }
    }
    __builtin_amdgcn_wave_barrier();
    float myact0 = 0.f, myact1 = 0.f;
#pragma unroll 1
    for (int eb = 0; eb < 128; eb += 16) {
        u32x4 q[16];
#pragma unroll
        for (int r = 0; r < 16; r++) q[r] = *(const u32x4*)(utab + (size_t)eid[eb + r] * 1024 + lane * 16);
#pragma unroll
        for (int r = 0; r < 16; r++) {
            float sacc = 0.f;
#pragma unroll
            for (int i = 0; i < 4; i++) {
                const f32x2 f01 = __builtin_amdgcn_cvt_pk_f32_fp8((int)q[r][i], false);
                const f32x2 f23 = __builtin_amdgcn_cvt_pk_f32_fp8((int)q[r][i], true);
                sacc += f01[0] * x[4 * i] + f01[1] * x[4 * i + 1] + f23[0] * x[4 * i + 2] + f23[1] * x[4 * i + 3];
            }
            sacc = wave_allsum_fast(sacc);
            const int e = eb + r;
            if (lane == (e & 63)) { if (e < 64) myact0 = sacc; else myact1 = sacc; }
        }
    }
    coef[lane] = g0 * gelu_tanh(myact0 * ru0);
    coef[lane + 64] = g1 * gelu_tanh(myact1 * ru1);
    __builtin_amdgcn_wave_barrier();
    float acc[16];
#pragma unroll
    for (int i = 0; i < 16; i++) acc[i] = 0.f;
#pragma unroll 1
    for (int eb = 0; eb < 128; eb += 16) {
        u32x4 q[16];
#pragma unroll
        for (int r = 0; r < 16; r++) q[r] = *(const u32x4*)(vtab + (size_t)eid[eb + r] * 1024 + lane * 16);
#pragma unroll
        for (int r = 0; r < 16; r++) {
            const float cf = coef[eb + r];
#pragma unroll
            for (int i = 0; i < 4; i++) {
                const f32x2 f01 = __builtin_amdgcn_cvt_pk_f32_fp8((int)q[r][i], false);
                const f32x2 f23 = __builtin_amdgcn_cvt_pk_f32_fp8((int)q[r][i], true);
                acc[4 * i] += cf * f01[0]; acc[4 * i + 1] += cf * f01[1]; acc[4 * i + 2] += cf * f23[0]; acc[4 * i + 3] += cf * f23[1];
            }
        }
    }
    const float* m = modl + (size_t)tok_modrow(t) * 6144 + 5 * 1024 + lane * 16;
    float* xo = xrun + (size_t)t * DM + lane * 16;
    float ss = 0.f;
#pragma unroll
    for (int j = 0; j < 4; j++) {
        float4 xa = *(float4*)(xo + 4 * j);
        const float4 ma = *(const float4*)(m + 4 * j);
        xa.x += ma.x * acc[4 * j]; xa.y += ma.y * acc[4 * j + 1]; xa.z += ma.z * acc[4 * j + 2]; xa.w += ma.w * acc[4 * j + 3];
        *(float4*)(xo + 4 * j) = xa;
        acc[4 * j] = xa.x; acc[4 * j + 1] = xa.y; acc[4 * j + 2] = xa.z; acc[4 * j + 3] = xa.w;
        ss += xa.x * xa.x + xa.y * xa.y + xa.z * xa.z + xa.w * xa.w;
    }
    if (g_next != nullptr) {
        ss = wave_allsum_fast(ss);
        const float rstd = rsqrtf(ss * (1.f / DM) + 1e-6f);
        const float* mn = mod_next + (size_t)tok_modrow(t) * 6144 + lane * 16;
#pragma unroll
        for (int j = 0; j < 4; j++) {
            const float4 gg = *(const float4*)(g_next + lane * 16 + 4 * j);
            const float4 sh = *(const float4*)(mn + 4 * j);
            const float4 sc = *(const float4*)(mn + 1024 + 4 * j);
            *(ushort4*)(h_next + (size_t)t * DM + lane * 16 + 4 * j) =
                pack_bf4(acc[4 * j] * rstd * gg.x * (1.f + sc.x) + sh.x, acc[4 * j + 1] * rstd * gg.y * (1.f + sc.y) + sh.y,
                         acc[4 * j + 2] * rstd * gg.z * (1.f + sc.z) + sh.z, acc[4 * j + 3] * rstd * gg.w * (1.f + sc.w) + sh.w);
        }
    }
}

#define XB_TMO      128
#define XB_XCNT(j)  (256  + 64 * (j))
#define XB_XSUB(j)  (1280 + 64 * (j))
#define XB_XGEN(j)  (2304 + 64 * (j))
#define XB_TOP      3328
#define XB_TOPGEN   3392
#define XCD_BAR_WORDS 3456
#define XB_SPIN_CAP (1u << 22)
#define LAS __attribute__((address_space(3)))
__device__ __forceinline__ unsigned xb_ld(unsigned* p) { return __hip_atomic_load(p, __ATOMIC_RELAXED, __HIP_MEMORY_SCOPE_AGENT); }
__device__ __forceinline__ unsigned xb_add(unsigned* p, unsigned v) { return __hip_atomic_fetch_add(p, v, __ATOMIC_RELAXED, __HIP_MEMORY_SCOPE_AGENT); }
__device__ __forceinline__ unsigned xb_xcc_id() { return (unsigned)__builtin_amdgcn_s_getreg((3 << 11) | 20) & 0xFu; }
#define XB_SPIN(cond, bar) do { unsigned _sp = 0; while (cond) { __builtin_amdgcn_s_sleep(1); \
    if ((++_sp & 255u) == 0u) { if (xb_ld(&(bar)[XB_TMO])) break; if (_sp > XB_SPIN_CAP) { atomicAdd(&(bar)[XB_TMO], 1u); break; } } } } while (0)
struct XcdBarrier { unsigned* bar; unsigned x; volatile LAS unsigned* st; };
__device__ __forceinline__ XcdBarrier xcd_barrier_post(unsigned* bar, volatile LAS unsigned* st) {
    XcdBarrier b; b.bar = bar; b.x = xb_xcc_id(); b.st = st;
    if (threadIdx.x == 0) (void)xb_add(&bar[XB_XCNT(b.x)], 1u);
    return b;
}
__device__ __forceinline__ void xcd_barrier_complete(unsigned* bar, unsigned x, unsigned& nloc, unsigned& nx) {
    const unsigned G = gridDim.x * gridDim.y * gridDim.z;
    unsigned sum, cnt, mine, sp = 0u;
    for (;;) {
        sum = 0u; cnt = 0u; mine = 0u;
#pragma unroll
        for (unsigned j = 0; j < 16; ++j) { const unsigned c = xb_ld(&bar[XB_XCNT(j)]); sum += c; cnt += (c > 0u) ? 1u : 0u; mine = (j == x) ? c : mine; }
        if (sum == G) break;
        __builtin_amdgcn_s_sleep(1);
        if ((++sp & 255u) == 0u) { if (xb_ld(&bar[XB_TMO])) break; if (sp > XB_SPIN_CAP) { atomicAdd(&bar[XB_TMO], 1u); break; } }
    }
    nloc = mine > 0u ? mine : 1u; nx = cnt > 0u ? cnt : 1u;
}
__device__ __forceinline__ void xcd_barrier_(unsigned* bar_, char* smem_) {
    XcdBarrier b; b.bar = bar_; b.x = xb_xcc_id(); b.st = (volatile LAS unsigned*)(smem_ + GEMM_LDS_BYTES);
    asm volatile("s_waitcnt vmcnt(0)" ::: "memory");
    __syncthreads();
    if (threadIdx.x == 0) {
        unsigned* bar = b.bar;
        __builtin_amdgcn_s_waitcnt(0);
        unsigned nloc = b.st[0], nx = b.st[1];
        if (nloc == 0u) { xcd_barrier_complete(bar, b.x, nloc, nx); b.st[0] = nloc; b.st[1] = nx; }
        const unsigned old = xb_add(&bar[XB_XSUB(b.x)], 1u);
        const unsigned gen = old / nloc;
        if (old + 1u == (gen + 1u) * nloc) {
            __builtin_amdgcn_fence(__ATOMIC_RELEASE, "agent");
            asm volatile("s_waitcnt vmcnt(0)" ::: "memory");
            const unsigned og = xb_add(&bar[XB_TOP], 1u);
            const unsigned tg = og / nx;
            if (og + 1u == (tg + 1u) * nx) xb_add(&bar[XB_TOPGEN], 1u);
            else XB_SPIN(xb_ld(&bar[XB_TOPGEN]) == tg, bar);
            __builtin_amdgcn_fence(__ATOMIC_ACQUIRE, "agent");
            xb_add(&bar[XB_XGEN(b.x)], 1u);
            asm volatile("s_waitcnt vmcnt(0)" ::: "memory");
        } else {
            XB_SPIN(xb_ld(&bar[XB_XGEN(b.x)]) == gen, bar);
            __builtin_amdgcn_fence(__ATOMIC_ACQUIRE, "agent");
            asm volatile("s_waitcnt vmcnt(0)" ::: "memory");
        }
    }
    __syncthreads();
}

constexpr size_t ws_al(size_t x) { return (x + 255) & ~(size_t)255; }
struct WS {
    static constexpr size_t mod = 0;
    static constexpr size_t w_in_t = ws_al(mod + (size_t)(2*5*6144*4));
    static constexpr size_t w_out_t = ws_al(w_in_t + (size_t)(2304*1024*2));
    static constexpr size_t hy_w_in_t = ws_al(w_out_t + (size_t)(1024*1024*2));
    static constexpr size_t hy_w_out_t = ws_al(hy_w_in_t + (size_t)(3072*1024*2));
    static constexpr size_t w_q_t = ws_al(hy_w_out_t + (size_t)(1024*1024*2));
    static constexpr size_t q_up_t = ws_al(w_q_t + (size_t)(2*2048*1024*2));
    static constexpr size_t kv_up_t = ws_al(q_up_t + (size_t)(768*256*2));
    static constexpr size_t w2_t = ws_al(kv_up_t + (size_t)(1024*128*2));
    static constexpr size_t a2_t = ws_al(w2_t + (size_t)(2*512*64*2));
    static constexpr size_t g2_t = ws_al(a2_t + (size_t)(2*512*64*2));
    static constexpr size_t ctxb = ws_al(g2_t + (size_t)(512*128*2));
    static constexpr size_t keysb = ws_al(ctxb + (size_t)(1024*128*2));
    static constexpr size_t tabU = ws_al(keysb + (size_t)(2*16*128*128*2));
    static constexpr size_t tabV = ws_al(tabU + (size_t)(16384*1024));
    static constexpr size_t rsU = ws_al(tabV + (size_t)(16384*1024));
    static constexpr size_t rsV = ws_al(rsU + (size_t)(16384*4));
    static constexpr size_t nsum = ws_al(rsV + (size_t)(16384*4));
    static constexpr size_t gTS = ws_al(nsum + (size_t)(2*1024*4 + 3456*4 + 1024));
    static constexpr size_t gTP = ws_al(gTS + (size_t)1024*2*2048*2);
    static constexpr size_t R1 = ws_al(gTP + (size_t)1024*2*256*2);
    static constexpr size_t R2 = ws_al(R1 + (size_t)((size_t)TT*1024*4));
    static constexpr size_t rb = ws_al(R2 + (size_t)((size_t)TT*1792*2 + (size_t)TT*448*4));
    static constexpr size_t kb = ws_al(rb + (size_t)((size_t)TT*512*2));
    static constexpr size_t vb = ws_al(kb + (size_t)((size_t)TT*512*2));
    static constexpr size_t kkb = ws_al(vb + (size_t)((size_t)TT*512*2));
    static constexpr size_t lr0 = ws_al(kkb + (size_t)((size_t)TT*512*2));
    static constexpr size_t lr1 = ws_al(lr0 + (size_t)((size_t)TT*512*2));
    static constexpr size_t gateb = ws_al(lr1 + (size_t)((size_t)TT*512*2));
    static constexpr size_t du0 = ws_al(gateb + (size_t)((size_t)TT*512*2));
    static constexpr size_t du1 = ws_al(du0 + (size_t)((size_t)TT*512*2));
    static constexpr size_t twb = ws_al(du1 + (size_t)((size_t)TT*512*2));
    static constexpr size_t advb = ws_al(twb + (size_t)((size_t)TT*64*2));
    static constexpr size_t sgb = ws_al(advb + (size_t)((size_t)TT*64*2));
    static constexpr size_t bonus = ws_al(sgb + (size_t)((size_t)TT*128*2));
    static constexpr size_t kpe = ws_al(bonus + (size_t)((size_t)TT*8*4));
    static constexpr size_t qcnb = ws_al(kpe + (size_t)((size_t)TT*64*4));
    static constexpr size_t ckvb = ws_al(qcnb + (size_t)((size_t)TT*256*2));
    static constexpr size_t Qb = ws_al(ckvb + (size_t)((size_t)TT*128*2));
    static constexpr size_t Kp = ws_al(Qb + (size_t)((size_t)TT*768*2));
    static constexpr size_t Vp = ws_al(Kp + (size_t)(16*4*256*192*2));
    static constexpr size_t Ks = ws_al(Vp + (size_t)(16*4*256*128*2));
    static constexpr size_t Vs = ws_al(Ks + (size_t)(4*4*2304*192*2));
    static constexpr size_t kvctxb = ws_al(Vs + (size_t)(4*4*2304*128*2));
    static constexpr size_t pidx = ws_al(kvctxb + (size_t)(1024*1024*2));
    static constexpr size_t pg = ws_al(pidx + (size_t)((size_t)TT*128*4));
    static constexpr size_t END = ws_al(pg + (size_t)((size_t)TT*128*4));
    static constexpr size_t hb = R1;
    static constexpr size_t catb = R1;
    static constexpr size_t zbb = R1;
    static constexpr size_t kvrawb = R1;
    static constexpr size_t qrawb = R1 + (size_t)TT*1024*2;
    static constexpr size_t projrw = R2;
    static constexpr size_t projmla = R2 + (size_t)TT*1792*2;
    static constexpr size_t y0 = R2;
    static constexpr size_t y1 = R2 + (size_t)TT*512*4;
    static constexpr size_t qb = R2;
    static constexpr size_t scT = rb;
    static constexpr size_t pre = R2;
    static constexpr size_t zT = R2 + (size_t)TT*3072*2;
    static constexpr size_t x0b = R2 + (size_t)TT*3072*2 + (size_t)TT*1024*2;
    static constexpr size_t yT = R2 + (size_t)TT*3072*2 + (size_t)TT*1024*4;
    static constexpr size_t bar = nsum + 2*1024*4;
};
struct Params {
    const float* in[46];
    float* out;
    char* ws;
    __device__ __forceinline__ const float* x_prompt() const { return in[0]; }
    __device__ __forceinline__ const float* x_sample() const { return in[1]; }
    __device__ __forceinline__ const float* st_f() const { return in[2]; }
    __device__ __forceinline__ const float* st_b() const { return in[3]; }
    __device__ __forceinline__ const float* cache_ckv() const { return in[4]; }
    __device__ __forceinline__ const float* cache_kpe() const { return in[5]; }
    __device__ __forceinline__ const float* c() const { return in[6]; }
    __device__ __forceinline__ const float* c_ctx() const { return in[7]; }
    __device__ __forceinline__ const float* norm_g() const { return in[8]; }
    __device__ __forceinline__ const float* w_mod() const { return in[9]; }
    __device__ __forceinline__ const float* b_mod() const { return in[10]; }
    __device__ __forceinline__ const float* ab_w_in() const { return in[11]; }
    __device__ __forceinline__ const float* rw_mu() const { return in[12]; }
    __device__ __forceinline__ const float* rw_w0() const { return in[13]; }
    __device__ __forceinline__ const float* rw_w2() const { return in[14]; }
    __device__ __forceinline__ const float* rw_a0() const { return in[15]; }
    __device__ __forceinline__ const float* rw_a2() const { return in[16]; }
    __device__ __forceinline__ const float* rw_g2() const { return in[17]; }
    __device__ __forceinline__ const float* rw_k_k() const { return in[18]; }
    __device__ __forceinline__ const float* rw_k_a() const { return in[19]; }
    __device__ __forceinline__ const float* rw_r_k() const { return in[20]; }
    __device__ __forceinline__ const float* rw_lnx_g() const { return in[21]; }
    __device__ __forceinline__ const float* rw_lnx_b() const { return in[22]; }
    __device__ __forceinline__ const float* mla_q_norm() const { return in[23]; }
    __device__ __forceinline__ const float* mla_q_up() const { return in[24]; }
    __device__ __forceinline__ const float* mla_kv_norm() const { return in[25]; }
    __device__ __forceinline__ const float* mla_kv_up() const { return in[26]; }
    __device__ __forceinline__ const float* mla_qn() const { return in[27]; }
    __device__ __forceinline__ const float* mla_kn() const { return in[28]; }
    __device__ __forceinline__ const float* ab_w_out() const { return in[29]; }
    __device__ __forceinline__ const float* hy_w_in() const { return in[30]; }
    __device__ __forceinline__ const float* hy_b_in() const { return in[31]; }
    __device__ __forceinline__ const float* hy_conv_w() const { return in[32]; }
    __device__ __forceinline__ const float* hy_conv_b() const { return in[33]; }
    __device__ __forceinline__ const float* hy_f_w1() const { return in[34]; }
    __device__ __forceinline__ const float* hy_f_b1() const { return in[35]; }
    __device__ __forceinline__ const float* hy_f_w2() const { return in[36]; }
    __device__ __forceinline__ const float* hy_f_b2() const { return in[37]; }
    __device__ __forceinline__ const float* hy_f_w3() const { return in[38]; }
    __device__ __forceinline__ const float* hy_f_freq() const { return in[39]; }
    __device__ __forceinline__ const float* hy_bias() const { return in[40]; }
    __device__ __forceinline__ const float* hy_w_out() const { return in[41]; }
    __device__ __forceinline__ const float* peer_w_q() const { return in[42]; }
    __device__ __forceinline__ const float* peer_keys() const { return in[43]; }
    __device__ __forceinline__ const float* peer_u() const { return in[44]; }
    __device__ __forceinline__ const float* peer_v() const { return in[45]; }
    __device__ __forceinline__ float* xrun() const { return out + (0); }
    __device__ __forceinline__ float* out_sf() const { return out + ((size_t)TT*DM); }
    __device__ __forceinline__ float* out_sb() const { return out + ((size_t)TT*DM + 16*8*64*64); }
    __device__ __forceinline__ float* out_ckv() const { return out + ((size_t)TT*DM + 2*16*8*64*64); }
    __device__ __forceinline__ float* out_kpe() const { return out + ((size_t)TT*DM + 2*16*8*64*64 + 16*256*128); }
    __device__ __forceinline__ float* mod() const { return (float*)(ws + WS::mod); }
    __device__ __forceinline__ bf16_t* w_in_t() const { return (bf16_t*)(ws + WS::w_in_t); }
    __device__ __forceinline__ bf16_t* w_out_t() const { return (bf16_t*)(ws + WS::w_out_t); }
    __device__ __forceinline__ bf16_t* hy_w_in_t() const { return (bf16_t*)(ws + WS::hy_w_in_t); }
    __device__ __forceinline__ bf16_t* hy_w_out_t() const { return (bf16_t*)(ws + WS::hy_w_out_t); }
    __device__ __forceinline__ bf16_t* w_q_t() const { return (bf16_t*)(ws + WS::w_q_t); }
    __device__ __forceinline__ bf16_t* q_up_t() const { return (bf16_t*)(ws + WS::q_up_t); }
    __device__ __forceinline__ bf16_t* kv_up_t() const { return (bf16_t*)(ws + WS::kv_up_t); }
    __device__ __forceinline__ bf16_t* w2_t() const { return (bf16_t*)(ws + WS::w2_t); }
    __device__ __forceinline__ bf16_t* a2_t() const { return (bf16_t*)(ws + WS::a2_t); }
    __device__ __forceinline__ bf16_t* g2_t() const { return (bf16_t*)(ws + WS::g2_t); }
    __device__ __forceinline__ bf16_t* ctxb() const { return (bf16_t*)(ws + WS::ctxb); }
    __device__ __forceinline__ bf16_t* keysb() const { return (bf16_t*)(ws + WS::keysb); }
    __device__ __forceinline__ unsigned char* tabU() const { return (unsigned char*)(ws + WS::tabU); }
    __device__ __forceinline__ float* rsU() const { return (float*)(ws + WS::rsU); }
    __device__ __forceinline__ float* rsV() const { return (float*)(ws + WS::rsV); }
    __device__ __forceinline__ unsigned char* tabV() const { return (unsigned char*)(ws + WS::tabV); }
    __device__ __forceinline__ float* nsum() const { return (float*)(ws + WS::nsum); }
    __device__ __forceinline__ bf16_t* rb() const { return (bf16_t*)(ws + WS::rb); }
    __device__ __forceinline__ bf16_t* kb() const { return (bf16_t*)(ws + WS::kb); }
    __device__ __forceinline__ bf16_t* vb() const { return (bf16_t*)(ws + WS::vb); }
    __device__ __forceinline__ bf16_t* kkb() const { return (bf16_t*)(ws + WS::kkb); }
    __device__ __forceinline__ bf16_t* lr0() const { return (bf16_t*)(ws + WS::lr0); }
    __device__ __forceinline__ bf16_t* lr1() const { return (bf16_t*)(ws + WS::lr1); }
    __device__ __forceinline__ bf16_t* gateb() const { return (bf16_t*)(ws + WS::gateb); }
    __device__ __forceinline__ _Float16* du0() const { return (_Float16*)(ws + WS::du0); }
    __device__ __forceinline__ _Float16* du1() const { return (_Float16*)(ws + WS::du1); }
    __device__ __forceinline__ bf16_t* twb() const { return (bf16_t*)(ws + WS::twb); }
    __device__ __forceinline__ bf16_t* advb() const { return (bf16_t*)(ws + WS::advb); }
    __device__ __forceinline__ bf16_t* sgb() const { return (bf16_t*)(ws + WS::sgb); }
    __device__ __forceinline__ float* bonus() const { return (float*)(ws + WS::bonus); }
    __device__ __forceinline__ float* kpe() const { return (float*)(ws + WS::kpe); }
    __device__ __forceinline__ bf16_t* qcnb() const { return (bf16_t*)(ws + WS::qcnb); }
    __device__ __forceinline__ bf16_t* ckvb() const { return (bf16_t*)(ws + WS::ckvb); }
    __device__ __forceinline__ bf16_t* Qb() const { return (bf16_t*)(ws + WS::Qb); }
    __device__ __forceinline__ bf16_t* Kp() const { return (bf16_t*)(ws + WS::Kp); }
    __device__ __forceinline__ bf16_t* Vp() const { return (bf16_t*)(ws + WS::Vp); }
    __device__ __forceinline__ bf16_t* Ks() const { return (bf16_t*)(ws + WS::Ks); }
    __device__ __forceinline__ bf16_t* Vs() const { return (bf16_t*)(ws + WS::Vs); }
    __device__ __forceinline__ bf16_t* kvctxb() const { return (bf16_t*)(ws + WS::kvctxb); }
    __device__ __forceinline__ int* pidx() const { return (int*)(ws + WS::pidx); }
    __device__ __forceinline__ float* pg() const { return (float*)(ws + WS::pg); }
    __device__ __forceinline__ bf16_t* hb() const { return (bf16_t*)(ws + WS::hb); }
    __device__ __forceinline__ bf16_t* catb() const { return (bf16_t*)(ws + WS::catb); }
    __device__ __forceinline__ bf16_t* zbb() const { return (bf16_t*)(ws + WS::zbb); }
    __device__ __forceinline__ bf16_t* kvrawb() const { return (bf16_t*)(ws + WS::kvrawb); }
    __device__ __forceinline__ bf16_t* qrawb() const { return (bf16_t*)(ws + WS::qrawb); }
    __device__ __forceinline__ bf16_t* projrw() const { return (bf16_t*)(ws + WS::projrw); }
    __device__ __forceinline__ float* projmla() const { return (float*)(ws + WS::projmla); }
    __device__ __forceinline__ float* y0() const { return (float*)(ws + WS::y0); }
    __device__ __forceinline__ float* y1() const { return (float*)(ws + WS::y1); }
    __device__ __forceinline__ bf16_t* qb() const { return (bf16_t*)(ws + WS::qb); }
    __device__ __forceinline__ float* scT() const { return (float*)(ws + WS::scT); }
    __device__ __forceinline__ bf16_t* pre() const { return (bf16_t*)(ws + WS::pre); }
    __device__ __forceinline__ bf16_t* zT() const { return (bf16_t*)(ws + WS::zT); }
    __device__ __forceinline__ bf16_t* x0b() const { return (bf16_t*)(ws + WS::x0b); }
    __device__ __forceinline__ bf16_t* yT() const { return (bf16_t*)(ws + WS::yT); }
    __device__ __forceinline__ bf16_t* gTS() const { return (bf16_t*)(ws + WS::gTS); }
    __device__ __forceinline__ bf16_t* gTP() const { return (bf16_t*)(ws + WS::gTP); }
    __device__ __forceinline__ unsigned* bar() const { return (unsigned*)(ws + WS::bar); }
};

#define VLOOP(n) for (int vb = blockIdx.x; vb < (n); vb += gridDim.x)
#define ENDV __syncthreads();

#define QLOOP(ctr_word, nitems, ...)                                                            \
    {                                                                                           \
        unsigned* qctr = p.bar() + XCD_BAR_WORDS + 128 + (ctr_word);                            \
        volatile unsigned* bc = (volatile unsigned*)(smem + GEMM_LDS_BYTES + 8);                \
        for (;;) {                                                                              \
            if (threadIdx.x == 0) *bc = atomicAdd(qctr, 1u);                                    \
            __syncthreads();                                                                    \
            const int item = (int)*bc;                                                          \
            __syncthreads();                                                                    \
            if (item >= (nitems)) break;                                                        \
            __VA_ARGS__                                                                         \
        }                                                                                       \
    }
__device__ __forceinline__ void peer_layer(const Params& p, char* smem, int li, const float* modl, float* xrs) {
    const bf16_t* wq = p.w_q_t() + (size_t)li * 2048 * 1024;
    const bf16_t* kys = p.keysb() + (size_t)li * 16 * 128 * 128;
    VLOOP(TT / 8) { d_norm_mod2(vb, p.xrun(), xrs, p.norm_g() + (li * 2 + 1) * 1024, modl, 3, 4, p.hb()); }
    xcd_barrier_(p.bar(), smem);
    VLOOP(16 * 96) { d_gemm_bf16(vb % 16, vb / 16, smem, p.hb(), 1024, wq, 1024, 1024, 2048, EpiStoreBf{p.qb(), 2048, 0}); }
    xcd_barrier_(p.bar(), smem);
    VLOOP(8 * 96) { d_peer_route2(vb, smem, kys, p.qb(), p.pidx(), p.pg()); ENDV }
    if (li == 0) {
        QLOOP(4, 1536, {
            const int t1 = 48 * 16, t2 = t1 + 16 * 16;
            const float* W; bf16_t* Wt; int N, lv;
            if (item < t1) { W = p.hy_w_in(); Wt = p.hy_w_in_t(); N = 3072; lv = item; }
            else if (item < t2) { W = p.hy_w_out(); Wt = p.hy_w_out_t(); N = 1024; lv = item - t1; }
            else { W = p.peer_w_q() + (size_t)1024 * 2048; Wt = p.w_q_t() + (size_t)2048 * 1024; N = 2048; lv = item - t2; }
            d_transpose_w(lv, smem, W, 1024, N, Wt);
        })
    }
    xcd_barrier_(p.bar(), smem);
    VLOOP(TT / 4) { d_peer_apply3(vb, smem, p.hb(), p.pidx(), p.pg(), p.tabU(), p.tabV(), p.rsU(), p.rsV(), modl, p.xrun(),
                                    li == 0 ? p.norm_g() + 2048 : nullptr, p.mod() + 5 * 6144, p.hb()); ENDV }
}

__global__ void __launch_bounds__(256, 2) mega(Params p) {
    __shared__ __attribute__((aligned(16))) char smem[GEMM_LDS_BYTES + 16];
    cg::grid_group grid = cg::this_grid();
    if (threadIdx.x < 4) ((unsigned*)(smem + GEMM_LDS_BYTES))[threadIdx.x] = 0u;
    __syncthreads();
    (void)xcd_barrier_post(p.bar(), (volatile LAS unsigned*)(smem + GEMM_LDS_BYTES));
    const float* mod0 = p.mod();
    const float* mod1 = p.mod() + 5 * 6144;
    float* xrs = p.xrun() + (size_t)TP * DM;

    VLOOP(192) { d_mod3(vb, smem, p.c(), p.c_ctx(), p.w_mod(), p.b_mod(), p.mod()); ENDV }
    {
        const int j1 = 36 * 16;
        const int j7 = j1 + 12 * 4;
        const int j8 = j7 + 16 * 2;
        const int j9 = j8 + 8;
        const int j10 = j9 + 8;
        const int j11 = j10 + 8;
        const int j12 = j11 + 8;
        const int j13 = j12 + 8 * 2;
        VLOOP(j13) {
            const float* W; bf16_t* Wt; int K, N, lv;
            if (vb < j1) { W = p.ab_w_in(); Wt = p.w_in_t(); K = 1024; N = 2240; lv = vb; }
            else if (vb < j7) { W = p.mla_q_up(); Wt = p.q_up_t(); K = 256; N = 768; lv = vb - j1; }
            else if (vb < j8) { W = p.mla_kv_up(); Wt = p.kv_up_t(); K = 128; N = 1024; lv = vb - j7; }
            else if (vb < j9) { W = p.rw_w2(); Wt = p.w2_t(); K = 64; N = 512; lv = vb - j8; }
            else if (vb < j10) { W = p.rw_w2() + 64 * 512; Wt = p.w2_t() + 512 * 64; K = 64; N = 512; lv = vb - j9; }
            else if (vb < j11) { W = p.rw_a2(); Wt = p.a2_t(); K = 64; N = 512; lv = vb - j10; }
            else if (vb < j12) { W = p.rw_a2() + 64 * 512; Wt = p.a2_t() + 512 * 64; K = 64; N = 512; lv = vb - j11; }
            else { W = p.rw_g2(); Wt = p.g2_t(); K = 128; N = 512; lv = vb - j12; }
            d_transpose_w(lv, smem, W, K, N, Wt);
            ENDV }
    }
    VLOOP(40) { if (vb < 8) d_cvt_bf16(vb, p.cache_ckv(), p.ctxb()); else d_cvt_bf16(vb - 8, p.peer_keys(), p.keysb()); }
    if (p.ws == nullptr) grid.sync();
    xcd_barrier_(p.bar(), smem);
    VLOOP(TT / 8) { d_norm_mod2(vb, p.x_prompt(), p.x_sample(), p.norm_g(), mod0, 0, 1, p.hb()); }
    xcd_barrier_(p.bar(), smem);
    VLOOP(18 * 96) { d_gemm_bf16(vb % 18, vb / 18, smem, p.hb(), 1024, p.w_in_t(), 1024, 1024, ABIN, EpiProj{p.projrw(), p.projmla()}); }
    xcd_barrier_(p.bar(), smem);
    VLOOP(2688 + 768) {
        if (vb < 2688) d_rw_shift2(vb, p.projrw(), p.rw_mu(), p.rb(), p.kb(), p.vb(), p.twb(), p.advb(), p.sgb());
        else d_mla_pre2(vb - 2688, p.projmla(), p.mla_q_norm(), p.mla_kv_norm(), p.qcnb(), p.ckvb(), p.kpe(), p.out_ckv(), p.out_kpe());
    }
    xcd_barrier_(p.bar(), smem);
    {
        const int n0 = 4 * 96, n1 = 6 * 96, n2 = 8 * 96, n3 = 8 * 8;
        VLOOP(5 * n0 + n1 + n2 + n3) {
            int v = vb;
            if (v < n0) d_gemm_bf16(v % 4, v / 4, smem, p.twb(), 64, p.w2_t(), 64, 64, 512, EpiDecay{p.du0(), p.rw_w0()});
            else if ((v -= n0) < n0) d_gemm_bf16(v % 4, v / 4, smem, p.twb(), 64, p.w2_t() + 512 * 64, 64, 64, 512, EpiDecay{p.du1(), p.rw_w0() + 512});
            else if ((v -= n0) < n0) d_gemm_bf16(v % 4, v / 4, smem, p.advb(), 64, p.a2_t(), 64, 64, 512, EpiLr{p.lr0(), p.rw_a0()});
            else if ((v -= n0) < n0) d_gemm_bf16(v % 4, v / 4, smem, p.advb(), 64, p.a2_t() + 512 * 64, 64, 64, 512, EpiLr{p.lr1(), p.rw_a0() + 512});
            else if ((v -= n0) < n0) d_gemm_bf16(v % 4, v / 4, smem, p.sgb(), 128, p.g2_t(), 128, 128, 512, EpiStoreBf{p.gateb(), 512, 0});
            else if ((v -= n0) < n1) d_gemm_bf16(v % 6, v / 6, smem, p.qcnb(), 256, p.q_up_t(), 256, 256, 768, EpiStoreBf{p.qrawb(), 768, 0});
            else if ((v -= n1) < n2) d_gemm_bf16(v % 8, v / 8, smem, p.ckvb(), 128, p.kv_up_t(), 128, 128, 1024, EpiKV{p.kvrawb(), p.Vp(), p.Vs(), 0, 0});
            else { v -= n2; d_gemm_bf16(v % 8, v / 8, smem, p.ctxb(), 128, p.kv_up_t(), 128, 128, 1024, EpiKV{p.kvctxb(), p.Vp(), p.Vs(), 1, 0}); }
        }
    }
    xcd_barrier_(p.bar(), smem);
    VLOOP(384 + 3328) {
        if (vb < 384) d_rw_kk2(vb, smem, p.rb(), p.kb(), p.lr0(), p.lr1(), p.rw_k_k(), p.rw_k_a(), p.rw_r_k(), p.kkb(), p.bonus());
        else d_mla_post2(vb - 384, p.qrawb(), p.kvrawb(), p.kvctxb(), p.kpe(), p.cache_kpe(), p.mla_qn(), p.mla_kn(), p.Qb(), p.Kp(), p.Ks());
        ENDV }
    xcd_barrier_(p.bar(), smem);
    {
        const bool big = gridDim.x >= 512;
        const int stride = big ? (blockIdx.x < 256 ? (1 << 28) : (int)gridDim.x - 256) : (int)gridDim.x;
        if (big && blockIdx.x < 256) __builtin_amdgcn_s_setprio(3);
        for (int v = blockIdx.x; v < 256 + 1024; v += stride)
            d_scan2(v < 256 ? v : v - 256, v < 256, smem, p.rb(), p.kb(), p.vb(), p.kkb(), p.lr0(), p.lr1(), p.du0(), p.du1(), p.rw_k_a(), p.st_f(), p.st_b(), p.y0(), p.y1(), p.out_sf(), p.out_sb());
        __builtin_amdgcn_s_setprio(0);
    }
    QLOOP(0, 384, {
        const bool smp = item < 256;
        d_attn_mfma(smp ? item : item - 256, smem, p.Qb(), smp ? p.Ks() : p.Kp(), smp ? p.Vs() : p.Vp(), p.catb(), smp ? TP : 0, smp ? LS : LP,
                    smp ? 2304 : LP, smp ? 16 : 2);
    })
    QLOOP(2, 2048, {
        const bool isv = item >= 1024;
        d_cvt_fp8_rows(isv ? item - 1024 : item, isv ? p.peer_v() : p.peer_u(), isv ? p.tabV() : p.tabU(), isv ? p.rsV() : p.rsU());
    })
    QLOOP(3, 768, {
        const bool a_ = item < 256;
        d_transpose_w(a_ ? item : item - 256, smem, a_ ? p.ab_w_out() : p.peer_w_q(), 1024, a_ ? 1024 : 2048, a_ ? p.w_out_t() : p.w_q_t());
    })
    xcd_barrier_(p.bar(), smem);
    VLOOP(384) { d_rw_post2(vb, smem, p.y0(), p.y1(), p.bonus(), p.vb(), p.gateb(), p.rw_lnx_g(), p.rw_lnx_b(), p.catb()); ENDV }
    QLOOP(1, 576, {
        const bool smp = item < 512;
        d_hy_filt2(smp ? item : item - 512, smem, smp ? LS : LP, p.hy_f_w1(), p.hy_f_b1(), p.hy_f_w2(), p.hy_f_b2(), p.hy_f_w3(), p.hy_f_freq(),
                   smp ? p.gTS() : p.gTP(), smp ? p.nsum() : p.nsum() + 1024);
    })
    xcd_barrier_(p.bar(), smem);
    VLOOP(8 * 96) { d_gemm_bf16(vb % 8, vb / 8, smem, p.catb(), 1024, p.w_out_t(), 1024, 1024, 1024, EpiResid{p.x_prompt(), p.x_sample(), p.xrun(), mod0, 2, 0}); }
    xcd_barrier_(p.bar(), smem);
    peer_layer(p, smem, 0, mod0, xrs);
    xcd_barrier_(p.bar(), smem);
    VLOOP(24 * 96) { d_gemm_bf16(vb % 24, vb / 24, smem, p.hb(), 1024, p.hy_w_in_t(), 1024, 1024, 3072, EpiStoreBfBias{p.pre(), p.hy_b_in(), 3072, 0}); }
    VLOOP(2048) {
        const bool isv = vb >= 1024;
        d_cvt_fp8_rows(isv ? vb - 1024 : vb, (isv ? p.peer_v() : p.peer_u()) + (size_t)16384 * 1024, isv ? p.tabV() : p.tabU(), isv ? p.rsV() : p.rsU());
    }
    xcd_barrier_(p.bar(), smem);
    VLOOP(192 * 8) { d_hy_dw3(vb, smem, p.pre(), p.hy_conv_w(), p.hy_conv_b(), p.zT(), p.x0b()); ENDV }
    xcd_barrier_(p.bar(), smem);
    VLOOP(512 + 512) {
        const int wv = threadIdx.x >> 6;
        char* wsm = smem + (wv >> 1) * 28672;
        if (vb < 512) d_hy_conv2<true>(vb * 2 + (wv >> 1), wv & 1, wsm, p.gTS(), p.nsum(), p.zT(), p.hy_bias(), p.yT());
        else d_hy_conv2<false>((vb - 512) * 2 + (wv >> 1), wv & 1, wsm, p.gTP(), p.nsum() + 1024, p.zT(), p.hy_bias(), p.yT());
        ENDV }
    xcd_barrier_(p.bar(), smem);
    VLOOP(192 * 8) { d_hy_post2(vb, smem, p.yT(), p.x0b(), p.zbb()); ENDV }
    xcd_barrier_(p.bar(), smem);
    VLOOP(8 * 96) { d_gemm_bf16(vb % 8, vb / 8, smem, p.zbb(), 1024, p.hy_w_out_t(), 1024, 1024, 1024, EpiResid{p.xrun(), xrs, p.xrun(), mod1, 2, 0}); }
    xcd_barrier_(p.bar(), smem);
    peer_layer(p, smem, 1, mod1, xrs);
}

static inline size_t align_up(size_t x) { return (x + 255) & ~(size_t)255; }

extern "C" void kernel_launch(void* const* d_in, const int* in_sizes, int n_in, void* d_out, int out_size, void* d_ws, size_t ws_size,
                              hipStream_t stream) {
    Params p{};
    for (int i = 0; i < 46; i++) p.in[i] = (const float*)d_in[i];
    p.out = (float*)d_out;
    p.ws = (char*)d_ws;
    static_assert(WS::END <= (size_t)422781952, "workspace plan exceeds the guaranteed scratch size");
    static int grid_blocks = 0;
    if (!grid_blocks) {
        int dev = 0, cus = 0, per_cu = 0;
        (void)hipGetDevice(&dev);
        (void)hipDeviceGetAttribute(&cus, hipDeviceAttributeMultiprocessorCount, dev);
        (void)hipOccupancyMaxActiveBlocksPerMultiprocessor(&per_cu, mega, 256, 0);
        if (per_cu > 2) per_cu = 2;
        if (per_cu < 1) per_cu = 1;
        grid_blocks = cus * per_cu;
    }
    (void)hipMemsetAsync(p.ws + WS::nsum, 0, (size_t)2 * 1024 * 4 + (size_t)XCD_BAR_WORDS * 4 + 1024, stream);
    (void)hipMemsetAsync(p.ws + WS::mod, 0, (size_t)2 * 5 * 6144 * 4, stream);
    void* args[] = {&p};
    (void)hipLaunchCooperativeKernel((void*)mega, dim3(grid_blocks), dim3(256), args, 0, stream);
}
```

```cpp
#include <hip/hip_runtime.h>
#include <stdint.h>
#include <hip/hip_cooperative_groups.h>
namespace cg = cooperative_groups;

#define DM 1024
#define TP 4096
#define TS 8192
#define TT 12288
#define LP 256
#define LS 2048
#define NBP 16
#define NBS 4
#define ABIN 2240
#define RWIN 1792

typedef unsigned short bf16_t;
__device__ __forceinline__ bf16_t f2bf(float f) { unsigned u = __float_as_uint(f); u += 0x7fffu + ((u >> 16) & 1u); return (bf16_t)(u >> 16); }
__device__ __forceinline__ float bf2f(bf16_t h) { return __uint_as_float(((unsigned)h) << 16); }
__device__ __forceinline__ float sigmoidf_(float x) { return 1.f / (1.f + expf(-x)); }
__device__ __forceinline__ float gelu_tanh(float x) { return 0.5f * x * (1.f + tanhf(0.7978845608028654f * (x + 0.044715f * x * x * x))); }

__device__ __forceinline__ int tok_pos(int t) { return t < TP ? (t & (LP - 1)) : ((t - TP) & (LS - 1)); }
__device__ __forceinline__ int tok_len(int t) { return t < TP ? LP : LS; }
__device__ __forceinline__ int tok_modrow(int t) { return t < TP ? 0 : 1 + ((t - TP) >> 11); }

__device__ __forceinline__ float wave_sum(float v) {
#pragma unroll
    for (int o = 32; o > 0; o >>= 1) v += __shfl_xor(v, o, 64);
    return v;
}

__device__ __forceinline__ void d_mod(const int bx, const int by, const int bz, char* smem, const float* __restrict__ c, const float* __restrict__ c_ctx, const float* __restrict__ w_mod,
                                             const float* __restrict__ b_mod, float* __restrict__ mod) {
    float (*s)[1024] = (float(*)[1024])smem;
    const int li = by;
    const int n = bx * 256 + threadIdx.x;
    for (int i = threadIdx.x; i < 5 * 1024; i += 256) {
        int r = i >> 10, k = i & 1023;
        float v = (r == 0) ? c_ctx[k] : c[(r - 1) * 1024 + k];
        s[r][k] = v / (1.f + expf(-v));
    }
    __syncthreads();
    float a0 = 0, a1 = 0, a2 = 0, a3 = 0, a4 = 0;
    const float* w = w_mod + (size_t)li * 1024 * 6144 + n;
    for (int k = 0; k < 1024; k++) {
        float wv = w[(size_t)k * 6144];
        a0 += s[0][k] * wv; a1 += s[1][k] * wv; a2 += s[2][k] * wv; a3 += s[3][k] * wv; a4 += s[4][k] * wv;
    }
    float bb = b_mod[li * 6144 + n];
    float* o = mod + (size_t)li * 5 * 6144 + n;
    o[0 * 6144] = a0 + bb; o[1 * 6144] = a1 + bb; o[2 * 6144] = a2 + bb; o[3 * 6144] = a3 + bb; o[4 * 6144] = a4 + bb;
}


__device__ __forceinline__ void d_mod2(const int vb, char* smem, const float* __restrict__ c, const float* __restrict__ c_ctx,
                                       const float* __restrict__ w_mod, const float* __restrict__ b_mod, float* __restrict__ mod) {
    float* sl = (float*)smem;
    float* red = sl + 5 * 1024;
    const int li = vb / 96, n0 = (vb % 96) * 64;
    const int tid = threadIdx.x, col = tid & 63, kg = tid >> 6;
    for (int i = tid; i < 5 * 1024; i += 256) {
        const int r = i >> 10, k = i & 1023;
        const float v = (r == 0) ? c_ctx[k] : c[(r - 1) * 1024 + k];
        sl[i] = v / (1.f + __expf(-v));
    }
    __syncthreads();
    float a0 = 0, a1 = 0, a2 = 0, a3 = 0, a4 = 0;
    const float* w = w_mod + (size_t)li * 1024 * 6144 + (size_t)(kg * 256) * 6144 + n0 + col;
    const float* s0 = sl + kg * 256;
#pragma unroll 8
    for (int k = 0; k < 256; k++) {
        const float wv = w[(size_t)k * 6144];
        a0 += s0[k] * wv; a1 += s0[1024 + k] * wv; a2 += s0[2048 + k] * wv; a3 += s0[3072 + k] * wv; a4 += s0[4096 + k] * wv;
    }
    red[(kg * 5 + 0) * 64 + col] = a0; red[(kg * 5 + 1) * 64 + col] = a1; red[(kg * 5 + 2) * 64 + col] = a2;
    red[(kg * 5 + 3) * 64 + col] = a3; red[(kg * 5 + 4) * 64 + col] = a4;
    __syncthreads();
    for (int i = tid; i < 5 * 64; i += 256) {
        const int r = i >> 6, cc = i & 63;
        const float v = red[(0 * 5 + r) * 64 + cc] + red[(1 * 5 + r) * 64 + cc] + red[(2 * 5 + r) * 64 + cc] + red[(3 * 5 + r) * 64 + cc];
        mod[(size_t)(li * 5 + r) * 6144 + n0 + cc] = v + b_mod[li * 6144 + n0 + cc];
    }
}


__device__ __forceinline__ void d_mod3(const int vb, char* smem, const float* __restrict__ c, const float* __restrict__ c_ctx,
                                       const float* __restrict__ w_mod, const float* __restrict__ b_mod, float* __restrict__ mod) {
    float* sl = (float*)smem;
    const int li = vb / 96, kc = (vb % 96) / 6, cg6 = vb % 6;
    const int tid = threadIdx.x;
    for (int i = tid; i < 5 * 64; i += 256) {
        const int r = i >> 6, k = kc * 64 + (i & 63);
        const float v = (r == 0) ? c_ctx[k] : c[(r - 1) * 1024 + k];
        sl[i] = v / (1.f + __expf(-v));
    }
    __syncthreads();
    const int n = cg6 * 1024 + tid * 4;
    float4 a0 = {0, 0, 0, 0}, a1 = a0, a2 = a0, a3 = a0, a4 = a0;
    const float* w = w_mod + ((size_t)li * 1024 + kc * 64) * 6144 + n;
#pragma unroll 16
    for (int k = 0; k < 64; k++) {
        const float4 wv = *(const float4*)(w + (size_t)k * 6144);
        const float s0 = sl[k], s1 = sl[64 + k], s2 = sl[128 + k], s3 = sl[192 + k], s4 = sl[256 + k];
        a0.x += s0 * wv.x; a0.y += s0 * wv.y; a0.z += s0 * wv.z; a0.w += s0 * wv.w;
        a1.x += s1 * wv.x; a1.y += s1 * wv.y; a1.z += s1 * wv.z; a1.w += s1 * wv.w;
        a2.x += s2 * wv.x; a2.y += s2 * wv.y; a2.z += s2 * wv.z; a2.w += s2 * wv.w;
        a3.x += s3 * wv.x; a3.y += s3 * wv.y; a3.z += s3 * wv.z; a3.w += s3 * wv.w;
        a4.x += s4 * wv.x; a4.y += s4 * wv.y; a4.z += s4 * wv.z; a4.w += s4 * wv.w;
    }
    if (kc == 0) {
        const float4 bb = *(const float4*)(b_mod + li * 6144 + n);
        a0.x += bb.x; a0.y += bb.y; a0.z += bb.z; a0.w += bb.w; a1.x += bb.x; a1.y += bb.y; a1.z += bb.z; a1.w += bb.w;
        a2.x += bb.x; a2.y += bb.y; a2.z += bb.z; a2.w += bb.w; a3.x += bb.x; a3.y += bb.y; a3.z += bb.z; a3.w += bb.w;
        a4.x += bb.x; a4.y += bb.y; a4.z += bb.z; a4.w += bb.w;
    }
    float* o = mod + (size_t)(li * 5) * 6144 + n;
    atomicAdd(o + 0, a0.x); atomicAdd(o + 1, a0.y); atomicAdd(o + 2, a0.z); atomicAdd(o + 3, a0.w);
    atomicAdd(o + 6144 + 0, a1.x); atomicAdd(o + 6144 + 1, a1.y); atomicAdd(o + 6144 + 2, a1.z); atomicAdd(o + 6144 + 3, a1.w);
    atomicAdd(o + 2 * 6144 + 0, a2.x); atomicAdd(o + 2 * 6144 + 1, a2.y); atomicAdd(o + 2 * 6144 + 2, a2.z); atomicAdd(o + 2 * 6144 + 3, a2.w);
    atomicAdd(o + 3 * 6144 + 0, a3.x); atomicAdd(o + 3 * 6144 + 1, a3.y); atomicAdd(o + 3 * 6144 + 2, a3.z); atomicAdd(o + 3 * 6144 + 3, a3.w);
    atomicAdd(o + 4 * 6144 + 0, a4.x); atomicAdd(o + 4 * 6144 + 1, a4.y); atomicAdd(o + 4 * 6144 + 2, a4.z); atomicAdd(o + 4 * 6144 + 3, a4.w);
}

__device__ __forceinline__ void d_norm_mod(const int bx, const int by, const int bz, char* smem, const float* __restrict__ xa, const float* __restrict__ xb, const float* __restrict__ g,
                                                  const float* __restrict__ modl, int shift_idx, int scale_idx, bf16_t* __restrict__ h) {
    float* red = (float*)smem;
    const int t = bx;
    const float* x = (t < TP) ? (xa + (size_t)t * DM) : (xb + (size_t)(t - TP) * DM);
    const int c = threadIdx.x * 4;
    float4 v = *(const float4*)(x + c);
    float ss = v.x * v.x + v.y * v.y + v.z * v.z + v.w * v.w;
    ss = wave_sum(ss);
    if ((threadIdx.x & 63) == 0) red[threadIdx.x >> 6] = ss;
    __syncthreads();
    float tot = red[0] + red[1] + red[2] + red[3];
    float rstd = rsqrtf(tot * (1.f / DM) + 1e-6f);
    const float* m = modl + (size_t)tok_modrow(t) * 6144;
    float4 gg = *(const float4*)(g + c);
    float4 sh = *(const float4*)(m + shift_idx * 1024 + c);
    float4 sc = *(const float4*)(m + scale_idx * 1024 + c);
    float4 o;
    o.x = v.x * rstd * gg.x * (1.f + sc.x) + sh.x;
    o.y = v.y * rstd * gg.y * (1.f + sc.y) + sh.y;
    o.z = v.z * rstd * gg.z * (1.f + sc.z) + sh.z;
    o.w = v.w * rstd * gg.w * (1.f + sc.w) + sh.w;
    ushort4 ob; ob.x = f2bf(o.x); ob.y = f2bf(o.y); ob.z = f2bf(o.z); ob.w = f2bf(o.w);
    *(ushort4*)(h + (size_t)t * DM + c) = ob;
}

struct EpiStore { static constexpr bool kQuad = false; float* C; const float* bias; int ldc; int pad;
    __device__ void operator()(int m, int n, float a) const { C[(size_t)m * ldc + n] = a + (bias ? bias[n] : 0.f); } };
struct EpiStoreBfBias { static constexpr bool kQuad = false; bf16_t* C; const float* bias; int ldc; int pad;
    __device__ void operator()(int m, int n, float a) const { C[(size_t)m * ldc + n] = f2bf(a + bias[n]); } };
struct EpiStoreBf { static constexpr bool kQuad = false; bf16_t* C; int ldc; int pad;
    __device__ void operator()(int m, int n, float a) const { C[(size_t)m * ldc + n] = f2bf(a); } };
struct EpiDecay { static constexpr bool kQuad = false; _Float16* out; const float* w0;
    __device__ void operator()(int m, int n, float a) const { out[(size_t)m * 512 + n] = (_Float16)sigmoidf_(w0[n] + a); } };
struct EpiProj { static constexpr bool kQuad = false; bf16_t* rw; float* mla;
    __device__ void operator()(int m, int n, float a) const { if (n < RWIN) rw[(size_t)m * RWIN + n] = f2bf(a); else mla[(size_t)m * 448 + (n - RWIN)] = a; } };
struct EpiLr { static constexpr bool kQuad = false; bf16_t* out; const float* a0;
    __device__ void operator()(int m, int n, float a) const { out[(size_t)m * 512 + n] = f2bf(sigmoidf_(a0[n] + a)); } };
struct EpiResid { static constexpr bool kQuad = false; const float* xa; const float* xb; float* out; const float* modl; int gate_idx; int pad;
    __device__ void operator()(int m, int n, float a) const {
        float x = (m < TP) ? xa[(size_t)m * DM + n] : xb[(size_t)(m - TP) * DM + n];
        float gt = modl[(size_t)tok_modrow(m) * 6144 + gate_idx * 1024 + n];
        out[(size_t)m * DM + n] = x + gt * a; } };

struct EpiKV { static constexpr bool kQuad = true;
    bf16_t* kvraw; bf16_t* Vp; bf16_t* Vs; int ctx; int pad;
    __device__ void operator()(int m, int n, float a) const {}
    __device__ void quad(int row0, int col, float v0, float v1, float v2, float v3) const {
        const int hd = col >> 8, within = col & 255;
        if (within < 128) {
            bf16_t* d = kvraw + (size_t)row0 * 1024 + col;
            d[0] = f2bf(v0); d[1024] = f2bf(v1); d[2048] = f2bf(v2); d[3072] = f2bf(v3);
        } else {
            const int dv = within - 128;
            int b, kidx, Lk; bf16_t* base;
            if (ctx) { b = row0 >> 8; kidx = row0 & 255; Lk = 2304; base = Vs; }
            else if (row0 < TP) { b = row0 >> 8; kidx = row0 & 255; Lk = LP; base = Vp; }
            else { b = (row0 - TP) >> 11; kidx = 256 + ((row0 - TP) & 2047); Lk = 2304; base = Vs; }
            const int kpos = (kidx & ~12) | ((kidx & 8) >> 1) | ((kidx & 4) << 1);
            ushort4 o; o.x = f2bf(v0); o.y = f2bf(v1); o.z = f2bf(v2); o.w = f2bf(v3);
            *(ushort4*)(base + ((size_t)((b * 4 + hd) * 128 + dv)) * Lk + kpos) = o;
        }
    } };

template <class Epi>
__device__ __forceinline__ void d_gemm(const int bx, const int by, const int bz, char* smem, const float* __restrict__ A, int lda, const float* __restrict__ B, int ldb, int K, Epi epi) {
    float (*As)[68] = (float(*)[68])smem;
    float (*Bs)[68] = (float(*)[68])(smem + 16 * 68 * 4);
    const int m0 = by * 64, n0 = bx * 64;
    const int tid = threadIdx.x, tx = tid & 15, ty = tid >> 4;
    float acc[4][4];
#pragma unroll
    for (int i = 0; i < 4; i++)
#pragma unroll
        for (int j = 0; j < 4; j++) acc[i][j] = 0.f;
    for (int k0 = 0; k0 < K; k0 += 16) {
        {
            int r = tid >> 2, kq = (tid & 3) * 4;
            float4 v = *(const float4*)(A + (size_t)(m0 + r) * lda + k0 + kq);
            As[kq + 0][r] = v.x; As[kq + 1][r] = v.y; As[kq + 2][r] = v.z; As[kq + 3][r] = v.w;
        }
        {
            int kk = tid >> 4, nq = (tid & 15) * 4;
            float4 v = *(const float4*)(B + (size_t)(k0 + kk) * ldb + n0 + nq);
            *(float4*)&Bs[kk][nq] = v;
        }
        __syncthreads();
#pragma unroll
        for (int k = 0; k < 16; k++) {
            float a[4], b[4];
#pragma unroll
            for (int i = 0; i < 4; i++) a[i] = As[k][ty * 4 + i];
            float4 bv = *(const float4*)&Bs[k][tx * 4];
            b[0] = bv.x; b[1] = bv.y; b[2] = bv.z; b[3] = bv.w;
#pragma unroll
            for (int i = 0; i < 4; i++)
#pragma unroll
                for (int j = 0; j < 4; j++) acc[i][j] += a[i] * b[j];
        }
        __syncthreads();
    }
#pragma unroll
    for (int i = 0; i < 4; i++)
#pragma unroll
        for (int j = 0; j < 4; j++) epi(m0 + ty * 4 + i, n0 + tx * 4 + j, acc[i][j]);
}


typedef __attribute__((ext_vector_type(8))) short bf16x8;
typedef __attribute__((ext_vector_type(16))) float f32x16;
typedef __attribute__((ext_vector_type(4))) float f32x4;
typedef __attribute__((ext_vector_type(4))) unsigned u32x4;
#define GEMM_LDS_BYTES 73728

template <int NJ, class Epi>
__device__ __forceinline__ void d_gemm_bf16n(const int bx, const int by, char* smem, const bf16_t* __restrict__ A, int lda,
                                             const bf16_t* __restrict__ Bt, int ldb, int K, int N, Epi epi) {
    const int tid = threadIdx.x, lane = tid & 63, wid = tid >> 6;
    const int wm = wid >> 1, wn = wid & 1;
    const int m0 = by * 128, n0 = bx * (64 * NJ);
    f32x16 acc[2][NJ];
#pragma unroll
    for (int i = 0; i < 2; i++)
#pragma unroll
        for (int j = 0; j < NJ; j++)
#pragma unroll
            for (int r = 0; r < 16; r++) acc[i][j][r] = 0.f;
    const int lrow = tid >> 3, lcol = (tid & 7) * 8;
    const bf16_t* ga = A + (size_t)(m0 + lrow) * lda + lcol;
    const bf16_t* gb = Bt + (size_t)(n0 + lrow) * ldb + lcol;
    u32x4 raA[4], rbA[2 * NJ], raB[4], rbB[2 * NJ];
    const int KT = K >> 6;
    const int frow = lane & 31, fk = (lane >> 5) * 16;
#define GM_LOAD(RA_, RB_, kt_)                                                                                              \
    {                                                                                                                       \
        _Pragma("unroll") for (int i = 0; i < 4; i++) RA_[i] = *(const u32x4*)(ga + (size_t)(32 * i) * lda + (kt_) * 64);   \
        _Pragma("unroll") for (int i = 0; i < 2 * NJ; i++) RB_[i] = *(const u32x4*)(gb + (size_t)(32 * i) * ldb + (kt_) * 64); \
    }
#define GM_STORE(RA_, RB_, st_)                                                                                             \
    {                                                                                                                       \
        char* sn_ = smem + (st_) * 36864;                                                                                   \
        _Pragma("unroll") for (int i = 0; i < 4; i++) *(u32x4*)(sn_ + (lrow + 32 * i) * 144 + lcol * 2) = RA_[i];           \
        _Pragma("unroll") for (int i = 0; i < 2 * NJ; i++) *(u32x4*)(sn_ + 18432 + (lrow + 32 * i) * 144 + lcol * 2) = RB_[i]; \
    }
#define GM_COMPUTE(st_)                                                                                                     \
    {                                                                                                                       \
        const char* sa_ = smem + (st_) * 36864;                                                                             \
        const char* sb_ = sa_ + 18432;                                                                                      \
        _Pragma("unroll") for (int ks = 0; ks < 4; ks++) {                                                                  \
            bf16x8 af[2], bfr[NJ];                                                                                          \
            _Pragma("unroll") for (int i = 0; i < 2; i++) af[i] = *(const bf16x8*)(sa_ + (wm * 64 + i * 32 + frow) * 144 + ks * 32 + fk); \
            _Pragma("unroll") for (int j = 0; j < NJ; j++) bfr[j] = *(const bf16x8*)(sb_ + (wn * (32 * NJ) + j * 32 + frow) * 144 + ks * 32 + fk); \
            _Pragma("unroll") for (int i = 0; i < 2; i++)                                                                   \
                _Pragma("unroll") for (int j = 0; j < NJ; j++) acc[i][j] = __builtin_amdgcn_mfma_f32_32x32x16_bf16(af[i], bfr[j], acc[i][j], 0, 0, 0); \
        }                                                                                                                   \
    }
    GM_LOAD(raA, rbA, 0)
    GM_STORE(raA, rbA, 0)
    if (KT > 1) GM_LOAD(raA, rbA, 1)
    __syncthreads();
    for (int kt = 0; kt < KT; kt += 2) {
        if (kt + 2 < KT) GM_LOAD(raB, rbB, kt + 2)
        GM_COMPUTE(0)
        if (kt + 1 < KT) GM_STORE(raA, rbA, 1)
        __syncthreads();
        if (kt + 1 < KT) {
            if (kt + 3 < KT) GM_LOAD(raA, rbA, kt + 3)
            GM_COMPUTE(1)
            if (kt + 2 < KT) GM_STORE(raB, rbB, 0)
            __syncthreads();
        }
    }
#pragma unroll
    for (int i = 0; i < 2; i++)
#pragma unroll
        for (int j = 0; j < NJ; j++) {
            const int col = n0 + wn * (32 * NJ) + j * 32 + (lane & 31);
            if (col < N) {
                if constexpr (Epi::kQuad) {
#pragma unroll
                    for (int g = 0; g < 4; g++) {
                        const int row0 = m0 + wm * 64 + i * 32 + 8 * g + 4 * (lane >> 5);
                        epi.quad(row0, col, acc[i][j][4 * g], acc[i][j][4 * g + 1], acc[i][j][4 * g + 2], acc[i][j][4 * g + 3]);
                    }
                } else {
#pragma unroll
                    for (int r = 0; r < 16; r++) {
                        const int row = m0 + wm * 64 + i * 32 + (r & 3) + 8 * (r >> 2) + 4 * (lane >> 5);
                        epi(row, col, acc[i][j][r]);
                    }
                }
            }
        }
}
template <class Epi>
__device__ __forceinline__ void d_gemm_bf16(const int bx, const int by, char* smem, const bf16_t* __restrict__ A, int lda,
                                            const bf16_t* __restrict__ Bt, int ldb, int K, int N, Epi epi) {
    d_gemm_bf16n<2, Epi>(bx, by, smem, A, lda, Bt, ldb, K, N, epi);
}
__device__ __forceinline__ void d_transpose_w(const int vb, char* smem, const float* __restrict__ W, int K, int N, bf16_t* __restrict__ Wt) {
    float (*tile)[65] = (float(*)[65])smem;
    const int kt = K >> 6;
    const int nb = vb / kt, kb = vb % kt;
    const int tid = threadIdx.x;
    {
        const int n = nb * 64 + (tid & 63);
#pragma unroll
        for (int i = 0; i < 16; i++) {
            int k = (tid >> 6) + 4 * i;
            tile[k][tid & 63] = (n < N) ? W[(size_t)(kb * 64 + k) * N + n] : 0.f;
        }
    }
    __syncthreads();
    {
        const int k = tid & 63;
#pragma unroll
        for (int i = 0; i < 16; i++) {
            int n = (tid >> 6) + 4 * i;
            Wt[(size_t)(nb * 64 + n) * K + kb * 64 + k] = f2bf(tile[k][n]);
        }
    }
}

__device__ __forceinline__ void d_rw_shift(const int bx, const int by, const int bz, char* smem, const bf16_t* __restrict__ proj, const float* __restrict__ mu, bf16_t* __restrict__ rb,
                                                  bf16_t* __restrict__ kb, bf16_t* __restrict__ vb, bf16_t* __restrict__ tw, bf16_t* __restrict__ adv,
                                                  bf16_t* __restrict__ sg) {
    const int t = bx;
    const int pos = tok_pos(t), L = tok_len(t);
    const bf16_t* P = proj + (size_t)t * RWIN;
    for (int c = threadIdx.x; c < RWIN; c += 256) {
        float cur = bf2f(P[c]);
        float prev = (pos > 0) ? bf2f(P[c - RWIN]) : 0.f;
        float nxt = (pos < L - 1) ? bf2f(P[c + RWIN]) : 0.f;
        float val = cur + mu[c] * (0.5f * (prev + nxt) - cur);
        if (c < 512) rb[(size_t)t * 512 + c] = f2bf(val);
        else if (c < 1024) kb[(size_t)t * 512 + c - 512] = f2bf(val);
        else if (c < 1536) vb[(size_t)t * 512 + c - 1024] = f2bf(val);
        else if (c < 1600) tw[(size_t)t * 64 + c - 1536] = f2bf(tanhf(val));
        else if (c < 1664) adv[(size_t)t * 64 + c - 1600] = f2bf(val);
        else sg[(size_t)t * 128 + c - 1664] = f2bf(sigmoidf_(val));
    }
}

__device__ __forceinline__ void d_rw_kk(const int bx, const int by, const int bz, char* smem, const bf16_t* __restrict__ rb, const bf16_t* __restrict__ kb, const bf16_t* __restrict__ lr0,
                                               const bf16_t* __restrict__ lr1, const float* __restrict__ k_k, const float* __restrict__ k_a,
                                               const float* __restrict__ r_k, bf16_t* __restrict__ kkb, float* __restrict__ bonus) {
    const int w = bx * 4 + (threadIdx.x >> 6);
    const int lane = threadIdx.x & 63;
    const int t = w >> 3, h = w & 7;
    const size_t o = (size_t)t * 512 + h * 64 + lane;
    const int ch = h * 64 + lane;
    float k = bf2f(kb[o]), r = bf2f(rb[o]);
    float kk = k * k_k[ch];
    float nrm = sqrtf(wave_sum(kk * kk));
    kk = kk / fmaxf(nrm, 1e-12f);
    kkb[o] = f2bf(kk);
    float l0 = bf2f(lr0[o]), l1 = bf2f(lr1[o]);
    float ka = k_a[ch];
    float kd0 = k * (1.f + (l0 - 1.f) * ka), kd1 = k * (1.f + (l1 - 1.f) * ka);
    float s = wave_sum(r * (kd0 + kd1) * r_k[ch]);
    if (lane == 0) bonus[w] = s;
}

__device__ __forceinline__ void d_scan(const int bx, const int by, const int bz, char* smem, const bf16_t* __restrict__ rb, const bf16_t* __restrict__ kb, const bf16_t* __restrict__ vb,
                                             const bf16_t* __restrict__ kkb, const bf16_t* __restrict__ lr0, const bf16_t* __restrict__ lr1,
                                             const _Float16* __restrict__ dec0, const _Float16* __restrict__ dec1, const float* __restrict__ k_a,
                                             const float* __restrict__ st_f, const float* __restrict__ st_b, float* __restrict__ y0,
                                             float* __restrict__ y1, float* __restrict__ out_sf, float* __restrict__ out_sb) {
    float* sbase = (float*)smem + (threadIdx.x >> 6) * 320;
    float* sa_ = sbase; float* sw_ = sbase + 64; float* sb_ = sbase + 128; float* skd_ = sbase + 192; float* sr_ = sbase + 256;
    int id = bx * 4 + (threadIdx.x >> 6);
    int d, h, b, L, tbase;
    bool prompt = id < 256;
    if (prompt) { d = id & 1; h = (id >> 1) & 7; b = id >> 4; L = LP; tbase = b * LP; }
    else { int j = id - 256; d = j & 1; h = (j >> 1) & 7; b = j >> 4; L = LS; tbase = TP + b * LS; }
    const int v = threadIdx.x & 63;
    const bf16_t* lr = d ? lr1 : lr0;
    const _Float16* dec = d ? dec1 : dec0;
    float* yo = d ? y1 : y0;
    const float ka = k_a[h * 64 + v];
    float S[64];
    if (prompt) {
#pragma unroll
        for (int k = 0; k < 64; k++) S[k] = 0.f;
    } else {
        const float* st = (d ? st_b : st_f) + ((size_t)(b * 8 + h) * 64 + v) * 64;
#pragma unroll
        for (int k = 0; k < 64; k += 4) { float4 q = *(const float4*)(st + k); S[k] = q.x; S[k + 1] = q.y; S[k + 2] = q.z; S[k + 3] = q.w; }
    }
    for (int i = 0; i < L; i++) {
        const int t = tbase + (d ? (L - 1 - i) : i);
        const size_t o = (size_t)t * 512 + h * 64 + v;
        float kkv = bf2f(kkb[o]), lrv = bf2f(lr[o]), kv = bf2f(kb[o]), rv = bf2f(rb[o]), vv = bf2f(vb[o]), wv = __expf(-0.6065306597126334f * (float)dec[o]);
        __builtin_amdgcn_wave_barrier();
        sa_[v] = -kkv; sb_[v] = kkv * lrv; skd_[v] = kv * (1.f + (lrv - 1.f) * ka); sw_[v] = wv; sr_[v] = rv;
        __builtin_amdgcn_wave_barrier();
        float sa = 0.f;
#pragma unroll
        for (int k = 0; k < 64; k += 4) { float4 a = *(const float4*)&sa_[k]; sa += S[k] * a.x + S[k + 1] * a.y + S[k + 2] * a.z + S[k + 3] * a.w; }
        float y = 0.f;
#pragma unroll
        for (int k = 0; k < 64; k += 4) {
            float4 w4 = *(const float4*)&sw_[k]; float4 b4 = *(const float4*)&sb_[k]; float4 k4 = *(const float4*)&skd_[k]; float4 r4 = *(const float4*)&sr_[k];
            S[k] = S[k] * w4.x + sa * b4.x + vv * k4.x; y += S[k] * r4.x;
            S[k + 1] = S[k + 1] * w4.y + sa * b4.y + vv * k4.y; y += S[k + 1] * r4.y;
            S[k + 2] = S[k + 2] * w4.z + sa * b4.z + vv * k4.z; y += S[k + 2] * r4.z;
            S[k + 3] = S[k + 3] * w4.w + sa * b4.w + vv * k4.w; y += S[k + 3] * r4.w;
        }
        yo[o] = y;
    }
    if (prompt) {
        float* os = (d ? out_sb : out_sf) + ((size_t)(b * 8 + h) * 64 + v) * 64;
#pragma unroll
        for (int k = 0; k < 64; k += 4) *(float4*)(os + k) = make_float4(S[k], S[k + 1], S[k + 2], S[k + 3]);
    }
}


#define SC_STEP 336
template <int CTRL>
__device__ __forceinline__ float dpp_add(float v) {
    return v + __int_as_float(__builtin_amdgcn_update_dpp(0, __float_as_int(v), CTRL, 0xf, 0xf, false));
}
__device__ __forceinline__ float row16_allsum(float v) {
    v = dpp_add<0x128>(v); v = dpp_add<0x124>(v); v = dpp_add<0x122>(v); v = dpp_add<0x121>(v);
    return v;
}
__device__ __forceinline__ void d_scan2(const int item, const bool sample, char* smem, const bf16_t* __restrict__ rb, const bf16_t* __restrict__ kb,
                                        const bf16_t* __restrict__ vb, const bf16_t* __restrict__ kkb, const bf16_t* __restrict__ lr0,
                                        const bf16_t* __restrict__ lr1, const _Float16* __restrict__ du0, const _Float16* __restrict__ du1,
                                        const float* __restrict__ k_a, const float* __restrict__ st_f, const float* __restrict__ st_b,
                                        float* __restrict__ y0, float* __restrict__ y1, float* __restrict__ out_sf, float* __restrict__ out_sb) {
    const int chain = item >> 2, qd = item & 3;
    const int d = chain & 1, h = (chain >> 1) & 7, b = chain >> 4;
    const int L = sample ? LS : LP;
    const int tbase = sample ? (TP + b * LS) : (b * LP);
    const int tid = threadIdx.x, wid = tid >> 6, lane = tid & 63;
    const int rr = lane >> 4, pp = lane & 15;
    const int row = qd * 16 + wid * 4 + rr;
    const bf16_t* lr = d ? lr1 : lr0;
    const _Float16* du = d ? du1 : du0;
    float* yo = d ? y1 : y0;
    float S0, S1, S2, S3;
    if (sample) {
        const float4 s4 = *(const float4*)((d ? st_b : st_f) + ((size_t)(b * 8 + h) * 64 + row) * 64 + pp * 4);
        S0 = s4.x; S1 = s4.y; S2 = s4.z; S3 = s4.w;
    } else { S0 = S1 = S2 = S3 = 0.f; }
    const int sk = tid & 63, ss = tid >> 6;
    const float ka = k_a[h * 64 + sk];
    const size_t colk = (size_t)h * 64 + sk;
    const size_t colv = (size_t)h * 64 + qd * 16 + (tid & 15);
    float* buf = (float*)smem;
    unsigned gA_kk[4], gA_lr[4], gA_k[4], gA_r[4], gA_u[4], gA_v;
    unsigned gB_kk[4], gB_lr[4], gB_k[4], gB_r[4], gB_u[4], gB_v;
    const int nch = L >> 4;
#define SC_GLOAD(X, c)                                                                                     \
    {                                                                                                      \
        _Pragma("unroll") for (int j = 0; j < 4; j++) {                                                    \
            const int i = (c) * 16 + ss + 4 * j;                                                           \
            const size_t o = (size_t)(tbase + (d ? (L - 1 - i) : i)) * 512 + colk;                         \
            X##_kk[j] = kkb[o]; X##_lr[j] = lr[o]; X##_k[j] = kb[o]; X##_r[j] = rb[o]; X##_u[j] = ((const unsigned short*)du)[o]; \
        }                                                                                                  \
        { const int i = (c) * 16 + (tid >> 4); X##_v = vb[(size_t)(tbase + (d ? (L - 1 - i) : i)) * 512 + colv]; } \
    }
#define SC_SSTORE(X, bi)                                                                                   \
    {                                                                                                      \
        float* B_ = buf + (bi) * 16 * SC_STEP;                                                             \
        _Pragma("unroll") for (int j = 0; j < 4; j++) {                                                    \
            float* st_ = B_ + (ss + 4 * j) * SC_STEP + sk;                                                 \
            const float kkv = __uint_as_float(X##_kk[j] << 16), lrv = __uint_as_float(X##_lr[j] << 16), kv = __uint_as_float(X##_k[j] << 16); \
            st_[0] = -kkv; st_[64] = __expf(-0.6065306597126334f * (float)__builtin_bit_cast(_Float16, (unsigned short)X##_u[j])); st_[128] = kkv * lrv;   \
            st_[192] = kv * (1.f + (lrv - 1.f) * ka); st_[256] = __uint_as_float(X##_r[j] << 16);          \
        }                                                                                                  \
        B_[(tid >> 4) * SC_STEP + 320 + (tid & 15)] = __uint_as_float(X##_v << 16);                        \
    }
#define SC_COMPUTE(c)                                                                                      \
    {                                                                                                      \
        const float* B_ = buf + ((c) & 1) * 16 * SC_STEP;                                                  \
        float ysave = 0.f;                                                                                 \
        _Pragma("unroll 4") for (int s_ = 0; s_ < 16; s_++) {                                              \
            const float* st_ = B_ + s_ * SC_STEP;                                                          \
            const float4 a4 = *(const float4*)(st_ + pp * 4);                                              \
            const float4 w4 = *(const float4*)(st_ + 64 + pp * 4);                                         \
            const float4 b4 = *(const float4*)(st_ + 128 + pp * 4);                                        \
            const float4 k4 = *(const float4*)(st_ + 192 + pp * 4);                                        \
            const float4 r4 = *(const float4*)(st_ + 256 + pp * 4);                                        \
            const float vv = st_[320 + wid * 4 + rr];                                                      \
            float sa = (S0 * a4.x + S1 * a4.y) + (S2 * a4.z + S3 * a4.w);                                  \
            const float p0 = S0 * w4.x + vv * k4.x, p1 = S1 * w4.y + vv * k4.y, p2 = S2 * w4.z + vv * k4.z, p3 = S3 * w4.w + vv * k4.w; \
            sa = row16_allsum(sa);                                                                         \
            S0 = sa * b4.x + p0; S1 = sa * b4.y + p1; S2 = sa * b4.z + p2; S3 = sa * b4.w + p3;            \
            float y = (S0 * r4.x + S1 * r4.y) + (S2 * r4.z + S3 * r4.w);                                   \
            y = row16_allsum(y);                                                                           \
            ysave = (pp == s_) ? y : ysave;                                                                \
        }                                                                                                  \
        { const int i = (c) * 16 + pp; yo[(size_t)(tbase + (d ? (L - 1 - i) : i)) * 512 + h * 64 + row] = ysave; } \
    }
    SC_GLOAD(gA, 0)
    SC_SSTORE(gA, 0)
    if (nch > 1) SC_GLOAD(gA, 1)
    __syncthreads();
    for (int c = 0; c < nch; c += 2) {
        if (c + 2 < nch) SC_GLOAD(gB, c + 2)
        __builtin_amdgcn_sched_barrier(0);
        SC_COMPUTE(c)
        __builtin_amdgcn_sched_barrier(0);
        SC_SSTORE(gA, 1)
        __syncthreads();
        if (c + 3 < nch) SC_GLOAD(gA, c + 3)
        __builtin_amdgcn_sched_barrier(0);
        SC_COMPUTE(c + 1)
        __builtin_amdgcn_sched_barrier(0);
        if (c + 2 < nch) SC_SSTORE(gB, 0)
        __syncthreads();
    }
    if (!sample) {
        float* os = (d ? out_sb : out_sf) + ((size_t)(b * 8 + h) * 64 + row) * 64 + pp * 4;
        *(float4*)os = make_float4(S0, S1, S2, S3);
    }
}

__device__ __forceinline__ void d_rw_post(const int bx, const int by, const int bz, char* smem, const float* __restrict__ y0, const float* __restrict__ y1, const float* __restrict__ bonus,
                                                 const bf16_t* __restrict__ vb, const bf16_t* __restrict__ gate, const float* __restrict__ lnx_g,
                                                 const float* __restrict__ lnx_b, bf16_t* __restrict__ cat) {
    const int w = bx * 4 + (threadIdx.x >> 6);
    const int lane = threadIdx.x & 63;
    const int t = w >> 3, h = w & 7;
    const size_t o = (size_t)t * 512 + h * 64 + lane;
    const int ch = h * 64 + lane;
    float y = y0[o] + y1[o];
    float mean = wave_sum(y) * (1.f / 64.f);
    float dlt = y - mean;
    float var = wave_sum(dlt * dlt) * (1.f / 64.f);
    float yn = dlt * rsqrtf(var + 64e-5f) * lnx_g[ch] + lnx_b[ch];
    float val = (yn + bonus[w] * bf2f(vb[o])) * bf2f(gate[o]);
    cat[(size_t)t * DM + ch] = f2bf(val);
}

__device__ __forceinline__ void d_mla_pre(const int bx, const int by, const int bz, char* smem, const float* __restrict__ proj, const float* __restrict__ q_norm, const float* __restrict__ kv_norm,
                                                 bf16_t* __restrict__ qcn, bf16_t* __restrict__ ckv, float* __restrict__ kpe,
                                                 float* __restrict__ out_ckv, float* __restrict__ out_kpe) {
    float* red = (float*)smem; float* red2 = red + 4;
    const int t = bx;
    const int tid = threadIdx.x;
    const float* P = proj + (size_t)t * 448;
    float q = P[tid];
    float kv = (tid < 128) ? P[256 + tid] : 0.f;
    float ss = wave_sum(q * q);
    float s2 = wave_sum(kv * kv);
    if ((tid & 63) == 0) { red[tid >> 6] = ss; red2[tid >> 6] = s2; }
    __syncthreads();
    float rq = rsqrtf((red[0] + red[1] + red[2] + red[3]) * (1.f / 256.f) + 1e-6f);
    float rk = rsqrtf((red2[0] + red2[1] + red2[2] + red2[3]) * (1.f / 128.f) + 1e-6f);
    qcn[(size_t)t * 256 + tid] = f2bf(q * rq * q_norm[tid]);
    if (tid < 128) {
        float val = kv * rk * kv_norm[tid];
        ckv[(size_t)t * 128 + tid] = f2bf(val);
        if (t < TP) out_ckv[(size_t)t * 128 + tid] = val;
    } else if (tid < 192) {
        float pe = P[384 + tid - 128];
        kpe[(size_t)t * 64 + tid - 128] = pe;
        if (t < TP) out_kpe[(size_t)t * 64 + tid - 128] = pe;
    }
}

__device__ __forceinline__ void d_mla_post(const int bx, const int by, const int bz, char* smem, const bf16_t* __restrict__ qraw, const bf16_t* __restrict__ kvraw, const bf16_t* __restrict__ kvraw_ctx,
                                                  const float* __restrict__ kpe, const float* __restrict__ cache_kpe, const float* __restrict__ qn,
                                                  const float* __restrict__ kn, bf16_t* __restrict__ Qb, bf16_t* __restrict__ Kp, bf16_t* __restrict__ Vp,
                                                  bf16_t* __restrict__ Ks, bf16_t* __restrict__ Vs) {
    float (*sq)[192] = (float(*)[192])smem; float (*sk)[192] = (float(*)[192])(smem + 4 * 192 * 4);
    const int wi = threadIdx.x >> 6, lane = threadIdx.x & 63;
    const int row = bx, h = wi;
    const bool isctx = row >= TT;
    const bool sample = row >= TP;
    float kx[3], qx[3] = {0.f, 0.f, 0.f};
    const bf16_t* kvr; const float* pe; int pos = 0;
    if (isctx) { int cr = row - TT; kvr = kvraw_ctx + (size_t)cr * 1024; pe = cache_kpe + (size_t)cr * 64; }
    else { kvr = kvraw + (size_t)row * 1024; pe = kpe + (size_t)row * 64; pos = tok_pos(row); }
#pragma unroll
    for (int j = 0; j < 3; j++) {
        int i = lane + 64 * j;
        kx[j] = (i < 128) ? bf2f(kvr[h * 256 + i]) : pe[i - 128];
        if (!isctx) qx[j] = bf2f(qraw[(size_t)row * 768 + h * 192 + i]);
    }
    float ssk = wave_sum(kx[0] * kx[0] + kx[1] * kx[1] + kx[2] * kx[2]);
    float ssq = wave_sum(qx[0] * qx[0] + qx[1] * qx[1] + qx[2] * qx[2]);
    float rk = rsqrtf(ssk * (1.f / 192.f) + 1e-6f), rq = rsqrtf(ssq * (1.f / 192.f) + 1e-6f);
#pragma unroll
    for (int j = 0; j < 3; j++) {
        int i = lane + 64 * j;
        sk[wi][i] = kx[j] * rk * kn[i];
        sq[wi][i] = qx[j] * rq * qn[i];
    }
    __syncthreads();
    if (sample && !isctx && lane < 32) {
        int rowi = pos >> 6, coli = pos & 63;
        int fi = lane & 15;
        float inv = expf(-(float)fi * (1.f / 16.f) * 9.210340371976184f);
        float ang = (lane < 16 ? (float)rowi : (float)coli) * inv;
        float cs = cosf(ang), sn = sinf(ang);
        float a = sk[wi][128 + 2 * lane], bq = sk[wi][128 + 2 * lane + 1];
        sk[wi][128 + 2 * lane] = a * cs - bq * sn; sk[wi][128 + 2 * lane + 1] = a * sn + bq * cs;
        a = sq[wi][128 + 2 * lane]; bq = sq[wi][128 + 2 * lane + 1];
        sq[wi][128 + 2 * lane] = a * cs - bq * sn; sq[wi][128 + 2 * lane + 1] = a * sn + bq * cs;
    }
    __syncthreads();
    bf16_t* kd; bf16_t* vd; int vLk, kidx;
    if (!sample) { int b = row >> 8, p = row & 255; kd = Kp + ((size_t)(b * 4 + h) * LP + p) * 192; vd = Vp + (size_t)(b * 4 + h) * 128 * LP; vLk = LP; kidx = p; }
    else if (!isctx) { int b = (row - TP) >> 11, p = (row - TP) & 2047; kd = Ks + ((size_t)(b * 4 + h) * 2304 + 256 + p) * 192; vd = Vs + (size_t)(b * 4 + h) * 128 * 2304; vLk = 2304; kidx = 256 + p; }
    else { int cr = row - TT; int b = cr >> 8, p = cr & 255; kd = Ks + ((size_t)(b * 4 + h) * 2304 + p) * 192; vd = Vs + (size_t)(b * 4 + h) * 128 * 2304; vLk = 2304; kidx = p; }
    const int kpos = (kidx & ~12) | ((kidx & 8) >> 1) | ((kidx & 4) << 1);
#pragma unroll
    for (int j = 0; j < 3; j++) {
        int i = lane + 64 * j;
        kd[i] = f2bf(sk[wi][i]);
        if (!isctx) Qb[((size_t)row * 4 + h) * 192 + i] = f2bf(sq[wi][i]);
    }
    vd[(size_t)lane * vLk + kpos] = kvr[h * 256 + 128 + lane];
    vd[(size_t)(lane + 64) * vLk + kpos] = kvr[h * 256 + 128 + lane + 64];
}

__device__ __forceinline__ void d_attn(const int bx, const int by, const int bz, char* smem, const bf16_t* __restrict__ Qb, const bf16_t* __restrict__ Kall, const bf16_t* __restrict__ Vall,
                                              bf16_t* __restrict__ cat, int tbase, int Lq, int Lk) {
    float (*Vsm)[128] = (float(*)[128])smem;
    float (*Qs)[192] = (float(*)[192])(smem + 32 * 128 * 4);
    float (*Ksm)[193] = (float(*)[193])(smem + 32 * 128 * 4 + 16 * 192 * 4);
    float (*Ss)[33] = (float(*)[33])(smem + 32 * 128 * 4 + 16 * 192 * 4 + 32 * 193 * 4);
    const int q0 = bx * 16, h = by, b = bz;
    const int tid = threadIdx.x;
    const int qi = tid >> 4, sub = tid & 15;
    const bf16_t* K = Kall + (size_t)(b * 4 + h) * Lk * 192;
    const bf16_t* V = Vall + (size_t)(b * 4 + h) * Lk * 128;
    for (int i = tid; i < 16 * 192; i += 256) {
        int r = i / 192, c = i % 192;
        int t = tbase + b * Lq + q0 + r;
        Qs[r][c] = bf2f(Qb[((size_t)t * 4 + h) * 192 + c]);
    }
    float m = -1e30f, l = 0.f;
    float acc[8];
#pragma unroll
    for (int j = 0; j < 8; j++) acc[j] = 0.f;
    const float scale = 0.07216878364870322f;
    for (int k0 = 0; k0 < Lk; k0 += 32) {
        __syncthreads();
        for (int i = tid; i < 32 * 192; i += 256) { int r = i / 192, c = i % 192; Ksm[r][c] = bf2f(K[(size_t)(k0 + r) * 192 + c]); }
        for (int i = tid; i < 32 * 128; i += 256) { int r = i >> 7, c = i & 127; Vsm[r][c] = bf2f(V[(size_t)(k0 + r) * 128 + c]); }
        __syncthreads();
        float s0 = 0.f, s1 = 0.f;
        for (int dd = 0; dd < 192; dd++) { float qv = Qs[qi][dd]; s0 += qv * Ksm[sub][dd]; s1 += qv * Ksm[sub + 16][dd]; }
        s0 *= scale; s1 *= scale;
        float mx = fmaxf(s0, s1);
#pragma unroll
        for (int o = 8; o > 0; o >>= 1) mx = fmaxf(mx, __shfl_xor(mx, o, 64));
        float mn = fmaxf(m, mx);
        float alpha = expf(m - mn);
        float p0 = expf(s0 - mn), p1 = expf(s1 - mn);
        float ps = p0 + p1;
#pragma unroll
        for (int o = 8; o > 0; o >>= 1) ps += __shfl_xor(ps, o, 64);
        l = l * alpha + ps; m = mn;
        Ss[qi][sub] = p0; Ss[qi][sub + 16] = p1;
        __syncthreads();
#pragma unroll
        for (int j = 0; j < 8; j++) acc[j] *= alpha;
        for (int kk = 0; kk < 32; kk++) {
            float p = Ss[qi][kk];
            float4 v0 = *(const float4*)&Vsm[kk][sub * 8], v1 = *(const float4*)&Vsm[kk][sub * 8 + 4];
            acc[0] += p * v0.x; acc[1] += p * v0.y; acc[2] += p * v0.z; acc[3] += p * v0.w;
            acc[4] += p * v1.x; acc[5] += p * v1.y; acc[6] += p * v1.z; acc[7] += p * v1.w;
        }
    }
    const int t = tbase + b * Lq + q0 + qi;
    float il = 1.f / l;
    bf16_t* o = cat + (size_t)t * DM + 512 + h * 128 + sub * 8;
#pragma unroll
    for (int j = 0; j < 8; j++) o[j] = f2bf(acc[j] * il);
}


#define ATT_SV_OFF 25600
#define ATT_SQ_OFF 44032
__device__ __forceinline__ void d_attn_mfma(const int item, char* smem, const bf16_t* __restrict__ Qb, const bf16_t* __restrict__ Kall,
                                            const bf16_t* __restrict__ VtAll, bf16_t* __restrict__ cat, int tbase, int Lq, int Lk, int nqb) {
    const int qb = item % nqb, bh = item / nqb;
    const int b = bh >> 2, h = bh & 3;
    const int tid = threadIdx.x, lane = tid & 63, wid = tid >> 6;
    const int q = lane & 31, hh = lane >> 5;
    const int t = tbase + b * Lq + qb * 128 + wid * 32 + q;
    bf16x8 qf[12];
    {
        const bf16_t* qp = Qb + ((size_t)t * 4 + h) * 192 + hh * 8;
#pragma unroll
        for (int ks = 0; ks < 12; ks++) qf[ks] = *(const bf16x8*)(qp + ks * 16);
    }
    f32x16 o[4];
#pragma unroll
    for (int i = 0; i < 4; i++)
#pragma unroll
        for (int r = 0; r < 16; r++) o[i][r] = 0.f;
    float m = -1e30f, l = 0.f;
    const bf16_t* K = Kall + (size_t)bh * Lk * 192;
    const bf16_t* Vt = VtAll + (size_t)bh * 128 * Lk;
    char* sK = smem;
    char* sV = smem + ATT_SV_OFF;
    u32x4 pk[6], pv[4];
    const int nkt = Lk >> 6;
#pragma unroll
    for (int i = 0; i < 6; i++) pk[i] = *(const u32x4*)(K + (size_t)(tid + 256 * i) * 8);
#pragma unroll
    for (int i = 0; i < 4; i++) { int c = tid + 256 * i; pv[i] = *(const u32x4*)(Vt + (size_t)(c >> 3) * Lk + (c & 7) * 8); }
#pragma unroll
    for (int i = 0; i < 6; i++) { int c = tid + 256 * i; *(u32x4*)(sK + (c / 24) * 400 + (c % 24) * 16) = pk[i]; }
#pragma unroll
    for (int i = 0; i < 4; i++) { int c = tid + 256 * i; *(u32x4*)(sV + (c >> 3) * 144 + (c & 7) * 16) = pv[i]; }
    __syncthreads();
    const float sc2 = 0.07216878364870322f * 1.4426950408889634f;
    for (int kt = 0; kt < nkt; kt++) {
        f32x16 st[2];
#pragma unroll
        for (int bk = 0; bk < 2; bk++)
#pragma unroll
            for (int r = 0; r < 16; r++) st[bk][r] = 0.f;
#pragma unroll
        for (int ks = 0; ks < 12; ks++) {
            const bf16x8 qfk = qf[ks];
#pragma unroll
            for (int bk = 0; bk < 2; bk++) {
                bf16x8 a = *(const bf16x8*)(sK + (bk * 32 + q) * 400 + ks * 32 + hh * 16);
                st[bk] = __builtin_amdgcn_mfma_f32_32x32x16_bf16(a, qfk, st[bk], 0, 0, 0);
            }
        }
        float mx = -1e30f;
#pragma unroll
        for (int bk = 0; bk < 2; bk++)
#pragma unroll
            for (int r = 0; r < 16; r++) { st[bk][r] *= sc2; mx = fmaxf(mx, st[bk][r]); }
        mx = fmaxf(mx, __shfl_xor(mx, 32, 64));
        const float mn = fmaxf(m, mx);
        const float alpha = exp2f(m - mn);
        float ps = 0.f;
#pragma unroll
        for (int bk = 0; bk < 2; bk++)
#pragma unroll
            for (int r = 0; r < 16; r++) { st[bk][r] = exp2f(st[bk][r] - mn); ps += st[bk][r]; }
        ps += __shfl_xor(ps, 32, 64);
        l = l * alpha + ps; m = mn;
#pragma unroll
        for (int i = 0; i < 4; i++)
#pragma unroll
            for (int r = 0; r < 16; r++) o[i][r] *= alpha;
#pragma unroll
        for (int s4 = 0; s4 < 4; s4++) {
            bf16x8 pb;
#pragma unroll
            for (int j = 0; j < 8; j++) pb[j] = (short)f2bf(st[s4 >> 1][8 * (s4 & 1) + j]);
#pragma unroll
            for (int i = 0; i < 4; i++) {
                bf16x8 a = *(const bf16x8*)(sV + (i * 32 + q) * 144 + s4 * 32 + hh * 16);
                o[i] = __builtin_amdgcn_mfma_f32_32x32x16_bf16(a, pb, o[i], 0, 0, 0);
            }
        }
        __syncthreads();
        if (kt + 1 < nkt) {
            const bf16_t* Kn = K + (size_t)(kt + 1) * 64 * 192;
            const bf16_t* Vn = Vt + (kt + 1) * 64;
#pragma unroll
            for (int i = 0; i < 6; i++) pk[i] = *(const u32x4*)(Kn + (size_t)(tid + 256 * i) * 8);
#pragma unroll
            for (int i = 0; i < 4; i++) { int c = tid + 256 * i; pv[i] = *(const u32x4*)(Vn + (size_t)(c >> 3) * Lk + (c & 7) * 8); }
#pragma unroll
            for (int i = 0; i < 6; i++) { int c = tid + 256 * i; *(u32x4*)(sK + (c / 24) * 400 + (c % 24) * 16) = pk[i]; }
#pragma unroll
            for (int i = 0; i < 4; i++) { int c = tid + 256 * i; *(u32x4*)(sV + (c >> 3) * 144 + (c & 7) * 16) = pv[i]; }
        }
        __syncthreads();
    }
    const float il = 1.f / l;
    bf16_t* op = cat + (size_t)t * DM + 512 + h * 128;
#pragma unroll
    for (int i = 0; i < 4; i++)
#pragma unroll
        for (int g = 0; g < 4; g++) {
            ushort4 w;
            w.x = f2bf(o[i][4 * g + 0] * il); w.y = f2bf(o[i][4 * g + 1] * il); w.z = f2bf(o[i][4 * g + 2] * il); w.w = f2bf(o[i][4 * g + 3] * il);
            *(ushort4*)(op + i * 32 + 8 * g + 4 * hh) = w;
        }
}

__device__ __forceinline__ void d_peer_route(const int bx, const int by, const int bz, char* smem, const float* __restrict__ qp, const float* __restrict__ keys  ,
                                                    int* __restrict__ pidx, float* __restrict__ pg) {
    float (*sq)[256] = (float(*)[256])smem;
    float (*sc)[256] = (float(*)[256])(smem + 4096);
    float (*tv)[32] = (float(*)[32])(smem + 8192);
    int (*ti)[32] = (int(*)[32])(smem + 8192 + 512);
    float (*topv)[16] = (float(*)[16])(smem + 8192 + 1024);
    int (*topi)[16] = (int(*)[16])(smem + 8192 + 1024 + 256);
    const int wi = threadIdx.x >> 6, lane = threadIdx.x & 63;
    const int w = bx * 4 + wi;
    const int t = w >> 3, h = w & 7;
    const float* q = qp + (size_t)t * 2048 + h * 256;
#pragma unroll
    for (int j = 0; j < 4; j++) sq[wi][lane + 64 * j] = q[lane + 64 * j];
    __syncthreads();
#pragma unroll
    for (int p = 0; p < 2; p++)
#pragma unroll
        for (int half = 0; half < 2; half++) {
            int n = lane + 64 * half;
            const float* kr = keys + ((size_t)(h * 2 + p) * 128 + n) * 128;
            float s = 0.f;
            for (int dd = 0; dd < 128; dd += 4) {
                float4 kv = *(const float4*)(kr + dd);
                s += sq[wi][p * 128 + dd] * kv.x + sq[wi][p * 128 + dd + 1] * kv.y + sq[wi][p * 128 + dd + 2] * kv.z + sq[wi][p * 128 + dd + 3] * kv.w;
            }
            sc[wi][p * 128 + n] = s;
        }
    __syncthreads();
#pragma unroll
    for (int p = 0; p < 2; p++)
#pragma unroll
        for (int half = 0; half < 2; half++) {
            int n = lane + 64 * half;
            float s = sc[wi][p * 128 + n];
            int rank = 0;
            for (int j = 0; j < 128; j++) { float o = sc[wi][p * 128 + j]; rank += (o > s || (o == s && j < n)) ? 1 : 0; }
            if (rank < 16) { tv[wi][p * 16 + rank] = s; ti[wi][p * 16 + rank] = n; }
        }
    __syncthreads();
    float cv[4];
#pragma unroll
    for (int j = 0; j < 4; j++) { int c = lane + 64 * j; cv[j] = tv[wi][c >> 4] + tv[wi][16 + (c & 15)]; }
    __syncthreads();
#pragma unroll
    for (int j = 0; j < 4; j++) sc[wi][lane + 64 * j] = cv[j];
    __syncthreads();
#pragma unroll
    for (int j = 0; j < 4; j++) {
        int c = lane + 64 * j;
        float s = cv[j];
        int rank = 0;
        for (int i = 0; i < 256; i++) { float o = sc[wi][i]; rank += (o > s || (o == s && i < c)) ? 1 : 0; }
        if (rank < 16) { topv[wi][rank] = s; topi[wi][rank] = (ti[wi][c >> 4] * 128 + ti[wi][16 + (c & 15)]) & 16383; }
    }
    __syncthreads();
    if (lane < 16) {
        float mx = topv[wi][0];
        float sum = 0.f;
        for (int i = 0; i < 16; i++) sum += expf(topv[wi][i] - mx);
        pg[(size_t)w * 16 + lane] = expf(topv[wi][lane] - mx) / sum;
        pidx[(size_t)w * 16 + lane] = topi[wi][lane] & 16383;
    }
}

__device__ __forceinline__ void d_peer_apply(const int bx, const int by, const int bz, char* smem, const bf16_t* __restrict__ hbuf, const int* __restrict__ pidx, const float* __restrict__ pg,
                                                    const float* __restrict__ utab, const float* __restrict__ vtab, const float* __restrict__ modl,
                                                    float* __restrict__ xrun) {
    float* coef = (float*)smem; int* eid = (int*)(smem + 512);
    const int t = bx, tid = threadIdx.x, wi = tid >> 6, lane = tid & 63;
    if (tid < 128) eid[tid] = pidx[(size_t)t * 128 + tid];
    float4 xv[4];
#pragma unroll
    for (int j = 0; j < 4; j++) { ushort4 q = *(const ushort4*)(hbuf + (size_t)t * DM + j * 256 + lane * 4); xv[j] = make_float4(bf2f(q.x), bf2f(q.y), bf2f(q.z), bf2f(q.w)); }
    __syncthreads();
    for (int e = wi * 32; e < wi * 32 + 32; e++) {
        const float* ur = utab + (size_t)eid[e] * DM;
        float s = 0.f;
#pragma unroll
        for (int j = 0; j < 4; j++) { float4 u = *(const float4*)(ur + j * 256 + lane * 4); s += u.x * xv[j].x + u.y * xv[j].y + u.z * xv[j].z + u.w * xv[j].w; }
        s = wave_sum(s);
        if (lane == 0) coef[e] = pg[(size_t)t * 128 + e] * gelu_tanh(s);
    }
    __syncthreads();
    float4 acc = make_float4(0.f, 0.f, 0.f, 0.f);
    for (int e = 0; e < 128; e++) {
        float cf = coef[e];
        float4 v = *(const float4*)(vtab + (size_t)eid[e] * DM + tid * 4);
        acc.x += cf * v.x; acc.y += cf * v.y; acc.z += cf * v.z; acc.w += cf * v.w;
    }
    const float* m = modl + (size_t)tok_modrow(t) * 6144 + 5 * 1024 + tid * 4;
    float* xo = xrun + (size_t)t * DM + tid * 4;
    float4 x = *(float4*)xo;
    x.x += m[0] * acc.x; x.y += m[1] * acc.y; x.z += m[2] * acc.z; x.w += m[3] * acc.w;
    *(float4*)xo = x;
}


template <int K, int J>
__device__ __forceinline__ void bit_stage16(float (&x)[16]) {
#pragma unroll
    for (int i = 0; i < 16; i++) {
        const int l = i ^ J;
        if (l > i) {
            const bool desc = ((i & K) == 0);
            const float a = x[i], b = x[l];
            const float hi = fmaxf(a, b), lo = fminf(a, b);
            x[i] = desc ? hi : lo; x[l] = desc ? lo : hi;
        }
    }
}
__device__ __forceinline__ void bit_sort16_desc(float (&x)[16]) {
    bit_stage16<2, 1>(x);
    bit_stage16<4, 2>(x); bit_stage16<4, 1>(x);
    bit_stage16<8, 4>(x); bit_stage16<8, 2>(x); bit_stage16<8, 1>(x);
    bit_stage16<16, 8>(x); bit_stage16<16, 4>(x); bit_stage16<16, 2>(x); bit_stage16<16, 1>(x);
}
__device__ __forceinline__ void bit_merge16_desc(float (&x)[16]) {
    bit_stage16<16, 8>(x); bit_stage16<16, 4>(x); bit_stage16<16, 2>(x); bit_stage16<16, 1>(x);
}
template <int K, int J>
__device__ __forceinline__ void bit_stage16u(unsigned (&x)[16]) {
#pragma unroll
    for (int i = 0; i < 16; i++) {
        const int l = i ^ J;
        if (l > i) {
            const bool asc = ((i & K) == 0);
            const unsigned a = x[i], b = x[l];
            const unsigned lo = a < b ? a : b, hi = a < b ? b : a;
            x[i] = asc ? lo : hi; x[l] = asc ? hi : lo;
        }
    }
}
__device__ __forceinline__ void bit_sort16u_asc(unsigned (&x)[16]) {
    bit_stage16u<2, 1>(x);
    bit_stage16u<4, 2>(x); bit_stage16u<4, 1>(x);
    bit_stage16u<8, 4>(x); bit_stage16u<8, 2>(x); bit_stage16u<8, 1>(x);
    bit_stage16u<16, 8>(x); bit_stage16u<16, 4>(x); bit_stage16u<16, 2>(x); bit_stage16u<16, 1>(x);
}
__device__ __forceinline__ void bit_merge16u_asc(unsigned (&x)[16]) {
    bit_stage16u<16, 8>(x); bit_stage16u<16, 4>(x); bit_stage16u<16, 2>(x); bit_stage16u<16, 1>(x);
}
__device__ __forceinline__ void top16_merge(float (&L)[16], const float (&C)[16]) {
#pragma unroll
    for (int i = 0; i < 16; i++) L[i] = fmaxf(L[i], C[15 - i]);
    bit_merge16_desc(L);
}
__device__ __forceinline__ void low16_merge_u(unsigned (&L)[16], const unsigned (&C)[16]) {
#pragma unroll
    for (int i = 0; i < 16; i++) { const unsigned c = C[15 - i]; L[i] = L[i] < c ? L[i] : c; }
    bit_merge16u_asc(L);
}
__device__ __forceinline__ float key_val(float k) { return __uint_as_float(__float_as_uint(k) & ~127u); }
__device__ __forceinline__ int key_idx(float k) { return (int)(__float_as_uint(k) & 127u); }

struct EpiLds { static constexpr bool kQuad = false; float* lds; int c0; int pad;
    __device__ void operator()(int m, int n, float a) const { lds[m * 128 + (n - c0)] = a; } };

__device__ __forceinline__ void top16_col(const float* __restrict__ col, float (&L)[16]) {
#pragma unroll
    for (int ch = 0; ch < 8; ch++) {
        float C[16];
#pragma unroll
        for (int i = 0; i < 16; i++) {
            const int n = ch * 16 + i;
            C[i] = __uint_as_float((__float_as_uint(col[n * 128]) & ~127u) | (unsigned)n);
        }
        bit_sort16_desc(C);
        if (ch == 0) {
#pragma unroll
            for (int i = 0; i < 16; i++) L[i] = C[i];
        } else top16_merge(L, C);
    }
}
__device__ __forceinline__ void d_peer_route2(const int vb, char* smem, const bf16_t* __restrict__ kys, const bf16_t* __restrict__ qb,
                                              int* __restrict__ pidx, float* __restrict__ pg) {
    const int tt = vb % 96, h = vb / 96;
    const int tid = threadIdx.x;
    float A[16], B[16];
#pragma unroll
    for (int p = 0; p < 2; p++) {
        const int hp = h * 2 + p;
        d_gemm_bf16(tt, 0, smem, kys + (size_t)hp * 128 * 128, 128, qb + hp * 128, 2048, 128, TT, EpiLds{(float*)smem, tt * 128, 0});
        __syncthreads();
        if (tid < 128) {
            float L[16];
            top16_col((const float*)smem + tid, L);
#pragma unroll
            for (int i = 0; i < 16; i++) { if (p == 0) A[i] = L[i]; else B[i] = L[i]; }
        }
        __syncthreads();
    }
    if (tid >= 128) return;
    const int t = tt * 128 + tid;
    const float smax = key_val(A[0]) + key_val(B[0]);
    unsigned Tk[16];
#pragma unroll
    for (int g = 0; g < 4; g++) {
        unsigned Ck[16];
#pragma unroll
        for (int e = 0; e < 16; e++) {
            const int c = g * 16 + e;
            int i, j;
            if (c < 16) { i = 0; j = c; }
            else if (c < 24) { i = 1; j = c - 16; }
            else if (c < 29) { i = 2; j = c - 24; }
            else if (c < 33) { i = 3; j = c - 29; }
            else if (c < 36) { i = 4; j = c - 33; }
            else if (c < 42) { i = 5 + (c - 36) / 2; j = (c - 36) % 2; }
            else if (c < 50) { i = 8 + (c - 42); j = 0; }
            else { i = -1; j = 0; }
            if (i >= 0) {
                const float dd = smax - (key_val(A[i]) + key_val(B[j]));
                unsigned qd = (unsigned)fminf(dd * 32768.f, 262143.f);
                Ck[e] = (qd << 14) | (unsigned)(key_idx(A[i]) * 128 + key_idx(B[j]));
            } else Ck[e] = 0xffffffffu;
        }
        bit_sort16u_asc(Ck);
        if (g == 0) {
#pragma unroll
            for (int e = 0; e < 16; e++) Tk[e] = Ck[e];
        } else low16_merge_u(Tk, Ck);
    }
    float sum = 0.f;
    float w[16]; int Tp[16];
#pragma unroll
    for (int e = 0; e < 16; e++) { w[e] = __expf(-(float)(Tk[e] >> 14) * (1.f / 32768.f)); sum += w[e]; Tp[e] = (int)(Tk[e] & 16383u); }
    const float inv = 1.f / sum;
    int* pi = pidx + ((size_t)t * 8 + h) * 16;
    float* pw = pg + ((size_t)t * 8 + h) * 16;
#pragma unroll
    for (int e = 0; e < 16; e += 4) {
        *(int4*)(pi + e) = make_int4(Tp[e], Tp[e + 1], Tp[e + 2], Tp[e + 3]);
        *(float4*)(pw + e) = make_float4(w[e] * inv, w[e + 1] * inv, w[e + 2] * inv, w[e + 3] * inv);
    }
}

typedef __attribute__((ext_vector_type(2))) short bf16x2;
__device__ __forceinline__ float dot8_bf16(u32x4 a, u32x4 b, float acc) {
#pragma unroll
    for (int i = 0; i < 4; i++) {
        const unsigned x = a[i], y = b[i];
        acc += __uint_as_float(x << 16) * __uint_as_float(y << 16);
        acc += __uint_as_float(x & 0xffff0000u) * __uint_as_float(y & 0xffff0000u);
    }
    return acc;
}
__device__ __forceinline__ void d_peer_apply2(const int vb, char* smem, const bf16_t* __restrict__ hb, const int* __restrict__ pidx,
                                              const float* __restrict__ pg, const bf16_t* __restrict__ utab, const bf16_t* __restrict__ vtab,
                                              const float* __restrict__ modl, float* __restrict__ xrun) {
    const int wid = threadIdx.x >> 6, lane = threadIdx.x & 63;
    const int t = vb * 4 + wid;
    float* coef = (float*)smem + wid * 128;
    int* eid = (int*)(smem + 2048) + wid * 128;
    eid[lane] = pidx[(size_t)t * 128 + lane]; eid[lane + 64] = pidx[(size_t)t * 128 + lane + 64];
    const float g0 = pg[(size_t)t * 128 + lane], g1 = pg[(size_t)t * 128 + lane + 64];
    const u32x4 x0 = *(const u32x4*)(hb + (size_t)t * DM + lane * 8);
    const u32x4 x1 = *(const u32x4*)(hb + (size_t)t * DM + 512 + lane * 8);
    __builtin_amdgcn_wave_barrier();
    float myact0 = 0.f, myact1 = 0.f;
    for (int eb = 0; eb < 128; eb += 8) {
        u32x4 ua[8], ub[8];
#pragma unroll
        for (int r = 0; r < 8; r++) {
            const bf16_t* ur = utab + (size_t)eid[eb + r] * DM;
            ua[r] = *(const u32x4*)(ur + lane * 8);
            ub[r] = *(const u32x4*)(ur + 512 + lane * 8);
        }
#pragma unroll
        for (int r = 0; r < 8; r++) {
            float sacc = dot8_bf16(ua[r], x0, 0.f);
            sacc = dot8_bf16(ub[r], x1, sacc);
            sacc = wave_sum(sacc);
            const int e = eb + r;
            if (lane == (e & 63)) { if (e < 64) myact0 = sacc; else myact1 = sacc; }
        }
    }
    coef[lane] = g0 * gelu_tanh(myact0);
    coef[lane + 64] = g1 * gelu_tanh(myact1);
    __builtin_amdgcn_wave_barrier();
    float acc[16];
#pragma unroll
    for (int i = 0; i < 16; i++) acc[i] = 0.f;
    for (int eb = 0; eb < 128; eb += 8) {
        u32x4 va[8], vbq[8];
#pragma unroll
        for (int r = 0; r < 8; r++) {
            const bf16_t* vr = vtab + (size_t)eid[eb + r] * DM;
            va[r] = *(const u32x4*)(vr + lane * 8);
            vbq[r] = *(const u32x4*)(vr + 512 + lane * 8);
        }
#pragma unroll
        for (int r = 0; r < 8; r++) {
            const float cf = coef[eb + r];
#pragma unroll
            for (int i = 0; i < 4; i++) {
                acc[2 * i] += cf * __uint_as_float(va[r][i] << 16);
                acc[2 * i + 1] += cf * __uint_as_float(va[r][i] & 0xffff0000u);
                acc[8 + 2 * i] += cf * __uint_as_float(vbq[r][i] << 16);
                acc[8 + 2 * i + 1] += cf * __uint_as_float(vbq[r][i] & 0xffff0000u);
            }
        }
    }
    const float* m = modl + (size_t)tok_modrow(t) * 6144 + 5 * 1024;
    float* xo = xrun + (size_t)t * DM;
#pragma unroll
    for (int hlf = 0; hlf < 2; hlf++) {
        const int c0 = hlf * 512 + lane * 8;
        float4 xa = *(float4*)(xo + c0), xb2 = *(float4*)(xo + c0 + 4);
        const float4 ma = *(const float4*)(m + c0), mb = *(const float4*)(m + c0 + 4);
        xa.x += ma.x * acc[hlf * 8 + 0]; xa.y += ma.y * acc[hlf * 8 + 1]; xa.z += ma.z * acc[hlf * 8 + 2]; xa.w += ma.w * acc[hlf * 8 + 3];
        xb2.x += mb.x * acc[hlf * 8 + 4]; xb2.y += mb.y * acc[hlf * 8 + 5]; xb2.z += mb.z * acc[hlf * 8 + 6]; xb2.w += mb.w * acc[hlf * 8 + 7];
        *(float4*)(xo + c0) = xa; *(float4*)(xo + c0 + 4) = xb2;
    }
}
__device__ __forceinline__ void d_cvt_bf16(const int vb, const float* __restrict__ src, bf16_t* __restrict__ dst) {
    const size_t base = (size_t)vb * 16384 + threadIdx.x * 4;
#pragma unroll
    for (int i = 0; i < 16; i++) {
        const float4 v = *(const float4*)(src + base + i * 1024);
        ushort4 o; o.x = f2bf(v.x); o.y = f2bf(v.y); o.z = f2bf(v.z); o.w = f2bf(v.w);
        *(ushort4*)(dst + base + i * 1024) = o;
    }
}

__device__ __forceinline__ void d_hy_dw(const int bx, const int by, const int bz, char* smem, const float* __restrict__ pre, const float* __restrict__ cw, const float* __restrict__ cb,
                                               bf16_t* __restrict__ zin, bf16_t* __restrict__ x0) {
    const int t = bx;
    const int pos = tok_pos(t), L = tok_len(t);
    const float* P = pre + (size_t)t * 3072;
    for (int c = threadIdx.x; c < 1024; c += 256) {
        float u[3];
#pragma unroll
        for (int part = 0; part < 3; part++) {
            int cc = part * 1024 + c;
            float cur = P[cc];
            float prev = (pos > 0) ? P[cc - 3072] : 0.f;
            float nxt = (pos < L - 1) ? P[cc + 3072] : 0.f;
            u[part] = prev * cw[cc] + cur * cw[3072 + cc] + nxt * cw[2 * 3072 + cc] + cb[cc];
        }
        x0[(size_t)t * DM + c] = f2bf(u[0]);
        zin[(size_t)t * DM + c] = f2bf(u[1] * u[2]);
    }
}

__device__ __forceinline__ void d_hy_filt(const int bx, const int by, const int bz, char* smem, int L, const float* __restrict__ w1, const float* __restrict__ b1, const float* __restrict__ w2,
                                                 const float* __restrict__ b2, const float* __restrict__ w3, const float* __restrict__ fr,
                                                 float* __restrict__ hf, float* __restrict__ hb) {
    float* z = (float*)smem; float* h1 = z + 64; float* h2 = z + 128;
    const int t = bx, tid = threadIdx.x;
    const float tu = (float)t / (float)(L - 1);
    if (tid == 0) z[0] = tu;
    if (tid >= 1 && tid < 17) {
        int i = tid - 1;
        float band = 1e-4f + (float)i * ((15.f - 1e-4f) / 15.f);
        float ang = 6.283185307179586f * (float)t * band / (float)L;
        z[1 + i] = cosf(ang); z[17 + i] = -sinf(ang);
    }
    __syncthreads();
    if (tid < 64) { float s = b1[tid]; for (int i = 0; i < 33; i++) s += z[i] * w1[i * 64 + tid]; h1[tid] = sinf(fr[tid] * s); }
    __syncthreads();
    if (tid < 64) { float s = b2[tid]; for (int i = 0; i < 64; i++) s += h1[i] * w2[i * 64 + tid]; h2[tid] = sinf(fr[tid] * s); }
    __syncthreads();
    for (int c = tid; c < 2048; c += 256) {
        float s = 0.f;
        for (int i = 0; i < 64; i++) s += h2[i] * w3[i * 2048 + c];
        int ch = c & 1023;
        float d0 = -4.605170185988091f / 0.3f, d1 = -4.605170185988091f / 1.5f;
        float delta = d0 + (d1 - d0) * ((float)ch / 1023.f);
        float win = expf(-tu * fabsf(delta));
        float val = s * win;
        if (c < 1024) hf[(size_t)t * 1024 + ch] = val; else hb[(size_t)t * 1024 + ch] = val;
    }
}
__device__ __forceinline__ void d_hy_norm(const int bx, const int by, const int bz, char* smem, int L, const float* __restrict__ hf, const float* __restrict__ hb, float* __restrict__ inv) {
    const int c = bx * 256 + threadIdx.x;
    float s = 0.f;
    for (int t = 0; t < L; t++) { s += fabsf(hf[(size_t)t * 1024 + c]); if (t > 0) s += fabsf(hb[(size_t)t * 1024 + c]); }
    inv[c] = 1.f / s;
}
__device__ __forceinline__ void d_hy_conv(const int bx, const int by, const int bz, char* smem, int L, int tbase, const bf16_t* __restrict__ zin, const bf16_t* __restrict__ x0, const float* __restrict__ hf,
                                                 const float* __restrict__ hb, const float* __restrict__ inv, const float* __restrict__ bias,
                                                 bf16_t* __restrict__ zb) {
    const int c = bx * 256 + threadIdx.x;
    const int t0 = by * 8, b = bz;
    const bf16_t* Z = zin + (size_t)(tbase + b * L) * DM + c;
    float acc[8];
#pragma unroll
    for (int i = 0; i < 8; i++) acc[i] = 0.f;
    for (int s = 0; s < L; s++) {
        float z = bf2f(Z[(size_t)s * DM]);
#pragma unroll
        for (int i = 0; i < 8; i++) {
            int j = t0 + i - s;
            float g = (j >= 0) ? hf[(size_t)j * 1024 + c] : hb[(size_t)(-j) * 1024 + c];
            acc[i] += z * g;
        }
    }
    float iv = inv[c], bs = bias[c];
#pragma unroll
    for (int i = 0; i < 8; i++) {
        size_t o = (size_t)(tbase + b * L + t0 + i) * DM + c;
        float zz = bf2f(zin[o]);
        zb[o] = f2bf(bf2f(x0[o]) * (acc[i] * iv + zz * bs));
    }
}


__device__ __forceinline__ void d_hy_filt2(const int vbl8, char* smem, const int L, const float* __restrict__ w1, const float* __restrict__ b1,
                                           const float* __restrict__ w2, const float* __restrict__ b2, const float* __restrict__ w3,
                                           const float* __restrict__ fr, bf16_t* __restrict__ gT, float* __restrict__ nsum) {
    float* zp = (float*)smem;
    float* h1 = zp + 32 * 33;
    float* h2t = h1 + 32 * 64;
    float* sw1 = h2t + 64 * 32;
    float* sw2 = sw1 + 33 * 64;
    const int tid = threadIdx.x;
    const int vbl = vbl8 >> 3, mm = vbl8 & 7;
    const int t0 = vbl * 32;
    for (int e = tid; e < 33 * 64; e += 256) sw1[e] = w1[e];
    for (int e = tid; e < 64 * 64; e += 256) sw2[e] = w2[e];
    for (int e = tid; e < 32 * 33; e += 256) {
        const int pos = e / 33, i = e % 33;
        const float t = (float)(t0 + pos);
        float val;
        if (i == 0) val = t / (float)(L - 1);
        else {
            const int bi = (i <= 16) ? (i - 1) : (i - 17);
            const float band = 1e-4f + (float)bi * ((15.f - 1e-4f) / 15.f);
            const float ang = 6.283185307179586f * t * band / (float)L;
            val = (i <= 16) ? __cosf(ang) : -__sinf(ang);
        }
        zp[e] = val;
    }
    const int c = tid + 256 * mm;
    float wv[8];
#pragma unroll
    for (int jj = 0; jj < 8; jj++) wv[jj] = w3[jj * 2048 + c];
    __syncthreads();
    {
        const int j = tid & 63;
        const float frj = fr[j];
#pragma unroll 1
        for (int i = 0; i < 8; i++) {
            const int pos = (tid >> 6) + 4 * i;
            float sacc = b1[j];
#pragma unroll 3
            for (int q = 0; q < 33; q++) sacc += zp[pos * 33 + q] * sw1[q * 64 + j];
            h1[pos * 64 + j] = __sinf(frj * sacc);
        }
        __syncthreads();
#pragma unroll 1
        for (int i = 0; i < 8; i++) {
            const int pos = (tid >> 6) + 4 * i;
            float sacc = b2[j];
#pragma unroll 4
            for (int q = 0; q < 64; q++) sacc += h1[pos * 64 + q] * sw2[q * 64 + j];
            h2t[j * 32 + pos] = __sinf(frj * sacc);
        }
    }
    __syncthreads();
    {
        float acc[32];
#pragma unroll
        for (int i = 0; i < 32; i++) acc[i] = 0.f;
#pragma unroll 1
        for (int jb = 0; jb < 64; jb += 8) {
            float wn[8];
            if (jb + 8 < 64) {
#pragma unroll
                for (int jj = 0; jj < 8; jj++) wn[jj] = w3[(jb + 8 + jj) * 2048 + c];
            }
#pragma unroll
            for (int jj = 0; jj < 8; jj++) {
                const float w = wv[jj];
#pragma unroll
                for (int i = 0; i < 8; i++) {
                    const float4 hv = *(const float4*)(h2t + (jb + jj) * 32 + i * 4);
                    acc[4 * i] += hv.x * w; acc[4 * i + 1] += hv.y * w; acc[4 * i + 2] += hv.z * w; acc[4 * i + 3] += hv.w * w;
                }
                __builtin_amdgcn_sched_barrier(0);
            }
            if (jb + 8 < 64) {
#pragma unroll
                for (int jj = 0; jj < 8; jj++) wv[jj] = wn[jj];
            }
        }
        const int ch = c & 1023;
        const float d0 = -4.605170185988091f / 0.3f, d1 = -4.605170185988091f / 1.5f;
        const float adelta = fabsf(d0 + (d1 - d0) * ((float)ch / 1023.f));
        float absum = 0.f;
        bf16_t* g = gT + (size_t)ch * 2 * L;
#pragma unroll
        for (int i = 0; i < 32; i++) {
            const int t = t0 + i;
            const float tu = (float)t / (float)(L - 1);
            const float val = acc[i] * __expf(-tu * adelta);
            if (c < 1024) { absum += fabsf(val); g[L - t] = f2bf(val); }
            else if (t >= 1) { absum += fabsf(val); g[L + t] = f2bf(val); }
            if ((i & 3) == 3) __builtin_amdgcn_sched_barrier(0);
        }
        atomicAdd(nsum + ch, absum);
    }
}

__device__ __forceinline__ void d_hy_dw3(const int vb, char* smem, const bf16_t* __restrict__ pre, const float* __restrict__ cw,
                                         const float* __restrict__ cb, bf16_t* __restrict__ zT, bf16_t* __restrict__ x0b) {
    bf16_t* tile = (bf16_t*)smem;
    const int tt = vb >> 3, ct = vb & 7;
    const int tid = threadIdx.x;
    const int cp = tid & 63, c = ct * 128 + cp * 2;
    const int tq = tid >> 6;
    const int tok0 = tt * 64 + tq * 16;
    const int pos0 = tok_pos(tok0), L = tok_len(tok0);
    unsigned raw[3][18];
#pragma unroll
    for (int part = 0; part < 3; part++)
#pragma unroll
        for (int i = 0; i < 18; i++) {
            const int pos = pos0 - 1 + i;
            raw[part][i] = (pos >= 0 && pos < L) ? *(const unsigned*)(pre + (size_t)(tok0 - 1 + i) * 3072 + part * 1024 + c) : 0u;
        }
    float w0[3][2], w1[3][2], w2[3][2], bb[3][2];
#pragma unroll
    for (int part = 0; part < 3; part++)
#pragma unroll
        for (int e = 0; e < 2; e++) {
            const int col = part * 1024 + c + e;
            w0[part][e] = cw[col]; w1[part][e] = cw[3072 + col]; w2[part][e] = cw[2 * 3072 + col]; bb[part][e] = cb[col];
        }
#pragma unroll
    for (int i = 0; i < 16; i++) {
        float u[3][2];
#pragma unroll
        for (int part = 0; part < 3; part++) {
            const unsigned p0 = raw[part][i], p1 = raw[part][i + 1], p2 = raw[part][i + 2];
            u[part][0] = __uint_as_float(p0 << 16) * w0[part][0] + __uint_as_float(p1 << 16) * w1[part][0] + __uint_as_float(p2 << 16) * w2[part][0] + bb[part][0];
            u[part][1] = __uint_as_float(p0 & 0xffff0000u) * w0[part][1] + __uint_as_float(p1 & 0xffff0000u) * w1[part][1] +
                         __uint_as_float(p2 & 0xffff0000u) * w2[part][1] + bb[part][1];
        }
        *(unsigned*)(x0b + (size_t)(tok0 + i) * DM + c) = (unsigned)f2bf(u[0][0]) | ((unsigned)f2bf(u[0][1]) << 16);
        tile[(cp * 2) * 72 + tq * 16 + i] = f2bf(u[1][0] * u[2][0]);
        tile[(cp * 2 + 1) * 72 + tq * 16 + i] = f2bf(u[1][1] * u[2][1]);
    }
    __syncthreads();
    {
        const int cch = tid >> 1, hf = tid & 1;
        bf16_t* dst = zT + (size_t)(ct * 128 + cch) * TT + tt * 64 + hf * 32;
        const bf16_t* src = tile + cch * 72 + hf * 32;
#pragma unroll
        for (int q = 0; q < 4; q++) *(u32x4*)(dst + q * 8) = *(const u32x4*)(src + q * 8);
    }
}

template <bool SAMPLE>
__device__ __forceinline__ void d_hy_conv2(const int c, const int half, char* wsm, const bf16_t* __restrict__ gTall, const float* __restrict__ nsum,
                                           const bf16_t* __restrict__ zT, const float* __restrict__ bias, bf16_t* __restrict__ yT) {
    constexpr int L = SAMPLE ? LS : LP;
    constexpr int NB = L / 32;
    constexpr int NBATCH = SAMPLE ? 4 : 16;
    constexpr int BSH = SAMPLE ? 2 : 4;
    constexpr int TPB = 32 >> BSH;
    constexpr int NCB = NB / TPB;
    constexpr int HCB = NCB / 2;
    constexpr int PADB = SAMPLE ? 8 : 2;
    constexpr int ZLEN = L + 2 * PADB * 32;
    constexpr int tbase = SAMPLE ? TP : 0;
    const int lane = threadIdx.x & 63;
    const int l2 = half * 64 + lane;
    const int lc = lane & 31, hh = lane >> 5;
    const int b = lc & (NBATCH - 1), Tl = lc >> BSH;
    bf16_t* R = (bf16_t*)wsm;
    bf16_t* Z = R + 2 * L;
    {
        const u32x4* src = (const u32x4*)(gTall + (size_t)c * 2 * L);
        for (int i = l2; i < 2 * L / 8; i += 128) ((u32x4*)R)[i] = src[i];
        const u32x4 zero = {0u, 0u, 0u, 0u};
#pragma unroll 1
        for (int b2 = 0; b2 < NBATCH; b2++) {
            const u32x4* zs = (const u32x4*)(zT + (size_t)c * TT + tbase + b2 * L);
            u32x4* zd = (u32x4*)(Z + b2 * ZLEN);
            for (int i = l2; i < PADB * 4; i += 128) { zd[i] = zero; zd[PADB * 4 + L / 8 + i] = zero; }
            for (int i = l2; i < L / 8; i += 128) zd[PADB * 4 + i] = zs[i];
        }
    }
    __syncthreads();
    f32x16 acc[HCB];
#pragma unroll
    for (int cb = 0; cb < HCB; cb++)
#pragma unroll
        for (int r = 0; r < 16; r++) acc[cb][r] = 0.f;
    const bf16_t* Zb = Z + b * ZLEN + PADB * 32 + 8 * hh;
    const int cb0 = half * HCB;
    const int Dlo = TPB * cb0 - (NB - 1), Dhi = TPB * (cb0 + HCB - 1) + TPB - 1;
#pragma unroll 1
    for (int D = (Dlo < -(NB - 1) ? -(NB - 1) : Dlo); D <= (Dhi > NB - 1 ? NB - 1 : Dhi); D++) {
        bf16x8 af[2];
#pragma unroll
        for (int ks = 0; ks < 2; ks++) {
            const bf16_t* rp = R + (L - 32 * D - lc + 16 * ks + 8 * hh);
#pragma unroll
            for (int j = 0; j < 8; j++) af[ks][j] = (short)rp[j];
        }
#pragma unroll
        for (int lcb = 0; lcb < HCB; lcb++) {
            const int cb = cb0 + lcb;
            if (D >= TPB * cb - (NB - 1) && D <= TPB * cb + TPB - 1) {
                const int S = TPB * cb + Tl - D;
#pragma unroll
                for (int ks = 0; ks < 2; ks++) {
                    const bf16x8 bfr = *(const bf16x8*)(Zb + 32 * S + 16 * ks);
                    acc[lcb] = __builtin_amdgcn_mfma_f32_32x32x16_bf16(af[ks], bfr, acc[lcb], 0, 0, 0);
                }
            }
        }
    }
    const float inv = 1.f / nsum[c], bs = bias[c];
    bf16_t* yrow = yT + (size_t)c * TT + tbase + b * L;
    const bf16_t* zrow = Z + b * ZLEN + PADB * 32;
#pragma unroll
    for (int lcb = 0; lcb < HCB; lcb++)
#pragma unroll
        for (int g = 0; g < 4; g++) {
            const int t = 32 * (TPB * (cb0 + lcb) + Tl) + 8 * g + 4 * hh;
            ushort4 o;
            o.x = f2bf(acc[lcb][4 * g + 0] * inv + bf2f(zrow[t + 0]) * bs);
            o.y = f2bf(acc[lcb][4 * g + 1] * inv + bf2f(zrow[t + 1]) * bs);
            o.z = f2bf(acc[lcb][4 * g + 2] * inv + bf2f(zrow[t + 2]) * bs);
            o.w = f2bf(acc[lcb][4 * g + 3] * inv + bf2f(zrow[t + 3]) * bs);
            *(ushort4*)(yrow + t) = o;
        }
}

__device__ __forceinline__ void d_hy_post2(const int vb, char* smem, const bf16_t* __restrict__ yT, const bf16_t* __restrict__ x0b, bf16_t* __restrict__ zb) {
    bf16_t* tile = (bf16_t*)smem;
    const int tt = vb >> 3, ct = vb & 7;
    const int tid = threadIdx.x;
    const int cp = tid & 63, c = ct * 128 + cp * 2, tq = tid >> 6;
    const int tok0 = tt * 64 + tq * 16;
    unsigned xr[16];
#pragma unroll
    for (int i = 0; i < 16; i++) xr[i] = *(const unsigned*)(x0b + (size_t)(tok0 + i) * DM + c);
    {
        const int cch = tid >> 1, hf = tid & 1;
        const bf16_t* src = yT + (size_t)(ct * 128 + cch) * TT + tt * 64 + hf * 32;
        bf16_t* dst = tile + cch * 72 + hf * 32;
#pragma unroll
        for (int q = 0; q < 4; q++) *(u32x4*)(dst + q * 8) = *(const u32x4*)(src + q * 8);
    }
    __syncthreads();
#pragma unroll
    for (int i = 0; i < 16; i++) {
        const float y0 = bf2f(tile[(cp * 2) * 72 + tq * 16 + i]), y1 = bf2f(tile[(cp * 2 + 1) * 72 + tq * 16 + i]);
        const float r0 = __uint_as_float(xr[i] << 16) * y0, r1 = __uint_as_float(xr[i] & 0xffff0000u) * y1;
        *(unsigned*)(zb + (size_t)(tok0 + i) * DM + c) = (unsigned)f2bf(r0) | ((unsigned)f2bf(r1) << 16);
    }
}

__device__ __forceinline__ float wave_allsum_fast(float v) {
    v = row16_allsum(v);
    const float r0 = __int_as_float(__builtin_amdgcn_readlane(__float_as_int(v), 0));
    const float r1 = __int_as_float(__builtin_amdgcn_readlane(__float_as_int(v), 16));
    const float r2 = __int_as_float(__builtin_amdgcn_readlane(__float_as_int(v), 32));
    const float r3 = __int_as_float(__builtin_amdgcn_readlane(__float_as_int(v), 48));
    return (r0 + r1) + (r2 + r3);
}
__device__ __forceinline__ ushort4 pack_bf4(float a, float b, float c, float d) { ushort4 o; o.x = f2bf(a); o.y = f2bf(b); o.z = f2bf(c); o.w = f2bf(d); return o; }

__device__ __forceinline__ void d_norm_mod2(const int vb, const float* __restrict__ xa, const float* __restrict__ xb, const float* __restrict__ g,
                                            const float* __restrict__ modl, const int shift_idx, const int scale_idx, bf16_t* __restrict__ h) {
    const int wid = threadIdx.x >> 6, lane = threadIdx.x & 63;
    const int t0 = vb * 8 + wid * 2;
    float4 v[2][4];
#pragma unroll
    for (int u = 0; u < 2; u++) {
        const int t = t0 + u;
        const float* x = (t < TP) ? (xa + (size_t)t * DM) : (xb + (size_t)(t - TP) * DM);
#pragma unroll
        for (int j = 0; j < 4; j++) v[u][j] = *(const float4*)(x + j * 256 + lane * 4);
    }
#pragma unroll
    for (int u = 0; u < 2; u++) {
        const int t = t0 + u;
        float ss = 0.f;
#pragma unroll
        for (int j = 0; j < 4; j++) ss += v[u][j].x * v[u][j].x + v[u][j].y * v[u][j].y + v[u][j].z * v[u][j].z + v[u][j].w * v[u][j].w;
        ss = wave_allsum_fast(ss);
        const float rstd = rsqrtf(ss * (1.f / DM) + 1e-6f);
        const float* m = modl + (size_t)tok_modrow(t) * 6144;
#pragma unroll
        for (int j = 0; j < 4; j++) {
            const int c = j * 256 + lane * 4;
            const float4 gg = *(const float4*)(g + c);
            const float4 sh = *(const float4*)(m + shift_idx * 1024 + c);
            const float4 sc = *(const float4*)(m + scale_idx * 1024 + c);
            *(ushort4*)(h + (size_t)t * DM + c) = pack_bf4(v[u][j].x * rstd * gg.x * (1.f + sc.x) + sh.x, v[u][j].y * rstd * gg.y * (1.f + sc.y) + sh.y,
                                                           v[u][j].z * rstd * gg.z * (1.f + sc.z) + sh.z, v[u][j].w * rstd * gg.w * (1.f + sc.w) + sh.w);
        }
    }
}

__device__ __forceinline__ void d_rw_shift2(const int vb, const bf16_t* __restrict__ proj, const float* __restrict__ mu, bf16_t* __restrict__ rb,
                                            bf16_t* __restrict__ kb, bf16_t* __restrict__ vbuf, bf16_t* __restrict__ tw, bf16_t* __restrict__ adv,
                                            bf16_t* __restrict__ sg) {
#pragma unroll
    for (int u = 0; u < 4; u++) {
        const int id = vb * 1024 + u * 256 + threadIdx.x;
        const int t = id / 224, c = (id % 224) * 8;
        const int pos = tok_pos(t), L = tok_len(t);
        const bf16_t* P = proj + (size_t)t * RWIN + c;
        const u32x4 cur = *(const u32x4*)P;
        u32x4 prv = {0u, 0u, 0u, 0u}, nxt = {0u, 0u, 0u, 0u};
        if (pos > 0) prv = *(const u32x4*)(P - RWIN);
        if (pos < L - 1) nxt = *(const u32x4*)(P + RWIN);
        const float4 m0 = *(const float4*)(mu + c), m1 = *(const float4*)(mu + c + 4);
        const float mm[8] = {m0.x, m0.y, m0.z, m0.w, m1.x, m1.y, m1.z, m1.w};
        float val[8];
#pragma unroll
        for (int i = 0; i < 4; i++) {
            const float c0 = __uint_as_float(cur[i] << 16), c1 = __uint_as_float(cur[i] & 0xffff0000u);
            const float p0 = __uint_as_float(prv[i] << 16), p1 = __uint_as_float(prv[i] & 0xffff0000u);
            const float n0 = __uint_as_float(nxt[i] << 16), n1 = __uint_as_float(nxt[i] & 0xffff0000u);
            val[2 * i] = c0 + mm[2 * i] * (0.5f * (p0 + n0) - c0);
            val[2 * i + 1] = c1 + mm[2 * i + 1] * (0.5f * (p1 + n1) - c1);
        }
        bf16_t* dst;
        if (c < 512) dst = rb + (size_t)t * 512 + c;
        else if (c < 1024) dst = kb + (size_t)t * 512 + (c - 512);
        else if (c < 1536) dst = vbuf + (size_t)t * 512 + (c - 1024);
        else if (c < 1600) { dst = tw + (size_t)t * 64 + (c - 1536);
#pragma unroll
            for (int i = 0; i < 8; i++) val[i] = tanhf(val[i]); }
        else if (c < 1664) dst = adv + (size_t)t * 64 + (c - 1600);
        else { dst = sg + (size_t)t * 128 + (c - 1664);
#pragma unroll
            for (int i = 0; i < 8; i++) val[i] = sigmoidf_(val[i]); }
        u32x4 o;
#pragma unroll
        for (int i = 0; i < 4; i++) o[i] = (unsigned)f2bf(val[2 * i]) | ((unsigned)f2bf(val[2 * i + 1]) << 16);
        *(u32x4*)dst = o;
    }
}

__device__ __forceinline__ void d_mla_pre2(const int vb, const float* __restrict__ proj, const float* __restrict__ q_norm, const float* __restrict__ kv_norm,
                                           bf16_t* __restrict__ qcn, bf16_t* __restrict__ ckv, float* __restrict__ kpe, float* __restrict__ out_ckv,
                                           float* __restrict__ out_kpe) {
    const int t = vb * 16 + (threadIdx.x >> 4), l16 = threadIdx.x & 15;
    const float* P = proj + (size_t)t * 448;
    float4 x[7];
#pragma unroll
    for (int j = 0; j < 7; j++) x[j] = *(const float4*)(P + 4 * (l16 + 16 * j));
    float sq = 0.f, sk = 0.f;
#pragma unroll
    for (int j = 0; j < 4; j++) sq += x[j].x * x[j].x + x[j].y * x[j].y + x[j].z * x[j].z + x[j].w * x[j].w;
#pragma unroll
    for (int j = 4; j < 6; j++) sk += x[j].x * x[j].x + x[j].y * x[j].y + x[j].z * x[j].z + x[j].w * x[j].w;
    sq = row16_allsum(sq); sk = row16_allsum(sk);
    const float rq = rsqrtf(sq * (1.f / 256.f) + 1e-6f), rk = rsqrtf(sk * (1.f / 128.f) + 1e-6f);
#pragma unroll
    for (int j = 0; j < 4; j++) {
        const int c = 4 * (l16 + 16 * j);
        const float4 w = *(const float4*)(q_norm + c);
        *(ushort4*)(qcn + (size_t)t * 256 + c) = pack_bf4(x[j].x * rq * w.x, x[j].y * rq * w.y, x[j].z * rq * w.z, x[j].w * rq * w.w);
    }
#pragma unroll
    for (int j = 4; j < 6; j++) {
        const int c = 4 * (l16 + 16 * (j - 4));
        const float4 w = *(const float4*)(kv_norm + c);
        const float4 o = make_float4(x[j].x * rk * w.x, x[j].y * rk * w.y, x[j].z * rk * w.z, x[j].w * rk * w.w);
        *(ushort4*)(ckv + (size_t)t * 128 + c) = pack_bf4(o.x, o.y, o.z, o.w);
        if (t < TP) *(float4*)(out_ckv + (size_t)t * 128 + c) = o;
    }
    {
        const int c = 4 * l16;
        *(float4*)(kpe + (size_t)t * 64 + c) = x[6];
        if (t < TP) *(float4*)(out_kpe + (size_t)t * 64 + c) = x[6];
    }
}

__device__ __forceinline__ void d_rw_kk2(const int vb, char* smem, const bf16_t* __restrict__ rb, const bf16_t* __restrict__ kb,
                                         const bf16_t* __restrict__ lr0, const bf16_t* __restrict__ lr1, const float* __restrict__ k_k,
                                         const float* __restrict__ k_a, const float* __restrict__ r_k, bf16_t* __restrict__ kkb, float* __restrict__ bonus) {
    float* pk = (float*)smem;
    for (int i = threadIdx.x; i < 512; i += 256) { pk[i] = k_k[i]; pk[512 + i] = k_a[i]; pk[1024 + i] = r_k[i]; }
    __syncthreads();
    const int w = vb * 256 + threadIdx.x;
    const int h = w & 7;
    const size_t o = (size_t)w * 64;
    u32x4 kq[8];
#pragma unroll
    for (int i = 0; i < 8; i++) kq[i] = *(const u32x4*)(kb + o + i * 8);
    const float* kkp = pk + h * 64; const float* kap = pk + 512 + h * 64; const float* rkp = pk + 1024 + h * 64;
    float ss = 0.f;
#pragma unroll
    for (int i = 0; i < 8; i++)
#pragma unroll
        for (int j = 0; j < 4; j++) {
            const float a = __uint_as_float(kq[i][j] << 16) * kkp[i * 8 + 2 * j], b = __uint_as_float(kq[i][j] & 0xffff0000u) * kkp[i * 8 + 2 * j + 1];
            ss += a * a + b * b;
        }
    const float inv = 1.f / fmaxf(sqrtf(ss), 1e-12f);
    float bs = 0.f;
#pragma unroll 2
    for (int i = 0; i < 8; i++) {
        const u32x4 kq2 = *(const u32x4*)(kb + o + i * 8);
        const u32x4 rq = *(const u32x4*)(rb + o + i * 8);
        const u32x4 l0 = *(const u32x4*)(lr0 + o + i * 8);
        const u32x4 l1 = *(const u32x4*)(lr1 + o + i * 8);
        u32x4 ok;
#pragma unroll
        for (int j = 0; j < 4; j++) {
            const int e0 = i * 8 + 2 * j, e1 = e0 + 1;
            const float k0 = __uint_as_float(kq2[j] << 16), k1 = __uint_as_float(kq2[j] & 0xffff0000u);
            const float r0 = __uint_as_float(rq[j] << 16), r1 = __uint_as_float(rq[j] & 0xffff0000u);
            const float a0 = __uint_as_float(l0[j] << 16), a1 = __uint_as_float(l0[j] & 0xffff0000u);
            const float b0 = __uint_as_float(l1[j] << 16), b1 = __uint_as_float(l1[j] & 0xffff0000u);
            bs += r0 * k0 * (2.f + (a0 + b0 - 2.f) * kap[e0]) * rkp[e0] + r1 * k1 * (2.f + (a1 + b1 - 2.f) * kap[e1]) * rkp[e1];
            ok[j] = (unsigned)f2bf(k0 * kkp[e0] * inv) | ((unsigned)f2bf(k1 * kkp[e1] * inv) << 16);
        }
        *(u32x4*)(kkb + o + i * 8) = ok;
    }
    bonus[w] = bs;
}

__device__ __forceinline__ void d_mla_post2(const int vb, const bf16_t* __restrict__ qraw, const bf16_t* __restrict__ kvraw, const bf16_t* __restrict__ kvraw_ctx,
                                            const float* __restrict__ kpe, const float* __restrict__ cache_kpe, const float* __restrict__ qn,
                                            const float* __restrict__ kn, bf16_t* __restrict__ Qb, bf16_t* __restrict__ Kp, bf16_t* __restrict__ Ks) {
    const int item = vb * 16 + (threadIdx.x >> 4), l16 = threadIdx.x & 15;
    const int row = item >> 2, h = item & 3;
    const bool isctx = row >= TT, sample = row >= TP;
    const int e0 = 12 * l16;
    const bf16_t* kvr; const float* pe; int pos = 0;
    if (isctx) { const int cr = row - TT; kvr = kvraw_ctx + (size_t)cr * 1024; pe = cache_kpe + (size_t)cr * 64; }
    else { kvr = kvraw + (size_t)row * 1024; pe = kpe + (size_t)row * 64; pos = tok_pos(row); }
    float kx[12], qx[12];
#pragma unroll
    for (int j = 0; j < 12; j++) {
        const int e = e0 + j;
        kx[j] = (e < 128) ? bf2f(kvr[h * 256 + (e < 128 ? e : 0)]) : pe[(e >= 128 ? e - 128 : 0)];
        qx[j] = isctx ? 0.f : bf2f(qraw[(size_t)row * 768 + h * 192 + e]);
    }
    float sk = 0.f, sq = 0.f;
#pragma unroll
    for (int j = 0; j < 12; j++) { sk += kx[j] * kx[j]; sq += qx[j] * qx[j]; }
    sk = row16_allsum(sk); sq = row16_allsum(sq);
    const float rk = rsqrtf(sk * (1.f / 192.f) + 1e-6f), rq = rsqrtf(sq * (1.f / 192.f) + 1e-6f);
#pragma unroll
    for (int j = 0; j < 12; j++) { kx[j] *= rk * kn[e0 + j]; qx[j] *= rq * qn[e0 + j]; }
    if (sample && !isctx) {
        const float rowf = (float)(pos >> 6), colf = (float)(pos & 63);
#pragma unroll
        for (int j = 0; j < 12; j += 2) {
            const int e = e0 + j;
            if (e >= 128) {
                const int pi = (e - 128) >> 1;
                const float inv = expf(-(float)(pi & 15) * (1.f / 16.f) * 9.210340371976184f);
                const float ang = (pi < 16 ? rowf : colf) * inv;
                const float cs = __cosf(ang), sn = __sinf(ang);
                const float a = kx[j], bq = kx[j + 1];
                kx[j] = a * cs - bq * sn; kx[j + 1] = a * sn + bq * cs;
                const float a2 = qx[j], b2 = qx[j + 1];
                qx[j] = a2 * cs - b2 * sn; qx[j + 1] = a2 * sn + b2 * cs;
            }
        }
    }
    bf16_t* kd;
    if (!sample) { const int b = row >> 8, pp = row & 255; kd = Kp + ((size_t)(b * 4 + h) * LP + pp) * 192; }
    else if (!isctx) { const int b = (row - TP) >> 11, pp = (row - TP) & 2047; kd = Ks + ((size_t)(b * 4 + h) * 2304 + 256 + pp) * 192; }
    else { const int cr = row - TT; const int b = cr >> 8, pp = cr & 255; kd = Ks + ((size_t)(b * 4 + h) * 2304 + pp) * 192; }
#pragma unroll
    for (int j = 0; j < 12; j += 4) {
        *(ushort4*)(kd + e0 + j) = pack_bf4(kx[j], kx[j + 1], kx[j + 2], kx[j + 3]);
        if (!isctx) *(ushort4*)(Qb + ((size_t)row * 4 + h) * 192 + e0 + j) = pack_bf4(qx[j], qx[j + 1], qx[j + 2], qx[j + 3]);
    }
}

__device__ __forceinline__ void d_rw_post2(const int vb, char* smem, const float* __restrict__ y0, const float* __restrict__ y1, const float* __restrict__ bonus,
                                           const bf16_t* __restrict__ vbuf, const bf16_t* __restrict__ gate, const float* __restrict__ lnx_g,
                                           const float* __restrict__ lnx_b, bf16_t* __restrict__ cat) {
    float* pg = (float*)smem;
    for (int i = threadIdx.x; i < 512; i += 256) { pg[i] = lnx_g[i]; pg[512 + i] = lnx_b[i]; }
    __syncthreads();
    const int w = vb * 256 + threadIdx.x;
    const int t = w >> 3, h = w & 7;
    const size_t o = (size_t)w * 64;
    float s1 = 0.f, s2 = 0.f;
#pragma unroll 4
    for (int i = 0; i < 16; i++) {
        const float4 a = *(const float4*)(y0 + o + i * 4), b = *(const float4*)(y1 + o + i * 4);
        const float e0 = a.x + b.x, e1 = a.y + b.y, e2 = a.z + b.z, e3 = a.w + b.w;
        s1 += (e0 + e1) + (e2 + e3);
        s2 += (e0 * e0 + e1 * e1) + (e2 * e2 + e3 * e3);
    }
    const float mean = s1 * (1.f / 64.f);
    const float var = fmaxf(s2 * (1.f / 64.f) - mean * mean, 0.f);
    const float rstd = rsqrtf(var + 64e-5f);
    const float bn = bonus[w];
    const float* gp = pg + h * 64; const float* bp = pg + 512 + h * 64;
#pragma unroll 2
    for (int i = 0; i < 8; i++) {
        const float4 ya = *(const float4*)(y0 + o + i * 8), yb = *(const float4*)(y1 + o + i * 8);
        const float4 yc = *(const float4*)(y0 + o + i * 8 + 4), yd = *(const float4*)(y1 + o + i * 8 + 4);
        const float yy[8] = {ya.x + yb.x, ya.y + yb.y, ya.z + yb.z, ya.w + yb.w, yc.x + yd.x, yc.y + yd.y, yc.z + yd.z, yc.w + yd.w};
        const u32x4 vq = *(const u32x4*)(vbuf + o + i * 8);
        const u32x4 gq = *(const u32x4*)(gate + o + i * 8);
        u32x4 oq;
#pragma unroll
        for (int j = 0; j < 4; j++) {
            const int e0 = i * 8 + 2 * j, e1 = e0 + 1;
            const float v0 = __uint_as_float(vq[j] << 16), v1 = __uint_as_float(vq[j] & 0xffff0000u);
            const float g0 = __uint_as_float(gq[j] << 16), g1 = __uint_as_float(gq[j] & 0xffff0000u);
            const float r0 = ((yy[2 * j] - mean) * rstd * gp[e0] + bp[e0] + bn * v0) * g0;
            const float r1 = ((yy[2 * j + 1] - mean) * rstd * gp[e1] + bp[e1] + bn * v1) * g1;
            oq[j] = (unsigned)f2bf(r0) | ((unsigned)f2bf(r1) << 16);
        }
        *(u32x4*)(cat + (size_t)t * DM + h * 64 + i * 8) = oq;
    }
}


typedef float f32x2 __attribute__((ext_vector_type(2)));
template <int CTRL>
__device__ __forceinline__ float dpp_max(float v) {
    return fmaxf(v, __int_as_float(__builtin_amdgcn_update_dpp(0, __float_as_int(v), CTRL, 0xf, 0xf, false)));
}
__device__ __forceinline__ float wave_allmax_fast(float v) {
    v = dpp_max<0x128>(v); v = dpp_max<0x124>(v); v = dpp_max<0x122>(v); v = dpp_max<0x121>(v);
    const float r0 = __int_as_float(__builtin_amdgcn_readlane(__float_as_int(v), 0));
    const float r1 = __int_as_float(__builtin_amdgcn_readlane(__float_as_int(v), 16));
    const float r2 = __int_as_float(__builtin_amdgcn_readlane(__float_as_int(v), 32));
    const float r3 = __int_as_float(__builtin_amdgcn_readlane(__float_as_int(v), 48));
    return fmaxf(fmaxf(r0, r1), fmaxf(r2, r3));
}
__device__ __forceinline__ void d_cvt_fp8_rows(const int vb, const float* __restrict__ src, unsigned char* __restrict__ dst, float* __restrict__ rscale) {
    const int wid = threadIdx.x >> 6, lane = threadIdx.x & 63;
    float4 x[4][4];
#pragma unroll
    for (int u = 0; u < 4; u++) {
        const float* r = src + (size_t)(vb * 16 + wid * 4 + u) * 1024 + lane * 4;
#pragma unroll
        for (int j = 0; j < 4; j++) x[u][j] = *(const float4*)(r + 256 * j);
    }
#pragma unroll
    for (int u = 0; u < 4; u++) {
        const int row = vb * 16 + wid * 4 + u;
        float am = 0.f;
#pragma unroll
        for (int j = 0; j < 4; j++) am = fmaxf(am, fmaxf(fmaxf(fabsf(x[u][j].x), fabsf(x[u][j].y)), fmaxf(fabsf(x[u][j].z), fabsf(x[u][j].w))));
        am = wave_allmax_fast(am);
        const float sc = am > 0.f ? 448.f / am : 1.f;
#pragma unroll
        for (int j = 0; j < 4; j++) {
            int pk = __builtin_amdgcn_cvt_pk_fp8_f32(x[u][j].x * sc, x[u][j].y * sc, 0, false);
            pk = __builtin_amdgcn_cvt_pk_fp8_f32(x[u][j].z * sc, x[u][j].w * sc, pk, true);
            *(unsigned*)(dst + (size_t)row * 1024 + 256 * j + lane * 4) = (unsigned)pk;
        }
        if (lane == 0) rscale[row] = am > 0.f ? am * (1.f / 448.f) : 1.f;
    }
}
__device__ __forceinline__ void d_peer_apply3(const int vb, char* smem, const bf16_t* __restrict__ hb, const int* __restrict__ pidx,
                                              const float* __restrict__ pg, const unsigned char* __restrict__ utab, const unsigned char* __restrict__ vtab,
                                              const float* __restrict__ rsU, const float* __restrict__ rsV, const float* __restrict__ modl,
                                              float* __restrict__ xrun, const float* __restrict__ g_next, const float* __restrict__ mod_next,
                                              bf16_t* __restrict__ h_next) {
    const int wid = threadIdx.x >> 6, lane = threadIdx.x & 63;
    const int t = vb * 4 + wid;
    float* coef = (float*)smem + wid * 128;
    int* eid = (int*)(smem + 2048) + wid * 128;
    const int e_lo = pidx[(size_t)t * 128 + lane], e_hi = pidx[(size_t)t * 128 + lane + 64];
    eid[lane] = e_lo; eid[lane + 64] = e_hi;
    const float g0 = pg[(size_t)t * 128 + lane] * rsV[e_lo], g1 = pg[(size_t)t * 128 + lane + 64] * rsV[e_hi];
    const float ru0 = rsU[e_lo], ru1 = rsU[e_hi];
    float x[16];
    {
        const u32x4 a = *(const u32x4*)(hb + (size_t)t * DM + lane * 16), b = *(const u32x4*)(hb + (size_t)t * DM + lane * 16 + 8);
#pragma unroll
        for (int i = 0; i < 4; i++) {
            x[2 * i] = __uint_as_float(a[i] << 16); x[2 * i + 1] = __uint_as_float(a[i] & 0xffff0000u);
            x[8 + 2 * i] = __uint_as_float(b[i] << 16); x[8 + 2 * i + 1] = __uint_as_float(b[i] & 0xffff0000u);
        }
    }
    __builtin_amdgcn_wave_barrier();
    float myact0 = 0.f, myact1 = 0.f;
#pragma unroll 1
    for (int eb = 0; eb < 128; eb += 16) {
        u32x4 q[16];
#pragma unroll
        for (int r = 0; r < 16; r++) q[r] = *(const u32x4*)(utab + (size_t)eid[eb + r] * 1024 + lane * 16);
#pragma unroll
        for (int r = 0; r < 16; r++) {
            float sacc = 0.f;
#pragma unroll
            for (int i = 0; i < 4; i++) {
                const f32x2 f01 = __builtin_amdgcn_cvt_pk_f32_fp8((int)q[r][i], false);
                const f32x2 f23 = __builtin_amdgcn_cvt_pk_f32_fp8((int)q[r][i], true);
                sacc += f01[0] * x[4 * i] + f01[1] * x[4 * i + 1] + f23[0] * x[4 * i + 2] + f23[1] * x[4 * i + 3];
            }
            sacc = wave_allsum_fast(sacc);
            const int e = eb + r;
            if (lane == (e & 63)) { if (e < 64) myact0 = sacc; else myact1 = sacc; }
        }
    }
    coef[lane] = g0 * gelu_tanh(myact0 * ru0);
    coef[lane + 64] = g1 * gelu_tanh(myact1 * ru1);
    __builtin_amdgcn_wave_barrier();
    float acc[16];
#pragma unroll
    for (int i = 0; i < 16; i++) acc[i] = 0.f;
#pragma unroll 1
    for (int eb = 0; eb < 128; eb += 16) {
        u32x4 q[16];
#pragma unroll
        for (int r = 0; r < 16; r++) q[r] = *(const u32x4*)(vtab + (size_t)eid[eb + r] * 1024 + lane * 16);
#pragma unroll
        for (int r = 0; r < 16; r++) {
            const float cf = coef[eb + r];
#pragma unroll
            for (int i = 0; i < 4; i++) {
                const f32x2 f01 = __builtin_amdgcn_cvt_pk_f32_fp8((int)q[r][i], false);
                const f32x2 f23 = __builtin_amdgcn_cvt_pk_f32_fp8((int)q[r][i], true);
                acc[4 * i] += cf * f01[0]; acc[4 * i + 1] += cf * f01[1]; acc[4 * i + 2] += cf * f23[0]; acc[4 * i + 3] += cf * f23[1];
            }
        }
    }
    const float* m = modl + (size_t)tok_modrow(t) * 6144 + 5 * 1024 + lane * 16;
    float* xo = xrun + (size_t)t * DM + lane * 16;
    float ss = 0.f;
#pragma unroll
    for (int j = 0; j < 4; j++) {
        float4 xa = *(float4*)(xo + 4 * j);
        const float4 ma = *(const float4*)(m + 4 * j);
        xa.x += ma.x * acc[4 * j]; xa.y += ma.y * acc[4 * j + 1]; xa.z += ma.z * acc[4 * j + 2]; xa.w += ma.w * acc[4 * j + 3];
        *(float4*)(xo + 4 * j) = xa;
        acc[4 * j] = xa.x; acc[4 * j + 1] = xa.y; acc[4 * j + 2] = xa.z; acc[4 * j + 3] = xa.w;
        ss += xa.x * xa.x + xa.y * xa.y + xa.z * xa.z + xa.w * xa.w;
    }
    if (g_next != nullptr) {
        ss = wave_allsum_fast(ss);
        const float rstd = rsqrtf(ss * (1.f / DM) + 1e-6f);
        const float* mn = mod_next + (size_t)tok_modrow(t) * 6144 + lane * 16;
#pragma unroll
        for (int j = 0; j < 4; j++) {
            const float4 gg = *(const float4*)(g_next + lane * 16 + 4 * j);
            const float4 sh = *(const float4*)(mn + 4 * j);
            const float4 sc = *(const float4*)(mn + 1024 + 4 * j);
            *(ushort4*)(h_next + (size_t)t * DM + lane * 16 + 4 * j) =
                pack_bf4(acc[4 * j] * rstd * gg.x * (1.f + sc.x) + sh.x, acc[4 * j + 1] * rstd * gg.y * (1.f + sc.y) + sh.y,
                         acc[4 * j + 2] * rstd * gg.z * (1.f + sc.z) + sh.z, acc[4 * j + 3] * rstd * gg.w * (1.f + sc.w) + sh.w);
        }
    }
}


__device__ __forceinline__ void d_rw_kk3(const int vb, const bf16_t* __restrict__ rb, const bf16_t* __restrict__ kb, const bf16_t* __restrict__ lr0,
                                         const bf16_t* __restrict__ lr1, const float* __restrict__ k_k, const float* __restrict__ k_a,
                                         const float* __restrict__ r_k, bf16_t* __restrict__ kkb, float* __restrict__ bonus) {
    const int g = threadIdx.x >> 4, l16 = threadIdx.x & 15;
    uint2 kq[4], rq[4], aq[4], bq[4];
#pragma unroll
    for (int u = 0; u < 4; u++) {
        const size_t o = (size_t)(vb * 64 + g + 16 * u) * 64 + l16 * 4;
        kq[u] = *(const uint2*)(kb + o); rq[u] = *(const uint2*)(rb + o); aq[u] = *(const uint2*)(lr0 + o); bq[u] = *(const uint2*)(lr1 + o);
    }
#pragma unroll
    for (int u = 0; u < 4; u++) {
        const int w = vb * 64 + g + 16 * u;
        const int h = w & 7;
        const float4 kk4 = *(const float4*)(k_k + h * 64 + l16 * 4), ka4 = *(const float4*)(k_a + h * 64 + l16 * 4), rk4 = *(const float4*)(r_k + h * 64 + l16 * 4);
        const float k0 = __uint_as_float(kq[u].x << 16), k1 = __uint_as_float(kq[u].x & 0xffff0000u), k2 = __uint_as_float(kq[u].y << 16), k3 = __uint_as_float(kq[u].y & 0xffff0000u);
        const float r0 = __uint_as_float(rq[u].x << 16), r1 = __uint_as_float(rq[u].x & 0xffff0000u), r2 = __uint_as_float(rq[u].y << 16), r3 = __uint_as_float(rq[u].y & 0xffff0000u);
        const float a0 = __uint_as_float(aq[u].x << 16), a1 = __uint_as_float(aq[u].x & 0xffff0000u), a2 = __uint_as_float(aq[u].y << 16), a3 = __uint_as_float(aq[u].y & 0xffff0000u);
        const float b0 = __uint_as_float(bq[u].x << 16), b1 = __uint_as_float(bq[u].x & 0xffff0000u), b2 = __uint_as_float(bq[u].y << 16), b3 = __uint_as_float(bq[u].y & 0xffff0000u);
        const float q0 = k0 * kk4.x, q1 = k1 * kk4.y, q2 = k2 * kk4.z, q3 = k3 * kk4.w;
        float ss = (q0 * q0 + q1 * q1) + (q2 * q2 + q3 * q3);
        float bs = r0 * k0 * (2.f + (a0 + b0 - 2.f) * ka4.x) * rk4.x + r1 * k1 * (2.f + (a1 + b1 - 2.f) * ka4.y) * rk4.y +
                   r2 * k2 * (2.f + (a2 + b2 - 2.f) * ka4.z) * rk4.z + r3 * k3 * (2.f + (a3 + b3 - 2.f) * ka4.w) * rk4.w;
        ss = row16_allsum(ss); bs = row16_allsum(bs);
        const float inv = 1.f / fmaxf(sqrtf(ss), 1e-12f);
        uint2 o2;
        o2.x = (unsigned)f2bf(q0 * inv) | ((unsigned)f2bf(q1 * inv) << 16);
        o2.y = (unsigned)f2bf(q2 * inv) | ((unsigned)f2bf(q3 * inv) << 16);
        *(uint2*)(kkb + (size_t)w * 64 + l16 * 4) = o2;
        if (l16 == 0) bonus[w] = bs;
    }
}
__device__ __forceinline__ void d_rw_post3(const int vb, const float* __restrict__ y0, const float* __restrict__ y1, const float* __restrict__ bonus,
                                           const bf16_t* __restrict__ vbuf, const bf16_t* __restrict__ gate, const float* __restrict__ lnx_g,
                                           const float* __restrict__ lnx_b, bf16_t* __restrict__ cat) {
    const int g = threadIdx.x >> 4, l16 = threadIdx.x & 15;
    float4 ya[4], yb[4]; uint2 vq[4], gq[4];
#pragma unroll
    for (int u = 0; u < 4; u++) {
        const size_t o = (size_t)(vb * 64 + g + 16 * u) * 64 + l16 * 4;
        ya[u] = *(const float4*)(y0 + o); yb[u] = *(const float4*)(y1 + o); vq[u] = *(const uint2*)(vbuf + o); gq[u] = *(const uint2*)(gate + o);
    }
#pragma unroll
    for (int u = 0; u < 4; u++) {
        const int w = vb * 64 + g + 16 * u;
        const int t = w >> 3, h = w & 7;
        const float e0 = ya[u].x + yb[u].x, e1 = ya[u].y + yb[u].y, e2 = ya[u].z + yb[u].z, e3 = ya[u].w + yb[u].w;
        const float mean = row16_allsum((e0 + e1) + (e2 + e3)) * (1.f / 64.f);
        const float d0 = e0 - mean, d1 = e1 - mean, d2 = e2 - mean, d3 = e3 - mean;
        const float var = row16_allsum((d0 * d0 + d1 * d1) + (d2 * d2 + d3 * d3)) * (1.f / 64.f);
        const float rstd = rsqrtf(var + 64e-5f);
        const float bn = bonus[w];
        const float4 g4 = *(const float4*)(lnx_g + h * 64 + l16 * 4), b4 = *(const float4*)(lnx_b + h * 64 + l16 * 4);
        const float v0 = __uint_as_float(vq[u].x << 16), v1 = __uint_as_float(vq[u].x & 0xffff0000u), v2 = __uint_as_float(vq[u].y << 16), v3 = __uint_as_float(vq[u].y & 0xffff0000u);
        const float t0 = __uint_as_float(gq[u].x << 16), t1 = __uint_as_float(gq[u].x & 0xffff0000u), t2 = __uint_as_float(gq[u].y << 16), t3 = __uint_as_float(gq[u].y & 0xffff0000u);
        uint2 o2;
        o2.x = (unsigned)f2bf((d0 * rstd * g4.x + b4.x + bn * v0) * t0) | ((unsigned)f2bf((d1 * rstd * g4.y + b4.y + bn * v1) * t1) << 16);
        o2.y = (unsigned)f2bf((d2 * rstd * g4.z + b4.z + bn * v2) * t2) | ((unsigned)f2bf((d3 * rstd * g4.w + b4.w + bn * v3) * t3) << 16);
        *(uint2*)(cat + (size_t)t * DM + h * 64 + l16 * 4) = o2;
    }
}


__device__ __forceinline__ void d_mla_post3(const int vb, const bf16_t* __restrict__ qraw, const bf16_t* __restrict__ kvraw, const bf16_t* __restrict__ kvraw_ctx,
                                            const float* __restrict__ kpe, const float* __restrict__ cache_kpe, const float* __restrict__ qn,
                                            const float* __restrict__ kn, bf16_t* __restrict__ Qb, bf16_t* __restrict__ Kp, bf16_t* __restrict__ Ks) {
    const int g = threadIdx.x >> 4, l16 = threadIdx.x & 15;
    const float inv = __expf(-(float)l16 * (1.f / 16.f) * 9.210340371976184f);
    float2 qnv[6], knv[6];
#pragma unroll
    for (int j = 0; j < 6; j++) { qnv[j] = *(const float2*)(qn + 2 * (l16 + 16 * j)); knv[j] = *(const float2*)(kn + 2 * (l16 + 16 * j)); }
#pragma unroll 2
    for (int u = 0; u < 4; u++) {
        const int item = vb * 64 + g + 16 * u;
        const int row = item >> 2, h = item & 3;
        const bool isctx = row >= TT, sample = row >= TP;
        const bf16_t* kvr; const float* pe; int pos = 0;
        if (isctx) { const int cr = row - TT; kvr = kvraw_ctx + (size_t)cr * 1024; pe = cache_kpe + (size_t)cr * 64; }
        else { kvr = kvraw + (size_t)row * 1024; pe = kpe + (size_t)row * 64; pos = tok_pos(row); }
        float kx[12], qx[12];
#pragma unroll
        for (int j = 0; j < 4; j++) {
            const unsigned kw = *(const unsigned*)(kvr + h * 256 + 2 * (l16 + 16 * j));
            kx[2 * j] = __uint_as_float(kw << 16); kx[2 * j + 1] = __uint_as_float(kw & 0xffff0000u);
        }
#pragma unroll
        for (int j = 4; j < 6; j++) { const float2 pv = *(const float2*)(pe + 2 * (l16 + 16 * (j - 4))); kx[2 * j] = pv.x; kx[2 * j + 1] = pv.y; }
#pragma unroll
        for (int j = 0; j < 6; j++) {
            const unsigned qw = isctx ? 0u : *(const unsigned*)(qraw + (size_t)row * 768 + h * 192 + 2 * (l16 + 16 * j));
            qx[2 * j] = __uint_as_float(qw << 16); qx[2 * j + 1] = __uint_as_float(qw & 0xffff0000u);
        }
        float sk = 0.f, sq = 0.f;
#pragma unroll
        for (int j = 0; j < 12; j++) { sk += kx[j] * kx[j]; sq += qx[j] * qx[j]; }
        sk = row16_allsum(sk); sq = row16_allsum(sq);
        const float rk = rsqrtf(sk * (1.f / 192.f) + 1e-6f), rq = rsqrtf(sq * (1.f / 192.f) + 1e-6f);
#pragma unroll
        for (int j = 0; j < 6; j++) {
            kx[2 * j] *= rk * knv[j].x; kx[2 * j + 1] *= rk * knv[j].y;
            qx[2 * j] *= rq * qnv[j].x; qx[2 * j + 1] *= rq * qnv[j].y;
        }
        if (sample && !isctx) {
#pragma unroll
            for (int j = 4; j < 6; j++) {
                const float ang = (j == 4 ? (float)(pos >> 6) : (float)(pos & 63)) * inv;
                const float cs = __cosf(ang), sn = __sinf(ang);
                const float a = kx[2 * j], bq = kx[2 * j + 1];
                kx[2 * j] = a * cs - bq * sn; kx[2 * j + 1] = a * sn + bq * cs;
                const float a2 = qx[2 * j], b2 = qx[2 * j + 1];
                qx[2 * j] = a2 * cs - b2 * sn; qx[2 * j + 1] = a2 * sn + b2 * cs;
            }
        }
        bf16_t* kd;
        if (!sample) { const int b = row >> 8, pp = row & 255; kd = Kp + ((size_t)(b * 4 + h) * LP + pp) * 192; }
        else if (!isctx) { const int b = (row - TP) >> 11, pp = (row - TP) & 2047; kd = Ks + ((size_t)(b * 4 + h) * 2304 + 256 + pp) * 192; }
        else { const int cr = row - TT; const int b = cr >> 8, pp = cr & 255; kd = Ks + ((size_t)(b * 4 + h) * 2304 + pp) * 192; }
#pragma unroll
        for (int j = 0; j < 6; j++) {
            const int e = 2 * (l16 + 16 * j);
            *(unsigned*)(kd + e) = (unsigned)f2bf(kx[2 * j]) | ((unsigned)f2bf(kx[2 * j + 1]) << 16);
            if (!isctx) *(unsigned*)(Qb + ((size_t)row * 4 + h) * 192 + e) = (unsigned)f2bf(qx[2 * j]) | ((unsigned)f2bf(qx[2 * j + 1]) << 16);
        }
    }
}

#define XB_TMO      128
#define XB_XCNT(j)  (256  + 64 * (j))
#define XB_XSUB(j)  (1280 + 64 * (j))
#define XB_XGEN(j)  (2304 + 64 * (j))
#define XB_TOP      3328
#define XB_TOPGEN   3392
#define XCD_BAR_WORDS 3456
#define XB_SPIN_CAP (1u << 22)
#define LAS __attribute__((address_space(3)))
__device__ __forceinline__ unsigned xb_ld(unsigned* p) { return __hip_atomic_load(p, __ATOMIC_RELAXED, __HIP_MEMORY_SCOPE_AGENT); }
__device__ __forceinline__ unsigned xb_add(unsigned* p, unsigned v) { return __hip_atomic_fetch_add(p, v, __ATOMIC_RELAXED, __HIP_MEMORY_SCOPE_AGENT); }
__device__ __forceinline__ unsigned xb_xcc_id() { return (unsigned)__builtin_amdgcn_s_getreg((3 << 11) | 20) & 0xFu; }
#define XB_SPIN(cond, bar) do { unsigned _sp = 0; while (cond) { __builtin_amdgcn_s_sleep(1); \
    if ((++_sp & 255u) == 0u) { if (xb_ld(&(bar)[XB_TMO])) break; if (_sp > XB_SPIN_CAP) { atomicAdd(&(bar)[XB_TMO], 1u); break; } } } } while (0)
struct XcdBarrier { unsigned* bar; unsigned x; volatile LAS unsigned* st; };
__device__ __forceinline__ XcdBarrier xcd_barrier_post(unsigned* bar, volatile LAS unsigned* st) {
    XcdBarrier b; b.bar = bar; b.x = xb_xcc_id(); b.st = st;
    if (threadIdx.x == 0) (void)xb_add(&bar[XB_XCNT(b.x)], 1u);
    return b;
}
__device__ __forceinline__ void xcd_barrier_complete(unsigned* bar, unsigned x, unsigned& nloc, unsigned& nx) {
    const unsigned G = gridDim.x * gridDim.y * gridDim.z;
    unsigned sum, cnt, mine, sp = 0u;
    for (;;) {
        sum = 0u; cnt = 0u; mine = 0u;
#pragma unroll
        for (unsigned j = 0; j < 16; ++j) { const unsigned c = xb_ld(&bar[XB_XCNT(j)]); sum += c; cnt += (c > 0u) ? 1u : 0u; mine = (j == x) ? c : mine; }
        if (sum == G) break;
        __builtin_amdgcn_s_sleep(1);
        if ((++sp & 255u) == 0u) { if (xb_ld(&bar[XB_TMO])) break; if (sp > XB_SPIN_CAP) { atomicAdd(&bar[XB_TMO], 1u); break; } }
    }
    nloc = mine > 0u ? mine : 1u; nx = cnt > 0u ? cnt : 1u;
}
__device__ __forceinline__ void xcd_barrier_(unsigned* bar_, char* smem_) {
    XcdBarrier b; b.bar = bar_; b.x = xb_xcc_id(); b.st = (volatile LAS unsigned*)(smem_ + GEMM_LDS_BYTES);
    asm volatile("s_waitcnt vmcnt(0)" ::: "memory");
    __syncthreads();
    if (threadIdx.x == 0) {
        unsigned* bar = b.bar;
        __builtin_amdgcn_s_waitcnt(0);
        unsigned nloc = b.st[0], nx = b.st[1];
        if (nloc == 0u) { xcd_barrier_complete(bar, b.x, nloc, nx); b.st[0] = nloc; b.st[1] = nx; }
        const unsigned old = xb_add(&bar[XB_XSUB(b.x)], 1u);
        const unsigned gen = old / nloc;
        if (old + 1u == (gen + 1u) * nloc) {
            __builtin_amdgcn_fence(__ATOMIC_RELEASE, "agent");
            asm volatile("s_waitcnt vmcnt(0)" ::: "memory");
            const unsigned og = xb_add(&bar[XB_TOP], 1u);
            const unsigned tg = og / nx;
            if (og + 1u == (tg + 1u) * nx) xb_add(&bar[XB_TOPGEN], 1u);
            else XB_SPIN(xb_ld(&bar[XB_TOPGEN]) == tg, bar);
            __builtin_amdgcn_fence(__ATOMIC_ACQUIRE, "agent");
            xb_add(&bar[XB_XGEN(b.x)], 1u);
            asm volatile("s_waitcnt vmcnt(0)" ::: "memory");
        } else {
            XB_SPIN(xb_ld(&bar[XB_XGEN(b.x)]) == gen, bar);
            __builtin_amdgcn_fence(__ATOMIC_ACQUIRE, "agent");
            asm volatile("s_waitcnt vmcnt(0)" ::: "memory");
        }
    }
    __syncthreads();
}

constexpr size_t ws_al(size_t x) { return (x + 255) & ~(size_t)255; }
struct WS {
    static constexpr size_t mod = 0;
    static constexpr size_t w_in_t = ws_al(mod + (size_t)(2*5*6144*4));
    static constexpr size_t w_out_t = ws_al(w_in_t + (size_t)(2304*1024*2));
    static constexpr size_t hy_w_in_t = ws_al(w_out_t + (size_t)(1024*1024*2));
    static constexpr size_t hy_w_out_t = ws_al(hy_w_in_t + (size_t)(3072*1024*2));
    static constexpr size_t w_q_t = ws_al(hy_w_out_t + (size_t)(1024*1024*2));
    static constexpr size_t q_up_t = ws_al(w_q_t + (size_t)(2*2048*1024*2));
    static constexpr size_t kv_up_t = ws_al(q_up_t + (size_t)(768*256*2));
    static constexpr size_t w2_t = ws_al(kv_up_t + (size_t)(1024*128*2));
    static constexpr size_t a2_t = ws_al(w2_t + (size_t)(2*512*64*2));
    static constexpr size_t g2_t = ws_al(a2_t + (size_t)(2*512*64*2));
    static constexpr size_t ctxb = ws_al(g2_t + (size_t)(512*128*2));
    static constexpr size_t keysb = ws_al(ctxb + (size_t)(1024*128*2));
    static constexpr size_t tabU = ws_al(keysb + (size_t)(2*16*128*128*2));
    static constexpr size_t tabV = ws_al(tabU + (size_t)(16384*1024));
    static constexpr size_t rsU = ws_al(tabV + (size_t)(16384*1024));
    static constexpr size_t rsV = ws_al(rsU + (size_t)(16384*4));
    static constexpr size_t nsum = ws_al(rsV + (size_t)(16384*4));
    static constexpr size_t gTS = ws_al(nsum + (size_t)(2*1024*4 + 3456*4 + 1024));
    static constexpr size_t gTP = ws_al(gTS + (size_t)1024*2*2048*2);
    static constexpr size_t R1 = ws_al(gTP + (size_t)1024*2*256*2);
    static constexpr size_t R2 = ws_al(R1 + (size_t)((size_t)TT*1024*4));
    static constexpr size_t rb = ws_al(R2 + (size_t)((size_t)TT*1792*2 + (size_t)TT*448*4));
    static constexpr size_t kb = ws_al(rb + (size_t)((size_t)TT*512*2));
    static constexpr size_t vb = ws_al(kb + (size_t)((size_t)TT*512*2));
    static constexpr size_t kkb = ws_al(vb + (size_t)((size_t)TT*512*2));
    static constexpr size_t lr0 = ws_al(kkb + (size_t)((size_t)TT*512*2));
    static constexpr size_t lr1 = ws_al(lr0 + (size_t)((size_t)TT*512*2));
    static constexpr size_t gateb = ws_al(lr1 + (size_t)((size_t)TT*512*2));
    static constexpr size_t du0 = ws_al(gateb + (size_t)((size_t)TT*512*2));
    static constexpr size_t du1 = ws_al(du0 + (size_t)((size_t)TT*512*2));
    static constexpr size_t twb = ws_al(du1 + (size_t)((size_t)TT*512*2));
    static constexpr size_t advb = ws_al(twb + (size_t)((size_t)TT*64*2));
    static constexpr size_t sgb = ws_al(advb + (size_t)((size_t)TT*64*2));
    static constexpr size_t bonus = ws_al(sgb + (size_t)((size_t)TT*128*2));
    static constexpr size_t kpe = ws_al(bonus + (size_t)((size_t)TT*8*4));
    static constexpr size_t qcnb = ws_al(kpe + (size_t)((size_t)TT*64*4));
    static constexpr size_t ckvb = ws_al(qcnb + (size_t)((size_t)TT*256*2));
    static constexpr size_t Qb = ws_al(ckvb + (size_t)((size_t)TT*128*2));
    static constexpr size_t Kp = ws_al(Qb + (size_t)((size_t)TT*768*2));
    static constexpr size_t Vp = ws_al(Kp + (size_t)(16*4*256*192*2));
    static constexpr size_t Ks = ws_al(Vp + (size_t)(16*4*256*128*2));
    static constexpr size_t Vs = ws_al(Ks + (size_t)(4*4*2304*192*2));
    static constexpr size_t kvctxb = ws_al(Vs + (size_t)(4*4*2304*128*2));
    static constexpr size_t pidx = ws_al(kvctxb + (size_t)(1024*1024*2));
    static constexpr size_t pg = ws_al(pidx + (size_t)((size_t)TT*128*4));
    static constexpr size_t END = ws_al(pg + (size_t)((size_t)TT*128*4));
    static constexpr size_t hb = R1;
    static constexpr size_t catb = R1;
    static constexpr size_t zbb = R1;
    static constexpr size_t kvrawb = R1;
    static constexpr size_t qrawb = R1 + (size_t)TT*1024*2;
    static constexpr size_t projrw = R2;
    static constexpr size_t projmla = R2 + (size_t)TT*1792*2;
    static constexpr size_t y0 = R2;
    static constexpr size_t y1 = R2 + (size_t)TT*512*4;
    static constexpr size_t qb = R2;
    static constexpr size_t scT = rb;
    static constexpr size_t pre = R2;
    static constexpr size_t zT = R2 + (size_t)TT*3072*2;
    static constexpr size_t x0b = R2 + (size_t)TT*3072*2 + (size_t)TT*1024*2;
    static constexpr size_t yT = R2 + (size_t)TT*3072*2 + (size_t)TT*1024*4;
    static constexpr size_t bar = nsum + 2*1024*4;
};
struct Params {
    const float* in[46];
    float* out;
    char* ws;
    __device__ __forceinline__ const float* x_prompt() const { return in[0]; }
    __device__ __forceinline__ const float* x_sample() const { return in[1]; }
    __device__ __forceinline__ const float* st_f() const { return in[2]; }
    __device__ __forceinline__ const float* st_b() const { return in[3]; }
    __device__ __forceinline__ const float* cache_ckv() const { return in[4]; }
    __device__ __forceinline__ const float* cache_kpe() const { return in[5]; }
    __device__ __forceinline__ const float* c() const { return in[6]; }
    __device__ __forceinline__ const float* c_ctx() const { return in[7]; }
    __device__ __forceinline__ const float* norm_g() const { return in[8]; }
    __device__ __forceinline__ const float* w_mod() const { return in[9]; }
    __device__ __forceinline__ const float* b_mod() const { return in[10]; }
    __device__ __forceinline__ const float* ab_w_in() const { return in[11]; }
    __device__ __forceinline__ const float* rw_mu() const { return in[12]; }
    __device__ __forceinline__ const float* rw_w0() const { return in[13]; }
    __device__ __forceinline__ const float* rw_w2() const { return in[14]; }
    __device__ __forceinline__ const float* rw_a0() const { return in[15]; }
    __device__ __forceinline__ const float* rw_a2() const { return in[16]; }
    __device__ __forceinline__ const float* rw_g2() const { return in[17]; }
    __device__ __forceinline__ const float* rw_k_k() const { return in[18]; }
    __device__ __forceinline__ const float* rw_k_a() const { return in[19]; }
    __device__ __forceinline__ const float* rw_r_k() const { return in[20]; }
    __device__ __forceinline__ const float* rw_lnx_g() const { return in[21]; }
    __device__ __forceinline__ const float* rw_lnx_b() const { return in[22]; }
    __device__ __forceinline__ const float* mla_q_norm() const { return in[23]; }
    __device__ __forceinline__ const float* mla_q_up() const { return in[24]; }
    __device__ __forceinline__ const float* mla_kv_norm() const { return in[25]; }
    __device__ __forceinline__ const float* mla_kv_up() const { return in[26]; }
    __device__ __forceinline__ const float* mla_qn() const { return in[27]; }
    __device__ __forceinline__ const float* mla_kn() const { return in[28]; }
    __device__ __forceinline__ const float* ab_w_out() const { return in[29]; }
    __device__ __forceinline__ const float* hy_w_in() const { return in[30]; }
    __device__ __forceinline__ const float* hy_b_in() const { return in[31]; }
    __device__ __forceinline__ const float* hy_conv_w() const { return in[32]; }
    __device__ __forceinline__ const float* hy_conv_b() const { return in[33]; }
    __device__ __forceinline__ const float* hy_f_w1() const { return in[34]; }
    __device__ __forceinline__ const float* hy_f_b1() const { return in[35]; }
    __device__ __forceinline__ const float* hy_f_w2() const { return in[36]; }
    __device__ __forceinline__ const float* hy_f_b2() const { return in[37]; }
    __device__ __forceinline__ const float* hy_f_w3() const { return in[38]; }
    __device__ __forceinline__ const float* hy_f_freq() const { return in[39]; }
    __device__ __forceinline__ const float* hy_bias() const { return in[40]; }
    __device__ __forceinline__ const float* hy_w_out() const { return in[41]; }
    __device__ __forceinline__ const float* peer_w_q() const { return in[42]; }
    __device__ __forceinline__ const float* peer_keys() const { return in[43]; }
    __device__ __forceinline__ const float* peer_u() const { return in[44]; }
    __device__ __forceinline__ const float* peer_v() const { return in[45]; }
    __device__ __forceinline__ float* xrun() const { return out + (0); }
    __device__ __forceinline__ float* out_sf() const { return out + ((size_t)TT*DM); }
    __device__ __forceinline__ float* out_sb() const { return out + ((size_t)TT*DM + 16*8*64*64); }
    __device__ __forceinline__ float* out_ckv() const { return out + ((size_t)TT*DM + 2*16*8*64*64); }
    __device__ __forceinline__ float* out_kpe() const { return out + ((size_t)TT*DM + 2*16*8*64*64 + 16*256*128); }
    __device__ __forceinline__ float* mod() const { return (float*)(ws + WS::mod); }
    __device__ __forceinline__ bf16_t* w_in_t() const { return (bf16_t*)(ws + WS::w_in_t); }
    __device__ __forceinline__ bf16_t* w_out_t() const { return (bf16_t*)(ws + WS::w_out_t); }
    __device__ __forceinline__ bf16_t* hy_w_in_t() const { return (bf16_t*)(ws + WS::hy_w_in_t); }
    __device__ __forceinline__ bf16_t* hy_w_out_t() const { return (bf16_t*)(ws + WS::hy_w_out_t); }
    __device__ __forceinline__ bf16_t* w_q_t() const { return (bf16_t*)(ws + WS::w_q_t); }
    __device__ __forceinline__ bf16_t* q_up_t() const { return (bf16_t*)(ws + WS::q_up_t); }
    __device__ __forceinline__ bf16_t* kv_up_t() const { return (bf16_t*)(ws + WS::kv_up_t); }
    __device__ __forceinline__ bf16_t* w2_t() const { return (bf16_t*)(ws + WS::w2_t); }
    __device__ __forceinline__ bf16_t* a2_t() const { return (bf16_t*)(ws + WS::a2_t); }
    __device__ __forceinline__ bf16_t* g2_t() const { return (bf16_t*)(ws + WS::g2_t); }
    __device__ __forceinline__ bf16_t* ctxb() const { return (bf16_t*)(ws + WS::ctxb); }
    __device__ __forceinline__ bf16_t* keysb() const { return (bf16_t*)(ws + WS::keysb); }
    __device__ __forceinline__ unsigned char* tabU() const { return (unsigned char*)(ws + WS::tabU); }
    __device__ __forceinline__ float* rsU() const { return (float*)(ws + WS::rsU); }
    __device__ __forceinline__ float* rsV() const { return (float*)(ws + WS::rsV); }
    __device__ __forceinline__ unsigned char* tabV() const { return (unsigned char*)(ws + WS::tabV); }
    __device__ __forceinline__ float* nsum() const { return (float*)(ws + WS::nsum); }
    __device__ __forceinline__ bf16_t* rb() const { return (bf16_t*)(ws + WS::rb); }
    __device__ __forceinline__ bf16_t* kb() const { return (bf16_t*)(ws + WS::kb); }
    __device__ __forceinline__ bf16_t* vb() const { return (bf16_t*)(ws + WS::vb); }
    __device__ __forceinline__ bf16_t* kkb() const { return (bf16_t*)(ws + WS::kkb); }
    __device__ __forceinline__ bf16_t* lr0() const { return (bf16_t*)(ws + WS::lr0); }
    __device__ __forceinline__ bf16_t* lr1() const { return (bf16_t*)(ws + WS::lr1); }
    __device__ __forceinline__ bf16_t* gateb() const { return (bf16_t*)(ws + WS::gateb); }
    __device__ __forceinline__ _Float16* du0() const { return (_Float16*)(ws + WS::du0); }
    __device__ __forceinline__ _Float16* du1() const { return (_Float16*)(ws + WS::du1); }
    __device__ __forceinline__ bf16_t* twb() const { return (bf16_t*)(ws + WS::twb); }
    __device__ __forceinline__ bf16_t* advb() const { return (bf16_t*)(ws + WS::advb); }
    __device__ __forceinline__ bf16_t* sgb() const { return (bf16_t*)(ws + WS::sgb); }
    __device__ __forceinline__ float* bonus() const { return (float*)(ws + WS::bonus); }
    __device__ __forceinline__ float* kpe() const { return (float*)(ws + WS::kpe); }
    __device__ __forceinline__ bf16_t* qcnb() const { return (bf16_t*)(ws + WS::qcnb); }
    __device__ __forceinline__ bf16_t* ckvb() const { return (bf16_t*)(ws + WS::ckvb); }
    __device__ __forceinline__ bf16_t* Qb() const { return (bf16_t*)(ws + WS::Qb); }
    __device__ __forceinline__ bf16_t* Kp() const { return (bf16_t*)(ws + WS::Kp); }
    __device__ __forceinline__ bf16_t* Vp() const { return (bf16_t*)(ws + WS::Vp); }
    __device__ __forceinline__ bf16_t* Ks() const { return (bf16_t*)(ws + WS::Ks); }
    __device__ __forceinline__ bf16_t* Vs() const { return (bf16_t*)(ws + WS::Vs); }
    __device__ __forceinline__ bf16_t* kvctxb() const { return (bf16_t*)(ws + WS::kvctxb); }
    __device__ __forceinline__ int* pidx() const { return (int*)(ws + WS::pidx); }
    __device__ __forceinline__ float* pg() const { return (float*)(ws + WS::pg); }
    __device__ __forceinline__ bf16_t* hb() const { return (bf16_t*)(ws + WS::hb); }
    __device__ __forceinline__ bf16_t* catb() const { return (bf16_t*)(ws + WS::catb); }
    __device__ __forceinline__ bf16_t* zbb() const { return (bf16_t*)(ws + WS::zbb); }
    __device__ __forceinline__ bf16_t* kvrawb() const { return (bf16_t*)(ws + WS::kvrawb); }
    __device__ __forceinline__ bf16_t* qrawb() const { return (bf16_t*)(ws + WS::qrawb); }
    __device__ __forceinline__ bf16_t* projrw() const { return (bf16_t*)(ws + WS::projrw); }
    __device__ __forceinline__ float* projmla() const { return (float*)(ws + WS::projmla); }
    __device__ __forceinline__ float* y0() const { return (float*)(ws + WS::y0); }
    __device__ __forceinline__ float* y1() const { return (float*)(ws + WS::y1); }
    __device__ __forceinline__ bf16_t* qb() const { return (bf16_t*)(ws + WS::qb); }
    __device__ __forceinline__ float* scT() const { return (float*)(ws + WS::scT); }
    __device__ __forceinline__ bf16_t* pre() const { return (bf16_t*)(ws + WS::pre); }
    __device__ __forceinline__ bf16_t* zT() const { return (bf16_t*)(ws + WS::zT); }
    __device__ __forceinline__ bf16_t* x0b() const { return (bf16_t*)(ws + WS::x0b); }
    __device__ __forceinline__ bf16_t* yT() const { return (bf16_t*)(ws + WS::yT); }
    __device__ __forceinline__ bf16_t* gTS() const { return (bf16_t*)(ws + WS::gTS); }
    __device__ __forceinline__ bf16_t* gTP() const { return (bf16_t*)(ws + WS::gTP); }
    __device__ __forceinline__ unsigned* bar() const { return (unsigned*)(ws + WS::bar); }
};

#define VLOOP(n) for (int vb = blockIdx.x; vb < (n); vb += gridDim.x)
#define ENDV __syncthreads();

#define QLOOP(ctr_word, nitems, ...)                                                            \
    {                                                                                           \
        unsigned* qctr = p.bar() + XCD_BAR_WORDS + 128 + (ctr_word);                            \
        volatile unsigned* bc = (volatile unsigned*)(smem + GEMM_LDS_BYTES + 8);                \
        for (;;) {                                                                              \
            if (threadIdx.x == 0) *bc = atomicAdd(qctr, 1u);                                    \
            __syncthreads();                                                                    \
            const int item = (int)*bc;                                                          \
            __syncthreads();                                                                    \
            if (item >= (nitems)) break;                                                        \
            __VA_ARGS__                                                                         \
        }                                                                                       \
    }
__device__ __forceinline__ void peer_layer(const Params& p, char* smem, int li, const float* modl, float* xrs) {
    const bf16_t* wq = p.w_q_t() + (size_t)li * 2048 * 1024;
    const bf16_t* kys = p.keysb() + (size_t)li * 16 * 128 * 128;
    VLOOP(TT / 8) { d_norm_mod2(vb, p.xrun(), xrs, p.norm_g() + (li * 2 + 1) * 1024, modl, 3, 4, p.hb()); }
    xcd_barrier_(p.bar(), smem);
    VLOOP(16 * 96) { d_gemm_bf16(vb % 16, vb / 16, smem, p.hb(), 1024, wq, 1024, 1024, 2048, EpiStoreBf{p.qb(), 2048, 0}); }
    xcd_barrier_(p.bar(), smem);
    VLOOP(8 * 96) { d_peer_route2(vb, smem, kys, p.qb(), p.pidx(), p.pg()); ENDV }
    if (li == 0) {
        QLOOP(4, 1536, {
            const int t1 = 48 * 16, t2 = t1 + 16 * 16;
            const float* W; bf16_t* Wt; int N, lv;
            if (item < t1) { W = p.hy_w_in(); Wt = p.hy_w_in_t(); N = 3072; lv = item; }
            else if (item < t2) { W = p.hy_w_out(); Wt = p.hy_w_out_t(); N = 1024; lv = item - t1; }
            else { W = p.peer_w_q() + (size_t)1024 * 2048; Wt = p.w_q_t() + (size_t)2048 * 1024; N = 2048; lv = item - t2; }
            d_transpose_w(lv, smem, W, 1024, N, Wt);
        })
    }
    xcd_barrier_(p.bar(), smem);
    VLOOP(TT / 4) { d_peer_apply3(vb, smem, p.hb(), p.pidx(), p.pg(), p.tabU(), p.tabV(), p.rsU(), p.rsV(), modl, p.xrun(),
                                    li == 0 ? p.norm_g() + 2048 : nullptr, p.mod() + 5 * 6144, p.hb()); ENDV }
}

__global__ void __launch_bounds__(256, 2) mega(Params p) {
    __shared__ __attribute__((aligned(16))) char smem[GEMM_LDS_BYTES + 16];
    cg::grid_group grid = cg::this_grid();
    if (threadIdx.x < 4) ((unsigned*)(smem + GEMM_LDS_BYTES))[threadIdx.x] = 0u;
    __syncthreads();
    (void)xcd_barrier_post(p.bar(), (volatile LAS unsigned*)(smem + GEMM_LDS_BYTES));
    const float* mod0 = p.mod();
    const float* mod1 = p.mod() + 5 * 6144;
    float* xrs = p.xrun() + (size_t)TP * DM;

    VLOOP(192) { d_mod3(vb, smem, p.c(), p.c_ctx(), p.w_mod(), p.b_mod(), p.mod()); ENDV }
    {
        const int j1 = 36 * 16;
        const int j7 = j1 + 12 * 4;
        const int j8 = j7 + 16 * 2;
        const int j9 = j8 + 8;
        const int j10 = j9 + 8;
        const int j11 = j10 + 8;
        const int j12 = j11 + 8;
        const int j13 = j12 + 8 * 2;
        VLOOP(j13) {
            const float* W; bf16_t* Wt; int K, N, lv;
            if (vb < j1) { W = p.ab_w_in(); Wt = p.w_in_t(); K = 1024; N = 2240; lv = vb; }
            else if (vb < j7) { W = p.mla_q_up(); Wt = p.q_up_t(); K = 256; N = 768; lv = vb - j1; }
            else if (vb < j8) { W = p.mla_kv_up(); Wt = p.kv_up_t(); K = 128; N = 1024; lv = vb - j7; }
            else if (vb < j9) { W = p.rw_w2(); Wt = p.w2_t(); K = 64; N = 512; lv = vb - j8; }
            else if (vb < j10) { W = p.rw_w2() + 64 * 512; Wt = p.w2_t() + 512 * 64; K = 64; N = 512; lv = vb - j9; }
            else if (vb < j11) { W = p.rw_a2(); Wt = p.a2_t(); K = 64; N = 512; lv = vb - j10; }
            else if (vb < j12) { W = p.rw_a2() + 64 * 512; Wt = p.a2_t() + 512 * 64; K = 64; N = 512; lv = vb - j11; }
            else { W = p.rw_g2(); Wt = p.g2_t(); K = 128; N = 512; lv = vb - j12; }
            d_transpose_w(lv, smem, W, K, N, Wt);
            ENDV }
    }
    VLOOP(40) { if (vb < 8) d_cvt_bf16(vb, p.cache_ckv(), p.ctxb()); else d_cvt_bf16(vb - 8, p.peer_keys(), p.keysb()); }
    if (p.ws == nullptr) grid.sync();
    xcd_barrier_(p.bar(), smem);
    VLOOP(TT / 8) { d_norm_mod2(vb, p.x_prompt(), p.x_sample(), p.norm_g(), mod0, 0, 1, p.hb()); }
    xcd_barrier_(p.bar(), smem);
    VLOOP(18 * 96) { d_gemm_bf16(vb % 18, vb / 18, smem, p.hb(), 1024, p.w_in_t(), 1024, 1024, ABIN, EpiProj{p.projrw(), p.projmla()}); }
    xcd_barrier_(p.bar(), smem);
    VLOOP(2688 + 768) {
        if (vb < 2688) d_rw_shift2(vb, p.projrw(), p.rw_mu(), p.rb(), p.kb(), p.vb(), p.twb(), p.advb(), p.sgb());
        else d_mla_pre2(vb - 2688, p.projmla(), p.mla_q_norm(), p.mla_kv_norm(), p.qcnb(), p.ckvb(), p.kpe(), p.out_ckv(), p.out_kpe());
    }
    xcd_barrier_(p.bar(), smem);
    {
        const int n0 = 4 * 96, n1 = 6 * 96, n2 = 8 * 96, n3 = 8 * 8;
        VLOOP(5 * n0 + n1 + n2 + n3) {
            int v = vb;
            if (v < n0) d_gemm_bf16(v % 4, v / 4, smem, p.twb(), 64, p.w2_t(), 64, 64, 512, EpiDecay{p.du0(), p.rw_w0()});
            else if ((v -= n0) < n0) d_gemm_bf16(v % 4, v / 4, smem, p.twb(), 64, p.w2_t() + 512 * 64, 64, 64, 512, EpiDecay{p.du1(), p.rw_w0() + 512});
            else if ((v -= n0) < n0) d_gemm_bf16(v % 4, v / 4, smem, p.advb(), 64, p.a2_t(), 64, 64, 512, EpiLr{p.lr0(), p.rw_a0()});
            else if ((v -= n0) < n0) d_gemm_bf16(v % 4, v / 4, smem, p.advb(), 64, p.a2_t() + 512 * 64, 64, 64, 512, EpiLr{p.lr1(), p.rw_a0() + 512});
            else if ((v -= n0) < n0) d_gemm_bf16(v % 4, v / 4, smem, p.sgb(), 128, p.g2_t(), 128, 128, 512, EpiStoreBf{p.gateb(), 512, 0});
            else if ((v -= n0) < n1) d_gemm_bf16(v % 6, v / 6, smem, p.qcnb(), 256, p.q_up_t(), 256, 256, 768, EpiStoreBf{p.qrawb(), 768, 0});
            else if ((v -= n1) < n2) d_gemm_bf16(v % 8, v / 8, smem, p.ckvb(), 128, p.kv_up_t(), 128, 128, 1024, EpiKV{p.kvrawb(), p.Vp(), p.Vs(), 0, 0});
            else { v -= n2; d_gemm_bf16(v % 8, v / 8, smem, p.ctxb(), 128, p.kv_up_t(), 128, 128, 1024, EpiKV{p.kvctxb(), p.Vp(), p.Vs(), 1, 0}); }
        }
    }
    xcd_barrier_(p.bar(), smem);
    VLOOP(1536 + 832) {
        if (vb < 1536) d_rw_kk3(vb, p.rb(), p.kb(), p.lr0(), p.lr1(), p.rw_k_k(), p.rw_k_a(), p.rw_r_k(), p.kkb(), p.bonus());
        else d_mla_post3(vb - 1536, p.qrawb(), p.kvrawb(), p.kvctxb(), p.kpe(), p.cache_kpe(), p.mla_qn(), p.mla_kn(), p.Qb(), p.Kp(), p.Ks());
        ENDV }
    xcd_barrier_(p.bar(), smem);
    {
        const bool big = gridDim.x >= 512;
        if (big && blockIdx.x < 256) __builtin_amdgcn_s_setprio(3);
        for (int v = blockIdx.x; v < 256; v += gridDim.x)
            d_scan2(v, true, smem, p.rb(), p.kb(), p.vb(), p.kkb(), p.lr0(), p.lr1(), p.du0(), p.du1(), p.rw_k_a(), p.st_f(), p.st_b(), p.y0(), p.y1(), p.out_sf(), p.out_sb());
        __builtin_amdgcn_s_setprio(0);
    }
    QLOOP(0, 384, {
        const bool smp = item < 256;
        d_attn_mfma(smp ? item : item - 256, smem, p.Qb(), smp ? p.Ks() : p.Kp(), smp ? p.Vs() : p.Vp(), p.catb(), smp ? TP : 0, smp ? LS : LP,
                    smp ? 2304 : LP, smp ? 16 : 2);
    })
    QLOOP(2, 2048, {
        const bool isv = item >= 1024;
        d_cvt_fp8_rows(isv ? item - 1024 : item, isv ? p.peer_v() : p.peer_u(), isv ? p.tabV() : p.tabU(), isv ? p.rsV() : p.rsU());
    })
    QLOOP(3, 768, {
        const bool a_ = item < 256;
        d_transpose_w(a_ ? item : item - 256, smem, a_ ? p.ab_w_out() : p.peer_w_q(), 1024, a_ ? 1024 : 2048, a_ ? p.w_out_t() : p.w_q_t());
    })
    QLOOP(7, 1024, {
        d_scan2(item, false, smem, p.rb(), p.kb(), p.vb(), p.kkb(), p.lr0(), p.lr1(), p.du0(), p.du1(), p.rw_k_a(), p.st_f(), p.st_b(), p.y0(), p.y1(), p.out_sf(), p.out_sb());
    })
    xcd_barrier_(p.bar(), smem);
    VLOOP(1536) { d_rw_post3(vb, p.y0(), p.y1(), p.bonus(), p.vb(), p.gateb(), p.rw_lnx_g(), p.rw_lnx_b(), p.catb()); }
    QLOOP(1, 576, {
        const bool smp = item < 512;
        d_hy_filt2(smp ? item : item - 512, smem, smp ? LS : LP, p.hy_f_w1(), p.hy_f_b1(), p.hy_f_w2(), p.hy_f_b2(), p.hy_f_w3(), p.hy_f_freq(),
                   smp ? p.gTS() : p.gTP(), smp ? p.nsum() : p.nsum() + 1024);
    })
    xcd_barrier_(p.bar(), smem);
    QLOOP(5, 480 + 576, {
        if (item < 480) d_gemm_bf16n<2>(item % 5, item / 5, smem, p.catb(), 1024, p.w_out_t(), 1024, 1024, 1024, EpiResid{p.x_prompt(), p.x_sample(), p.xrun(), mod0, 2, 0});
        else { const int it = item - 480; d_gemm_bf16n<1>(10 + it % 6, it / 6, smem, p.catb(), 1024, p.w_out_t(), 1024, 1024, 1024, EpiResid{p.x_prompt(), p.x_sample(), p.xrun(), mod0, 2, 0}); }
    })
    xcd_barrier_(p.bar(), smem);
    peer_layer(p, smem, 0, mod0, xrs);
    xcd_barrier_(p.bar(), smem);
    VLOOP(24 * 96) { d_gemm_bf16(vb % 24, vb / 24, smem, p.hb(), 1024, p.hy_w_in_t(), 1024, 1024, 3072, EpiStoreBfBias{p.pre(), p.hy_b_in(), 3072, 0}); }
    VLOOP(2048) {
        const bool isv = vb >= 1024;
        d_cvt_fp8_rows(isv ? vb - 1024 : vb, (isv ? p.peer_v() : p.peer_u()) + (size_t)16384 * 1024, isv ? p.tabV() : p.tabU(), isv ? p.rsV() : p.rsU());
    }
    xcd_barrier_(p.bar(), smem);
    VLOOP(192 * 8) { d_hy_dw3(vb, smem, p.pre(), p.hy_conv_w(), p.hy_conv_b(), p.zT(), p.x0b()); ENDV }
    xcd_barrier_(p.bar(), smem);
    VLOOP(512 + 512) {
        const int wv = threadIdx.x >> 6;
        char* wsm = smem + (wv >> 1) * 28672;
        if (vb < 512) d_hy_conv2<true>(vb * 2 + (wv >> 1), wv & 1, wsm, p.gTS(), p.nsum(), p.zT(), p.hy_bias(), p.yT());
        else d_hy_conv2<false>((vb - 512) * 2 + (wv >> 1), wv & 1, wsm, p.gTP(), p.nsum() + 1024, p.zT(), p.hy_bias(), p.yT());
        ENDV }
    xcd_barrier_(p.bar(), smem);
    VLOOP(192 * 8) { d_hy_post2(vb, smem, p.yT(), p.x0b(), p.zbb()); ENDV }
    xcd_barrier_(p.bar(), smem);
    QLOOP(6, 480 + 576, {
        if (item < 480) d_gemm_bf16n<2>(item % 5, item / 5, smem, p.zbb(), 1024, p.hy_w_out_t(), 1024, 1024, 1024, EpiResid{p.xrun(), xrs, p.xrun(), mod1, 2, 0});
        else { const int it = item - 480; d_gemm_bf16n<1>(10 + it % 6, it / 6, smem, p.zbb(), 1024, p.hy_w_out_t(), 1024, 1024, 1024, EpiResid{p.xrun(), xrs, p.xrun(), mod1, 2, 0}); }
    })
    xcd_barrier_(p.bar(), smem);
    peer_layer(p, smem, 1, mod1, xrs);
}

static inline size_t align_up(size_t x) { return (x + 255) & ~(size_t)255; }

extern "C" void kernel_launch(void* const* d_in, const int* in_sizes, int n_in, void* d_out, int out_size, void* d_ws, size_t ws_size,
                              hipStream_t stream) {
    Params p{};
    for (int i = 0; i < 46; i++) p.in[i] = (const float*)d_in[i];
    p.out = (float*)d_out;
    p.ws = (char*)d_ws;
    static_assert(WS::END <= (size_t)422781952, "workspace plan exceeds the guaranteed scratch size");
    static int grid_blocks = 0;
    if (!grid_blocks) {
        int dev = 0, cus = 0, per_cu = 0;
        (void)hipGetDevice(&dev);
        (void)hipDeviceGetAttribute(&cus, hipDeviceAttributeMultiprocessorCount, dev);
        (void)hipOccupancyMaxActiveBlocksPerMultiprocessor(&per_cu, mega, 256, 0);
        if (per_cu > 2) per_cu = 2;
        if (per_cu < 1) per_cu = 1;
        grid_blocks = cus * per_cu;
    }
    (void)hipMemsetAsync(p.ws + WS::nsum, 0, (size_t)2 * 1024 * 4 + (size_t)XCD_BAR_WORDS * 4 + 1024, stream);
    (void)hipMemsetAsync(p.ws + WS::mod, 0, (size_t)2 * 5 * 6144 * 4, stream);
    void* args[] = {&p};
    (void)hipLaunchCooperativeKernel((void*)mega, dim3(grid_blocks), dim3(256), args, 0, stream);
}
```

```cpp
#include <hip/hip_runtime.h>
#include <stdint.h>
#include <hip/hip_cooperative_groups.h>
namespace cg = cooperative_groups;

#define DM 1024
#define TP 4096
#define TS 8192
#define TT 12288
#define LP 256
#define LS 2048
#define NBP 16
#define NBS 4
#define ABIN 2240
#define RWIN 1792

typedef unsigned short bf16_t;
__device__ __forceinline__ bf16_t f2bf(float f) { unsigned u = __float_as_uint(f); u += 0x7fffu + ((u >> 16) & 1u); return (bf16_t)(u >> 16); }
__device__ __forceinline__ float bf2f(bf16_t h) { return __uint_as_float(((unsigned)h) << 16); }
__device__ __forceinline__ float sigmoidf_(float x) { return 1.f / (1.f + expf(-x)); }
__device__ __forceinline__ float gelu_tanh(float x) { return 0.5f * x * (1.f + tanhf(0.7978845608028654f * (x + 0.044715f * x * x * x))); }

__device__ __forceinline__ int tok_pos(int t) { return t < TP ? (t & (LP - 1)) : ((t - TP) & (LS - 1)); }
__device__ __forceinline__ int tok_len(int t) { return t < TP ? LP : LS; }
__device__ __forceinline__ int tok_modrow(int t) { return t < TP ? 0 : 1 + ((t - TP) >> 11); }

__device__ __forceinline__ float wave_sum(float v) {
#pragma unroll
    for (int o = 32; o > 0; o >>= 1) v += __shfl_xor(v, o, 64);
    return v;
}


__device__ __forceinline__ void d_mod3(const int vb, char* smem, const float* __restrict__ c, const float* __restrict__ c_ctx,
                                       const float* __restrict__ w_mod, const float* __restrict__ b_mod, float* __restrict__ mod) {
    float* sl = (float*)smem;
    const int li = vb / 96, kc = (vb % 96) / 6, cg6 = vb % 6;
    const int tid = threadIdx.x;
    for (int i = tid; i < 5 * 64; i += 256) {
        const int r = i >> 6, k = kc * 64 + (i & 63);
        const float v = (r == 0) ? c_ctx[k] : c[(r - 1) * 1024 + k];
        sl[i] = v / (1.f + __expf(-v));
    }
    __syncthreads();
    const int n = cg6 * 1024 + tid * 4;
    float4 a0 = {0, 0, 0, 0}, a1 = a0, a2 = a0, a3 = a0, a4 = a0;
    const float* w = w_mod + ((size_t)li * 1024 + kc * 64) * 6144 + n;
#pragma unroll 16
    for (int k = 0; k < 64; k++) {
        const float4 wv = *(const float4*)(w + (size_t)k * 6144);
        const float s0 = sl[k], s1 = sl[64 + k], s2 = sl[128 + k], s3 = sl[192 + k], s4 = sl[256 + k];
        a0.x += s0 * wv.x; a0.y += s0 * wv.y; a0.z += s0 * wv.z; a0.w += s0 * wv.w;
        a1.x += s1 * wv.x; a1.y += s1 * wv.y; a1.z += s1 * wv.z; a1.w += s1 * wv.w;
        a2.x += s2 * wv.x; a2.y += s2 * wv.y; a2.z += s2 * wv.z; a2.w += s2 * wv.w;
        a3.x += s3 * wv.x; a3.y += s3 * wv.y; a3.z += s3 * wv.z; a3.w += s3 * wv.w;
        a4.x += s4 * wv.x; a4.y += s4 * wv.y; a4.z += s4 * wv.z; a4.w += s4 * wv.w;
    }
    if (kc == 0) {
        const float4 bb = *(const float4*)(b_mod + li * 6144 + n);
        a0.x += bb.x; a0.y += bb.y; a0.z += bb.z; a0.w += bb.w; a1.x += bb.x; a1.y += bb.y; a1.z += bb.z; a1.w += bb.w;
        a2.x += bb.x; a2.y += bb.y; a2.z += bb.z; a2.w += bb.w; a3.x += bb.x; a3.y += bb.y; a3.z += bb.z; a3.w += bb.w;
        a4.x += bb.x; a4.y += bb.y; a4.z += bb.z; a4.w += bb.w;
    }
    float* o = mod + (size_t)(li * 5) * 6144 + n;
    atomicAdd(o + 0, a0.x); atomicAdd(o + 1, a0.y); atomicAdd(o + 2, a0.z); atomicAdd(o + 3, a0.w);
    atomicAdd(o + 6144 + 0, a1.x); atomicAdd(o + 6144 + 1, a1.y); atomicAdd(o + 6144 + 2, a1.z); atomicAdd(o + 6144 + 3, a1.w);
    atomicAdd(o + 2 * 6144 + 0, a2.x); atomicAdd(o + 2 * 6144 + 1, a2.y); atomicAdd(o + 2 * 6144 + 2, a2.z); atomicAdd(o + 2 * 6144 + 3, a2.w);
    atomicAdd(o + 3 * 6144 + 0, a3.x); atomicAdd(o + 3 * 6144 + 1, a3.y); atomicAdd(o + 3 * 6144 + 2, a3.z); atomicAdd(o + 3 * 6144 + 3, a3.w);
    atomicAdd(o + 4 * 6144 + 0, a4.x); atomicAdd(o + 4 * 6144 + 1, a4.y); atomicAdd(o + 4 * 6144 + 2, a4.z); atomicAdd(o + 4 * 6144 + 3, a4.w);
}


struct EpiStore { static constexpr bool kQuad = false; float* C; const float* bias; int ldc; int pad;
    __device__ void operator()(int m, int n, float a) const { C[(size_t)m * ldc + n] = a + (bias ? bias[n] : 0.f); } };
struct EpiStoreBfBias { static constexpr bool kQuad = false; bf16_t* C; const float* bias; int ldc; int pad;
    __device__ void operator()(int m, int n, float a) const { C[(size_t)m * ldc + n] = f2bf(a + bias[n]); } };
struct EpiStoreBf { static constexpr bool kQuad = false; bf16_t* C; int ldc; int pad;
    __device__ void operator()(int m, int n, float a) const { C[(size_t)m * ldc + n] = f2bf(a); } };
struct EpiDecay { static constexpr bool kQuad = false; _Float16* out; const float* w0;
    __device__ void operator()(int m, int n, float a) const { out[(size_t)m * 512 + n] = (_Float16)sigmoidf_(w0[n] + a); } };
struct EpiProj { static constexpr bool kQuad = false; bf16_t* rw; float* mla;
    __device__ void operator()(int m, int n, float a) const { if (n < RWIN) rw[(size_t)m * RWIN + n] = f2bf(a); else mla[(size_t)m * 448 + (n - RWIN)] = a; } };
struct EpiLr { static constexpr bool kQuad = false; bf16_t* out; const float* a0;
    __device__ void operator()(int m, int n, float a) const { out[(size_t)m * 512 + n] = f2bf(sigmoidf_(a0[n] + a)); } };
struct EpiResid { static constexpr bool kQuad = false; const float* xa; const float* xb; float* out; const float* modl; int gate_idx; int pad;
    __device__ void operator()(int m, int n, float a) const {
        float x = (m < TP) ? xa[(size_t)m * DM + n] : xb[(size_t)(m - TP) * DM + n];
        float gt = modl[(size_t)tok_modrow(m) * 6144 + gate_idx * 1024 + n];
        out[(size_t)m * DM + n] = x + gt * a; } };

struct EpiKV { static constexpr bool kQuad = true;
    bf16_t* kvraw; bf16_t* Vp; bf16_t* Vs; int ctx; int pad;
    __device__ void operator()(int m, int n, float a) const {}
    __device__ void quad(int row0, int col, float v0, float v1, float v2, float v3) const {
        const int hd = col >> 8, within = col & 255;
        if (within < 128) {
            bf16_t* d = kvraw + (size_t)row0 * 1024 + col;
            d[0] = f2bf(v0); d[1024] = f2bf(v1); d[2048] = f2bf(v2); d[3072] = f2bf(v3);
        } else {
            const int dv = within - 128;
            int b, kidx, Lk; bf16_t* base;
            if (ctx) { b = row0 >> 8; kidx = row0 & 255; Lk = 2304; base = Vs; }
            else if (row0 < TP) { b = row0 >> 8; kidx = row0 & 255; Lk = LP; base = Vp; }
            else { b = (row0 - TP) >> 11; kidx = 256 + ((row0 - TP) & 2047); Lk = 2304; base = Vs; }
            const int kpos = (kidx & ~12) | ((kidx & 8) >> 1) | ((kidx & 4) << 1);
            ushort4 o; o.x = f2bf(v0); o.y = f2bf(v1); o.z = f2bf(v2); o.w = f2bf(v3);
            *(ushort4*)(base + ((size_t)((b * 4 + hd) * 128 + dv)) * Lk + kpos) = o;
        }
    } };


typedef __attribute__((ext_vector_type(8))) short bf16x8;
typedef __attribute__((ext_vector_type(16))) float f32x16;
typedef __attribute__((ext_vector_type(4))) float f32x4;
typedef __attribute__((ext_vector_type(4))) unsigned u32x4;
#define GEMM_LDS_BYTES 73728

template <int NJ, class Epi>
__device__ __forceinline__ void d_gemm_bf16n(const int bx, const int by, char* smem, const bf16_t* __restrict__ A, int lda,
                                             const bf16_t* __restrict__ Bt, int ldb, int K, int N, Epi epi) {
    const int tid = threadIdx.x, lane = tid & 63, wid = tid >> 6;
    const int wm = wid >> 1, wn = wid & 1;
    const int m0 = by * 128, n0 = bx * (64 * NJ);
    f32x16 acc[2][NJ];
#pragma unroll
    for (int i = 0; i < 2; i++)
#pragma unroll
        for (int j = 0; j < NJ; j++)
#pragma unroll
            for (int r = 0; r < 16; r++) acc[i][j][r] = 0.f;
    const int lrow = tid >> 3, lcol = (tid & 7) * 8;
    const bf16_t* ga = A + (size_t)(m0 + lrow) * lda + lcol;
    const bf16_t* gb = Bt + (size_t)(n0 + lrow) * ldb + lcol;
    u32x4 raA[4], rbA[2 * NJ], raB[4], rbB[2 * NJ];
    const int KT = K >> 6;
    const int frow = lane & 31, fk = (lane >> 5) * 16;
#define GM_LOAD(RA_, RB_, kt_)                                                                                              \
    {                                                                                                                       \
        _Pragma("unroll") for (int i = 0; i < 4; i++) RA_[i] = *(const u32x4*)(ga + (size_t)(32 * i) * lda + (kt_) * 64);   \
        _Pragma("unroll") for (int i = 0; i < 2 * NJ; i++) RB_[i] = *(const u32x4*)(gb + (size_t)(32 * i) * ldb + (kt_) * 64); \
    }
#define GM_STORE(RA_, RB_, st_)                                                                                             \
    {                                                                                                                       \
        char* sn_ = smem + (st_) * 36864;                                                                                   \
        _Pragma("unroll") for (int i = 0; i < 4; i++) *(u32x4*)(sn_ + (lrow + 32 * i) * 144 + lcol * 2) = RA_[i];           \
        _Pragma("unroll") for (int i = 0; i < 2 * NJ; i++) *(u32x4*)(sn_ + 18432 + (lrow + 32 * i) * 144 + lcol * 2) = RB_[i]; \
    }
#define GM_COMPUTE(st_)                                                                                                     \
    {                                                                                                                       \
        const char* sa_ = smem + (st_) * 36864;                                                                             \
        const char* sb_ = sa_ + 18432;                                                                                      \
        _Pragma("unroll") for (int ks = 0; ks < 4; ks++) {                                                                  \
            bf16x8 af[2], bfr[NJ];                                                                                          \
            _Pragma("unroll") for (int i = 0; i < 2; i++) af[i] = *(const bf16x8*)(sa_ + (wm * 64 + i * 32 + frow) * 144 + ks * 32 + fk); \
            _Pragma("unroll") for (int j = 0; j < NJ; j++) bfr[j] = *(const bf16x8*)(sb_ + (wn * (32 * NJ) + j * 32 + frow) * 144 + ks * 32 + fk); \
            _Pragma("unroll") for (int i = 0; i < 2; i++)                                                                   \
                _Pragma("unroll") for (int j = 0; j < NJ; j++) acc[i][j] = __builtin_amdgcn_mfma_f32_32x32x16_bf16(af[i], bfr[j], acc[i][j], 0, 0, 0); \
        }                                                                                                                   \
    }
    GM_LOAD(raA, rbA, 0)
    GM_STORE(raA, rbA, 0)
    if (KT > 1) GM_LOAD(raA, rbA, 1)
    __syncthreads();
    for (int kt = 0; kt < KT; kt += 2) {
        if (kt + 2 < KT) GM_LOAD(raB, rbB, kt + 2)
        GM_COMPUTE(0)
        if (kt + 1 < KT) GM_STORE(raA, rbA, 1)
        __syncthreads();
        if (kt + 1 < KT) {
            if (kt + 3 < KT) GM_LOAD(raA, rbA, kt + 3)
            GM_COMPUTE(1)
            if (kt + 2 < KT) GM_STORE(raB, rbB, 0)
            __syncthreads();
        }
    }
#pragma unroll
    for (int i = 0; i < 2; i++)
#pragma unroll
        for (int j = 0; j < NJ; j++) {
            const int col = n0 + wn * (32 * NJ) + j * 32 + (lane & 31);
            if (col < N) {
                if constexpr (Epi::kQuad) {
#pragma unroll
                    for (int g = 0; g < 4; g++) {
                        const int row0 = m0 + wm * 64 + i * 32 + 8 * g + 4 * (lane >> 5);
                        epi.quad(row0, col, acc[i][j][4 * g], acc[i][j][4 * g + 1], acc[i][j][4 * g + 2], acc[i][j][4 * g + 3]);
                    }
                } else {
#pragma unroll
                    for (int r = 0; r < 16; r++) {
                        const int row = m0 + wm * 64 + i * 32 + (r & 3) + 8 * (r >> 2) + 4 * (lane >> 5);
                        epi(row, col, acc[i][j][r]);
                    }
                }
            }
        }
}
template <class Epi>
__device__ __forceinline__ void d_gemm_bf16(const int bx, const int by, char* smem, const bf16_t* __restrict__ A, int lda,
                                            const bf16_t* __restrict__ Bt, int ldb, int K, int N, Epi epi) {
    d_gemm_bf16n<2, Epi>(bx, by, smem, A, lda, Bt, ldb, K, N, epi);
}
__device__ __forceinline__ void d_transpose_w(const int vb, char* smem, const float* __restrict__ W, int K, int N, bf16_t* __restrict__ Wt) {
    float (*tile)[65] = (float(*)[65])smem;
    const int kt = K >> 6;
    const int nb = vb / kt, kb = vb % kt;
    const int tid = threadIdx.x;
    {
        const int n = nb * 64 + (tid & 63);
#pragma unroll
        for (int i = 0; i < 16; i++) {
            int k = (tid >> 6) + 4 * i;
            tile[k][tid & 63] = (n < N) ? W[(size_t)(kb * 64 + k) * N + n] : 0.f;
        }
    }
    __syncthreads();
    {
        const int k = tid & 63;
#pragma unroll
        for (int i = 0; i < 16; i++) {
            int n = (tid >> 6) + 4 * i;
            Wt[(size_t)(nb * 64 + n) * K + kb * 64 + k] = f2bf(tile[k][n]);
        }
    }
}


#define SC_STEP 336
template <int CTRL>
__device__ __forceinline__ float dpp_add(float v) {
    return v + __int_as_float(__builtin_amdgcn_update_dpp(0, __float_as_int(v), CTRL, 0xf, 0xf, false));
}
__device__ __forceinline__ float row16_allsum(float v) {
    v = dpp_add<0x128>(v); v = dpp_add<0x124>(v); v = dpp_add<0x122>(v); v = dpp_add<0x121>(v);
    return v;
}
__device__ __forceinline__ void d_scan2(const int item, const bool sample, char* smem, const bf16_t* __restrict__ rb, const bf16_t* __restrict__ kb,
                                        const bf16_t* __restrict__ vb, const bf16_t* __restrict__ kkb, const bf16_t* __restrict__ lr0,
                                        const bf16_t* __restrict__ lr1, const _Float16* __restrict__ du0, const _Float16* __restrict__ du1,
                                        const float* __restrict__ k_a, const float* __restrict__ st_f, const float* __restrict__ st_b,
                                        float* __restrict__ y0, float* __restrict__ y1, float* __restrict__ out_sf, float* __restrict__ out_sb) {
    const int chain = item >> 2, qd = item & 3;
    const int d = chain & 1, h = (chain >> 1) & 7, b = chain >> 4;
    const int L = sample ? LS : LP;
    const int tbase = sample ? (TP + b * LS) : (b * LP);
    const int tid = threadIdx.x, wid = tid >> 6, lane = tid & 63;
    const int rr = lane >> 4, pp = lane & 15;
    const int row = qd * 16 + wid * 4 + rr;
    const bf16_t* lr = d ? lr1 : lr0;
    const _Float16* du = d ? du1 : du0;
    float* yo = d ? y1 : y0;
    float S0, S1, S2, S3;
    if (sample) {
        const float4 s4 = *(const float4*)((d ? st_b : st_f) + ((size_t)(b * 8 + h) * 64 + row) * 64 + pp * 4);
        S0 = s4.x; S1 = s4.y; S2 = s4.z; S3 = s4.w;
    } else { S0 = S1 = S2 = S3 = 0.f; }
    const int sk = tid & 63, ss = tid >> 6;
    const float ka = k_a[h * 64 + sk];
    const size_t colk = (size_t)h * 64 + sk;
    const size_t colv = (size_t)h * 64 + qd * 16 + (tid & 15);
    float* buf = (float*)smem;
    unsigned gA_kk[4], gA_lr[4], gA_k[4], gA_r[4], gA_u[4], gA_v;
    unsigned gB_kk[4], gB_lr[4], gB_k[4], gB_r[4], gB_u[4], gB_v;
    const int nch = L >> 4;
#define SC_GLOAD(X, c)                                                                                     \
    {                                                                                                      \
        _Pragma("unroll") for (int j = 0; j < 4; j++) {                                                    \
            const int i = (c) * 16 + ss + 4 * j;                                                           \
            const size_t o = (size_t)(tbase + (d ? (L - 1 - i) : i)) * 512 + colk;                         \
            X##_kk[j] = kkb[o]; X##_lr[j] = lr[o]; X##_k[j] = kb[o]; X##_r[j] = rb[o]; X##_u[j] = ((const unsigned short*)du)[o]; \
        }                                                                                                  \
        { const int i = (c) * 16 + (tid >> 4); X##_v = vb[(size_t)(tbase + (d ? (L - 1 - i) : i)) * 512 + colv]; } \
    }
#define SC_SSTORE(X, bi)                                                                                   \
    {                                                                                                      \
        float* B_ = buf + (bi) * 16 * SC_STEP;                                                             \
        _Pragma("unroll") for (int j = 0; j < 4; j++) {                                                    \
            float* st_ = B_ + (ss + 4 * j) * SC_STEP + sk;                                                 \
            const float kkv = __uint_as_float(X##_kk[j] << 16), lrv = __uint_as_float(X##_lr[j] << 16), kv = __uint_as_float(X##_k[j] << 16); \
            st_[0] = -kkv; st_[64] = __expf(-0.6065306597126334f * (float)__builtin_bit_cast(_Float16, (unsigned short)X##_u[j])); st_[128] = kkv * lrv;   \
            st_[192] = kv * (1.f + (lrv - 1.f) * ka); st_[256] = __uint_as_float(X##_r[j] << 16);          \
        }                                                                                                  \
        B_[(tid >> 4) * SC_STEP + 320 + (tid & 15)] = __uint_as_float(X##_v << 16);                        \
    }
#define SC_COMPUTE(c)                                                                                      \
    {                                                                                                      \
        const float* B_ = buf + ((c) & 1) * 16 * SC_STEP;                                                  \
        float ysave = 0.f;                                                                                 \
        _Pragma("unroll 4") for (int s_ = 0; s_ < 16; s_++) {                                              \
            const float* st_ = B_ + s_ * SC_STEP;                                                          \
            const float4 a4 = *(const float4*)(st_ + pp * 4);                                              \
            const float4 w4 = *(const float4*)(st_ + 64 + pp * 4);                                         \
            const float4 b4 = *(const float4*)(st_ + 128 + pp * 4);                                        \
            const float4 k4 = *(const float4*)(st_ + 192 + pp * 4);                                        \
            const float4 r4 = *(const float4*)(st_ + 256 + pp * 4);                                        \
            const float vv = st_[320 + wid * 4 + rr];                                                      \
            float sa = (S0 * a4.x + S1 * a4.y) + (S2 * a4.z + S3 * a4.w);                                  \
            const float p0 = S0 * w4.x + vv * k4.x, p1 = S1 * w4.y + vv * k4.y, p2 = S2 * w4.z + vv * k4.z, p3 = S3 * w4.w + vv * k4.w; \
            sa = row16_allsum(sa);                                                                         \
            S0 = sa * b4.x + p0; S1 = sa * b4.y + p1; S2 = sa * b4.z + p2; S3 = sa * b4.w + p3;            \
            float y = (S0 * r4.x + S1 * r4.y) + (S2 * r4.z + S3 * r4.w);                                   \
            y = row16_allsum(y);                                                                           \
            ysave = (pp == s_) ? y : ysave;                                                                \
        }                                                                                                  \
        { const int i = (c) * 16 + pp; yo[(size_t)(tbase + (d ? (L - 1 - i) : i)) * 512 + h * 64 + row] = ysave; } \
    }
    SC_GLOAD(gA, 0)
    SC_SSTORE(gA, 0)
    if (nch > 1) SC_GLOAD(gA, 1)
    __syncthreads();
    for (int c = 0; c < nch; c += 2) {
        if (c + 2 < nch) SC_GLOAD(gB, c + 2)
        __builtin_amdgcn_sched_barrier(0);
        SC_COMPUTE(c)
        __builtin_amdgcn_sched_barrier(0);
        SC_SSTORE(gA, 1)
        __syncthreads();
        if (c + 3 < nch) SC_GLOAD(gA, c + 3)
        __builtin_amdgcn_sched_barrier(0);
        SC_COMPUTE(c + 1)
        __builtin_amdgcn_sched_barrier(0);
        if (c + 2 < nch) SC_SSTORE(gB, 0)
        __syncthreads();
    }
    if (!sample) {
        float* os = (d ? out_sb : out_sf) + ((size_t)(b * 8 + h) * 64 + row) * 64 + pp * 4;
        *(float4*)os = make_float4(S0, S1, S2, S3);
    }
}


#define ATT_SV_OFF 25600
#define ATT_SQ_OFF 44032
__device__ __forceinline__ void d_attn_mfma(const int item, char* smem, const bf16_t* __restrict__ Qb, const bf16_t* __restrict__ Kall,
                                            const bf16_t* __restrict__ VtAll, bf16_t* __restrict__ cat, int tbase, int Lq, int Lk, int nqb) {
    const int qb = item % nqb, bh = item / nqb;
    const int b = bh >> 2, h = bh & 3;
    const int tid = threadIdx.x, lane = tid & 63, wid = tid >> 6;
    const int q = lane & 31, hh = lane >> 5;
    const int t = tbase + b * Lq + qb * 128 + wid * 32 + q;
    bf16x8 qf[12];
    {
        const bf16_t* qp = Qb + ((size_t)t * 4 + h) * 192 + hh * 8;
#pragma unroll
        for (int ks = 0; ks < 12; ks++) qf[ks] = *(const bf16x8*)(qp + ks * 16);
    }
    f32x16 o[4];
#pragma unroll
    for (int i = 0; i < 4; i++)
#pragma unroll
        for (int r = 0; r < 16; r++) o[i][r] = 0.f;
    float m = -1e30f, l = 0.f;
    const bf16_t* K = Kall + (size_t)bh * Lk * 192;
    const bf16_t* Vt = VtAll + (size_t)bh * 128 * Lk;
    char* sK = smem;
    char* sV = smem + ATT_SV_OFF;
    u32x4 pk[6], pv[4];
    const int nkt = Lk >> 6;
#pragma unroll
    for (int i = 0; i < 6; i++) pk[i] = *(const u32x4*)(K + (size_t)(tid + 256 * i) * 8);
#pragma unroll
    for (int i = 0; i < 4; i++) { int c = tid + 256 * i; pv[i] = *(const u32x4*)(Vt + (size_t)(c >> 3) * Lk + (c & 7) * 8); }
#pragma unroll
    for (int i = 0; i < 6; i++) { int c = tid + 256 * i; *(u32x4*)(sK + (c / 24) * 400 + (c % 24) * 16) = pk[i]; }
#pragma unroll
    for (int i = 0; i < 4; i++) { int c = tid + 256 * i; *(u32x4*)(sV + (c >> 3) * 144 + (c & 7) * 16) = pv[i]; }
    __syncthreads();
    const float sc2 = 0.07216878364870322f * 1.4426950408889634f;
    for (int kt = 0; kt < nkt; kt++) {
        f32x16 st[2];
#pragma unroll
        for (int bk = 0; bk < 2; bk++)
#pragma unroll
            for (int r = 0; r < 16; r++) st[bk][r] = 0.f;
#pragma unroll
        for (int ks = 0; ks < 12; ks++) {
            const bf16x8 qfk = qf[ks];
#pragma unroll
            for (int bk = 0; bk < 2; bk++) {
                bf16x8 a = *(const bf16x8*)(sK + (bk * 32 + q) * 400 + ks * 32 + hh * 16);
                st[bk] = __builtin_amdgcn_mfma_f32_32x32x16_bf16(a, qfk, st[bk], 0, 0, 0);
            }
        }
        float mx = -1e30f;
#pragma unroll
        for (int bk = 0; bk < 2; bk++)
#pragma unroll
            for (int r = 0; r < 16; r++) { st[bk][r] *= sc2; mx = fmaxf(mx, st[bk][r]); }
        mx = fmaxf(mx, __shfl_xor(mx, 32, 64));
        const float mn = fmaxf(m, mx);
        const float alpha = exp2f(m - mn);
        float ps = 0.f;
#pragma unroll
        for (int bk = 0; bk < 2; bk++)
#pragma unroll
            for (int r = 0; r < 16; r++) { st[bk][r] = exp2f(st[bk][r] - mn); ps += st[bk][r]; }
        ps += __shfl_xor(ps, 32, 64);
        l = l * alpha + ps; m = mn;
#pragma unroll
        for (int i = 0; i < 4; i++)
#pragma unroll
            for (int r = 0; r < 16; r++) o[i][r] *= alpha;
#pragma unroll
        for (int s4 = 0; s4 < 4; s4++) {
            bf16x8 pb;
#pragma unroll
            for (int j = 0; j < 8; j++) pb[j] = (short)f2bf(st[s4 >> 1][8 * (s4 & 1) + j]);
#pragma unroll
            for (int i = 0; i < 4; i++) {
                bf16x8 a = *(const bf16x8*)(sV + (i * 32 + q) * 144 + s4 * 32 + hh * 16);
                o[i] = __builtin_amdgcn_mfma_f32_32x32x16_bf16(a, pb, o[i], 0, 0, 0);
            }
        }
        __syncthreads();
        if (kt + 1 < nkt) {
            const bf16_t* Kn = K + (size_t)(kt + 1) * 64 * 192;
            const bf16_t* Vn = Vt + (kt + 1) * 64;
#pragma unroll
            for (int i = 0; i < 6; i++) pk[i] = *(const u32x4*)(Kn + (size_t)(tid + 256 * i) * 8);
#pragma unroll
            for (int i = 0; i < 4; i++) { int c = tid + 256 * i; pv[i] = *(const u32x4*)(Vn + (size_t)(c >> 3) * Lk + (c & 7) * 8); }
#pragma unroll
            for (int i = 0; i < 6; i++) { int c = tid + 256 * i; *(u32x4*)(sK + (c / 24) * 400 + (c % 24) * 16) = pk[i]; }
#pragma unroll
            for (int i = 0; i < 4; i++) { int c = tid + 256 * i; *(u32x4*)(sV + (c >> 3) * 144 + (c & 7) * 16) = pv[i]; }
        }
        __syncthreads();
    }
    const float il = 1.f / l;
    bf16_t* op = cat + (size_t)t * DM + 512 + h * 128;
#pragma unroll
    for (int i = 0; i < 4; i++)
#pragma unroll
        for (int g = 0; g < 4; g++) {
            ushort4 w;
            w.x = f2bf(o[i][4 * g + 0] * il); w.y = f2bf(o[i][4 * g + 1] * il); w.z = f2bf(o[i][4 * g + 2] * il); w.w = f2bf(o[i][4 * g + 3] * il);
            *(ushort4*)(op + i * 32 + 8 * g + 4 * hh) = w;
        }
}


template <int K, int J>
__device__ __forceinline__ void bit_stage16(float (&x)[16]) {
#pragma unroll
    for (int i = 0; i < 16; i++) {
        const int l = i ^ J;
        if (l > i) {
            const bool desc = ((i & K) == 0);
            const float a = x[i], b = x[l];
            const float hi = fmaxf(a, b), lo = fminf(a, b);
            x[i] = desc ? hi : lo; x[l] = desc ? lo : hi;
        }
    }
}
__device__ __forceinline__ void bit_sort16_desc(float (&x)[16]) {
    bit_stage16<2, 1>(x);
    bit_stage16<4, 2>(x); bit_stage16<4, 1>(x);
    bit_stage16<8, 4>(x); bit_stage16<8, 2>(x); bit_stage16<8, 1>(x);
    bit_stage16<16, 8>(x); bit_stage16<16, 4>(x); bit_stage16<16, 2>(x); bit_stage16<16, 1>(x);
}
__device__ __forceinline__ void bit_merge16_desc(float (&x)[16]) {
    bit_stage16<16, 8>(x); bit_stage16<16, 4>(x); bit_stage16<16, 2>(x); bit_stage16<16, 1>(x);
}
template <int K, int J>
__device__ __forceinline__ void bit_stage16u(unsigned (&x)[16]) {
#pragma unroll
    for (int i = 0; i < 16; i++) {
        const int l = i ^ J;
        if (l > i) {
            const bool asc = ((i & K) == 0);
            const unsigned a = x[i], b = x[l];
            const unsigned lo = a < b ? a : b, hi = a < b ? b : a;
            x[i] = asc ? lo : hi; x[l] = asc ? hi : lo;
        }
    }
}
__device__ __forceinline__ void bit_sort16u_asc(unsigned (&x)[16]) {
    bit_stage16u<2, 1>(x);
    bit_stage16u<4, 2>(x); bit_stage16u<4, 1>(x);
    bit_stage16u<8, 4>(x); bit_stage16u<8, 2>(x); bit_stage16u<8, 1>(x);
    bit_stage16u<16, 8>(x); bit_stage16u<16, 4>(x); bit_stage16u<16, 2>(x); bit_stage16u<16, 1>(x);
}
__device__ __forceinline__ void bit_merge16u_asc(unsigned (&x)[16]) {
    bit_stage16u<16, 8>(x); bit_stage16u<16, 4>(x); bit_stage16u<16, 2>(x); bit_stage16u<16, 1>(x);
}
__device__ __forceinline__ void top16_merge(float (&L)[16], const float (&C)[16]) {
#pragma unroll
    for (int i = 0; i < 16; i++) L[i] = fmaxf(L[i], C[15 - i]);
    bit_merge16_desc(L);
}
__device__ __forceinline__ void low16_merge_u(unsigned (&L)[16], const unsigned (&C)[16]) {
#pragma unroll
    for (int i = 0; i < 16; i++) { const unsigned c = C[15 - i]; L[i] = L[i] < c ? L[i] : c; }
    bit_merge16u_asc(L);
}
__device__ __forceinline__ float key_val(float k) { return __uint_as_float(__float_as_uint(k) & ~127u); }
__device__ __forceinline__ int key_idx(float k) { return (int)(__float_as_uint(k) & 127u); }

struct EpiLds { static constexpr bool kQuad = false; float* lds; int c0; int pad;
    __device__ void operator()(int m, int n, float a) const { lds[m * 128 + (n - c0)] = a; } };

__device__ __forceinline__ void top16_col(const float* __restrict__ col, float (&L)[16]) {
#pragma unroll
    for (int ch = 0; ch < 8; ch++) {
        float C[16];
#pragma unroll
        for (int i = 0; i < 16; i++) {
            const int n = ch * 16 + i;
            C[i] = __uint_as_float((__float_as_uint(col[n * 128]) & ~127u) | (unsigned)n);
        }
        bit_sort16_desc(C);
        if (ch == 0) {
#pragma unroll
            for (int i = 0; i < 16; i++) L[i] = C[i];
        } else top16_merge(L, C);
    }
}
__device__ __forceinline__ void d_peer_route2(const int vb, char* smem, const bf16_t* __restrict__ kys, const bf16_t* __restrict__ qb,
                                              int* __restrict__ pidx, float* __restrict__ pg) {
    const int tt = vb % 96, h = vb / 96;
    const int tid = threadIdx.x;
    float A[16], B[16];
#pragma unroll
    for (int p = 0; p < 2; p++) {
        const int hp = h * 2 + p;
        d_gemm_bf16(tt, 0, smem, kys + (size_t)hp * 128 * 128, 128, qb + hp * 128, 2048, 128, TT, EpiLds{(float*)smem, tt * 128, 0});
        __syncthreads();
        if (tid < 128) {
            float L[16];
            top16_col((const float*)smem + tid, L);
#pragma unroll
            for (int i = 0; i < 16; i++) { if (p == 0) A[i] = L[i]; else B[i] = L[i]; }
        }
        __syncthreads();
    }
    if (tid >= 128) return;
    const int t = tt * 128 + tid;
    const float smax = key_val(A[0]) + key_val(B[0]);
    unsigned Tk[16];
#pragma unroll
    for (int g = 0; g < 4; g++) {
        unsigned Ck[16];
#pragma unroll
        for (int e = 0; e < 16; e++) {
            const int c = g * 16 + e;
            int i, j;
            if (c < 16) { i = 0; j = c; }
            else if (c < 24) { i = 1; j = c - 16; }
            else if (c < 29) { i = 2; j = c - 24; }
            else if (c < 33) { i = 3; j = c - 29; }
            else if (c < 36) { i = 4; j = c - 33; }
            else if (c < 42) { i = 5 + (c - 36) / 2; j = (c - 36) % 2; }
            else if (c < 50) { i = 8 + (c - 42); j = 0; }
            else { i = -1; j = 0; }
            if (i >= 0) {
                const float dd = smax - (key_val(A[i]) + key_val(B[j]));
                unsigned qd = (unsigned)fminf(dd * 32768.f, 262143.f);
                Ck[e] = (qd << 14) | (unsigned)(key_idx(A[i]) * 128 + key_idx(B[j]));
            } else Ck[e] = 0xffffffffu;
        }
        bit_sort16u_asc(Ck);
        if (g == 0) {
#pragma unroll
            for (int e = 0; e < 16; e++) Tk[e] = Ck[e];
        } else low16_merge_u(Tk, Ck);
    }
    float sum = 0.f;
    float w[16]; int Tp[16];
#pragma unroll
    for (int e = 0; e < 16; e++) { w[e] = __expf(-(float)(Tk[e] >> 14) * (1.f / 32768.f)); sum += w[e]; Tp[e] = (int)(Tk[e] & 16383u); }
    const float inv = 1.f / sum;
    int* pi = pidx + ((size_t)t * 8 + h) * 16;
    float* pw = pg + ((size_t)t * 8 + h) * 16;
#pragma unroll
    for (int e = 0; e < 16; e += 4) {
        *(int4*)(pi + e) = make_int4(Tp[e], Tp[e + 1], Tp[e + 2], Tp[e + 3]);
        *(float4*)(pw + e) = make_float4(w[e] * inv, w[e + 1] * inv, w[e + 2] * inv, w[e + 3] * inv);
    }
}

typedef __attribute__((ext_vector_type(2))) short bf16x2;
__device__ __forceinline__ float dot8_bf16(u32x4 a, u32x4 b, float acc) {
#pragma unroll
    for (int i = 0; i < 4; i++) {
        const unsigned x = a[i], y = b[i];
        acc += __uint_as_float(x << 16) * __uint_as_float(y << 16);
        acc += __uint_as_float(x & 0xffff0000u) * __uint_as_float(y & 0xffff0000u);
    }
    return acc;
}
__device__ __forceinline__ void d_cvt_bf16(const int vb, const float* __restrict__ src, bf16_t* __restrict__ dst) {
    const size_t base = (size_t)vb * 16384 + threadIdx.x * 4;
#pragma unroll
    for (int i = 0; i < 16; i++) {
        const float4 v = *(const float4*)(src + base + i * 1024);
        ushort4 o; o.x = f2bf(v.x); o.y = f2bf(v.y); o.z = f2bf(v.z); o.w = f2bf(v.w);
        *(ushort4*)(dst + base + i * 1024) = o;
    }
}


__device__ __forceinline__ void d_hy_filt2(const int vbl8, char* smem, const int L, const float* __restrict__ w1, const float* __restrict__ b1,
                                           const float* __restrict__ w2, const float* __restrict__ b2, const float* __restrict__ w3,
                                           const float* __restrict__ fr, bf16_t* __restrict__ gT, float* __restrict__ nsum) {
    float* zp = (float*)smem;
    float* h1 = zp + 32 * 33;
    float* h2t = h1 + 32 * 64;
    float* sw1 = h2t + 64 * 32;
    float* sw2 = sw1 + 33 * 64;
    const int tid = threadIdx.x;
    const int vbl = vbl8 >> 3, mm = vbl8 & 7;
    const int t0 = vbl * 32;
    for (int e = tid; e < 33 * 64; e += 256) sw1[e] = w1[e];
    for (int e = tid; e < 64 * 64; e += 256) sw2[e] = w2[e];
    for (int e = tid; e < 32 * 33; e += 256) {
        const int pos = e / 33, i = e % 33;
        const float t = (float)(t0 + pos);
        float val;
        if (i == 0) val = t / (float)(L - 1);
        else {
            const int bi = (i <= 16) ? (i - 1) : (i - 17);
            const float band = 1e-4f + (float)bi * ((15.f - 1e-4f) / 15.f);
            const float ang = 6.283185307179586f * t * band / (float)L;
            val = (i <= 16) ? __cosf(ang) : -__sinf(ang);
        }
        zp[e] = val;
    }
    const int c = tid + 256 * mm;
    float wv[8];
#pragma unroll
    for (int jj = 0; jj < 8; jj++) wv[jj] = w3[jj * 2048 + c];
    __syncthreads();
    {
        const int j = tid & 63;
        const float frj = fr[j];
#pragma unroll 1
        for (int i = 0; i < 8; i++) {
            const int pos = (tid >> 6) + 4 * i;
            float sacc = b1[j];
#pragma unroll 3
            for (int q = 0; q < 33; q++) sacc += zp[pos * 33 + q] * sw1[q * 64 + j];
            h1[pos * 64 + j] = __sinf(frj * sacc);
        }
        __syncthreads();
#pragma unroll 1
        for (int i = 0; i < 8; i++) {
            const int pos = (tid >> 6) + 4 * i;
            float sacc = b2[j];
#pragma unroll 4
            for (int q = 0; q < 64; q++) sacc += h1[pos * 64 + q] * sw2[q * 64 + j];
            h2t[j * 32 + pos] = __sinf(frj * sacc);
        }
    }
    __syncthreads();
    {
        float acc[32];
#pragma unroll
        for (int i = 0; i < 32; i++) acc[i] = 0.f;
#pragma unroll 1
        for (int jb = 0; jb < 64; jb += 8) {
            float wn[8];
            if (jb + 8 < 64) {
#pragma unroll
                for (int jj = 0; jj < 8; jj++) wn[jj] = w3[(jb + 8 + jj) * 2048 + c];
            }
#pragma unroll
            for (int jj = 0; jj < 8; jj++) {
                const float w = wv[jj];
#pragma unroll
                for (int i = 0; i < 8; i++) {
                    const float4 hv = *(const float4*)(h2t + (jb + jj) * 32 + i * 4);
                    acc[4 * i] += hv.x * w; acc[4 * i + 1] += hv.y * w; acc[4 * i + 2] += hv.z * w; acc[4 * i + 3] += hv.w * w;
                }
                __builtin_amdgcn_sched_barrier(0);
            }
            if (jb + 8 < 64) {
#pragma unroll
                for (int jj = 0; jj < 8; jj++) wv[jj] = wn[jj];
            }
        }
        const int ch = c & 1023;
        const float d0 = -4.605170185988091f / 0.3f, d1 = -4.605170185988091f / 1.5f;
        const float adelta = fabsf(d0 + (d1 - d0) * ((float)ch / 1023.f));
        float absum = 0.f;
        bf16_t* g = gT + (size_t)ch * 2 * L;
#pragma unroll
        for (int i = 0; i < 32; i++) {
            const int t = t0 + i;
            const float tu = (float)t / (float)(L - 1);
            const float val = acc[i] * __expf(-tu * adelta);
            if (c < 1024) { absum += fabsf(val); g[L - t] = f2bf(val); }
            else if (t >= 1) { absum += fabsf(val); g[L + t] = f2bf(val); }
            if ((i & 3) == 3) __builtin_amdgcn_sched_barrier(0);
        }
        atomicAdd(nsum + ch, absum);
    }
}

__device__ __forceinline__ void d_hy_dw3(const int vb, char* smem, const bf16_t* __restrict__ pre, const float* __restrict__ cw,
                                         const float* __restrict__ cb, bf16_t* __restrict__ zT, bf16_t* __restrict__ x0b) {
    bf16_t* tile = (bf16_t*)smem;
    const int tt = vb >> 3, ct = vb & 7;
    const int tid = threadIdx.x;
    const int cp = tid & 63, c = ct * 128 + cp * 2;
    const int tq = tid >> 6;
    const int tok0 = tt * 64 + tq * 16;
    const int pos0 = tok_pos(tok0), L = tok_len(tok0);
    unsigned raw[3][18];
#pragma unroll
    for (int part = 0; part < 3; part++)
#pragma unroll
        for (int i = 0; i < 18; i++) {
            const int pos = pos0 - 1 + i;
            raw[part][i] = (pos >= 0 && pos < L) ? *(const unsigned*)(pre + (size_t)(tok0 - 1 + i) * 3072 + part * 1024 + c) : 0u;
        }
    float w0[3][2], w1[3][2], w2[3][2], bb[3][2];
#pragma unroll
    for (int part = 0; part < 3; part++)
#pragma unroll
        for (int e = 0; e < 2; e++) {
            const int col = part * 1024 + c + e;
            w0[part][e] = cw[col]; w1[part][e] = cw[3072 + col]; w2[part][e] = cw[2 * 3072 + col]; bb[part][e] = cb[col];
        }
#pragma unroll
    for (int i = 0; i < 16; i++) {
        float u[3][2];
#pragma unroll
        for (int part = 0; part < 3; part++) {
            const unsigned p0 = raw[part][i], p1 = raw[part][i + 1], p2 = raw[part][i + 2];
            u[part][0] = __uint_as_float(p0 << 16) * w0[part][0] + __uint_as_float(p1 << 16) * w1[part][0] + __uint_as_float(p2 << 16) * w2[part][0] + bb[part][0];
            u[part][1] = __uint_as_float(p0 & 0xffff0000u) * w0[part][1] + __uint_as_float(p1 & 0xffff0000u) * w1[part][1] +
                         __uint_as_float(p2 & 0xffff0000u) * w2[part][1] + bb[part][1];
        }
        *(unsigned*)(x0b + (size_t)(tok0 + i) * DM + c) = (unsigned)f2bf(u[0][0]) | ((unsigned)f2bf(u[0][1]) << 16);
        tile[(cp * 2) * 72 + tq * 16 + i] = f2bf(u[1][0] * u[2][0]);
        tile[(cp * 2 + 1) * 72 + tq * 16 + i] = f2bf(u[1][1] * u[2][1]);
    }
    __syncthreads();
    {
        const int cch = tid >> 1, hf = tid & 1;
        bf16_t* dst = zT + (size_t)(ct * 128 + cch) * TT + tt * 64 + hf * 32;
        const bf16_t* src = tile + cch * 72 + hf * 32;
#pragma unroll
        for (int q = 0; q < 4; q++) *(u32x4*)(dst + q * 8) = *(const u32x4*)(src + q * 8);
    }
}

template <bool SAMPLE>
__device__ __forceinline__ void d_hy_conv2(const int c, const int half, char* wsm, const bf16_t* __restrict__ gTall, const float* __restrict__ nsum,
                                           const bf16_t* __restrict__ zT, const float* __restrict__ bias, bf16_t* __restrict__ yT) {
    constexpr int L = SAMPLE ? LS : LP;
    constexpr int NB = L / 32;
    constexpr int NBATCH = SAMPLE ? 4 : 16;
    constexpr int BSH = SAMPLE ? 2 : 4;
    constexpr int TPB = 32 >> BSH;
    constexpr int NCB = NB / TPB;
    constexpr int HCB = NCB / 2;
    constexpr int PADB = SAMPLE ? 8 : 2;
    constexpr int ZLEN = L + 2 * PADB * 32;
    constexpr int tbase = SAMPLE ? TP : 0;
    const int lane = threadIdx.x & 63;
    const int l2 = half * 64 + lane;
    const int lc = lane & 31, hh = lane >> 5;
    const int b = lc & (NBATCH - 1), Tl = lc >> BSH;
    bf16_t* R = (bf16_t*)wsm;
    bf16_t* Z = R + 2 * L;
    {
        constexpr int RCH = 2 * L / 8 / 128;
        constexpr int ZCH = NBATCH * (L / 8) / 128;
        const u32x4* src = (const u32x4*)(gTall + (size_t)c * 2 * L);
        u32x4 rr[RCH > 0 ? RCH : 1], zz[ZCH];
        if constexpr (RCH > 0) {
#pragma unroll
            for (int i = 0; i < RCH; i++) rr[i] = src[l2 + 128 * i];
        } else {
            if (l2 < 2 * L / 8) rr[0] = src[l2];
        }
#pragma unroll
        for (int i = 0; i < ZCH; i++) {
            const int q = l2 + 128 * i;
            const int b2 = q / (L / 8), ci = q % (L / 8);
            zz[i] = ((const u32x4*)(zT + (size_t)c * TT + tbase + b2 * L))[ci];
        }
        const u32x4 zero = {0u, 0u, 0u, 0u};
        for (int q = l2; q < NBATCH * PADB * 4; q += 128) {
            const int b2 = q / (PADB * 4), i = q % (PADB * 4);
            u32x4* zd = (u32x4*)(Z + b2 * ZLEN);
            zd[i] = zero; zd[PADB * 4 + L / 8 + i] = zero;
        }
        if constexpr (RCH > 0) {
#pragma unroll
            for (int i = 0; i < RCH; i++) ((u32x4*)R)[l2 + 128 * i] = rr[i];
        } else {
            if (l2 < 2 * L / 8) ((u32x4*)R)[l2] = rr[0];
        }
#pragma unroll
        for (int i = 0; i < ZCH; i++) {
            const int q = l2 + 128 * i;
            const int b2 = q / (L / 8), ci = q % (L / 8);
            ((u32x4*)(Z + b2 * ZLEN))[PADB * 4 + ci] = zz[i];
        }
    }
    __syncthreads();
    f32x16 acc[HCB];
#pragma unroll
    for (int cb = 0; cb < HCB; cb++)
#pragma unroll
        for (int r = 0; r < 16; r++) acc[cb][r] = 0.f;
    const bf16_t* Zb = Z + b * ZLEN + PADB * 32 + 8 * hh;
    const int cb0 = half * HCB;
    const int Dlo = TPB * cb0 - (NB - 1), Dhi = TPB * (cb0 + HCB - 1) + TPB - 1;
#pragma unroll 1
    for (int D = (Dlo < -(NB - 1) ? -(NB - 1) : Dlo); D <= (Dhi > NB - 1 ? NB - 1 : Dhi); D++) {
        bf16x8 af[2];
#pragma unroll
        for (int ks = 0; ks < 2; ks++) {
            const bf16_t* rp = R + (L - 32 * D - lc + 16 * ks + 8 * hh);
#pragma unroll
            for (int j = 0; j < 8; j++) af[ks][j] = (short)rp[j];
        }
#pragma unroll
        for (int lcb = 0; lcb < HCB; lcb++) {
            const int cb = cb0 + lcb;
            if (D >= TPB * cb - (NB - 1) && D <= TPB * cb + TPB - 1) {
                const int S = TPB * cb + Tl - D;
#pragma unroll
                for (int ks = 0; ks < 2; ks++) {
                    const bf16x8 bfr = *(const bf16x8*)(Zb + 32 * S + 16 * ks);
                    acc[lcb] = __builtin_amdgcn_mfma_f32_32x32x16_bf16(af[ks], bfr, acc[lcb], 0, 0, 0);
                }
            }
        }
    }
    const float inv = 1.f / nsum[c], bs = bias[c];
    bf16_t* yrow = yT + (size_t)c * TT + tbase + b * L;
    const bf16_t* zrow = Z + b * ZLEN + PADB * 32;
#pragma unroll
    for (int lcb = 0; lcb < HCB; lcb++)
#pragma unroll
        for (int g = 0; g < 4; g++) {
            const int t = 32 * (TPB * (cb0 + lcb) + Tl) + 8 * g + 4 * hh;
            ushort4 o;
            o.x = f2bf(acc[lcb][4 * g + 0] * inv + bf2f(zrow[t + 0]) * bs);
            o.y = f2bf(acc[lcb][4 * g + 1] * inv + bf2f(zrow[t + 1]) * bs);
            o.z = f2bf(acc[lcb][4 * g + 2] * inv + bf2f(zrow[t + 2]) * bs);
            o.w = f2bf(acc[lcb][4 * g + 3] * inv + bf2f(zrow[t + 3]) * bs);
            *(ushort4*)(yrow + t) = o;
        }
}

__device__ __forceinline__ void d_hy_post2(const int vb, char* smem, const bf16_t* __restrict__ yT, const bf16_t* __restrict__ x0b, bf16_t* __restrict__ zb) {
    bf16_t* tile = (bf16_t*)smem;
    const int tt = vb >> 3, ct = vb & 7;
    const int tid = threadIdx.x;
    const int cp = tid & 63, c = ct * 128 + cp * 2, tq = tid >> 6;
    const int tok0 = tt * 64 + tq * 16;
    unsigned xr[16];
#pragma unroll
    for (int i = 0; i < 16; i++) xr[i] = *(const unsigned*)(x0b + (size_t)(tok0 + i) * DM + c);
    {
        const int cch = tid >> 1, hf = tid & 1;
        const bf16_t* src = yT + (size_t)(ct * 128 + cch) * TT + tt * 64 + hf * 32;
        bf16_t* dst = tile + cch * 72 + hf * 32;
#pragma unroll
        for (int q = 0; q < 4; q++) *(u32x4*)(dst + q * 8) = *(const u32x4*)(src + q * 8);
    }
    __syncthreads();
#pragma unroll
    for (int i = 0; i < 16; i++) {
        const float y0 = bf2f(tile[(cp * 2) * 72 + tq * 16 + i]), y1 = bf2f(tile[(cp * 2 + 1) * 72 + tq * 16 + i]);
        const float r0 = __uint_as_float(xr[i] << 16) * y0, r1 = __uint_as_float(xr[i] & 0xffff0000u) * y1;
        *(unsigned*)(zb + (size_t)(tok0 + i) * DM + c) = (unsigned)f2bf(r0) | ((unsigned)f2bf(r1) << 16);
    }
}

__device__ __forceinline__ float wave_allsum_fast(float v) {
    v = row16_allsum(v);
    const float r0 = __int_as_float(__builtin_amdgcn_readlane(__float_as_int(v), 0));
    const float r1 = __int_as_float(__builtin_amdgcn_readlane(__float_as_int(v), 16));
    const float r2 = __int_as_float(__builtin_amdgcn_readlane(__float_as_int(v), 32));
    const float r3 = __int_as_float(__builtin_amdgcn_readlane(__float_as_int(v), 48));
    return (r0 + r1) + (r2 + r3);
}
__device__ __forceinline__ ushort4 pack_bf4(float a, float b, float c, float d) { ushort4 o; o.x = f2bf(a); o.y = f2bf(b); o.z = f2bf(c); o.w = f2bf(d); return o; }

__device__ __forceinline__ void d_norm_mod2(const int vb, const float* __restrict__ xa, const float* __restrict__ xb, const float* __restrict__ g,
                                            const float* __restrict__ modl, const int shift_idx, const int scale_idx, bf16_t* __restrict__ h) {
    const int wid = threadIdx.x >> 6, lane = threadIdx.x & 63;
    const int t0 = vb * 8 + wid * 2;
    float4 v[2][4];
#pragma unroll
    for (int u = 0; u < 2; u++) {
        const int t = t0 + u;
        const float* x = (t < TP) ? (xa + (size_t)t * DM) : (xb + (size_t)(t - TP) * DM);
#pragma unroll
        for (int j = 0; j < 4; j++) v[u][j] = *(const float4*)(x + j * 256 + lane * 4);
    }
#pragma unroll
    for (int u = 0; u < 2; u++) {
        const int t = t0 + u;
        float ss = 0.f;
#pragma unroll
        for (int j = 0; j < 4; j++) ss += v[u][j].x * v[u][j].x + v[u][j].y * v[u][j].y + v[u][j].z * v[u][j].z + v[u][j].w * v[u][j].w;
        ss = wave_allsum_fast(ss);
        const float rstd = rsqrtf(ss * (1.f / DM) + 1e-6f);
        const float* m = modl + (size_t)tok_modrow(t) * 6144;
#pragma unroll
        for (int j = 0; j < 4; j++) {
            const int c = j * 256 + lane * 4;
            const float4 gg = *(const float4*)(g + c);
            const float4 sh = *(const float4*)(m + shift_idx * 1024 + c);
            const float4 sc = *(const float4*)(m + scale_idx * 1024 + c);
            *(ushort4*)(h + (size_t)t * DM + c) = pack_bf4(v[u][j].x * rstd * gg.x * (1.f + sc.x) + sh.x, v[u][j].y * rstd * gg.y * (1.f + sc.y) + sh.y,
                                                           v[u][j].z * rstd * gg.z * (1.f + sc.z) + sh.z, v[u][j].w * rstd * gg.w * (1.f + sc.w) + sh.w);
        }
    }
}

__device__ __forceinline__ void d_rw_shift2(const int vb, const bf16_t* __restrict__ proj, const float* __restrict__ mu, bf16_t* __restrict__ rb,
                                            bf16_t* __restrict__ kb, bf16_t* __restrict__ vbuf, bf16_t* __restrict__ tw, bf16_t* __restrict__ adv,
                                            bf16_t* __restrict__ sg) {
#pragma unroll
    for (int u = 0; u < 4; u++) {
        const int id = vb * 1024 + u * 256 + threadIdx.x;
        const int t = id / 224, c = (id % 224) * 8;
        const int pos = tok_pos(t), L = tok_len(t);
        const bf16_t* P = proj + (size_t)t * RWIN + c;
        const u32x4 cur = *(const u32x4*)P;
        u32x4 prv = {0u, 0u, 0u, 0u}, nxt = {0u, 0u, 0u, 0u};
        if (pos > 0) prv = *(const u32x4*)(P - RWIN);
        if (pos < L - 1) nxt = *(const u32x4*)(P + RWIN);
        const float4 m0 = *(const float4*)(mu + c), m1 = *(const float4*)(mu + c + 4);
        const float mm[8] = {m0.x, m0.y, m0.z, m0.w, m1.x, m1.y, m1.z, m1.w};
        float val[8];
#pragma unroll
        for (int i = 0; i < 4; i++) {
            const float c0 = __uint_as_float(cur[i] << 16), c1 = __uint_as_float(cur[i] & 0xffff0000u);
            const float p0 = __uint_as_float(prv[i] << 16), p1 = __uint_as_float(prv[i] & 0xffff0000u);
            const float n0 = __uint_as_float(nxt[i] << 16), n1 = __uint_as_float(nxt[i] & 0xffff0000u);
            val[2 * i] = c0 + mm[2 * i] * (0.5f * (p0 + n0) - c0);
            val[2 * i + 1] = c1 + mm[2 * i + 1] * (0.5f * (p1 + n1) - c1);
        }
        bf16_t* dst;
        if (c < 512) dst = rb + (size_t)t * 512 + c;
        else if (c < 1024) dst = kb + (size_t)t * 512 + (c - 512);
        else if (c < 1536) dst = vbuf + (size_t)t * 512 + (c - 1024);
        else if (c < 1600) { dst = tw + (size_t)t * 64 + (c - 1536);
#pragma unroll
            for (int i = 0; i < 8; i++) val[i] = tanhf(val[i]); }
        else if (c < 1664) dst = adv + (size_t)t * 64 + (c - 1600);
        else { dst = sg + (size_t)t * 128 + (c - 1664);
#pragma unroll
            for (int i = 0; i < 8; i++) val[i] = sigmoidf_(val[i]); }
        u32x4 o;
#pragma unroll
        for (int i = 0; i < 4; i++) o[i] = (unsigned)f2bf(val[2 * i]) | ((unsigned)f2bf(val[2 * i + 1]) << 16);
        *(u32x4*)dst = o;
    }
}

__device__ __forceinline__ void d_mla_pre2(const int vb, const float* __restrict__ proj, const float* __restrict__ q_norm, const float* __restrict__ kv_norm,
                                           bf16_t* __restrict__ qcn, bf16_t* __restrict__ ckv, float* __restrict__ kpe, float* __restrict__ out_ckv,
                                           float* __restrict__ out_kpe) {
    const int t = vb * 16 + (threadIdx.x >> 4), l16 = threadIdx.x & 15;
    const float* P = proj + (size_t)t * 448;
    float4 x[7];
#pragma unroll
    for (int j = 0; j < 7; j++) x[j] = *(const float4*)(P + 4 * (l16 + 16 * j));
    float sq = 0.f, sk = 0.f;
#pragma unroll
    for (int j = 0; j < 4; j++) sq += x[j].x * x[j].x + x[j].y * x[j].y + x[j].z * x[j].z + x[j].w * x[j].w;
#pragma unroll
    for (int j = 4; j < 6; j++) sk += x[j].x * x[j].x + x[j].y * x[j].y + x[j].z * x[j].z + x[j].w * x[j].w;
    sq = row16_allsum(sq); sk = row16_allsum(sk);
    const float rq = rsqrtf(sq * (1.f / 256.f) + 1e-6f), rk = rsqrtf(sk * (1.f / 128.f) + 1e-6f);
#pragma unroll
    for (int j = 0; j < 4; j++) {
        const int c = 4 * (l16 + 16 * j);
        const float4 w = *(const float4*)(q_norm + c);
        *(ushort4*)(qcn + (size_t)t * 256 + c) = pack_bf4(x[j].x * rq * w.x, x[j].y * rq * w.y, x[j].z * rq * w.z, x[j].w * rq * w.w);
    }
#pragma unroll
    for (int j = 4; j < 6; j++) {
        const int c = 4 * (l16 + 16 * (j - 4));
        const float4 w = *(const float4*)(kv_norm + c);
        const float4 o = make_float4(x[j].x * rk * w.x, x[j].y * rk * w.y, x[j].z * rk * w.z, x[j].w * rk * w.w);
        *(ushort4*)(ckv + (size_t)t * 128 + c) = pack_bf4(o.x, o.y, o.z, o.w);
        if (t < TP) *(float4*)(out_ckv + (size_t)t * 128 + c) = o;
    }
    {
        const int c = 4 * l16;
        *(float4*)(kpe + (size_t)t * 64 + c) = x[6];
        if (t < TP) *(float4*)(out_kpe + (size_t)t * 64 + c) = x[6];
    }
}


typedef float f32x2 __attribute__((ext_vector_type(2)));
template <int CTRL>
__device__ __forceinline__ float dpp_max(float v) {
    return fmaxf(v, __int_as_float(__builtin_amdgcn_update_dpp(0, __float_as_int(v), CTRL, 0xf, 0xf, false)));
}
__device__ __forceinline__ float wave_allmax_fast(float v) {
    v = dpp_max<0x128>(v); v = dpp_max<0x124>(v); v = dpp_max<0x122>(v); v = dpp_max<0x121>(v);
    const float r0 = __int_as_float(__builtin_amdgcn_readlane(__float_as_int(v), 0));
    const float r1 = __int_as_float(__builtin_amdgcn_readlane(__float_as_int(v), 16));
    const float r2 = __int_as_float(__builtin_amdgcn_readlane(__float_as_int(v), 32));
    const float r3 = __int_as_float(__builtin_amdgcn_readlane(__float_as_int(v), 48));
    return fmaxf(fmaxf(r0, r1), fmaxf(r2, r3));
}
__device__ __forceinline__ void d_cvt_fp8_rows(const int vb, const float* __restrict__ src, unsigned char* __restrict__ dst, float* __restrict__ rscale) {
    const int wid = threadIdx.x >> 6, lane = threadIdx.x & 63;
    float4 x[4][4];
#pragma unroll
    for (int u = 0; u < 4; u++) {
        const float* r = src + (size_t)(vb * 16 + wid * 4 + u) * 1024 + lane * 4;
#pragma unroll
        for (int j = 0; j < 4; j++) x[u][j] = *(const float4*)(r + 256 * j);
    }
#pragma unroll
    for (int u = 0; u < 4; u++) {
        const int row = vb * 16 + wid * 4 + u;
        float am = 0.f;
#pragma unroll
        for (int j = 0; j < 4; j++) am = fmaxf(am, fmaxf(fmaxf(fabsf(x[u][j].x), fabsf(x[u][j].y)), fmaxf(fabsf(x[u][j].z), fabsf(x[u][j].w))));
        am = wave_allmax_fast(am);
        const float sc = am > 0.f ? 448.f / am : 1.f;
#pragma unroll
        for (int j = 0; j < 4; j++) {
            int pk = __builtin_amdgcn_cvt_pk_fp8_f32(x[u][j].x * sc, x[u][j].y * sc, 0, false);
            pk = __builtin_amdgcn_cvt_pk_fp8_f32(x[u][j].z * sc, x[u][j].w * sc, pk, true);
            *(unsigned*)(dst + (size_t)row * 1024 + 256 * j + lane * 4) = (unsigned)pk;
        }
        if (lane == 0) rscale[row] = am > 0.f ? am * (1.f / 448.f) : 1.f;
    }
}
__device__ __forceinline__ void d_peer_apply3(const int vb, char* smem, const bf16_t* __restrict__ hb, const int* __restrict__ pidx,
                                              const float* __restrict__ pg, const unsigned char* __restrict__ utab, const unsigned char* __restrict__ vtab,
                                              const float* __restrict__ rsU, const float* __restrict__ rsV, const float* __restrict__ modl,
                                              float* __restrict__ xrun, const float* __restrict__ g_next, const float* __restrict__ mod_next,
                                              bf16_t* __restrict__ h_next) {
    const int wid = threadIdx.x >> 6, lane = threadIdx.x & 63;
    const int t = vb * 4 + wid;
    float* coef = (float*)smem + wid * 128;
    int* eid = (int*)(smem + 2048) + wid * 128;
    const int e_lo = pidx[(size_t)t * 128 + lane], e_hi = pidx[(size_t)t * 128 + lane + 64];
    eid[lane] = e_lo; eid[lane + 64] = e_hi;
    const float g0 = pg[(size_t)t * 128 + lane] * rsV[e_lo], g1 = pg[(size_t)t * 128 + lane + 64] * rsV[e_hi];
    const float ru0 = rsU[e_lo], ru1 = rsU[e_hi];
    float x[16];
    {
        const u32x4 a = *(const u32x4*)(hb + (size_t)t * DM + lane * 16), b = *(const u32x4*)(hb + (size_t)t * DM + lane * 16 + 8);
#pragma unroll
        for (int i = 0; i < 4; i++) {
            x[2 * i] = __uint_as_float(a[i] << 16); x[2 * i + 1] = __uint_as_float(a[i] & 0xffff0000u);
            x[8 + 2 * i] = __uint_as_float(b[i] << 16); x[8 + 2 * i + 1] = __uint_as_float(b[i] & 0xffff0000u);
        }
    }
    __builtin_amdgcn_wave_barrier();
    float myact0 = 0.f, myact1 = 0.f;
#pragma unroll 1
    for (int eb = 0; eb < 128; eb += 16) {
        u32x4 q[16];
#pragma unroll
        for (int r = 0; r < 16; r++) q[r] = *(const u32x4*)(utab + (size_t)eid[eb + r] * 1024 + lane * 16);
#pragma unroll
        for (int r = 0; r < 16; r++) {
            float sacc = 0.f;
#pragma unroll
            for (int i = 0; i < 4; i++) {
                const f32x2 f01 = __builtin_amdgcn_cvt_pk_f32_fp8((int)q[r][i], false);
                const f32x2 f23 = __builtin_amdgcn_cvt_pk_f32_fp8((int)q[r][i], true);
                sacc += f01[0] * x[4 * i] + f01[1] * x[4 * i + 1] + f23[0] * x[4 * i + 2] + f23[1] * x[4 * i + 3];
            }
            sacc = wave_allsum_fast(sacc);
            const int e = eb + r;
            if (lane == (e & 63)) { if (e < 64) myact0 = sacc; else myact1 = sacc; }
        }
    }
    coef[lane] = g0 * gelu_tanh(myact0 * ru0);
    coef[lane + 64] = g1 * gelu_tanh(myact1 * ru1);
    __builtin_amdgcn_wave_barrier();
    float acc[16];
#pragma unroll
    for (int i = 0; i < 16; i++) acc[i] = 0.f;
#pragma unroll 1
    for (int eb = 0; eb < 128; eb += 16) {
        u32x4 q[16];
#pragma unroll
        for (int r = 0; r < 16; r++) q[r] = *(const u32x4*)(vtab + (size_t)eid[eb + r] * 1024 + lane * 16);
#pragma unroll
        for (int r = 0; r < 16; r++) {
            const float cf = coef[eb + r];
#pragma unroll
            for (int i = 0; i < 4; i++) {
                const f32x2 f01 = __builtin_amdgcn_cvt_pk_f32_fp8((int)q[r][i], false);
                const f32x2 f23 = __builtin_amdgcn_cvt_pk_f32_fp8((int)q[r][i], true);
                acc[4 * i] += cf * f01[0]; acc[4 * i + 1] += cf * f01[1]; acc[4 * i + 2] += cf * f23[0]; acc[4 * i + 3] += cf * f23[1];
            }
        }
    }
    const float* m = modl + (size_t)tok_modrow(t) * 6144 + 5 * 1024 + lane * 16;
    float* xo = xrun + (size_t)t * DM + lane * 16;
    float ss = 0.f;
#pragma unroll
    for (int j = 0; j < 4; j++) {
        float4 xa = *(float4*)(xo + 4 * j);
        const float4 ma = *(const float4*)(m + 4 * j);
        xa.x += ma.x * acc[4 * j]; xa.y += ma.y * acc[4 * j + 1]; xa.z += ma.z * acc[4 * j + 2]; xa.w += ma.w * acc[4 * j + 3];
        *(float4*)(xo + 4 * j) = xa;
        acc[4 * j] = xa.x; acc[4 * j + 1] = xa.y; acc[4 * j + 2] = xa.z; acc[4 * j + 3] = xa.w;
        ss += xa.x * xa.x + xa.y * xa.y + xa.z * xa.z + xa.w * xa.w;
    }
    if (g_next != nullptr) {
        ss = wave_allsum_fast(ss);
        const float rstd = rsqrtf(ss * (1.f / DM) + 1e-6f);
        const float* mn = mod_next + (size_t)tok_modrow(t) * 6144 + lane * 16;
#pragma unroll
        for (int j = 0; j < 4; j++) {
            const float4 gg = *(const float4*)(g_next + lane * 16 + 4 * j);
            const float4 sh = *(const float4*)(mn + 4 * j);
            const float4 sc = *(const float4*)(mn + 1024 + 4 * j);
            *(ushort4*)(h_next + (size_t)t * DM + lane * 16 + 4 * j) =
                pack_bf4(acc[4 * j] * rstd * gg.x * (1.f + sc.x) + sh.x, acc[4 * j + 1] * rstd * gg.y * (1.f + sc.y) + sh.y,
                         acc[4 * j + 2] * rstd * gg.z * (1.f + sc.z) + sh.z, acc[4 * j + 3] * rstd * gg.w * (1.f + sc.w) + sh.w);
        }
    }
}


__device__ __forceinline__ void d_rw_kk3(const int vb, const bf16_t* __restrict__ rb, const bf16_t* __restrict__ kb, const bf16_t* __restrict__ lr0,
                                         const bf16_t* __restrict__ lr1, const float* __restrict__ k_k, const float* __restrict__ k_a,
                                         const float* __restrict__ r_k, bf16_t* __restrict__ kkb, float* __restrict__ bonus) {
    const int g = threadIdx.x >> 4, l16 = threadIdx.x & 15;
    uint2 kq[4], rq[4], aq[4], bq[4];
#pragma unroll
    for (int u = 0; u < 4; u++) {
        const size_t o = (size_t)(vb * 64 + g + 16 * u) * 64 + l16 * 4;
        kq[u] = *(const uint2*)(kb + o); rq[u] = *(const uint2*)(rb + o); aq[u] = *(const uint2*)(lr0 + o); bq[u] = *(const uint2*)(lr1 + o);
    }
#pragma unroll
    for (int u = 0; u < 4; u++) {
        const int w = vb * 64 + g + 16 * u;
        const int h = w & 7;
        const float4 kk4 = *(const float4*)(k_k + h * 64 + l16 * 4), ka4 = *(const float4*)(k_a + h * 64 + l16 * 4), rk4 = *(const float4*)(r_k + h * 64 + l16 * 4);
        const float k0 = __uint_as_float(kq[u].x << 16), k1 = __uint_as_float(kq[u].x & 0xffff0000u), k2 = __uint_as_float(kq[u].y << 16), k3 = __uint_as_float(kq[u].y & 0xffff0000u);
        const float r0 = __uint_as_float(rq[u].x << 16), r1 = __uint_as_float(rq[u].x & 0xffff0000u), r2 = __uint_as_float(rq[u].y << 16), r3 = __uint_as_float(rq[u].y & 0xffff0000u);
        const float a0 = __uint_as_float(aq[u].x << 16), a1 = __uint_as_float(aq[u].x & 0xffff0000u), a2 = __uint_as_float(aq[u].y << 16), a3 = __uint_as_float(aq[u].y & 0xffff0000u);
        const float b0 = __uint_as_float(bq[u].x << 16), b1 = __uint_as_float(bq[u].x & 0xffff0000u), b2 = __uint_as_float(bq[u].y << 16), b3 = __uint_as_float(bq[u].y & 0xffff0000u);
        const float q0 = k0 * kk4.x, q1 = k1 * kk4.y, q2 = k2 * kk4.z, q3 = k3 * kk4.w;
        float ss = (q0 * q0 + q1 * q1) + (q2 * q2 + q3 * q3);
        float bs = r0 * k0 * (2.f + (a0 + b0 - 2.f) * ka4.x) * rk4.x + r1 * k1 * (2.f + (a1 + b1 - 2.f) * ka4.y) * rk4.y +
                   r2 * k2 * (2.f + (a2 + b2 - 2.f) * ka4.z) * rk4.z + r3 * k3 * (2.f + (a3 + b3 - 2.f) * ka4.w) * rk4.w;
        ss = row16_allsum(ss); bs = row16_allsum(bs);
        const float inv = 1.f / fmaxf(sqrtf(ss), 1e-12f);
        uint2 o2;
        o2.x = (unsigned)f2bf(q0 * inv) | ((unsigned)f2bf(q1 * inv) << 16);
        o2.y = (unsigned)f2bf(q2 * inv) | ((unsigned)f2bf(q3 * inv) << 16);
        *(uint2*)(kkb + (size_t)w * 64 + l16 * 4) = o2;
        if (l16 == 0) bonus[w] = bs;
    }
}
__device__ __forceinline__ void d_rw_post3(const int vb, const float* __restrict__ y0, const float* __restrict__ y1, const float* __restrict__ bonus,
                                           const bf16_t* __restrict__ vbuf, const bf16_t* __restrict__ gate, const float* __restrict__ lnx_g,
                                           const float* __restrict__ lnx_b, bf16_t* __restrict__ cat) {
    const int g = threadIdx.x >> 4, l16 = threadIdx.x & 15;
    float4 ya[4], yb[4]; uint2 vq[4], gq[4];
#pragma unroll
    for (int u = 0; u < 4; u++) {
        const size_t o = (size_t)(vb * 64 + g + 16 * u) * 64 + l16 * 4;
        ya[u] = *(const float4*)(y0 + o); yb[u] = *(const float4*)(y1 + o); vq[u] = *(const uint2*)(vbuf + o); gq[u] = *(const uint2*)(gate + o);
    }
#pragma unroll
    for (int u = 0; u < 4; u++) {
        const int w = vb * 64 + g + 16 * u;
        const int t = w >> 3, h = w & 7;
        const float e0 = ya[u].x + yb[u].x, e1 = ya[u].y + yb[u].y, e2 = ya[u].z + yb[u].z, e3 = ya[u].w + yb[u].w;
        const float mean = row16_allsum((e0 + e1) + (e2 + e3)) * (1.f / 64.f);
        const float d0 = e0 - mean, d1 = e1 - mean, d2 = e2 - mean, d3 = e3 - mean;
        const float var = row16_allsum((d0 * d0 + d1 * d1) + (d2 * d2 + d3 * d3)) * (1.f / 64.f);
        const float rstd = rsqrtf(var + 64e-5f);
        const float bn = bonus[w];
        const float4 g4 = *(const float4*)(lnx_g + h * 64 + l16 * 4), b4 = *(const float4*)(lnx_b + h * 64 + l16 * 4);
        const float v0 = __uint_as_float(vq[u].x << 16), v1 = __uint_as_float(vq[u].x & 0xffff0000u), v2 = __uint_as_float(vq[u].y << 16), v3 = __uint_as_float(vq[u].y & 0xffff0000u);
        const float t0 = __uint_as_float(gq[u].x << 16), t1 = __uint_as_float(gq[u].x & 0xffff0000u), t2 = __uint_as_float(gq[u].y << 16), t3 = __uint_as_float(gq[u].y & 0xffff0000u);
        uint2 o2;
        o2.x = (unsigned)f2bf((d0 * rstd * g4.x + b4.x + bn * v0) * t0) | ((unsigned)f2bf((d1 * rstd * g4.y + b4.y + bn * v1) * t1) << 16);
        o2.y = (unsigned)f2bf((d2 * rstd * g4.z + b4.z + bn * v2) * t2) | ((unsigned)f2bf((d3 * rstd * g4.w + b4.w + bn * v3) * t3) << 16);
        *(uint2*)(cat + (size_t)t * DM + h * 64 + l16 * 4) = o2;
    }
}


__device__ __forceinline__ void d_mla_post3(const int vb, const bf16_t* __restrict__ qraw, const bf16_t* __restrict__ kvraw, const bf16_t* __restrict__ kvraw_ctx,
                                            const float* __restrict__ kpe, const float* __restrict__ cache_kpe, const float* __restrict__ qn,
                                            const float* __restrict__ kn, bf16_t* __restrict__ Qb, bf16_t* __restrict__ Kp, bf16_t* __restrict__ Ks) {
    const int g = threadIdx.x >> 4, l16 = threadIdx.x & 15;
    const float inv = __expf(-(float)l16 * (1.f / 16.f) * 9.210340371976184f);
    float2 qnv[6], knv[6];
#pragma unroll
    for (int j = 0; j < 6; j++) { qnv[j] = *(const float2*)(qn + 2 * (l16 + 16 * j)); knv[j] = *(const float2*)(kn + 2 * (l16 + 16 * j)); }
#pragma unroll 2
    for (int u = 0; u < 4; u++) {
        const int item = vb * 64 + g + 16 * u;
        const int row = item >> 2, h = item & 3;
        const bool isctx = row >= TT, sample = row >= TP;
        const bf16_t* kvr; const float* pe; int pos = 0;
        if (isctx) { const int cr = row - TT; kvr = kvraw_ctx + (size_t)cr * 1024; pe = cache_kpe + (size_t)cr * 64; }
        else { kvr = kvraw + (size_t)row * 1024; pe = kpe + (size_t)row * 64; pos = tok_pos(row); }
        float kx[12], qx[12];
#pragma unroll
        for (int j = 0; j < 4; j++) {
            const unsigned kw = *(const unsigned*)(kvr + h * 256 + 2 * (l16 + 16 * j));
            kx[2 * j] = __uint_as_float(kw << 16); kx[2 * j + 1] = __uint_as_float(kw & 0xffff0000u);
        }
#pragma unroll
        for (int j = 4; j < 6; j++) { const float2 pv = *(const float2*)(pe + 2 * (l16 + 16 * (j - 4))); kx[2 * j] = pv.x; kx[2 * j + 1] = pv.y; }
#pragma unroll
        for (int j = 0; j < 6; j++) {
            const unsigned qw = isctx ? 0u : *(const unsigned*)(qraw + (size_t)row * 768 + h * 192 + 2 * (l16 + 16 * j));
            qx[2 * j] = __uint_as_float(qw << 16); qx[2 * j + 1] = __uint_as_float(qw & 0xffff0000u);
        }
        float sk = 0.f, sq = 0.f;
#pragma unroll
        for (int j = 0; j < 12; j++) { sk += kx[j] * kx[j]; sq += qx[j] * qx[j]; }
        sk = row16_allsum(sk); sq = row16_allsum(sq);
        const float rk = rsqrtf(sk * (1.f / 192.f) + 1e-6f), rq = rsqrtf(sq * (1.f / 192.f) + 1e-6f);
#pragma unroll
        for (int j = 0; j < 6; j++) {
            kx[2 * j] *= rk * knv[j].x; kx[2 * j + 1] *= rk * knv[j].y;
            qx[2 * j] *= rq * qnv[j].x; qx[2 * j + 1] *= rq * qnv[j].y;
        }
        if (sample && !isctx) {
#pragma unroll
            for (int j = 4; j < 6; j++) {
                const float ang = (j == 4 ? (float)(pos >> 6) : (float)(pos & 63)) * inv;
                const float cs = __cosf(ang), sn = __sinf(ang);
                const float a = kx[2 * j], bq = kx[2 * j + 1];
                kx[2 * j] = a * cs - bq * sn; kx[2 * j + 1] = a * sn + bq * cs;
                const float a2 = qx[2 * j], b2 = qx[2 * j + 1];
                qx[2 * j] = a2 * cs - b2 * sn; qx[2 * j + 1] = a2 * sn + b2 * cs;
            }
        }
        bf16_t* kd;
        if (!sample) { const int b = row >> 8, pp = row & 255; kd = Kp + ((size_t)(b * 4 + h) * LP + pp) * 192; }
        else if (!isctx) { const int b = (row - TP) >> 11, pp = (row - TP) & 2047; kd = Ks + ((size_t)(b * 4 + h) * 2304 + 256 + pp) * 192; }
        else { const int cr = row - TT; const int b = cr >> 8, pp = cr & 255; kd = Ks + ((size_t)(b * 4 + h) * 2304 + pp) * 192; }
#pragma unroll
        for (int j = 0; j < 6; j++) {
            const int e = 2 * (l16 + 16 * j);
            *(unsigned*)(kd + e) = (unsigned)f2bf(kx[2 * j]) | ((unsigned)f2bf(kx[2 * j + 1]) << 16);
            if (!isctx) *(unsigned*)(Qb + ((size_t)row * 4 + h) * 192 + e) = (unsigned)f2bf(qx[2 * j]) | ((unsigned)f2bf(qx[2 * j + 1]) << 16);
        }
    }
}

#define XB_TMO      128
#define XB_XCNT(j)  (256  + 64 * (j))
#define XB_XSUB(j)  (1280 + 64 * (j))
#define XB_XGEN(j)  (2304 + 64 * (j))
#define XB_TOP      3328
#define XB_TOPGEN   3392
#define XCD_BAR_WORDS 3456
#define XB_SPIN_CAP (1u << 22)
#define LAS __attribute__((address_space(3)))
__device__ __forceinline__ unsigned xb_ld(unsigned* p) { return __hip_atomic_load(p, __ATOMIC_RELAXED, __HIP_MEMORY_SCOPE_AGENT); }
__device__ __forceinline__ unsigned xb_add(unsigned* p, unsigned v) { return __hip_atomic_fetch_add(p, v, __ATOMIC_RELAXED, __HIP_MEMORY_SCOPE_AGENT); }
__device__ __forceinline__ unsigned xb_xcc_id() { return (unsigned)__builtin_amdgcn_s_getreg((3 << 11) | 20) & 0xFu; }
#define XB_SPIN(cond, bar) do { unsigned _sp = 0; while (cond) { __builtin_amdgcn_s_sleep(1); \
    if ((++_sp & 255u) == 0u) { if (xb_ld(&(bar)[XB_TMO])) break; if (_sp > XB_SPIN_CAP) { atomicAdd(&(bar)[XB_TMO], 1u); break; } } } } while (0)
struct XcdBarrier { unsigned* bar; unsigned x; volatile LAS unsigned* st; };
__device__ __forceinline__ XcdBarrier xcd_barrier_post(unsigned* bar, volatile LAS unsigned* st) {
    XcdBarrier b; b.bar = bar; b.x = xb_xcc_id(); b.st = st;
    if (threadIdx.x == 0) (void)xb_add(&bar[XB_XCNT(b.x)], 1u);
    return b;
}
__device__ __forceinline__ void xcd_barrier_complete(unsigned* bar, unsigned x, unsigned& nloc, unsigned& nx) {
    const unsigned G = gridDim.x * gridDim.y * gridDim.z;
    unsigned sum, cnt, mine, sp = 0u;
    for (;;) {
        sum = 0u; cnt = 0u; mine = 0u;
#pragma unroll
        for (unsigned j = 0; j < 16; ++j) { const unsigned c = xb_ld(&bar[XB_XCNT(j)]); sum += c; cnt += (c > 0u) ? 1u : 0u; mine = (j == x) ? c : mine; }
        if (sum == G) break;
        __builtin_amdgcn_s_sleep(1);
        if ((++sp & 255u) == 0u) { if (xb_ld(&bar[XB_TMO])) break; if (sp > XB_SPIN_CAP) { atomicAdd(&bar[XB_TMO], 1u); break; } }
    }
    nloc = mine > 0u ? mine : 1u; nx = cnt > 0u ? cnt : 1u;
}
__device__ __forceinline__ void xcd_barrier_(unsigned* bar_, char* smem_) {
    XcdBarrier b; b.bar = bar_; b.x = xb_xcc_id(); b.st = (volatile LAS unsigned*)(smem_ + GEMM_LDS_BYTES);
    asm volatile("s_waitcnt vmcnt(0)" ::: "memory");
    __syncthreads();
    if (threadIdx.x == 0) {
        unsigned* bar = b.bar;
        __builtin_amdgcn_s_waitcnt(0);
        unsigned nloc = b.st[0], nx = b.st[1];
        if (nloc == 0u) { xcd_barrier_complete(bar, b.x, nloc, nx); b.st[0] = nloc; b.st[1] = nx; }
        const unsigned old = xb_add(&bar[XB_XSUB(b.x)], 1u);
        const unsigned gen = old / nloc;
        if (old + 1u == (gen + 1u) * nloc) {
            __builtin_amdgcn_fence(__ATOMIC_RELEASE, "agent");
            asm volatile("s_waitcnt vmcnt(0)" ::: "memory");
            const unsigned og = xb_add(&bar[XB_TOP], 1u);
            const unsigned tg = og / nx;
            if (og + 1u == (tg + 1u) * nx) xb_add(&bar[XB_TOPGEN], 1u);
            else XB_SPIN(xb_ld(&bar[XB_TOPGEN]) == tg, bar);
            __builtin_amdgcn_fence(__ATOMIC_ACQUIRE, "agent");
            xb_add(&bar[XB_XGEN(b.x)], 1u);
            asm volatile("s_waitcnt vmcnt(0)" ::: "memory");
        } else {
            XB_SPIN(xb_ld(&bar[XB_XGEN(b.x)]) == gen, bar);
            __builtin_amdgcn_fence(__ATOMIC_ACQUIRE, "agent");
            asm volatile("s_waitcnt vmcnt(0)" ::: "memory");
        }
    }
    __syncthreads();
}

constexpr size_t ws_al(size_t x) { return (x + 255) & ~(size_t)255; }
struct WS {
    static constexpr size_t mod = 0;
    static constexpr size_t w_in_t = ws_al(mod + (size_t)(2*5*6144*4));
    static constexpr size_t w_out_t = ws_al(w_in_t + (size_t)(2304*1024*2));
    static constexpr size_t hy_w_in_t = ws_al(w_out_t + (size_t)(1024*1024*2));
    static constexpr size_t hy_w_out_t = ws_al(hy_w_in_t + (size_t)(3072*1024*2));
    static constexpr size_t w_q_t = ws_al(hy_w_out_t + (size_t)(1024*1024*2));
    static constexpr size_t q_up_t = ws_al(w_q_t + (size_t)(2*2048*1024*2));
    static constexpr size_t kv_up_t = ws_al(q_up_t + (size_t)(768*256*2));
    static constexpr size_t w2_t = ws_al(kv_up_t + (size_t)(1024*128*2));
    static constexpr size_t a2_t = ws_al(w2_t + (size_t)(2*512*64*2));
    static constexpr size_t g2_t = ws_al(a2_t + (size_t)(2*512*64*2));
    static constexpr size_t ctxb = ws_al(g2_t + (size_t)(512*128*2));
    static constexpr size_t keysb = ws_al(ctxb + (size_t)(1024*128*2));
    static constexpr size_t tabU = ws_al(keysb + (size_t)(2*16*128*128*2));
    static constexpr size_t tabV = ws_al(tabU + (size_t)(16384*1024));
    static constexpr size_t rsU = ws_al(tabV + (size_t)(16384*1024));
    static constexpr size_t rsV = ws_al(rsU + (size_t)(16384*4));
    static constexpr size_t nsum = ws_al(rsV + (size_t)(16384*4));
    static constexpr size_t gTS = ws_al(nsum + (size_t)(2*1024*4 + 3456*4 + 1024));
    static constexpr size_t gTP = ws_al(gTS + (size_t)1024*2*2048*2);
    static constexpr size_t R1 = ws_al(gTP + (size_t)1024*2*256*2);
    static constexpr size_t R2 = ws_al(R1 + (size_t)((size_t)TT*1024*4));
    static constexpr size_t rb = ws_al(R2 + (size_t)((size_t)TT*1792*2 + (size_t)TT*448*4));
    static constexpr size_t kb = ws_al(rb + (size_t)((size_t)TT*512*2));
    static constexpr size_t vb = ws_al(kb + (size_t)((size_t)TT*512*2));
    static constexpr size_t kkb = ws_al(vb + (size_t)((size_t)TT*512*2));
    static constexpr size_t lr0 = ws_al(kkb + (size_t)((size_t)TT*512*2));
    static constexpr size_t lr1 = ws_al(lr0 + (size_t)((size_t)TT*512*2));
    static constexpr size_t gateb = ws_al(lr1 + (size_t)((size_t)TT*512*2));
    static constexpr size_t du0 = ws_al(gateb + (size_t)((size_t)TT*512*2));
    static constexpr size_t du1 = ws_al(du0 + (size_t)((size_t)TT*512*2));
    static constexpr size_t twb = ws_al(du1 + (size_t)((size_t)TT*512*2));
    static constexpr size_t advb = ws_al(twb + (size_t)((size_t)TT*64*2));
    static constexpr size_t sgb = ws_al(advb + (size_t)((size_t)TT*64*2));
    static constexpr size_t bonus = ws_al(sgb + (size_t)((size_t)TT*128*2));
    static constexpr size_t kpe = ws_al(bonus + (size_t)((size_t)TT*8*4));
    static constexpr size_t qcnb = ws_al(kpe + (size_t)((size_t)TT*64*4));
    static constexpr size_t ckvb = ws_al(qcnb + (size_t)((size_t)TT*256*2));
    static constexpr size_t Qb = ws_al(ckvb + (size_t)((size_t)TT*128*2));
    static constexpr size_t Kp = ws_al(Qb + (size_t)((size_t)TT*768*2));
    static constexpr size_t Vp = ws_al(Kp + (size_t)(16*4*256*192*2));
    static constexpr size_t Ks = ws_al(Vp + (size_t)(16*4*256*128*2));
    static constexpr size_t Vs = ws_al(Ks + (size_t)(4*4*2304*192*2));
    static constexpr size_t kvctxb = ws_al(Vs + (size_t)(4*4*2304*128*2));
    static constexpr size_t pidx = ws_al(kvctxb + (size_t)(1024*1024*2));
    static constexpr size_t pg = ws_al(pidx + (size_t)((size_t)TT*128*4));
    static constexpr size_t END = ws_al(pg + (size_t)((size_t)TT*128*4));
    static constexpr size_t hb = R1;
    static constexpr size_t catb = R1;
    static constexpr size_t zbb = R1;
    static constexpr size_t kvrawb = R1;
    static constexpr size_t qrawb = R1 + (size_t)TT*1024*2;
    static constexpr size_t projrw = R2;
    static constexpr size_t projmla = R2 + (size_t)TT*1792*2;
    static constexpr size_t y0 = R2;
    static constexpr size_t y1 = R2 + (size_t)TT*512*4;
    static constexpr size_t qb = R2;
    static constexpr size_t scT = rb;
    static constexpr size_t pre = R2;
    static constexpr size_t zT = R2 + (size_t)TT*3072*2;
    static constexpr size_t x0b = R2 + (size_t)TT*3072*2 + (size_t)TT*1024*2;
    static constexpr size_t yT = R2 + (size_t)TT*3072*2 + (size_t)TT*1024*4;
    static constexpr size_t bar = nsum + 2*1024*4;
};
struct Params {
    const float* in[46];
    float* out;
    char* ws;
    __device__ __forceinline__ const float* x_prompt() const { return in[0]; }
    __device__ __forceinline__ const float* x_sample() const { return in[1]; }
    __device__ __forceinline__ const float* st_f() const { return in[2]; }
    __device__ __forceinline__ const float* st_b() const { return in[3]; }
    __device__ __forceinline__ const float* cache_ckv() const { return in[4]; }
    __device__ __forceinline__ const float* cache_kpe() const { return in[5]; }
    __device__ __forceinline__ const float* c() const { return in[6]; }
    __device__ __forceinline__ const float* c_ctx() const { return in[7]; }
    __device__ __forceinline__ const float* norm_g() const { return in[8]; }
    __device__ __forceinline__ const float* w_mod() const { return in[9]; }
    __device__ __forceinline__ const float* b_mod() const { return in[10]; }
    __device__ __forceinline__ const float* ab_w_in() const { return in[11]; }
    __device__ __forceinline__ const float* rw_mu() const { return in[12]; }
    __device__ __forceinline__ const float* rw_w0() const { return in[13]; }
    __device__ __forceinline__ const float* rw_w2() const { return in[14]; }
    __device__ __forceinline__ const float* rw_a0() const { return in[15]; }
    __device__ __forceinline__ const float* rw_a2() const { return in[16]; }
    __device__ __forceinline__ const float* rw_g2() const { return in[17]; }
    __device__ __forceinline__ const float* rw_k_k() const { return in[18]; }
    __device__ __forceinline__ const float* rw_k_a() const { return in[19]; }
    __device__ __forceinline__ const float* rw_r_k() const { return in[20]; }
    __device__ __forceinline__ const float* rw_lnx_g() const { return in[21]; }
    __device__ __forceinline__ const float* rw_lnx_b() const { return in[22]; }
    __device__ __forceinline__ const float* mla_q_norm() const { return in[23]; }
    __device__ __forceinline__ const float* mla_q_up() const { return in[24]; }
    __device__ __forceinline__ const float* mla_kv_norm() const { return in[25]; }
    __device__ __forceinline__ const float* mla_kv_up() const { return in[26]; }
    __device__ __forceinline__ const float* mla_qn() const { return in[27]; }
    __device__ __forceinline__ const float* mla_kn() const { return in[28]; }
    __device__ __forceinline__ const float* ab_w_out() const { return in[29]; }
    __device__ __forceinline__ const float* hy_w_in() const { return in[30]; }
    __device__ __forceinline__ const float* hy_b_in() const { return in[31]; }
    __device__ __forceinline__ const float* hy_conv_w() const { return in[32]; }
    __device__ __forceinline__ const float* hy_conv_b() const { return in[33]; }
    __device__ __forceinline__ const float* hy_f_w1() const { return in[34]; }
    __device__ __forceinline__ const float* hy_f_b1() const { return in[35]; }
    __device__ __forceinline__ const float* hy_f_w2() const { return in[36]; }
    __device__ __forceinline__ const float* hy_f_b2() const { return in[37]; }
    __device__ __forceinline__ const float* hy_f_w3() const { return in[38]; }
    __device__ __forceinline__ const float* hy_f_freq() const { return in[39]; }
    __device__ __forceinline__ const float* hy_bias() const { return in[40]; }
    __device__ __forceinline__ const float* hy_w_out() const { return in[41]; }
    __device__ __forceinline__ const float* peer_w_q() const { return in[42]; }
    __device__ __forceinline__ const float* peer_keys() const { return in[43]; }
    __device__ __forceinline__ const float* peer_u() const { return in[44]; }
    __device__ __forceinline__ const float* peer_v() const { return in[45]; }
    __device__ __forceinline__ float* xrun() const { return out + (0); }
    __device__ __forceinline__ float* out_sf() const { return out + ((size_t)TT*DM); }
    __device__ __forceinline__ float* out_sb() const { return out + ((size_t)TT*DM + 16*8*64*64); }
    __device__ __forceinline__ float* out_ckv() const { return out + ((size_t)TT*DM + 2*16*8*64*64); }
    __device__ __forceinline__ float* out_kpe() const { return out + ((size_t)TT*DM + 2*16*8*64*64 + 16*256*128); }
    __device__ __forceinline__ float* mod() const { return (float*)(ws + WS::mod); }
    __device__ __forceinline__ bf16_t* w_in_t() const { return (bf16_t*)(ws + WS::w_in_t); }
    __device__ __forceinline__ bf16_t* w_out_t() const { return (bf16_t*)(ws + WS::w_out_t); }
    __device__ __forceinline__ bf16_t* hy_w_in_t() const { return (bf16_t*)(ws + WS::hy_w_in_t); }
    __device__ __forceinline__ bf16_t* hy_w_out_t() const { return (bf16_t*)(ws + WS::hy_w_out_t); }
    __device__ __forceinline__ bf16_t* w_q_t() const { return (bf16_t*)(ws + WS::w_q_t); }
    __device__ __forceinline__ bf16_t* q_up_t() const { return (bf16_t*)(ws + WS::q_up_t); }
    __device__ __forceinline__ bf16_t* kv_up_t() const { return (bf16_t*)(ws + WS::kv_up_t); }
    __device__ __forceinline__ bf16_t* w2_t() const { return (bf16_t*)(ws + WS::w2_t); }
    __device__ __forceinline__ bf16_t* a2_t() const { return (bf16_t*)(ws + WS::a2_t); }
    __device__ __forceinline__ bf16_t* g2_t() const { return (bf16_t*)(ws + WS::g2_t); }
    __device__ __forceinline__ bf16_t* ctxb() const { return (bf16_t*)(ws + WS::ctxb); }
    __device__ __forceinline__ bf16_t* keysb() const { return (bf16_t*)(ws + WS::keysb); }
    __device__ __forceinline__ unsigned char* tabU() const { return (unsigned char*)(ws + WS::tabU); }
    __device__ __forceinline__ float* rsU() const { return (float*)(ws + WS::rsU); }
    __device__ __forceinline__ float* rsV() const { return (float*)(ws + WS::rsV); }
    __device__ __forceinline__ unsigned char* tabV() const { return (unsigned char*)(ws + WS::tabV); }
    __device__ __forceinline__ float* nsum() const { return (float*)(ws + WS::nsum); }
    __device__ __forceinline__ bf16_t* rb() const { return (bf16_t*)(ws + WS::rb); }
    __device__ __forceinline__ bf16_t* kb() const { return (bf16_t*)(ws + WS::kb); }
    __device__ __forceinline__ bf16_t* vb() const { return (bf16_t*)(ws + WS::vb); }
    __device__ __forceinline__ bf16_t* kkb() const { return (bf16_t*)(ws + WS::kkb); }
    __device__ __forceinline__ bf16_t* lr0() const { return (bf16_t*)(ws + WS::lr0); }
    __device__ __forceinline__ bf16_t* lr1() const { return (bf16_t*)(ws + WS::lr1); }
    __device__ __forceinline__ bf16_t* gateb() const { return (bf16_t*)(ws + WS::gateb); }
    __device__ __forceinline__ _Float16* du0() const { return (_Float16*)(ws + WS::du0); }
    __device__ __forceinline__ _Float16* du1() const { return (_Float16*)(ws + WS::du1); }
    __device__ __forceinline__ bf16_t* twb() const { return (bf16_t*)(ws + WS::twb); }
    __device__ __forceinline__ bf16_t* advb() const { return (bf16_t*)(ws + WS::advb); }
    __device__ __forceinline__ bf16_t* sgb() const { return (bf16_t*)(ws + WS::sgb); }
    __device__ __forceinline__ float* bonus() const { return (float*)(ws + WS::bonus); }
    __device__ __forceinline__ float* kpe() const { return (float*)(ws + WS::kpe); }
    __device__ __forceinline__ bf16_t* qcnb() const { return (bf16_t*)(ws + WS::qcnb); }
    __device__ __forceinline__ bf16_t* ckvb() const { return (bf16_t*)(ws + WS::ckvb); }
    __device__ __forceinline__ bf16_t* Qb() const { return (bf16_t*)(ws + WS::Qb); }
    __device__ __forceinline__ bf16_t* Kp() const { return (bf16_t*)(ws + WS::Kp); }
    __device__ __forceinline__ bf16_t* Vp() const { return (bf16_t*)(ws + WS::Vp); }
    __device__ __forceinline__ bf16_t* Ks() const { return (bf16_t*)(ws + WS::Ks); }
    __device__ __forceinline__ bf16_t* Vs() const { return (bf16_t*)(ws + WS::Vs); }
    __device__ __forceinline__ bf16_t* kvctxb() const { return (bf16_t*)(ws + WS::kvctxb); }
    __device__ __forceinline__ int* pidx() const { return (int*)(ws + WS::pidx); }
    __device__ __forceinline__ float* pg() const { return (float*)(ws + WS::pg); }
    __device__ __forceinline__ bf16_t* hb() const { return (bf16_t*)(ws + WS::hb); }
    __device__ __forceinline__ bf16_t* catb() const { return (bf16_t*)(ws + WS::catb); }
    __device__ __forceinline__ bf16_t* zbb() const { return (bf16_t*)(ws + WS::zbb); }
    __device__ __forceinline__ bf16_t* kvrawb() const { return (bf16_t*)(ws + WS::kvrawb); }
    __device__ __forceinline__ bf16_t* qrawb() const { return (bf16_t*)(ws + WS::qrawb); }
    __device__ __forceinline__ bf16_t* projrw() const { return (bf16_t*)(ws + WS::projrw); }
    __device__ __forceinline__ float* projmla() const { return (float*)(ws + WS::projmla); }
    __device__ __forceinline__ float* y0() const { return (float*)(ws + WS::y0); }
    __device__ __forceinline__ float* y1() const { return (float*)(ws + WS::y1); }
    __device__ __forceinline__ bf16_t* qb() const { return (bf16_t*)(ws + WS::qb); }
    __device__ __forceinline__ float* scT() const { return (float*)(ws + WS::scT); }
    __device__ __forceinline__ bf16_t* pre() const { return (bf16_t*)(ws + WS::pre); }
    __device__ __forceinline__ bf16_t* zT() const { return (bf16_t*)(ws + WS::zT); }
    __device__ __forceinline__ bf16_t* x0b() const { return (bf16_t*)(ws + WS::x0b); }
    __device__ __forceinline__ bf16_t* yT() const { return (bf16_t*)(ws + WS::yT); }
    __device__ __forceinline__ bf16_t* gTS() const { return (bf16_t*)(ws + WS::gTS); }
    __device__ __forceinline__ bf16_t* gTP() const { return (bf16_t*)(ws + WS::gTP); }
    __device__ __forceinline__ unsigned* bar() const { return (unsigned*)(ws + WS::bar); }
};

#define VLOOP(n) for (int vb = blockIdx.x; vb < (n); vb += gridDim.x)
#define ENDV __syncthreads();

#define QLOOP(ctr_word, nitems, ...)                                                            \
    {                                                                                           \
        unsigned* qctr = p.bar() + XCD_BAR_WORDS + 128 + (ctr_word);                            \
        volatile unsigned* bc = (volatile unsigned*)(smem + GEMM_LDS_BYTES + 8);                \
        for (;;) {                                                                              \
            if (threadIdx.x == 0) *bc = atomicAdd(qctr, 1u);                                    \
            __syncthreads();                                                                    \
            const int item = (int)*bc;                                                          \
            __syncthreads();                                                                    \
            if (item >= (nitems)) break;                                                        \
            __VA_ARGS__                                                                         \
        }                                                                                       \
    }
__device__ __forceinline__ void peer_layer(const Params& p, char* smem, int li, const float* modl, float* xrs) {
    const bf16_t* wq = p.w_q_t() + (size_t)li * 2048 * 1024;
    const bf16_t* kys = p.keysb() + (size_t)li * 16 * 128 * 128;
    VLOOP(TT / 8) { d_norm_mod2(vb, p.xrun(), xrs, p.norm_g() + (li * 2 + 1) * 1024, modl, 3, 4, p.hb()); }
    xcd_barrier_(p.bar(), smem);
    VLOOP(16 * 96) { d_gemm_bf16(vb % 16, vb / 16, smem, p.hb(), 1024, wq, 1024, 1024, 2048, EpiStoreBf{p.qb(), 2048, 0}); }
    xcd_barrier_(p.bar(), smem);
    VLOOP(8 * 96) { d_peer_route2(vb, smem, kys, p.qb(), p.pidx(), p.pg()); ENDV }
    if (li == 0) {
        QLOOP(4, 1536, {
            const int t1 = 48 * 16, t2 = t1 + 16 * 16;
            const float* W; bf16_t* Wt; int N, lv;
            if (item < t1) { W = p.hy_w_in(); Wt = p.hy_w_in_t(); N = 3072; lv = item; }
            else if (item < t2) { W = p.hy_w_out(); Wt = p.hy_w_out_t(); N = 1024; lv = item - t1; }
            else { W = p.peer_w_q() + (size_t)1024 * 2048; Wt = p.w_q_t() + (size_t)2048 * 1024; N = 2048; lv = item - t2; }
            d_transpose_w(lv, smem, W, 1024, N, Wt);
        })
    }
    xcd_barrier_(p.bar(), smem);
    VLOOP(TT / 4) { d_peer_apply3(vb, smem, p.hb(), p.pidx(), p.pg(), p.tabU(), p.tabV(), p.rsU(), p.rsV(), modl, p.xrun(),
                                    li == 0 ? p.norm_g() + 2048 : nullptr, p.mod() + 5 * 6144, p.hb()); ENDV }
}

__global__ void __launch_bounds__(256, 2) mega(Params p) {
    __shared__ __attribute__((aligned(16))) char smem[GEMM_LDS_BYTES + 16];
    cg::grid_group grid = cg::this_grid();
    if (threadIdx.x < 4) ((unsigned*)(smem + GEMM_LDS_BYTES))[threadIdx.x] = 0u;
    __syncthreads();
    (void)xcd_barrier_post(p.bar(), (volatile LAS unsigned*)(smem + GEMM_LDS_BYTES));
    const float* mod0 = p.mod();
    const float* mod1 = p.mod() + 5 * 6144;
    float* xrs = p.xrun() + (size_t)TP * DM;

    VLOOP(192) { d_mod3(vb, smem, p.c(), p.c_ctx(), p.w_mod(), p.b_mod(), p.mod()); ENDV }
    if (p.ws == nullptr) grid.sync();
    xcd_barrier_(p.bar(), smem);
    VLOOP(TT / 8) { d_norm_mod2(vb, p.x_prompt(), p.x_sample(), p.norm_g(), mod0, 0, 1, p.hb()); }
    {
        const int j1 = 36 * 16;
        const int j7 = j1 + 12 * 4;
        const int j8 = j7 + 16 * 2;
        const int j9 = j8 + 8;
        const int j10 = j9 + 8;
        const int j11 = j10 + 8;
        const int j12 = j11 + 8;
        const int j13 = j12 + 8 * 2;
        VLOOP(j13) {
            const float* W; bf16_t* Wt; int K, N, lv;
            if (vb < j1) { W = p.ab_w_in(); Wt = p.w_in_t(); K = 1024; N = 2240; lv = vb; }
            else if (vb < j7) { W = p.mla_q_up(); Wt = p.q_up_t(); K = 256; N = 768; lv = vb - j1; }
            else if (vb < j8) { W = p.mla_kv_up(); Wt = p.kv_up_t(); K = 128; N = 1024; lv = vb - j7; }
            else if (vb < j9) { W = p.rw_w2(); Wt = p.w2_t(); K = 64; N = 512; lv = vb - j8; }
            else if (vb < j10) { W = p.rw_w2() + 64 * 512; Wt = p.w2_t() + 512 * 64; K = 64; N = 512; lv = vb - j9; }
            else if (vb < j11) { W = p.rw_a2(); Wt = p.a2_t(); K = 64; N = 512; lv = vb - j10; }
            else if (vb < j12) { W = p.rw_a2() + 64 * 512; Wt = p.a2_t() + 512 * 64; K = 64; N = 512; lv = vb - j11; }
            else { W = p.rw_g2(); Wt = p.g2_t(); K = 128; N = 512; lv = vb - j12; }
            d_transpose_w(lv, smem, W, K, N, Wt);
            ENDV }
    }
    VLOOP(40) { if (vb < 8) d_cvt_bf16(vb, p.cache_ckv(), p.ctxb()); else d_cvt_bf16(vb - 8, p.peer_keys(), p.keysb()); }
    xcd_barrier_(p.bar(), smem);
    VLOOP(18 * 96) { d_gemm_bf16(vb % 18, vb / 18, smem, p.hb(), 1024, p.w_in_t(), 1024, 1024, ABIN, EpiProj{p.projrw(), p.projmla()}); }
    xcd_barrier_(p.bar(), smem);
    VLOOP(2688 + 768) {
        if (vb < 2688) d_rw_shift2(vb, p.projrw(), p.rw_mu(), p.rb(), p.kb(), p.vb(), p.twb(), p.advb(), p.sgb());
        else d_mla_pre2(vb - 2688, p.projmla(), p.mla_q_norm(), p.mla_kv_norm(), p.qcnb(), p.ckvb(), p.kpe(), p.out_ckv(), p.out_kpe());
    }
    xcd_barrier_(p.bar(), smem);
    {
        const int n0 = 4 * 96, n1 = 6 * 96, n2 = 8 * 96, n3 = 8 * 8;
        VLOOP(5 * n0 + n1 + n2 + n3) {
            int v = vb;
            if (v < n0) d_gemm_bf16(v % 4, v / 4, smem, p.twb(), 64, p.w2_t(), 64, 64, 512, EpiDecay{p.du0(), p.rw_w0()});
            else if ((v -= n0) < n0) d_gemm_bf16(v % 4, v / 4, smem, p.twb(), 64, p.w2_t() + 512 * 64, 64, 64, 512, EpiDecay{p.du1(), p.rw_w0() + 512});
            else if ((v -= n0) < n0) d_gemm_bf16(v % 4, v / 4, smem, p.advb(), 64, p.a2_t(), 64, 64, 512, EpiLr{p.lr0(), p.rw_a0()});
            else if ((v -= n0) < n0) d_gemm_bf16(v % 4, v / 4, smem, p.advb(), 64, p.a2_t() + 512 * 64, 64, 64, 512, EpiLr{p.lr1(), p.rw_a0() + 512});
            else if ((v -= n0) < n0) d_gemm_bf16(v % 4, v / 4, smem, p.sgb(), 128, p.g2_t(), 128, 128, 512, EpiStoreBf{p.gateb(), 512, 0});
            else if ((v -= n0) < n1) d_gemm_bf16(v % 6, v / 6, smem, p.qcnb(), 256, p.q_up_t(), 256, 256, 768, EpiStoreBf{p.qrawb(), 768, 0});
            else if ((v -= n1) < n2) d_gemm_bf16(v % 8, v / 8, smem, p.ckvb(), 128, p.kv_up_t(), 128, 128, 1024, EpiKV{p.kvrawb(), p.Vp(), p.Vs(), 0, 0});
            else { v -= n2; d_gemm_bf16(v % 8, v / 8, smem, p.ctxb(), 128, p.kv_up_t(), 128, 128, 1024, EpiKV{p.kvctxb(), p.Vp(), p.Vs(), 1, 0}); }
        }
    }
    xcd_barrier_(p.bar(), smem);
    VLOOP(1536 + 832) {
        if (vb < 1536) d_rw_kk3(vb, p.rb(), p.kb(), p.lr0(), p.lr1(), p.rw_k_k(), p.rw_k_a(), p.rw_r_k(), p.kkb(), p.bonus());
        else d_mla_post3(vb - 1536, p.qrawb(), p.kvrawb(), p.kvctxb(), p.kpe(), p.cache_kpe(), p.mla_qn(), p.mla_kn(), p.Qb(), p.Kp(), p.Ks());
        ENDV }
    xcd_barrier_(p.bar(), smem);
    {
        const bool big = gridDim.x >= 512;
        if (big && blockIdx.x < 256) __builtin_amdgcn_s_setprio(3);
        for (int v = blockIdx.x; v < 256; v += gridDim.x)
            d_scan2(v, true, smem, p.rb(), p.kb(), p.vb(), p.kkb(), p.lr0(), p.lr1(), p.du0(), p.du1(), p.rw_k_a(), p.st_f(), p.st_b(), p.y0(), p.y1(), p.out_sf(), p.out_sb());
        __builtin_amdgcn_s_setprio(0);
    }
    QLOOP(0, 384, {
        const bool smp = item < 256;
        d_attn_mfma(smp ? item : item - 256, smem, p.Qb(), smp ? p.Ks() : p.Kp(), smp ? p.Vs() : p.Vp(), p.catb(), smp ? TP : 0, smp ? LS : LP,
                    smp ? 2304 : LP, smp ? 16 : 2);
    })
    QLOOP(2, 2048, {
        const bool isv = item >= 1024;
        d_cvt_fp8_rows(isv ? item - 1024 : item, isv ? p.peer_v() : p.peer_u(), isv ? p.tabV() : p.tabU(), isv ? p.rsV() : p.rsU());
    })
    QLOOP(3, 768, {
        const bool a_ = item < 256;
        d_transpose_w(a_ ? item : item - 256, smem, a_ ? p.ab_w_out() : p.peer_w_q(), 1024, a_ ? 1024 : 2048, a_ ? p.w_out_t() : p.w_q_t());
    })
    QLOOP(7, 1024, {
        d_scan2(item, false, smem, p.rb(), p.kb(), p.vb(), p.kkb(), p.lr0(), p.lr1(), p.du0(), p.du1(), p.rw_k_a(), p.st_f(), p.st_b(), p.y0(), p.y1(), p.out_sf(), p.out_sb());
    })
    xcd_barrier_(p.bar(), smem);
    VLOOP(1536) { d_rw_post3(vb, p.y0(), p.y1(), p.bonus(), p.vb(), p.gateb(), p.rw_lnx_g(), p.rw_lnx_b(), p.catb()); }
    QLOOP(1, 576, {
        const bool smp = item < 512;
        d_hy_filt2(smp ? item : item - 512, smem, smp ? LS : LP, p.hy_f_w1(), p.hy_f_b1(), p.hy_f_w2(), p.hy_f_b2(), p.hy_f_w3(), p.hy_f_freq(),
                   smp ? p.gTS() : p.gTP(), smp ? p.nsum() : p.nsum() + 1024);
    })
    xcd_barrier_(p.bar(), smem);
    QLOOP(5, 480 + 576, {
        if (item < 480) d_gemm_bf16n<2>(item % 5, item / 5, smem, p.catb(), 1024, p.w_out_t(), 1024, 1024, 1024, EpiResid{p.x_prompt(), p.x_sample(), p.xrun(), mod0, 2, 0});
        else { const int it = item - 480; d_gemm_bf16n<1>(10 + it % 6, it / 6, smem, p.catb(), 1024, p.w_out_t(), 1024, 1024, 1024, EpiResid{p.x_prompt(), p.x_sample(), p.xrun(), mod0, 2, 0}); }
    })
    xcd_barrier_(p.bar(), smem);
    peer_layer(p, smem, 0, mod0, xrs);
    xcd_barrier_(p.bar(), smem);
    VLOOP(24 * 96) { d_gemm_bf16(vb % 24, vb / 24, smem, p.hb(), 1024, p.hy_w_in_t(), 1024, 1024, 3072, EpiStoreBfBias{p.pre(), p.hy_b_in(), 3072, 0}); }
    VLOOP(2048) {
        const bool isv = vb >= 1024;
        d_cvt_fp8_rows(isv ? vb - 1024 : vb, (isv ? p.peer_v() : p.peer_u()) + (size_t)16384 * 1024, isv ? p.tabV() : p.tabU(), isv ? p.rsV() : p.rsU());
    }
    xcd_barrier_(p.bar(), smem);
    VLOOP(192 * 8) { d_hy_dw3(vb, smem, p.pre(), p.hy_conv_w(), p.hy_conv_b(), p.zT(), p.x0b()); ENDV }
    xcd_barrier_(p.bar(), smem);
    VLOOP(512 + 512) {
        const int wv = threadIdx.x >> 6;
        char* wsm = smem + (wv >> 1) * 28672;
        if (vb < 512) d_hy_conv2<true>(vb * 2 + (wv >> 1), wv & 1, wsm, p.gTS(), p.nsum(), p.zT(), p.hy_bias(), p.yT());
        else d_hy_conv2<false>((vb - 512) * 2 + (wv >> 1), wv & 1, wsm, p.gTP(), p.nsum() + 1024, p.zT(), p.hy_bias(), p.yT());
        ENDV }
    xcd_barrier_(p.bar(), smem);
    VLOOP(192 * 8) { d_hy_post2(vb, smem, p.yT(), p.x0b(), p.zbb()); ENDV }
    xcd_barrier_(p.bar(), smem);
    QLOOP(6, 480 + 576, {
        if (item < 480) d_gemm_bf16n<2>(item % 5, item / 5, smem, p.zbb(), 1024, p.hy_w_out_t(), 1024, 1024, 1024, EpiResid{p.xrun(), xrs, p.xrun(), mod1, 2, 0});
        else { const int it = item - 480; d_gemm_bf16n<1>(10 + it % 6, it / 6, smem, p.zbb(), 1024, p.hy_w_out_t(), 1024, 1024, 1024, EpiResid{p.xrun(), xrs, p.xrun(), mod1, 2, 0}); }
    })
    xcd_barrier_(p.bar(), smem);
    peer_layer(p, smem, 1, mod1, xrs);
}

static inline size_t align_up(size_t x) { return (x + 255) & ~(size_t)255; }

extern "C" void kernel_launch(void* const* d_in, const int* in_sizes, int n_in, void* d_out, int out_size, void* d_ws, size_t ws_size,
                              hipStream_t stream) {
    Params p{};
    for (int i = 0; i < 46; i++) p.in[i] = (const float*)d_in[i];
    p.out = (float*)d_out;
    p.ws = (char*)d_ws;
    static_assert(WS::END <= (size_t)422781952, "workspace plan exceeds the guaranteed scratch size");
    static int grid_blocks = 0;
    if (!grid_blocks) {
        int dev = 0, cus = 0, per_cu = 0;
        (void)hipGetDevice(&dev);
        (void)hipDeviceGetAttribute(&cus, hipDeviceAttributeMultiprocessorCount, dev);
        (void)hipOccupancyMaxActiveBlocksPerMultiprocessor(&per_cu, mega, 256, 0);
        if (per_cu > 2) per_cu = 2;
        if (per_cu < 1) per_cu = 1;
        grid_blocks = cus * per_cu;
    }
    (void)hipMemsetAsync(p.ws + WS::nsum, 0, (size_t)2 * 1024 * 4 + (size_t)XCD_BAR_WORDS * 4 + 1024, stream);
    (void)hipMemsetAsync(p.ws + WS::mod, 0, (size_t)2 * 5 * 6144 * 4, stream);
    void* args[] = {&p};
    (void)hipLaunchCooperativeKernel((void*)mega, dim3(grid_blocks), dim3(256), args, 0, stream);
}
```

```cpp
#include <hip/hip_runtime.h>
#include <stdint.h>
#include <hip/hip_cooperative_groups.h>
namespace cg = cooperative_groups;

#define DM 1024
#define TP 4096
#define TS 8192
#define TT 12288
#define LP 256
#define LS 2048
#define NBP 16
#define NBS 4
#define ABIN 2240
#define RWIN 1792

typedef unsigned short bf16_t;
__device__ __forceinline__ bf16_t f2bf(float f) { unsigned u = __float_as_uint(f); u += 0x7fffu + ((u >> 16) & 1u); return (bf16_t)(u >> 16); }
__device__ __forceinline__ float bf2f(bf16_t h) { return __uint_as_float(((unsigned)h) << 16); }
__device__ __forceinline__ float sigmoidf_(float x) { return 1.f / (1.f + expf(-x)); }
__device__ __forceinline__ float gelu_tanh(float x) { return 0.5f * x * (1.f + tanhf(0.7978845608028654f * (x + 0.044715f * x * x * x))); }

__device__ __forceinline__ int tok_pos(int t) { return t < TP ? (t & (LP - 1)) : ((t - TP) & (LS - 1)); }
__device__ __forceinline__ int tok_len(int t) { return t < TP ? LP : LS; }
__device__ __forceinline__ int tok_modrow(int t) { return t < TP ? 0 : 1 + ((t - TP) >> 11); }

__device__ __forceinline__ float wave_sum(float v) {
#pragma unroll
    for (int o = 32; o > 0; o >>= 1) v += __shfl_xor(v, o, 64);
    return v;
}


__device__ __forceinline__ void d_mod3(const int vb, char* smem, const float* __restrict__ c, const float* __restrict__ c_ctx,
                                       const float* __restrict__ w_mod, const float* __restrict__ b_mod, float* __restrict__ mod) {
    float* sl = (float*)smem;
    const int li = vb / 96, kc = (vb % 96) / 6, cg6 = vb % 6;
    const int tid = threadIdx.x;
    for (int i = tid; i < 5 * 64; i += 256) {
        const int r = i >> 6, k = kc * 64 + (i & 63);
        const float v = (r == 0) ? c_ctx[k] : c[(r - 1) * 1024 + k];
        sl[i] = v / (1.f + __expf(-v));
    }
    __syncthreads();
    const int n = cg6 * 1024 + tid * 4;
    float4 a0 = {0, 0, 0, 0}, a1 = a0, a2 = a0, a3 = a0, a4 = a0;
    const float* w = w_mod + ((size_t)li * 1024 + kc * 64) * 6144 + n;
#pragma unroll 16
    for (int k = 0; k < 64; k++) {
        const float4 wv = *(const float4*)(w + (size_t)k * 6144);
        const float s0 = sl[k], s1 = sl[64 + k], s2 = sl[128 + k], s3 = sl[192 + k], s4 = sl[256 + k];
        a0.x += s0 * wv.x; a0.y += s0 * wv.y; a0.z += s0 * wv.z; a0.w += s0 * wv.w;
        a1.x += s1 * wv.x; a1.y += s1 * wv.y; a1.z += s1 * wv.z; a1.w += s1 * wv.w;
        a2.x += s2 * wv.x; a2.y += s2 * wv.y; a2.z += s2 * wv.z; a2.w += s2 * wv.w;
        a3.x += s3 * wv.x; a3.y += s3 * wv.y; a3.z += s3 * wv.z; a3.w += s3 * wv.w;
        a4.x += s4 * wv.x; a4.y += s4 * wv.y; a4.z += s4 * wv.z; a4.w += s4 * wv.w;
    }
    if (kc == 0) {
        const float4 bb = *(const float4*)(b_mod + li * 6144 + n);
        a0.x += bb.x; a0.y += bb.y; a0.z += bb.z; a0.w += bb.w; a1.x += bb.x; a1.y += bb.y; a1.z += bb.z; a1.w += bb.w;
        a2.x += bb.x; a2.y += bb.y; a2.z += bb.z; a2.w += bb.w; a3.x += bb.x; a3.y += bb.y; a3.z += bb.z; a3.w += bb.w;
        a4.x += bb.x; a4.y += bb.y; a4.z += bb.z; a4.w += bb.w;
    }
    float* o = mod + (size_t)(li * 5) * 6144 + n;
    atomicAdd(o + 0, a0.x); atomicAdd(o + 1, a0.y); atomicAdd(o + 2, a0.z); atomicAdd(o + 3, a0.w);
    atomicAdd(o + 6144 + 0, a1.x); atomicAdd(o + 6144 + 1, a1.y); atomicAdd(o + 6144 + 2, a1.z); atomicAdd(o + 6144 + 3, a1.w);
    atomicAdd(o + 2 * 6144 + 0, a2.x); atomicAdd(o + 2 * 6144 + 1, a2.y); atomicAdd(o + 2 * 6144 + 2, a2.z); atomicAdd(o + 2 * 6144 + 3, a2.w);
    atomicAdd(o + 3 * 6144 + 0, a3.x); atomicAdd(o + 3 * 6144 + 1, a3.y); atomicAdd(o + 3 * 6144 + 2, a3.z); atomicAdd(o + 3 * 6144 + 3, a3.w);
    atomicAdd(o + 4 * 6144 + 0, a4.x); atomicAdd(o + 4 * 6144 + 1, a4.y); atomicAdd(o + 4 * 6144 + 2, a4.z); atomicAdd(o + 4 * 6144 + 3, a4.w);
}


struct EpiStore { static constexpr bool kQuad = false; float* C; const float* bias; int ldc; int pad;
    __device__ void operator()(int m, int n, float a) const { C[(size_t)m * ldc + n] = a + (bias ? bias[n] : 0.f); } };
struct EpiStoreBfBias { static constexpr bool kQuad = false; bf16_t* C; const float* bias; int ldc; int pad;
    __device__ void operator()(int m, int n, float a) const { C[(size_t)m * ldc + n] = f2bf(a + bias[n]); } };
struct EpiStoreBf { static constexpr bool kQuad = false; bf16_t* C; int ldc; int pad;
    __device__ void operator()(int m, int n, float a) const { C[(size_t)m * ldc + n] = f2bf(a); } };
struct EpiDecay { static constexpr bool kQuad = false; _Float16* out; const float* w0;
    __device__ void operator()(int m, int n, float a) const { out[(size_t)m * 512 + n] = (_Float16)sigmoidf_(w0[n] + a); } };
struct EpiProj { static constexpr bool kQuad = false; bf16_t* rw; float* mla;
    __device__ void operator()(int m, int n, float a) const { if (n < RWIN) rw[(size_t)m * RWIN + n] = f2bf(a); else mla[(size_t)m * 448 + (n - RWIN)] = a; } };
struct EpiLr { static constexpr bool kQuad = false; bf16_t* out; const float* a0;
    __device__ void operator()(int m, int n, float a) const { out[(size_t)m * 512 + n] = f2bf(sigmoidf_(a0[n] + a)); } };
struct EpiResid { static constexpr bool kQuad = false; const float* xa; const float* xb; float* out; const float* modl; int gate_idx; int pad;
    __device__ void operator()(int m, int n, float a) const {
        float x = (m < TP) ? xa[(size_t)m * DM + n] : xb[(size_t)(m - TP) * DM + n];
        float gt = modl[(size_t)tok_modrow(m) * 6144 + gate_idx * 1024 + n];
        out[(size_t)m * DM + n] = x + gt * a; } };

struct EpiKV { static constexpr bool kQuad = true;
    bf16_t* kvraw; bf16_t* Vp; bf16_t* Vs; int ctx; int pad;
    __device__ void operator()(int m, int n, float a) const {}
    __device__ void quad(int row0, int col, float v0, float v1, float v2, float v3) const {
        const int hd = col >> 8, within = col & 255;
        if (within < 128) {
            bf16_t* d = kvraw + (size_t)row0 * 1024 + col;
            d[0] = f2bf(v0); d[1024] = f2bf(v1); d[2048] = f2bf(v2); d[3072] = f2bf(v3);
        } else {
            const int dv = within - 128;
            int b, kidx, Lk; bf16_t* base;
            if (ctx) { b = row0 >> 8; kidx = row0 & 255; Lk = 2304; base = Vs; }
            else if (row0 < TP) { b = row0 >> 8; kidx = row0 & 255; Lk = LP; base = Vp; }
            else { b = (row0 - TP) >> 11; kidx = 256 + ((row0 - TP) & 2047); Lk = 2304; base = Vs; }
            const int kpos = (kidx & ~12) | ((kidx & 8) >> 1) | ((kidx & 4) << 1);
            ushort4 o; o.x = f2bf(v0); o.y = f2bf(v1); o.z = f2bf(v2); o.w = f2bf(v3);
            *(ushort4*)(base + ((size_t)((b * 4 + hd) * 128 + dv)) * Lk + kpos) = o;
        }
    } };


typedef __attribute__((ext_vector_type(8))) short bf16x8;
typedef __attribute__((ext_vector_type(16))) float f32x16;
typedef __attribute__((ext_vector_type(4))) float f32x4;
typedef __attribute__((ext_vector_type(4))) unsigned u32x4;
#define GEMM_LDS_BYTES 73728

template <int NJ, class Epi>
__device__ __forceinline__ void d_gemm_bf16n(const int bx, const int by, char* smem, const bf16_t* __restrict__ A, int lda,
                                             const bf16_t* __restrict__ Bt, int ldb, int K, int N, Epi epi) {
    const int tid = threadIdx.x, lane = tid & 63, wid = tid >> 6;
    const int wm = wid >> 1, wn = wid & 1;
    const int m0 = by * 128, n0 = bx * (64 * NJ);
    f32x16 acc[2][NJ];
#pragma unroll
    for (int i = 0; i < 2; i++)
#pragma unroll
        for (int j = 0; j < NJ; j++)
#pragma unroll
            for (int r = 0; r < 16; r++) acc[i][j][r] = 0.f;
    const int lrow = tid >> 3, lcol = (tid & 7) * 8;
    const bf16_t* ga = A + (size_t)(m0 + lrow) * lda + lcol;
    const bf16_t* gb = Bt + (size_t)(n0 + lrow) * ldb + lcol;
    u32x4 raA[4], rbA[2 * NJ], raB[4], rbB[2 * NJ];
    const int KT = K >> 6;
    const int frow = lane & 31, fk = (lane >> 5) * 16;
#define GM_LOAD(RA_, RB_, kt_)                                                                                              \
    {                                                                                                                       \
        _Pragma("unroll") for (int i = 0; i < 4; i++) RA_[i] = *(const u32x4*)(ga + (size_t)(32 * i) * lda + (kt_) * 64);   \
        _Pragma("unroll") for (int i = 0; i < 2 * NJ; i++) RB_[i] = *(const u32x4*)(gb + (size_t)(32 * i) * ldb + (kt_) * 64); \
    }
#define GM_STORE(RA_, RB_, st_)                                                                                             \
    {                                                                                                                       \
        char* sn_ = smem + (st_) * 36864;                                                                                   \
        _Pragma("unroll") for (int i = 0; i < 4; i++) *(u32x4*)(sn_ + (lrow + 32 * i) * 144 + lcol * 2) = RA_[i];           \
        _Pragma("unroll") for (int i = 0; i < 2 * NJ; i++) *(u32x4*)(sn_ + 18432 + (lrow + 32 * i) * 144 + lcol * 2) = RB_[i]; \
    }
#define GM_COMPUTE(st_)                                                                                                     \
    {                                                                                                                       \
        const char* sa_ = smem + (st_) * 36864;                                                                             \
        const char* sb_ = sa_ + 18432;                                                                                      \
        _Pragma("unroll") for (int ks = 0; ks < 4; ks++) {                                                                  \
            bf16x8 af[2], bfr[NJ];                                                                                          \
            _Pragma("unroll") for (int i = 0; i < 2; i++) af[i] = *(const bf16x8*)(sa_ + (wm * 64 + i * 32 + frow) * 144 + ks * 32 + fk); \
            _Pragma("unroll") for (int j = 0; j < NJ; j++) bfr[j] = *(const bf16x8*)(sb_ + (wn * (32 * NJ) + j * 32 + frow) * 144 + ks * 32 + fk); \
            _Pragma("unroll") for (int i = 0; i < 2; i++)                                                                   \
                _Pragma("unroll") for (int j = 0; j < NJ; j++) acc[i][j] = __builtin_amdgcn_mfma_f32_32x32x16_bf16(af[i], bfr[j], acc[i][j], 0, 0, 0); \
        }                                                                                                                   \
    }
    GM_LOAD(raA, rbA, 0)
    GM_STORE(raA, rbA, 0)
    if (KT > 1) GM_LOAD(raA, rbA, 1)
    __syncthreads();
    for (int kt = 0; kt < KT; kt += 2) {
        if (kt + 2 < KT) GM_LOAD(raB, rbB, kt + 2)
        GM_COMPUTE(0)
        if (kt + 1 < KT) GM_STORE(raA, rbA, 1)
        __syncthreads();
        if (kt + 1 < KT) {
            if (kt + 3 < KT) GM_LOAD(raA, rbA, kt + 3)
            GM_COMPUTE(1)
            if (kt + 2 < KT) GM_STORE(raB, rbB, 0)
            __syncthreads();
        }
    }
#pragma unroll
    for (int i = 0; i < 2; i++)
#pragma unroll
        for (int j = 0; j < NJ; j++) {
            const int col = n0 + wn * (32 * NJ) + j * 32 + (lane & 31);
            if (col < N) {
                if constexpr (Epi::kQuad) {
#pragma unroll
                    for (int g = 0; g < 4; g++) {
                        const int row0 = m0 + wm * 64 + i * 32 + 8 * g + 4 * (lane >> 5);
                        epi.quad(row0, col, acc[i][j][4 * g], acc[i][j][4 * g + 1], acc[i][j][4 * g + 2], acc[i][j][4 * g + 3]);
                    }
                } else {
#pragma unroll
                    for (int r = 0; r < 16; r++) {
                        const int row = m0 + wm * 64 + i * 32 + (r & 3) + 8 * (r >> 2) + 4 * (lane >> 5);
                        epi(row, col, acc[i][j][r]);
                    }
                }
            }
        }
}
template <class Epi>
__device__ __forceinline__ void d_gemm_bf16(const int bx, const int by, char* smem, const bf16_t* __restrict__ A, int lda,
                                            const bf16_t* __restrict__ Bt, int ldb, int K, int N, Epi epi) {
    d_gemm_bf16n<2, Epi>(bx, by, smem, A, lda, Bt, ldb, K, N, epi);
}
__device__ __forceinline__ void d_transpose_w(const int vb, char* smem, const float* __restrict__ W, int K, int N, bf16_t* __restrict__ Wt) {
    float (*tile)[65] = (float(*)[65])smem;
    const int kt = K >> 6;
    const int nb = vb / kt, kb = vb % kt;
    const int tid = threadIdx.x;
    {
        const int n = nb * 64 + (tid & 63);
#pragma unroll
        for (int i = 0; i < 16; i++) {
            int k = (tid >> 6) + 4 * i;
            tile[k][tid & 63] = (n < N) ? W[(size_t)(kb * 64 + k) * N + n] : 0.f;
        }
    }
    __syncthreads();
    {
        const int k = tid & 63;
#pragma unroll
        for (int i = 0; i < 16; i++) {
            int n = (tid >> 6) + 4 * i;
            Wt[(size_t)(nb * 64 + n) * K + kb * 64 + k] = f2bf(tile[k][n]);
        }
    }
}


template <int CTRL>
__device__ __forceinline__ float dpp_add(float v) {
    return v + __int_as_float(__builtin_amdgcn_update_dpp(0, __float_as_int(v), CTRL, 0xf, 0xf, false));
}
__device__ __forceinline__ float row16_allsum(float v) {
    v = dpp_add<0x128>(v); v = dpp_add<0x124>(v); v = dpp_add<0x122>(v); v = dpp_add<0x121>(v);
    return v;
}

typedef __bf16 bf16x2_t __attribute__((ext_vector_type(2)));
typedef float f32x2v __attribute__((ext_vector_type(2)));
__device__ __forceinline__ unsigned pk_bf2(float a, float b) { f32x2v v = {a, b}; return __builtin_bit_cast(unsigned, __builtin_convertvector(v, bf16x2_t)); }
__device__ __forceinline__ bf16x8 pk_bf8(float a0, float a1, float a2, float a3, float a4, float a5, float a6, float a7) {
    u32x4 u = {pk_bf2(a0, a1), pk_bf2(a2, a3), pk_bf2(a4, a5), pk_bf2(a6, a7)};
    return __builtin_bit_cast(bf16x8, u);
}
#define S3_SLOT 16384
#define S3_A1   0
#define S3_HD   4608
#define S3_A2F  9728
#define S3_ATF  10752
#define S3_ACF  11776
#define S3_VT   12800
#define S3_GC   14848
#define S3_AAB  15104
__device__ __forceinline__ void d_scan3(const int chain, const bool sample, char* smem, const bf16_t* __restrict__ rb, const bf16_t* __restrict__ kb,
                                        const bf16_t* __restrict__ vb, const bf16_t* __restrict__ kkb, const bf16_t* __restrict__ lr0,
                                        const bf16_t* __restrict__ lr1, const _Float16* __restrict__ du0, const _Float16* __restrict__ du1,
                                        const float* __restrict__ k_a, const float* __restrict__ st_f, const float* __restrict__ st_b,
                                        float* __restrict__ y0, float* __restrict__ y1, float* __restrict__ out_sf, float* __restrict__ out_sb) {
    const int d = chain & 1, h = (chain >> 1) & 7, b = chain >> 4;
    const int L = sample ? LS : LP;
    const int tbase = sample ? (TP + b * LS) : (b * LP);
    const int tid = threadIdx.x, wid = tid >> 6, lane = tid & 63;
    const int n = lane & 31, hh = lane >> 5;
    const bf16_t* lr = d ? lr1 : lr0;
    const unsigned short* du = (const unsigned short*)(d ? du1 : du0);
    float* yo = d ? y1 : y0;
    const float ka = k_a[h * 64 + lane];
    const int row = 32 * (wid & 1) + n;
    const int sw = (lane & ~12) | ((lane & 8) >> 1) | ((lane & 4) << 1);
    f32x16 St0, St1;
    if (sample) {
        const float* s0 = (d ? st_b : st_f) + ((size_t)(b * 8 + h) * 64 + row) * 64 + 4 * hh;
#pragma unroll
        for (int q = 0; q < 4; q++) {
            const float4 x0 = *(const float4*)(s0 + 8 * q), x1 = *(const float4*)(s0 + 32 + 8 * q);
            St0[4 * q] = x0.x; St0[4 * q + 1] = x0.y; St0[4 * q + 2] = x0.z; St0[4 * q + 3] = x0.w;
            St1[4 * q] = x1.x; St1[4 * q + 1] = x1.y; St1[4 * q + 2] = x1.z; St1[4 * q + 3] = x1.w;
        }
    } else {
#pragma unroll
        for (int r = 0; r < 16; r++) { St0[r] = 0.f; St1[r] = 0.f; }
    }
    char* slot = smem + wid * S3_SLOT;
    const int ngrp = L >> 6;
    const ptrdiff_t dstep = d ? -512 : 512;
    for (int g = 0; g < ngrp; g++) {
        {
            const int i0 = (g * 4 + wid) * 16;
            const size_t o0 = (size_t)(tbase + (d ? (L - 1 - i0) : i0)) * 512 + h * 64 + lane;
            const bf16_t* pkk = kkb + o0; const bf16_t* plr = lr + o0; const bf16_t* pk = kb + o0; const bf16_t* pr = rb + o0;
            const unsigned short* pu = du + o0; const bf16_t* pv = vb + o0;
            unsigned d1p[16], vtp[8];
            float cs = 0.f, G = 1.f;
#pragma unroll
            for (int jh = 0; jh < 2; jh++) {
                unsigned rkk[8], rlr[8], rk[8], rr[8], ru[8], rv[8];
#pragma unroll
                for (int j8 = 0; j8 < 8; j8++) {
                    const int j = jh * 8 + j8;
                    rkk[j8] = pkk[j * dstep]; rlr[j8] = plr[j * dstep]; rk[j8] = pk[j * dstep]; rr[j8] = pr[j * dstep]; ru[j8] = pu[j * dstep]; rv[j8] = pv[j * dstep];
                }
                float bprev = 0.f, kprev = 0.f;
#pragma unroll
                for (int j8 = 0; j8 < 8; j8++) {
                    const int j = jh * 8 + j8;
                    const float kkv = __uint_as_float(rkk[j8] << 16), lrv = __uint_as_float(rlr[j8] << 16), kv = __uint_as_float(rk[j8] << 16), rv_ = __uint_as_float(rr[j8] << 16);
                    const float uv = (float)__builtin_bit_cast(_Float16, (unsigned short)ru[j8]);
                    const float Gm = G;
                    cs += uv;
                    G = __expf(-0.6065306597126334f * cs);
                    const float Gi = __builtin_amdgcn_rcpf(G);
                    const float at = -kkv * Gm, rt = rv_ * G;
                    const float bh = kkv * lrv * Gi;
                    const float kh = kv * (1.f + (lrv - 1.f) * ka) * Gi;
                    const unsigned p0 = pk_bf2(at, rt), p1 = pk_bf2(bh, kh);
                    *(unsigned short*)(slot + S3_A1 + j * 144 + sw * 2) = (unsigned short)p0;
                    *(unsigned short*)(slot + S3_A1 + (16 + j) * 144 + sw * 2) = (unsigned short)(p0 >> 16);
                    *(unsigned short*)(slot + S3_HD + j * 144 + sw * 2) = (unsigned short)p1;
                    *(unsigned short*)(slot + S3_HD + (16 + j) * 144 + sw * 2) = (unsigned short)(p1 >> 16);
                    if (j8 & 1) {
                        const int pj = ((j - 1) & ~12) | (((j - 1) & 8) >> 1) | (((j - 1) & 4) << 1);
                        d1p[pj >> 1] = pk_bf2(bprev, bh);
                        d1p[8 + (pj >> 1)] = pk_bf2(kprev, kh);
                        vtp[pj >> 1] = rv[j8 - 1] | (rv[j8] << 16);
                    }
                    bprev = bh; kprev = kh;
                }
            }
            ((float*)(slot + S3_GC))[lane] = G;
            {
                u32x4 v0 = {vtp[0], vtp[1], vtp[2], vtp[3]};
                u32x4 v1 = {vtp[4], vtp[5], vtp[6], vtp[7]};
                *(u32x4*)(slot + S3_VT + lane * 32) = v0;
                *(u32x4*)(slot + S3_VT + lane * 32 + 16) = v1;
            }
            f32x16 D;
#pragma unroll
            for (int r = 0; r < 16; r++) D[r] = 0.f;
#pragma unroll
            for (int s = 0; s < 4; s++) {
                const bf16x8 af = *(const bf16x8*)(slot + S3_HD + n * 144 + s * 32 + hh * 16);
                const bf16x8 bf = *(const bf16x8*)(slot + S3_A1 + n * 144 + s * 32 + hh * 16);
                D = __builtin_amdgcn_mfma_f32_32x32x16_bf16(af, bf, D, 0, 0, 0);
            }
            const int t = n & 15;
            const bool strict = n < 16;
            const int lim = strict ? t : t + 1;
            float a2[8], ac[8];
#pragma unroll
            for (int r = 0; r < 8; r++) {
                const int j = (r & 3) + 8 * (r >> 2) + 4 * hh;
                const bool keep = j < lim;
                a2[r] = keep ? D[8 + r] : 0.f;
                const float lo = keep ? D[r] : 0.f;
                ac[r] = strict ? 0.f : lo;
                if (strict) ((float*)(slot + S3_AAB))[j * 20 + t] = lo;
            }
            *(bf16x8*)(slot + S3_A2F + lane * 16) = pk_bf8(a2[0], a2[1], a2[2], a2[3], a2[4], a2[5], a2[6], a2[7]);
            *(bf16x8*)(slot + S3_ACF + lane * 16) = pk_bf8(ac[0], ac[1], ac[2], ac[3], ac[4], ac[5], ac[6], ac[7]);
            {
                u32x4 q0 = {d1p[0], d1p[1], d1p[2], d1p[3]}, q1 = {d1p[4], d1p[5], d1p[6], d1p[7]};
                u32x4 q2 = {d1p[8], d1p[9], d1p[10], d1p[11]}, q3 = {d1p[12], d1p[13], d1p[14], d1p[15]};
                *(u32x4*)(slot + S3_HD + lane * 80) = q0;
                *(u32x4*)(slot + S3_HD + lane * 80 + 16) = q1;
                *(u32x4*)(slot + S3_HD + lane * 80 + 32) = q2;
                *(u32x4*)(slot + S3_HD + lane * 80 + 48) = q3;
            }
            float x[16];
#pragma unroll
            for (int i = 15; i >= 0; i--) {
                float s = (i == t) ? 1.f : 0.f;
#pragma unroll
                for (int q = (i + 1) >> 2; q < 4; q++) {
                    const float4 a4 = *(const float4*)(slot + S3_AAB + (i * 20 + 4 * q) * 4);
                    if (4 * q + 0 > i) s += a4.x * x[4 * q + 0];
                    if (4 * q + 1 > i) s += a4.y * x[4 * q + 1];
                    if (4 * q + 2 > i) s += a4.z * x[4 * q + 2];
                    if (4 * q + 3 > i) s += a4.w * x[4 * q + 3];
                }
                x[i] = s;
            }
            {
                const float e0 = hh ? x[4] : x[0], e1 = hh ? x[5] : x[1], e2 = hh ? x[6] : x[2], e3 = hh ? x[7] : x[3];
                const float e4 = hh ? x[12] : x[8], e5 = hh ? x[13] : x[9], e6 = hh ? x[14] : x[10], e7 = hh ? x[15] : x[11];
                bf16x8 tf = pk_bf8(e0, e1, e2, e3, e4, e5, e6, e7);
                if (!strict) { tf = (bf16x8){0, 0, 0, 0, 0, 0, 0, 0}; }
                *(bf16x8*)(slot + S3_ATF + lane * 16) = tf;
            }
        }
        __syncthreads();
        if (wid < 2) {
#pragma unroll 1
            for (int q = 0; q < 4; q++) {
                const char* sl = smem + q * S3_SLOT;
                const bf16x8 sb0 = pk_bf8(St0[0], St0[1], St0[2], St0[3], St0[4], St0[5], St0[6], St0[7]);
                const bf16x8 sb1 = pk_bf8(St0[8], St0[9], St0[10], St0[11], St0[12], St0[13], St0[14], St0[15]);
                const bf16x8 sb2 = pk_bf8(St1[0], St1[1], St1[2], St1[3], St1[4], St1[5], St1[6], St1[7]);
                const bf16x8 sb3 = pk_bf8(St1[8], St1[9], St1[10], St1[11], St1[12], St1[13], St1[14], St1[15]);
                f32x16 acc1;
#pragma unroll
                for (int r = 0; r < 16; r++) acc1[r] = 0.f;
                acc1 = __builtin_amdgcn_mfma_f32_32x32x16_bf16(*(const bf16x8*)(sl + S3_A1 + n * 144 + 0 + hh * 16), sb0, acc1, 0, 0, 0);
                acc1 = __builtin_amdgcn_mfma_f32_32x32x16_bf16(*(const bf16x8*)(sl + S3_A1 + n * 144 + 32 + hh * 16), sb1, acc1, 0, 0, 0);
                acc1 = __builtin_amdgcn_mfma_f32_32x32x16_bf16(*(const bf16x8*)(sl + S3_A1 + n * 144 + 64 + hh * 16), sb2, acc1, 0, 0, 0);
                acc1 = __builtin_amdgcn_mfma_f32_32x32x16_bf16(*(const bf16x8*)(sl + S3_A1 + n * 144 + 96 + hh * 16), sb3, acc1, 0, 0, 0);
                const bf16x8 vt = *(const bf16x8*)(sl + S3_VT + row * 32 + hh * 16);
                acc1 = __builtin_amdgcn_mfma_f32_32x32x16_bf16(*(const bf16x8*)(sl + S3_A2F + lane * 16), vt, acc1, 0, 0, 0);
                const bf16x8 pf = pk_bf8(acc1[0], acc1[1], acc1[2], acc1[3], acc1[4], acc1[5], acc1[6], acc1[7]);
                f32x16 acc2;
#pragma unroll
                for (int r = 0; r < 16; r++) acc2[r] = 0.f;
                acc2 = __builtin_amdgcn_mfma_f32_32x32x16_bf16(*(const bf16x8*)(sl + S3_ATF + lane * 16), pf, acc2, 0, 0, 0);
                const bf16x8 uf = pk_bf8(acc2[0], acc2[1], acc2[2], acc2[3], acc2[4], acc2[5], acc2[6], acc2[7]);
                acc1 = __builtin_amdgcn_mfma_f32_32x32x16_bf16(*(const bf16x8*)(sl + S3_ACF + lane * 16), uf, acc1, 0, 0, 0);
                St0 = __builtin_amdgcn_mfma_f32_32x32x16_bf16(*(const bf16x8*)(sl + S3_HD + n * 80 + hh * 16), uf, St0, 0, 0, 0);
                St1 = __builtin_amdgcn_mfma_f32_32x32x16_bf16(*(const bf16x8*)(sl + S3_HD + (32 + n) * 80 + hh * 16), uf, St1, 0, 0, 0);
                St0 = __builtin_amdgcn_mfma_f32_32x32x16_bf16(*(const bf16x8*)(sl + S3_HD + n * 80 + 32 + hh * 16), vt, St0, 0, 0, 0);
                St1 = __builtin_amdgcn_mfma_f32_32x32x16_bf16(*(const bf16x8*)(sl + S3_HD + (32 + n) * 80 + 32 + hh * 16), vt, St1, 0, 0, 0);
                {
                    const int i0 = (g * 4 + q) * 16;
                    float* yb = yo + (size_t)(tbase + (d ? (L - 1 - i0) : i0)) * 512 + h * 64 + row;
#pragma unroll
                    for (int r = 0; r < 8; r++) {
                        const int tt = (r & 3) + 8 * (r >> 2) + 4 * hh;
                        yb[tt * dstep] = acc1[8 + r];
                    }
                }
                const float* gc = (const float*)(sl + S3_GC) + 4 * hh;
#pragma unroll
                for (int c4 = 0; c4 < 4; c4++) {
                    const float4 g0 = *(const float4*)(gc + 8 * c4), g1 = *(const float4*)(gc + 32 + 8 * c4);
                    St0[4 * c4] *= g0.x; St0[4 * c4 + 1] *= g0.y; St0[4 * c4 + 2] *= g0.z; St0[4 * c4 + 3] *= g0.w;
                    St1[4 * c4] *= g1.x; St1[4 * c4 + 1] *= g1.y; St1[4 * c4 + 2] *= g1.z; St1[4 * c4 + 3] *= g1.w;
                }
            }
        }
        __syncthreads();
    }
    if (!sample && wid < 2) {
        float* os = (d ? out_sb : out_sf) + ((size_t)(b * 8 + h) * 64 + row) * 64 + 4 * hh;
#pragma unroll
        for (int q = 0; q < 4; q++) {
            *(float4*)(os + 8 * q) = make_float4(St0[4 * q], St0[4 * q + 1], St0[4 * q + 2], St0[4 * q + 3]);
            *(float4*)(os + 32 + 8 * q) = make_float4(St1[4 * q], St1[4 * q + 1], St1[4 * q + 2], St1[4 * q + 3]);
        }
    }
}


#define ATT_SV_OFF 25600
#define ATT_SQ_OFF 44032
__device__ __forceinline__ void d_attn_mfma(const int item, char* smem, const bf16_t* __restrict__ Qb, const bf16_t* __restrict__ Kall,
                                            const bf16_t* __restrict__ VtAll, bf16_t* __restrict__ cat, int tbase, int Lq, int Lk, int nqb) {
    const int qb = item % nqb, bh = item / nqb;
    const int b = bh >> 2, h = bh & 3;
    const int tid = threadIdx.x, lane = tid & 63, wid = tid >> 6;
    const int q = lane & 31, hh = lane >> 5;
    const int t = tbase + b * Lq + qb * 128 + wid * 32 + q;
    bf16x8 qf[12];
    {
        const bf16_t* qp = Qb + ((size_t)t * 4 + h) * 192 + hh * 8;
#pragma unroll
        for (int ks = 0; ks < 12; ks++) qf[ks] = *(const bf16x8*)(qp + ks * 16);
    }
    f32x16 o[4];
#pragma unroll
    for (int i = 0; i < 4; i++)
#pragma unroll
        for (int r = 0; r < 16; r++) o[i][r] = 0.f;
    float m = -1e30f, l = 0.f;
    const bf16_t* K = Kall + (size_t)bh * Lk * 192;
    const bf16_t* Vt = VtAll + (size_t)bh * 128 * Lk;
    char* sK = smem;
    char* sV = smem + ATT_SV_OFF;
    u32x4 pk[6], pv[4];
    const int nkt = Lk >> 6;
#pragma unroll
    for (int i = 0; i < 6; i++) pk[i] = *(const u32x4*)(K + (size_t)(tid + 256 * i) * 8);
#pragma unroll
    for (int i = 0; i < 4; i++) { int c = tid + 256 * i; pv[i] = *(const u32x4*)(Vt + (size_t)(c >> 3) * Lk + (c & 7) * 8); }
#pragma unroll
    for (int i = 0; i < 6; i++) { int c = tid + 256 * i; *(u32x4*)(sK + (c / 24) * 400 + (c % 24) * 16) = pk[i]; }
#pragma unroll
    for (int i = 0; i < 4; i++) { int c = tid + 256 * i; *(u32x4*)(sV + (c >> 3) * 144 + (c & 7) * 16) = pv[i]; }
    __syncthreads();
    const float sc2 = 0.07216878364870322f * 1.4426950408889634f;
    for (int kt = 0; kt < nkt; kt++) {
        f32x16 st[2];
#pragma unroll
        for (int bk = 0; bk < 2; bk++)
#pragma unroll
            for (int r = 0; r < 16; r++) st[bk][r] = 0.f;
#pragma unroll
        for (int ks = 0; ks < 12; ks++) {
            const bf16x8 qfk = qf[ks];
#pragma unroll
            for (int bk = 0; bk < 2; bk++) {
                bf16x8 a = *(const bf16x8*)(sK + (bk * 32 + q) * 400 + ks * 32 + hh * 16);
                st[bk] = __builtin_amdgcn_mfma_f32_32x32x16_bf16(a, qfk, st[bk], 0, 0, 0);
            }
        }
        float mx = -1e30f;
#pragma unroll
        for (int bk = 0; bk < 2; bk++)
#pragma unroll
            for (int r = 0; r < 16; r++) { st[bk][r] *= sc2; mx = fmaxf(mx, st[bk][r]); }
        mx = fmaxf(mx, __shfl_xor(mx, 32, 64));
        const float mn = fmaxf(m, mx);
        const float alpha = exp2f(m - mn);
        float ps = 0.f;
#pragma unroll
        for (int bk = 0; bk < 2; bk++)
#pragma unroll
            for (int r = 0; r < 16; r++) { st[bk][r] = exp2f(st[bk][r] - mn); ps += st[bk][r]; }
        ps += __shfl_xor(ps, 32, 64);
        l = l * alpha + ps; m = mn;
#pragma unroll
        for (int i = 0; i < 4; i++)
#pragma unroll
            for (int r = 0; r < 16; r++) o[i][r] *= alpha;
#pragma unroll
        for (int s4 = 0; s4 < 4; s4++) {
            bf16x8 pb;
#pragma unroll
            for (int j = 0; j < 8; j++) pb[j] = (short)f2bf(st[s4 >> 1][8 * (s4 & 1) + j]);
#pragma unroll
            for (int i = 0; i < 4; i++) {
                bf16x8 a = *(const bf16x8*)(sV + (i * 32 + q) * 144 + s4 * 32 + hh * 16);
                o[i] = __builtin_amdgcn_mfma_f32_32x32x16_bf16(a, pb, o[i], 0, 0, 0);
            }
        }
        __syncthreads();
        if (kt + 1 < nkt) {
            const bf16_t* Kn = K + (size_t)(kt + 1) * 64 * 192;
            const bf16_t* Vn = Vt + (kt + 1) * 64;
#pragma unroll
            for (int i = 0; i < 6; i++) pk[i] = *(const u32x4*)(Kn + (size_t)(tid + 256 * i) * 8);
#pragma unroll
            for (int i = 0; i < 4; i++) { int c = tid + 256 * i; pv[i] = *(const u32x4*)(Vn + (size_t)(c >> 3) * Lk + (c & 7) * 8); }
#pragma unroll
            for (int i = 0; i < 6; i++) { int c = tid + 256 * i; *(u32x4*)(sK + (c / 24) * 400 + (c % 24) * 16) = pk[i]; }
#pragma unroll
            for (int i = 0; i < 4; i++) { int c = tid + 256 * i; *(u32x4*)(sV + (c >> 3) * 144 + (c & 7) * 16) = pv[i]; }
        }
        __syncthreads();
    }
    const float il = 1.f / l;
    bf16_t* op = cat + (size_t)t * DM + 512 + h * 128;
#pragma unroll
    for (int i = 0; i < 4; i++)
#pragma unroll
        for (int g = 0; g < 4; g++) {
            ushort4 w;
            w.x = f2bf(o[i][4 * g + 0] * il); w.y = f2bf(o[i][4 * g + 1] * il); w.z = f2bf(o[i][4 * g + 2] * il); w.w = f2bf(o[i][4 * g + 3] * il);
            *(ushort4*)(op + i * 32 + 8 * g + 4 * hh) = w;
        }
}


template <int K, int J>
__device__ __forceinline__ void bit_stage16(float (&x)[16]) {
#pragma unroll
    for (int i = 0; i < 16; i++) {
        const int l = i ^ J;
        if (l > i) {
            const bool desc = ((i & K) == 0);
            const float a = x[i], b = x[l];
            const float hi = fmaxf(a, b), lo = fminf(a, b);
            x[i] = desc ? hi : lo; x[l] = desc ? lo : hi;
        }
    }
}
__device__ __forceinline__ void bit_sort16_desc(float (&x)[16]) {
    bit_stage16<2, 1>(x);
    bit_stage16<4, 2>(x); bit_stage16<4, 1>(x);
    bit_stage16<8, 4>(x); bit_stage16<8, 2>(x); bit_stage16<8, 1>(x);
    bit_stage16<16, 8>(x); bit_stage16<16, 4>(x); bit_stage16<16, 2>(x); bit_stage16<16, 1>(x);
}
__device__ __forceinline__ void bit_merge16_desc(float (&x)[16]) {
    bit_stage16<16, 8>(x); bit_stage16<16, 4>(x); bit_stage16<16, 2>(x); bit_stage16<16, 1>(x);
}
template <int K, int J>
__device__ __forceinline__ void bit_stage16u(unsigned (&x)[16]) {
#pragma unroll
    for (int i = 0; i < 16; i++) {
        const int l = i ^ J;
        if (l > i) {
            const bool asc = ((i & K) == 0);
            const unsigned a = x[i], b = x[l];
            const unsigned lo = a < b ? a : b, hi = a < b ? b : a;
            x[i] = asc ? lo : hi; x[l] = asc ? hi : lo;
        }
    }
}
__device__ __forceinline__ void bit_sort16u_asc(unsigned (&x)[16]) {
    bit_stage16u<2, 1>(x);
    bit_stage16u<4, 2>(x); bit_stage16u<4, 1>(x);
    bit_stage16u<8, 4>(x); bit_stage16u<8, 2>(x); bit_stage16u<8, 1>(x);
    bit_stage16u<16, 8>(x); bit_stage16u<16, 4>(x); bit_stage16u<16, 2>(x); bit_stage16u<16, 1>(x);
}
__device__ __forceinline__ void bit_merge16u_asc(unsigned (&x)[16]) {
    bit_stage16u<16, 8>(x); bit_stage16u<16, 4>(x); bit_stage16u<16, 2>(x); bit_stage16u<16, 1>(x);
}
__device__ __forceinline__ void top16_merge(float (&L)[16], const float (&C)[16]) {
#pragma unroll
    for (int i = 0; i < 16; i++) L[i] = fmaxf(L[i], C[15 - i]);
    bit_merge16_desc(L);
}
__device__ __forceinline__ void low16_merge_u(unsigned (&L)[16], const unsigned (&C)[16]) {
#pragma unroll
    for (int i = 0; i < 16; i++) { const unsigned c = C[15 - i]; L[i] = L[i] < c ? L[i] : c; }
    bit_merge16u_asc(L);
}
__device__ __forceinline__ float key_val(float k) { return __uint_as_float(__float_as_uint(k) & ~127u); }
__device__ __forceinline__ int key_idx(float k) { return (int)(__float_as_uint(k) & 127u); }

struct EpiLds { static constexpr bool kQuad = false; float* lds; int c0; int pad;
    __device__ void operator()(int m, int n, float a) const { lds[m * 128 + (n - c0)] = a; } };

__device__ __forceinline__ void top16_col(const float* __restrict__ col, float (&L)[16]) {
#pragma unroll
    for (int ch = 0; ch < 8; ch++) {
        float C[16];
#pragma unroll
        for (int i = 0; i < 16; i++) {
            const int n = ch * 16 + i;
            C[i] = __uint_as_float((__float_as_uint(col[n * 128]) & ~127u) | (unsigned)n);
        }
        bit_sort16_desc(C);
        if (ch == 0) {
#pragma unroll
            for (int i = 0; i < 16; i++) L[i] = C[i];
        } else top16_merge(L, C);
    }
}
__device__ __forceinline__ void d_peer_route2(const int vb, char* smem, const bf16_t* __restrict__ kys, const bf16_t* __restrict__ qb,
                                              int* __restrict__ pidx, float* __restrict__ pg) {
    const int tt = vb % 96, h = vb / 96;
    const int tid = threadIdx.x;
    float A[16], B[16];
#pragma unroll
    for (int p = 0; p < 2; p++) {
        const int hp = h * 2 + p;
        d_gemm_bf16(tt, 0, smem, kys + (size_t)hp * 128 * 128, 128, qb + hp * 128, 2048, 128, TT, EpiLds{(float*)smem, tt * 128, 0});
        __syncthreads();
        if (tid < 128) {
            float L[16];
            top16_col((const float*)smem + tid, L);
#pragma unroll
            for (int i = 0; i < 16; i++) { if (p == 0) A[i] = L[i]; else B[i] = L[i]; }
        }
        __syncthreads();
    }
    if (tid >= 128) return;
    const int t = tt * 128 + tid;
    const float smax = key_val(A[0]) + key_val(B[0]);
    unsigned Tk[16];
#pragma unroll
    for (int g = 0; g < 4; g++) {
        unsigned Ck[16];
#pragma unroll
        for (int e = 0; e < 16; e++) {
            const int c = g * 16 + e;
            int i, j;
            if (c < 16) { i = 0; j = c; }
            else if (c < 24) { i = 1; j = c - 16; }
            else if (c < 29) { i = 2; j = c - 24; }
            else if (c < 33) { i = 3; j = c - 29; }
            else if (c < 36) { i = 4; j = c - 33; }
            else if (c < 42) { i = 5 + (c - 36) / 2; j = (c - 36) % 2; }
            else if (c < 50) { i = 8 + (c - 42); j = 0; }
            else { i = -1; j = 0; }
            if (i >= 0) {
                const float dd = smax - (key_val(A[i]) + key_val(B[j]));
                unsigned qd = (unsigned)fminf(dd * 32768.f, 262143.f);
                Ck[e] = (qd << 14) | (unsigned)(key_idx(A[i]) * 128 + key_idx(B[j]));
            } else Ck[e] = 0xffffffffu;
        }
        bit_sort16u_asc(Ck);
        if (g == 0) {
#pragma unroll
            for (int e = 0; e < 16; e++) Tk[e] = Ck[e];
        } else low16_merge_u(Tk, Ck);
    }
    float sum = 0.f;
    float w[16]; int Tp[16];
#pragma unroll
    for (int e = 0; e < 16; e++) { w[e] = __expf(-(float)(Tk[e] >> 14) * (1.f / 32768.f)); sum += w[e]; Tp[e] = (int)(Tk[e] & 16383u); }
    const float inv = 1.f / sum;
    int* pi = pidx + ((size_t)t * 8 + h) * 16;
    float* pw = pg + ((size_t)t * 8 + h) * 16;
#pragma unroll
    for (int e = 0; e < 16; e += 4) {
        *(int4*)(pi + e) = make_int4(Tp[e], Tp[e + 1], Tp[e + 2], Tp[e + 3]);
        *(float4*)(pw + e) = make_float4(w[e] * inv, w[e + 1] * inv, w[e + 2] * inv, w[e + 3] * inv);
    }
}

typedef __attribute__((ext_vector_type(2))) short bf16x2;
__device__ __forceinline__ float dot8_bf16(u32x4 a, u32x4 b, float acc) {
#pragma unroll
    for (int i = 0; i < 4; i++) {
        const unsigned x = a[i], y = b[i];
        acc += __uint_as_float(x << 16) * __uint_as_float(y << 16);
        acc += __uint_as_float(x & 0xffff0000u) * __uint_as_float(y & 0xffff0000u);
    }
    return acc;
}
__device__ __forceinline__ void d_cvt_bf16(const int vb, const float* __restrict__ src, bf16_t* __restrict__ dst) {
    const size_t base = (size_t)vb * 16384 + threadIdx.x * 4;
#pragma unroll
    for (int i = 0; i < 16; i++) {
        const float4 v = *(const float4*)(src + base + i * 1024);
        ushort4 o; o.x = f2bf(v.x); o.y = f2bf(v.y); o.z = f2bf(v.z); o.w = f2bf(v.w);
        *(ushort4*)(dst + base + i * 1024) = o;
    }
}


__device__ __forceinline__ void d_hy_filt2(const int vbl8, char* smem, const int L, const float* __restrict__ w1, const float* __restrict__ b1,
                                           const float* __restrict__ w2, const float* __restrict__ b2, const float* __restrict__ w3,
                                           const float* __restrict__ fr, bf16_t* __restrict__ gT, float* __restrict__ nsum) {
    float* zp = (float*)smem;
    float* h1 = zp + 32 * 33;
    float* h2t = h1 + 32 * 64;
    float* sw1 = h2t + 64 * 32;
    float* sw2 = sw1 + 33 * 64;
    const int tid = threadIdx.x;
    const int vbl = vbl8 >> 3, mm = vbl8 & 7;
    const int t0 = vbl * 32;
    for (int e = tid; e < 33 * 64; e += 256) sw1[e] = w1[e];
    for (int e = tid; e < 64 * 64; e += 256) sw2[e] = w2[e];
    for (int e = tid; e < 32 * 33; e += 256) {
        const int pos = e / 33, i = e % 33;
        const float t = (float)(t0 + pos);
        float val;
        if (i == 0) val = t / (float)(L - 1);
        else {
            const int bi = (i <= 16) ? (i - 1) : (i - 17);
            const float band = 1e-4f + (float)bi * ((15.f - 1e-4f) / 15.f);
            const float ang = 6.283185307179586f * t * band / (float)L;
            val = (i <= 16) ? __cosf(ang) : -__sinf(ang);
        }
        zp[e] = val;
    }
    const int c = tid + 256 * mm;
    float wv[8];
#pragma unroll
    for (int jj = 0; jj < 8; jj++) wv[jj] = w3[jj * 2048 + c];
    __syncthreads();
    {
        const int j = tid & 63;
        const float frj = fr[j];
#pragma unroll 1
        for (int i = 0; i < 8; i++) {
            const int pos = (tid >> 6) + 4 * i;
            float sacc = b1[j];
#pragma unroll 3
            for (int q = 0; q < 33; q++) sacc += zp[pos * 33 + q] * sw1[q * 64 + j];
            h1[pos * 64 + j] = __sinf(frj * sacc);
        }
        __syncthreads();
#pragma unroll 1
        for (int i = 0; i < 8; i++) {
            const int pos = (tid >> 6) + 4 * i;
            float sacc = b2[j];
#pragma unroll 4
            for (int q = 0; q < 64; q++) sacc += h1[pos * 64 + q] * sw2[q * 64 + j];
            h2t[j * 32 + pos] = __sinf(frj * sacc);
        }
    }
    __syncthreads();
    {
        float acc[32];
#pragma unroll
        for (int i = 0; i < 32; i++) acc[i] = 0.f;
#pragma unroll 1
        for (int jb = 0; jb < 64; jb += 8) {
            float wn[8];
            if (jb + 8 < 64) {
#pragma unroll
                for (int jj = 0; jj < 8; jj++) wn[jj] = w3[(jb + 8 + jj) * 2048 + c];
            }
#pragma unroll
            for (int jj = 0; jj < 8; jj++) {
                const float w = wv[jj];
#pragma unroll
                for (int i = 0; i < 8; i++) {
                    const float4 hv = *(const float4*)(h2t + (jb + jj) * 32 + i * 4);
                    acc[4 * i] += hv.x * w; acc[4 * i + 1] += hv.y * w; acc[4 * i + 2] += hv.z * w; acc[4 * i + 3] += hv.w * w;
                }
                __builtin_amdgcn_sched_barrier(0);
            }
            if (jb + 8 < 64) {
#pragma unroll
                for (int jj = 0; jj < 8; jj++) wv[jj] = wn[jj];
            }
        }
        const int ch = c & 1023;
        const float d0 = -4.605170185988091f / 0.3f, d1 = -4.605170185988091f / 1.5f;
        const float adelta = fabsf(d0 + (d1 - d0) * ((float)ch / 1023.f));
        float absum = 0.f;
        bf16_t* g = gT + (size_t)ch * 2 * L;
#pragma unroll
        for (int i = 0; i < 32; i++) {
            const int t = t0 + i;
            const float tu = (float)t / (float)(L - 1);
            const float val = acc[i] * __expf(-tu * adelta);
            if (c < 1024) { absum += fabsf(val); g[L - t] = f2bf(val); }
            else if (t >= 1) { absum += fabsf(val); g[L + t] = f2bf(val); }
            if ((i & 3) == 3) __builtin_amdgcn_sched_barrier(0);
        }
        atomicAdd(nsum + ch, absum);
    }
}

__device__ __forceinline__ void d_hy_dw3(const int vb, char* smem, const bf16_t* __restrict__ pre, const float* __restrict__ cw,
                                         const float* __restrict__ cb, bf16_t* __restrict__ zT, bf16_t* __restrict__ x0b) {
    bf16_t* tile = (bf16_t*)smem;
    const int tt = vb >> 3, ct = vb & 7;
    const int tid = threadIdx.x;
    const int cp = tid & 63, c = ct * 128 + cp * 2;
    const int tq = tid >> 6;
    const int tok0 = tt * 64 + tq * 16;
    const int pos0 = tok_pos(tok0), L = tok_len(tok0);
    unsigned raw[3][18];
#pragma unroll
    for (int part = 0; part < 3; part++)
#pragma unroll
        for (int i = 0; i < 18; i++) {
            const int pos = pos0 - 1 + i;
            raw[part][i] = (pos >= 0 && pos < L) ? *(const unsigned*)(pre + (size_t)(tok0 - 1 + i) * 3072 + part * 1024 + c) : 0u;
        }
    float w0[3][2], w1[3][2], w2[3][2], bb[3][2];
#pragma unroll
    for (int part = 0; part < 3; part++)
#pragma unroll
        for (int e = 0; e < 2; e++) {
            const int col = part * 1024 + c + e;
            w0[part][e] = cw[col]; w1[part][e] = cw[3072 + col]; w2[part][e] = cw[2 * 3072 + col]; bb[part][e] = cb[col];
        }
#pragma unroll
    for (int i = 0; i < 16; i++) {
        float u[3][2];
#pragma unroll
        for (int part = 0; part < 3; part++) {
            const unsigned p0 = raw[part][i], p1 = raw[part][i + 1], p2 = raw[part][i + 2];
            u[part][0] = __uint_as_float(p0 << 16) * w0[part][0] + __uint_as_float(p1 << 16) * w1[part][0] + __uint_as_float(p2 << 16) * w2[part][0] + bb[part][0];
            u[part][1] = __uint_as_float(p0 & 0xffff0000u) * w0[part][1] + __uint_as_float(p1 & 0xffff0000u) * w1[part][1] +
                         __uint_as_float(p2 & 0xffff0000u) * w2[part][1] + bb[part][1];
        }
        *(unsigned*)(x0b + (size_t)(tok0 + i) * DM + c) = (unsigned)f2bf(u[0][0]) | ((unsigned)f2bf(u[0][1]) << 16);
        tile[(cp * 2) * 72 + tq * 16 + i] = f2bf(u[1][0] * u[2][0]);
        tile[(cp * 2 + 1) * 72 + tq * 16 + i] = f2bf(u[1][1] * u[2][1]);
    }
    __syncthreads();
    {
        const int cch = tid >> 1, hf = tid & 1;
        bf16_t* dst = zT + (size_t)(ct * 128 + cch) * TT + tt * 64 + hf * 32;
        const bf16_t* src = tile + cch * 72 + hf * 32;
#pragma unroll
        for (int q = 0; q < 4; q++) *(u32x4*)(dst + q * 8) = *(const u32x4*)(src + q * 8);
    }
}

template <bool SAMPLE>
__device__ __forceinline__ void d_hy_conv2(const int c, const int half, char* wsm, const bf16_t* __restrict__ gTall, const float* __restrict__ nsum,
                                           const bf16_t* __restrict__ zT, const float* __restrict__ bias, bf16_t* __restrict__ yT) {
    constexpr int L = SAMPLE ? LS : LP;
    constexpr int NB = L / 32;
    constexpr int NBATCH = SAMPLE ? 4 : 16;
    constexpr int BSH = SAMPLE ? 2 : 4;
    constexpr int TPB = 32 >> BSH;
    constexpr int NCB = NB / TPB;
    constexpr int HCB = NCB / 2;
    constexpr int PADB = SAMPLE ? 8 : 2;
    constexpr int ZLEN = L + 2 * PADB * 32;
    constexpr int tbase = SAMPLE ? TP : 0;
    const int lane = threadIdx.x & 63;
    const int l2 = half * 64 + lane;
    const int lc = lane & 31, hh = lane >> 5;
    const int b = lc & (NBATCH - 1), Tl = lc >> BSH;
    bf16_t* R = (bf16_t*)wsm;
    bf16_t* Z = R + 2 * L;
    {
        constexpr int RCH = 2 * L / 8 / 128;
        constexpr int ZCH = NBATCH * (L / 8) / 128;
        const u32x4* src = (const u32x4*)(gTall + (size_t)c * 2 * L);
        u32x4 rr[RCH > 0 ? RCH : 1], zz[ZCH];
        if constexpr (RCH > 0) {
#pragma unroll
            for (int i = 0; i < RCH; i++) rr[i] = src[l2 + 128 * i];
        } else {
            if (l2 < 2 * L / 8) rr[0] = src[l2];
        }
#pragma unroll
        for (int i = 0; i < ZCH; i++) {
            const int q = l2 + 128 * i;
            const int b2 = q / (L / 8), ci = q % (L / 8);
            zz[i] = ((const u32x4*)(zT + (size_t)c * TT + tbase + b2 * L))[ci];
        }
        const u32x4 zero = {0u, 0u, 0u, 0u};
        for (int q = l2; q < NBATCH * PADB * 4; q += 128) {
            const int b2 = q / (PADB * 4), i = q % (PADB * 4);
            u32x4* zd = (u32x4*)(Z + b2 * ZLEN);
            zd[i] = zero; zd[PADB * 4 + L / 8 + i] = zero;
        }
        if constexpr (RCH > 0) {
#pragma unroll
            for (int i = 0; i < RCH; i++) ((u32x4*)R)[l2 + 128 * i] = rr[i];
        } else {
            if (l2 < 2 * L / 8) ((u32x4*)R)[l2] = rr[0];
        }
#pragma unroll
        for (int i = 0; i < ZCH; i++) {
            const int q = l2 + 128 * i;
            const int b2 = q / (L / 8), ci = q % (L / 8);
            ((u32x4*)(Z + b2 * ZLEN))[PADB * 4 + ci] = zz[i];
        }
    }
    __syncthreads();
    f32x16 acc[HCB];
#pragma unroll
    for (int cb = 0; cb < HCB; cb++)
#pragma unroll
        for (int r = 0; r < 16; r++) acc[cb][r] = 0.f;
    const bf16_t* Zb = Z + b * ZLEN + PADB * 32 + 8 * hh;
    const int cb0 = half * HCB;
    const int Dlo = TPB * cb0 - (NB - 1), Dhi = TPB * (cb0 + HCB - 1) + TPB - 1;
#pragma unroll 1
    for (int D = (Dlo < -(NB - 1) ? -(NB - 1) : Dlo); D <= (Dhi > NB - 1 ? NB - 1 : Dhi); D++) {
        bf16x8 af[2];
#pragma unroll
        for (int ks = 0; ks < 2; ks++) {
            const bf16_t* rp = R + (L - 32 * D - lc + 16 * ks + 8 * hh);
#pragma unroll
            for (int j = 0; j < 8; j++) af[ks][j] = (short)rp[j];
        }
#pragma unroll
        for (int lcb = 0; lcb < HCB; lcb++) {
            const int cb = cb0 + lcb;
            if (D >= TPB * cb - (NB - 1) && D <= TPB * cb + TPB - 1) {
                const int S = TPB * cb + Tl - D;
#pragma unroll
                for (int ks = 0; ks < 2; ks++) {
                    const bf16x8 bfr = *(const bf16x8*)(Zb + 32 * S + 16 * ks);
                    acc[lcb] = __builtin_amdgcn_mfma_f32_32x32x16_bf16(af[ks], bfr, acc[lcb], 0, 0, 0);
                }
            }
        }
    }
    const float inv = 1.f / nsum[c], bs = bias[c];
    bf16_t* yrow = yT + (size_t)c * TT + tbase + b * L;
    const bf16_t* zrow = Z + b * ZLEN + PADB * 32;
#pragma unroll
    for (int lcb = 0; lcb < HCB; lcb++)
#pragma unroll
        for (int g = 0; g < 4; g++) {
            const int t = 32 * (TPB * (cb0 + lcb) + Tl) + 8 * g + 4 * hh;
            ushort4 o;
            o.x = f2bf(acc[lcb][4 * g + 0] * inv + bf2f(zrow[t + 0]) * bs);
            o.y = f2bf(acc[lcb][4 * g + 1] * inv + bf2f(zrow[t + 1]) * bs);
            o.z = f2bf(acc[lcb][4 * g + 2] * inv + bf2f(zrow[t + 2]) * bs);
            o.w = f2bf(acc[lcb][4 * g + 3] * inv + bf2f(zrow[t + 3]) * bs);
            *(ushort4*)(yrow + t) = o;
        }
}

__device__ __forceinline__ void d_hy_post2(const int vb, char* smem, const bf16_t* __restrict__ yT, const bf16_t* __restrict__ x0b, bf16_t* __restrict__ zb) {
    bf16_t* tile = (bf16_t*)smem;
    const int tt = vb >> 3, ct = vb & 7;
    const int tid = threadIdx.x;
    const int cp = tid & 63, c = ct * 128 + cp * 2, tq = tid >> 6;
    const int tok0 = tt * 64 + tq * 16;
    unsigned xr[16];
#pragma unroll
    for (int i = 0; i < 16; i++) xr[i] = *(const unsigned*)(x0b + (size_t)(tok0 + i) * DM + c);
    {
        const int cch = tid >> 1, hf = tid & 1;
        const bf16_t* src = yT + (size_t)(ct * 128 + cch) * TT + tt * 64 + hf * 32;
        bf16_t* dst = tile + cch * 72 + hf * 32;
#pragma unroll
        for (int q = 0; q < 4; q++) *(u32x4*)(dst + q * 8) = *(const u32x4*)(src + q * 8);
    }
    __syncthreads();
#pragma unroll
    for (int i = 0; i < 16; i++) {
        const float y0 = bf2f(tile[(cp * 2) * 72 + tq * 16 + i]), y1 = bf2f(tile[(cp * 2 + 1) * 72 + tq * 16 + i]);
        const float r0 = __uint_as_float(xr[i] << 16) * y0, r1 = __uint_as_float(xr[i] & 0xffff0000u) * y1;
        *(unsigned*)(zb + (size_t)(tok0 + i) * DM + c) = (unsigned)f2bf(r0) | ((unsigned)f2bf(r1) << 16);
    }
}

__device__ __forceinline__ float wave_allsum_fast(float v) {
    v = row16_allsum(v);
    const float r0 = __int_as_float(__builtin_amdgcn_readlane(__float_as_int(v), 0));
    const float r1 = __int_as_float(__builtin_amdgcn_readlane(__float_as_int(v), 16));
    const float r2 = __int_as_float(__builtin_amdgcn_readlane(__float_as_int(v), 32));
    const float r3 = __int_as_float(__builtin_amdgcn_readlane(__float_as_int(v), 48));
    return (r0 + r1) + (r2 + r3);
}
__device__ __forceinline__ ushort4 pack_bf4(float a, float b, float c, float d) { ushort4 o; o.x = f2bf(a); o.y = f2bf(b); o.z = f2bf(c); o.w = f2bf(d); return o; }

__device__ __forceinline__ void d_norm_mod2(const int vb, const float* __restrict__ xa, const float* __restrict__ xb, const float* __restrict__ g,
                                            const float* __restrict__ modl, const int shift_idx, const int scale_idx, bf16_t* __restrict__ h) {
    const int wid = threadIdx.x >> 6, lane = threadIdx.x & 63;
    const int t0 = vb * 8 + wid * 2;
    float4 v[2][4];
#pragma unroll
    for (int u = 0; u < 2; u++) {
        const int t = t0 + u;
        const float* x = (t < TP) ? (xa + (size_t)t * DM) : (xb + (size_t)(t - TP) * DM);
#pragma unroll
        for (int j = 0; j < 4; j++) v[u][j] = *(const float4*)(x + j * 256 + lane * 4);
    }
#pragma unroll
    for (int u = 0; u < 2; u++) {
        const int t = t0 + u;
        float ss = 0.f;
#pragma unroll
        for (int j = 0; j < 4; j++) ss += v[u][j].x * v[u][j].x + v[u][j].y * v[u][j].y + v[u][j].z * v[u][j].z + v[u][j].w * v[u][j].w;
        ss = wave_allsum_fast(ss);
        const float rstd = rsqrtf(ss * (1.f / DM) + 1e-6f);
        const float* m = modl + (size_t)tok_modrow(t) * 6144;
#pragma unroll
        for (int j = 0; j < 4; j++) {
            const int c = j * 256 + lane * 4;
            const float4 gg = *(const float4*)(g + c);
            const float4 sh = *(const float4*)(m + shift_idx * 1024 + c);
            const float4 sc = *(const float4*)(m + scale_idx * 1024 + c);
            *(ushort4*)(h + (size_t)t * DM + c) = pack_bf4(v[u][j].x * rstd * gg.x * (1.f + sc.x) + sh.x, v[u][j].y * rstd * gg.y * (1.f + sc.y) + sh.y,
                                                           v[u][j].z * rstd * gg.z * (1.f + sc.z) + sh.z, v[u][j].w * rstd * gg.w * (1.f + sc.w) + sh.w);
        }
    }
}

__device__ __forceinline__ void d_rw_shift2(const int vb, const bf16_t* __restrict__ proj, const float* __restrict__ mu, bf16_t* __restrict__ rb,
                                            bf16_t* __restrict__ kb, bf16_t* __restrict__ vbuf, bf16_t* __restrict__ tw, bf16_t* __restrict__ adv,
                                            bf16_t* __restrict__ sg) {
#pragma unroll
    for (int u = 0; u < 4; u++) {
        const int id = vb * 1024 + u * 256 + threadIdx.x;
        const int t = id / 224, c = (id % 224) * 8;
        const int pos = tok_pos(t), L = tok_len(t);
        const bf16_t* P = proj + (size_t)t * RWIN + c;
        const u32x4 cur = *(const u32x4*)P;
        u32x4 prv = {0u, 0u, 0u, 0u}, nxt = {0u, 0u, 0u, 0u};
        if (pos > 0) prv = *(const u32x4*)(P - RWIN);
        if (pos < L - 1) nxt = *(const u32x4*)(P + RWIN);
        const float4 m0 = *(const float4*)(mu + c), m1 = *(const float4*)(mu + c + 4);
        const float mm[8] = {m0.x, m0.y, m0.z, m0.w, m1.x, m1.y, m1.z, m1.w};
        float val[8];
#pragma unroll
        for (int i = 0; i < 4; i++) {
            const float c0 = __uint_as_float(cur[i] << 16), c1 = __uint_as_float(cur[i] & 0xffff0000u);
            const float p0 = __uint_as_float(prv[i] << 16), p1 = __uint_as_float(prv[i] & 0xffff0000u);
            const float n0 = __uint_as_float(nxt[i] << 16), n1 = __uint_as_float(nxt[i] & 0xffff0000u);
            val[2 * i] = c0 + mm[2 * i] * (0.5f * (p0 + n0) - c0);
            val[2 * i + 1] = c1 + mm[2 * i + 1] * (0.5f * (p1 + n1) - c1);
        }
        bf16_t* dst;
        if (c < 512) dst = rb + (size_t)t * 512 + c;
        else if (c < 1024) dst = kb + (size_t)t * 512 + (c - 512);
        else if (c < 1536) dst = vbuf + (size_t)t * 512 + (c - 1024);
        else if (c < 1600) { dst = tw + (size_t)t * 64 + (c - 1536);
#pragma unroll
            for (int i = 0; i < 8; i++) val[i] = tanhf(val[i]); }
        else if (c < 1664) dst = adv + (size_t)t * 64 + (c - 1600);
        else { dst = sg + (size_t)t * 128 + (c - 1664);
#pragma unroll
            for (int i = 0; i < 8; i++) val[i] = sigmoidf_(val[i]); }
        u32x4 o;
#pragma unroll
        for (int i = 0; i < 4; i++) o[i] = (unsigned)f2bf(val[2 * i]) | ((unsigned)f2bf(val[2 * i + 1]) << 16);
        *(u32x4*)dst = o;
    }
}

__device__ __forceinline__ void d_mla_pre2(const int vb, const float* __restrict__ proj, const float* __restrict__ q_norm, const float* __restrict__ kv_norm,
                                           bf16_t* __restrict__ qcn, bf16_t* __restrict__ ckv, float* __restrict__ kpe, float* __restrict__ out_ckv,
                                           float* __restrict__ out_kpe) {
    const int t = vb * 16 + (threadIdx.x >> 4), l16 = threadIdx.x & 15;
    const float* P = proj + (size_t)t * 448;
    float4 x[7];
#pragma unroll
    for (int j = 0; j < 7; j++) x[j] = *(const float4*)(P + 4 * (l16 + 16 * j));
    float sq = 0.f, sk = 0.f;
#pragma unroll
    for (int j = 0; j < 4; j++) sq += x[j].x * x[j].x + x[j].y * x[j].y + x[j].z * x[j].z + x[j].w * x[j].w;
#pragma unroll
    for (int j = 4; j < 6; j++) sk += x[j].x * x[j].x + x[j].y * x[j].y + x[j].z * x[j].z + x[j].w * x[j].w;
    sq = row16_allsum(sq); sk = row16_allsum(sk);
    const float rq = rsqrtf(sq * (1.f / 256.f) + 1e-6f), rk = rsqrtf(sk * (1.f / 128.f) + 1e-6f);
#pragma unroll
    for (int j = 0; j < 4; j++) {
        const int c = 4 * (l16 + 16 * j);
        const float4 w = *(const float4*)(q_norm + c);
        *(ushort4*)(qcn + (size_t)t * 256 + c) = pack_bf4(x[j].x * rq * w.x, x[j].y * rq * w.y, x[j].z * rq * w.z, x[j].w * rq * w.w);
    }
#pragma unroll
    for (int j = 4; j < 6; j++) {
        const int c = 4 * (l16 + 16 * (j - 4));
        const float4 w = *(const float4*)(kv_norm + c);
        const float4 o = make_float4(x[j].x * rk * w.x, x[j].y * rk * w.y, x[j].z * rk * w.z, x[j].w * rk * w.w);
        *(ushort4*)(ckv + (size_t)t * 128 + c) = pack_bf4(o.x, o.y, o.z, o.w);
        if (t < TP) *(float4*)(out_ckv + (size_t)t * 128 + c) = o;
    }
    {
        const int c = 4 * l16;
        *(float4*)(kpe + (size_t)t * 64 + c) = x[6];
        if (t < TP) *(float4*)(out_kpe + (size_t)t * 64 + c) = x[6];
    }
}


typedef float f32x2 __attribute__((ext_vector_type(2)));
template <int CTRL>
__device__ __forceinline__ float dpp_max(float v) {
    return fmaxf(v, __int_as_float(__builtin_amdgcn_update_dpp(0, __float_as_int(v), CTRL, 0xf, 0xf, false)));
}
__device__ __forceinline__ float wave_allmax_fast(float v) {
    v = dpp_max<0x128>(v); v = dpp_max<0x124>(v); v = dpp_max<0x122>(v); v = dpp_max<0x121>(v);
    const float r0 = __int_as_float(__builtin_amdgcn_readlane(__float_as_int(v), 0));
    const float r1 = __int_as_float(__builtin_amdgcn_readlane(__float_as_int(v), 16));
    const float r2 = __int_as_float(__builtin_amdgcn_readlane(__float_as_int(v), 32));
    const float r3 = __int_as_float(__builtin_amdgcn_readlane(__float_as_int(v), 48));
    return fmaxf(fmaxf(r0, r1), fmaxf(r2, r3));
}
__device__ __forceinline__ void d_cvt_fp8_rows(const int vb, const float* __restrict__ src, unsigned char* __restrict__ dst, float* __restrict__ rscale) {
    const int wid = threadIdx.x >> 6, lane = threadIdx.x & 63;
    float4 x[4][4];
#pragma unroll
    for (int u = 0; u < 4; u++) {
        const float* r = src + (size_t)(vb * 16 + wid * 4 + u) * 1024 + lane * 4;
#pragma unroll
        for (int j = 0; j < 4; j++) x[u][j] = *(const float4*)(r + 256 * j);
    }
#pragma unroll
    for (int u = 0; u < 4; u++) {
        const int row = vb * 16 + wid * 4 + u;
        float am = 0.f;
#pragma unroll
        for (int j = 0; j < 4; j++) am = fmaxf(am, fmaxf(fmaxf(fabsf(x[u][j].x), fabsf(x[u][j].y)), fmaxf(fabsf(x[u][j].z), fabsf(x[u][j].w))));
        am = wave_allmax_fast(am);
        const float sc = am > 0.f ? 448.f / am : 1.f;
#pragma unroll
        for (int j = 0; j < 4; j++) {
            int pk = __builtin_amdgcn_cvt_pk_fp8_f32(x[u][j].x * sc, x[u][j].y * sc, 0, false);
            pk = __builtin_amdgcn_cvt_pk_fp8_f32(x[u][j].z * sc, x[u][j].w * sc, pk, true);
            *(unsigned*)(dst + (size_t)row * 1024 + 256 * j + lane * 4) = (unsigned)pk;
        }
        if (lane == 0) rscale[row] = am > 0.f ? am * (1.f / 448.f) : 1.f;
    }
}
__device__ __forceinline__ void d_peer_apply3(const int vb, char* smem, const bf16_t* __restrict__ hb, const int* __restrict__ pidx,
                                              const float* __restrict__ pg, const unsigned char* __restrict__ utab, const unsigned char* __restrict__ vtab,
                                              const float* __restrict__ rsU, const float* __restrict__ rsV, const float* __restrict__ modl,
                                              float* __restrict__ xrun, const float* __restrict__ g_next, const float* __restrict__ mod_next,
                                              bf16_t* __restrict__ h_next) {
    const int wid = threadIdx.x >> 6, lane = threadIdx.x & 63;
    const int t = vb * 4 + wid;
    float* coef = (float*)smem + wid * 128;
    int* eid = (int*)(smem + 2048) + wid * 128;
    const int e_lo = pidx[(size_t)t * 128 + lane], e_hi = pidx[(size_t)t * 128 + lane + 64];
    eid[lane] = e_lo; eid[lane + 64] = e_hi;
    const float g0 = pg[(size_t)t * 128 + lane] * rsV[e_lo], g1 = pg[(size_t)t * 128 + lane + 64] * rsV[e_hi];
    const float ru0 = rsU[e_lo], ru1 = rsU[e_hi];
    float x[16];
    {
        const u32x4 a = *(const u32x4*)(hb + (size_t)t * DM + lane * 16), b = *(const u32x4*)(hb + (size_t)t * DM + lane * 16 + 8);
#pragma unroll
        for (int i = 0; i < 4; i++) {
            x[2 * i] = __uint_as_float(a[i] << 16); x[2 * i + 1] = __uint_as_float(a[i] & 0xffff0000u);
            x[8 + 2 * i] = __uint_as_float(b[i] << 16); x[8 + 2 * i + 1] = __uint_as_float(b[i] & 0xffff0000u);
        }
    }
    __builtin_amdgcn_wave_barrier();
    float myact0 = 0.f, myact1 = 0.f;
#pragma unroll 1
    for (int eb = 0; eb < 128; eb += 16) {
        u32x4 q[16];
#pragma unroll
        for (int r = 0; r < 16; r++) q[r] = *(const u32x4*)(utab + (size_t)eid[eb + r] * 1024 + lane * 16);
#pragma unroll
        for (int r = 0; r < 16; r++) {
            float sacc = 0.f;
#pragma unroll
            for (int i = 0; i < 4; i++) {
                const f32x2 f01 = __builtin_amdgcn_cvt_pk_f32_fp8((int)q[r][i], false);
                const f32x2 f23 = __builtin_amdgcn_cvt_pk_f32_fp8((int)q[r][i], true);
                sacc += f01[0] * x[4 * i] + f01[1] * x[4 * i + 1] + f23[0] * x[4 * i + 2] + f23[1] * x[4 * i + 3];
            }
            sacc = wave_allsum_fast(sacc);
            const int e = eb + r;
            if (lane == (e & 63)) { if (e < 64) myact0 = sacc; else myact1 = sacc; }
        }
    }
    coef[lane] = g0 * gelu_tanh(myact0 * ru0);
    coef[lane + 64] = g1 * gelu_tanh(myact1 * ru1);
    __builtin_amdgcn_wave_barrier();
    float acc[16];
#pragma unroll
    for (int i = 0; i < 16; i++) acc[i] = 0.f;
#pragma unroll 1
    for (int eb = 0; eb < 128; eb += 16) {
        u32x4 q[16];
#pragma unroll
        for (int r = 0; r < 16; r++) q[r] = *(const u32x4*)(vtab + (size_t)eid[eb + r] * 1024 + lane * 16);
#pragma unroll
        for (int r = 0; r < 16; r++) {
            const float cf = coef[eb + r];
#pragma unroll
            for (int i = 0; i < 4; i++) {
                const f32x2 f01 = __builtin_amdgcn_cvt_pk_f32_fp8((int)q[r][i], false);
                const f32x2 f23 = __builtin_amdgcn_cvt_pk_f32_fp8((int)q[r][i], true);
                acc[4 * i] += cf * f01[0]; acc[4 * i + 1] += cf * f01[1]; acc[4 * i + 2] += cf * f23[0]; acc[4 * i + 3] += cf * f23[1];
            }
        }
    }
    const float* m = modl + (size_t)tok_modrow(t) * 6144 + 5 * 1024 + lane * 16;
    float* xo = xrun + (size_t)t * DM + lane * 16;
    float ss = 0.f;
#pragma unroll
    for (int j = 0; j < 4; j++) {
        float4 xa = *(float4*)(xo + 4 * j);
        const float4 ma = *(const float4*)(m + 4 * j);
        xa.x += ma.x * acc[4 * j]; xa.y += ma.y * acc[4 * j + 1]; xa.z += ma.z * acc[4 * j + 2]; xa.w += ma.w * acc[4 * j + 3];
        *(float4*)(xo + 4 * j) = xa;
        acc[4 * j] = xa.x; acc[4 * j + 1] = xa.y; acc[4 * j + 2] = xa.z; acc[4 * j + 3] = xa.w;
        ss += xa.x * xa.x + xa.y * xa.y + xa.z * xa.z + xa.w * xa.w;
    }
    if (g_next != nullptr) {
        ss = wave_allsum_fast(ss);
        const float rstd = rsqrtf(ss * (1.f / DM) + 1e-6f);
        const float* mn = mod_next + (size_t)tok_modrow(t) * 6144 + lane * 16;
#pragma unroll
        for (int j = 0; j < 4; j++) {
            const float4 gg = *(const float4*)(g_next + lane * 16 + 4 * j);
            const float4 sh = *(const float4*)(mn + 4 * j);
            const float4 sc = *(const float4*)(mn + 1024 + 4 * j);
            *(ushort4*)(h_next + (size_t)t * DM + lane * 16 + 4 * j) =
                pack_bf4(acc[4 * j] * rstd * gg.x * (1.f + sc.x) + sh.x, acc[4 * j + 1] * rstd * gg.y * (1.f + sc.y) + sh.y,
                         acc[4 * j + 2] * rstd * gg.z * (1.f + sc.z) + sh.z, acc[4 * j + 3] * rstd * gg.w * (1.f + sc.w) + sh.w);
        }
    }
}


__device__ __forceinline__ void d_rw_kk3(const int vb, const bf16_t* __restrict__ rb, const bf16_t* __restrict__ kb, const bf16_t* __restrict__ lr0,
                                         const bf16_t* __restrict__ lr1, const float* __restrict__ k_k, const float* __restrict__ k_a,
                                         const float* __restrict__ r_k, bf16_t* __restrict__ kkb, float* __restrict__ bonus) {
    const int g = threadIdx.x >> 4, l16 = threadIdx.x & 15;
    uint2 kq[4], rq[4], aq[4], bq[4];
#pragma unroll
    for (int u = 0; u < 4; u++) {
        const size_t o = (size_t)(vb * 64 + g + 16 * u) * 64 + l16 * 4;
        kq[u] = *(const uint2*)(kb + o); rq[u] = *(const uint2*)(rb + o); aq[u] = *(const uint2*)(lr0 + o); bq[u] = *(const uint2*)(lr1 + o);
    }
#pragma unroll
    for (int u = 0; u < 4; u++) {
        const int w = vb * 64 + g + 16 * u;
        const int h = w & 7;
        const float4 kk4 = *(const float4*)(k_k + h * 64 + l16 * 4), ka4 = *(const float4*)(k_a + h * 64 + l16 * 4), rk4 = *(const float4*)(r_k + h * 64 + l16 * 4);
        const float k0 = __uint_as_float(kq[u].x << 16), k1 = __uint_as_float(kq[u].x & 0xffff0000u), k2 = __uint_as_float(kq[u].y << 16), k3 = __uint_as_float(kq[u].y & 0xffff0000u);
        const float r0 = __uint_as_float(rq[u].x << 16), r1 = __uint_as_float(rq[u].x & 0xffff0000u), r2 = __uint_as_float(rq[u].y << 16), r3 = __uint_as_float(rq[u].y & 0xffff0000u);
        const float a0 = __uint_as_float(aq[u].x << 16), a1 = __uint_as_float(aq[u].x & 0xffff0000u), a2 = __uint_as_float(aq[u].y << 16), a3 = __uint_as_float(aq[u].y & 0xffff0000u);
        const float b0 = __uint_as_float(bq[u].x << 16), b1 = __uint_as_float(bq[u].x & 0xffff0000u), b2 = __uint_as_float(bq[u].y << 16), b3 = __uint_as_float(bq[u].y & 0xffff0000u);
        const float q0 = k0 * kk4.x, q1 = k1 * kk4.y, q2 = k2 * kk4.z, q3 = k3 * kk4.w;
        float ss = (q0 * q0 + q1 * q1) + (q2 * q2 + q3 * q3);
        float bs = r0 * k0 * (2.f + (a0 + b0 - 2.f) * ka4.x) * rk4.x + r1 * k1 * (2.f + (a1 + b1 - 2.f) * ka4.y) * rk4.y +
                   r2 * k2 * (2.f + (a2 + b2 - 2.f) * ka4.z) * rk4.z + r3 * k3 * (2.f + (a3 + b3 - 2.f) * ka4.w) * rk4.w;
        ss = row16_allsum(ss); bs = row16_allsum(bs);
        const float inv = 1.f / fmaxf(sqrtf(ss), 1e-12f);
        uint2 o2;
        o2.x = (unsigned)f2bf(q0 * inv) | ((unsigned)f2bf(q1 * inv) << 16);
        o2.y = (unsigned)f2bf(q2 * inv) | ((unsigned)f2bf(q3 * inv) << 16);
        *(uint2*)(kkb + (size_t)w * 64 + l16 * 4) = o2;
        if (l16 == 0) bonus[w] = bs;
    }
}
__device__ __forceinline__ void d_rw_post3(const int vb, const float* __restrict__ y0, const float* __restrict__ y1, const float* __restrict__ bonus,
                                           const bf16_t* __restrict__ vbuf, const bf16_t* __restrict__ gate, const float* __restrict__ lnx_g,
                                           const float* __restrict__ lnx_b, bf16_t* __restrict__ cat) {
    const int g = threadIdx.x >> 4, l16 = threadIdx.x & 15;
    float4 ya[4], yb[4]; uint2 vq[4], gq[4];
#pragma unroll
    for (int u = 0; u < 4; u++) {
        const size_t o = (size_t)(vb * 64 + g + 16 * u) * 64 + l16 * 4;
        ya[u] = *(const float4*)(y0 + o); yb[u] = *(const float4*)(y1 + o); vq[u] = *(const uint2*)(vbuf + o); gq[u] = *(const uint2*)(gate + o);
    }
#pragma unroll
    for (int u = 0; u < 4; u++) {
        const int w = vb * 64 + g + 16 * u;
        const int t = w >> 3, h = w & 7;
        const float e0 = ya[u].x + yb[u].x, e1 = ya[u].y + yb[u].y, e2 = ya[u].z + yb[u].z, e3 = ya[u].w + yb[u].w;
        const float mean = row16_allsum((e0 + e1) + (e2 + e3)) * (1.f / 64.f);
        const float d0 = e0 - mean, d1 = e1 - mean, d2 = e2 - mean, d3 = e3 - mean;
        const float var = row16_allsum((d0 * d0 + d1 * d1) + (d2 * d2 + d3 * d3)) * (1.f / 64.f);
        const float rstd = rsqrtf(var + 64e-5f);
        const float bn = bonus[w];
        const float4 g4 = *(const float4*)(lnx_g + h * 64 + l16 * 4), b4 = *(const float4*)(lnx_b + h * 64 + l16 * 4);
        const float v0 = __uint_as_float(vq[u].x << 16), v1 = __uint_as_float(vq[u].x & 0xffff0000u), v2 = __uint_as_float(vq[u].y << 16), v3 = __uint_as_float(vq[u].y & 0xffff0000u);
        const float t0 = __uint_as_float(gq[u].x << 16), t1 = __uint_as_float(gq[u].x & 0xffff0000u), t2 = __uint_as_float(gq[u].y << 16), t3 = __uint_as_float(gq[u].y & 0xffff0000u);
        uint2 o2;
        o2.x = (unsigned)f2bf((d0 * rstd * g4.x + b4.x + bn * v0) * t0) | ((unsigned)f2bf((d1 * rstd * g4.y + b4.y + bn * v1) * t1) << 16);
        o2.y = (unsigned)f2bf((d2 * rstd * g4.z + b4.z + bn * v2) * t2) | ((unsigned)f2bf((d3 * rstd * g4.w + b4.w + bn * v3) * t3) << 16);
        *(uint2*)(cat + (size_t)t * DM + h * 64 + l16 * 4) = o2;
    }
}


__device__ __forceinline__ void d_mla_post3(const int vb, const bf16_t* __restrict__ qraw, const bf16_t* __restrict__ kvraw, const bf16_t* __restrict__ kvraw_ctx,
                                            const float* __restrict__ kpe, const float* __restrict__ cache_kpe, const float* __restrict__ qn,
                                            const float* __restrict__ kn, bf16_t* __restrict__ Qb, bf16_t* __restrict__ Kp, bf16_t* __restrict__ Ks) {
    const int g = threadIdx.x >> 4, l16 = threadIdx.x & 15;
    const float inv = __expf(-(float)l16 * (1.f / 16.f) * 9.210340371976184f);
    float2 qnv[6], knv[6];
#pragma unroll
    for (int j = 0; j < 6; j++) { qnv[j] = *(const float2*)(qn + 2 * (l16 + 16 * j)); knv[j] = *(const float2*)(kn + 2 * (l16 + 16 * j)); }
#pragma unroll 2
    for (int u = 0; u < 4; u++) {
        const int item = vb * 64 + g + 16 * u;
        const int row = item >> 2, h = item & 3;
        const bool isctx = row >= TT, sample = row >= TP;
        const bf16_t* kvr; const float* pe; int pos = 0;
        if (isctx) { const int cr = row - TT; kvr = kvraw_ctx + (size_t)cr * 1024; pe = cache_kpe + (size_t)cr * 64; }
        else { kvr = kvraw + (size_t)row * 1024; pe = kpe + (size_t)row * 64; pos = tok_pos(row); }
        float kx[12], qx[12];
#pragma unroll
        for (int j = 0; j < 4; j++) {
            const unsigned kw = *(const unsigned*)(kvr + h * 256 + 2 * (l16 + 16 * j));
            kx[2 * j] = __uint_as_float(kw << 16); kx[2 * j + 1] = __uint_as_float(kw & 0xffff0000u);
        }
#pragma unroll
        for (int j = 4; j < 6; j++) { const float2 pv = *(const float2*)(pe + 2 * (l16 + 16 * (j - 4))); kx[2 * j] = pv.x; kx[2 * j + 1] = pv.y; }
#pragma unroll
        for (int j = 0; j < 6; j++) {
            const unsigned qw = isctx ? 0u : *(const unsigned*)(qraw + (size_t)row * 768 + h * 192 + 2 * (l16 + 16 * j));
            qx[2 * j] = __uint_as_float(qw << 16); qx[2 * j + 1] = __uint_as_float(qw & 0xffff0000u);
        }
        float sk = 0.f, sq = 0.f;
#pragma unroll
        for (int j = 0; j < 12; j++) { sk += kx[j] * kx[j]; sq += qx[j] * qx[j]; }
        sk = row16_allsum(sk); sq = row16_allsum(sq);
        const float rk = rsqrtf(sk * (1.f / 192.f) + 1e-6f), rq = rsqrtf(sq * (1.f / 192.f) + 1e-6f);
#pragma unroll
        for (int j = 0; j < 6; j++) {
            kx[2 * j] *= rk * knv[j].x; kx[2 * j + 1] *= rk * knv[j].y;
            qx[2 * j] *= rq * qnv[j].x; qx[2 * j + 1] *= rq * qnv[j].y;
        }
        if (sample && !isctx) {
#pragma unroll
            for (int j = 4; j < 6; j++) {
                const float ang = (j == 4 ? (float)(pos >> 6) : (float)(pos & 63)) * inv;
                const float cs = __cosf(ang), sn = __sinf(ang);
                const float a = kx[2 * j], bq = kx[2 * j + 1];
                kx[2 * j] = a * cs - bq * sn; kx[2 * j + 1] = a * sn + bq * cs;
                const float a2 = qx[2 * j], b2 = qx[2 * j + 1];
                qx[2 * j] = a2 * cs - b2 * sn; qx[2 * j + 1] = a2 * sn + b2 * cs;
            }
        }
        bf16_t* kd;
        if (!sample) { const int b = row >> 8, pp = row & 255; kd = Kp + ((size_t)(b * 4 + h) * LP + pp) * 192; }
        else if (!isctx) { const int b = (row - TP) >> 11, pp = (row - TP) & 2047; kd = Ks + ((size_t)(b * 4 + h) * 2304 + 256 + pp) * 192; }
        else { const int cr = row - TT; const int b = cr >> 8, pp = cr & 255; kd = Ks + ((size_t)(b * 4 + h) * 2304 + pp) * 192; }
#pragma unroll
        for (int j = 0; j < 6; j++) {
            const int e = 2 * (l16 + 16 * j);
            *(unsigned*)(kd + e) = (unsigned)f2bf(kx[2 * j]) | ((unsigned)f2bf(kx[2 * j + 1]) << 16);
            if (!isctx) *(unsigned*)(Qb + ((size_t)row * 4 + h) * 192 + e) = (unsigned)f2bf(qx[2 * j]) | ((unsigned)f2bf(qx[2 * j + 1]) << 16);
        }
    }
}

#define XB_TMO      128
#define XB_XCNT(j)  (256  + 64 * (j))
#define XB_XSUB(j)  (1280 + 64 * (j))
#define XB_XGEN(j)  (2304 + 64 * (j))
#define XB_TOP      3328
#define XB_TOPGEN   3392
#define XCD_BAR_WORDS 3456
#define XB_SPIN_CAP (1u << 22)
#define LAS __attribute__((address_space(3)))
__device__ __forceinline__ unsigned xb_ld(unsigned* p) { return __hip_atomic_load(p, __ATOMIC_RELAXED, __HIP_MEMORY_SCOPE_AGENT); }
__device__ __forceinline__ unsigned xb_add(unsigned* p, unsigned v) { return __hip_atomic_fetch_add(p, v, __ATOMIC_RELAXED, __HIP_MEMORY_SCOPE_AGENT); }
__device__ __forceinline__ unsigned xb_xcc_id() { return (unsigned)__builtin_amdgcn_s_getreg((3 << 11) | 20) & 0xFu; }
#define XB_SPIN(cond, bar) do { unsigned _sp = 0; while (cond) { __builtin_amdgcn_s_sleep(1); \
    if ((++_sp & 255u) == 0u) { if (xb_ld(&(bar)[XB_TMO])) break; if (_sp > XB_SPIN_CAP) { atomicAdd(&(bar)[XB_TMO], 1u); break; } } } } while (0)
struct XcdBarrier { unsigned* bar; unsigned x; volatile LAS unsigned* st; };
__device__ __forceinline__ XcdBarrier xcd_barrier_post(unsigned* bar, volatile LAS unsigned* st) {
    XcdBarrier b; b.bar = bar; b.x = xb_xcc_id(); b.st = st;
    if (threadIdx.x == 0) (void)xb_add(&bar[XB_XCNT(b.x)], 1u);
    return b;
}
__device__ __forceinline__ void xcd_barrier_complete(unsigned* bar, unsigned x, unsigned& nloc, unsigned& nx) {
    const unsigned G = gridDim.x * gridDim.y * gridDim.z;
    unsigned sum, cnt, mine, sp = 0u;
    for (;;) {
        sum = 0u; cnt = 0u; mine = 0u;
#pragma unroll
        for (unsigned j = 0; j < 16; ++j) { const unsigned c = xb_ld(&bar[XB_XCNT(j)]); sum += c; cnt += (c > 0u) ? 1u : 0u; mine = (j == x) ? c : mine; }
        if (sum == G) break;
        __builtin_amdgcn_s_sleep(1);
        if ((++sp & 255u) == 0u) { if (xb_ld(&bar[XB_TMO])) break; if (sp > XB_SPIN_CAP) { atomicAdd(&bar[XB_TMO], 1u); break; } }
    }
    nloc = mine > 0u ? mine : 1u; nx = cnt > 0u ? cnt : 1u;
}
__device__ __forceinline__ void xcd_barrier_(unsigned* bar_, char* smem_) {
    XcdBarrier b; b.bar = bar_; b.x = xb_xcc_id(); b.st = (volatile LAS unsigned*)(smem_ + GEMM_LDS_BYTES);
    asm volatile("s_waitcnt vmcnt(0)" ::: "memory");
    __syncthreads();
    if (threadIdx.x == 0) {
        unsigned* bar = b.bar;
        __builtin_amdgcn_s_waitcnt(0);
        unsigned nloc = b.st[0], nx = b.st[1];
        if (nloc == 0u) { xcd_barrier_complete(bar, b.x, nloc, nx); b.st[0] = nloc; b.st[1] = nx; }
        const unsigned old = xb_add(&bar[XB_XSUB(b.x)], 1u);
        const unsigned gen = old / nloc;
        if (old + 1u == (gen + 1u) * nloc) {
            __builtin_amdgcn_fence(__ATOMIC_RELEASE, "agent");
            asm volatile("s_waitcnt vmcnt(0)" ::: "memory");
            const unsigned og = xb_add(&bar[XB_TOP], 1u);
            const unsigned tg = og / nx;
            if (og + 1u == (tg + 1u) * nx) xb_add(&bar[XB_TOPGEN], 1u);
            else XB_SPIN(xb_ld(&bar[XB_TOPGEN]) == tg, bar);
            __builtin_amdgcn_fence(__ATOMIC_ACQUIRE, "agent");
            xb_add(&bar[XB_XGEN(b.x)], 1u);
            asm volatile("s_waitcnt vmcnt(0)" ::: "memory");
        } else {
            XB_SPIN(xb_ld(&bar[XB_XGEN(b.x)]) == gen, bar);
            __builtin_amdgcn_fence(__ATOMIC_ACQUIRE, "agent");
            asm volatile("s_waitcnt vmcnt(0)" ::: "memory");
        }
    }
    __syncthreads();
}

constexpr size_t ws_al(size_t x) { return (x + 255) & ~(size_t)255; }
struct WS {
    static constexpr size_t mod = 0;
    static constexpr size_t w_in_t = ws_al(mod + (size_t)(2*5*6144*4));
    static constexpr size_t w_out_t = ws_al(w_in_t + (size_t)(2304*1024*2));
    static constexpr size_t hy_w_in_t = ws_al(w_out_t + (size_t)(1024*1024*2));
    static constexpr size_t hy_w_out_t = ws_al(hy_w_in_t + (size_t)(3072*1024*2));
    static constexpr size_t w_q_t = ws_al(hy_w_out_t + (size_t)(1024*1024*2));
    static constexpr size_t q_up_t = ws_al(w_q_t + (size_t)(2*2048*1024*2));
    static constexpr size_t kv_up_t = ws_al(q_up_t + (size_t)(768*256*2));
    static constexpr size_t w2_t = ws_al(kv_up_t + (size_t)(1024*128*2));
    static constexpr size_t a2_t = ws_al(w2_t + (size_t)(2*512*64*2));
    static constexpr size_t g2_t = ws_al(a2_t + (size_t)(2*512*64*2));
    static constexpr size_t ctxb = ws_al(g2_t + (size_t)(512*128*2));
    static constexpr size_t keysb = ws_al(ctxb + (size_t)(1024*128*2));
    static constexpr size_t tabU = ws_al(keysb + (size_t)(2*16*128*128*2));
    static constexpr size_t tabV = ws_al(tabU + (size_t)(16384*1024));
    static constexpr size_t rsU = ws_al(tabV + (size_t)(16384*1024));
    static constexpr size_t rsV = ws_al(rsU + (size_t)(16384*4));
    static constexpr size_t nsum = ws_al(rsV + (size_t)(16384*4));
    static constexpr size_t gTS = ws_al(nsum + (size_t)(2*1024*4 + 3456*4 + 1024));
    static constexpr size_t gTP = ws_al(gTS + (size_t)1024*2*2048*2);
    static constexpr size_t R1 = ws_al(gTP + (size_t)1024*2*256*2);
    static constexpr size_t R2 = ws_al(R1 + (size_t)((size_t)TT*1024*4));
    static constexpr size_t rb = ws_al(R2 + (size_t)((size_t)TT*1792*2 + (size_t)TT*448*4));
    static constexpr size_t kb = ws_al(rb + (size_t)((size_t)TT*512*2));
    static constexpr size_t vb = ws_al(kb + (size_t)((size_t)TT*512*2));
    static constexpr size_t kkb = ws_al(vb + (size_t)((size_t)TT*512*2));
    static constexpr size_t lr0 = ws_al(kkb + (size_t)((size_t)TT*512*2));
    static constexpr size_t lr1 = ws_al(lr0 + (size_t)((size_t)TT*512*2));
    static constexpr size_t gateb = ws_al(lr1 + (size_t)((size_t)TT*512*2));
    static constexpr size_t du0 = ws_al(gateb + (size_t)((size_t)TT*512*2));
    static constexpr size_t du1 = ws_al(du0 + (size_t)((size_t)TT*512*2));
    static constexpr size_t twb = ws_al(du1 + (size_t)((size_t)TT*512*2));
    static constexpr size_t advb = ws_al(twb + (size_t)((size_t)TT*64*2));
    static constexpr size_t sgb = ws_al(advb + (size_t)((size_t)TT*64*2));
    static constexpr size_t bonus = ws_al(sgb + (size_t)((size_t)TT*128*2));
    static constexpr size_t kpe = ws_al(bonus + (size_t)((size_t)TT*8*4));
    static constexpr size_t qcnb = ws_al(kpe + (size_t)((size_t)TT*64*4));
    static constexpr size_t ckvb = ws_al(qcnb + (size_t)((size_t)TT*256*2));
    static constexpr size_t Qb = ws_al(ckvb + (size_t)((size_t)TT*128*2));
    static constexpr size_t Kp = ws_al(Qb + (size_t)((size_t)TT*768*2));
    static constexpr size_t Vp = ws_al(Kp + (size_t)(16*4*256*192*2));
    static constexpr size_t Ks = ws_al(Vp + (size_t)(16*4*256*128*2));
    static constexpr size_t Vs = ws_al(Ks + (size_t)(4*4*2304*192*2));
    static constexpr size_t kvctxb = ws_al(Vs + (size_t)(4*4*2304*128*2));
    static constexpr size_t pidx = ws_al(kvctxb + (size_t)(1024*1024*2));
    static constexpr size_t pg = ws_al(pidx + (size_t)((size_t)TT*128*4));
    static constexpr size_t END = ws_al(pg + (size_t)((size_t)TT*128*4));
    static constexpr size_t hb = R1;
    static constexpr size_t catb = R1;
    static constexpr size_t zbb = R1;
    static constexpr size_t kvrawb = R1;
    static constexpr size_t qrawb = R1 + (size_t)TT*1024*2;
    static constexpr size_t projrw = R2;
    static constexpr size_t projmla = R2 + (size_t)TT*1792*2;
    static constexpr size_t y0 = R2;
    static constexpr size_t y1 = R2 + (size_t)TT*512*4;
    static constexpr size_t qb = R2;
    static constexpr size_t scT = rb;
    static constexpr size_t pre = R2;
    static constexpr size_t zT = R2 + (size_t)TT*3072*2;
    static constexpr size_t x0b = R2 + (size_t)TT*3072*2 + (size_t)TT*1024*2;
    static constexpr size_t yT = R2 + (size_t)TT*3072*2 + (size_t)TT*1024*4;
    static constexpr size_t bar = nsum + 2*1024*4;
};
struct Params {
    const float* in[46];
    float* out;
    char* ws;
    __device__ __forceinline__ const float* x_prompt() const { return in[0]; }
    __device__ __forceinline__ const float* x_sample() const { return in[1]; }
    __device__ __forceinline__ const float* st_f() const { return in[2]; }
    __device__ __forceinline__ const float* st_b() const { return in[3]; }
    __device__ __forceinline__ const float* cache_ckv() const { return in[4]; }
    __device__ __forceinline__ const float* cache_kpe() const { return in[5]; }
    __device__ __forceinline__ const float* c() const { return in[6]; }
    __device__ __forceinline__ const float* c_ctx() const { return in[7]; }
    __device__ __forceinline__ const float* norm_g() const { return in[8]; }
    __device__ __forceinline__ const float* w_mod() const { return in[9]; }
    __device__ __forceinline__ const float* b_mod() const { return in[10]; }
    __device__ __forceinline__ const float* ab_w_in() const { return in[11]; }
    __device__ __forceinline__ const float* rw_mu() const { return in[12]; }
    __device__ __forceinline__ const float* rw_w0() const { return in[13]; }
    __device__ __forceinline__ const float* rw_w2() const { return in[14]; }
    __device__ __forceinline__ const float* rw_a0() const { return in[15]; }
    __device__ __forceinline__ const float* rw_a2() const { return in[16]; }
    __device__ __forceinline__ const float* rw_g2() const { return in[17]; }
    __device__ __forceinline__ const float* rw_k_k() const { return in[18]; }
    __device__ __forceinline__ const float* rw_k_a() const { return in[19]; }
    __device__ __forceinline__ const float* rw_r_k() const { return in[20]; }
    __device__ __forceinline__ const float* rw_lnx_g() const { return in[21]; }
    __device__ __forceinline__ const float* rw_lnx_b() const { return in[22]; }
    __device__ __forceinline__ const float* mla_q_norm() const { return in[23]; }
    __device__ __forceinline__ const float* mla_q_up() const { return in[24]; }
    __device__ __forceinline__ const float* mla_kv_norm() const { return in[25]; }
    __device__ __forceinline__ const float* mla_kv_up() const { return in[26]; }
    __device__ __forceinline__ const float* mla_qn() const { return in[27]; }
    __device__ __forceinline__ const float* mla_kn() const { return in[28]; }
    __device__ __forceinline__ const float* ab_w_out() const { return in[29]; }
    __device__ __forceinline__ const float* hy_w_in() const { return in[30]; }
    __device__ __forceinline__ const float* hy_b_in() const { return in[31]; }
    __device__ __forceinline__ const float* hy_conv_w() const { return in[32]; }
    __device__ __forceinline__ const float* hy_conv_b() const { return in[33]; }
    __device__ __forceinline__ const float* hy_f_w1() const { return in[34]; }
    __device__ __forceinline__ const float* hy_f_b1() const { return in[35]; }
    __device__ __forceinline__ const float* hy_f_w2() const { return in[36]; }
    __device__ __forceinline__ const float* hy_f_b2() const { return in[37]; }
    __device__ __forceinline__ const float* hy_f_w3() const { return in[38]; }
    __device__ __forceinline__ const float* hy_f_freq() const { return in[39]; }
    __device__ __forceinline__ const float* hy_bias() const { return in[40]; }
    __device__ __forceinline__ const float* hy_w_out() const { return in[41]; }
    __device__ __forceinline__ const float* peer_w_q() const { return in[42]; }
    __device__ __forceinline__ const float* peer_keys() const { return in[43]; }
    __device__ __forceinline__ const float* peer_u() const { return in[44]; }
    __device__ __forceinline__ const float* peer_v() const { return in[45]; }
    __device__ __forceinline__ float* xrun() const { return out + (0); }
    __device__ __forceinline__ float* out_sf() const { return out + ((size_t)TT*DM); }
    __device__ __forceinline__ float* out_sb() const { return out + ((size_t)TT*DM + 16*8*64*64); }
    __device__ __forceinline__ float* out_ckv() const { return out + ((size_t)TT*DM + 2*16*8*64*64); }
    __device__ __forceinline__ float* out_kpe() const { return out + ((size_t)TT*DM + 2*16*8*64*64 + 16*256*128); }
    __device__ __forceinline__ float* mod() const { return (float*)(ws + WS::mod); }
    __device__ __forceinline__ bf16_t* w_in_t() const { return (bf16_t*)(ws + WS::w_in_t); }
    __device__ __forceinline__ bf16_t* w_out_t() const { return (bf16_t*)(ws + WS::w_out_t); }
    __device__ __forceinline__ bf16_t* hy_w_in_t() const { return (bf16_t*)(ws + WS::hy_w_in_t); }
    __device__ __forceinline__ bf16_t* hy_w_out_t() const { return (bf16_t*)(ws + WS::hy_w_out_t); }
    __device__ __forceinline__ bf16_t* w_q_t() const { return (bf16_t*)(ws + WS::w_q_t); }
    __device__ __forceinline__ bf16_t* q_up_t() const { return (bf16_t*)(ws + WS::q_up_t); }
    __device__ __forceinline__ bf16_t* kv_up_t() const { return (bf16_t*)(ws + WS::kv_up_t); }
    __device__ __forceinline__ bf16_t* w2_t() const { return (bf16_t*)(ws + WS::w2_t); }
    __device__ __forceinline__ bf16_t* a2_t() const { return (bf16_t*)(ws + WS::a2_t); }
    __device__ __forceinline__ bf16_t* g2_t() const { return (bf16_t*)(ws + WS::g2_t); }
    __device__ __forceinline__ bf16_t* ctxb() const { return (bf16_t*)(ws + WS::ctxb); }
    __device__ __forceinline__ bf16_t* keysb() const { return (bf16_t*)(ws + WS::keysb); }
    __device__ __forceinline__ unsigned char* tabU() const { return (unsigned char*)(ws + WS::tabU); }
    __device__ __forceinline__ float* rsU() const { return (float*)(ws + WS::rsU); }
    __device__ __forceinline__ float* rsV() const { return (float*)(ws + WS::rsV); }
    __device__ __forceinline__ unsigned char* tabV() const { return (unsigned char*)(ws + WS::tabV); }
    __device__ __forceinline__ float* nsum() const { return (float*)(ws + WS::nsum); }
    __device__ __forceinline__ bf16_t* rb() const { return (bf16_t*)(ws + WS::rb); }
    __device__ __forceinline__ bf16_t* kb() const { return (bf16_t*)(ws + WS::kb); }
    __device__ __forceinline__ bf16_t* vb() const { return (bf16_t*)(ws + WS::vb); }
    __device__ __forceinline__ bf16_t* kkb() const { return (bf16_t*)(ws + WS::kkb); }
    __device__ __forceinline__ bf16_t* lr0() const { return (bf16_t*)(ws + WS::lr0); }
    __device__ __forceinline__ bf16_t* lr1() const { return (bf16_t*)(ws + WS::lr1); }
    __device__ __forceinline__ bf16_t* gateb() const { return (bf16_t*)(ws + WS::gateb); }
    __device__ __forceinline__ _Float16* du0() const { return (_Float16*)(ws + WS::du0); }
    __device__ __forceinline__ _Float16* du1() const { return (_Float16*)(ws + WS::du1); }
    __device__ __forceinline__ bf16_t* twb() const { return (bf16_t*)(ws + WS::twb); }
    __device__ __forceinline__ bf16_t* advb() const { return (bf16_t*)(ws + WS::advb); }
    __device__ __forceinline__ bf16_t* sgb() const { return (bf16_t*)(ws + WS::sgb); }
    __device__ __forceinline__ float* bonus() const { return (float*)(ws + WS::bonus); }
    __device__ __forceinline__ float* kpe() const { return (float*)(ws + WS::kpe); }
    __device__ __forceinline__ bf16_t* qcnb() const { return (bf16_t*)(ws + WS::qcnb); }
    __device__ __forceinline__ bf16_t* ckvb() const { return (bf16_t*)(ws + WS::ckvb); }
    __device__ __forceinline__ bf16_t* Qb() const { return (bf16_t*)(ws + WS::Qb); }
    __device__ __forceinline__ bf16_t* Kp() const { return (bf16_t*)(ws + WS::Kp); }
    __device__ __forceinline__ bf16_t* Vp() const { return (bf16_t*)(ws + WS::Vp); }
    __device__ __forceinline__ bf16_t* Ks() const { return (bf16_t*)(ws + WS::Ks); }
    __device__ __forceinline__ bf16_t* Vs() const { return (bf16_t*)(ws + WS::Vs); }
    __device__ __forceinline__ bf16_t* kvctxb() const { return (bf16_t*)(ws + WS::kvctxb); }
    __device__ __forceinline__ int* pidx() const { return (int*)(ws + WS::pidx); }
    __device__ __forceinline__ float* pg() const { return (float*)(ws + WS::pg); }
    __device__ __forceinline__ bf16_t* hb() const { return (bf16_t*)(ws + WS::hb); }
    __device__ __forceinline__ bf16_t* catb() const { return (bf16_t*)(ws + WS::catb); }
    __device__ __forceinline__ bf16_t* zbb() const { return (bf16_t*)(ws + WS::zbb); }
    __device__ __forceinline__ bf16_t* kvrawb() const { return (bf16_t*)(ws + WS::kvrawb); }
    __device__ __forceinline__ bf16_t* qrawb() const { return (bf16_t*)(ws + WS::qrawb); }
    __device__ __forceinline__ bf16_t* projrw() const { return (bf16_t*)(ws + WS::projrw); }
    __device__ __forceinline__ float* projmla() const { return (float*)(ws + WS::projmla); }
    __device__ __forceinline__ float* y0() const { return (float*)(ws + WS::y0); }
    __device__ __forceinline__ float* y1() const { return (float*)(ws + WS::y1); }
    __device__ __forceinline__ bf16_t* qb() const { return (bf16_t*)(ws + WS::qb); }
    __device__ __forceinline__ float* scT() const { return (float*)(ws + WS::scT); }
    __device__ __forceinline__ bf16_t* pre() const { return (bf16_t*)(ws + WS::pre); }
    __device__ __forceinline__ bf16_t* zT() const { return (bf16_t*)(ws + WS::zT); }
    __device__ __forceinline__ bf16_t* x0b() const { return (bf16_t*)(ws + WS::x0b); }
    __device__ __forceinline__ bf16_t* yT() const { return (bf16_t*)(ws + WS::yT); }
    __device__ __forceinline__ bf16_t* gTS() const { return (bf16_t*)(ws + WS::gTS); }
    __device__ __forceinline__ bf16_t* gTP() const { return (bf16_t*)(ws + WS::gTP); }
    __device__ __forceinline__ unsigned* bar() const { return (unsigned*)(ws + WS::bar); }
};

#define VLOOP(n) for (int vb = blockIdx.x; vb < (n); vb += gridDim.x)
#define ENDV __syncthreads();

#define QLOOP(ctr_word, nitems, ...)                                                            \
    {                                                                                           \
        unsigned* qctr = p.bar() + XCD_BAR_WORDS + 128 + (ctr_word);                            \
        volatile unsigned* bc = (volatile unsigned*)(smem + GEMM_LDS_BYTES + 8);                \
        for (;;) {                                                                              \
            if (threadIdx.x == 0) *bc = atomicAdd(qctr, 1u);                                    \
            __syncthreads();                                                                    \
            const int item = (int)*bc;                                                          \
            __syncthreads();                                                                    \
            if (item >= (nitems)) break;                                                        \
            __VA_ARGS__                                                                         \
        }                                                                                       \
    }
__device__ __forceinline__ void peer_layer(const Params& p, char* smem, int li, const float* modl, float* xrs) {
    const bf16_t* wq = p.w_q_t() + (size_t)li * 2048 * 1024;
    const bf16_t* kys = p.keysb() + (size_t)li * 16 * 128 * 128;
    VLOOP(TT / 8) { d_norm_mod2(vb, p.xrun(), xrs, p.norm_g() + (li * 2 + 1) * 1024, modl, 3, 4, p.hb()); }
    xcd_barrier_(p.bar(), smem);
    VLOOP(16 * 96) { d_gemm_bf16(vb % 16, vb / 16, smem, p.hb(), 1024, wq, 1024, 1024, 2048, EpiStoreBf{p.qb(), 2048, 0}); }
    xcd_barrier_(p.bar(), smem);
    VLOOP(8 * 96) { d_peer_route2(vb, smem, kys, p.qb(), p.pidx(), p.pg()); ENDV }
    if (li == 0) {
        QLOOP(4, 1536, {
            const int t1 = 48 * 16, t2 = t1 + 16 * 16;
            const float* W; bf16_t* Wt; int N, lv;
            if (item < t1) { W = p.hy_w_in(); Wt = p.hy_w_in_t(); N = 3072; lv = item; }
            else if (item < t2) { W = p.hy_w_out(); Wt = p.hy_w_out_t(); N = 1024; lv = item - t1; }
            else { W = p.peer_w_q() + (size_t)1024 * 2048; Wt = p.w_q_t() + (size_t)2048 * 1024; N = 2048; lv = item - t2; }
            d_transpose_w(lv, smem, W, 1024, N, Wt);
        })
    }
    xcd_barrier_(p.bar(), smem);
    VLOOP(TT / 4) { d_peer_apply3(vb, smem, p.hb(), p.pidx(), p.pg(), p.tabU(), p.tabV(), p.rsU(), p.rsV(), modl, p.xrun(),
                                    li == 0 ? p.norm_g() + 2048 : nullptr, p.mod() + 5 * 6144, p.hb()); ENDV }
}

__global__ void __launch_bounds__(256, 2) mega(Params p) {
    __shared__ __attribute__((aligned(16))) char smem[GEMM_LDS_BYTES + 16];
    cg::grid_group grid = cg::this_grid();
    if (threadIdx.x < 4) ((unsigned*)(smem + GEMM_LDS_BYTES))[threadIdx.x] = 0u;
    __syncthreads();
    (void)xcd_barrier_post(p.bar(), (volatile LAS unsigned*)(smem + GEMM_LDS_BYTES));
    const float* mod0 = p.mod();
    const float* mod1 = p.mod() + 5 * 6144;
    float* xrs = p.xrun() + (size_t)TP * DM;

    VLOOP(192) { d_mod3(vb, smem, p.c(), p.c_ctx(), p.w_mod(), p.b_mod(), p.mod()); ENDV }
    if (p.ws == nullptr) grid.sync();
    xcd_barrier_(p.bar(), smem);
    VLOOP(TT / 8) { d_norm_mod2(vb, p.x_prompt(), p.x_sample(), p.norm_g(), mod0, 0, 1, p.hb()); }
    {
        const int j1 = 36 * 16;
        const int j7 = j1 + 12 * 4;
        const int j8 = j7 + 16 * 2;
        const int j9 = j8 + 8;
        const int j10 = j9 + 8;
        const int j11 = j10 + 8;
        const int j12 = j11 + 8;
        const int j13 = j12 + 8 * 2;
        VLOOP(j13) {
            const float* W; bf16_t* Wt; int K, N, lv;
            if (vb < j1) { W = p.ab_w_in(); Wt = p.w_in_t(); K = 1024; N = 2240; lv = vb; }
            else if (vb < j7) { W = p.mla_q_up(); Wt = p.q_up_t(); K = 256; N = 768; lv = vb - j1; }
            else if (vb < j8) { W = p.mla_kv_up(); Wt = p.kv_up_t(); K = 128; N = 1024; lv = vb - j7; }
            else if (vb < j9) { W = p.rw_w2(); Wt = p.w2_t(); K = 64; N = 512; lv = vb - j8; }
            else if (vb < j10) { W = p.rw_w2() + 64 * 512; Wt = p.w2_t() + 512 * 64; K = 64; N = 512; lv = vb - j9; }
            else if (vb < j11) { W = p.rw_a2(); Wt = p.a2_t(); K = 64; N = 512; lv = vb - j10; }
            else if (vb < j12) { W = p.rw_a2() + 64 * 512; Wt = p.a2_t() + 512 * 64; K = 64; N = 512; lv = vb - j11; }
            else { W = p.rw_g2(); Wt = p.g2_t(); K = 128; N = 512; lv = vb - j12; }
            d_transpose_w(lv, smem, W, K, N, Wt);
            ENDV }
    }
    VLOOP(40) { if (vb < 8) d_cvt_bf16(vb, p.cache_ckv(), p.ctxb()); else d_cvt_bf16(vb - 8, p.peer_keys(), p.keysb()); }
    xcd_barrier_(p.bar(), smem);
    VLOOP(18 * 96) { d_gemm_bf16(vb % 18, vb / 18, smem, p.hb(), 1024, p.w_in_t(), 1024, 1024, ABIN, EpiProj{p.projrw(), p.projmla()}); }
    xcd_barrier_(p.bar(), smem);
    VLOOP(2688 + 768) {
        if (vb < 2688) d_rw_shift2(vb, p.projrw(), p.rw_mu(), p.rb(), p.kb(), p.vb(), p.twb(), p.advb(), p.sgb());
        else d_mla_pre2(vb - 2688, p.projmla(), p.mla_q_norm(), p.mla_kv_norm(), p.qcnb(), p.ckvb(), p.kpe(), p.out_ckv(), p.out_kpe());
    }
    xcd_barrier_(p.bar(), smem);
    {
        const int n0 = 4 * 96, n1 = 6 * 96, n2 = 8 * 96, n3 = 8 * 8;
        VLOOP(5 * n0 + n1 + n2 + n3) {
            int v = vb;
            if (v < n0) d_gemm_bf16(v % 4, v / 4, smem, p.twb(), 64, p.w2_t(), 64, 64, 512, EpiDecay{p.du0(), p.rw_w0()});
            else if ((v -= n0) < n0) d_gemm_bf16(v % 4, v / 4, smem, p.twb(), 64, p.w2_t() + 512 * 64, 64, 64, 512, EpiDecay{p.du1(), p.rw_w0() + 512});
            else if ((v -= n0) < n0) d_gemm_bf16(v % 4, v / 4, smem, p.advb(), 64, p.a2_t(), 64, 64, 512, EpiLr{p.lr0(), p.rw_a0()});
            else if ((v -= n0) < n0) d_gemm_bf16(v % 4, v / 4, smem, p.advb(), 64, p.a2_t() + 512 * 64, 64, 64, 512, EpiLr{p.lr1(), p.rw_a0() + 512});
            else if ((v -= n0) < n0) d_gemm_bf16(v % 4, v / 4, smem, p.sgb(), 128, p.g2_t(), 128, 128, 512, EpiStoreBf{p.gateb(), 512, 0});
            else if ((v -= n0) < n1) d_gemm_bf16(v % 6, v / 6, smem, p.qcnb(), 256, p.q_up_t(), 256, 256, 768, EpiStoreBf{p.qrawb(), 768, 0});
            else if ((v -= n1) < n2) d_gemm_bf16(v % 8, v / 8, smem, p.ckvb(), 128, p.kv_up_t(), 128, 128, 1024, EpiKV{p.kvrawb(), p.Vp(), p.Vs(), 0, 0});
            else { v -= n2; d_gemm_bf16(v % 8, v / 8, smem, p.ctxb(), 128, p.kv_up_t(), 128, 128, 1024, EpiKV{p.kvctxb(), p.Vp(), p.Vs(), 1, 0}); }
        }
    }
    xcd_barrier_(p.bar(), smem);
    VLOOP(1536 + 832) {
        if (vb < 1536) d_rw_kk3(vb, p.rb(), p.kb(), p.lr0(), p.lr1(), p.rw_k_k(), p.rw_k_a(), p.rw_r_k(), p.kkb(), p.bonus());
        else d_mla_post3(vb - 1536, p.qrawb(), p.kvrawb(), p.kvctxb(), p.kpe(), p.cache_kpe(), p.mla_qn(), p.mla_kn(), p.Qb(), p.Kp(), p.Ks());
        ENDV }
    xcd_barrier_(p.bar(), smem);
    QLOOP(7, 320, {
        const bool smp = item < 64;
        if (smp) __builtin_amdgcn_s_setprio(3);
        d_scan3(smp ? item : item - 64, smp, smem, p.rb(), p.kb(), p.vb(), p.kkb(), p.lr0(), p.lr1(), p.du0(), p.du1(), p.rw_k_a(), p.st_f(), p.st_b(), p.y0(), p.y1(), p.out_sf(), p.out_sb());
        __builtin_amdgcn_s_setprio(0);
    })
    QLOOP(0, 384, {
        const bool smp = item < 256;
        d_attn_mfma(smp ? item : item - 256, smem, p.Qb(), smp ? p.Ks() : p.Kp(), smp ? p.Vs() : p.Vp(), p.catb(), smp ? TP : 0, smp ? LS : LP,
                    smp ? 2304 : LP, smp ? 16 : 2);
    })
    QLOOP(2, 2048, {
        const bool isv = item >= 1024;
        d_cvt_fp8_rows(isv ? item - 1024 : item, isv ? p.peer_v() : p.peer_u(), isv ? p.tabV() : p.tabU(), isv ? p.rsV() : p.rsU());
    })
    QLOOP(3, 768, {
        const bool a_ = item < 256;
        d_transpose_w(a_ ? item : item - 256, smem, a_ ? p.ab_w_out() : p.peer_w_q(), 1024, a_ ? 1024 : 2048, a_ ? p.w_out_t() : p.w_q_t());
    })
    xcd_barrier_(p.bar(), smem);
    VLOOP(1536) { d_rw_post3(vb, p.y0(), p.y1(), p.bonus(), p.vb(), p.gateb(), p.rw_lnx_g(), p.rw_lnx_b(), p.catb()); }
    QLOOP(1, 576, {
        const bool smp = item < 512;
        d_hy_filt2(smp ? item : item - 512, smem, smp ? LS : LP, p.hy_f_w1(), p.hy_f_b1(), p.hy_f_w2(), p.hy_f_b2(), p.hy_f_w3(), p.hy_f_freq(),
                   smp ? p.gTS() : p.gTP(), smp ? p.nsum() : p.nsum() + 1024);
    })
    xcd_barrier_(p.bar(), smem);
    QLOOP(5, 480 + 576, {
        if (item < 480) d_gemm_bf16n<2>(item % 5, item / 5, smem, p.catb(), 1024, p.w_out_t(), 1024, 1024, 1024, EpiResid{p.x_prompt(), p.x_sample(), p.xrun(), mod0, 2, 0});
        else { const int it = item - 480; d_gemm_bf16n<1>(10 + it % 6, it / 6, smem, p.catb(), 1024, p.w_out_t(), 1024, 1024, 1024, EpiResid{p.x_prompt(), p.x_sample(), p.xrun(), mod0, 2, 0}); }
    })
    xcd_barrier_(p.bar(), smem);
    peer_layer(p, smem, 0, mod0, xrs);
    xcd_barrier_(p.bar(), smem);
    VLOOP(24 * 96) { d_gemm_bf16(vb % 24, vb / 24, smem, p.hb(), 1024, p.hy_w_in_t(), 1024, 1024, 3072, EpiStoreBfBias{p.pre(), p.hy_b_in(), 3072, 0}); }
    VLOOP(2048) {
        const bool isv = vb >= 1024;
        d_cvt_fp8_rows(isv ? vb - 1024 : vb, (isv ? p.peer_v() : p.peer_u()) + (size_t)16384 * 1024, isv ? p.tabV() : p.tabU(), isv ? p.rsV() : p.rsU());
    }
    xcd_barrier_(p.bar(), smem);
    VLOOP(192 * 8) { d_hy_dw3(vb, smem, p.pre(), p.hy_conv_w(), p.hy_conv_b(), p.zT(), p.x0b()); ENDV }
    xcd_barrier_(p.bar(), smem);
    VLOOP(512 + 512) {
        const int wv = threadIdx.x >> 6;
        char* wsm = smem + (wv >> 1) * 28672;
        if (vb < 512) d_hy_conv2<true>(vb * 2 + (wv >> 1), wv & 1, wsm, p.gTS(), p.nsum(), p.zT(), p.hy_bias(), p.yT());
        else d_hy_conv2<false>((vb - 512) * 2 + (wv >> 1), wv & 1, wsm, p.gTP(), p.nsum() + 1024, p.zT(), p.hy_bias(), p.yT());
        ENDV }
    xcd_barrier_(p.bar(), smem);
    VLOOP(192 * 8) { d_hy_post2(vb, smem, p.yT(), p.x0b(), p.zbb()); ENDV }
    xcd_barrier_(p.bar(), smem);
    QLOOP(6, 480 + 576, {
        if (item < 480) d_gemm_bf16n<2>(item % 5, item / 5, smem, p.zbb(), 1024, p.hy_w_out_t(), 1024, 1024, 1024, EpiResid{p.xrun(), xrs, p.xrun(), mod1, 2, 0});
        else { const int it = item - 480; d_gemm_bf16n<1>(10 + it % 6, it / 6, smem, p.zbb(), 1024, p.hy_w_out_t(), 1024, 1024, 1024, EpiResid{p.xrun(), xrs, p.xrun(), mod1, 2, 0}); }
    })
    xcd_barrier_(p.bar(), smem);
    peer_layer(p, smem, 1, mod1, xrs);
}

static inline size_t align_up(size_t x) { return (x + 255) & ~(size_t)255; }

extern "C" void kernel_launch(void* const* d_in, const int* in_sizes, int n_in, void* d_out, int out_size, void* d_ws, size_t ws_size,
                              hipStream_t stream) {
    Params p{};
    for (int i = 0; i < 46; i++) p.in[i] = (const float*)d_in[i];
    p.out = (float*)d_out;
    p.ws = (char*)d_ws;
    static_assert(WS::END <= (size_t)422781952, "workspace plan exceeds the guaranteed scratch size");
    static int grid_blocks = 0;
    if (!grid_blocks) {
        int dev = 0, cus = 0, per_cu = 0;
        (void)hipGetDevice(&dev);
        (void)hipDeviceGetAttribute(&cus, hipDeviceAttributeMultiprocessorCount, dev);
        (void)hipOccupancyMaxActiveBlocksPerMultiprocessor(&per_cu, mega, 256, 0);
        if (per_cu > 2) per_cu = 2;
        if (per_cu < 1) per_cu = 1;
        grid_blocks = cus * per_cu;
    }
    (void)hipMemsetAsync(p.ws + WS::nsum, 0, (size_t)2 * 1024 * 4 + (size_t)XCD_BAR_WORDS * 4 + 1024, stream);
    (void)hipMemsetAsync(p.ws + WS::mod, 0, (size_t)2 * 5 * 6144 * 4, stream);
    void* args[] = {&p};
    (void)hipLaunchCooperativeKernel((void*)mega, dim3(grid_blocks), dim3(256), args, 0, stream);
}
```

```cpp
#include <hip/hip_runtime.h>
#include <stdint.h>
#include <hip/hip_cooperative_groups.h>
namespace cg = cooperative_groups;

#define DM 1024
#define TP 4096
#define TS 8192
#define TT 12288
#define LP 256
#define LS 2048
#define NBP 16
#define NBS 4
#define ABIN 2240
#define RWIN 1792

typedef unsigned short bf16_t;
__device__ __forceinline__ bf16_t f2bf(float f) { unsigned u = __float_as_uint(f); u += 0x7fffu + ((u >> 16) & 1u); return (bf16_t)(u >> 16); }
__device__ __forceinline__ float bf2f(bf16_t h) { return __uint_as_float(((unsigned)h) << 16); }
__device__ __forceinline__ float sigmoidf_(float x) { return 1.f / (1.f + expf(-x)); }
__device__ __forceinline__ float gelu_tanh(float x) { return 0.5f * x * (1.f + tanhf(0.7978845608028654f * (x + 0.044715f * x * x * x))); }

__device__ __forceinline__ int tok_pos(int t) { return t < TP ? (t & (LP - 1)) : ((t - TP) & (LS - 1)); }
__device__ __forceinline__ int tok_len(int t) { return t < TP ? LP : LS; }
__device__ __forceinline__ int tok_modrow(int t) { return t < TP ? 0 : 1 + ((t - TP) >> 11); }

__device__ __forceinline__ float wave_sum(float v) {
#pragma unroll
    for (int o = 32; o > 0; o >>= 1) v += __shfl_xor(v, o, 64);
    return v;
}


__device__ __forceinline__ void d_mod3(const int vb, char* smem, const float* __restrict__ c, const float* __restrict__ c_ctx,
                                       const float* __restrict__ w_mod, const float* __restrict__ b_mod, float* __restrict__ mod) {
    float* sl = (float*)smem;
    const int li = vb / 96, kc = (vb % 96) / 6, cg6 = vb % 6;
    const int tid = threadIdx.x;
    for (int i = tid; i < 5 * 64; i += 256) {
        const int r = i >> 6, k = kc * 64 + (i & 63);
        const float v = (r == 0) ? c_ctx[k] : c[(r - 1) * 1024 + k];
        sl[i] = v / (1.f + __expf(-v));
    }
    __syncthreads();
    const int n = cg6 * 1024 + tid * 4;
    float4 a0 = {0, 0, 0, 0}, a1 = a0, a2 = a0, a3 = a0, a4 = a0;
    const float* w = w_mod + ((size_t)li * 1024 + kc * 64) * 6144 + n;
#pragma unroll 16
    for (int k = 0; k < 64; k++) {
        const float4 wv = *(const float4*)(w + (size_t)k * 6144);
        const float s0 = sl[k], s1 = sl[64 + k], s2 = sl[128 + k], s3 = sl[192 + k], s4 = sl[256 + k];
        a0.x += s0 * wv.x; a0.y += s0 * wv.y; a0.z += s0 * wv.z; a0.w += s0 * wv.w;
        a1.x += s1 * wv.x; a1.y += s1 * wv.y; a1.z += s1 * wv.z; a1.w += s1 * wv.w;
        a2.x += s2 * wv.x; a2.y += s2 * wv.y; a2.z += s2 * wv.z; a2.w += s2 * wv.w;
        a3.x += s3 * wv.x; a3.y += s3 * wv.y; a3.z += s3 * wv.z; a3.w += s3 * wv.w;
        a4.x += s4 * wv.x; a4.y += s4 * wv.y; a4.z += s4 * wv.z; a4.w += s4 * wv.w;
    }
    if (kc == 0) {
        const float4 bb = *(const float4*)(b_mod + li * 6144 + n);
        a0.x += bb.x; a0.y += bb.y; a0.z += bb.z; a0.w += bb.w; a1.x += bb.x; a1.y += bb.y; a1.z += bb.z; a1.w += bb.w;
        a2.x += bb.x; a2.y += bb.y; a2.z += bb.z; a2.w += bb.w; a3.x += bb.x; a3.y += bb.y; a3.z += bb.z; a3.w += bb.w;
        a4.x += bb.x; a4.y += bb.y; a4.z += bb.z; a4.w += bb.w;
    }
    float* o = mod + (size_t)(li * 5) * 6144 + n;
    atomicAdd(o + 0, a0.x); atomicAdd(o + 1, a0.y); atomicAdd(o + 2, a0.z); atomicAdd(o + 3, a0.w);
    atomicAdd(o + 6144 + 0, a1.x); atomicAdd(o + 6144 + 1, a1.y); atomicAdd(o + 6144 + 2, a1.z); atomicAdd(o + 6144 + 3, a1.w);
    atomicAdd(o + 2 * 6144 + 0, a2.x); atomicAdd(o + 2 * 6144 + 1, a2.y); atomicAdd(o + 2 * 6144 + 2, a2.z); atomicAdd(o + 2 * 6144 + 3, a2.w);
    atomicAdd(o + 3 * 6144 + 0, a3.x); atomicAdd(o + 3 * 6144 + 1, a3.y); atomicAdd(o + 3 * 6144 + 2, a3.z); atomicAdd(o + 3 * 6144 + 3, a3.w);
    atomicAdd(o + 4 * 6144 + 0, a4.x); atomicAdd(o + 4 * 6144 + 1, a4.y); atomicAdd(o + 4 * 6144 + 2, a4.z); atomicAdd(o + 4 * 6144 + 3, a4.w);
}


struct EpiStore { static constexpr bool kQuad = false; float* C; const float* bias; int ldc; int pad;
    __device__ void operator()(int m, int n, float a) const { C[(size_t)m * ldc + n] = a + (bias ? bias[n] : 0.f); } };
struct EpiStoreBfBias { static constexpr bool kQuad = false; bf16_t* C; const float* bias; int ldc; int pad;
    __device__ void operator()(int m, int n, float a) const { C[(size_t)m * ldc + n] = f2bf(a + bias[n]); } };
struct EpiStoreBf { static constexpr bool kQuad = false; bf16_t* C; int ldc; int pad;
    __device__ void operator()(int m, int n, float a) const { C[(size_t)m * ldc + n] = f2bf(a); } };
struct EpiDecay { static constexpr bool kQuad = false; _Float16* out; const float* w0;
    __device__ void operator()(int m, int n, float a) const { out[(size_t)m * 512 + n] = (_Float16)sigmoidf_(w0[n] + a); } };
struct EpiProj { static constexpr bool kQuad = false; bf16_t* rw; float* mla;
    __device__ void operator()(int m, int n, float a) const { if (n < RWIN) rw[(size_t)m * RWIN + n] = f2bf(a); else mla[(size_t)m * 448 + (n - RWIN)] = a; } };
struct EpiLr { static constexpr bool kQuad = false; bf16_t* out; const float* a0;
    __device__ void operator()(int m, int n, float a) const { out[(size_t)m * 512 + n] = f2bf(sigmoidf_(a0[n] + a)); } };
struct EpiResid { static constexpr bool kQuad = false; const float* xa; const float* xb; float* out; const float* modl; int gate_idx; int pad;
    __device__ void operator()(int m, int n, float a) const {
        float x = (m < TP) ? xa[(size_t)m * DM + n] : xb[(size_t)(m - TP) * DM + n];
        float gt = modl[(size_t)tok_modrow(m) * 6144 + gate_idx * 1024 + n];
        out[(size_t)m * DM + n] = x + gt * a; } };

struct EpiKV { static constexpr bool kQuad = true;
    bf16_t* kvraw; bf16_t* Vp; bf16_t* Vs; int ctx; int pad;
    __device__ void operator()(int m, int n, float a) const {}
    __device__ void quad(int row0, int col, float v0, float v1, float v2, float v3) const {
        const int hd = col >> 8, within = col & 255;
        if (within < 128) {
            bf16_t* d = kvraw + (size_t)row0 * 1024 + col;
            d[0] = f2bf(v0); d[1024] = f2bf(v1); d[2048] = f2bf(v2); d[3072] = f2bf(v3);
        } else {
            const int dv = within - 128;
            int b, kidx, Lk; bf16_t* base;
            if (ctx) { b = row0 >> 8; kidx = row0 & 255; Lk = 2304; base = Vs; }
            else if (row0 < TP) { b = row0 >> 8; kidx = row0 & 255; Lk = LP; base = Vp; }
            else { b = (row0 - TP) >> 11; kidx = 256 + ((row0 - TP) & 2047); Lk = 2304; base = Vs; }
            const int kpos = (kidx & ~12) | ((kidx & 8) >> 1) | ((kidx & 4) << 1);
            ushort4 o; o.x = f2bf(v0); o.y = f2bf(v1); o.z = f2bf(v2); o.w = f2bf(v3);
            *(ushort4*)(base + ((size_t)((b * 4 + hd) * 128 + dv)) * Lk + kpos) = o;
        }
    } };


typedef __attribute__((ext_vector_type(8))) short bf16x8;
typedef __attribute__((ext_vector_type(16))) float f32x16;
typedef __attribute__((ext_vector_type(4))) float f32x4;
typedef __attribute__((ext_vector_type(4))) unsigned u32x4;
#define GEMM_LDS_BYTES 73728

template <int NJ, class Epi>
__device__ __forceinline__ void d_gemm_bf16n(const int bx, const int by, char* smem, const bf16_t* __restrict__ A, int lda,
                                             const bf16_t* __restrict__ Bt, int ldb, int K, int N, Epi epi) {
    const int tid = threadIdx.x, lane = tid & 63, wid = tid >> 6;
    const int wm = wid >> 1, wn = wid & 1;
    const int m0 = by * 128, n0 = bx * (64 * NJ);
    f32x16 acc[2][NJ];
#pragma unroll
    for (int i = 0; i < 2; i++)
#pragma unroll
        for (int j = 0; j < NJ; j++)
#pragma unroll
            for (int r = 0; r < 16; r++) acc[i][j][r] = 0.f;
    const int lrow = tid >> 3, lcol = (tid & 7) * 8;
    const bf16_t* ga = A + (size_t)(m0 + lrow) * lda + lcol;
    const bf16_t* gb = Bt + (size_t)(n0 + lrow) * ldb + lcol;
    u32x4 raA[4], rbA[2 * NJ], raB[4], rbB[2 * NJ];
    const int KT = K >> 6;
    const int frow = lane & 31, fk = (lane >> 5) * 16;
#define GM_LOAD(RA_, RB_, kt_)                                                                                              \
    {                                                                                                                       \
        _Pragma("unroll") for (int i = 0; i < 4; i++) RA_[i] = *(const u32x4*)(ga + (size_t)(32 * i) * lda + (kt_) * 64);   \
        _Pragma("unroll") for (int i = 0; i < 2 * NJ; i++) RB_[i] = *(const u32x4*)(gb + (size_t)(32 * i) * ldb + (kt_) * 64); \
    }
#define GM_STORE(RA_, RB_, st_)                                                                                             \
    {                                                                                                                       \
        char* sn_ = smem + (st_) * 36864;                                                                                   \
        _Pragma("unroll") for (int i = 0; i < 4; i++) *(u32x4*)(sn_ + (lrow + 32 * i) * 144 + lcol * 2) = RA_[i];           \
        _Pragma("unroll") for (int i = 0; i < 2 * NJ; i++) *(u32x4*)(sn_ + 18432 + (lrow + 32 * i) * 144 + lcol * 2) = RB_[i]; \
    }
#define GM_COMPUTE(st_)                                                                                                     \
    {                                                                                                                       \
        const char* sa_ = smem + (st_) * 36864;                                                                             \
        const char* sb_ = sa_ + 18432;                                                                                      \
        _Pragma("unroll") for (int ks = 0; ks < 4; ks++) {                                                                  \
            bf16x8 af[2], bfr[NJ];                                                                                          \
            _Pragma("unroll") for (int i = 0; i < 2; i++) af[i] = *(const bf16x8*)(sa_ + (wm * 64 + i * 32 + frow) * 144 + ks * 32 + fk); \
            _Pragma("unroll") for (int j = 0; j < NJ; j++) bfr[j] = *(const bf16x8*)(sb_ + (wn * (32 * NJ) + j * 32 + frow) * 144 + ks * 32 + fk); \
            _Pragma("unroll") for (int i = 0; i < 2; i++)                                                                   \
                _Pragma("unroll") for (int j = 0; j < NJ; j++) acc[i][j] = __builtin_amdgcn_mfma_f32_32x32x16_bf16(af[i], bfr[j], acc[i][j], 0, 0, 0); \
        }                                                                                                                   \
    }
    GM_LOAD(raA, rbA, 0)
    GM_STORE(raA, rbA, 0)
    if (KT > 1) GM_LOAD(raA, rbA, 1)
    __syncthreads();
    for (int kt = 0; kt < KT; kt += 2) {
        if (kt + 2 < KT) GM_LOAD(raB, rbB, kt + 2)
        GM_COMPUTE(0)
        if (kt + 1 < KT) GM_STORE(raA, rbA, 1)
        __syncthreads();
        if (kt + 1 < KT) {
            if (kt + 3 < KT) GM_LOAD(raA, rbA, kt + 3)
            GM_COMPUTE(1)
            if (kt + 2 < KT) GM_STORE(raB, rbB, 0)
            __syncthreads();
        }
    }
#pragma unroll
    for (int i = 0; i < 2; i++)
#pragma unroll
        for (int j = 0; j < NJ; j++) {
            const int col = n0 + wn * (32 * NJ) + j * 32 + (lane & 31);
            if (col < N) {
                if constexpr (Epi::kQuad) {
#pragma unroll
                    for (int g = 0; g < 4; g++) {
                        const int row0 = m0 + wm * 64 + i * 32 + 8 * g + 4 * (lane >> 5);
                        epi.quad(row0, col, acc[i][j][4 * g], acc[i][j][4 * g + 1], acc[i][j][4 * g + 2], acc[i][j][4 * g + 3]);
                    }
                } else {
#pragma unroll
                    for (int r = 0; r < 16; r++) {
                        const int row = m0 + wm * 64 + i * 32 + (r & 3) + 8 * (r >> 2) + 4 * (lane >> 5);
                        epi(row, col, acc[i][j][r]);
                    }
                }
            }
        }
}
template <class Epi>
__device__ __forceinline__ void d_gemm_bf16(const int bx, const int by, char* smem, const bf16_t* __restrict__ A, int lda,
                                            const bf16_t* __restrict__ Bt, int ldb, int K, int N, Epi epi) {
    d_gemm_bf16n<2, Epi>(bx, by, smem, A, lda, Bt, ldb, K, N, epi);
}
__device__ __forceinline__ void d_transpose_w(const int vb, char* smem, const float* __restrict__ W, int K, int N, bf16_t* __restrict__ Wt) {
    float (*tile)[65] = (float(*)[65])smem;
    const int kt = K >> 6;
    const int nb = vb / kt, kb = vb % kt;
    const int tid = threadIdx.x;
    {
        const int n = nb * 64 + (tid & 63);
#pragma unroll
        for (int i = 0; i < 16; i++) {
            int k = (tid >> 6) + 4 * i;
            tile[k][tid & 63] = (n < N) ? W[(size_t)(kb * 64 + k) * N + n] : 0.f;
        }
    }
    __syncthreads();
    {
        const int k = tid & 63;
#pragma unroll
        for (int i = 0; i < 16; i++) {
            int n = (tid >> 6) + 4 * i;
            Wt[(size_t)(nb * 64 + n) * K + kb * 64 + k] = f2bf(tile[k][n]);
        }
    }
}


template <int CTRL>
__device__ __forceinline__ float dpp_add(float v) {
    return v + __int_as_float(__builtin_amdgcn_update_dpp(0, __float_as_int(v), CTRL, 0xf, 0xf, false));
}
__device__ __forceinline__ float row16_allsum(float v) {
    v = dpp_add<0x128>(v); v = dpp_add<0x124>(v); v = dpp_add<0x122>(v); v = dpp_add<0x121>(v);
    return v;
}

typedef __bf16 bf16x2_t __attribute__((ext_vector_type(2)));
typedef float f32x2v __attribute__((ext_vector_type(2)));
__device__ __forceinline__ unsigned pk_bf2(float a, float b) { f32x2v v = {a, b}; return __builtin_bit_cast(unsigned, __builtin_convertvector(v, bf16x2_t)); }
__device__ __forceinline__ bf16x8 pk_bf8(float a0, float a1, float a2, float a3, float a4, float a5, float a6, float a7) {
    u32x4 u = {pk_bf2(a0, a1), pk_bf2(a2, a3), pk_bf2(a4, a5), pk_bf2(a6, a7)};
    return __builtin_bit_cast(bf16x8, u);
}
#define S3_SLOT 16384
#define S3_A1   0
#define S3_HD   4608
#define S3_A2F  9728
#define S3_ATF  10752
#define S3_ACF  11776
#define S3_VT   12800
#define S3_GC   14848
#define S3_AAB  15104
__device__ __forceinline__ void d_scan3(const int chain, const bool sample, char* smem, const bf16_t* __restrict__ rb, const bf16_t* __restrict__ kb,
                                        const bf16_t* __restrict__ vb, const bf16_t* __restrict__ kkb, const bf16_t* __restrict__ lr0,
                                        const bf16_t* __restrict__ lr1, const _Float16* __restrict__ du0, const _Float16* __restrict__ du1,
                                        const float* __restrict__ k_a, const float* __restrict__ st_f, const float* __restrict__ st_b,
                                        float* __restrict__ y0, float* __restrict__ y1, float* __restrict__ out_sf, float* __restrict__ out_sb) {
    const int d = chain & 1, h = (chain >> 1) & 7, b = chain >> 4;
    const int L = sample ? LS : LP;
    const int tbase = sample ? (TP + b * LS) : (b * LP);
    const int tid = threadIdx.x, wid = tid >> 6, lane = tid & 63;
    const int n = lane & 31, hh = lane >> 5;
    const bf16_t* lr = d ? lr1 : lr0;
    const unsigned short* du = (const unsigned short*)(d ? du1 : du0);
    float* yo = d ? y1 : y0;
    const float ka = k_a[h * 64 + lane];
    const int row = 32 * (wid & 1) + n;
    const int sw = (lane & ~12) | ((lane & 8) >> 1) | ((lane & 4) << 1);
    f32x16 St0, St1;
    if (sample) {
        const float* s0 = (d ? st_b : st_f) + ((size_t)(b * 8 + h) * 64 + row) * 64 + 4 * hh;
#pragma unroll
        for (int q = 0; q < 4; q++) {
            const float4 x0 = *(const float4*)(s0 + 8 * q), x1 = *(const float4*)(s0 + 32 + 8 * q);
            St0[4 * q] = x0.x; St0[4 * q + 1] = x0.y; St0[4 * q + 2] = x0.z; St0[4 * q + 3] = x0.w;
            St1[4 * q] = x1.x; St1[4 * q + 1] = x1.y; St1[4 * q + 2] = x1.z; St1[4 * q + 3] = x1.w;
        }
    } else {
#pragma unroll
        for (int r = 0; r < 16; r++) { St0[r] = 0.f; St1[r] = 0.f; }
    }
    char* slot = smem + wid * S3_SLOT;
    const int ngrp = L >> 6;
    const int dstep = d ? -512 : 512;
    const int wid_u = __builtin_amdgcn_readfirstlane(wid);
    unsigned rkk[16], rlr[16], rk[16], rr[16], ru[16], rv[16];
#define S3_LOAD(gg, J0, J1)                                                                                                   \
    {                                                                                                                        \
        const int i0_ = ((gg) * 4 + wid_u) * 16;                                                                             \
        const int e0_ = (tbase + (d ? (L - 1 - i0_) : i0_)) * 512 + h * 64;                  \
        _Pragma("unroll") for (int j = (J0); j < (J1); j++) {                                                                 \
            const int e_ = e0_ + j * dstep;                                                                                  \
            rkk[j] = (kkb + e_)[lane]; rlr[j] = (lr + e_)[lane]; rk[j] = (kb + e_)[lane]; rr[j] = (rb + e_)[lane];           \
            ru[j] = (du + e_)[lane]; rv[j] = (vb + e_)[lane];                                                                \
        }                                                                                                                    \
    }
    S3_LOAD(0, 0, 8)
    for (int g = 0; g < ngrp; g++) {
        {
            unsigned d1p[16], vtp[8];
            float cs = 0.f, G = 1.f;
            float bprev = 0.f, kprev = 0.f;
            S3_LOAD(g, 8, 12)
            __builtin_amdgcn_sched_barrier(0);
#pragma unroll
            for (int j = 0; j < 16; j++) {
                if (j == 4) { __builtin_amdgcn_sched_barrier(0); S3_LOAD(g, 12, 16) __builtin_amdgcn_sched_barrier(0); }
                const float kkv = __uint_as_float(rkk[j] << 16), lrv = __uint_as_float(rlr[j] << 16), kv = __uint_as_float(rk[j] << 16), rv_ = __uint_as_float(rr[j] << 16);
                const float uv = (float)__builtin_bit_cast(_Float16, (unsigned short)ru[j]);
                const float Gm = G;
                cs += uv;
                G = __expf(-0.6065306597126334f * cs);
                const float Gi = __builtin_amdgcn_rcpf(G);
                const float at = -kkv * Gm, rt = rv_ * G;
                const float bh = kkv * lrv * Gi;
                const float kh = kv * (1.f + (lrv - 1.f) * ka) * Gi;
                const unsigned p0 = pk_bf2(at, rt), p1 = pk_bf2(bh, kh);
                *(unsigned short*)(slot + S3_A1 + j * 144 + sw * 2) = (unsigned short)p0;
                *(unsigned short*)(slot + S3_A1 + (16 + j) * 144 + sw * 2) = (unsigned short)(p0 >> 16);
                *(unsigned short*)(slot + S3_HD + j * 144 + sw * 2) = (unsigned short)p1;
                *(unsigned short*)(slot + S3_HD + (16 + j) * 144 + sw * 2) = (unsigned short)(p1 >> 16);
                if (j & 1) {
                    const int pj = ((j - 1) & ~12) | (((j - 1) & 8) >> 1) | (((j - 1) & 4) << 1);
                    d1p[pj >> 1] = pk_bf2(bprev, bh);
                    d1p[8 + (pj >> 1)] = pk_bf2(kprev, kh);
                    vtp[pj >> 1] = rv[j - 1] | (rv[j] << 16);
                }
                bprev = bh; kprev = kh;
            }
            if (g + 1 < ngrp) S3_LOAD(g + 1, 0, 8)
            ((float*)(slot + S3_GC))[lane] = G;
            {
                u32x4 v0 = {vtp[0], vtp[1], vtp[2], vtp[3]};
                u32x4 v1 = {vtp[4], vtp[5], vtp[6], vtp[7]};
                *(u32x4*)(slot + S3_VT + lane * 32) = v0;
                *(u32x4*)(slot + S3_VT + lane * 32 + 16) = v1;
            }
            f32x16 D;
#pragma unroll
            for (int r = 0; r < 16; r++) D[r] = 0.f;
#pragma unroll
            for (int s = 0; s < 4; s++) {
                const bf16x8 af = *(const bf16x8*)(slot + S3_HD + n * 144 + s * 32 + hh * 16);
                const bf16x8 bf = *(const bf16x8*)(slot + S3_A1 + n * 144 + s * 32 + hh * 16);
                D = __builtin_amdgcn_mfma_f32_32x32x16_bf16(af, bf, D, 0, 0, 0);
            }
            const int t = n & 15;
            const bool strict = n < 16;
            const int lim = strict ? t : t + 1;
            float a2[8], ac[8];
#pragma unroll
            for (int r = 0; r < 8; r++) {
                const int j = (r & 3) + 8 * (r >> 2) + 4 * hh;
                const bool keep = j < lim;
                a2[r] = keep ? D[8 + r] : 0.f;
                const float lo = keep ? D[r] : 0.f;
                ac[r] = strict ? 0.f : lo;
                if (strict) ((float*)(slot + S3_AAB))[j * 20 + t] = lo;
            }
            *(bf16x8*)(slot + S3_A2F + lane * 16) = pk_bf8(a2[0], a2[1], a2[2], a2[3], a2[4], a2[5], a2[6], a2[7]);
            *(bf16x8*)(slot + S3_ACF + lane * 16) = pk_bf8(ac[0], ac[1], ac[2], ac[3], ac[4], ac[5], ac[6], ac[7]);
            {
                u32x4 q0 = {d1p[0], d1p[1], d1p[2], d1p[3]}, q1 = {d1p[4], d1p[5], d1p[6], d1p[7]};
                u32x4 q2 = {d1p[8], d1p[9], d1p[10], d1p[11]}, q3 = {d1p[12], d1p[13], d1p[14], d1p[15]};
                *(u32x4*)(slot + S3_HD + lane * 80) = q0;
                *(u32x4*)(slot + S3_HD + lane * 80 + 16) = q1;
                *(u32x4*)(slot + S3_HD + lane * 80 + 32) = q2;
                *(u32x4*)(slot + S3_HD + lane * 80 + 48) = q3;
            }
            float x[16];
#pragma unroll
            for (int i = 15; i >= 0; i--) {
                if (i == 11 || i == 7 || i == 3) __builtin_amdgcn_sched_barrier(0);
                float s = (i == t) ? 1.f : 0.f;
#pragma unroll
                for (int q = (i + 1) >> 2; q < 4; q++) {
                    const float4 a4 = *(const float4*)(slot + S3_AAB + (i * 20 + 4 * q) * 4);
                    if (4 * q + 0 > i) s += a4.x * x[4 * q + 0];
                    if (4 * q + 1 > i) s += a4.y * x[4 * q + 1];
                    if (4 * q + 2 > i) s += a4.z * x[4 * q + 2];
                    if (4 * q + 3 > i) s += a4.w * x[4 * q + 3];
                }
                x[i] = s;
            }
            {
                const float e0 = hh ? x[4] : x[0], e1 = hh ? x[5] : x[1], e2 = hh ? x[6] : x[2], e3 = hh ? x[7] : x[3];
                const float e4 = hh ? x[12] : x[8], e5 = hh ? x[13] : x[9], e6 = hh ? x[14] : x[10], e7 = hh ? x[15] : x[11];
                bf16x8 tf = pk_bf8(e0, e1, e2, e3, e4, e5, e6, e7);
                if (!strict) { tf = (bf16x8){0, 0, 0, 0, 0, 0, 0, 0}; }
                *(bf16x8*)(slot + S3_ATF + lane * 16) = tf;
            }
        }
        __syncthreads();
        if (wid < 2) {
#pragma unroll 1
            for (int q = 0; q < 4; q++) {
                const char* sl = smem + q * S3_SLOT;
                const bf16x8 sb0 = pk_bf8(St0[0], St0[1], St0[2], St0[3], St0[4], St0[5], St0[6], St0[7]);
                const bf16x8 sb1 = pk_bf8(St0[8], St0[9], St0[10], St0[11], St0[12], St0[13], St0[14], St0[15]);
                const bf16x8 sb2 = pk_bf8(St1[0], St1[1], St1[2], St1[3], St1[4], St1[5], St1[6], St1[7]);
                const bf16x8 sb3 = pk_bf8(St1[8], St1[9], St1[10], St1[11], St1[12], St1[13], St1[14], St1[15]);
                f32x16 acc1;
#pragma unroll
                for (int r = 0; r < 16; r++) acc1[r] = 0.f;
                acc1 = __builtin_amdgcn_mfma_f32_32x32x16_bf16(*(const bf16x8*)(sl + S3_A1 + n * 144 + 0 + hh * 16), sb0, acc1, 0, 0, 0);
                acc1 = __builtin_amdgcn_mfma_f32_32x32x16_bf16(*(const bf16x8*)(sl + S3_A1 + n * 144 + 32 + hh * 16), sb1, acc1, 0, 0, 0);
                acc1 = __builtin_amdgcn_mfma_f32_32x32x16_bf16(*(const bf16x8*)(sl + S3_A1 + n * 144 + 64 + hh * 16), sb2, acc1, 0, 0, 0);
                acc1 = __builtin_amdgcn_mfma_f32_32x32x16_bf16(*(const bf16x8*)(sl + S3_A1 + n * 144 + 96 + hh * 16), sb3, acc1, 0, 0, 0);
                const bf16x8 vt = *(const bf16x8*)(sl + S3_VT + row * 32 + hh * 16);
                acc1 = __builtin_amdgcn_mfma_f32_32x32x16_bf16(*(const bf16x8*)(sl + S3_A2F + lane * 16), vt, acc1, 0, 0, 0);
                const bf16x8 pf = pk_bf8(acc1[0], acc1[1], acc1[2], acc1[3], acc1[4], acc1[5], acc1[6], acc1[7]);
                f32x16 acc2;
#pragma unroll
                for (int r = 0; r < 16; r++) acc2[r] = 0.f;
                acc2 = __builtin_amdgcn_mfma_f32_32x32x16_bf16(*(const bf16x8*)(sl + S3_ATF + lane * 16), pf, acc2, 0, 0, 0);
                const bf16x8 uf = pk_bf8(acc2[0], acc2[1], acc2[2], acc2[3], acc2[4], acc2[5], acc2[6], acc2[7]);
                acc1 = __builtin_amdgcn_mfma_f32_32x32x16_bf16(*(const bf16x8*)(sl + S3_ACF + lane * 16), uf, acc1, 0, 0, 0);
                St0 = __builtin_amdgcn_mfma_f32_32x32x16_bf16(*(const bf16x8*)(sl + S3_HD + n * 80 + hh * 16), uf, St0, 0, 0, 0);
                St1 = __builtin_amdgcn_mfma_f32_32x32x16_bf16(*(const bf16x8*)(sl + S3_HD + (32 + n) * 80 + hh * 16), uf, St1, 0, 0, 0);
                St0 = __builtin_amdgcn_mfma_f32_32x32x16_bf16(*(const bf16x8*)(sl + S3_HD + n * 80 + 32 + hh * 16), vt, St0, 0, 0, 0);
                St1 = __builtin_amdgcn_mfma_f32_32x32x16_bf16(*(const bf16x8*)(sl + S3_HD + (32 + n) * 80 + 32 + hh * 16), vt, St1, 0, 0, 0);
                {
                    const int i0 = (g * 4 + q) * 16;
                    float* yb = yo + (size_t)(tbase + (d ? (L - 1 - i0) : i0)) * 512 + h * 64 + row;
#pragma unroll
                    for (int r = 0; r < 8; r++) {
                        const int tt = (r & 3) + 8 * (r >> 2) + 4 * hh;
                        yb[tt * dstep] = acc1[8 + r];
                    }
                }
                const float* gc = (const float*)(sl + S3_GC) + 4 * hh;
#pragma unroll
                for (int c4 = 0; c4 < 4; c4++) {
                    const float4 g0 = *(const float4*)(gc + 8 * c4), g1 = *(const float4*)(gc + 32 + 8 * c4);
                    St0[4 * c4] *= g0.x; St0[4 * c4 + 1] *= g0.y; St0[4 * c4 + 2] *= g0.z; St0[4 * c4 + 3] *= g0.w;
                    St1[4 * c4] *= g1.x; St1[4 * c4 + 1] *= g1.y; St1[4 * c4 + 2] *= g1.z; St1[4 * c4 + 3] *= g1.w;
                }
            }
        }
        __syncthreads();
    }
    if (!sample && wid < 2) {
        float* os = (d ? out_sb : out_sf) + ((size_t)(b * 8 + h) * 64 + row) * 64 + 4 * hh;
#pragma unroll
        for (int q = 0; q < 4; q++) {
            *(float4*)(os + 8 * q) = make_float4(St0[4 * q], St0[4 * q + 1], St0[4 * q + 2], St0[4 * q + 3]);
            *(float4*)(os + 32 + 8 * q) = make_float4(St1[4 * q], St1[4 * q + 1], St1[4 * q + 2], St1[4 * q + 3]);
        }
    }
}


#define ATT_SV_OFF 25600
#define ATT_SQ_OFF 44032
__device__ __forceinline__ void d_attn_mfma(const int item, char* smem, const bf16_t* __restrict__ Qb, const bf16_t* __restrict__ Kall,
                                            const bf16_t* __restrict__ VtAll, bf16_t* __restrict__ cat, int tbase, int Lq, int Lk, int nqb) {
    const int qb = item % nqb, bh = item / nqb;
    const int b = bh >> 2, h = bh & 3;
    const int tid = threadIdx.x, lane = tid & 63, wid = tid >> 6;
    const int q = lane & 31, hh = lane >> 5;
    const int t = tbase + b * Lq + qb * 128 + wid * 32 + q;
    bf16x8 qf[12];
    {
        const bf16_t* qp = Qb + ((size_t)t * 4 + h) * 192 + hh * 8;
#pragma unroll
        for (int ks = 0; ks < 12; ks++) qf[ks] = *(const bf16x8*)(qp + ks * 16);
    }
    f32x16 o[4];
#pragma unroll
    for (int i = 0; i < 4; i++)
#pragma unroll
        for (int r = 0; r < 16; r++) o[i][r] = 0.f;
    float m = -1e30f, l = 0.f;
    const bf16_t* K = Kall + (size_t)bh * Lk * 192;
    const bf16_t* Vt = VtAll + (size_t)bh * 128 * Lk;
    char* sK = smem;
    char* sV = smem + ATT_SV_OFF;
    u32x4 pk[6], pv[4];
    const int nkt = Lk >> 6;
#pragma unroll
    for (int i = 0; i < 6; i++) pk[i] = *(const u32x4*)(K + (size_t)(tid + 256 * i) * 8);
#pragma unroll
    for (int i = 0; i < 4; i++) { int c = tid + 256 * i; pv[i] = *(const u32x4*)(Vt + (size_t)(c >> 3) * Lk + (c & 7) * 8); }
#pragma unroll
    for (int i = 0; i < 6; i++) { int c = tid + 256 * i; *(u32x4*)(sK + (c / 24) * 400 + (c % 24) * 16) = pk[i]; }
#pragma unroll
    for (int i = 0; i < 4; i++) { int c = tid + 256 * i; *(u32x4*)(sV + (c >> 3) * 144 + (c & 7) * 16) = pv[i]; }
    __syncthreads();
    const float sc2 = 0.07216878364870322f * 1.4426950408889634f;
    for (int kt = 0; kt < nkt; kt++) {
        f32x16 st[2];
#pragma unroll
        for (int bk = 0; bk < 2; bk++)
#pragma unroll
            for (int r = 0; r < 16; r++) st[bk][r] = 0.f;
#pragma unroll
        for (int ks = 0; ks < 12; ks++) {
            const bf16x8 qfk = qf[ks];
#pragma unroll
            for (int bk = 0; bk < 2; bk++) {
                bf16x8 a = *(const bf16x8*)(sK + (bk * 32 + q) * 400 + ks * 32 + hh * 16);
                st[bk] = __builtin_amdgcn_mfma_f32_32x32x16_bf16(a, qfk, st[bk], 0, 0, 0);
            }
        }
        float mx = -1e30f;
#pragma unroll
        for (int bk = 0; bk < 2; bk++)
#pragma unroll
            for (int r = 0; r < 16; r++) { st[bk][r] *= sc2; mx = fmaxf(mx, st[bk][r]); }
        mx = fmaxf(mx, __shfl_xor(mx, 32, 64));
        const float mn = fmaxf(m, mx);
        const float alpha = exp2f(m - mn);
        float ps = 0.f;
#pragma unroll
        for (int bk = 0; bk < 2; bk++)
#pragma unroll
            for (int r = 0; r < 16; r++) { st[bk][r] = exp2f(st[bk][r] - mn); ps += st[bk][r]; }
        ps += __shfl_xor(ps, 32, 64);
        l = l * alpha + ps; m = mn;
#pragma unroll
        for (int i = 0; i < 4; i++)
#pragma unroll
            for (int r = 0; r < 16; r++) o[i][r] *= alpha;
#pragma unroll
        for (int s4 = 0; s4 < 4; s4++) {
            bf16x8 pb;
#pragma unroll
            for (int j = 0; j < 8; j++) pb[j] = (short)f2bf(st[s4 >> 1][8 * (s4 & 1) + j]);
#pragma unroll
            for (int i = 0; i < 4; i++) {
                bf16x8 a = *(const bf16x8*)(sV + (i * 32 + q) * 144 + s4 * 32 + hh * 16);
                o[i] = __builtin_amdgcn_mfma_f32_32x32x16_bf16(a, pb, o[i], 0, 0, 0);
            }
        }
        __syncthreads();
        if (kt + 1 < nkt) {
            const bf16_t* Kn = K + (size_t)(kt + 1) * 64 * 192;
            const bf16_t* Vn = Vt + (kt + 1) * 64;
#pragma unroll
            for (int i = 0; i < 6; i++) pk[i] = *(const u32x4*)(Kn + (size_t)(tid + 256 * i) * 8);
#pragma unroll
            for (int i = 0; i < 4; i++) { int c = tid + 256 * i; pv[i] = *(const u32x4*)(Vn + (size_t)(c >> 3) * Lk + (c & 7) * 8); }
#pragma unroll
            for (int i = 0; i < 6; i++) { int c = tid + 256 * i; *(u32x4*)(sK + (c / 24) * 400 + (c % 24) * 16) = pk[i]; }
#pragma unroll
            for (int i = 0; i < 4; i++) { int c = tid + 256 * i; *(u32x4*)(sV + (c >> 3) * 144 + (c & 7) * 16) = pv[i]; }
        }
        __syncthreads();
    }
    const float il = 1.f / l;
    bf16_t* op = cat + (size_t)t * DM + 512 + h * 128;
#pragma unroll
    for (int i = 0; i < 4; i++)
#pragma unroll
        for (int g = 0; g < 4; g++) {
            ushort4 w;
            w.x = f2bf(o[i][4 * g + 0] * il); w.y = f2bf(o[i][4 * g + 1] * il); w.z = f2bf(o[i][4 * g + 2] * il); w.w = f2bf(o[i][4 * g + 3] * il);
            *(ushort4*)(op + i * 32 + 8 * g + 4 * hh) = w;
        }
}


template <int K, int J>
__device__ __forceinline__ void bit_stage16(float (&x)[16]) {
#pragma unroll
    for (int i = 0; i < 16; i++) {
        const int l = i ^ J;
        if (l > i) {
            const bool desc = ((i & K) == 0);
            const float a = x[i], b = x[l];
            const float hi = fmaxf(a, b), lo = fminf(a, b);
            x[i] = desc ? hi : lo; x[l] = desc ? lo : hi;
        }
    }
}
__device__ __forceinline__ void bit_sort16_desc(float (&x)[16]) {
    bit_stage16<2, 1>(x);
    bit_stage16<4, 2>(x); bit_stage16<4, 1>(x);
    bit_stage16<8, 4>(x); bit_stage16<8, 2>(x); bit_stage16<8, 1>(x);
    bit_stage16<16, 8>(x); bit_stage16<16, 4>(x); bit_stage16<16, 2>(x); bit_stage16<16, 1>(x);
}
__device__ __forceinline__ void bit_merge16_desc(float (&x)[16]) {
    bit_stage16<16, 8>(x); bit_stage16<16, 4>(x); bit_stage16<16, 2>(x); bit_stage16<16, 1>(x);
}
template <int K, int J>
__device__ __forceinline__ void bit_stage16u(unsigned (&x)[16]) {
#pragma unroll
    for (int i = 0; i < 16; i++) {
        const int l = i ^ J;
        if (l > i) {
            const bool asc = ((i & K) == 0);
            const unsigned a = x[i], b = x[l];
            const unsigned lo = a < b ? a : b, hi = a < b ? b : a;
            x[i] = asc ? lo : hi; x[l] = asc ? hi : lo;
        }
    }
}
__device__ __forceinline__ void bit_sort16u_asc(unsigned (&x)[16]) {
    bit_stage16u<2, 1>(x);
    bit_stage16u<4, 2>(x); bit_stage16u<4, 1>(x);
    bit_stage16u<8, 4>(x); bit_stage16u<8, 2>(x); bit_stage16u<8, 1>(x);
    bit_stage16u<16, 8>(x); bit_stage16u<16, 4>(x); bit_stage16u<16, 2>(x); bit_stage16u<16, 1>(x);
}
__device__ __forceinline__ void bit_merge16u_asc(unsigned (&x)[16]) {
    bit_stage16u<16, 8>(x); bit_stage16u<16, 4>(x); bit_stage16u<16, 2>(x); bit_stage16u<16, 1>(x);
}
__device__ __forceinline__ void top16_merge(float (&L)[16], const float (&C)[16]) {
#pragma unroll
    for (int i = 0; i < 16; i++) L[i] = fmaxf(L[i], C[15 - i]);
    bit_merge16_desc(L);
}
__device__ __forceinline__ void low16_merge_u(unsigned (&L)[16], const unsigned (&C)[16]) {
#pragma unroll
    for (int i = 0; i < 16; i++) { const unsigned c = C[15 - i]; L[i] = L[i] < c ? L[i] : c; }
    bit_merge16u_asc(L);
}
__device__ __forceinline__ float key_val(float k) { return __uint_as_float(__float_as_uint(k) & ~127u); }
__device__ __forceinline__ int key_idx(float k) { return (int)(__float_as_uint(k) & 127u); }

struct EpiLds { static constexpr bool kQuad = false; float* lds; int c0; int pad;
    __device__ void operator()(int m, int n, float a) const { lds[m * 128 + (n - c0)] = a; } };

__device__ __forceinline__ void top16_col(const float* __restrict__ col, float (&L)[16]) {
#pragma unroll
    for (int ch = 0; ch < 8; ch++) {
        float C[16];
#pragma unroll
        for (int i = 0; i < 16; i++) {
            const int n = ch * 16 + i;
            C[i] = __uint_as_float((__float_as_uint(col[n * 128]) & ~127u) | (unsigned)n);
        }
        bit_sort16_desc(C);
        if (ch == 0) {
#pragma unroll
            for (int i = 0; i < 16; i++) L[i] = C[i];
        } else top16_merge(L, C);
    }
}
__device__ __forceinline__ void d_peer_route2(const int vb, char* smem, const bf16_t* __restrict__ kys, const bf16_t* __restrict__ qb,
                                              int* __restrict__ pidx, float* __restrict__ pg) {
    const int tt = vb % 96, h = vb / 96;
    const int tid = threadIdx.x;
    float A[16], B[16];
#pragma unroll
    for (int p = 0; p < 2; p++) {
        const int hp = h * 2 + p;
        d_gemm_bf16(tt, 0, smem, kys + (size_t)hp * 128 * 128, 128, qb + hp * 128, 2048, 128, TT, EpiLds{(float*)smem, tt * 128, 0});
        __syncthreads();
        if (tid < 128) {
            float L[16];
            top16_col((const float*)smem + tid, L);
#pragma unroll
            for (int i = 0; i < 16; i++) { if (p == 0) A[i] = L[i]; else B[i] = L[i]; }
        }
        __syncthreads();
    }
    if (tid >= 128) return;
    const int t = tt * 128 + tid;
    const float smax = key_val(A[0]) + key_val(B[0]);
    unsigned Tk[16];
#pragma unroll
    for (int g = 0; g < 4; g++) {
        unsigned Ck[16];
#pragma unroll
        for (int e = 0; e < 16; e++) {
            const int c = g * 16 + e;
            int i, j;
            if (c < 16) { i = 0; j = c; }
            else if (c < 24) { i = 1; j = c - 16; }
            else if (c < 29) { i = 2; j = c - 24; }
            else if (c < 33) { i = 3; j = c - 29; }
            else if (c < 36) { i = 4; j = c - 33; }
            else if (c < 42) { i = 5 + (c - 36) / 2; j = (c - 36) % 2; }
            else if (c < 50) { i = 8 + (c - 42); j = 0; }
            else { i = -1; j = 0; }
            if (i >= 0) {
                const float dd = smax - (key_val(A[i]) + key_val(B[j]));
                unsigned qd = (unsigned)fminf(dd * 32768.f, 262143.f);
                Ck[e] = (qd << 14) | (unsigned)(key_idx(A[i]) * 128 + key_idx(B[j]));
            } else Ck[e] = 0xffffffffu;
        }
        bit_sort16u_asc(Ck);
        if (g == 0) {
#pragma unroll
            for (int e = 0; e < 16; e++) Tk[e] = Ck[e];
        } else low16_merge_u(Tk, Ck);
    }
    float sum = 0.f;
    float w[16]; int Tp[16];
#pragma unroll
    for (int e = 0; e < 16; e++) { w[e] = __expf(-(float)(Tk[e] >> 14) * (1.f / 32768.f)); sum += w[e]; Tp[e] = (int)(Tk[e] & 16383u); }
    const float inv = 1.f / sum;
    int* pi = pidx + ((size_t)t * 8 + h) * 16;
    float* pw = pg + ((size_t)t * 8 + h) * 16;
#pragma unroll
    for (int e = 0; e < 16; e += 4) {
        *(int4*)(pi + e) = make_int4(Tp[e], Tp[e + 1], Tp[e + 2], Tp[e + 3]);
        *(float4*)(pw + e) = make_float4(w[e] * inv, w[e + 1] * inv, w[e + 2] * inv, w[e + 3] * inv);
    }
}

typedef __attribute__((ext_vector_type(2))) short bf16x2;
__device__ __forceinline__ float dot8_bf16(u32x4 a, u32x4 b, float acc) {
#pragma unroll
    for (int i = 0; i < 4; i++) {
        const unsigned x = a[i], y = b[i];
        acc += __uint_as_float(x << 16) * __uint_as_float(y << 16);
        acc += __uint_as_float(x & 0xffff0000u) * __uint_as_float(y & 0xffff0000u);
    }
    return acc;
}
__device__ __forceinline__ void d_cvt_bf16(const int vb, const float* __restrict__ src, bf16_t* __restrict__ dst) {
    const size_t base = (size_t)vb * 16384 + threadIdx.x * 4;
#pragma unroll
    for (int i = 0; i < 16; i++) {
        const float4 v = *(const float4*)(src + base + i * 1024);
        ushort4 o; o.x = f2bf(v.x); o.y = f2bf(v.y); o.z = f2bf(v.z); o.w = f2bf(v.w);
        *(ushort4*)(dst + base + i * 1024) = o;
    }
}


__device__ __forceinline__ void d_hy_filt2(const int vbl8, char* smem, const int L, const float* __restrict__ w1, const float* __restrict__ b1,
                                           const float* __restrict__ w2, const float* __restrict__ b2, const float* __restrict__ w3,
                                           const float* __restrict__ fr, bf16_t* __restrict__ gT, float* __restrict__ nsum) {
    float* zp = (float*)smem;
    float* h1 = zp + 32 * 33;
    float* h2t = h1 + 32 * 64;
    float* sw1 = h2t + 64 * 32;
    float* sw2 = sw1 + 33 * 64;
    const int tid = threadIdx.x;
    const int vbl = vbl8 >> 3, mm = vbl8 & 7;
    const int t0 = vbl * 32;
    for (int e = tid; e < 33 * 64; e += 256) sw1[e] = w1[e];
    for (int e = tid; e < 64 * 64; e += 256) sw2[e] = w2[e];
    for (int e = tid; e < 32 * 33; e += 256) {
        const int pos = e / 33, i = e % 33;
        const float t = (float)(t0 + pos);
        float val;
        if (i == 0) val = t / (float)(L - 1);
        else {
            const int bi = (i <= 16) ? (i - 1) : (i - 17);
            const float band = 1e-4f + (float)bi * ((15.f - 1e-4f) / 15.f);
            const float ang = 6.283185307179586f * t * band / (float)L;
            val = (i <= 16) ? __cosf(ang) : -__sinf(ang);
        }
        zp[e] = val;
    }
    const int c = tid + 256 * mm;
    float wv[8];
#pragma unroll
    for (int jj = 0; jj < 8; jj++) wv[jj] = w3[jj * 2048 + c];
    __syncthreads();
    {
        const int j = tid & 63;
        const float frj = fr[j];
#pragma unroll 1
        for (int i = 0; i < 8; i++) {
            const int pos = (tid >> 6) + 4 * i;
            float sacc = b1[j];
#pragma unroll 3
            for (int q = 0; q < 33; q++) sacc += zp[pos * 33 + q] * sw1[q * 64 + j];
            h1[pos * 64 + j] = __sinf(frj * sacc);
        }
        __syncthreads();
#pragma unroll 1
        for (int i = 0; i < 8; i++) {
            const int pos = (tid >> 6) + 4 * i;
            float sacc = b2[j];
#pragma unroll 4
            for (int q = 0; q < 64; q++) sacc += h1[pos * 64 + q] * sw2[q * 64 + j];
            h2t[j * 32 + pos] = __sinf(frj * sacc);
        }
    }
    __syncthreads();
    {
        float acc[32];
#pragma unroll
        for (int i = 0; i < 32; i++) acc[i] = 0.f;
#pragma unroll 1
        for (int jb = 0; jb < 64; jb += 8) {
            float wn[8];
            if (jb + 8 < 64) {
#pragma unroll
                for (int jj = 0; jj < 8; jj++) wn[jj] = w3[(jb + 8 + jj) * 2048 + c];
            }
#pragma unroll
            for (int jj = 0; jj < 8; jj++) {
                const float w = wv[jj];
#pragma unroll
                for (int i = 0; i < 8; i++) {
                    const float4 hv = *(const float4*)(h2t + (jb + jj) * 32 + i * 4);
                    acc[4 * i] += hv.x * w; acc[4 * i + 1] += hv.y * w; acc[4 * i + 2] += hv.z * w; acc[4 * i + 3] += hv.w * w;
                }
                __builtin_amdgcn_sched_barrier(0);
            }
            if (jb + 8 < 64) {
#pragma unroll
                for (int jj = 0; jj < 8; jj++) wv[jj] = wn[jj];
            }
        }
        const int ch = c & 1023;
        const float d0 = -4.605170185988091f / 0.3f, d1 = -4.605170185988091f / 1.5f;
        const float adelta = fabsf(d0 + (d1 - d0) * ((float)ch / 1023.f));
        float absum = 0.f;
        bf16_t* g = gT + (size_t)ch * 2 * L;
#pragma unroll
        for (int i = 0; i < 32; i++) {
            const int t = t0 + i;
            const float tu = (float)t / (float)(L - 1);
            const float val = acc[i] * __expf(-tu * adelta);
            if (c < 1024) { absum += fabsf(val); g[L - t] = f2bf(val); }
            else if (t >= 1) { absum += fabsf(val); g[L + t] = f2bf(val); }
            if ((i & 3) == 3) __builtin_amdgcn_sched_barrier(0);
        }
        atomicAdd(nsum + ch, absum);
    }
}

__device__ __forceinline__ void d_hy_dw3(const int vb, char* smem, const bf16_t* __restrict__ pre, const float* __restrict__ cw,
                                         const float* __restrict__ cb, bf16_t* __restrict__ zT, bf16_t* __restrict__ x0b) {
    bf16_t* tile = (bf16_t*)smem;
    const int tt = vb >> 3, ct = vb & 7;
    const int tid = threadIdx.x;
    const int cp = tid & 63, c = ct * 128 + cp * 2;
    const int tq = tid >> 6;
    const int tok0 = tt * 64 + tq * 16;
    const int pos0 = tok_pos(tok0), L = tok_len(tok0);
    unsigned raw[3][18];
#pragma unroll
    for (int part = 0; part < 3; part++)
#pragma unroll
        for (int i = 0; i < 18; i++) {
            const int pos = pos0 - 1 + i;
            raw[part][i] = (pos >= 0 && pos < L) ? *(const unsigned*)(pre + (size_t)(tok0 - 1 + i) * 3072 + part * 1024 + c) : 0u;
        }
    float w0[3][2], w1[3][2], w2[3][2], bb[3][2];
#pragma unroll
    for (int part = 0; part < 3; part++)
#pragma unroll
        for (int e = 0; e < 2; e++) {
            const int col = part * 1024 + c + e;
            w0[part][e] = cw[col]; w1[part][e] = cw[3072 + col]; w2[part][e] = cw[2 * 3072 + col]; bb[part][e] = cb[col];
        }
#pragma unroll
    for (int i = 0; i < 16; i++) {
        float u[3][2];
#pragma unroll
        for (int part = 0; part < 3; part++) {
            const unsigned p0 = raw[part][i], p1 = raw[part][i + 1], p2 = raw[part][i + 2];
            u[part][0] = __uint_as_float(p0 << 16) * w0[part][0] + __uint_as_float(p1 << 16) * w1[part][0] + __uint_as_float(p2 << 16) * w2[part][0] + bb[part][0];
            u[part][1] = __uint_as_float(p0 & 0xffff0000u) * w0[part][1] + __uint_as_float(p1 & 0xffff0000u) * w1[part][1] +
                         __uint_as_float(p2 & 0xffff0000u) * w2[part][1] + bb[part][1];
        }
        *(unsigned*)(x0b + (size_t)(tok0 + i) * DM + c) = (unsigned)f2bf(u[0][0]) | ((unsigned)f2bf(u[0][1]) << 16);
        tile[(cp * 2) * 72 + tq * 16 + i] = f2bf(u[1][0] * u[2][0]);
        tile[(cp * 2 + 1) * 72 + tq * 16 + i] = f2bf(u[1][1] * u[2][1]);
    }
    __syncthreads();
    {
        const int cch = tid >> 1, hf = tid & 1;
        bf16_t* dst = zT + (size_t)(ct * 128 + cch) * TT + tt * 64 + hf * 32;
        const bf16_t* src = tile + cch * 72 + hf * 32;
#pragma unroll
        for (int q = 0; q < 4; q++) *(u32x4*)(dst + q * 8) = *(const u32x4*)(src + q * 8);
    }
}

template <bool SAMPLE>
__device__ __forceinline__ void d_hy_conv2(const int c, const int half, char* wsm, const bf16_t* __restrict__ gTall, const float* __restrict__ nsum,
                                           const bf16_t* __restrict__ zT, const float* __restrict__ bias, bf16_t* __restrict__ yT) {
    constexpr int L = SAMPLE ? LS : LP;
    constexpr int NB = L / 32;
    constexpr int NBATCH = SAMPLE ? 4 : 16;
    constexpr int BSH = SAMPLE ? 2 : 4;
    constexpr int TPB = 32 >> BSH;
    constexpr int NCB = NB / TPB;
    constexpr int HCB = NCB / 2;
    constexpr int PADB = SAMPLE ? 8 : 2;
    constexpr int ZLEN = L + 2 * PADB * 32;
    constexpr int tbase = SAMPLE ? TP : 0;
    const int lane = threadIdx.x & 63;
    const int l2 = half * 64 + lane;
    const int lc = lane & 31, hh = lane >> 5;
    const int b = lc & (NBATCH - 1), Tl = lc >> BSH;
    bf16_t* R = (bf16_t*)wsm;
    bf16_t* Z = R + 2 * L;
    {
        constexpr int RCH = 2 * L / 8 / 128;
        constexpr int ZCH = NBATCH * (L / 8) / 128;
        const u32x4* src = (const u32x4*)(gTall + (size_t)c * 2 * L);
        u32x4 rr[RCH > 0 ? RCH : 1], zz[ZCH];
        if constexpr (RCH > 0) {
#pragma unroll
            for (int i = 0; i < RCH; i++) rr[i] = src[l2 + 128 * i];
        } else {
            if (l2 < 2 * L / 8) rr[0] = src[l2];
        }
#pragma unroll
        for (int i = 0; i < ZCH; i++) {
            const int q = l2 + 128 * i;
            const int b2 = q / (L / 8), ci = q % (L / 8);
            zz[i] = ((const u32x4*)(zT + (size_t)c * TT + tbase + b2 * L))[ci];
        }
        const u32x4 zero = {0u, 0u, 0u, 0u};
        for (int q = l2; q < NBATCH * PADB * 4; q += 128) {
            const int b2 = q / (PADB * 4), i = q % (PADB * 4);
            u32x4* zd = (u32x4*)(Z + b2 * ZLEN);
            zd[i] = zero; zd[PADB * 4 + L / 8 + i] = zero;
        }
        if constexpr (RCH > 0) {
#pragma unroll
            for (int i = 0; i < RCH; i++) ((u32x4*)R)[l2 + 128 * i] = rr[i];
        } else {
            if (l2 < 2 * L / 8) ((u32x4*)R)[l2] = rr[0];
        }
#pragma unroll
        for (int i = 0; i < ZCH; i++) {
            const int q = l2 + 128 * i;
            const int b2 = q / (L / 8), ci = q % (L / 8);
            ((u32x4*)(Z + b2 * ZLEN))[PADB * 4 + ci] = zz[i];
        }
    }
    __syncthreads();
    f32x16 acc[HCB];
#pragma unroll
    for (int cb = 0; cb < HCB; cb++)
#pragma unroll
        for (int r = 0; r < 16; r++) acc[cb][r] = 0.f;
    const bf16_t* Zb = Z + b * ZLEN + PADB * 32 + 8 * hh;
    const int cb0 = half * HCB;
    const int Dlo = TPB * cb0 - (NB - 1), Dhi = TPB * (cb0 + HCB - 1) + TPB - 1;
#pragma unroll 1
    for (int D = (Dlo < -(NB - 1) ? -(NB - 1) : Dlo); D <= (Dhi > NB - 1 ? NB - 1 : Dhi); D++) {
        bf16x8 af[2];
#pragma unroll
        for (int ks = 0; ks < 2; ks++) {
            const bf16_t* rp = R + (L - 32 * D - lc + 16 * ks + 8 * hh);
#pragma unroll
            for (int j = 0; j < 8; j++) af[ks][j] = (short)rp[j];
        }
#pragma unroll
        for (int lcb = 0; lcb < HCB; lcb++) {
            const int cb = cb0 + lcb;
            if (D >= TPB * cb - (NB - 1) && D <= TPB * cb + TPB - 1) {
                const int S = TPB * cb + Tl - D;
#pragma unroll
                for (int ks = 0; ks < 2; ks++) {
                    const bf16x8 bfr = *(const bf16x8*)(Zb + 32 * S + 16 * ks);
                    acc[lcb] = __builtin_amdgcn_mfma_f32_32x32x16_bf16(af[ks], bfr, acc[lcb], 0, 0, 0);
                }
            }
        }
    }
    const float inv = 1.f / nsum[c], bs = bias[c];
    bf16_t* yrow = yT + (size_t)c * TT + tbase + b * L;
    const bf16_t* zrow = Z + b * ZLEN + PADB * 32;
#pragma unroll
    for (int lcb = 0; lcb < HCB; lcb++)
#pragma unroll
        for (int g = 0; g < 4; g++) {
            const int t = 32 * (TPB * (cb0 + lcb) + Tl) + 8 * g + 4 * hh;
            ushort4 o;
            o.x = f2bf(acc[lcb][4 * g + 0] * inv + bf2f(zrow[t + 0]) * bs);
            o.y = f2bf(acc[lcb][4 * g + 1] * inv + bf2f(zrow[t + 1]) * bs);
            o.z = f2bf(acc[lcb][4 * g + 2] * inv + bf2f(zrow[t + 2]) * bs);
            o.w = f2bf(acc[lcb][4 * g + 3] * inv + bf2f(zrow[t + 3]) * bs);
            *(ushort4*)(yrow + t) = o;
        }
}

__device__ __forceinline__ void d_hy_post2(const int vb, char* smem, const bf16_t* __restrict__ yT, const bf16_t* __restrict__ x0b, bf16_t* __restrict__ zb) {
    bf16_t* tile = (bf16_t*)smem;
    const int tt = vb >> 3, ct = vb & 7;
    const int tid = threadIdx.x;
    const int cp = tid & 63, c = ct * 128 + cp * 2, tq = tid >> 6;
    const int tok0 = tt * 64 + tq * 16;
    unsigned xr[16];
#pragma unroll
    for (int i = 0; i < 16; i++) xr[i] = *(const unsigned*)(x0b + (size_t)(tok0 + i) * DM + c);
    {
        const int cch = tid >> 1, hf = tid & 1;
        const bf16_t* src = yT + (size_t)(ct * 128 + cch) * TT + tt * 64 + hf * 32;
        bf16_t* dst = tile + cch * 72 + hf * 32;
#pragma unroll
        for (int q = 0; q < 4; q++) *(u32x4*)(dst + q * 8) = *(const u32x4*)(src + q * 8);
    }
    __syncthreads();
#pragma unroll
    for (int i = 0; i < 16; i++) {
        const float y0 = bf2f(tile[(cp * 2) * 72 + tq * 16 + i]), y1 = bf2f(tile[(cp * 2 + 1) * 72 + tq * 16 + i]);
        const float r0 = __uint_as_float(xr[i] << 16) * y0, r1 = __uint_as_float(xr[i] & 0xffff0000u) * y1;
        *(unsigned*)(zb + (size_t)(tok0 + i) * DM + c) = (unsigned)f2bf(r0) | ((unsigned)f2bf(r1) << 16);
    }
}

__device__ __forceinline__ float wave_allsum_fast(float v) {
    v = row16_allsum(v);
    const float r0 = __int_as_float(__builtin_amdgcn_readlane(__float_as_int(v), 0));
    const float r1 = __int_as_float(__builtin_amdgcn_readlane(__float_as_int(v), 16));
    const float r2 = __int_as_float(__builtin_amdgcn_readlane(__float_as_int(v), 32));
    const float r3 = __int_as_float(__builtin_amdgcn_readlane(__float_as_int(v), 48));
    return (r0 + r1) + (r2 + r3);
}
__device__ __forceinline__ ushort4 pack_bf4(float a, float b, float c, float d) { ushort4 o; o.x = f2bf(a); o.y = f2bf(b); o.z = f2bf(c); o.w = f2bf(d); return o; }

__device__ __forceinline__ void d_norm_mod2(const int vb, const float* __restrict__ xa, const float* __restrict__ xb, const float* __restrict__ g,
                                            const float* __restrict__ modl, const int shift_idx, const int scale_idx, bf16_t* __restrict__ h) {
    const int wid = threadIdx.x >> 6, lane = threadIdx.x & 63;
    const int t0 = vb * 8 + wid * 2;
    float4 v[2][4];
#pragma unroll
    for (int u = 0; u < 2; u++) {
        const int t = t0 + u;
        const float* x = (t < TP) ? (xa + (size_t)t * DM) : (xb + (size_t)(t - TP) * DM);
#pragma unroll
        for (int j = 0; j < 4; j++) v[u][j] = *(const float4*)(x + j * 256 + lane * 4);
    }
#pragma unroll
    for (int u = 0; u < 2; u++) {
        const int t = t0 + u;
        float ss = 0.f;
#pragma unroll
        for (int j = 0; j < 4; j++) ss += v[u][j].x * v[u][j].x + v[u][j].y * v[u][j].y + v[u][j].z * v[u][j].z + v[u][j].w * v[u][j].w;
        ss = wave_allsum_fast(ss);
        const float rstd = rsqrtf(ss * (1.f / DM) + 1e-6f);
        const float* m = modl + (size_t)tok_modrow(t) * 6144;
#pragma unroll
        for (int j = 0; j < 4; j++) {
            const int c = j * 256 + lane * 4;
            const float4 gg = *(const float4*)(g + c);
            const float4 sh = *(const float4*)(m + shift_idx * 1024 + c);
            const float4 sc = *(const float4*)(m + scale_idx * 1024 + c);
            *(ushort4*)(h + (size_t)t * DM + c) = pack_bf4(v[u][j].x * rstd * gg.x * (1.f + sc.x) + sh.x, v[u][j].y * rstd * gg.y * (1.f + sc.y) + sh.y,
                                                           v[u][j].z * rstd * gg.z * (1.f + sc.z) + sh.z, v[u][j].w * rstd * gg.w * (1.f + sc.w) + sh.w);
        }
    }
}

__device__ __forceinline__ void d_rw_shift2(const int vb, const bf16_t* __restrict__ proj, const float* __restrict__ mu, bf16_t* __restrict__ rb,
                                            bf16_t* __restrict__ kb, bf16_t* __restrict__ vbuf, bf16_t* __restrict__ tw, bf16_t* __restrict__ adv,
                                            bf16_t* __restrict__ sg) {
#pragma unroll
    for (int u = 0; u < 4; u++) {
        const int id = vb * 1024 + u * 256 + threadIdx.x;
        const int t = id / 224, c = (id % 224) * 8;
        const int pos = tok_pos(t), L = tok_len(t);
        const bf16_t* P = proj + (size_t)t * RWIN + c;
        const u32x4 cur = *(const u32x4*)P;
        u32x4 prv = {0u, 0u, 0u, 0u}, nxt = {0u, 0u, 0u, 0u};
        if (pos > 0) prv = *(const u32x4*)(P - RWIN);
        if (pos < L - 1) nxt = *(const u32x4*)(P + RWIN);
        const float4 m0 = *(const float4*)(mu + c), m1 = *(const float4*)(mu + c + 4);
        const float mm[8] = {m0.x, m0.y, m0.z, m0.w, m1.x, m1.y, m1.z, m1.w};
        float val[8];
#pragma unroll
        for (int i = 0; i < 4; i++) {
            const float c0 = __uint_as_float(cur[i] << 16), c1 = __uint_as_float(cur[i] & 0xffff0000u);
            const float p0 = __uint_as_float(prv[i] << 16), p1 = __uint_as_float(prv[i] & 0xffff0000u);
            const float n0 = __uint_as_float(nxt[i] << 16), n1 = __uint_as_float(nxt[i] & 0xffff0000u);
            val[2 * i] = c0 + mm[2 * i] * (0.5f * (p0 + n0) - c0);
            val[2 * i + 1] = c1 + mm[2 * i + 1] * (0.5f * (p1 + n1) - c1);
        }
        bf16_t* dst;
        if (c < 512) dst = rb + (size_t)t * 512 + c;
        else if (c < 1024) dst = kb + (size_t)t * 512 + (c - 512);
        else if (c < 1536) dst = vbuf + (size_t)t * 512 + (c - 1024);
        else if (c < 1600) { dst = tw + (size_t)t * 64 + (c - 1536);
#pragma unroll
            for (int i = 0; i < 8; i++) val[i] = tanhf(val[i]); }
        else if (c < 1664) dst = adv + (size_t)t * 64 + (c - 1600);
        else { dst = sg + (size_t)t * 128 + (c - 1664);
#pragma unroll
            for (int i = 0; i < 8; i++) val[i] = sigmoidf_(val[i]); }
        u32x4 o;
#pragma unroll
        for (int i = 0; i < 4; i++) o[i] = (unsigned)f2bf(val[2 * i]) | ((unsigned)f2bf(val[2 * i + 1]) << 16);
        *(u32x4*)dst = o;
    }
}

__device__ __forceinline__ void d_mla_pre2(const int vb, const float* __restrict__ proj, const float* __restrict__ q_norm, const float* __restrict__ kv_norm,
                                           bf16_t* __restrict__ qcn, bf16_t* __restrict__ ckv, float* __restrict__ kpe, float* __restrict__ out_ckv,
                                           float* __restrict__ out_kpe) {
    const int t = vb * 16 + (threadIdx.x >> 4), l16 = threadIdx.x & 15;
    const float* P = proj + (size_t)t * 448;
    float4 x[7];
#pragma unroll
    for (int j = 0; j < 7; j++) x[j] = *(const float4*)(P + 4 * (l16 + 16 * j));
    float sq = 0.f, sk = 0.f;
#pragma unroll
    for (int j = 0; j < 4; j++) sq += x[j].x * x[j].x + x[j].y * x[j].y + x[j].z * x[j].z + x[j].w * x[j].w;
#pragma unroll
    for (int j = 4; j < 6; j++) sk += x[j].x * x[j].x + x[j].y * x[j].y + x[j].z * x[j].z + x[j].w * x[j].w;
    sq = row16_allsum(sq); sk = row16_allsum(sk);
    const float rq = rsqrtf(sq * (1.f / 256.f) + 1e-6f), rk = rsqrtf(sk * (1.f / 128.f) + 1e-6f);
#pragma unroll
    for (int j = 0; j < 4; j++) {
        const int c = 4 * (l16 + 16 * j);
        const float4 w = *(const float4*)(q_norm + c);
        *(ushort4*)(qcn + (size_t)t * 256 + c) = pack_bf4(x[j].x * rq * w.x, x[j].y * rq * w.y, x[j].z * rq * w.z, x[j].w * rq * w.w);
    }
#pragma unroll
    for (int j = 4; j < 6; j++) {
        const int c = 4 * (l16 + 16 * (j - 4));
        const float4 w = *(const float4*)(kv_norm + c);
        const float4 o = make_float4(x[j].x * rk * w.x, x[j].y * rk * w.y, x[j].z * rk * w.z, x[j].w * rk * w.w);
        *(ushort4*)(ckv + (size_t)t * 128 + c) = pack_bf4(o.x, o.y, o.z, o.w);
        if (t < TP) *(float4*)(out_ckv + (size_t)t * 128 + c) = o;
    }
    {
        const int c = 4 * l16;
        *(float4*)(kpe + (size_t)t * 64 + c) = x[6];
        if (t < TP) *(float4*)(out_kpe + (size_t)t * 64 + c) = x[6];
    }
}


typedef float f32x2 __attribute__((ext_vector_type(2)));
template <int CTRL>
__device__ __forceinline__ float dpp_max(float v) {
    return fmaxf(v, __int_as_float(__builtin_amdgcn_update_dpp(0, __float_as_int(v), CTRL, 0xf, 0xf, false)));
}
__device__ __forceinline__ float wave_allmax_fast(float v) {
    v = dpp_max<0x128>(v); v = dpp_max<0x124>(v); v = dpp_max<0x122>(v); v = dpp_max<0x121>(v);
    const float r0 = __int_as_float(__builtin_amdgcn_readlane(__float_as_int(v), 0));
    const float r1 = __int_as_float(__builtin_amdgcn_readlane(__float_as_int(v), 16));
    const float r2 = __int_as_float(__builtin_amdgcn_readlane(__float_as_int(v), 32));
    const float r3 = __int_as_float(__builtin_amdgcn_readlane(__float_as_int(v), 48));
    return fmaxf(fmaxf(r0, r1), fmaxf(r2, r3));
}
__device__ __forceinline__ void d_cvt_fp8_rows(const int vb, const float* __restrict__ src, unsigned char* __restrict__ dst, float* __restrict__ rscale) {
    const int wid = threadIdx.x >> 6, lane = threadIdx.x & 63;
    float4 x[4][4];
#pragma unroll
    for (int u = 0; u < 4; u++) {
        const float* r = src + (size_t)(vb * 16 + wid * 4 + u) * 1024 + lane * 4;
#pragma unroll
        for (int j = 0; j < 4; j++) x[u][j] = *(const float4*)(r + 256 * j);
    }
#pragma unroll
    for (int u = 0; u < 4; u++) {
        const int row = vb * 16 + wid * 4 + u;
        float am = 0.f;
#pragma unroll
        for (int j = 0; j < 4; j++) am = fmaxf(am, fmaxf(fmaxf(fabsf(x[u][j].x), fabsf(x[u][j].y)), fmaxf(fabsf(x[u][j].z), fabsf(x[u][j].w))));
        am = wave_allmax_fast(am);
        const float sc = am > 0.f ? 448.f / am : 1.f;
#pragma unroll
        for (int j = 0; j < 4; j++) {
            int pk = __builtin_amdgcn_cvt_pk_fp8_f32(x[u][j].x * sc, x[u][j].y * sc, 0, false);
            pk = __builtin_amdgcn_cvt_pk_fp8_f32(x[u][j].z * sc, x[u][j].w * sc, pk, true);
            *(unsigned*)(dst + (size_t)row * 1024 + 256 * j + lane * 4) = (unsigned)pk;
        }
        if (lane == 0) rscale[row] = am > 0.f ? am * (1.f / 448.f) : 1.f;
    }
}
__device__ __forceinline__ void d_peer_apply3(const int vb, char* smem, const bf16_t* __restrict__ hb, const int* __restrict__ pidx,
                                              const float* __restrict__ pg, const unsigned char* __restrict__ utab, const unsigned char* __restrict__ vtab,
                                              const float* __restrict__ rsU, const float* __restrict__ rsV, const float* __restrict__ modl,
                                              float* __restrict__ xrun, const float* __restrict__ g_next, const float* __restrict__ mod_next,
                                              bf16_t* __restrict__ h_next) {
    const int wid = threadIdx.x >> 6, lane = threadIdx.x & 63;
    const int t = vb * 4 + wid;
    float* coef = (float*)smem + wid * 128;
    int* eid = (int*)(smem + 2048) + wid * 128;
    const int e_lo = pidx[(size_t)t * 128 + lane], e_hi = pidx[(size_t)t * 128 + lane + 64];
    eid[lane] = e_lo; eid[lane + 64] = e_hi;
    const float g0 = pg[(size_t)t * 128 + lane] * rsV[e_lo], g1 = pg[(size_t)t * 128 + lane + 64] * rsV[e_hi];
    const float ru0 = rsU[e_lo], ru1 = rsU[e_hi];
    float x[16];
    {
        const u32x4 a = *(const u32x4*)(hb + (size_t)t * DM + lane * 16), b = *(const u32x4*)(hb + (size_t)t * DM + lane * 16 + 8);
#pragma unroll
        for (int i = 0; i < 4; i++) {
            x[2 * i] = __uint_as_float(a[i] << 16); x[2 * i + 1] = __uint_as_float(a[i] & 0xffff0000u);
            x[8 + 2 * i] = __uint_as_float(b[i] << 16); x[8 + 2 * i + 1] = __uint_as_float(b[i] & 0xffff0000u);
        }
    }
    __builtin_amdgcn_wave_barrier();
    float myact0 = 0.f, myact1 = 0.f;
#pragma unroll 1
    for (int eb = 0; eb < 128; eb += 16) {
        u32x4 q[16];
#pragma unroll
        for (int r = 0; r < 16; r++) q[r] = *(const u32x4*)(utab + (size_t)eid[eb + r] * 1024 + lane * 16);
#pragma unroll
        for (int r = 0; r < 16; r++) {
            float sacc = 0.f;
#pragma unroll
            for (int i = 0; i < 4; i++) {
                const f32x2 f01 = __builtin_amdgcn_cvt_pk_f32_fp8((int)q[r][i], false);
                const f32x2 f23 = __builtin_amdgcn_cvt_pk_f32_fp8((int)q[r][i], true);
                sacc += f01[0] * x[4 * i] + f01[1] * x[4 * i + 1] + f23[0] * x[4 * i + 2] + f23[1] * x[4 * i + 3];
            }
            sacc = wave_allsum_fast(sacc);
            const int e = eb + r;
            if (lane == (e & 63)) { if (e < 64) myact0 = sacc; else myact1 = sacc; }
        }
    }
    coef[lane] = g0 * gelu_tanh(myact0 * ru0);
    coef[lane + 64] = g1 * gelu_tanh(myact1 * ru1);
    __builtin_amdgcn_wave_barrier();
    float acc[16];
#pragma unroll
    for (int i = 0; i < 16; i++) acc[i] = 0.f;
#pragma unroll 1
    for (int eb = 0; eb < 128; eb += 16) {
        u32x4 q[16];
#pragma unroll
        for (int r = 0; r < 16; r++) q[r] = *(const u32x4*)(vtab + (size_t)eid[eb + r] * 1024 + lane * 16);
#pragma unroll
        for (int r = 0; r < 16; r++) {
            const float cf = coef[eb + r];
#pragma unroll
            for (int i = 0; i < 4; i++) {
                const f32x2 f01 = __builtin_amdgcn_cvt_pk_f32_fp8((int)q[r][i], false);
                const f32x2 f23 = __builtin_amdgcn_cvt_pk_f32_fp8((int)q[r][i], true);
                acc[4 * i] += cf * f01[0]; acc[4 * i + 1] += cf * f01[1]; acc[4 * i + 2] += cf * f23[0]; acc[4 * i + 3] += cf * f23[1];
            }
        }
    }
    const float* m = modl + (size_t)tok_modrow(t) * 6144 + 5 * 1024 + lane * 16;
    float* xo = xrun + (size_t)t * DM + lane * 16;
    float ss = 0.f;
#pragma unroll
    for (int j = 0; j < 4; j++) {
        float4 xa = *(float4*)(xo + 4 * j);
        const float4 ma = *(const float4*)(m + 4 * j);
        xa.x += ma.x * acc[4 * j]; xa.y += ma.y * acc[4 * j + 1]; xa.z += ma.z * acc[4 * j + 2]; xa.w += ma.w * acc[4 * j + 3];
        *(float4*)(xo + 4 * j) = xa;
        acc[4 * j] = xa.x; acc[4 * j + 1] = xa.y; acc[4 * j + 2] = xa.z; acc[4 * j + 3] = xa.w;
        ss += xa.x * xa.x + xa.y * xa.y + xa.z * xa.z + xa.w * xa.w;
    }
    if (g_next != nullptr) {
        ss = wave_allsum_fast(ss);
        const float rstd = rsqrtf(ss * (1.f / DM) + 1e-6f);
        const float* mn = mod_next + (size_t)tok_modrow(t) * 6144 + lane * 16;
#pragma unroll
        for (int j = 0; j < 4; j++) {
            const float4 gg = *(const float4*)(g_next + lane * 16 + 4 * j);
            const float4 sh = *(const float4*)(mn + 4 * j);
            const float4 sc = *(const float4*)(mn + 1024 + 4 * j);
            *(ushort4*)(h_next + (size_t)t * DM + lane * 16 + 4 * j) =
                pack_bf4(acc[4 * j] * rstd * gg.x * (1.f + sc.x) + sh.x, acc[4 * j + 1] * rstd * gg.y * (1.f + sc.y) + sh.y,
                         acc[4 * j + 2] * rstd * gg.z * (1.f + sc.z) + sh.z, acc[4 * j + 3] * rstd * gg.w * (1.f + sc.w) + sh.w);
        }
    }
}


__device__ __forceinline__ void d_rw_kk3(const int vb, const bf16_t* __restrict__ rb, const bf16_t* __restrict__ kb, const bf16_t* __restrict__ lr0,
                                         const bf16_t* __restrict__ lr1, const float* __restrict__ k_k, const float* __restrict__ k_a,
                                         const float* __restrict__ r_k, bf16_t* __restrict__ kkb, float* __restrict__ bonus) {
    const int g = threadIdx.x >> 4, l16 = threadIdx.x & 15;
    uint2 kq[4], rq[4], aq[4], bq[4];
#pragma unroll
    for (int u = 0; u < 4; u++) {
        const size_t o = (size_t)(vb * 64 + g + 16 * u) * 64 + l16 * 4;
        kq[u] = *(const uint2*)(kb + o); rq[u] = *(const uint2*)(rb + o); aq[u] = *(const uint2*)(lr0 + o); bq[u] = *(const uint2*)(lr1 + o);
    }
#pragma unroll
    for (int u = 0; u < 4; u++) {
        const int w = vb * 64 + g + 16 * u;
        const int h = w & 7;
        const float4 kk4 = *(const float4*)(k_k + h * 64 + l16 * 4), ka4 = *(const float4*)(k_a + h * 64 + l16 * 4), rk4 = *(const float4*)(r_k + h * 64 + l16 * 4);
        const float k0 = __uint_as_float(kq[u].x << 16), k1 = __uint_as_float(kq[u].x & 0xffff0000u), k2 = __uint_as_float(kq[u].y << 16), k3 = __uint_as_float(kq[u].y & 0xffff0000u);
        const float r0 = __uint_as_float(rq[u].x << 16), r1 = __uint_as_float(rq[u].x & 0xffff0000u), r2 = __uint_as_float(rq[u].y << 16), r3 = __uint_as_float(rq[u].y & 0xffff0000u);
        const float a0 = __uint_as_float(aq[u].x << 16), a1 = __uint_as_float(aq[u].x & 0xffff0000u), a2 = __uint_as_float(aq[u].y << 16), a3 = __uint_as_float(aq[u].y & 0xffff0000u);
        const float b0 = __uint_as_float(bq[u].x << 16), b1 = __uint_as_float(bq[u].x & 0xffff0000u), b2 = __uint_as_float(bq[u].y << 16), b3 = __uint_as_float(bq[u].y & 0xffff0000u);
        const float q0 = k0 * kk4.x, q1 = k1 * kk4.y, q2 = k2 * kk4.z, q3 = k3 * kk4.w;
        float ss = (q0 * q0 + q1 * q1) + (q2 * q2 + q3 * q3);
        float bs = r0 * k0 * (2.f + (a0 + b0 - 2.f) * ka4.x) * rk4.x + r1 * k1 * (2.f + (a1 + b1 - 2.f) * ka4.y) * rk4.y +
                   r2 * k2 * (2.f + (a2 + b2 - 2.f) * ka4.z) * rk4.z + r3 * k3 * (2.f + (a3 + b3 - 2.f) * ka4.w) * rk4.w;
        ss = row16_allsum(ss); bs = row16_allsum(bs);
        const float inv = 1.f / fmaxf(sqrtf(ss), 1e-12f);
        uint2 o2;
        o2.x = (unsigned)f2bf(q0 * inv) | ((unsigned)f2bf(q1 * inv) << 16);
        o2.y = (unsigned)f2bf(q2 * inv) | ((unsigned)f2bf(q3 * inv) << 16);
        *(uint2*)(kkb + (size_t)w * 64 + l16 * 4) = o2;
        if (l16 == 0) bonus[w] = bs;
    }
}
__device__ __forceinline__ void d_rw_post3(const int vb, const float* __restrict__ y0, const float* __restrict__ y1, const float* __restrict__ bonus,
                                           const bf16_t* __restrict__ vbuf, const bf16_t* __restrict__ gate, const float* __restrict__ lnx_g,
                                           const float* __restrict__ lnx_b, bf16_t* __restrict__ cat) {
    const int g = threadIdx.x >> 4, l16 = threadIdx.x & 15;
    float4 ya[4], yb[4]; uint2 vq[4], gq[4];
#pragma unroll
    for (int u = 0; u < 4; u++) {
        const size_t o = (size_t)(vb * 64 + g + 16 * u) * 64 + l16 * 4;
        ya[u] = *(const float4*)(y0 + o); yb[u] = *(const float4*)(y1 + o); vq[u] = *(const uint2*)(vbuf + o); gq[u] = *(const uint2*)(gate + o);
    }
#pragma unroll
    for (int u = 0; u < 4; u++) {
        const int w = vb * 64 + g + 16 * u;
        const int t = w >> 3, h = w & 7;
        const float e0 = ya[u].x + yb[u].x, e1 = ya[u].y + yb[u].y, e2 = ya[u].z + yb[u].z, e3 = ya[u].w + yb[u].w;
        const float mean = row16_allsum((e0 + e1) + (e2 + e3)) * (1.f / 64.f);
        const float d0 = e0 - mean, d1 = e1 - mean, d2 = e2 - mean, d3 = e3 - mean;
        const float var = row16_allsum((d0 * d0 + d1 * d1) + (d2 * d2 + d3 * d3)) * (1.f / 64.f);
        const float rstd = rsqrtf(var + 64e-5f);
        const float bn = bonus[w];
        const float4 g4 = *(const float4*)(lnx_g + h * 64 + l16 * 4), b4 = *(const float4*)(lnx_b + h * 64 + l16 * 4);
        const float v0 = __uint_as_float(vq[u].x << 16), v1 = __uint_as_float(vq[u].x & 0xffff0000u), v2 = __uint_as_float(vq[u].y << 16), v3 = __uint_as_float(vq[u].y & 0xffff0000u);
        const float t0 = __uint_as_float(gq[u].x << 16), t1 = __uint_as_float(gq[u].x & 0xffff0000u), t2 = __uint_as_float(gq[u].y << 16), t3 = __uint_as_float(gq[u].y & 0xffff0000u);
        uint2 o2;
        o2.x = (unsigned)f2bf((d0 * rstd * g4.x + b4.x + bn * v0) * t0) | ((unsigned)f2bf((d1 * rstd * g4.y + b4.y + bn * v1) * t1) << 16);
        o2.y = (unsigned)f2bf((d2 * rstd * g4.z + b4.z + bn * v2) * t2) | ((unsigned)f2bf((d3 * rstd * g4.w + b4.w + bn * v3) * t3) << 16);
        *(uint2*)(cat + (size_t)t * DM + h * 64 + l16 * 4) = o2;
    }
}


__device__ __forceinline__ void d_mla_post3(const int vb, const bf16_t* __restrict__ qraw, const bf16_t* __restrict__ kvraw, const bf16_t* __restrict__ kvraw_ctx,
                                            const float* __restrict__ kpe, const float* __restrict__ cache_kpe, const float* __restrict__ qn,
                                            const float* __restrict__ kn, bf16_t* __restrict__ Qb, bf16_t* __restrict__ Kp, bf16_t* __restrict__ Ks) {
    const int g = threadIdx.x >> 4, l16 = threadIdx.x & 15;
    const float inv = __expf(-(float)l16 * (1.f / 16.f) * 9.210340371976184f);
    float2 qnv[6], knv[6];
#pragma unroll
    for (int j = 0; j < 6; j++) { qnv[j] = *(const float2*)(qn + 2 * (l16 + 16 * j)); knv[j] = *(const float2*)(kn + 2 * (l16 + 16 * j)); }
#pragma unroll 2
    for (int u = 0; u < 4; u++) {
        const int item = vb * 64 + g + 16 * u;
        const int row = item >> 2, h = item & 3;
        const bool isctx = row >= TT, sample = row >= TP;
        const bf16_t* kvr; const float* pe; int pos = 0;
        if (isctx) { const int cr = row - TT; kvr = kvraw_ctx + (size_t)cr * 1024; pe = cache_kpe + (size_t)cr * 64; }
        else { kvr = kvraw + (size_t)row * 1024; pe = kpe + (size_t)row * 64; pos = tok_pos(row); }
        float kx[12], qx[12];
#pragma unroll
        for (int j = 0; j < 4; j++) {
            const unsigned kw = *(const unsigned*)(kvr + h * 256 + 2 * (l16 + 16 * j));
            kx[2 * j] = __uint_as_float(kw << 16); kx[2 * j + 1] = __uint_as_float(kw & 0xffff0000u);
        }
#pragma unroll
        for (int j = 4; j < 6; j++) { const float2 pv = *(const float2*)(pe + 2 * (l16 + 16 * (j - 4))); kx[2 * j] = pv.x; kx[2 * j + 1] = pv.y; }
#pragma unroll
        for (int j = 0; j < 6; j++) {
            const unsigned qw = isctx ? 0u : *(const unsigned*)(qraw + (size_t)row * 768 + h * 192 + 2 * (l16 + 16 * j));
            qx[2 * j] = __uint_as_float(qw << 16); qx[2 * j + 1] = __uint_as_float(qw & 0xffff0000u);
        }
        float sk = 0.f, sq = 0.f;
#pragma unroll
        for (int j = 0; j < 12; j++) { sk += kx[j] * kx[j]; sq += qx[j] * qx[j]; }
        sk = row16_allsum(sk); sq = row16_allsum(sq);
        const float rk = rsqrtf(sk * (1.f / 192.f) + 1e-6f), rq = rsqrtf(sq * (1.f / 192.f) + 1e-6f);
#pragma unroll
        for (int j = 0; j < 6; j++) {
            kx[2 * j] *= rk * knv[j].x; kx[2 * j + 1] *= rk * knv[j].y;
            qx[2 * j] *= rq * qnv[j].x; qx[2 * j + 1] *= rq * qnv[j].y;
        }
        if (sample && !isctx) {
#pragma unroll
            for (int j = 4; j < 6; j++) {
                const float ang = (j == 4 ? (float)(pos >> 6) : (float)(pos & 63)) * inv;
                const float cs = __cosf(ang), sn = __sinf(ang);
                const float a = kx[2 * j], bq = kx[2 * j + 1];
                kx[2 * j] = a * cs - bq * sn; kx[2 * j + 1] = a * sn + bq * cs;
                const float a2 = qx[2 * j], b2 = qx[2 * j + 1];
                qx[2 * j] = a2 * cs - b2 * sn; qx[2 * j + 1] = a2 * sn + b2 * cs;
            }
        }
        bf16_t* kd;
        if (!sample) { const int b = row >> 8, pp = row & 255; kd = Kp + ((size_t)(b * 4 + h) * LP + pp) * 192; }
        else if (!isctx) { const int b = (row - TP) >> 11, pp = (row - TP) & 2047; kd = Ks + ((size_t)(b * 4 + h) * 2304 + 256 + pp) * 192; }
        else { const int cr = row - TT; const int b = cr >> 8, pp = cr & 255; kd = Ks + ((size_t)(b * 4 + h) * 2304 + pp) * 192; }
#pragma unroll
        for (int j = 0; j < 6; j++) {
            const int e = 2 * (l16 + 16 * j);
            *(unsigned*)(kd + e) = (unsigned)f2bf(kx[2 * j]) | ((unsigned)f2bf(kx[2 * j + 1]) << 16);
            if (!isctx) *(unsigned*)(Qb + ((size_t)row * 4 + h) * 192 + e) = (unsigned)f2bf(qx[2 * j]) | ((unsigned)f2bf(qx[2 * j + 1]) << 16);
        }
    }
}

#define XB_TMO      128
#define XB_XCNT(j)  (256  + 64 * (j))
#define XB_XSUB(j)  (1280 + 64 * (j))
#define XB_XGEN(j)  (2304 + 64 * (j))
#define XB_TOP      3328
#define XB_TOPGEN   3392
#define XCD_BAR_WORDS 3456
#define XB_SPIN_CAP (1u << 22)
#define LAS __attribute__((address_space(3)))
__device__ __forceinline__ unsigned xb_ld(unsigned* p) { return __hip_atomic_load(p, __ATOMIC_RELAXED, __HIP_MEMORY_SCOPE_AGENT); }
__device__ __forceinline__ unsigned xb_add(unsigned* p, unsigned v) { return __hip_atomic_fetch_add(p, v, __ATOMIC_RELAXED, __HIP_MEMORY_SCOPE_AGENT); }
__device__ __forceinline__ unsigned xb_xcc_id() { return (unsigned)__builtin_amdgcn_s_getreg((3 << 11) | 20) & 0xFu; }
#define XB_SPIN(cond, bar) do { unsigned _sp = 0; while (cond) { __builtin_amdgcn_s_sleep(1); \
    if ((++_sp & 255u) == 0u) { if (xb_ld(&(bar)[XB_TMO])) break; if (_sp > XB_SPIN_CAP) { atomicAdd(&(bar)[XB_TMO], 1u); break; } } } } while (0)
struct XcdBarrier { unsigned* bar; unsigned x; volatile LAS unsigned* st; };
__device__ __forceinline__ XcdBarrier xcd_barrier_post(unsigned* bar, volatile LAS unsigned* st) {
    XcdBarrier b; b.bar = bar; b.x = xb_xcc_id(); b.st = st;
    if (threadIdx.x == 0) (void)xb_add(&bar[XB_XCNT(b.x)], 1u);
    return b;
}
__device__ __forceinline__ void xcd_barrier_complete(unsigned* bar, unsigned x, unsigned& nloc, unsigned& nx) {
    const unsigned G = gridDim.x * gridDim.y * gridDim.z;
    unsigned sum, cnt, mine, sp = 0u;
    for (;;) {
        sum = 0u; cnt = 0u; mine = 0u;
#pragma unroll
        for (unsigned j = 0; j < 16; ++j) { const unsigned c = xb_ld(&bar[XB_XCNT(j)]); sum += c; cnt += (c > 0u) ? 1u : 0u; mine = (j == x) ? c : mine; }
        if (sum == G) break;
        __builtin_amdgcn_s_sleep(1);
        if ((++sp & 255u) == 0u) { if (xb_ld(&bar[XB_TMO])) break; if (sp > XB_SPIN_CAP) { atomicAdd(&bar[XB_TMO], 1u); break; } }
    }
    nloc = mine > 0u ? mine : 1u; nx = cnt > 0u ? cnt : 1u;
}
__device__ __forceinline__ void xcd_barrier_(unsigned* bar_, char* smem_) {
    XcdBarrier b; b.bar = bar_; b.x = xb_xcc_id(); b.st = (volatile LAS unsigned*)(smem_ + GEMM_LDS_BYTES);
    asm volatile("s_waitcnt vmcnt(0)" ::: "memory");
    __syncthreads();
    if (threadIdx.x == 0) {
        unsigned* bar = b.bar;
        __builtin_amdgcn_s_waitcnt(0);
        unsigned nloc = b.st[0], nx = b.st[1];
        if (nloc == 0u) { xcd_barrier_complete(bar, b.x, nloc, nx); b.st[0] = nloc; b.st[1] = nx; }
        const unsigned old = xb_add(&bar[XB_XSUB(b.x)], 1u);
        const unsigned gen = old / nloc;
        if (old + 1u == (gen + 1u) * nloc) {
            __builtin_amdgcn_fence(__ATOMIC_RELEASE, "agent");
            asm volatile("s_waitcnt vmcnt(0)" ::: "memory");
            const unsigned og = xb_add(&bar[XB_TOP], 1u);
            const unsigned tg = og / nx;
            if (og + 1u == (tg + 1u) * nx) xb_add(&bar[XB_TOPGEN], 1u);
            else XB_SPIN(xb_ld(&bar[XB_TOPGEN]) == tg, bar);
            __builtin_amdgcn_fence(__ATOMIC_ACQUIRE, "agent");
            xb_add(&bar[XB_XGEN(b.x)], 1u);
            asm volatile("s_waitcnt vmcnt(0)" ::: "memory");
        } else {
            XB_SPIN(xb_ld(&bar[XB_XGEN(b.x)]) == gen, bar);
            __builtin_amdgcn_fence(__ATOMIC_ACQUIRE, "agent");
            asm volatile("s_waitcnt vmcnt(0)" ::: "memory");
        }
    }
    __syncthreads();
}

constexpr size_t ws_al(size_t x) { return (x + 255) & ~(size_t)255; }
struct WS {
    static constexpr size_t mod = 0;
    static constexpr size_t w_in_t = ws_al(mod + (size_t)(2*5*6144*4));
    static constexpr size_t w_out_t = ws_al(w_in_t + (size_t)(2304*1024*2));
    static constexpr size_t hy_w_in_t = ws_al(w_out_t + (size_t)(1024*1024*2));
    static constexpr size_t hy_w_out_t = ws_al(hy_w_in_t + (size_t)(3072*1024*2));
    static constexpr size_t w_q_t = ws_al(hy_w_out_t + (size_t)(1024*1024*2));
    static constexpr size_t q_up_t = ws_al(w_q_t + (size_t)(2*2048*1024*2));
    static constexpr size_t kv_up_t = ws_al(q_up_t + (size_t)(768*256*2));
    static constexpr size_t w2_t = ws_al(kv_up_t + (size_t)(1024*128*2));
    static constexpr size_t a2_t = ws_al(w2_t + (size_t)(2*512*64*2));
    static constexpr size_t g2_t = ws_al(a2_t + (size_t)(2*512*64*2));
    static constexpr size_t ctxb = ws_al(g2_t + (size_t)(512*128*2));
    static constexpr size_t keysb = ws_al(ctxb + (size_t)(1024*128*2));
    static constexpr size_t tabU = ws_al(keysb + (size_t)(2*16*128*128*2));
    static constexpr size_t tabV = ws_al(tabU + (size_t)(16384*1024));
    static constexpr size_t rsU = ws_al(tabV + (size_t)(16384*1024));
    static constexpr size_t rsV = ws_al(rsU + (size_t)(16384*4));
    static constexpr size_t nsum = ws_al(rsV + (size_t)(16384*4));
    static constexpr size_t gTS = ws_al(nsum + (size_t)(2*1024*4 + 3456*4 + 1024));
    static constexpr size_t gTP = ws_al(gTS + (size_t)1024*2*2048*2);
    static constexpr size_t R1 = ws_al(gTP + (size_t)1024*2*256*2);
    static constexpr size_t R2 = ws_al(R1 + (size_t)((size_t)TT*1024*4));
    static constexpr size_t rb = ws_al(R2 + (size_t)((size_t)TT*1792*2 + (size_t)TT*448*4));
    static constexpr size_t kb = ws_al(rb + (size_t)((size_t)TT*512*2));
    static constexpr size_t vb = ws_al(kb + (size_t)((size_t)TT*512*2));
    static constexpr size_t kkb = ws_al(vb + (size_t)((size_t)TT*512*2));
    static constexpr size_t lr0 = ws_al(kkb + (size_t)((size_t)TT*512*2));
    static constexpr size_t lr1 = ws_al(lr0 + (size_t)((size_t)TT*512*2));
    static constexpr size_t gateb = ws_al(lr1 + (size_t)((size_t)TT*512*2));
    static constexpr size_t du0 = ws_al(gateb + (size_t)((size_t)TT*512*2));
    static constexpr size_t du1 = ws_al(du0 + (size_t)((size_t)TT*512*2));
    static constexpr size_t twb = ws_al(du1 + (size_t)((size_t)TT*512*2));
    static constexpr size_t advb = ws_al(twb + (size_t)((size_t)TT*64*2));
    static constexpr size_t sgb = ws_al(advb + (size_t)((size_t)TT*64*2));
    static constexpr size_t bonus = ws_al(sgb + (size_t)((size_t)TT*128*2));
    static constexpr size_t kpe = ws_al(bonus + (size_t)((size_t)TT*8*4));
    static constexpr size_t qcnb = ws_al(kpe + (size_t)((size_t)TT*64*4));
    static constexpr size_t ckvb = ws_al(qcnb + (size_t)((size_t)TT*256*2));
    static constexpr size_t Qb = ws_al(ckvb + (size_t)((size_t)TT*128*2));
    static constexpr size_t Kp = ws_al(Qb + (size_t)((size_t)TT*768*2));
    static constexpr size_t Vp = ws_al(Kp + (size_t)(16*4*256*192*2));
    static constexpr size_t Ks = ws_al(Vp + (size_t)(16*4*256*128*2));
    static constexpr size_t Vs = ws_al(Ks + (size_t)(4*4*2304*192*2));
    static constexpr size_t kvctxb = ws_al(Vs + (size_t)(4*4*2304*128*2));
    static constexpr size_t pidx = ws_al(kvctxb + (size_t)(1024*1024*2));
    static constexpr size_t pg = ws_al(pidx + (size_t)((size_t)TT*128*4));
    static constexpr size_t END = ws_al(pg + (size_t)((size_t)TT*128*4));
    static constexpr size_t hb = R1;
    static constexpr size_t catb = R1;
    static constexpr size_t zbb = R1;
    static constexpr size_t kvrawb = R1;
    static constexpr size_t qrawb = R1 + (size_t)TT*1024*2;
    static constexpr size_t projrw = R2;
    static constexpr size_t projmla = R2 + (size_t)TT*1792*2;
    static constexpr size_t y0 = R2;
    static constexpr size_t y1 = R2 + (size_t)TT*512*4;
    static constexpr size_t qb = R2;
    static constexpr size_t scT = rb;
    static constexpr size_t pre = R2;
    static constexpr size_t zT = R2 + (size_t)TT*3072*2;
    static constexpr size_t x0b = R2 + (size_t)TT*3072*2 + (size_t)TT*1024*2;
    static constexpr size_t yT = R2 + (size_t)TT*3072*2 + (size_t)TT*1024*4;
    static constexpr size_t bar = nsum + 2*1024*4;
};
struct Params {
    const float* in[46];
    float* out;
    char* ws;
    __device__ __forceinline__ const float* x_prompt() const { return in[0]; }
    __device__ __forceinline__ const float* x_sample() const { return in[1]; }
    __device__ __forceinline__ const float* st_f() const { return in[2]; }
    __device__ __forceinline__ const float* st_b() const { return in[3]; }
    __device__ __forceinline__ const float* cache_ckv() const { return in[4]; }
    __device__ __forceinline__ const float* cache_kpe() const { return in[5]; }
    __device__ __forceinline__ const float* c() const { return in[6]; }
    __device__ __forceinline__ const float* c_ctx() const { return in[7]; }
    __device__ __forceinline__ const float* norm_g() const { return in[8]; }
    __device__ __forceinline__ const float* w_mod() const { return in[9]; }
    __device__ __forceinline__ const float* b_mod() const { return in[10]; }
    __device__ __forceinline__ const float* ab_w_in() const { return in[11]; }
    __device__ __forceinline__ const float* rw_mu() const { return in[12]; }
    __device__ __forceinline__ const float* rw_w0() const { return in[13]; }
    __device__ __forceinline__ const float* rw_w2() const { return in[14]; }
    __device__ __forceinline__ const float* rw_a0() const { return in[15]; }
    __device__ __forceinline__ const float* rw_a2() const { return in[16]; }
    __device__ __forceinline__ const float* rw_g2() const { return in[17]; }
    __device__ __forceinline__ const float* rw_k_k() const { return in[18]; }
    __device__ __forceinline__ const float* rw_k_a() const { return in[19]; }
    __device__ __forceinline__ const float* rw_r_k() const { return in[20]; }
    __device__ __forceinline__ const float* rw_lnx_g() const { return in[21]; }
    __device__ __forceinline__ const float* rw_lnx_b() const { return in[22]; }
    __device__ __forceinline__ const float* mla_q_norm() const { return in[23]; }
    __device__ __forceinline__ const float* mla_q_up() const { return in[24]; }
    __device__ __forceinline__ const float* mla_kv_norm() const { return in[25]; }
    __device__ __forceinline__ const float* mla_kv_up() const { return in[26]; }
    __device__ __forceinline__ const float* mla_qn() const { return in[27]; }
    __device__ __forceinline__ const float* mla_kn() const { return in[28]; }
    __device__ __forceinline__ const float* ab_w_out() const { return in[29]; }
    __device__ __forceinline__ const float* hy_w_in() const { return in[30]; }
    __device__ __forceinline__ const float* hy_b_in() const { return in[31]; }
    __device__ __forceinline__ const float* hy_conv_w() const { return in[32]; }
    __device__ __forceinline__ const float* hy_conv_b() const { return in[33]; }
    __device__ __forceinline__ const float* hy_f_w1() const { return in[34]; }
    __device__ __forceinline__ const float* hy_f_b1() const { return in[35]; }
    __device__ __forceinline__ const float* hy_f_w2() const { return in[36]; }
    __device__ __forceinline__ const float* hy_f_b2() const { return in[37]; }
    __device__ __forceinline__ const float* hy_f_w3() const { return in[38]; }
    __device__ __forceinline__ const float* hy_f_freq() const { return in[39]; }
    __device__ __forceinline__ const float* hy_bias() const { return in[40]; }
    __device__ __forceinline__ const float* hy_w_out() const { return in[41]; }
    __device__ __forceinline__ const float* peer_w_q() const { return in[42]; }
    __device__ __forceinline__ const float* peer_keys() const { return in[43]; }
    __device__ __forceinline__ const float* peer_u() const { return in[44]; }
    __device__ __forceinline__ const float* peer_v() const { return in[45]; }
    __device__ __forceinline__ float* xrun() const { return out + (0); }
    __device__ __forceinline__ float* out_sf() const { return out + ((size_t)TT*DM); }
    __device__ __forceinline__ float* out_sb() const { return out + ((size_t)TT*DM + 16*8*64*64); }
    __device__ __forceinline__ float* out_ckv() const { return out + ((size_t)TT*DM + 2*16*8*64*64); }
    __device__ __forceinline__ float* out_kpe() const { return out + ((size_t)TT*DM + 2*16*8*64*64 + 16*256*128); }
    __device__ __forceinline__ float* mod() const { return (float*)(ws + WS::mod); }
    __device__ __forceinline__ bf16_t* w_in_t() const { return (bf16_t*)(ws + WS::w_in_t); }
    __device__ __forceinline__ bf16_t* w_out_t() const { return (bf16_t*)(ws + WS::w_out_t); }
    __device__ __forceinline__ bf16_t* hy_w_in_t() const { return (bf16_t*)(ws + WS::hy_w_in_t); }
    __device__ __forceinline__ bf16_t* hy_w_out_t() const { return (bf16_t*)(ws + WS::hy_w_out_t); }
    __device__ __forceinline__ bf16_t* w_q_t() const { return (bf16_t*)(ws + WS::w_q_t); }
    __device__ __forceinline__ bf16_t* q_up_t() const { return (bf16_t*)(ws + WS::q_up_t); }
    __device__ __forceinline__ bf16_t* kv_up_t() const { return (bf16_t*)(ws + WS::kv_up_t); }
    __device__ __forceinline__ bf16_t* w2_t() const { return (bf16_t*)(ws + WS::w2_t); }
    __device__ __forceinline__ bf16_t* a2_t() const { return (bf16_t*)(ws + WS::a2_t); }
    __device__ __forceinline__ bf16_t* g2_t() const { return (bf16_t*)(ws + WS::g2_t); }
    __device__ __forceinline__ bf16_t* ctxb() const { return (bf16_t*)(ws + WS::ctxb); }
    __device__ __forceinline__ bf16_t* keysb() const { return (bf16_t*)(ws + WS::keysb); }
    __device__ __forceinline__ unsigned char* tabU() const { return (unsigned char*)(ws + WS::tabU); }
    __device__ __forceinline__ float* rsU() const { return (float*)(ws + WS::rsU); }
    __device__ __forceinline__ float* rsV() const { return (float*)(ws + WS::rsV); }
    __device__ __forceinline__ unsigned char* tabV() const { return (unsigned char*)(ws + WS::tabV); }
    __device__ __forceinline__ float* nsum() const { return (float*)(ws + WS::nsum); }
    __device__ __forceinline__ bf16_t* rb() const { return (bf16_t*)(ws + WS::rb); }
    __device__ __forceinline__ bf16_t* kb() const { return (bf16_t*)(ws + WS::kb); }
    __device__ __forceinline__ bf16_t* vb() const { return (bf16_t*)(ws + WS::vb); }
    __device__ __forceinline__ bf16_t* kkb() const { return (bf16_t*)(ws + WS::kkb); }
    __device__ __forceinline__ bf16_t* lr0() const { return (bf16_t*)(ws + WS::lr0); }
    __device__ __forceinline__ bf16_t* lr1() const { return (bf16_t*)(ws + WS::lr1); }
    __device__ __forceinline__ bf16_t* gateb() const { return (bf16_t*)(ws + WS::gateb); }
    __device__ __forceinline__ _Float16* du0() const { return (_Float16*)(ws + WS::du0); }
    __device__ __forceinline__ _Float16* du1() const { return (_Float16*)(ws + WS::du1); }
    __device__ __forceinline__ bf16_t* twb() const { return (bf16_t*)(ws + WS::twb); }
    __device__ __forceinline__ bf16_t* advb() const { return (bf16_t*)(ws + WS::advb); }
    __device__ __forceinline__ bf16_t* sgb() const { return (bf16_t*)(ws + WS::sgb); }
    __device__ __forceinline__ float* bonus() const { return (float*)(ws + WS::bonus); }
    __device__ __forceinline__ float* kpe() const { return (float*)(ws + WS::kpe); }
    __device__ __forceinline__ bf16_t* qcnb() const { return (bf16_t*)(ws + WS::qcnb); }
    __device__ __forceinline__ bf16_t* ckvb() const { return (bf16_t*)(ws + WS::ckvb); }
    __device__ __forceinline__ bf16_t* Qb() const { return (bf16_t*)(ws + WS::Qb); }
    __device__ __forceinline__ bf16_t* Kp() const { return (bf16_t*)(ws + WS::Kp); }
    __device__ __forceinline__ bf16_t* Vp() const { return (bf16_t*)(ws + WS::Vp); }
    __device__ __forceinline__ bf16_t* Ks() const { return (bf16_t*)(ws + WS::Ks); }
    __device__ __forceinline__ bf16_t* Vs() const { return (bf16_t*)(ws + WS::Vs); }
    __device__ __forceinline__ bf16_t* kvctxb() const { return (bf16_t*)(ws + WS::kvctxb); }
    __device__ __forceinline__ int* pidx() const { return (int*)(ws + WS::pidx); }
    __device__ __forceinline__ float* pg() const { return (float*)(ws + WS::pg); }
    __device__ __forceinline__ bf16_t* hb() const { return (bf16_t*)(ws + WS::hb); }
    __device__ __forceinline__ bf16_t* catb() const { return (bf16_t*)(ws + WS::catb); }
    __device__ __forceinline__ bf16_t* zbb() const { return (bf16_t*)(ws + WS::zbb); }
    __device__ __forceinline__ bf16_t* kvrawb() const { return (bf16_t*)(ws + WS::kvrawb); }
    __device__ __forceinline__ bf16_t* qrawb() const { return (bf16_t*)(ws + WS::qrawb); }
    __device__ __forceinline__ bf16_t* projrw() const { return (bf16_t*)(ws + WS::projrw); }
    __device__ __forceinline__ float* projmla() const { return (float*)(ws + WS::projmla); }
    __device__ __forceinline__ float* y0() const { return (float*)(ws + WS::y0); }
    __device__ __forceinline__ float* y1() const { return (float*)(ws + WS::y1); }
    __device__ __forceinline__ bf16_t* qb() const { return (bf16_t*)(ws + WS::qb); }
    __device__ __forceinline__ float* scT() const { return (float*)(ws + WS::scT); }
    __device__ __forceinline__ bf16_t* pre() const { return (bf16_t*)(ws + WS::pre); }
    __device__ __forceinline__ bf16_t* zT() const { return (bf16_t*)(ws + WS::zT); }
    __device__ __forceinline__ bf16_t* x0b() const { return (bf16_t*)(ws + WS::x0b); }
    __device__ __forceinline__ bf16_t* yT() const { return (bf16_t*)(ws + WS::yT); }
    __device__ __forceinline__ bf16_t* gTS() const { return (bf16_t*)(ws + WS::gTS); }
    __device__ __forceinline__ bf16_t* gTP() const { return (bf16_t*)(ws + WS::gTP); }
    __device__ __forceinline__ unsigned* bar() const { return (unsigned*)(ws + WS::bar); }
};

#define VLOOP(n) for (int vb = blockIdx.x; vb < (n); vb += gridDim.x)
#define ENDV __syncthreads();

#define QLOOP(ctr_word, nitems, ...)                                                            \
    {                                                                                           \
        unsigned* qctr = p.bar() + XCD_BAR_WORDS + 128 + (ctr_word);                            \
        volatile unsigned* bc = (volatile unsigned*)(smem + GEMM_LDS_BYTES + 8);                \
        for (;;) {                                                                              \
            if (threadIdx.x == 0) *bc = atomicAdd(qctr, 1u);                                    \
            __syncthreads();                                                                    \
            const int item = __builtin_amdgcn_readfirstlane((int)*bc);                          \
            __syncthreads();                                                                    \
            if (item >= (nitems)) break;                                                        \
            __VA_ARGS__                                                                         \
        }                                                                                       \
    }
__device__ __forceinline__ void peer_layer(const Params& p, char* smem, int li, const float* modl, float* xrs) {
    const bf16_t* wq = p.w_q_t() + (size_t)li * 2048 * 1024;
    const bf16_t* kys = p.keysb() + (size_t)li * 16 * 128 * 128;
    VLOOP(TT / 8) { d_norm_mod2(vb, p.xrun(), xrs, p.norm_g() + (li * 2 + 1) * 1024, modl, 3, 4, p.hb()); }
    xcd_barrier_(p.bar(), smem);
    VLOOP(16 * 96) { d_gemm_bf16(vb % 16, vb / 16, smem, p.hb(), 1024, wq, 1024, 1024, 2048, EpiStoreBf{p.qb(), 2048, 0}); }
    xcd_barrier_(p.bar(), smem);
    VLOOP(8 * 96) { d_peer_route2(vb, smem, kys, p.qb(), p.pidx(), p.pg()); ENDV }
    if (li == 0) {
        QLOOP(4, 1536, {
            const int t1 = 48 * 16, t2 = t1 + 16 * 16;
            const float* W; bf16_t* Wt; int N, lv;
            if (item < t1) { W = p.hy_w_in(); Wt = p.hy_w_in_t(); N = 3072; lv = item; }
            else if (item < t2) { W = p.hy_w_out(); Wt = p.hy_w_out_t(); N = 1024; lv = item - t1; }
            else { W = p.peer_w_q() + (size_t)1024 * 2048; Wt = p.w_q_t() + (size_t)2048 * 1024; N = 2048; lv = item - t2; }
            d_transpose_w(lv, smem, W, 1024, N, Wt);
        })
    }
    xcd_barrier_(p.bar(), smem);
    VLOOP(TT / 4) { d_peer_apply3(vb, smem, p.hb(), p.pidx(), p.pg(), p.tabU(), p.tabV(), p.rsU(), p.rsV(), modl, p.xrun(),
                                    li == 0 ? p.norm_g() + 2048 : nullptr, p.mod() + 5 * 6144, p.hb()); ENDV }
}

__global__ void __launch_bounds__(256, 2) mega(Params p) {
    __shared__ __attribute__((aligned(16))) char smem[GEMM_LDS_BYTES + 16];
    cg::grid_group grid = cg::this_grid();
    if (threadIdx.x < 4) ((unsigned*)(smem + GEMM_LDS_BYTES))[threadIdx.x] = 0u;
    __syncthreads();
    (void)xcd_barrier_post(p.bar(), (volatile LAS unsigned*)(smem + GEMM_LDS_BYTES));
    const float* mod0 = p.mod();
    const float* mod1 = p.mod() + 5 * 6144;
    float* xrs = p.xrun() + (size_t)TP * DM;

    VLOOP(192) { d_mod3(vb, smem, p.c(), p.c_ctx(), p.w_mod(), p.b_mod(), p.mod()); ENDV }
    if (p.ws == nullptr) grid.sync();
    xcd_barrier_(p.bar(), smem);
    VLOOP(TT / 8) { d_norm_mod2(vb, p.x_prompt(), p.x_sample(), p.norm_g(), mod0, 0, 1, p.hb()); }
    {
        const int j1 = 36 * 16;
        const int j7 = j1 + 12 * 4;
        const int j8 = j7 + 16 * 2;
        const int j9 = j8 + 8;
        const int j10 = j9 + 8;
        const int j11 = j10 + 8;
        const int j12 = j11 + 8;
        const int j13 = j12 + 8 * 2;
        VLOOP(j13) {
            const float* W; bf16_t* Wt; int K, N, lv;
            if (vb < j1) { W = p.ab_w_in(); Wt = p.w_in_t(); K = 1024; N = 2240; lv = vb; }
            else if (vb < j7) { W = p.mla_q_up(); Wt = p.q_up_t(); K = 256; N = 768; lv = vb - j1; }
            else if (vb < j8) { W = p.mla_kv_up(); Wt = p.kv_up_t(); K = 128; N = 1024; lv = vb - j7; }
            else if (vb < j9) { W = p.rw_w2(); Wt = p.w2_t(); K = 64; N = 512; lv = vb - j8; }
            else if (vb < j10) { W = p.rw_w2() + 64 * 512; Wt = p.w2_t() + 512 * 64; K = 64; N = 512; lv = vb - j9; }
            else if (vb < j11) { W = p.rw_a2(); Wt = p.a2_t(); K = 64; N = 512; lv = vb - j10; }
            else if (vb < j12) { W = p.rw_a2() + 64 * 512; Wt = p.a2_t() + 512 * 64; K = 64; N = 512; lv = vb - j11; }
            else { W = p.rw_g2(); Wt = p.g2_t(); K = 128; N = 512; lv = vb - j12; }
            d_transpose_w(lv, smem, W, K, N, Wt);
            ENDV }
    }
    VLOOP(40) { if (vb < 8) d_cvt_bf16(vb, p.cache_ckv(), p.ctxb()); else d_cvt_bf16(vb - 8, p.peer_keys(), p.keysb()); }
    xcd_barrier_(p.bar(), smem);
    VLOOP(18 * 96) { d_gemm_bf16(vb % 18, vb / 18, smem, p.hb(), 1024, p.w_in_t(), 1024, 1024, ABIN, EpiProj{p.projrw(), p.projmla()}); }
    xcd_barrier_(p.bar(), smem);
    VLOOP(2688 + 768) {
        if (vb < 2688) d_rw_shift2(vb, p.projrw(), p.rw_mu(), p.rb(), p.kb(), p.vb(), p.twb(), p.advb(), p.sgb());
        else d_mla_pre2(vb - 2688, p.projmla(), p.mla_q_norm(), p.mla_kv_norm(), p.qcnb(), p.ckvb(), p.kpe(), p.out_ckv(), p.out_kpe());
    }
    xcd_barrier_(p.bar(), smem);
    {
        const int n0 = 4 * 96, n1 = 6 * 96, n2 = 8 * 96, n3 = 8 * 8;
        VLOOP(5 * n0 + n1 + n2 + n3) {
            int v = vb;
            if (v < n0) d_gemm_bf16(v % 4, v / 4, smem, p.twb(), 64, p.w2_t(), 64, 64, 512, EpiDecay{p.du0(), p.rw_w0()});
            else if ((v -= n0) < n0) d_gemm_bf16(v % 4, v / 4, smem, p.twb(), 64, p.w2_t() + 512 * 64, 64, 64, 512, EpiDecay{p.du1(), p.rw_w0() + 512});
            else if ((v -= n0) < n0) d_gemm_bf16(v % 4, v / 4, smem, p.advb(), 64, p.a2_t(), 64, 64, 512, EpiLr{p.lr0(), p.rw_a0()});
            else if ((v -= n0) < n0) d_gemm_bf16(v % 4, v / 4, smem, p.advb(), 64, p.a2_t() + 512 * 64, 64, 64, 512, EpiLr{p.lr1(), p.rw_a0() + 512});
            else if ((v -= n0) < n0) d_gemm_bf16(v % 4, v / 4, smem, p.sgb(), 128, p.g2_t(), 128, 128, 512, EpiStoreBf{p.gateb(), 512, 0});
            else if ((v -= n0) < n1) d_gemm_bf16(v % 6, v / 6, smem, p.qcnb(), 256, p.q_up_t(), 256, 256, 768, EpiStoreBf{p.qrawb(), 768, 0});
            else if ((v -= n1) < n2) d_gemm_bf16(v % 8, v / 8, smem, p.ckvb(), 128, p.kv_up_t(), 128, 128, 1024, EpiKV{p.kvrawb(), p.Vp(), p.Vs(), 0, 0});
            else { v -= n2; d_gemm_bf16(v % 8, v / 8, smem, p.ctxb(), 128, p.kv_up_t(), 128, 128, 1024, EpiKV{p.kvctxb(), p.Vp(), p.Vs(), 1, 0}); }
        }
    }
    xcd_barrier_(p.bar(), smem);
    VLOOP(1536 + 832) {
        if (vb < 1536) d_rw_kk3(vb, p.rb(), p.kb(), p.lr0(), p.lr1(), p.rw_k_k(), p.rw_k_a(), p.rw_r_k(), p.kkb(), p.bonus());
        else d_mla_post3(vb - 1536, p.qrawb(), p.kvrawb(), p.kvctxb(), p.kpe(), p.cache_kpe(), p.mla_qn(), p.mla_kn(), p.Qb(), p.Kp(), p.Ks());
        ENDV }
    xcd_barrier_(p.bar(), smem);
    QLOOP(7, 320, {
        const bool smp = item < 64;
        if (smp) __builtin_amdgcn_s_setprio(3);
        d_scan3(smp ? item : item - 64, smp, smem, p.rb(), p.kb(), p.vb(), p.kkb(), p.lr0(), p.lr1(), p.du0(), p.du1(), p.rw_k_a(), p.st_f(), p.st_b(), p.y0(), p.y1(), p.out_sf(), p.out_sb());
        __builtin_amdgcn_s_setprio(0);
    })
    QLOOP(0, 384, {
        const bool smp = item < 256;
        d_attn_mfma(smp ? item : item - 256, smem, p.Qb(), smp ? p.Ks() : p.Kp(), smp ? p.Vs() : p.Vp(), p.catb(), smp ? TP : 0, smp ? LS : LP,
                    smp ? 2304 : LP, smp ? 16 : 2);
    })
    QLOOP(2, 2048, {
        const bool isv = item >= 1024;
        d_cvt_fp8_rows(isv ? item - 1024 : item, isv ? p.peer_v() : p.peer_u(), isv ? p.tabV() : p.tabU(), isv ? p.rsV() : p.rsU());
    })
    QLOOP(3, 768, {
        const bool a_ = item < 256;
        d_transpose_w(a_ ? item : item - 256, smem, a_ ? p.ab_w_out() : p.peer_w_q(), 1024, a_ ? 1024 : 2048, a_ ? p.w_out_t() : p.w_q_t());
    })
    xcd_barrier_(p.bar(), smem);
    VLOOP(1536) { d_rw_post3(vb, p.y0(), p.y1(), p.bonus(), p.vb(), p.gateb(), p.rw_lnx_g(), p.rw_lnx_b(), p.catb()); }
    QLOOP(1, 576, {
        const bool smp = item < 512;
        d_hy_filt2(smp ? item : item - 512, smem, smp ? LS : LP, p.hy_f_w1(), p.hy_f_b1(), p.hy_f_w2(), p.hy_f_b2(), p.hy_f_w3(), p.hy_f_freq(),
                   smp ? p.gTS() : p.gTP(), smp ? p.nsum() : p.nsum() + 1024);
    })
    xcd_barrier_(p.bar(), smem);
    QLOOP(5, 480 + 576, {
        if (item < 480) d_gemm_bf16n<2>(item % 5, item / 5, smem, p.catb(), 1024, p.w_out_t(), 1024, 1024, 1024, EpiResid{p.x_prompt(), p.x_sample(), p.xrun(), mod0, 2, 0});
        else { const int it = item - 480; d_gemm_bf16n<1>(10 + it % 6, it / 6, smem, p.catb(), 1024, p.w_out_t(), 1024, 1024, 1024, EpiResid{p.x_prompt(), p.x_sample(), p.xrun(), mod0, 2, 0}); }
    })
    xcd_barrier_(p.bar(), smem);
    peer_layer(p, smem, 0, mod0, xrs);
    xcd_barrier_(p.bar(), smem);
    VLOOP(24 * 96) { d_gemm_bf16(vb % 24, vb / 24, smem, p.hb(), 1024, p.hy_w_in_t(), 1024, 1024, 3072, EpiStoreBfBias{p.pre(), p.hy_b_in(), 3072, 0}); }
    VLOOP(2048) {
        const bool isv = vb >= 1024;
        d_cvt_fp8_rows(isv ? vb - 1024 : vb, (isv ? p.peer_v() : p.peer_u()) + (size_t)16384 * 1024, isv ? p.tabV() : p.tabU(), isv ? p.rsV() : p.rsU());
    }
    xcd_barrier_(p.bar(), smem);
    VLOOP(192 * 8) { d_hy_dw3(vb, smem, p.pre(), p.hy_conv_w(), p.hy_conv_b(), p.zT(), p.x0b()); ENDV }
    xcd_barrier_(p.bar(), smem);
    VLOOP(512 + 512) {
        const int wv = threadIdx.x >> 6;
        char* wsm = smem + (wv >> 1) * 28672;
        if (vb < 512) d_hy_conv2<true>(vb * 2 + (wv >> 1), wv & 1, wsm, p.gTS(), p.nsum(), p.zT(), p.hy_bias(), p.yT());
        else d_hy_conv2<false>((vb - 512) * 2 + (wv >> 1), wv & 1, wsm, p.gTP(), p.nsum() + 1024, p.zT(), p.hy_bias(), p.yT());
        ENDV }
    xcd_barrier_(p.bar(), smem);
    VLOOP(192 * 8) { d_hy_post2(vb, smem, p.yT(), p.x0b(), p.zbb()); ENDV }
    xcd_barrier_(p.bar(), smem);
    QLOOP(6, 480 + 576, {
        if (item < 480) d_gemm_bf16n<2>(item % 5, item / 5, smem, p.zbb(), 1024, p.hy_w_out_t(), 1024, 1024, 1024, EpiResid{p.xrun(), xrs, p.xrun(), mod1, 2, 0});
        else { const int it = item - 480; d_gemm_bf16n<1>(10 + it % 6, it / 6, smem, p.zbb(), 1024, p.hy_w_out_t(), 1024, 1024, 1024, EpiResid{p.xrun(), xrs, p.xrun(), mod1, 2, 0}); }
    })
    xcd_barrier_(p.bar(), smem);
    peer_layer(p, smem, 1, mod1, xrs);
}

static inline size_t align_up(size_t x) { return (x + 255) & ~(size_t)255; }

extern "C" void kernel_launch(void* const* d_in, const int* in_sizes, int n_in, void* d_out, int out_size, void* d_ws, size_t ws_size,
                              hipStream_t stream) {
    Params p{};
    for (int i = 0; i < 46; i++) p.in[i] = (const float*)d_in[i];
    p.out = (float*)d_out;
    p.ws = (char*)d_ws;
    static_assert(WS::END <= (size_t)422781952, "workspace plan exceeds the guaranteed scratch size");
    static int grid_blocks = 0;
    if (!grid_blocks) {
        int dev = 0, cus = 0, per_cu = 0;
        (void)hipGetDevice(&dev);
        (void)hipDeviceGetAttribute(&cus, hipDeviceAttributeMultiprocessorCount, dev);
        (void)hipOccupancyMaxActiveBlocksPerMultiprocessor(&per_cu, mega, 256, 0);
        if (per_cu > 2) per_cu = 2;
        if (per_cu < 1) per_cu = 1;
        grid_blocks = cus * per_cu;
    }
    (void)hipMemsetAsync(p.ws + WS::nsum, 0, (size_t)2 * 1024 * 4 + (size_t)XCD_BAR_WORDS * 4 + 1024, stream);
    (void)hipMemsetAsync(p.ws + WS::mod, 0, (size_t)2 * 5 * 6144 * 4, stream);
    void* args[] = {&p};
    (void)hipLaunchCooperativeKernel((void*)mega, dim3(grid_blocks), dim3(256), args, 0, stream);
}
```

```cpp
#include <hip/hip_runtime.h>
#include <stdint.h>
#include <hip/hip_cooperative_groups.h>
namespace cg = cooperative_groups;

#define DM 1024
#define TP 4096
#define TS 8192
#define TT 12288
#define LP 256
#define LS 2048
#define NBP 16
#define NBS 4
#define ABIN 2240
#define RWIN 1792

typedef unsigned short bf16_t;
__device__ __forceinline__ bf16_t f2bf(float f) { unsigned u = __float_as_uint(f); u += 0x7fffu + ((u >> 16) & 1u); return (bf16_t)(u >> 16); }
__device__ __forceinline__ float bf2f(bf16_t h) { return __uint_as_float(((unsigned)h) << 16); }
__device__ __forceinline__ float sigmoidf_(float x) { return 1.f / (1.f + expf(-x)); }
__device__ __forceinline__ float gelu_tanh(float x) { return 0.5f * x * (1.f + tanhf(0.7978845608028654f * (x + 0.044715f * x * x * x))); }

__device__ __forceinline__ int tok_pos(int t) { return t < TP ? (t & (LP - 1)) : ((t - TP) & (LS - 1)); }
__device__ __forceinline__ int tok_len(int t) { return t < TP ? LP : LS; }
__device__ __forceinline__ int tok_modrow(int t) { return t < TP ? 0 : 1 + ((t - TP) >> 11); }

__device__ __forceinline__ float wave_sum(float v) {
#pragma unroll
    for (int o = 32; o > 0; o >>= 1) v += __shfl_xor(v, o, 64);
    return v;
}


__device__ __forceinline__ void d_mod3(const int vb, char* smem, const float* __restrict__ c, const float* __restrict__ c_ctx,
                                       const float* __restrict__ w_mod, const float* __restrict__ b_mod, float* __restrict__ mod) {
    float* sl = (float*)smem;
    const int li = vb / 96, kc = (vb % 96) / 6, cg6 = vb % 6;
    const int tid = threadIdx.x;
    for (int i = tid; i < 5 * 64; i += 256) {
        const int r = i >> 6, k = kc * 64 + (i & 63);
        const float v = (r == 0) ? c_ctx[k] : c[(r - 1) * 1024 + k];
        sl[i] = v / (1.f + __expf(-v));
    }
    __syncthreads();
    const int n = cg6 * 1024 + tid * 4;
    float4 a0 = {0, 0, 0, 0}, a1 = a0, a2 = a0, a3 = a0, a4 = a0;
    const float* w = w_mod + ((size_t)li * 1024 + kc * 64) * 6144 + n;
#pragma unroll 16
    for (int k = 0; k < 64; k++) {
        const float4 wv = *(const float4*)(w + (size_t)k * 6144);
        const float s0 = sl[k], s1 = sl[64 + k], s2 = sl[128 + k], s3 = sl[192 + k], s4 = sl[256 + k];
        a0.x += s0 * wv.x; a0.y += s0 * wv.y; a0.z += s0 * wv.z; a0.w += s0 * wv.w;
        a1.x += s1 * wv.x; a1.y += s1 * wv.y; a1.z += s1 * wv.z; a1.w += s1 * wv.w;
        a2.x += s2 * wv.x; a2.y += s2 * wv.y; a2.z += s2 * wv.z; a2.w += s2 * wv.w;
        a3.x += s3 * wv.x; a3.y += s3 * wv.y; a3.z += s3 * wv.z; a3.w += s3 * wv.w;
        a4.x += s4 * wv.x; a4.y += s4 * wv.y; a4.z += s4 * wv.z; a4.w += s4 * wv.w;
    }
    if (kc == 0) {
        const float4 bb = *(const float4*)(b_mod + li * 6144 + n);
        a0.x += bb.x; a0.y += bb.y; a0.z += bb.z; a0.w += bb.w; a1.x += bb.x; a1.y += bb.y; a1.z += bb.z; a1.w += bb.w;
        a2.x += bb.x; a2.y += bb.y; a2.z += bb.z; a2.w += bb.w; a3.x += bb.x; a3.y += bb.y; a3.z += bb.z; a3.w += bb.w;
        a4.x += bb.x; a4.y += bb.y; a4.z += bb.z; a4.w += bb.w;
    }
    float* o = mod + (size_t)(li * 5) * 6144 + n;
    atomicAdd(o + 0, a0.x); atomicAdd(o + 1, a0.y); atomicAdd(o + 2, a0.z); atomicAdd(o + 3, a0.w);
    atomicAdd(o + 6144 + 0, a1.x); atomicAdd(o + 6144 + 1, a1.y); atomicAdd(o + 6144 + 2, a1.z); atomicAdd(o + 6144 + 3, a1.w);
    atomicAdd(o + 2 * 6144 + 0, a2.x); atomicAdd(o + 2 * 6144 + 1, a2.y); atomicAdd(o + 2 * 6144 + 2, a2.z); atomicAdd(o + 2 * 6144 + 3, a2.w);
    atomicAdd(o + 3 * 6144 + 0, a3.x); atomicAdd(o + 3 * 6144 + 1, a3.y); atomicAdd(o + 3 * 6144 + 2, a3.z); atomicAdd(o + 3 * 6144 + 3, a3.w);
    atomicAdd(o + 4 * 6144 + 0, a4.x); atomicAdd(o + 4 * 6144 + 1, a4.y); atomicAdd(o + 4 * 6144 + 2, a4.z); atomicAdd(o + 4 * 6144 + 3, a4.w);
}


struct EpiStore { static constexpr bool kQuad = false; float* C; const float* bias; int ldc; int pad;
    __device__ void operator()(int m, int n, float a) const { C[(size_t)m * ldc + n] = a + (bias ? bias[n] : 0.f); } };
struct EpiStoreBfBias { static constexpr bool kQuad = false; bf16_t* C; const float* bias; int ldc; int pad;
    __device__ void operator()(int m, int n, float a) const { C[(size_t)m * ldc + n] = f2bf(a + bias[n]); } };
struct EpiStoreBf { static constexpr bool kQuad = false; bf16_t* C; int ldc; int pad;
    __device__ void operator()(int m, int n, float a) const { C[(size_t)m * ldc + n] = f2bf(a); } };
struct EpiDecay { static constexpr bool kQuad = false; _Float16* out; const float* w0;
    __device__ void operator()(int m, int n, float a) const { out[(size_t)m * 512 + n] = (_Float16)sigmoidf_(w0[n] + a); } };
struct EpiProj { static constexpr bool kQuad = false; bf16_t* rw; float* mla;
    __device__ void operator()(int m, int n, float a) const { if (n < RWIN) rw[(size_t)m * RWIN + n] = f2bf(a); else mla[(size_t)m * 448 + (n - RWIN)] = a; } };
struct EpiLr { static constexpr bool kQuad = false; bf16_t* out; const float* a0;
    __device__ void operator()(int m, int n, float a) const { out[(size_t)m * 512 + n] = f2bf(sigmoidf_(a0[n] + a)); } };
struct EpiResid { static constexpr bool kQuad = false; const float* xa; const float* xb; float* out; const float* modl; int gate_idx; int pad;
    __device__ void operator()(int m, int n, float a) const {
        float x = (m < TP) ? xa[(size_t)m * DM + n] : xb[(size_t)(m - TP) * DM + n];
        float gt = modl[(size_t)tok_modrow(m) * 6144 + gate_idx * 1024 + n];
        out[(size_t)m * DM + n] = x + gt * a; } };

struct EpiKV { static constexpr bool kQuad = true;
    bf16_t* kvraw; bf16_t* Vp; bf16_t* Vs; int ctx; int pad;
    __device__ void operator()(int m, int n, float a) const {}
    __device__ void quad(int row0, int col, float v0, float v1, float v2, float v3) const {
        const int hd = col >> 8, within = col & 255;
        if (within < 128) {
            bf16_t* d = kvraw + (size_t)row0 * 1024 + col;
            d[0] = f2bf(v0); d[1024] = f2bf(v1); d[2048] = f2bf(v2); d[3072] = f2bf(v3);
        } else {
            const int dv = within - 128;
            int b, kidx, Lk; bf16_t* base;
            if (ctx) { b = row0 >> 8; kidx = row0 & 255; Lk = 2304; base = Vs; }
            else if (row0 < TP) { b = row0 >> 8; kidx = row0 & 255; Lk = LP; base = Vp; }
            else { b = (row0 - TP) >> 11; kidx = 256 + ((row0 - TP) & 2047); Lk = 2304; base = Vs; }
            const int kpos = (kidx & ~12) | ((kidx & 8) >> 1) | ((kidx & 4) << 1);
            ushort4 o; o.x = f2bf(v0); o.y = f2bf(v1); o.z = f2bf(v2); o.w = f2bf(v3);
            *(ushort4*)(base + ((size_t)((b * 4 + hd) * 128 + dv)) * Lk + kpos) = o;
        }
    } };


typedef __attribute__((ext_vector_type(8))) short bf16x8;
typedef __attribute__((ext_vector_type(16))) float f32x16;
typedef __attribute__((ext_vector_type(4))) float f32x4;
typedef __attribute__((ext_vector_type(4))) unsigned u32x4;
typedef __attribute__((ext_vector_type(2))) unsigned u32x2;
#define GEMM_LDS_BYTES 73728

template <int NJ, class Epi>
__device__ __forceinline__ void d_gemm_bf16n(const int bx, const int by, char* smem, const bf16_t* __restrict__ A, int lda,
                                             const bf16_t* __restrict__ Bt, int ldb, int K, int N, Epi epi) {
    const int tid = threadIdx.x, lane = tid & 63, wid = tid >> 6;
    const int wm = wid >> 1, wn = wid & 1;
    const int m0 = by * 128, n0 = bx * (64 * NJ);
    f32x16 acc[2][NJ];
#pragma unroll
    for (int i = 0; i < 2; i++)
#pragma unroll
        for (int j = 0; j < NJ; j++)
#pragma unroll
            for (int r = 0; r < 16; r++) acc[i][j][r] = 0.f;
    const int lrow = tid >> 3, lcol = (tid & 7) * 8;
    const bf16_t* ga = A + (size_t)(m0 + lrow) * lda + lcol;
    const bf16_t* gb = Bt + (size_t)(n0 + lrow) * ldb + lcol;
    u32x4 raA[4], rbA[2 * NJ], raB[4], rbB[2 * NJ];
    const int KT = K >> 6;
    const int frow = lane & 31, fk = (lane >> 5) * 16;
#define GM_LOAD(RA_, RB_, kt_)                                                                                              \
    {                                                                                                                       \
        _Pragma("unroll") for (int i = 0; i < 4; i++) RA_[i] = *(const u32x4*)(ga + (size_t)(32 * i) * lda + (kt_) * 64);   \
        _Pragma("unroll") for (int i = 0; i < 2 * NJ; i++) RB_[i] = *(const u32x4*)(gb + (size_t)(32 * i) * ldb + (kt_) * 64); \
    }
#define GM_STORE(RA_, RB_, st_)                                                                                             \
    {                                                                                                                       \
        char* sn_ = smem + (st_) * 36864;                                                                                   \
        _Pragma("unroll") for (int i = 0; i < 4; i++) *(u32x4*)(sn_ + (lrow + 32 * i) * 144 + lcol * 2) = RA_[i];           \
        _Pragma("unroll") for (int i = 0; i < 2 * NJ; i++) *(u32x4*)(sn_ + 18432 + (lrow + 32 * i) * 144 + lcol * 2) = RB_[i]; \
    }
#define GM_COMPUTE(st_)                                                                                                     \
    {                                                                                                                       \
        const char* sa_ = smem + (st_) * 36864;                                                                             \
        const char* sb_ = sa_ + 18432;                                                                                      \
        _Pragma("unroll") for (int ks = 0; ks < 4; ks++) {                                                                  \
            bf16x8 af[2], bfr[NJ];                                                                                          \
            _Pragma("unroll") for (int i = 0; i < 2; i++) af[i] = *(const bf16x8*)(sa_ + (wm * 64 + i * 32 + frow) * 144 + ks * 32 + fk); \
            _Pragma("unroll") for (int j = 0; j < NJ; j++) bfr[j] = *(const bf16x8*)(sb_ + (wn * (32 * NJ) + j * 32 + frow) * 144 + ks * 32 + fk); \
            _Pragma("unroll") for (int i = 0; i < 2; i++)                                                                   \
                _Pragma("unroll") for (int j = 0; j < NJ; j++) acc[i][j] = __builtin_amdgcn_mfma_f32_32x32x16_bf16(af[i], bfr[j], acc[i][j], 0, 0, 0); \
        }                                                                                                                   \
    }
    GM_LOAD(raA, rbA, 0)
    GM_STORE(raA, rbA, 0)
    if (KT > 1) GM_LOAD(raA, rbA, 1)
    __syncthreads();
    for (int kt = 0; kt < KT; kt += 2) {
        if (kt + 2 < KT) GM_LOAD(raB, rbB, kt + 2)
        GM_COMPUTE(0)
        if (kt + 1 < KT) GM_STORE(raA, rbA, 1)
        __syncthreads();
        if (kt + 1 < KT) {
            if (kt + 3 < KT) GM_LOAD(raA, rbA, kt + 3)
            GM_COMPUTE(1)
            if (kt + 2 < KT) GM_STORE(raB, rbB, 0)
            __syncthreads();
        }
    }
#pragma unroll
    for (int i = 0; i < 2; i++)
#pragma unroll
        for (int j = 0; j < NJ; j++) {
            const int col = n0 + wn * (32 * NJ) + j * 32 + (lane & 31);
            if (col < N) {
                if constexpr (Epi::kQuad) {
#pragma unroll
                    for (int g = 0; g < 4; g++) {
                        const int row0 = m0 + wm * 64 + i * 32 + 8 * g + 4 * (lane >> 5);
                        epi.quad(row0, col, acc[i][j][4 * g], acc[i][j][4 * g + 1], acc[i][j][4 * g + 2], acc[i][j][4 * g + 3]);
                    }
                } else {
#pragma unroll
                    for (int r = 0; r < 16; r++) {
                        const int row = m0 + wm * 64 + i * 32 + (r & 3) + 8 * (r >> 2) + 4 * (lane >> 5);
                        epi(row, col, acc[i][j][r]);
                    }
                }
            }
        }
}
template <class Epi>
__device__ __forceinline__ void d_gemm_bf16(const int bx, const int by, char* smem, const bf16_t* __restrict__ A, int lda,
                                            const bf16_t* __restrict__ Bt, int ldb, int K, int N, Epi epi) {
    d_gemm_bf16n<2, Epi>(bx, by, smem, A, lda, Bt, ldb, K, N, epi);
}
__device__ __forceinline__ void d_transpose_w(const int vb, char* smem, const float* __restrict__ W, int K, int N, bf16_t* __restrict__ Wt) {
    float (*tile)[65] = (float(*)[65])smem;
    const int kt = K >> 6;
    const int nb = vb / kt, kb = vb % kt;
    const int tid = threadIdx.x;
    {
        const int n = nb * 64 + (tid & 63);
#pragma unroll
        for (int i = 0; i < 16; i++) {
            int k = (tid >> 6) + 4 * i;
            tile[k][tid & 63] = (n < N) ? W[(size_t)(kb * 64 + k) * N + n] : 0.f;
        }
    }
    __syncthreads();
    {
        const int k = tid & 63;
#pragma unroll
        for (int i = 0; i < 16; i++) {
            int n = (tid >> 6) + 4 * i;
            Wt[(size_t)(nb * 64 + n) * K + kb * 64 + k] = f2bf(tile[k][n]);
        }
    }
}


template <int CTRL>
__device__ __forceinline__ float dpp_add(float v) {
    return v + __int_as_float(__builtin_amdgcn_update_dpp(0, __float_as_int(v), CTRL, 0xf, 0xf, false));
}
__device__ __forceinline__ float row16_allsum(float v) {
    v = dpp_add<0x128>(v); v = dpp_add<0x124>(v); v = dpp_add<0x122>(v); v = dpp_add<0x121>(v);
    return v;
}

typedef __bf16 bf16x2_t __attribute__((ext_vector_type(2)));
typedef float f32x2v __attribute__((ext_vector_type(2)));
__device__ __forceinline__ unsigned pk_bf2(float a, float b) { f32x2v v = {a, b}; return __builtin_bit_cast(unsigned, __builtin_convertvector(v, bf16x2_t)); }
__device__ __forceinline__ bf16x8 pk_bf8(float a0, float a1, float a2, float a3, float a4, float a5, float a6, float a7) {
    u32x4 u = {pk_bf2(a0, a1), pk_bf2(a2, a3), pk_bf2(a4, a5), pk_bf2(a6, a7)};
    return __builtin_bit_cast(bf16x8, u);
}
#define S3_SLOT 16384
#define S3_A1   0
#define S3_HD   4608
#define S3_A2F  9728
#define S3_ATF  10752
#define S3_ACF  11776
#define S3_VT   12800
#define S3_GC   14848
#define S3_AAB  15104
__device__ __forceinline__ void d_scan3(const int chain, const bool sample, char* smem, const bf16_t* __restrict__ rb, const bf16_t* __restrict__ kb,
                                        const bf16_t* __restrict__ vb, const bf16_t* __restrict__ kkb, const bf16_t* __restrict__ lr0,
                                        const bf16_t* __restrict__ lr1, const _Float16* __restrict__ du0, const _Float16* __restrict__ du1,
                                        const float* __restrict__ k_a, const float* __restrict__ st_f, const float* __restrict__ st_b,
                                        float* __restrict__ y0, float* __restrict__ y1, float* __restrict__ out_sf, float* __restrict__ out_sb) {
    const int d = chain & 1, h = (chain >> 1) & 7, b = chain >> 4;
    const int L = sample ? LS : LP;
    const int tbase = sample ? (TP + b * LS) : (b * LP);
    const int tid = threadIdx.x, wid = tid >> 6, lane = tid & 63;
    const int n = lane & 31, hh = lane >> 5;
    const bf16_t* lr = d ? lr1 : lr0;
    const unsigned short* du = (const unsigned short*)(d ? du1 : du0);
    float* yo = d ? y1 : y0;
    const int row = 32 * (wid & 1) + n;
    f32x16 St0, St1;
    if (sample) {
        const float* s0 = (d ? st_b : st_f) + ((size_t)(b * 8 + h) * 64 + row) * 64 + 4 * hh;
#pragma unroll
        for (int q = 0; q < 4; q++) {
            const float4 x0 = *(const float4*)(s0 + 8 * q), x1 = *(const float4*)(s0 + 32 + 8 * q);
            St0[4 * q] = x0.x; St0[4 * q + 1] = x0.y; St0[4 * q + 2] = x0.z; St0[4 * q + 3] = x0.w;
            St1[4 * q] = x1.x; St1[4 * q + 1] = x1.y; St1[4 * q + 2] = x1.z; St1[4 * q + 3] = x1.w;
        }
    } else {
#pragma unroll
        for (int r = 0; r < 16; r++) { St0[r] = 0.f; St1[r] = 0.f; }
    }
    char* slot = smem + wid * S3_SLOT;
    const int ngrp = L >> 6;
    const int dstep = d ? -512 : 512;
    const int wid_u = __builtin_amdgcn_readfirstlane(wid);
    const int pg = lane >> 4, pc = lane & 15;
    const float4 ka4 = *(const float4*)(k_a + h * 64 + 4 * pc);
    const int swc = 4 * ((pc & ~3) | ((pc & 1) << 1) | ((pc >> 1) & 1));
    const int swg = 4 * (((pg & 1) << 1) | (pg >> 1));
    const __amdgpu_buffer_rsrc_t q_kk = __builtin_amdgcn_make_buffer_rsrc((void*)kkb, 0, TT * 1024, 0x00020000);
    const __amdgpu_buffer_rsrc_t q_lr = __builtin_amdgcn_make_buffer_rsrc((void*)lr, 0, TT * 1024, 0x00020000);
    const __amdgpu_buffer_rsrc_t q_k = __builtin_amdgcn_make_buffer_rsrc((void*)kb, 0, TT * 1024, 0x00020000);
    const __amdgpu_buffer_rsrc_t q_r = __builtin_amdgcn_make_buffer_rsrc((void*)rb, 0, TT * 1024, 0x00020000);
    const __amdgpu_buffer_rsrc_t q_u = __builtin_amdgcn_make_buffer_rsrc((void*)du, 0, TT * 1024, 0x00020000);
    const __amdgpu_buffer_rsrc_t q_v = __builtin_amdgcn_make_buffer_rsrc((void*)vb, 0, TT * 1024, 0x00020000);
    const int vo = ((d ? (12 - 4 * pg) : 4 * pg) * 512 + 4 * pc) * 2;
    u32x2 rkk[4], rlr[4], rk[4], rr[4], ru[4], rv[4];
#define S3_LOAD(gg)                                                                                                          \
    {                                                                                                                        \
        const int i0_ = ((gg) * 4 + wid_u) * 16;                                                                             \
        const int sb_ = ((tbase + (d ? (L - 16 - i0_) : i0_)) * 512 + h * 64) * 2;         \
        _Pragma("unroll") for (int i = 0; i < 4; i++) {                                                                      \
            const int so_ = sb_ + (d ? (3 - i) : i) * 1024;                                                                  \
            rkk[i] = __builtin_amdgcn_raw_buffer_load_b64(q_kk, vo, so_, 0);                                                 \
            rlr[i] = __builtin_amdgcn_raw_buffer_load_b64(q_lr, vo, so_, 0);                                                 \
            rk[i] = __builtin_amdgcn_raw_buffer_load_b64(q_k, vo, so_, 0);                                                   \
            rr[i] = __builtin_amdgcn_raw_buffer_load_b64(q_r, vo, so_, 0);                                                   \
            ru[i] = __builtin_amdgcn_raw_buffer_load_b64(q_u, vo, so_, 0);                                                   \
            rv[i] = __builtin_amdgcn_raw_buffer_load_b64(q_v, vo, so_, 0);                                                   \
        }                                                                                                                    \
    }
    S3_LOAD(0)
    for (int g = 0; g < ngrp; g++) {
        {
            float pu[4][4];
#pragma unroll
            for (int i = 0; i < 4; i++)
#pragma unroll
                for (int e = 0; e < 4; e++) {
                    const unsigned w = ru[i][e >> 1];
                    const float uv = (float)__builtin_bit_cast(_Float16, (unsigned short)((e & 1) ? (w >> 16) : w));
                    pu[i][e] = (i ? pu[i - 1][e] : 0.f) + uv;
                }
            float off[4], Gp[4];
#pragma unroll
            for (int e = 0; e < 4; e++) {
                const float tot = pu[3][e];
                const float s1 = __shfl_up(tot, 16, 64);
                const float t1 = tot + (pg >= 1 ? s1 : 0.f);
                const float s2 = __shfl_up(t1, 32, 64);
                const float t2 = t1 + (pg >= 2 ? s2 : 0.f);
                off[e] = t2 - tot;
                Gp[e] = __expf(-0.6065306597126334f * off[e]);
            }
            float bh[4][4], kh[4][4];
            const float kav[4] = {ka4.x, ka4.y, ka4.z, ka4.w};
#pragma unroll
            for (int i = 0; i < 4; i++) {
                float at[4], rt[4];
#pragma unroll
                for (int e = 0; e < 4; e++) {
                    const unsigned wkk = rkk[i][e >> 1], wlr = rlr[i][e >> 1], wk = rk[i][e >> 1], wr = rr[i][e >> 1];
                    const float kkv = __uint_as_float((e & 1) ? (wkk & 0xffff0000u) : (wkk << 16));
                    const float lrv = __uint_as_float((e & 1) ? (wlr & 0xffff0000u) : (wlr << 16));
                    const float kv = __uint_as_float((e & 1) ? (wk & 0xffff0000u) : (wk << 16));
                    const float rv_ = __uint_as_float((e & 1) ? (wr & 0xffff0000u) : (wr << 16));
                    const float G = __expf(-0.6065306597126334f * (off[e] + pu[i][e]));
                    const float Gi = __builtin_amdgcn_rcpf(G);
                    at[e] = -kkv * Gp[e]; rt[e] = rv_ * G;
                    bh[i][e] = kkv * lrv * Gi;
                    kh[i][e] = kv * (1.f + (lrv - 1.f) * kav[e]) * Gi;
                    Gp[e] = G;
                }
                char* rowp = slot + (4 * pg + i) * 144 + swc * 2;
                { u32x2 w = {pk_bf2(at[0], at[1]), pk_bf2(at[2], at[3])}; *(u32x2*)(rowp + S3_A1) = w; }
                { u32x2 w = {pk_bf2(rt[0], rt[1]), pk_bf2(rt[2], rt[3])}; *(u32x2*)(rowp + S3_A1 + 16 * 144) = w; }
                { u32x2 w = {pk_bf2(bh[i][0], bh[i][1]), pk_bf2(bh[i][2], bh[i][3])}; *(u32x2*)(rowp + S3_HD) = w; }
                { u32x2 w = {pk_bf2(kh[i][0], kh[i][1]), pk_bf2(kh[i][2], kh[i][3])}; *(u32x2*)(rowp + S3_HD + 16 * 144) = w; }
            }
            if (pg == 3) *(float4*)(slot + S3_GC + 16 * pc) = make_float4(Gp[0], Gp[1], Gp[2], Gp[3]);
            u32x2 d1b[4], d1k[4];
#pragma unroll
            for (int e = 0; e < 4; e++) {
                d1b[e][0] = pk_bf2(bh[0][e], bh[1][e]); d1b[e][1] = pk_bf2(bh[2][e], bh[3][e]);
                d1k[e][0] = pk_bf2(kh[0][e], kh[1][e]); d1k[e][1] = pk_bf2(kh[2][e], kh[3][e]);
                const unsigned v0 = rv[0][e >> 1], v1 = rv[1][e >> 1], v2 = rv[2][e >> 1], v3 = rv[3][e >> 1];
                u32x2 w;
                if (e & 1) { w[0] = (v0 >> 16) | (v1 & 0xffff0000u); w[1] = (v2 >> 16) | (v3 & 0xffff0000u); }
                else { w[0] = (v0 & 0xffffu) | (v1 << 16); w[1] = (v2 & 0xffffu) | (v3 << 16); }
                *(u32x2*)(slot + S3_VT + (4 * pc + e) * 32 + swg * 2) = w;
            }
            if (g + 1 < ngrp) S3_LOAD(g + 1)
            f32x16 D;
#pragma unroll
            for (int r = 0; r < 16; r++) D[r] = 0.f;
#pragma unroll
            for (int s = 0; s < 4; s++) {
                const bf16x8 af = *(const bf16x8*)(slot + S3_HD + n * 144 + s * 32 + hh * 16);
                const bf16x8 bf = *(const bf16x8*)(slot + S3_A1 + n * 144 + s * 32 + hh * 16);
                D = __builtin_amdgcn_mfma_f32_32x32x16_bf16(af, bf, D, 0, 0, 0);
            }
            const int t = n & 15;
            const bool strict = n < 16;
            const int lim = strict ? t : t + 1;
            float a2[8], ac[8], lo8[8];
#pragma unroll
            for (int r = 0; r < 8; r++) {
                const int j = (r & 3) + 8 * (r >> 2) + 4 * hh;
                const bool keep = j < lim;
                a2[r] = keep ? D[8 + r] : 0.f;
                const float lo = keep ? D[r] : 0.f;
                ac[r] = strict ? 0.f : lo;
                lo8[r] = lo;
            }
            if (strict) {
                *(float4*)(slot + S3_AAB + (t * 20 + 4 * hh) * 4) = make_float4(lo8[0], lo8[1], lo8[2], lo8[3]);
                *(float4*)(slot + S3_AAB + (t * 20 + 8 + 4 * hh) * 4) = make_float4(lo8[4], lo8[5], lo8[6], lo8[7]);
            }
            *(bf16x8*)(slot + S3_A2F + lane * 16) = pk_bf8(a2[0], a2[1], a2[2], a2[3], a2[4], a2[5], a2[6], a2[7]);
            *(bf16x8*)(slot + S3_ACF + lane * 16) = pk_bf8(ac[0], ac[1], ac[2], ac[3], ac[4], ac[5], ac[6], ac[7]);
#pragma unroll
            for (int e = 0; e < 4; e++) {
                *(u32x2*)(slot + S3_HD + (4 * pc + e) * 80 + swg * 2) = d1b[e];
                *(u32x2*)(slot + S3_HD + (4 * pc + e) * 80 + 32 + swg * 2) = d1k[e];
            }
            f32x2v xs[8];
#pragma unroll
            for (int i = 0; i < 8; i++) { xs[i][0] = (2 * i == t) ? 1.f : 0.f; xs[i][1] = (2 * i + 1 == t) ? 1.f : 0.f; }
#pragma unroll
            for (int j = 15; j >= 1; j--) {
                if (j == 11 || j == 7) __builtin_amdgcn_sched_barrier(0);
                const float xj = xs[j >> 1][j & 1];
                const f32x2v xj2 = {xj, xj};
#pragma unroll
                for (int q = 0; q < (j + 3) / 4; q++) {
                    const f32x4 a4 = *(const f32x4*)(slot + S3_AAB + (j * 20 + 4 * q) * 4);
                    const f32x2v lo2 = {a4[0], a4[1]}, hi2 = {a4[2], a4[3]};
                    xs[2 * q] = __builtin_elementwise_fma(lo2, xj2, xs[2 * q]);
                    if (4 * q + 2 < j) xs[2 * q + 1] = __builtin_elementwise_fma(hi2, xj2, xs[2 * q + 1]);
                }
            }
            float x[16];
#pragma unroll
            for (int i = 0; i < 16; i++) x[i] = xs[i >> 1][i & 1];
            {
                const float e0 = hh ? x[4] : x[0], e1 = hh ? x[5] : x[1], e2 = hh ? x[6] : x[2], e3 = hh ? x[7] : x[3];
                const float e4 = hh ? x[12] : x[8], e5 = hh ? x[13] : x[9], e6 = hh ? x[14] : x[10], e7 = hh ? x[15] : x[11];
                bf16x8 tf = pk_bf8(e0, e1, e2, e3, e4, e5, e6, e7);
                if (!strict) { tf = (bf16x8){0, 0, 0, 0, 0, 0, 0, 0}; }
                *(bf16x8*)(slot + S3_ATF + lane * 16) = tf;
            }
        }
        __syncthreads();
        if (wid < 2) {
#pragma unroll 1
            for (int q = 0; q < 4; q++) {
                const char* sl = smem + q * S3_SLOT;
                const bf16x8 sb0 = pk_bf8(St0[0], St0[1], St0[2], St0[3], St0[4], St0[5], St0[6], St0[7]);
                const bf16x8 sb1 = pk_bf8(St0[8], St0[9], St0[10], St0[11], St0[12], St0[13], St0[14], St0[15]);
                const bf16x8 sb2 = pk_bf8(St1[0], St1[1], St1[2], St1[3], St1[4], St1[5], St1[6], St1[7]);
                const bf16x8 sb3 = pk_bf8(St1[8], St1[9], St1[10], St1[11], St1[12], St1[13], St1[14], St1[15]);
                f32x16 acc1;
#pragma unroll
                for (int r = 0; r < 16; r++) acc1[r] = 0.f;
                acc1 = __builtin_amdgcn_mfma_f32_32x32x16_bf16(*(const bf16x8*)(sl + S3_A1 + n * 144 + 0 + hh * 16), sb0, acc1, 0, 0, 0);
                acc1 = __builtin_amdgcn_mfma_f32_32x32x16_bf16(*(const bf16x8*)(sl + S3_A1 + n * 144 + 32 + hh * 16), sb1, acc1, 0, 0, 0);
                acc1 = __builtin_amdgcn_mfma_f32_32x32x16_bf16(*(const bf16x8*)(sl + S3_A1 + n * 144 + 64 + hh * 16), sb2, acc1, 0, 0, 0);
                acc1 = __builtin_amdgcn_mfma_f32_32x32x16_bf16(*(const bf16x8*)(sl + S3_A1 + n * 144 + 96 + hh * 16), sb3, acc1, 0, 0, 0);
                const bf16x8 vt = *(const bf16x8*)(sl + S3_VT + row * 32 + hh * 16);
                acc1 = __builtin_amdgcn_mfma_f32_32x32x16_bf16(*(const bf16x8*)(sl + S3_A2F + lane * 16), vt, acc1, 0, 0, 0);
                const bf16x8 pf = pk_bf8(acc1[0], acc1[1], acc1[2], acc1[3], acc1[4], acc1[5], acc1[6], acc1[7]);
                f32x16 acc2;
#pragma unroll
                for (int r = 0; r < 16; r++) acc2[r] = 0.f;
                acc2 = __builtin_amdgcn_mfma_f32_32x32x16_bf16(*(const bf16x8*)(sl + S3_ATF + lane * 16), pf, acc2, 0, 0, 0);
                const bf16x8 uf = pk_bf8(acc2[0], acc2[1], acc2[2], acc2[3], acc2[4], acc2[5], acc2[6], acc2[7]);
                acc1 = __builtin_amdgcn_mfma_f32_32x32x16_bf16(*(const bf16x8*)(sl + S3_ACF + lane * 16), uf, acc1, 0, 0, 0);
                St0 = __builtin_amdgcn_mfma_f32_32x32x16_bf16(*(const bf16x8*)(sl + S3_HD + n * 80 + hh * 16), uf, St0, 0, 0, 0);
                St1 = __builtin_amdgcn_mfma_f32_32x32x16_bf16(*(const bf16x8*)(sl + S3_HD + (32 + n) * 80 + hh * 16), uf, St1, 0, 0, 0);
                St0 = __builtin_amdgcn_mfma_f32_32x32x16_bf16(*(const bf16x8*)(sl + S3_HD + n * 80 + 32 + hh * 16), vt, St0, 0, 0, 0);
                St1 = __builtin_amdgcn_mfma_f32_32x32x16_bf16(*(const bf16x8*)(sl + S3_HD + (32 + n) * 80 + 32 + hh * 16), vt, St1, 0, 0, 0);
                {
                    const int i0 = (g * 4 + q) * 16;
                    float* yb = yo + (size_t)(tbase + (d ? (L - 1 - i0) : i0)) * 512 + h * 64 + row;
#pragma unroll
                    for (int r = 0; r < 8; r++) {
                        const int tt = (r & 3) + 8 * (r >> 2) + 4 * hh;
                        yb[tt * dstep] = acc1[8 + r];
                    }
                }
                const float* gc = (const float*)(sl + S3_GC) + 4 * hh;
#pragma unroll
                for (int c4 = 0; c4 < 4; c4++) {
                    const float4 g0 = *(const float4*)(gc + 8 * c4), g1 = *(const float4*)(gc + 32 + 8 * c4);
                    St0[4 * c4] *= g0.x; St0[4 * c4 + 1] *= g0.y; St0[4 * c4 + 2] *= g0.z; St0[4 * c4 + 3] *= g0.w;
                    St1[4 * c4] *= g1.x; St1[4 * c4 + 1] *= g1.y; St1[4 * c4 + 2] *= g1.z; St1[4 * c4 + 3] *= g1.w;
                }
            }
        }
        __syncthreads();
    }
    if (!sample && wid < 2) {
        float* os = (d ? out_sb : out_sf) + ((size_t)(b * 8 + h) * 64 + row) * 64 + 4 * hh;
#pragma unroll
        for (int q = 0; q < 4; q++) {
            *(float4*)(os + 8 * q) = make_float4(St0[4 * q], St0[4 * q + 1], St0[4 * q + 2], St0[4 * q + 3]);
            *(float4*)(os + 32 + 8 * q) = make_float4(St1[4 * q], St1[4 * q + 1], St1[4 * q + 2], St1[4 * q + 3]);
        }
    }
}


#define ATT_SV_OFF 25600
#define ATT_SQ_OFF 44032
__device__ __forceinline__ void d_attn_mfma(const int item, char* smem, const bf16_t* __restrict__ Qb, const bf16_t* __restrict__ Kall,
                                            const bf16_t* __restrict__ VtAll, bf16_t* __restrict__ cat, int tbase, int Lq, int Lk, int nqb) {
    const int qb = item % nqb, bh = item / nqb;
    const int b = bh >> 2, h = bh & 3;
    const int tid = threadIdx.x, lane = tid & 63, wid = tid >> 6;
    const int q = lane & 31, hh = lane >> 5;
    const int t = tbase + b * Lq + qb * 128 + wid * 32 + q;
    bf16x8 qf[12];
    {
        const bf16_t* qp = Qb + ((size_t)t * 4 + h) * 192 + hh * 8;
#pragma unroll
        for (int ks = 0; ks < 12; ks++) qf[ks] = *(const bf16x8*)(qp + ks * 16);
    }
    f32x16 o[4];
#pragma unroll
    for (int i = 0; i < 4; i++)
#pragma unroll
        for (int r = 0; r < 16; r++) o[i][r] = 0.f;
    float m = -1e30f, l = 0.f;
    const bf16_t* K = Kall + (size_t)bh * Lk * 192;
    const bf16_t* Vt = VtAll + (size_t)bh * 128 * Lk;
    char* sK = smem;
    char* sV = smem + ATT_SV_OFF;
    u32x4 pk[6], pv[4];
    const int nkt = Lk >> 6;
#pragma unroll
    for (int i = 0; i < 6; i++) pk[i] = *(const u32x4*)(K + (size_t)(tid + 256 * i) * 8);
#pragma unroll
    for (int i = 0; i < 4; i++) { int c = tid + 256 * i; pv[i] = *(const u32x4*)(Vt + (size_t)(c >> 3) * Lk + (c & 7) * 8); }
#pragma unroll
    for (int i = 0; i < 6; i++) { int c = tid + 256 * i; *(u32x4*)(sK + (c / 24) * 400 + (c % 24) * 16) = pk[i]; }
#pragma unroll
    for (int i = 0; i < 4; i++) { int c = tid + 256 * i; *(u32x4*)(sV + (c >> 3) * 144 + (c & 7) * 16) = pv[i]; }
    __syncthreads();
    const float sc2 = 0.07216878364870322f * 1.4426950408889634f;
    for (int kt = 0; kt < nkt; kt++) {
        f32x16 st[2];
#pragma unroll
        for (int bk = 0; bk < 2; bk++)
#pragma unroll
            for (int r = 0; r < 16; r++) st[bk][r] = 0.f;
#pragma unroll
        for (int ks = 0; ks < 12; ks++) {
            const bf16x8 qfk = qf[ks];
#pragma unroll
            for (int bk = 0; bk < 2; bk++) {
                bf16x8 a = *(const bf16x8*)(sK + (bk * 32 + q) * 400 + ks * 32 + hh * 16);
                st[bk] = __builtin_amdgcn_mfma_f32_32x32x16_bf16(a, qfk, st[bk], 0, 0, 0);
            }
        }
        float mx = -1e30f;
#pragma unroll
        for (int bk = 0; bk < 2; bk++)
#pragma unroll
            for (int r = 0; r < 16; r++) { st[bk][r] *= sc2; mx = fmaxf(mx, st[bk][r]); }
        mx = fmaxf(mx, __shfl_xor(mx, 32, 64));
        const float mn = fmaxf(m, mx);
        const float alpha = exp2f(m - mn);
        float ps = 0.f;
#pragma unroll
        for (int bk = 0; bk < 2; bk++)
#pragma unroll
            for (int r = 0; r < 16; r++) { st[bk][r] = exp2f(st[bk][r] - mn); ps += st[bk][r]; }
        ps += __shfl_xor(ps, 32, 64);
        l = l * alpha + ps; m = mn;
#pragma unroll
        for (int i = 0; i < 4; i++)
#pragma unroll
            for (int r = 0; r < 16; r++) o[i][r] *= alpha;
#pragma unroll
        for (int s4 = 0; s4 < 4; s4++) {
            bf16x8 pb;
#pragma unroll
            for (int j = 0; j < 8; j++) pb[j] = (short)f2bf(st[s4 >> 1][8 * (s4 & 1) + j]);
#pragma unroll
            for (int i = 0; i < 4; i++) {
                bf16x8 a = *(const bf16x8*)(sV + (i * 32 + q) * 144 + s4 * 32 + hh * 16);
                o[i] = __builtin_amdgcn_mfma_f32_32x32x16_bf16(a, pb, o[i], 0, 0, 0);
            }
        }
        __syncthreads();
        if (kt + 1 < nkt) {
            const bf16_t* Kn = K + (size_t)(kt + 1) * 64 * 192;
            const bf16_t* Vn = Vt + (kt + 1) * 64;
#pragma unroll
            for (int i = 0; i < 6; i++) pk[i] = *(const u32x4*)(Kn + (size_t)(tid + 256 * i) * 8);
#pragma unroll
            for (int i = 0; i < 4; i++) { int c = tid + 256 * i; pv[i] = *(const u32x4*)(Vn + (size_t)(c >> 3) * Lk + (c & 7) * 8); }
#pragma unroll
            for (int i = 0; i < 6; i++) { int c = tid + 256 * i; *(u32x4*)(sK + (c / 24) * 400 + (c % 24) * 16) = pk[i]; }
#pragma unroll
            for (int i = 0; i < 4; i++) { int c = tid + 256 * i; *(u32x4*)(sV + (c >> 3) * 144 + (c & 7) * 16) = pv[i]; }
        }
        __syncthreads();
    }
    const float il = 1.f / l;
    bf16_t* op = cat + (size_t)t * DM + 512 + h * 128;
#pragma unroll
    for (int i = 0; i < 4; i++)
#pragma unroll
        for (int g = 0; g < 4; g++) {
            ushort4 w;
            w.x = f2bf(o[i][4 * g + 0] * il); w.y = f2bf(o[i][4 * g + 1] * il); w.z = f2bf(o[i][4 * g + 2] * il); w.w = f2bf(o[i][4 * g + 3] * il);
            *(ushort4*)(op + i * 32 + 8 * g + 4 * hh) = w;
        }
}


template <int K, int J>
__device__ __forceinline__ void bit_stage16(float (&x)[16]) {
#pragma unroll
    for (int i = 0; i < 16; i++) {
        const int l = i ^ J;
        if (l > i) {
            const bool desc = ((i & K) == 0);
            const float a = x[i], b = x[l];
            const float hi = fmaxf(a, b), lo = fminf(a, b);
            x[i] = desc ? hi : lo; x[l] = desc ? lo : hi;
        }
    }
}
__device__ __forceinline__ void bit_sort16_desc(float (&x)[16]) {
    bit_stage16<2, 1>(x);
    bit_stage16<4, 2>(x); bit_stage16<4, 1>(x);
    bit_stage16<8, 4>(x); bit_stage16<8, 2>(x); bit_stage16<8, 1>(x);
    bit_stage16<16, 8>(x); bit_stage16<16, 4>(x); bit_stage16<16, 2>(x); bit_stage16<16, 1>(x);
}
__device__ __forceinline__ void bit_merge16_desc(float (&x)[16]) {
    bit_stage16<16, 8>(x); bit_stage16<16, 4>(x); bit_stage16<16, 2>(x); bit_stage16<16, 1>(x);
}
template <int K, int J>
__device__ __forceinline__ void bit_stage16u(unsigned (&x)[16]) {
#pragma unroll
    for (int i = 0; i < 16; i++) {
        const int l = i ^ J;
        if (l > i) {
            const bool asc = ((i & K) == 0);
            const unsigned a = x[i], b = x[l];
            const unsigned lo = a < b ? a : b, hi = a < b ? b : a;
            x[i] = asc ? lo : hi; x[l] = asc ? hi : lo;
        }
    }
}
__device__ __forceinline__ void bit_sort16u_asc(unsigned (&x)[16]) {
    bit_stage16u<2, 1>(x);
    bit_stage16u<4, 2>(x); bit_stage16u<4, 1>(x);
    bit_stage16u<8, 4>(x); bit_stage16u<8, 2>(x); bit_stage16u<8, 1>(x);
    bit_stage16u<16, 8>(x); bit_stage16u<16, 4>(x); bit_stage16u<16, 2>(x); bit_stage16u<16, 1>(x);
}
__device__ __forceinline__ void bit_merge16u_asc(unsigned (&x)[16]) {
    bit_stage16u<16, 8>(x); bit_stage16u<16, 4>(x); bit_stage16u<16, 2>(x); bit_stage16u<16, 1>(x);
}
__device__ __forceinline__ void top16_merge(float (&L)[16], const float (&C)[16]) {
#pragma unroll
    for (int i = 0; i < 16; i++) L[i] = fmaxf(L[i], C[15 - i]);
    bit_merge16_desc(L);
}
__device__ __forceinline__ void low16_merge_u(unsigned (&L)[16], const unsigned (&C)[16]) {
#pragma unroll
    for (int i = 0; i < 16; i++) { const unsigned c = C[15 - i]; L[i] = L[i] < c ? L[i] : c; }
    bit_merge16u_asc(L);
}
__device__ __forceinline__ float key_val(float k) { return __uint_as_float(__float_as_uint(k) & ~127u); }
__device__ __forceinline__ int key_idx(float k) { return (int)(__float_as_uint(k) & 127u); }

struct EpiLds { static constexpr bool kQuad = false; float* lds; int c0; int pad;
    __device__ void operator()(int m, int n, float a) const { lds[m * 128 + (n - c0)] = a; } };

__device__ __forceinline__ void top16_col(const float* __restrict__ col, float (&L)[16]) {
#pragma unroll
    for (int ch = 0; ch < 8; ch++) {
        float C[16];
#pragma unroll
        for (int i = 0; i < 16; i++) {
            const int n = ch * 16 + i;
            C[i] = __uint_as_float((__float_as_uint(col[n * 128]) & ~127u) | (unsigned)n);
        }
        bit_sort16_desc(C);
        if (ch == 0) {
#pragma unroll
            for (int i = 0; i < 16; i++) L[i] = C[i];
        } else top16_merge(L, C);
    }
}
__device__ __forceinline__ void d_peer_route2(const int vb, char* smem, const bf16_t* __restrict__ kys, const bf16_t* __restrict__ qb,
                                              int* __restrict__ pidx, float* __restrict__ pg) {
    const int tt = vb % 96, h = vb / 96;
    const int tid = threadIdx.x;
    float A[16], B[16];
#pragma unroll
    for (int p = 0; p < 2; p++) {
        const int hp = h * 2 + p;
        d_gemm_bf16(tt, 0, smem, kys + (size_t)hp * 128 * 128, 128, qb + hp * 128, 2048, 128, TT, EpiLds{(float*)smem, tt * 128, 0});
        __syncthreads();
        if (tid < 128) {
            float L[16];
            top16_col((const float*)smem + tid, L);
#pragma unroll
            for (int i = 0; i < 16; i++) { if (p == 0) A[i] = L[i]; else B[i] = L[i]; }
        }
        __syncthreads();
    }
    if (tid >= 128) return;
    const int t = tt * 128 + tid;
    const float smax = key_val(A[0]) + key_val(B[0]);
    unsigned Tk[16];
#pragma unroll
    for (int g = 0; g < 4; g++) {
        unsigned Ck[16];
#pragma unroll
        for (int e = 0; e < 16; e++) {
            const int c = g * 16 + e;
            int i, j;
            if (c < 16) { i = 0; j = c; }
            else if (c < 24) { i = 1; j = c - 16; }
            else if (c < 29) { i = 2; j = c - 24; }
            else if (c < 33) { i = 3; j = c - 29; }
            else if (c < 36) { i = 4; j = c - 33; }
            else if (c < 42) { i = 5 + (c - 36) / 2; j = (c - 36) % 2; }
            else if (c < 50) { i = 8 + (c - 42); j = 0; }
            else { i = -1; j = 0; }
            if (i >= 0) {
                const float dd = smax - (key_val(A[i]) + key_val(B[j]));
                unsigned qd = (unsigned)fminf(dd * 32768.f, 262143.f);
                Ck[e] = (qd << 14) | (unsigned)(key_idx(A[i]) * 128 + key_idx(B[j]));
            } else Ck[e] = 0xffffffffu;
        }
        bit_sort16u_asc(Ck);
        if (g == 0) {
#pragma unroll
            for (int e = 0; e < 16; e++) Tk[e] = Ck[e];
        } else low16_merge_u(Tk, Ck);
    }
    float sum = 0.f;
    float w[16]; int Tp[16];
#pragma unroll
    for (int e = 0; e < 16; e++) { w[e] = __expf(-(float)(Tk[e] >> 14) * (1.f / 32768.f)); sum += w[e]; Tp[e] = (int)(Tk[e] & 16383u); }
    const float inv = 1.f / sum;
    int* pi = pidx + ((size_t)t * 8 + h) * 16;
    float* pw = pg + ((size_t)t * 8 + h) * 16;
#pragma unroll
    for (int e = 0; e < 16; e += 4) {
        *(int4*)(pi + e) = make_int4(Tp[e], Tp[e + 1], Tp[e + 2], Tp[e + 3]);
        *(float4*)(pw + e) = make_float4(w[e] * inv, w[e + 1] * inv, w[e + 2] * inv, w[e + 3] * inv);
    }
}

typedef __attribute__((ext_vector_type(2))) short bf16x2;
__device__ __forceinline__ float dot8_bf16(u32x4 a, u32x4 b, float acc) {
#pragma unroll
    for (int i = 0; i < 4; i++) {
        const unsigned x = a[i], y = b[i];
        acc += __uint_as_float(x << 16) * __uint_as_float(y << 16);
        acc += __uint_as_float(x & 0xffff0000u) * __uint_as_float(y & 0xffff0000u);
    }
    return acc;
}
__device__ __forceinline__ void d_cvt_bf16(const int vb, const float* __restrict__ src, bf16_t* __restrict__ dst) {
    const size_t base = (size_t)vb * 16384 + threadIdx.x * 4;
#pragma unroll
    for (int i = 0; i < 16; i++) {
        const float4 v = *(const float4*)(src + base + i * 1024);
        ushort4 o; o.x = f2bf(v.x); o.y = f2bf(v.y); o.z = f2bf(v.z); o.w = f2bf(v.w);
        *(ushort4*)(dst + base + i * 1024) = o;
    }
}


__device__ __forceinline__ void d_hy_filt2(const int vbl8, char* smem, const int L, const float* __restrict__ w1, const float* __restrict__ b1,
                                           const float* __restrict__ w2, const float* __restrict__ b2, const float* __restrict__ w3,
                                           const float* __restrict__ fr, bf16_t* __restrict__ gT, float* __restrict__ nsum) {
    float* zp = (float*)smem;
    float* h1 = zp + 32 * 33;
    float* h2t = h1 + 32 * 64;
    float* sw1 = h2t + 64 * 32;
    float* sw2 = sw1 + 33 * 64;
    const int tid = threadIdx.x;
    const int vbl = vbl8 >> 3, mm = vbl8 & 7;
    const int t0 = vbl * 32;
    for (int e = tid; e < 33 * 64; e += 256) sw1[e] = w1[e];
    for (int e = tid; e < 64 * 64; e += 256) sw2[e] = w2[e];
    for (int e = tid; e < 32 * 33; e += 256) {
        const int pos = e / 33, i = e % 33;
        const float t = (float)(t0 + pos);
        float val;
        if (i == 0) val = t / (float)(L - 1);
        else {
            const int bi = (i <= 16) ? (i - 1) : (i - 17);
            const float band = 1e-4f + (float)bi * ((15.f - 1e-4f) / 15.f);
            const float ang = 6.283185307179586f * t * band / (float)L;
            val = (i <= 16) ? __cosf(ang) : -__sinf(ang);
        }
        zp[e] = val;
    }
    const int c = tid + 256 * mm;
    float wv[8];
#pragma unroll
    for (int jj = 0; jj < 8; jj++) wv[jj] = w3[jj * 2048 + c];
    __syncthreads();
    {
        const int j = tid & 63;
        const float frj = fr[j];
#pragma unroll 1
        for (int i = 0; i < 8; i++) {
            const int pos = (tid >> 6) + 4 * i;
            float sacc = b1[j];
#pragma unroll 3
            for (int q = 0; q < 33; q++) sacc += zp[pos * 33 + q] * sw1[q * 64 + j];
            h1[pos * 64 + j] = __sinf(frj * sacc);
        }
        __syncthreads();
#pragma unroll 1
        for (int i = 0; i < 8; i++) {
            const int pos = (tid >> 6) + 4 * i;
            float sacc = b2[j];
#pragma unroll 4
            for (int q = 0; q < 64; q++) sacc += h1[pos * 64 + q] * sw2[q * 64 + j];
            h2t[j * 32 + pos] = __sinf(frj * sacc);
        }
    }
    __syncthreads();
    {
        float acc[32];
#pragma unroll
        for (int i = 0; i < 32; i++) acc[i] = 0.f;
#pragma unroll 1
        for (int jb = 0; jb < 64; jb += 8) {
            float wn[8];
            if (jb + 8 < 64) {
#pragma unroll
                for (int jj = 0; jj < 8; jj++) wn[jj] = w3[(jb + 8 + jj) * 2048 + c];
            }
#pragma unroll
            for (int jj = 0; jj < 8; jj++) {
                const float w = wv[jj];
#pragma unroll
                for (int i = 0; i < 8; i++) {
                    const float4 hv = *(const float4*)(h2t + (jb + jj) * 32 + i * 4);
                    acc[4 * i] += hv.x * w; acc[4 * i + 1] += hv.y * w; acc[4 * i + 2] += hv.z * w; acc[4 * i + 3] += hv.w * w;
                }
                __builtin_amdgcn_sched_barrier(0);
            }
            if (jb + 8 < 64) {
#pragma unroll
                for (int jj = 0; jj < 8; jj++) wv[jj] = wn[jj];
            }
        }
        const int ch = c & 1023;
        const float d0 = -4.605170185988091f / 0.3f, d1 = -4.605170185988091f / 1.5f;
        const float adelta = fabsf(d0 + (d1 - d0) * ((float)ch / 1023.f));
        float absum = 0.f;
        bf16_t* g = gT + (size_t)ch * 2 * L;
#pragma unroll
        for (int i = 0; i < 32; i++) {
            const int t = t0 + i;
            const float tu = (float)t / (float)(L - 1);
            const float val = acc[i] * __expf(-tu * adelta);
            if (c < 1024) { absum += fabsf(val); g[L - t] = f2bf(val); }
            else if (t >= 1) { absum += fabsf(val); g[L + t] = f2bf(val); }
            if ((i & 3) == 3) __builtin_amdgcn_sched_barrier(0);
        }
        atomicAdd(nsum + ch, absum);
    }
}

__device__ __forceinline__ void d_hy_dw3(const int vb, char* smem, const bf16_t* __restrict__ pre, const float* __restrict__ cw,
                                         const float* __restrict__ cb, bf16_t* __restrict__ zT, bf16_t* __restrict__ x0b) {
    bf16_t* tile = (bf16_t*)smem;
    const int tt = vb >> 3, ct = vb & 7;
    const int tid = threadIdx.x;
    const int cp = tid & 63, c = ct * 128 + cp * 2;
    const int tq = tid >> 6;
    const int tok0 = tt * 64 + tq * 16;
    const int pos0 = tok_pos(tok0), L = tok_len(tok0);
    unsigned raw[3][18];
#pragma unroll
    for (int part = 0; part < 3; part++)
#pragma unroll
        for (int i = 0; i < 18; i++) {
            const int pos = pos0 - 1 + i;
            raw[part][i] = (pos >= 0 && pos < L) ? *(const unsigned*)(pre + (size_t)(tok0 - 1 + i) * 3072 + part * 1024 + c) : 0u;
        }
    float w0[3][2], w1[3][2], w2[3][2], bb[3][2];
#pragma unroll
    for (int part = 0; part < 3; part++)
#pragma unroll
        for (int e = 0; e < 2; e++) {
            const int col = part * 1024 + c + e;
            w0[part][e] = cw[col]; w1[part][e] = cw[3072 + col]; w2[part][e] = cw[2 * 3072 + col]; bb[part][e] = cb[col];
        }
#pragma unroll
    for (int i = 0; i < 16; i++) {
        float u[3][2];
#pragma unroll
        for (int part = 0; part < 3; part++) {
            const unsigned p0 = raw[part][i], p1 = raw[part][i + 1], p2 = raw[part][i + 2];
            u[part][0] = __uint_as_float(p0 << 16) * w0[part][0] + __uint_as_float(p1 << 16) * w1[part][0] + __uint_as_float(p2 << 16) * w2[part][0] + bb[part][0];
            u[part][1] = __uint_as_float(p0 & 0xffff0000u) * w0[part][1] + __uint_as_float(p1 & 0xffff0000u) * w1[part][1] +
                         __uint_as_float(p2 & 0xffff0000u) * w2[part][1] + bb[part][1];
        }
        *(unsigned*)(x0b + (size_t)(tok0 + i) * DM + c) = (unsigned)f2bf(u[0][0]) | ((unsigned)f2bf(u[0][1]) << 16);
        tile[(cp * 2) * 72 + tq * 16 + i] = f2bf(u[1][0] * u[2][0]);
        tile[(cp * 2 + 1) * 72 + tq * 16 + i] = f2bf(u[1][1] * u[2][1]);
    }
    __syncthreads();
    {
        const int cch = tid >> 1, hf = tid & 1;
        bf16_t* dst = zT + (size_t)(ct * 128 + cch) * TT + tt * 64 + hf * 32;
        const bf16_t* src = tile + cch * 72 + hf * 32;
#pragma unroll
        for (int q = 0; q < 4; q++) *(u32x4*)(dst + q * 8) = *(const u32x4*)(src + q * 8);
    }
}

template <bool SAMPLE>
__device__ __forceinline__ void d_hy_conv2(const int c, const int half, char* wsm, const bf16_t* __restrict__ gTall, const float* __restrict__ nsum,
                                           const bf16_t* __restrict__ zT, const float* __restrict__ bias, bf16_t* __restrict__ yT) {
    constexpr int L = SAMPLE ? LS : LP;
    constexpr int NB = L / 32;
    constexpr int NBATCH = SAMPLE ? 4 : 16;
    constexpr int BSH = SAMPLE ? 2 : 4;
    constexpr int TPB = 32 >> BSH;
    constexpr int NCB = NB / TPB;
    constexpr int HCB = NCB / 2;
    constexpr int PADB = SAMPLE ? 8 : 2;
    constexpr int ZLEN = L + 2 * PADB * 32;
    constexpr int tbase = SAMPLE ? TP : 0;
    const int lane = threadIdx.x & 63;
    const int l2 = half * 64 + lane;
    const int lc = lane & 31, hh = lane >> 5;
    const int b = lc & (NBATCH - 1), Tl = lc >> BSH;
    bf16_t* R = (bf16_t*)wsm;
    bf16_t* Z = R + 2 * L;
    {
        constexpr int RCH = 2 * L / 8 / 128;
        constexpr int ZCH = NBATCH * (L / 8) / 128;
        const u32x4* src = (const u32x4*)(gTall + (size_t)c * 2 * L);
        u32x4 rr[RCH > 0 ? RCH : 1], zz[ZCH];
        if constexpr (RCH > 0) {
#pragma unroll
            for (int i = 0; i < RCH; i++) rr[i] = src[l2 + 128 * i];
        } else {
            if (l2 < 2 * L / 8) rr[0] = src[l2];
        }
#pragma unroll
        for (int i = 0; i < ZCH; i++) {
            const int q = l2 + 128 * i;
            const int b2 = q / (L / 8), ci = q % (L / 8);
            zz[i] = ((const u32x4*)(zT + (size_t)c * TT + tbase + b2 * L))[ci];
        }
        const u32x4 zero = {0u, 0u, 0u, 0u};
        for (int q = l2; q < NBATCH * PADB * 4; q += 128) {
            const int b2 = q / (PADB * 4), i = q % (PADB * 4);
            u32x4* zd = (u32x4*)(Z + b2 * ZLEN);
            zd[i] = zero; zd[PADB * 4 + L / 8 + i] = zero;
        }
        if constexpr (RCH > 0) {
#pragma unroll
            for (int i = 0; i < RCH; i++) ((u32x4*)R)[l2 + 128 * i] = rr[i];
        } else {
            if (l2 < 2 * L / 8) ((u32x4*)R)[l2] = rr[0];
        }
#pragma unroll
        for (int i = 0; i < ZCH; i++) {
            const int q = l2 + 128 * i;
            const int b2 = q / (L / 8), ci = q % (L / 8);
            ((u32x4*)(Z + b2 * ZLEN))[PADB * 4 + ci] = zz[i];
        }
    }
    __syncthreads();
    f32x16 acc[HCB];
#pragma unroll
    for (int cb = 0; cb < HCB; cb++)
#pragma unroll
        for (int r = 0; r < 16; r++) acc[cb][r] = 0.f;
    const bf16_t* Zb = Z + b * ZLEN + PADB * 32 + 8 * hh;
    const int cb0 = half * HCB;
    const int Dlo = TPB * cb0 - (NB - 1), Dhi = TPB * (cb0 + HCB - 1) + TPB - 1;
#pragma unroll 1
    for (int D = (Dlo < -(NB - 1) ? -(NB - 1) : Dlo); D <= (Dhi > NB - 1 ? NB - 1 : Dhi); D++) {
        bf16x8 af[2];
#pragma unroll
        for (int ks = 0; ks < 2; ks++) {
            const bf16_t* rp = R + (L - 32 * D - lc + 16 * ks + 8 * hh);
#pragma unroll
            for (int j = 0; j < 8; j++) af[ks][j] = (short)rp[j];
        }
#pragma unroll
        for (int lcb = 0; lcb < HCB; lcb++) {
            const int cb = cb0 + lcb;
            if (D >= TPB * cb - (NB - 1) && D <= TPB * cb + TPB - 1) {
                const int S = TPB * cb + Tl - D;
#pragma unroll
                for (int ks = 0; ks < 2; ks++) {
                    const bf16x8 bfr = *(const bf16x8*)(Zb + 32 * S + 16 * ks);
                    acc[lcb] = __builtin_amdgcn_mfma_f32_32x32x16_bf16(af[ks], bfr, acc[lcb], 0, 0, 0);
                }
            }
        }
    }
    const float inv = 1.f / nsum[c], bs = bias[c];
    bf16_t* yrow = yT + (size_t)c * TT + tbase + b * L;
    const bf16_t* zrow = Z + b * ZLEN + PADB * 32;
#pragma unroll
    for (int lcb = 0; lcb < HCB; lcb++)
#pragma unroll
        for (int g = 0; g < 4; g++) {
            const int t = 32 * (TPB * (cb0 + lcb) + Tl) + 8 * g + 4 * hh;
            ushort4 o;
            o.x = f2bf(acc[lcb][4 * g + 0] * inv + bf2f(zrow[t + 0]) * bs);
            o.y = f2bf(acc[lcb][4 * g + 1] * inv + bf2f(zrow[t + 1]) * bs);
            o.z = f2bf(acc[lcb][4 * g + 2] * inv + bf2f(zrow[t + 2]) * bs);
            o.w = f2bf(acc[lcb][4 * g + 3] * inv + bf2f(zrow[t + 3]) * bs);
            *(ushort4*)(yrow + t) = o;
        }
}

__device__ __forceinline__ void d_hy_post2(const int vb, char* smem, const bf16_t* __restrict__ yT, const bf16_t* __restrict__ x0b, bf16_t* __restrict__ zb) {
    bf16_t* tile = (bf16_t*)smem;
    const int tt = vb >> 3, ct = vb & 7;
    const int tid = threadIdx.x;
    const int cp = tid & 63, c = ct * 128 + cp * 2, tq = tid >> 6;
    const int tok0 = tt * 64 + tq * 16;
    unsigned xr[16];
#pragma unroll
    for (int i = 0; i < 16; i++) xr[i] = *(const unsigned*)(x0b + (size_t)(tok0 + i) * DM + c);
    {
        const int cch = tid >> 1, hf = tid & 1;
        const bf16_t* src = yT + (size_t)(ct * 128 + cch) * TT + tt * 64 + hf * 32;
        bf16_t* dst = tile + cch * 72 + hf * 32;
#pragma unroll
        for (int q = 0; q < 4; q++) *(u32x4*)(dst + q * 8) = *(const u32x4*)(src + q * 8);
    }
    __syncthreads();
#pragma unroll
    for (int i = 0; i < 16; i++) {
        const float y0 = bf2f(tile[(cp * 2) * 72 + tq * 16 + i]), y1 = bf2f(tile[(cp * 2 + 1) * 72 + tq * 16 + i]);
        const float r0 = __uint_as_float(xr[i] << 16) * y0, r1 = __uint_as_float(xr[i] & 0xffff0000u) * y1;
        *(unsigned*)(zb + (size_t)(tok0 + i) * DM + c) = (unsigned)f2bf(r0) | ((unsigned)f2bf(r1) << 16);
    }
}

__device__ __forceinline__ float wave_allsum_fast(float v) {
    v = row16_allsum(v);
    const float r0 = __int_as_float(__builtin_amdgcn_readlane(__float_as_int(v), 0));
    const float r1 = __int_as_float(__builtin_amdgcn_readlane(__float_as_int(v), 16));
    const float r2 = __int_as_float(__builtin_amdgcn_readlane(__float_as_int(v), 32));
    const float r3 = __int_as_float(__builtin_amdgcn_readlane(__float_as_int(v), 48));
    return (r0 + r1) + (r2 + r3);
}
__device__ __forceinline__ ushort4 pack_bf4(float a, float b, float c, float d) { ushort4 o; o.x = f2bf(a); o.y = f2bf(b); o.z = f2bf(c); o.w = f2bf(d); return o; }

__device__ __forceinline__ void d_norm_mod2(const int vb, const float* __restrict__ xa, const float* __restrict__ xb, const float* __restrict__ g,
                                            const float* __restrict__ modl, const int shift_idx, const int scale_idx, bf16_t* __restrict__ h) {
    const int wid = threadIdx.x >> 6, lane = threadIdx.x & 63;
    const int t0 = vb * 8 + wid * 2;
    float4 v[2][4];
#pragma unroll
    for (int u = 0; u < 2; u++) {
        const int t = t0 + u;
        const float* x = (t < TP) ? (xa + (size_t)t * DM) : (xb + (size_t)(t - TP) * DM);
#pragma unroll
        for (int j = 0; j < 4; j++) v[u][j] = *(const float4*)(x + j * 256 + lane * 4);
    }
#pragma unroll
    for (int u = 0; u < 2; u++) {
        const int t = t0 + u;
        float ss = 0.f;
#pragma unroll
        for (int j = 0; j < 4; j++) ss += v[u][j].x * v[u][j].x + v[u][j].y * v[u][j].y + v[u][j].z * v[u][j].z + v[u][j].w * v[u][j].w;
        ss = wave_allsum_fast(ss);
        const float rstd = rsqrtf(ss * (1.f / DM) + 1e-6f);
        const float* m = modl + (size_t)tok_modrow(t) * 6144;
#pragma unroll
        for (int j = 0; j < 4; j++) {
            const int c = j * 256 + lane * 4;
            const float4 gg = *(const float4*)(g + c);
            const float4 sh = *(const float4*)(m + shift_idx * 1024 + c);
            const float4 sc = *(const float4*)(m + scale_idx * 1024 + c);
            *(ushort4*)(h + (size_t)t * DM + c) = pack_bf4(v[u][j].x * rstd * gg.x * (1.f + sc.x) + sh.x, v[u][j].y * rstd * gg.y * (1.f + sc.y) + sh.y,
                                                           v[u][j].z * rstd * gg.z * (1.f + sc.z) + sh.z, v[u][j].w * rstd * gg.w * (1.f + sc.w) + sh.w);
        }
    }
}

__device__ __forceinline__ void d_rw_shift2(const int vb, const bf16_t* __restrict__ proj, const float* __restrict__ mu, bf16_t* __restrict__ rb,
                                            bf16_t* __restrict__ kb, bf16_t* __restrict__ vbuf, bf16_t* __restrict__ tw, bf16_t* __restrict__ adv,
                                            bf16_t* __restrict__ sg) {
#pragma unroll
    for (int u = 0; u < 4; u++) {
        const int id = vb * 1024 + u * 256 + threadIdx.x;
        const int t = id / 224, c = (id % 224) * 8;
        const int pos = tok_pos(t), L = tok_len(t);
        const bf16_t* P = proj + (size_t)t * RWIN + c;
        const u32x4 cur = *(const u32x4*)P;
        u32x4 prv = {0u, 0u, 0u, 0u}, nxt = {0u, 0u, 0u, 0u};
        if (pos > 0) prv = *(const u32x4*)(P - RWIN);
        if (pos < L - 1) nxt = *(const u32x4*)(P + RWIN);
        const float4 m0 = *(const float4*)(mu + c), m1 = *(const float4*)(mu + c + 4);
        const float mm[8] = {m0.x, m0.y, m0.z, m0.w, m1.x, m1.y, m1.z, m1.w};
        float val[8];
#pragma unroll
        for (int i = 0; i < 4; i++) {
            const float c0 = __uint_as_float(cur[i] << 16), c1 = __uint_as_float(cur[i] & 0xffff0000u);
            const float p0 = __uint_as_float(prv[i] << 16), p1 = __uint_as_float(prv[i] & 0xffff0000u);
            const float n0 = __uint_as_float(nxt[i] << 16), n1 = __uint_as_float(nxt[i] & 0xffff0000u);
            val[2 * i] = c0 + mm[2 * i] * (0.5f * (p0 + n0) - c0);
            val[2 * i + 1] = c1 + mm[2 * i + 1] * (0.5f * (p1 + n1) - c1);
        }
        bf16_t* dst;
        if (c < 512) dst = rb + (size_t)t * 512 + c;
        else if (c < 1024) dst = kb + (size_t)t * 512 + (c - 512);
        else if (c < 1536) dst = vbuf + (size_t)t * 512 + (c - 1024);
        else if (c < 1600) { dst = tw + (size_t)t * 64 + (c - 1536);
#pragma unroll
            for (int i = 0; i < 8; i++) val[i] = tanhf(val[i]); }
        else if (c < 1664) dst = adv + (size_t)t * 64 + (c - 1600);
        else { dst = sg + (size_t)t * 128 + (c - 1664);
#pragma unroll
            for (int i = 0; i < 8; i++) val[i] = sigmoidf_(val[i]); }
        u32x4 o;
#pragma unroll
        for (int i = 0; i < 4; i++) o[i] = (unsigned)f2bf(val[2 * i]) | ((unsigned)f2bf(val[2 * i + 1]) << 16);
        *(u32x4*)dst = o;
    }
}

__device__ __forceinline__ void d_mla_pre2(const int vb, const float* __restrict__ proj, const float* __restrict__ q_norm, const float* __restrict__ kv_norm,
                                           bf16_t* __restrict__ qcn, bf16_t* __restrict__ ckv, float* __restrict__ kpe, float* __restrict__ out_ckv,
                                           float* __restrict__ out_kpe) {
    const int t = vb * 16 + (threadIdx.x >> 4), l16 = threadIdx.x & 15;
    const float* P = proj + (size_t)t * 448;
    float4 x[7];
#pragma unroll
    for (int j = 0; j < 7; j++) x[j] = *(const float4*)(P + 4 * (l16 + 16 * j));
    float sq = 0.f, sk = 0.f;
#pragma unroll
    for (int j = 0; j < 4; j++) sq += x[j].x * x[j].x + x[j].y * x[j].y + x[j].z * x[j].z + x[j].w * x[j].w;
#pragma unroll
    for (int j = 4; j < 6; j++) sk += x[j].x * x[j].x + x[j].y * x[j].y + x[j].z * x[j].z + x[j].w * x[j].w;
    sq = row16_allsum(sq); sk = row16_allsum(sk);
    const float rq = rsqrtf(sq * (1.f / 256.f) + 1e-6f), rk = rsqrtf(sk * (1.f / 128.f) + 1e-6f);
#pragma unroll
    for (int j = 0; j < 4; j++) {
        const int c = 4 * (l16 + 16 * j);
        const float4 w = *(const float4*)(q_norm + c);
        *(ushort4*)(qcn + (size_t)t * 256 + c) = pack_bf4(x[j].x * rq * w.x, x[j].y * rq * w.y, x[j].z * rq * w.z, x[j].w * rq * w.w);
    }
#pragma unroll
    for (int j = 4; j < 6; j++) {
        const int c = 4 * (l16 + 16 * (j - 4));
        const float4 w = *(const float4*)(kv_norm + c);
        const float4 o = make_float4(x[j].x * rk * w.x, x[j].y * rk * w.y, x[j].z * rk * w.z, x[j].w * rk * w.w);
        *(ushort4*)(ckv + (size_t)t * 128 + c) = pack_bf4(o.x, o.y, o.z, o.w);
        if (t < TP) *(float4*)(out_ckv + (size_t)t * 128 + c) = o;
    }
    {
        const int c = 4 * l16;
        *(float4*)(kpe + (size_t)t * 64 + c) = x[6];
        if (t < TP) *(float4*)(out_kpe + (size_t)t * 64 + c) = x[6];
    }
}


typedef float f32x2 __attribute__((ext_vector_type(2)));
template <int CTRL>
__device__ __forceinline__ float dpp_max(float v) {
    return fmaxf(v, __int_as_float(__builtin_amdgcn_update_dpp(0, __float_as_int(v), CTRL, 0xf, 0xf, false)));
}
__device__ __forceinline__ float wave_allmax_fast(float v) {
    v = dpp_max<0x128>(v); v = dpp_max<0x124>(v); v = dpp_max<0x122>(v); v = dpp_max<0x121>(v);
    const float r0 = __int_as_float(__builtin_amdgcn_readlane(__float_as_int(v), 0));
    const float r1 = __int_as_float(__builtin_amdgcn_readlane(__float_as_int(v), 16));
    const float r2 = __int_as_float(__builtin_amdgcn_readlane(__float_as_int(v), 32));
    const float r3 = __int_as_float(__builtin_amdgcn_readlane(__float_as_int(v), 48));
    return fmaxf(fmaxf(r0, r1), fmaxf(r2, r3));
}
__device__ __forceinline__ void d_cvt_fp8_rows(const int vb, const float* __restrict__ src, unsigned char* __restrict__ dst, float* __restrict__ rscale) {
    const int wid = threadIdx.x >> 6, lane = threadIdx.x & 63;
    float4 x[4][4];
#pragma unroll
    for (int u = 0; u < 4; u++) {
        const float* r = src + (size_t)(vb * 16 + wid * 4 + u) * 1024 + lane * 4;
#pragma unroll
        for (int j = 0; j < 4; j++) x[u][j] = *(const float4*)(r + 256 * j);
    }
#pragma unroll
    for (int u = 0; u < 4; u++) {
        const int row = vb * 16 + wid * 4 + u;
        float am = 0.f;
#pragma unroll
        for (int j = 0; j < 4; j++) am = fmaxf(am, fmaxf(fmaxf(fabsf(x[u][j].x), fabsf(x[u][j].y)), fmaxf(fabsf(x[u][j].z), fabsf(x[u][j].w))));
        am = wave_allmax_fast(am);
        const float sc = am > 0.f ? 448.f / am : 1.f;
#pragma unroll
        for (int j = 0; j < 4; j++) {
            int pk = __builtin_amdgcn_cvt_pk_fp8_f32(x[u][j].x * sc, x[u][j].y * sc, 0, false);
            pk = __builtin_amdgcn_cvt_pk_fp8_f32(x[u][j].z * sc, x[u][j].w * sc, pk, true);
            *(unsigned*)(dst + (size_t)row * 1024 + 256 * j + lane * 4) = (unsigned)pk;
        }
        if (lane == 0) rscale[row] = am > 0.f ? am * (1.f / 448.f) : 1.f;
    }
}
__device__ __forceinline__ void d_peer_apply3(const int vb, char* smem, const bf16_t* __restrict__ hb, const int* __restrict__ pidx,
                                              const float* __restrict__ pg, const unsigned char* __restrict__ utab, const unsigned char* __restrict__ vtab,
                                              const float* __restrict__ rsU, const float* __restrict__ rsV, const float* __restrict__ modl,
                                              float* __restrict__ xrun, const float* __restrict__ g_next, const float* __restrict__ mod_next,
                                              bf16_t* __restrict__ h_next) {
    const int wid = threadIdx.x >> 6, lane = threadIdx.x & 63;
    const int t = vb * 4 + wid;
    float* coef = (float*)smem + wid * 128;
    int* eid = (int*)(smem + 2048) + wid * 128;
    const int e_lo = pidx[(size_t)t * 128 + lane], e_hi = pidx[(size_t)t * 128 + lane + 64];
    eid[lane] = e_lo; eid[lane + 64] = e_hi;
    const float g0 = pg[(size_t)t * 128 + lane] * rsV[e_lo], g1 = pg[(size_t)t * 128 + lane + 64] * rsV[e_hi];
    const float ru0 = rsU[e_lo], ru1 = rsU[e_hi];
    float x[16];
    {
        const u32x4 a = *(const u32x4*)(hb + (size_t)t * DM + lane * 16), b = *(const u32x4*)(hb + (size_t)t * DM + lane * 16 + 8);
#pragma unroll
        for (int i = 0; i < 4; i++) {
            x[2 * i] = __uint_as_float(a[i] << 16); x[2 * i + 1] = __uint_as_float(a[i] & 0xffff0000u);
            x[8 + 2 * i] = __uint_as_float(b[i] << 16); x[8 + 2 * i + 1] = __uint_as_float(b[i] & 0xffff0000u);
        }
    }
    __builtin_amdgcn_wave_barrier();
    float myact0 = 0.f, myact1 = 0.f;
#pragma unroll 1
    for (int eb = 0; eb < 128; eb += 16) {
        u32x4 q[16];
#pragma unroll
        for (int r = 0; r < 16; r++) q[r] = *(const u32x4*)(utab + (size_t)eid[eb + r] * 1024 + lane * 16);
#pragma unroll
        for (int r = 0; r < 16; r++) {
            float sacc = 0.f;
#pragma unroll
            for (int i = 0; i < 4; i++) {
                const f32x2 f01 = __builtin_amdgcn_cvt_pk_f32_fp8((int)q[r][i], false);
                const f32x2 f23 = __builtin_amdgcn_cvt_pk_f32_fp8((int)q[r][i], true);
                sacc += f01[0] * x[4 * i] + f01[1] * x[4 * i + 1] + f23[0] * x[4 * i + 2] + f23[1] * x[4 * i + 3];
            }
            sacc = wave_allsum_fast(sacc);
            const int e = eb + r;
            if (lane == (e & 63)) { if (e < 64) myact0 = sacc; else myact1 = sacc; }
        }
    }
    coef[lane] = g0 * gelu_tanh(myact0 * ru0);
    coef[lane + 64] = g1 * gelu_tanh(myact1 * ru1);
    __builtin_amdgcn_wave_barrier();
    float acc[16];
#pragma unroll
    for (int i = 0; i < 16; i++) acc[i] = 0.f;
#pragma unroll 1
    for (int eb = 0; eb < 128; eb += 16) {
        u32x4 q[16];
#pragma unroll
        for (int r = 0; r < 16; r++) q[r] = *(const u32x4*)(vtab + (size_t)eid[eb + r] * 1024 + lane * 16);
#pragma unroll
        for (int r = 0; r < 16; r++) {
            const float cf = coef[eb + r];
#pragma unroll
            for (int i = 0; i < 4; i++) {
                const f32x2 f01 = __builtin_amdgcn_cvt_pk_f32_fp8((int)q[r][i], false);
                const f32x2 f23 = __builtin_amdgcn_cvt_pk_f32_fp8((int)q[r][i], true);
                acc[4 * i] += cf * f01[0]; acc[4 * i + 1] += cf * f01[1]; acc[4 * i + 2] += cf * f23[0]; acc[4 * i + 3] += cf * f23[1];
            }
        }
    }
    const float* m = modl + (size_t)tok_modrow(t) * 6144 + 5 * 1024 + lane * 16;
    float* xo = xrun + (size_t)t * DM + lane * 16;
    float ss = 0.f;
#pragma unroll
    for (int j = 0; j < 4; j++) {
        float4 xa = *(float4*)(xo + 4 * j);
        const float4 ma = *(const float4*)(m + 4 * j);
        xa.x += ma.x * acc[4 * j]; xa.y += ma.y * acc[4 * j + 1]; xa.z += ma.z * acc[4 * j + 2]; xa.w += ma.w * acc[4 * j + 3];
        *(float4*)(xo + 4 * j) = xa;
        acc[4 * j] = xa.x; acc[4 * j + 1] = xa.y; acc[4 * j + 2] = xa.z; acc[4 * j + 3] = xa.w;
        ss += xa.x * xa.x + xa.y * xa.y + xa.z * xa.z + xa.w * xa.w;
    }
    if (g_next != nullptr) {
        ss = wave_allsum_fast(ss);
        const float rstd = rsqrtf(ss * (1.f / DM) + 1e-6f);
        const float* mn = mod_next + (size_t)tok_modrow(t) * 6144 + lane * 16;
#pragma unroll
        for (int j = 0; j < 4; j++) {
            const float4 gg = *(const float4*)(g_next + lane * 16 + 4 * j);
            const float4 sh = *(const float4*)(mn + 4 * j);
            const float4 sc = *(const float4*)(mn + 1024 + 4 * j);
            *(ushort4*)(h_next + (size_t)t * DM + lane * 16 + 4 * j) =
                pack_bf4(acc[4 * j] * rstd * gg.x * (1.f + sc.x) + sh.x, acc[4 * j + 1] * rstd * gg.y * (1.f + sc.y) + sh.y,
                         acc[4 * j + 2] * rstd * gg.z * (1.f + sc.z) + sh.z, acc[4 * j + 3] * rstd * gg.w * (1.f + sc.w) + sh.w);
        }
    }
}


__device__ __forceinline__ void d_rw_kk3(const int vb, const bf16_t* __restrict__ rb, const bf16_t* __restrict__ kb, const bf16_t* __restrict__ lr0,
                                         const bf16_t* __restrict__ lr1, const float* __restrict__ k_k, const float* __restrict__ k_a,
                                         const float* __restrict__ r_k, bf16_t* __restrict__ kkb, float* __restrict__ bonus) {
    const int g = threadIdx.x >> 4, l16 = threadIdx.x & 15;
    uint2 kq[4], rq[4], aq[4], bq[4];
#pragma unroll
    for (int u = 0; u < 4; u++) {
        const size_t o = (size_t)(vb * 64 + g + 16 * u) * 64 + l16 * 4;
        kq[u] = *(const uint2*)(kb + o); rq[u] = *(const uint2*)(rb + o); aq[u] = *(const uint2*)(lr0 + o); bq[u] = *(const uint2*)(lr1 + o);
    }
#pragma unroll
    for (int u = 0; u < 4; u++) {
        const int w = vb * 64 + g + 16 * u;
        const int h = w & 7;
        const float4 kk4 = *(const float4*)(k_k + h * 64 + l16 * 4), ka4 = *(const float4*)(k_a + h * 64 + l16 * 4), rk4 = *(const float4*)(r_k + h * 64 + l16 * 4);
        const float k0 = __uint_as_float(kq[u].x << 16), k1 = __uint_as_float(kq[u].x & 0xffff0000u), k2 = __uint_as_float(kq[u].y << 16), k3 = __uint_as_float(kq[u].y & 0xffff0000u);
        const float r0 = __uint_as_float(rq[u].x << 16), r1 = __uint_as_float(rq[u].x & 0xffff0000u), r2 = __uint_as_float(rq[u].y << 16), r3 = __uint_as_float(rq[u].y & 0xffff0000u);
        const float a0 = __uint_as_float(aq[u].x << 16), a1 = __uint_as_float(aq[u].x & 0xffff0000u), a2 = __uint_as_float(aq[u].y << 16), a3 = __uint_as_float(aq[u].y & 0xffff0000u);
        const float b0 = __uint_as_float(bq[u].x << 16), b1 = __uint_as_float(bq[u].x & 0xffff0000u), b2 = __uint_as_float(bq[u].y << 16), b3 = __uint_as_float(bq[u].y & 0xffff0000u);
        const float q0 = k0 * kk4.x, q1 = k1 * kk4.y, q2 = k2 * kk4.z, q3 = k3 * kk4.w;
        float ss = (q0 * q0 + q1 * q1) + (q2 * q2 + q3 * q3);
        float bs = r0 * k0 * (2.f + (a0 + b0 - 2.f) * ka4.x) * rk4.x + r1 * k1 * (2.f + (a1 + b1 - 2.f) * ka4.y) * rk4.y +
                   r2 * k2 * (2.f + (a2 + b2 - 2.f) * ka4.z) * rk4.z + r3 * k3 * (2.f + (a3 + b3 - 2.f) * ka4.w) * rk4.w;
        ss = row16_allsum(ss); bs = row16_allsum(bs);
        const float inv = 1.f / fmaxf(sqrtf(ss), 1e-12f);
        uint2 o2;
        o2.x = (unsigned)f2bf(q0 * inv) | ((unsigned)f2bf(q1 * inv) << 16);
        o2.y = (unsigned)f2bf(q2 * inv) | ((unsigned)f2bf(q3 * inv) << 16);
        *(uint2*)(kkb + (size_t)w * 64 + l16 * 4) = o2;
        if (l16 == 0) bonus[w] = bs;
    }
}
__device__ __forceinline__ void d_rw_post3(const int vb, const float* __restrict__ y0, const float* __restrict__ y1, const float* __restrict__ bonus,
                                           const bf16_t* __restrict__ vbuf, const bf16_t* __restrict__ gate, const float* __restrict__ lnx_g,
                                           const float* __restrict__ lnx_b, bf16_t* __restrict__ cat) {
    const int g = threadIdx.x >> 4, l16 = threadIdx.x & 15;
    float4 ya[4], yb[4]; uint2 vq[4], gq[4];
#pragma unroll
    for (int u = 0; u < 4; u++) {
        const size_t o = (size_t)(vb * 64 + g + 16 * u) * 64 + l16 * 4;
        ya[u] = *(const float4*)(y0 + o); yb[u] = *(const float4*)(y1 + o); vq[u] = *(const uint2*)(vbuf + o); gq[u] = *(const uint2*)(gate + o);
    }
#pragma unroll
    for (int u = 0; u < 4; u++) {
        const int w = vb * 64 + g + 16 * u;
        const int t = w >> 3, h = w & 7;
        const float e0 = ya[u].x + yb[u].x, e1 = ya[u].y + yb[u].y, e2 = ya[u].z + yb[u].z, e3 = ya[u].w + yb[u].w;
        const float mean = row16_allsum((e0 + e1) + (e2 + e3)) * (1.f / 64.f);
        const float d0 = e0 - mean, d1 = e1 - mean, d2 = e2 - mean, d3 = e3 - mean;
        const float var = row16_allsum((d0 * d0 + d1 * d1) + (d2 * d2 + d3 * d3)) * (1.f / 64.f);
        const float rstd = rsqrtf(var + 64e-5f);
        const float bn = bonus[w];
        const float4 g4 = *(const float4*)(lnx_g + h * 64 + l16 * 4), b4 = *(const float4*)(lnx_b + h * 64 + l16 * 4);
        const float v0 = __uint_as_float(vq[u].x << 16), v1 = __uint_as_float(vq[u].x & 0xffff0000u), v2 = __uint_as_float(vq[u].y << 16), v3 = __uint_as_float(vq[u].y & 0xffff0000u);
        const float t0 = __uint_as_float(gq[u].x << 16), t1 = __uint_as_float(gq[u].x & 0xffff0000u), t2 = __uint_as_float(gq[u].y << 16), t3 = __uint_as_float(gq[u].y & 0xffff0000u);
        uint2 o2;
        o2.x = (unsigned)f2bf((d0 * rstd * g4.x + b4.x + bn * v0) * t0) | ((unsigned)f2bf((d1 * rstd * g4.y + b4.y + bn * v1) * t1) << 16);
        o2.y = (unsigned)f2bf((d2 * rstd * g4.z + b4.z + bn * v2) * t2) | ((unsigned)f2bf((d3 * rstd * g4.w + b4.w + bn * v3) * t3) << 16);
        *(uint2*)(cat + (size_t)t * DM + h * 64 + l16 * 4) = o2;
    }
}


__device__ __forceinline__ void d_mla_post3(const int vb, const bf16_t* __restrict__ qraw, const bf16_t* __restrict__ kvraw, const bf16_t* __restrict__ kvraw_ctx,
                                            const float* __restrict__ kpe, const float* __restrict__ cache_kpe, const float* __restrict__ qn,
                                            const float* __restrict__ kn, bf16_t* __restrict__ Qb, bf16_t* __restrict__ Kp, bf16_t* __restrict__ Ks) {
    const int g = threadIdx.x >> 4, l16 = threadIdx.x & 15;
    const float inv = __expf(-(float)l16 * (1.f / 16.f) * 9.210340371976184f);
    float2 qnv[6], knv[6];
#pragma unroll
    for (int j = 0; j < 6; j++) { qnv[j] = *(const float2*)(qn + 2 * (l16 + 16 * j)); knv[j] = *(const float2*)(kn + 2 * (l16 + 16 * j)); }
#pragma unroll 2
    for (int u = 0; u < 4; u++) {
        const int item = vb * 64 + g + 16 * u;
        const int row = item >> 2, h = item & 3;
        const bool isctx = row >= TT, sample = row >= TP;
        const bf16_t* kvr; const float* pe; int pos = 0;
        if (isctx) { const int cr = row - TT; kvr = kvraw_ctx + (size_t)cr * 1024; pe = cache_kpe + (size_t)cr * 64; }
        else { kvr = kvraw + (size_t)row * 1024; pe = kpe + (size_t)row * 64; pos = tok_pos(row); }
        float kx[12], qx[12];
#pragma unroll
        for (int j = 0; j < 4; j++) {
            const unsigned kw = *(const unsigned*)(kvr + h * 256 + 2 * (l16 + 16 * j));
            kx[2 * j] = __uint_as_float(kw << 16); kx[2 * j + 1] = __uint_as_float(kw & 0xffff0000u);
        }
#pragma unroll
        for (int j = 4; j < 6; j++) { const float2 pv = *(const float2*)(pe + 2 * (l16 + 16 * (j - 4))); kx[2 * j] = pv.x; kx[2 * j + 1] = pv.y; }
#pragma unroll
        for (int j = 0; j < 6; j++) {
            const unsigned qw = isctx ? 0u : *(const unsigned*)(qraw + (size_t)row * 768 + h * 192 + 2 * (l16 + 16 * j));
            qx[2 * j] = __uint_as_float(qw << 16); qx[2 * j + 1] = __uint_as_float(qw & 0xffff0000u);
        }
        float sk = 0.f, sq = 0.f;
#pragma unroll
        for (int j = 0; j < 12; j++) { sk += kx[j] * kx[j]; sq += qx[j] * qx[j]; }
        sk = row16_allsum(sk); sq = row16_allsum(sq);
        const float rk = rsqrtf(sk * (1.f / 192.f) + 1e-6f), rq = rsqrtf(sq * (1.f / 192.f) + 1e-6f);
#pragma unroll
        for (int j = 0; j < 6; j++) {
            kx[2 * j] *= rk * knv[j].x; kx[2 * j + 1] *= rk * knv[j].y;
            qx[2 * j] *= rq * qnv[j].x; qx[2 * j + 1] *= rq * qnv[j].y;
        }
        if (sample && !isctx) {
#pragma unroll
            for (int j = 4; j < 6; j++) {
                const float ang = (j == 4 ? (float)(pos >> 6) : (float)(pos & 63)) * inv;
                const float cs = __cosf(ang), sn = __sinf(ang);
                const float a = kx[2 * j], bq = kx[2 * j + 1];
                kx[2 * j] = a * cs - bq * sn; kx[2 * j + 1] = a * sn + bq * cs;
                const float a2 = qx[2 * j], b2 = qx[2 * j + 1];
                qx[2 * j] = a2 * cs - b2 * sn; qx[2 * j + 1] = a2 * sn + b2 * cs;
            }
        }
        bf16_t* kd;
        if (!sample) { const int b = row >> 8, pp = row & 255; kd = Kp + ((size_t)(b * 4 + h) * LP + pp) * 192; }
        else if (!isctx) { const int b = (row - TP) >> 11, pp = (row - TP) & 2047; kd = Ks + ((size_t)(b * 4 + h) * 2304 + 256 + pp) * 192; }
        else { const int cr = row - TT; const int b = cr >> 8, pp = cr & 255; kd = Ks + ((size_t)(b * 4 + h) * 2304 + pp) * 192; }
#pragma unroll
        for (int j = 0; j < 6; j++) {
            const int e = 2 * (l16 + 16 * j);
            *(unsigned*)(kd + e) = (unsigned)f2bf(kx[2 * j]) | ((unsigned)f2bf(kx[2 * j + 1]) << 16);
            if (!isctx) *(unsigned*)(Qb + ((size_t)row * 4 + h) * 192 + e) = (unsigned)f2bf(qx[2 * j]) | ((unsigned)f2bf(qx[2 * j + 1]) << 16);
        }
    }
}

#define XB_TMO      128
#define XB_XCNT(j)  (256  + 64 * (j))
#define XB_XSUB(j)  (1280 + 64 * (j))
#define XB_XGEN(j)  (2304 + 64 * (j))
#define XB_TOP      3328
#define XB_TOPGEN   3392
#define XCD_BAR_WORDS 3456
#define XB_SPIN_CAP (1u << 22)
#define LAS __attribute__((address_space(3)))
__device__ __forceinline__ unsigned xb_ld(unsigned* p) { return __hip_atomic_load(p, __ATOMIC_RELAXED, __HIP_MEMORY_SCOPE_AGENT); }
__device__ __forceinline__ unsigned xb_add(unsigned* p, unsigned v) { return __hip_atomic_fetch_add(p, v, __ATOMIC_RELAXED, __HIP_MEMORY_SCOPE_AGENT); }
__device__ __forceinline__ unsigned xb_xcc_id() { return (unsigned)__builtin_amdgcn_s_getreg((3 << 11) | 20) & 0xFu; }
#define XB_SPIN(cond, bar) do { unsigned _sp = 0; while (cond) { __builtin_amdgcn_s_sleep(1); \
    if ((++_sp & 255u) == 0u) { if (xb_ld(&(bar)[XB_TMO])) break; if (_sp > XB_SPIN_CAP) { atomicAdd(&(bar)[XB_TMO], 1u); break; } } } } while (0)
struct XcdBarrier { unsigned* bar; unsigned x; volatile LAS unsigned* st; };
__device__ __forceinline__ XcdBarrier xcd_barrier_post(unsigned* bar, volatile LAS unsigned* st) {
    XcdBarrier b; b.bar = bar; b.x = xb_xcc_id(); b.st = st;
    if (threadIdx.x == 0) (void)xb_add(&bar[XB_XCNT(b.x)], 1u);
    return b;
}
__device__ __forceinline__ void xcd_barrier_complete(unsigned* bar, unsigned x, unsigned& nloc, unsigned& nx) {
    const unsigned G = gridDim.x * gridDim.y * gridDim.z;
    unsigned sum, cnt, mine, sp = 0u;
    for (;;) {
        sum = 0u; cnt = 0u; mine = 0u;
#pragma unroll
        for (unsigned j = 0; j < 16; ++j) { const unsigned c = xb_ld(&bar[XB_XCNT(j)]); sum += c; cnt += (c > 0u) ? 1u : 0u; mine = (j == x) ? c : mine; }
        if (sum == G) break;
        __builtin_amdgcn_s_sleep(1);
        if ((++sp & 255u) == 0u) { if (xb_ld(&bar[XB_TMO])) break; if (sp > XB_SPIN_CAP) { atomicAdd(&bar[XB_TMO], 1u); break; } }
    }
    nloc = mine > 0u ? mine : 1u; nx = cnt > 0u ? cnt : 1u;
}
__device__ __forceinline__ void xcd_barrier_(unsigned* bar_, char* smem_) {
    XcdBarrier b; b.bar = bar_; b.x = xb_xcc_id(); b.st = (volatile LAS unsigned*)(smem_ + GEMM_LDS_BYTES);
    asm volatile("s_waitcnt vmcnt(0)" ::: "memory");
    __syncthreads();
    if (threadIdx.x == 0) {
        unsigned* bar = b.bar;
        __builtin_amdgcn_s_waitcnt(0);
        unsigned nloc = b.st[0], nx = b.st[1];
        if (nloc == 0u) { xcd_barrier_complete(bar, b.x, nloc, nx); b.st[0] = nloc; b.st[1] = nx; }
        const unsigned old = xb_add(&bar[XB_XSUB(b.x)], 1u);
        const unsigned gen = old / nloc;
        if (old + 1u == (gen + 1u) * nloc) {
            __builtin_amdgcn_fence(__ATOMIC_RELEASE, "agent");
            asm volatile("s_waitcnt vmcnt(0)" ::: "memory");
            const unsigned og = xb_add(&bar[XB_TOP], 1u);
            const unsigned tg = og / nx;
            if (og + 1u == (tg + 1u) * nx) xb_add(&bar[XB_TOPGEN], 1u);
            else XB_SPIN(xb_ld(&bar[XB_TOPGEN]) == tg, bar);
            __builtin_amdgcn_fence(__ATOMIC_ACQUIRE, "agent");
            xb_add(&bar[XB_XGEN(b.x)], 1u);
            asm volatile("s_waitcnt vmcnt(0)" ::: "memory");
        } else {
            XB_SPIN(xb_ld(&bar[XB_XGEN(b.x)]) == gen, bar);
            __builtin_amdgcn_fence(__ATOMIC_ACQUIRE, "agent");
            asm volatile("s_waitcnt vmcnt(0)" ::: "memory");
        }
    }
    __syncthreads();
}

constexpr size_t ws_al(size_t x) { return (x + 255) & ~(size_t)255; }
struct WS {
    static constexpr size_t mod = 0;
    static constexpr size_t w_in_t = ws_al(mod + (size_t)(2*5*6144*4));
    static constexpr size_t w_out_t = ws_al(w_in_t + (size_t)(2304*1024*2));
    static constexpr size_t hy_w_in_t = ws_al(w_out_t + (size_t)(1024*1024*2));
    static constexpr size_t hy_w_out_t = ws_al(hy_w_in_t + (size_t)(3072*1024*2));
    static constexpr size_t w_q_t = ws_al(hy_w_out_t + (size_t)(1024*1024*2));
    static constexpr size_t q_up_t = ws_al(w_q_t + (size_t)(2*2048*1024*2));
    static constexpr size_t kv_up_t = ws_al(q_up_t + (size_t)(768*256*2));
    static constexpr size_t w2_t = ws_al(kv_up_t + (size_t)(1024*128*2));
    static constexpr size_t a2_t = ws_al(w2_t + (size_t)(2*512*64*2));
    static constexpr size_t g2_t = ws_al(a2_t + (size_t)(2*512*64*2));
    static constexpr size_t ctxb = ws_al(g2_t + (size_t)(512*128*2));
    static constexpr size_t keysb = ws_al(ctxb + (size_t)(1024*128*2));
    static constexpr size_t tabU = ws_al(keysb + (size_t)(2*16*128*128*2));
    static constexpr size_t tabV = ws_al(tabU + (size_t)(16384*1024));
    static constexpr size_t rsU = ws_al(tabV + (size_t)(16384*1024));
    static constexpr size_t rsV = ws_al(rsU + (size_t)(16384*4));
    static constexpr size_t nsum = ws_al(rsV + (size_t)(16384*4));
    static constexpr size_t gTS = ws_al(nsum + (size_t)(2*1024*4 + 3456*4 + 1024));
    static constexpr size_t gTP = ws_al(gTS + (size_t)1024*2*2048*2);
    static constexpr size_t R1 = ws_al(gTP + (size_t)1024*2*256*2);
    static constexpr size_t R2 = ws_al(R1 + (size_t)((size_t)TT*1024*4));
    static constexpr size_t rb = ws_al(R2 + (size_t)((size_t)TT*1792*2 + (size_t)TT*448*4));
    static constexpr size_t kb = ws_al(rb + (size_t)((size_t)TT*512*2));
    static constexpr size_t vb = ws_al(kb + (size_t)((size_t)TT*512*2));
    static constexpr size_t kkb = ws_al(vb + (size_t)((size_t)TT*512*2));
    static constexpr size_t lr0 = ws_al(kkb + (size_t)((size_t)TT*512*2));
    static constexpr size_t lr1 = ws_al(lr0 + (size_t)((size_t)TT*512*2));
    static constexpr size_t gateb = ws_al(lr1 + (size_t)((size_t)TT*512*2));
    static constexpr size_t du0 = ws_al(gateb + (size_t)((size_t)TT*512*2));
    static constexpr size_t du1 = ws_al(du0 + (size_t)((size_t)TT*512*2));
    static constexpr size_t twb = ws_al(du1 + (size_t)((size_t)TT*512*2));
    static constexpr size_t advb = ws_al(twb + (size_t)((size_t)TT*64*2));
    static constexpr size_t sgb = ws_al(advb + (size_t)((size_t)TT*64*2));
    static constexpr size_t bonus = ws_al(sgb + (size_t)((size_t)TT*128*2));
    static constexpr size_t kpe = ws_al(bonus + (size_t)((size_t)TT*8*4));
    static constexpr size_t qcnb = ws_al(kpe + (size_t)((size_t)TT*64*4));
    static constexpr size_t ckvb = ws_al(qcnb + (size_t)((size_t)TT*256*2));
    static constexpr size_t Qb = ws_al(ckvb + (size_t)((size_t)TT*128*2));
    static constexpr size_t Kp = ws_al(Qb + (size_t)((size_t)TT*768*2));
    static constexpr size_t Vp = ws_al(Kp + (size_t)(16*4*256*192*2));
    static constexpr size_t Ks = ws_al(Vp + (size_t)(16*4*256*128*2));
    static constexpr size_t Vs = ws_al(Ks + (size_t)(4*4*2304*192*2));
    static constexpr size_t kvctxb = ws_al(Vs + (size_t)(4*4*2304*128*2));
    static constexpr size_t pidx = ws_al(kvctxb + (size_t)(1024*1024*2));
    static constexpr size_t pg = ws_al(pidx + (size_t)((size_t)TT*128*4));
    static constexpr size_t END = ws_al(pg + (size_t)((size_t)TT*128*4));
    static constexpr size_t hb = R1;
    static constexpr size_t catb = R1;
    static constexpr size_t zbb = R1;
    static constexpr size_t kvrawb = R1;
    static constexpr size_t qrawb = R1 + (size_t)TT*1024*2;
    static constexpr size_t projrw = R2;
    static constexpr size_t projmla = R2 + (size_t)TT*1792*2;
    static constexpr size_t y0 = R2;
    static constexpr size_t y1 = R2 + (size_t)TT*512*4;
    static constexpr size_t qb = R2;
    static constexpr size_t scT = rb;
    static constexpr size_t pre = R2;
    static constexpr size_t zT = R2 + (size_t)TT*3072*2;
    static constexpr size_t x0b = R2 + (size_t)TT*3072*2 + (size_t)TT*1024*2;
    static constexpr size_t yT = R2 + (size_t)TT*3072*2 + (size_t)TT*1024*4;
    static constexpr size_t bar = nsum + 2*1024*4;
};
struct Params {
    const float* in[46];
    float* out;
    char* ws;
    __device__ __forceinline__ const float* x_prompt() const { return in[0]; }
    __device__ __forceinline__ const float* x_sample() const { return in[1]; }
    __device__ __forceinline__ const float* st_f() const { return in[2]; }
    __device__ __forceinline__ const float* st_b() const { return in[3]; }
    __device__ __forceinline__ const float* cache_ckv() const { return in[4]; }
    __device__ __forceinline__ const float* cache_kpe() const { return in[5]; }
    __device__ __forceinline__ const float* c() const { return in[6]; }
    __device__ __forceinline__ const float* c_ctx() const { return in[7]; }
    __device__ __forceinline__ const float* norm_g() const { return in[8]; }
    __device__ __forceinline__ const float* w_mod() const { return in[9]; }
    __device__ __forceinline__ const float* b_mod() const { return in[10]; }
    __device__ __forceinline__ const float* ab_w_in() const { return in[11]; }
    __device__ __forceinline__ const float* rw_mu() const { return in[12]; }
    __device__ __forceinline__ const float* rw_w0() const { return in[13]; }
    __device__ __forceinline__ const float* rw_w2() const { return in[14]; }
    __device__ __forceinline__ const float* rw_a0() const { return in[15]; }
    __device__ __forceinline__ const float* rw_a2() const { return in[16]; }
    __device__ __forceinline__ const float* rw_g2() const { return in[17]; }
    __device__ __forceinline__ const float* rw_k_k() const { return in[18]; }
    __device__ __forceinline__ const float* rw_k_a() const { return in[19]; }
    __device__ __forceinline__ const float* rw_r_k() const { return in[20]; }
    __device__ __forceinline__ const float* rw_lnx_g() const { return in[21]; }
    __device__ __forceinline__ const float* rw_lnx_b() const { return in[22]; }
    __device__ __forceinline__ const float* mla_q_norm() const { return in[23]; }
    __device__ __forceinline__ const float* mla_q_up() const { return in[24]; }
    __device__ __forceinline__ const float* mla_kv_norm() const { return in[25]; }
    __device__ __forceinline__ const float* mla_kv_up() const { return in[26]; }
    __device__ __forceinline__ const float* mla_qn() const { return in[27]; }
    __device__ __forceinline__ const float* mla_kn() const { return in[28]; }
    __device__ __forceinline__ const float* ab_w_out() const { return in[29]; }
    __device__ __forceinline__ const float* hy_w_in() const { return in[30]; }
    __device__ __forceinline__ const float* hy_b_in() const { return in[31]; }
    __device__ __forceinline__ const float* hy_conv_w() const { return in[32]; }
    __device__ __forceinline__ const float* hy_conv_b() const { return in[33]; }
    __device__ __forceinline__ const float* hy_f_w1() const { return in[34]; }
    __device__ __forceinline__ const float* hy_f_b1() const { return in[35]; }
    __device__ __forceinline__ const float* hy_f_w2() const { return in[36]; }
    __device__ __forceinline__ const float* hy_f_b2() const { return in[37]; }
    __device__ __forceinline__ const float* hy_f_w3() const { return in[38]; }
    __device__ __forceinline__ const float* hy_f_freq() const { return in[39]; }
    __device__ __forceinline__ const float* hy_bias() const { return in[40]; }
    __device__ __forceinline__ const float* hy_w_out() const { return in[41]; }
    __device__ __forceinline__ const float* peer_w_q() const { return in[42]; }
    __device__ __forceinline__ const float* peer_keys() const { return in[43]; }
    __device__ __forceinline__ const float* peer_u() const { return in[44]; }
    __device__ __forceinline__ const float* peer_v() const { return in[45]; }
    __device__ __forceinline__ float* xrun() const { return out + (0); }
    __device__ __forceinline__ float* out_sf() const { return out + ((size_t)TT*DM); }
    __device__ __forceinline__ float* out_sb() const { return out + ((size_t)TT*DM + 16*8*64*64); }
    __device__ __forceinline__ float* out_ckv() const { return out + ((size_t)TT*DM + 2*16*8*64*64); }
    __device__ __forceinline__ float* out_kpe() const { return out + ((size_t)TT*DM + 2*16*8*64*64 + 16*256*128); }
    __device__ __forceinline__ float* mod() const { return (float*)(ws + WS::mod); }
    __device__ __forceinline__ bf16_t* w_in_t() const { return (bf16_t*)(ws + WS::w_in_t); }
    __device__ __forceinline__ bf16_t* w_out_t() const { return (bf16_t*)(ws + WS::w_out_t); }
    __device__ __forceinline__ bf16_t* hy_w_in_t() const { return (bf16_t*)(ws + WS::hy_w_in_t); }
    __device__ __forceinline__ bf16_t* hy_w_out_t() const { return (bf16_t*)(ws + WS::hy_w_out_t); }
    __device__ __forceinline__ bf16_t* w_q_t() const { return (bf16_t*)(ws + WS::w_q_t); }
    __device__ __forceinline__ bf16_t* q_up_t() const { return (bf16_t*)(ws + WS::q_up_t); }
    __device__ __forceinline__ bf16_t* kv_up_t() const { return (bf16_t*)(ws + WS::kv_up_t); }
    __device__ __forceinline__ bf16_t* w2_t() const { return (bf16_t*)(ws + WS::w2_t); }
    __device__ __forceinline__ bf16_t* a2_t() const { return (bf16_t*)(ws + WS::a2_t); }
    __device__ __forceinline__ bf16_t* g2_t() const { return (bf16_t*)(ws + WS::g2_t); }
    __device__ __forceinline__ bf16_t* ctxb() const { return (bf16_t*)(ws + WS::ctxb); }
    __device__ __forceinline__ bf16_t* keysb() const { return (bf16_t*)(ws + WS::keysb); }
    __device__ __forceinline__ unsigned char* tabU() const { return (unsigned char*)(ws + WS::tabU); }
    __device__ __forceinline__ float* rsU() const { return (float*)(ws + WS::rsU); }
    __device__ __forceinline__ float* rsV() const { return (float*)(ws + WS::rsV); }
    __device__ __forceinline__ unsigned char* tabV() const { return (unsigned char*)(ws + WS::tabV); }
    __device__ __forceinline__ float* nsum() const { return (float*)(ws + WS::nsum); }
    __device__ __forceinline__ bf16_t* rb() const { return (bf16_t*)(ws + WS::rb); }
    __device__ __forceinline__ bf16_t* kb() const { return (bf16_t*)(ws + WS::kb); }
    __device__ __forceinline__ bf16_t* vb() const { return (bf16_t*)(ws + WS::vb); }
    __device__ __forceinline__ bf16_t* kkb() const { return (bf16_t*)(ws + WS::kkb); }
    __device__ __forceinline__ bf16_t* lr0() const { return (bf16_t*)(ws + WS::lr0); }
    __device__ __forceinline__ bf16_t* lr1() const { return (bf16_t*)(ws + WS::lr1); }
    __device__ __forceinline__ bf16_t* gateb() const { return (bf16_t*)(ws + WS::gateb); }
    __device__ __forceinline__ _Float16* du0() const { return (_Float16*)(ws + WS::du0); }
    __device__ __forceinline__ _Float16* du1() const { return (_Float16*)(ws + WS::du1); }
    __device__ __forceinline__ bf16_t* twb() const { return (bf16_t*)(ws + WS::twb); }
    __device__ __forceinline__ bf16_t* advb() const { return (bf16_t*)(ws + WS::advb); }
    __device__ __forceinline__ bf16_t* sgb() const { return (bf16_t*)(ws + WS::sgb); }
    __device__ __forceinline__ float* bonus() const { return (float*)(ws + WS::bonus); }
    __device__ __forceinline__ float* kpe() const { return (float*)(ws + WS::kpe); }
    __device__ __forceinline__ bf16_t* qcnb() const { return (bf16_t*)(ws + WS::qcnb); }
    __device__ __forceinline__ bf16_t* ckvb() const { return (bf16_t*)(ws + WS::ckvb); }
    __device__ __forceinline__ bf16_t* Qb() const { return (bf16_t*)(ws + WS::Qb); }
    __device__ __forceinline__ bf16_t* Kp() const { return (bf16_t*)(ws + WS::Kp); }
    __device__ __forceinline__ bf16_t* Vp() const { return (bf16_t*)(ws + WS::Vp); }
    __device__ __forceinline__ bf16_t* Ks() const { return (bf16_t*)(ws + WS::Ks); }
    __device__ __forceinline__ bf16_t* Vs() const { return (bf16_t*)(ws + WS::Vs); }
    __device__ __forceinline__ bf16_t* kvctxb() const { return (bf16_t*)(ws + WS::kvctxb); }
    __device__ __forceinline__ int* pidx() const { return (int*)(ws + WS::pidx); }
    __device__ __forceinline__ float* pg() const { return (float*)(ws + WS::pg); }
    __device__ __forceinline__ bf16_t* hb() const { return (bf16_t*)(ws + WS::hb); }
    __device__ __forceinline__ bf16_t* catb() const { return (bf16_t*)(ws + WS::catb); }
    __device__ __forceinline__ bf16_t* zbb() const { return (bf16_t*)(ws + WS::zbb); }
    __device__ __forceinline__ bf16_t* kvrawb() const { return (bf16_t*)(ws + WS::kvrawb); }
    __device__ __forceinline__ bf16_t* qrawb() const { return (bf16_t*)(ws + WS::qrawb); }
    __device__ __forceinline__ bf16_t* projrw() const { return (bf16_t*)(ws + WS::projrw); }
    __device__ __forceinline__ float* projmla() const { return (float*)(ws + WS::projmla); }
    __device__ __forceinline__ float* y0() const { return (float*)(ws + WS::y0); }
    __device__ __forceinline__ float* y1() const { return (float*)(ws + WS::y1); }
    __device__ __forceinline__ bf16_t* qb() const { return (bf16_t*)(ws + WS::qb); }
    __device__ __forceinline__ float* scT() const { return (float*)(ws + WS::scT); }
    __device__ __forceinline__ bf16_t* pre() const { return (bf16_t*)(ws + WS::pre); }
    __device__ __forceinline__ bf16_t* zT() const { return (bf16_t*)(ws + WS::zT); }
    __device__ __forceinline__ bf16_t* x0b() const { return (bf16_t*)(ws + WS::x0b); }
    __device__ __forceinline__ bf16_t* yT() const { return (bf16_t*)(ws + WS::yT); }
    __device__ __forceinline__ bf16_t* gTS() const { return (bf16_t*)(ws + WS::gTS); }
    __device__ __forceinline__ bf16_t* gTP() const { return (bf16_t*)(ws + WS::gTP); }
    __device__ __forceinline__ unsigned* bar() const { return (unsigned*)(ws + WS::bar); }
};

#define VLOOP(n) for (int vb = blockIdx.x; vb < (n); vb += gridDim.x)
#define ENDV __syncthreads();

#define QLOOP(ctr_word, nitems, ...)                                                            \
    {                                                                                           \
        unsigned* qctr = p.bar() + XCD_BAR_WORDS + 128 + (ctr_word);                            \
        volatile unsigned* bc = (volatile unsigned*)(smem + GEMM_LDS_BYTES + 8);                \
        for (;;) {                                                                              \
            if (threadIdx.x == 0) *bc = atomicAdd(qctr, 1u);                                    \
            __syncthreads();                                                                    \
            const int item = __builtin_amdgcn_readfirstlane((int)*bc);                          \
            __syncthreads();                                                                    \
            if (item >= (nitems)) break;                                                        \
            __VA_ARGS__                                                                         \
        }                                                                                       \
    }
__device__ __forceinline__ void peer_layer(const Params& p, char* smem, int li, const float* modl, float* xrs) {
    const bf16_t* wq = p.w_q_t() + (size_t)li * 2048 * 1024;
    const bf16_t* kys = p.keysb() + (size_t)li * 16 * 128 * 128;
    VLOOP(TT / 8) { d_norm_mod2(vb, p.xrun(), xrs, p.norm_g() + (li * 2 + 1) * 1024, modl, 3, 4, p.hb()); }
    xcd_barrier_(p.bar(), smem);
    VLOOP(16 * 96) { d_gemm_bf16(vb % 16, vb / 16, smem, p.hb(), 1024, wq, 1024, 1024, 2048, EpiStoreBf{p.qb(), 2048, 0}); }
    xcd_barrier_(p.bar(), smem);
    VLOOP(8 * 96) { d_peer_route2(vb, smem, kys, p.qb(), p.pidx(), p.pg()); ENDV }
    if (li == 0) {
        QLOOP(4, 1536, {
            const int t1 = 48 * 16, t2 = t1 + 16 * 16;
            const float* W; bf16_t* Wt; int N, lv;
            if (item < t1) { W = p.hy_w_in(); Wt = p.hy_w_in_t(); N = 3072; lv = item; }
            else if (item < t2) { W = p.hy_w_out(); Wt = p.hy_w_out_t(); N = 1024; lv = item - t1; }
            else { W = p.peer_w_q() + (size_t)1024 * 2048; Wt = p.w_q_t() + (size_t)2048 * 1024; N = 2048; lv = item - t2; }
            d_transpose_w(lv, smem, W, 1024, N, Wt);
        })
    }
    xcd_barrier_(p.bar(), smem);
    VLOOP(TT / 4) { d_peer_apply3(vb, smem, p.hb(), p.pidx(), p.pg(), p.tabU(), p.tabV(), p.rsU(), p.rsV(), modl, p.xrun(),
                                    li == 0 ? p.norm_g() + 2048 : nullptr, p.mod() + 5 * 6144, p.hb()); ENDV }
}

__global__ void __launch_bounds__(256, 2) mega(Params p) {
    __shared__ __attribute__((aligned(16))) char smem[GEMM_LDS_BYTES + 16];
    cg::grid_group grid = cg::this_grid();
    if (threadIdx.x < 4) ((unsigned*)(smem + GEMM_LDS_BYTES))[threadIdx.x] = 0u;
    __syncthreads();
    (void)xcd_barrier_post(p.bar(), (volatile LAS unsigned*)(smem + GEMM_LDS_BYTES));
    const float* mod0 = p.mod();
    const float* mod1 = p.mod() + 5 * 6144;
    float* xrs = p.xrun() + (size_t)TP * DM;

    VLOOP(192) { d_mod3(vb, smem, p.c(), p.c_ctx(), p.w_mod(), p.b_mod(), p.mod()); ENDV }
    if (p.ws == nullptr) grid.sync();
    xcd_barrier_(p.bar(), smem);
    VLOOP(TT / 8) { d_norm_mod2(vb, p.x_prompt(), p.x_sample(), p.norm_g(), mod0, 0, 1, p.hb()); }
    {
        const int j1 = 36 * 16;
        const int j7 = j1 + 12 * 4;
        const int j8 = j7 + 16 * 2;
        const int j9 = j8 + 8;
        const int j10 = j9 + 8;
        const int j11 = j10 + 8;
        const int j12 = j11 + 8;
        const int j13 = j12 + 8 * 2;
        VLOOP(j13) {
            const float* W; bf16_t* Wt; int K, N, lv;
            if (vb < j1) { W = p.ab_w_in(); Wt = p.w_in_t(); K = 1024; N = 2240; lv = vb; }
            else if (vb < j7) { W = p.mla_q_up(); Wt = p.q_up_t(); K = 256; N = 768; lv = vb - j1; }
            else if (vb < j8) { W = p.mla_kv_up(); Wt = p.kv_up_t(); K = 128; N = 1024; lv = vb - j7; }
            else if (vb < j9) { W = p.rw_w2(); Wt = p.w2_t(); K = 64; N = 512; lv = vb - j8; }
            else if (vb < j10) { W = p.rw_w2() + 64 * 512; Wt = p.w2_t() + 512 * 64; K = 64; N = 512; lv = vb - j9; }
            else if (vb < j11) { W = p.rw_a2(); Wt = p.a2_t(); K = 64; N = 512; lv = vb - j10; }
            else if (vb < j12) { W = p.rw_a2() + 64 * 512; Wt = p.a2_t() + 512 * 64; K = 64; N = 512; lv = vb - j11; }
            else { W = p.rw_g2(); Wt = p.g2_t(); K = 128; N = 512; lv = vb - j12; }
            d_transpose_w(lv, smem, W, K, N, Wt);
            ENDV }
    }
    VLOOP(40) { if (vb < 8) d_cvt_bf16(vb, p.cache_ckv(), p.ctxb()); else d_cvt_bf16(vb - 8, p.peer_keys(), p.keysb()); }
    xcd_barrier_(p.bar(), smem);
    VLOOP(18 * 96) { d_gemm_bf16(vb % 18, vb / 18, smem, p.hb(), 1024, p.w_in_t(), 1024, 1024, ABIN, EpiProj{p.projrw(), p.projmla()}); }
    xcd_barrier_(p.bar(), smem);
    VLOOP(2688 + 768) {
        if (vb < 2688) d_rw_shift2(vb, p.projrw(), p.rw_mu(), p.rb(), p.kb(), p.vb(), p.twb(), p.advb(), p.sgb());
        else d_mla_pre2(vb - 2688, p.projmla(), p.mla_q_norm(), p.mla_kv_norm(), p.qcnb(), p.ckvb(), p.kpe(), p.out_ckv(), p.out_kpe());
    }
    xcd_barrier_(p.bar(), smem);
    {
        const int n0 = 4 * 96, n1 = 6 * 96, n2 = 8 * 96, n3 = 8 * 8;
        VLOOP(5 * n0 + n1 + n2 + n3) {
            int v = vb;
            if (v < n0) d_gemm_bf16(v % 4, v / 4, smem, p.twb(), 64, p.w2_t(), 64, 64, 512, EpiDecay{p.du0(), p.rw_w0()});
            else if ((v -= n0) < n0) d_gemm_bf16(v % 4, v / 4, smem, p.twb(), 64, p.w2_t() + 512 * 64, 64, 64, 512, EpiDecay{p.du1(), p.rw_w0() + 512});
            else if ((v -= n0) < n0) d_gemm_bf16(v % 4, v / 4, smem, p.advb(), 64, p.a2_t(), 64, 64, 512, EpiLr{p.lr0(), p.rw_a0()});
            else if ((v -= n0) < n0) d_gemm_bf16(v % 4, v / 4, smem, p.advb(), 64, p.a2_t() + 512 * 64, 64, 64, 512, EpiLr{p.lr1(), p.rw_a0() + 512});
            else if ((v -= n0) < n0) d_gemm_bf16(v % 4, v / 4, smem, p.sgb(), 128, p.g2_t(), 128, 128, 512, EpiStoreBf{p.gateb(), 512, 0});
            else if ((v -= n0) < n1) d_gemm_bf16(v % 6, v / 6, smem, p.qcnb(), 256, p.q_up_t(), 256, 256, 768, EpiStoreBf{p.qrawb(), 768, 0});
            else if ((v -= n1) < n2) d_gemm_bf16(v % 8, v / 8, smem, p.ckvb(), 128, p.kv_up_t(), 128, 128, 1024, EpiKV{p.kvrawb(), p.Vp(), p.Vs(), 0, 0});
            else { v -= n2; d_gemm_bf16(v % 8, v / 8, smem, p.ctxb(), 128, p.kv_up_t(), 128, 128, 1024, EpiKV{p.kvctxb(), p.Vp(), p.Vs(), 1, 0}); }
        }
    }
    xcd_barrier_(p.bar(), smem);
    VLOOP(1536 + 832) {
        if (vb < 1536) d_rw_kk3(vb, p.rb(), p.kb(), p.lr0(), p.lr1(), p.rw_k_k(), p.rw_k_a(), p.rw_r_k(), p.kkb(), p.bonus());
        else d_mla_post3(vb - 1536, p.qrawb(), p.kvrawb(), p.kvctxb(), p.kpe(), p.cache_kpe(), p.mla_qn(), p.mla_kn(), p.Qb(), p.Kp(), p.Ks());
        ENDV }
    xcd_barrier_(p.bar(), smem);
    QLOOP(7, 320, {
        const bool smp = item < 64;
        if (smp) __builtin_amdgcn_s_setprio(3);
        d_scan3(smp ? item : item - 64, smp, smem, p.rb(), p.kb(), p.vb(), p.kkb(), p.lr0(), p.lr1(), p.du0(), p.du1(), p.rw_k_a(), p.st_f(), p.st_b(), p.y0(), p.y1(), p.out_sf(), p.out_sb());
        __builtin_amdgcn_s_setprio(0);
    })
    QLOOP(0, 384, {
        const bool smp = item < 256;
        d_attn_mfma(smp ? item : item - 256, smem, p.Qb(), smp ? p.Ks() : p.Kp(), smp ? p.Vs() : p.Vp(), p.catb(), smp ? TP : 0, smp ? LS : LP,
                    smp ? 2304 : LP, smp ? 16 : 2);
    })
    QLOOP(2, 2048, {
        const bool isv = item >= 1024;
        d_cvt_fp8_rows(isv ? item - 1024 : item, isv ? p.peer_v() : p.peer_u(), isv ? p.tabV() : p.tabU(), isv ? p.rsV() : p.rsU());
    })
    QLOOP(3, 768, {
        const bool a_ = item < 256;
        d_transpose_w(a_ ? item : item - 256, smem, a_ ? p.ab_w_out() : p.peer_w_q(), 1024, a_ ? 1024 : 2048, a_ ? p.w_out_t() : p.w_q_t());
    })
    xcd_barrier_(p.bar(), smem);
    VLOOP(1536) { d_rw_post3(vb, p.y0(), p.y1(), p.bonus(), p.vb(), p.gateb(), p.rw_lnx_g(), p.rw_lnx_b(), p.catb()); }
    QLOOP(1, 576, {
        const bool smp = item < 512;
        d_hy_filt2(smp ? item : item - 512, smem, smp ? LS : LP, p.hy_f_w1(), p.hy_f_b1(), p.hy_f_w2(), p.hy_f_b2(), p.hy_f_w3(), p.hy_f_freq(),
                   smp ? p.gTS() : p.gTP(), smp ? p.nsum() : p.nsum() + 1024);
    })
    xcd_barrier_(p.bar(), smem);
    QLOOP(5, 480 + 576, {
        if (item < 480) d_gemm_bf16n<2>(item % 5, item / 5, smem, p.catb(), 1024, p.w_out_t(), 1024, 1024, 1024, EpiResid{p.x_prompt(), p.x_sample(), p.xrun(), mod0, 2, 0});
        else { const int it = item - 480; d_gemm_bf16n<1>(10 + it % 6, it / 6, smem, p.catb(), 1024, p.w_out_t(), 1024, 1024, 1024, EpiResid{p.x_prompt(), p.x_sample(), p.xrun(), mod0, 2, 0}); }
    })
    xcd_barrier_(p.bar(), smem);
    peer_layer(p, smem, 0, mod0, xrs);
    xcd_barrier_(p.bar(), smem);
    VLOOP(24 * 96) { d_gemm_bf16(vb % 24, vb / 24, smem, p.hb(), 1024, p.hy_w_in_t(), 1024, 1024, 3072, EpiStoreBfBias{p.pre(), p.hy_b_in(), 3072, 0}); }
    VLOOP(2048) {
        const bool isv = vb >= 1024;
        d_cvt_fp8_rows(isv ? vb - 1024 : vb, (isv ? p.peer_v() : p.peer_u()) + (size_t)16384 * 1024, isv ? p.tabV() : p.tabU(), isv ? p.rsV() : p.rsU());
    }
    xcd_barrier_(p.bar(), smem);
    VLOOP(192 * 8) { d_hy_dw3(vb, smem, p.pre(), p.hy_conv_w(), p.hy_conv_b(), p.zT(), p.x0b()); ENDV }
    xcd_barrier_(p.bar(), smem);
    VLOOP(512 + 512) {
        const int wv = threadIdx.x >> 6;
        char* wsm = smem + (wv >> 1) * 28672;
        if (vb < 512) d_hy_conv2<true>(vb * 2 + (wv >> 1), wv & 1, wsm, p.gTS(), p.nsum(), p.zT(), p.hy_bias(), p.yT());
        else d_hy_conv2<false>((vb - 512) * 2 + (wv >> 1), wv & 1, wsm, p.gTP(), p.nsum() + 1024, p.zT(), p.hy_bias(), p.yT());
        ENDV }
    xcd_barrier_(p.bar(), smem);
    VLOOP(192 * 8) { d_hy_post2(vb, smem, p.yT(), p.x0b(), p.zbb()); ENDV }
    xcd_barrier_(p.bar(), smem);
    QLOOP(6, 480 + 576, {
        if (item < 480) d_gemm_bf16n<2>(item % 5, item / 5, smem, p.zbb(), 1024, p.hy_w_out_t(), 1024, 1024, 1024, EpiResid{p.xrun(), xrs, p.xrun(), mod1, 2, 0});
        else { const int it = item - 480; d_gemm_bf16n<1>(10 + it % 6, it / 6, smem, p.zbb(), 1024, p.hy_w_out_t(), 1024, 1024, 1024, EpiResid{p.xrun(), xrs, p.xrun(), mod1, 2, 0}); }
    })
    xcd_barrier_(p.bar(), smem);
    peer_layer(p, smem, 1, mod1, xrs);
}

static inline size_t align_up(size_t x) { return (x + 255) & ~(size_t)255; }

extern "C" void kernel_launch(void* const* d_in, const int* in_sizes, int n_in, void* d_out, int out_size, void* d_ws, size_t ws_size,
                              hipStream_t stream) {
    Params p{};
    for (int i = 0; i < 46; i++) p.in[i] = (const float*)d_in[i];
    p.out = (float*)d_out;
    p.ws = (char*)d_ws;
    static_assert(WS::END <= (size_t)422781952, "workspace plan exceeds the guaranteed scratch size");
    static int grid_blocks = 0;
    if (!grid_blocks) {
        int dev = 0, cus = 0, per_cu = 0;
        (void)hipGetDevice(&dev);
        (void)hipDeviceGetAttribute(&cus, hipDeviceAttributeMultiprocessorCount, dev);
        (void)hipOccupancyMaxActiveBlocksPerMultiprocessor(&per_cu, mega, 256, 0);
        if (per_cu > 2) per_cu = 2;
        if (per_cu < 1) per_cu = 1;
        grid_blocks = cus * per_cu;
    }
    (void)hipMemsetAsync(p.ws + WS::nsum, 0, (size_t)2 * 1024 * 4 + (size_t)XCD_BAR_WORDS * 4 + 1024, stream);
    (void)hipMemsetAsync(p.ws + WS::mod, 0, (size_t)2 * 5 * 6144 * 4, stream);
    void* args[] = {&p};
    (void)hipLaunchCooperativeKernel((void*)mega, dim3(grid_blocks), dim3(256), args, 0, stream);
}
```

```cpp
#include <hip/hip_runtime.h>
#include <stdint.h>
#include <hip/hip_cooperative_groups.h>
namespace cg = cooperative_groups;

#define DM 1024
#define TP 4096
#define TS 8192
#define TT 12288
#define LP 256
#define LS 2048
#define NBP 16
#define NBS 4
#define ABIN 2240
#define RWIN 1792

typedef unsigned short bf16_t;
__device__ __forceinline__ bf16_t f2bf(float f) { unsigned u = __float_as_uint(f); u += 0x7fffu + ((u >> 16) & 1u); return (bf16_t)(u >> 16); }
__device__ __forceinline__ float bf2f(bf16_t h) { return __uint_as_float(((unsigned)h) << 16); }
__device__ __forceinline__ float sigmoidf_(float x) { return 1.f / (1.f + expf(-x)); }
__device__ __forceinline__ float gelu_tanh(float x) { return 0.5f * x * (1.f + tanhf(0.7978845608028654f * (x + 0.044715f * x * x * x))); }

__device__ __forceinline__ int tok_pos(int t) { return t < TP ? (t & (LP - 1)) : ((t - TP) & (LS - 1)); }
__device__ __forceinline__ int tok_len(int t) { return t < TP ? LP : LS; }
__device__ __forceinline__ int tok_modrow(int t) { return t < TP ? 0 : 1 + ((t - TP) >> 11); }

__device__ __forceinline__ float wave_sum(float v) {
#pragma unroll
    for (int o = 32; o > 0; o >>= 1) v += __shfl_xor(v, o, 64);
    return v;
}


__device__ __forceinline__ void d_mod3(const int vb, char* smem, const float* __restrict__ c, const float* __restrict__ c_ctx,
                                       const float* __restrict__ w_mod, const float* __restrict__ b_mod, float* __restrict__ mod) {
    float* sl = (float*)smem;
    const int li = vb / 96, kc = (vb % 96) / 6, cg6 = vb % 6;
    const int tid = threadIdx.x;
    for (int i = tid; i < 5 * 64; i += 256) {
        const int r = i >> 6, k = kc * 64 + (i & 63);
        const float v = (r == 0) ? c_ctx[k] : c[(r - 1) * 1024 + k];
        sl[i] = v / (1.f + __expf(-v));
    }
    __syncthreads();
    const int n = cg6 * 1024 + tid * 4;
    float4 a0 = {0, 0, 0, 0}, a1 = a0, a2 = a0, a3 = a0, a4 = a0;
    const float* w = w_mod + ((size_t)li * 1024 + kc * 64) * 6144 + n;
#pragma unroll 16
    for (int k = 0; k < 64; k++) {
        const float4 wv = *(const float4*)(w + (size_t)k * 6144);
        const float s0 = sl[k], s1 = sl[64 + k], s2 = sl[128 + k], s3 = sl[192 + k], s4 = sl[256 + k];
        a0.x += s0 * wv.x; a0.y += s0 * wv.y; a0.z += s0 * wv.z; a0.w += s0 * wv.w;
        a1.x += s1 * wv.x; a1.y += s1 * wv.y; a1.z += s1 * wv.z; a1.w += s1 * wv.w;
        a2.x += s2 * wv.x; a2.y += s2 * wv.y; a2.z += s2 * wv.z; a2.w += s2 * wv.w;
        a3.x += s3 * wv.x; a3.y += s3 * wv.y; a3.z += s3 * wv.z; a3.w += s3 * wv.w;
        a4.x += s4 * wv.x; a4.y += s4 * wv.y; a4.z += s4 * wv.z; a4.w += s4 * wv.w;
    }
    if (kc == 0) {
        const float4 bb = *(const float4*)(b_mod + li * 6144 + n);
        a0.x += bb.x; a0.y += bb.y; a0.z += bb.z; a0.w += bb.w; a1.x += bb.x; a1.y += bb.y; a1.z += bb.z; a1.w += bb.w;
        a2.x += bb.x; a2.y += bb.y; a2.z += bb.z; a2.w += bb.w; a3.x += bb.x; a3.y += bb.y; a3.z += bb.z; a3.w += bb.w;
        a4.x += bb.x; a4.y += bb.y; a4.z += bb.z; a4.w += bb.w;
    }
    float* o = mod + (size_t)(li * 5) * 6144 + n;
    atomicAdd(o + 0, a0.x); atomicAdd(o + 1, a0.y); atomicAdd(o + 2, a0.z); atomicAdd(o + 3, a0.w);
    atomicAdd(o + 6144 + 0, a1.x); atomicAdd(o + 6144 + 1, a1.y); atomicAdd(o + 6144 + 2, a1.z); atomicAdd(o + 6144 + 3, a1.w);
    atomicAdd(o + 2 * 6144 + 0, a2.x); atomicAdd(o + 2 * 6144 + 1, a2.y); atomicAdd(o + 2 * 6144 + 2, a2.z); atomicAdd(o + 2 * 6144 + 3, a2.w);
    atomicAdd(o + 3 * 6144 + 0, a3.x); atomicAdd(o + 3 * 6144 + 1, a3.y); atomicAdd(o + 3 * 6144 + 2, a3.z); atomicAdd(o + 3 * 6144 + 3, a3.w);
    atomicAdd(o + 4 * 6144 + 0, a4.x); atomicAdd(o + 4 * 6144 + 1, a4.y); atomicAdd(o + 4 * 6144 + 2, a4.z); atomicAdd(o + 4 * 6144 + 3, a4.w);
}


struct EpiStore { static constexpr bool kQuad = false; float* C; const float* bias; int ldc; int pad;
    __device__ void operator()(int m, int n, float a) const { C[(size_t)m * ldc + n] = a + (bias ? bias[n] : 0.f); } };
struct EpiStoreBfBias { static constexpr bool kQuad = false; bf16_t* C; const float* bias; int ldc; int pad;
    __device__ void operator()(int m, int n, float a) const { C[(size_t)m * ldc + n] = f2bf(a + bias[n]); } };
struct EpiStoreBf { static constexpr bool kQuad = false; bf16_t* C; int ldc; int pad;
    __device__ void operator()(int m, int n, float a) const { C[(size_t)m * ldc + n] = f2bf(a); } };
struct EpiDecay { static constexpr bool kQuad = false; _Float16* out; const float* w0;
    __device__ void operator()(int m, int n, float a) const { out[(size_t)m * 512 + n] = (_Float16)sigmoidf_(w0[n] + a); } };
struct EpiProj { static constexpr bool kQuad = false; bf16_t* rw; float* mla;
    __device__ void operator()(int m, int n, float a) const { if (n < RWIN) rw[(size_t)m * RWIN + n] = f2bf(a); else mla[(size_t)m * 448 + (n - RWIN)] = a; } };
struct EpiLr { static constexpr bool kQuad = false; bf16_t* out; const float* a0;
    __device__ void operator()(int m, int n, float a) const { out[(size_t)m * 512 + n] = f2bf(sigmoidf_(a0[n] + a)); } };
struct EpiResid { static constexpr bool kQuad = false; const float* xa; const float* xb; float* out; const float* modl; int gate_idx; int pad;
    __device__ void operator()(int m, int n, float a) const {
        float x = (m < TP) ? xa[(size_t)m * DM + n] : xb[(size_t)(m - TP) * DM + n];
        float gt = modl[(size_t)tok_modrow(m) * 6144 + gate_idx * 1024 + n];
        out[(size_t)m * DM + n] = x + gt * a; } };

struct EpiKV { static constexpr bool kQuad = true;
    bf16_t* kvraw; bf16_t* Vp; bf16_t* Vs; int ctx; int pad;
    __device__ void operator()(int m, int n, float a) const {}
    __device__ void quad(int row0, int col, float v0, float v1, float v2, float v3) const {
        const int hd = col >> 8, within = col & 255;
        if (within < 128) {
            bf16_t* d = kvraw + (size_t)row0 * 1024 + col;
            d[0] = f2bf(v0); d[1024] = f2bf(v1); d[2048] = f2bf(v2); d[3072] = f2bf(v3);
        } else {
            const int dv = within - 128;
            int b, kidx, Lk; bf16_t* base;
            if (ctx) { b = row0 >> 8; kidx = row0 & 255; Lk = 2304; base = Vs; }
            else if (row0 < TP) { b = row0 >> 8; kidx = row0 & 255; Lk = LP; base = Vp; }
            else { b = (row0 - TP) >> 11; kidx = 256 + ((row0 - TP) & 2047); Lk = 2304; base = Vs; }
            const int kpos = (kidx & ~12) | ((kidx & 8) >> 1) | ((kidx & 4) << 1);
            ushort4 o; o.x = f2bf(v0); o.y = f2bf(v1); o.z = f2bf(v2); o.w = f2bf(v3);
            *(ushort4*)(base + ((size_t)((b * 4 + hd) * 128 + dv)) * Lk + kpos) = o;
        }
    } };


typedef __attribute__((ext_vector_type(8))) short bf16x8;
typedef __attribute__((ext_vector_type(16))) float f32x16;
typedef __attribute__((ext_vector_type(4))) float f32x4;
typedef __attribute__((ext_vector_type(4))) unsigned u32x4;
#define GEMM_LDS_BYTES 73728

template <int NJ, class Epi>
__device__ __forceinline__ void d_gemm_bf16n(const int bx, const int by, char* smem, const bf16_t* __restrict__ A, int lda,
                                             const bf16_t* __restrict__ Bt, int ldb, int K, int N, Epi epi) {
    const int tid = threadIdx.x, lane = tid & 63, wid = tid >> 6;
    const int wm = wid >> 1, wn = wid & 1;
    const int m0 = by * 128, n0 = bx * (64 * NJ);
    f32x16 acc[2][NJ];
#pragma unroll
    for (int i = 0; i < 2; i++)
#pragma unroll
        for (int j = 0; j < NJ; j++)
#pragma unroll
            for (int r = 0; r < 16; r++) acc[i][j][r] = 0.f;
    const int lrow = tid >> 3, lcol = (tid & 7) * 8;
    const bf16_t* ga = A + (size_t)(m0 + lrow) * lda + lcol;
    const bf16_t* gb = Bt + (size_t)(n0 + lrow) * ldb + lcol;
    u32x4 raA[4], rbA[2 * NJ], raB[4], rbB[2 * NJ];
    const int KT = K >> 6;
    const int frow = lane & 31, fk = (lane >> 5) * 16;
#define GM_LOAD(RA_, RB_, kt_)                                                                                              \
    {                                                                                                                       \
        _Pragma("unroll") for (int i = 0; i < 4; i++) RA_[i] = *(const u32x4*)(ga + (size_t)(32 * i) * lda + (kt_) * 64);   \
        _Pragma("unroll") for (int i = 0; i < 2 * NJ; i++) RB_[i] = *(const u32x4*)(gb + (size_t)(32 * i) * ldb + (kt_) * 64); \
    }
#define GM_STORE(RA_, RB_, st_)                                                                                             \
    {                                                                                                                       \
        char* sn_ = smem + (st_) * 36864;                                                                                   \
        _Pragma("unroll") for (int i = 0; i < 4; i++) *(u32x4*)(sn_ + (lrow + 32 * i) * 144 + lcol * 2) = RA_[i];           \
        _Pragma("unroll") for (int i = 0; i < 2 * NJ; i++) *(u32x4*)(sn_ + 18432 + (lrow + 32 * i) * 144 + lcol * 2) = RB_[i]; \
    }
#define GM_COMPUTE(st_)                                                                                                     \
    {                                                                                                                       \
        const char* sa_ = smem + (st_) * 36864;                                                                             \
        const char* sb_ = sa_ + 18432;                                                                                      \
        _Pragma("unroll") for (int ks = 0; ks < 4; ks++) {                                                                  \
            bf16x8 af[2], bfr[NJ];                                                                                          \
            _Pragma("unroll") for (int i = 0; i < 2; i++) af[i] = *(const bf16x8*)(sa_ + (wm * 64 + i * 32 + frow) * 144 + ks * 32 + fk); \
            _Pragma("unroll") for (int j = 0; j < NJ; j++) bfr[j] = *(const bf16x8*)(sb_ + (wn * (32 * NJ) + j * 32 + frow) * 144 + ks * 32 + fk); \
            _Pragma("unroll") for (int i = 0; i < 2; i++)                                                                   \
                _Pragma("unroll") for (int j = 0; j < NJ; j++) acc[i][j] = __builtin_amdgcn_mfma_f32_32x32x16_bf16(af[i], bfr[j], acc[i][j], 0, 0, 0); \
        }                                                                                                                   \
    }
    GM_LOAD(raA, rbA, 0)
    GM_STORE(raA, rbA, 0)
    if (KT > 1) GM_LOAD(raA, rbA, 1)
    __syncthreads();
    for (int kt = 0; kt < KT; kt += 2) {
        if (kt + 2 < KT) GM_LOAD(raB, rbB, kt + 2)
        GM_COMPUTE(0)
        if (kt + 1 < KT) GM_STORE(raA, rbA, 1)
        __syncthreads();
        if (kt + 1 < KT) {
            if (kt + 3 < KT) GM_LOAD(raA, rbA, kt + 3)
            GM_COMPUTE(1)
            if (kt + 2 < KT) GM_STORE(raB, rbB, 0)
            __syncthreads();
        }
    }
#pragma unroll
    for (int i = 0; i < 2; i++)
#pragma unroll
        for (int j = 0; j < NJ; j++) {
            const int col = n0 + wn * (32 * NJ) + j * 32 + (lane & 31);
            if (col < N) {
                if constexpr (Epi::kQuad) {
#pragma unroll
                    for (int g = 0; g < 4; g++) {
                        const int row0 = m0 + wm * 64 + i * 32 + 8 * g + 4 * (lane >> 5);
                        epi.quad(row0, col, acc[i][j][4 * g], acc[i][j][4 * g + 1], acc[i][j][4 * g + 2], acc[i][j][4 * g + 3]);
                    }
                } else {
#pragma unroll
                    for (int r = 0; r < 16; r++) {
                        const int row = m0 + wm * 64 + i * 32 + (r & 3) + 8 * (r >> 2) + 4 * (lane >> 5);
                        epi(row, col, acc[i][j][r]);
                    }
                }
            }
        }
}
template <class Epi>
__device__ __forceinline__ void d_gemm_bf16(const int bx, const int by, char* smem, const bf16_t* __restrict__ A, int lda,
                                            const bf16_t* __restrict__ Bt, int ldb, int K, int N, Epi epi) {
    d_gemm_bf16n<2, Epi>(bx, by, smem, A, lda, Bt, ldb, K, N, epi);
}
__device__ __forceinline__ void d_transpose_w(const int vb, char* smem, const float* __restrict__ W, int K, int N, bf16_t* __restrict__ Wt) {
    float (*tile)[65] = (float(*)[65])smem;
    const int kt = K >> 6;
    const int nb = vb / kt, kb = vb % kt;
    const int tid = threadIdx.x;
    {
        const int n = nb * 64 + (tid & 63);
#pragma unroll
        for (int i = 0; i < 16; i++) {
            int k = (tid >> 6) + 4 * i;
            tile[k][tid & 63] = (n < N) ? W[(size_t)(kb * 64 + k) * N + n] : 0.f;
        }
    }
    __syncthreads();
    {
        const int k = tid & 63;
#pragma unroll
        for (int i = 0; i < 16; i++) {
            int n = (tid >> 6) + 4 * i;
            Wt[(size_t)(nb * 64 + n) * K + kb * 64 + k] = f2bf(tile[k][n]);
        }
    }
}


template <int CTRL>
__device__ __forceinline__ float dpp_add(float v) {
    return v + __int_as_float(__builtin_amdgcn_update_dpp(0, __float_as_int(v), CTRL, 0xf, 0xf, false));
}
__device__ __forceinline__ float row16_allsum(float v) {
    v = dpp_add<0x128>(v); v = dpp_add<0x124>(v); v = dpp_add<0x122>(v); v = dpp_add<0x121>(v);
    return v;
}

typedef __bf16 bf16x2_t __attribute__((ext_vector_type(2)));
typedef float f32x2v __attribute__((ext_vector_type(2)));
__device__ __forceinline__ unsigned pk_bf2(float a, float b) { f32x2v v = {a, b}; return __builtin_bit_cast(unsigned, __builtin_convertvector(v, bf16x2_t)); }
__device__ __forceinline__ bf16x8 pk_bf8(float a0, float a1, float a2, float a3, float a4, float a5, float a6, float a7) {
    u32x4 u = {pk_bf2(a0, a1), pk_bf2(a2, a3), pk_bf2(a4, a5), pk_bf2(a6, a7)};
    return __builtin_bit_cast(bf16x8, u);
}
#define S3_SLOT 16384
#define S3_A1   0
#define S3_HD   4608
#define S3_A2F  9728
#define S3_ATF  10752
#define S3_ACF  11776
#define S3_VT   12800
#define S3_GC   14848
#define S3_AAB  15104
__device__ __forceinline__ void d_scan3(const int chain, const bool sample, char* smem, const bf16_t* __restrict__ rb, const bf16_t* __restrict__ kb,
                                        const bf16_t* __restrict__ vb, const bf16_t* __restrict__ kkb, const bf16_t* __restrict__ lr0,
                                        const bf16_t* __restrict__ lr1, const _Float16* __restrict__ du0, const _Float16* __restrict__ du1,
                                        const float* __restrict__ k_a, const float* __restrict__ st_f, const float* __restrict__ st_b,
                                        float* __restrict__ y0, float* __restrict__ y1, float* __restrict__ out_sf, float* __restrict__ out_sb) {
    const int d = chain & 1, h = (chain >> 1) & 7, b = chain >> 4;
    const int L = sample ? LS : LP;
    const int tbase = sample ? (TP + b * LS) : (b * LP);
    const int tid = threadIdx.x, wid = tid >> 6, lane = tid & 63;
    const int n = lane & 31, hh = lane >> 5;
    const bf16_t* lr = d ? lr1 : lr0;
    const unsigned short* du = (const unsigned short*)(d ? du1 : du0);
    float* yo = d ? y1 : y0;
    const float ka = k_a[h * 64 + lane];
    const int row = 32 * (wid & 1) + n;
    const int sw = (lane & ~12) | ((lane & 8) >> 1) | ((lane & 4) << 1);
    f32x16 St0, St1;
    if (sample) {
        const float* s0 = (d ? st_b : st_f) + ((size_t)(b * 8 + h) * 64 + row) * 64 + 4 * hh;
#pragma unroll
        for (int q = 0; q < 4; q++) {
            const float4 x0 = *(const float4*)(s0 + 8 * q), x1 = *(const float4*)(s0 + 32 + 8 * q);
            St0[4 * q] = x0.x; St0[4 * q + 1] = x0.y; St0[4 * q + 2] = x0.z; St0[4 * q + 3] = x0.w;
            St1[4 * q] = x1.x; St1[4 * q + 1] = x1.y; St1[4 * q + 2] = x1.z; St1[4 * q + 3] = x1.w;
        }
    } else {
#pragma unroll
        for (int r = 0; r < 16; r++) { St0[r] = 0.f; St1[r] = 0.f; }
    }
    char* slot = smem + wid * S3_SLOT;
    const int ngrp = L >> 6;
    const int dstep = d ? -512 : 512;
    const int wid_u = __builtin_amdgcn_readfirstlane(wid);
    unsigned rkk[16], rlr[16], rk[16], rr[16], ru[16], rv[16];
#define S3_LOAD(gg, J0, J1)                                                                                                   \
    {                                                                                                                        \
        const int i0_ = ((gg) * 4 + wid_u) * 16;                                                                             \
        const int e0_ = (tbase + (d ? (L - 1 - i0_) : i0_)) * 512 + h * 64;                  \
        _Pragma("unroll") for (int j = (J0); j < (J1); j++) {                                                                 \
            const int e_ = e0_ + j * dstep;                                                                                  \
            rkk[j] = (kkb + e_)[lane]; rlr[j] = (lr + e_)[lane]; rk[j] = (kb + e_)[lane]; rr[j] = (rb + e_)[lane];           \
            ru[j] = (du + e_)[lane]; rv[j] = (vb + e_)[lane];                                                                \
        }                                                                                                                    \
    }
    S3_LOAD(0, 0, 8)
    for (int g = 0; g < ngrp; g++) {
        {
            unsigned d1p[16], vtp[8];
            float cs = 0.f, G = 1.f;
            float bprev = 0.f, kprev = 0.f;
            S3_LOAD(g, 8, 12)
            __builtin_amdgcn_sched_barrier(0);
#pragma unroll
            for (int j = 0; j < 16; j++) {
                if (j == 4) { __builtin_amdgcn_sched_barrier(0); S3_LOAD(g, 12, 16) __builtin_amdgcn_sched_barrier(0); }
                const float kkv = __uint_as_float(rkk[j] << 16), lrv = __uint_as_float(rlr[j] << 16), kv = __uint_as_float(rk[j] << 16), rv_ = __uint_as_float(rr[j] << 16);
                const float uv = (float)__builtin_bit_cast(_Float16, (unsigned short)ru[j]);
                const float Gm = G;
                cs += uv;
                G = __expf(-0.6065306597126334f * cs);
                const float Gi = __builtin_amdgcn_rcpf(G);
                const float at = -kkv * Gm, rt = rv_ * G;
                const float bh = kkv * lrv * Gi;
                const float kh = kv * (1.f + (lrv - 1.f) * ka) * Gi;
                const unsigned p0 = pk_bf2(at, rt), p1 = pk_bf2(bh, kh);
                *(unsigned short*)(slot + S3_A1 + j * 144 + sw * 2) = (unsigned short)p0;
                *(unsigned short*)(slot + S3_A1 + (16 + j) * 144 + sw * 2) = (unsigned short)(p0 >> 16);
                *(unsigned short*)(slot + S3_HD + j * 144 + sw * 2) = (unsigned short)p1;
                *(unsigned short*)(slot + S3_HD + (16 + j) * 144 + sw * 2) = (unsigned short)(p1 >> 16);
                if (j & 1) {
                    const int pj = ((j - 1) & ~12) | (((j - 1) & 8) >> 1) | (((j - 1) & 4) << 1);
                    d1p[pj >> 1] = pk_bf2(bprev, bh);
                    d1p[8 + (pj >> 1)] = pk_bf2(kprev, kh);
                    vtp[pj >> 1] = rv[j - 1] | (rv[j] << 16);
                }
                bprev = bh; kprev = kh;
            }
            if (g + 1 < ngrp) S3_LOAD(g + 1, 0, 8)
            ((float*)(slot + S3_GC))[lane] = G;
            {
                u32x4 v0 = {vtp[0], vtp[1], vtp[2], vtp[3]};
                u32x4 v1 = {vtp[4], vtp[5], vtp[6], vtp[7]};
                *(u32x4*)(slot + S3_VT + lane * 32) = v0;
                *(u32x4*)(slot + S3_VT + lane * 32 + 16) = v1;
            }
            f32x16 D;
#pragma unroll
            for (int r = 0; r < 16; r++) D[r] = 0.f;
#pragma unroll
            for (int s = 0; s < 4; s++) {
                const bf16x8 af = *(const bf16x8*)(slot + S3_HD + n * 144 + s * 32 + hh * 16);
                const bf16x8 bf = *(const bf16x8*)(slot + S3_A1 + n * 144 + s * 32 + hh * 16);
                D = __builtin_amdgcn_mfma_f32_32x32x16_bf16(af, bf, D, 0, 0, 0);
            }
            const int t = n & 15;
            const bool strict = n < 16;
            const int lim = strict ? t : t + 1;
            float a2[8], ac[8];
#pragma unroll
            for (int r = 0; r < 8; r++) {
                const int j = (r & 3) + 8 * (r >> 2) + 4 * hh;
                const bool keep = j < lim;
                a2[r] = keep ? D[8 + r] : 0.f;
                const float lo = keep ? D[r] : 0.f;
                ac[r] = strict ? 0.f : lo;
                if (strict) ((float*)(slot + S3_AAB))[j * 20 + t] = lo;
            }
            *(bf16x8*)(slot + S3_A2F + lane * 16) = pk_bf8(a2[0], a2[1], a2[2], a2[3], a2[4], a2[5], a2[6], a2[7]);
            *(bf16x8*)(slot + S3_ACF + lane * 16) = pk_bf8(ac[0], ac[1], ac[2], ac[3], ac[4], ac[5], ac[6], ac[7]);
            {
                u32x4 q0 = {d1p[0], d1p[1], d1p[2], d1p[3]}, q1 = {d1p[4], d1p[5], d1p[6], d1p[7]};
                u32x4 q2 = {d1p[8], d1p[9], d1p[10], d1p[11]}, q3 = {d1p[12], d1p[13], d1p[14], d1p[15]};
                *(u32x4*)(slot + S3_HD + lane * 80) = q0;
                *(u32x4*)(slot + S3_HD + lane * 80 + 16) = q1;
                *(u32x4*)(slot + S3_HD + lane * 80 + 32) = q2;
                *(u32x4*)(slot + S3_HD + lane * 80 + 48) = q3;
            }
            float x[16];
#pragma unroll
            for (int i = 15; i >= 0; i--) {
                if (i == 11 || i == 7 || i == 3) __builtin_amdgcn_sched_barrier(0);
                float s = (i == t) ? 1.f : 0.f;
#pragma unroll
                for (int q = (i + 1) >> 2; q < 4; q++) {
                    const float4 a4 = *(const float4*)(slot + S3_AAB + (i * 20 + 4 * q) * 4);
                    if (4 * q + 0 > i) s += a4.x * x[4 * q + 0];
                    if (4 * q + 1 > i) s += a4.y * x[4 * q + 1];
                    if (4 * q + 2 > i) s += a4.z * x[4 * q + 2];
                    if (4 * q + 3 > i) s += a4.w * x[4 * q + 3];
                }
                x[i] = s;
            }
            {
                const float e0 = hh ? x[4] : x[0], e1 = hh ? x[5] : x[1], e2 = hh ? x[6] : x[2], e3 = hh ? x[7] : x[3];
                const float e4 = hh ? x[12] : x[8], e5 = hh ? x[13] : x[9], e6 = hh ? x[14] : x[10], e7 = hh ? x[15] : x[11];
                bf16x8 tf = pk_bf8(e0, e1, e2, e3, e4, e5, e6, e7);
                if (!strict) { tf = (bf16x8){0, 0, 0, 0, 0, 0, 0, 0}; }
                *(bf16x8*)(slot + S3_ATF + lane * 16) = tf;
            }
        }
        __syncthreads();
        if (wid < 2) {
#pragma unroll 1
            for (int q = 0; q < 4; q++) {
                const char* sl = smem + q * S3_SLOT;
                const bf16x8 sb0 = pk_bf8(St0[0], St0[1], St0[2], St0[3], St0[4], St0[5], St0[6], St0[7]);
                const bf16x8 sb1 = pk_bf8(St0[8], St0[9], St0[10], St0[11], St0[12], St0[13], St0[14], St0[15]);
                const bf16x8 sb2 = pk_bf8(St1[0], St1[1], St1[2], St1[3], St1[4], St1[5], St1[6], St1[7]);
                const bf16x8 sb3 = pk_bf8(St1[8], St1[9], St1[10], St1[11], St1[12], St1[13], St1[14], St1[15]);
                f32x16 acc1;
#pragma unroll
                for (int r = 0; r < 16; r++) acc1[r] = 0.f;
                acc1 = __builtin_amdgcn_mfma_f32_32x32x16_bf16(*(const bf16x8*)(sl + S3_A1 + n * 144 + 0 + hh * 16), sb0, acc1, 0, 0, 0);
                acc1 = __builtin_amdgcn_mfma_f32_32x32x16_bf16(*(const bf16x8*)(sl + S3_A1 + n * 144 + 32 + hh * 16), sb1, acc1, 0, 0, 0);
                acc1 = __builtin_amdgcn_mfma_f32_32x32x16_bf16(*(const bf16x8*)(sl + S3_A1 + n * 144 + 64 + hh * 16), sb2, acc1, 0, 0, 0);
                acc1 = __builtin_amdgcn_mfma_f32_32x32x16_bf16(*(const bf16x8*)(sl + S3_A1 + n * 144 + 96 + hh * 16), sb3, acc1, 0, 0, 0);
                const bf16x8 vt = *(const bf16x8*)(sl + S3_VT + row * 32 + hh * 16);
                acc1 = __builtin_amdgcn_mfma_f32_32x32x16_bf16(*(const bf16x8*)(sl + S3_A2F + lane * 16), vt, acc1, 0, 0, 0);
                const bf16x8 pf = pk_bf8(acc1[0], acc1[1], acc1[2], acc1[3], acc1[4], acc1[5], acc1[6], acc1[7]);
                f32x16 acc2;
#pragma unroll
                for (int r = 0; r < 16; r++) acc2[r] = 0.f;
                acc2 = __builtin_amdgcn_mfma_f32_32x32x16_bf16(*(const bf16x8*)(sl + S3_ATF + lane * 16), pf, acc2, 0, 0, 0);
                const bf16x8 uf = pk_bf8(acc2[0], acc2[1], acc2[2], acc2[3], acc2[4], acc2[5], acc2[6], acc2[7]);
                acc1 = __builtin_amdgcn_mfma_f32_32x32x16_bf16(*(const bf16x8*)(sl + S3_ACF + lane * 16), uf, acc1, 0, 0, 0);
                St0 = __builtin_amdgcn_mfma_f32_32x32x16_bf16(*(const bf16x8*)(sl + S3_HD + n * 80 + hh * 16), uf, St0, 0, 0, 0);
                St1 = __builtin_amdgcn_mfma_f32_32x32x16_bf16(*(const bf16x8*)(sl + S3_HD + (32 + n) * 80 + hh * 16), uf, St1, 0, 0, 0);
                St0 = __builtin_amdgcn_mfma_f32_32x32x16_bf16(*(const bf16x8*)(sl + S3_HD + n * 80 + 32 + hh * 16), vt, St0, 0, 0, 0);
                St1 = __builtin_amdgcn_mfma_f32_32x32x16_bf16(*(const bf16x8*)(sl + S3_HD + (32 + n) * 80 + 32 + hh * 16), vt, St1, 0, 0, 0);
                {
                    const int i0 = (g * 4 + q) * 16;
                    float* yb = yo + (size_t)(tbase + (d ? (L - 1 - i0) : i0)) * 512 + h * 64 + row;
#pragma unroll
                    for (int r = 0; r < 8; r++) {
                        const int tt = (r & 3) + 8 * (r >> 2) + 4 * hh;
                        yb[tt * dstep] = acc1[8 + r];
                    }
                }
                const float* gc = (const float*)(sl + S3_GC) + 4 * hh;
#pragma unroll
                for (int c4 = 0; c4 < 4; c4++) {
                    const float4 g0 = *(const float4*)(gc + 8 * c4), g1 = *(const float4*)(gc + 32 + 8 * c4);
                    St0[4 * c4] *= g0.x; St0[4 * c4 + 1] *= g0.y; St0[4 * c4 + 2] *= g0.z; St0[4 * c4 + 3] *= g0.w;
                    St1[4 * c4] *= g1.x; St1[4 * c4 + 1] *= g1.y; St1[4 * c4 + 2] *= g1.z; St1[4 * c4 + 3] *= g1.w;
                }
            }
        }
        __syncthreads();
    }
    if (!sample && wid < 2) {
        float* os = (d ? out_sb : out_sf) + ((size_t)(b * 8 + h) * 64 + row) * 64 + 4 * hh;
#pragma unroll
        for (int q = 0; q < 4; q++) {
            *(float4*)(os + 8 * q) = make_float4(St0[4 * q], St0[4 * q + 1], St0[4 * q + 2], St0[4 * q + 3]);
            *(float4*)(os + 32 + 8 * q) = make_float4(St1[4 * q], St1[4 * q + 1], St1[4 * q + 2], St1[4 * q + 3]);
        }
    }
}


#define ATT_SV_OFF 25600
#define ATT_SQ_OFF 44032
__device__ __forceinline__ void d_attn_mfma(const int item, char* smem, const bf16_t* __restrict__ Qb, const bf16_t* __restrict__ Kall,
                                            const bf16_t* __restrict__ VtAll, bf16_t* __restrict__ cat, int tbase, int Lq, int Lk, int nqb) {
    const int qb = item % nqb, bh = item / nqb;
    const int b = bh >> 2, h = bh & 3;
    const int tid = threadIdx.x, lane = tid & 63, wid = tid >> 6;
    const int q = lane & 31, hh = lane >> 5;
    const int t = tbase + b * Lq + qb * 128 + wid * 32 + q;
    bf16x8 qf[12];
    {
        const bf16_t* qp = Qb + ((size_t)t * 4 + h) * 192 + hh * 8;
#pragma unroll
        for (int ks = 0; ks < 12; ks++) qf[ks] = *(const bf16x8*)(qp + ks * 16);
    }
    f32x16 o[4];
#pragma unroll
    for (int i = 0; i < 4; i++)
#pragma unroll
        for (int r = 0; r < 16; r++) o[i][r] = 0.f;
    float m = -1e30f, l = 0.f;
    const bf16_t* K = Kall + (size_t)bh * Lk * 192;
    const bf16_t* Vt = VtAll + (size_t)bh * 128 * Lk;
    char* sK = smem;
    char* sV = smem + ATT_SV_OFF;
    u32x4 pk[6], pv[4];
    const int nkt = Lk >> 6;
#pragma unroll
    for (int i = 0; i < 6; i++) pk[i] = *(const u32x4*)(K + (size_t)(tid + 256 * i) * 8);
#pragma unroll
    for (int i = 0; i < 4; i++) { int c = tid + 256 * i; pv[i] = *(const u32x4*)(Vt + (size_t)(c >> 3) * Lk + (c & 7) * 8); }
#pragma unroll
    for (int i = 0; i < 6; i++) { int c = tid + 256 * i; *(u32x4*)(sK + (c / 24) * 400 + (c % 24) * 16) = pk[i]; }
#pragma unroll
    for (int i = 0; i < 4; i++) { int c = tid + 256 * i; *(u32x4*)(sV + (c >> 3) * 144 + (c & 7) * 16) = pv[i]; }
    __syncthreads();
    const float sc2 = 0.07216878364870322f * 1.4426950408889634f;
    for (int kt = 0; kt < nkt; kt++) {
        f32x16 st[2];
#pragma unroll
        for (int bk = 0; bk < 2; bk++)
#pragma unroll
            for (int r = 0; r < 16; r++) st[bk][r] = 0.f;
#pragma unroll
        for (int ks = 0; ks < 12; ks++) {
            const bf16x8 qfk = qf[ks];
#pragma unroll
            for (int bk = 0; bk < 2; bk++) {
                bf16x8 a = *(const bf16x8*)(sK + (bk * 32 + q) * 400 + ks * 32 + hh * 16);
                st[bk] = __builtin_amdgcn_mfma_f32_32x32x16_bf16(a, qfk, st[bk], 0, 0, 0);
            }
        }
        float mx = -1e30f;
#pragma unroll
        for (int bk = 0; bk < 2; bk++)
#pragma unroll
            for (int r = 0; r < 16; r++) { st[bk][r] *= sc2; mx = fmaxf(mx, st[bk][r]); }
        mx = fmaxf(mx, __shfl_xor(mx, 32, 64));
        const float mn = fmaxf(m, mx);
        const float alpha = exp2f(m - mn);
        float ps = 0.f;
#pragma unroll
        for (int bk = 0; bk < 2; bk++)
#pragma unroll
            for (int r = 0; r < 16; r++) { st[bk][r] = exp2f(st[bk][r] - mn); ps += st[bk][r]; }
        ps += __shfl_xor(ps, 32, 64);
        l = l * alpha + ps; m = mn;
#pragma unroll
        for (int i = 0; i < 4; i++)
#pragma unroll
            for (int r = 0; r < 16; r++) o[i][r] *= alpha;
#pragma unroll
        for (int s4 = 0; s4 < 4; s4++) {
            bf16x8 pb;
#pragma unroll
            for (int j = 0; j < 8; j++) pb[j] = (short)f2bf(st[s4 >> 1][8 * (s4 & 1) + j]);
#pragma unroll
            for (int i = 0; i < 4; i++) {
                bf16x8 a = *(const bf16x8*)(sV + (i * 32 + q) * 144 + s4 * 32 + hh * 16);
                o[i] = __builtin_amdgcn_mfma_f32_32x32x16_bf16(a, pb, o[i], 0, 0, 0);
            }
        }
        __syncthreads();
        if (kt + 1 < nkt) {
            const bf16_t* Kn = K + (size_t)(kt + 1) * 64 * 192;
            const bf16_t* Vn = Vt + (kt + 1) * 64;
#pragma unroll
            for (int i = 0; i < 6; i++) pk[i] = *(const u32x4*)(Kn + (size_t)(tid + 256 * i) * 8);
#pragma unroll
            for (int i = 0; i < 4; i++) { int c = tid + 256 * i; pv[i] = *(const u32x4*)(Vn + (size_t)(c >> 3) * Lk + (c & 7) * 8); }
#pragma unroll
            for (int i = 0; i < 6; i++) { int c = tid + 256 * i; *(u32x4*)(sK + (c / 24) * 400 + (c % 24) * 16) = pk[i]; }
#pragma unroll
            for (int i = 0; i < 4; i++) { int c = tid + 256 * i; *(u32x4*)(sV + (c >> 3) * 144 + (c & 7) * 16) = pv[i]; }
        }
        __syncthreads();
    }
    const float il = 1.f / l;
    bf16_t* op = cat + (size_t)t * DM + 512 + h * 128;
#pragma unroll
    for (int i = 0; i < 4; i++)
#pragma unroll
        for (int g = 0; g < 4; g++) {
            ushort4 w;
            w.x = f2bf(o[i][4 * g + 0] * il); w.y = f2bf(o[i][4 * g + 1] * il); w.z = f2bf(o[i][4 * g + 2] * il); w.w = f2bf(o[i][4 * g + 3] * il);
            *(ushort4*)(op + i * 32 + 8 * g + 4 * hh) = w;
        }
}


template <int K, int J>
__device__ __forceinline__ void bit_stage16(float (&x)[16]) {
#pragma unroll
    for (int i = 0; i < 16; i++) {
        const int l = i ^ J;
        if (l > i) {
            const bool desc = ((i & K) == 0);
            const float a = x[i], b = x[l];
            const float hi = fmaxf(a, b), lo = fminf(a, b);
            x[i] = desc ? hi : lo; x[l] = desc ? lo : hi;
        }
    }
}
__device__ __forceinline__ void bit_sort16_desc(float (&x)[16]) {
    bit_stage16<2, 1>(x);
    bit_stage16<4, 2>(x); bit_stage16<4, 1>(x);
    bit_stage16<8, 4>(x); bit_stage16<8, 2>(x); bit_stage16<8, 1>(x);
    bit_stage16<16, 8>(x); bit_stage16<16, 4>(x); bit_stage16<16, 2>(x); bit_stage16<16, 1>(x);
}
__device__ __forceinline__ void bit_merge16_desc(float (&x)[16]) {
    bit_stage16<16, 8>(x); bit_stage16<16, 4>(x); bit_stage16<16, 2>(x); bit_stage16<16, 1>(x);
}
template <int K, int J>
__device__ __forceinline__ void bit_stage16u(unsigned (&x)[16]) {
#pragma unroll
    for (int i = 0; i < 16; i++) {
        const int l = i ^ J;
        if (l > i) {
            const bool asc = ((i & K) == 0);
            const unsigned a = x[i], b = x[l];
            const unsigned lo = a < b ? a : b, hi = a < b ? b : a;
            x[i] = asc ? lo : hi; x[l] = asc ? hi : lo;
        }
    }
}
__device__ __forceinline__ void bit_sort16u_asc(unsigned (&x)[16]) {
    bit_stage16u<2, 1>(x);
    bit_stage16u<4, 2>(x); bit_stage16u<4, 1>(x);
    bit_stage16u<8, 4>(x); bit_stage16u<8, 2>(x); bit_stage16u<8, 1>(x);
    bit_stage16u<16, 8>(x); bit_stage16u<16, 4>(x); bit_stage16u<16, 2>(x); bit_stage16u<16, 1>(x);
}
__device__ __forceinline__ void bit_merge16u_asc(unsigned (&x)[16]) {
    bit_stage16u<16, 8>(x); bit_stage16u<16, 4>(x); bit_stage16u<16, 2>(x); bit_stage16u<16, 1>(x);
}
__device__ __forceinline__ void top16_merge(float (&L)[16], const float (&C)[16]) {
#pragma unroll
    for (int i = 0; i < 16; i++) L[i] = fmaxf(L[i], C[15 - i]);
    bit_merge16_desc(L);
}
__device__ __forceinline__ void low16_merge_u(unsigned (&L)[16], const unsigned (&C)[16]) {
#pragma unroll
    for (int i = 0; i < 16; i++) { const unsigned c = C[15 - i]; L[i] = L[i] < c ? L[i] : c; }
    bit_merge16u_asc(L);
}
__device__ __forceinline__ float key_val(float k) { return __uint_as_float(__float_as_uint(k) & ~127u); }
__device__ __forceinline__ int key_idx(float k) { return (int)(__float_as_uint(k) & 127u); }

struct EpiLds { static constexpr bool kQuad = false; float* lds; int c0; int pad;
    __device__ void operator()(int m, int n, float a) const { lds[m * 128 + (n - c0)] = a; } };

__device__ __forceinline__ void top16_col(const float* __restrict__ col, float (&L)[16]) {
#pragma unroll
    for (int ch = 0; ch < 8; ch++) {
        float C[16];
#pragma unroll
        for (int i = 0; i < 16; i++) {
            const int n = ch * 16 + i;
            C[i] = __uint_as_float((__float_as_uint(col[n * 128]) & ~127u) | (unsigned)n);
        }
        bit_sort16_desc(C);
        if (ch == 0) {
#pragma unroll
            for (int i = 0; i < 16; i++) L[i] = C[i];
        } else top16_merge(L, C);
    }
}
__device__ __forceinline__ void d_peer_route2(const int vb, char* smem, const bf16_t* __restrict__ kys, const bf16_t* __restrict__ qb,
                                              int* __restrict__ pidx, float* __restrict__ pg) {
    const int tt = vb % 96, h = vb / 96;
    const int tid = threadIdx.x;
    float A[16], B[16];
#pragma unroll
    for (int p = 0; p < 2; p++) {
        const int hp = h * 2 + p;
        d_gemm_bf16(tt, 0, smem, kys + (size_t)hp * 128 * 128, 128, qb + hp * 128, 2048, 128, TT, EpiLds{(float*)smem, tt * 128, 0});
        __syncthreads();
        if (tid < 128) {
            float L[16];
            top16_col((const float*)smem + tid, L);
#pragma unroll
            for (int i = 0; i < 16; i++) { if (p == 0) A[i] = L[i]; else B[i] = L[i]; }
        }
        __syncthreads();
    }
    if (tid >= 128) return;
    const int t = tt * 128 + tid;
    const float smax = key_val(A[0]) + key_val(B[0]);
    unsigned Tk[16];
#pragma unroll
    for (int g = 0; g < 4; g++) {
        unsigned Ck[16];
#pragma unroll
        for (int e = 0; e < 16; e++) {
            const int c = g * 16 + e;
            int i, j;
            if (c < 16) { i = 0; j = c; }
            else if (c < 24) { i = 1; j = c - 16; }
            else if (c < 29) { i = 2; j = c - 24; }
            else if (c < 33) { i = 3; j = c - 29; }
            else if (c < 36) { i = 4; j = c - 33; }
            else if (c < 42) { i = 5 + (c - 36) / 2; j = (c - 36) % 2; }
            else if (c < 50) { i = 8 + (c - 42); j = 0; }
            else { i = -1; j = 0; }
            if (i >= 0) {
                const float dd = smax - (key_val(A[i]) + key_val(B[j]));
                unsigned qd = (unsigned)fminf(dd * 32768.f, 262143.f);
                Ck[e] = (qd << 14) | (unsigned)(key_idx(A[i]) * 128 + key_idx(B[j]));
            } else Ck[e] = 0xffffffffu;
        }
        bit_sort16u_asc(Ck);
        if (g == 0) {
#pragma unroll
            for (int e = 0; e < 16; e++) Tk[e] = Ck[e];
        } else low16_merge_u(Tk, Ck);
    }
    float sum = 0.f;
    float w[16]; int Tp[16];
#pragma unroll
    for (int e = 0; e < 16; e++) { w[e] = __expf(-(float)(Tk[e] >> 14) * (1.f / 32768.f)); sum += w[e]; Tp[e] = (int)(Tk[e] & 16383u); }
    const float inv = 1.f / sum;
    int* pi = pidx + ((size_t)t * 8 + h) * 16;
    float* pw = pg + ((size_t)t * 8 + h) * 16;
#pragma unroll
    for (int e = 0; e < 16; e += 4) {
        *(int4*)(pi + e) = make_int4(Tp[e], Tp[e + 1], Tp[e + 2], Tp[e + 3]);
        *(float4*)(pw + e) = make_float4(w[e] * inv, w[e + 1] * inv, w[e + 2] * inv, w[e + 3] * inv);
    }
}

typedef __attribute__((ext_vector_type(2))) short bf16x2;
__device__ __forceinline__ float dot8_bf16(u32x4 a, u32x4 b, float acc) {
#pragma unroll
    for (int i = 0; i < 4; i++) {
        const unsigned x = a[i], y = b[i];
        acc += __uint_as_float(x << 16) * __uint_as_float(y << 16);
        acc += __uint_as_float(x & 0xffff0000u) * __uint_as_float(y & 0xffff0000u);
    }
    return acc;
}
__device__ __forceinline__ void d_cvt_bf16(const int vb, const float* __restrict__ src, bf16_t* __restrict__ dst) {
    const size_t base = (size_t)vb * 16384 + threadIdx.x * 4;
#pragma unroll
    for (int i = 0; i < 16; i++) {
        const float4 v = *(const float4*)(src + base + i * 1024);
        ushort4 o; o.x = f2bf(v.x); o.y = f2bf(v.y); o.z = f2bf(v.z); o.w = f2bf(v.w);
        *(ushort4*)(dst + base + i * 1024) = o;
    }
}


__device__ __forceinline__ void d_hy_filt2(const int vbl8, char* smem, const int L, const float* __restrict__ w1, const float* __restrict__ b1,
                                           const float* __restrict__ w2, const float* __restrict__ b2, const float* __restrict__ w3,
                                           const float* __restrict__ fr, bf16_t* __restrict__ gT, float* __restrict__ nsum) {
    float* zp = (float*)smem;
    float* h1 = zp + 32 * 33;
    float* h2t = h1 + 32 * 64;
    float* sw1 = h2t + 64 * 32;
    float* sw2 = sw1 + 33 * 64;
    const int tid = threadIdx.x;
    const int vbl = vbl8 >> 3, mm = vbl8 & 7;
    const int t0 = vbl * 32;
    for (int e = tid; e < 33 * 64; e += 256) sw1[e] = w1[e];
    for (int e = tid; e < 64 * 64; e += 256) sw2[e] = w2[e];
    for (int e = tid; e < 32 * 33; e += 256) {
        const int pos = e / 33, i = e % 33;
        const float t = (float)(t0 + pos);
        float val;
        if (i == 0) val = t / (float)(L - 1);
        else {
            const int bi = (i <= 16) ? (i - 1) : (i - 17);
            const float band = 1e-4f + (float)bi * ((15.f - 1e-4f) / 15.f);
            const float ang = 6.283185307179586f * t * band / (float)L;
            val = (i <= 16) ? __cosf(ang) : -__sinf(ang);
        }
        zp[e] = val;
    }
    const int c = tid + 256 * mm;
    float wv[8];
#pragma unroll
    for (int jj = 0; jj < 8; jj++) wv[jj] = w3[jj * 2048 + c];
    __syncthreads();
    {
        const int j = tid & 63;
        const float frj = fr[j];
#pragma unroll 1
        for (int i = 0; i < 8; i++) {
            const int pos = (tid >> 6) + 4 * i;
            float sacc = b1[j];
#pragma unroll 3
            for (int q = 0; q < 33; q++) sacc += zp[pos * 33 + q] * sw1[q * 64 + j];
            h1[pos * 64 + j] = __sinf(frj * sacc);
        }
        __syncthreads();
#pragma unroll 1
        for (int i = 0; i < 8; i++) {
            const int pos = (tid >> 6) + 4 * i;
            float sacc = b2[j];
#pragma unroll 4
            for (int q = 0; q < 64; q++) sacc += h1[pos * 64 + q] * sw2[q * 64 + j];
            h2t[j * 32 + pos] = __sinf(frj * sacc);
        }
    }
    __syncthreads();
    {
        float acc[32];
#pragma unroll
        for (int i = 0; i < 32; i++) acc[i] = 0.f;
#pragma unroll 1
        for (int jb = 0; jb < 64; jb += 8) {
            float wn[8];
            if (jb + 8 < 64) {
#pragma unroll
                for (int jj = 0; jj < 8; jj++) wn[jj] = w3[(jb + 8 + jj) * 2048 + c];
            }
#pragma unroll
            for (int jj = 0; jj < 8; jj++) {
                const float w = wv[jj];
#pragma unroll
                for (int i = 0; i < 8; i++) {
                    const float4 hv = *(const float4*)(h2t + (jb + jj) * 32 + i * 4);
                    acc[4 * i] += hv.x * w; acc[4 * i + 1] += hv.y * w; acc[4 * i + 2] += hv.z * w; acc[4 * i + 3] += hv.w * w;
                }
                __builtin_amdgcn_sched_barrier(0);
            }
            if (jb + 8 < 64) {
#pragma unroll
                for (int jj = 0; jj < 8; jj++) wv[jj] = wn[jj];
            }
        }
        const int ch = c & 1023;
        const float d0 = -4.605170185988091f / 0.3f, d1 = -4.605170185988091f / 1.5f;
        const float adelta = fabsf(d0 + (d1 - d0) * ((float)ch / 1023.f));
        float absum = 0.f;
        bf16_t* g = gT + (size_t)ch * 2 * L;
#pragma unroll
        for (int i = 0; i < 32; i++) {
            const int t = t0 + i;
            const float tu = (float)t / (float)(L - 1);
            const float val = acc[i] * __expf(-tu * adelta);
            if (c < 1024) { absum += fabsf(val); g[L - t] = f2bf(val); }
            else if (t >= 1) { absum += fabsf(val); g[L + t] = f2bf(val); }
            if ((i & 3) == 3) __builtin_amdgcn_sched_barrier(0);
        }
        atomicAdd(nsum + ch, absum);
    }
}

__device__ __forceinline__ void d_hy_dw3(const int vb, char* smem, const bf16_t* __restrict__ pre, const float* __restrict__ cw,
                                         const float* __restrict__ cb, bf16_t* __restrict__ zT, bf16_t* __restrict__ x0b) {
    bf16_t* tile = (bf16_t*)smem;
    const int tt = vb >> 3, ct = vb & 7;
    const int tid = threadIdx.x;
    const int cp = tid & 63, c = ct * 128 + cp * 2;
    const int tq = tid >> 6;
    const int tok0 = tt * 64 + tq * 16;
    const int pos0 = tok_pos(tok0), L = tok_len(tok0);
    unsigned raw[3][18];
#pragma unroll
    for (int part = 0; part < 3; part++)
#pragma unroll
        for (int i = 0; i < 18; i++) {
            const int pos = pos0 - 1 + i;
            raw[part][i] = (pos >= 0 && pos < L) ? *(const unsigned*)(pre + (size_t)(tok0 - 1 + i) * 3072 + part * 1024 + c) : 0u;
        }
    float w0[3][2], w1[3][2], w2[3][2], bb[3][2];
#pragma unroll
    for (int part = 0; part < 3; part++)
#pragma unroll
        for (int e = 0; e < 2; e++) {
            const int col = part * 1024 + c + e;
            w0[part][e] = cw[col]; w1[part][e] = cw[3072 + col]; w2[part][e] = cw[2 * 3072 + col]; bb[part][e] = cb[col];
        }
#pragma unroll
    for (int i = 0; i < 16; i++) {
        float u[3][2];
#pragma unroll
        for (int part = 0; part < 3; part++) {
            const unsigned p0 = raw[part][i], p1 = raw[part][i + 1], p2 = raw[part][i + 2];
            u[part][0] = __uint_as_float(p0 << 16) * w0[part][0] + __uint_as_float(p1 << 16) * w1[part][0] + __uint_as_float(p2 << 16) * w2[part][0] + bb[part][0];
            u[part][1] = __uint_as_float(p0 & 0xffff0000u) * w0[part][1] + __uint_as_float(p1 & 0xffff0000u) * w1[part][1] +
                         __uint_as_float(p2 & 0xffff0000u) * w2[part][1] + bb[part][1];
        }
        *(unsigned*)(x0b + (size_t)(tok0 + i) * DM + c) = (unsigned)f2bf(u[0][0]) | ((unsigned)f2bf(u[0][1]) << 16);
        tile[(cp * 2) * 72 + tq * 16 + i] = f2bf(u[1][0] * u[2][0]);
        tile[(cp * 2 + 1) * 72 + tq * 16 + i] = f2bf(u[1][1] * u[2][1]);
    }
    __syncthreads();
    {
        const int cch = tid >> 1, hf = tid & 1;
        bf16_t* dst = zT + (size_t)(ct * 128 + cch) * TT + tt * 64 + hf * 32;
        const bf16_t* src = tile + cch * 72 + hf * 32;
#pragma unroll
        for (int q = 0; q < 4; q++) *(u32x4*)(dst + q * 8) = *(const u32x4*)(src + q * 8);
    }
}

template <bool SAMPLE>
__device__ __forceinline__ void d_hy_conv2(const int c, const int half, char* wsm, const bf16_t* __restrict__ gTall, const float* __restrict__ nsum,
                                           const bf16_t* __restrict__ zT, const float* __restrict__ bias, bf16_t* __restrict__ yT) {
    constexpr int L = SAMPLE ? LS : LP;
    constexpr int NB = L / 32;
    constexpr int NBATCH = SAMPLE ? 4 : 16;
    constexpr int BSH = SAMPLE ? 2 : 4;
    constexpr int TPB = 32 >> BSH;
    constexpr int NCB = NB / TPB;
    constexpr int HCB = NCB / 2;
    constexpr int PADB = SAMPLE ? 8 : 2;
    constexpr int ZLEN = L + 2 * PADB * 32;
    constexpr int tbase = SAMPLE ? TP : 0;
    const int lane = threadIdx.x & 63;
    const int l2 = half * 64 + lane;
    const int lc = lane & 31, hh = lane >> 5;
    const int b = lc & (NBATCH - 1), Tl = lc >> BSH;
    bf16_t* R = (bf16_t*)wsm;
    bf16_t* Z = R + 2 * L;
    {
        constexpr int RCH = 2 * L / 8 / 128;
        constexpr int ZCH = NBATCH * (L / 8) / 128;
        const u32x4* src = (const u32x4*)(gTall + (size_t)c * 2 * L);
        u32x4 rr[RCH > 0 ? RCH : 1], zz[ZCH];
        if constexpr (RCH > 0) {
#pragma unroll
            for (int i = 0; i < RCH; i++) rr[i] = src[l2 + 128 * i];
        } else {
            if (l2 < 2 * L / 8) rr[0] = src[l2];
        }
#pragma unroll
        for (int i = 0; i < ZCH; i++) {
            const int q = l2 + 128 * i;
            const int b2 = q / (L / 8), ci = q % (L / 8);
            zz[i] = ((const u32x4*)(zT + (size_t)c * TT + tbase + b2 * L))[ci];
        }
        const u32x4 zero = {0u, 0u, 0u, 0u};
        for (int q = l2; q < NBATCH * PADB * 4; q += 128) {
            const int b2 = q / (PADB * 4), i = q % (PADB * 4);
            u32x4* zd = (u32x4*)(Z + b2 * ZLEN);
            zd[i] = zero; zd[PADB * 4 + L / 8 + i] = zero;
        }
        if constexpr (RCH > 0) {
#pragma unroll
            for (int i = 0; i < RCH; i++) ((u32x4*)R)[l2 + 128 * i] = rr[i];
        } else {
            if (l2 < 2 * L / 8) ((u32x4*)R)[l2] = rr[0];
        }
#pragma unroll
        for (int i = 0; i < ZCH; i++) {
            const int q = l2 + 128 * i;
            const int b2 = q / (L / 8), ci = q % (L / 8);
            ((u32x4*)(Z + b2 * ZLEN))[PADB * 4 + ci] = zz[i];
        }
    }
    __syncthreads();
    f32x16 acc[HCB];
#pragma unroll
    for (int cb = 0; cb < HCB; cb++)
#pragma unroll
        for (int r = 0; r < 16; r++) acc[cb][r] = 0.f;
    const bf16_t* Zb = Z + b * ZLEN + PADB * 32 + 8 * hh;
    const int cb0 = half * HCB;
    const int Dlo = TPB * cb0 - (NB - 1), Dhi = TPB * (cb0 + HCB - 1) + TPB - 1;
#pragma unroll 1
    for (int D = (Dlo < -(NB - 1) ? -(NB - 1) : Dlo); D <= (Dhi > NB - 1 ? NB - 1 : Dhi); D++) {
        bf16x8 af[2];
#pragma unroll
        for (int ks = 0; ks < 2; ks++) {
            const bf16_t* rp = R + (L - 32 * D - lc + 16 * ks + 8 * hh);
#pragma unroll
            for (int j = 0; j < 8; j++) af[ks][j] = (short)rp[j];
        }
#pragma unroll
        for (int lcb = 0; lcb < HCB; lcb++) {
            const int cb = cb0 + lcb;
            if (D >= TPB * cb - (NB - 1) && D <= TPB * cb + TPB - 1) {
                const int S = TPB * cb + Tl - D;
#pragma unroll
                for (int ks = 0; ks < 2; ks++) {
                    const bf16x8 bfr = *(const bf16x8*)(Zb + 32 * S + 16 * ks);
                    acc[lcb] = __builtin_amdgcn_mfma_f32_32x32x16_bf16(af[ks], bfr, acc[lcb], 0, 0, 0);
                }
            }
        }
    }
    const float inv = 1.f / nsum[c], bs = bias[c];
    bf16_t* yrow = yT + (size_t)c * TT + tbase + b * L;
    const bf16_t* zrow = Z + b * ZLEN + PADB * 32;
#pragma unroll
    for (int lcb = 0; lcb < HCB; lcb++)
#pragma unroll
        for (int g = 0; g < 4; g++) {
            const int t = 32 * (TPB * (cb0 + lcb) + Tl) + 8 * g + 4 * hh;
            ushort4 o;
            o.x = f2bf(acc[lcb][4 * g + 0] * inv + bf2f(zrow[t + 0]) * bs);
            o.y = f2bf(acc[lcb][4 * g + 1] * inv + bf2f(zrow[t + 1]) * bs);
            o.z = f2bf(acc[lcb][4 * g + 2] * inv + bf2f(zrow[t + 2]) * bs);
            o.w = f2bf(acc[lcb][4 * g + 3] * inv + bf2f(zrow[t + 3]) * bs);
            *(ushort4*)(yrow + t) = o;
        }
}

__device__ __forceinline__ void d_hy_post2(const int vb, char* smem, const bf16_t* __restrict__ yT, const bf16_t* __restrict__ x0b, bf16_t* __restrict__ zb) {
    bf16_t* tile = (bf16_t*)smem;
    const int tt = vb >> 3, ct = vb & 7;
    const int tid = threadIdx.x;
    const int cp = tid & 63, c = ct * 128 + cp * 2, tq = tid >> 6;
    const int tok0 = tt * 64 + tq * 16;
    unsigned xr[16];
#pragma unroll
    for (int i = 0; i < 16; i++) xr[i] = *(const unsigned*)(x0b + (size_t)(tok0 + i) * DM + c);
    {
        const int cch = tid >> 1, hf = tid & 1;
        const bf16_t* src = yT + (size_t)(ct * 128 + cch) * TT + tt * 64 + hf * 32;
        bf16_t* dst = tile + cch * 72 + hf * 32;
#pragma unroll
        for (int q = 0; q < 4; q++) *(u32x4*)(dst + q * 8) = *(const u32x4*)(src + q * 8);
    }
    __syncthreads();
#pragma unroll
    for (int i = 0; i < 16; i++) {
        const float y0 = bf2f(tile[(cp * 2) * 72 + tq * 16 + i]), y1 = bf2f(tile[(cp * 2 + 1) * 72 + tq * 16 + i]);
        const float r0 = __uint_as_float(xr[i] << 16) * y0, r1 = __uint_as_float(xr[i] & 0xffff0000u) * y1;
        *(unsigned*)(zb + (size_t)(tok0 + i) * DM + c) = (unsigned)f2bf(r0) | ((unsigned)f2bf(r1) << 16);
    }
}

__device__ __forceinline__ float wave_allsum_fast(float v) {
    v = row16_allsum(v);
    const float r0 = __int_as_float(__builtin_amdgcn_readlane(__float_as_int(v), 0));
    const float r1 = __int_as_float(__builtin_amdgcn_readlane(__float_as_int(v), 16));
    const float r2 = __int_as_float(__builtin_amdgcn_readlane(__float_as_int(v), 32));
    const float r3 = __int_as_float(__builtin_amdgcn_readlane(__float_as_int(v), 48));
    return (r0 + r1) + (r2 + r3);
}
__device__ __forceinline__ ushort4 pack_bf4(float a, float b, float c, float d) { ushort4 o; o.x = f2bf(a); o.y = f2bf(b); o.z = f2bf(c); o.w = f2bf(d); return o; }

__device__ __forceinline__ void d_norm_mod2(const int vb, const float* __restrict__ xa, const float* __restrict__ xb, const float* __restrict__ g,
                                            const float* __restrict__ modl, const int shift_idx, const int scale_idx, bf16_t* __restrict__ h) {
    const int wid = threadIdx.x >> 6, lane = threadIdx.x & 63;
    const int t0 = vb * 8 + wid * 2;
    float4 v[2][4];
#pragma unroll
    for (int u = 0; u < 2; u++) {
        const int t = t0 + u;
        const float* x = (t < TP) ? (xa + (size_t)t * DM) : (xb + (size_t)(t - TP) * DM);
#pragma unroll
        for (int j = 0; j < 4; j++) v[u][j] = *(const float4*)(x + j * 256 + lane * 4);
    }
#pragma unroll
    for (int u = 0; u < 2; u++) {
        const int t = t0 + u;
        float ss = 0.f;
#pragma unroll
        for (int j = 0; j < 4; j++) ss += v[u][j].x * v[u][j].x + v[u][j].y * v[u][j].y + v[u][j].z * v[u][j].z + v[u][j].w * v[u][j].w;
        ss = wave_allsum_fast(ss);
        const float rstd = rsqrtf(ss * (1.f / DM) + 1e-6f);
        const float* m = modl + (size_t)tok_modrow(t) * 6144;
#pragma unroll
        for (int j = 0; j < 4; j++) {
            const int c = j * 256 + lane * 4;
            const float4 gg = *(const float4*)(g + c);
            const float4 sh = *(const float4*)(m + shift_idx * 1024 + c);
            const float4 sc = *(const float4*)(m + scale_idx * 1024 + c);
            *(ushort4*)(h + (size_t)t * DM + c) = pack_bf4(v[u][j].x * rstd * gg.x * (1.f + sc.x) + sh.x, v[u][j].y * rstd * gg.y * (1.f + sc.y) + sh.y,
                                                           v[u][j].z * rstd * gg.z * (1.f + sc.z) + sh.z, v[u][j].w * rstd * gg.w * (1.f + sc.w) + sh.w);
        }
    }
}

__device__ __forceinline__ void d_rw_shift2(const int vb, const bf16_t* __restrict__ proj, const float* __restrict__ mu, bf16_t* __restrict__ rb,
                                            bf16_t* __restrict__ kb, bf16_t* __restrict__ vbuf, bf16_t* __restrict__ tw, bf16_t* __restrict__ adv,
                                            bf16_t* __restrict__ sg) {
#pragma unroll
    for (int u = 0; u < 4; u++) {
        const int id = vb * 1024 + u * 256 + threadIdx.x;
        const int t = id / 224, c = (id % 224) * 8;
        const int pos = tok_pos(t), L = tok_len(t);
        const bf16_t* P = proj + (size_t)t * RWIN + c;
        const u32x4 cur = *(const u32x4*)P;
        u32x4 prv = {0u, 0u, 0u, 0u}, nxt = {0u, 0u, 0u, 0u};
        if (pos > 0) prv = *(const u32x4*)(P - RWIN);
        if (pos < L - 1) nxt = *(const u32x4*)(P + RWIN);
        const float4 m0 = *(const float4*)(mu + c), m1 = *(const float4*)(mu + c + 4);
        const float mm[8] = {m0.x, m0.y, m0.z, m0.w, m1.x, m1.y, m1.z, m1.w};
        float val[8];
#pragma unroll
        for (int i = 0; i < 4; i++) {
            const float c0 = __uint_as_float(cur[i] << 16), c1 = __uint_as_float(cur[i] & 0xffff0000u);
            const float p0 = __uint_as_float(prv[i] << 16), p1 = __uint_as_float(prv[i] & 0xffff0000u);
            const float n0 = __uint_as_float(nxt[i] << 16), n1 = __uint_as_float(nxt[i] & 0xffff0000u);
            val[2 * i] = c0 + mm[2 * i] * (0.5f * (p0 + n0) - c0);
            val[2 * i + 1] = c1 + mm[2 * i + 1] * (0.5f * (p1 + n1) - c1);
        }
        bf16_t* dst;
        if (c < 512) dst = rb + (size_t)t * 512 + c;
        else if (c < 1024) dst = kb + (size_t)t * 512 + (c - 512);
        else if (c < 1536) dst = vbuf + (size_t)t * 512 + (c - 1024);
        else if (c < 1600) { dst = tw + (size_t)t * 64 + (c - 1536);
#pragma unroll
            for (int i = 0; i < 8; i++) val[i] = tanhf(val[i]); }
        else if (c < 1664) dst = adv + (size_t)t * 64 + (c - 1600);
        else { dst = sg + (size_t)t * 128 + (c - 1664);
#pragma unroll
            for (int i = 0; i < 8; i++) val[i] = sigmoidf_(val[i]); }
        u32x4 o;
#pragma unroll
        for (int i = 0; i < 4; i++) o[i] = (unsigned)f2bf(val[2 * i]) | ((unsigned)f2bf(val[2 * i + 1]) << 16);
        *(u32x4*)dst = o;
    }
}

__device__ __forceinline__ void d_mla_pre2(const int vb, const float* __restrict__ proj, const float* __restrict__ q_norm, const float* __restrict__ kv_norm,
                                           bf16_t* __restrict__ qcn, bf16_t* __restrict__ ckv, float* __restrict__ kpe, float* __restrict__ out_ckv,
                                           float* __restrict__ out_kpe) {
    const int t = vb * 16 + (threadIdx.x >> 4), l16 = threadIdx.x & 15;
    const float* P = proj + (size_t)t * 448;
    float4 x[7];
#pragma unroll
    for (int j = 0; j < 7; j++) x[j] = *(const float4*)(P + 4 * (l16 + 16 * j));
    float sq = 0.f, sk = 0.f;
#pragma unroll
    for (int j = 0; j < 4; j++) sq += x[j].x * x[j].x + x[j].y * x[j].y + x[j].z * x[j].z + x[j].w * x[j].w;
#pragma unroll
    for (int j = 4; j < 6; j++) sk += x[j].x * x[j].x + x[j].y * x[j].y + x[j].z * x[j].z + x[j].w * x[j].w;
    sq = row16_allsum(sq); sk = row16_allsum(sk);
    const float rq = rsqrtf(sq * (1.f / 256.f) + 1e-6f), rk = rsqrtf(sk * (1.f / 128.f) + 1e-6f);
#pragma unroll
    for (int j = 0; j < 4; j++) {
        const int c = 4 * (l16 + 16 * j);
        const float4 w = *(const float4*)(q_norm + c);
        *(ushort4*)(qcn + (size_t)t * 256 + c) = pack_bf4(x[j].x * rq * w.x, x[j].y * rq * w.y, x[j].z * rq * w.z, x[j].w * rq * w.w);
    }
#pragma unroll
    for (int j = 4; j < 6; j++) {
        const int c = 4 * (l16 + 16 * (j - 4));
        const float4 w = *(const float4*)(kv_norm + c);
        const float4 o = make_float4(x[j].x * rk * w.x, x[j].y * rk * w.y, x[j].z * rk * w.z, x[j].w * rk * w.w);
        *(ushort4*)(ckv + (size_t)t * 128 + c) = pack_bf4(o.x, o.y, o.z, o.w);
        if (t < TP) *(float4*)(out_ckv + (size_t)t * 128 + c) = o;
    }
    {
        const int c = 4 * l16;
        *(float4*)(kpe + (size_t)t * 64 + c) = x[6];
        if (t < TP) *(float4*)(out_kpe + (size_t)t * 64 + c) = x[6];
    }
}


typedef float f32x2 __attribute__((ext_vector_type(2)));
template <int CTRL>
__device__ __forceinline__ float dpp_max(float v) {
    return fmaxf(v, __int_as_float(__builtin_amdgcn_update_dpp(0, __float_as_int(v), CTRL, 0xf, 0xf, false)));
}
__device__ __forceinline__ float wave_allmax_fast(float v) {
    v = dpp_max<0x128>(v); v = dpp_max<0x124>(v); v = dpp_max<0x122>(v); v = dpp_max<0x121>(v);
    const float r0 = __int_as_float(__builtin_amdgcn_readlane(__float_as_int(v), 0));
    const float r1 = __int_as_float(__builtin_amdgcn_readlane(__float_as_int(v), 16));
    const float r2 = __int_as_float(__builtin_amdgcn_readlane(__float_as_int(v), 32));
    const float r3 = __int_as_float(__builtin_amdgcn_readlane(__float_as_int(v), 48));
    return fmaxf(fmaxf(r0, r1), fmaxf(r2, r3));
}
__device__ __forceinline__ void d_cvt_fp8_rows(const int vb, const float* __restrict__ src, unsigned char* __restrict__ dst, float* __restrict__ rscale) {
    const int wid = threadIdx.x >> 6, lane = threadIdx.x & 63;
    float4 x[4][4];
#pragma unroll
    for (int u = 0; u < 4; u++) {
        const float* r = src + (size_t)(vb * 16 + wid * 4 + u) * 1024 + lane * 4;
#pragma unroll
        for (int j = 0; j < 4; j++) x[u][j] = *(const float4*)(r + 256 * j);
    }
#pragma unroll
    for (int u = 0; u < 4; u++) {
        const int row = vb * 16 + wid * 4 + u;
        float am = 0.f;
#pragma unroll
        for (int j = 0; j < 4; j++) am = fmaxf(am, fmaxf(fmaxf(fabsf(x[u][j].x), fabsf(x[u][j].y)), fmaxf(fabsf(x[u][j].z), fabsf(x[u][j].w))));
        am = wave_allmax_fast(am);
        const float sc = am > 0.f ? 448.f / am : 1.f;
#pragma unroll
        for (int j = 0; j < 4; j++) {
            int pk = __builtin_amdgcn_cvt_pk_fp8_f32(x[u][j].x * sc, x[u][j].y * sc, 0, false);
            pk = __builtin_amdgcn_cvt_pk_fp8_f32(x[u][j].z * sc, x[u][j].w * sc, pk, true);
            *(unsigned*)(dst + (size_t)row * 1024 + 256 * j + lane * 4) = (unsigned)pk;
        }
        if (lane == 0) rscale[row] = am > 0.f ? am * (1.f / 448.f) : 1.f;
    }
}
__device__ __forceinline__ void d_peer_apply3(const int vb, char* smem, const bf16_t* __restrict__ hb, const int* __restrict__ pidx,
                                              const float* __restrict__ pg, const unsigned char* __restrict__ utab, const unsigned char* __restrict__ vtab,
                                              const float* __restrict__ rsU, const float* __restrict__ rsV, const float* __restrict__ modl,
                                              float* __restrict__ xrun, const float* __restrict__ g_next, const float* __restrict__ mod_next,
                                              bf16_t* __restrict__ h_next) {
    const int wid = threadIdx.x >> 6, lane = threadIdx.x & 63;
    const int t = vb * 4 + wid;
    float* coef = (float*)smem + wid * 128;
    int* eid = (int*)(smem + 2048) + wid * 128;
    const int e_lo = pidx[(size_t)t * 128 + lane], e_hi = pidx[(size_t)t * 128 + lane + 64];
    eid[lane] = e_lo; eid[lane + 64] = e_hi;
    const float g0 = pg[(size_t)t * 128 + lane] * rsV[e_lo], g1 = pg[(size_t)t * 128 + lane + 64] * rsV[e_hi];
    const float ru0 = rsU[e_lo], ru1 = rsU[e_hi];
    float x[16];
    {
        const u32x4 a = *(const u32x4*)(hb + (size_t)t * DM + lane * 16), b = *(const u32x4*)(hb + (size_t)t * DM + lane * 16 + 8);
#pragma unroll
        for (int i = 0; i < 4; i++) {
            x[2 * i] = __uint_as_float(a[i] << 16); x[2 * i + 1] = __uint_as_float(a[i] & 0xffff0000u);
            x[8 + 2 * i] = __uint_as_float(b[i] << 16); x[8 + 2 * i + 1] = __uint_as_float(b[i] & 0xffff0000u);
        }
    }
    __builtin_amdgcn_wave_barrier();
    float myact0 = 0.f, myact1 = 0.f;
    f32x2 xp[8];
#pragma unroll
    for (int i = 0; i < 8; i++) { xp[i][0] = x[2 * i]; xp[i][1] = x[2 * i + 1]; }
    const bool b3 = (lane & 8) != 0;
    const int bp_addr = ((lane & 14) << 2) * 4;
#pragma unroll 1
    for (int eb = 0; eb < 128; eb += 16) {
        u32x4 q[16];
#pragma unroll
        for (int r = 0; r < 16; r++) q[r] = *(const u32x4*)(utab + (size_t)eid[eb + r] * 1024 + lane * 16);
        float sacc[16];
#pragma unroll
        for (int r = 0; r < 16; r++) {
            f32x2 a2 = {0.f, 0.f};
#pragma unroll
            for (int i = 0; i < 4; i++) {
                const f32x2 f01 = __builtin_amdgcn_cvt_pk_f32_fp8((int)q[r][i], false);
                const f32x2 f23 = __builtin_amdgcn_cvt_pk_f32_fp8((int)q[r][i], true);
                a2 = __builtin_elementwise_fma(f01, xp[2 * i], a2);
                a2 = __builtin_elementwise_fma(f23, xp[2 * i + 1], a2);
            }
            sacc[r] = a2[0] + a2[1];
        }
        float t8[8], t4[4], t2[2];
#pragma unroll
        for (int r = 0; r < 8; r++) {
            const auto R = __builtin_amdgcn_permlane32_swap(__float_as_uint(sacc[r]), __float_as_uint(sacc[r + 8]), false, false);
            t8[r] = __uint_as_float(R[0]) + __uint_as_float(R[1]);
        }
#pragma unroll
        for (int r = 0; r < 4; r++) {
            const auto R = __builtin_amdgcn_permlane16_swap(__float_as_uint(t8[r]), __float_as_uint(t8[r + 4]), false, false);
            t4[r] = __uint_as_float(R[0]) + __uint_as_float(R[1]);
        }
#pragma unroll
        for (int r = 0; r < 2; r++) {
            const float keep = b3 ? t4[r + 2] : t4[r], give = b3 ? t4[r] : t4[r + 2];
            float v = keep + __int_as_float(__builtin_amdgcn_update_dpp(0, __float_as_int(give), 0x128, 0xf, 0xf, false));
            v += __int_as_float(__builtin_amdgcn_update_dpp(0, __float_as_int(v), 0xB1, 0xf, 0xf, false));
            v += __int_as_float(__builtin_amdgcn_update_dpp(0, __float_as_int(v), 0x4E, 0xf, 0xf, false));
            v += __int_as_float(__builtin_amdgcn_update_dpp(0, __float_as_int(v), 0x141, 0xf, 0xf, false));
            t2[r] = v;
        }
        const float v0 = __int_as_float(__builtin_amdgcn_ds_bpermute(bp_addr, __float_as_int(t2[0])));
        const float v1 = __int_as_float(__builtin_amdgcn_ds_bpermute(bp_addr, __float_as_int(t2[1])));
        const float val = (lane & 1) ? v1 : v0;
        if ((lane & 48) == (eb & 48)) { if (eb < 64) myact0 = val; else myact1 = val; }
    }
    coef[lane] = g0 * gelu_tanh(myact0 * ru0);
    coef[lane + 64] = g1 * gelu_tanh(myact1 * ru1);
    __builtin_amdgcn_wave_barrier();
    float acc[16];
#pragma unroll
    for (int i = 0; i < 16; i++) acc[i] = 0.f;
#pragma unroll 1
    for (int eb = 0; eb < 128; eb += 16) {
        u32x4 q[16];
#pragma unroll
        for (int r = 0; r < 16; r++) q[r] = *(const u32x4*)(vtab + (size_t)eid[eb + r] * 1024 + lane * 16);
#pragma unroll
        for (int r = 0; r < 16; r++) {
            const float cf = coef[eb + r];
#pragma unroll
            for (int i = 0; i < 4; i++) {
                const f32x2 f01 = __builtin_amdgcn_cvt_pk_f32_fp8((int)q[r][i], false);
                const f32x2 f23 = __builtin_amdgcn_cvt_pk_f32_fp8((int)q[r][i], true);
                acc[4 * i] += cf * f01[0]; acc[4 * i + 1] += cf * f01[1]; acc[4 * i + 2] += cf * f23[0]; acc[4 * i + 3] += cf * f23[1];
            }
        }
    }
    const float* m = modl + (size_t)tok_modrow(t) * 6144 + 5 * 1024 + lane * 16;
    float* xo = xrun + (size_t)t * DM + lane * 16;
    float ss = 0.f;
#pragma unroll
    for (int j = 0; j < 4; j++) {
        float4 xa = *(float4*)(xo + 4 * j);
        const float4 ma = *(const float4*)(m + 4 * j);
        xa.x += ma.x * acc[4 * j]; xa.y += ma.y * acc[4 * j + 1]; xa.z += ma.z * acc[4 * j + 2]; xa.w += ma.w * acc[4 * j + 3];
        *(float4*)(xo + 4 * j) = xa;
        acc[4 * j] = xa.x; acc[4 * j + 1] = xa.y; acc[4 * j + 2] = xa.z; acc[4 * j + 3] = xa.w;
        ss += xa.x * xa.x + xa.y * xa.y + xa.z * xa.z + xa.w * xa.w;
    }
    if (g_next != nullptr) {
        ss = wave_allsum_fast(ss);
        const float rstd = rsqrtf(ss * (1.f / DM) + 1e-6f);
        const float* mn = mod_next + (size_t)tok_modrow(t) * 6144 + lane * 16;
#pragma unroll
        for (int j = 0; j < 4; j++) {
            const float4 gg = *(const float4*)(g_next + lane * 16 + 4 * j);
            const float4 sh = *(const float4*)(mn + 4 * j);
            const float4 sc = *(const float4*)(mn + 1024 + 4 * j);
            *(ushort4*)(h_next + (size_t)t * DM + lane * 16 + 4 * j) =
                pack_bf4(acc[4 * j] * rstd * gg.x * (1.f + sc.x) + sh.x, acc[4 * j + 1] * rstd * gg.y * (1.f + sc.y) + sh.y,
                         acc[4 * j + 2] * rstd * gg.z * (1.f + sc.z) + sh.z, acc[4 * j + 3] * rstd * gg.w * (1.f + sc.w) + sh.w);
        }
    }
}


__device__ __forceinline__ void d_rw_kk3(const int vb, const bf16_t* __restrict__ rb, const bf16_t* __restrict__ kb, const bf16_t* __restrict__ lr0,
                                         const bf16_t* __restrict__ lr1, const float* __restrict__ k_k, const float* __restrict__ k_a,
                                         const float* __restrict__ r_k, bf16_t* __restrict__ kkb, float* __restrict__ bonus) {
    const int g = threadIdx.x >> 4, l16 = threadIdx.x & 15;
    uint2 kq[4], rq[4], aq[4], bq[4];
#pragma unroll
    for (int u = 0; u < 4; u++) {
        const size_t o = (size_t)(vb * 64 + g + 16 * u) * 64 + l16 * 4;
        kq[u] = *(const uint2*)(kb + o); rq[u] = *(const uint2*)(rb + o); aq[u] = *(const uint2*)(lr0 + o); bq[u] = *(const uint2*)(lr1 + o);
    }
#pragma unroll
    for (int u = 0; u < 4; u++) {
        const int w = vb * 64 + g + 16 * u;
        const int h = w & 7;
        const float4 kk4 = *(const float4*)(k_k + h * 64 + l16 * 4), ka4 = *(const float4*)(k_a + h * 64 + l16 * 4), rk4 = *(const float4*)(r_k + h * 64 + l16 * 4);
        const float k0 = __uint_as_float(kq[u].x << 16), k1 = __uint_as_float(kq[u].x & 0xffff0000u), k2 = __uint_as_float(kq[u].y << 16), k3 = __uint_as_float(kq[u].y & 0xffff0000u);
        const float r0 = __uint_as_float(rq[u].x << 16), r1 = __uint_as_float(rq[u].x & 0xffff0000u), r2 = __uint_as_float(rq[u].y << 16), r3 = __uint_as_float(rq[u].y & 0xffff0000u);
        const float a0 = __uint_as_float(aq[u].x << 16), a1 = __uint_as_float(aq[u].x & 0xffff0000u), a2 = __uint_as_float(aq[u].y << 16), a3 = __uint_as_float(aq[u].y & 0xffff0000u);
        const float b0 = __uint_as_float(bq[u].x << 16), b1 = __uint_as_float(bq[u].x & 0xffff0000u), b2 = __uint_as_float(bq[u].y << 16), b3 = __uint_as_float(bq[u].y & 0xffff0000u);
        const float q0 = k0 * kk4.x, q1 = k1 * kk4.y, q2 = k2 * kk4.z, q3 = k3 * kk4.w;
        float ss = (q0 * q0 + q1 * q1) + (q2 * q2 + q3 * q3);
        float bs = r0 * k0 * (2.f + (a0 + b0 - 2.f) * ka4.x) * rk4.x + r1 * k1 * (2.f + (a1 + b1 - 2.f) * ka4.y) * rk4.y +
                   r2 * k2 * (2.f + (a2 + b2 - 2.f) * ka4.z) * rk4.z + r3 * k3 * (2.f + (a3 + b3 - 2.f) * ka4.w) * rk4.w;
        ss = row16_allsum(ss); bs = row16_allsum(bs);
        const float inv = 1.f / fmaxf(sqrtf(ss), 1e-12f);
        uint2 o2;
        o2.x = (unsigned)f2bf(q0 * inv) | ((unsigned)f2bf(q1 * inv) << 16);
        o2.y = (unsigned)f2bf(q2 * inv) | ((unsigned)f2bf(q3 * inv) << 16);
        *(uint2*)(kkb + (size_t)w * 64 + l16 * 4) = o2;
        if (l16 == 0) bonus[w] = bs;
    }
}
__device__ __forceinline__ void d_rw_post3(const int vb, const float* __restrict__ y0, const float* __restrict__ y1, const float* __restrict__ bonus,
                                           const bf16_t* __restrict__ vbuf, const bf16_t* __restrict__ gate, const float* __restrict__ lnx_g,
                                           const float* __restrict__ lnx_b, bf16_t* __restrict__ cat) {
    const int g = threadIdx.x >> 4, l16 = threadIdx.x & 15;
    float4 ya[4], yb[4]; uint2 vq[4], gq[4];
#pragma unroll
    for (int u = 0; u < 4; u++) {
        const size_t o = (size_t)(vb * 64 + g + 16 * u) * 64 + l16 * 4;
        ya[u] = *(const float4*)(y0 + o); yb[u] = *(const float4*)(y1 + o); vq[u] = *(const uint2*)(vbuf + o); gq[u] = *(const uint2*)(gate + o);
    }
#pragma unroll
    for (int u = 0; u < 4; u++) {
        const int w = vb * 64 + g + 16 * u;
        const int t = w >> 3, h = w & 7;
        const float e0 = ya[u].x + yb[u].x, e1 = ya[u].y + yb[u].y, e2 = ya[u].z + yb[u].z, e3 = ya[u].w + yb[u].w;
        const float mean = row16_allsum((e0 + e1) + (e2 + e3)) * (1.f / 64.f);
        const float d0 = e0 - mean, d1 = e1 - mean, d2 = e2 - mean, d3 = e3 - mean;
        const float var = row16_allsum((d0 * d0 + d1 * d1) + (d2 * d2 + d3 * d3)) * (1.f / 64.f);
        const float rstd = rsqrtf(var + 64e-5f);
        const float bn = bonus[w];
        const float4 g4 = *(const float4*)(lnx_g + h * 64 + l16 * 4), b4 = *(const float4*)(lnx_b + h * 64 + l16 * 4);
        const float v0 = __uint_as_float(vq[u].x << 16), v1 = __uint_as_float(vq[u].x & 0xffff0000u), v2 = __uint_as_float(vq[u].y << 16), v3 = __uint_as_float(vq[u].y & 0xffff0000u);
        const float t0 = __uint_as_float(gq[u].x << 16), t1 = __uint_as_float(gq[u].x & 0xffff0000u), t2 = __uint_as_float(gq[u].y << 16), t3 = __uint_as_float(gq[u].y & 0xffff0000u);
        uint2 o2;
        o2.x = (unsigned)f2bf((d0 * rstd * g4.x + b4.x + bn * v0) * t0) | ((unsigned)f2bf((d1 * rstd * g4.y + b4.y + bn * v1) * t1) << 16);
        o2.y = (unsigned)f2bf((d2 * rstd * g4.z + b4.z + bn * v2) * t2) | ((unsigned)f2bf((d3 * rstd * g4.w + b4.w + bn * v3) * t3) << 16);
        *(uint2*)(cat + (size_t)t * DM + h * 64 + l16 * 4) = o2;
    }
}


__device__ __forceinline__ void d_mla_post3(const int vb, const bf16_t* __restrict__ qraw, const bf16_t* __restrict__ kvraw, const bf16_t* __restrict__ kvraw_ctx,
                                            const float* __restrict__ kpe, const float* __restrict__ cache_kpe, const float* __restrict__ qn,
                                            const float* __restrict__ kn, bf16_t* __restrict__ Qb, bf16_t* __restrict__ Kp, bf16_t* __restrict__ Ks) {
    const int g = threadIdx.x >> 4, l16 = threadIdx.x & 15;
    const float inv = __expf(-(float)l16 * (1.f / 16.f) * 9.210340371976184f);
    float2 qnv[6], knv[6];
#pragma unroll
    for (int j = 0; j < 6; j++) { qnv[j] = *(const float2*)(qn + 2 * (l16 + 16 * j)); knv[j] = *(const float2*)(kn + 2 * (l16 + 16 * j)); }
#pragma unroll 2
    for (int u = 0; u < 4; u++) {
        const int item = vb * 64 + g + 16 * u;
        const int row = item >> 2, h = item & 3;
        const bool isctx = row >= TT, sample = row >= TP;
        const bf16_t* kvr; const float* pe; int pos = 0;
        if (isctx) { const int cr = row - TT; kvr = kvraw_ctx + (size_t)cr * 1024; pe = cache_kpe + (size_t)cr * 64; }
        else { kvr = kvraw + (size_t)row * 1024; pe = kpe + (size_t)row * 64; pos = tok_pos(row); }
        float kx[12], qx[12];
#pragma unroll
        for (int j = 0; j < 4; j++) {
            const unsigned kw = *(const unsigned*)(kvr + h * 256 + 2 * (l16 + 16 * j));
            kx[2 * j] = __uint_as_float(kw << 16); kx[2 * j + 1] = __uint_as_float(kw & 0xffff0000u);
        }
#pragma unroll
        for (int j = 4; j < 6; j++) { const float2 pv = *(const float2*)(pe + 2 * (l16 + 16 * (j - 4))); kx[2 * j] = pv.x; kx[2 * j + 1] = pv.y; }
#pragma unroll
        for (int j = 0; j < 6; j++) {
            const unsigned qw = isctx ? 0u : *(const unsigned*)(qraw + (size_t)row * 768 + h * 192 + 2 * (l16 + 16 * j));
            qx[2 * j] = __uint_as_float(qw << 16); qx[2 * j + 1] = __uint_as_float(qw & 0xffff0000u);
        }
        float sk = 0.f, sq = 0.f;
#pragma unroll
        for (int j = 0; j < 12; j++) { sk += kx[j] * kx[j]; sq += qx[j] * qx[j]; }
        sk = row16_allsum(sk); sq = row16_allsum(sq);
        const float rk = rsqrtf(sk * (1.f / 192.f) + 1e-6f), rq = rsqrtf(sq * (1.f / 192.f) + 1e-6f);
#pragma unroll
        for (int j = 0; j < 6; j++) {
            kx[2 * j] *= rk * knv[j].x; kx[2 * j + 1] *= rk * knv[j].y;
            qx[2 * j] *= rq * qnv[j].x; qx[2 * j + 1] *= rq * qnv[j].y;
        }
        if (sample && !isctx) {
#pragma unroll
            for (int j = 4; j < 6; j++) {
                const float ang = (j == 4 ? (float)(pos >> 6) : (float)(pos & 63)) * inv;
                const float cs = __cosf(ang), sn = __sinf(ang);
                const float a = kx[2 * j], bq = kx[2 * j + 1];
                kx[2 * j] = a * cs - bq * sn; kx[2 * j + 1] = a * sn + bq * cs;
                const float a2 = qx[2 * j], b2 = qx[2 * j + 1];
                qx[2 * j] = a2 * cs - b2 * sn; qx[2 * j + 1] = a2 * sn + b2 * cs;
            }
        }
        bf16_t* kd;
        if (!sample) { const int b = row >> 8, pp = row & 255; kd = Kp + ((size_t)(b * 4 + h) * LP + pp) * 192; }
        else if (!isctx) { const int b = (row - TP) >> 11, pp = (row - TP) & 2047; kd = Ks + ((size_t)(b * 4 + h) * 2304 + 256 + pp) * 192; }
        else { const int cr = row - TT; const int b = cr >> 8, pp = cr & 255; kd = Ks + ((size_t)(b * 4 + h) * 2304 + pp) * 192; }
#pragma unroll
        for (int j = 0; j < 6; j++) {
            const int e = 2 * (l16 + 16 * j);
            *(unsigned*)(kd + e) = (unsigned)f2bf(kx[2 * j]) | ((unsigned)f2bf(kx[2 * j + 1]) << 16);
            if (!isctx) *(unsigned*)(Qb + ((size_t)row * 4 + h) * 192 + e) = (unsigned)f2bf(qx[2 * j]) | ((unsigned)f2bf(qx[2 * j + 1]) << 16);
        }
    }
}

#define XB_TMO      128
#define XB_XCNT(j)  (256  + 64 * (j))
#define XB_XSUB(j)  (1280 + 64 * (j))
#define XB_XGEN(j)  (2304 + 64 * (j))
#define XB_TOP      3328
#define XB_TOPGEN   3392
#define XCD_BAR_WORDS 3456
#define XB_SPIN_CAP (1u << 22)
#define LAS __attribute__((address_space(3)))
__device__ __forceinline__ unsigned xb_ld(unsigned* p) { return __hip_atomic_load(p, __ATOMIC_RELAXED, __HIP_MEMORY_SCOPE_AGENT); }
__device__ __forceinline__ unsigned xb_add(unsigned* p, unsigned v) { return __hip_atomic_fetch_add(p, v, __ATOMIC_RELAXED, __HIP_MEMORY_SCOPE_AGENT); }
__device__ __forceinline__ unsigned xb_xcc_id() { return (unsigned)__builtin_amdgcn_s_getreg((3 << 11) | 20) & 0xFu; }
#define XB_SPIN(cond, bar) do { unsigned _sp = 0; while (cond) { __builtin_amdgcn_s_sleep(1); \
    if ((++_sp & 255u) == 0u) { if (xb_ld(&(bar)[XB_TMO])) break; if (_sp > XB_SPIN_CAP) { atomicAdd(&(bar)[XB_TMO], 1u); break; } } } } while (0)
struct XcdBarrier { unsigned* bar; unsigned x; volatile LAS unsigned* st; };
__device__ __forceinline__ XcdBarrier xcd_barrier_post(unsigned* bar, volatile LAS unsigned* st) {
    XcdBarrier b; b.bar = bar; b.x = xb_xcc_id(); b.st = st;
    if (threadIdx.x == 0) (void)xb_add(&bar[XB_XCNT(b.x)], 1u);
    return b;
}
__device__ __forceinline__ void xcd_barrier_complete(unsigned* bar, unsigned x, unsigned& nloc, unsigned& nx) {
    const unsigned G = gridDim.x * gridDim.y * gridDim.z;
    unsigned sum, cnt, mine, sp = 0u;
    for (;;) {
        sum = 0u; cnt = 0u; mine = 0u;
#pragma unroll
        for (unsigned j = 0; j < 16; ++j) { const unsigned c = xb_ld(&bar[XB_XCNT(j)]); sum += c; cnt += (c > 0u) ? 1u : 0u; mine = (j == x) ? c : mine; }
        if (sum == G) break;
        __builtin_amdgcn_s_sleep(1);
        if ((++sp & 255u) == 0u) { if (xb_ld(&bar[XB_TMO])) break; if (sp > XB_SPIN_CAP) { atomicAdd(&bar[XB_TMO], 1u); break; } }
    }
    nloc = mine > 0u ? mine : 1u; nx = cnt > 0u ? cnt : 1u;
}
__device__ __forceinline__ void xcd_barrier_(unsigned* bar_, char* smem_) {
    XcdBarrier b; b.bar = bar_; b.x = xb_xcc_id(); b.st = (volatile LAS unsigned*)(smem_ + GEMM_LDS_BYTES);
    asm volatile("s_waitcnt vmcnt(0)" ::: "memory");
    __syncthreads();
    if (threadIdx.x == 0) {
        unsigned* bar = b.bar;
        __builtin_amdgcn_s_waitcnt(0);
        unsigned nloc = b.st[0], nx = b.st[1];
        if (nloc == 0u) { xcd_barrier_complete(bar, b.x, nloc, nx); b.st[0] = nloc; b.st[1] = nx; }
        const unsigned old = xb_add(&bar[XB_XSUB(b.x)], 1u);
        const unsigned gen = old / nloc;
        if (old + 1u == (gen + 1u) * nloc) {
            __builtin_amdgcn_fence(__ATOMIC_RELEASE, "agent");
            asm volatile("s_waitcnt vmcnt(0)" ::: "memory");
            const unsigned og = xb_add(&bar[XB_TOP], 1u);
            const unsigned tg = og / nx;
            if (og + 1u == (tg + 1u) * nx) xb_add(&bar[XB_TOPGEN], 1u);
            else XB_SPIN(xb_ld(&bar[XB_TOPGEN]) == tg, bar);
            __builtin_amdgcn_fence(__ATOMIC_ACQUIRE, "agent");
            xb_add(&bar[XB_XGEN(b.x)], 1u);
            asm volatile("s_waitcnt vmcnt(0)" ::: "memory");
        } else {
            XB_SPIN(xb_ld(&bar[XB_XGEN(b.x)]) == gen, bar);
            __builtin_amdgcn_fence(__ATOMIC_ACQUIRE, "agent");
            asm volatile("s_waitcnt vmcnt(0)" ::: "memory");
        }
    }
    __syncthreads();
}

constexpr size_t ws_al(size_t x) { return (x + 255) & ~(size_t)255; }
struct WS {
    static constexpr size_t mod = 0;
    static constexpr size_t w_in_t = ws_al(mod + (size_t)(2*5*6144*4));
    static constexpr size_t w_out_t = ws_al(w_in_t + (size_t)(2304*1024*2));
    static constexpr size_t hy_w_in_t = ws_al(w_out_t + (size_t)(1024*1024*2));
    static constexpr size_t hy_w_out_t = ws_al(hy_w_in_t + (size_t)(3072*1024*2));
    static constexpr size_t w_q_t = ws_al(hy_w_out_t + (size_t)(1024*1024*2));
    static constexpr size_t q_up_t = ws_al(w_q_t + (size_t)(2*2048*1024*2));
    static constexpr size_t kv_up_t = ws_al(q_up_t + (size_t)(768*256*2));
    static constexpr size_t w2_t = ws_al(kv_up_t + (size_t)(1024*128*2));
    static constexpr size_t a2_t = ws_al(w2_t + (size_t)(2*512*64*2));
    static constexpr size_t g2_t = ws_al(a2_t + (size_t)(2*512*64*2));
    static constexpr size_t ctxb = ws_al(g2_t + (size_t)(512*128*2));
    static constexpr size_t keysb = ws_al(ctxb + (size_t)(1024*128*2));
    static constexpr size_t tabU = ws_al(keysb + (size_t)(2*16*128*128*2));
    static constexpr size_t tabV = ws_al(tabU + (size_t)(16384*1024));
    static constexpr size_t rsU = ws_al(tabV + (size_t)(16384*1024));
    static constexpr size_t rsV = ws_al(rsU + (size_t)(16384*4));
    static constexpr size_t nsum = ws_al(rsV + (size_t)(16384*4));
    static constexpr size_t gTS = ws_al(nsum + (size_t)(2*1024*4 + 3456*4 + 1024));
    static constexpr size_t gTP = ws_al(gTS + (size_t)1024*2*2048*2);
    static constexpr size_t R1 = ws_al(gTP + (size_t)1024*2*256*2);
    static constexpr size_t R2 = ws_al(R1 + (size_t)((size_t)TT*1024*4));
    static constexpr size_t rb = ws_al(R2 + (size_t)((size_t)TT*1792*2 + (size_t)TT*448*4));
    static constexpr size_t kb = ws_al(rb + (size_t)((size_t)TT*512*2));
    static constexpr size_t vb = ws_al(kb + (size_t)((size_t)TT*512*2));
    static constexpr size_t kkb = ws_al(vb + (size_t)((size_t)TT*512*2));
    static constexpr size_t lr0 = ws_al(kkb + (size_t)((size_t)TT*512*2));
    static constexpr size_t lr1 = ws_al(lr0 + (size_t)((size_t)TT*512*2));
    static constexpr size_t gateb = ws_al(lr1 + (size_t)((size_t)TT*512*2));
    static constexpr size_t du0 = ws_al(gateb + (size_t)((size_t)TT*512*2));
    static constexpr size_t du1 = ws_al(du0 + (size_t)((size_t)TT*512*2));
    static constexpr size_t twb = ws_al(du1 + (size_t)((size_t)TT*512*2));
    static constexpr size_t advb = ws_al(twb + (size_t)((size_t)TT*64*2));
    static constexpr size_t sgb = ws_al(advb + (size_t)((size_t)TT*64*2));
    static constexpr size_t bonus = ws_al(sgb + (size_t)((size_t)TT*128*2));
    static constexpr size_t kpe = ws_al(bonus + (size_t)((size_t)TT*8*4));
    static constexpr size_t qcnb = ws_al(kpe + (size_t)((size_t)TT*64*4));
    static constexpr size_t ckvb = ws_al(qcnb + (size_t)((size_t)TT*256*2));
    static constexpr size_t Qb = ws_al(ckvb + (size_t)((size_t)TT*128*2));
    static constexpr size_t Kp = ws_al(Qb + (size_t)((size_t)TT*768*2));
    static constexpr size_t Vp = ws_al(Kp + (size_t)(16*4*256*192*2));
    static constexpr size_t Ks = ws_al(Vp + (size_t)(16*4*256*128*2));
    static constexpr size_t Vs = ws_al(Ks + (size_t)(4*4*2304*192*2));
    static constexpr size_t kvctxb = ws_al(Vs + (size_t)(4*4*2304*128*2));
    static constexpr size_t pidx = ws_al(kvctxb + (size_t)(1024*1024*2));
    static constexpr size_t pg = ws_al(pidx + (size_t)((size_t)TT*128*4));
    static constexpr size_t tab1 = ws_al(pg + (size_t)((size_t)TT*128*4));
    static constexpr size_t END = ws_al(tab1 + (nsum - tabU));
    static constexpr size_t hb = R1;
    static constexpr size_t catb = R1;
    static constexpr size_t zbb = R1;
    static constexpr size_t kvrawb = R1;
    static constexpr size_t qrawb = R1 + (size_t)TT*1024*2;
    static constexpr size_t projrw = R2;
    static constexpr size_t projmla = R2 + (size_t)TT*1792*2;
    static constexpr size_t y0 = R2;
    static constexpr size_t y1 = R2 + (size_t)TT*512*4;
    static constexpr size_t qb = R2;
    static constexpr size_t scT = rb;
    static constexpr size_t pre = R2;
    static constexpr size_t zT = R2 + (size_t)TT*3072*2;
    static constexpr size_t x0b = R2 + (size_t)TT*3072*2 + (size_t)TT*1024*2;
    static constexpr size_t yT = R2 + (size_t)TT*3072*2 + (size_t)TT*1024*4;
    static constexpr size_t bar = nsum + 2*1024*4;
};
struct Params {
    const float* in[46];
    float* out;
    char* ws;
    __device__ __forceinline__ const float* x_prompt() const { return in[0]; }
    __device__ __forceinline__ const float* x_sample() const { return in[1]; }
    __device__ __forceinline__ const float* st_f() const { return in[2]; }
    __device__ __forceinline__ const float* st_b() const { return in[3]; }
    __device__ __forceinline__ const float* cache_ckv() const { return in[4]; }
    __device__ __forceinline__ const float* cache_kpe() const { return in[5]; }
    __device__ __forceinline__ const float* c() const { return in[6]; }
    __device__ __forceinline__ const float* c_ctx() const { return in[7]; }
    __device__ __forceinline__ const float* norm_g() const { return in[8]; }
    __device__ __forceinline__ const float* w_mod() const { return in[9]; }
    __device__ __forceinline__ const float* b_mod() const { return in[10]; }
    __device__ __forceinline__ const float* ab_w_in() const { return in[11]; }
    __device__ __forceinline__ const float* rw_mu() const { return in[12]; }
    __device__ __forceinline__ const float* rw_w0() const { return in[13]; }
    __device__ __forceinline__ const float* rw_w2() const { return in[14]; }
    __device__ __forceinline__ const float* rw_a0() const { return in[15]; }
    __device__ __forceinline__ const float* rw_a2() const { return in[16]; }
    __device__ __forceinline__ const float* rw_g2() const { return in[17]; }
    __device__ __forceinline__ const float* rw_k_k() const { return in[18]; }
    __device__ __forceinline__ const float* rw_k_a() const { return in[19]; }
    __device__ __forceinline__ const float* rw_r_k() const { return in[20]; }
    __device__ __forceinline__ const float* rw_lnx_g() const { return in[21]; }
    __device__ __forceinline__ const float* rw_lnx_b() const { return in[22]; }
    __device__ __forceinline__ const float* mla_q_norm() const { return in[23]; }
    __device__ __forceinline__ const float* mla_q_up() const { return in[24]; }
    __device__ __forceinline__ const float* mla_kv_norm() const { return in[25]; }
    __device__ __forceinline__ const float* mla_kv_up() const { return in[26]; }
    __device__ __forceinline__ const float* mla_qn() const { return in[27]; }
    __device__ __forceinline__ const float* mla_kn() const { return in[28]; }
    __device__ __forceinline__ const float* ab_w_out() const { return in[29]; }
    __device__ __forceinline__ const float* hy_w_in() const { return in[30]; }
    __device__ __forceinline__ const float* hy_b_in() const { return in[31]; }
    __device__ __forceinline__ const float* hy_conv_w() const { return in[32]; }
    __device__ __forceinline__ const float* hy_conv_b() const { return in[33]; }
    __device__ __forceinline__ const float* hy_f_w1() const { return in[34]; }
    __device__ __forceinline__ const float* hy_f_b1() const { return in[35]; }
    __device__ __forceinline__ const float* hy_f_w2() const { return in[36]; }
    __device__ __forceinline__ const float* hy_f_b2() const { return in[37]; }
    __device__ __forceinline__ const float* hy_f_w3() const { return in[38]; }
    __device__ __forceinline__ const float* hy_f_freq() const { return in[39]; }
    __device__ __forceinline__ const float* hy_bias() const { return in[40]; }
    __device__ __forceinline__ const float* hy_w_out() const { return in[41]; }
    __device__ __forceinline__ const float* peer_w_q() const { return in[42]; }
    __device__ __forceinline__ const float* peer_keys() const { return in[43]; }
    __device__ __forceinline__ const float* peer_u() const { return in[44]; }
    __device__ __forceinline__ const float* peer_v() const { return in[45]; }
    __device__ __forceinline__ float* xrun() const { return out + (0); }
    __device__ __forceinline__ float* out_sf() const { return out + ((size_t)TT*DM); }
    __device__ __forceinline__ float* out_sb() const { return out + ((size_t)TT*DM + 16*8*64*64); }
    __device__ __forceinline__ float* out_ckv() const { return out + ((size_t)TT*DM + 2*16*8*64*64); }
    __device__ __forceinline__ float* out_kpe() const { return out + ((size_t)TT*DM + 2*16*8*64*64 + 16*256*128); }
    __device__ __forceinline__ float* mod() const { return (float*)(ws + WS::mod); }
    __device__ __forceinline__ bf16_t* w_in_t() const { return (bf16_t*)(ws + WS::w_in_t); }
    __device__ __forceinline__ bf16_t* w_out_t() const { return (bf16_t*)(ws + WS::w_out_t); }
    __device__ __forceinline__ bf16_t* hy_w_in_t() const { return (bf16_t*)(ws + WS::hy_w_in_t); }
    __device__ __forceinline__ bf16_t* hy_w_out_t() const { return (bf16_t*)(ws + WS::hy_w_out_t); }
    __device__ __forceinline__ bf16_t* w_q_t() const { return (bf16_t*)(ws + WS::w_q_t); }
    __device__ __forceinline__ bf16_t* q_up_t() const { return (bf16_t*)(ws + WS::q_up_t); }
    __device__ __forceinline__ bf16_t* kv_up_t() const { return (bf16_t*)(ws + WS::kv_up_t); }
    __device__ __forceinline__ bf16_t* w2_t() const { return (bf16_t*)(ws + WS::w2_t); }
    __device__ __forceinline__ bf16_t* a2_t() const { return (bf16_t*)(ws + WS::a2_t); }
    __device__ __forceinline__ bf16_t* g2_t() const { return (bf16_t*)(ws + WS::g2_t); }
    __device__ __forceinline__ bf16_t* ctxb() const { return (bf16_t*)(ws + WS::ctxb); }
    __device__ __forceinline__ bf16_t* keysb() const { return (bf16_t*)(ws + WS::keysb); }
    __device__ __forceinline__ unsigned char* tabU(int li = 0) const { return (unsigned char*)(ws + (li ? WS::tab1 : WS::tabU)); }
    __device__ __forceinline__ float* rsU(int li = 0) const { return (float*)(ws + (li ? WS::tab1 + (WS::rsU - WS::tabU) : WS::rsU)); }
    __device__ __forceinline__ float* rsV(int li = 0) const { return (float*)(ws + (li ? WS::tab1 + (WS::rsV - WS::tabU) : WS::rsV)); }
    __device__ __forceinline__ unsigned char* tabV(int li = 0) const { return (unsigned char*)(ws + (li ? WS::tab1 + (WS::tabV - WS::tabU) : WS::tabV)); }
    __device__ __forceinline__ float* nsum() const { return (float*)(ws + WS::nsum); }
    __device__ __forceinline__ bf16_t* rb() const { return (bf16_t*)(ws + WS::rb); }
    __device__ __forceinline__ bf16_t* kb() const { return (bf16_t*)(ws + WS::kb); }
    __device__ __forceinline__ bf16_t* vb() const { return (bf16_t*)(ws + WS::vb); }
    __device__ __forceinline__ bf16_t* kkb() const { return (bf16_t*)(ws + WS::kkb); }
    __device__ __forceinline__ bf16_t* lr0() const { return (bf16_t*)(ws + WS::lr0); }
    __device__ __forceinline__ bf16_t* lr1() const { return (bf16_t*)(ws + WS::lr1); }
    __device__ __forceinline__ bf16_t* gateb() const { return (bf16_t*)(ws + WS::gateb); }
    __device__ __forceinline__ _Float16* du0() const { return (_Float16*)(ws + WS::du0); }
    __device__ __forceinline__ _Float16* du1() const { return (_Float16*)(ws + WS::du1); }
    __device__ __forceinline__ bf16_t* twb() const { return (bf16_t*)(ws + WS::twb); }
    __device__ __forceinline__ bf16_t* advb() const { return (bf16_t*)(ws + WS::advb); }
    __device__ __forceinline__ bf16_t* sgb() const { return (bf16_t*)(ws + WS::sgb); }
    __device__ __forceinline__ float* bonus() const { return (float*)(ws + WS::bonus); }
    __device__ __forceinline__ float* kpe() const { return (float*)(ws + WS::kpe); }
    __device__ __forceinline__ bf16_t* qcnb() const { return (bf16_t*)(ws + WS::qcnb); }
    __device__ __forceinline__ bf16_t* ckvb() const { return (bf16_t*)(ws + WS::ckvb); }
    __device__ __forceinline__ bf16_t* Qb() const { return (bf16_t*)(ws + WS::Qb); }
    __device__ __forceinline__ bf16_t* Kp() const { return (bf16_t*)(ws + WS::Kp); }
    __device__ __forceinline__ bf16_t* Vp() const { return (bf16_t*)(ws + WS::Vp); }
    __device__ __forceinline__ bf16_t* Ks() const { return (bf16_t*)(ws + WS::Ks); }
    __device__ __forceinline__ bf16_t* Vs() const { return (bf16_t*)(ws + WS::Vs); }
    __device__ __forceinline__ bf16_t* kvctxb() const { return (bf16_t*)(ws + WS::kvctxb); }
    __device__ __forceinline__ int* pidx() const { return (int*)(ws + WS::pidx); }
    __device__ __forceinline__ float* pg() const { return (float*)(ws + WS::pg); }
    __device__ __forceinline__ bf16_t* hb() const { return (bf16_t*)(ws + WS::hb); }
    __device__ __forceinline__ bf16_t* catb() const { return (bf16_t*)(ws + WS::catb); }
    __device__ __forceinline__ bf16_t* zbb() const { return (bf16_t*)(ws + WS::zbb); }
    __device__ __forceinline__ bf16_t* kvrawb() const { return (bf16_t*)(ws + WS::kvrawb); }
    __device__ __forceinline__ bf16_t* qrawb() const { return (bf16_t*)(ws + WS::qrawb); }
    __device__ __forceinline__ bf16_t* projrw() const { return (bf16_t*)(ws + WS::projrw); }
    __device__ __forceinline__ float* projmla() const { return (float*)(ws + WS::projmla); }
    __device__ __forceinline__ float* y0() const { return (float*)(ws + WS::y0); }
    __device__ __forceinline__ float* y1() const { return (float*)(ws + WS::y1); }
    __device__ __forceinline__ bf16_t* qb() const { return (bf16_t*)(ws + WS::qb); }
    __device__ __forceinline__ float* scT() const { return (float*)(ws + WS::scT); }
    __device__ __forceinline__ bf16_t* pre() const { return (bf16_t*)(ws + WS::pre); }
    __device__ __forceinline__ bf16_t* zT() const { return (bf16_t*)(ws + WS::zT); }
    __device__ __forceinline__ bf16_t* x0b() const { return (bf16_t*)(ws + WS::x0b); }
    __device__ __forceinline__ bf16_t* yT() const { return (bf16_t*)(ws + WS::yT); }
    __device__ __forceinline__ bf16_t* gTS() const { return (bf16_t*)(ws + WS::gTS); }
    __device__ __forceinline__ bf16_t* gTP() const { return (bf16_t*)(ws + WS::gTP); }
    __device__ __forceinline__ unsigned* bar() const { return (unsigned*)(ws + WS::bar); }
};

#define VLOOP(n) for (int vb = blockIdx.x; vb < (n); vb += gridDim.x)
#define ENDV __syncthreads();

#define QLOOP(ctr_word, nitems, ...)                                                            \
    {                                                                                           \
        unsigned* qctr = p.bar() + XCD_BAR_WORDS + 128 + (ctr_word);                            \
        volatile unsigned* bc = (volatile unsigned*)(smem + GEMM_LDS_BYTES + 8);                \
        for (;;) {                                                                              \
            if (threadIdx.x == 0) *bc = atomicAdd(qctr, 1u);                                    \
            __syncthreads();                                                                    \
            const int item = __builtin_amdgcn_readfirstlane((int)*bc);                          \
            __syncthreads();                                                                    \
            if (item >= (nitems)) break;                                                        \
            __VA_ARGS__                                                                         \
        }                                                                                       \
    }
__device__ __forceinline__ void peer_layer(const Params& p, char* smem, int li, const float* modl, float* xrs) {
    const bf16_t* wq = p.w_q_t() + (size_t)li * 2048 * 1024;
    const bf16_t* kys = p.keysb() + (size_t)li * 16 * 128 * 128;
    VLOOP(TT / 8) { d_norm_mod2(vb, p.xrun(), xrs, p.norm_g() + (li * 2 + 1) * 1024, modl, 3, 4, p.hb()); }
    xcd_barrier_(p.bar(), smem);
    VLOOP(16 * 96) { d_gemm_bf16(vb % 16, vb / 16, smem, p.hb(), 1024, wq, 1024, 1024, 2048, EpiStoreBf{p.qb(), 2048, 0}); }
    xcd_barrier_(p.bar(), smem);
    VLOOP(8 * 96) { d_peer_route2(vb, smem, kys, p.qb(), p.pidx(), p.pg()); ENDV }
    xcd_barrier_(p.bar(), smem);
    VLOOP(TT / 4) { d_peer_apply3(vb, smem, p.hb(), p.pidx(), p.pg(), p.tabU(li), p.tabV(li), p.rsU(li), p.rsV(li), modl, p.xrun(),
                                    li == 0 ? p.norm_g() + 2048 : nullptr, p.mod() + 5 * 6144, p.hb()); ENDV }
}

__global__ void __launch_bounds__(256, 2) mega(Params p) {
    __shared__ __attribute__((aligned(16))) char smem[GEMM_LDS_BYTES + 16];
    cg::grid_group grid = cg::this_grid();
    if (threadIdx.x < 4) ((unsigned*)(smem + GEMM_LDS_BYTES))[threadIdx.x] = 0u;
    __syncthreads();
    (void)xcd_barrier_post(p.bar(), (volatile LAS unsigned*)(smem + GEMM_LDS_BYTES));
    const float* mod0 = p.mod();
    const float* mod1 = p.mod() + 5 * 6144;
    float* xrs = p.xrun() + (size_t)TP * DM;

    VLOOP(192) { d_mod3(vb, smem, p.c(), p.c_ctx(), p.w_mod(), p.b_mod(), p.mod()); ENDV }
    if (p.ws == nullptr) grid.sync();
    xcd_barrier_(p.bar(), smem);
    VLOOP(TT / 8) { d_norm_mod2(vb, p.x_prompt(), p.x_sample(), p.norm_g(), mod0, 0, 1, p.hb()); }
    {
        const int j1 = 36 * 16;
        const int j7 = j1 + 12 * 4;
        const int j8 = j7 + 16 * 2;
        const int j9 = j8 + 8;
        const int j10 = j9 + 8;
        const int j11 = j10 + 8;
        const int j12 = j11 + 8;
        const int j13 = j12 + 8 * 2;
        VLOOP(j13) {
            const float* W; bf16_t* Wt; int K, N, lv;
            if (vb < j1) { W = p.ab_w_in(); Wt = p.w_in_t(); K = 1024; N = 2240; lv = vb; }
            else if (vb < j7) { W = p.mla_q_up(); Wt = p.q_up_t(); K = 256; N = 768; lv = vb - j1; }
            else if (vb < j8) { W = p.mla_kv_up(); Wt = p.kv_up_t(); K = 128; N = 1024; lv = vb - j7; }
            else if (vb < j9) { W = p.rw_w2(); Wt = p.w2_t(); K = 64; N = 512; lv = vb - j8; }
            else if (vb < j10) { W = p.rw_w2() + 64 * 512; Wt = p.w2_t() + 512 * 64; K = 64; N = 512; lv = vb - j9; }
            else if (vb < j11) { W = p.rw_a2(); Wt = p.a2_t(); K = 64; N = 512; lv = vb - j10; }
            else if (vb < j12) { W = p.rw_a2() + 64 * 512; Wt = p.a2_t() + 512 * 64; K = 64; N = 512; lv = vb - j11; }
            else { W = p.rw_g2(); Wt = p.g2_t(); K = 128; N = 512; lv = vb - j12; }
            d_transpose_w(lv, smem, W, K, N, Wt);
            ENDV }
    }
    VLOOP(40) { if (vb < 8) d_cvt_bf16(vb, p.cache_ckv(), p.ctxb()); else d_cvt_bf16(vb - 8, p.peer_keys(), p.keysb()); }
    xcd_barrier_(p.bar(), smem);
    VLOOP(18 * 96) { d_gemm_bf16(vb % 18, vb / 18, smem, p.hb(), 1024, p.w_in_t(), 1024, 1024, ABIN, EpiProj{p.projrw(), p.projmla()}); }
    xcd_barrier_(p.bar(), smem);
    VLOOP(2688 + 768) {
        if (vb < 2688) d_rw_shift2(vb, p.projrw(), p.rw_mu(), p.rb(), p.kb(), p.vb(), p.twb(), p.advb(), p.sgb());
        else d_mla_pre2(vb - 2688, p.projmla(), p.mla_q_norm(), p.mla_kv_norm(), p.qcnb(), p.ckvb(), p.kpe(), p.out_ckv(), p.out_kpe());
    }
    xcd_barrier_(p.bar(), smem);
    {
        const int n0 = 4 * 96, n1 = 6 * 96, n2 = 8 * 96, n3 = 8 * 8;
        VLOOP(5 * n0 + n1 + n2 + n3) {
            int v = vb;
            if (v < n0) d_gemm_bf16(v % 4, v / 4, smem, p.twb(), 64, p.w2_t(), 64, 64, 512, EpiDecay{p.du0(), p.rw_w0()});
            else if ((v -= n0) < n0) d_gemm_bf16(v % 4, v / 4, smem, p.twb(), 64, p.w2_t() + 512 * 64, 64, 64, 512, EpiDecay{p.du1(), p.rw_w0() + 512});
            else if ((v -= n0) < n0) d_gemm_bf16(v % 4, v / 4, smem, p.advb(), 64, p.a2_t(), 64, 64, 512, EpiLr{p.lr0(), p.rw_a0()});
            else if ((v -= n0) < n0) d_gemm_bf16(v % 4, v / 4, smem, p.advb(), 64, p.a2_t() + 512 * 64, 64, 64, 512, EpiLr{p.lr1(), p.rw_a0() + 512});
            else if ((v -= n0) < n0) d_gemm_bf16(v % 4, v / 4, smem, p.sgb(), 128, p.g2_t(), 128, 128, 512, EpiStoreBf{p.gateb(), 512, 0});
            else if ((v -= n0) < n1) d_gemm_bf16(v % 6, v / 6, smem, p.qcnb(), 256, p.q_up_t(), 256, 256, 768, EpiStoreBf{p.qrawb(), 768, 0});
            else if ((v -= n1) < n2) d_gemm_bf16(v % 8, v / 8, smem, p.ckvb(), 128, p.kv_up_t(), 128, 128, 1024, EpiKV{p.kvrawb(), p.Vp(), p.Vs(), 0, 0});
            else { v -= n2; d_gemm_bf16(v % 8, v / 8, smem, p.ctxb(), 128, p.kv_up_t(), 128, 128, 1024, EpiKV{p.kvctxb(), p.Vp(), p.Vs(), 1, 0}); }
        }
    }
    xcd_barrier_(p.bar(), smem);
    VLOOP(1536 + 832) {
        if (vb < 1536) d_rw_kk3(vb, p.rb(), p.kb(), p.lr0(), p.lr1(), p.rw_k_k(), p.rw_k_a(), p.rw_r_k(), p.kkb(), p.bonus());
        else d_mla_post3(vb - 1536, p.qrawb(), p.kvrawb(), p.kvctxb(), p.kpe(), p.cache_kpe(), p.mla_qn(), p.mla_kn(), p.Qb(), p.Kp(), p.Ks());
        ENDV }
    xcd_barrier_(p.bar(), smem);
    QLOOP(7, 320, {
        const bool smp = item < 64;
        if (smp) __builtin_amdgcn_s_setprio(3);
        d_scan3(smp ? item : item - 64, smp, smem, p.rb(), p.kb(), p.vb(), p.kkb(), p.lr0(), p.lr1(), p.du0(), p.du1(), p.rw_k_a(), p.st_f(), p.st_b(), p.y0(), p.y1(), p.out_sf(), p.out_sb());
        __builtin_amdgcn_s_setprio(0);
    })
    QLOOP(0, 384, {
        const bool smp = item < 256;
        d_attn_mfma(smp ? item : item - 256, smem, p.Qb(), smp ? p.Ks() : p.Kp(), smp ? p.Vs() : p.Vp(), p.catb(), smp ? TP : 0, smp ? LS : LP,
                    smp ? 2304 : LP, smp ? 16 : 2);
    })
    QLOOP(2, 2048, {
        const bool isv = item >= 1024;
        d_cvt_fp8_rows(isv ? item - 1024 : item, isv ? p.peer_v() : p.peer_u(), isv ? p.tabV() : p.tabU(), isv ? p.rsV() : p.rsU());
    })
    QLOOP(3, 768, {
        const bool a_ = item < 256;
        d_transpose_w(a_ ? item : item - 256, smem, a_ ? p.ab_w_out() : p.peer_w_q(), 1024, a_ ? 1024 : 2048, a_ ? p.w_out_t() : p.w_q_t());
    })
    QLOOP(1, 576, {
        const bool smp = item < 512;
        d_hy_filt2(smp ? item : item - 512, smem, smp ? LS : LP, p.hy_f_w1(), p.hy_f_b1(), p.hy_f_w2(), p.hy_f_b2(), p.hy_f_w3(), p.hy_f_freq(),
                   smp ? p.gTS() : p.gTP(), smp ? p.nsum() : p.nsum() + 1024);
    })
    QLOOP(4, 1536, {
        const int t1 = 48 * 16, t2 = t1 + 16 * 16;
        const float* W; bf16_t* Wt; int N, lv;
        if (item < t1) { W = p.hy_w_in(); Wt = p.hy_w_in_t(); N = 3072; lv = item; }
        else if (item < t2) { W = p.hy_w_out(); Wt = p.hy_w_out_t(); N = 1024; lv = item - t1; }
        else { W = p.peer_w_q() + (size_t)1024 * 2048; Wt = p.w_q_t() + (size_t)2048 * 1024; N = 2048; lv = item - t2; }
        d_transpose_w(lv, smem, W, 1024, N, Wt);
    })
    QLOOP(8, 2048, {
        const bool isv = item >= 1024;
        d_cvt_fp8_rows(isv ? item - 1024 : item, (isv ? p.peer_v() : p.peer_u()) + (size_t)16384 * 1024, isv ? p.tabV(1) : p.tabU(1), isv ? p.rsV(1) : p.rsU(1));
    })
    xcd_barrier_(p.bar(), smem);
    VLOOP(1536) { d_rw_post3(vb, p.y0(), p.y1(), p.bonus(), p.vb(), p.gateb(), p.rw_lnx_g(), p.rw_lnx_b(), p.catb()); }
    xcd_barrier_(p.bar(), smem);
    QLOOP(5, 480 + 576, {
        if (item < 480) d_gemm_bf16n<2>(item % 5, item / 5, smem, p.catb(), 1024, p.w_out_t(), 1024, 1024, 1024, EpiResid{p.x_prompt(), p.x_sample(), p.xrun(), mod0, 2, 0});
        else { const int it = item - 480; d_gemm_bf16n<1>(10 + it % 6, it / 6, smem, p.catb(), 1024, p.w_out_t(), 1024, 1024, 1024, EpiResid{p.x_prompt(), p.x_sample(), p.xrun(), mod0, 2, 0}); }
    })
    xcd_barrier_(p.bar(), smem);
    peer_layer(p, smem, 0, mod0, xrs);
    xcd_barrier_(p.bar(), smem);
    VLOOP(24 * 96) { d_gemm_bf16(vb % 24, vb / 24, smem, p.hb(), 1024, p.hy_w_in_t(), 1024, 1024, 3072, EpiStoreBfBias{p.pre(), p.hy_b_in(), 3072, 0}); }
    xcd_barrier_(p.bar(), smem);
    VLOOP(192 * 8) { d_hy_dw3(vb, smem, p.pre(), p.hy_conv_w(), p.hy_conv_b(), p.zT(), p.x0b()); ENDV }
    xcd_barrier_(p.bar(), smem);
    VLOOP(512 + 512) {
        const int wv = threadIdx.x >> 6;
        char* wsm = smem + (wv >> 1) * 28672;
        if (vb < 512) d_hy_conv2<true>(vb * 2 + (wv >> 1), wv & 1, wsm, p.gTS(), p.nsum(), p.zT(), p.hy_bias(), p.yT());
        else d_hy_conv2<false>((vb - 512) * 2 + (wv >> 1), wv & 1, wsm, p.gTP(), p.nsum() + 1024, p.zT(), p.hy_bias(), p.yT());
        ENDV }
    xcd_barrier_(p.bar(), smem);
    VLOOP(192 * 8) { d_hy_post2(vb, smem, p.yT(), p.x0b(), p.zbb()); ENDV }
    xcd_barrier_(p.bar(), smem);
    QLOOP(6, 480 + 576, {
        if (item < 480) d_gemm_bf16n<2>(item % 5, item / 5, smem, p.zbb(), 1024, p.hy_w_out_t(), 1024, 1024, 1024, EpiResid{p.xrun(), xrs, p.xrun(), mod1, 2, 0});
        else { const int it = item - 480; d_gemm_bf16n<1>(10 + it % 6, it / 6, smem, p.zbb(), 1024, p.hy_w_out_t(), 1024, 1024, 1024, EpiResid{p.xrun(), xrs, p.xrun(), mod1, 2, 0}); }
    })
    xcd_barrier_(p.bar(), smem);
    peer_layer(p, smem, 1, mod1, xrs);
}

static inline size_t align_up(size_t x) { return (x + 255) & ~(size_t)255; }

extern "C" void kernel_launch(void* const* d_in, const int* in_sizes, int n_in, void* d_out, int out_size, void* d_ws, size_t ws_size,
                              hipStream_t stream) {
    Params p{};
    for (int i = 0; i < 46; i++) p.in[i] = (const float*)d_in[i];
    p.out = (float*)d_out;
    p.ws = (char*)d_ws;
    static_assert(WS::END <= (size_t)422781952, "workspace plan exceeds the guaranteed scratch size");
    static int grid_blocks = 0;
    if (!grid_blocks) {
        int dev = 0, cus = 0, per_cu = 0;
        (void)hipGetDevice(&dev);
        (void)hipDeviceGetAttribute(&cus, hipDeviceAttributeMultiprocessorCount, dev);
        (void)hipOccupancyMaxActiveBlocksPerMultiprocessor(&per_cu, mega, 256, 0);
        if (per_cu > 2) per_cu = 2;
        if (per_cu < 1) per_cu = 1;
        grid_blocks = cus * per_cu;
    }
    (void)hipMemsetAsync(p.ws + WS::nsum, 0, (size_t)2 * 1024 * 4 + (size_t)XCD_BAR_WORDS * 4 + 1024, stream);
    (void)hipMemsetAsync(p.ws + WS::mod, 0, (size_t)2 * 5 * 6144 * 4, stream);
    void* args[] = {&p};
    (void)hipLaunchCooperativeKernel((void*)mega, dim3(grid_blocks), dim3(256), args, 0, stream);
}
```
